# Optimizing an MI355X kernel written in HIP

```python
import math
import jax, jax.numpy as jnp
from jax import lax
import numpy as np

D_MODEL = 1024
BATCH = 16
SEQ = 2048
DEPTH = 2

D_MIX = D_MODEL
D_ATTN = D_MIX // 2
D_POOL = D_MIX - D_ATTN
N_HEADS = 8
HEAD_DIM = D_ATTN // N_HEADS
ROT_DIM = HEAD_DIM // 4
ROPE_THETA = 500000.0
MOBA_BLOCK = 256
MOBA_TOPK = 3
Q_CHUNK = 32
POOL_WINDOWS = (2, 4, 8, 16)
N_POOL_GROUPS = len(POOL_WINDOWS)
POOL_GROUP = D_POOL // N_POOL_GROUPS
D_IN = 3 * D_ATTN + D_POOL
N_EXPERTS = 16
N_EXPERT_GROUPS = 4
EXPERTS_PER_GROUP = N_EXPERTS // N_EXPERT_GROUPS
TOP_K = 2
D_EXPERT = 512
DEEPNORM_ALPHA = (2 * DEPTH) ** 0.25
DEEPNORM_BETA = (8 * DEPTH) ** -0.25
N_MOD = 6
LN_EPS = 1e-5
NEG_INF = -1e30

kernel_name = "hymba_moba_pool_grouped_moe_deepnorm"


def layer_norm_plain(x):
    xf = x.astype(jnp.float32)
    mu = xf.mean(-1, keepdims=True)
    var = jnp.square(xf - mu).mean(-1, keepdims=True)
    return ((xf - mu) * lax.rsqrt(var + LN_EPS)).astype(x.dtype)


def layer_norm_affine(x, g, b):
    xf = x.astype(jnp.float32)
    mu = xf.mean(-1, keepdims=True)
    var = jnp.square(xf - mu).mean(-1, keepdims=True)
    y = (xf - mu) * lax.rsqrt(var + LN_EPS) * g.astype(jnp.float32) + b.astype(jnp.float32)
    return y.astype(x.dtype)


def split_heads(t):
    B, S, _ = t.shape
    return t.reshape(B, S, N_HEADS, HEAD_DIM).transpose(0, 2, 1, 3)


def partial_rope(x, pos):
    half = ROT_DIM // 2
    inv_freq = ROPE_THETA ** (-(jnp.arange(half, dtype=jnp.float32) * 2.0 / ROT_DIM))
    ang = pos.astype(jnp.float32)[:, None] * inv_freq[None, :]
    cos, sin = jnp.cos(ang), jnp.sin(ang)
    xr = x[..., :ROT_DIM].astype(jnp.float32)
    x1, x2 = xr[..., :half], xr[..., half:]
    rot = jnp.concatenate([x1 * cos - x2 * sin, x2 * cos + x1 * sin], axis=-1).astype(x.dtype)
    return jnp.concatenate([rot, x[..., ROT_DIM:]], axis=-1)


def moba_attention(q, k, v):
    B, H, S, Dh = q.shape
    n_blk = -(-S // MOBA_BLOCK)
    S_pad = n_blk * MOBA_BLOCK
    pad = ((0, 0), (0, 0), (0, S_pad - S), (0, 0))
    q, k, v = jnp.pad(q, pad), jnp.pad(k, pad), jnp.pad(v, pad)
    n_sel = min(MOBA_TOPK, n_blk - 1)
    scale = HEAD_DIM ** -0.5
    kb = k.reshape(B, H, n_blk, MOBA_BLOCK, Dh)
    vb = v.reshape(B, H, n_blk, MOBA_BLOCK, Dh)
    qblk = jnp.arange(S_pad) // MOBA_BLOCK
    if n_sel > 0:
        kbar = kb.astype(jnp.float32).mean(axis=3)
        gate = jnp.einsum('bhsd,bhnd->bhsn', q.astype(jnp.float32), kbar)
        past = jnp.arange(n_blk)[None, :] < qblk[:, None]
        gate = jnp.where(past, gate, NEG_INF)
        _, sel = lax.top_k(gate, n_sel)
        sel_ok = jnp.arange(n_sel)[None, :] < qblk[:, None]
    else:
        sel = jnp.zeros((B, H, S_pad, 0), jnp.int32)
        sel_ok = jnp.zeros((S_pad, 0), bool)
    n_chunk = S_pad // Q_CHUNK
    q_all = q.reshape(B, H, n_chunk, Q_CHUNK, Dh).transpose(2, 0, 1, 3, 4)
    sel_all = sel.reshape(B, H, n_chunk, Q_CHUNK, n_sel).transpose(2, 0, 1, 3, 4)
    ok_all = sel_ok.reshape(n_chunk, Q_CHUNK, n_sel)
    starts = jnp.arange(n_chunk, dtype=jnp.int32) * Q_CHUNK
    b_ix = jnp.arange(B)[:, None, None]
    h_ix = jnp.arange(H)[None, :, None]

    def chunk(args):
        qc, selc, okc, start = args
        blk_start = (start // MOBA_BLOCK) * MOBA_BLOCK
        k_own = lax.dynamic_slice_in_dim(k, blk_start, MOBA_BLOCK, axis=2)
        v_own = lax.dynamic_slice_in_dim(v, blk_start, MOBA_BLOCK, axis=2)
        qp = start + jnp.arange(Q_CHUNK)
        kp = blk_start + jnp.arange(MOBA_BLOCK)
        own = jnp.einsum('bhqd,bhkd->bhqk', qc, k_own, preferred_element_type=jnp.float32) * scale
        logits = [jnp.where(kp[None, :] <= qp[:, None], own, NEG_INF)]
        for r in range(n_sel):
            kg = kb[b_ix, h_ix, selc[..., r]]
            lr = jnp.einsum('bhqd,bhqkd->bhqk', qc, kg, preferred_element_type=jnp.float32) * scale
            logits.append(jnp.where(okc[:, r][:, None], lr, NEG_INF))
        p = jax.nn.softmax(jnp.concatenate(logits, axis=-1), axis=-1)
        ps = jnp.split(p, n_sel + 1, axis=-1)
        out = jnp.einsum('bhqk,bhkd->bhqd', ps[0].astype(v.dtype), v_own, preferred_element_type=jnp.float32)
        for r in range(n_sel):
            vg = vb[b_ix, h_ix, selc[..., r]]
            out = out + jnp.einsum('bhqk,bhqkd->bhqd', ps[r + 1].astype(v.dtype), vg, preferred_element_type=jnp.float32)
        return out.astype(v.dtype)

    out = lax.map(chunk, (q_all, sel_all, ok_all, starts))
    return out.transpose(1, 2, 0, 3, 4).reshape(B, H, S_pad, Dh)[:, :, :S]


def pool_mixer(p, w_pool, pool_scale):
    B, S, _ = p.shape
    pf = p.astype(jnp.float32).reshape(B, S, N_POOL_GROUPS, POOL_GROUP)
    cs = jnp.concatenate([jnp.zeros_like(pf[:, :1]), jnp.cumsum(pf, axis=1)], axis=1)
    t = jnp.arange(1, S + 1, dtype=jnp.float32)
    outs = []
    for g, w in enumerate(POOL_WINDOWS):
        hi = cs[:, 1:, g]
        lo = jnp.concatenate([jnp.zeros_like(cs[:, :w - 1, g]), cs[:, :S - w + 1, g]], axis=1)
        cnt = jnp.minimum(t, float(w))[None, :, None]
        outs.append((hi - lo) / cnt - pf[:, :, g])
    d = jnp.stack(outs, axis=2).astype(p.dtype)
    y = jnp.einsum('bsgc,gce->bsge', d, w_pool).reshape(B, S, D_POOL)
    return y * pool_scale


def grouped_moe(h, w_router, router_bias, w_gate, w_up, w_down):
    B, S, D = h.shape
    hf = h.reshape(B * S, D)
    scores = jax.nn.softmax((hf @ w_router).astype(jnp.float32), axis=-1)
    sel = scores + router_bias.astype(jnp.float32)
    grp = sel.reshape(-1, N_EXPERT_GROUPS, EXPERTS_PER_GROUP)
    grp_score = lax.top_k(grp, TOP_K)[0].sum(-1)
    best = jnp.argmax(grp_score, axis=-1)
    in_grp = (jnp.arange(N_EXPERTS) // EXPERTS_PER_GROUP)[None, :] == best[:, None]
    _, idx = lax.top_k(jnp.where(in_grp, sel, NEG_INF), TOP_K)
    wts = jnp.take_along_axis(scores, idx, axis=-1)
    wts = wts / wts.sum(-1, keepdims=True)
    gates = jnp.sum(jax.nn.one_hot(idx, N_EXPERTS, dtype=jnp.float32) * wts[..., None], axis=1)
    y = jnp.zeros((B * S, D), jnp.float32)
    for e in range(N_EXPERTS):
        a = jax.nn.silu(hf @ w_gate[e]) * (hf @ w_up[e])
        y = y + gates[:, e:e + 1] * (a @ w_down[e]).astype(jnp.float32)
    return y.astype(h.dtype).reshape(B, S, D)


def setup_inputs(seed: int = 0) -> dict:
    key = jax.random.key(seed)
    ks = jax.random.split(key, 20)
    f32 = jnp.float32
    nrm = lambda k, shape, s: jax.random.normal(k, shape, f32) * s
    x = jax.random.normal(ks[0], (BATCH, SEQ, D_MODEL), f32)
    c = jax.random.normal(ks[1], (BATCH, D_MODEL), f32)
    w_mod = nrm(ks[2], (DEPTH, D_MODEL, N_MOD * D_MODEL), 0.5 * D_MODEL ** -0.5)
    b_mod = nrm(ks[3], (DEPTH, N_MOD * D_MODEL), 0.02)
    w_in = nrm(ks[4], (DEPTH, D_MODEL, D_IN), D_MODEL ** -0.5)
    col_scale = jnp.concatenate([jnp.ones((2 * D_ATTN,), f32),
                                 jnp.full((D_ATTN,), DEEPNORM_BETA, f32),
                                 jnp.ones((D_POOL,), f32)])
    w_in = w_in * col_scale
    w_pool = nrm(ks[5], (DEPTH, N_POOL_GROUPS, POOL_GROUP, POOL_GROUP), POOL_GROUP ** -0.5 * DEEPNORM_BETA)
    pool_scale = 1.0 + nrm(ks[6], (DEPTH, D_POOL), 0.1)
    w_out = nrm(ks[7], (DEPTH, D_MIX, D_MODEL), D_MIX ** -0.5 * DEEPNORM_BETA)
    ln1_g = 1.0 + nrm(ks[8], (DEPTH, D_MODEL), 0.05)
    ln1_b = nrm(ks[9], (DEPTH, D_MODEL), 0.02)
    w_router = nrm(ks[10], (D_MODEL, N_EXPERTS), D_MODEL ** -0.5)
    router_bias = nrm(ks[11], (N_EXPERTS,), 0.01)
    w_gate = nrm(ks[12], (DEPTH, N_EXPERTS, D_MODEL, D_EXPERT), D_MODEL ** -0.5)
    w_up = nrm(ks[13], (DEPTH, N_EXPERTS, D_MODEL, D_EXPERT), D_MODEL ** -0.5)
    w_down = nrm(ks[14], (DEPTH, N_EXPERTS, D_EXPERT, D_MODEL), D_EXPERT ** -0.5 * DEEPNORM_BETA)
    ln2_g = 1.0 + nrm(ks[15], (DEPTH, D_MODEL), 0.05)
    ln2_b = nrm(ks[16], (DEPTH, D_MODEL), 0.02)
    return {"x": x, "c": c, "w_mod": w_mod, "b_mod": b_mod, "w_in": w_in,
            "w_pool": w_pool, "pool_scale": pool_scale, "w_out": w_out,
            "ln1_g": ln1_g, "ln1_b": ln1_b, "w_router": w_router,
            "router_bias": router_bias, "w_gate": w_gate, "w_up": w_up,
            "w_down": w_down, "ln2_g": ln2_g, "ln2_b": ln2_b}


def reference(x, c, w_mod, b_mod, w_in, w_pool, pool_scale, w_out, ln1_g, ln1_b,
              w_router, router_bias, w_gate, w_up, w_down, ln2_g, ln2_b):
    B, S, D = x.shape
    pos = jnp.arange(S)
    cond = jax.nn.silu(c)
    for l in range(DEPTH):
        mod = cond @ w_mod[l] + b_mod[l]
        sh1, sc1, g1, sh2, sc2, g2 = [m[:, None, :] for m in jnp.split(mod, N_MOD, axis=-1)]
        h = layer_norm_plain(x) * (1 + sc1) + sh1
        proj = h @ w_in[l]
        q, k, v, p = jnp.split(proj, [D_ATTN, 2 * D_ATTN, 3 * D_ATTN], axis=-1)
        q = partial_rope(split_heads(q), pos)
        k = partial_rope(split_heads(k), pos)
        a = moba_attention(q, k, split_heads(v))
        a = a.transpose(0, 2, 1, 3).reshape(B, S, D_ATTN)
        m = pool_mixer(p, w_pool[l], pool_scale[l])
        y = jnp.concatenate([a, m], axis=-1) @ w_out[l]
        x = layer_norm_affine(DEEPNORM_ALPHA * x + g1 * y, ln1_g[l], ln1_b[l])
        h = layer_norm_plain(x) * (1 + sc2) + sh2
        y = grouped_moe(h, w_router, router_bias, w_gate[l], w_up[l], w_down[l])
        x = layer_norm_affine(DEEPNORM_ALPHA * x + g2 * y, ln2_g[l], ln2_b[l])
    return x
```

```cpp
#include <hip/hip_runtime.h>
#include <cstdint>
#include <cstdio>

constexpr int NB = 16, SEQ = 2048, DM = 1024, NTOK = NB * SEQ, DIN = 2048, NH = 8, HD = 64, NBLK = 8, MBLK = 256;
constexpr int NE = 16, NCLS = 24, DE = 512, NMOD = 6 * DM;
constexpr float ALPHA = 1.41421356237309515f, LN_EPS = 1e-5f;
constexpr float QSCALE = 0.125f * 1.4426950408889634f;
constexpr int LISTCAP = NTOK;

constexpr size_t MiB = 1u << 20;
constexpr size_t WS_CTL = 0, CTL_ZERO_BYTES = 1 * MiB;
constexpr size_t WS_MOD = 1 * MiB;
constexpr size_t WS_ROPE = 2 * MiB;
constexpr size_t WS_KBAR = 2 * MiB + 256 * 1024;
constexpr size_t WS_LIST = 3 * MiB;
constexpr size_t WS_RW = 6 * MiB;
constexpr size_t WS_WIN = 12 * MiB;
constexpr size_t WS_WOUT = 20 * MiB;
constexpr size_t WS_WGU = 24 * MiB;
constexpr size_t WS_WD = 88 * MiB;
constexpr size_t WS_HB = 120 * MiB;
constexpr size_t WS_QKVP = 184 * MiB;
constexpr size_t WS_AD = 312 * MiB;
constexpr size_t WS_X1 = 376 * MiB;
constexpr size_t WS_END = 504 * MiB;
constexpr int CW_TMO = 0, CW_CNT = 64;

typedef unsigned short bf16_t;
typedef short bf16x8 __attribute__((ext_vector_type(8)));
typedef float f32x4 __attribute__((ext_vector_type(4)));
typedef float f32x16 __attribute__((ext_vector_type(16)));
typedef unsigned u32x4 __attribute__((ext_vector_type(4)));
typedef unsigned u32x2 __attribute__((ext_vector_type(2)));

#define DEVFN __device__ __forceinline__
#define LDS_WAIT() asm volatile("s_waitcnt lgkmcnt(0)" ::: "memory")
#define RLX_AGENT __ATOMIC_RELAXED, __HIP_MEMORY_SCOPE_AGENT

DEVFN float bf_lo(unsigned w) { return __uint_as_float(w << 16); }
DEVFN float bf_hi(unsigned w) { return __uint_as_float(w & 0xffff0000u); }
DEVFN float bf2f(bf16_t v) { return __uint_as_float((unsigned)v << 16); }
DEVFN unsigned f2bf(float f) { unsigned u = __float_as_uint(f); return (u + 0x7fffu + ((u >> 16) & 1u)) >> 16; }
DEVFN unsigned pk2(float lo, float hi) { return f2bf(lo) | (f2bf(hi) << 16); }
DEVFN int crow(int r, int hi) { return (r & 3) + 8 * (r >> 2) + 4 * hi; }
DEVFN float wave_sum(float v) {
#pragma unroll
    for (int o = 1; o < 64; o <<= 1) v += __shfl_xor(v, o);
    return v;
}
__host__ __device__ __forceinline__ int inproj_lgroup(int P) { return P < 16 ? (P >> 2) * 8 + (P & 3) * 2 : ((P - 16) >> 2) * 8 + ((P - 16) & 3) * 2 + 1; }
__host__ __device__ __forceinline__ int inproj_nlog(int n) { return (n & ~255) + inproj_lgroup((n & 255) >> 3) * 8 + (n & 7); }

struct Args { const float* in[17]; float* out; unsigned char* ws; int ph_lo, ph_hi; };
enum { I_X = 0, I_C, I_WMOD, I_BMOD, I_WIN, I_WPOOL, I_PSCALE, I_WOUT, I_LN1G, I_LN1B, I_WR, I_RB, I_WG, I_WU, I_WDN, I_LN2G, I_LN2B };

struct Ctx { unsigned char* lds; int tid, lane, wave, G, bid, gw, NGW; };

DEVFN void transpose_item(const float* src, int ldn, int k0, int col, bf16_t* dst, int ldk, int dst_row0, int dst_k0, float* scr, int lane) {
#pragma unroll 8
    for (int i = 0; i < 32; ++i) { const int kk = 2 * i + (lane >> 5); scr[kk * 33 + (lane & 31)] = src[(size_t)(k0 + kk) * ldn + col]; }
    LDS_WAIT();
    const int c = lane & 7;
#pragma unroll
    for (int j = 0; j < 4; ++j) { const int n = (lane >> 3) + 8 * j; const float* s = scr + (8 * c) * 33 + n;
        u32x4 o; o.x = pk2(s[0 * 33], s[1 * 33]); o.y = pk2(s[2 * 33], s[3 * 33]); o.z = pk2(s[4 * 33], s[5 * 33]); o.w = pk2(s[6 * 33], s[7 * 33]);
        *(u32x4*)(dst + (size_t)(dst_row0 + n) * ldk + dst_k0 + 8 * c) = o; }
    LDS_WAIT();
}

DEVFN void ph_prologue(const Args& a, const Ctx& c) {
    unsigned char* ws = a.ws;
    float* scr = (float*)(c.lds + c.wave * 16384);
    const int lane = c.lane;
    constexpr int N1 = 2 * 16 * 64, N2 = 2 * 8 * 32, N3 = 32 * 16 * 32, N4 = 32 * 8 * 32, N5 = 2 * 64 * 16, N6 = 256;
    for (int it = c.gw; it < N1 + N2 + N3 + N4 + N5 + N6; it += c.NGW) {
        int r = it;
        if (r < N1) {
            const int l = r / 1024, kb = (r % 1024) / 64, nb = r % 64;
            const int nphys = 32 * nb + (lane & 31);
            transpose_item(a.in[I_WIN] + (size_t)l * DM * DIN, DIN, 64 * kb, inproj_nlog(nphys), (bf16_t*)(ws + WS_WIN) + (size_t)l * DIN * DM, DM, 32 * nb, 64 * kb, scr, lane);
            continue; }
        r -= N1;
        if (r < N2) {
            const int l = r / 256, kb = (r % 256) / 32, nb = r % 32;
            transpose_item(a.in[I_WOUT] + (size_t)l * DM * DM, DM, 64 * kb, 32 * nb + (lane & 31), (bf16_t*)(ws + WS_WOUT) + (size_t)l * DM * DM, DM, 32 * nb, 64 * kb, scr, lane);
            continue; }
        r -= N2;
        if (r < N3) {
            const int le = r / 512, kb = (r % 512) / 32, nb = r % 32;
            const int n = 32 * nb + (lane & 31), jt = n >> 8, bj = (n >> 7) & 1, i = n & 127;
            const float* src = (bj ? a.in[I_WU] : a.in[I_WG]) + (size_t)le * DM * DE;
            transpose_item(src, DE, 64 * kb, jt * 128 + i, (bf16_t*)(ws + WS_WGU) + (size_t)le * DM * DM, DM, 32 * nb, 64 * kb, scr, lane);
            continue; }
        r -= N3;
        if (r < N4) {
            const int le = r / 256, kb = (r % 256) / 32, nb = r % 32;
            transpose_item(a.in[I_WDN] + (size_t)le * DE * DM, DM, 64 * kb, 32 * nb + (lane & 31), (bf16_t*)(ws + WS_WD) + (size_t)le * DM * DE, DE, 32 * nb, 64 * kb, scr, lane);
            continue; }
        r -= N4;
        if (r < N5) {
            const int l = r / 1024, kdg = (r % 1024) / 16, nb = r % 16;
            const int n = nb * 64 + lane, kd0 = kdg * 8, g = kd0 >> 7, c0 = kd0 & 127;
            const float* wo = a.in[I_WOUT] + (size_t)l * DM * DM + (size_t)(512 + g * 128) * DM + n;
            const float* ps = a.in[I_PSCALE] + l * 512 + g * 128;
            const float* wp = a.in[I_WPOOL] + ((size_t)(l * 4 + g) * 128 + c0) * 128;
            float acc[8];
#pragma unroll
            for (int j = 0; j < 8; ++j) acc[j] = 0.f;
            for (int e = 0; e < 128; ++e) { const float w = wo[(size_t)e * DM] * ps[e];
#pragma unroll
                for (int j = 0; j < 8; ++j) acc[j] += wp[j * 128 + e] * w; }
            u32x4 o; o.x = pk2(acc[0], acc[1]); o.y = pk2(acc[2], acc[3]); o.z = pk2(acc[4], acc[5]); o.w = pk2(acc[6], acc[7]);
            *(u32x4*)((bf16_t*)(ws + WS_WOUT) + (size_t)l * DM * DM + (size_t)n * DM + 512 + kd0) = o;
            continue; }
        r -= N5;
        {
            const int ent = r * 64 + lane, pos = ent >> 3, i = ent & 7;
            const float inv = (float)exp2(-(double)i / 8.0 * 18.931568569324174);
            const float ang = (float)pos * inv;
            float* t = (float*)(ws + WS_ROPE) + ent * 2;
            t[0] = (float)cos((double)ang); t[1] = (float)sin((double)ang);
        }
    }
    __syncthreads();
    if (c.bid < 192) {
        float* condT = (float*)c.lds;
        float* red = (float*)(c.lds + 65536);
        for (int idx = c.tid; idx < NB * DM; idx += 512) { const int b = idx >> 10, k = idx & 1023; const float v = a.in[I_C][idx]; condT[k * 16 + b] = v / (1.f + __expf(-v)); }
        __syncthreads();
        for (int u = c.bid; u < 192; u += c.G) {
            const int l = u / 96, n0 = (u % 96) * 64;
            const float* W = a.in[I_WMOD] + (size_t)l * DM * NMOD + n0 + lane;
            float acc[16];
#pragma unroll
            for (int b = 0; b < 16; ++b) acc[b] = 0.f;
            for (int k = 128 * c.wave; k < 128 * c.wave + 128; k += 8) {
                float wv[8];
#pragma unroll
                for (int j = 0; j < 8; ++j) wv[j] = W[(size_t)(k + j) * NMOD];
#pragma unroll
                for (int j = 0; j < 8; ++j) {
                    const f32x4* cp = (const f32x4*)(condT + (k + j) * 16);
#pragma unroll
                    for (int q = 0; q < 4; ++q) { const f32x4 cv = cp[q]; acc[4 * q + 0] += cv.x * wv[j]; acc[4 * q + 1] += cv.y * wv[j]; acc[4 * q + 2] += cv.z * wv[j]; acc[4 * q + 3] += cv.w * wv[j]; }
                }
            }
#pragma unroll
            for (int b = 0; b < 16; ++b) red[(c.wave * 16 + b) * 64 + lane] = acc[b];
            __syncthreads();
            for (int o = c.tid; o < 1024; o += 512) { const int b = o >> 6, cc = o & 63; float s = a.in[I_BMOD][l * NMOD + n0 + cc];
#pragma unroll
                for (int w = 0; w < 8; ++w) s += red[(w * 16 + b) * 64 + cc];
                ((float*)(ws + WS_MOD))[(size_t)(l * NB + b) * NMOD + n0 + cc] = s; }
            __syncthreads();
        }
    }
}

DEVFN void row_stats(const f32x4 (&v)[4], float& mean, float& rstd) {
    float s = 0.f;
#pragma unroll
    for (int j = 0; j < 4; ++j) s += (v[j].x + v[j].y) + (v[j].z + v[j].w);
    mean = wave_sum(s) * (1.f / DM);
    float q = 0.f;
#pragma unroll
    for (int j = 0; j < 4; ++j) { const f32x4 d = v[j] - mean; q += (d.x * d.x + d.y * d.y) + (d.z * d.z + d.w * d.w); }
    rstd = 1.f / sqrtf(wave_sum(q) * (1.f / DM) + LN_EPS);
}
DEVFN void row_load(const float* p, int lane, f32x4 (&v)[4]) {
#pragma unroll
    for (int j = 0; j < 4; ++j) v[j] = *(const f32x4*)(p + 4 * lane + 256 * j);
}
DEVFN void row_mod_store(f32x4 (&v)[4], const float* sc, const float* sh, bf16_t* out, int lane) {
    float mean, rstd; row_stats(v, mean, rstd);
#pragma unroll
    for (int j = 0; j < 4; ++j) {
        const f32x4 s = *(const f32x4*)(sc + 4 * lane + 256 * j), h = *(const f32x4*)(sh + 4 * lane + 256 * j);
        v[j] = (v[j] - mean) * rstd * (s + 1.f) + h;
        u32x2 o; o.x = pk2(v[j].x, v[j].y); o.y = pk2(v[j].z, v[j].w);
        *(u32x2*)(out + 4 * lane + 256 * j) = o;
    }
}

DEVFN void ph_h1_rows(const Args& a, const Ctx& c) {
    const float* mod = (const float*)(a.ws + WS_MOD);
    for (int m = c.gw; m < NTOK; m += c.NGW) {
        const int b = m >> 11; f32x4 v[4]; row_load(a.in[I_X] + (size_t)m * DM, c.lane, v);
        row_mod_store(v, mod + (size_t)b * NMOD + DM, mod + (size_t)b * NMOD, (bf16_t*)(a.ws + WS_HB) + (size_t)m * DM, c.lane);
    }
}

DEVFN void wave_gemm32(f32x16& acc, const bf16_t* ap, const bf16_t* bp, int K) {
#pragma unroll 4
    for (int k = 0; k < K; k += 16) {
        const bf16x8 av = *(const bf16x8*)(ap + k), bv = *(const bf16x8*)(bp + k);
        acc = __builtin_amdgcn_mfma_f32_32x32x16_bf16(av, bv, acc, 0, 0, 0);
    }
}

DEVFN void ph_inproj_naive(const Args& a, const Ctx& c, int l) {
    const bf16_t* A = (const bf16_t*)(a.ws + WS_HB); const bf16_t* Bt = (const bf16_t*)(a.ws + WS_WIN) + (size_t)l * DIN * DM;
    bf16_t* O = (bf16_t*)(a.ws + WS_QKVP);
    const int r32 = c.lane & 31, hi = c.lane >> 5, wy = c.wave >> 2, wx = c.wave & 3;
    for (int u = c.bid; u < 512 * 16; u += c.G) {
        const int mt = u >> 4, nt = u & 15;
        f32x16 acc = {};
        wave_gemm32(acc, A + (size_t)(mt * 64 + wy * 32 + r32) * DM + hi * 8, Bt + (size_t)(nt * 128 + wx * 32 + r32) * DM + hi * 8, DM);
        const int nl = inproj_nlog(nt * 128 + wx * 32 + r32);
#pragma unroll
        for (int r = 0; r < 16; ++r) O[(size_t)(mt * 64 + wy * 32 + crow(r, hi)) * DIN + nl] = (bf16_t)f2bf(acc[r]);
    }
}

DEVFN void ph_rope_naive(const Args& a, const Ctx& c) {
    bf16_t* O = (bf16_t*)(a.ws + WS_QKVP); const float* rope = (const float*)(a.ws + WS_ROPE);
    for (int idx = c.bid * 512 + c.tid; idx < NTOK * 16; idx += c.G * 512) {
        const int which = idx & 1, hh = (idx >> 1) & 7, m = idx >> 4, t = m & (SEQ - 1);
        bf16_t* p = O + (size_t)m * DIN + which * 512 + hh * 64;
        float v[64];
#pragma unroll
        for (int q = 0; q < 8; ++q) { const u32x4 w = *(const u32x4*)(p + 8 * q);
            v[8 * q + 0] = bf_lo(w.x); v[8 * q + 1] = bf_hi(w.x); v[8 * q + 2] = bf_lo(w.y); v[8 * q + 3] = bf_hi(w.y);
            v[8 * q + 4] = bf_lo(w.z); v[8 * q + 5] = bf_hi(w.z); v[8 * q + 6] = bf_lo(w.w); v[8 * q + 7] = bf_hi(w.w); }
#pragma unroll
        for (int i = 0; i < 8; ++i) { const float cs = rope[(t * 8 + i) * 2], sn = rope[(t * 8 + i) * 2 + 1]; const float x1 = v[i], x2 = v[8 + i];
            v[i] = x1 * cs - x2 * sn; v[8 + i] = x2 * cs + x1 * sn; }
        const float sc = which == 0 ? QSCALE : 1.f;
#pragma unroll
        for (int q = 0; q < 8; ++q) { u32x4 w; w.x = pk2(v[8 * q] * sc, v[8 * q + 1] * sc); w.y = pk2(v[8 * q + 2] * sc, v[8 * q + 3] * sc); w.z = pk2(v[8 * q + 4] * sc, v[8 * q + 5] * sc); w.w = pk2(v[8 * q + 6] * sc, v[8 * q + 7] * sc);
            *(u32x4*)(p + 8 * q) = w; }
    }
}

DEVFN void ph_kbar(const Args& a, const Ctx& c, int l) {
    const bf16_t* O = (const bf16_t*)(a.ws + WS_QKVP); float* kbar = (float*)(a.ws + WS_KBAR) + (size_t)l * NB * NH * NBLK * HD;
    for (int it = c.gw; it < NB * NH * NBLK; it += c.NGW) {
        const int n = it & 7, hh = (it >> 3) & 7, b = it >> 6;
        const bf16_t* p = O + (size_t)(b * SEQ + n * MBLK) * DIN + 512 + hh * 64 + c.lane;
        float s = 0.f;
#pragma unroll 8
        for (int j = 0; j < MBLK; ++j) s += bf2f(p[(size_t)j * DIN]);
        kbar[(size_t)it * 64 + c.lane] = s * (1.f / MBLK);
    }
}

__global__ void __launch_bounds__(256) k_attn_naive(Args a, int l) {
    Ctx c; c.tid = threadIdx.x; c.G = gridDim.x; c.bid = blockIdx.x;
    const bf16_t* QK = (const bf16_t*)(a.ws + WS_QKVP); const float* kbar = (const float*)(a.ws + WS_KBAR) + (size_t)l * NB * NH * NBLK * HD;
    bf16_t* AD = (bf16_t*)(a.ws + WS_AD);
    for (int it = c.bid * 256 + c.tid; it < NB * NH * SEQ; it += c.G * 256) {
        const int t = it & (SEQ - 1), hh = (it >> 11) & 7, b = it >> 14, qb = t >> 8;
        const size_t m = (size_t)b * SEQ + t;
        unsigned qp[32];
        { const bf16_t* p = QK + m * DIN + hh * 64;
#pragma unroll
          for (int s = 0; s < 8; ++s) { const u32x4 w = *(const u32x4*)(p + 8 * s); qp[4 * s] = w.x; qp[4 * s + 1] = w.y; qp[4 * s + 2] = w.z; qp[4 * s + 3] = w.w; } }
#define QF(d) (((d) & 1) ? bf_hi(qp[(d) >> 1]) : bf_lo(qp[(d) >> 1]))
        unsigned mask = 0u;
        if (qb <= 3) mask = (1u << qb) - 1u;
        else {
            float g[7];
            const float* kb = kbar + (size_t)((b * NH + hh) * NBLK) * 64;
#pragma unroll
            for (int n = 0; n < 7; ++n) { float s = 0.f;
                if (n < qb) {
#pragma unroll
                    for (int d = 0; d < 64; ++d) s += QF(d) * kb[n * 64 + d]; } else s = -3.0e38f;
                g[n] = s; }
#pragma unroll
            for (int pick = 0; pick < 3; ++pick) { float best = -3.4e38f; int bi = 0;
#pragma unroll
                for (int n = 0; n < 7; ++n) { const bool ok = !((mask >> n) & 1u) && g[n] > best; best = ok ? g[n] : best; bi = ok ? n : bi; }
                mask |= 1u << bi; }
        }
        mask |= 1u << qb;
        float mrun = -1.0e30f, lrun = 0.f, o[64];
#pragma unroll
        for (int d = 0; d < 64; ++d) o[d] = 0.f;
        for (int n = 0; n <= qb; ++n) {
            const bool selb = (mask >> n) & 1u;
            const int jend = (n == qb) ? (t & 255) + 1 : MBLK;
            const int jmax = (n == qb) ? MBLK : MBLK;
            const bf16_t* kp = QK + ((size_t)b * SEQ + n * MBLK) * DIN + 512 + hh * 64;
#pragma unroll 1
            for (int j = 0; j < jmax; ++j) {
                const bool valid = selb && (j < jend);
                const bf16_t* kr = kp + (size_t)j * DIN;
                float s = 0.f;
#pragma unroll
                for (int sg = 0; sg < 8; ++sg) { const u32x4 w = *(const u32x4*)(kr + 8 * sg);
                    s += QF(8 * sg + 0) * bf_lo(w.x) + QF(8 * sg + 1) * bf_hi(w.x) + QF(8 * sg + 2) * bf_lo(w.y) + QF(8 * sg + 3) * bf_hi(w.y)
                       + QF(8 * sg + 4) * bf_lo(w.z) + QF(8 * sg + 5) * bf_hi(w.z) + QF(8 * sg + 6) * bf_lo(w.w) + QF(8 * sg + 7) * bf_hi(w.w); }
                const float mnew = valid ? fmaxf(mrun, s) : mrun;
                const float corr = exp2f(mrun - mnew), p = valid ? exp2f(s - mnew) : 0.f;
                lrun = lrun * corr + p; mrun = mnew;
                const bf16_t* vr = kr + 512;
#pragma unroll
                for (int sg = 0; sg < 8; ++sg) { const u32x4 w = *(const u32x4*)(vr + 8 * sg);
                    o[8 * sg + 0] = o[8 * sg + 0] * corr + p * bf_lo(w.x); o[8 * sg + 1] = o[8 * sg + 1] * corr + p * bf_hi(w.x);
                    o[8 * sg + 2] = o[8 * sg + 2] * corr + p * bf_lo(w.y); o[8 * sg + 3] = o[8 * sg + 3] * corr + p * bf_hi(w.y);
                    o[8 * sg + 4] = o[8 * sg + 4] * corr + p * bf_lo(w.z); o[8 * sg + 5] = o[8 * sg + 5] * corr + p * bf_hi(w.z);
                    o[8 * sg + 6] = o[8 * sg + 6] * corr + p * bf_lo(w.w); o[8 * sg + 7] = o[8 * sg + 7] * corr + p * bf_hi(w.w); }
            }
        }
        const float il = 1.f / lrun;
        bf16_t* op = AD + m * DM + hh * 64;
#pragma unroll
        for (int sg = 0; sg < 8; ++sg) { u32x4 w; w.x = pk2(o[8 * sg] * il, o[8 * sg + 1] * il); w.y = pk2(o[8 * sg + 2] * il, o[8 * sg + 3] * il); w.z = pk2(o[8 * sg + 4] * il, o[8 * sg + 5] * il); w.w = pk2(o[8 * sg + 6] * il, o[8 * sg + 7] * il);
            *(u32x4*)(op + 8 * sg) = w; }
    }
#undef QF
}

DEVFN void ph_pool(const Args& a, const Ctx& c) {
    const bf16_t* P = (const bf16_t*)(a.ws + WS_QKVP) + 1536; bf16_t* AD = (bf16_t*)(a.ws + WS_AD) + 512;
    for (int it = c.bid * 512 + c.tid; it < NTOK * 64; it += c.G * 512) {
        const int cg = it & 63, m = it >> 6, t = m & (SEQ - 1), g = cg >> 4, w = 2 << g;
        const int cnt = (t + 1 < w) ? t + 1 : w;
        float s[8];
#pragma unroll
        for (int j = 0; j < 8; ++j) s[j] = 0.f;
        float p0[8];
        for (int i = 0; i < cnt; ++i) { const u32x4 v = *(const u32x4*)(P + (size_t)(m - i) * DIN + cg * 8);
            const float f[8] = {bf_lo(v.x), bf_hi(v.x), bf_lo(v.y), bf_hi(v.y), bf_lo(v.z), bf_hi(v.z), bf_lo(v.w), bf_hi(v.w)};
#pragma unroll
            for (int j = 0; j < 8; ++j) { s[j] += f[j]; if (i == 0) p0[j] = f[j]; } }
        const float ic = 1.f / (float)cnt;
        u32x4 o; o.x = pk2(s[0] * ic - p0[0], s[1] * ic - p0[1]); o.y = pk2(s[2] * ic - p0[2], s[3] * ic - p0[3]); o.z = pk2(s[4] * ic - p0[4], s[5] * ic - p0[5]); o.w = pk2(s[6] * ic - p0[6], s[7] * ic - p0[7]);
        *(u32x4*)(AD + (size_t)m * DM + cg * 8) = o;
    }
}

DEVFN void ph_wout_naive(const Args& a, const Ctx& c, int l) {
    const bf16_t* A = (const bf16_t*)(a.ws + WS_AD); const bf16_t* Bt = (const bf16_t*)(a.ws + WS_WOUT) + (size_t)l * DM * DM;
    float* Y = (float*)(a.ws + WS_QKVP);
    const int r32 = c.lane & 31, hi = c.lane >> 5, wy = c.wave >> 2, wx = c.wave & 3;
    for (int u = c.bid; u < 512 * 8; u += c.G) {
        const int mt = u >> 3, nt = u & 7;
        f32x16 acc = {};
        wave_gemm32(acc, A + (size_t)(mt * 64 + wy * 32 + r32) * DM + hi * 8, Bt + (size_t)(nt * 128 + wx * 32 + r32) * DM + hi * 8, DM);
#pragma unroll
        for (int r = 0; r < 16; ++r) Y[(size_t)(mt * 64 + wy * 32 + crow(r, hi)) * DM + nt * 128 + wx * 32 + r32] = acc[r];
    }
}

DEVFN void ph_rows_c(const Args& a, const Ctx& c, int l) {
    const float* mod = (const float*)(a.ws + WS_MOD) + (size_t)l * NB * NMOD;
    const float* xin = l == 0 ? a.in[I_X] : a.out;
    const float* Y = (const float*)(a.ws + WS_QKVP);
    float* X1 = (float*)(a.ws + WS_X1); bf16_t* HB = (bf16_t*)(a.ws + WS_HB);
    const float* lg = a.in[I_LN1G] + l * DM; const float* lb = a.in[I_LN1B] + l * DM;
    float* wr = (float*)c.lds;
    int* lcnt = (int*)(c.lds + 65536); int* lbase = lcnt + 32;
    int* rcls = lbase + 32; float* rw1 = (float*)(rcls + 8 * 64); float* rw2 = rw1 + 8 * 64; int* rrow = (int*)(rw2 + 8 * 64);
    for (int i = c.tid; i < DM * NE; i += 512) wr[i] = a.in[I_WR][i];
    if (c.tid < 32) lcnt[c.tid] = 0;
    __syncthreads();
    float rb[16];
#pragma unroll
    for (int e = 0; e < 16; ++e) rb[e] = a.in[I_RB][e];
    int nr = 0;
    for (int m = c.gw; m < NTOK; m += c.NGW, ++nr) {
        const int b = m >> 11; const float* mb = mod + (size_t)b * NMOD;
        f32x4 v[4], y[4]; row_load(xin + (size_t)m * DM, c.lane, v); row_load(Y + (size_t)m * DM, c.lane, y);
#pragma unroll
        for (int j = 0; j < 4; ++j) { const f32x4 g = *(const f32x4*)(mb + 2 * DM + 4 * c.lane + 256 * j); v[j] = v[j] * ALPHA + g * y[j]; }
        float mean, rstd; row_stats(v, mean, rstd);
#pragma unroll
        for (int j = 0; j < 4; ++j) { const f32x4 g = *(const f32x4*)(lg + 4 * c.lane + 256 * j), bb = *(const f32x4*)(lb + 4 * c.lane + 256 * j);
            v[j] = (v[j] - mean) * rstd * g + bb; *(f32x4*)(X1 + (size_t)m * DM + 4 * c.lane + 256 * j) = v[j]; }
        row_mod_store(v, mb + 4 * DM, mb + 3 * DM, HB + (size_t)m * DM, c.lane);
        float lg16[16];
#pragma unroll
        for (int e = 0; e < 16; ++e) lg16[e] = 0.f;
#pragma unroll
        for (int j = 0; j < 4; ++j)
#pragma unroll
            for (int i = 0; i < 4; ++i) { const float hv = v[j][i]; const f32x4* wp = (const f32x4*)(wr + (4 * c.lane + 256 * j + i) * 16);
#pragma unroll
                for (int q = 0; q < 4; ++q) { const f32x4 w = wp[q]; lg16[4 * q] += hv * w.x; lg16[4 * q + 1] += hv * w.y; lg16[4 * q + 2] += hv * w.z; lg16[4 * q + 3] += hv * w.w; } }
#pragma unroll
        for (int e = 0; e < 16; ++e) lg16[e] = wave_sum(lg16[e]);
        float mx = lg16[0];
#pragma unroll
        for (int e = 1; e < 16; ++e) mx = fmaxf(mx, lg16[e]);
        float sum = 0.f, sc[16];
#pragma unroll
        for (int e = 0; e < 16; ++e) { sc[e] = __expf(lg16[e] - mx); sum += sc[e]; }
        const float isum = 1.f / sum;
#pragma unroll
        for (int e = 0; e < 16; ++e) sc[e] *= isum;
        float bestg = -3.4e38f; int gb = 0, bi1 = 0, bi2 = 1; float bw1 = 0.f, bw2 = 0.f;
#pragma unroll
        for (int g = 0; g < 4; ++g) {
            float m1 = sc[4 * g] + rb[4 * g], s1 = sc[4 * g]; int i1 = 0;
#pragma unroll
            for (int i = 1; i < 4; ++i) { const float sv = sc[4 * g + i] + rb[4 * g + i]; const bool ok = sv > m1; m1 = ok ? sv : m1; s1 = ok ? sc[4 * g + i] : s1; i1 = ok ? i : i1; }
            float m2 = -3.4e38f, s2 = 0.f; int i2 = 0;
#pragma unroll
            for (int i = 0; i < 4; ++i) { const float sv = sc[4 * g + i] + rb[4 * g + i]; const bool ok = (i != i1) && sv > m2; m2 = ok ? sv : m2; s2 = ok ? sc[4 * g + i] : s2; i2 = ok ? i : i2; }
            const float gs = m1 + m2; const bool better = gs > bestg;
            bestg = better ? gs : bestg; gb = better ? g : gb; bi1 = better ? i1 : bi1; bi2 = better ? i2 : bi2; bw1 = better ? s1 : bw1; bw2 = better ? s2 : bw2;
        }
        const float inv = 1.f / (bw1 + bw2);
        const int lo = bi1 < bi2 ? bi1 : bi2, hi2 = bi1 < bi2 ? bi2 : bi1;
        const float wlo = (bi1 < bi2 ? bw1 : bw2) * inv, whi = (bi1 < bi2 ? bw2 : bw1) * inv;
        const int pidx = lo == 0 ? hi2 - 1 : (lo == 1 ? hi2 + 1 : 5);
        if (c.lane == 0) { rcls[c.wave * 64 + nr] = gb * 6 + pidx; rw1[c.wave * 64 + nr] = wlo; rw2[c.wave * 64 + nr] = whi; rrow[c.wave * 64 + nr] = m; }
    }
    LDS_WAIT();
    int rank = 0, cls = 0;
    if (c.lane < nr) { cls = rcls[c.wave * 64 + c.lane]; rank = atomicAdd(&lcnt[cls], 1); }
    __syncthreads();
    if (c.tid < NCLS) lbase[c.tid] = (int)__hip_atomic_fetch_add((unsigned*)(a.ws + WS_CTL) + CW_CNT + l * 32 + c.tid, (unsigned)lcnt[c.tid], RLX_AGENT);
    __syncthreads();
    if (c.lane < nr) {
        const int pos = lbase[cls] + rank;
        ((int*)(a.ws + WS_LIST))[(size_t)cls * LISTCAP + pos] = rrow[c.wave * 64 + c.lane];
        float* rw = (float*)(a.ws + WS_RW) + ((size_t)cls * LISTCAP + pos) * 2;
        rw[0] = rw1[c.wave * 64 + c.lane]; rw[1] = rw2[c.wave * 64 + c.lane];
    }
}

struct MoeTab { int* cnt; int* tp; };
DEVFN MoeTab moe_table(const Args& a, const Ctx& c, int l, unsigned char* lds_at) {
    MoeTab t; t.cnt = (int*)lds_at; t.tp = t.cnt + 32;
    if (c.tid < NCLS) t.cnt[c.tid] = (int)__hip_atomic_load((unsigned*)(a.ws + WS_CTL) + CW_CNT + l * 32 + c.tid, RLX_AGENT);
    __syncthreads();
    if (c.tid == 0) { int s = 0; for (int k = 0; k < NCLS; ++k) { t.tp[k] = s; s += (t.cnt[k] + 255) >> 8; } t.tp[NCLS] = s; }
    __syncthreads();
    return t;
}
DEVFN void cls_experts(int cls, int& e1, int& e2) { const int g = cls / 6, p = cls % 6; const int lo = p < 3 ? 0 : (p < 5 ? 1 : 2), hi = p < 3 ? p + 1 : (p < 5 ? p - 1 : 3); e1 = g * 4 + lo; e2 = g * 4 + hi; }

DEVFN void ph_gateup_naive(const Args& a, const Ctx& c, int l) {
    const MoeTab T = moe_table(a, c, l, c.lds);
    const int ntiles = T.tp[NCLS];
    const bf16_t* HB = (const bf16_t*)(a.ws + WS_HB); const bf16_t* WGU = (const bf16_t*)(a.ws + WS_WGU) + (size_t)l * NE * DM * DM;
    const int* list = (const int*)(a.ws + WS_LIST); const float* rw = (const float*)(a.ws + WS_RW);
    bf16_t* ACT = (bf16_t*)(a.ws + WS_QKVP);
    const int r32 = c.lane & 31, hi = c.lane >> 5, wy = c.wave >> 2, wx = c.wave & 3;
    for (int u = c.bid; u < ntiles * 32; u += c.G) {
        const int Tt = u >> 5, sub = (u >> 3) & 3, half = (u >> 2) & 1, jt = u & 3;
        int cls = 0; while (Tt >= T.tp[cls + 1]) ++cls;
        const int j = Tt - T.tp[cls], cnt = T.cnt[cls];
        int e1, e2; cls_experts(cls, e1, e2); const int e = half ? e2 : e1;
        const int lr = sub * 64 + wy * 32 + r32, li = 256 * j + lr;
        const int tok = list[(size_t)cls * LISTCAP + (li < cnt ? li : 256 * j)];
        const bf16_t* ap = HB + (size_t)tok * DM + hi * 8;
        const bf16_t* bg = WGU + (size_t)e * DM * DM + (size_t)(jt * 256 + wx * 32 + r32) * DM + hi * 8;
        f32x16 ag = {}, au = {};
        wave_gemm32(ag, ap, bg, DM); wave_gemm32(au, ap, bg + (size_t)128 * DM, DM);
#pragma unroll
        for (int r = 0; r < 16; ++r) {
            const int lro = sub * 64 + wy * 32 + crow(r, hi), lio = 256 * j + lro;
            const float wgt = lio < cnt ? rw[((size_t)cls * LISTCAP + lio) * 2 + half] : 0.f;
            const float g = ag[r], act = g / (1.f + __expf(-g)) * au[r] * wgt;
            ACT[(size_t)(256 * Tt + lro) * DM + half * 512 + jt * 128 + wx * 32 + r32] = (bf16_t)f2bf(act);
        }
    }
}

DEVFN void ph_down_naive(const Args& a, const Ctx& c, int l) {
    const MoeTab T = moe_table(a, c, l, c.lds);
    const int ntiles = T.tp[NCLS];
    const bf16_t* ACT = (const bf16_t*)(a.ws + WS_QKVP); const bf16_t* WD = (const bf16_t*)(a.ws + WS_WD) + (size_t)l * NE * DM * DE;
    const int* list = (const int*)(a.ws + WS_LIST);
    bf16_t* Y2 = (bf16_t*)(a.ws + WS_AD);
    const int r32 = c.lane & 31, hi = c.lane >> 5, wy = c.wave >> 2, wx = c.wave & 3;
    for (int u = c.bid; u < ntiles * 32; u += c.G) {
        const int Tt = u >> 5, sub = (u >> 3) & 3, nt = u & 7;
        int cls = 0; while (Tt >= T.tp[cls + 1]) ++cls;
        const int j = Tt - T.tp[cls], cnt = T.cnt[cls];
        int e1, e2; cls_experts(cls, e1, e2);
        const bf16_t* ap = ACT + (size_t)(256 * Tt + sub * 64 + wy * 32 + r32) * DM + hi * 8;
        const int n = nt * 128 + wx * 32 + r32;
        f32x16 acc = {};
        wave_gemm32(acc, ap, WD + (size_t)e1 * DM * DE + (size_t)n * DE + hi * 8, DE);
        wave_gemm32(acc, ap + DE, WD + (size_t)e2 * DM * DE + (size_t)n * DE + hi * 8, DE);
#pragma unroll
        for (int r = 0; r < 16; ++r) {
            const int lio = 256 * j + sub * 64 + wy * 32 + crow(r, hi);
            if (lio < cnt) { const int tok = list[(size_t)cls * LISTCAP + lio]; Y2[(size_t)tok * DM + n] = (bf16_t)f2bf(acc[r]); }
        }
    }
}

DEVFN void ph_rows_g(const Args& a, const Ctx& c, int l) {
    const float* mod = (const float*)(a.ws + WS_MOD) + (size_t)l * NB * NMOD;
    const float* X1 = (const float*)(a.ws + WS_X1); const bf16_t* Y2 = (const bf16_t*)(a.ws + WS_AD);
    const float* lg = a.in[I_LN2G] + l * DM; const float* lb = a.in[I_LN2B] + l * DM;
    for (int m = c.gw; m < NTOK; m += c.NGW) {
        const int b = m >> 11; const float* mb = mod + (size_t)b * NMOD;
        f32x4 v[4]; row_load(X1 + (size_t)m * DM, c.lane, v);
#pragma unroll
        for (int j = 0; j < 4; ++j) { const f32x4 g = *(const f32x4*)(mb + 5 * DM + 4 * c.lane + 256 * j); const u32x2 yw = *(const u32x2*)(Y2 + (size_t)m * DM + 4 * c.lane + 256 * j);
            const f32x4 y = {bf_lo(yw.x), bf_hi(yw.x), bf_lo(yw.y), bf_hi(yw.y)}; v[j] = v[j] * ALPHA + g * y; }
        float mean, rstd; row_stats(v, mean, rstd);
#pragma unroll
        for (int j = 0; j < 4; ++j) { const f32x4 g = *(const f32x4*)(lg + 4 * c.lane + 256 * j), bb = *(const f32x4*)(lb + 4 * c.lane + 256 * j);
            v[j] = (v[j] - mean) * rstd * g + bb; *(f32x4*)(a.out + (size_t)m * DM + 4 * c.lane + 256 * j) = v[j]; }
        if (l == 0) { const float* mb1 = mod + (size_t)NB * NMOD + (size_t)b * NMOD; row_mod_store(v, mb1 + DM, mb1, (bf16_t*)(a.ws + WS_HB) + (size_t)m * DM, c.lane); }
    }
}

constexpr int LDS_BYTES = 147456;
constexpr int PH_PER_LAYER = 9, NPHASE = 2 + 2 * PH_PER_LAYER;
__global__ void __launch_bounds__(512, 2) fwd(Args a) {
    extern __shared__ __attribute__((aligned(16))) unsigned char lds[];
    Ctx c; c.lds = lds; c.tid = threadIdx.x; c.lane = c.tid & 63; c.wave = __builtin_amdgcn_readfirstlane(c.tid >> 6); c.G = gridDim.x; c.bid = blockIdx.x;
    c.gw = c.bid * 8 + c.wave; c.NGW = c.G * 8;
    const int lo = a.ph_lo, hi = a.ph_hi;
#define IN(k) (lo <= (k) && (k) < hi)
    if (IN(0)) ph_prologue(a, c);
    if (IN(1)) ph_h1_rows(a, c);
    for (int l = 0; l < 2; ++l) {
        const int p0 = 2 + l * PH_PER_LAYER;
        if (IN(p0 + 0)) ph_inproj_naive(a, c, l);
        if (IN(p0 + 1)) ph_rope_naive(a, c);
        if (IN(p0 + 2)) ph_kbar(a, c, l);
        if (IN(p0 + 3)) { ph_pool(a, c); }
        if (IN(p0 + 4)) ph_wout_naive(a, c, l);
        if (IN(p0 + 5)) ph_rows_c(a, c, l);
        if (IN(p0 + 6)) ph_gateup_naive(a, c, l);
        if (IN(p0 + 7)) ph_down_naive(a, c, l);
        if (IN(p0 + 8)) ph_rows_g(a, c, l);
    }
#undef IN
}

extern "C" void kernel_launch(void* const* d_in, const int* in_sizes, int n_in, void* d_out, int out_size, void* d_ws, size_t ws_size, hipStream_t stream) {
    static int grid = 0;
    if (grid == 0) {
        if (n_in != 17 || out_size != NTOK * DM || ws_size < WS_END) { fprintf(stderr, "kernel_launch: unexpected problem (n_in %d out %d ws %zu)\n", n_in, out_size, ws_size); grid = -1; return; }
        if (hipFuncSetAttribute((const void*)fwd, hipFuncAttributeMaxDynamicSharedMemorySize, LDS_BYTES) != hipSuccess) { fprintf(stderr, "kernel_launch: hipFuncSetAttribute failed\n"); grid = -1; return; }
        int dev = 0, cus = 0; hipGetDevice(&dev); hipDeviceGetAttribute(&cus, hipDeviceAttributeMultiprocessorCount, dev);
        (void)hipGetLastError();
        grid = cus > 0 ? cus : 256;
    }
    if (grid < 0) return;
    hipMemsetAsync((char*)d_ws + WS_CTL, 0, CTL_ZERO_BYTES, stream);
    Args a{};
    for (int i = 0; i < 17; ++i) a.in[i] = (const float*)d_in[i];
    a.out = (float*)d_out; a.ws = (unsigned char*)d_ws;
    for (int p = 0; p < NPHASE; ++p) { a.ph_lo = p; a.ph_hi = p + 1; hipLaunchKernelGGL(fwd, dim3(grid), dim3(512), LDS_BYTES, stream, a);
        if (p >= 2 && (p - 2) % PH_PER_LAYER == 3) hipLaunchKernelGGL(k_attn_naive, dim3(1024), dim3(256), 0, stream, a, (p - 2) / PH_PER_LAYER); }
}
```

```cpp
#include <hip/hip_runtime.h>
#include <cstdint>
#include <cstdio>

constexpr int NB = 16, SEQ = 2048, DM = 1024, NTOK = NB * SEQ, DIN = 2048, NH = 8, HD = 64, NBLK = 8, MBLK = 256;
constexpr int NE = 16, NCLS = 24, DE = 512, NMOD = 6 * DM;
constexpr float ALPHA = 1.41421356237309515f, LN_EPS = 1e-5f;
constexpr float QSCALE = 0.125f * 1.4426950408889634f;
constexpr int LISTCAP = NTOK;

constexpr size_t MiB = 1u << 20;
constexpr size_t WS_CTL = 0, CTL_ZERO_BYTES = 1 * MiB;
constexpr size_t WS_MOD = 1 * MiB;
constexpr size_t WS_ROPE = 2 * MiB;
constexpr size_t WS_KBAR = 2 * MiB + 256 * 1024;
constexpr size_t WS_LIST = 3 * MiB;
constexpr size_t WS_RW = 6 * MiB;
constexpr size_t WS_WIN = 12 * MiB;
constexpr size_t WS_WOUT = 20 * MiB;
constexpr size_t WS_WGU = 24 * MiB;
constexpr size_t WS_WD = 88 * MiB;
constexpr size_t WS_HB = 120 * MiB;
constexpr size_t WS_QKVP = 184 * MiB;
constexpr size_t WS_AD = 312 * MiB;
constexpr size_t WS_X1 = 376 * MiB;
constexpr size_t WS_END = 504 * MiB;
constexpr int CW_TMO = 0, CW_CNT = 64;

typedef unsigned short bf16_t;
typedef short bf16x8 __attribute__((ext_vector_type(8)));
typedef float f32x4 __attribute__((ext_vector_type(4)));
typedef float f32x16 __attribute__((ext_vector_type(16)));
typedef unsigned u32x4 __attribute__((ext_vector_type(4)));
typedef unsigned u32x2 __attribute__((ext_vector_type(2)));

#define DEVFN __device__ __forceinline__
#define LDS_WAIT() asm volatile("s_waitcnt lgkmcnt(0)" ::: "memory")
#define RLX_AGENT __ATOMIC_RELAXED, __HIP_MEMORY_SCOPE_AGENT

DEVFN float bf_lo(unsigned w) { return __uint_as_float(w << 16); }
DEVFN float bf_hi(unsigned w) { return __uint_as_float(w & 0xffff0000u); }
DEVFN float bf2f(bf16_t v) { return __uint_as_float((unsigned)v << 16); }
DEVFN unsigned f2bf(float f) { unsigned u = __float_as_uint(f); return (u + 0x7fffu + ((u >> 16) & 1u)) >> 16; }
DEVFN unsigned pk2(float lo, float hi) { return f2bf(lo) | (f2bf(hi) << 16); }
DEVFN int crow(int r, int hi) { return (r & 3) + 8 * (r >> 2) + 4 * hi; }
#define SWZ_XOR(m) (0x1f | ((m) << 10))
DEVFN float swz_xor_add(float v, const int m) {
    switch (m) {
        case 1: return v + __int_as_float(__builtin_amdgcn_ds_swizzle(__float_as_int(v), SWZ_XOR(1)));
        case 2: return v + __int_as_float(__builtin_amdgcn_ds_swizzle(__float_as_int(v), SWZ_XOR(2)));
        case 4: return v + __int_as_float(__builtin_amdgcn_ds_swizzle(__float_as_int(v), SWZ_XOR(4)));
        case 8: return v + __int_as_float(__builtin_amdgcn_ds_swizzle(__float_as_int(v), SWZ_XOR(8)));
        default: return v + __int_as_float(__builtin_amdgcn_ds_swizzle(__float_as_int(v), SWZ_XOR(16)));
    }
}
DEVFN float half_swap_add(float v) { auto rr = __builtin_amdgcn_permlane32_swap(__float_as_uint(v), __float_as_uint(v), false, false); return __uint_as_float(rr[0]) + __uint_as_float(rr[1]); }
DEVFN float wave_sum(float v) {
    v = swz_xor_add(v, 1); v = swz_xor_add(v, 2); v = swz_xor_add(v, 4); v = swz_xor_add(v, 8); v = swz_xor_add(v, 16);
    return half_swap_add(v);
}
__host__ __device__ __forceinline__ int inproj_lgroup(int P) { return P < 16 ? (P >> 2) * 8 + (P & 3) * 2 : ((P - 16) >> 2) * 8 + ((P - 16) & 3) * 2 + 1; }
__host__ __device__ __forceinline__ int inproj_nlog(int n) { return (n & ~255) + inproj_lgroup((n & 255) >> 3) * 8 + (n & 7); }

#define GAS __attribute__((address_space(1)))
#define LAS __attribute__((address_space(3)))
typedef GAS unsigned gu32;
namespace pg8 {
#define PG8_LAS __attribute__((address_space(3)))
typedef unsigned short bf16_t;
typedef short bf16x8 __attribute__((ext_vector_type(8)));
typedef float f32x4 __attribute__((ext_vector_type(4)));
typedef unsigned u32x4 __attribute__((ext_vector_type(4)));
constexpr int BM = 256, BK = 64, HALF = 128, HTB = HALF * BK * 2  , STAGE_BYTES = 8 * HTB, NXCD = 8, WGM = 8;

__host__ __device__ __forceinline__ int lds_byte(int r, int c) { const int st = (r >> 4) * 2 + (c >> 5), rr = r & 15, cc = c & 31, ob = rr * 64 + cc * 2; return st * 1024 + (ob ^ (((ob >> 9) & 1) << 5)); }
__host__ __device__ __forceinline__ void stage_rc(int b, int& R, int& C) { const int st = b / 1024, sb = b % 1024, swz = sb ^ (((sb >> 9) & 1) << 5); R = (st >> 1) * 16 + swz / 64; C = (st & 1) * 32 + (swz % 64) / 2; }
__host__ __device__ __forceinline__ int perm32(int rho) { const int n = rho >> 4, i = rho & 15; return 8 * (i >> 2) + 4 * n + (i & 3); }

struct Unit { int pm, pn; };
struct Gemm { const bf16_t* A; const bf16_t* Bt; int M, N, K; };

struct StaticOrder {
    int nM, nN, nwg, G, c;
    __host__ __device__ void init(int M, int N, int G_, int c_) { nM = M / BM; nN = N / BM; nwg = nM * nN; G = G_; c = c_; }
    __host__ __device__ bool next(int i, Unit& u) const {
        const long L = (long)i * G + c; if (L >= nwg) return false;
        int wgid = (int)L; { const int q = nwg / NXCD, r = nwg % NXCD, xcd = wgid % NXCD, off = wgid / NXCD; wgid = (xcd < r ? xcd * (q + 1) : r * (q + 1) + (xcd - r) * q) + off; }
        const int nig = WGM * nN, gid = wgid / nig, fm = gid * WGM, gsz = (nM - fm) < WGM ? (nM - fm) : WGM;
        u.pm = fm + ((wgid % nig) % gsz); u.pn = (wgid % nig) / gsz; return true;
    }
    __device__ __forceinline__ void a_ready(const Unit&) const {}
    __device__ __forceinline__ void done(const Unit&) const {}
};

__device__ __forceinline__ unsigned cvt_pk_bf16(float lo, float hi) { unsigned r; asm volatile("v_cvt_pk_bf16_f32 %0, %1, %2" : "=v"(r) : "v"(lo), "v"(hi)); return r; }
typedef float f32x2 __attribute__((ext_vector_type(2)));
__device__ __forceinline__ f32x2 gelu_pk(f32x2 v) {
    const f32x2 av = __builtin_elementwise_abs(v), d = av * 0.2316418882f + 1.0f;
    f32x2 t; t.x = __builtin_amdgcn_rcpf(d.x); t.y = __builtin_amdgcn_rcpf(d.y);
    f32x2 q = t * 0.5307027145f + (-0.7265760135f); q = q * t + 0.7107068705f; q = q * t + (-0.142248368f); q = q * t + 0.127414796f; q = q * t;
    const f32x2 s = (v * v) * (-0.72134752044f);
    f32x2 e; e.x = __builtin_amdgcn_exp2f(s.x); e.y = __builtin_amdgcn_exp2f(s.y);
    const f32x2 m = v * (q * e), r = v - m;
    f32x2 o; o.x = v.x < 0.f ? m.x : r.x; o.y = v.y < 0.f ? m.y : r.y; return o;
}

template <int ACT  > struct EpiBf16 {
    static constexpr bool PERM = true, AFTER_DRAIN = false; static_assert(ACT == 0 || ACT == 1, "EpiBf16: ACT is 0 (none) or 1 (gelu_pk)");
    bf16_t* O; int ldc; const float* bias; int split_cols; size_t split_stride; float scale0;
    __device__ __forceinline__ void operator()(const f32x4 (&acc)[2][2][4][2], const Unit& u, int wr, int wc, int fr, int fq) const {
        const int row0 = u.pm * BM + wr * 64 + fr; int colt = u.pn * BM; bf16_t* base = O;
        float sc = 1.f; if (split_cols) { const int t = colt / split_cols; base += (size_t)t * split_stride; colt -= t * split_cols; if (t == 0) sc = scale0; }
        const int col0 = colt + wc * 32 + 8 * fq, bcol0 = u.pn * BM + wc * 32 + 8 * fq;
        f32x4 bv[2][2];
#pragma unroll
        for (int bj = 0; bj < 2; ++bj)
#pragma unroll
            for (int n = 0; n < 2; ++n) bv[bj][n] = bias ? *(const f32x4*)(bias + bcol0 + bj * HALF + 4 * n) : (f32x4){0.f, 0.f, 0.f, 0.f};
#pragma unroll
        for (int ai = 0; ai < 2; ++ai)
#pragma unroll
            for (int m = 0; m < 4; ++m) { bf16_t* rowp = base + (size_t)(row0 + ai * HALF + m * 16) * ldc + col0;
#pragma unroll
                for (int bj = 0; bj < 2; ++bj) { f32x4 v0 = acc[ai][bj][m][0] + bv[bj][0], v1 = acc[ai][bj][m][1] + bv[bj][1];
                    if (ACT == 1) { f32x2 a = gelu_pk((f32x2){v0[0], v0[1]}), b = gelu_pk((f32x2){v0[2], v0[3]}), c = gelu_pk((f32x2){v1[0], v1[1]}), d = gelu_pk((f32x2){v1[2], v1[3]});
                        v0 = (f32x4){a.x, a.y, b.x, b.y}; v1 = (f32x4){c.x, c.y, d.x, d.y}; }
                    v0 = v0 * sc; v1 = v1 * sc; u32x4 w; w.x = cvt_pk_bf16(v0[0], v0[1]); w.y = cvt_pk_bf16(v0[2], v0[3]); w.z = cvt_pk_bf16(v1[0], v1[1]); w.w = cvt_pk_bf16(v1[2], v1[3]);
                    *(u32x4*)(rowp + bj * HALF) = w; } }
    }
};

struct PanelStats {
    unsigned* xbuf;
    unsigned* cnt;
    unsigned* tmo;
    int ntn; float eps;
    unsigned code;
    __device__ __forceinline__ bool run(const f32x4 (&v)[2][2][4][2], const Unit& u, int wr, int wc, int fr, int fq, PG8_LAS unsigned char* lds, int wid, int lane) const {
        typedef float f32x2v __attribute__((ext_vector_type(2)));
        PG8_LAS f32x2v* P = (PG8_LAS f32x2v*)lds;
        PG8_LAS f32x2v* S = (PG8_LAS f32x2v*)(lds + 8192);
        PG8_LAS unsigned* flag = (PG8_LAS unsigned*)(lds + 8192 + 2048);
#pragma unroll
        for (int ai = 0; ai < 2; ++ai)
#pragma unroll
            for (int m = 0; m < 4; ++m) {
                float s = 0.f;
#pragma unroll
                for (int bj = 0; bj < 2; ++bj)
#pragma unroll
                    for (int n = 0; n < 2; ++n) { const f32x4 x = v[ai][bj][m][n]; s += (x[0] + x[1]) + (x[2] + x[3]); }
                s += __shfl_xor(s, 16); s += __shfl_xor(s, 32);
                const float mw = s * (1.0f / 64.0f); float q = 0.f;
#pragma unroll
                for (int bj = 0; bj < 2; ++bj)
#pragma unroll
                    for (int n = 0; n < 2; ++n) { const f32x4 d = v[ai][bj][m][n] - mw; q += (d[0] * d[0] + d[1] * d[1]) + (d[2] * d[2] + d[3] * d[3]); }
                q += __shfl_xor(q, 16); q += __shfl_xor(q, 32);
                if (fq == 0) P[(ai * HALF + wr * 64 + m * 16 + fr) * 4 + wc] = (f32x2v){mw, q};
            }
        asm volatile("s_waitcnt lgkmcnt(0)" ::: "memory"); __builtin_amdgcn_s_barrier(); asm volatile("" ::: "memory");
#if defined(BROKEN_EXCHANGE_NO_WAIT)
#warning BROKEN CONTROL BUILD: the row-statistics exchange does not wait; results are wrong by design
        if (blockIdx.x >= 64) { const long long t0_ = clock64(); while (clock64() - t0_ < 60000) __builtin_amdgcn_s_sleep(8); }
#endif
        const int row = wid * 32 + (lane & 31);
        if (lane < 32) {
            const f32x2v a = P[row * 4 + 0], b = P[row * 4 + 1], c = P[row * 4 + 2], d = P[row * 4 + 3];
            const float mt = (a.x + b.x + c.x + d.x) * 0.25f;
            const float da = a.x - mt, db = b.x - mt, dc = c.x - mt, dd = d.x - mt;
            const float m2 = (a.y + b.y) + (c.y + d.y) + 64.0f * ((da * da + db * db) + (dc * dc + dd * dd));
            unsigned long long* slot = (unsigned long long*)xbuf + ((size_t)(u.pm * BM + row) * 4 + u.pn);
            __hip_atomic_store(slot, ((unsigned long long)__float_as_uint(m2) << 32) | __float_as_uint(mt), __ATOMIC_RELAXED, __HIP_MEMORY_SCOPE_AGENT);
        }
        asm volatile("s_waitcnt vmcnt(0)" ::: "memory");
        if (lane == 0) __hip_atomic_fetch_add(cnt + 64 * u.pm, 1u, __ATOMIC_RELAXED, __HIP_MEMORY_SCOPE_AGENT);
        if (wid == 0) {
            bool dead = false; const unsigned long long t0 = __builtin_amdgcn_s_memrealtime(); const unsigned want = 8u * (unsigned)ntn;
            for (;;) {
#if defined(BROKEN_EXCHANGE_NO_WAIT)
                break;
#endif
                if ((unsigned)__builtin_amdgcn_readfirstlane(__hip_atomic_load(cnt + 64 * u.pm, __ATOMIC_RELAXED, __HIP_MEMORY_SCOPE_AGENT)) >= want) break;
                if (__builtin_amdgcn_s_memrealtime() - t0 > 2000000ull) {
                    if (lane == 0) { unsigned expect = 0u; __hip_atomic_compare_exchange_strong(tmo + 1, &expect, code | (unsigned)(u.pm & 0xff), __ATOMIC_RELAXED, __ATOMIC_RELAXED, __HIP_MEMORY_SCOPE_AGENT);
                                     __hip_atomic_store(tmo, 1u, __ATOMIC_RELAXED, __HIP_MEMORY_SCOPE_AGENT); }
                    dead = true; break; }
                __builtin_amdgcn_s_sleep(2);
            }
            __builtin_amdgcn_fence(__ATOMIC_ACQUIRE, "agent");
            if (lane == 0) flag[0] = dead ? 1u : 0u;
        }
        asm volatile("s_waitcnt vmcnt(0) lgkmcnt(0)" ::: "memory"); __builtin_amdgcn_s_barrier(); asm volatile("" ::: "memory");
        const bool bad = flag[0] != 0u;
        if (lane < 32) {
            const unsigned long long* slot = (const unsigned long long*)xbuf + (size_t)(u.pm * BM + row) * 4; float mt[4], m2[4]; float ms = 0.f;
#pragma unroll
            for (int t = 0; t < 4; ++t) { if (t < ntn) { const unsigned long long w = __hip_atomic_load(slot + t, __ATOMIC_RELAXED, __HIP_MEMORY_SCOPE_AGENT); mt[t] = __uint_as_float((unsigned)w); m2[t] = __uint_as_float((unsigned)(w >> 32)); } else { mt[t] = 0.f; m2[t] = 0.f; } ms += mt[t]; }
            const float mean = ms / (float)ntn; float q = 0.f;
#pragma unroll
            for (int t = 0; t < 4; ++t) if (t < ntn) { const float dm = mt[t] - mean; q += m2[t] + 256.0f * dm * dm; }
            S[row] = (f32x2v){mean, 1.0f / sqrtf(q / (256.0f * (float)ntn) + eps)};
        }
        asm volatile("s_waitcnt lgkmcnt(0)" ::: "memory"); __builtin_amdgcn_s_barrier(); asm volatile("" ::: "memory");
        return bad;
    }
};
struct EpiLnRes {
    static constexpr bool PERM = false, AFTER_DRAIN = true;
    const float* base; float* out; int ldc; const float* bias; PanelStats st; unsigned poison;
    __device__ __forceinline__ void fused(f32x4 (&acc)[2][2][4][2], const Unit& u, int wr, int wc, int fr, int fq, PG8_LAS unsigned char* lds, int wid, int lane) const {
        typedef float f32x2v __attribute__((ext_vector_type(2)));
        const PG8_LAS f32x2v* S = (const PG8_LAS f32x2v*)(lds + 8192);
        const int col0 = u.pn * BM + wc * 32 + 4 * fq;
#pragma unroll
        for (int bj = 0; bj < 2; ++bj)
#pragma unroll
            for (int n = 0; n < 2; ++n) { const f32x4 bv = bias ? *(const f32x4*)(bias + col0 + bj * HALF + n * 16) : (f32x4){0.f, 0.f, 0.f, 0.f};
#pragma unroll
                for (int ai = 0; ai < 2; ++ai)
#pragma unroll
                    for (int m = 0; m < 4; ++m) acc[ai][bj][m][n] += bv; }
        f32x4 pre[4][2][2];
#pragma unroll
        for (int m = 0; m < 4; ++m) { const size_t off = (size_t)(u.pm * BM + wr * 64 + m * 16 + fr) * ldc + col0;
#pragma unroll
            for (int bj = 0; bj < 2; ++bj)
#pragma unroll
                for (int n = 0; n < 2; ++n) pre[m][bj][n] = *(const f32x4*)(base + off + bj * HALF + n * 16); }
        const bool bad = st.run(acc, u, wr, wc, fr, fq, lds, wid, lane) || poison != 0u;
        const float qnan = __builtin_nanf("");
#pragma unroll
        for (int ai = 0; ai < 2; ++ai)
#pragma unroll
            for (int m = 0; m < 4; ++m) { const int r = ai * HALF + wr * 64 + m * 16 + fr; const f32x2v sr = S[r]; const size_t off = (size_t)(u.pm * BM + r) * ldc + col0;
#pragma unroll
                for (int bj = 0; bj < 2; ++bj)
#pragma unroll
                    for (int n = 0; n < 2; ++n) { const f32x4 bs = ai == 0 ? pre[m][bj][n] : *(const f32x4*)(base + off + bj * HALF + n * 16); f32x4 o = bs + (acc[ai][bj][m][n] - sr.x) * sr.y;
                        if (bad) o = (f32x4){qnan, qnan, qnan, qnan}; *(f32x4*)(out + off + bj * HALF + n * 16) = o; }
                if (m & 1) asm volatile("" ::: "memory"); }
    }
};
struct EpiLnResLn {
    static constexpr bool PERM = false, AFTER_DRAIN = true;
    const float* base; float* out; bf16_t* xn; int ldc; const float* bias; PanelStats st1, st2; unsigned poison;
    __device__ __forceinline__ void fused(f32x4 (&acc)[2][2][4][2], const Unit& u, int wr, int wc, int fr, int fq, PG8_LAS unsigned char* lds, int wid, int lane) const {
        typedef float f32x2v __attribute__((ext_vector_type(2))); typedef unsigned u32x2v __attribute__((ext_vector_type(2)));
        const PG8_LAS f32x2v* S = (const PG8_LAS f32x2v*)(lds + 8192);
        const int col0 = u.pn * BM + wc * 32 + 4 * fq;
#pragma unroll
        for (int bj = 0; bj < 2; ++bj)
#pragma unroll
            for (int n = 0; n < 2; ++n) { const f32x4 bv = bias ? *(const f32x4*)(bias + col0 + bj * HALF + n * 16) : (f32x4){0.f, 0.f, 0.f, 0.f};
#pragma unroll
                for (int ai = 0; ai < 2; ++ai)
#pragma unroll
                    for (int m = 0; m < 4; ++m) acc[ai][bj][m][n] += bv; }
        bool bad = st1.run(acc, u, wr, wc, fr, fq, lds, wid, lane) || poison != 0u;
        const float qnan = __builtin_nanf("");
#pragma unroll
        for (int ai = 0; ai < 2; ++ai)
#pragma unroll
            for (int m = 0; m < 4; ++m) { const int r = ai * HALF + wr * 64 + m * 16 + fr; const f32x2v sr = S[r]; const size_t off = (size_t)(u.pm * BM + r) * ldc + col0;
#pragma unroll
                for (int bj = 0; bj < 2; ++bj)
#pragma unroll
                    for (int n = 0; n < 2; ++n) { const f32x4 bs = *(const f32x4*)(base + off + bj * HALF + n * 16); acc[ai][bj][m][n] = bs + (acc[ai][bj][m][n] - sr.x) * sr.y; }
                asm volatile("" : "+v"(acc[ai][0][m][0]), "+v"(acc[ai][0][m][1]), "+v"(acc[ai][1][m][0]), "+v"(acc[ai][1][m][1]));
                if (m & 1) asm volatile("" ::: "memory"); }
        const bool bad1 = bad;
        bad = st2.run(acc, u, wr, wc, fr, fq, lds, wid, lane) || bad;
#pragma unroll
        for (int ai = 0; ai < 2; ++ai)
#pragma unroll
            for (int m = 0; m < 4; ++m) { const int r = ai * HALF + wr * 64 + m * 16 + fr; const f32x2v sr = S[r]; const size_t off = (size_t)(u.pm * BM + r) * ldc + col0;
#pragma unroll
                for (int bj = 0; bj < 2; ++bj)
#pragma unroll
                    for (int n = 0; n < 2; ++n) { const f32x4 x1 = acc[ai][bj][m][n]; *(f32x4*)(out + off + bj * HALF + n * 16) = bad1 ? (f32x4){qnan, qnan, qnan, qnan} : x1;
                        const f32x4 o = (x1 - sr.x) * sr.y; u32x2v w; w.x = cvt_pk_bf16(o[0], o[1]); w.y = cvt_pk_bf16(o[2], o[3]);
                        if (bad) { w.x = 0x7fc07fc0u; w.y = 0x7fc07fc0u; } *(u32x2v*)(xn + off + bj * HALF + n * 16) = w; }
                asm volatile("" ::: "memory"); }
    }
};

template <class Epi, class Sched, bool ALIGN_EPI = false, bool SP2 = false>
__device__ __forceinline__ void gemm_phase(PG8_LAS unsigned char* lds, const Gemm g, const Sched& S, const Epi& E) {
    const int tid = threadIdx.x, wid = __builtin_amdgcn_readfirstlane(tid >> 6), lane = tid & 63, wr = wid >> 2, wc = wid & 3, fr = lane & 15, fq = lane >> 4;
    const int K = g.K, nt = K / BK;
    unsigned voffA[2], voffB[2];
#pragma unroll
    for (int i = 0; i < 2; ++i) { int R, C; stage_rc(tid * 16 + i * 8192, R, C); const int Rb = Epi::PERM ? ((R & ~31) + perm32(R & 31)) : R;
        voffA[i] = (unsigned)(R * K + C) * 2u; voffB[i] = (unsigned)(Rb * K + C) * 2u; }
    const size_t kstep = (size_t)(BK * 2);
    const size_t hstep = (size_t)HALF * K * 2;
    const size_t tstep = 2 * hstep;
    const unsigned ldsw = (unsigned)wid * 1024u;
    const int aoff = lds_byte(wr * 64 + fr, fq * 8), boff = lds_byte(wc * 32 + fr, fq * 8);
#define PG8_SA(b, h) (((b) * 2 + (h)) * HTB)
#define PG8_SB(b, h) ((4 + (b) * 2 + (h)) * HTB)
#define PG8_STAGE(bufoff, gbase, voff) do { _Pragma("unroll") for (int _i = 0; _i < 2; ++_i) \
        __builtin_amdgcn_global_load_lds((const unsigned*)((const char*)(gbase) + (voff)[_i]), (PG8_LAS unsigned*)(lds + (bufoff) + ldsw + _i * 8192), 16, 0, 0); } while (0)
#define PG8_LDA(dst, b, h) do { _Pragma("unroll") for (int m = 0; m < 4; ++m) _Pragma("unroll") for (int k = 0; k < 2; ++k) dst[m][k] = *(const PG8_LAS bf16x8*)(lds + PG8_SA(b, h) + aoff + m * 2048 + k * 1024); } while (0)
#define PG8_LDB(dst, b, h) do { _Pragma("unroll") for (int n = 0; n < 2; ++n) _Pragma("unroll") for (int k = 0; k < 2; ++k) dst[n][k] = *(const PG8_LAS bf16x8*)(lds + PG8_SB(b, h) + boff + n * 2048 + k * 1024); } while (0)
#define PG8_MMA(ai, bj, At, Bt) do { __builtin_amdgcn_s_setprio(1); _Pragma("unroll") for (int m = 0; m < 4; ++m) _Pragma("unroll") for (int n = 0; n < 2; ++n) _Pragma("unroll") for (int k = 0; k < 2; ++k) \
        acc[ai][bj][m][n] = __builtin_amdgcn_mfma_f32_16x16x32_bf16(Bt[n][k], At[m][k], acc[ai][bj][m][n], 0, 0, 0); __builtin_amdgcn_s_setprio(0); } while (0)
#define PG8_WAIT_V(n) asm volatile("s_waitcnt vmcnt(" #n ")" ::: "memory")
#define PG8_WAIT_L(n) asm volatile("s_waitcnt lgkmcnt(" #n ")" ::: "memory")
#define PG8_BAR __builtin_amdgcn_s_barrier()
#define PG8_SCHED __builtin_amdgcn_sched_barrier(0)
    Unit cur, nxt; int ui = 0;
    if (!S.next(0, cur)) return;
    f32x4 acc[2][2][4][2];
#pragma unroll
    for (int a = 0; a < 2; ++a)
#pragma unroll
        for (int b = 0; b < 2; ++b)
#pragma unroll
            for (int m = 0; m < 4; ++m)
#pragma unroll
                for (int n = 0; n < 2; ++n) acc[a][b][m][n] = (f32x4){0.f, 0.f, 0.f, 0.f};
    bf16x8 At[4][2], B0[2][2], B1[2][2];
    const char* cA = (const char*)g.A + (size_t)cur.pm * tstep; const char* cB = (const char*)g.Bt + (size_t)cur.pn * tstep;
    S.a_ready(cur);
    if constexpr (SP2) {
        PG8_STAGE(PG8_SB(0, 0), cB, voffB); PG8_STAGE(PG8_SB(0, 1), cB + hstep, voffB); PG8_STAGE(PG8_SA(0, 0), cA, voffA); PG8_STAGE(PG8_SA(0, 1), cA + hstep, voffA);
        if (wr == 1) PG8_BAR;
        PG8_WAIT_V(2); PG8_BAR;
        PG8_STAGE(PG8_SB(1, 0), cB + kstep, voffB); PG8_STAGE(PG8_SA(1, 0), cA + kstep, voffA); PG8_STAGE(PG8_SB(1, 1), cB + hstep + kstep, voffB);
        PG8_WAIT_V(6); PG8_BAR;
    } else {
        PG8_STAGE(PG8_SB(0, 0), cB, voffB); PG8_STAGE(PG8_SA(0, 0), cA, voffA); PG8_STAGE(PG8_SB(0, 1), cB + hstep, voffB); PG8_STAGE(PG8_SA(0, 1), cA + hstep, voffA);
        if (wr == 1) PG8_BAR;
        PG8_WAIT_V(4); PG8_BAR;
        PG8_STAGE(PG8_SB(1, 0), cB + kstep, voffB); PG8_STAGE(PG8_SA(1, 0), cA + kstep, voffA); PG8_STAGE(PG8_SB(1, 1), cB + hstep + kstep, voffB);
        PG8_WAIT_V(6); PG8_BAR;
    }
    for (;;) {
        const bool has_next = S.next(ui + 1, nxt);
        const char* nA = has_next ? (const char*)g.A + (size_t)nxt.pm * tstep : cA; const char* nB = has_next ? (const char*)g.Bt + (size_t)nxt.pn * tstep : cB;
        for (int t = 0; t < nt; t += 2) {
            const bool last = (t == nt - 2);
            const char* a1 = cA + (size_t)(t + 1) * kstep;
            const char* a2 = last ? nA : cA + (size_t)(t + 2) * kstep; const char* b2 = last ? nB : cB + (size_t)(t + 2) * kstep;
            const char* a3 = a2 + kstep; const char* b3 = b2 + kstep;
            if (last && has_next) S.a_ready(nxt);
            if constexpr (SP2) {
            PG8_LDB(B0, 0, 0); PG8_LDB(B1, 0, 1); PG8_SCHED; PG8_LDA(At, 0, 0); PG8_STAGE(PG8_SA(1, 1), a1 + hstep, voffA);
            PG8_WAIT_V(8); PG8_WAIT_L(0); PG8_BAR; PG8_MMA(0, 0, At, B0); PG8_MMA(0, 1, At, B1); PG8_BAR; PG8_SCHED;
            PG8_LDA(At, 0, 1); PG8_STAGE(PG8_SB(0, 0), b2, voffB); PG8_STAGE(PG8_SB(0, 1), b2 + hstep, voffB); PG8_STAGE(PG8_SA(0, 0), a2, voffA);
            PG8_WAIT_V(8); PG8_WAIT_L(0); PG8_BAR; PG8_MMA(1, 0, At, B0); PG8_MMA(1, 1, At, B1); PG8_BAR; PG8_SCHED;
            PG8_LDB(B0, 1, 0); PG8_LDB(B1, 1, 1); PG8_SCHED; PG8_LDA(At, 1, 0); PG8_STAGE(PG8_SA(0, 1), a2 + hstep, voffA);
            PG8_WAIT_V(8); PG8_WAIT_L(0); PG8_BAR; PG8_MMA(0, 0, At, B0); PG8_MMA(0, 1, At, B1); PG8_BAR; PG8_SCHED;
            PG8_LDA(At, 1, 1); PG8_STAGE(PG8_SB(1, 0), b3, voffB); PG8_STAGE(PG8_SB(1, 1), b3 + hstep, voffB); PG8_STAGE(PG8_SA(1, 0), a3, voffA);
            PG8_WAIT_V(8); PG8_WAIT_L(0); PG8_BAR; PG8_MMA(1, 0, At, B0); PG8_MMA(1, 1, At, B1); PG8_BAR; PG8_SCHED;
            } else {
            PG8_LDB(B0, 0, 0); PG8_SCHED; PG8_LDA(At, 0, 0); PG8_STAGE(PG8_SA(1, 1), a1 + hstep, voffA);
            PG8_WAIT_L(8); PG8_BAR; PG8_WAIT_L(0); PG8_MMA(0, 0, At, B0); PG8_BAR; PG8_SCHED;
            PG8_LDB(B1, 0, 1); PG8_STAGE(PG8_SB(0, 0), b2, voffB);
            PG8_BAR; PG8_WAIT_L(0); PG8_MMA(0, 1, At, B1); PG8_BAR;
            PG8_LDA(At, 0, 1); PG8_STAGE(PG8_SA(0, 0), a2, voffA);
            PG8_BAR; PG8_WAIT_L(0); PG8_MMA(1, 0, At, B0); PG8_BAR; PG8_SCHED;
            PG8_STAGE(PG8_SB(0, 1), b2 + hstep, voffB);
            PG8_WAIT_V(6); PG8_BAR; PG8_MMA(1, 1, At, B1); PG8_BAR;
            PG8_LDB(B0, 1, 0); PG8_SCHED; PG8_LDA(At, 1, 0); PG8_STAGE(PG8_SA(0, 1), a2 + hstep, voffA);
            PG8_WAIT_L(8); PG8_BAR; PG8_WAIT_L(0); PG8_MMA(0, 0, At, B0); PG8_BAR; PG8_SCHED;
            PG8_LDB(B1, 1, 1); PG8_STAGE(PG8_SB(1, 0), b3, voffB);
            PG8_BAR; PG8_WAIT_L(0); PG8_MMA(0, 1, At, B1); PG8_BAR;
            PG8_LDA(At, 1, 1); PG8_STAGE(PG8_SA(1, 0), a3, voffA);
            PG8_BAR; PG8_WAIT_L(0); PG8_MMA(1, 0, At, B0); PG8_BAR; PG8_SCHED;
            PG8_STAGE(PG8_SB(1, 1), b3 + hstep, voffB);
            PG8_WAIT_V(6); PG8_BAR; PG8_MMA(1, 1, At, B1); PG8_BAR;
            }
        }
        if constexpr (ALIGN_EPI) { if (wr == 0) PG8_BAR; }
        if constexpr (!Epi::AFTER_DRAIN) { E(acc, cur, wr, wc, fr, fq); S.done(cur); }
        if (!has_next) break;
#pragma unroll
        for (int a = 0; a < 2; ++a)
#pragma unroll
            for (int b = 0; b < 2; ++b)
#pragma unroll
                for (int m = 0; m < 4; ++m)
#pragma unroll
                    for (int n = 0; n < 2; ++n) acc[a][b][m][n] = (f32x4){0.f, 0.f, 0.f, 0.f};
        cur = nxt; cA = nA; cB = nB; ++ui;
        if constexpr (ALIGN_EPI) { if (wr == 1) PG8_BAR; }
    }
    PG8_WAIT_V(0);
    if constexpr (!ALIGN_EPI) { if (wr == 0) PG8_BAR; }
    PG8_BAR;
    if constexpr (Epi::AFTER_DRAIN) { E.fused(acc, cur, wr, wc, fr, fq, lds, wid, lane); S.done(cur); }
#undef PG8_SA
#undef PG8_SB
#undef PG8_STAGE
#undef PG8_LDA
#undef PG8_LDB
#undef PG8_MMA
#undef PG8_WAIT_V
#undef PG8_WAIT_L
#undef PG8_BAR
#undef PG8_SCHED
}
}

#include <hip/hip_bf16.h>
#include <cmath>
namespace attn_body {
using bf16=__hip_bfloat16;
using bf16x8=__attribute__((ext_vector_type(8)))short;
using s16x4=__attribute__((ext_vector_type(4)))short;
using f32x16=__attribute__((ext_vector_type(16)))float;
using u32x4=__attribute__((ext_vector_type(4)))unsigned;
constexpr int BATCH=16,NHEAD=8,SEQ=2048,D=64,QP=2048,OP=1024;
constexpr int NW=8,QBLK=32,QB=QBLK*NW,KVBLK=64,NQB=SEQ/QB;
constexpr int ATTN_PITCH=QP, ATTN_UNIT_ROWS=QB;
__device__ __forceinline__ int crow(int r,int hi){return (r&3)+8*(r>>2)+4*hi;}
#define SBAR() __builtin_amdgcn_sched_barrier(0)
__device__ __forceinline__ void cmask(f32x16&p0,f32x16&p1,int jb,int qrel,int hi){
  const float NEG=-INFINITY; int kb=64*jb+4*hi;
  #pragma unroll
  for(int r=0;r<16;++r){int kv=kb+(r&3)+8*(r>>2); if(kv>qrel)p0[r]=NEG; if(kv+32>qrel)p1[r]=NEG;}
}

constexpr int NSLOT=3, SLOTB=8192;
constexpr int LDS_K=0, LDS_V=NSLOT*SLOTB, LDS_WS=2*NSLOT*SLOTB, LDS_OST=LDS_WS+NW*64*4, LDS_KBAR=LDS_OST+NW*4096, LDS_BYTES=LDS_KBAR+2048;
constexpr float NEGBIG=-1.0e30f; typedef float f32x4_t __attribute__((ext_vector_type(4)));
__device__ __forceinline__ float bfs(short v){return __uint_as_float(((unsigned)(unsigned short)v)<<16);}
constexpr float C2=0.125f*1.4426950408889634f;
__device__ __forceinline__ void glds16(const void*gsrc,unsigned lds_dst){unsigned keep;
  asm volatile("s_mov_b32 %0, m0\n\ts_mov_b32 m0, %2\n\ts_nop 0\n\tglobal_load_lds_dwordx4 %1, off\n\ts_mov_b32 m0, %0":"=&s"(keep):"v"(gsrc),"s"(lds_dst):"memory");}
__device__ __forceinline__ float max3f(float a,float b,float c){float r;asm("v_max3_f32 %0, %1, %2, %3":"=v"(r):"v"(a),"v"(b),"v"(c));return r;}
__device__ __forceinline__ float max2f(float a,float b){float r;asm("v_max_f32_e32 %0, %1, %2":"=v"(r):"v"(a),"v"(b));return r;}
__device__ __forceinline__ float fadd_s(float a,float b){float r;asm("v_add_f32_e32 %0, %1, %2":"=v"(r):"v"(a),"v"(b));return r;}
__device__ __forceinline__ float fsub_s(float a,float b){float r;asm("v_sub_f32_e32 %0, %1, %2":"=v"(r):"v"(a),"v"(b));return r;}
typedef float f32x2_t __attribute__((ext_vector_type(2))); typedef __bf16 bf16x2_t __attribute__((ext_vector_type(2)));
__device__ __forceinline__ unsigned cvtpk_s(float lo,float hi){f32x2_t v={lo,hi};bf16x2_t b=__builtin_convertvector(v,bf16x2_t);return __builtin_bit_cast(unsigned,b);}
#define WAIT_BAR(N) asm volatile("s_waitcnt vmcnt(" #N ") lgkmcnt(0)\n\ts_barrier":::"memory")

__device__ __forceinline__ void qkt(f32x16&p0,f32x16&p1,const char*Kslot,const bf16x8*qr,const f32x16&negm,int r32,int hi){
  const char*kb=Kslot+hi*1024+r32*16;
  #pragma unroll
  for(int d0=0;d0<4;++d0){
    const bf16x8 b0=*reinterpret_cast<const bf16x8*>(kb+d0*2048);
    const bf16x8 b1=*reinterpret_cast<const bf16x8*>(kb+d0*2048+512);
    if(d0==0){p0=__builtin_amdgcn_mfma_f32_32x32x16_bf16(b0,qr[0],negm,0,0,0);p1=__builtin_amdgcn_mfma_f32_32x32x16_bf16(b1,qr[0],negm,0,0,0);}
    else{p0=__builtin_amdgcn_mfma_f32_32x32x16_bf16(b0,qr[d0],p0,0,0,0);p1=__builtin_amdgcn_mfma_f32_32x32x16_bf16(b1,qr[d0],p1,0,0,0);}}
}
typedef __attribute__((address_space(3))) const char* lds_cptr;
typedef short v4i16_t __attribute__((ext_vector_type(4)));
__device__ __forceinline__ void kload8(bf16x8*kf,lds_cptr kp){
  kf[0]=*(const __attribute__((address_space(3))) bf16x8*)(kp);      kf[1]=*(const __attribute__((address_space(3))) bf16x8*)(kp+512);
  kf[2]=*(const __attribute__((address_space(3))) bf16x8*)(kp+2048); kf[3]=*(const __attribute__((address_space(3))) bf16x8*)(kp+2560);
  kf[4]=*(const __attribute__((address_space(3))) bf16x8*)(kp+4096); kf[5]=*(const __attribute__((address_space(3))) bf16x8*)(kp+4608);
  kf[6]=*(const __attribute__((address_space(3))) bf16x8*)(kp+6144); kf[7]=*(const __attribute__((address_space(3))) bf16x8*)(kp+6656);
}
__device__ __forceinline__ void kload2(bf16x8*kf,lds_cptr kp,int j){ kf[2*j]=*(const __attribute__((address_space(3))) bf16x8*)(kp+j*2048); kf[2*j+1]=*(const __attribute__((address_space(3))) bf16x8*)(kp+j*2048+512); }
__device__ __forceinline__ s16x4 vtr(lds_cptr p){ return __builtin_bit_cast(s16x4,__builtin_amdgcn_ds_read_tr16_b64_v4i16((__attribute__((address_space(3))) v4i16_t*)p)); }
__device__ __forceinline__ float rowmax(const f32x16&p0,const f32x16&p1){
  float a=max3f(p0[0],p0[1],p1[0]),b=max3f(p0[2],p0[3],p1[1]);a=max3f(a,p1[2],p1[3]);
  #pragma unroll
  for(int r=4;r<16;r+=4){a=max3f(a,p0[r],p0[r+1]);b=max3f(b,p0[r+2],p0[r+3]);a=max3f(a,p1[r],p1[r+1]);b=max3f(b,p1[r+2],p1[r+3]);}
  const float m=max2f(a,b);
  auto rr=__builtin_amdgcn_permlane32_swap(__float_as_uint(m),__float_as_uint(m),false,false);
  return max2f(__uint_as_float(rr[0]),__uint_as_float(rr[1]));
}
__device__ __forceinline__ void pv(f32x16*o,int vb,bf16x8 pa0,bf16x8 pa1,bf16x8 pa2,bf16x8 pa3){
  #pragma unroll
  for(int d0=0;d0<2;++d0){s16x4 lo[4],hi[4];
    #pragma unroll
    for(int ks=0;ks<4;++ks){
      asm volatile("ds_read_b64_tr_b16 %0,%1 offset:%c2":"=&v"(lo[ks]):"v"(vb),"i"(d0*4096+ks*1024):"memory");
      asm volatile("ds_read_b64_tr_b16 %0,%1 offset:%c2":"=&v"(hi[ks]):"v"(vb),"i"(d0*4096+ks*1024+512):"memory");}
    asm volatile("s_waitcnt lgkmcnt(0)":::"memory");SBAR();
    #define PK(k) (bf16x8){lo[k][0],lo[k][1],lo[k][2],lo[k][3],hi[k][0],hi[k][1],hi[k][2],hi[k][3]}
    o[d0]=__builtin_amdgcn_mfma_f32_32x32x16_bf16(pa0,PK(0),o[d0],0,0,0);
    o[d0]=__builtin_amdgcn_mfma_f32_32x32x16_bf16(pa1,PK(1),o[d0],0,0,0);
    o[d0]=__builtin_amdgcn_mfma_f32_32x32x16_bf16(pa2,PK(2),o[d0],0,0,0);
    o[d0]=__builtin_amdgcn_mfma_f32_32x32x16_bf16(pa3,PK(3),o[d0],0,0,0);
    #undef PK
  }
}

#ifndef ATTN_STORE16
#define ATTN_STORE16(p,v) (*(u32x4*)(p)=(v))
#endif
template<int THRL> __device__ __forceinline__ void attn_unit(int b,int h,int qb,const bf16*Q,const bf16*__restrict__ K,const bf16*__restrict__ V,bf16*O,const float*__restrict__ kbar,char*shm,const int tid){
  const int lane=tid&63,r32=lane&31,hi=lane>>5; const int wid=__builtin_amdgcn_readfirstlane(tid>>6);
  float kbv=0.f; { int tk=tid; asm volatile("":"+v"(tk)); if(qb>=4&&tk<448)kbv=kbar[tk]; }
  const long rowbase=(long)b*SEQ; const int q0=qb*QB;
  const bf16*Qw=Q+(rowbase+q0+wid*QBLK)*QP+h*D;
  const bf16*Kh=K+rowbase*QP+h*D,*Vh=V+rowbase*QP+h*D;
  const unsigned lds0=(unsigned)(uintptr_t)shm;
  float*wsf=(float*)(shm+LDS_WS)+wid*64;
  const bf16*ksrc=Kh+(long)lane*QP+wid*8;
  const bf16*vsrc=Vh+(long)(16*(wid&3)+(lane>>2))*QP+(wid>>2)*32+(lane&3)*8;
  const unsigned kdst=lds0+LDS_K+wid*1024, vdst=lds0+LDS_V+wid*1024;
  #define DMA_K(t,slot) glds16(ksrc+(long)(t)*KVBLK*QP,(unsigned)__builtin_amdgcn_readfirstlane(kdst+(slot)))
  #define DMA_V(t,slot) glds16(vsrc+(long)(t)*KVBLK*QP,(unsigned)__builtin_amdgcn_readfirstlane(vdst+(slot)))
  const int vb0=(int)(lds0+LDS_V)+((lane>>4)&1)*32+(lane&3)*8+(4*hi+((lane&15)>>2))*64;
  const char*Kbase=shm+LDS_K; bf16x8 kf[8];
  const lds_cptr shm3=(lds_cptr)shm; const lds_cptr kp0=shm3+LDS_K+hi*1024+r32*16; const lds_cptr vp0=shm3+LDS_V+((lane>>4)&1)*32+(lane&3)*8+(4*hi+((lane&15)>>2))*64;
  const int NT=(q0+QB)/KVBLK;
  DMA_K(0,0);DMA_V(0,0);DMA_K(1,SLOTB);
  bf16x8 qr[4];
  #pragma unroll
  for(int d0=0;d0<4;++d0)qr[d0]=*reinterpret_cast<const bf16x8*>(&Qw[(long)r32*QP+d0*16+hi*8]);
  float mhat=0.f,l_reg=0.f;f32x16 o[2];o[0]=f32x16{};o[1]=f32x16{};f32x16 negm=f32x16{};asm volatile("":"+v"(negm));
  const int qrel=wid*QBLK+r32;
  #define CMASK(P0,P1,t) do{int jb_=(t)-(NT-4); if(jb_>=0)cmask(P0,P1,jb_,qrel,hi);}while(0)
  bool resc=false;
  #define START(P0,P1) do{ const float rm=rowmax(P0,P1); resc=false; \
    { const float dl=selcur?rm:-64.f; mhat=fadd_s(mhat,dl); \
      _Pragma("unroll") for(int r=0;r<16;++r){P0[r]=fsub_s(P0[r],dl);P1[r]=fsub_s(P1[r],dl);} \
      { const float nv_=selcur?-mhat:NEGBIG; _Pragma("unroll") for(int r=0;r<16;++r)negm[r]=nv_; } asm volatile("":"+v"(negm)); } \
    _Pragma("unroll") for(int r=0;r<16;++r)P0[r]=__builtin_amdgcn_exp2f(P0[r]); }while(0)
  #define RESC() do{ if(resc){ asm volatile("s_waitcnt lgkmcnt(0)":::"memory"); \
      _Pragma("unroll") for(int d_=0;d_<2;++d_) _Pragma("unroll") for(int r=0;r<16;++r)o[d_][r]*=wsf[crow(r,hi)]; } }while(0)
  f32x16 pA0,pA1,pB0,pB1;
  int sl_prev=0,sl_cur=0,sl_next=SLOTB;
  #define ROT() do{sl_prev=sl_cur;sl_cur=sl_next;sl_next=(sl_next==(NSLOT-1)*SLOTB)?0:sl_next+SLOTB;}while(0)
  DMA_K(2,2*SLOTB);
  if(qb>=4){ if(tid<448)((float*)(shm+LDS_KBAR))[tid]=kbv; }
  WAIT_BAR(3);
  unsigned bmask=(1u<<(qb+1))-1u;
  if(qb>=4){ const float*kbl=(const float*)(shm+LDS_KBAR)+hi*8; float gsc[7];
    _Pragma("unroll") for(int n=0;n<7;++n){ float s_=0.f;
      _Pragma("unroll") for(int d0=0;d0<4;++d0){ const f32x4_t k0_=*(const f32x4_t*)(kbl+n*64+d0*16), k1_=*(const f32x4_t*)(kbl+n*64+d0*16+4); const bf16x8 qv=qr[d0];
        s_+=bfs(qv[0])*k0_[0]+bfs(qv[1])*k0_[1]+bfs(qv[2])*k0_[2]+bfs(qv[3])*k0_[3]+bfs(qv[4])*k1_[0]+bfs(qv[5])*k1_[1]+bfs(qv[6])*k1_[2]+bfs(qv[7])*k1_[3]; }
      { auto rr=__builtin_amdgcn_permlane32_swap(__float_as_uint(s_),__float_as_uint(s_),false,false); s_=__uint_as_float(rr[0])+__uint_as_float(rr[1]); }
      gsc[n]=(n<qb)?s_:-3.0e38f; SBAR(); }
    bmask=1u<<qb;
    _Pragma("unroll") for(int pick=0;pick<3;++pick){ float best=-3.4e38f; unsigned bi=0u;
      _Pragma("unroll") for(int n=0;n<7;++n){ const bool ok=!((bmask>>n)&1u)&&gsc[n]>best; best=ok?gsc[n]:best; bi=ok?(unsigned)n:bi; }
      bmask|=1u<<bi; } }
  bool selcur=(bmask&1u)!=0u;
  { const float nv=selcur?0.f:NEGBIG; _Pragma("unroll") for(int r=0;r<16;++r)negm[r]=nv; asm volatile("":"+v"(negm)); }
  qkt(pA0,pA1,Kbase,qr,negm,r32,hi);asm volatile("s_nop 15\n\ts_nop 7":"+v"(pA0),"+v"(pA1));CMASK(pA0,pA1,0);
  START(pA0,pA1);
  _Pragma("unroll") for(int r=0;r<16;++r)pA1[r]=__builtin_amdgcn_exp2f(pA1[r]);
  WAIT_BAR(0);
  DMA_K(3,0);DMA_V(1,SLOTB);
  ROT();
  kload8(kf,kp0+sl_cur);
  WAIT_BAR(2);
  s16x4 vlo[8],vhi[8]; u32x4 pw0,pw1,pw2,pw3;
  #define PKW(P,B) cvtpk_s(P[B],P[B+1])
  #define PAF(k) __builtin_bit_cast(bf16x8,pw##k)
  #define VFR(i) (bf16x8){vlo[i][0],vlo[i][1],vlo[i][2],vlo[i][3],vhi[i][0],vhi[i][1],vhi[i][2],vhi[i][3]}
  #define PIN(x) asm volatile("":"+v"(x))
  #define MX3(a,b,c) __builtin_fmaxf(__builtin_fmaxf((a),(b)),(c))
  #define GAPA(MF,A0,A1,A2,A3,W0,W1,PW) do{ MF; sacc+=A0; sacc+=A1; sacc+=A2; sacc+=A3; PIN(sacc); W0; W1; PIN(PW); SBAR(); }while(0)
  #define EX(v) __builtin_amdgcn_exp2f(v)
  #define GAPB(MF,X,B) do{ MF; X[B]=EX(X[B]); X[B+1]=EX(X[B+1]); X[B+2]=EX(X[B+2]); X[B+3]=EX(X[B+3]); PIN(X); SBAR(); }while(0)
  #define VRD(i) do{ vlo[i]=vtr(vp_+(((i)>>2)*4096+((i)&3)*1024)); vhi[i]=vtr(vp_+(((i)>>2)*4096+((i)&3)*1024+512)); }while(0)
  #define KRD(G,j) do{ if(G){ kload2(kf,kp0+sl_next,j); SBAR(); } }while(0)
  #define STEP(C0,C1,P0,P1,t,GK,GV,GL) do{ SBAR(); \
    const lds_cptr vp_=vp0+sl_prev; \
    VRD(0); SBAR(); float sacc=(P0[0]+P0[1]); \
    GAPA(C0=__builtin_amdgcn_mfma_f32_32x32x16_bf16(kf[0],qr[0],negm,0,0,0), P0[2],P0[3],P0[4],P0[5],     pw0[0]=PKW(P0,0), pw0[1]=PKW(P0,2), pw0); \
    VRD(4); SBAR(); GAPA(C1=__builtin_amdgcn_mfma_f32_32x32x16_bf16(kf[1],qr[0],negm,0,0,0), P0[6],P0[7],P0[8],P0[9],     pw0[2]=PKW(P0,4), pw0[3]=PKW(P0,6), pw0); \
    VRD(1); SBAR(); GAPA(C0=__builtin_amdgcn_mfma_f32_32x32x16_bf16(kf[2],qr[1],C0,0,0,0),   P0[10],P0[11],P0[12],P0[13], pw1[0]=PKW(P0,8), pw1[1]=PKW(P0,10), pw1); \
    VRD(5); SBAR(); GAPA(C1=__builtin_amdgcn_mfma_f32_32x32x16_bf16(kf[3],qr[1],C1,0,0,0),   P0[14],P0[15],P1[0],P1[1],   pw1[2]=PKW(P0,12),pw1[3]=PKW(P0,14), pw1); \
    VRD(2); SBAR(); GAPA(C0=__builtin_amdgcn_mfma_f32_32x32x16_bf16(kf[4],qr[2],C0,0,0,0),   P1[2],P1[3],P1[4],P1[5],     pw2[0]=PKW(P1,0), pw2[1]=PKW(P1,2), pw2); \
    VRD(6); SBAR(); GAPA(C1=__builtin_amdgcn_mfma_f32_32x32x16_bf16(kf[5],qr[2],C1,0,0,0),   P1[6],P1[7],P1[8],P1[9],     pw2[2]=PKW(P1,4), pw2[3]=PKW(P1,6), pw2); \
    VRD(3); SBAR(); GAPA(C0=__builtin_amdgcn_mfma_f32_32x32x16_bf16(kf[6],qr[3],C0,0,0,0),   P1[10],P1[11],P1[12],P1[13], pw3[0]=PKW(P1,8), pw3[1]=PKW(P1,10), pw3); \
    VRD(7); SBAR(); GAPA(C1=__builtin_amdgcn_mfma_f32_32x32x16_bf16(kf[7],qr[3],C1,0,0,0),   P1[14],P1[15],0.f,0.f,       pw3[2]=PKW(P1,12),pw3[3]=PKW(P1,14), pw3); \
    l_reg+=sacc; \
    if(GK){DMA_K((t)+3,sl_cur);} if(GV){DMA_V((t)+1,sl_next);} \
    CMASK(C0,C1,t); \
    { float a=MX3(C0[0],C0[1],C1[0]),b=MX3(C0[2],C0[3],C1[1]); a=MX3(a,C1[2],C1[3]); \
      _Pragma("unroll") for(int r=4;r<16;r+=4){a=MX3(a,C0[r],C0[r+1]);b=MX3(b,C0[r+2],C0[r+3]);a=MX3(a,C1[r],C1[r+1]);b=MX3(b,C1[r+2],C1[r+3]);} \
      float rm=__builtin_fmaxf(a,b); { auto rr=__builtin_amdgcn_permlane32_swap(__float_as_uint(rm),__float_as_uint(rm),false,false); rm=__builtin_fmaxf(__uint_as_float(rr[0]),__uint_as_float(rr[1])); } \
      resc=false; \
      if(__builtin_expect(__any(rm>(float)THRL),0)){ const float dl=__builtin_fmaxf(rm,0.f); mhat+=dl; \
        _Pragma("unroll") for(int r=0;r<16;++r){C0[r]-=dl;C1[r]-=dl;} \
        { const float nv_=selcur?-mhat:NEGBIG; _Pragma("unroll") for(int r=0;r<16;++r)negm[r]=nv_; } asm volatile("":"+v"(negm)); \
        const float f=__builtin_amdgcn_exp2f(-dl); l_reg*=f; if(hi==0)wsf[r32]=f; resc=true; } } \
    SBAR(); \
    GAPB(o[0]=__builtin_amdgcn_mfma_f32_32x32x16_bf16(PAF(0),VFR(0),o[0],0,0,0), C0,0); \
    GAPB(o[1]=__builtin_amdgcn_mfma_f32_32x32x16_bf16(PAF(0),VFR(4),o[1],0,0,0), C0,4); \
    KRD(GL,0); GAPB(o[0]=__builtin_amdgcn_mfma_f32_32x32x16_bf16(PAF(1),VFR(1),o[0],0,0,0), C0,8); \
    KRD(GL,1); GAPB(o[1]=__builtin_amdgcn_mfma_f32_32x32x16_bf16(PAF(1),VFR(5),o[1],0,0,0), C0,12); \
    KRD(GL,2); GAPB(o[0]=__builtin_amdgcn_mfma_f32_32x32x16_bf16(PAF(2),VFR(2),o[0],0,0,0), C1,0); \
    KRD(GL,3); GAPB(o[1]=__builtin_amdgcn_mfma_f32_32x32x16_bf16(PAF(2),VFR(6),o[1],0,0,0), C1,4); \
    GAPB(o[0]=__builtin_amdgcn_mfma_f32_32x32x16_bf16(PAF(3),VFR(3),o[0],0,0,0), C1,8); \
    GAPB(o[1]=__builtin_amdgcn_mfma_f32_32x32x16_bf16(PAF(3),VFR(7),o[1],0,0,0), C1,12); \
    }while(0)
  #define BLKSEL(tt) do{ if((((tt))&3)==0){ selcur=((bmask>>((tt)>>2))&1u)!=0u; const float nv_=selcur?-mhat:NEGBIG; _Pragma("unroll") for(int r=0;r<16;++r)negm[r]=nv_; asm volatile("":"+v"(negm)); } }while(0)
  int t=1;
  #undef CMASK
  #define CMASK(P0,P1,t) do{}while(0)
  for(;t+5<NT;t+=2){
    STEP(pB0,pB1,pA0,pA1,t,true,true,true);     WAIT_BAR(2); RESC(); ROT(); BLKSEL(t+1);
    STEP(pA0,pA1,pB0,pB1,t+1,true,true,true);   WAIT_BAR(2); RESC(); ROT();
  }
  #undef CMASK
  #define CMASK(P0,P1,t) do{int jb_=(t)-(NT-4); if(jb_>=0)cmask(P0,P1,jb_,qrel,hi);}while(0)
  #define ENDW(tt) do{ if((tt)+3<NT){WAIT_BAR(2);} else if((tt)+2<NT){WAIT_BAR(1);} else {WAIT_BAR(0);} }while(0)
  for(;t+1<NT;t+=2){
    STEP(pB0,pB1,pA0,pA1,t,(t+3<NT),(t+1<NT),(t+1<NT));       ENDW(t);   RESC(); ROT(); BLKSEL(t+1);
    STEP(pA0,pA1,pB0,pB1,t+1,(t+4<NT),(t+2<NT),(t+2<NT));     ENDW(t+1); RESC(); ROT();
  }
  STEP(pB0,pB1,pA0,pA1,NT-1,false,false,false); RESC();
  { float sacc=pB0[0]+pB0[1]; _Pragma("unroll") for(int r=2;r<16;++r)sacc+=pB0[r]; _Pragma("unroll") for(int r=0;r<16;++r)sacc+=pB1[r]; l_reg+=sacc;
    pw0=(u32x4){PKW(pB0,0),PKW(pB0,2),PKW(pB0,4),PKW(pB0,6)};pw1=(u32x4){PKW(pB0,8),PKW(pB0,10),PKW(pB0,12),PKW(pB0,14)};pw2=(u32x4){PKW(pB1,0),PKW(pB1,2),PKW(pB1,4),PKW(pB1,6)};pw3=(u32x4){PKW(pB1,8),PKW(pB1,10),PKW(pB1,12),PKW(pB1,14)};
    SBAR(); pv(o,vb0+sl_cur,PAF(0),PAF(1),PAF(2),PAF(3)); }
  #undef PKW
  #undef PAF
  #undef VFR
  #undef PIN
  #undef MX3
  #undef GAPA
  #undef GAPB
  #undef EX
  #undef VRD
  #undef KRD
  #undef STEP
  #undef ENDW
  {auto rr=__builtin_amdgcn_permlane32_swap(__float_as_uint(l_reg),__float_as_uint(l_reg),false,false);l_reg=__uint_as_float(rr[0])+__uint_as_float(rr[1]);}
  if(hi==0)wsf[32+r32]=l_reg;asm volatile("s_waitcnt lgkmcnt(0)":::"memory");
  float rli[16];
  #pragma unroll
  for(int r=0;r<16;++r)rli[r]=__builtin_amdgcn_rcpf(wsf[32+crow(r,hi)]);
  bf16*Ow=O+(rowbase+q0+wid*QBLK)*OP+h*D;
  { bf16*stg=(bf16*)(shm+LDS_OST)+wid*2048;
    #pragma unroll
    for(int r=0;r<16;++r){const int orow=crow(r,hi);
      #pragma unroll
      for(int d0=0;d0<2;++d0)stg[orow*64+d0*32+r32]=__float2bfloat16(o[d0][r]*rli[r]);}
    asm volatile("s_waitcnt lgkmcnt(0)":::"memory");
    #pragma unroll
    for(int i=0;i<4;++i){const int row=i*8+(lane>>3),ch=lane&7; const u32x4 v=*(const u32x4*)(stg+row*64+ch*8); ATTN_STORE16(Ow+(long)row*OP+ch*8,v);} }
  asm volatile("s_waitcnt lgkmcnt(0)\n\ts_barrier":::"memory");
  #undef BLKSEL
  #undef DMA_K
  #undef DMA_V
  #undef CMASK
  #undef START
  #undef RESC
  #undef ROT
}
constexpr int ATTN_LDS_BYTES=LDS_BYTES;
struct AttnTensors { const bf16* Q; const bf16* K; const bf16* V; bf16* O; const float* kbar; };
struct AttnUnit { int bh; int qb; };
struct StaticOrder {
  int vcu, G;
  __device__ __forceinline__ explicit StaticOrder(int grid,int block):vcu((grid%8==0)?(block%8)*(grid/8)+block/8:block),G(grid){}
  __device__ __forceinline__ bool next(int i,AttnUnit&u)const{ const int pr=(vcu+(i>>2)*G)*2+((i>>1)&1); if(pr>=BATCH*NHEAD*4)return false;
    const int s=pr&3; u.bh=pr>>2; u.qb=(i&1)?7-s:s; return true; }
  __device__ __forceinline__ void a_ready(const AttnUnit&)const{}
  __device__ __forceinline__ void done(const AttnUnit&)const{}
};
template<class Sched,int THRL=8> __device__ __forceinline__ void attn_phase(char*lds,const AttnTensors&T,const Sched&S,const int tid_in){
  AttnUnit u; int tid_=tid_in; asm volatile("":"+v"(tid_));
  for(int i=0;S.next(i,u);++i){ S.a_ready(u); attn_unit<THRL>(u.bh/NHEAD,u.bh%NHEAD,u.qb,T.Q,T.K,T.V,T.O,T.kbar+(long)u.bh*512,lds,tid_); S.done(u); }
}
#undef SBAR
#undef WAIT_BAR
}

#define XB_TMO      128
#define XB_XCNT(j)  (256  + 64 * (j))
#define XB_XSUB(j)  (1280 + 64 * (j))
#define XB_XGEN(j)  (2304 + 64 * (j))
#define XB_TOP      3328
#define XB_TOPGEN   3392
#define XCD_BAR_WORDS 3456
#define XB_SPIN_CAP (1u << 18)

__device__ __forceinline__ unsigned xb_ld(unsigned* p)              { return __hip_atomic_load(p, __ATOMIC_RELAXED, __HIP_MEMORY_SCOPE_AGENT); }
__device__ __forceinline__ unsigned xb_add(unsigned* p, unsigned v) { return __hip_atomic_fetch_add(p, v, __ATOMIC_RELAXED, __HIP_MEMORY_SCOPE_AGENT); }
__device__ __forceinline__ unsigned xb_xcc_id() { return (unsigned)__builtin_amdgcn_s_getreg((3 << 11) | 20) & 0xFu; }
#define XB_SPIN(cond, bar) do { unsigned _sp = 0; while (cond) { __builtin_amdgcn_s_sleep(1); \
    if ((++_sp & 255u) == 0u) { if (xb_ld(&(bar)[XB_TMO])) break; if (_sp > XB_SPIN_CAP) { atomicAdd(&(bar)[XB_TMO], 1u); break; } } } } while (0)

struct XcdBarrier {
    unsigned* bar; unsigned x;
    volatile LAS unsigned* st;
};

__device__ __forceinline__ XcdBarrier xcd_barrier_post(unsigned* bar, volatile LAS unsigned* st) {
    XcdBarrier b; b.bar = bar; b.x = xb_xcc_id(); b.st = st;
    if (threadIdx.x == 0) (void)xb_add(&bar[XB_XCNT(b.x)], 1u);
    return b;
}
__device__ __forceinline__ void xcd_barrier_complete(unsigned* bar, unsigned x, unsigned& nloc, unsigned& nx) {
    const unsigned G = gridDim.x * gridDim.y * gridDim.z;
    unsigned sum, cnt, mine, sp = 0u;
    for (;;) {
        sum = 0u; cnt = 0u; mine = 0u;
#pragma unroll
        for (unsigned j = 0; j < 16; ++j) { const unsigned c = xb_ld(&bar[XB_XCNT(j)]); sum += c; cnt += (c > 0u) ? 1u : 0u; mine = (j == x) ? c : mine; }
        if (sum == G) break;
        __builtin_amdgcn_s_sleep(1);
        if ((++sp & 255u) == 0u) { if (xb_ld(&bar[XB_TMO])) break; if (sp > XB_SPIN_CAP) { atomicAdd(&bar[XB_TMO], 1u); break; } }
    }
    nloc = mine > 0u ? mine : 1u; nx = cnt > 0u ? cnt : 1u;
}

__device__ __forceinline__ void xcd_barrier(const XcdBarrier& b, const bool is_t0) {
    asm volatile("s_waitcnt vmcnt(0)" ::: "memory");
    __syncthreads();
    if (is_t0) {
        unsigned* bar = b.bar;
        __builtin_amdgcn_s_waitcnt(0);
        unsigned nloc = b.st[0], nx = b.st[1];
        if (nloc == 0u) { xcd_barrier_complete(bar, b.x, nloc, nx); b.st[0] = nloc; b.st[1] = nx; }
        const unsigned old = xb_add(&bar[XB_XSUB(b.x)], 1u);
        const unsigned gen = old / nloc;
        if (old + 1u == (gen + 1u) * nloc) {
            __builtin_amdgcn_fence(__ATOMIC_RELEASE, "agent");
            asm volatile("s_waitcnt vmcnt(0)" ::: "memory");
            const unsigned og = xb_add(&bar[XB_TOP], 1u);
            const unsigned tg = og / nx;
            if (og + 1u == (tg + 1u) * nx) xb_add(&bar[XB_TOPGEN], 1u);
            else XB_SPIN(xb_ld(&bar[XB_TOPGEN]) == tg, bar);
            __builtin_amdgcn_fence(__ATOMIC_ACQUIRE, "agent");
            xb_add(&bar[XB_XGEN(b.x)], 1u);
            asm volatile("s_waitcnt vmcnt(0)" ::: "memory");
        } else {
            XB_SPIN(xb_ld(&bar[XB_XGEN(b.x)]) == gen, bar);
            __builtin_amdgcn_fence(__ATOMIC_ACQUIRE, "agent");
            asm volatile("s_waitcnt vmcnt(0)" ::: "memory");
        }
    }
    __syncthreads();
}

struct Args { const float* in[17]; float* out; unsigned char* ws; int ph_lo, ph_hi; };
enum { I_X = 0, I_C, I_WMOD, I_BMOD, I_WIN, I_WPOOL, I_PSCALE, I_WOUT, I_LN1G, I_LN1B, I_WR, I_RB, I_WG, I_WU, I_WDN, I_LN2G, I_LN2B };

DEVFN int lane_id_volatile() { int l; asm volatile("v_mbcnt_lo_u32_b32 %0, -1, 0\n\tv_mbcnt_hi_u32_b32 %0, -1, %0" : "=v"(l)); return l; }
struct Ctx { unsigned char* lds; int tid, lane, wave, G, bid, gw, NGW; };

DEVFN void transpose_item(const float* src, int ldn, int k0, int col, bf16_t* dst, int ldk, int dst_row0, int dst_k0, float* scr, int lane) {
#pragma unroll 8
    for (int i = 0; i < 32; ++i) { const int kk = 2 * i + (lane >> 5); scr[kk * 33 + (lane & 31)] = src[(size_t)(k0 + kk) * ldn + col]; }
    LDS_WAIT();
    const int c = lane & 7;
#pragma unroll
    for (int j = 0; j < 4; ++j) { const int n = (lane >> 3) + 8 * j; const float* s = scr + (8 * c) * 33 + n;
        u32x4 o; o.x = pk2(s[0 * 33], s[1 * 33]); o.y = pk2(s[2 * 33], s[3 * 33]); o.z = pk2(s[4 * 33], s[5 * 33]); o.w = pk2(s[6 * 33], s[7 * 33]);
        *(u32x4*)(dst + (size_t)(dst_row0 + n) * ldk + dst_k0 + 8 * c) = o; }
    LDS_WAIT();
}

DEVFN void ph_prologue(const Args& a, const Ctx& c) {
    unsigned char* ws = a.ws;
    float* scr = (float*)(c.lds + c.wave * 16384);
    const int lane = c.lane;
    constexpr int N1 = 2 * 16 * 64, N2 = 2 * 8 * 32, N3 = 32 * 16 * 32, N4 = 32 * 8 * 32, N5 = 2 * 64 * 16, N6 = 256;
    for (int it = c.gw; it < N1 + N2 + N3 + N4 + N5 + N6; it += c.NGW) {
        int r = it;
        if (r < N1) {
            const int l = r / 1024, kb = (r % 1024) / 64, nb = r % 64;
            const int nphys = 32 * nb + (lane & 31);
            transpose_item(a.in[I_WIN] + (size_t)l * DM * DIN, DIN, 64 * kb, inproj_nlog(nphys), (bf16_t*)(ws + WS_WIN) + (size_t)l * DIN * DM, DM, 32 * nb, 64 * kb, scr, lane);
            continue; }
        r -= N1;
        if (r < N2) {
            const int l = r / 256, kb = (r % 256) / 32, nb = r % 32;
            transpose_item(a.in[I_WOUT] + (size_t)l * DM * DM, DM, 64 * kb, 32 * nb + (lane & 31), (bf16_t*)(ws + WS_WOUT) + (size_t)l * DM * DM, DM, 32 * nb, 64 * kb, scr, lane);
            continue; }
        r -= N2;
        if (r < N3) {
            const int le = r / 512, kb = (r % 512) / 32, nb = r % 32;
            const int n = 32 * nb + (lane & 31), jt = n >> 8, bj = (n >> 7) & 1, i = n & 127;
            const float* src = (bj ? a.in[I_WU] : a.in[I_WG]) + (size_t)le * DM * DE;
            transpose_item(src, DE, 64 * kb, jt * 128 + i, (bf16_t*)(ws + WS_WGU) + (size_t)le * DM * DM, DM, 32 * nb, 64 * kb, scr, lane);
            continue; }
        r -= N3;
        if (r < N4) {
            const int le = r / 256, kb = (r % 256) / 32, nb = r % 32;
            transpose_item(a.in[I_WDN] + (size_t)le * DE * DM, DM, 64 * kb, 32 * nb + (lane & 31), (bf16_t*)(ws + WS_WD) + (size_t)le * DM * DE, DE, 32 * nb, 64 * kb, scr, lane);
            continue; }
        r -= N4;
        if (r < N5) {
            const int l = r / 1024, kdg = (r % 1024) / 16, nb = r % 16;
            const int n = nb * 64 + lane, kd0 = kdg * 8, g = kd0 >> 7, c0 = kd0 & 127;
            const float* wo = a.in[I_WOUT] + (size_t)l * DM * DM + (size_t)(512 + g * 128) * DM + n;
            const float* ps = a.in[I_PSCALE] + l * 512 + g * 128;
            const float* wp = a.in[I_WPOOL] + ((size_t)(l * 4 + g) * 128 + c0) * 128;
            float acc[8];
#pragma unroll
            for (int j = 0; j < 8; ++j) acc[j] = 0.f;
            for (int e = 0; e < 128; ++e) { const float w = wo[(size_t)e * DM] * ps[e];
#pragma unroll
                for (int j = 0; j < 8; ++j) acc[j] += wp[j * 128 + e] * w; }
            u32x4 o; o.x = pk2(acc[0], acc[1]); o.y = pk2(acc[2], acc[3]); o.z = pk2(acc[4], acc[5]); o.w = pk2(acc[6], acc[7]);
            *(u32x4*)((bf16_t*)(ws + WS_WOUT) + (size_t)l * DM * DM + (size_t)n * DM + 512 + kd0) = o;
            continue; }
        r -= N5;
        {
            const int ent = r * 64 + lane, pos = ent >> 3, i = ent & 7;
            const float inv = (float)exp2(-(double)i / 8.0 * 18.931568569324174);
            const float ang = (float)pos * inv;
            float* t = (float*)(ws + WS_ROPE) + ent * 2;
            t[0] = (float)cos((double)ang); t[1] = (float)sin((double)ang);
        }
    }
    __syncthreads();
    if (c.bid < 192) {
        float* condT = (float*)c.lds;
        float* red = (float*)(c.lds + 65536);
        for (int idx = c.tid; idx < NB * DM; idx += 512) { const int b = idx >> 10, k = idx & 1023; const float v = a.in[I_C][idx]; condT[k * 16 + b] = v / (1.f + __expf(-v)); }
        __syncthreads();
        for (int u = c.bid; u < 192; u += c.G) {
            const int l = u / 96, n0 = (u % 96) * 64;
            const float* W = a.in[I_WMOD] + (size_t)l * DM * NMOD + n0 + lane;
            float acc[16];
#pragma unroll
            for (int b = 0; b < 16; ++b) acc[b] = 0.f;
            for (int k = 128 * c.wave; k < 128 * c.wave + 128; k += 8) {
                float wv[8];
#pragma unroll
                for (int j = 0; j < 8; ++j) wv[j] = W[(size_t)(k + j) * NMOD];
#pragma unroll
                for (int j = 0; j < 8; ++j) {
                    const f32x4* cp = (const f32x4*)(condT + (k + j) * 16);
#pragma unroll
                    for (int q = 0; q < 4; ++q) { const f32x4 cv = cp[q]; acc[4 * q + 0] += cv.x * wv[j]; acc[4 * q + 1] += cv.y * wv[j]; acc[4 * q + 2] += cv.z * wv[j]; acc[4 * q + 3] += cv.w * wv[j]; }
                }
            }
#pragma unroll
            for (int b = 0; b < 16; ++b) red[(c.wave * 16 + b) * 64 + lane] = acc[b];
            __syncthreads();
            for (int o = c.tid; o < 1024; o += 512) { const int b = o >> 6, cc = o & 63; float s = a.in[I_BMOD][l * NMOD + n0 + cc];
#pragma unroll
                for (int w = 0; w < 8; ++w) s += red[(w * 16 + b) * 64 + cc];
                ((float*)(ws + WS_MOD))[(size_t)(l * NB + b) * NMOD + n0 + cc] = s; }
            __syncthreads();
        }
    }
}

DEVFN void row_stats(const f32x4 (&v)[4], float& mean, float& rstd) {
    float s = 0.f;
#pragma unroll
    for (int j = 0; j < 4; ++j) s += (v[j].x + v[j].y) + (v[j].z + v[j].w);
    mean = wave_sum(s) * (1.f / DM);
    float q = 0.f;
#pragma unroll
    for (int j = 0; j < 4; ++j) { const f32x4 d = v[j] - mean; q += (d.x * d.x + d.y * d.y) + (d.z * d.z + d.w * d.w); }
    rstd = 1.f / sqrtf(wave_sum(q) * (1.f / DM) + LN_EPS);
}
DEVFN void row_load(const float* p, int lane, f32x4 (&v)[4]) {
#pragma unroll
    for (int j = 0; j < 4; ++j) v[j] = *(const f32x4*)(p + 4 * lane + 256 * j);
}
DEVFN void row_mod_store(f32x4 (&v)[4], const float* sc, const float* sh, bf16_t* out, int lane) {
    float mean, rstd; row_stats(v, mean, rstd);
#pragma unroll
    for (int j = 0; j < 4; ++j) {
        const f32x4 s = *(const f32x4*)(sc + 4 * lane + 256 * j), h = *(const f32x4*)(sh + 4 * lane + 256 * j);
        v[j] = (v[j] - mean) * rstd * (s + 1.f) + h;
        u32x2 o; o.x = pk2(v[j].x, v[j].y); o.y = pk2(v[j].z, v[j].w);
        *(u32x2*)(out + 4 * lane + 256 * j) = o;
    }
}

DEVFN void ph_h1_rows(const Args& a, const Ctx& c) {
    const float* mod = (const float*)(a.ws + WS_MOD);
    for (int m = c.gw; m < NTOK; m += c.NGW) {
        const int b = m >> 11; f32x4 v[4]; row_load(a.in[I_X] + (size_t)m * DM, c.lane, v);
        row_mod_store(v, mod + (size_t)b * NMOD + DM, mod + (size_t)b * NMOD, (bf16_t*)(a.ws + WS_HB) + (size_t)m * DM, c.lane);
    }
}

DEVFN void wave_gemm32(f32x16& acc, const bf16_t* ap, const bf16_t* bp, int K) {
#pragma unroll 4
    for (int k = 0; k < K; k += 16) {
        const bf16x8 av = *(const bf16x8*)(ap + k), bv = *(const bf16x8*)(bp + k);
        acc = __builtin_amdgcn_mfma_f32_32x32x16_bf16(av, bv, acc, 0, 0, 0);
    }
}

DEVFN void ph_inproj_naive(const Args& a, const Ctx& c, int l) {
    const bf16_t* A = (const bf16_t*)(a.ws + WS_HB); const bf16_t* Bt = (const bf16_t*)(a.ws + WS_WIN) + (size_t)l * DIN * DM;
    bf16_t* O = (bf16_t*)(a.ws + WS_QKVP);
    const int r32 = c.lane & 31, hi = c.lane >> 5, wy = c.wave >> 2, wx = c.wave & 3;
    for (int u = c.bid; u < 512 * 16; u += c.G) {
        const int mt = u >> 4, nt = u & 15;
        f32x16 acc = {};
        wave_gemm32(acc, A + (size_t)(mt * 64 + wy * 32 + r32) * DM + hi * 8, Bt + (size_t)(nt * 128 + wx * 32 + r32) * DM + hi * 8, DM);
        const int nl = inproj_nlog(nt * 128 + wx * 32 + r32);
#pragma unroll
        for (int r = 0; r < 16; ++r) O[(size_t)(mt * 64 + wy * 32 + crow(r, hi)) * DIN + nl] = (bf16_t)f2bf(acc[r]);
    }
}

DEVFN void ph_rope_naive(const Args& a, const Ctx& c) {
    bf16_t* O = (bf16_t*)(a.ws + WS_QKVP); const float* rope = (const float*)(a.ws + WS_ROPE);
    for (int idx = c.bid * 512 + c.tid; idx < NTOK * 16; idx += c.G * 512) {
        const int which = idx & 1, hh = (idx >> 1) & 7, m = idx >> 4, t = m & (SEQ - 1);
        bf16_t* p = O + (size_t)m * DIN + which * 512 + hh * 64;
        float v[64];
#pragma unroll
        for (int q = 0; q < 8; ++q) { const u32x4 w = *(const u32x4*)(p + 8 * q);
            v[8 * q + 0] = bf_lo(w.x); v[8 * q + 1] = bf_hi(w.x); v[8 * q + 2] = bf_lo(w.y); v[8 * q + 3] = bf_hi(w.y);
            v[8 * q + 4] = bf_lo(w.z); v[8 * q + 5] = bf_hi(w.z); v[8 * q + 6] = bf_lo(w.w); v[8 * q + 7] = bf_hi(w.w); }
#pragma unroll
        for (int i = 0; i < 8; ++i) { const float cs = rope[(t * 8 + i) * 2], sn = rope[(t * 8 + i) * 2 + 1]; const float x1 = v[i], x2 = v[8 + i];
            v[i] = x1 * cs - x2 * sn; v[8 + i] = x2 * cs + x1 * sn; }
        const float sc = which == 0 ? QSCALE : 1.f;
#pragma unroll
        for (int q = 0; q < 8; ++q) { u32x4 w; w.x = pk2(v[8 * q] * sc, v[8 * q + 1] * sc); w.y = pk2(v[8 * q + 2] * sc, v[8 * q + 3] * sc); w.z = pk2(v[8 * q + 4] * sc, v[8 * q + 5] * sc); w.w = pk2(v[8 * q + 6] * sc, v[8 * q + 7] * sc);
            *(u32x4*)(p + 8 * q) = w; }
    }
}

DEVFN void ph_kbar(const Args& a, const Ctx& c, int l) {
    const bf16_t* O = (const bf16_t*)(a.ws + WS_QKVP); float* kbar = (float*)(a.ws + WS_KBAR) + (size_t)l * NB * NH * NBLK * HD;
    for (int it = c.gw; it < NB * NH * NBLK; it += c.NGW) {
        const int n = it & 7, hh = (it >> 3) & 7, b = it >> 6;
        const bf16_t* p = O + (size_t)(b * SEQ + n * MBLK) * DIN + 512 + hh * 64 + c.lane;
        float s = 0.f;
#pragma unroll 8
        for (int j = 0; j < MBLK; ++j) s += bf2f(p[(size_t)j * DIN]);
        kbar[(size_t)it * 64 + c.lane] = s * (1.f / MBLK);
    }
}

DEVFN void ph_pool(const Args& a, const Ctx& c) {
    const bf16_t* P = (const bf16_t*)(a.ws + WS_QKVP) + 1536; bf16_t* AD = (bf16_t*)(a.ws + WS_AD) + 512;
    for (int it = c.bid * 512 + c.tid; it < NTOK * 64; it += c.G * 512) {
        const int cg = it & 63, m = it >> 6, t = m & (SEQ - 1), g = cg >> 4, w = 2 << g;
        const int cnt = (t + 1 < w) ? t + 1 : w;
        float s[8];
#pragma unroll
        for (int j = 0; j < 8; ++j) s[j] = 0.f;
        float p0[8];
        for (int i = 0; i < cnt; ++i) { const u32x4 v = *(const u32x4*)(P + (size_t)(m - i) * DIN + cg * 8);
            const float f[8] = {bf_lo(v.x), bf_hi(v.x), bf_lo(v.y), bf_hi(v.y), bf_lo(v.z), bf_hi(v.z), bf_lo(v.w), bf_hi(v.w)};
#pragma unroll
            for (int j = 0; j < 8; ++j) { s[j] += f[j]; if (i == 0) p0[j] = f[j]; } }
        const float ic = 1.f / (float)cnt;
        u32x4 o; o.x = pk2(s[0] * ic - p0[0], s[1] * ic - p0[1]); o.y = pk2(s[2] * ic - p0[2], s[3] * ic - p0[3]); o.z = pk2(s[4] * ic - p0[4], s[5] * ic - p0[5]); o.w = pk2(s[6] * ic - p0[6], s[7] * ic - p0[7]);
        *(u32x4*)(AD + (size_t)m * DM + cg * 8) = o;
    }
}

DEVFN void ph_wout_naive(const Args& a, const Ctx& c, int l) {
    const bf16_t* A = (const bf16_t*)(a.ws + WS_AD); const bf16_t* Bt = (const bf16_t*)(a.ws + WS_WOUT) + (size_t)l * DM * DM;
    float* Y = (float*)(a.ws + WS_QKVP);
    const int r32 = c.lane & 31, hi = c.lane >> 5, wy = c.wave >> 2, wx = c.wave & 3;
    for (int u = c.bid; u < 512 * 8; u += c.G) {
        const int mt = u >> 3, nt = u & 7;
        f32x16 acc = {};
        wave_gemm32(acc, A + (size_t)(mt * 64 + wy * 32 + r32) * DM + hi * 8, Bt + (size_t)(nt * 128 + wx * 32 + r32) * DM + hi * 8, DM);
#pragma unroll
        for (int r = 0; r < 16; ++r) Y[(size_t)(mt * 64 + wy * 32 + crow(r, hi)) * DM + nt * 128 + wx * 32 + r32] = acc[r];
    }
}

DEVFN void ph_rows_c(const Args& a, const Ctx& c, int l) {
    const float* mod = (const float*)(a.ws + WS_MOD) + (size_t)l * NB * NMOD;
    const float* xin = l == 0 ? a.in[I_X] : a.out;
    const float* Y = (const float*)(a.ws + WS_QKVP);
    float* X1 = (float*)(a.ws + WS_X1); bf16_t* HB = (bf16_t*)(a.ws + WS_HB);
    const float* lg = a.in[I_LN1G] + l * DM; const float* lb = a.in[I_LN1B] + l * DM;
    float* wr = (float*)c.lds;
    int* lcnt = (int*)(c.lds + 65536); int* lbase = lcnt + 32;
    int* rcls = lbase + 32; float* rw1 = (float*)(rcls + 8 * 64); float* rw2 = rw1 + 8 * 64; int* rrow = (int*)(rw2 + 8 * 64);
    for (int i = c.tid; i < DM * NE; i += 512) wr[i] = a.in[I_WR][i];
    if (c.tid < 32) lcnt[c.tid] = 0;
    __syncthreads();
    float rb[16];
#pragma unroll
    for (int e = 0; e < 16; ++e) rb[e] = a.in[I_RB][e];
    int nr = 0;
    for (int m = c.gw; m < NTOK; m += c.NGW, ++nr) {
        const int b = m >> 11; const float* mb = mod + (size_t)b * NMOD;
        f32x4 v[4], y[4]; row_load(xin + (size_t)m * DM, c.lane, v); row_load(Y + (size_t)m * DM, c.lane, y);
#pragma unroll
        for (int j = 0; j < 4; ++j) { const f32x4 g = *(const f32x4*)(mb + 2 * DM + 4 * c.lane + 256 * j); v[j] = v[j] * ALPHA + g * y[j]; }
        float mean, rstd; row_stats(v, mean, rstd);
#pragma unroll
        for (int j = 0; j < 4; ++j) { const f32x4 g = *(const f32x4*)(lg + 4 * c.lane + 256 * j), bb = *(const f32x4*)(lb + 4 * c.lane + 256 * j);
            v[j] = (v[j] - mean) * rstd * g + bb; *(f32x4*)(X1 + (size_t)m * DM + 4 * c.lane + 256 * j) = v[j]; }
        row_mod_store(v, mb + 4 * DM, mb + 3 * DM, HB + (size_t)m * DM, c.lane);
        float lg16[16];
#pragma unroll
        for (int e = 0; e < 16; ++e) lg16[e] = 0.f;
#pragma unroll
        for (int j = 0; j < 4; ++j)
#pragma unroll
            for (int i = 0; i < 4; ++i) { const float hv = v[j][i]; const f32x4* wp = (const f32x4*)(wr + (4 * c.lane + 256 * j + i) * 16);
#pragma unroll
                for (int q = 0; q < 4; ++q) { const f32x4 w = wp[q]; lg16[4 * q] += hv * w.x; lg16[4 * q + 1] += hv * w.y; lg16[4 * q + 2] += hv * w.z; lg16[4 * q + 3] += hv * w.w; } }
#pragma unroll
        for (int e = 0; e < 16; ++e) lg16[e] = wave_sum(lg16[e]);
        float mx = lg16[0];
#pragma unroll
        for (int e = 1; e < 16; ++e) mx = fmaxf(mx, lg16[e]);
        float sum = 0.f, sc[16];
#pragma unroll
        for (int e = 0; e < 16; ++e) { sc[e] = __expf(lg16[e] - mx); sum += sc[e]; }
        const float isum = 1.f / sum;
#pragma unroll
        for (int e = 0; e < 16; ++e) sc[e] *= isum;
        float bestg = -3.4e38f; int gb = 0, bi1 = 0, bi2 = 1; float bw1 = 0.f, bw2 = 0.f;
#pragma unroll
        for (int g = 0; g < 4; ++g) {
            float m1 = sc[4 * g] + rb[4 * g], s1 = sc[4 * g]; int i1 = 0;
#pragma unroll
            for (int i = 1; i < 4; ++i) { const float sv = sc[4 * g + i] + rb[4 * g + i]; const bool ok = sv > m1; m1 = ok ? sv : m1; s1 = ok ? sc[4 * g + i] : s1; i1 = ok ? i : i1; }
            float m2 = -3.4e38f, s2 = 0.f; int i2 = 0;
#pragma unroll
            for (int i = 0; i < 4; ++i) { const float sv = sc[4 * g + i] + rb[4 * g + i]; const bool ok = (i != i1) && sv > m2; m2 = ok ? sv : m2; s2 = ok ? sc[4 * g + i] : s2; i2 = ok ? i : i2; }
            const float gs = m1 + m2; const bool better = gs > bestg;
            bestg = better ? gs : bestg; gb = better ? g : gb; bi1 = better ? i1 : bi1; bi2 = better ? i2 : bi2; bw1 = better ? s1 : bw1; bw2 = better ? s2 : bw2;
        }
        const float inv = 1.f / (bw1 + bw2);
        const int lo = bi1 < bi2 ? bi1 : bi2, hi2 = bi1 < bi2 ? bi2 : bi1;
        const float wlo = (bi1 < bi2 ? bw1 : bw2) * inv, whi = (bi1 < bi2 ? bw2 : bw1) * inv;
        const int pidx = lo == 0 ? hi2 - 1 : (lo == 1 ? hi2 + 1 : 5);
        if (c.lane == 0) { rcls[c.wave * 64 + nr] = gb * 6 + pidx; rw1[c.wave * 64 + nr] = wlo; rw2[c.wave * 64 + nr] = whi; rrow[c.wave * 64 + nr] = m; }
    }
    LDS_WAIT();
    int rank = 0, cls = 0;
    if (c.lane < nr) { cls = rcls[c.wave * 64 + c.lane]; rank = atomicAdd(&lcnt[cls], 1); }
    __syncthreads();
    if (c.tid < NCLS) lbase[c.tid] = (int)__hip_atomic_fetch_add((unsigned*)(a.ws + WS_CTL) + CW_CNT + l * 32 + c.tid, (unsigned)lcnt[c.tid], RLX_AGENT);
    __syncthreads();
    if (c.lane < nr) {
        const int pos = lbase[cls] + rank;
        ((int*)(a.ws + WS_LIST))[(size_t)cls * LISTCAP + pos] = rrow[c.wave * 64 + c.lane];
        float* rw = (float*)(a.ws + WS_RW) + ((size_t)cls * LISTCAP + pos) * 2;
        rw[0] = rw1[c.wave * 64 + c.lane]; rw[1] = rw2[c.wave * 64 + c.lane];
    }
}

struct MoeTab { int* cnt; int* tp; };
DEVFN MoeTab moe_table(const Args& a, const Ctx& c, int l, unsigned char* lds_at) {
    MoeTab t; t.cnt = (int*)lds_at; t.tp = t.cnt + 32;
    if (c.tid < NCLS) t.cnt[c.tid] = (int)__hip_atomic_load((unsigned*)(a.ws + WS_CTL) + CW_CNT + l * 32 + c.tid, RLX_AGENT);
    __syncthreads();
    if (c.tid == 0) { int s = 0; for (int k = 0; k < NCLS; ++k) { t.tp[k] = s; s += (t.cnt[k] + 255) >> 8; } t.tp[NCLS] = s; }
    __syncthreads();
    return t;
}
DEVFN void cls_experts(int cls, int& e1, int& e2) { const int g = cls / 6, p = cls % 6; const int lo = p < 3 ? 0 : (p < 5 ? 1 : 2), hi = p < 3 ? p + 1 : (p < 5 ? p - 1 : 3); e1 = g * 4 + lo; e2 = g * 4 + hi; }

DEVFN void ph_gateup_naive(const Args& a, const Ctx& c, int l) {
    const MoeTab T = moe_table(a, c, l, c.lds);
    const int ntiles = T.tp[NCLS];
    const bf16_t* HB = (const bf16_t*)(a.ws + WS_HB); const bf16_t* WGU = (const bf16_t*)(a.ws + WS_WGU) + (size_t)l * NE * DM * DM;
    const int* list = (const int*)(a.ws + WS_LIST); const float* rw = (const float*)(a.ws + WS_RW);
    bf16_t* ACT = (bf16_t*)(a.ws + WS_QKVP);
    const int r32 = c.lane & 31, hi = c.lane >> 5, wy = c.wave >> 2, wx = c.wave & 3;
    for (int u = c.bid; u < ntiles * 32; u += c.G) {
        const int Tt = u >> 5, sub = (u >> 3) & 3, half = (u >> 2) & 1, jt = u & 3;
        int cls = 0; while (Tt >= T.tp[cls + 1]) ++cls;
        const int j = Tt - T.tp[cls], cnt = T.cnt[cls];
        int e1, e2; cls_experts(cls, e1, e2); const int e = half ? e2 : e1;
        const int lr = sub * 64 + wy * 32 + r32, li = 256 * j + lr;
        const int tok = list[(size_t)cls * LISTCAP + (li < cnt ? li : 256 * j)];
        const bf16_t* ap = HB + (size_t)tok * DM + hi * 8;
        const bf16_t* bg = WGU + (size_t)e * DM * DM + (size_t)(jt * 256 + wx * 32 + r32) * DM + hi * 8;
        f32x16 ag = {}, au = {};
        wave_gemm32(ag, ap, bg, DM); wave_gemm32(au, ap, bg + (size_t)128 * DM, DM);
#pragma unroll
        for (int r = 0; r < 16; ++r) {
            const int lro = sub * 64 + wy * 32 + crow(r, hi), lio = 256 * j + lro;
            const float wgt = lio < cnt ? rw[((size_t)cls * LISTCAP + lio) * 2 + half] : 0.f;
            const float g = ag[r], act = g / (1.f + __expf(-g)) * au[r] * wgt;
            ACT[(size_t)(256 * Tt + lro) * DM + half * 512 + jt * 128 + wx * 32 + r32] = (bf16_t)f2bf(act);
        }
    }
}

DEVFN void ph_down_naive(const Args& a, const Ctx& c, int l) {
    const MoeTab T = moe_table(a, c, l, c.lds);
    const int ntiles = T.tp[NCLS];
    const bf16_t* ACT = (const bf16_t*)(a.ws + WS_QKVP); const bf16_t* WD = (const bf16_t*)(a.ws + WS_WD) + (size_t)l * NE * DM * DE;
    const int* list = (const int*)(a.ws + WS_LIST);
    bf16_t* Y2 = (bf16_t*)(a.ws + WS_AD);
    const int r32 = c.lane & 31, hi = c.lane >> 5, wy = c.wave >> 2, wx = c.wave & 3;
    for (int u = c.bid; u < ntiles * 32; u += c.G) {
        const int Tt = u >> 5, sub = (u >> 3) & 3, nt = u & 7;
        int cls = 0; while (Tt >= T.tp[cls + 1]) ++cls;
        const int j = Tt - T.tp[cls], cnt = T.cnt[cls];
        int e1, e2; cls_experts(cls, e1, e2);
        const bf16_t* ap = ACT + (size_t)(256 * Tt + sub * 64 + wy * 32 + r32) * DM + hi * 8;
        const int n = nt * 128 + wx * 32 + r32;
        f32x16 acc = {};
        wave_gemm32(acc, ap, WD + (size_t)e1 * DM * DE + (size_t)n * DE + hi * 8, DE);
        wave_gemm32(acc, ap + DE, WD + (size_t)e2 * DM * DE + (size_t)n * DE + hi * 8, DE);
#pragma unroll
        for (int r = 0; r < 16; ++r) {
            const int lio = 256 * j + sub * 64 + wy * 32 + crow(r, hi);
            if (lio < cnt) { const int tok = list[(size_t)cls * LISTCAP + lio]; Y2[(size_t)tok * DM + n] = (bf16_t)f2bf(acc[r]); }
        }
    }
}

DEVFN void ph_rows_g(const Args& a, const Ctx& c, int l) {
    const float* mod = (const float*)(a.ws + WS_MOD) + (size_t)l * NB * NMOD;
    const float* X1 = (const float*)(a.ws + WS_X1); const bf16_t* Y2 = (const bf16_t*)(a.ws + WS_AD);
    const float* lg = a.in[I_LN2G] + l * DM; const float* lb = a.in[I_LN2B] + l * DM;
    for (int m = c.gw; m < NTOK; m += c.NGW) {
        const int b = m >> 11; const float* mb = mod + (size_t)b * NMOD;
        f32x4 v[4]; row_load(X1 + (size_t)m * DM, c.lane, v);
#pragma unroll
        for (int j = 0; j < 4; ++j) { const f32x4 g = *(const f32x4*)(mb + 5 * DM + 4 * c.lane + 256 * j); const u32x2 yw = *(const u32x2*)(Y2 + (size_t)m * DM + 4 * c.lane + 256 * j);
            const f32x4 y = {bf_lo(yw.x), bf_hi(yw.x), bf_lo(yw.y), bf_hi(yw.y)}; v[j] = v[j] * ALPHA + g * y; }
        float mean, rstd; row_stats(v, mean, rstd);
#pragma unroll
        for (int j = 0; j < 4; ++j) { const f32x4 g = *(const f32x4*)(lg + 4 * c.lane + 256 * j), bb = *(const f32x4*)(lb + 4 * c.lane + 256 * j);
            v[j] = (v[j] - mean) * rstd * g + bb; *(f32x4*)(a.out + (size_t)m * DM + 4 * c.lane + 256 * j) = v[j]; }
        if (l == 0) { const float* mb1 = mod + (size_t)NB * NMOD + (size_t)b * NMOD; row_mod_store(v, mb1 + DM, mb1, (bf16_t*)(a.ws + WS_HB) + (size_t)m * DM, c.lane); }
    }
}

#ifndef MK_N_LAUNCHES
#define MK_N_LAUNCHES 1
#endif
constexpr int RING_BYTES = 131072, LDSCTL_OFF = RING_BYTES, MISC_OFF = LDSCTL_OFF + 320, LDS_BYTES = 147456;
constexpr int PH_PER_LAYER = 9, NPHASE = 2 + 2 * PH_PER_LAYER;
constexpr int CW_BAR = 4096;
static_assert((CW_BAR + XCD_BAR_WORDS) * 4 <= (int)CTL_ZERO_BYTES, "CTL");

__global__ void __launch_bounds__(512, 2) fwd(Args a) {
    extern __shared__ __attribute__((aligned(16))) unsigned char lds[];
    const int wave_s = __builtin_amdgcn_readfirstlane(threadIdx.x >> 6);
#define MKTID() (wave_s * 64 + lane_id_volatile())
#define MKCTX() Ctx c; { int t_ = MKTID(); asm volatile("" : "+v"(t_)); c.lds = lds; c.tid = t_; c.lane = t_ & 63; c.wave = __builtin_amdgcn_readfirstlane(t_ >> 6); c.G = gridDim.x; c.bid = blockIdx.x; c.gw = c.bid * 8 + c.wave; c.NGW = c.G * 8; }
    const int lo = a.ph_lo, hi = a.ph_hi;
    const bool one = (hi - lo) > 1;
    for (int u = threadIdx.x; u < (LDS_BYTES - LDSCTL_OFF) / 4; u += 512) ((LAS unsigned*)((LAS unsigned char*)lds + LDSCTL_OFF))[u] = 0u;
    __syncthreads();
    XcdBarrier bar; bar.bar = (unsigned*)(a.ws + WS_CTL) + CW_BAR; bar.x = 0; bar.st = nullptr;
    if (one) bar = xcd_barrier_post((unsigned*)(a.ws + WS_CTL) + CW_BAR, (volatile LAS unsigned*)((LAS unsigned char*)lds + MISC_OFF) + 8);
#define IN(k) (lo <= (k) && (k) < hi)
#define SEAM(k) do { if (IN(k) && IN((k) + 1)) xcd_barrier(bar, MKTID() == 0); } while (0)
    if (IN(0)) { MKCTX(); ph_prologue(a, c); SEAM(0); }
    if (IN(1)) { MKCTX(); ph_h1_rows(a, c); SEAM(1); }
    for (int l = 0; l < 2; ++l) {
        const int p0 = 2 + l * PH_PER_LAYER;
        if (IN(p0 + 0)) { MKCTX(); ph_inproj_naive(a, c, l); SEAM(p0 + 0); }
        if (IN(p0 + 1)) { MKCTX(); ph_rope_naive(a, c); SEAM(p0 + 1); }
        if (IN(p0 + 2)) { MKCTX(); ph_kbar(a, c, l); SEAM(p0 + 2); }
        if (IN(p0 + 3)) {
            { MKCTX(); ph_pool(a, c); }
            __syncthreads();
            const attn_body::AttnTensors AT{(const attn_body::bf16*)(a.ws + WS_QKVP), (const attn_body::bf16*)(a.ws + WS_QKVP) + 512, (const attn_body::bf16*)(a.ws + WS_QKVP) + 1024,
                                            (attn_body::bf16*)(a.ws + WS_AD), (const float*)(a.ws + WS_KBAR) + (size_t)l * NB * NH * NBLK * HD};
            const attn_body::StaticOrder S((int)gridDim.x, (int)blockIdx.x);
            attn_body::attn_phase<attn_body::StaticOrder>((char*)lds, AT, S, MKTID());
            SEAM(p0 + 3);
        }
        if (IN(p0 + 4)) { MKCTX(); ph_wout_naive(a, c, l); SEAM(p0 + 4); }
        if (IN(p0 + 5)) { MKCTX(); ph_rows_c(a, c, l); SEAM(p0 + 5); }
        if (IN(p0 + 6)) { MKCTX(); ph_gateup_naive(a, c, l); SEAM(p0 + 6); }
        if (IN(p0 + 7)) { MKCTX(); ph_down_naive(a, c, l); SEAM(p0 + 7); }
        if (IN(p0 + 8)) { MKCTX(); ph_rows_g(a, c, l); SEAM(p0 + 8); }
    }
#undef IN
#undef SEAM
}

extern "C" void kernel_launch(void* const* d_in, const int* in_sizes, int n_in, void* d_out, int out_size, void* d_ws, size_t ws_size, hipStream_t stream) {
    static int grid = 0;
    if (grid == 0) {
        if (n_in != 17 || out_size != NTOK * DM || ws_size < WS_END) { fprintf(stderr, "kernel_launch: unexpected problem (n_in %d out %d ws %zu)\n", n_in, out_size, ws_size); grid = -1; return; }
        if (hipFuncSetAttribute((const void*)fwd, hipFuncAttributeMaxDynamicSharedMemorySize, LDS_BYTES) != hipSuccess) { fprintf(stderr, "kernel_launch: hipFuncSetAttribute failed\n"); grid = -1; return; }
        int dev = 0, cus = 0, per_cu = 0;
        (void)hipGetDevice(&dev); (void)hipDeviceGetAttribute(&cus, hipDeviceAttributeMultiprocessorCount, dev);
        if (hipOccupancyMaxActiveBlocksPerMultiprocessor(&per_cu, (const void*)fwd, 512, LDS_BYTES) != hipSuccess || per_cu < 1) fprintf(stderr, "kernel_launch: occupancy query reports %d workgroups per CU\n", per_cu);
        (void)hipGetLastError();
        grid = cus > 0 ? cus : 256;
    }
    if (grid < 0) return;
    (void)hipMemsetAsync((char*)d_ws + WS_CTL, 0, CTL_ZERO_BYTES, stream);
    Args a{};
    for (int i = 0; i < 17; ++i) a.in[i] = (const float*)d_in[i];
    a.out = (float*)d_out; a.ws = (unsigned char*)d_ws;
#if MK_N_LAUNCHES == 1
    a.ph_lo = 0; a.ph_hi = NPHASE; hipLaunchKernelGGL(fwd, dim3(grid), dim3(512), LDS_BYTES, stream, a);
#else
    for (int p = 0; p < NPHASE; ++p) { a.ph_lo = p; a.ph_hi = p + 1; hipLaunchKernelGGL(fwd, dim3(grid), dim3(512), LDS_BYTES, stream, a); }
#endif
}
```

```cpp
#include <hip/hip_runtime.h>
#include <cstdint>
#include <cstdio>

constexpr int NB = 16, SEQ = 2048, DM = 1024, NTOK = NB * SEQ, DIN = 2048, NH = 8, HD = 64, NBLK = 8, MBLK = 256;
constexpr int NE = 16, NCLS = 24, DE = 512, NMOD = 6 * DM;
constexpr float ALPHA = 1.41421356237309515f, LN_EPS = 1e-5f;
constexpr float QSCALE = 0.125f * 1.4426950408889634f;
constexpr int LISTCAP = NTOK;

constexpr size_t MiB = 1u << 20;
constexpr size_t WS_CTL = 0, CTL_ZERO_BYTES = 1 * MiB;
constexpr size_t WS_MOD = 1 * MiB;
constexpr size_t WS_ROPE = 2 * MiB;
constexpr size_t WS_KBAR = 2 * MiB + 256 * 1024;
constexpr size_t WS_LIST = 3 * MiB;
constexpr size_t WS_RW = 6 * MiB;
constexpr size_t WS_WIN = 12 * MiB;
constexpr size_t WS_WOUT = 20 * MiB;
constexpr size_t WS_WGU = 24 * MiB;
constexpr size_t WS_WD = 88 * MiB;
constexpr size_t WS_HB = 120 * MiB;
constexpr size_t WS_QKVP = 184 * MiB;
constexpr size_t WS_AD = 312 * MiB;
constexpr size_t WS_X1 = 376 * MiB;
constexpr size_t WS_END = 504 * MiB;
constexpr int CW_TMO = 0, CW_CNT = 64;

typedef unsigned short bf16_t;
typedef short bf16x8 __attribute__((ext_vector_type(8)));
typedef float f32x4 __attribute__((ext_vector_type(4)));
typedef float f32x16 __attribute__((ext_vector_type(16)));
typedef unsigned u32x4 __attribute__((ext_vector_type(4)));
typedef unsigned u32x2 __attribute__((ext_vector_type(2)));

#define DEVFN __device__ __forceinline__
#define LDS_WAIT() asm volatile("s_waitcnt lgkmcnt(0)" ::: "memory")
#define RLX_AGENT __ATOMIC_RELAXED, __HIP_MEMORY_SCOPE_AGENT

DEVFN float bf_lo(unsigned w) { return __uint_as_float(w << 16); }
DEVFN float bf_hi(unsigned w) { return __uint_as_float(w & 0xffff0000u); }
DEVFN float bf2f(bf16_t v) { return __uint_as_float((unsigned)v << 16); }
DEVFN unsigned f2bf(float f) { unsigned u = __float_as_uint(f); return (u + 0x7fffu + ((u >> 16) & 1u)) >> 16; }
DEVFN unsigned pk2(float lo, float hi) { return f2bf(lo) | (f2bf(hi) << 16); }
DEVFN int crow(int r, int hi) { return (r & 3) + 8 * (r >> 2) + 4 * hi; }
#define SWZ_XOR(m) (0x1f | ((m) << 10))
DEVFN float swz_xor_add(float v, const int m) {
    switch (m) {
        case 1: return v + __int_as_float(__builtin_amdgcn_ds_swizzle(__float_as_int(v), SWZ_XOR(1)));
        case 2: return v + __int_as_float(__builtin_amdgcn_ds_swizzle(__float_as_int(v), SWZ_XOR(2)));
        case 4: return v + __int_as_float(__builtin_amdgcn_ds_swizzle(__float_as_int(v), SWZ_XOR(4)));
        case 8: return v + __int_as_float(__builtin_amdgcn_ds_swizzle(__float_as_int(v), SWZ_XOR(8)));
        default: return v + __int_as_float(__builtin_amdgcn_ds_swizzle(__float_as_int(v), SWZ_XOR(16)));
    }
}
DEVFN float half_swap_add(float v) { auto rr = __builtin_amdgcn_permlane32_swap(__float_as_uint(v), __float_as_uint(v), false, false); return __uint_as_float(rr[0]) + __uint_as_float(rr[1]); }
DEVFN float wave_sum(float v) {
    v = swz_xor_add(v, 1); v = swz_xor_add(v, 2); v = swz_xor_add(v, 4); v = swz_xor_add(v, 8); v = swz_xor_add(v, 16);
    return half_swap_add(v);
}
__host__ __device__ __forceinline__ int inproj_lgroup(int P) { return P < 16 ? (P >> 2) * 8 + (P & 3) * 2 : ((P - 16) >> 2) * 8 + ((P - 16) & 3) * 2 + 1; }
__host__ __device__ __forceinline__ int inproj_nlog(int n) { return (n & ~255) + inproj_lgroup((n & 255) >> 3) * 8 + (n & 7); }

#define GAS __attribute__((address_space(1)))
#define LAS __attribute__((address_space(3)))
typedef GAS unsigned gu32;
namespace pg8 {
#define PG8_LAS __attribute__((address_space(3)))
typedef unsigned short bf16_t;
typedef short bf16x8 __attribute__((ext_vector_type(8)));
typedef float f32x4 __attribute__((ext_vector_type(4)));
typedef unsigned u32x4 __attribute__((ext_vector_type(4)));
constexpr int BM = 256, BK = 64, HALF = 128, HTB = HALF * BK * 2  , STAGE_BYTES = 8 * HTB, NXCD = 8, WGM = 8;

__host__ __device__ __forceinline__ int lds_byte(int r, int c) { const int st = (r >> 4) * 2 + (c >> 5), rr = r & 15, cc = c & 31, ob = rr * 64 + cc * 2; return st * 1024 + (ob ^ (((ob >> 9) & 1) << 5)); }
__host__ __device__ __forceinline__ void stage_rc(int b, int& R, int& C) { const int st = b / 1024, sb = b % 1024, swz = sb ^ (((sb >> 9) & 1) << 5); R = (st >> 1) * 16 + swz / 64; C = (st & 1) * 32 + (swz % 64) / 2; }
__host__ __device__ __forceinline__ int perm32(int rho) { const int n = rho >> 4, i = rho & 15; return 8 * (i >> 2) + 4 * n + (i & 3); }

struct Unit { int pm, pn; };
struct Gemm { const bf16_t* A; const bf16_t* Bt; int M, N, K; };

struct StaticOrder {
    int nM, nN, nwg, G, c;
    __host__ __device__ void init(int M, int N, int G_, int c_) { nM = M / BM; nN = N / BM; nwg = nM * nN; G = G_; c = c_; }
    __host__ __device__ bool next(int i, Unit& u) const {
        const long L = (long)i * G + c; if (L >= nwg) return false;
        int wgid = (int)L; { const int q = nwg / NXCD, r = nwg % NXCD, xcd = wgid % NXCD, off = wgid / NXCD; wgid = (xcd < r ? xcd * (q + 1) : r * (q + 1) + (xcd - r) * q) + off; }
        const int nig = WGM * nN, gid = wgid / nig, fm = gid * WGM, gsz = (nM - fm) < WGM ? (nM - fm) : WGM;
        u.pm = fm + ((wgid % nig) % gsz); u.pn = (wgid % nig) / gsz; return true;
    }
    __device__ __forceinline__ void a_ready(const Unit&) const {}
    __device__ __forceinline__ void done(const Unit&) const {}
};

__device__ __forceinline__ unsigned cvt_pk_bf16(float lo, float hi) { unsigned r; asm volatile("v_cvt_pk_bf16_f32 %0, %1, %2" : "=v"(r) : "v"(lo), "v"(hi)); return r; }
typedef float f32x2 __attribute__((ext_vector_type(2)));
__device__ __forceinline__ f32x2 gelu_pk(f32x2 v) {
    const f32x2 av = __builtin_elementwise_abs(v), d = av * 0.2316418882f + 1.0f;
    f32x2 t; t.x = __builtin_amdgcn_rcpf(d.x); t.y = __builtin_amdgcn_rcpf(d.y);
    f32x2 q = t * 0.5307027145f + (-0.7265760135f); q = q * t + 0.7107068705f; q = q * t + (-0.142248368f); q = q * t + 0.127414796f; q = q * t;
    const f32x2 s = (v * v) * (-0.72134752044f);
    f32x2 e; e.x = __builtin_amdgcn_exp2f(s.x); e.y = __builtin_amdgcn_exp2f(s.y);
    const f32x2 m = v * (q * e), r = v - m;
    f32x2 o; o.x = v.x < 0.f ? m.x : r.x; o.y = v.y < 0.f ? m.y : r.y; return o;
}

template <int ACT  > struct EpiBf16 {
    static constexpr bool PERM = true, AFTER_DRAIN = false; static_assert(ACT == 0 || ACT == 1, "EpiBf16: ACT is 0 (none) or 1 (gelu_pk)");
    bf16_t* O; int ldc; const float* bias; int split_cols; size_t split_stride; float scale0;
    __device__ __forceinline__ void operator()(const f32x4 (&acc)[2][2][4][2], const Unit& u, int wr, int wc, int fr, int fq) const {
        const int row0 = u.pm * BM + wr * 64 + fr; int colt = u.pn * BM; bf16_t* base = O;
        float sc = 1.f; if (split_cols) { const int t = colt / split_cols; base += (size_t)t * split_stride; colt -= t * split_cols; if (t == 0) sc = scale0; }
        const int col0 = colt + wc * 32 + 8 * fq, bcol0 = u.pn * BM + wc * 32 + 8 * fq;
        f32x4 bv[2][2];
#pragma unroll
        for (int bj = 0; bj < 2; ++bj)
#pragma unroll
            for (int n = 0; n < 2; ++n) bv[bj][n] = bias ? *(const f32x4*)(bias + bcol0 + bj * HALF + 4 * n) : (f32x4){0.f, 0.f, 0.f, 0.f};
#pragma unroll
        for (int ai = 0; ai < 2; ++ai)
#pragma unroll
            for (int m = 0; m < 4; ++m) { bf16_t* rowp = base + (size_t)(row0 + ai * HALF + m * 16) * ldc + col0;
#pragma unroll
                for (int bj = 0; bj < 2; ++bj) { f32x4 v0 = acc[ai][bj][m][0] + bv[bj][0], v1 = acc[ai][bj][m][1] + bv[bj][1];
                    if (ACT == 1) { f32x2 a = gelu_pk((f32x2){v0[0], v0[1]}), b = gelu_pk((f32x2){v0[2], v0[3]}), c = gelu_pk((f32x2){v1[0], v1[1]}), d = gelu_pk((f32x2){v1[2], v1[3]});
                        v0 = (f32x4){a.x, a.y, b.x, b.y}; v1 = (f32x4){c.x, c.y, d.x, d.y}; }
                    v0 = v0 * sc; v1 = v1 * sc; u32x4 w; w.x = cvt_pk_bf16(v0[0], v0[1]); w.y = cvt_pk_bf16(v0[2], v0[3]); w.z = cvt_pk_bf16(v1[0], v1[1]); w.w = cvt_pk_bf16(v1[2], v1[3]);
                    *(u32x4*)(rowp + bj * HALF) = w; } }
    }
};

struct PanelStats {
    unsigned* xbuf;
    unsigned* cnt;
    unsigned* tmo;
    int ntn; float eps;
    unsigned code;
    __device__ __forceinline__ bool run(const f32x4 (&v)[2][2][4][2], const Unit& u, int wr, int wc, int fr, int fq, PG8_LAS unsigned char* lds, int wid, int lane) const {
        typedef float f32x2v __attribute__((ext_vector_type(2)));
        PG8_LAS f32x2v* P = (PG8_LAS f32x2v*)lds;
        PG8_LAS f32x2v* S = (PG8_LAS f32x2v*)(lds + 8192);
        PG8_LAS unsigned* flag = (PG8_LAS unsigned*)(lds + 8192 + 2048);
#pragma unroll
        for (int ai = 0; ai < 2; ++ai)
#pragma unroll
            for (int m = 0; m < 4; ++m) {
                float s = 0.f;
#pragma unroll
                for (int bj = 0; bj < 2; ++bj)
#pragma unroll
                    for (int n = 0; n < 2; ++n) { const f32x4 x = v[ai][bj][m][n]; s += (x[0] + x[1]) + (x[2] + x[3]); }
                s += __shfl_xor(s, 16); s += __shfl_xor(s, 32);
                const float mw = s * (1.0f / 64.0f); float q = 0.f;
#pragma unroll
                for (int bj = 0; bj < 2; ++bj)
#pragma unroll
                    for (int n = 0; n < 2; ++n) { const f32x4 d = v[ai][bj][m][n] - mw; q += (d[0] * d[0] + d[1] * d[1]) + (d[2] * d[2] + d[3] * d[3]); }
                q += __shfl_xor(q, 16); q += __shfl_xor(q, 32);
                if (fq == 0) P[(ai * HALF + wr * 64 + m * 16 + fr) * 4 + wc] = (f32x2v){mw, q};
            }
        asm volatile("s_waitcnt lgkmcnt(0)" ::: "memory"); __builtin_amdgcn_s_barrier(); asm volatile("" ::: "memory");
#if defined(BROKEN_EXCHANGE_NO_WAIT)
#warning BROKEN CONTROL BUILD: the row-statistics exchange does not wait; results are wrong by design
        if (blockIdx.x >= 64) { const long long t0_ = clock64(); while (clock64() - t0_ < 60000) __builtin_amdgcn_s_sleep(8); }
#endif
        const int row = wid * 32 + (lane & 31);
        if (lane < 32) {
            const f32x2v a = P[row * 4 + 0], b = P[row * 4 + 1], c = P[row * 4 + 2], d = P[row * 4 + 3];
            const float mt = (a.x + b.x + c.x + d.x) * 0.25f;
            const float da = a.x - mt, db = b.x - mt, dc = c.x - mt, dd = d.x - mt;
            const float m2 = (a.y + b.y) + (c.y + d.y) + 64.0f * ((da * da + db * db) + (dc * dc + dd * dd));
            unsigned long long* slot = (unsigned long long*)xbuf + ((size_t)(u.pm * BM + row) * 4 + u.pn);
            __hip_atomic_store(slot, ((unsigned long long)__float_as_uint(m2) << 32) | __float_as_uint(mt), __ATOMIC_RELAXED, __HIP_MEMORY_SCOPE_AGENT);
        }
        asm volatile("s_waitcnt vmcnt(0)" ::: "memory");
        if (lane == 0) __hip_atomic_fetch_add(cnt + 64 * u.pm, 1u, __ATOMIC_RELAXED, __HIP_MEMORY_SCOPE_AGENT);
        if (wid == 0) {
            bool dead = false; const unsigned long long t0 = __builtin_amdgcn_s_memrealtime(); const unsigned want = 8u * (unsigned)ntn;
            for (;;) {
#if defined(BROKEN_EXCHANGE_NO_WAIT)
                break;
#endif
                if ((unsigned)__builtin_amdgcn_readfirstlane(__hip_atomic_load(cnt + 64 * u.pm, __ATOMIC_RELAXED, __HIP_MEMORY_SCOPE_AGENT)) >= want) break;
                if (__builtin_amdgcn_s_memrealtime() - t0 > 2000000ull) {
                    if (lane == 0) { unsigned expect = 0u; __hip_atomic_compare_exchange_strong(tmo + 1, &expect, code | (unsigned)(u.pm & 0xff), __ATOMIC_RELAXED, __ATOMIC_RELAXED, __HIP_MEMORY_SCOPE_AGENT);
                                     __hip_atomic_store(tmo, 1u, __ATOMIC_RELAXED, __HIP_MEMORY_SCOPE_AGENT); }
                    dead = true; break; }
                __builtin_amdgcn_s_sleep(2);
            }
            __builtin_amdgcn_fence(__ATOMIC_ACQUIRE, "agent");
            if (lane == 0) flag[0] = dead ? 1u : 0u;
        }
        asm volatile("s_waitcnt vmcnt(0) lgkmcnt(0)" ::: "memory"); __builtin_amdgcn_s_barrier(); asm volatile("" ::: "memory");
        const bool bad = flag[0] != 0u;
        if (lane < 32) {
            const unsigned long long* slot = (const unsigned long long*)xbuf + (size_t)(u.pm * BM + row) * 4; float mt[4], m2[4]; float ms = 0.f;
#pragma unroll
            for (int t = 0; t < 4; ++t) { if (t < ntn) { const unsigned long long w = __hip_atomic_load(slot + t, __ATOMIC_RELAXED, __HIP_MEMORY_SCOPE_AGENT); mt[t] = __uint_as_float((unsigned)w); m2[t] = __uint_as_float((unsigned)(w >> 32)); } else { mt[t] = 0.f; m2[t] = 0.f; } ms += mt[t]; }
            const float mean = ms / (float)ntn; float q = 0.f;
#pragma unroll
            for (int t = 0; t < 4; ++t) if (t < ntn) { const float dm = mt[t] - mean; q += m2[t] + 256.0f * dm * dm; }
            S[row] = (f32x2v){mean, 1.0f / sqrtf(q / (256.0f * (float)ntn) + eps)};
        }
        asm volatile("s_waitcnt lgkmcnt(0)" ::: "memory"); __builtin_amdgcn_s_barrier(); asm volatile("" ::: "memory");
        return bad;
    }
};
struct EpiLnRes {
    static constexpr bool PERM = false, AFTER_DRAIN = true;
    const float* base; float* out; int ldc; const float* bias; PanelStats st; unsigned poison;
    __device__ __forceinline__ void fused(f32x4 (&acc)[2][2][4][2], const Unit& u, int wr, int wc, int fr, int fq, PG8_LAS unsigned char* lds, int wid, int lane) const {
        typedef float f32x2v __attribute__((ext_vector_type(2)));
        const PG8_LAS f32x2v* S = (const PG8_LAS f32x2v*)(lds + 8192);
        const int col0 = u.pn * BM + wc * 32 + 4 * fq;
#pragma unroll
        for (int bj = 0; bj < 2; ++bj)
#pragma unroll
            for (int n = 0; n < 2; ++n) { const f32x4 bv = bias ? *(const f32x4*)(bias + col0 + bj * HALF + n * 16) : (f32x4){0.f, 0.f, 0.f, 0.f};
#pragma unroll
                for (int ai = 0; ai < 2; ++ai)
#pragma unroll
                    for (int m = 0; m < 4; ++m) acc[ai][bj][m][n] += bv; }
        f32x4 pre[4][2][2];
#pragma unroll
        for (int m = 0; m < 4; ++m) { const size_t off = (size_t)(u.pm * BM + wr * 64 + m * 16 + fr) * ldc + col0;
#pragma unroll
            for (int bj = 0; bj < 2; ++bj)
#pragma unroll
                for (int n = 0; n < 2; ++n) pre[m][bj][n] = *(const f32x4*)(base + off + bj * HALF + n * 16); }
        const bool bad = st.run(acc, u, wr, wc, fr, fq, lds, wid, lane) || poison != 0u;
        const float qnan = __builtin_nanf("");
#pragma unroll
        for (int ai = 0; ai < 2; ++ai)
#pragma unroll
            for (int m = 0; m < 4; ++m) { const int r = ai * HALF + wr * 64 + m * 16 + fr; const f32x2v sr = S[r]; const size_t off = (size_t)(u.pm * BM + r) * ldc + col0;
#pragma unroll
                for (int bj = 0; bj < 2; ++bj)
#pragma unroll
                    for (int n = 0; n < 2; ++n) { const f32x4 bs = ai == 0 ? pre[m][bj][n] : *(const f32x4*)(base + off + bj * HALF + n * 16); f32x4 o = bs + (acc[ai][bj][m][n] - sr.x) * sr.y;
                        if (bad) o = (f32x4){qnan, qnan, qnan, qnan}; *(f32x4*)(out + off + bj * HALF + n * 16) = o; }
                if (m & 1) asm volatile("" ::: "memory"); }
    }
};
struct EpiLnResLn {
    static constexpr bool PERM = false, AFTER_DRAIN = true;
    const float* base; float* out; bf16_t* xn; int ldc; const float* bias; PanelStats st1, st2; unsigned poison;
    __device__ __forceinline__ void fused(f32x4 (&acc)[2][2][4][2], const Unit& u, int wr, int wc, int fr, int fq, PG8_LAS unsigned char* lds, int wid, int lane) const {
        typedef float f32x2v __attribute__((ext_vector_type(2))); typedef unsigned u32x2v __attribute__((ext_vector_type(2)));
        const PG8_LAS f32x2v* S = (const PG8_LAS f32x2v*)(lds + 8192);
        const int col0 = u.pn * BM + wc * 32 + 4 * fq;
#pragma unroll
        for (int bj = 0; bj < 2; ++bj)
#pragma unroll
            for (int n = 0; n < 2; ++n) { const f32x4 bv = bias ? *(const f32x4*)(bias + col0 + bj * HALF + n * 16) : (f32x4){0.f, 0.f, 0.f, 0.f};
#pragma unroll
                for (int ai = 0; ai < 2; ++ai)
#pragma unroll
                    for (int m = 0; m < 4; ++m) acc[ai][bj][m][n] += bv; }
        bool bad = st1.run(acc, u, wr, wc, fr, fq, lds, wid, lane) || poison != 0u;
        const float qnan = __builtin_nanf("");
#pragma unroll
        for (int ai = 0; ai < 2; ++ai)
#pragma unroll
            for (int m = 0; m < 4; ++m) { const int r = ai * HALF + wr * 64 + m * 16 + fr; const f32x2v sr = S[r]; const size_t off = (size_t)(u.pm * BM + r) * ldc + col0;
#pragma unroll
                for (int bj = 0; bj < 2; ++bj)
#pragma unroll
                    for (int n = 0; n < 2; ++n) { const f32x4 bs = *(const f32x4*)(base + off + bj * HALF + n * 16); acc[ai][bj][m][n] = bs + (acc[ai][bj][m][n] - sr.x) * sr.y; }
                asm volatile("" : "+v"(acc[ai][0][m][0]), "+v"(acc[ai][0][m][1]), "+v"(acc[ai][1][m][0]), "+v"(acc[ai][1][m][1]));
                if (m & 1) asm volatile("" ::: "memory"); }
        const bool bad1 = bad;
        bad = st2.run(acc, u, wr, wc, fr, fq, lds, wid, lane) || bad;
#pragma unroll
        for (int ai = 0; ai < 2; ++ai)
#pragma unroll
            for (int m = 0; m < 4; ++m) { const int r = ai * HALF + wr * 64 + m * 16 + fr; const f32x2v sr = S[r]; const size_t off = (size_t)(u.pm * BM + r) * ldc + col0;
#pragma unroll
                for (int bj = 0; bj < 2; ++bj)
#pragma unroll
                    for (int n = 0; n < 2; ++n) { const f32x4 x1 = acc[ai][bj][m][n]; *(f32x4*)(out + off + bj * HALF + n * 16) = bad1 ? (f32x4){qnan, qnan, qnan, qnan} : x1;
                        const f32x4 o = (x1 - sr.x) * sr.y; u32x2v w; w.x = cvt_pk_bf16(o[0], o[1]); w.y = cvt_pk_bf16(o[2], o[3]);
                        if (bad) { w.x = 0x7fc07fc0u; w.y = 0x7fc07fc0u; } *(u32x2v*)(xn + off + bj * HALF + n * 16) = w; }
                asm volatile("" ::: "memory"); }
    }
};

template <class Epi, class Sched, bool ALIGN_EPI = false, bool SP2 = false>
__device__ __forceinline__ void gemm_phase(PG8_LAS unsigned char* lds, const Gemm g, const Sched& S, const Epi& E) {
    const int tid = threadIdx.x, wid = __builtin_amdgcn_readfirstlane(tid >> 6), lane = tid & 63, wr = wid >> 2, wc = wid & 3, fr = lane & 15, fq = lane >> 4;
    const int K = g.K, nt = K / BK;
    unsigned voffA[2], voffB[2];
#pragma unroll
    for (int i = 0; i < 2; ++i) { int R, C; stage_rc(tid * 16 + i * 8192, R, C); const int Rb = Epi::PERM ? ((R & ~31) + perm32(R & 31)) : R;
        voffA[i] = (unsigned)(R * K + C) * 2u; voffB[i] = (unsigned)(Rb * K + C) * 2u; }
    const size_t kstep = (size_t)(BK * 2);
    const size_t hstep = (size_t)HALF * K * 2;
    const size_t tstep = 2 * hstep;
    const unsigned ldsw = (unsigned)wid * 1024u;
    const int aoff = lds_byte(wr * 64 + fr, fq * 8), boff = lds_byte(wc * 32 + fr, fq * 8);
#define PG8_SA(b, h) (((b) * 2 + (h)) * HTB)
#define PG8_SB(b, h) ((4 + (b) * 2 + (h)) * HTB)
#define PG8_STAGE(bufoff, gbase, voff) do { _Pragma("unroll") for (int _i = 0; _i < 2; ++_i) \
        __builtin_amdgcn_global_load_lds((const unsigned*)((const char*)(gbase) + (voff)[_i]), (PG8_LAS unsigned*)(lds + (bufoff) + ldsw + _i * 8192), 16, 0, 0); } while (0)
#define PG8_LDA(dst, b, h) do { _Pragma("unroll") for (int m = 0; m < 4; ++m) _Pragma("unroll") for (int k = 0; k < 2; ++k) dst[m][k] = *(const PG8_LAS bf16x8*)(lds + PG8_SA(b, h) + aoff + m * 2048 + k * 1024); } while (0)
#define PG8_LDB(dst, b, h) do { _Pragma("unroll") for (int n = 0; n < 2; ++n) _Pragma("unroll") for (int k = 0; k < 2; ++k) dst[n][k] = *(const PG8_LAS bf16x8*)(lds + PG8_SB(b, h) + boff + n * 2048 + k * 1024); } while (0)
#define PG8_MMA(ai, bj, At, Bt) do { __builtin_amdgcn_s_setprio(1); _Pragma("unroll") for (int m = 0; m < 4; ++m) _Pragma("unroll") for (int n = 0; n < 2; ++n) _Pragma("unroll") for (int k = 0; k < 2; ++k) \
        acc[ai][bj][m][n] = __builtin_amdgcn_mfma_f32_16x16x32_bf16(Bt[n][k], At[m][k], acc[ai][bj][m][n], 0, 0, 0); __builtin_amdgcn_s_setprio(0); } while (0)
#define PG8_WAIT_V(n) asm volatile("s_waitcnt vmcnt(" #n ")" ::: "memory")
#define PG8_WAIT_L(n) asm volatile("s_waitcnt lgkmcnt(" #n ")" ::: "memory")
#define PG8_BAR __builtin_amdgcn_s_barrier()
#define PG8_SCHED __builtin_amdgcn_sched_barrier(0)
    Unit cur, nxt; int ui = 0;
    if (!S.next(0, cur)) return;
    f32x4 acc[2][2][4][2];
#pragma unroll
    for (int a = 0; a < 2; ++a)
#pragma unroll
        for (int b = 0; b < 2; ++b)
#pragma unroll
            for (int m = 0; m < 4; ++m)
#pragma unroll
                for (int n = 0; n < 2; ++n) acc[a][b][m][n] = (f32x4){0.f, 0.f, 0.f, 0.f};
    bf16x8 At[4][2], B0[2][2], B1[2][2];
    const char* cA = (const char*)g.A + (size_t)cur.pm * tstep; const char* cB = (const char*)g.Bt + (size_t)cur.pn * tstep;
    S.a_ready(cur);
    if constexpr (SP2) {
        PG8_STAGE(PG8_SB(0, 0), cB, voffB); PG8_STAGE(PG8_SB(0, 1), cB + hstep, voffB); PG8_STAGE(PG8_SA(0, 0), cA, voffA); PG8_STAGE(PG8_SA(0, 1), cA + hstep, voffA);
        if (wr == 1) PG8_BAR;
        PG8_WAIT_V(2); PG8_BAR;
        PG8_STAGE(PG8_SB(1, 0), cB + kstep, voffB); PG8_STAGE(PG8_SA(1, 0), cA + kstep, voffA); PG8_STAGE(PG8_SB(1, 1), cB + hstep + kstep, voffB);
        PG8_WAIT_V(6); PG8_BAR;
    } else {
        PG8_STAGE(PG8_SB(0, 0), cB, voffB); PG8_STAGE(PG8_SA(0, 0), cA, voffA); PG8_STAGE(PG8_SB(0, 1), cB + hstep, voffB); PG8_STAGE(PG8_SA(0, 1), cA + hstep, voffA);
        if (wr == 1) PG8_BAR;
        PG8_WAIT_V(4); PG8_BAR;
        PG8_STAGE(PG8_SB(1, 0), cB + kstep, voffB); PG8_STAGE(PG8_SA(1, 0), cA + kstep, voffA); PG8_STAGE(PG8_SB(1, 1), cB + hstep + kstep, voffB);
        PG8_WAIT_V(6); PG8_BAR;
    }
    for (;;) {
        const bool has_next = S.next(ui + 1, nxt);
        const char* nA = has_next ? (const char*)g.A + (size_t)nxt.pm * tstep : cA; const char* nB = has_next ? (const char*)g.Bt + (size_t)nxt.pn * tstep : cB;
        for (int t = 0; t < nt; t += 2) {
            const bool last = (t == nt - 2);
            const char* a1 = cA + (size_t)(t + 1) * kstep;
            const char* a2 = last ? nA : cA + (size_t)(t + 2) * kstep; const char* b2 = last ? nB : cB + (size_t)(t + 2) * kstep;
            const char* a3 = a2 + kstep; const char* b3 = b2 + kstep;
            if (last && has_next) S.a_ready(nxt);
            if constexpr (SP2) {
            PG8_LDB(B0, 0, 0); PG8_LDB(B1, 0, 1); PG8_SCHED; PG8_LDA(At, 0, 0); PG8_STAGE(PG8_SA(1, 1), a1 + hstep, voffA);
            PG8_WAIT_V(8); PG8_WAIT_L(0); PG8_BAR; PG8_MMA(0, 0, At, B0); PG8_MMA(0, 1, At, B1); PG8_BAR; PG8_SCHED;
            PG8_LDA(At, 0, 1); PG8_STAGE(PG8_SB(0, 0), b2, voffB); PG8_STAGE(PG8_SB(0, 1), b2 + hstep, voffB); PG8_STAGE(PG8_SA(0, 0), a2, voffA);
            PG8_WAIT_V(8); PG8_WAIT_L(0); PG8_BAR; PG8_MMA(1, 0, At, B0); PG8_MMA(1, 1, At, B1); PG8_BAR; PG8_SCHED;
            PG8_LDB(B0, 1, 0); PG8_LDB(B1, 1, 1); PG8_SCHED; PG8_LDA(At, 1, 0); PG8_STAGE(PG8_SA(0, 1), a2 + hstep, voffA);
            PG8_WAIT_V(8); PG8_WAIT_L(0); PG8_BAR; PG8_MMA(0, 0, At, B0); PG8_MMA(0, 1, At, B1); PG8_BAR; PG8_SCHED;
            PG8_LDA(At, 1, 1); PG8_STAGE(PG8_SB(1, 0), b3, voffB); PG8_STAGE(PG8_SB(1, 1), b3 + hstep, voffB); PG8_STAGE(PG8_SA(1, 0), a3, voffA);
            PG8_WAIT_V(8); PG8_WAIT_L(0); PG8_BAR; PG8_MMA(1, 0, At, B0); PG8_MMA(1, 1, At, B1); PG8_BAR; PG8_SCHED;
            } else {
            PG8_LDB(B0, 0, 0); PG8_SCHED; PG8_LDA(At, 0, 0); PG8_STAGE(PG8_SA(1, 1), a1 + hstep, voffA);
            PG8_WAIT_L(8); PG8_BAR; PG8_WAIT_L(0); PG8_MMA(0, 0, At, B0); PG8_BAR; PG8_SCHED;
            PG8_LDB(B1, 0, 1); PG8_STAGE(PG8_SB(0, 0), b2, voffB);
            PG8_BAR; PG8_WAIT_L(0); PG8_MMA(0, 1, At, B1); PG8_BAR;
            PG8_LDA(At, 0, 1); PG8_STAGE(PG8_SA(0, 0), a2, voffA);
            PG8_BAR; PG8_WAIT_L(0); PG8_MMA(1, 0, At, B0); PG8_BAR; PG8_SCHED;
            PG8_STAGE(PG8_SB(0, 1), b2 + hstep, voffB);
            PG8_WAIT_V(6); PG8_BAR; PG8_MMA(1, 1, At, B1); PG8_BAR;
            PG8_LDB(B0, 1, 0); PG8_SCHED; PG8_LDA(At, 1, 0); PG8_STAGE(PG8_SA(0, 1), a2 + hstep, voffA);
            PG8_WAIT_L(8); PG8_BAR; PG8_WAIT_L(0); PG8_MMA(0, 0, At, B0); PG8_BAR; PG8_SCHED;
            PG8_LDB(B1, 1, 1); PG8_STAGE(PG8_SB(1, 0), b3, voffB);
            PG8_BAR; PG8_WAIT_L(0); PG8_MMA(0, 1, At, B1); PG8_BAR;
            PG8_LDA(At, 1, 1); PG8_STAGE(PG8_SA(1, 0), a3, voffA);
            PG8_BAR; PG8_WAIT_L(0); PG8_MMA(1, 0, At, B0); PG8_BAR; PG8_SCHED;
            PG8_STAGE(PG8_SB(1, 1), b3 + hstep, voffB);
            PG8_WAIT_V(6); PG8_BAR; PG8_MMA(1, 1, At, B1); PG8_BAR;
            }
        }
        if constexpr (ALIGN_EPI) { if (wr == 0) PG8_BAR; }
        if constexpr (!Epi::AFTER_DRAIN) { E(acc, cur, wr, wc, fr, fq); S.done(cur); }
        if (!has_next) break;
#pragma unroll
        for (int a = 0; a < 2; ++a)
#pragma unroll
            for (int b = 0; b < 2; ++b)
#pragma unroll
                for (int m = 0; m < 4; ++m)
#pragma unroll
                    for (int n = 0; n < 2; ++n) acc[a][b][m][n] = (f32x4){0.f, 0.f, 0.f, 0.f};
        cur = nxt; cA = nA; cB = nB; ++ui;
        if constexpr (ALIGN_EPI) { if (wr == 1) PG8_BAR; }
    }
    PG8_WAIT_V(0);
    if constexpr (!ALIGN_EPI) { if (wr == 0) PG8_BAR; }
    PG8_BAR;
    if constexpr (Epi::AFTER_DRAIN) { E.fused(acc, cur, wr, wc, fr, fq, lds, wid, lane); S.done(cur); }
#undef PG8_SA
#undef PG8_SB
#undef PG8_STAGE
#undef PG8_LDA
#undef PG8_LDB
#undef PG8_MMA
#undef PG8_WAIT_V
#undef PG8_WAIT_L
#undef PG8_BAR
#undef PG8_SCHED
}
}
namespace pg8 {
template <class Epi, class Sched, bool ALIGN_EPI, bool GATHER, bool KSPLIT>
__device__ __forceinline__ void gemm_phase2(PG8_LAS unsigned char* lds, const int K, const int ldb, const Sched& S, const Epi& E, const int tid) {
    typedef typename Sched::UnitT UnitT;
    const int wid = __builtin_amdgcn_readfirstlane(tid >> 6), lane = tid & 63, wr = wid >> 2, wc = wid & 3, fr = lane & 15, fq = lane >> 4;
    const int nt = K / BK, nth = nt / 2;
    int R[2], C[2]; unsigned voffB[2];
#pragma unroll
    for (int i = 0; i < 2; ++i) { stage_rc(tid * 16 + i * 8192, R[i], C[i]); const int Rb = Epi::PERM ? ((R[i] & ~31) + perm32(R[i] & 31)) : R[i]; voffB[i] = (unsigned)(Rb * ldb + C[i]) * 2u; }
    const size_t kstep = (size_t)(BK * 2);
    const size_t hstepB = (size_t)HALF * ldb * 2;
    const unsigned ldsw = (unsigned)wid * 1024u;
    const int aoff = lds_byte(wr * 64 + fr, fq * 8), boff = lds_byte(wc * 32 + fr, fq * 8);
#define PG8_SA(b, h) (((b) * 2 + (h)) * HTB)
#define PG8_SB(b, h) ((4 + (b) * 2 + (h)) * HTB)
#define PG8_STAGE(bufoff, gbase, voff) do { _Pragma("unroll") for (int _i = 0; _i < 2; ++_i) \
        __builtin_amdgcn_global_load_lds((const unsigned*)((const char*)(gbase) + (voff)[_i]), (PG8_LAS unsigned*)(lds + (bufoff) + ldsw + _i * 8192), 16, 0, 0); } while (0)
#define PG8_LDA(dst, b, h) do { _Pragma("unroll") for (int m = 0; m < 4; ++m) _Pragma("unroll") for (int k = 0; k < 2; ++k) dst[m][k] = *(const PG8_LAS bf16x8*)(lds + PG8_SA(b, h) + aoff + m * 2048 + k * 1024); } while (0)
#define PG8_LDB(dst, b, h) do { _Pragma("unroll") for (int n = 0; n < 2; ++n) _Pragma("unroll") for (int k = 0; k < 2; ++k) dst[n][k] = *(const PG8_LAS bf16x8*)(lds + PG8_SB(b, h) + boff + n * 2048 + k * 1024); } while (0)
#define PG8_MMA(ai, bj, At, Bt) do { __builtin_amdgcn_s_setprio(1); _Pragma("unroll") for (int m = 0; m < 4; ++m) _Pragma("unroll") for (int n = 0; n < 2; ++n) _Pragma("unroll") for (int k = 0; k < 2; ++k) \
        acc[ai][bj][m][n] = __builtin_amdgcn_mfma_f32_16x16x32_bf16(Bt[n][k], At[m][k], acc[ai][bj][m][n], 0, 0, 0); __builtin_amdgcn_s_setprio(0); } while (0)
#define PG8_WAIT_V(n) asm volatile("s_waitcnt vmcnt(" #n ")" ::: "memory")
#define PG8_WAIT_L(n) asm volatile("s_waitcnt lgkmcnt(" #n ")" ::: "memory")
#define PG8_BAR __builtin_amdgcn_s_barrier()
#define PG8_SCHED __builtin_amdgcn_sched_barrier(0)
#define PG8_BK(cb, cb2, kt) ((KSPLIT && (kt) >= nth) ? (cb2) + (size_t)((kt) - nth) * kstep : (cb) + (size_t)(kt) * kstep)
    UnitT cur, nxt; int ui = 0;
    if (!S.next(0, cur)) return;
    f32x4 acc[2][2][4][2];
#pragma unroll
    for (int a = 0; a < 2; ++a)
#pragma unroll
        for (int b = 0; b < 2; ++b)
#pragma unroll
            for (int m = 0; m < 4; ++m)
#pragma unroll
                for (int n = 0; n < 2; ++n) acc[a][b][m][n] = (f32x4){0.f, 0.f, 0.f, 0.f};
    bf16x8 At[4][2], B0[2][2], B1[2][2];
    unsigned vA[2][2], vAn[2][2];
    S.arows(cur, R, C, vA);
#pragma unroll
    for (int h = 0; h < 2; ++h)
#pragma unroll
        for (int i = 0; i < 2; ++i) vAn[h][i] = vA[h][i];
    const char* cA = S.aptr(cur); const char* cB = S.bptr(cur); const char* cB2 = KSPLIT ? S.bptr2(cur) : cB;
    PG8_STAGE(PG8_SB(0, 0), cB, voffB); PG8_STAGE(PG8_SB(0, 1), cB + hstepB, voffB); PG8_STAGE(PG8_SA(0, 0), cA, vA[0]); PG8_STAGE(PG8_SA(0, 1), cA, vA[1]);
    if (wr == 1) PG8_BAR;
    PG8_WAIT_V(2); PG8_BAR;
    PG8_STAGE(PG8_SB(1, 0), PG8_BK(cB, cB2, 1), voffB); PG8_STAGE(PG8_SA(1, 0), cA + kstep, vA[0]); PG8_STAGE(PG8_SB(1, 1), PG8_BK(cB, cB2, 1) + hstepB, voffB);
    PG8_WAIT_V(6); PG8_BAR;
    for (;;) {
        const bool has_next = S.next(ui + 1, nxt);
        const char* nA = has_next ? S.aptr(nxt) : cA; const char* nB = has_next ? S.bptr(nxt) : cB; const char* nB2 = (KSPLIT && has_next) ? S.bptr2(nxt) : cB2;
        if (GATHER && has_next) S.arows(nxt, R, C, vAn);
        for (int t = 0; t < nt; t += 2) {
            const bool last = (t == nt - 2);
            const char* a1 = cA + (size_t)(t + 1) * kstep;
            const char* a2 = last ? nA : cA + (size_t)(t + 2) * kstep;
            const char* b2 = last ? nB : PG8_BK(cB, cB2, t + 2);
            const char* b3 = last ? (KSPLIT ? PG8_BK(nB, nB2, 1) : nB + kstep) : PG8_BK(cB, cB2, t + 3);
            const char* a3 = a2 + kstep;
            PG8_LDB(B0, 0, 0); PG8_LDB(B1, 0, 1); PG8_SCHED; PG8_LDA(At, 0, 0); PG8_STAGE(PG8_SA(1, 1), a1, vA[1]);
            PG8_WAIT_V(8); PG8_WAIT_L(0); PG8_BAR; PG8_MMA(0, 0, At, B0); PG8_MMA(0, 1, At, B1); PG8_BAR; PG8_SCHED;
            if (GATHER && last) {
#pragma unroll
                for (int h = 0; h < 2; ++h)
#pragma unroll
                    for (int i = 0; i < 2; ++i) vA[h][i] = vAn[h][i]; }
            PG8_LDA(At, 0, 1); PG8_STAGE(PG8_SB(0, 0), b2, voffB); PG8_STAGE(PG8_SB(0, 1), b2 + hstepB, voffB); PG8_STAGE(PG8_SA(0, 0), a2, vA[0]);
            PG8_WAIT_V(8); PG8_WAIT_L(0); PG8_BAR; PG8_MMA(1, 0, At, B0); PG8_MMA(1, 1, At, B1); PG8_BAR; PG8_SCHED;
            PG8_LDB(B0, 1, 0); PG8_LDB(B1, 1, 1); PG8_SCHED; PG8_LDA(At, 1, 0); PG8_STAGE(PG8_SA(0, 1), a2, vA[1]);
            PG8_WAIT_V(8); PG8_WAIT_L(0); PG8_BAR; PG8_MMA(0, 0, At, B0); PG8_MMA(0, 1, At, B1); PG8_BAR; PG8_SCHED;
            PG8_LDA(At, 1, 1); PG8_STAGE(PG8_SB(1, 0), b3, voffB); PG8_STAGE(PG8_SB(1, 1), b3 + hstepB, voffB); PG8_STAGE(PG8_SA(1, 0), a3, vA[0]);
            PG8_WAIT_V(8); PG8_WAIT_L(0); PG8_BAR; PG8_MMA(1, 0, At, B0); PG8_MMA(1, 1, At, B1); PG8_BAR; PG8_SCHED;
        }
        if constexpr (ALIGN_EPI) { if (wr == 0) PG8_BAR; }
        if constexpr (!Epi::AFTER_DRAIN) { E(acc, cur, wr, wc, fr, fq); }
        if (!has_next) break;
#pragma unroll
        for (int a = 0; a < 2; ++a)
#pragma unroll
            for (int b = 0; b < 2; ++b)
#pragma unroll
                for (int m = 0; m < 4; ++m)
#pragma unroll
                    for (int n = 0; n < 2; ++n) acc[a][b][m][n] = (f32x4){0.f, 0.f, 0.f, 0.f};
        cur = nxt; cA = nA; cB = nB; cB2 = nB2; ++ui;
        if constexpr (ALIGN_EPI) { if (wr == 1) PG8_BAR; }
    }
    PG8_WAIT_V(0);
    if constexpr (!ALIGN_EPI) { if (wr == 0) PG8_BAR; }
    PG8_BAR;
    if constexpr (Epi::AFTER_DRAIN) { E.fused(acc, cur, wr, wc, fr, fq, lds, wid, lane); }
#undef PG8_SA
#undef PG8_SB
#undef PG8_STAGE
#undef PG8_LDA
#undef PG8_LDB
#undef PG8_MMA
#undef PG8_WAIT_V
#undef PG8_WAIT_L
#undef PG8_BAR
#undef PG8_SCHED
#undef PG8_BK
}
}
namespace pg8 {
DEVFN unsigned pkbf(float lo, float hi) { return cvt_pk_bf16(lo, hi); }
struct DenseSched {
    typedef Unit UnitT;
    StaticOrder so; const char* A; const char* Bt; int lda, ldb;
    DEVFN bool next(int i, Unit& u) const { return so.next(i, u); }
    DEVFN const char* aptr(const Unit& u) const { return A + (size_t)u.pm * BM * lda * 2; }
    DEVFN void arows(const Unit&, const int (&R)[2], const int (&C)[2], unsigned (&v)[2][2]) const {
#pragma unroll
        for (int h = 0; h < 2; ++h)
#pragma unroll
            for (int i = 0; i < 2; ++i) v[h][i] = (unsigned)((h * HALF + R[i]) * lda + C[i]) * 2u; }
    DEVFN const char* bptr(const Unit& u) const { return Bt + (size_t)u.pn * BM * ldb * 2; }
    DEVFN const char* bptr2(const Unit& u) const { return bptr(u); }
};
struct EpiInproj {
    static constexpr bool PERM = true, AFTER_DRAIN = false;
    bf16_t* O; const float* rope; float* kbar;
    DEVFN void operator()(f32x4 (&acc)[2][2][4][2], const Unit& u, int wr, int wc, int fr, int fq) const {
        const int pn = u.pn, row0 = u.pm * BM + wr * 64 + fr;
        if (pn < 4 && fq == 0) {
#pragma unroll
            for (int ai = 0; ai < 2; ++ai)
#pragma unroll
                for (int m = 0; m < 4; ++m) { const int t = (row0 + ai * HALF + m * 16) & (SEQ - 1); const f32x4* rp = (const f32x4*)(rope + t * 16);
#pragma unroll
                    for (int q = 0; q < 4; ++q) { const f32x4 cs = rp[q];
                        { const int d = 2 * q, n = d >> 2, e = d & 3; const float x1 = acc[ai][0][m][n][e], x2 = acc[ai][1][m][n][e]; acc[ai][0][m][n][e] = x1 * cs[0] - x2 * cs[1]; acc[ai][1][m][n][e] = x2 * cs[0] + x1 * cs[1]; }
                        { const int d = 2 * q + 1, n = d >> 2, e = d & 3; const float x1 = acc[ai][0][m][n][e], x2 = acc[ai][1][m][n][e]; acc[ai][0][m][n][e] = x1 * cs[2] - x2 * cs[3]; acc[ai][1][m][n][e] = x2 * cs[2] + x1 * cs[3]; } } }
        }
        if (pn == 2 || pn == 3) {
            float* kb = kbar + (size_t)((((u.pm >> 3) * NH + (pn - 2) * 4 + wc) * NBLK + (u.pm & 7)) * HD);
#pragma unroll
            for (int bj = 0; bj < 2; ++bj)
#pragma unroll
                for (int n = 0; n < 2; ++n)
#pragma unroll
                    for (int e = 0; e < 4; ++e) { float s = 0.f;
#pragma unroll
                        for (int ai = 0; ai < 2; ++ai)
#pragma unroll
                            for (int m = 0; m < 4; ++m) s += acc[ai][bj][m][n][e];
                        s = swz_xor_add(s, 1); s = swz_xor_add(s, 2); s = swz_xor_add(s, 4); s = swz_xor_add(s, 8);
                        if (fr == 0) atomicAdd(kb + (2 * fq + bj) * 8 + 4 * n + e, s * (1.f / MBLK)); }
        }
        const float sc = pn < 2 ? QSCALE : 1.f;
#pragma unroll
        for (int ai = 0; ai < 2; ++ai)
#pragma unroll
            for (int m = 0; m < 4; ++m) { bf16_t* rowp = O + (size_t)(row0 + ai * HALF + m * 16) * DIN + pn * BM + wc * 64;
#pragma unroll
                for (int bj = 0; bj < 2; ++bj) { const f32x4 v0 = acc[ai][bj][m][0] * sc, v1 = acc[ai][bj][m][1] * sc;
                    u32x4 w; w.x = pkbf(v0[0], v0[1]); w.y = pkbf(v0[2], v0[3]); w.z = pkbf(v1[0], v1[1]); w.w = pkbf(v1[2], v1[3]);
                    *(u32x4*)(rowp + (2 * fq + bj) * 8) = w; } }
    }
};
struct MoeUnit { int pm, pn, cls, j, cnt; };
struct MoeBase {
    const PG8_LAS int* tp; const PG8_LAS int* cnt; int nunits, G, c, npn_shift;
    DEVFN bool next_(int i, MoeUnit& u) const {
        const int L = i * G + c; if (L >= nunits) return false;
        u.pm = L >> npn_shift; u.pn = L & ((1 << npn_shift) - 1);
        int cls = 0; while (u.pm >= tp[cls + 1]) ++cls;
        u.cls = cls; u.j = u.pm - tp[cls]; u.cnt = cnt[cls]; return true; }
};
DEVFN void moe_experts(int cls, int& e1, int& e2) { const int g = cls / 6, p = cls % 6; const int lo = p < 3 ? 0 : (p < 5 ? 1 : 2), hi = p < 3 ? p + 1 : (p < 5 ? p - 1 : 3); e1 = g * 4 + lo; e2 = g * 4 + hi; }
struct GateUpSched : MoeBase {
    typedef MoeUnit UnitT;
    const char* HB; const int* list; const char* W;
    DEVFN bool next(int i, MoeUnit& u) const { return next_(i, u); }
    DEVFN const char* aptr(const MoeUnit&) const { return HB; }
    DEVFN void arows(const MoeUnit& u, const int (&R)[2], const int (&C)[2], unsigned (&v)[2][2]) const {
#pragma unroll
        for (int h = 0; h < 2; ++h)
#pragma unroll
            for (int i = 0; i < 2; ++i) { const int li = 256 * u.j + h * HALF + R[i]; const int tok = list[(size_t)u.cls * LISTCAP + (li < u.cnt ? li : 256 * u.j)]; v[h][i] = (unsigned)(tok * DM + C[i]) * 2u; } }
    DEVFN const char* bptr(const MoeUnit& u) const { int e1, e2; moe_experts(u.cls, e1, e2); return W + (size_t)(u.pn < 4 ? e1 : e2) * DM * DM * 2 + (size_t)(u.pn & 3) * BM * DM * 2; }
    DEVFN const char* bptr2(const MoeUnit& u) const { return bptr(u); }
};
struct DownSched : MoeBase {
    typedef MoeUnit UnitT;
    const char* ACT; const char* W;
    DEVFN bool next(int i, MoeUnit& u) const { return next_(i, u); }
    DEVFN const char* aptr(const MoeUnit& u) const { return ACT + (size_t)u.pm * BM * DM * 2; }
    DEVFN void arows(const MoeUnit&, const int (&R)[2], const int (&C)[2], unsigned (&v)[2][2]) const {
#pragma unroll
        for (int h = 0; h < 2; ++h)
#pragma unroll
            for (int i = 0; i < 2; ++i) v[h][i] = (unsigned)((h * HALF + R[i]) * DM + C[i]) * 2u; }
    DEVFN const char* bptr(const MoeUnit& u) const { int e1, e2; moe_experts(u.cls, e1, e2); return W + (size_t)e1 * DM * DE * 2 + (size_t)u.pn * BM * DE * 2; }
    DEVFN const char* bptr2(const MoeUnit& u) const { int e1, e2; moe_experts(u.cls, e1, e2); return W + (size_t)e2 * DM * DE * 2 + (size_t)u.pn * BM * DE * 2; }
};
struct EpiGateUp {
    static constexpr bool PERM = true, AFTER_DRAIN = false;
    bf16_t* ACT; const float* rw;
    DEVFN void operator()(f32x4 (&acc)[2][2][4][2], const MoeUnit& u, int wr, int wc, int fr, int fq) const {
        const int half = u.pn >> 2, jt = u.pn & 3;
#pragma unroll
        for (int ai = 0; ai < 2; ++ai)
#pragma unroll
            for (int m = 0; m < 4; ++m) { const int lr = ai * HALF + wr * 64 + m * 16 + fr, li = 256 * u.j + lr;
                const float wgt = li < u.cnt ? rw[((size_t)u.cls * LISTCAP + li) * 2 + half] : 0.f;
                f32x4 o[2];
#pragma unroll
                for (int n = 0; n < 2; ++n)
#pragma unroll
                    for (int e = 0; e < 4; ++e) { const float g = acc[ai][0][m][n][e]; o[n][e] = g * __builtin_amdgcn_rcpf(1.f + __expf(-g)) * acc[ai][1][m][n][e] * wgt; }
                u32x4 w; w.x = pkbf(o[0][0], o[0][1]); w.y = pkbf(o[0][2], o[0][3]); w.z = pkbf(o[1][0], o[1][1]); w.w = pkbf(o[1][2], o[1][3]);
                *(u32x4*)(ACT + (size_t)(u.pm * BM + lr) * DM + half * 512 + jt * 128 + wc * 32 + fq * 8) = w; }
    }
};
struct EpiDown {
    static constexpr bool PERM = true, AFTER_DRAIN = false;
    bf16_t* Y2; const int* list;
    DEVFN void operator()(f32x4 (&acc)[2][2][4][2], const MoeUnit& u, int wr, int wc, int fr, int fq) const {
#pragma unroll
        for (int ai = 0; ai < 2; ++ai)
#pragma unroll
            for (int m = 0; m < 4; ++m) { const int li = 256 * u.j + ai * HALF + wr * 64 + m * 16 + fr;
                if (li < u.cnt) { const int tok = list[(size_t)u.cls * LISTCAP + li]; bf16_t* rowp = Y2 + (size_t)tok * DM + u.pn * BM + wc * 32 + fq * 8;
#pragma unroll
                    for (int bj = 0; bj < 2; ++bj) { const f32x4 v0 = acc[ai][bj][m][0], v1 = acc[ai][bj][m][1];
                        u32x4 w; w.x = pkbf(v0[0], v0[1]); w.y = pkbf(v0[2], v0[3]); w.z = pkbf(v1[0], v1[1]); w.w = pkbf(v1[2], v1[3]);
                        *(u32x4*)(rowp + bj * HALF) = w; } } }
    }
};
}

#include <hip/hip_bf16.h>
#include <cmath>
namespace attn_body {
using bf16=__hip_bfloat16;
using bf16x8=__attribute__((ext_vector_type(8)))short;
using s16x4=__attribute__((ext_vector_type(4)))short;
using f32x16=__attribute__((ext_vector_type(16)))float;
using u32x4=__attribute__((ext_vector_type(4)))unsigned;
constexpr int BATCH=16,NHEAD=8,SEQ=2048,D=64,QP=2048,OP=1024;
constexpr int NW=8,QBLK=32,QB=QBLK*NW,KVBLK=64,NQB=SEQ/QB;
constexpr int ATTN_PITCH=QP, ATTN_UNIT_ROWS=QB;
__device__ __forceinline__ int crow(int r,int hi){return (r&3)+8*(r>>2)+4*hi;}
#define SBAR() __builtin_amdgcn_sched_barrier(0)
__device__ __forceinline__ void cmask(f32x16&p0,f32x16&p1,int jb,int qrel,int hi){
  const float NEG=-INFINITY; int kb=64*jb+4*hi;
  #pragma unroll
  for(int r=0;r<16;++r){int kv=kb+(r&3)+8*(r>>2); if(kv>qrel)p0[r]=NEG; if(kv+32>qrel)p1[r]=NEG;}
}

constexpr int NSLOT=3, SLOTB=8192;
constexpr int LDS_K=0, LDS_V=NSLOT*SLOTB, LDS_WS=2*NSLOT*SLOTB, LDS_OST=LDS_WS+NW*64*4, LDS_KBAR=LDS_OST+NW*4096, LDS_BYTES=LDS_KBAR+2048;
constexpr float NEGBIG=-1.0e30f; typedef float f32x4_t __attribute__((ext_vector_type(4)));
__device__ __forceinline__ float bfs(short v){return __uint_as_float(((unsigned)(unsigned short)v)<<16);}
constexpr float C2=0.125f*1.4426950408889634f;
__device__ __forceinline__ void glds16(const void*gsrc,unsigned lds_dst){unsigned keep;
  asm volatile("s_mov_b32 %0, m0\n\ts_mov_b32 m0, %2\n\ts_nop 0\n\tglobal_load_lds_dwordx4 %1, off\n\ts_mov_b32 m0, %0":"=&s"(keep):"v"(gsrc),"s"(lds_dst):"memory");}
__device__ __forceinline__ float max3f(float a,float b,float c){float r;asm("v_max3_f32 %0, %1, %2, %3":"=v"(r):"v"(a),"v"(b),"v"(c));return r;}
__device__ __forceinline__ float max2f(float a,float b){float r;asm("v_max_f32_e32 %0, %1, %2":"=v"(r):"v"(a),"v"(b));return r;}
__device__ __forceinline__ float fadd_s(float a,float b){float r;asm("v_add_f32_e32 %0, %1, %2":"=v"(r):"v"(a),"v"(b));return r;}
__device__ __forceinline__ float fsub_s(float a,float b){float r;asm("v_sub_f32_e32 %0, %1, %2":"=v"(r):"v"(a),"v"(b));return r;}
typedef float f32x2_t __attribute__((ext_vector_type(2))); typedef __bf16 bf16x2_t __attribute__((ext_vector_type(2)));
__device__ __forceinline__ unsigned cvtpk_s(float lo,float hi){f32x2_t v={lo,hi};bf16x2_t b=__builtin_convertvector(v,bf16x2_t);return __builtin_bit_cast(unsigned,b);}
#define WAIT_BAR(N) asm volatile("s_waitcnt vmcnt(" #N ") lgkmcnt(0)\n\ts_barrier":::"memory")

__device__ __forceinline__ void qkt(f32x16&p0,f32x16&p1,const char*Kslot,const bf16x8*qr,const f32x16&negm,int r32,int hi){
  const char*kb=Kslot+hi*1024+r32*16;
  #pragma unroll
  for(int d0=0;d0<4;++d0){
    const bf16x8 b0=*reinterpret_cast<const bf16x8*>(kb+d0*2048);
    const bf16x8 b1=*reinterpret_cast<const bf16x8*>(kb+d0*2048+512);
    if(d0==0){p0=__builtin_amdgcn_mfma_f32_32x32x16_bf16(b0,qr[0],negm,0,0,0);p1=__builtin_amdgcn_mfma_f32_32x32x16_bf16(b1,qr[0],negm,0,0,0);}
    else{p0=__builtin_amdgcn_mfma_f32_32x32x16_bf16(b0,qr[d0],p0,0,0,0);p1=__builtin_amdgcn_mfma_f32_32x32x16_bf16(b1,qr[d0],p1,0,0,0);}}
}
typedef __attribute__((address_space(3))) const char* lds_cptr;
typedef short v4i16_t __attribute__((ext_vector_type(4)));
__device__ __forceinline__ void kload8(bf16x8*kf,lds_cptr kp){
  kf[0]=*(const __attribute__((address_space(3))) bf16x8*)(kp);      kf[1]=*(const __attribute__((address_space(3))) bf16x8*)(kp+512);
  kf[2]=*(const __attribute__((address_space(3))) bf16x8*)(kp+2048); kf[3]=*(const __attribute__((address_space(3))) bf16x8*)(kp+2560);
  kf[4]=*(const __attribute__((address_space(3))) bf16x8*)(kp+4096); kf[5]=*(const __attribute__((address_space(3))) bf16x8*)(kp+4608);
  kf[6]=*(const __attribute__((address_space(3))) bf16x8*)(kp+6144); kf[7]=*(const __attribute__((address_space(3))) bf16x8*)(kp+6656);
}
__device__ __forceinline__ void kload2(bf16x8*kf,lds_cptr kp,int j){ kf[2*j]=*(const __attribute__((address_space(3))) bf16x8*)(kp+j*2048); kf[2*j+1]=*(const __attribute__((address_space(3))) bf16x8*)(kp+j*2048+512); }
__device__ __forceinline__ s16x4 vtr(lds_cptr p){ return __builtin_bit_cast(s16x4,__builtin_amdgcn_ds_read_tr16_b64_v4i16((__attribute__((address_space(3))) v4i16_t*)p)); }
__device__ __forceinline__ float rowmax(const f32x16&p0,const f32x16&p1){
  float a=max3f(p0[0],p0[1],p1[0]),b=max3f(p0[2],p0[3],p1[1]);a=max3f(a,p1[2],p1[3]);
  #pragma unroll
  for(int r=4;r<16;r+=4){a=max3f(a,p0[r],p0[r+1]);b=max3f(b,p0[r+2],p0[r+3]);a=max3f(a,p1[r],p1[r+1]);b=max3f(b,p1[r+2],p1[r+3]);}
  const float m=max2f(a,b);
  auto rr=__builtin_amdgcn_permlane32_swap(__float_as_uint(m),__float_as_uint(m),false,false);
  return max2f(__uint_as_float(rr[0]),__uint_as_float(rr[1]));
}
__device__ __forceinline__ void pv(f32x16*o,int vb,bf16x8 pa0,bf16x8 pa1,bf16x8 pa2,bf16x8 pa3){
  #pragma unroll
  for(int d0=0;d0<2;++d0){s16x4 lo[4],hi[4];
    #pragma unroll
    for(int ks=0;ks<4;++ks){
      asm volatile("ds_read_b64_tr_b16 %0,%1 offset:%c2":"=&v"(lo[ks]):"v"(vb),"i"(d0*4096+ks*1024):"memory");
      asm volatile("ds_read_b64_tr_b16 %0,%1 offset:%c2":"=&v"(hi[ks]):"v"(vb),"i"(d0*4096+ks*1024+512):"memory");}
    asm volatile("s_waitcnt lgkmcnt(0)":::"memory");SBAR();
    #define PK(k) (bf16x8){lo[k][0],lo[k][1],lo[k][2],lo[k][3],hi[k][0],hi[k][1],hi[k][2],hi[k][3]}
    o[d0]=__builtin_amdgcn_mfma_f32_32x32x16_bf16(pa0,PK(0),o[d0],0,0,0);
    o[d0]=__builtin_amdgcn_mfma_f32_32x32x16_bf16(pa1,PK(1),o[d0],0,0,0);
    o[d0]=__builtin_amdgcn_mfma_f32_32x32x16_bf16(pa2,PK(2),o[d0],0,0,0);
    o[d0]=__builtin_amdgcn_mfma_f32_32x32x16_bf16(pa3,PK(3),o[d0],0,0,0);
    #undef PK
  }
}

#ifndef ATTN_STORE16
#define ATTN_STORE16(p,v) (*(u32x4*)(p)=(v))
#endif
template<int THRL> __device__ __forceinline__ void attn_unit(int b,int h,int qb,const bf16*Q,const bf16*__restrict__ K,const bf16*__restrict__ V,bf16*O,const float*__restrict__ kbar,char*shm,const int tid){
  const int lane=tid&63,r32=lane&31,hi=lane>>5; const int wid=__builtin_amdgcn_readfirstlane(tid>>6);
  float kbv=0.f; { int tk=tid; asm volatile("":"+v"(tk)); if(qb>=4&&tk<448)kbv=kbar[tk]; }
  const long rowbase=(long)b*SEQ; const int q0=qb*QB;
  const bf16*Qw=Q+(rowbase+q0+wid*QBLK)*QP+h*D;
  const bf16*Kh=K+rowbase*QP+h*D,*Vh=V+rowbase*QP+h*D;
  const unsigned lds0=(unsigned)(uintptr_t)shm;
  float*wsf=(float*)(shm+LDS_WS)+wid*64;
  const bf16*ksrc=Kh+(long)lane*QP+wid*8;
  const bf16*vsrc=Vh+(long)(16*(wid&3)+(lane>>2))*QP+(wid>>2)*32+(lane&3)*8;
  const unsigned kdst=lds0+LDS_K+wid*1024, vdst=lds0+LDS_V+wid*1024;
  #define DMA_K(t,slot) glds16(ksrc+(long)(t)*KVBLK*QP,(unsigned)__builtin_amdgcn_readfirstlane(kdst+(slot)))
  #define DMA_V(t,slot) glds16(vsrc+(long)(t)*KVBLK*QP,(unsigned)__builtin_amdgcn_readfirstlane(vdst+(slot)))
  const int vb0=(int)(lds0+LDS_V)+((lane>>4)&1)*32+(lane&3)*8+(4*hi+((lane&15)>>2))*64;
  const char*Kbase=shm+LDS_K; bf16x8 kf[8];
  const lds_cptr shm3=(lds_cptr)shm; const lds_cptr kp0=shm3+LDS_K+hi*1024+r32*16; const lds_cptr vp0=shm3+LDS_V+((lane>>4)&1)*32+(lane&3)*8+(4*hi+((lane&15)>>2))*64;
  const int NT=(q0+QB)/KVBLK;
  DMA_K(0,0);DMA_V(0,0);DMA_K(1,SLOTB);
  bf16x8 qr[4];
  #pragma unroll
  for(int d0=0;d0<4;++d0)qr[d0]=*reinterpret_cast<const bf16x8*>(&Qw[(long)r32*QP+d0*16+hi*8]);
  float mhat=0.f,l_reg=0.f;f32x16 o[2];o[0]=f32x16{};o[1]=f32x16{};f32x16 negm=f32x16{};asm volatile("":"+v"(negm));
  const int qrel=wid*QBLK+r32;
  #define CMASK(P0,P1,t) do{int jb_=(t)-(NT-4); if(jb_>=0)cmask(P0,P1,jb_,qrel,hi);}while(0)
  bool resc=false;
  #define START(P0,P1) do{ const float rm=rowmax(P0,P1); resc=false; \
    { const float dl=selcur?rm:-64.f; mhat=fadd_s(mhat,dl); \
      _Pragma("unroll") for(int r=0;r<16;++r){P0[r]=fsub_s(P0[r],dl);P1[r]=fsub_s(P1[r],dl);} \
      { const float nv_=selcur?-mhat:NEGBIG; _Pragma("unroll") for(int r=0;r<16;++r)negm[r]=nv_; } asm volatile("":"+v"(negm)); } \
    _Pragma("unroll") for(int r=0;r<16;++r)P0[r]=__builtin_amdgcn_exp2f(P0[r]); }while(0)
  #define RESC() do{ if(resc){ asm volatile("s_waitcnt lgkmcnt(0)":::"memory"); \
      _Pragma("unroll") for(int d_=0;d_<2;++d_) _Pragma("unroll") for(int r=0;r<16;++r)o[d_][r]*=wsf[crow(r,hi)]; } }while(0)
  f32x16 pA0,pA1,pB0,pB1;
  int sl_prev=0,sl_cur=0,sl_next=SLOTB;
  #define ROT() do{sl_prev=sl_cur;sl_cur=sl_next;sl_next=(sl_next==(NSLOT-1)*SLOTB)?0:sl_next+SLOTB;}while(0)
  DMA_K(2,2*SLOTB);
  if(qb>=4){ if(tid<448){ const unsigned hb=__builtin_bit_cast(unsigned,kbv); const unsigned hr=(hb+0x7fffu+((hb>>16)&1u))&0xffff0000u; const float lo_=kbv-__builtin_bit_cast(float,hr); const unsigned lb=__builtin_bit_cast(unsigned,lo_);
      ((unsigned short*)(shm+LDS_KBAR))[tid]=(unsigned short)(hr>>16); ((unsigned short*)(shm+LDS_KBAR+1024))[tid]=(unsigned short)((lb+0x7fffu+((lb>>16)&1u))>>16); } }
  WAIT_BAR(3);
  unsigned bmask=(1u<<(qb+1))-1u;
  if(qb>=4){ float gsc[8];
    { const lds_cptr kb3=shm3+LDS_KBAR+(r32&7)*128+hi*16; f32x16 g=f32x16{};
      _Pragma("unroll") for(int d0=0;d0<4;++d0){ const bf16x8 ah=*(const __attribute__((address_space(3))) bf16x8*)(kb3+d0*32), al=*(const __attribute__((address_space(3))) bf16x8*)(kb3+1024+d0*32);
        g=__builtin_amdgcn_mfma_f32_32x32x16_bf16(ah,qr[d0],g,0,0,0); g=__builtin_amdgcn_mfma_f32_32x32x16_bf16(al,qr[d0],g,0,0,0); }
      _Pragma("unroll") for(int r=0;r<4;++r){ auto rr=__builtin_amdgcn_permlane32_swap(__float_as_uint(g[r]),__float_as_uint(g[r]),false,false); gsc[r]=__uint_as_float(rr[0]); gsc[4+r]=__uint_as_float(rr[1]); } }
    _Pragma("unroll") for(int n=0;n<7;++n) gsc[n]=(n<qb)?gsc[n]:-3.0e38f;
    bmask=1u<<qb;
    _Pragma("unroll") for(int pick=0;pick<3;++pick){ float best=-3.4e38f; unsigned bi=0u;
      _Pragma("unroll") for(int n=0;n<7;++n){ const bool ok=!((bmask>>n)&1u)&&gsc[n]>best; best=ok?gsc[n]:best; bi=ok?(unsigned)n:bi; }
      bmask|=1u<<bi; } }
  bool selcur=(bmask&1u)!=0u;
  { const float nv=selcur?0.f:NEGBIG; _Pragma("unroll") for(int r=0;r<16;++r)negm[r]=nv; asm volatile("":"+v"(negm)); }
  qkt(pA0,pA1,Kbase,qr,negm,r32,hi);asm volatile("s_nop 15\n\ts_nop 7":"+v"(pA0),"+v"(pA1));CMASK(pA0,pA1,0);
  START(pA0,pA1);
  _Pragma("unroll") for(int r=0;r<16;++r)pA1[r]=__builtin_amdgcn_exp2f(pA1[r]);
  WAIT_BAR(0);
  DMA_K(3,0);DMA_V(1,SLOTB);
  ROT();
  kload8(kf,kp0+sl_cur);
  WAIT_BAR(2);
  s16x4 vlo[8],vhi[8]; u32x4 pw0,pw1,pw2,pw3;
  #define PKW(P,B) cvtpk_s(P[B],P[B+1])
  #define PAF(k) __builtin_bit_cast(bf16x8,pw##k)
  #define VFR(i) (bf16x8){vlo[i][0],vlo[i][1],vlo[i][2],vlo[i][3],vhi[i][0],vhi[i][1],vhi[i][2],vhi[i][3]}
  #define PIN(x) asm volatile("":"+v"(x))
  #define MX3(a,b,c) __builtin_fmaxf(__builtin_fmaxf((a),(b)),(c))
  #define GAPA(MF,A0,A1,A2,A3,W0,W1,PW) do{ MF; sacc+=A0; sacc+=A1; sacc+=A2; sacc+=A3; PIN(sacc); W0; W1; PIN(PW); SBAR(); }while(0)
  #define EX(v) __builtin_amdgcn_exp2f(v)
  #define GAPB(MF,X,B) do{ MF; X[B]=EX(X[B]); X[B+1]=EX(X[B+1]); X[B+2]=EX(X[B+2]); X[B+3]=EX(X[B+3]); PIN(X); SBAR(); }while(0)
  #define VRD(i) do{ vlo[i]=vtr(vp_+(((i)>>2)*4096+((i)&3)*1024)); vhi[i]=vtr(vp_+(((i)>>2)*4096+((i)&3)*1024+512)); }while(0)
  #define KRD(G,j) do{ if(G){ kload2(kf,kp0+sl_next,j); SBAR(); } }while(0)
  #define STEP(C0,C1,P0,P1,t,GK,GV,GL) do{ SBAR(); \
    const lds_cptr vp_=vp0+sl_prev; \
    VRD(0); SBAR(); float sacc=(P0[0]+P0[1]); \
    GAPA(C0=__builtin_amdgcn_mfma_f32_32x32x16_bf16(kf[0],qr[0],negm,0,0,0), P0[2],P0[3],P0[4],P0[5],     pw0[0]=PKW(P0,0), pw0[1]=PKW(P0,2), pw0); \
    VRD(4); SBAR(); GAPA(C1=__builtin_amdgcn_mfma_f32_32x32x16_bf16(kf[1],qr[0],negm,0,0,0), P0[6],P0[7],P0[8],P0[9],     pw0[2]=PKW(P0,4), pw0[3]=PKW(P0,6), pw0); \
    VRD(1); SBAR(); GAPA(C0=__builtin_amdgcn_mfma_f32_32x32x16_bf16(kf[2],qr[1],C0,0,0,0),   P0[10],P0[11],P0[12],P0[13], pw1[0]=PKW(P0,8), pw1[1]=PKW(P0,10), pw1); \
    VRD(5); SBAR(); GAPA(C1=__builtin_amdgcn_mfma_f32_32x32x16_bf16(kf[3],qr[1],C1,0,0,0),   P0[14],P0[15],P1[0],P1[1],   pw1[2]=PKW(P0,12),pw1[3]=PKW(P0,14), pw1); \
    VRD(2); SBAR(); GAPA(C0=__builtin_amdgcn_mfma_f32_32x32x16_bf16(kf[4],qr[2],C0,0,0,0),   P1[2],P1[3],P1[4],P1[5],     pw2[0]=PKW(P1,0), pw2[1]=PKW(P1,2), pw2); \
    VRD(6); SBAR(); GAPA(C1=__builtin_amdgcn_mfma_f32_32x32x16_bf16(kf[5],qr[2],C1,0,0,0),   P1[6],P1[7],P1[8],P1[9],     pw2[2]=PKW(P1,4), pw2[3]=PKW(P1,6), pw2); \
    VRD(3); SBAR(); GAPA(C0=__builtin_amdgcn_mfma_f32_32x32x16_bf16(kf[6],qr[3],C0,0,0,0),   P1[10],P1[11],P1[12],P1[13], pw3[0]=PKW(P1,8), pw3[1]=PKW(P1,10), pw3); \
    VRD(7); SBAR(); GAPA(C1=__builtin_amdgcn_mfma_f32_32x32x16_bf16(kf[7],qr[3],C1,0,0,0),   P1[14],P1[15],0.f,0.f,       pw3[2]=PKW(P1,12),pw3[3]=PKW(P1,14), pw3); \
    l_reg+=sacc; \
    if(GK){DMA_K((t)+3,sl_cur);} if(GV){DMA_V((t)+1,sl_next);} \
    CMASK(C0,C1,t); \
    { float a=MX3(C0[0],C0[1],C1[0]),b=MX3(C0[2],C0[3],C1[1]); a=MX3(a,C1[2],C1[3]); \
      _Pragma("unroll") for(int r=4;r<16;r+=4){a=MX3(a,C0[r],C0[r+1]);b=MX3(b,C0[r+2],C0[r+3]);a=MX3(a,C1[r],C1[r+1]);b=MX3(b,C1[r+2],C1[r+3]);} \
      float rm=__builtin_fmaxf(a,b); { auto rr=__builtin_amdgcn_permlane32_swap(__float_as_uint(rm),__float_as_uint(rm),false,false); rm=__builtin_fmaxf(__uint_as_float(rr[0]),__uint_as_float(rr[1])); } \
      resc=false; \
      if(__builtin_expect(__any(rm>(float)THRL),0)){ const float dl=__builtin_fmaxf(rm,0.f); mhat+=dl; \
        _Pragma("unroll") for(int r=0;r<16;++r){C0[r]-=dl;C1[r]-=dl;} \
        { const float nv_=selcur?-mhat:NEGBIG; _Pragma("unroll") for(int r=0;r<16;++r)negm[r]=nv_; } asm volatile("":"+v"(negm)); \
        const float f=__builtin_amdgcn_exp2f(-dl); l_reg*=f; if(hi==0)wsf[r32]=f; resc=true; } } \
    SBAR(); \
    GAPB(o[0]=__builtin_amdgcn_mfma_f32_32x32x16_bf16(PAF(0),VFR(0),o[0],0,0,0), C0,0); \
    GAPB(o[1]=__builtin_amdgcn_mfma_f32_32x32x16_bf16(PAF(0),VFR(4),o[1],0,0,0), C0,4); \
    KRD(GL,0); GAPB(o[0]=__builtin_amdgcn_mfma_f32_32x32x16_bf16(PAF(1),VFR(1),o[0],0,0,0), C0,8); \
    KRD(GL,1); GAPB(o[1]=__builtin_amdgcn_mfma_f32_32x32x16_bf16(PAF(1),VFR(5),o[1],0,0,0), C0,12); \
    KRD(GL,2); GAPB(o[0]=__builtin_amdgcn_mfma_f32_32x32x16_bf16(PAF(2),VFR(2),o[0],0,0,0), C1,0); \
    KRD(GL,3); GAPB(o[1]=__builtin_amdgcn_mfma_f32_32x32x16_bf16(PAF(2),VFR(6),o[1],0,0,0), C1,4); \
    GAPB(o[0]=__builtin_amdgcn_mfma_f32_32x32x16_bf16(PAF(3),VFR(3),o[0],0,0,0), C1,8); \
    GAPB(o[1]=__builtin_amdgcn_mfma_f32_32x32x16_bf16(PAF(3),VFR(7),o[1],0,0,0), C1,12); \
    }while(0)
  #define BLKSEL(tt) do{ if((((tt))&3)==0){ selcur=((bmask>>((tt)>>2))&1u)!=0u; const float nv_=selcur?-mhat:NEGBIG; _Pragma("unroll") for(int r=0;r<16;++r)negm[r]=nv_; asm volatile("":"+v"(negm)); } }while(0)
  int t=1;
  #undef CMASK
  #define CMASK(P0,P1,t) do{}while(0)
  for(;t+5<NT;t+=2){
    STEP(pB0,pB1,pA0,pA1,t,true,true,true);     WAIT_BAR(2); RESC(); ROT(); BLKSEL(t+1);
    STEP(pA0,pA1,pB0,pB1,t+1,true,true,true);   WAIT_BAR(2); RESC(); ROT();
  }
  #undef CMASK
  #define CMASK(P0,P1,t) do{int jb_=(t)-(NT-4); if(jb_>=0)cmask(P0,P1,jb_,qrel,hi);}while(0)
  #define ENDW(tt) do{ if((tt)+3<NT){WAIT_BAR(2);} else if((tt)+2<NT){WAIT_BAR(1);} else {WAIT_BAR(0);} }while(0)
  for(;t+1<NT;t+=2){
    STEP(pB0,pB1,pA0,pA1,t,(t+3<NT),(t+1<NT),(t+1<NT));       ENDW(t);   RESC(); ROT(); BLKSEL(t+1);
    STEP(pA0,pA1,pB0,pB1,t+1,(t+4<NT),(t+2<NT),(t+2<NT));     ENDW(t+1); RESC(); ROT();
  }
  STEP(pB0,pB1,pA0,pA1,NT-1,false,false,false); RESC();
  { float sacc=pB0[0]+pB0[1]; _Pragma("unroll") for(int r=2;r<16;++r)sacc+=pB0[r]; _Pragma("unroll") for(int r=0;r<16;++r)sacc+=pB1[r]; l_reg+=sacc;
    pw0=(u32x4){PKW(pB0,0),PKW(pB0,2),PKW(pB0,4),PKW(pB0,6)};pw1=(u32x4){PKW(pB0,8),PKW(pB0,10),PKW(pB0,12),PKW(pB0,14)};pw2=(u32x4){PKW(pB1,0),PKW(pB1,2),PKW(pB1,4),PKW(pB1,6)};pw3=(u32x4){PKW(pB1,8),PKW(pB1,10),PKW(pB1,12),PKW(pB1,14)};
    SBAR(); pv(o,vb0+sl_cur,PAF(0),PAF(1),PAF(2),PAF(3)); }
  #undef PKW
  #undef PAF
  #undef VFR
  #undef PIN
  #undef MX3
  #undef GAPA
  #undef GAPB
  #undef EX
  #undef VRD
  #undef KRD
  #undef STEP
  #undef ENDW
  {auto rr=__builtin_amdgcn_permlane32_swap(__float_as_uint(l_reg),__float_as_uint(l_reg),false,false);l_reg=__uint_as_float(rr[0])+__uint_as_float(rr[1]);}
  if(hi==0)wsf[32+r32]=l_reg;asm volatile("s_waitcnt lgkmcnt(0)":::"memory");
  float rli[16];
  #pragma unroll
  for(int r=0;r<16;++r)rli[r]=__builtin_amdgcn_rcpf(wsf[32+crow(r,hi)]);
  bf16*Ow=O+(rowbase+q0+wid*QBLK)*OP+h*D;
  { bf16*stg=(bf16*)(shm+LDS_OST)+wid*2048;
    #pragma unroll
    for(int r=0;r<16;++r){const int orow=crow(r,hi);
      #pragma unroll
      for(int d0=0;d0<2;++d0)stg[orow*64+d0*32+r32]=__float2bfloat16(o[d0][r]*rli[r]);}
    asm volatile("s_waitcnt lgkmcnt(0)":::"memory");
    #pragma unroll
    for(int i=0;i<4;++i){const int row=i*8+(lane>>3),ch=lane&7; const u32x4 v=*(const u32x4*)(stg+row*64+ch*8); ATTN_STORE16(Ow+(long)row*OP+ch*8,v);} }
  asm volatile("s_waitcnt lgkmcnt(0)\n\ts_barrier":::"memory");
  #undef BLKSEL
  #undef DMA_K
  #undef DMA_V
  #undef CMASK
  #undef START
  #undef RESC
  #undef ROT
}
constexpr int ATTN_LDS_BYTES=LDS_BYTES;
struct AttnTensors { const bf16* Q; const bf16* K; const bf16* V; bf16* O; const float* kbar; };
struct AttnUnit { int bh; int qb; };
struct StaticOrder {
  int vcu, G;
  __device__ __forceinline__ explicit StaticOrder(int grid,int block):vcu((grid%8==0)?(block%8)*(grid/8)+block/8:block),G(grid){}
  __device__ __forceinline__ bool next(int i,AttnUnit&u)const{ const int pr=(vcu+(i>>2)*G)*2+((i>>1)&1); if(pr>=BATCH*NHEAD*4)return false;
    const int s=pr&3; u.bh=pr>>2; u.qb=(i&1)?7-s:s; return true; }
  __device__ __forceinline__ void a_ready(const AttnUnit&)const{}
  __device__ __forceinline__ void done(const AttnUnit&)const{}
};
template<class Sched,int THRL=8> __device__ __forceinline__ void attn_phase(char*lds,const AttnTensors&T,const Sched&S,const int tid_in){
  AttnUnit u; int tid_=tid_in; asm volatile("":"+v"(tid_));
  for(int i=0;S.next(i,u);++i){ S.a_ready(u); attn_unit<THRL>(u.bh/NHEAD,u.bh%NHEAD,u.qb,T.Q,T.K,T.V,T.O,T.kbar+(long)u.bh*512,lds,tid_); S.done(u); }
}
#undef SBAR
#undef WAIT_BAR
}

#define XB_TMO      128
#define XB_XCNT(j)  (256  + 64 * (j))
#define XB_XSUB(j)  (1280 + 64 * (j))
#define XB_XGEN(j)  (2304 + 64 * (j))
#define XB_TOP      3328
#define XB_TOPGEN   3392
#define XCD_BAR_WORDS 3456
#define XB_SPIN_CAP (1u << 18)

__device__ __forceinline__ unsigned xb_ld(unsigned* p)              { return __hip_atomic_load(p, __ATOMIC_RELAXED, __HIP_MEMORY_SCOPE_AGENT); }
__device__ __forceinline__ unsigned xb_add(unsigned* p, unsigned v) { return __hip_atomic_fetch_add(p, v, __ATOMIC_RELAXED, __HIP_MEMORY_SCOPE_AGENT); }
__device__ __forceinline__ unsigned xb_xcc_id() { return (unsigned)__builtin_amdgcn_s_getreg((3 << 11) | 20) & 0xFu; }
#define XB_SPIN(cond, bar) do { unsigned _sp = 0; while (cond) { __builtin_amdgcn_s_sleep(1); \
    if ((++_sp & 255u) == 0u) { if (xb_ld(&(bar)[XB_TMO])) break; if (_sp > XB_SPIN_CAP) { atomicAdd(&(bar)[XB_TMO], 1u); break; } } } } while (0)

struct XcdBarrier {
    unsigned* bar; unsigned x;
    volatile LAS unsigned* st;
};

__device__ __forceinline__ XcdBarrier xcd_barrier_post(unsigned* bar, volatile LAS unsigned* st) {
    XcdBarrier b; b.bar = bar; b.x = xb_xcc_id(); b.st = st;
    if (threadIdx.x == 0) (void)xb_add(&bar[XB_XCNT(b.x)], 1u);
    return b;
}
__device__ __forceinline__ void xcd_barrier_complete(unsigned* bar, unsigned x, unsigned& nloc, unsigned& nx) {
    const unsigned G = gridDim.x * gridDim.y * gridDim.z;
    unsigned sum, cnt, mine, sp = 0u;
    for (;;) {
        sum = 0u; cnt = 0u; mine = 0u;
#pragma unroll
        for (unsigned j = 0; j < 16; ++j) { const unsigned c = xb_ld(&bar[XB_XCNT(j)]); sum += c; cnt += (c > 0u) ? 1u : 0u; mine = (j == x) ? c : mine; }
        if (sum == G) break;
        __builtin_amdgcn_s_sleep(1);
        if ((++sp & 255u) == 0u) { if (xb_ld(&bar[XB_TMO])) break; if (sp > XB_SPIN_CAP) { atomicAdd(&bar[XB_TMO], 1u); break; } }
    }
    nloc = mine > 0u ? mine : 1u; nx = cnt > 0u ? cnt : 1u;
}

__device__ __forceinline__ void xcd_barrier(const XcdBarrier& b, const bool is_t0) {
    asm volatile("s_waitcnt vmcnt(0)" ::: "memory");
    __syncthreads();
    if (is_t0) {
        unsigned* bar = b.bar;
        __builtin_amdgcn_s_waitcnt(0);
        unsigned nloc = b.st[0], nx = b.st[1];
        if (nloc == 0u) { xcd_barrier_complete(bar, b.x, nloc, nx); b.st[0] = nloc; b.st[1] = nx; }
        const unsigned old = xb_add(&bar[XB_XSUB(b.x)], 1u);
        const unsigned gen = old / nloc;
        if (old + 1u == (gen + 1u) * nloc) {
            __builtin_amdgcn_fence(__ATOMIC_RELEASE, "agent");
            asm volatile("s_waitcnt vmcnt(0)" ::: "memory");
            const unsigned og = xb_add(&bar[XB_TOP], 1u);
            const unsigned tg = og / nx;
            if (og + 1u == (tg + 1u) * nx) xb_add(&bar[XB_TOPGEN], 1u);
            else XB_SPIN(xb_ld(&bar[XB_TOPGEN]) == tg, bar);
            __builtin_amdgcn_fence(__ATOMIC_ACQUIRE, "agent");
            xb_add(&bar[XB_XGEN(b.x)], 1u);
            asm volatile("s_waitcnt vmcnt(0)" ::: "memory");
        } else {
            XB_SPIN(xb_ld(&bar[XB_XGEN(b.x)]) == gen, bar);
            __builtin_amdgcn_fence(__ATOMIC_ACQUIRE, "agent");
            asm volatile("s_waitcnt vmcnt(0)" ::: "memory");
        }
    }
    __syncthreads();
}

struct Args { const float* in[17]; float* out; unsigned char* ws; int ph_lo, ph_hi; };
enum { I_X = 0, I_C, I_WMOD, I_BMOD, I_WIN, I_WPOOL, I_PSCALE, I_WOUT, I_LN1G, I_LN1B, I_WR, I_RB, I_WG, I_WU, I_WDN, I_LN2G, I_LN2B };

DEVFN int lane_id_volatile() { int l; asm volatile("v_mbcnt_lo_u32_b32 %0, -1, 0\n\tv_mbcnt_hi_u32_b32 %0, -1, %0" : "=v"(l)); return l; }
struct Ctx { unsigned char* lds; __attribute__((address_space(3))) unsigned char* lds3; int tid, lane, wave, G, bid, gw, NGW; };

DEVFN void transpose_item(const float* src, int ldn, int k0, int col, bf16_t* dst, int ldk, int dst_row0, int dst_k0, float* scr, int lane) {
#pragma unroll 8
    for (int i = 0; i < 32; ++i) { const int kk = 2 * i + (lane >> 5); scr[kk * 33 + (lane & 31)] = src[(size_t)(k0 + kk) * ldn + col]; }
    LDS_WAIT();
    const int c = lane & 7;
#pragma unroll
    for (int j = 0; j < 4; ++j) { const int n = (lane >> 3) + 8 * j; const float* s = scr + (8 * c) * 33 + n;
        u32x4 o; o.x = pk2(s[0 * 33], s[1 * 33]); o.y = pk2(s[2 * 33], s[3 * 33]); o.z = pk2(s[4 * 33], s[5 * 33]); o.w = pk2(s[6 * 33], s[7 * 33]);
        *(u32x4*)(dst + (size_t)(dst_row0 + n) * ldk + dst_k0 + 8 * c) = o; }
    LDS_WAIT();
}

DEVFN void ph_prologue(const Args& a, const Ctx& c) {
    unsigned char* ws = a.ws;
    float* scr = (float*)(c.lds + c.wave * 16384);
    const int lane = c.lane;
    constexpr int N1 = 2 * 16 * 64, N2 = 2 * 8 * 32, N3 = 32 * 16 * 32, N4 = 32 * 8 * 32, N5 = 2 * 64 * 16, N6 = 256;
    for (int it = c.gw; it < N1 + N2 + N3 + N4 + N5 + N6; it += c.NGW) {
        int r = it;
        if (r < N1) {
            const int l = r / 1024, kb = (r % 1024) / 64, nb = r % 64;
            const int nphys = 32 * nb + (lane & 31);
            transpose_item(a.in[I_WIN] + (size_t)l * DM * DIN, DIN, 64 * kb, inproj_nlog(nphys), (bf16_t*)(ws + WS_WIN) + (size_t)l * DIN * DM, DM, 32 * nb, 64 * kb, scr, lane);
            continue; }
        r -= N1;
        if (r < N2) {
            const int l = r / 256, kb = (r % 256) / 32, nb = r % 32;
            transpose_item(a.in[I_WOUT] + (size_t)l * DM * DM, DM, 64 * kb, 32 * nb + (lane & 31), (bf16_t*)(ws + WS_WOUT) + (size_t)l * DM * DM, DM, 32 * nb, 64 * kb, scr, lane);
            continue; }
        r -= N2;
        if (r < N3) {
            const int le = r / 512, kb = (r % 512) / 32, nb = r % 32;
            const int n = 32 * nb + (lane & 31), jt = n >> 8, bj = (n >> 7) & 1, i = n & 127;
            const float* src = (bj ? a.in[I_WU] : a.in[I_WG]) + (size_t)le * DM * DE;
            transpose_item(src, DE, 64 * kb, jt * 128 + i, (bf16_t*)(ws + WS_WGU) + (size_t)le * DM * DM, DM, 32 * nb, 64 * kb, scr, lane);
            continue; }
        r -= N3;
        if (r < N4) {
            const int le = r / 256, kb = (r % 256) / 32, nb = r % 32;
            transpose_item(a.in[I_WDN] + (size_t)le * DE * DM, DM, 64 * kb, 32 * nb + (lane & 31), (bf16_t*)(ws + WS_WD) + (size_t)le * DM * DE, DE, 32 * nb, 64 * kb, scr, lane);
            continue; }
        r -= N4;
        if (r < N5) {
            const int l = r / 1024, kdg = (r % 1024) / 16, nb = r % 16;
            const int n = nb * 64 + lane, kd0 = kdg * 8, g = kd0 >> 7, c0 = kd0 & 127;
            const float* wo = a.in[I_WOUT] + (size_t)l * DM * DM + (size_t)(512 + g * 128) * DM + n;
            const float* ps = a.in[I_PSCALE] + l * 512 + g * 128;
            const float* wp = a.in[I_WPOOL] + ((size_t)(l * 4 + g) * 128 + c0) * 128;
            float acc[8];
#pragma unroll
            for (int j = 0; j < 8; ++j) acc[j] = 0.f;
            for (int e = 0; e < 128; ++e) { const float w = wo[(size_t)e * DM] * ps[e];
#pragma unroll
                for (int j = 0; j < 8; ++j) acc[j] += wp[j * 128 + e] * w; }
            u32x4 o; o.x = pk2(acc[0], acc[1]); o.y = pk2(acc[2], acc[3]); o.z = pk2(acc[4], acc[5]); o.w = pk2(acc[6], acc[7]);
            *(u32x4*)((bf16_t*)(ws + WS_WOUT) + (size_t)l * DM * DM + (size_t)n * DM + 512 + kd0) = o;
            continue; }
        r -= N5;
        {
            const int ent = r * 64 + lane, pos = ent >> 3, i = ent & 7;
            const float inv = (float)exp2(-(double)i / 8.0 * 18.931568569324174);
            const float ang = (float)pos * inv;
            float* t = (float*)(ws + WS_ROPE) + ent * 2;
            t[0] = (float)cos((double)ang); t[1] = (float)sin((double)ang);
        }
    }
    for (int i = c.bid * 512 + c.tid; i < 2 * NB * NH * NBLK * HD; i += c.G * 512) ((float*)(ws + WS_KBAR))[i] = 0.f;
    __syncthreads();
    if (c.bid < 192) {
        float* condT = (float*)c.lds;
        float* red = (float*)(c.lds + 65536);
        for (int idx = c.tid; idx < NB * DM; idx += 512) { const int b = idx >> 10, k = idx & 1023; const float v = a.in[I_C][idx]; condT[k * 16 + b] = v / (1.f + __expf(-v)); }
        __syncthreads();
        for (int u = c.bid; u < 192; u += c.G) {
            const int l = u / 96, n0 = (u % 96) * 64;
            const float* W = a.in[I_WMOD] + (size_t)l * DM * NMOD + n0 + lane;
            float acc[16];
#pragma unroll
            for (int b = 0; b < 16; ++b) acc[b] = 0.f;
            for (int k = 128 * c.wave; k < 128 * c.wave + 128; k += 8) {
                float wv[8];
#pragma unroll
                for (int j = 0; j < 8; ++j) wv[j] = W[(size_t)(k + j) * NMOD];
#pragma unroll
                for (int j = 0; j < 8; ++j) {
                    const f32x4* cp = (const f32x4*)(condT + (k + j) * 16);
#pragma unroll
                    for (int q = 0; q < 4; ++q) { const f32x4 cv = cp[q]; acc[4 * q + 0] += cv.x * wv[j]; acc[4 * q + 1] += cv.y * wv[j]; acc[4 * q + 2] += cv.z * wv[j]; acc[4 * q + 3] += cv.w * wv[j]; }
                }
            }
#pragma unroll
            for (int b = 0; b < 16; ++b) red[(c.wave * 16 + b) * 64 + lane] = acc[b];
            __syncthreads();
            for (int o = c.tid; o < 1024; o += 512) { const int b = o >> 6, cc = o & 63; float s = a.in[I_BMOD][l * NMOD + n0 + cc];
#pragma unroll
                for (int w = 0; w < 8; ++w) s += red[(w * 16 + b) * 64 + cc];
                ((float*)(ws + WS_MOD))[(size_t)(l * NB + b) * NMOD + n0 + cc] = s; }
            __syncthreads();
        }
    }
}

DEVFN void row_stats(const f32x4 (&v)[4], float& mean, float& rstd) {
    float s = 0.f;
#pragma unroll
    for (int j = 0; j < 4; ++j) s += (v[j].x + v[j].y) + (v[j].z + v[j].w);
    mean = wave_sum(s) * (1.f / DM);
    float q = 0.f;
#pragma unroll
    for (int j = 0; j < 4; ++j) { const f32x4 d = v[j] - mean; q += (d.x * d.x + d.y * d.y) + (d.z * d.z + d.w * d.w); }
    rstd = 1.f / sqrtf(wave_sum(q) * (1.f / DM) + LN_EPS);
}
DEVFN void row_load(const float* p, int lane, f32x4 (&v)[4]) {
#pragma unroll
    for (int j = 0; j < 4; ++j) v[j] = *(const f32x4*)(p + 4 * lane + 256 * j);
}
DEVFN void row_mod_store(f32x4 (&v)[4], const float* sc, const float* sh, bf16_t* out, int lane) {
    float mean, rstd; row_stats(v, mean, rstd);
#pragma unroll
    for (int j = 0; j < 4; ++j) {
        const f32x4 s = *(const f32x4*)(sc + 4 * lane + 256 * j), h = *(const f32x4*)(sh + 4 * lane + 256 * j);
        v[j] = (v[j] - mean) * rstd * (s + 1.f) + h;
        u32x2 o; o.x = pk2(v[j].x, v[j].y); o.y = pk2(v[j].z, v[j].w);
        *(u32x2*)(out + 4 * lane + 256 * j) = o;
    }
}

DEVFN void ph_h1_rows(const Args& a, const Ctx& c) {
    const float* mod = (const float*)(a.ws + WS_MOD);
    for (int m = c.gw; m < NTOK; m += c.NGW) {
        const int b = m >> 11; f32x4 v[4]; row_load(a.in[I_X] + (size_t)m * DM, c.lane, v);
        row_mod_store(v, mod + (size_t)b * NMOD + DM, mod + (size_t)b * NMOD, (bf16_t*)(a.ws + WS_HB) + (size_t)m * DM, c.lane);
    }
}

DEVFN void wave_gemm32(f32x16& acc, const bf16_t* ap, const bf16_t* bp, int K) {
#pragma unroll 4
    for (int k = 0; k < K; k += 16) {
        const bf16x8 av = *(const bf16x8*)(ap + k), bv = *(const bf16x8*)(bp + k);
        acc = __builtin_amdgcn_mfma_f32_32x32x16_bf16(av, bv, acc, 0, 0, 0);
    }
}

DEVFN void ph_inproj_naive(const Args& a, const Ctx& c, int l) {
    const bf16_t* A = (const bf16_t*)(a.ws + WS_HB); const bf16_t* Bt = (const bf16_t*)(a.ws + WS_WIN) + (size_t)l * DIN * DM;
    bf16_t* O = (bf16_t*)(a.ws + WS_QKVP);
    const int r32 = c.lane & 31, hi = c.lane >> 5, wy = c.wave >> 2, wx = c.wave & 3;
    for (int u = c.bid; u < 512 * 16; u += c.G) {
        const int mt = u >> 4, nt = u & 15;
        f32x16 acc = {};
        wave_gemm32(acc, A + (size_t)(mt * 64 + wy * 32 + r32) * DM + hi * 8, Bt + (size_t)(nt * 128 + wx * 32 + r32) * DM + hi * 8, DM);
        const int nl = inproj_nlog(nt * 128 + wx * 32 + r32);
#pragma unroll
        for (int r = 0; r < 16; ++r) O[(size_t)(mt * 64 + wy * 32 + crow(r, hi)) * DIN + nl] = (bf16_t)f2bf(acc[r]);
    }
}

DEVFN void ph_rope_naive(const Args& a, const Ctx& c) {
    bf16_t* O = (bf16_t*)(a.ws + WS_QKVP); const float* rope = (const float*)(a.ws + WS_ROPE);
    for (int idx = c.bid * 512 + c.tid; idx < NTOK * 16; idx += c.G * 512) {
        const int which = idx & 1, hh = (idx >> 1) & 7, m = idx >> 4, t = m & (SEQ - 1);
        bf16_t* p = O + (size_t)m * DIN + which * 512 + hh * 64;
        float v[64];
#pragma unroll
        for (int q = 0; q < 8; ++q) { const u32x4 w = *(const u32x4*)(p + 8 * q);
            v[8 * q + 0] = bf_lo(w.x); v[8 * q + 1] = bf_hi(w.x); v[8 * q + 2] = bf_lo(w.y); v[8 * q + 3] = bf_hi(w.y);
            v[8 * q + 4] = bf_lo(w.z); v[8 * q + 5] = bf_hi(w.z); v[8 * q + 6] = bf_lo(w.w); v[8 * q + 7] = bf_hi(w.w); }
#pragma unroll
        for (int i = 0; i < 8; ++i) { const float cs = rope[(t * 8 + i) * 2], sn = rope[(t * 8 + i) * 2 + 1]; const float x1 = v[i], x2 = v[8 + i];
            v[i] = x1 * cs - x2 * sn; v[8 + i] = x2 * cs + x1 * sn; }
        const float sc = which == 0 ? QSCALE : 1.f;
#pragma unroll
        for (int q = 0; q < 8; ++q) { u32x4 w; w.x = pk2(v[8 * q] * sc, v[8 * q + 1] * sc); w.y = pk2(v[8 * q + 2] * sc, v[8 * q + 3] * sc); w.z = pk2(v[8 * q + 4] * sc, v[8 * q + 5] * sc); w.w = pk2(v[8 * q + 6] * sc, v[8 * q + 7] * sc);
            *(u32x4*)(p + 8 * q) = w; }
    }
}

DEVFN void ph_kbar(const Args& a, const Ctx& c, int l) {
    const bf16_t* O = (const bf16_t*)(a.ws + WS_QKVP); float* kbar = (float*)(a.ws + WS_KBAR) + (size_t)l * NB * NH * NBLK * HD;
    for (int it = c.gw; it < NB * NH * NBLK; it += c.NGW) {
        const int n = it & 7, hh = (it >> 3) & 7, b = it >> 6;
        const bf16_t* p = O + (size_t)(b * SEQ + n * MBLK) * DIN + 512 + hh * 64 + c.lane;
        float s = 0.f;
#pragma unroll 8
        for (int j = 0; j < MBLK; ++j) s += bf2f(p[(size_t)j * DIN]);
        kbar[(size_t)it * 64 + c.lane] = s * (1.f / MBLK);
    }
}

DEVFN void ph_pool(const Args& a, const Ctx& c) {
    const bf16_t* P = (const bf16_t*)(a.ws + WS_QKVP) + 1536; bf16_t* AD = (bf16_t*)(a.ws + WS_AD) + 512;
    for (int it = c.bid * 512 + c.tid; it < NTOK * 64; it += c.G * 512) {
        const int cg = it & 63, m = it >> 6, t = m & (SEQ - 1), g = cg >> 4, w = 2 << g;
        const int cnt = (t + 1 < w) ? t + 1 : w;
        float s[8];
#pragma unroll
        for (int j = 0; j < 8; ++j) s[j] = 0.f;
        float p0[8];
        for (int i = 0; i < cnt; ++i) { const u32x4 v = *(const u32x4*)(P + (size_t)(m - i) * DIN + cg * 8);
            const float f[8] = {bf_lo(v.x), bf_hi(v.x), bf_lo(v.y), bf_hi(v.y), bf_lo(v.z), bf_hi(v.z), bf_lo(v.w), bf_hi(v.w)};
#pragma unroll
            for (int j = 0; j < 8; ++j) { s[j] += f[j]; if (i == 0) p0[j] = f[j]; } }
        const float ic = 1.f / (float)cnt;
        u32x4 o; o.x = pk2(s[0] * ic - p0[0], s[1] * ic - p0[1]); o.y = pk2(s[2] * ic - p0[2], s[3] * ic - p0[3]); o.z = pk2(s[4] * ic - p0[4], s[5] * ic - p0[5]); o.w = pk2(s[6] * ic - p0[6], s[7] * ic - p0[7]);
        *(u32x4*)(AD + (size_t)m * DM + cg * 8) = o;
    }
}

DEVFN void ph_wout_naive(const Args& a, const Ctx& c, int l) {
    const bf16_t* A = (const bf16_t*)(a.ws + WS_AD); const bf16_t* Bt = (const bf16_t*)(a.ws + WS_WOUT) + (size_t)l * DM * DM;
    float* Y = (float*)(a.ws + WS_QKVP);
    const int r32 = c.lane & 31, hi = c.lane >> 5, wy = c.wave >> 2, wx = c.wave & 3;
    for (int u = c.bid; u < 512 * 8; u += c.G) {
        const int mt = u >> 3, nt = u & 7;
        f32x16 acc = {};
        wave_gemm32(acc, A + (size_t)(mt * 64 + wy * 32 + r32) * DM + hi * 8, Bt + (size_t)(nt * 128 + wx * 32 + r32) * DM + hi * 8, DM);
#pragma unroll
        for (int r = 0; r < 16; ++r) Y[(size_t)(mt * 64 + wy * 32 + crow(r, hi)) * DM + nt * 128 + wx * 32 + r32] = acc[r];
    }
}

DEVFN void ph_rows_c(const Args& a, const Ctx& c, int l) {
    const float* mod = (const float*)(a.ws + WS_MOD) + (size_t)l * NB * NMOD;
    const float* xin = l == 0 ? a.in[I_X] : a.out;
    const bf16_t* Y = (const bf16_t*)(a.ws + WS_QKVP);
    float* X1 = (float*)(a.ws + WS_X1); bf16_t* HB = (bf16_t*)(a.ws + WS_HB);
    const float* lg = a.in[I_LN1G] + l * DM; const float* lb = a.in[I_LN1B] + l * DM;
    float* wr = (float*)c.lds;
    int* lcnt = (int*)(c.lds + 65536); int* lbase = lcnt + 32;
    int* rcls = lbase + 32; float* rw1 = (float*)(rcls + 8 * 64); float* rw2 = rw1 + 8 * 64; int* rrow = (int*)(rw2 + 8 * 64);
    for (int i = c.tid; i < DM * NE; i += 512) wr[i] = a.in[I_WR][i];
    if (c.tid < 32) lcnt[c.tid] = 0;
    __syncthreads();
    float rb[16];
#pragma unroll
    for (int e = 0; e < 16; ++e) rb[e] = a.in[I_RB][e];
    int nr = 0;
    for (int m = c.gw; m < NTOK; m += c.NGW, ++nr) {
        const int b = m >> 11; const float* mb = mod + (size_t)b * NMOD;
        f32x4 v[4], y[4]; row_load(xin + (size_t)m * DM, c.lane, v);
#pragma unroll
        for (int j = 0; j < 4; ++j) { const u32x2 yw = *(const u32x2*)(Y + (size_t)m * DM + 4 * c.lane + 256 * j); y[j] = (f32x4){bf_lo(yw.x), bf_hi(yw.x), bf_lo(yw.y), bf_hi(yw.y)}; }
#pragma unroll
        for (int j = 0; j < 4; ++j) { const f32x4 g = *(const f32x4*)(mb + 2 * DM + 4 * c.lane + 256 * j); v[j] = v[j] * ALPHA + g * y[j]; }
        float mean, rstd; row_stats(v, mean, rstd);
#pragma unroll
        for (int j = 0; j < 4; ++j) { const f32x4 g = *(const f32x4*)(lg + 4 * c.lane + 256 * j), bb = *(const f32x4*)(lb + 4 * c.lane + 256 * j);
            v[j] = (v[j] - mean) * rstd * g + bb; *(f32x4*)(X1 + (size_t)m * DM + 4 * c.lane + 256 * j) = v[j]; }
        row_mod_store(v, mb + 4 * DM, mb + 3 * DM, HB + (size_t)m * DM, c.lane);
        float lg16[16];
#pragma unroll
        for (int e = 0; e < 16; ++e) lg16[e] = 0.f;
#pragma unroll
        for (int j = 0; j < 4; ++j)
#pragma unroll
            for (int i = 0; i < 4; ++i) { const float hv = v[j][i]; const f32x4* wp = (const f32x4*)(wr + (4 * c.lane + 256 * j + i) * 16);
#pragma unroll
                for (int q = 0; q < 4; ++q) { const f32x4 w = wp[q]; lg16[4 * q] += hv * w.x; lg16[4 * q + 1] += hv * w.y; lg16[4 * q + 2] += hv * w.z; lg16[4 * q + 3] += hv * w.w; } }
#pragma unroll
        for (int e = 0; e < 16; ++e) lg16[e] = wave_sum(lg16[e]);
        float mx = lg16[0];
#pragma unroll
        for (int e = 1; e < 16; ++e) mx = fmaxf(mx, lg16[e]);
        float sum = 0.f, sc[16];
#pragma unroll
        for (int e = 0; e < 16; ++e) { sc[e] = __expf(lg16[e] - mx); sum += sc[e]; }
        const float isum = 1.f / sum;
#pragma unroll
        for (int e = 0; e < 16; ++e) sc[e] *= isum;
        float bestg = -3.4e38f; int gb = 0, bi1 = 0, bi2 = 1; float bw1 = 0.f, bw2 = 0.f;
#pragma unroll
        for (int g = 0; g < 4; ++g) {
            float m1 = sc[4 * g] + rb[4 * g], s1 = sc[4 * g]; int i1 = 0;
#pragma unroll
            for (int i = 1; i < 4; ++i) { const float sv = sc[4 * g + i] + rb[4 * g + i]; const bool ok = sv > m1; m1 = ok ? sv : m1; s1 = ok ? sc[4 * g + i] : s1; i1 = ok ? i : i1; }
            float m2 = -3.4e38f, s2 = 0.f; int i2 = 0;
#pragma unroll
            for (int i = 0; i < 4; ++i) { const float sv = sc[4 * g + i] + rb[4 * g + i]; const bool ok = (i != i1) && sv > m2; m2 = ok ? sv : m2; s2 = ok ? sc[4 * g + i] : s2; i2 = ok ? i : i2; }
            const float gs = m1 + m2; const bool better = gs > bestg;
            bestg = better ? gs : bestg; gb = better ? g : gb; bi1 = better ? i1 : bi1; bi2 = better ? i2 : bi2; bw1 = better ? s1 : bw1; bw2 = better ? s2 : bw2;
        }
        const float inv = 1.f / (bw1 + bw2);
        const int lo = bi1 < bi2 ? bi1 : bi2, hi2 = bi1 < bi2 ? bi2 : bi1;
        const float wlo = (bi1 < bi2 ? bw1 : bw2) * inv, whi = (bi1 < bi2 ? bw2 : bw1) * inv;
        const int pidx = lo == 0 ? hi2 - 1 : (lo == 1 ? hi2 + 1 : 5);
        if (c.lane == 0) { rcls[c.wave * 64 + nr] = gb * 6 + pidx; rw1[c.wave * 64 + nr] = wlo; rw2[c.wave * 64 + nr] = whi; rrow[c.wave * 64 + nr] = m; }
    }
    LDS_WAIT();
    int rank = 0, cls = 0;
    if (c.lane < nr) { cls = rcls[c.wave * 64 + c.lane]; rank = atomicAdd(&lcnt[cls], 1); }
    __syncthreads();
    if (c.tid < NCLS) lbase[c.tid] = (int)__hip_atomic_fetch_add((unsigned*)(a.ws + WS_CTL) + CW_CNT + l * 32 + c.tid, (unsigned)lcnt[c.tid], RLX_AGENT);
    __syncthreads();
    if (c.lane < nr) {
        const int pos = lbase[cls] + rank;
        ((int*)(a.ws + WS_LIST))[(size_t)cls * LISTCAP + pos] = rrow[c.wave * 64 + c.lane];
        float* rw = (float*)(a.ws + WS_RW) + ((size_t)cls * LISTCAP + pos) * 2;
        rw[0] = rw1[c.wave * 64 + c.lane]; rw[1] = rw2[c.wave * 64 + c.lane];
    }
}

struct MoeTab { int* cnt; int* tp; };
DEVFN MoeTab moe_table(const Args& a, const Ctx& c, int l, unsigned char* lds_at) {
    MoeTab t; t.cnt = (int*)lds_at; t.tp = t.cnt + 32;
    if (c.tid < NCLS) t.cnt[c.tid] = (int)__hip_atomic_load((unsigned*)(a.ws + WS_CTL) + CW_CNT + l * 32 + c.tid, RLX_AGENT);
    __syncthreads();
    if (c.tid == 0) { int s = 0; for (int k = 0; k < NCLS; ++k) { t.tp[k] = s; s += (t.cnt[k] + 255) >> 8; } t.tp[NCLS] = s; }
    __syncthreads();
    return t;
}
DEVFN void cls_experts(int cls, int& e1, int& e2) { const int g = cls / 6, p = cls % 6; const int lo = p < 3 ? 0 : (p < 5 ? 1 : 2), hi = p < 3 ? p + 1 : (p < 5 ? p - 1 : 3); e1 = g * 4 + lo; e2 = g * 4 + hi; }

DEVFN void ph_gateup_naive(const Args& a, const Ctx& c, int l) {
    const MoeTab T = moe_table(a, c, l, c.lds);
    const int ntiles = T.tp[NCLS];
    const bf16_t* HB = (const bf16_t*)(a.ws + WS_HB); const bf16_t* WGU = (const bf16_t*)(a.ws + WS_WGU) + (size_t)l * NE * DM * DM;
    const int* list = (const int*)(a.ws + WS_LIST); const float* rw = (const float*)(a.ws + WS_RW);
    bf16_t* ACT = (bf16_t*)(a.ws + WS_QKVP);
    const int r32 = c.lane & 31, hi = c.lane >> 5, wy = c.wave >> 2, wx = c.wave & 3;
    for (int u = c.bid; u < ntiles * 32; u += c.G) {
        const int Tt = u >> 5, sub = (u >> 3) & 3, half = (u >> 2) & 1, jt = u & 3;
        int cls = 0; while (Tt >= T.tp[cls + 1]) ++cls;
        const int j = Tt - T.tp[cls], cnt = T.cnt[cls];
        int e1, e2; cls_experts(cls, e1, e2); const int e = half ? e2 : e1;
        const int lr = sub * 64 + wy * 32 + r32, li = 256 * j + lr;
        const int tok = list[(size_t)cls * LISTCAP + (li < cnt ? li : 256 * j)];
        const bf16_t* ap = HB + (size_t)tok * DM + hi * 8;
        const bf16_t* bg = WGU + (size_t)e * DM * DM + (size_t)(jt * 256 + wx * 32 + r32) * DM + hi * 8;
        f32x16 ag = {}, au = {};
        wave_gemm32(ag, ap, bg, DM); wave_gemm32(au, ap, bg + (size_t)128 * DM, DM);
#pragma unroll
        for (int r = 0; r < 16; ++r) {
            const int lro = sub * 64 + wy * 32 + crow(r, hi), lio = 256 * j + lro;
            const float wgt = lio < cnt ? rw[((size_t)cls * LISTCAP + lio) * 2 + half] : 0.f;
            const float g = ag[r], act = g / (1.f + __expf(-g)) * au[r] * wgt;
            ACT[(size_t)(256 * Tt + lro) * DM + half * 512 + jt * 128 + wx * 32 + r32] = (bf16_t)f2bf(act);
        }
    }
}

DEVFN void ph_down_naive(const Args& a, const Ctx& c, int l) {
    const MoeTab T = moe_table(a, c, l, c.lds);
    const int ntiles = T.tp[NCLS];
    const bf16_t* ACT = (const bf16_t*)(a.ws + WS_QKVP); const bf16_t* WD = (const bf16_t*)(a.ws + WS_WD) + (size_t)l * NE * DM * DE;
    const int* list = (const int*)(a.ws + WS_LIST);
    bf16_t* Y2 = (bf16_t*)(a.ws + WS_AD);
    const int r32 = c.lane & 31, hi = c.lane >> 5, wy = c.wave >> 2, wx = c.wave & 3;
    for (int u = c.bid; u < ntiles * 32; u += c.G) {
        const int Tt = u >> 5, sub = (u >> 3) & 3, nt = u & 7;
        int cls = 0; while (Tt >= T.tp[cls + 1]) ++cls;
        const int j = Tt - T.tp[cls], cnt = T.cnt[cls];
        int e1, e2; cls_experts(cls, e1, e2);
        const bf16_t* ap = ACT + (size_t)(256 * Tt + sub * 64 + wy * 32 + r32) * DM + hi * 8;
        const int n = nt * 128 + wx * 32 + r32;
        f32x16 acc = {};
        wave_gemm32(acc, ap, WD + (size_t)e1 * DM * DE + (size_t)n * DE + hi * 8, DE);
        wave_gemm32(acc, ap + DE, WD + (size_t)e2 * DM * DE + (size_t)n * DE + hi * 8, DE);
#pragma unroll
        for (int r = 0; r < 16; ++r) {
            const int lio = 256 * j + sub * 64 + wy * 32 + crow(r, hi);
            if (lio < cnt) { const int tok = list[(size_t)cls * LISTCAP + lio]; Y2[(size_t)tok * DM + n] = (bf16_t)f2bf(acc[r]); }
        }
    }
}

DEVFN void ph_rows_g(const Args& a, const Ctx& c, int l) {
    const float* mod = (const float*)(a.ws + WS_MOD) + (size_t)l * NB * NMOD;
    const float* X1 = (const float*)(a.ws + WS_X1); const bf16_t* Y2 = (const bf16_t*)(a.ws + WS_AD);
    const float* lg = a.in[I_LN2G] + l * DM; const float* lb = a.in[I_LN2B] + l * DM;
    for (int m = c.gw; m < NTOK; m += c.NGW) {
        const int b = m >> 11; const float* mb = mod + (size_t)b * NMOD;
        f32x4 v[4]; row_load(X1 + (size_t)m * DM, c.lane, v);
#pragma unroll
        for (int j = 0; j < 4; ++j) { const f32x4 g = *(const f32x4*)(mb + 5 * DM + 4 * c.lane + 256 * j); const u32x2 yw = *(const u32x2*)(Y2 + (size_t)m * DM + 4 * c.lane + 256 * j);
            const f32x4 y = {bf_lo(yw.x), bf_hi(yw.x), bf_lo(yw.y), bf_hi(yw.y)}; v[j] = v[j] * ALPHA + g * y; }
        float mean, rstd; row_stats(v, mean, rstd);
#pragma unroll
        for (int j = 0; j < 4; ++j) { const f32x4 g = *(const f32x4*)(lg + 4 * c.lane + 256 * j), bb = *(const f32x4*)(lb + 4 * c.lane + 256 * j);
            v[j] = (v[j] - mean) * rstd * g + bb; *(f32x4*)(a.out + (size_t)m * DM + 4 * c.lane + 256 * j) = v[j]; }
        if (l == 0) { const float* mb1 = mod + (size_t)NB * NMOD + (size_t)b * NMOD; row_mod_store(v, mb1 + DM, mb1, (bf16_t*)(a.ws + WS_HB) + (size_t)m * DM, c.lane); }
    }
}


constexpr int MOETAB_OFF = 131072 + 512;
DEVFN void ph_inproj_fast(const Args& a, const Ctx& c, int l) {
    pg8::DenseSched S; S.so.init(NTOK, DIN, c.G, c.bid); S.A = (const char*)(a.ws + WS_HB); S.Bt = (const char*)(a.ws + WS_WIN) + (size_t)l * DIN * DM * 2; S.lda = DM; S.ldb = DM;
    const pg8::EpiInproj E{(bf16_t*)(a.ws + WS_QKVP), (const float*)(a.ws + WS_ROPE), (float*)(a.ws + WS_KBAR) + (size_t)l * NB * NH * NBLK * HD};
    pg8::gemm_phase2<pg8::EpiInproj, pg8::DenseSched, true, false, false>(c.lds3, DM, DM, S, E, c.tid);
}
DEVFN void ph_wout_fast(const Args& a, const Ctx& c, int l) {
    pg8::DenseSched S; S.so.init(NTOK, DM, c.G, c.bid); S.A = (const char*)(a.ws + WS_AD); S.Bt = (const char*)(a.ws + WS_WOUT) + (size_t)l * DM * DM * 2; S.lda = DM; S.ldb = DM;
    const pg8::EpiBf16<0> E{(bf16_t*)(a.ws + WS_QKVP), DM, nullptr, 0, 0, 1.f};
    pg8::gemm_phase2<pg8::EpiBf16<0>, pg8::DenseSched, true, false, false>(c.lds3, DM, DM, S, E, c.tid);
}
DEVFN void moe_table_lds(const Args& a, const Ctx& c, int l) {
    int* cnt = (int*)(c.lds + MOETAB_OFF); int* tp = cnt + 32;
    if (c.tid < NCLS) cnt[c.tid] = (int)__hip_atomic_load((unsigned*)(a.ws + WS_CTL) + CW_CNT + l * 32 + c.tid, RLX_AGENT);
    __syncthreads();
    if (c.tid == 0) { int s = 0; for (int k = 0; k < NCLS; ++k) { tp[k] = s; s += (cnt[k] + 255) >> 8; } tp[NCLS] = s; }
    __syncthreads();
}
DEVFN void ph_gateup_fast(const Args& a, const Ctx& c, int l) {
    moe_table_lds(a, c, l);
    pg8::GateUpSched S; S.cnt = (const LAS int*)(c.lds3 + MOETAB_OFF); S.tp = S.cnt + 32; S.npn_shift = 3; S.nunits = S.tp[NCLS] * 8; S.G = c.G; S.c = c.bid;
    S.HB = (const char*)(a.ws + WS_HB); S.list = (const int*)(a.ws + WS_LIST); S.W = (const char*)(a.ws + WS_WGU) + (size_t)l * NE * DM * DM * 2;
    const pg8::EpiGateUp E{(bf16_t*)(a.ws + WS_QKVP), (const float*)(a.ws + WS_RW)};
    pg8::gemm_phase2<pg8::EpiGateUp, pg8::GateUpSched, true, true, false>(c.lds3, DM, DM, S, E, c.tid);
}
DEVFN void ph_down_fast(const Args& a, const Ctx& c, int l) {
    moe_table_lds(a, c, l);
    pg8::DownSched S; S.cnt = (const LAS int*)(c.lds3 + MOETAB_OFF); S.tp = S.cnt + 32; S.npn_shift = 2; S.nunits = S.tp[NCLS] * 4; S.G = c.G; S.c = c.bid;
    S.ACT = (const char*)(a.ws + WS_QKVP); S.W = (const char*)(a.ws + WS_WD) + (size_t)l * NE * DM * DE * 2;
    const pg8::EpiDown E{(bf16_t*)(a.ws + WS_AD), (const int*)(a.ws + WS_LIST)};
    pg8::gemm_phase2<pg8::EpiDown, pg8::DownSched, true, false, true>(c.lds3, DM, DE, S, E, c.tid);
}

#ifndef MK_N_LAUNCHES
#define MK_N_LAUNCHES 1
#endif
constexpr int RING_BYTES = 131072, LDSCTL_OFF = RING_BYTES, MISC_OFF = LDSCTL_OFF + 320, LDS_BYTES = 147456;
constexpr int PH_PER_LAYER = 7, NPHASE = 2 + 2 * PH_PER_LAYER;
constexpr int CW_BAR = 4096;
static_assert((CW_BAR + XCD_BAR_WORDS) * 4 <= (int)CTL_ZERO_BYTES, "CTL");

__global__ void __launch_bounds__(512, 2) fwd(Args a) {
    extern __shared__ __attribute__((aligned(16))) unsigned char lds[];
    const int wave_s = __builtin_amdgcn_readfirstlane(threadIdx.x >> 6);
#define MKTID() (wave_s * 64 + lane_id_volatile())
#define MKCTX() Ctx c; { int t_ = MKTID(); asm volatile("" : "+v"(t_)); c.lds = lds; c.lds3 = (LAS unsigned char*)lds; c.tid = t_; c.lane = t_ & 63; c.wave = __builtin_amdgcn_readfirstlane(t_ >> 6); c.G = gridDim.x; c.bid = blockIdx.x; c.gw = c.bid * 8 + c.wave; c.NGW = c.G * 8; }
    const int lo = a.ph_lo, hi = a.ph_hi;
    const bool one = (hi - lo) > 1;
    for (int u = threadIdx.x; u < (LDS_BYTES - LDSCTL_OFF) / 4; u += 512) ((LAS unsigned*)((LAS unsigned char*)lds + LDSCTL_OFF))[u] = 0u;
    __syncthreads();
    XcdBarrier bar; bar.bar = (unsigned*)(a.ws + WS_CTL) + CW_BAR; bar.x = 0; bar.st = nullptr;
    if (one) bar = xcd_barrier_post((unsigned*)(a.ws + WS_CTL) + CW_BAR, (volatile LAS unsigned*)((LAS unsigned char*)lds + MISC_OFF) + 8);
#define IN(k) (lo <= (k) && (k) < hi)
#define SEAM(k) do { if (IN(k) && IN((k) + 1)) xcd_barrier(bar, MKTID() == 0); } while (0)
    if (IN(0)) { MKCTX(); ph_prologue(a, c); SEAM(0); }
    if (IN(1)) { MKCTX(); ph_h1_rows(a, c); SEAM(1); }
    for (int l = 0; l < 2; ++l) {
        const int p0 = 2 + l * PH_PER_LAYER;
        if (IN(p0 + 0)) { MKCTX(); ph_inproj_fast(a, c, l); SEAM(p0 + 0); }
        if (IN(p0 + 1)) {
            { MKCTX(); ph_pool(a, c); }
            __syncthreads();
            const attn_body::AttnTensors AT{(const attn_body::bf16*)(a.ws + WS_QKVP), (const attn_body::bf16*)(a.ws + WS_QKVP) + 512, (const attn_body::bf16*)(a.ws + WS_QKVP) + 1024,
                                            (attn_body::bf16*)(a.ws + WS_AD), (const float*)(a.ws + WS_KBAR) + (size_t)l * NB * NH * NBLK * HD};
            const attn_body::StaticOrder S((int)gridDim.x, (int)blockIdx.x);
            attn_body::attn_phase<attn_body::StaticOrder>((char*)lds, AT, S, MKTID());
            SEAM(p0 + 1);
        }
        if (IN(p0 + 2)) { MKCTX(); ph_wout_fast(a, c, l); SEAM(p0 + 2); }
        if (IN(p0 + 3)) { MKCTX(); ph_rows_c(a, c, l); SEAM(p0 + 3); }
        if (IN(p0 + 4)) { MKCTX(); ph_gateup_fast(a, c, l); SEAM(p0 + 4); }
        if (IN(p0 + 5)) { MKCTX(); ph_down_fast(a, c, l); SEAM(p0 + 5); }
        if (IN(p0 + 6)) { MKCTX(); ph_rows_g(a, c, l); SEAM(p0 + 6); }
    }
#undef IN
#undef SEAM
}

extern "C" void kernel_launch(void* const* d_in, const int* in_sizes, int n_in, void* d_out, int out_size, void* d_ws, size_t ws_size, hipStream_t stream) {
    static int grid = 0;
    if (grid == 0) {
        if (n_in != 17 || out_size != NTOK * DM || ws_size < WS_END) { fprintf(stderr, "kernel_launch: unexpected problem (n_in %d out %d ws %zu)\n", n_in, out_size, ws_size); grid = -1; return; }
        if (hipFuncSetAttribute((const void*)fwd, hipFuncAttributeMaxDynamicSharedMemorySize, LDS_BYTES) != hipSuccess) { fprintf(stderr, "kernel_launch: hipFuncSetAttribute failed\n"); grid = -1; return; }
        int dev = 0, cus = 0, per_cu = 0;
        (void)hipGetDevice(&dev); (void)hipDeviceGetAttribute(&cus, hipDeviceAttributeMultiprocessorCount, dev);
        if (hipOccupancyMaxActiveBlocksPerMultiprocessor(&per_cu, (const void*)fwd, 512, LDS_BYTES) != hipSuccess || per_cu < 1) fprintf(stderr, "kernel_launch: occupancy query reports %d workgroups per CU\n", per_cu);
        (void)hipGetLastError();
        grid = cus > 0 ? cus : 256;
    }
    if (grid < 0) return;
    (void)hipMemsetAsync((char*)d_ws + WS_CTL, 0, CTL_ZERO_BYTES, stream);
    Args a{};
    for (int i = 0; i < 17; ++i) a.in[i] = (const float*)d_in[i];
    a.out = (float*)d_out; a.ws = (unsigned char*)d_ws;
#if MK_N_LAUNCHES == 1
    a.ph_lo = 0; a.ph_hi = NPHASE; hipLaunchKernelGGL(fwd, dim3(grid), dim3(512), LDS_BYTES, stream, a);
#else
    for (int p = 0; p < NPHASE; ++p) { a.ph_lo = p; a.ph_hi = p + 1; hipLaunchKernelGGL(fwd, dim3(grid), dim3(512), LDS_BYTES, stream, a); }
#endif
}
```

```cpp
#include <hip/hip_runtime.h>
#include <cstdint>
#include <cstdio>

constexpr int NB = 16, SEQ = 2048, DM = 1024, NTOK = NB * SEQ, DIN = 2048, NH = 8, HD = 64, NBLK = 8, MBLK = 256;
constexpr int NE = 16, NCLS = 24, DE = 512, NMOD = 6 * DM;
constexpr float ALPHA = 1.41421356237309515f, LN_EPS = 1e-5f;
constexpr float QSCALE = 0.125f * 1.4426950408889634f;
constexpr int LISTCAP = NTOK;

constexpr size_t MiB = 1u << 20;
constexpr size_t WS_CTL = 0, CTL_ZERO_BYTES = 1 * MiB;
constexpr size_t WS_MOD = 1 * MiB;
constexpr size_t WS_ROPE = 2 * MiB;
constexpr size_t WS_KBAR = 2 * MiB + 256 * 1024;
constexpr size_t WS_LIST = 3 * MiB;
constexpr size_t WS_RW = 6 * MiB;
constexpr size_t WS_WIN = 12 * MiB;
constexpr size_t WS_WOUT = 20 * MiB;
constexpr size_t WS_WGU = 24 * MiB;
constexpr size_t WS_WD = 88 * MiB;
constexpr size_t WS_HB = 120 * MiB;
constexpr size_t WS_QKVP = 184 * MiB;
constexpr size_t WS_AD = 312 * MiB;
constexpr size_t WS_X1 = 376 * MiB;
constexpr size_t WS_END = 504 * MiB;
constexpr int CW_TMO = 0, CW_CNT = 64;

typedef unsigned short bf16_t;
typedef short bf16x8 __attribute__((ext_vector_type(8)));
typedef float f32x4 __attribute__((ext_vector_type(4)));
typedef float f32x16 __attribute__((ext_vector_type(16)));
typedef unsigned u32x4 __attribute__((ext_vector_type(4)));
typedef unsigned u32x2 __attribute__((ext_vector_type(2)));

#define DEVFN __device__ __forceinline__
#define LDS_WAIT() asm volatile("s_waitcnt lgkmcnt(0)" ::: "memory")
#define RLX_AGENT __ATOMIC_RELAXED, __HIP_MEMORY_SCOPE_AGENT

DEVFN float bf_lo(unsigned w) { return __uint_as_float(w << 16); }
DEVFN float bf_hi(unsigned w) { return __uint_as_float(w & 0xffff0000u); }
DEVFN float bf2f(bf16_t v) { return __uint_as_float((unsigned)v << 16); }
DEVFN unsigned f2bf(float f) { unsigned u = __float_as_uint(f); return (u + 0x7fffu + ((u >> 16) & 1u)) >> 16; }
DEVFN unsigned pk2(float lo, float hi) { return f2bf(lo) | (f2bf(hi) << 16); }
DEVFN int crow(int r, int hi) { return (r & 3) + 8 * (r >> 2) + 4 * hi; }
#define SWZ_XOR(m) (0x1f | ((m) << 10))
DEVFN float swz_xor_add(float v, const int m) {
    switch (m) {
        case 1: return v + __int_as_float(__builtin_amdgcn_ds_swizzle(__float_as_int(v), SWZ_XOR(1)));
        case 2: return v + __int_as_float(__builtin_amdgcn_ds_swizzle(__float_as_int(v), SWZ_XOR(2)));
        case 4: return v + __int_as_float(__builtin_amdgcn_ds_swizzle(__float_as_int(v), SWZ_XOR(4)));
        case 8: return v + __int_as_float(__builtin_amdgcn_ds_swizzle(__float_as_int(v), SWZ_XOR(8)));
        default: return v + __int_as_float(__builtin_amdgcn_ds_swizzle(__float_as_int(v), SWZ_XOR(16)));
    }
}
DEVFN float half_swap_add(float v) { auto rr = __builtin_amdgcn_permlane32_swap(__float_as_uint(v), __float_as_uint(v), false, false); return __uint_as_float(rr[0]) + __uint_as_float(rr[1]); }
DEVFN float wave_sum(float v) {
    v = swz_xor_add(v, 1); v = swz_xor_add(v, 2); v = swz_xor_add(v, 4); v = swz_xor_add(v, 8); v = swz_xor_add(v, 16);
    return half_swap_add(v);
}
__host__ __device__ __forceinline__ int inproj_lgroup(int P) { return P < 16 ? (P >> 2) * 8 + (P & 3) * 2 : ((P - 16) >> 2) * 8 + ((P - 16) & 3) * 2 + 1; }
__host__ __device__ __forceinline__ int inproj_nlog(int n) { return (n & ~255) + inproj_lgroup((n & 255) >> 3) * 8 + (n & 7); }

#define GAS __attribute__((address_space(1)))
#define LAS __attribute__((address_space(3)))
typedef GAS unsigned gu32;
namespace pg8 {
#define PG8_LAS __attribute__((address_space(3)))
typedef unsigned short bf16_t;
typedef short bf16x8 __attribute__((ext_vector_type(8)));
typedef float f32x4 __attribute__((ext_vector_type(4)));
typedef unsigned u32x4 __attribute__((ext_vector_type(4)));
constexpr int BM = 256, BK = 64, HALF = 128, HTB = HALF * BK * 2  , STAGE_BYTES = 8 * HTB, NXCD = 8, WGM = 8;

__host__ __device__ __forceinline__ int lds_byte(int r, int c) { const int st = (r >> 4) * 2 + (c >> 5), rr = r & 15, cc = c & 31, ob = rr * 64 + cc * 2; return st * 1024 + (ob ^ (((ob >> 9) & 1) << 5)); }
__host__ __device__ __forceinline__ void stage_rc(int b, int& R, int& C) { const int st = b / 1024, sb = b % 1024, swz = sb ^ (((sb >> 9) & 1) << 5); R = (st >> 1) * 16 + swz / 64; C = (st & 1) * 32 + (swz % 64) / 2; }
__host__ __device__ __forceinline__ int perm32(int rho) { const int n = rho >> 4, i = rho & 15; return 8 * (i >> 2) + 4 * n + (i & 3); }

struct Unit { int pm, pn; };
struct Gemm { const bf16_t* A; const bf16_t* Bt; int M, N, K; };

struct StaticOrder {
    int nM, nN, nwg, G, c;
    __host__ __device__ void init(int M, int N, int G_, int c_) { nM = M / BM; nN = N / BM; nwg = nM * nN; G = G_; c = c_; }
    __host__ __device__ bool next(int i, Unit& u) const {
        const long L = (long)i * G + c; if (L >= nwg) return false;
        int wgid = (int)L; { const int q = nwg / NXCD, r = nwg % NXCD, xcd = wgid % NXCD, off = wgid / NXCD; wgid = (xcd < r ? xcd * (q + 1) : r * (q + 1) + (xcd - r) * q) + off; }
        const int nig = WGM * nN, gid = wgid / nig, fm = gid * WGM, gsz = (nM - fm) < WGM ? (nM - fm) : WGM;
        u.pm = fm + ((wgid % nig) % gsz); u.pn = (wgid % nig) / gsz; return true;
    }
    __device__ __forceinline__ void a_ready(const Unit&) const {}
    __device__ __forceinline__ void done(const Unit&) const {}
};

__device__ __forceinline__ unsigned cvt_pk_bf16(float lo, float hi) { unsigned r; asm volatile("v_cvt_pk_bf16_f32 %0, %1, %2" : "=v"(r) : "v"(lo), "v"(hi)); return r; }
typedef float f32x2 __attribute__((ext_vector_type(2)));
__device__ __forceinline__ f32x2 gelu_pk(f32x2 v) {
    const f32x2 av = __builtin_elementwise_abs(v), d = av * 0.2316418882f + 1.0f;
    f32x2 t; t.x = __builtin_amdgcn_rcpf(d.x); t.y = __builtin_amdgcn_rcpf(d.y);
    f32x2 q = t * 0.5307027145f + (-0.7265760135f); q = q * t + 0.7107068705f; q = q * t + (-0.142248368f); q = q * t + 0.127414796f; q = q * t;
    const f32x2 s = (v * v) * (-0.72134752044f);
    f32x2 e; e.x = __builtin_amdgcn_exp2f(s.x); e.y = __builtin_amdgcn_exp2f(s.y);
    const f32x2 m = v * (q * e), r = v - m;
    f32x2 o; o.x = v.x < 0.f ? m.x : r.x; o.y = v.y < 0.f ? m.y : r.y; return o;
}

template <int ACT  > struct EpiBf16 {
    static constexpr bool PERM = true, AFTER_DRAIN = false; static_assert(ACT == 0 || ACT == 1, "EpiBf16: ACT is 0 (none) or 1 (gelu_pk)");
    bf16_t* O; int ldc; const float* bias; int split_cols; size_t split_stride; float scale0;
    __device__ __forceinline__ void operator()(const f32x4 (&acc)[2][2][4][2], const Unit& u, int wr, int wc, int fr, int fq) const {
        const int row0 = u.pm * BM + wr * 64 + fr; int colt = u.pn * BM; bf16_t* base = O;
        float sc = 1.f; if (split_cols) { const int t = colt / split_cols; base += (size_t)t * split_stride; colt -= t * split_cols; if (t == 0) sc = scale0; }
        const int col0 = colt + wc * 32 + 8 * fq, bcol0 = u.pn * BM + wc * 32 + 8 * fq;
        f32x4 bv[2][2];
#pragma unroll
        for (int bj = 0; bj < 2; ++bj)
#pragma unroll
            for (int n = 0; n < 2; ++n) bv[bj][n] = bias ? *(const f32x4*)(bias + bcol0 + bj * HALF + 4 * n) : (f32x4){0.f, 0.f, 0.f, 0.f};
#pragma unroll
        for (int ai = 0; ai < 2; ++ai)
#pragma unroll
            for (int m = 0; m < 4; ++m) { bf16_t* rowp = base + (size_t)(row0 + ai * HALF + m * 16) * ldc + col0;
#pragma unroll
                for (int bj = 0; bj < 2; ++bj) { f32x4 v0 = acc[ai][bj][m][0] + bv[bj][0], v1 = acc[ai][bj][m][1] + bv[bj][1];
                    if (ACT == 1) { f32x2 a = gelu_pk((f32x2){v0[0], v0[1]}), b = gelu_pk((f32x2){v0[2], v0[3]}), c = gelu_pk((f32x2){v1[0], v1[1]}), d = gelu_pk((f32x2){v1[2], v1[3]});
                        v0 = (f32x4){a.x, a.y, b.x, b.y}; v1 = (f32x4){c.x, c.y, d.x, d.y}; }
                    v0 = v0 * sc; v1 = v1 * sc; u32x4 w; w.x = cvt_pk_bf16(v0[0], v0[1]); w.y = cvt_pk_bf16(v0[2], v0[3]); w.z = cvt_pk_bf16(v1[0], v1[1]); w.w = cvt_pk_bf16(v1[2], v1[3]);
                    *(u32x4*)(rowp + bj * HALF) = w; } }
    }
};

struct PanelStats {
    unsigned* xbuf;
    unsigned* cnt;
    unsigned* tmo;
    int ntn; float eps;
    unsigned code;
    __device__ __forceinline__ bool run(const f32x4 (&v)[2][2][4][2], const Unit& u, int wr, int wc, int fr, int fq, PG8_LAS unsigned char* lds, int wid, int lane) const {
        typedef float f32x2v __attribute__((ext_vector_type(2)));
        PG8_LAS f32x2v* P = (PG8_LAS f32x2v*)lds;
        PG8_LAS f32x2v* S = (PG8_LAS f32x2v*)(lds + 8192);
        PG8_LAS unsigned* flag = (PG8_LAS unsigned*)(lds + 8192 + 2048);
#pragma unroll
        for (int ai = 0; ai < 2; ++ai)
#pragma unroll
            for (int m = 0; m < 4; ++m) {
                float s = 0.f;
#pragma unroll
                for (int bj = 0; bj < 2; ++bj)
#pragma unroll
                    for (int n = 0; n < 2; ++n) { const f32x4 x = v[ai][bj][m][n]; s += (x[0] + x[1]) + (x[2] + x[3]); }
                s += __shfl_xor(s, 16); s += __shfl_xor(s, 32);
                const float mw = s * (1.0f / 64.0f); float q = 0.f;
#pragma unroll
                for (int bj = 0; bj < 2; ++bj)
#pragma unroll
                    for (int n = 0; n < 2; ++n) { const f32x4 d = v[ai][bj][m][n] - mw; q += (d[0] * d[0] + d[1] * d[1]) + (d[2] * d[2] + d[3] * d[3]); }
                q += __shfl_xor(q, 16); q += __shfl_xor(q, 32);
                if (fq == 0) P[(ai * HALF + wr * 64 + m * 16 + fr) * 4 + wc] = (f32x2v){mw, q};
            }
        asm volatile("s_waitcnt lgkmcnt(0)" ::: "memory"); __builtin_amdgcn_s_barrier(); asm volatile("" ::: "memory");
#if defined(BROKEN_EXCHANGE_NO_WAIT)
#warning BROKEN CONTROL BUILD: the row-statistics exchange does not wait; results are wrong by design
        if (blockIdx.x >= 64) { const long long t0_ = clock64(); while (clock64() - t0_ < 60000) __builtin_amdgcn_s_sleep(8); }
#endif
        const int row = wid * 32 + (lane & 31);
        if (lane < 32) {
            const f32x2v a = P[row * 4 + 0], b = P[row * 4 + 1], c = P[row * 4 + 2], d = P[row * 4 + 3];
            const float mt = (a.x + b.x + c.x + d.x) * 0.25f;
            const float da = a.x - mt, db = b.x - mt, dc = c.x - mt, dd = d.x - mt;
            const float m2 = (a.y + b.y) + (c.y + d.y) + 64.0f * ((da * da + db * db) + (dc * dc + dd * dd));
            unsigned long long* slot = (unsigned long long*)xbuf + ((size_t)(u.pm * BM + row) * 4 + u.pn);
            __hip_atomic_store(slot, ((unsigned long long)__float_as_uint(m2) << 32) | __float_as_uint(mt), __ATOMIC_RELAXED, __HIP_MEMORY_SCOPE_AGENT);
        }
        asm volatile("s_waitcnt vmcnt(0)" ::: "memory");
        if (lane == 0) __hip_atomic_fetch_add(cnt + 64 * u.pm, 1u, __ATOMIC_RELAXED, __HIP_MEMORY_SCOPE_AGENT);
        if (wid == 0) {
            bool dead = false; const unsigned long long t0 = __builtin_amdgcn_s_memrealtime(); const unsigned want = 8u * (unsigned)ntn;
            for (;;) {
#if defined(BROKEN_EXCHANGE_NO_WAIT)
                break;
#endif
                if ((unsigned)__builtin_amdgcn_readfirstlane(__hip_atomic_load(cnt + 64 * u.pm, __ATOMIC_RELAXED, __HIP_MEMORY_SCOPE_AGENT)) >= want) break;
                if (__builtin_amdgcn_s_memrealtime() - t0 > 2000000ull) {
                    if (lane == 0) { unsigned expect = 0u; __hip_atomic_compare_exchange_strong(tmo + 1, &expect, code | (unsigned)(u.pm & 0xff), __ATOMIC_RELAXED, __ATOMIC_RELAXED, __HIP_MEMORY_SCOPE_AGENT);
                                     __hip_atomic_store(tmo, 1u, __ATOMIC_RELAXED, __HIP_MEMORY_SCOPE_AGENT); }
                    dead = true; break; }
                __builtin_amdgcn_s_sleep(2);
            }
            __builtin_amdgcn_fence(__ATOMIC_ACQUIRE, "agent");
            if (lane == 0) flag[0] = dead ? 1u : 0u;
        }
        asm volatile("s_waitcnt vmcnt(0) lgkmcnt(0)" ::: "memory"); __builtin_amdgcn_s_barrier(); asm volatile("" ::: "memory");
        const bool bad = flag[0] != 0u;
        if (lane < 32) {
            const unsigned long long* slot = (const unsigned long long*)xbuf + (size_t)(u.pm * BM + row) * 4; float mt[4], m2[4]; float ms = 0.f;
#pragma unroll
            for (int t = 0; t < 4; ++t) { if (t < ntn) { const unsigned long long w = __hip_atomic_load(slot + t, __ATOMIC_RELAXED, __HIP_MEMORY_SCOPE_AGENT); mt[t] = __uint_as_float((unsigned)w); m2[t] = __uint_as_float((unsigned)(w >> 32)); } else { mt[t] = 0.f; m2[t] = 0.f; } ms += mt[t]; }
            const float mean = ms / (float)ntn; float q = 0.f;
#pragma unroll
            for (int t = 0; t < 4; ++t) if (t < ntn) { const float dm = mt[t] - mean; q += m2[t] + 256.0f * dm * dm; }
            S[row] = (f32x2v){mean, 1.0f / sqrtf(q / (256.0f * (float)ntn) + eps)};
        }
        asm volatile("s_waitcnt lgkmcnt(0)" ::: "memory"); __builtin_amdgcn_s_barrier(); asm volatile("" ::: "memory");
        return bad;
    }
};
struct EpiLnRes {
    static constexpr bool PERM = false, AFTER_DRAIN = true;
    const float* base; float* out; int ldc; const float* bias; PanelStats st; unsigned poison;
    __device__ __forceinline__ void fused(f32x4 (&acc)[2][2][4][2], const Unit& u, int wr, int wc, int fr, int fq, PG8_LAS unsigned char* lds, int wid, int lane) const {
        typedef float f32x2v __attribute__((ext_vector_type(2)));
        const PG8_LAS f32x2v* S = (const PG8_LAS f32x2v*)(lds + 8192);
        const int col0 = u.pn * BM + wc * 32 + 4 * fq;
#pragma unroll
        for (int bj = 0; bj < 2; ++bj)
#pragma unroll
            for (int n = 0; n < 2; ++n) { const f32x4 bv = bias ? *(const f32x4*)(bias + col0 + bj * HALF + n * 16) : (f32x4){0.f, 0.f, 0.f, 0.f};
#pragma unroll
                for (int ai = 0; ai < 2; ++ai)
#pragma unroll
                    for (int m = 0; m < 4; ++m) acc[ai][bj][m][n] += bv; }
        f32x4 pre[4][2][2];
#pragma unroll
        for (int m = 0; m < 4; ++m) { const size_t off = (size_t)(u.pm * BM + wr * 64 + m * 16 + fr) * ldc + col0;
#pragma unroll
            for (int bj = 0; bj < 2; ++bj)
#pragma unroll
                for (int n = 0; n < 2; ++n) pre[m][bj][n] = *(const f32x4*)(base + off + bj * HALF + n * 16); }
        const bool bad = st.run(acc, u, wr, wc, fr, fq, lds, wid, lane) || poison != 0u;
        const float qnan = __builtin_nanf("");
#pragma unroll
        for (int ai = 0; ai < 2; ++ai)
#pragma unroll
            for (int m = 0; m < 4; ++m) { const int r = ai * HALF + wr * 64 + m * 16 + fr; const f32x2v sr = S[r]; const size_t off = (size_t)(u.pm * BM + r) * ldc + col0;
#pragma unroll
                for (int bj = 0; bj < 2; ++bj)
#pragma unroll
                    for (int n = 0; n < 2; ++n) { const f32x4 bs = ai == 0 ? pre[m][bj][n] : *(const f32x4*)(base + off + bj * HALF + n * 16); f32x4 o = bs + (acc[ai][bj][m][n] - sr.x) * sr.y;
                        if (bad) o = (f32x4){qnan, qnan, qnan, qnan}; *(f32x4*)(out + off + bj * HALF + n * 16) = o; }
                if (m & 1) asm volatile("" ::: "memory"); }
    }
};
struct EpiLnResLn {
    static constexpr bool PERM = false, AFTER_DRAIN = true;
    const float* base; float* out; bf16_t* xn; int ldc; const float* bias; PanelStats st1, st2; unsigned poison;
    __device__ __forceinline__ void fused(f32x4 (&acc)[2][2][4][2], const Unit& u, int wr, int wc, int fr, int fq, PG8_LAS unsigned char* lds, int wid, int lane) const {
        typedef float f32x2v __attribute__((ext_vector_type(2))); typedef unsigned u32x2v __attribute__((ext_vector_type(2)));
        const PG8_LAS f32x2v* S = (const PG8_LAS f32x2v*)(lds + 8192);
        const int col0 = u.pn * BM + wc * 32 + 4 * fq;
#pragma unroll
        for (int bj = 0; bj < 2; ++bj)
#pragma unroll
            for (int n = 0; n < 2; ++n) { const f32x4 bv = bias ? *(const f32x4*)(bias + col0 + bj * HALF + n * 16) : (f32x4){0.f, 0.f, 0.f, 0.f};
#pragma unroll
                for (int ai = 0; ai < 2; ++ai)
#pragma unroll
                    for (int m = 0; m < 4; ++m) acc[ai][bj][m][n] += bv; }
        bool bad = st1.run(acc, u, wr, wc, fr, fq, lds, wid, lane) || poison != 0u;
        const float qnan = __builtin_nanf("");
#pragma unroll
        for (int ai = 0; ai < 2; ++ai)
#pragma unroll
            for (int m = 0; m < 4; ++m) { const int r = ai * HALF + wr * 64 + m * 16 + fr; const f32x2v sr = S[r]; const size_t off = (size_t)(u.pm * BM + r) * ldc + col0;
#pragma unroll
                for (int bj = 0; bj < 2; ++bj)
#pragma unroll
                    for (int n = 0; n < 2; ++n) { const f32x4 bs = *(const f32x4*)(base + off + bj * HALF + n * 16); acc[ai][bj][m][n] = bs + (acc[ai][bj][m][n] - sr.x) * sr.y; }
                asm volatile("" : "+v"(acc[ai][0][m][0]), "+v"(acc[ai][0][m][1]), "+v"(acc[ai][1][m][0]), "+v"(acc[ai][1][m][1]));
                if (m & 1) asm volatile("" ::: "memory"); }
        const bool bad1 = bad;
        bad = st2.run(acc, u, wr, wc, fr, fq, lds, wid, lane) || bad;
#pragma unroll
        for (int ai = 0; ai < 2; ++ai)
#pragma unroll
            for (int m = 0; m < 4; ++m) { const int r = ai * HALF + wr * 64 + m * 16 + fr; const f32x2v sr = S[r]; const size_t off = (size_t)(u.pm * BM + r) * ldc + col0;
#pragma unroll
                for (int bj = 0; bj < 2; ++bj)
#pragma unroll
                    for (int n = 0; n < 2; ++n) { const f32x4 x1 = acc[ai][bj][m][n]; *(f32x4*)(out + off + bj * HALF + n * 16) = bad1 ? (f32x4){qnan, qnan, qnan, qnan} : x1;
                        const f32x4 o = (x1 - sr.x) * sr.y; u32x2v w; w.x = cvt_pk_bf16(o[0], o[1]); w.y = cvt_pk_bf16(o[2], o[3]);
                        if (bad) { w.x = 0x7fc07fc0u; w.y = 0x7fc07fc0u; } *(u32x2v*)(xn + off + bj * HALF + n * 16) = w; }
                asm volatile("" ::: "memory"); }
    }
};

template <class Epi, class Sched, bool ALIGN_EPI = false, bool SP2 = false>
__device__ __forceinline__ void gemm_phase(PG8_LAS unsigned char* lds, const Gemm g, const Sched& S, const Epi& E) {
    const int tid = threadIdx.x, wid = __builtin_amdgcn_readfirstlane(tid >> 6), lane = tid & 63, wr = wid >> 2, wc = wid & 3, fr = lane & 15, fq = lane >> 4;
    const int K = g.K, nt = K / BK;
    unsigned voffA[2], voffB[2];
#pragma unroll
    for (int i = 0; i < 2; ++i) { int R, C; stage_rc(tid * 16 + i * 8192, R, C); const int Rb = Epi::PERM ? ((R & ~31) + perm32(R & 31)) : R;
        voffA[i] = (unsigned)(R * K + C) * 2u; voffB[i] = (unsigned)(Rb * K + C) * 2u; }
    const size_t kstep = (size_t)(BK * 2);
    const size_t hstep = (size_t)HALF * K * 2;
    const size_t tstep = 2 * hstep;
    const unsigned ldsw = (unsigned)wid * 1024u;
    const int aoff = lds_byte(wr * 64 + fr, fq * 8), boff = lds_byte(wc * 32 + fr, fq * 8);
#define PG8_SA(b, h) (((b) * 2 + (h)) * HTB)
#define PG8_SB(b, h) ((4 + (b) * 2 + (h)) * HTB)
#define PG8_STAGE(bufoff, gbase, voff) do { _Pragma("unroll") for (int _i = 0; _i < 2; ++_i) \
        __builtin_amdgcn_global_load_lds((const unsigned*)((const char*)(gbase) + (voff)[_i]), (PG8_LAS unsigned*)(lds + (bufoff) + ldsw + _i * 8192), 16, 0, 0); } while (0)
#define PG8_LDA(dst, b, h) do { _Pragma("unroll") for (int m = 0; m < 4; ++m) _Pragma("unroll") for (int k = 0; k < 2; ++k) dst[m][k] = *(const PG8_LAS bf16x8*)(lds + PG8_SA(b, h) + aoff + m * 2048 + k * 1024); } while (0)
#define PG8_LDB(dst, b, h) do { _Pragma("unroll") for (int n = 0; n < 2; ++n) _Pragma("unroll") for (int k = 0; k < 2; ++k) dst[n][k] = *(const PG8_LAS bf16x8*)(lds + PG8_SB(b, h) + boff + n * 2048 + k * 1024); } while (0)
#define PG8_MMA(ai, bj, At, Bt) do { __builtin_amdgcn_s_setprio(1); _Pragma("unroll") for (int m = 0; m < 4; ++m) _Pragma("unroll") for (int n = 0; n < 2; ++n) _Pragma("unroll") for (int k = 0; k < 2; ++k) \
        acc[ai][bj][m][n] = __builtin_amdgcn_mfma_f32_16x16x32_bf16(Bt[n][k], At[m][k], acc[ai][bj][m][n], 0, 0, 0); __builtin_amdgcn_s_setprio(0); } while (0)
#define PG8_WAIT_V(n) asm volatile("s_waitcnt vmcnt(" #n ")" ::: "memory")
#define PG8_WAIT_L(n) asm volatile("s_waitcnt lgkmcnt(" #n ")" ::: "memory")
#define PG8_BAR __builtin_amdgcn_s_barrier()
#define PG8_SCHED __builtin_amdgcn_sched_barrier(0)
    Unit cur, nxt; int ui = 0;
    if (!S.next(0, cur)) return;
    f32x4 acc[2][2][4][2];
#pragma unroll
    for (int a = 0; a < 2; ++a)
#pragma unroll
        for (int b = 0; b < 2; ++b)
#pragma unroll
            for (int m = 0; m < 4; ++m)
#pragma unroll
                for (int n = 0; n < 2; ++n) acc[a][b][m][n] = (f32x4){0.f, 0.f, 0.f, 0.f};
    bf16x8 At[4][2], B0[2][2], B1[2][2];
    const char* cA = (const char*)g.A + (size_t)cur.pm * tstep; const char* cB = (const char*)g.Bt + (size_t)cur.pn * tstep;
    S.a_ready(cur);
    if constexpr (SP2) {
        PG8_STAGE(PG8_SB(0, 0), cB, voffB); PG8_STAGE(PG8_SB(0, 1), cB + hstep, voffB); PG8_STAGE(PG8_SA(0, 0), cA, voffA); PG8_STAGE(PG8_SA(0, 1), cA + hstep, voffA);
        if (wr == 1) PG8_BAR;
        PG8_WAIT_V(2); PG8_BAR;
        PG8_STAGE(PG8_SB(1, 0), cB + kstep, voffB); PG8_STAGE(PG8_SA(1, 0), cA + kstep, voffA); PG8_STAGE(PG8_SB(1, 1), cB + hstep + kstep, voffB);
        PG8_WAIT_V(6); PG8_BAR;
    } else {
        PG8_STAGE(PG8_SB(0, 0), cB, voffB); PG8_STAGE(PG8_SA(0, 0), cA, voffA); PG8_STAGE(PG8_SB(0, 1), cB + hstep, voffB); PG8_STAGE(PG8_SA(0, 1), cA + hstep, voffA);
        if (wr == 1) PG8_BAR;
        PG8_WAIT_V(4); PG8_BAR;
        PG8_STAGE(PG8_SB(1, 0), cB + kstep, voffB); PG8_STAGE(PG8_SA(1, 0), cA + kstep, voffA); PG8_STAGE(PG8_SB(1, 1), cB + hstep + kstep, voffB);
        PG8_WAIT_V(6); PG8_BAR;
    }
    for (;;) {
        const bool has_next = S.next(ui + 1, nxt);
        const char* nA = has_next ? (const char*)g.A + (size_t)nxt.pm * tstep : cA; const char* nB = has_next ? (const char*)g.Bt + (size_t)nxt.pn * tstep : cB;
        for (int t = 0; t < nt; t += 2) {
            const bool last = (t == nt - 2);
            const char* a1 = cA + (size_t)(t + 1) * kstep;
            const char* a2 = last ? nA : cA + (size_t)(t + 2) * kstep; const char* b2 = last ? nB : cB + (size_t)(t + 2) * kstep;
            const char* a3 = a2 + kstep; const char* b3 = b2 + kstep;
            if (last && has_next) S.a_ready(nxt);
            if constexpr (SP2) {
            PG8_LDB(B0, 0, 0); PG8_LDB(B1, 0, 1); PG8_SCHED; PG8_LDA(At, 0, 0); PG8_STAGE(PG8_SA(1, 1), a1 + hstep, voffA);
            PG8_WAIT_V(8); PG8_WAIT_L(0); PG8_BAR; PG8_MMA(0, 0, At, B0); PG8_MMA(0, 1, At, B1); PG8_BAR; PG8_SCHED;
            PG8_LDA(At, 0, 1); PG8_STAGE(PG8_SB(0, 0), b2, voffB); PG8_STAGE(PG8_SB(0, 1), b2 + hstep, voffB); PG8_STAGE(PG8_SA(0, 0), a2, voffA);
            PG8_WAIT_V(8); PG8_WAIT_L(0); PG8_BAR; PG8_MMA(1, 0, At, B0); PG8_MMA(1, 1, At, B1); PG8_BAR; PG8_SCHED;
            PG8_LDB(B0, 1, 0); PG8_LDB(B1, 1, 1); PG8_SCHED; PG8_LDA(At, 1, 0); PG8_STAGE(PG8_SA(0, 1), a2 + hstep, voffA);
            PG8_WAIT_V(8); PG8_WAIT_L(0); PG8_BAR; PG8_MMA(0, 0, At, B0); PG8_MMA(0, 1, At, B1); PG8_BAR; PG8_SCHED;
            PG8_LDA(At, 1, 1); PG8_STAGE(PG8_SB(1, 0), b3, voffB); PG8_STAGE(PG8_SB(1, 1), b3 + hstep, voffB); PG8_STAGE(PG8_SA(1, 0), a3, voffA);
            PG8_WAIT_V(8); PG8_WAIT_L(0); PG8_BAR; PG8_MMA(1, 0, At, B0); PG8_MMA(1, 1, At, B1); PG8_BAR; PG8_SCHED;
            } else {
            PG8_LDB(B0, 0, 0); PG8_SCHED; PG8_LDA(At, 0, 0); PG8_STAGE(PG8_SA(1, 1), a1 + hstep, voffA);
            PG8_WAIT_L(8); PG8_BAR; PG8_WAIT_L(0); PG8_MMA(0, 0, At, B0); PG8_BAR; PG8_SCHED;
            PG8_LDB(B1, 0, 1); PG8_STAGE(PG8_SB(0, 0), b2, voffB);
            PG8_BAR; PG8_WAIT_L(0); PG8_MMA(0, 1, At, B1); PG8_BAR;
            PG8_LDA(At, 0, 1); PG8_STAGE(PG8_SA(0, 0), a2, voffA);
            PG8_BAR; PG8_WAIT_L(0); PG8_MMA(1, 0, At, B0); PG8_BAR; PG8_SCHED;
            PG8_STAGE(PG8_SB(0, 1), b2 + hstep, voffB);
            PG8_WAIT_V(6); PG8_BAR; PG8_MMA(1, 1, At, B1); PG8_BAR;
            PG8_LDB(B0, 1, 0); PG8_SCHED; PG8_LDA(At, 1, 0); PG8_STAGE(PG8_SA(0, 1), a2 + hstep, voffA);
            PG8_WAIT_L(8); PG8_BAR; PG8_WAIT_L(0); PG8_MMA(0, 0, At, B0); PG8_BAR; PG8_SCHED;
            PG8_LDB(B1, 1, 1); PG8_STAGE(PG8_SB(1, 0), b3, voffB);
            PG8_BAR; PG8_WAIT_L(0); PG8_MMA(0, 1, At, B1); PG8_BAR;
            PG8_LDA(At, 1, 1); PG8_STAGE(PG8_SA(1, 0), a3, voffA);
            PG8_BAR; PG8_WAIT_L(0); PG8_MMA(1, 0, At, B0); PG8_BAR; PG8_SCHED;
            PG8_STAGE(PG8_SB(1, 1), b3 + hstep, voffB);
            PG8_WAIT_V(6); PG8_BAR; PG8_MMA(1, 1, At, B1); PG8_BAR;
            }
        }
        if constexpr (ALIGN_EPI) { if (wr == 0) PG8_BAR; }
        if constexpr (!Epi::AFTER_DRAIN) { E(acc, cur, wr, wc, fr, fq); S.done(cur); }
        if (!has_next) break;
#pragma unroll
        for (int a = 0; a < 2; ++a)
#pragma unroll
            for (int b = 0; b < 2; ++b)
#pragma unroll
                for (int m = 0; m < 4; ++m)
#pragma unroll
                    for (int n = 0; n < 2; ++n) acc[a][b][m][n] = (f32x4){0.f, 0.f, 0.f, 0.f};
        cur = nxt; cA = nA; cB = nB; ++ui;
        if constexpr (ALIGN_EPI) { if (wr == 1) PG8_BAR; }
    }
    PG8_WAIT_V(0);
    if constexpr (!ALIGN_EPI) { if (wr == 0) PG8_BAR; }
    PG8_BAR;
    if constexpr (Epi::AFTER_DRAIN) { E.fused(acc, cur, wr, wc, fr, fq, lds, wid, lane); S.done(cur); }
#undef PG8_SA
#undef PG8_SB
#undef PG8_STAGE
#undef PG8_LDA
#undef PG8_LDB
#undef PG8_MMA
#undef PG8_WAIT_V
#undef PG8_WAIT_L
#undef PG8_BAR
#undef PG8_SCHED
}
}
namespace pg8 {
template <class Epi, class Sched, bool ALIGN_EPI, bool GATHER, bool KSPLIT>
__device__ __forceinline__ void gemm_phase2(PG8_LAS unsigned char* lds, const int K, const int ldb, const Sched& S, const Epi& E, const int tid) {
    typedef typename Sched::UnitT UnitT;
    const int wid = __builtin_amdgcn_readfirstlane(tid >> 6), lane = tid & 63, wr = wid >> 2, wc = wid & 3, fr = lane & 15, fq = lane >> 4;
    const int nt = K / BK, nth = nt / 2;
    int R[2], C[2]; unsigned voffB[2];
#pragma unroll
    for (int i = 0; i < 2; ++i) { stage_rc(tid * 16 + i * 8192, R[i], C[i]); const int Rb = Epi::PERM ? ((R[i] & ~31) + perm32(R[i] & 31)) : R[i]; voffB[i] = (unsigned)(Rb * ldb + C[i]) * 2u; }
    const size_t kstep = (size_t)(BK * 2);
    const size_t hstepB = (size_t)HALF * ldb * 2;
    const unsigned ldsw = (unsigned)wid * 1024u;
    const int aoff = lds_byte(wr * 64 + fr, fq * 8), boff = lds_byte(wc * 32 + fr, fq * 8);
#define PG8_SA(b, h) (((b) * 2 + (h)) * HTB)
#define PG8_SB(b, h) ((4 + (b) * 2 + (h)) * HTB)
#define PG8_STAGE(bufoff, gbase, voff) do { _Pragma("unroll") for (int _i = 0; _i < 2; ++_i) \
        __builtin_amdgcn_global_load_lds((const unsigned*)((const char*)(gbase) + (voff)[_i]), (PG8_LAS unsigned*)(lds + (bufoff) + ldsw + _i * 8192), 16, 0, 0); } while (0)
#define PG8_LDA(dst, b, h) do { _Pragma("unroll") for (int m = 0; m < 4; ++m) _Pragma("unroll") for (int k = 0; k < 2; ++k) dst[m][k] = *(const PG8_LAS bf16x8*)(lds + PG8_SA(b, h) + aoff + m * 2048 + k * 1024); } while (0)
#define PG8_LDB(dst, b, h) do { _Pragma("unroll") for (int n = 0; n < 2; ++n) _Pragma("unroll") for (int k = 0; k < 2; ++k) dst[n][k] = *(const PG8_LAS bf16x8*)(lds + PG8_SB(b, h) + boff + n * 2048 + k * 1024); } while (0)
#define PG8_MMA(ai, bj, At, Bt) do { __builtin_amdgcn_s_setprio(1); _Pragma("unroll") for (int m = 0; m < 4; ++m) _Pragma("unroll") for (int n = 0; n < 2; ++n) _Pragma("unroll") for (int k = 0; k < 2; ++k) \
        acc[ai][bj][m][n] = __builtin_amdgcn_mfma_f32_16x16x32_bf16(Bt[n][k], At[m][k], acc[ai][bj][m][n], 0, 0, 0); __builtin_amdgcn_s_setprio(0); } while (0)
#define PG8_WAIT_V(n) asm volatile("s_waitcnt vmcnt(" #n ")" ::: "memory")
#define PG8_WAIT_L(n) asm volatile("s_waitcnt lgkmcnt(" #n ")" ::: "memory")
#define PG8_BAR __builtin_amdgcn_s_barrier()
#define PG8_SCHED __builtin_amdgcn_sched_barrier(0)
#define PG8_BK(cb, cb2, kt) ((KSPLIT && (kt) >= nth) ? (cb2) + (size_t)((kt) - nth) * kstep : (cb) + (size_t)(kt) * kstep)
    UnitT cur, nxt; int ui = 0;
    if (!S.next(0, cur)) return;
    f32x4 acc[2][2][4][2];
#pragma unroll
    for (int a = 0; a < 2; ++a)
#pragma unroll
        for (int b = 0; b < 2; ++b)
#pragma unroll
            for (int m = 0; m < 4; ++m)
#pragma unroll
                for (int n = 0; n < 2; ++n) acc[a][b][m][n] = (f32x4){0.f, 0.f, 0.f, 0.f};
    bf16x8 At[4][2], B0[2][2], B1[2][2];
    unsigned vA[2][2], vAn[2][2];
    S.arows(cur, R, C, vA);
#pragma unroll
    for (int h = 0; h < 2; ++h)
#pragma unroll
        for (int i = 0; i < 2; ++i) vAn[h][i] = vA[h][i];
    const char* cA = S.aptr(cur); const char* cB = S.bptr(cur); const char* cB2 = KSPLIT ? S.bptr2(cur) : cB;
    PG8_STAGE(PG8_SB(0, 0), cB, voffB); PG8_STAGE(PG8_SB(0, 1), cB + hstepB, voffB); PG8_STAGE(PG8_SA(0, 0), cA, vA[0]); PG8_STAGE(PG8_SA(0, 1), cA, vA[1]);
    if (wr == 1) PG8_BAR;
    PG8_WAIT_V(2); PG8_BAR;
    PG8_STAGE(PG8_SB(1, 0), PG8_BK(cB, cB2, 1), voffB); PG8_STAGE(PG8_SA(1, 0), cA + kstep, vA[0]); PG8_STAGE(PG8_SB(1, 1), PG8_BK(cB, cB2, 1) + hstepB, voffB);
    PG8_WAIT_V(6); PG8_BAR;
    for (;;) {
        const bool has_next = S.next(ui + 1, nxt);
        const char* nA = has_next ? S.aptr(nxt) : cA; const char* nB = has_next ? S.bptr(nxt) : cB; const char* nB2 = (KSPLIT && has_next) ? S.bptr2(nxt) : cB2;
        if (GATHER && has_next) S.arows(nxt, R, C, vAn);
        for (int t = 0; t < nt; t += 2) {
            const bool last = (t == nt - 2);
            const char* a1 = cA + (size_t)(t + 1) * kstep;
            const char* a2 = last ? nA : cA + (size_t)(t + 2) * kstep;
            const char* b2 = last ? nB : PG8_BK(cB, cB2, t + 2);
            const char* b3 = last ? (KSPLIT ? PG8_BK(nB, nB2, 1) : nB + kstep) : PG8_BK(cB, cB2, t + 3);
            const char* a3 = a2 + kstep;
            PG8_LDB(B0, 0, 0); PG8_LDB(B1, 0, 1); PG8_SCHED; PG8_LDA(At, 0, 0); PG8_STAGE(PG8_SA(1, 1), a1, vA[1]);
            PG8_WAIT_V(8); PG8_WAIT_L(0); PG8_BAR; PG8_MMA(0, 0, At, B0); PG8_MMA(0, 1, At, B1); PG8_BAR; PG8_SCHED;
            if (GATHER && last) {
#pragma unroll
                for (int h = 0; h < 2; ++h)
#pragma unroll
                    for (int i = 0; i < 2; ++i) vA[h][i] = vAn[h][i]; }
            PG8_LDA(At, 0, 1); PG8_STAGE(PG8_SB(0, 0), b2, voffB); PG8_STAGE(PG8_SB(0, 1), b2 + hstepB, voffB); PG8_STAGE(PG8_SA(0, 0), a2, vA[0]);
            PG8_WAIT_V(8); PG8_WAIT_L(0); PG8_BAR; PG8_MMA(1, 0, At, B0); PG8_MMA(1, 1, At, B1); PG8_BAR; PG8_SCHED;
            PG8_LDB(B0, 1, 0); PG8_LDB(B1, 1, 1); PG8_SCHED; PG8_LDA(At, 1, 0); PG8_STAGE(PG8_SA(0, 1), a2, vA[1]);
            PG8_WAIT_V(8); PG8_WAIT_L(0); PG8_BAR; PG8_MMA(0, 0, At, B0); PG8_MMA(0, 1, At, B1); PG8_BAR; PG8_SCHED;
            PG8_LDA(At, 1, 1); PG8_STAGE(PG8_SB(1, 0), b3, voffB); PG8_STAGE(PG8_SB(1, 1), b3 + hstepB, voffB); PG8_STAGE(PG8_SA(1, 0), a3, vA[0]);
            PG8_WAIT_V(8); PG8_WAIT_L(0); PG8_BAR; PG8_MMA(1, 0, At, B0); PG8_MMA(1, 1, At, B1); PG8_BAR; PG8_SCHED;
        }
        if constexpr (ALIGN_EPI) { if (wr == 0) PG8_BAR; }
        if constexpr (!Epi::AFTER_DRAIN) { E(acc, cur, wr, wc, fr, fq); }
        if (!has_next) break;
#pragma unroll
        for (int a = 0; a < 2; ++a)
#pragma unroll
            for (int b = 0; b < 2; ++b)
#pragma unroll
                for (int m = 0; m < 4; ++m)
#pragma unroll
                    for (int n = 0; n < 2; ++n) acc[a][b][m][n] = (f32x4){0.f, 0.f, 0.f, 0.f};
        cur = nxt; cA = nA; cB = nB; cB2 = nB2; ++ui;
        if constexpr (ALIGN_EPI) { if (wr == 1) PG8_BAR; }
    }
    PG8_WAIT_V(0);
    if constexpr (!ALIGN_EPI) { if (wr == 0) PG8_BAR; }
    PG8_BAR;
    if constexpr (Epi::AFTER_DRAIN) { E.fused(acc, cur, wr, wc, fr, fq, lds, wid, lane); }
#undef PG8_SA
#undef PG8_SB
#undef PG8_STAGE
#undef PG8_LDA
#undef PG8_LDB
#undef PG8_MMA
#undef PG8_WAIT_V
#undef PG8_WAIT_L
#undef PG8_BAR
#undef PG8_SCHED
#undef PG8_BK
}
}
namespace pg8 {
DEVFN unsigned pkbf(float lo, float hi) { return cvt_pk_bf16(lo, hi); }
struct DenseSched {
    typedef Unit UnitT;
    StaticOrder so; const char* A; const char* Bt; int lda, ldb;
    DEVFN bool next(int i, Unit& u) const { return so.next(i, u); }
    DEVFN const char* aptr(const Unit& u) const { return A + (size_t)u.pm * BM * lda * 2; }
    DEVFN void arows(const Unit&, const int (&R)[2], const int (&C)[2], unsigned (&v)[2][2]) const {
#pragma unroll
        for (int h = 0; h < 2; ++h)
#pragma unroll
            for (int i = 0; i < 2; ++i) v[h][i] = (unsigned)((h * HALF + R[i]) * lda + C[i]) * 2u; }
    DEVFN const char* bptr(const Unit& u) const { return Bt + (size_t)u.pn * BM * ldb * 2; }
    DEVFN const char* bptr2(const Unit& u) const { return bptr(u); }
};
struct EpiInproj {
    static constexpr bool PERM = true, AFTER_DRAIN = false;
    bf16_t* O; const float* rope; float* kbar;
    DEVFN void operator()(f32x4 (&acc)[2][2][4][2], const Unit& u, int wr, int wc, int fr, int fq) const {
        const int pn = u.pn, row0 = u.pm * BM + wr * 64 + fr;
        if (pn < 4 && fq == 0) {
#pragma unroll
            for (int ai = 0; ai < 2; ++ai)
#pragma unroll
                for (int m = 0; m < 4; ++m) { const int t = (row0 + ai * HALF + m * 16) & (SEQ - 1); const f32x4* rp = (const f32x4*)(rope + t * 16);
#pragma unroll
                    for (int q = 0; q < 4; ++q) { const f32x4 cs = rp[q];
                        { const int d = 2 * q, n = d >> 2, e = d & 3; const float x1 = acc[ai][0][m][n][e], x2 = acc[ai][1][m][n][e]; acc[ai][0][m][n][e] = x1 * cs[0] - x2 * cs[1]; acc[ai][1][m][n][e] = x2 * cs[0] + x1 * cs[1]; }
                        { const int d = 2 * q + 1, n = d >> 2, e = d & 3; const float x1 = acc[ai][0][m][n][e], x2 = acc[ai][1][m][n][e]; acc[ai][0][m][n][e] = x1 * cs[2] - x2 * cs[3]; acc[ai][1][m][n][e] = x2 * cs[2] + x1 * cs[3]; } } }
        }
        if (pn == 2 || pn == 3) {
            float* kb = kbar + (size_t)((((u.pm >> 3) * NH + (pn - 2) * 4 + wc) * NBLK + (u.pm & 7)) * HD);
#pragma unroll
            for (int bj = 0; bj < 2; ++bj)
#pragma unroll
                for (int n = 0; n < 2; ++n)
#pragma unroll
                    for (int e = 0; e < 4; ++e) { float s = 0.f;
#pragma unroll
                        for (int ai = 0; ai < 2; ++ai)
#pragma unroll
                            for (int m = 0; m < 4; ++m) s += acc[ai][bj][m][n][e];
                        s = swz_xor_add(s, 1); s = swz_xor_add(s, 2); s = swz_xor_add(s, 4); s = swz_xor_add(s, 8);
                        if (fr == 0) atomicAdd(kb + (2 * fq + bj) * 8 + 4 * n + e, s * (1.f / MBLK)); }
        }
        const float sc = pn < 2 ? QSCALE : 1.f;
#pragma unroll
        for (int ai = 0; ai < 2; ++ai)
#pragma unroll
            for (int m = 0; m < 4; ++m) { bf16_t* rowp = O + (size_t)(row0 + ai * HALF + m * 16) * DIN + pn * BM + wc * 64;
#pragma unroll
                for (int bj = 0; bj < 2; ++bj) { const f32x4 v0 = acc[ai][bj][m][0] * sc, v1 = acc[ai][bj][m][1] * sc;
                    u32x4 w; w.x = pkbf(v0[0], v0[1]); w.y = pkbf(v0[2], v0[3]); w.z = pkbf(v1[0], v1[1]); w.w = pkbf(v1[2], v1[3]);
                    *(u32x4*)(rowp + (2 * fq + bj) * 8) = w; } }
    }
};
struct MoeUnit { int pm, pn, cls, j, cnt; };
struct MoeBase {
    const PG8_LAS int* tp; const PG8_LAS int* cnt; int nunits, G, c, npn_shift;
    DEVFN bool next_(int i, MoeUnit& u) const {
        const int L = i * G + c; if (L >= nunits) return false;
        u.pm = L >> npn_shift; u.pn = L & ((1 << npn_shift) - 1);
        int cls = 0; while (u.pm >= tp[cls + 1]) ++cls;
        u.cls = cls; u.j = u.pm - tp[cls]; u.cnt = cnt[cls]; return true; }
};
DEVFN void moe_experts(int cls, int& e1, int& e2) { const int g = cls / 6, p = cls % 6; const int lo = p < 3 ? 0 : (p < 5 ? 1 : 2), hi = p < 3 ? p + 1 : (p < 5 ? p - 1 : 3); e1 = g * 4 + lo; e2 = g * 4 + hi; }
struct GateUpSched : MoeBase {
    typedef MoeUnit UnitT;
    const char* HB; const int* list; const char* W;
    DEVFN bool next(int i, MoeUnit& u) const { return next_(i, u); }
    DEVFN const char* aptr(const MoeUnit&) const { return HB; }
    DEVFN void arows(const MoeUnit& u, const int (&R)[2], const int (&C)[2], unsigned (&v)[2][2]) const {
#pragma unroll
        for (int h = 0; h < 2; ++h)
#pragma unroll
            for (int i = 0; i < 2; ++i) { const int li = 256 * u.j + h * HALF + R[i]; const int tok = list[(size_t)u.cls * LISTCAP + (li < u.cnt ? li : 256 * u.j)]; v[h][i] = (unsigned)(tok * DM + C[i]) * 2u; } }
    DEVFN const char* bptr(const MoeUnit& u) const { int e1, e2; moe_experts(u.cls, e1, e2); return W + (size_t)(u.pn < 4 ? e1 : e2) * DM * DM * 2 + (size_t)(u.pn & 3) * BM * DM * 2; }
    DEVFN const char* bptr2(const MoeUnit& u) const { return bptr(u); }
};
struct DownSched : MoeBase {
    typedef MoeUnit UnitT;
    const char* ACT; const char* W;
    DEVFN bool next(int i, MoeUnit& u) const { return next_(i, u); }
    DEVFN const char* aptr(const MoeUnit& u) const { return ACT + (size_t)u.pm * BM * DM * 2; }
    DEVFN void arows(const MoeUnit&, const int (&R)[2], const int (&C)[2], unsigned (&v)[2][2]) const {
#pragma unroll
        for (int h = 0; h < 2; ++h)
#pragma unroll
            for (int i = 0; i < 2; ++i) v[h][i] = (unsigned)((h * HALF + R[i]) * DM + C[i]) * 2u; }
    DEVFN const char* bptr(const MoeUnit& u) const { int e1, e2; moe_experts(u.cls, e1, e2); return W + (size_t)e1 * DM * DE * 2 + (size_t)u.pn * BM * DE * 2; }
    DEVFN const char* bptr2(const MoeUnit& u) const { int e1, e2; moe_experts(u.cls, e1, e2); return W + (size_t)e2 * DM * DE * 2 + (size_t)u.pn * BM * DE * 2; }
};
struct EpiGateUp {
    static constexpr bool PERM = true, AFTER_DRAIN = false;
    bf16_t* ACT; const float* rw;
    DEVFN void operator()(f32x4 (&acc)[2][2][4][2], const MoeUnit& u, int wr, int wc, int fr, int fq) const {
        const int half = u.pn >> 2, jt = u.pn & 3;
#pragma unroll
        for (int ai = 0; ai < 2; ++ai)
#pragma unroll
            for (int m = 0; m < 4; ++m) { const int lr = ai * HALF + wr * 64 + m * 16 + fr, li = 256 * u.j + lr;
                const float wgt = li < u.cnt ? rw[((size_t)u.cls * LISTCAP + li) * 2 + half] : 0.f;
                f32x4 o[2];
#pragma unroll
                for (int n = 0; n < 2; ++n)
#pragma unroll
                    for (int e = 0; e < 4; ++e) { const float g = acc[ai][0][m][n][e]; o[n][e] = g * __builtin_amdgcn_rcpf(1.f + __expf(-g)) * acc[ai][1][m][n][e] * wgt; }
                u32x4 w; w.x = pkbf(o[0][0], o[0][1]); w.y = pkbf(o[0][2], o[0][3]); w.z = pkbf(o[1][0], o[1][1]); w.w = pkbf(o[1][2], o[1][3]);
                *(u32x4*)(ACT + (size_t)(u.pm * BM + lr) * DM + half * 512 + jt * 128 + wc * 32 + fq * 8) = w; }
    }
};
struct EpiDown {
    static constexpr bool PERM = true, AFTER_DRAIN = false;
    bf16_t* Y2; const int* list;
    DEVFN void operator()(f32x4 (&acc)[2][2][4][2], const MoeUnit& u, int wr, int wc, int fr, int fq) const {
#pragma unroll
        for (int ai = 0; ai < 2; ++ai)
#pragma unroll
            for (int m = 0; m < 4; ++m) { const int li = 256 * u.j + ai * HALF + wr * 64 + m * 16 + fr;
                if (li < u.cnt) { const int tok = list[(size_t)u.cls * LISTCAP + li]; bf16_t* rowp = Y2 + (size_t)tok * DM + u.pn * BM + wc * 32 + fq * 8;
#pragma unroll
                    for (int bj = 0; bj < 2; ++bj) { const f32x4 v0 = acc[ai][bj][m][0], v1 = acc[ai][bj][m][1];
                        u32x4 w; w.x = pkbf(v0[0], v0[1]); w.y = pkbf(v0[2], v0[3]); w.z = pkbf(v1[0], v1[1]); w.w = pkbf(v1[2], v1[3]);
                        *(u32x4*)(rowp + bj * HALF) = w; } } }
    }
};
}

#include <hip/hip_bf16.h>
#include <cmath>
namespace attn_body {
using bf16=__hip_bfloat16;
using bf16x8=__attribute__((ext_vector_type(8)))short;
using s16x4=__attribute__((ext_vector_type(4)))short;
using f32x16=__attribute__((ext_vector_type(16)))float;
using u32x4=__attribute__((ext_vector_type(4)))unsigned;
constexpr int BATCH=16,NHEAD=8,SEQ=2048,D=64,QP=2048,OP=1024;
constexpr int NW=8,QBLK=32,QB=QBLK*NW,KVBLK=64,NQB=SEQ/QB;
constexpr int ATTN_PITCH=QP, ATTN_UNIT_ROWS=QB;
__device__ __forceinline__ int crow(int r,int hi){return (r&3)+8*(r>>2)+4*hi;}
#define SBAR() __builtin_amdgcn_sched_barrier(0)
__device__ __forceinline__ void cmask(f32x16&p0,f32x16&p1,int jb,int qrel,int hi){
  const float NEG=-INFINITY; int kb=64*jb+4*hi;
  #pragma unroll
  for(int r=0;r<16;++r){int kv=kb+(r&3)+8*(r>>2); if(kv>qrel)p0[r]=NEG; if(kv+32>qrel)p1[r]=NEG;}
}

constexpr int NSLOT=3, SLOTB=8192;
constexpr int LDS_K=0, LDS_V=NSLOT*SLOTB, LDS_WS=2*NSLOT*SLOTB, LDS_OST=LDS_WS+NW*64*4, LDS_KBAR=LDS_OST+NW*4096, LDS_BYTES=LDS_KBAR+2048;
constexpr float NEGBIG=-1.0e30f; typedef float f32x4_t __attribute__((ext_vector_type(4)));
__device__ __forceinline__ float bfs(short v){return __uint_as_float(((unsigned)(unsigned short)v)<<16);}
constexpr float C2=0.125f*1.4426950408889634f;
__device__ __forceinline__ void glds16(const void*gsrc,unsigned lds_dst){unsigned keep;
  asm volatile("s_mov_b32 %0, m0\n\ts_mov_b32 m0, %2\n\ts_nop 0\n\tglobal_load_lds_dwordx4 %1, off\n\ts_mov_b32 m0, %0":"=&s"(keep):"v"(gsrc),"s"(lds_dst):"memory");}
__device__ __forceinline__ float max3f(float a,float b,float c){float r;asm("v_max3_f32 %0, %1, %2, %3":"=v"(r):"v"(a),"v"(b),"v"(c));return r;}
__device__ __forceinline__ float max2f(float a,float b){float r;asm("v_max_f32_e32 %0, %1, %2":"=v"(r):"v"(a),"v"(b));return r;}
__device__ __forceinline__ float fadd_s(float a,float b){float r;asm("v_add_f32_e32 %0, %1, %2":"=v"(r):"v"(a),"v"(b));return r;}
__device__ __forceinline__ float fsub_s(float a,float b){float r;asm("v_sub_f32_e32 %0, %1, %2":"=v"(r):"v"(a),"v"(b));return r;}
typedef float f32x2_t __attribute__((ext_vector_type(2))); typedef __bf16 bf16x2_t __attribute__((ext_vector_type(2)));
__device__ __forceinline__ unsigned cvtpk_s(float lo,float hi){f32x2_t v={lo,hi};bf16x2_t b=__builtin_convertvector(v,bf16x2_t);return __builtin_bit_cast(unsigned,b);}
#define WAIT_BAR(N) asm volatile("s_waitcnt vmcnt(" #N ") lgkmcnt(0)\n\ts_barrier":::"memory")

__device__ __forceinline__ void qkt(f32x16&p0,f32x16&p1,const char*Kslot,const bf16x8*qr,const f32x16&negm,int r32,int hi){
  const char*kb=Kslot+hi*1024+r32*16;
  #pragma unroll
  for(int d0=0;d0<4;++d0){
    const bf16x8 b0=*reinterpret_cast<const bf16x8*>(kb+d0*2048);
    const bf16x8 b1=*reinterpret_cast<const bf16x8*>(kb+d0*2048+512);
    if(d0==0){p0=__builtin_amdgcn_mfma_f32_32x32x16_bf16(b0,qr[0],negm,0,0,0);p1=__builtin_amdgcn_mfma_f32_32x32x16_bf16(b1,qr[0],negm,0,0,0);}
    else{p0=__builtin_amdgcn_mfma_f32_32x32x16_bf16(b0,qr[d0],p0,0,0,0);p1=__builtin_amdgcn_mfma_f32_32x32x16_bf16(b1,qr[d0],p1,0,0,0);}}
}
typedef __attribute__((address_space(3))) const char* lds_cptr;
typedef short v4i16_t __attribute__((ext_vector_type(4)));
__device__ __forceinline__ void kload8(bf16x8*kf,lds_cptr kp){
  kf[0]=*(const __attribute__((address_space(3))) bf16x8*)(kp);      kf[1]=*(const __attribute__((address_space(3))) bf16x8*)(kp+512);
  kf[2]=*(const __attribute__((address_space(3))) bf16x8*)(kp+2048); kf[3]=*(const __attribute__((address_space(3))) bf16x8*)(kp+2560);
  kf[4]=*(const __attribute__((address_space(3))) bf16x8*)(kp+4096); kf[5]=*(const __attribute__((address_space(3))) bf16x8*)(kp+4608);
  kf[6]=*(const __attribute__((address_space(3))) bf16x8*)(kp+6144); kf[7]=*(const __attribute__((address_space(3))) bf16x8*)(kp+6656);
}
__device__ __forceinline__ void kload2(bf16x8*kf,lds_cptr kp,int j){ kf[2*j]=*(const __attribute__((address_space(3))) bf16x8*)(kp+j*2048); kf[2*j+1]=*(const __attribute__((address_space(3))) bf16x8*)(kp+j*2048+512); }
__device__ __forceinline__ s16x4 vtr(lds_cptr p){ return __builtin_bit_cast(s16x4,__builtin_amdgcn_ds_read_tr16_b64_v4i16((__attribute__((address_space(3))) v4i16_t*)p)); }
__device__ __forceinline__ float rowmax(const f32x16&p0,const f32x16&p1){
  float a=max3f(p0[0],p0[1],p1[0]),b=max3f(p0[2],p0[3],p1[1]);a=max3f(a,p1[2],p1[3]);
  #pragma unroll
  for(int r=4;r<16;r+=4){a=max3f(a,p0[r],p0[r+1]);b=max3f(b,p0[r+2],p0[r+3]);a=max3f(a,p1[r],p1[r+1]);b=max3f(b,p1[r+2],p1[r+3]);}
  const float m=max2f(a,b);
  auto rr=__builtin_amdgcn_permlane32_swap(__float_as_uint(m),__float_as_uint(m),false,false);
  return max2f(__uint_as_float(rr[0]),__uint_as_float(rr[1]));
}
__device__ __forceinline__ void pv(f32x16*o,int vb,bf16x8 pa0,bf16x8 pa1,bf16x8 pa2,bf16x8 pa3){
  #pragma unroll
  for(int d0=0;d0<2;++d0){s16x4 lo[4],hi[4];
    #pragma unroll
    for(int ks=0;ks<4;++ks){
      asm volatile("ds_read_b64_tr_b16 %0,%1 offset:%c2":"=&v"(lo[ks]):"v"(vb),"i"(d0*4096+ks*1024):"memory");
      asm volatile("ds_read_b64_tr_b16 %0,%1 offset:%c2":"=&v"(hi[ks]):"v"(vb),"i"(d0*4096+ks*1024+512):"memory");}
    asm volatile("s_waitcnt lgkmcnt(0)":::"memory");SBAR();
    #define PK(k) (bf16x8){lo[k][0],lo[k][1],lo[k][2],lo[k][3],hi[k][0],hi[k][1],hi[k][2],hi[k][3]}
    o[d0]=__builtin_amdgcn_mfma_f32_32x32x16_bf16(pa0,PK(0),o[d0],0,0,0);
    o[d0]=__builtin_amdgcn_mfma_f32_32x32x16_bf16(pa1,PK(1),o[d0],0,0,0);
    o[d0]=__builtin_amdgcn_mfma_f32_32x32x16_bf16(pa2,PK(2),o[d0],0,0,0);
    o[d0]=__builtin_amdgcn_mfma_f32_32x32x16_bf16(pa3,PK(3),o[d0],0,0,0);
    #undef PK
  }
}

#ifndef ATTN_STORE16
#define ATTN_STORE16(p,v) (*(u32x4*)(p)=(v))
#endif
template<int THRL> __device__ __forceinline__ void attn_unit(int b,int h,int qb,const bf16*Q,const bf16*__restrict__ K,const bf16*__restrict__ V,bf16*O,const float*__restrict__ kbar,char*shm,const int tid){
  const int lane=tid&63,r32=lane&31,hi=lane>>5; const int wid=__builtin_amdgcn_readfirstlane(tid>>6);
  float kbv=0.f; { int tk=tid; asm volatile("":"+v"(tk)); if(qb>=4&&tk<448)kbv=kbar[tk]; }
  const long rowbase=(long)b*SEQ; const int q0=qb*QB;
  const bf16*Qw=Q+(rowbase+q0+wid*QBLK)*QP+h*D;
  const bf16*Kh=K+rowbase*QP+h*D,*Vh=V+rowbase*QP+h*D;
  const unsigned lds0=(unsigned)(uintptr_t)shm;
  float*wsf=(float*)(shm+LDS_WS)+wid*64;
  const bf16*ksrc=Kh+(long)lane*QP+wid*8;
  const bf16*vsrc=Vh+(long)(16*(wid&3)+(lane>>2))*QP+(wid>>2)*32+(lane&3)*8;
  const unsigned kdst=lds0+LDS_K+wid*1024, vdst=lds0+LDS_V+wid*1024;
  #define DMA_K(t,slot) glds16(ksrc+(long)(t)*KVBLK*QP,(unsigned)__builtin_amdgcn_readfirstlane(kdst+(slot)))
  #define DMA_V(t,slot) glds16(vsrc+(long)(t)*KVBLK*QP,(unsigned)__builtin_amdgcn_readfirstlane(vdst+(slot)))
  const int vb0=(int)(lds0+LDS_V)+((lane>>4)&1)*32+(lane&3)*8+(4*hi+((lane&15)>>2))*64;
  const char*Kbase=shm+LDS_K; bf16x8 kf[8];
  const lds_cptr shm3=(lds_cptr)shm; const lds_cptr kp0=shm3+LDS_K+hi*1024+r32*16; const lds_cptr vp0=shm3+LDS_V+((lane>>4)&1)*32+(lane&3)*8+(4*hi+((lane&15)>>2))*64;
  const int NT=(q0+QB)/KVBLK;
  DMA_K(0,0);DMA_V(0,0);DMA_K(1,SLOTB);
  bf16x8 qr[4];
  #pragma unroll
  for(int d0=0;d0<4;++d0)qr[d0]=*reinterpret_cast<const bf16x8*>(&Qw[(long)r32*QP+d0*16+hi*8]);
  float mhat=0.f,l_reg=0.f;f32x16 o[2];o[0]=f32x16{};o[1]=f32x16{};f32x16 negm=f32x16{};asm volatile("":"+v"(negm));
  const int qrel=wid*QBLK+r32;
  #define CMASK(P0,P1,t) do{int jb_=(t)-(NT-4); if(jb_>=0)cmask(P0,P1,jb_,qrel,hi);}while(0)
  bool resc=false;
  #define START(P0,P1) do{ const float rm=rowmax(P0,P1); resc=false; \
    { const float dl=selcur?rm:-64.f; mhat=fadd_s(mhat,dl); \
      _Pragma("unroll") for(int r=0;r<16;++r){P0[r]=fsub_s(P0[r],dl);P1[r]=fsub_s(P1[r],dl);} \
      { const float nv_=selcur?-mhat:NEGBIG; _Pragma("unroll") for(int r=0;r<16;++r)negm[r]=nv_; } asm volatile("":"+v"(negm)); } \
    _Pragma("unroll") for(int r=0;r<16;++r)P0[r]=__builtin_amdgcn_exp2f(P0[r]); }while(0)
  #define RESC() do{ if(resc){ asm volatile("s_waitcnt lgkmcnt(0)":::"memory"); \
      _Pragma("unroll") for(int d_=0;d_<2;++d_) _Pragma("unroll") for(int r=0;r<16;++r)o[d_][r]*=wsf[crow(r,hi)]; } }while(0)
  f32x16 pA0,pA1,pB0,pB1;
  int sl_prev=0,sl_cur=0,sl_next=SLOTB;
  #define ROT() do{sl_prev=sl_cur;sl_cur=sl_next;sl_next=(sl_next==(NSLOT-1)*SLOTB)?0:sl_next+SLOTB;}while(0)
  DMA_K(2,2*SLOTB);
  if(qb>=4){ if(tid<448){ const unsigned hb=__builtin_bit_cast(unsigned,kbv); const unsigned hr=(hb+0x7fffu+((hb>>16)&1u))&0xffff0000u; const float lo_=kbv-__builtin_bit_cast(float,hr); const unsigned lb=__builtin_bit_cast(unsigned,lo_);
      ((unsigned short*)(shm+LDS_KBAR))[tid]=(unsigned short)(hr>>16); ((unsigned short*)(shm+LDS_KBAR+1024))[tid]=(unsigned short)((lb+0x7fffu+((lb>>16)&1u))>>16); } }
  WAIT_BAR(3);
  unsigned bmask=(1u<<(qb+1))-1u;
  if(qb>=4){ float gsc[8];
    { const lds_cptr kb3=shm3+LDS_KBAR+(r32&7)*128+hi*16; f32x16 g=f32x16{};
      _Pragma("unroll") for(int d0=0;d0<4;++d0){ const bf16x8 ah=*(const __attribute__((address_space(3))) bf16x8*)(kb3+d0*32), al=*(const __attribute__((address_space(3))) bf16x8*)(kb3+1024+d0*32);
        g=__builtin_amdgcn_mfma_f32_32x32x16_bf16(ah,qr[d0],g,0,0,0); g=__builtin_amdgcn_mfma_f32_32x32x16_bf16(al,qr[d0],g,0,0,0); }
      _Pragma("unroll") for(int r=0;r<4;++r){ auto rr=__builtin_amdgcn_permlane32_swap(__float_as_uint(g[r]),__float_as_uint(g[r]),false,false); gsc[r]=__uint_as_float(rr[0]); gsc[4+r]=__uint_as_float(rr[1]); } }
    _Pragma("unroll") for(int n=0;n<7;++n) gsc[n]=(n<qb)?gsc[n]:-3.0e38f;
    bmask=1u<<qb;
    _Pragma("unroll") for(int pick=0;pick<3;++pick){ float best=-3.4e38f; unsigned bi=0u;
      _Pragma("unroll") for(int n=0;n<7;++n){ const bool ok=!((bmask>>n)&1u)&&gsc[n]>best; best=ok?gsc[n]:best; bi=ok?(unsigned)n:bi; }
      bmask|=1u<<bi; } }
  bool selcur=(bmask&1u)!=0u;
  { const float nv=selcur?0.f:NEGBIG; _Pragma("unroll") for(int r=0;r<16;++r)negm[r]=nv; asm volatile("":"+v"(negm)); }
  qkt(pA0,pA1,Kbase,qr,negm,r32,hi);asm volatile("s_nop 15\n\ts_nop 7":"+v"(pA0),"+v"(pA1));CMASK(pA0,pA1,0);
  START(pA0,pA1);
  _Pragma("unroll") for(int r=0;r<16;++r)pA1[r]=__builtin_amdgcn_exp2f(pA1[r]);
  WAIT_BAR(0);
  DMA_K(3,0);DMA_V(1,SLOTB);
  ROT();
  kload8(kf,kp0+sl_cur);
  WAIT_BAR(2);
  s16x4 vlo[8],vhi[8]; u32x4 pw0,pw1,pw2,pw3;
  #define PKW(P,B) cvtpk_s(P[B],P[B+1])
  #define PAF(k) __builtin_bit_cast(bf16x8,pw##k)
  #define VFR(i) (bf16x8){vlo[i][0],vlo[i][1],vlo[i][2],vlo[i][3],vhi[i][0],vhi[i][1],vhi[i][2],vhi[i][3]}
  #define PIN(x) asm volatile("":"+v"(x))
  #define MX3(a,b,c) __builtin_fmaxf(__builtin_fmaxf((a),(b)),(c))
  #define GAPA(MF,A0,A1,A2,A3,W0,W1,PW) do{ MF; sacc+=A0; sacc+=A1; sacc+=A2; sacc+=A3; PIN(sacc); W0; W1; PIN(PW); SBAR(); }while(0)
  #define EX(v) __builtin_amdgcn_exp2f(v)
  #define GAPB(MF,X,B) do{ MF; X[B]=EX(X[B]); X[B+1]=EX(X[B+1]); X[B+2]=EX(X[B+2]); X[B+3]=EX(X[B+3]); PIN(X); SBAR(); }while(0)
  #define VRD(i) do{ vlo[i]=vtr(vp_+(((i)>>2)*4096+((i)&3)*1024)); vhi[i]=vtr(vp_+(((i)>>2)*4096+((i)&3)*1024+512)); }while(0)
  #define KRD(G,j) do{ if(G){ kload2(kf,kp0+sl_next,j); SBAR(); } }while(0)
  #define STEP(C0,C1,P0,P1,t,GK,GV,GL) do{ SBAR(); \
    const lds_cptr vp_=vp0+sl_prev; \
    VRD(0); SBAR(); float sacc=(P0[0]+P0[1]); \
    GAPA(C0=__builtin_amdgcn_mfma_f32_32x32x16_bf16(kf[0],qr[0],negm,0,0,0), P0[2],P0[3],P0[4],P0[5],     pw0[0]=PKW(P0,0), pw0[1]=PKW(P0,2), pw0); \
    VRD(4); SBAR(); GAPA(C1=__builtin_amdgcn_mfma_f32_32x32x16_bf16(kf[1],qr[0],negm,0,0,0), P0[6],P0[7],P0[8],P0[9],     pw0[2]=PKW(P0,4), pw0[3]=PKW(P0,6), pw0); \
    VRD(1); SBAR(); GAPA(C0=__builtin_amdgcn_mfma_f32_32x32x16_bf16(kf[2],qr[1],C0,0,0,0),   P0[10],P0[11],P0[12],P0[13], pw1[0]=PKW(P0,8), pw1[1]=PKW(P0,10), pw1); \
    VRD(5); SBAR(); GAPA(C1=__builtin_amdgcn_mfma_f32_32x32x16_bf16(kf[3],qr[1],C1,0,0,0),   P0[14],P0[15],P1[0],P1[1],   pw1[2]=PKW(P0,12),pw1[3]=PKW(P0,14), pw1); \
    VRD(2); SBAR(); GAPA(C0=__builtin_amdgcn_mfma_f32_32x32x16_bf16(kf[4],qr[2],C0,0,0,0),   P1[2],P1[3],P1[4],P1[5],     pw2[0]=PKW(P1,0), pw2[1]=PKW(P1,2), pw2); \
    VRD(6); SBAR(); GAPA(C1=__builtin_amdgcn_mfma_f32_32x32x16_bf16(kf[5],qr[2],C1,0,0,0),   P1[6],P1[7],P1[8],P1[9],     pw2[2]=PKW(P1,4), pw2[3]=PKW(P1,6), pw2); \
    VRD(3); SBAR(); GAPA(C0=__builtin_amdgcn_mfma_f32_32x32x16_bf16(kf[6],qr[3],C0,0,0,0),   P1[10],P1[11],P1[12],P1[13], pw3[0]=PKW(P1,8), pw3[1]=PKW(P1,10), pw3); \
    VRD(7); SBAR(); GAPA(C1=__builtin_amdgcn_mfma_f32_32x32x16_bf16(kf[7],qr[3],C1,0,0,0),   P1[14],P1[15],0.f,0.f,       pw3[2]=PKW(P1,12),pw3[3]=PKW(P1,14), pw3); \
    l_reg+=sacc; \
    if(GK){DMA_K((t)+3,sl_cur);} if(GV){DMA_V((t)+1,sl_next);} \
    CMASK(C0,C1,t); \
    { float a=MX3(C0[0],C0[1],C1[0]),b=MX3(C0[2],C0[3],C1[1]); a=MX3(a,C1[2],C1[3]); \
      _Pragma("unroll") for(int r=4;r<16;r+=4){a=MX3(a,C0[r],C0[r+1]);b=MX3(b,C0[r+2],C0[r+3]);a=MX3(a,C1[r],C1[r+1]);b=MX3(b,C1[r+2],C1[r+3]);} \
      float rm=__builtin_fmaxf(a,b); { auto rr=__builtin_amdgcn_permlane32_swap(__float_as_uint(rm),__float_as_uint(rm),false,false); rm=__builtin_fmaxf(__uint_as_float(rr[0]),__uint_as_float(rr[1])); } \
      resc=false; \
      if(__builtin_expect(__any(rm>(float)THRL),0)){ const float dl=__builtin_fmaxf(rm,0.f); mhat+=dl; \
        _Pragma("unroll") for(int r=0;r<16;++r){C0[r]-=dl;C1[r]-=dl;} \
        { const float nv_=selcur?-mhat:NEGBIG; _Pragma("unroll") for(int r=0;r<16;++r)negm[r]=nv_; } asm volatile("":"+v"(negm)); \
        const float f=__builtin_amdgcn_exp2f(-dl); l_reg*=f; if(hi==0)wsf[r32]=f; resc=true; } } \
    SBAR(); \
    GAPB(o[0]=__builtin_amdgcn_mfma_f32_32x32x16_bf16(PAF(0),VFR(0),o[0],0,0,0), C0,0); \
    GAPB(o[1]=__builtin_amdgcn_mfma_f32_32x32x16_bf16(PAF(0),VFR(4),o[1],0,0,0), C0,4); \
    KRD(GL,0); GAPB(o[0]=__builtin_amdgcn_mfma_f32_32x32x16_bf16(PAF(1),VFR(1),o[0],0,0,0), C0,8); \
    KRD(GL,1); GAPB(o[1]=__builtin_amdgcn_mfma_f32_32x32x16_bf16(PAF(1),VFR(5),o[1],0,0,0), C0,12); \
    KRD(GL,2); GAPB(o[0]=__builtin_amdgcn_mfma_f32_32x32x16_bf16(PAF(2),VFR(2),o[0],0,0,0), C1,0); \
    KRD(GL,3); GAPB(o[1]=__builtin_amdgcn_mfma_f32_32x32x16_bf16(PAF(2),VFR(6),o[1],0,0,0), C1,4); \
    GAPB(o[0]=__builtin_amdgcn_mfma_f32_32x32x16_bf16(PAF(3),VFR(3),o[0],0,0,0), C1,8); \
    GAPB(o[1]=__builtin_amdgcn_mfma_f32_32x32x16_bf16(PAF(3),VFR(7),o[1],0,0,0), C1,12); \
    }while(0)
  #define BLKSEL(tt) do{ if((((tt))&3)==0){ selcur=((bmask>>((tt)>>2))&1u)!=0u; const float nv_=selcur?-mhat:NEGBIG; _Pragma("unroll") for(int r=0;r<16;++r)negm[r]=nv_; asm volatile("":"+v"(negm)); } }while(0)
  int t=1;
  #undef CMASK
  #define CMASK(P0,P1,t) do{}while(0)
  for(;t+5<NT;t+=2){
    STEP(pB0,pB1,pA0,pA1,t,true,true,true);     WAIT_BAR(2); RESC(); ROT(); BLKSEL(t+1);
    STEP(pA0,pA1,pB0,pB1,t+1,true,true,true);   WAIT_BAR(2); RESC(); ROT();
  }
  #undef CMASK
  #define CMASK(P0,P1,t) do{int jb_=(t)-(NT-4); if(jb_>=0)cmask(P0,P1,jb_,qrel,hi);}while(0)
  #define ENDW(tt) do{ if((tt)+3<NT){WAIT_BAR(2);} else if((tt)+2<NT){WAIT_BAR(1);} else {WAIT_BAR(0);} }while(0)
  for(;t+1<NT;t+=2){
    STEP(pB0,pB1,pA0,pA1,t,(t+3<NT),(t+1<NT),(t+1<NT));       ENDW(t);   RESC(); ROT(); BLKSEL(t+1);
    STEP(pA0,pA1,pB0,pB1,t+1,(t+4<NT),(t+2<NT),(t+2<NT));     ENDW(t+1); RESC(); ROT();
  }
  STEP(pB0,pB1,pA0,pA1,NT-1,false,false,false); RESC();
  { float sacc=pB0[0]+pB0[1]; _Pragma("unroll") for(int r=2;r<16;++r)sacc+=pB0[r]; _Pragma("unroll") for(int r=0;r<16;++r)sacc+=pB1[r]; l_reg+=sacc;
    pw0=(u32x4){PKW(pB0,0),PKW(pB0,2),PKW(pB0,4),PKW(pB0,6)};pw1=(u32x4){PKW(pB0,8),PKW(pB0,10),PKW(pB0,12),PKW(pB0,14)};pw2=(u32x4){PKW(pB1,0),PKW(pB1,2),PKW(pB1,4),PKW(pB1,6)};pw3=(u32x4){PKW(pB1,8),PKW(pB1,10),PKW(pB1,12),PKW(pB1,14)};
    SBAR(); pv(o,vb0+sl_cur,PAF(0),PAF(1),PAF(2),PAF(3)); }
  #undef PKW
  #undef PAF
  #undef VFR
  #undef PIN
  #undef MX3
  #undef GAPA
  #undef GAPB
  #undef EX
  #undef VRD
  #undef KRD
  #undef STEP
  #undef ENDW
  {auto rr=__builtin_amdgcn_permlane32_swap(__float_as_uint(l_reg),__float_as_uint(l_reg),false,false);l_reg=__uint_as_float(rr[0])+__uint_as_float(rr[1]);}
  if(hi==0)wsf[32+r32]=l_reg;asm volatile("s_waitcnt lgkmcnt(0)":::"memory");
  float rli[16];
  #pragma unroll
  for(int r=0;r<16;++r)rli[r]=__builtin_amdgcn_rcpf(wsf[32+crow(r,hi)]);
  bf16*Ow=O+(rowbase+q0+wid*QBLK)*OP+h*D;
  { bf16*stg=(bf16*)(shm+LDS_OST)+wid*2048;
    #pragma unroll
    for(int r=0;r<16;++r){const int orow=crow(r,hi);
      #pragma unroll
      for(int d0=0;d0<2;++d0)stg[orow*64+d0*32+r32]=__float2bfloat16(o[d0][r]*rli[r]);}
    asm volatile("s_waitcnt lgkmcnt(0)":::"memory");
    #pragma unroll
    for(int i=0;i<4;++i){const int row=i*8+(lane>>3),ch=lane&7; const u32x4 v=*(const u32x4*)(stg+row*64+ch*8); ATTN_STORE16(Ow+(long)row*OP+ch*8,v);} }
  asm volatile("s_waitcnt lgkmcnt(0)\n\ts_barrier":::"memory");
  #undef BLKSEL
  #undef DMA_K
  #undef DMA_V
  #undef CMASK
  #undef START
  #undef RESC
  #undef ROT
}
constexpr int ATTN_LDS_BYTES=LDS_BYTES;
struct AttnTensors { const bf16* Q; const bf16* K; const bf16* V; bf16* O; const float* kbar; };
struct AttnUnit { int bh; int qb; };
struct StaticOrder {
  int vcu, G;
  __device__ __forceinline__ explicit StaticOrder(int grid,int block):vcu((grid%8==0)?(block%8)*(grid/8)+block/8:block),G(grid){}
  __device__ __forceinline__ bool next(int i,AttnUnit&u)const{ const int pr=(vcu+(i>>2)*G)*2+((i>>1)&1); if(pr>=BATCH*NHEAD*4)return false;
    const int s=pr&3; u.bh=pr>>2; u.qb=(i&1)?7-s:s; return true; }
  __device__ __forceinline__ void a_ready(const AttnUnit&)const{}
  __device__ __forceinline__ void done(const AttnUnit&)const{}
};
template<class Sched,int THRL=8> __device__ __forceinline__ void attn_phase(char*lds,const AttnTensors&T,const Sched&S,const int tid_in){
  AttnUnit u; int tid_=tid_in; asm volatile("":"+v"(tid_));
  for(int i=0;S.next(i,u);++i){ S.a_ready(u); attn_unit<THRL>(u.bh/NHEAD,u.bh%NHEAD,u.qb,T.Q,T.K,T.V,T.O,T.kbar+(long)u.bh*512,lds,tid_); S.done(u); }
}
#undef SBAR
#undef WAIT_BAR
}

#define XB_TMO      128
#define XB_XCNT(j)  (256  + 64 * (j))
#define XB_XSUB(j)  (1280 + 64 * (j))
#define XB_XGEN(j)  (2304 + 64 * (j))
#define XB_TOP      3328
#define XB_TOPGEN   3392
#define XCD_BAR_WORDS 3456
#define XB_SPIN_CAP (1u << 18)

__device__ __forceinline__ unsigned xb_ld(unsigned* p)              { return __hip_atomic_load(p, __ATOMIC_RELAXED, __HIP_MEMORY_SCOPE_AGENT); }
__device__ __forceinline__ unsigned xb_add(unsigned* p, unsigned v) { return __hip_atomic_fetch_add(p, v, __ATOMIC_RELAXED, __HIP_MEMORY_SCOPE_AGENT); }
__device__ __forceinline__ unsigned xb_xcc_id() { return (unsigned)__builtin_amdgcn_s_getreg((3 << 11) | 20) & 0xFu; }
#define XB_SPIN(cond, bar) do { unsigned _sp = 0; while (cond) { __builtin_amdgcn_s_sleep(1); \
    if ((++_sp & 255u) == 0u) { if (xb_ld(&(bar)[XB_TMO])) break; if (_sp > XB_SPIN_CAP) { atomicAdd(&(bar)[XB_TMO], 1u); break; } } } } while (0)

struct XcdBarrier {
    unsigned* bar; unsigned x;
    volatile LAS unsigned* st;
};

__device__ __forceinline__ XcdBarrier xcd_barrier_post(unsigned* bar, volatile LAS unsigned* st) {
    XcdBarrier b; b.bar = bar; b.x = xb_xcc_id(); b.st = st;
    if (threadIdx.x == 0) (void)xb_add(&bar[XB_XCNT(b.x)], 1u);
    return b;
}
__device__ __forceinline__ void xcd_barrier_complete(unsigned* bar, unsigned x, unsigned& nloc, unsigned& nx) {
    const unsigned G = gridDim.x * gridDim.y * gridDim.z;
    unsigned sum, cnt, mine, sp = 0u;
    for (;;) {
        sum = 0u; cnt = 0u; mine = 0u;
#pragma unroll
        for (unsigned j = 0; j < 16; ++j) { const unsigned c = xb_ld(&bar[XB_XCNT(j)]); sum += c; cnt += (c > 0u) ? 1u : 0u; mine = (j == x) ? c : mine; }
        if (sum == G) break;
        __builtin_amdgcn_s_sleep(1);
        if ((++sp & 255u) == 0u) { if (xb_ld(&bar[XB_TMO])) break; if (sp > XB_SPIN_CAP) { atomicAdd(&bar[XB_TMO], 1u); break; } }
    }
    nloc = mine > 0u ? mine : 1u; nx = cnt > 0u ? cnt : 1u;
}

__device__ __forceinline__ void xcd_barrier(const XcdBarrier& b, const bool is_t0) {
    asm volatile("s_waitcnt vmcnt(0)" ::: "memory");
    __syncthreads();
    if (is_t0) {
        unsigned* bar = b.bar;
        __builtin_amdgcn_s_waitcnt(0);
        unsigned nloc = b.st[0], nx = b.st[1];
        if (nloc == 0u) { xcd_barrier_complete(bar, b.x, nloc, nx); b.st[0] = nloc; b.st[1] = nx; }
        const unsigned old = xb_add(&bar[XB_XSUB(b.x)], 1u);
        const unsigned gen = old / nloc;
        if (old + 1u == (gen + 1u) * nloc) {
            __builtin_amdgcn_fence(__ATOMIC_RELEASE, "agent");
            asm volatile("s_waitcnt vmcnt(0)" ::: "memory");
            const unsigned og = xb_add(&bar[XB_TOP], 1u);
            const unsigned tg = og / nx;
            if (og + 1u == (tg + 1u) * nx) xb_add(&bar[XB_TOPGEN], 1u);
            else XB_SPIN(xb_ld(&bar[XB_TOPGEN]) == tg, bar);
            __builtin_amdgcn_fence(__ATOMIC_ACQUIRE, "agent");
            xb_add(&bar[XB_XGEN(b.x)], 1u);
            asm volatile("s_waitcnt vmcnt(0)" ::: "memory");
        } else {
            XB_SPIN(xb_ld(&bar[XB_XGEN(b.x)]) == gen, bar);
            __builtin_amdgcn_fence(__ATOMIC_ACQUIRE, "agent");
            asm volatile("s_waitcnt vmcnt(0)" ::: "memory");
        }
    }
    __syncthreads();
}

struct Args { const float* in[17]; float* out; unsigned char* ws; int ph_lo, ph_hi; };
enum { I_X = 0, I_C, I_WMOD, I_BMOD, I_WIN, I_WPOOL, I_PSCALE, I_WOUT, I_LN1G, I_LN1B, I_WR, I_RB, I_WG, I_WU, I_WDN, I_LN2G, I_LN2B };

DEVFN int lane_id_volatile() { int l; asm volatile("v_mbcnt_lo_u32_b32 %0, -1, 0\n\tv_mbcnt_hi_u32_b32 %0, -1, %0" : "=v"(l)); return l; }
struct Ctx { unsigned char* lds; __attribute__((address_space(3))) unsigned char* lds3; int tid, lane, wave, G, bid, gw, NGW; };

DEVFN void transpose_item(const float* src, int ldn, int k0, int col, bf16_t* dst, int ldk, int dst_row0, int dst_k0, float* scr, int lane) {
#pragma unroll 8
    for (int i = 0; i < 32; ++i) { const int kk = 2 * i + (lane >> 5); scr[kk * 33 + (lane & 31)] = src[(size_t)(k0 + kk) * ldn + col]; }
    LDS_WAIT();
    const int c = lane & 7;
#pragma unroll
    for (int j = 0; j < 4; ++j) { const int n = (lane >> 3) + 8 * j; const float* s = scr + (8 * c) * 33 + n;
        u32x4 o; o.x = pk2(s[0 * 33], s[1 * 33]); o.y = pk2(s[2 * 33], s[3 * 33]); o.z = pk2(s[4 * 33], s[5 * 33]); o.w = pk2(s[6 * 33], s[7 * 33]);
        *(u32x4*)(dst + (size_t)(dst_row0 + n) * ldk + dst_k0 + 8 * c) = o; }
    LDS_WAIT();
}

DEVFN void ph_prologue(const Args& a, const Ctx& c) {
    unsigned char* ws = a.ws;
    float* scr = (float*)(c.lds + c.wave * 16384);
    const int lane = c.lane;
    constexpr int N1 = 2 * 16 * 64, N2 = 2 * 8 * 32, N3 = 32 * 16 * 32, N4 = 32 * 8 * 32, N5 = 2 * 64 * 16, N6 = 256;
    for (int it = c.gw; it < N1 + N2 + N3 + N4 + N5 + N6; it += c.NGW) {
        int r = it;
        if (r < N1) {
            const int l = r / 1024, kb = (r % 1024) / 64, nb = r % 64;
            const int nphys = 32 * nb + (lane & 31);
            transpose_item(a.in[I_WIN] + (size_t)l * DM * DIN, DIN, 64 * kb, inproj_nlog(nphys), (bf16_t*)(ws + WS_WIN) + (size_t)l * DIN * DM, DM, 32 * nb, 64 * kb, scr, lane);
            continue; }
        r -= N1;
        if (r < N2) {
            const int l = r / 256, kb = (r % 256) / 32, nb = r % 32;
            transpose_item(a.in[I_WOUT] + (size_t)l * DM * DM, DM, 64 * kb, 32 * nb + (lane & 31), (bf16_t*)(ws + WS_WOUT) + (size_t)l * DM * DM, DM, 32 * nb, 64 * kb, scr, lane);
            continue; }
        r -= N2;
        if (r < N3) {
            const int le = r / 512, kb = (r % 512) / 32, nb = r % 32;
            const int n = 32 * nb + (lane & 31), jt = n >> 8, bj = (n >> 7) & 1, i = n & 127;
            const float* src = (bj ? a.in[I_WU] : a.in[I_WG]) + (size_t)le * DM * DE;
            transpose_item(src, DE, 64 * kb, jt * 128 + i, (bf16_t*)(ws + WS_WGU) + (size_t)le * DM * DM, DM, 32 * nb, 64 * kb, scr, lane);
            continue; }
        r -= N3;
        if (r < N4) {
            const int le = r / 256, kb = (r % 256) / 32, nb = r % 32;
            transpose_item(a.in[I_WDN] + (size_t)le * DE * DM, DM, 64 * kb, 32 * nb + (lane & 31), (bf16_t*)(ws + WS_WD) + (size_t)le * DM * DE, DE, 32 * nb, 64 * kb, scr, lane);
            continue; }
        r -= N4;
        if (r < N5) {
            const int l = r / 1024, kdg = (r % 1024) / 16, nb = r % 16;
            const int n = nb * 64 + lane, kd0 = kdg * 8, g = kd0 >> 7, c0 = kd0 & 127;
            const float* wo = a.in[I_WOUT] + (size_t)l * DM * DM + (size_t)(512 + g * 128) * DM + n;
            const float* ps = a.in[I_PSCALE] + l * 512 + g * 128;
            const float* wp = a.in[I_WPOOL] + ((size_t)(l * 4 + g) * 128 + c0) * 128;
            float acc[8];
#pragma unroll
            for (int j = 0; j < 8; ++j) acc[j] = 0.f;
            for (int e = 0; e < 128; ++e) { const float w = wo[(size_t)e * DM] * ps[e];
#pragma unroll
                for (int j = 0; j < 8; ++j) acc[j] += wp[j * 128 + e] * w; }
            u32x4 o; o.x = pk2(acc[0], acc[1]); o.y = pk2(acc[2], acc[3]); o.z = pk2(acc[4], acc[5]); o.w = pk2(acc[6], acc[7]);
            *(u32x4*)((bf16_t*)(ws + WS_WOUT) + (size_t)l * DM * DM + (size_t)n * DM + 512 + kd0) = o;
            continue; }
        r -= N5;
        {
            const int ent = r * 64 + lane, pos = ent >> 3, i = ent & 7;
            const float inv = (float)exp2(-(double)i / 8.0 * 18.931568569324174);
            const float ang = (float)pos * inv;
            float* t = (float*)(ws + WS_ROPE) + ent * 2;
            t[0] = (float)cos((double)ang); t[1] = (float)sin((double)ang);
        }
    }
    for (int i = c.bid * 512 + c.tid; i < 2 * NB * NH * NBLK * HD; i += c.G * 512) ((float*)(ws + WS_KBAR))[i] = 0.f;
    __syncthreads();
    if (c.bid < 192) {
        float* condT = (float*)c.lds;
        float* red = (float*)(c.lds + 65536);
        for (int idx = c.tid; idx < NB * DM; idx += 512) { const int b = idx >> 10, k = idx & 1023; const float v = a.in[I_C][idx]; condT[k * 16 + b] = v / (1.f + __expf(-v)); }
        __syncthreads();
        for (int u = c.bid; u < 192; u += c.G) {
            const int l = u / 96, n0 = (u % 96) * 64;
            const float* W = a.in[I_WMOD] + (size_t)l * DM * NMOD + n0 + lane;
            float acc[16];
#pragma unroll
            for (int b = 0; b < 16; ++b) acc[b] = 0.f;
            for (int k = 128 * c.wave; k < 128 * c.wave + 128; k += 8) {
                float wv[8];
#pragma unroll
                for (int j = 0; j < 8; ++j) wv[j] = W[(size_t)(k + j) * NMOD];
#pragma unroll
                for (int j = 0; j < 8; ++j) {
                    const f32x4* cp = (const f32x4*)(condT + (k + j) * 16);
#pragma unroll
                    for (int q = 0; q < 4; ++q) { const f32x4 cv = cp[q]; acc[4 * q + 0] += cv.x * wv[j]; acc[4 * q + 1] += cv.y * wv[j]; acc[4 * q + 2] += cv.z * wv[j]; acc[4 * q + 3] += cv.w * wv[j]; }
                }
            }
#pragma unroll
            for (int b = 0; b < 16; ++b) red[(c.wave * 16 + b) * 64 + lane] = acc[b];
            __syncthreads();
            for (int o = c.tid; o < 1024; o += 512) { const int b = o >> 6, cc = o & 63; float s = a.in[I_BMOD][l * NMOD + n0 + cc];
#pragma unroll
                for (int w = 0; w < 8; ++w) s += red[(w * 16 + b) * 64 + cc];
                ((float*)(ws + WS_MOD))[(size_t)(l * NB + b) * NMOD + n0 + cc] = s; }
            __syncthreads();
        }
    }
}

DEVFN void row_stats(const f32x4 (&v)[4], float& mean, float& rstd) {
    float s = 0.f;
#pragma unroll
    for (int j = 0; j < 4; ++j) s += (v[j].x + v[j].y) + (v[j].z + v[j].w);
    mean = wave_sum(s) * (1.f / DM);
    float q = 0.f;
#pragma unroll
    for (int j = 0; j < 4; ++j) { const f32x4 d = v[j] - mean; q += (d.x * d.x + d.y * d.y) + (d.z * d.z + d.w * d.w); }
    rstd = 1.f / sqrtf(wave_sum(q) * (1.f / DM) + LN_EPS);
}
DEVFN void row_load(const float* p, int lane, f32x4 (&v)[4]) {
#pragma unroll
    for (int j = 0; j < 4; ++j) v[j] = *(const f32x4*)(p + 4 * lane + 256 * j);
}
DEVFN void row_mod_store(f32x4 (&v)[4], const float* sc, const float* sh, bf16_t* out, int lane) {
    float mean, rstd; row_stats(v, mean, rstd);
#pragma unroll
    for (int j = 0; j < 4; ++j) {
        const f32x4 s = *(const f32x4*)(sc + 4 * lane + 256 * j), h = *(const f32x4*)(sh + 4 * lane + 256 * j);
        v[j] = (v[j] - mean) * rstd * (s + 1.f) + h;
        u32x2 o; o.x = pk2(v[j].x, v[j].y); o.y = pk2(v[j].z, v[j].w);
        *(u32x2*)(out + 4 * lane + 256 * j) = o;
    }
}

DEVFN void wave_gemm32(f32x16& acc, const bf16_t* ap, const bf16_t* bp, int K) {
#pragma unroll 4
    for (int k = 0; k < K; k += 16) {
        const bf16x8 av = *(const bf16x8*)(ap + k), bv = *(const bf16x8*)(bp + k);
        acc = __builtin_amdgcn_mfma_f32_32x32x16_bf16(av, bv, acc, 0, 0, 0);
    }
}

DEVFN void ph_inproj_naive(const Args& a, const Ctx& c, int l) {
    const bf16_t* A = (const bf16_t*)(a.ws + WS_HB); const bf16_t* Bt = (const bf16_t*)(a.ws + WS_WIN) + (size_t)l * DIN * DM;
    bf16_t* O = (bf16_t*)(a.ws + WS_QKVP);
    const int r32 = c.lane & 31, hi = c.lane >> 5, wy = c.wave >> 2, wx = c.wave & 3;
    for (int u = c.bid; u < 512 * 16; u += c.G) {
        const int mt = u >> 4, nt = u & 15;
        f32x16 acc = {};
        wave_gemm32(acc, A + (size_t)(mt * 64 + wy * 32 + r32) * DM + hi * 8, Bt + (size_t)(nt * 128 + wx * 32 + r32) * DM + hi * 8, DM);
        const int nl = inproj_nlog(nt * 128 + wx * 32 + r32);
#pragma unroll
        for (int r = 0; r < 16; ++r) O[(size_t)(mt * 64 + wy * 32 + crow(r, hi)) * DIN + nl] = (bf16_t)f2bf(acc[r]);
    }
}

DEVFN void ph_rope_naive(const Args& a, const Ctx& c) {
    bf16_t* O = (bf16_t*)(a.ws + WS_QKVP); const float* rope = (const float*)(a.ws + WS_ROPE);
    for (int idx = c.bid * 512 + c.tid; idx < NTOK * 16; idx += c.G * 512) {
        const int which = idx & 1, hh = (idx >> 1) & 7, m = idx >> 4, t = m & (SEQ - 1);
        bf16_t* p = O + (size_t)m * DIN + which * 512 + hh * 64;
        float v[64];
#pragma unroll
        for (int q = 0; q < 8; ++q) { const u32x4 w = *(const u32x4*)(p + 8 * q);
            v[8 * q + 0] = bf_lo(w.x); v[8 * q + 1] = bf_hi(w.x); v[8 * q + 2] = bf_lo(w.y); v[8 * q + 3] = bf_hi(w.y);
            v[8 * q + 4] = bf_lo(w.z); v[8 * q + 5] = bf_hi(w.z); v[8 * q + 6] = bf_lo(w.w); v[8 * q + 7] = bf_hi(w.w); }
#pragma unroll
        for (int i = 0; i < 8; ++i) { const float cs = rope[(t * 8 + i) * 2], sn = rope[(t * 8 + i) * 2 + 1]; const float x1 = v[i], x2 = v[8 + i];
            v[i] = x1 * cs - x2 * sn; v[8 + i] = x2 * cs + x1 * sn; }
        const float sc = which == 0 ? QSCALE : 1.f;
#pragma unroll
        for (int q = 0; q < 8; ++q) { u32x4 w; w.x = pk2(v[8 * q] * sc, v[8 * q + 1] * sc); w.y = pk2(v[8 * q + 2] * sc, v[8 * q + 3] * sc); w.z = pk2(v[8 * q + 4] * sc, v[8 * q + 5] * sc); w.w = pk2(v[8 * q + 6] * sc, v[8 * q + 7] * sc);
            *(u32x4*)(p + 8 * q) = w; }
    }
}

DEVFN void ph_kbar(const Args& a, const Ctx& c, int l) {
    const bf16_t* O = (const bf16_t*)(a.ws + WS_QKVP); float* kbar = (float*)(a.ws + WS_KBAR) + (size_t)l * NB * NH * NBLK * HD;
    for (int it = c.gw; it < NB * NH * NBLK; it += c.NGW) {
        const int n = it & 7, hh = (it >> 3) & 7, b = it >> 6;
        const bf16_t* p = O + (size_t)(b * SEQ + n * MBLK) * DIN + 512 + hh * 64 + c.lane;
        float s = 0.f;
#pragma unroll 8
        for (int j = 0; j < MBLK; ++j) s += bf2f(p[(size_t)j * DIN]);
        kbar[(size_t)it * 64 + c.lane] = s * (1.f / MBLK);
    }
}

DEVFN void ph_pool(const Args& a, const Ctx& c) {
    const bf16_t* P = (const bf16_t*)(a.ws + WS_QKVP) + 1536; bf16_t* AD = (bf16_t*)(a.ws + WS_AD) + 512;
    for (int it = c.bid * 512 + c.tid; it < (NTOK / 16) * 64; it += c.G * 512) {
        const int cg = it & 63, m0 = (it >> 6) * 16, t0 = m0 & (SEQ - 1), g = cg >> 4, w = 2 << g;
        const bf16_t* pc = P + cg * 8;
        float s[8];
#pragma unroll
        for (int j = 0; j < 8; ++j) s[j] = 0.f;
        for (int i = 1; i < w; ++i) if (t0 - i >= 0) { const u32x4 v = *(const u32x4*)(pc + (size_t)(m0 - i) * DIN);
            s[0] += bf_lo(v.x); s[1] += bf_hi(v.x); s[2] += bf_lo(v.y); s[3] += bf_hi(v.y); s[4] += bf_lo(v.z); s[5] += bf_hi(v.z); s[6] += bf_lo(v.w); s[7] += bf_hi(v.w); }
#pragma unroll 4
        for (int r = 0; r < 16; ++r) {
            const int t = t0 + r; const u32x4 v = *(const u32x4*)(pc + (size_t)(m0 + r) * DIN);
            const float f[8] = {bf_lo(v.x), bf_hi(v.x), bf_lo(v.y), bf_hi(v.y), bf_lo(v.z), bf_hi(v.z), bf_lo(v.w), bf_hi(v.w)};
#pragma unroll
            for (int j = 0; j < 8; ++j) s[j] += f[j];
            const int cnt = (t + 1 < w) ? t + 1 : w; const float ic = 1.f / (float)cnt;
            u32x4 o; o.x = pk2(s[0] * ic - f[0], s[1] * ic - f[1]); o.y = pk2(s[2] * ic - f[2], s[3] * ic - f[3]); o.z = pk2(s[4] * ic - f[4], s[5] * ic - f[5]); o.w = pk2(s[6] * ic - f[6], s[7] * ic - f[7]);
            *(u32x4*)(AD + (size_t)(m0 + r) * DM + cg * 8) = o;
            if (t - w + 1 >= 0) { const u32x4 q = *(const u32x4*)(pc + (size_t)(m0 + r - w + 1) * DIN);
                s[0] -= bf_lo(q.x); s[1] -= bf_hi(q.x); s[2] -= bf_lo(q.y); s[3] -= bf_hi(q.y); s[4] -= bf_lo(q.z); s[5] -= bf_hi(q.z); s[6] -= bf_lo(q.w); s[7] -= bf_hi(q.w); }
        }
    }
}

DEVFN void ph_wout_naive(const Args& a, const Ctx& c, int l) {
    const bf16_t* A = (const bf16_t*)(a.ws + WS_AD); const bf16_t* Bt = (const bf16_t*)(a.ws + WS_WOUT) + (size_t)l * DM * DM;
    float* Y = (float*)(a.ws + WS_QKVP);
    const int r32 = c.lane & 31, hi = c.lane >> 5, wy = c.wave >> 2, wx = c.wave & 3;
    for (int u = c.bid; u < 512 * 8; u += c.G) {
        const int mt = u >> 3, nt = u & 7;
        f32x16 acc = {};
        wave_gemm32(acc, A + (size_t)(mt * 64 + wy * 32 + r32) * DM + hi * 8, Bt + (size_t)(nt * 128 + wx * 32 + r32) * DM + hi * 8, DM);
#pragma unroll
        for (int r = 0; r < 16; ++r) Y[(size_t)(mt * 64 + wy * 32 + crow(r, hi)) * DM + nt * 128 + wx * 32 + r32] = acc[r];
    }
}

struct MoeTab { int* cnt; int* tp; };
DEVFN MoeTab moe_table(const Args& a, const Ctx& c, int l, unsigned char* lds_at) {
    MoeTab t; t.cnt = (int*)lds_at; t.tp = t.cnt + 32;
    if (c.tid < NCLS) t.cnt[c.tid] = (int)__hip_atomic_load((unsigned*)(a.ws + WS_CTL) + CW_CNT + l * 32 + c.tid, RLX_AGENT);
    __syncthreads();
    if (c.tid == 0) { int s = 0; for (int k = 0; k < NCLS; ++k) { t.tp[k] = s; s += (t.cnt[k] + 255) >> 8; } t.tp[NCLS] = s; }
    __syncthreads();
    return t;
}
DEVFN void cls_experts(int cls, int& e1, int& e2) { const int g = cls / 6, p = cls % 6; const int lo = p < 3 ? 0 : (p < 5 ? 1 : 2), hi = p < 3 ? p + 1 : (p < 5 ? p - 1 : 3); e1 = g * 4 + lo; e2 = g * 4 + hi; }

DEVFN void ph_gateup_naive(const Args& a, const Ctx& c, int l) {
    const MoeTab T = moe_table(a, c, l, c.lds);
    const int ntiles = T.tp[NCLS];
    const bf16_t* HB = (const bf16_t*)(a.ws + WS_HB); const bf16_t* WGU = (const bf16_t*)(a.ws + WS_WGU) + (size_t)l * NE * DM * DM;
    const int* list = (const int*)(a.ws + WS_LIST); const float* rw = (const float*)(a.ws + WS_RW);
    bf16_t* ACT = (bf16_t*)(a.ws + WS_QKVP);
    const int r32 = c.lane & 31, hi = c.lane >> 5, wy = c.wave >> 2, wx = c.wave & 3;
    for (int u = c.bid; u < ntiles * 32; u += c.G) {
        const int Tt = u >> 5, sub = (u >> 3) & 3, half = (u >> 2) & 1, jt = u & 3;
        int cls = 0; while (Tt >= T.tp[cls + 1]) ++cls;
        const int j = Tt - T.tp[cls], cnt = T.cnt[cls];
        int e1, e2; cls_experts(cls, e1, e2); const int e = half ? e2 : e1;
        const int lr = sub * 64 + wy * 32 + r32, li = 256 * j + lr;
        const int tok = list[(size_t)cls * LISTCAP + (li < cnt ? li : 256 * j)];
        const bf16_t* ap = HB + (size_t)tok * DM + hi * 8;
        const bf16_t* bg = WGU + (size_t)e * DM * DM + (size_t)(jt * 256 + wx * 32 + r32) * DM + hi * 8;
        f32x16 ag = {}, au = {};
        wave_gemm32(ag, ap, bg, DM); wave_gemm32(au, ap, bg + (size_t)128 * DM, DM);
#pragma unroll
        for (int r = 0; r < 16; ++r) {
            const int lro = sub * 64 + wy * 32 + crow(r, hi), lio = 256 * j + lro;
            const float wgt = lio < cnt ? rw[((size_t)cls * LISTCAP + lio) * 2 + half] : 0.f;
            const float g = ag[r], act = g / (1.f + __expf(-g)) * au[r] * wgt;
            ACT[(size_t)(256 * Tt + lro) * DM + half * 512 + jt * 128 + wx * 32 + r32] = (bf16_t)f2bf(act);
        }
    }
}

DEVFN void ph_down_naive(const Args& a, const Ctx& c, int l) {
    const MoeTab T = moe_table(a, c, l, c.lds);
    const int ntiles = T.tp[NCLS];
    const bf16_t* ACT = (const bf16_t*)(a.ws + WS_QKVP); const bf16_t* WD = (const bf16_t*)(a.ws + WS_WD) + (size_t)l * NE * DM * DE;
    const int* list = (const int*)(a.ws + WS_LIST);
    bf16_t* Y2 = (bf16_t*)(a.ws + WS_AD);
    const int r32 = c.lane & 31, hi = c.lane >> 5, wy = c.wave >> 2, wx = c.wave & 3;
    for (int u = c.bid; u < ntiles * 32; u += c.G) {
        const int Tt = u >> 5, sub = (u >> 3) & 3, nt = u & 7;
        int cls = 0; while (Tt >= T.tp[cls + 1]) ++cls;
        const int j = Tt - T.tp[cls], cnt = T.cnt[cls];
        int e1, e2; cls_experts(cls, e1, e2);
        const bf16_t* ap = ACT + (size_t)(256 * Tt + sub * 64 + wy * 32 + r32) * DM + hi * 8;
        const int n = nt * 128 + wx * 32 + r32;
        f32x16 acc = {};
        wave_gemm32(acc, ap, WD + (size_t)e1 * DM * DE + (size_t)n * DE + hi * 8, DE);
        wave_gemm32(acc, ap + DE, WD + (size_t)e2 * DM * DE + (size_t)n * DE + hi * 8, DE);
#pragma unroll
        for (int r = 0; r < 16; ++r) {
            const int lio = 256 * j + sub * 64 + wy * 32 + crow(r, hi);
            if (lio < cnt) { const int tok = list[(size_t)cls * LISTCAP + lio]; Y2[(size_t)tok * DM + n] = (bf16_t)f2bf(acc[r]); }
        }
    }
}

constexpr size_t WS_X1B = WS_X1, WS_X2B = WS_X1 + 64 * MiB;
constexpr int ROWS_PER_WAVE = 16;
DEVFN void vec_load(const float* p, int lane, f32x4 (&v)[4]) {
#pragma unroll
    for (int j = 0; j < 4; ++j) v[j] = *(const f32x4*)(p + 4 * lane + 256 * j);
}
DEVFN void bfrow_load(const bf16_t* p, int lane, u32x2 (&w)[4]) {
#pragma unroll
    for (int j = 0; j < 4; ++j) w[j] = *(const u32x2*)(p + 4 * lane + 256 * j);
}
DEVFN f32x4 bf4(u32x2 w) { return (f32x4){bf_lo(w.x), bf_hi(w.x), bf_lo(w.y), bf_hi(w.y)}; }
DEVFN void bfrow_store(bf16_t* p, int lane, const f32x4 (&v)[4]) {
#pragma unroll
    for (int j = 0; j < 4; ++j) { u32x2 o; o.x = pk2(v[j].x, v[j].y); o.y = pk2(v[j].z, v[j].w); *(u32x2*)(p + 4 * lane + 256 * j) = o; }
}
DEVFN void ln_mod(f32x4 (&v)[4], const f32x4 (&sc)[4], const f32x4 (&sh)[4]) {
    float mean, rstd; row_stats(v, mean, rstd);
#pragma unroll
    for (int j = 0; j < 4; ++j) v[j] = (v[j] - mean) * rstd * (sc[j] + 1.f) + sh[j];
}
DEVFN void ln_aff(f32x4 (&v)[4], const f32x4 (&g)[4], const f32x4 (&b)[4]) {
    float mean, rstd; row_stats(v, mean, rstd);
#pragma unroll
    for (int j = 0; j < 4; ++j) v[j] = (v[j] - mean) * rstd * g[j] + b[j];
}

DEVFN void ph_h1_rows(const Args& a, const Ctx& c) {
    const float* mod = (const float*)(a.ws + WS_MOD); bf16_t* HB = (bf16_t*)(a.ws + WS_HB);
    for (int base = c.gw * ROWS_PER_WAVE; base < NTOK; base += c.NGW * ROWS_PER_WAVE) {
        const float* mb = mod + (size_t)(base >> 11) * NMOD;
        f32x4 sc[4], sh[4]; vec_load(mb + DM, c.lane, sc); vec_load(mb, c.lane, sh);
        f32x4 cur[4], nxt[4]; vec_load(a.in[I_X] + (size_t)base * DM, c.lane, cur);
#pragma unroll 1
        for (int i = 0; i < ROWS_PER_WAVE; ++i) {
            const int m = base + i;
            if (i + 1 < ROWS_PER_WAVE) vec_load(a.in[I_X] + (size_t)(m + 1) * DM, c.lane, nxt);
            ln_mod(cur, sc, sh); bfrow_store(HB + (size_t)m * DM, c.lane, cur);
#pragma unroll
            for (int j = 0; j < 4; ++j) cur[j] = nxt[j];
        }
    }
}

DEVFN void reduce16(float (&lg)[16]) {
    float t[8], u[4];
#pragma unroll
    for (int e = 0; e < 8; ++e) { auto rr = __builtin_amdgcn_permlane32_swap(__float_as_uint(lg[e]), __float_as_uint(lg[e + 8]), false, false); t[e] = __uint_as_float(rr[0]) + __uint_as_float(rr[1]); }
#pragma unroll
    for (int k = 0; k < 4; ++k) { auto rr = __builtin_amdgcn_permlane16_swap(__float_as_uint(t[k]), __float_as_uint(t[k + 4]), false, false); u[k] = __uint_as_float(rr[0]) + __uint_as_float(rr[1]); }
#pragma unroll
    for (int k = 0; k < 4; ++k) { u[k] = swz_xor_add(u[k], 1); u[k] = swz_xor_add(u[k], 2); u[k] = swz_xor_add(u[k], 4); u[k] = swz_xor_add(u[k], 8); }
#pragma unroll
    for (int h = 0; h < 4; ++h)
#pragma unroll
        for (int k = 0; k < 4; ++k) lg[(h >> 1) * 8 + (h & 1) * 4 + k] = __uint_as_float(__builtin_amdgcn_readlane(__float_as_uint(u[k]), 16 * h));
}

DEVFN void ph_rows_c(const Args& a, const Ctx& c, int l, bool publish) {
    const float* mod = (const float*)(a.ws + WS_MOD) + (size_t)l * NB * NMOD;
    const bf16_t* Y = (const bf16_t*)(a.ws + WS_QKVP); const bf16_t* X2B = (const bf16_t*)(a.ws + WS_X2B);
    bf16_t* X1B = (bf16_t*)(a.ws + WS_X1B); bf16_t* HB = (bf16_t*)(a.ws + WS_HB);
    float* wr = (float*)c.lds;
    int* lcnt = (int*)(c.lds + 65536); int* lbase = lcnt + 32;
    int* rcls = lbase + 32; float* rw1 = (float*)(rcls + 8 * 64); float* rw2 = rw1 + 8 * 64; int* rrow = (int*)(rw2 + 8 * 64);
    for (int i = c.tid; i < DM * NE; i += 512) wr[(i & 15) * DM + (i >> 4)] = a.in[I_WR][i];
    if (c.tid < 32) lcnt[c.tid] = 0;
    __syncthreads();
    float rb[16];
#pragma unroll
    for (int e = 0; e < 16; ++e) rb[e] = a.in[I_RB][e];
    int nr = 0;
    for (int base = c.gw * ROWS_PER_WAVE; base < NTOK; base += c.NGW * ROWS_PER_WAVE) {
        const float* mb = mod + (size_t)(base >> 11) * NMOD;
        f32x4 g1[4], lg[4], lb[4], sc[4], sh[4];
        vec_load(mb + 2 * DM, c.lane, g1); vec_load(a.in[I_LN1G] + l * DM, c.lane, lg); vec_load(a.in[I_LN1B] + l * DM, c.lane, lb); vec_load(mb + 4 * DM, c.lane, sc); vec_load(mb + 3 * DM, c.lane, sh);
        f32x4 xc[4], xn[4]; u32x2 yc[4], yn[4];
        if (l == 0) vec_load(a.in[I_X] + (size_t)base * DM, c.lane, xc);
        else { u32x2 w[4]; bfrow_load(X2B + (size_t)base * DM, c.lane, w);
#pragma unroll
            for (int j = 0; j < 4; ++j) { xc[j].x = __uint_as_float(w[j].x); xc[j].y = __uint_as_float(w[j].y); } }
        bfrow_load(Y + (size_t)base * DM, c.lane, yc);
#pragma unroll 1
        for (int i = 0; i < ROWS_PER_WAVE; ++i, ++nr) {
            const int m = base + i;
            if (i + 1 < ROWS_PER_WAVE) {
                if (l == 0) vec_load(a.in[I_X] + (size_t)(m + 1) * DM, c.lane, xn);
                else { u32x2 w[4]; bfrow_load(X2B + (size_t)(m + 1) * DM, c.lane, w);
#pragma unroll
                    for (int j = 0; j < 4; ++j) { xn[j].x = __uint_as_float(w[j].x); xn[j].y = __uint_as_float(w[j].y); } }
                bfrow_load(Y + (size_t)(m + 1) * DM, c.lane, yn);
            }
            f32x4 v[4];
#pragma unroll
            for (int j = 0; j < 4; ++j) { const f32x4 xv = (l == 0) ? xc[j] : bf4((u32x2){__float_as_uint(xc[j].x), __float_as_uint(xc[j].y)}); v[j] = xv * ALPHA + g1[j] * bf4(yc[j]); }
            ln_aff(v, lg, lb); bfrow_store(X1B + (size_t)m * DM, c.lane, v);
            ln_mod(v, sc, sh); bfrow_store(HB + (size_t)m * DM, c.lane, v);
            float lg16[16];
#pragma unroll
            for (int e = 0; e < 16; ++e) lg16[e] = 0.f;
#pragma unroll
            for (int j = 0; j < 4; ++j)
#pragma unroll
                for (int e = 0; e < 16; ++e) { const f32x4 w = *(const f32x4*)(wr + e * DM + 4 * c.lane + 256 * j); lg16[e] += (v[j].x * w.x + v[j].y * w.y) + (v[j].z * w.z + v[j].w * w.w); }
            reduce16(lg16);
            float mx = lg16[0];
#pragma unroll
            for (int e = 1; e < 16; ++e) mx = fmaxf(mx, lg16[e]);
            float sum = 0.f, scr[16];
#pragma unroll
            for (int e = 0; e < 16; ++e) { scr[e] = __expf(lg16[e] - mx); sum += scr[e]; }
            const float isum = 1.f / sum;
#pragma unroll
            for (int e = 0; e < 16; ++e) scr[e] *= isum;
            float bestg = -3.4e38f; int gb = 0, bi1 = 0, bi2 = 1; float bw1 = 0.f, bw2 = 0.f;
#pragma unroll
            for (int g = 0; g < 4; ++g) {
                float m1 = scr[4 * g] + rb[4 * g], s1 = scr[4 * g]; int i1 = 0;
#pragma unroll
                for (int q = 1; q < 4; ++q) { const float sv = scr[4 * g + q] + rb[4 * g + q]; const bool ok = sv > m1; m1 = ok ? sv : m1; s1 = ok ? scr[4 * g + q] : s1; i1 = ok ? q : i1; }
                float m2 = -3.4e38f, s2 = 0.f; int i2 = 0;
#pragma unroll
                for (int q = 0; q < 4; ++q) { const float sv = scr[4 * g + q] + rb[4 * g + q]; const bool ok = (q != i1) && sv > m2; m2 = ok ? sv : m2; s2 = ok ? scr[4 * g + q] : s2; i2 = ok ? q : i2; }
                const float gs = m1 + m2; const bool better = gs > bestg;
                bestg = better ? gs : bestg; gb = better ? g : gb; bi1 = better ? i1 : bi1; bi2 = better ? i2 : bi2; bw1 = better ? s1 : bw1; bw2 = better ? s2 : bw2;
            }
            const float inv = 1.f / (bw1 + bw2);
            const int lo = bi1 < bi2 ? bi1 : bi2, hi2 = bi1 < bi2 ? bi2 : bi1;
            const float wlo = (bi1 < bi2 ? bw1 : bw2) * inv, whi = (bi1 < bi2 ? bw2 : bw1) * inv;
            const int pidx = lo == 0 ? hi2 - 1 : (lo == 1 ? hi2 + 1 : 5);
            if (c.lane == 0) { rcls[c.wave * 64 + nr] = gb * 6 + pidx; rw1[c.wave * 64 + nr] = wlo; rw2[c.wave * 64 + nr] = whi; rrow[c.wave * 64 + nr] = m; }
#pragma unroll
            for (int j = 0; j < 4; ++j) { xc[j] = xn[j]; yc[j] = yn[j]; }
        }
    }
    LDS_WAIT();
    if (!publish) return;
    int rank = 0, cls = 0;
    if (c.lane < nr) { cls = rcls[c.wave * 64 + c.lane]; rank = atomicAdd(&lcnt[cls], 1); }
    __syncthreads();
    if (c.tid < NCLS) lbase[c.tid] = (int)__hip_atomic_fetch_add((unsigned*)(a.ws + WS_CTL) + CW_CNT + l * 32 + c.tid, (unsigned)lcnt[c.tid], RLX_AGENT);
    __syncthreads();
    if (c.lane < nr) {
        const int pos = lbase[cls] + rank;
        ((int*)(a.ws + WS_LIST))[(size_t)cls * LISTCAP + pos] = rrow[c.wave * 64 + c.lane];
        float* rw = (float*)(a.ws + WS_RW) + ((size_t)cls * LISTCAP + pos) * 2;
        rw[0] = rw1[c.wave * 64 + c.lane]; rw[1] = rw2[c.wave * 64 + c.lane];
    }
}

DEVFN void ph_rows_g(const Args& a, const Ctx& c, int l) {
    const float* mod = (const float*)(a.ws + WS_MOD) + (size_t)l * NB * NMOD;
    const bf16_t* X1B = (const bf16_t*)(a.ws + WS_X1B); const bf16_t* Y2 = (const bf16_t*)(a.ws + WS_AD);
    bf16_t* X2B = (bf16_t*)(a.ws + WS_X2B); bf16_t* HB = (bf16_t*)(a.ws + WS_HB);
    for (int base = c.gw * ROWS_PER_WAVE; base < NTOK; base += c.NGW * ROWS_PER_WAVE) {
        const float* mb = mod + (size_t)(base >> 11) * NMOD; const float* mb1 = mb + (size_t)NB * NMOD;
        f32x4 g2[4], lg[4], lb[4], sc[4], sh[4];
        vec_load(mb + 5 * DM, c.lane, g2); vec_load(a.in[I_LN2G] + l * DM, c.lane, lg); vec_load(a.in[I_LN2B] + l * DM, c.lane, lb);
        if (l == 0) { vec_load(mb1 + DM, c.lane, sc); vec_load(mb1, c.lane, sh); }
        u32x2 xc[4], xn[4], yc[4], yn[4];
        bfrow_load(X1B + (size_t)base * DM, c.lane, xc); bfrow_load(Y2 + (size_t)base * DM, c.lane, yc);
#pragma unroll 1
        for (int i = 0; i < ROWS_PER_WAVE; ++i) {
            const int m = base + i;
            if (i + 1 < ROWS_PER_WAVE) { bfrow_load(X1B + (size_t)(m + 1) * DM, c.lane, xn); bfrow_load(Y2 + (size_t)(m + 1) * DM, c.lane, yn); }
            f32x4 v[4];
#pragma unroll
            for (int j = 0; j < 4; ++j) v[j] = bf4(xc[j]) * ALPHA + g2[j] * bf4(yc[j]);
            ln_aff(v, lg, lb);
            if (l == 0) { bfrow_store(X2B + (size_t)m * DM, c.lane, v); ln_mod(v, sc, sh); bfrow_store(HB + (size_t)m * DM, c.lane, v); }
            else {
#pragma unroll
                for (int j = 0; j < 4; ++j) *(f32x4*)(a.out + (size_t)m * DM + 4 * c.lane + 256 * j) = v[j]; }
#pragma unroll
            for (int j = 0; j < 4; ++j) { xc[j] = xn[j]; yc[j] = yn[j]; }
        }
    }
}

constexpr int MOETAB_OFF = 131072 + 512;
DEVFN void ph_inproj_fast(const Args& a, const Ctx& c, int l, bool dummy_kbar) {
    pg8::DenseSched S; S.so.init(NTOK, DIN, c.G, c.bid); S.A = (const char*)(a.ws + WS_HB); S.Bt = (const char*)(a.ws + WS_WIN) + (size_t)l * DIN * DM * 2; S.lda = DM; S.ldb = DM;
    const pg8::EpiInproj E{(bf16_t*)(a.ws + WS_QKVP), (const float*)(a.ws + WS_ROPE), (dummy_kbar ? (float*)(a.ws + WS_RW) : (float*)(a.ws + WS_KBAR)) + (size_t)l * NB * NH * NBLK * HD};
    pg8::gemm_phase2<pg8::EpiInproj, pg8::DenseSched, true, false, false>(c.lds3, DM, DM, S, E, c.tid);
}
DEVFN void ph_wout_fast(const Args& a, const Ctx& c, int l) {
    pg8::DenseSched S; S.so.init(NTOK, DM, c.G, c.bid); S.A = (const char*)(a.ws + WS_AD); S.Bt = (const char*)(a.ws + WS_WOUT) + (size_t)l * DM * DM * 2; S.lda = DM; S.ldb = DM;
    const pg8::EpiBf16<0> E{(bf16_t*)(a.ws + WS_QKVP), DM, nullptr, 0, 0, 1.f};
    pg8::gemm_phase2<pg8::EpiBf16<0>, pg8::DenseSched, true, false, false>(c.lds3, DM, DM, S, E, c.tid);
}
DEVFN void moe_table_lds(const Args& a, const Ctx& c, int l) {
    int* cnt = (int*)(c.lds + MOETAB_OFF); int* tp = cnt + 32;
    if (c.tid < NCLS) cnt[c.tid] = (int)__hip_atomic_load((unsigned*)(a.ws + WS_CTL) + CW_CNT + l * 32 + c.tid, RLX_AGENT);
    __syncthreads();
    if (c.tid == 0) { int s = 0; for (int k = 0; k < NCLS; ++k) { tp[k] = s; s += (cnt[k] + 255) >> 8; } tp[NCLS] = s; }
    __syncthreads();
}
DEVFN void ph_gateup_fast(const Args& a, const Ctx& c, int l) {
    moe_table_lds(a, c, l);
    pg8::GateUpSched S; S.cnt = (const LAS int*)(c.lds3 + MOETAB_OFF); S.tp = S.cnt + 32; S.npn_shift = 3; S.nunits = S.tp[NCLS] * 8; S.G = c.G; S.c = c.bid;
    S.HB = (const char*)(a.ws + WS_HB); S.list = (const int*)(a.ws + WS_LIST); S.W = (const char*)(a.ws + WS_WGU) + (size_t)l * NE * DM * DM * 2;
    const pg8::EpiGateUp E{(bf16_t*)(a.ws + WS_QKVP), (const float*)(a.ws + WS_RW)};
    pg8::gemm_phase2<pg8::EpiGateUp, pg8::GateUpSched, true, true, false>(c.lds3, DM, DM, S, E, c.tid);
}
DEVFN void ph_down_fast(const Args& a, const Ctx& c, int l) {
    moe_table_lds(a, c, l);
    pg8::DownSched S; S.cnt = (const LAS int*)(c.lds3 + MOETAB_OFF); S.tp = S.cnt + 32; S.npn_shift = 2; S.nunits = S.tp[NCLS] * 4; S.G = c.G; S.c = c.bid;
    S.ACT = (const char*)(a.ws + WS_QKVP); S.W = (const char*)(a.ws + WS_WD) + (size_t)l * NE * DM * DE * 2;
    const pg8::EpiDown E{(bf16_t*)(a.ws + WS_AD), (const int*)(a.ws + WS_LIST)};
    pg8::gemm_phase2<pg8::EpiDown, pg8::DownSched, true, false, true>(c.lds3, DM, DE, S, E, c.tid);
}

#ifndef MK_N_LAUNCHES
#define MK_N_LAUNCHES 1
#endif
constexpr int RING_BYTES = 131072, LDSCTL_OFF = RING_BYTES, MISC_OFF = LDSCTL_OFF + 320, LDS_BYTES = 147456;
constexpr int PH_PER_LAYER = 7, NPHASE = 2 + 2 * PH_PER_LAYER;
constexpr int CW_BAR = 4096;
static_assert((CW_BAR + XCD_BAR_WORDS) * 4 <= (int)CTL_ZERO_BYTES, "CTL");

__global__ void __launch_bounds__(512, 2) fwd(Args a) {
    extern __shared__ __attribute__((aligned(16))) unsigned char lds[];
    const int wave_s = __builtin_amdgcn_readfirstlane(threadIdx.x >> 6);
#define MKTID() (wave_s * 64 + lane_id_volatile())
#define MKCTX() Ctx c; { int t_ = MKTID(); asm volatile("" : "+v"(t_)); c.lds = lds; c.lds3 = (LAS unsigned char*)lds; c.tid = t_; c.lane = t_ & 63; c.wave = __builtin_amdgcn_readfirstlane(t_ >> 6); c.G = gridDim.x; c.bid = blockIdx.x; c.gw = c.bid * 8 + c.wave; c.NGW = c.G * 8; }
    const int lo = a.ph_lo, hi = a.ph_hi;
    const bool one = (hi - lo) > 1;
    for (int u = threadIdx.x; u < (LDS_BYTES - LDSCTL_OFF) / 4; u += 512) ((LAS unsigned*)((LAS unsigned char*)lds + LDSCTL_OFF))[u] = 0u;
    __syncthreads();
    XcdBarrier bar; bar.bar = (unsigned*)(a.ws + WS_CTL) + CW_BAR; bar.x = 0; bar.st = nullptr;
    if (one) bar = xcd_barrier_post((unsigned*)(a.ws + WS_CTL) + CW_BAR, (volatile LAS unsigned*)((LAS unsigned char*)lds + MISC_OFF) + 8);
#ifndef REP_PHASE
#define REP_PHASE -1
#endif
#define IN(k) (lo <= (k) && (k) < hi)
#define SEAM(k) do { if (IN(k) && IN((k) + 1)) xcd_barrier(bar, MKTID() == 0); } while (0)
    if (IN(0)) { MKCTX(); ph_prologue(a, c); if (REP_PHASE == 0) { __syncthreads(); ph_prologue(a, c); } SEAM(0); }
    if (IN(1)) { MKCTX(); ph_h1_rows(a, c); if (REP_PHASE == 1) ph_h1_rows(a, c); SEAM(1); }
    for (int l = 0; l < 2; ++l) {
        const int p0 = 2 + l * PH_PER_LAYER;
        if (IN(p0 + 0)) { MKCTX(); ph_inproj_fast(a, c, l, false); if (REP_PHASE == 10) { __syncthreads(); ph_inproj_fast(a, c, l, true); } SEAM(p0 + 0); }
        if (IN(p0 + 1)) {
            { MKCTX(); ph_pool(a, c); }
            __syncthreads();
            const attn_body::AttnTensors AT{(const attn_body::bf16*)(a.ws + WS_QKVP), (const attn_body::bf16*)(a.ws + WS_QKVP) + 512, (const attn_body::bf16*)(a.ws + WS_QKVP) + 1024,
                                            (attn_body::bf16*)(a.ws + WS_AD), (const float*)(a.ws + WS_KBAR) + (size_t)l * NB * NH * NBLK * HD};
            const attn_body::StaticOrder S((int)gridDim.x, (int)blockIdx.x);
            attn_body::attn_phase<attn_body::StaticOrder>((char*)lds, AT, S, MKTID());
            if (REP_PHASE == 11) attn_body::attn_phase<attn_body::StaticOrder>((char*)lds, AT, S, MKTID());
            if (REP_PHASE == 17) { __syncthreads(); MKCTX(); ph_pool(a, c); }
            SEAM(p0 + 1);
        }
        if (IN(p0 + 2)) { MKCTX(); ph_wout_fast(a, c, l); if (REP_PHASE == 12) { __syncthreads(); ph_wout_fast(a, c, l); } SEAM(p0 + 2); }
        if (IN(p0 + 3)) { MKCTX(); if (REP_PHASE == 13) { ph_rows_c(a, c, l, false); __syncthreads(); } ph_rows_c(a, c, l, true); SEAM(p0 + 3); }
        if (IN(p0 + 4)) { MKCTX(); ph_gateup_fast(a, c, l); if (REP_PHASE == 14) { __syncthreads(); ph_gateup_fast(a, c, l); } SEAM(p0 + 4); }
        if (IN(p0 + 5)) { MKCTX(); ph_down_fast(a, c, l); if (REP_PHASE == 15) { __syncthreads(); ph_down_fast(a, c, l); } SEAM(p0 + 5); }
        if (IN(p0 + 6)) { MKCTX(); ph_rows_g(a, c, l); if (REP_PHASE == 16) ph_rows_g(a, c, l); SEAM(p0 + 6); }
    }
#undef IN
#undef SEAM
}

extern "C" void kernel_launch(void* const* d_in, const int* in_sizes, int n_in, void* d_out, int out_size, void* d_ws, size_t ws_size, hipStream_t stream) {
    static int grid = 0;
    if (grid == 0) {
        if (n_in != 17 || out_size != NTOK * DM || ws_size < WS_END) { fprintf(stderr, "kernel_launch: unexpected problem (n_in %d out %d ws %zu)\n", n_in, out_size, ws_size); grid = -1; return; }
        if (hipFuncSetAttribute((const void*)fwd, hipFuncAttributeMaxDynamicSharedMemorySize, LDS_BYTES) != hipSuccess) { fprintf(stderr, "kernel_launch: hipFuncSetAttribute failed\n"); grid = -1; return; }
        int dev = 0, cus = 0, per_cu = 0;
        (void)hipGetDevice(&dev); (void)hipDeviceGetAttribute(&cus, hipDeviceAttributeMultiprocessorCount, dev);
        if (hipOccupancyMaxActiveBlocksPerMultiprocessor(&per_cu, (const void*)fwd, 512, LDS_BYTES) != hipSuccess || per_cu < 1) fprintf(stderr, "kernel_launch: occupancy query reports %d workgroups per CU\n", per_cu);
        (void)hipGetLastError();
        grid = cus > 0 ? cus : 256;
    }
    if (grid < 0) return;
    (void)hipMemsetAsync((char*)d_ws + WS_CTL, 0, CTL_ZERO_BYTES, stream);
    Args a{};
    for (int i = 0; i < 17; ++i) a.in[i] = (const float*)d_in[i];
    a.out = (float*)d_out; a.ws = (unsigned char*)d_ws;
#if MK_N_LAUNCHES == 1
    a.ph_lo = 0; a.ph_hi = NPHASE; hipLaunchKernelGGL(fwd, dim3(grid), dim3(512), LDS_BYTES, stream, a);
#else
    for (int p = 0; p < NPHASE; ++p) { a.ph_lo = p; a.ph_hi = p + 1; hipLaunchKernelGGL(fwd, dim3(grid), dim3(512), LDS_BYTES, stream, a); }
#endif
}
```

```cpp
#include <hip/hip_runtime.h>
#include <cstdint>
#include <cstdio>

constexpr int NB = 16, SEQ = 2048, DM = 1024, NTOK = NB * SEQ, DIN = 2048, NH = 8, HD = 64, NBLK = 8, MBLK = 256;
constexpr int NE = 16, NCLS = 24, DE = 512, NMOD = 6 * DM;
constexpr float ALPHA = 1.41421356237309515f, LN_EPS = 1e-5f;
constexpr float QSCALE = 0.125f * 1.4426950408889634f;
constexpr int LISTCAP = NTOK;

constexpr size_t MiB = 1u << 20;
constexpr size_t WS_CTL = 0, CTL_ZERO_BYTES = 1 * MiB;
constexpr size_t WS_MOD = 1 * MiB;
constexpr size_t WS_ROPE = 2 * MiB;
constexpr size_t WS_KBAR = 2 * MiB + 256 * 1024;
constexpr size_t WS_LIST = 3 * MiB;
constexpr size_t WS_RW = 6 * MiB;
constexpr size_t WS_WIN = 12 * MiB;
constexpr size_t WS_WOUT = 20 * MiB;
constexpr size_t WS_WGU = 24 * MiB;
constexpr size_t WS_WD = 88 * MiB;
constexpr size_t WS_HB = 120 * MiB;
constexpr size_t WS_QKVP = 184 * MiB;
constexpr size_t WS_AD = 312 * MiB;
constexpr size_t WS_X1 = 376 * MiB;
constexpr size_t WS_END = 504 * MiB;
constexpr int CW_TMO = 0, CW_CNT = 64;

typedef unsigned short bf16_t;
typedef short bf16x8 __attribute__((ext_vector_type(8)));
typedef float f32x4 __attribute__((ext_vector_type(4)));
typedef float f32x16 __attribute__((ext_vector_type(16)));
typedef unsigned u32x4 __attribute__((ext_vector_type(4)));
typedef unsigned u32x2 __attribute__((ext_vector_type(2)));

#define DEVFN __device__ __forceinline__
#define LDS_WAIT() asm volatile("s_waitcnt lgkmcnt(0)" ::: "memory")
#define RLX_AGENT __ATOMIC_RELAXED, __HIP_MEMORY_SCOPE_AGENT

DEVFN float bf_lo(unsigned w) { return __uint_as_float(w << 16); }
DEVFN float bf_hi(unsigned w) { return __uint_as_float(w & 0xffff0000u); }
DEVFN float bf2f(bf16_t v) { return __uint_as_float((unsigned)v << 16); }
DEVFN unsigned f2bf(float f) { unsigned u = __float_as_uint(f); return (u + 0x7fffu + ((u >> 16) & 1u)) >> 16; }
DEVFN unsigned pk2(float lo, float hi) { return f2bf(lo) | (f2bf(hi) << 16); }
DEVFN unsigned pk4_fp8(float a, float b, float c, float d) {
    a = __builtin_amdgcn_fmed3f(a, -448.f, 448.f); b = __builtin_amdgcn_fmed3f(b, -448.f, 448.f); c = __builtin_amdgcn_fmed3f(c, -448.f, 448.f); d = __builtin_amdgcn_fmed3f(d, -448.f, 448.f);
    unsigned w = 0u; w = __builtin_amdgcn_cvt_pk_fp8_f32(a, b, w, false); w = __builtin_amdgcn_cvt_pk_fp8_f32(c, d, w, true); return w; }
DEVFN int crow(int r, int hi) { return (r & 3) + 8 * (r >> 2) + 4 * hi; }
#define SWZ_XOR(m) (0x1f | ((m) << 10))
DEVFN float swz_xor_add(float v, const int m) {
    switch (m) {
        case 1: return v + __int_as_float(__builtin_amdgcn_ds_swizzle(__float_as_int(v), SWZ_XOR(1)));
        case 2: return v + __int_as_float(__builtin_amdgcn_ds_swizzle(__float_as_int(v), SWZ_XOR(2)));
        case 4: return v + __int_as_float(__builtin_amdgcn_ds_swizzle(__float_as_int(v), SWZ_XOR(4)));
        case 8: return v + __int_as_float(__builtin_amdgcn_ds_swizzle(__float_as_int(v), SWZ_XOR(8)));
        default: return v + __int_as_float(__builtin_amdgcn_ds_swizzle(__float_as_int(v), SWZ_XOR(16)));
    }
}
DEVFN float half_swap_add(float v) { auto rr = __builtin_amdgcn_permlane32_swap(__float_as_uint(v), __float_as_uint(v), false, false); return __uint_as_float(rr[0]) + __uint_as_float(rr[1]); }
DEVFN float wave_sum(float v) {
    v = swz_xor_add(v, 1); v = swz_xor_add(v, 2); v = swz_xor_add(v, 4); v = swz_xor_add(v, 8); v = swz_xor_add(v, 16);
    return half_swap_add(v);
}
__host__ __device__ __forceinline__ int inproj_lgroup(int P) { return P < 16 ? (P >> 2) * 8 + (P & 3) * 2 : ((P - 16) >> 2) * 8 + ((P - 16) & 3) * 2 + 1; }
__host__ __device__ __forceinline__ int inproj_nlog(int n) { return (n & ~255) + inproj_lgroup((n & 255) >> 3) * 8 + (n & 7); }

#define GAS __attribute__((address_space(1)))
#define LAS __attribute__((address_space(3)))
typedef GAS unsigned gu32;
namespace pg8 {
#define PG8_LAS __attribute__((address_space(3)))
typedef unsigned short bf16_t;
typedef short bf16x8 __attribute__((ext_vector_type(8)));
typedef float f32x4 __attribute__((ext_vector_type(4)));
typedef unsigned u32x4 __attribute__((ext_vector_type(4)));
constexpr int BM = 256, BK = 64, HALF = 128, HTB = HALF * BK * 2  , STAGE_BYTES = 8 * HTB, NXCD = 8, WGM = 8;

__host__ __device__ __forceinline__ int lds_byte(int r, int c) { const int st = (r >> 4) * 2 + (c >> 5), rr = r & 15, cc = c & 31, ob = rr * 64 + cc * 2; return st * 1024 + (ob ^ (((ob >> 9) & 1) << 5)); }
__host__ __device__ __forceinline__ void stage_rc(int b, int& R, int& C) { const int st = b / 1024, sb = b % 1024, swz = sb ^ (((sb >> 9) & 1) << 5); R = (st >> 1) * 16 + swz / 64; C = (st & 1) * 32 + (swz % 64) / 2; }
__host__ __device__ __forceinline__ int perm32(int rho) { const int n = rho >> 4, i = rho & 15; return 8 * (i >> 2) + 4 * n + (i & 3); }

struct Unit { int pm, pn; };
struct Gemm { const bf16_t* A; const bf16_t* Bt; int M, N, K; };

struct StaticOrder {
    int nM, nN, nwg, G, c;
    __host__ __device__ void init(int M, int N, int G_, int c_) { nM = M / BM; nN = N / BM; nwg = nM * nN; G = G_; c = c_; }
    __host__ __device__ bool next(int i, Unit& u) const {
        const long L = (long)i * G + c; if (L >= nwg) return false;
        int wgid = (int)L; { const int q = nwg / NXCD, r = nwg % NXCD, xcd = wgid % NXCD, off = wgid / NXCD; wgid = (xcd < r ? xcd * (q + 1) : r * (q + 1) + (xcd - r) * q) + off; }
        const int nig = WGM * nN, gid = wgid / nig, fm = gid * WGM, gsz = (nM - fm) < WGM ? (nM - fm) : WGM;
        u.pm = fm + ((wgid % nig) % gsz); u.pn = (wgid % nig) / gsz; return true;
    }
    __device__ __forceinline__ void a_ready(const Unit&) const {}
    __device__ __forceinline__ void done(const Unit&) const {}
};

__device__ __forceinline__ unsigned cvt_pk_bf16(float lo, float hi) { unsigned r; asm volatile("v_cvt_pk_bf16_f32 %0, %1, %2" : "=v"(r) : "v"(lo), "v"(hi)); return r; }
typedef float f32x2 __attribute__((ext_vector_type(2)));
__device__ __forceinline__ f32x2 gelu_pk(f32x2 v) {
    const f32x2 av = __builtin_elementwise_abs(v), d = av * 0.2316418882f + 1.0f;
    f32x2 t; t.x = __builtin_amdgcn_rcpf(d.x); t.y = __builtin_amdgcn_rcpf(d.y);
    f32x2 q = t * 0.5307027145f + (-0.7265760135f); q = q * t + 0.7107068705f; q = q * t + (-0.142248368f); q = q * t + 0.127414796f; q = q * t;
    const f32x2 s = (v * v) * (-0.72134752044f);
    f32x2 e; e.x = __builtin_amdgcn_exp2f(s.x); e.y = __builtin_amdgcn_exp2f(s.y);
    const f32x2 m = v * (q * e), r = v - m;
    f32x2 o; o.x = v.x < 0.f ? m.x : r.x; o.y = v.y < 0.f ? m.y : r.y; return o;
}

template <int ACT  > struct EpiBf16 {
    static constexpr bool PERM = true, AFTER_DRAIN = false; static_assert(ACT == 0 || ACT == 1, "EpiBf16: ACT is 0 (none) or 1 (gelu_pk)");
    bf16_t* O; int ldc; const float* bias; int split_cols; size_t split_stride; float scale0;
    __device__ __forceinline__ void operator()(const f32x4 (&acc)[2][2][4][2], const Unit& u, int wr, int wc, int fr, int fq) const {
        const int row0 = u.pm * BM + wr * 64 + fr; int colt = u.pn * BM; bf16_t* base = O;
        float sc = 1.f; if (split_cols) { const int t = colt / split_cols; base += (size_t)t * split_stride; colt -= t * split_cols; if (t == 0) sc = scale0; }
        const int col0 = colt + wc * 32 + 8 * fq, bcol0 = u.pn * BM + wc * 32 + 8 * fq;
        f32x4 bv[2][2];
#pragma unroll
        for (int bj = 0; bj < 2; ++bj)
#pragma unroll
            for (int n = 0; n < 2; ++n) bv[bj][n] = bias ? *(const f32x4*)(bias + bcol0 + bj * HALF + 4 * n) : (f32x4){0.f, 0.f, 0.f, 0.f};
#pragma unroll
        for (int ai = 0; ai < 2; ++ai)
#pragma unroll
            for (int m = 0; m < 4; ++m) { bf16_t* rowp = base + (size_t)(row0 + ai * HALF + m * 16) * ldc + col0;
#pragma unroll
                for (int bj = 0; bj < 2; ++bj) { f32x4 v0 = acc[ai][bj][m][0] + bv[bj][0], v1 = acc[ai][bj][m][1] + bv[bj][1];
                    if (ACT == 1) { f32x2 a = gelu_pk((f32x2){v0[0], v0[1]}), b = gelu_pk((f32x2){v0[2], v0[3]}), c = gelu_pk((f32x2){v1[0], v1[1]}), d = gelu_pk((f32x2){v1[2], v1[3]});
                        v0 = (f32x4){a.x, a.y, b.x, b.y}; v1 = (f32x4){c.x, c.y, d.x, d.y}; }
                    v0 = v0 * sc; v1 = v1 * sc; u32x4 w; w.x = cvt_pk_bf16(v0[0], v0[1]); w.y = cvt_pk_bf16(v0[2], v0[3]); w.z = cvt_pk_bf16(v1[0], v1[1]); w.w = cvt_pk_bf16(v1[2], v1[3]);
                    *(u32x4*)(rowp + bj * HALF) = w; } }
    }
};

struct PanelStats {
    unsigned* xbuf;
    unsigned* cnt;
    unsigned* tmo;
    int ntn; float eps;
    unsigned code;
    __device__ __forceinline__ bool run(const f32x4 (&v)[2][2][4][2], const Unit& u, int wr, int wc, int fr, int fq, PG8_LAS unsigned char* lds, int wid, int lane) const {
        typedef float f32x2v __attribute__((ext_vector_type(2)));
        PG8_LAS f32x2v* P = (PG8_LAS f32x2v*)lds;
        PG8_LAS f32x2v* S = (PG8_LAS f32x2v*)(lds + 8192);
        PG8_LAS unsigned* flag = (PG8_LAS unsigned*)(lds + 8192 + 2048);
#pragma unroll
        for (int ai = 0; ai < 2; ++ai)
#pragma unroll
            for (int m = 0; m < 4; ++m) {
                float s = 0.f;
#pragma unroll
                for (int bj = 0; bj < 2; ++bj)
#pragma unroll
                    for (int n = 0; n < 2; ++n) { const f32x4 x = v[ai][bj][m][n]; s += (x[0] + x[1]) + (x[2] + x[3]); }
                s += __shfl_xor(s, 16); s += __shfl_xor(s, 32);
                const float mw = s * (1.0f / 64.0f); float q = 0.f;
#pragma unroll
                for (int bj = 0; bj < 2; ++bj)
#pragma unroll
                    for (int n = 0; n < 2; ++n) { const f32x4 d = v[ai][bj][m][n] - mw; q += (d[0] * d[0] + d[1] * d[1]) + (d[2] * d[2] + d[3] * d[3]); }
                q += __shfl_xor(q, 16); q += __shfl_xor(q, 32);
                if (fq == 0) P[(ai * HALF + wr * 64 + m * 16 + fr) * 4 + wc] = (f32x2v){mw, q};
            }
        asm volatile("s_waitcnt lgkmcnt(0)" ::: "memory"); __builtin_amdgcn_s_barrier(); asm volatile("" ::: "memory");
#if defined(BROKEN_EXCHANGE_NO_WAIT)
#warning BROKEN CONTROL BUILD: the row-statistics exchange does not wait; results are wrong by design
        if (blockIdx.x >= 64) { const long long t0_ = clock64(); while (clock64() - t0_ < 60000) __builtin_amdgcn_s_sleep(8); }
#endif
        const int row = wid * 32 + (lane & 31);
        if (lane < 32) {
            const f32x2v a = P[row * 4 + 0], b = P[row * 4 + 1], c = P[row * 4 + 2], d = P[row * 4 + 3];
            const float mt = (a.x + b.x + c.x + d.x) * 0.25f;
            const float da = a.x - mt, db = b.x - mt, dc = c.x - mt, dd = d.x - mt;
            const float m2 = (a.y + b.y) + (c.y + d.y) + 64.0f * ((da * da + db * db) + (dc * dc + dd * dd));
            unsigned long long* slot = (unsigned long long*)xbuf + ((size_t)(u.pm * BM + row) * 4 + u.pn);
            __hip_atomic_store(slot, ((unsigned long long)__float_as_uint(m2) << 32) | __float_as_uint(mt), __ATOMIC_RELAXED, __HIP_MEMORY_SCOPE_AGENT);
        }
        asm volatile("s_waitcnt vmcnt(0)" ::: "memory");
        if (lane == 0) __hip_atomic_fetch_add(cnt + 64 * u.pm, 1u, __ATOMIC_RELAXED, __HIP_MEMORY_SCOPE_AGENT);
        if (wid == 0) {
            bool dead = false; const unsigned long long t0 = __builtin_amdgcn_s_memrealtime(); const unsigned want = 8u * (unsigned)ntn;
            for (;;) {
#if defined(BROKEN_EXCHANGE_NO_WAIT)
                break;
#endif
                if ((unsigned)__builtin_amdgcn_readfirstlane(__hip_atomic_load(cnt + 64 * u.pm, __ATOMIC_RELAXED, __HIP_MEMORY_SCOPE_AGENT)) >= want) break;
                if (__builtin_amdgcn_s_memrealtime() - t0 > 2000000ull) {
                    if (lane == 0) { unsigned expect = 0u; __hip_atomic_compare_exchange_strong(tmo + 1, &expect, code | (unsigned)(u.pm & 0xff), __ATOMIC_RELAXED, __ATOMIC_RELAXED, __HIP_MEMORY_SCOPE_AGENT);
                                     __hip_atomic_store(tmo, 1u, __ATOMIC_RELAXED, __HIP_MEMORY_SCOPE_AGENT); }
                    dead = true; break; }
                __builtin_amdgcn_s_sleep(2);
            }
            __builtin_amdgcn_fence(__ATOMIC_ACQUIRE, "agent");
            if (lane == 0) flag[0] = dead ? 1u : 0u;
        }
        asm volatile("s_waitcnt vmcnt(0) lgkmcnt(0)" ::: "memory"); __builtin_amdgcn_s_barrier(); asm volatile("" ::: "memory");
        const bool bad = flag[0] != 0u;
        if (lane < 32) {
            const unsigned long long* slot = (const unsigned long long*)xbuf + (size_t)(u.pm * BM + row) * 4; float mt[4], m2[4]; float ms = 0.f;
#pragma unroll
            for (int t = 0; t < 4; ++t) { if (t < ntn) { const unsigned long long w = __hip_atomic_load(slot + t, __ATOMIC_RELAXED, __HIP_MEMORY_SCOPE_AGENT); mt[t] = __uint_as_float((unsigned)w); m2[t] = __uint_as_float((unsigned)(w >> 32)); } else { mt[t] = 0.f; m2[t] = 0.f; } ms += mt[t]; }
            const float mean = ms / (float)ntn; float q = 0.f;
#pragma unroll
            for (int t = 0; t < 4; ++t) if (t < ntn) { const float dm = mt[t] - mean; q += m2[t] + 256.0f * dm * dm; }
            S[row] = (f32x2v){mean, 1.0f / sqrtf(q / (256.0f * (float)ntn) + eps)};
        }
        asm volatile("s_waitcnt lgkmcnt(0)" ::: "memory"); __builtin_amdgcn_s_barrier(); asm volatile("" ::: "memory");
        return bad;
    }
};
struct EpiLnRes {
    static constexpr bool PERM = false, AFTER_DRAIN = true;
    const float* base; float* out; int ldc; const float* bias; PanelStats st; unsigned poison;
    __device__ __forceinline__ void fused(f32x4 (&acc)[2][2][4][2], const Unit& u, int wr, int wc, int fr, int fq, PG8_LAS unsigned char* lds, int wid, int lane) const {
        typedef float f32x2v __attribute__((ext_vector_type(2)));
        const PG8_LAS f32x2v* S = (const PG8_LAS f32x2v*)(lds + 8192);
        const int col0 = u.pn * BM + wc * 32 + 4 * fq;
#pragma unroll
        for (int bj = 0; bj < 2; ++bj)
#pragma unroll
            for (int n = 0; n < 2; ++n) { const f32x4 bv = bias ? *(const f32x4*)(bias + col0 + bj * HALF + n * 16) : (f32x4){0.f, 0.f, 0.f, 0.f};
#pragma unroll
                for (int ai = 0; ai < 2; ++ai)
#pragma unroll
                    for (int m = 0; m < 4; ++m) acc[ai][bj][m][n] += bv; }
        f32x4 pre[4][2][2];
#pragma unroll
        for (int m = 0; m < 4; ++m) { const size_t off = (size_t)(u.pm * BM + wr * 64 + m * 16 + fr) * ldc + col0;
#pragma unroll
            for (int bj = 0; bj < 2; ++bj)
#pragma unroll
                for (int n = 0; n < 2; ++n) pre[m][bj][n] = *(const f32x4*)(base + off + bj * HALF + n * 16); }
        const bool bad = st.run(acc, u, wr, wc, fr, fq, lds, wid, lane) || poison != 0u;
        const float qnan = __builtin_nanf("");
#pragma unroll
        for (int ai = 0; ai < 2; ++ai)
#pragma unroll
            for (int m = 0; m < 4; ++m) { const int r = ai * HALF + wr * 64 + m * 16 + fr; const f32x2v sr = S[r]; const size_t off = (size_t)(u.pm * BM + r) * ldc + col0;
#pragma unroll
                for (int bj = 0; bj < 2; ++bj)
#pragma unroll
                    for (int n = 0; n < 2; ++n) { const f32x4 bs = ai == 0 ? pre[m][bj][n] : *(const f32x4*)(base + off + bj * HALF + n * 16); f32x4 o = bs + (acc[ai][bj][m][n] - sr.x) * sr.y;
                        if (bad) o = (f32x4){qnan, qnan, qnan, qnan}; *(f32x4*)(out + off + bj * HALF + n * 16) = o; }
                if (m & 1) asm volatile("" ::: "memory"); }
    }
};
struct EpiLnResLn {
    static constexpr bool PERM = false, AFTER_DRAIN = true;
    const float* base; float* out; bf16_t* xn; int ldc; const float* bias; PanelStats st1, st2; unsigned poison;
    __device__ __forceinline__ void fused(f32x4 (&acc)[2][2][4][2], const Unit& u, int wr, int wc, int fr, int fq, PG8_LAS unsigned char* lds, int wid, int lane) const {
        typedef float f32x2v __attribute__((ext_vector_type(2))); typedef unsigned u32x2v __attribute__((ext_vector_type(2)));
        const PG8_LAS f32x2v* S = (const PG8_LAS f32x2v*)(lds + 8192);
        const int col0 = u.pn * BM + wc * 32 + 4 * fq;
#pragma unroll
        for (int bj = 0; bj < 2; ++bj)
#pragma unroll
            for (int n = 0; n < 2; ++n) { const f32x4 bv = bias ? *(const f32x4*)(bias + col0 + bj * HALF + n * 16) : (f32x4){0.f, 0.f, 0.f, 0.f};
#pragma unroll
                for (int ai = 0; ai < 2; ++ai)
#pragma unroll
                    for (int m = 0; m < 4; ++m) acc[ai][bj][m][n] += bv; }
        bool bad = st1.run(acc, u, wr, wc, fr, fq, lds, wid, lane) || poison != 0u;
        const float qnan = __builtin_nanf("");
#pragma unroll
        for (int ai = 0; ai < 2; ++ai)
#pragma unroll
            for (int m = 0; m < 4; ++m) { const int r = ai * HALF + wr * 64 + m * 16 + fr; const f32x2v sr = S[r]; const size_t off = (size_t)(u.pm * BM + r) * ldc + col0;
#pragma unroll
                for (int bj = 0; bj < 2; ++bj)
#pragma unroll
                    for (int n = 0; n < 2; ++n) { const f32x4 bs = *(const f32x4*)(base + off + bj * HALF + n * 16); acc[ai][bj][m][n] = bs + (acc[ai][bj][m][n] - sr.x) * sr.y; }
                asm volatile("" : "+v"(acc[ai][0][m][0]), "+v"(acc[ai][0][m][1]), "+v"(acc[ai][1][m][0]), "+v"(acc[ai][1][m][1]));
                if (m & 1) asm volatile("" ::: "memory"); }
        const bool bad1 = bad;
        bad = st2.run(acc, u, wr, wc, fr, fq, lds, wid, lane) || bad;
#pragma unroll
        for (int ai = 0; ai < 2; ++ai)
#pragma unroll
            for (int m = 0; m < 4; ++m) { const int r = ai * HALF + wr * 64 + m * 16 + fr; const f32x2v sr = S[r]; const size_t off = (size_t)(u.pm * BM + r) * ldc + col0;
#pragma unroll
                for (int bj = 0; bj < 2; ++bj)
#pragma unroll
                    for (int n = 0; n < 2; ++n) { const f32x4 x1 = acc[ai][bj][m][n]; *(f32x4*)(out + off + bj * HALF + n * 16) = bad1 ? (f32x4){qnan, qnan, qnan, qnan} : x1;
                        const f32x4 o = (x1 - sr.x) * sr.y; u32x2v w; w.x = cvt_pk_bf16(o[0], o[1]); w.y = cvt_pk_bf16(o[2], o[3]);
                        if (bad) { w.x = 0x7fc07fc0u; w.y = 0x7fc07fc0u; } *(u32x2v*)(xn + off + bj * HALF + n * 16) = w; }
                asm volatile("" ::: "memory"); }
    }
};

}
namespace pg8 {
typedef int v8i_t __attribute__((ext_vector_type(8))); typedef int v4i_t __attribute__((ext_vector_type(4)));
template <class Epi, class Sched, bool ALIGN_EPI, bool GATHER, bool KSPLIT, bool FP8 = false, int SCW = 127, int SCA = 127>
__device__ __forceinline__ void gemm_phase2(PG8_LAS unsigned char* lds, const int Kbytes, const int ldb_bytes, const Sched& S, const Epi& E, const int tid) {
    typedef typename Sched::UnitT UnitT;
    const int wid = __builtin_amdgcn_readfirstlane(tid >> 6), lane = tid & 63, wr = wid >> 2, wc = wid & 3, fr = lane & 15, fq = lane >> 4;
    int nt = Kbytes / (BK * 2); asm volatile("" : "+s"(nt));
    const int nth = nt / 2;
    unsigned voffB[2];
#pragma unroll
    for (int i = 0; i < 2; ++i) { int R[2], C[2]; stage_rc(tid * 16 + i * 8192, R[i], C[i]); const int Rb = Epi::PERM ? ((R[i] & ~31) + perm32(R[i] & 31)) : R[i]; voffB[i] = (unsigned)(Rb * ldb_bytes + C[i] * 2); }
    const size_t kstep = (size_t)(BK * 2);
    const size_t hstepB = (size_t)HALF * ldb_bytes;
    const unsigned ldsw = (unsigned)wid * 1024u;
    const int aoff = lds_byte(wr * 64 + fr, fq * 8), boff = lds_byte(wc * 32 + fr, fq * 8);
#define PG8_SA(b, h) (((b) * 2 + (h)) * HTB)
#define PG8_SB(b, h) ((4 + (b) * 2 + (h)) * HTB)
#define PG8_STAGE(bufoff, gbase, voff) do { _Pragma("unroll") for (int _i = 0; _i < 2; ++_i) \
        __builtin_amdgcn_global_load_lds((const unsigned*)((const char*)(gbase) + (voff)[_i]), (PG8_LAS unsigned*)(lds + (bufoff) + ldsw + _i * 8192), 16, 0, 0); } while (0)
#define PG8_LDA(dst, b, h) do { _Pragma("unroll") for (int m = 0; m < 4; ++m) _Pragma("unroll") for (int k = 0; k < 2; ++k) dst[m][k] = *(const PG8_LAS bf16x8*)(lds + PG8_SA(b, h) + aoff + m * 2048 + k * 1024); } while (0)
#define PG8_LDB(dst, b, h) do { _Pragma("unroll") for (int n = 0; n < 2; ++n) _Pragma("unroll") for (int k = 0; k < 2; ++k) dst[n][k] = *(const PG8_LAS bf16x8*)(lds + PG8_SB(b, h) + boff + n * 2048 + k * 1024); } while (0)
#define PG8_CAT8(x) __builtin_shufflevector(__builtin_bit_cast(v4i_t, (x)[0]), __builtin_bit_cast(v4i_t, (x)[1]), 0, 1, 2, 3, 4, 5, 6, 7)
#define PG8_MMA(ai, bj, At, Bt) do { __builtin_amdgcn_s_setprio(1); \
        if constexpr (FP8) { _Pragma("unroll") for (int m = 0; m < 4; ++m) _Pragma("unroll") for (int n = 0; n < 2; ++n) \
            acc[ai][bj][m][n] = __builtin_amdgcn_mfma_scale_f32_16x16x128_f8f6f4(PG8_CAT8(Bt[n]), PG8_CAT8(At[m]), acc[ai][bj][m][n], 0, 0, 0, SCW * 0x01010101, 0, SCA * 0x01010101); } \
        else { _Pragma("unroll") for (int m = 0; m < 4; ++m) _Pragma("unroll") for (int n = 0; n < 2; ++n) _Pragma("unroll") for (int k = 0; k < 2; ++k) \
            acc[ai][bj][m][n] = __builtin_amdgcn_mfma_f32_16x16x32_bf16(Bt[n][k], At[m][k], acc[ai][bj][m][n], 0, 0, 0); } \
        __builtin_amdgcn_s_setprio(0); } while (0)
#define PG8_WAIT_V(n) asm volatile("s_waitcnt vmcnt(" #n ")" ::: "memory")
#define PG8_WAIT_L(n) asm volatile("s_waitcnt lgkmcnt(" #n ")" ::: "memory")
#define PG8_BAR __builtin_amdgcn_s_barrier()
#define PG8_SCHED __builtin_amdgcn_sched_barrier(0)
#define PG8_BK(cb, cb2, kt) ((KSPLIT && (kt) >= nth) ? (cb2) + (size_t)((kt) - nth) * kstep : (cb) + (size_t)(kt) * kstep)
    UnitT cur, nxt; int ui = 0;
    if (!S.next(0, cur)) return;
    f32x4 acc[2][2][4][2];
#pragma unroll
    for (int a = 0; a < 2; ++a)
#pragma unroll
        for (int b = 0; b < 2; ++b)
#pragma unroll
            for (int m = 0; m < 4; ++m)
#pragma unroll
                for (int n = 0; n < 2; ++n) acc[a][b][m][n] = (f32x4){0.f, 0.f, 0.f, 0.f};
    bf16x8 At[4][2], B0[2][2], B1[2][2];
    unsigned vA[2][2], vAn[2][2];
    S.arows(cur, tid, vA);
#pragma unroll
    for (int h = 0; h < 2; ++h)
#pragma unroll
        for (int i = 0; i < 2; ++i) vAn[h][i] = vA[h][i];
    const char* cA = S.aptr(cur); const char* cB = S.bptr(cur); const char* cB2 = KSPLIT ? S.bptr2(cur) : cB;
    PG8_STAGE(PG8_SB(0, 0), cB, voffB); PG8_STAGE(PG8_SB(0, 1), cB + hstepB, voffB); PG8_STAGE(PG8_SA(0, 0), cA, vA[0]); PG8_STAGE(PG8_SA(0, 1), cA, vA[1]);
    if (wr == 1) PG8_BAR;
    PG8_WAIT_V(2); PG8_BAR;
    PG8_STAGE(PG8_SB(1, 0), PG8_BK(cB, cB2, 1), voffB); PG8_STAGE(PG8_SA(1, 0), cA + kstep, vA[0]); PG8_STAGE(PG8_SB(1, 1), PG8_BK(cB, cB2, 1) + hstepB, voffB);
    PG8_WAIT_V(6); PG8_BAR;
    for (;;) {
        const bool has_next = S.next(ui + 1, nxt);
        const char* nA = has_next ? S.aptr(nxt) : cA; const char* nB = has_next ? S.bptr(nxt) : cB; const char* nB2 = (KSPLIT && has_next) ? S.bptr2(nxt) : cB2;
        if (GATHER && has_next) S.arows(nxt, tid, vAn);
        for (int t = 0; t < nt; t += 2) {
            const bool last = (t == nt - 2);
            const char* a1 = cA + (size_t)(t + 1) * kstep;
            const char* a2 = last ? nA : cA + (size_t)(t + 2) * kstep;
            const char* b2 = last ? nB : PG8_BK(cB, cB2, t + 2);
            const char* b3 = last ? (KSPLIT ? PG8_BK(nB, nB2, 1) : nB + kstep) : PG8_BK(cB, cB2, t + 3);
            const char* a3 = a2 + kstep;
            PG8_LDB(B0, 0, 0); PG8_LDB(B1, 0, 1); PG8_SCHED; PG8_LDA(At, 0, 0); PG8_STAGE(PG8_SA(1, 1), a1, vA[1]);
            PG8_WAIT_V(8); PG8_WAIT_L(0); PG8_BAR; PG8_MMA(0, 0, At, B0); PG8_MMA(0, 1, At, B1); PG8_BAR; PG8_SCHED;
            if (GATHER && last) {
#pragma unroll
                for (int h = 0; h < 2; ++h)
#pragma unroll
                    for (int i = 0; i < 2; ++i) vA[h][i] = vAn[h][i]; }
            PG8_LDA(At, 0, 1); PG8_STAGE(PG8_SB(0, 0), b2, voffB); PG8_STAGE(PG8_SB(0, 1), b2 + hstepB, voffB); PG8_STAGE(PG8_SA(0, 0), a2, vA[0]);
            PG8_WAIT_V(8); PG8_WAIT_L(0); PG8_BAR; PG8_MMA(1, 0, At, B0); PG8_MMA(1, 1, At, B1); PG8_BAR; PG8_SCHED;
            PG8_LDB(B0, 1, 0); PG8_LDB(B1, 1, 1); PG8_SCHED; PG8_LDA(At, 1, 0); PG8_STAGE(PG8_SA(0, 1), a2, vA[1]);
            PG8_WAIT_V(8); PG8_WAIT_L(0); PG8_BAR; PG8_MMA(0, 0, At, B0); PG8_MMA(0, 1, At, B1); PG8_BAR; PG8_SCHED;
            PG8_LDA(At, 1, 1); PG8_STAGE(PG8_SB(1, 0), b3, voffB); PG8_STAGE(PG8_SB(1, 1), b3 + hstepB, voffB); PG8_STAGE(PG8_SA(1, 0), a3, vA[0]);
            PG8_WAIT_V(8); PG8_WAIT_L(0); PG8_BAR; PG8_MMA(1, 0, At, B0); PG8_MMA(1, 1, At, B1); PG8_BAR; PG8_SCHED;
        }
        if constexpr (ALIGN_EPI) { if (wr == 0) PG8_BAR; }
        if constexpr (!Epi::AFTER_DRAIN) { E(acc, cur, wr, wc, fr, fq); }
        if (!has_next) break;
#pragma unroll
        for (int a = 0; a < 2; ++a)
#pragma unroll
            for (int b = 0; b < 2; ++b)
#pragma unroll
                for (int m = 0; m < 4; ++m)
#pragma unroll
                    for (int n = 0; n < 2; ++n) acc[a][b][m][n] = (f32x4){0.f, 0.f, 0.f, 0.f};
        cur = nxt; cA = nA; cB = nB; cB2 = nB2; ++ui;
        if constexpr (ALIGN_EPI) { if (wr == 1) PG8_BAR; }
    }
    PG8_WAIT_V(0);
    if constexpr (!ALIGN_EPI) { if (wr == 0) PG8_BAR; }
    PG8_BAR;
    if constexpr (Epi::AFTER_DRAIN) { E.fused(acc, cur, wr, wc, fr, fq, lds, wid, lane); }
#undef PG8_SA
#undef PG8_SB
#undef PG8_STAGE
#undef PG8_LDA
#undef PG8_LDB
#undef PG8_MMA
#undef PG8_WAIT_V
#undef PG8_WAIT_L
#undef PG8_BAR
#undef PG8_SCHED
#undef PG8_BK
#undef PG8_CAT8
}
}
namespace pg8 {
DEVFN unsigned pkbf(float lo, float hi) { return cvt_pk_bf16(lo, hi); }
struct DenseSched {
    typedef Unit UnitT;
    StaticOrder so; const char* A; const char* Bt; int lda, ldb;
    DEVFN bool next(int i, Unit& u) const { return so.next(i, u); }
    DEVFN const char* aptr(const Unit& u) const { return A + (size_t)u.pm * BM * lda * 2; }
    DEVFN void arows(const Unit&, const int tid_, unsigned (&v)[2][2]) const {
        int R[2], C[2]; { int t_ = tid_; asm volatile("" : "+v"(t_)); stage_rc(t_ * 16, R[0], C[0]); stage_rc(t_ * 16 + 8192, R[1], C[1]); }
#pragma unroll
        for (int h = 0; h < 2; ++h)
#pragma unroll
            for (int i = 0; i < 2; ++i) v[h][i] = (unsigned)((h * HALF + R[i]) * lda + C[i]) * 2u; }
    DEVFN const char* bptr(const Unit& u) const { return Bt + (size_t)u.pn * BM * ldb * 2; }
    DEVFN const char* bptr2(const Unit& u) const { return bptr(u); }
};
struct EpiInproj {
    static constexpr bool PERM = true, AFTER_DRAIN = false;
    bf16_t* O; const float* rope; float* kbar;
    DEVFN void operator()(f32x4 (&acc)[2][2][4][2], const Unit& u, int wr, int wc, int fr, int fq) const {
        const int pn = u.pn, row0 = u.pm * BM + wr * 64 + fr;
        if (pn < 4 && fq == 0) {
#pragma unroll
            for (int ai = 0; ai < 2; ++ai)
#pragma unroll
                for (int m = 0; m < 4; ++m) { const int t = (row0 + ai * HALF + m * 16) & (SEQ - 1); const f32x4* rp = (const f32x4*)(rope + t * 16);
#pragma unroll
                    for (int q = 0; q < 4; ++q) { const f32x4 cs = rp[q];
                        { const int d = 2 * q, n = d >> 2, e = d & 3; const float x1 = acc[ai][0][m][n][e], x2 = acc[ai][1][m][n][e]; acc[ai][0][m][n][e] = x1 * cs[0] - x2 * cs[1]; acc[ai][1][m][n][e] = x2 * cs[0] + x1 * cs[1]; }
                        { const int d = 2 * q + 1, n = d >> 2, e = d & 3; const float x1 = acc[ai][0][m][n][e], x2 = acc[ai][1][m][n][e]; acc[ai][0][m][n][e] = x1 * cs[2] - x2 * cs[3]; acc[ai][1][m][n][e] = x2 * cs[2] + x1 * cs[3]; } } }
        }
        if (pn == 2 || pn == 3) {
            float* kb = kbar + (size_t)((((u.pm >> 3) * NH + (pn - 2) * 4 + wc) * NBLK + (u.pm & 7)) * HD);
#pragma unroll
            for (int bj = 0; bj < 2; ++bj)
#pragma unroll
                for (int n = 0; n < 2; ++n)
#pragma unroll
                    for (int e = 0; e < 4; ++e) { float s = 0.f;
#pragma unroll
                        for (int ai = 0; ai < 2; ++ai)
#pragma unroll
                            for (int m = 0; m < 4; ++m) s += acc[ai][bj][m][n][e];
                        s = swz_xor_add(s, 1); s = swz_xor_add(s, 2); s = swz_xor_add(s, 4); s = swz_xor_add(s, 8);
                        if (fr == 0) atomicAdd(kb + (2 * fq + bj) * 8 + 4 * n + e, s * (1.f / MBLK)); }
        }
        const float sc = pn < 2 ? QSCALE : 1.f;
#pragma unroll
        for (int ai = 0; ai < 2; ++ai)
#pragma unroll
            for (int m = 0; m < 4; ++m) { bf16_t* rowp = O + (size_t)(row0 + ai * HALF + m * 16) * DIN + pn * BM + wc * 64;
#pragma unroll
                for (int bj = 0; bj < 2; ++bj) { const f32x4 v0 = acc[ai][bj][m][0] * sc, v1 = acc[ai][bj][m][1] * sc;
                    u32x4 w; w.x = pkbf(v0[0], v0[1]); w.y = pkbf(v0[2], v0[3]); w.z = pkbf(v1[0], v1[1]); w.w = pkbf(v1[2], v1[3]);
                    *(u32x4*)(rowp + (2 * fq + bj) * 8) = w; } }
    }
};
struct MoeUnit { int pm, pn, cls, j, cnt; };
struct MoeBase {
    const PG8_LAS int* tp; const PG8_LAS int* cnt; int nunits, G, c, npn_shift;
    DEVFN bool next_(int i, MoeUnit& u) const {
        const int L = i * G + c; if (L >= nunits) return false;
        u.pm = L >> npn_shift; u.pn = L & ((1 << npn_shift) - 1);
        int cls = 0; while (u.pm >= tp[cls + 1]) ++cls;
        u.cls = cls; u.j = u.pm - tp[cls]; u.cnt = cnt[cls]; return true; }
};
DEVFN void moe_experts(int cls, int& e1, int& e2) { const int g = cls / 6, p = cls % 6; const int lo = p < 3 ? 0 : (p < 5 ? 1 : 2), hi = p < 3 ? p + 1 : (p < 5 ? p - 1 : 3); e1 = g * 4 + lo; e2 = g * 4 + hi; }
struct GateUpSched : MoeBase {
    typedef MoeUnit UnitT;
    const char* HB; const int* list; const char* W;
    DEVFN bool next(int i, MoeUnit& u) const { return next_(i, u); }
    DEVFN const char* aptr(const MoeUnit&) const { return HB; }
    DEVFN void arows(const MoeUnit& u, const int tid_, unsigned (&v)[2][2]) const {
        int R[2], C[2]; { int t_ = tid_; asm volatile("" : "+v"(t_)); stage_rc(t_ * 16, R[0], C[0]); stage_rc(t_ * 16 + 8192, R[1], C[1]); }
#pragma unroll
        for (int h = 0; h < 2; ++h)
#pragma unroll
            for (int i = 0; i < 2; ++i) { const int li = 256 * u.j + h * HALF + R[i]; const int tok = list[(size_t)u.cls * LISTCAP + (li < u.cnt ? li : 256 * u.j)]; v[h][i] = (unsigned)(tok * DM + C[i] * 2); } }
    DEVFN const char* bptr(const MoeUnit& u) const { int e1, e2; moe_experts(u.cls, e1, e2); return W + (size_t)(u.pn < 4 ? e1 : e2) * DM * DM + (size_t)(u.pn & 3) * BM * DM; }
    DEVFN const char* bptr2(const MoeUnit& u) const { return bptr(u); }
};
struct DownSched : MoeBase {
    typedef MoeUnit UnitT;
    const char* ACT; const char* W;
    DEVFN bool next(int i, MoeUnit& u) const { return next_(i, u); }
    DEVFN const char* aptr(const MoeUnit&) const { return ACT; }
    DEVFN void arows(const MoeUnit& u, const int tid_, unsigned (&v)[2][2]) const {
        int R[2], C[2]; { int t_ = tid_; asm volatile("" : "+v"(t_)); stage_rc(t_ * 16, R[0], C[0]); stage_rc(t_ * 16 + 8192, R[1], C[1]); }
#pragma unroll
        for (int h = 0; h < 2; ++h)
#pragma unroll
            for (int i = 0; i < 2; ++i) v[h][i] = (unsigned)((u.pm * BM + h * HALF + R[i]) * DM + C[i] * 2); }
    DEVFN const char* bptr(const MoeUnit& u) const { int e1, e2; moe_experts(u.cls, e1, e2); return W + (size_t)e1 * DM * DE + (size_t)u.pn * BM * DE; }
    DEVFN const char* bptr2(const MoeUnit& u) const { int e1, e2; moe_experts(u.cls, e1, e2); return W + (size_t)e2 * DM * DE + (size_t)u.pn * BM * DE; }
};
struct EpiGateUp {
    static constexpr bool PERM = true, AFTER_DRAIN = false;
    unsigned char* ACT; const float* rw;
    DEVFN void operator()(f32x4 (&acc)[2][2][4][2], const MoeUnit& u, int wr, int wc, int fr, int fq) const {
        const int half = u.pn >> 2, jt = u.pn & 3;
#pragma unroll
        for (int ai = 0; ai < 2; ++ai)
#pragma unroll
            for (int m = 0; m < 4; ++m) { const int lr = ai * HALF + wr * 64 + m * 16 + fr, li = 256 * u.j + lr;
                const float wgt = li < u.cnt ? 8.f * rw[((size_t)u.cls * LISTCAP + li) * 2 + half] : 0.f;
                f32x4 o[2];
#pragma unroll
                for (int n = 0; n < 2; ++n)
#pragma unroll
                    for (int e = 0; e < 4; ++e) { const float g = acc[ai][0][m][n][e]; o[n][e] = g * __builtin_amdgcn_rcpf(1.f + __expf(-g)) * acc[ai][1][m][n][e] * wgt; }
                u32x2 w; w.x = pk4_fp8(o[0][0], o[0][1], o[0][2], o[0][3]); w.y = pk4_fp8(o[1][0], o[1][1], o[1][2], o[1][3]);
                *(u32x2*)(ACT + (size_t)(u.pm * BM + lr) * DM + half * 512 + jt * 128 + wc * 32 + fq * 8) = w; }
    }
};
struct EpiDown {
    static constexpr bool PERM = true, AFTER_DRAIN = false;
    bf16_t* Y2; const int* list;
    DEVFN void operator()(f32x4 (&acc)[2][2][4][2], const MoeUnit& u, int wr, int wc, int fr, int fq) const {
#pragma unroll
        for (int ai = 0; ai < 2; ++ai)
#pragma unroll
            for (int m = 0; m < 4; ++m) { const int li = 256 * u.j + ai * HALF + wr * 64 + m * 16 + fr;
                if (li < u.cnt) { const int tok = list[(size_t)u.cls * LISTCAP + li]; bf16_t* rowp = Y2 + (size_t)tok * DM + u.pn * BM + wc * 32 + fq * 8;
#pragma unroll
                    for (int bj = 0; bj < 2; ++bj) { const f32x4 v0 = acc[ai][bj][m][0], v1 = acc[ai][bj][m][1];
                        u32x4 w; w.x = pkbf(v0[0], v0[1]); w.y = pkbf(v0[2], v0[3]); w.z = pkbf(v1[0], v1[1]); w.w = pkbf(v1[2], v1[3]);
                        *(u32x4*)(rowp + bj * HALF) = w; } } }
    }
};
}

#include <hip/hip_bf16.h>
#include <cmath>
namespace attn_body {
using bf16=__hip_bfloat16;
using bf16x8=__attribute__((ext_vector_type(8)))short;
using s16x4=__attribute__((ext_vector_type(4)))short;
using f32x16=__attribute__((ext_vector_type(16)))float;
using u32x4=__attribute__((ext_vector_type(4)))unsigned;
constexpr int BATCH=16,NHEAD=8,SEQ=2048,D=64,QP=2048,OP=1024;
constexpr int NW=8,QBLK=32,QB=QBLK*NW,KVBLK=64,NQB=SEQ/QB;
constexpr int ATTN_PITCH=QP, ATTN_UNIT_ROWS=QB;
__device__ __forceinline__ int crow(int r,int hi){return (r&3)+8*(r>>2)+4*hi;}
#define SBAR() __builtin_amdgcn_sched_barrier(0)
__device__ __forceinline__ void cmask(f32x16&p0,f32x16&p1,int jb,int qrel,int hi){
  const float NEG=-INFINITY; int kb=64*jb+4*hi;
  #pragma unroll
  for(int r=0;r<16;++r){int kv=kb+(r&3)+8*(r>>2); if(kv>qrel)p0[r]=NEG; if(kv+32>qrel)p1[r]=NEG;}
}

constexpr int NSLOT=3, SLOTB=8192;
constexpr int LDS_K=0, LDS_V=NSLOT*SLOTB, LDS_WS=2*NSLOT*SLOTB, LDS_OST=LDS_WS+NW*64*4, LDS_KBAR=LDS_OST+NW*4096, LDS_BYTES=LDS_KBAR+2048;
constexpr float NEGBIG=-1.0e30f; typedef float f32x4_t __attribute__((ext_vector_type(4)));
__device__ __forceinline__ float bfs(short v){return __uint_as_float(((unsigned)(unsigned short)v)<<16);}
constexpr float C2=0.125f*1.4426950408889634f;
__device__ __forceinline__ void glds16(const void*gsrc,unsigned lds_dst){unsigned keep;
  asm volatile("s_mov_b32 %0, m0\n\ts_mov_b32 m0, %2\n\ts_nop 0\n\tglobal_load_lds_dwordx4 %1, off\n\ts_mov_b32 m0, %0":"=&s"(keep):"v"(gsrc),"s"(lds_dst):"memory");}
__device__ __forceinline__ float max3f(float a,float b,float c){float r;asm("v_max3_f32 %0, %1, %2, %3":"=v"(r):"v"(a),"v"(b),"v"(c));return r;}
__device__ __forceinline__ float max2f(float a,float b){float r;asm("v_max_f32_e32 %0, %1, %2":"=v"(r):"v"(a),"v"(b));return r;}
__device__ __forceinline__ float fadd_s(float a,float b){float r;asm("v_add_f32_e32 %0, %1, %2":"=v"(r):"v"(a),"v"(b));return r;}
__device__ __forceinline__ float fsub_s(float a,float b){float r;asm("v_sub_f32_e32 %0, %1, %2":"=v"(r):"v"(a),"v"(b));return r;}
typedef float f32x2_t __attribute__((ext_vector_type(2))); typedef __bf16 bf16x2_t __attribute__((ext_vector_type(2)));
__device__ __forceinline__ unsigned cvtpk_s(float lo,float hi){f32x2_t v={lo,hi};bf16x2_t b=__builtin_convertvector(v,bf16x2_t);return __builtin_bit_cast(unsigned,b);}
#define WAIT_BAR(N) asm volatile("s_waitcnt vmcnt(" #N ") lgkmcnt(0)\n\ts_barrier":::"memory")

__device__ __forceinline__ void qkt(f32x16&p0,f32x16&p1,const char*Kslot,const bf16x8*qr,const f32x16&negm,int r32,int hi){
  const char*kb=Kslot+hi*1024+r32*16;
  #pragma unroll
  for(int d0=0;d0<4;++d0){
    const bf16x8 b0=*reinterpret_cast<const bf16x8*>(kb+d0*2048);
    const bf16x8 b1=*reinterpret_cast<const bf16x8*>(kb+d0*2048+512);
    if(d0==0){p0=__builtin_amdgcn_mfma_f32_32x32x16_bf16(b0,qr[0],negm,0,0,0);p1=__builtin_amdgcn_mfma_f32_32x32x16_bf16(b1,qr[0],negm,0,0,0);}
    else{p0=__builtin_amdgcn_mfma_f32_32x32x16_bf16(b0,qr[d0],p0,0,0,0);p1=__builtin_amdgcn_mfma_f32_32x32x16_bf16(b1,qr[d0],p1,0,0,0);}}
}
typedef __attribute__((address_space(3))) const char* lds_cptr;
typedef short v4i16_t __attribute__((ext_vector_type(4)));
__device__ __forceinline__ void kload8(bf16x8*kf,lds_cptr kp){
  kf[0]=*(const __attribute__((address_space(3))) bf16x8*)(kp);      kf[1]=*(const __attribute__((address_space(3))) bf16x8*)(kp+512);
  kf[2]=*(const __attribute__((address_space(3))) bf16x8*)(kp+2048); kf[3]=*(const __attribute__((address_space(3))) bf16x8*)(kp+2560);
  kf[4]=*(const __attribute__((address_space(3))) bf16x8*)(kp+4096); kf[5]=*(const __attribute__((address_space(3))) bf16x8*)(kp+4608);
  kf[6]=*(const __attribute__((address_space(3))) bf16x8*)(kp+6144); kf[7]=*(const __attribute__((address_space(3))) bf16x8*)(kp+6656);
}
__device__ __forceinline__ void kload2(bf16x8*kf,lds_cptr kp,int j){ kf[2*j]=*(const __attribute__((address_space(3))) bf16x8*)(kp+j*2048); kf[2*j+1]=*(const __attribute__((address_space(3))) bf16x8*)(kp+j*2048+512); }
__device__ __forceinline__ s16x4 vtr(lds_cptr p){ return __builtin_bit_cast(s16x4,__builtin_amdgcn_ds_read_tr16_b64_v4i16((__attribute__((address_space(3))) v4i16_t*)p)); }
__device__ __forceinline__ float rowmax(const f32x16&p0,const f32x16&p1){
  float a=max3f(p0[0],p0[1],p1[0]),b=max3f(p0[2],p0[3],p1[1]);a=max3f(a,p1[2],p1[3]);
  #pragma unroll
  for(int r=4;r<16;r+=4){a=max3f(a,p0[r],p0[r+1]);b=max3f(b,p0[r+2],p0[r+3]);a=max3f(a,p1[r],p1[r+1]);b=max3f(b,p1[r+2],p1[r+3]);}
  const float m=max2f(a,b);
  auto rr=__builtin_amdgcn_permlane32_swap(__float_as_uint(m),__float_as_uint(m),false,false);
  return max2f(__uint_as_float(rr[0]),__uint_as_float(rr[1]));
}
__device__ __forceinline__ void pv(f32x16*o,int vb,bf16x8 pa0,bf16x8 pa1,bf16x8 pa2,bf16x8 pa3){
  #pragma unroll
  for(int d0=0;d0<2;++d0){s16x4 lo[4],hi[4];
    #pragma unroll
    for(int ks=0;ks<4;++ks){
      asm volatile("ds_read_b64_tr_b16 %0,%1 offset:%c2":"=&v"(lo[ks]):"v"(vb),"i"(d0*4096+ks*1024):"memory");
      asm volatile("ds_read_b64_tr_b16 %0,%1 offset:%c2":"=&v"(hi[ks]):"v"(vb),"i"(d0*4096+ks*1024+512):"memory");}
    asm volatile("s_waitcnt lgkmcnt(0)":::"memory");SBAR();
    #define PK(k) (bf16x8){lo[k][0],lo[k][1],lo[k][2],lo[k][3],hi[k][0],hi[k][1],hi[k][2],hi[k][3]}
    o[d0]=__builtin_amdgcn_mfma_f32_32x32x16_bf16(pa0,PK(0),o[d0],0,0,0);
    o[d0]=__builtin_amdgcn_mfma_f32_32x32x16_bf16(pa1,PK(1),o[d0],0,0,0);
    o[d0]=__builtin_amdgcn_mfma_f32_32x32x16_bf16(pa2,PK(2),o[d0],0,0,0);
    o[d0]=__builtin_amdgcn_mfma_f32_32x32x16_bf16(pa3,PK(3),o[d0],0,0,0);
    #undef PK
  }
}

#ifndef ATTN_STORE16
#define ATTN_STORE16(p,v) (*(u32x4*)(p)=(v))
#endif
template<int THRL> __device__ __forceinline__ void attn_unit(int b,int h,int qb,const bf16*Q,const bf16*__restrict__ K,const bf16*__restrict__ V,bf16*O,const float*__restrict__ kbar,char*shm,const int tid){
  const int lane=tid&63,r32=lane&31,hi=lane>>5; const int wid=__builtin_amdgcn_readfirstlane(tid>>6);
  float kbv=0.f; { int tk=tid; asm volatile("":"+v"(tk)); if(qb>=4&&tk<448)kbv=kbar[tk]; }
  const long rowbase=(long)b*SEQ; const int q0=qb*QB;
  const bf16*Qw=Q+(rowbase+q0+wid*QBLK)*QP+h*D;
  const bf16*Kh=K+rowbase*QP+h*D,*Vh=V+rowbase*QP+h*D;
  const unsigned lds0=(unsigned)(uintptr_t)shm;
  float*wsf=(float*)(shm+LDS_WS)+wid*64;
  const bf16*ksrc=Kh+(long)lane*QP+wid*8;
  const bf16*vsrc=Vh+(long)(16*(wid&3)+(lane>>2))*QP+(wid>>2)*32+(lane&3)*8;
  const unsigned kdst=lds0+LDS_K+wid*1024, vdst=lds0+LDS_V+wid*1024;
  #define DMA_K(t,slot) glds16(ksrc+(long)(t)*KVBLK*QP,(unsigned)__builtin_amdgcn_readfirstlane(kdst+(slot)))
  #define DMA_V(t,slot) glds16(vsrc+(long)(t)*KVBLK*QP,(unsigned)__builtin_amdgcn_readfirstlane(vdst+(slot)))
  const int vb0=(int)(lds0+LDS_V)+((lane>>4)&1)*32+(lane&3)*8+(4*hi+((lane&15)>>2))*64;
  const char*Kbase=shm+LDS_K; bf16x8 kf[8];
  const lds_cptr shm3=(lds_cptr)shm; const lds_cptr kp0=shm3+LDS_K+hi*1024+r32*16; const lds_cptr vp0=shm3+LDS_V+((lane>>4)&1)*32+(lane&3)*8+(4*hi+((lane&15)>>2))*64;
  const int NT=(q0+QB)/KVBLK;
  DMA_K(0,0);DMA_V(0,0);DMA_K(1,SLOTB);
  bf16x8 qr[4];
  #pragma unroll
  for(int d0=0;d0<4;++d0)qr[d0]=*reinterpret_cast<const bf16x8*>(&Qw[(long)r32*QP+d0*16+hi*8]);
  float mhat=0.f,l_reg=0.f;f32x16 o[2];o[0]=f32x16{};o[1]=f32x16{};f32x16 negm=f32x16{};asm volatile("":"+v"(negm));
  const int qrel=wid*QBLK+r32;
  #define CMASK(P0,P1,t) do{int jb_=(t)-(NT-4); if(jb_>=0)cmask(P0,P1,jb_,qrel,hi);}while(0)
  bool resc=false;
  #define START(P0,P1) do{ const float rm=rowmax(P0,P1); resc=false; \
    { const float dl=selcur?rm:-64.f; mhat=fadd_s(mhat,dl); \
      _Pragma("unroll") for(int r=0;r<16;++r){P0[r]=fsub_s(P0[r],dl);P1[r]=fsub_s(P1[r],dl);} \
      { const float nv_=selcur?-mhat:NEGBIG; _Pragma("unroll") for(int r=0;r<16;++r)negm[r]=nv_; } asm volatile("":"+v"(negm)); } \
    _Pragma("unroll") for(int r=0;r<16;++r)P0[r]=__builtin_amdgcn_exp2f(P0[r]); }while(0)
  #define RESC() do{ if(resc){ asm volatile("s_waitcnt lgkmcnt(0)":::"memory"); \
      _Pragma("unroll") for(int d_=0;d_<2;++d_) _Pragma("unroll") for(int r=0;r<16;++r)o[d_][r]*=wsf[crow(r,hi)]; } }while(0)
  f32x16 pA0,pA1,pB0,pB1;
  int sl_prev=0,sl_cur=0,sl_next=SLOTB;
  #define ROT() do{sl_prev=sl_cur;sl_cur=sl_next;sl_next=(sl_next==(NSLOT-1)*SLOTB)?0:sl_next+SLOTB;}while(0)
  DMA_K(2,2*SLOTB);
  if(qb>=4){ if(tid<448){ const unsigned hb=__builtin_bit_cast(unsigned,kbv); const unsigned hr=(hb+0x7fffu+((hb>>16)&1u))&0xffff0000u; const float lo_=kbv-__builtin_bit_cast(float,hr); const unsigned lb=__builtin_bit_cast(unsigned,lo_);
      ((unsigned short*)(shm+LDS_KBAR))[tid]=(unsigned short)(hr>>16); ((unsigned short*)(shm+LDS_KBAR+1024))[tid]=(unsigned short)((lb+0x7fffu+((lb>>16)&1u))>>16); } }
  WAIT_BAR(3);
  unsigned bmask=(1u<<(qb+1))-1u;
  if(qb>=4){ float gsc[8];
    { const lds_cptr kb3=shm3+LDS_KBAR+(r32&7)*128+hi*16; f32x16 g=f32x16{};
      _Pragma("unroll") for(int d0=0;d0<4;++d0){ const bf16x8 ah=*(const __attribute__((address_space(3))) bf16x8*)(kb3+d0*32), al=*(const __attribute__((address_space(3))) bf16x8*)(kb3+1024+d0*32);
        g=__builtin_amdgcn_mfma_f32_32x32x16_bf16(ah,qr[d0],g,0,0,0); g=__builtin_amdgcn_mfma_f32_32x32x16_bf16(al,qr[d0],g,0,0,0); }
      _Pragma("unroll") for(int r=0;r<4;++r){ auto rr=__builtin_amdgcn_permlane32_swap(__float_as_uint(g[r]),__float_as_uint(g[r]),false,false); gsc[r]=__uint_as_float(rr[0]); gsc[4+r]=__uint_as_float(rr[1]); } }
    _Pragma("unroll") for(int n=0;n<7;++n) gsc[n]=(n<qb)?gsc[n]:-3.0e38f;
    bmask=1u<<qb;
    _Pragma("unroll") for(int pick=0;pick<3;++pick){ float best=-3.4e38f; unsigned bi=0u;
      _Pragma("unroll") for(int n=0;n<7;++n){ const bool ok=!((bmask>>n)&1u)&&gsc[n]>best; best=ok?gsc[n]:best; bi=ok?(unsigned)n:bi; }
      bmask|=1u<<bi; } }
  bool selcur=(bmask&1u)!=0u;
  { const float nv=selcur?0.f:NEGBIG; _Pragma("unroll") for(int r=0;r<16;++r)negm[r]=nv; asm volatile("":"+v"(negm)); }
  qkt(pA0,pA1,Kbase,qr,negm,r32,hi);asm volatile("s_nop 15\n\ts_nop 7":"+v"(pA0),"+v"(pA1));CMASK(pA0,pA1,0);
  START(pA0,pA1);
  _Pragma("unroll") for(int r=0;r<16;++r)pA1[r]=__builtin_amdgcn_exp2f(pA1[r]);
  WAIT_BAR(0);
  DMA_K(3,0);DMA_V(1,SLOTB);
  ROT();
  kload8(kf,kp0+sl_cur);
  WAIT_BAR(2);
  s16x4 vlo[8],vhi[8]; u32x4 pw0,pw1,pw2,pw3;
  #define PKW(P,B) cvtpk_s(P[B],P[B+1])
  #define PAF(k) __builtin_bit_cast(bf16x8,pw##k)
  #define VFR(i) (bf16x8){vlo[i][0],vlo[i][1],vlo[i][2],vlo[i][3],vhi[i][0],vhi[i][1],vhi[i][2],vhi[i][3]}
  #define PIN(x) asm volatile("":"+v"(x))
  #define MX3(a,b,c) __builtin_fmaxf(__builtin_fmaxf((a),(b)),(c))
  #define GAPA(MF,A0,A1,A2,A3,W0,W1,PW) do{ MF; sacc+=A0; sacc+=A1; sacc+=A2; sacc+=A3; PIN(sacc); W0; W1; PIN(PW); SBAR(); }while(0)
  #define EX(v) __builtin_amdgcn_exp2f(v)
  #define GAPB(MF,X,B) do{ MF; X[B]=EX(X[B]); X[B+1]=EX(X[B+1]); X[B+2]=EX(X[B+2]); X[B+3]=EX(X[B+3]); PIN(X); SBAR(); }while(0)
  #define VRD(i) do{ vlo[i]=vtr(vp_+(((i)>>2)*4096+((i)&3)*1024)); vhi[i]=vtr(vp_+(((i)>>2)*4096+((i)&3)*1024+512)); }while(0)
  #define KRD(G,j) do{ if(G){ kload2(kf,kp0+sl_next,j); SBAR(); } }while(0)
  #define STEP(C0,C1,P0,P1,t,GK,GV,GL) do{ SBAR(); \
    const lds_cptr vp_=vp0+sl_prev; \
    VRD(0); SBAR(); float sacc=(P0[0]+P0[1]); \
    GAPA(C0=__builtin_amdgcn_mfma_f32_32x32x16_bf16(kf[0],qr[0],negm,0,0,0), P0[2],P0[3],P0[4],P0[5],     pw0[0]=PKW(P0,0), pw0[1]=PKW(P0,2), pw0); \
    VRD(4); SBAR(); GAPA(C1=__builtin_amdgcn_mfma_f32_32x32x16_bf16(kf[1],qr[0],negm,0,0,0), P0[6],P0[7],P0[8],P0[9],     pw0[2]=PKW(P0,4), pw0[3]=PKW(P0,6), pw0); \
    VRD(1); SBAR(); GAPA(C0=__builtin_amdgcn_mfma_f32_32x32x16_bf16(kf[2],qr[1],C0,0,0,0),   P0[10],P0[11],P0[12],P0[13], pw1[0]=PKW(P0,8), pw1[1]=PKW(P0,10), pw1); \
    VRD(5); SBAR(); GAPA(C1=__builtin_amdgcn_mfma_f32_32x32x16_bf16(kf[3],qr[1],C1,0,0,0),   P0[14],P0[15],P1[0],P1[1],   pw1[2]=PKW(P0,12),pw1[3]=PKW(P0,14), pw1); \
    VRD(2); SBAR(); GAPA(C0=__builtin_amdgcn_mfma_f32_32x32x16_bf16(kf[4],qr[2],C0,0,0,0),   P1[2],P1[3],P1[4],P1[5],     pw2[0]=PKW(P1,0), pw2[1]=PKW(P1,2), pw2); \
    VRD(6); SBAR(); GAPA(C1=__builtin_amdgcn_mfma_f32_32x32x16_bf16(kf[5],qr[2],C1,0,0,0),   P1[6],P1[7],P1[8],P1[9],     pw2[2]=PKW(P1,4), pw2[3]=PKW(P1,6), pw2); \
    VRD(3); SBAR(); GAPA(C0=__builtin_amdgcn_mfma_f32_32x32x16_bf16(kf[6],qr[3],C0,0,0,0),   P1[10],P1[11],P1[12],P1[13], pw3[0]=PKW(P1,8), pw3[1]=PKW(P1,10), pw3); \
    VRD(7); SBAR(); GAPA(C1=__builtin_amdgcn_mfma_f32_32x32x16_bf16(kf[7],qr[3],C1,0,0,0),   P1[14],P1[15],0.f,0.f,       pw3[2]=PKW(P1,12),pw3[3]=PKW(P1,14), pw3); \
    l_reg+=sacc; \
    if(GK){DMA_K((t)+3,sl_cur);} if(GV){DMA_V((t)+1,sl_next);} \
    CMASK(C0,C1,t); \
    { float a=MX3(C0[0],C0[1],C1[0]),b=MX3(C0[2],C0[3],C1[1]); a=MX3(a,C1[2],C1[3]); \
      _Pragma("unroll") for(int r=4;r<16;r+=4){a=MX3(a,C0[r],C0[r+1]);b=MX3(b,C0[r+2],C0[r+3]);a=MX3(a,C1[r],C1[r+1]);b=MX3(b,C1[r+2],C1[r+3]);} \
      float rm=__builtin_fmaxf(a,b); { auto rr=__builtin_amdgcn_permlane32_swap(__float_as_uint(rm),__float_as_uint(rm),false,false); rm=__builtin_fmaxf(__uint_as_float(rr[0]),__uint_as_float(rr[1])); } \
      resc=false; \
      if(__builtin_expect(__any(rm>(float)THRL),0)){ const float dl=__builtin_fmaxf(rm,0.f); mhat+=dl; \
        _Pragma("unroll") for(int r=0;r<16;++r){C0[r]-=dl;C1[r]-=dl;} \
        { const float nv_=selcur?-mhat:NEGBIG; _Pragma("unroll") for(int r=0;r<16;++r)negm[r]=nv_; } asm volatile("":"+v"(negm)); \
        const float f=__builtin_amdgcn_exp2f(-dl); l_reg*=f; if(hi==0)wsf[r32]=f; resc=true; } } \
    SBAR(); \
    GAPB(o[0]=__builtin_amdgcn_mfma_f32_32x32x16_bf16(PAF(0),VFR(0),o[0],0,0,0), C0,0); \
    GAPB(o[1]=__builtin_amdgcn_mfma_f32_32x32x16_bf16(PAF(0),VFR(4),o[1],0,0,0), C0,4); \
    KRD(GL,0); GAPB(o[0]=__builtin_amdgcn_mfma_f32_32x32x16_bf16(PAF(1),VFR(1),o[0],0,0,0), C0,8); \
    KRD(GL,1); GAPB(o[1]=__builtin_amdgcn_mfma_f32_32x32x16_bf16(PAF(1),VFR(5),o[1],0,0,0), C0,12); \
    KRD(GL,2); GAPB(o[0]=__builtin_amdgcn_mfma_f32_32x32x16_bf16(PAF(2),VFR(2),o[0],0,0,0), C1,0); \
    KRD(GL,3); GAPB(o[1]=__builtin_amdgcn_mfma_f32_32x32x16_bf16(PAF(2),VFR(6),o[1],0,0,0), C1,4); \
    GAPB(o[0]=__builtin_amdgcn_mfma_f32_32x32x16_bf16(PAF(3),VFR(3),o[0],0,0,0), C1,8); \
    GAPB(o[1]=__builtin_amdgcn_mfma_f32_32x32x16_bf16(PAF(3),VFR(7),o[1],0,0,0), C1,12); \
    }while(0)
  #define BLKSEL(tt) do{ if((((tt))&3)==0){ selcur=((bmask>>((tt)>>2))&1u)!=0u; const float nv_=selcur?-mhat:NEGBIG; _Pragma("unroll") for(int r=0;r<16;++r)negm[r]=nv_; asm volatile("":"+v"(negm)); } }while(0)
  int t=1;
  #undef CMASK
  #define CMASK(P0,P1,t) do{}while(0)
  for(;t+5<NT;t+=2){
    STEP(pB0,pB1,pA0,pA1,t,true,true,true);     WAIT_BAR(2); RESC(); ROT(); BLKSEL(t+1);
    STEP(pA0,pA1,pB0,pB1,t+1,true,true,true);   WAIT_BAR(2); RESC(); ROT();
  }
  #undef CMASK
  #define CMASK(P0,P1,t) do{int jb_=(t)-(NT-4); if(jb_>=0)cmask(P0,P1,jb_,qrel,hi);}while(0)
  #define ENDW(tt) do{ if((tt)+3<NT){WAIT_BAR(2);} else if((tt)+2<NT){WAIT_BAR(1);} else {WAIT_BAR(0);} }while(0)
  for(;t+1<NT;t+=2){
    STEP(pB0,pB1,pA0,pA1,t,(t+3<NT),(t+1<NT),(t+1<NT));       ENDW(t);   RESC(); ROT(); BLKSEL(t+1);
    STEP(pA0,pA1,pB0,pB1,t+1,(t+4<NT),(t+2<NT),(t+2<NT));     ENDW(t+1); RESC(); ROT();
  }
  STEP(pB0,pB1,pA0,pA1,NT-1,false,false,false); RESC();
  { float sacc=pB0[0]+pB0[1]; _Pragma("unroll") for(int r=2;r<16;++r)sacc+=pB0[r]; _Pragma("unroll") for(int r=0;r<16;++r)sacc+=pB1[r]; l_reg+=sacc;
    pw0=(u32x4){PKW(pB0,0),PKW(pB0,2),PKW(pB0,4),PKW(pB0,6)};pw1=(u32x4){PKW(pB0,8),PKW(pB0,10),PKW(pB0,12),PKW(pB0,14)};pw2=(u32x4){PKW(pB1,0),PKW(pB1,2),PKW(pB1,4),PKW(pB1,6)};pw3=(u32x4){PKW(pB1,8),PKW(pB1,10),PKW(pB1,12),PKW(pB1,14)};
    SBAR(); pv(o,vb0+sl_cur,PAF(0),PAF(1),PAF(2),PAF(3)); }
  #undef PKW
  #undef PAF
  #undef VFR
  #undef PIN
  #undef MX3
  #undef GAPA
  #undef GAPB
  #undef EX
  #undef VRD
  #undef KRD
  #undef STEP
  #undef ENDW
  {auto rr=__builtin_amdgcn_permlane32_swap(__float_as_uint(l_reg),__float_as_uint(l_reg),false,false);l_reg=__uint_as_float(rr[0])+__uint_as_float(rr[1]);}
  if(hi==0)wsf[32+r32]=l_reg;asm volatile("s_waitcnt lgkmcnt(0)":::"memory");
  float rli[16];
  #pragma unroll
  for(int r=0;r<16;++r)rli[r]=__builtin_amdgcn_rcpf(wsf[32+crow(r,hi)]);
  bf16*Ow=O+(rowbase+q0+wid*QBLK)*OP+h*D;
  { bf16*stg=(bf16*)(shm+LDS_OST)+wid*2048;
    #pragma unroll
    for(int r=0;r<16;++r){const int orow=crow(r,hi);
      #pragma unroll
      for(int d0=0;d0<2;++d0)stg[orow*64+d0*32+r32]=__float2bfloat16(o[d0][r]*rli[r]);}
    asm volatile("s_waitcnt lgkmcnt(0)":::"memory");
    #pragma unroll
    for(int i=0;i<4;++i){const int row=i*8+(lane>>3),ch=lane&7; const u32x4 v=*(const u32x4*)(stg+row*64+ch*8); ATTN_STORE16(Ow+(long)row*OP+ch*8,v);} }
  asm volatile("s_waitcnt lgkmcnt(0)\n\ts_barrier":::"memory");
  #undef BLKSEL
  #undef DMA_K
  #undef DMA_V
  #undef CMASK
  #undef START
  #undef RESC
  #undef ROT
}
constexpr int ATTN_LDS_BYTES=LDS_BYTES;
struct AttnTensors { const bf16* Q; const bf16* K; const bf16* V; bf16* O; const float* kbar; };
struct AttnUnit { int bh; int qb; };
struct StaticOrder {
  int vcu, G;
  __device__ __forceinline__ explicit StaticOrder(int grid,int block):vcu((grid%8==0)?(block%8)*(grid/8)+block/8:block),G(grid){}
  __device__ __forceinline__ bool next(int i,AttnUnit&u)const{ const int pr=(vcu+(i>>2)*G)*2+((i>>1)&1); if(pr>=BATCH*NHEAD*4)return false;
    const int s=pr&3; u.bh=pr>>2; u.qb=(i&1)?7-s:s; return true; }
  __device__ __forceinline__ void a_ready(const AttnUnit&)const{}
  __device__ __forceinline__ void done(const AttnUnit&)const{}
};
template<class Sched,int THRL=8> __device__ __forceinline__ void attn_phase(char*lds,const AttnTensors&T,const Sched&S,const int tid_in){
  AttnUnit u; int tid_=tid_in; asm volatile("":"+v"(tid_));
  for(int i=0;S.next(i,u);++i){ S.a_ready(u); attn_unit<THRL>(u.bh/NHEAD,u.bh%NHEAD,u.qb,T.Q,T.K,T.V,T.O,T.kbar+(long)u.bh*512,lds,tid_); S.done(u); }
}
#undef SBAR
#undef WAIT_BAR
}

#define XB_TMO      128
#define XB_XCNT(j)  (256  + 64 * (j))
#define XB_XSUB(j)  (1280 + 64 * (j))
#define XB_XGEN(j)  (2304 + 64 * (j))
#define XB_TOP      3328
#define XB_TOPGEN   3392
#define XCD_BAR_WORDS 3456
#define XB_SPIN_CAP (1u << 18)

__device__ __forceinline__ unsigned xb_ld(unsigned* p)              { return __hip_atomic_load(p, __ATOMIC_RELAXED, __HIP_MEMORY_SCOPE_AGENT); }
__device__ __forceinline__ unsigned xb_add(unsigned* p, unsigned v) { return __hip_atomic_fetch_add(p, v, __ATOMIC_RELAXED, __HIP_MEMORY_SCOPE_AGENT); }
__device__ __forceinline__ unsigned xb_xcc_id() { return (unsigned)__builtin_amdgcn_s_getreg((3 << 11) | 20) & 0xFu; }
#define XB_SPIN(cond, bar) do { unsigned _sp = 0; while (cond) { __builtin_amdgcn_s_sleep(1); \
    if ((++_sp & 255u) == 0u) { if (xb_ld(&(bar)[XB_TMO])) break; if (_sp > XB_SPIN_CAP) { atomicAdd(&(bar)[XB_TMO], 1u); break; } } } } while (0)

struct XcdBarrier {
    unsigned* bar; unsigned x;
    volatile LAS unsigned* st;
};

__device__ __forceinline__ XcdBarrier xcd_barrier_post(unsigned* bar, volatile LAS unsigned* st) {
    XcdBarrier b; b.bar = bar; b.x = xb_xcc_id(); b.st = st;
    if (threadIdx.x == 0) (void)xb_add(&bar[XB_XCNT(b.x)], 1u);
    return b;
}
__device__ __forceinline__ void xcd_barrier_complete(unsigned* bar, unsigned x, unsigned& nloc, unsigned& nx) {
    const unsigned G = gridDim.x * gridDim.y * gridDim.z;
    unsigned sum, cnt, mine, sp = 0u;
    for (;;) {
        sum = 0u; cnt = 0u; mine = 0u;
#pragma unroll
        for (unsigned j = 0; j < 16; ++j) { const unsigned c = xb_ld(&bar[XB_XCNT(j)]); sum += c; cnt += (c > 0u) ? 1u : 0u; mine = (j == x) ? c : mine; }
        if (sum == G) break;
        __builtin_amdgcn_s_sleep(1);
        if ((++sp & 255u) == 0u) { if (xb_ld(&bar[XB_TMO])) break; if (sp > XB_SPIN_CAP) { atomicAdd(&bar[XB_TMO], 1u); break; } }
    }
    nloc = mine > 0u ? mine : 1u; nx = cnt > 0u ? cnt : 1u;
}

__device__ __forceinline__ void xcd_barrier(const XcdBarrier& b, const bool is_t0) {
    asm volatile("s_waitcnt vmcnt(0)" ::: "memory");
    __syncthreads();
    if (is_t0) {
        unsigned* bar = b.bar;
        __builtin_amdgcn_s_waitcnt(0);
        unsigned nloc = b.st[0], nx = b.st[1];
        if (nloc == 0u) { xcd_barrier_complete(bar, b.x, nloc, nx); b.st[0] = nloc; b.st[1] = nx; }
        const unsigned old = xb_add(&bar[XB_XSUB(b.x)], 1u);
        const unsigned gen = old / nloc;
        if (old + 1u == (gen + 1u) * nloc) {
            __builtin_amdgcn_fence(__ATOMIC_RELEASE, "agent");
            asm volatile("s_waitcnt vmcnt(0)" ::: "memory");
            const unsigned og = xb_add(&bar[XB_TOP], 1u);
            const unsigned tg = og / nx;
            if (og + 1u == (tg + 1u) * nx) xb_add(&bar[XB_TOPGEN], 1u);
            else XB_SPIN(xb_ld(&bar[XB_TOPGEN]) == tg, bar);
            __builtin_amdgcn_fence(__ATOMIC_ACQUIRE, "agent");
            xb_add(&bar[XB_XGEN(b.x)], 1u);
            asm volatile("s_waitcnt vmcnt(0)" ::: "memory");
        } else {
            XB_SPIN(xb_ld(&bar[XB_XGEN(b.x)]) == gen, bar);
            __builtin_amdgcn_fence(__ATOMIC_ACQUIRE, "agent");
            asm volatile("s_waitcnt vmcnt(0)" ::: "memory");
        }
    }
    __syncthreads();
}

struct Args { const float* in[17]; float* out; unsigned char* ws; int ph_lo, ph_hi; };
enum { I_X = 0, I_C, I_WMOD, I_BMOD, I_WIN, I_WPOOL, I_PSCALE, I_WOUT, I_LN1G, I_LN1B, I_WR, I_RB, I_WG, I_WU, I_WDN, I_LN2G, I_LN2B };

DEVFN int lane_id_volatile() { int l; asm volatile("v_mbcnt_lo_u32_b32 %0, -1, 0\n\tv_mbcnt_hi_u32_b32 %0, -1, %0" : "=v"(l)); return l; }
struct Ctx { unsigned char* lds; __attribute__((address_space(3))) unsigned char* lds3; int tid, lane, wave, G, bid, gw, NGW; };

DEVFN void transpose_item(const float* src, int ldn, int k0, int col, bf16_t* dst, int ldk, int dst_row0, int dst_k0, float* scr, int lane) {
#pragma unroll 8
    for (int i = 0; i < 32; ++i) { const int kk = 2 * i + (lane >> 5); scr[kk * 33 + (lane & 31)] = src[(size_t)(k0 + kk) * ldn + col]; }
    LDS_WAIT();
    const int c = lane & 7;
#pragma unroll
    for (int j = 0; j < 4; ++j) { const int n = (lane >> 3) + 8 * j; const float* s = scr + (8 * c) * 33 + n;
        u32x4 o; o.x = pk2(s[0 * 33], s[1 * 33]); o.y = pk2(s[2 * 33], s[3 * 33]); o.z = pk2(s[4 * 33], s[5 * 33]); o.w = pk2(s[6 * 33], s[7 * 33]);
        *(u32x4*)(dst + (size_t)(dst_row0 + n) * ldk + dst_k0 + 8 * c) = o; }
    LDS_WAIT();
}

DEVFN void transpose_item_f8(const float* src, int ldn, int k0, int col, unsigned char* dst, int ldk, int dst_row0, int dst_k0, float* scr, int lane) {
#pragma unroll 8
    for (int i = 0; i < 32; ++i) { const int kk = 2 * i + (lane >> 5); scr[kk * 33 + (lane & 31)] = src[(size_t)(k0 + kk) * ldn + col]; }
    LDS_WAIT();
    const int c = lane & 7;
#pragma unroll
    for (int j = 0; j < 4; ++j) { const int n = (lane >> 3) + 8 * j; const float* s = scr + (8 * c) * 33 + n;
        u32x2 o; o.x = pk4_fp8(32.f * s[0 * 33], 32.f * s[1 * 33], 32.f * s[2 * 33], 32.f * s[3 * 33]); o.y = pk4_fp8(32.f * s[4 * 33], 32.f * s[5 * 33], 32.f * s[6 * 33], 32.f * s[7 * 33]);
        *(u32x2*)(dst + (size_t)(dst_row0 + n) * ldk + dst_k0 + 8 * c) = o; }
    LDS_WAIT();
}

DEVFN void ph_prologue(const Args& a, const Ctx& c) {
    unsigned char* ws = a.ws;
    float* scr = (float*)(c.lds + c.wave * 16384);
    const int lane = c.lane;
    constexpr int N1 = 2 * 16 * 64, N2 = 2 * 8 * 32, N3 = 32 * 16 * 32, N4 = 32 * 8 * 32, N5 = 2 * 64 * 16, N6 = 256;
    for (int it = c.gw; it < N1 + N2 + N3 + N4 + N5 + N6; it += c.NGW) {
        int r = it;
        if (r < N1) {
            const int l = r / 1024, kb = (r % 1024) / 64, nb = r % 64;
            const int nphys = 32 * nb + (lane & 31);
            transpose_item(a.in[I_WIN] + (size_t)l * DM * DIN, DIN, 64 * kb, inproj_nlog(nphys), (bf16_t*)(ws + WS_WIN) + (size_t)l * DIN * DM, DM, 32 * nb, 64 * kb, scr, lane);
            continue; }
        r -= N1;
        if (r < N2) {
            const int l = r / 256, kb = (r % 256) / 32, nb = r % 32;
            transpose_item(a.in[I_WOUT] + (size_t)l * DM * DM, DM, 64 * kb, 32 * nb + (lane & 31), (bf16_t*)(ws + WS_WOUT) + (size_t)l * DM * DM, DM, 32 * nb, 64 * kb, scr, lane);
            continue; }
        r -= N2;
        if (r < N3) {
            const int le = r / 512, kb = (r % 512) / 32, nb = r % 32;
            const int n = 32 * nb + (lane & 31), jt = n >> 8, bj = (n >> 7) & 1, i = n & 127;
            const float* src = (bj ? a.in[I_WU] : a.in[I_WG]) + (size_t)le * DM * DE;
            transpose_item_f8(src, DE, 64 * kb, jt * 128 + i, (unsigned char*)(ws + WS_WGU) + (size_t)le * DM * DM, DM, 32 * nb, 64 * kb, scr, lane);
            continue; }
        r -= N3;
        if (r < N4) {
            const int le = r / 256, kb = (r % 256) / 32, nb = r % 32;
            transpose_item_f8(a.in[I_WDN] + (size_t)le * DE * DM, DM, 64 * kb, 32 * nb + (lane & 31), (unsigned char*)(ws + WS_WD) + (size_t)le * DM * DE, DE, 32 * nb, 64 * kb, scr, lane);
            continue; }
        r -= N4;
        if (r < N5) {
            const int l = r / 1024, kdg = (r % 1024) / 16, nb = r % 16;
            const int n = nb * 64 + lane, kd0 = kdg * 8, g = kd0 >> 7, c0 = kd0 & 127;
            const float* wo = a.in[I_WOUT] + (size_t)l * DM * DM + (size_t)(512 + g * 128) * DM + n;
            const float* ps = a.in[I_PSCALE] + l * 512 + g * 128;
            const float* wp = a.in[I_WPOOL] + ((size_t)(l * 4 + g) * 128 + c0) * 128;
            float acc[8];
#pragma unroll
            for (int j = 0; j < 8; ++j) acc[j] = 0.f;
            for (int e = 0; e < 128; ++e) { const float w = wo[(size_t)e * DM] * ps[e];
#pragma unroll
                for (int j = 0; j < 8; ++j) acc[j] += wp[j * 128 + e] * w; }
            u32x4 o; o.x = pk2(acc[0], acc[1]); o.y = pk2(acc[2], acc[3]); o.z = pk2(acc[4], acc[5]); o.w = pk2(acc[6], acc[7]);
            *(u32x4*)((bf16_t*)(ws + WS_WOUT) + (size_t)l * DM * DM + (size_t)n * DM + 512 + kd0) = o;
            continue; }
        r -= N5;
        {
            const int ent = r * 64 + lane, pos = ent >> 3, i = ent & 7;
            const float inv = (float)exp2(-(double)i / 8.0 * 18.931568569324174);
            const float ang = (float)pos * inv;
            float* t = (float*)(ws + WS_ROPE) + ent * 2;
            t[0] = (float)cos((double)ang); t[1] = (float)sin((double)ang);
        }
    }
    for (int i = c.bid * 512 + c.tid; i < 2 * NB * NH * NBLK * HD; i += c.G * 512) ((float*)(ws + WS_KBAR))[i] = 0.f;
    __syncthreads();
    if (c.bid < 192) {
        float* condT = (float*)c.lds;
        float* red = (float*)(c.lds + 65536);
        for (int idx = c.tid; idx < NB * DM; idx += 512) { const int b = idx >> 10, k = idx & 1023; const float v = a.in[I_C][idx]; condT[k * 16 + b] = v / (1.f + __expf(-v)); }
        __syncthreads();
        for (int u = c.bid; u < 192; u += c.G) {
            const int l = u / 96, n0 = (u % 96) * 64;
            const float* W = a.in[I_WMOD] + (size_t)l * DM * NMOD + n0 + lane;
            float acc[16];
#pragma unroll
            for (int b = 0; b < 16; ++b) acc[b] = 0.f;
            for (int k = 128 * c.wave; k < 128 * c.wave + 128; k += 8) {
                float wv[8];
#pragma unroll
                for (int j = 0; j < 8; ++j) wv[j] = W[(size_t)(k + j) * NMOD];
#pragma unroll
                for (int j = 0; j < 8; ++j) {
                    const f32x4* cp = (const f32x4*)(condT + (k + j) * 16);
#pragma unroll
                    for (int q = 0; q < 4; ++q) { const f32x4 cv = cp[q]; acc[4 * q + 0] += cv.x * wv[j]; acc[4 * q + 1] += cv.y * wv[j]; acc[4 * q + 2] += cv.z * wv[j]; acc[4 * q + 3] += cv.w * wv[j]; }
                }
            }
#pragma unroll
            for (int b = 0; b < 16; ++b) red[(c.wave * 16 + b) * 64 + lane] = acc[b];
            __syncthreads();
            for (int o = c.tid; o < 1024; o += 512) { const int b = o >> 6, cc = o & 63; float s = a.in[I_BMOD][l * NMOD + n0 + cc];
#pragma unroll
                for (int w = 0; w < 8; ++w) s += red[(w * 16 + b) * 64 + cc];
                ((float*)(ws + WS_MOD))[(size_t)(l * NB + b) * NMOD + n0 + cc] = s; }
            __syncthreads();
        }
    }
}

DEVFN void row_stats(const f32x4 (&v)[4], float& mean, float& rstd) {
    float s = 0.f;
#pragma unroll
    for (int j = 0; j < 4; ++j) s += (v[j].x + v[j].y) + (v[j].z + v[j].w);
    mean = wave_sum(s) * (1.f / DM);
    float q = 0.f;
#pragma unroll
    for (int j = 0; j < 4; ++j) { const f32x4 d = v[j] - mean; q += (d.x * d.x + d.y * d.y) + (d.z * d.z + d.w * d.w); }
    rstd = 1.f / sqrtf(wave_sum(q) * (1.f / DM) + LN_EPS);
}
DEVFN void row_load(const float* p, int lane, f32x4 (&v)[4]) {
#pragma unroll
    for (int j = 0; j < 4; ++j) v[j] = *(const f32x4*)(p + 4 * lane + 256 * j);
}
DEVFN void row_mod_store(f32x4 (&v)[4], const float* sc, const float* sh, bf16_t* out, int lane) {
    float mean, rstd; row_stats(v, mean, rstd);
#pragma unroll
    for (int j = 0; j < 4; ++j) {
        const f32x4 s = *(const f32x4*)(sc + 4 * lane + 256 * j), h = *(const f32x4*)(sh + 4 * lane + 256 * j);
        v[j] = (v[j] - mean) * rstd * (s + 1.f) + h;
        u32x2 o; o.x = pk2(v[j].x, v[j].y); o.y = pk2(v[j].z, v[j].w);
        *(u32x2*)(out + 4 * lane + 256 * j) = o;
    }
}

DEVFN void wave_gemm32(f32x16& acc, const bf16_t* ap, const bf16_t* bp, int K) {
#pragma unroll 4
    for (int k = 0; k < K; k += 16) {
        const bf16x8 av = *(const bf16x8*)(ap + k), bv = *(const bf16x8*)(bp + k);
        acc = __builtin_amdgcn_mfma_f32_32x32x16_bf16(av, bv, acc, 0, 0, 0);
    }
}

DEVFN void ph_inproj_naive(const Args& a, const Ctx& c, int l) {
    const bf16_t* A = (const bf16_t*)(a.ws + WS_HB); const bf16_t* Bt = (const bf16_t*)(a.ws + WS_WIN) + (size_t)l * DIN * DM;
    bf16_t* O = (bf16_t*)(a.ws + WS_QKVP);
    const int r32 = c.lane & 31, hi = c.lane >> 5, wy = c.wave >> 2, wx = c.wave & 3;
    for (int u = c.bid; u < 512 * 16; u += c.G) {
        const int mt = u >> 4, nt = u & 15;
        f32x16 acc = {};
        wave_gemm32(acc, A + (size_t)(mt * 64 + wy * 32 + r32) * DM + hi * 8, Bt + (size_t)(nt * 128 + wx * 32 + r32) * DM + hi * 8, DM);
        const int nl = inproj_nlog(nt * 128 + wx * 32 + r32);
#pragma unroll
        for (int r = 0; r < 16; ++r) O[(size_t)(mt * 64 + wy * 32 + crow(r, hi)) * DIN + nl] = (bf16_t)f2bf(acc[r]);
    }
}

DEVFN void ph_rope_naive(const Args& a, const Ctx& c) {
    bf16_t* O = (bf16_t*)(a.ws + WS_QKVP); const float* rope = (const float*)(a.ws + WS_ROPE);
    for (int idx = c.bid * 512 + c.tid; idx < NTOK * 16; idx += c.G * 512) {
        const int which = idx & 1, hh = (idx >> 1) & 7, m = idx >> 4, t = m & (SEQ - 1);
        bf16_t* p = O + (size_t)m * DIN + which * 512 + hh * 64;
        float v[64];
#pragma unroll
        for (int q = 0; q < 8; ++q) { const u32x4 w = *(const u32x4*)(p + 8 * q);
            v[8 * q + 0] = bf_lo(w.x); v[8 * q + 1] = bf_hi(w.x); v[8 * q + 2] = bf_lo(w.y); v[8 * q + 3] = bf_hi(w.y);
            v[8 * q + 4] = bf_lo(w.z); v[8 * q + 5] = bf_hi(w.z); v[8 * q + 6] = bf_lo(w.w); v[8 * q + 7] = bf_hi(w.w); }
#pragma unroll
        for (int i = 0; i < 8; ++i) { const float cs = rope[(t * 8 + i) * 2], sn = rope[(t * 8 + i) * 2 + 1]; const float x1 = v[i], x2 = v[8 + i];
            v[i] = x1 * cs - x2 * sn; v[8 + i] = x2 * cs + x1 * sn; }
        const float sc = which == 0 ? QSCALE : 1.f;
#pragma unroll
        for (int q = 0; q < 8; ++q) { u32x4 w; w.x = pk2(v[8 * q] * sc, v[8 * q + 1] * sc); w.y = pk2(v[8 * q + 2] * sc, v[8 * q + 3] * sc); w.z = pk2(v[8 * q + 4] * sc, v[8 * q + 5] * sc); w.w = pk2(v[8 * q + 6] * sc, v[8 * q + 7] * sc);
            *(u32x4*)(p + 8 * q) = w; }
    }
}

DEVFN void ph_kbar(const Args& a, const Ctx& c, int l) {
    const bf16_t* O = (const bf16_t*)(a.ws + WS_QKVP); float* kbar = (float*)(a.ws + WS_KBAR) + (size_t)l * NB * NH * NBLK * HD;
    for (int it = c.gw; it < NB * NH * NBLK; it += c.NGW) {
        const int n = it & 7, hh = (it >> 3) & 7, b = it >> 6;
        const bf16_t* p = O + (size_t)(b * SEQ + n * MBLK) * DIN + 512 + hh * 64 + c.lane;
        float s = 0.f;
#pragma unroll 8
        for (int j = 0; j < MBLK; ++j) s += bf2f(p[(size_t)j * DIN]);
        kbar[(size_t)it * 64 + c.lane] = s * (1.f / MBLK);
    }
}

DEVFN void ph_pool(const Args& a, const Ctx& c) {
    const bf16_t* P = (const bf16_t*)(a.ws + WS_QKVP) + 1536; bf16_t* AD = (bf16_t*)(a.ws + WS_AD) + 512;
    for (int it = c.bid * 512 + c.tid; it < (NTOK / 16) * 64; it += c.G * 512) {
        const int cg = it & 63, m0 = (it >> 6) * 16, t0 = m0 & (SEQ - 1), g = cg >> 4, w = 2 << g;
        const bf16_t* pc = P + cg * 8;
        float s[8];
#pragma unroll
        for (int j = 0; j < 8; ++j) s[j] = 0.f;
        for (int i = 1; i < w; ++i) if (t0 - i >= 0) { const u32x4 v = *(const u32x4*)(pc + (size_t)(m0 - i) * DIN);
            s[0] += bf_lo(v.x); s[1] += bf_hi(v.x); s[2] += bf_lo(v.y); s[3] += bf_hi(v.y); s[4] += bf_lo(v.z); s[5] += bf_hi(v.z); s[6] += bf_lo(v.w); s[7] += bf_hi(v.w); }
#pragma unroll 4
        for (int r = 0; r < 16; ++r) {
            const int t = t0 + r; const u32x4 v = *(const u32x4*)(pc + (size_t)(m0 + r) * DIN);
            const float f[8] = {bf_lo(v.x), bf_hi(v.x), bf_lo(v.y), bf_hi(v.y), bf_lo(v.z), bf_hi(v.z), bf_lo(v.w), bf_hi(v.w)};
#pragma unroll
            for (int j = 0; j < 8; ++j) s[j] += f[j];
            const int cnt = (t + 1 < w) ? t + 1 : w; const float ic = 1.f / (float)cnt;
            u32x4 o; o.x = pk2(s[0] * ic - f[0], s[1] * ic - f[1]); o.y = pk2(s[2] * ic - f[2], s[3] * ic - f[3]); o.z = pk2(s[4] * ic - f[4], s[5] * ic - f[5]); o.w = pk2(s[6] * ic - f[6], s[7] * ic - f[7]);
            *(u32x4*)(AD + (size_t)(m0 + r) * DM + cg * 8) = o;
            if (t - w + 1 >= 0) { const u32x4 q = *(const u32x4*)(pc + (size_t)(m0 + r - w + 1) * DIN);
                s[0] -= bf_lo(q.x); s[1] -= bf_hi(q.x); s[2] -= bf_lo(q.y); s[3] -= bf_hi(q.y); s[4] -= bf_lo(q.z); s[5] -= bf_hi(q.z); s[6] -= bf_lo(q.w); s[7] -= bf_hi(q.w); }
        }
    }
}

DEVFN void ph_wout_naive(const Args& a, const Ctx& c, int l) {
    const bf16_t* A = (const bf16_t*)(a.ws + WS_AD); const bf16_t* Bt = (const bf16_t*)(a.ws + WS_WOUT) + (size_t)l * DM * DM;
    float* Y = (float*)(a.ws + WS_QKVP);
    const int r32 = c.lane & 31, hi = c.lane >> 5, wy = c.wave >> 2, wx = c.wave & 3;
    for (int u = c.bid; u < 512 * 8; u += c.G) {
        const int mt = u >> 3, nt = u & 7;
        f32x16 acc = {};
        wave_gemm32(acc, A + (size_t)(mt * 64 + wy * 32 + r32) * DM + hi * 8, Bt + (size_t)(nt * 128 + wx * 32 + r32) * DM + hi * 8, DM);
#pragma unroll
        for (int r = 0; r < 16; ++r) Y[(size_t)(mt * 64 + wy * 32 + crow(r, hi)) * DM + nt * 128 + wx * 32 + r32] = acc[r];
    }
}

struct MoeTab { int* cnt; int* tp; };
DEVFN MoeTab moe_table(const Args& a, const Ctx& c, int l, unsigned char* lds_at) {
    MoeTab t; t.cnt = (int*)lds_at; t.tp = t.cnt + 32;
    if (c.tid < NCLS) t.cnt[c.tid] = (int)__hip_atomic_load((unsigned*)(a.ws + WS_CTL) + CW_CNT + l * 32 + c.tid, RLX_AGENT);
    __syncthreads();
    if (c.tid == 0) { int s = 0; for (int k = 0; k < NCLS; ++k) { t.tp[k] = s; s += (t.cnt[k] + 255) >> 8; } t.tp[NCLS] = s; }
    __syncthreads();
    return t;
}
DEVFN void cls_experts(int cls, int& e1, int& e2) { const int g = cls / 6, p = cls % 6; const int lo = p < 3 ? 0 : (p < 5 ? 1 : 2), hi = p < 3 ? p + 1 : (p < 5 ? p - 1 : 3); e1 = g * 4 + lo; e2 = g * 4 + hi; }

DEVFN void ph_gateup_naive(const Args& a, const Ctx& c, int l) {
    const MoeTab T = moe_table(a, c, l, c.lds);
    const int ntiles = T.tp[NCLS];
    const bf16_t* HB = (const bf16_t*)(a.ws + WS_HB); const bf16_t* WGU = (const bf16_t*)(a.ws + WS_WGU) + (size_t)l * NE * DM * DM;
    const int* list = (const int*)(a.ws + WS_LIST); const float* rw = (const float*)(a.ws + WS_RW);
    bf16_t* ACT = (bf16_t*)(a.ws + WS_QKVP);
    const int r32 = c.lane & 31, hi = c.lane >> 5, wy = c.wave >> 2, wx = c.wave & 3;
    for (int u = c.bid; u < ntiles * 32; u += c.G) {
        const int Tt = u >> 5, sub = (u >> 3) & 3, half = (u >> 2) & 1, jt = u & 3;
        int cls = 0; while (Tt >= T.tp[cls + 1]) ++cls;
        const int j = Tt - T.tp[cls], cnt = T.cnt[cls];
        int e1, e2; cls_experts(cls, e1, e2); const int e = half ? e2 : e1;
        const int lr = sub * 64 + wy * 32 + r32, li = 256 * j + lr;
        const int tok = list[(size_t)cls * LISTCAP + (li < cnt ? li : 256 * j)];
        const bf16_t* ap = HB + (size_t)tok * DM + hi * 8;
        const bf16_t* bg = WGU + (size_t)e * DM * DM + (size_t)(jt * 256 + wx * 32 + r32) * DM + hi * 8;
        f32x16 ag = {}, au = {};
        wave_gemm32(ag, ap, bg, DM); wave_gemm32(au, ap, bg + (size_t)128 * DM, DM);
#pragma unroll
        for (int r = 0; r < 16; ++r) {
            const int lro = sub * 64 + wy * 32 + crow(r, hi), lio = 256 * j + lro;
            const float wgt = lio < cnt ? rw[((size_t)cls * LISTCAP + lio) * 2 + half] : 0.f;
            const float g = ag[r], act = g / (1.f + __expf(-g)) * au[r] * wgt;
            ACT[(size_t)(256 * Tt + lro) * DM + half * 512 + jt * 128 + wx * 32 + r32] = (bf16_t)f2bf(act);
        }
    }
}

DEVFN void ph_down_naive(const Args& a, const Ctx& c, int l) {
    const MoeTab T = moe_table(a, c, l, c.lds);
    const int ntiles = T.tp[NCLS];
    const bf16_t* ACT = (const bf16_t*)(a.ws + WS_QKVP); const bf16_t* WD = (const bf16_t*)(a.ws + WS_WD) + (size_t)l * NE * DM * DE;
    const int* list = (const int*)(a.ws + WS_LIST);
    bf16_t* Y2 = (bf16_t*)(a.ws + WS_AD);
    const int r32 = c.lane & 31, hi = c.lane >> 5, wy = c.wave >> 2, wx = c.wave & 3;
    for (int u = c.bid; u < ntiles * 32; u += c.G) {
        const int Tt = u >> 5, sub = (u >> 3) & 3, nt = u & 7;
        int cls = 0; while (Tt >= T.tp[cls + 1]) ++cls;
        const int j = Tt - T.tp[cls], cnt = T.cnt[cls];
        int e1, e2; cls_experts(cls, e1, e2);
        const bf16_t* ap = ACT + (size_t)(256 * Tt + sub * 64 + wy * 32 + r32) * DM + hi * 8;
        const int n = nt * 128 + wx * 32 + r32;
        f32x16 acc = {};
        wave_gemm32(acc, ap, WD + (size_t)e1 * DM * DE + (size_t)n * DE + hi * 8, DE);
        wave_gemm32(acc, ap + DE, WD + (size_t)e2 * DM * DE + (size_t)n * DE + hi * 8, DE);
#pragma unroll
        for (int r = 0; r < 16; ++r) {
            const int lio = 256 * j + sub * 64 + wy * 32 + crow(r, hi);
            if (lio < cnt) { const int tok = list[(size_t)cls * LISTCAP + lio]; Y2[(size_t)tok * DM + n] = (bf16_t)f2bf(acc[r]); }
        }
    }
}

constexpr size_t WS_X1B = WS_X1, WS_X2B = WS_X1 + 64 * MiB;
constexpr int ROWS_PER_WAVE = 16;
DEVFN void vec_load(const float* p, int lane, f32x4 (&v)[4]) {
#pragma unroll
    for (int j = 0; j < 4; ++j) v[j] = *(const f32x4*)(p + 4 * lane + 256 * j);
}
DEVFN void bfrow_load(const bf16_t* p, int lane, u32x2 (&w)[4]) {
#pragma unroll
    for (int j = 0; j < 4; ++j) w[j] = *(const u32x2*)(p + 4 * lane + 256 * j);
}
DEVFN f32x4 bf4(u32x2 w) { return (f32x4){bf_lo(w.x), bf_hi(w.x), bf_lo(w.y), bf_hi(w.y)}; }
DEVFN void bfrow_store(bf16_t* p, int lane, const f32x4 (&v)[4]) {
#pragma unroll
    for (int j = 0; j < 4; ++j) { u32x2 o; o.x = pk2(v[j].x, v[j].y); o.y = pk2(v[j].z, v[j].w); *(u32x2*)(p + 4 * lane + 256 * j) = o; }
}
DEVFN void ln_mod(f32x4 (&v)[4], const f32x4 (&sc)[4], const f32x4 (&sh)[4]) {
    float mean, rstd; row_stats(v, mean, rstd);
#pragma unroll
    for (int j = 0; j < 4; ++j) v[j] = (v[j] - mean) * rstd * (sc[j] + 1.f) + sh[j];
}
DEVFN void ln_aff(f32x4 (&v)[4], const f32x4 (&g)[4], const f32x4 (&b)[4]) {
    float mean, rstd; row_stats(v, mean, rstd);
#pragma unroll
    for (int j = 0; j < 4; ++j) v[j] = (v[j] - mean) * rstd * g[j] + b[j];
}

DEVFN void ph_h1_rows(const Args& a, const Ctx& c) {
    const float* mod = (const float*)(a.ws + WS_MOD); bf16_t* HB = (bf16_t*)(a.ws + WS_HB);
    for (int base = c.gw * ROWS_PER_WAVE; base < NTOK; base += c.NGW * ROWS_PER_WAVE) {
        const float* mb = mod + (size_t)(base >> 11) * NMOD;
        f32x4 sc[4], sh[4]; vec_load(mb + DM, c.lane, sc); vec_load(mb, c.lane, sh);
        f32x4 cur[4], nxt[4]; vec_load(a.in[I_X] + (size_t)base * DM, c.lane, cur);
#pragma unroll 1
        for (int i = 0; i < ROWS_PER_WAVE; ++i) {
            const int m = base + i;
            if (i + 1 < ROWS_PER_WAVE) vec_load(a.in[I_X] + (size_t)(m + 1) * DM, c.lane, nxt);
            ln_mod(cur, sc, sh); bfrow_store(HB + (size_t)m * DM, c.lane, cur);
#pragma unroll
            for (int j = 0; j < 4; ++j) cur[j] = nxt[j];
        }
    }
}

DEVFN f32x4 reduce16(const float (&lg)[16]) {
    float t[8], u[4];
#pragma unroll
    for (int e = 0; e < 8; ++e) { auto rr = __builtin_amdgcn_permlane32_swap(__float_as_uint(lg[e]), __float_as_uint(lg[e + 8]), false, false); t[e] = __uint_as_float(rr[0]) + __uint_as_float(rr[1]); }
#pragma unroll
    for (int k = 0; k < 4; ++k) { auto rr = __builtin_amdgcn_permlane16_swap(__float_as_uint(t[k]), __float_as_uint(t[k + 4]), false, false); u[k] = __uint_as_float(rr[0]) + __uint_as_float(rr[1]); }
#pragma unroll
    for (int k = 0; k < 4; ++k) { u[k] = swz_xor_add(u[k], 1); u[k] = swz_xor_add(u[k], 2); u[k] = swz_xor_add(u[k], 4); u[k] = swz_xor_add(u[k], 8); }
    return (f32x4){u[0], u[1], u[2], u[3]};
}

DEVFN void ph_rows_c(const Args& a, const Ctx& c, int l, bool publish) {
    const float* mod = (const float*)(a.ws + WS_MOD) + (size_t)l * NB * NMOD;
    const bf16_t* Y = (const bf16_t*)(a.ws + WS_QKVP); const bf16_t* X2B = (const bf16_t*)(a.ws + WS_X2B);
    bf16_t* X1B = (bf16_t*)(a.ws + WS_X1B); bf16_t* HB = (bf16_t*)(a.ws + WS_HB);
    float* wr = (float*)c.lds;
    int* lcnt = (int*)(c.lds + 65536); int* lbase = lcnt + 32;
    int* rcls = lbase + 32; float* rw1 = (float*)(rcls + 8 * 64); float* rw2 = rw1 + 8 * 64; int* rrow = (int*)(rw2 + 8 * 64); float* lgs = (float*)(rrow + 8 * 64);
    for (int i = c.tid; i < DM * NE; i += 512) wr[(i & 15) * DM + (i >> 4)] = a.in[I_WR][i];
    if (c.tid < 32) lcnt[c.tid] = 0;
    __syncthreads();
    int nr = 0;
    for (int base = c.gw * ROWS_PER_WAVE; base < NTOK; base += c.NGW * ROWS_PER_WAVE) {
        const float* mb = mod + (size_t)(base >> 11) * NMOD;
        f32x4 g1[4], sc[4], sh[4];
        vec_load(mb + 2 * DM, c.lane, g1); vec_load(mb + 4 * DM, c.lane, sc); vec_load(mb + 3 * DM, c.lane, sh);
        f32x4 xc[4], xn[4]; u32x2 yc[4], yn[4];
        if (l == 0) vec_load(a.in[I_X] + (size_t)base * DM, c.lane, xc);
        else { u32x2 w[4]; bfrow_load(X2B + (size_t)base * DM, c.lane, w);
#pragma unroll
            for (int j = 0; j < 4; ++j) { xc[j].x = __uint_as_float(w[j].x); xc[j].y = __uint_as_float(w[j].y); } }
        bfrow_load(Y + (size_t)base * DM, c.lane, yc);
#pragma unroll 1
        for (int i = 0; i < ROWS_PER_WAVE; ++i) {
            const int m = base + i;
            if (i + 1 < ROWS_PER_WAVE) {
                if (l == 0) vec_load(a.in[I_X] + (size_t)(m + 1) * DM, c.lane, xn);
                else { u32x2 w[4]; bfrow_load(X2B + (size_t)(m + 1) * DM, c.lane, w);
#pragma unroll
                    for (int j = 0; j < 4; ++j) { xn[j].x = __uint_as_float(w[j].x); xn[j].y = __uint_as_float(w[j].y); } }
                bfrow_load(Y + (size_t)(m + 1) * DM, c.lane, yn);
            }
            f32x4 v[4];
#pragma unroll
            for (int j = 0; j < 4; ++j) { const f32x4 xv = (l == 0) ? xc[j] : bf4((u32x2){__float_as_uint(xc[j].x), __float_as_uint(xc[j].y)}); v[j] = xv * ALPHA + g1[j] * bf4(yc[j]); }
            { f32x4 lg[4], lb[4]; vec_load(a.in[I_LN1G] + l * DM, c.lane, lg); vec_load(a.in[I_LN1B] + l * DM, c.lane, lb); ln_aff(v, lg, lb); } bfrow_store(X1B + (size_t)m * DM, c.lane, v);
            ln_mod(v, sc, sh);
#pragma unroll
            for (int j = 0; j < 4; ++j) *(unsigned*)((unsigned char*)HB + (size_t)m * DM + 4 * c.lane + 256 * j) = pk4_fp8(v[j].x, v[j].y, v[j].z, v[j].w);
            float lg16[16];
#pragma unroll
            for (int e = 0; e < 16; ++e) lg16[e] = 0.f;
#pragma unroll
            for (int j = 0; j < 4; ++j)
#pragma unroll
                for (int e = 0; e < 16; ++e) { const f32x4 w = *(const f32x4*)(wr + e * DM + 4 * c.lane + 256 * j); lg16[e] += (v[j].x * w.x + v[j].y * w.y) + (v[j].z * w.z + v[j].w * w.w); }
            { const f32x4 uu = reduce16(lg16); if ((c.lane & 15) == 0) *(f32x4*)(lgs + (c.wave * 16 + i) * 16 + (c.lane >> 4) * 4) = uu; }
#pragma unroll
            for (int j = 0; j < 4; ++j) { xc[j] = xn[j]; yc[j] = yn[j]; }
        }
        LDS_WAIT();
        if (c.lane < ROWS_PER_WAVE) {
            float lg16[16], rb[16];
#pragma unroll
            for (int e = 0; e < 16; ++e) rb[e] = a.in[I_RB][e];
#pragma unroll
            for (int q = 0; q < 4; ++q) { const f32x4 t = *(const f32x4*)(lgs + (c.wave * 16 + c.lane) * 16 + 4 * q); lg16[4 * q] = t.x; lg16[4 * q + 1] = t.y; lg16[4 * q + 2] = t.z; lg16[4 * q + 3] = t.w; }
            float mx = lg16[0];
#pragma unroll
            for (int e = 1; e < 16; ++e) mx = fmaxf(mx, lg16[e]);
            float sum = 0.f, scr[16];
#pragma unroll
            for (int e = 0; e < 16; ++e) { scr[e] = __expf(lg16[e] - mx); sum += scr[e]; }
            const float isum = 1.f / sum;
#pragma unroll
            for (int e = 0; e < 16; ++e) scr[e] *= isum;
            float bestg = -3.4e38f; int gb = 0, bi1 = 0, bi2 = 1; float bw1 = 0.f, bw2 = 0.f;
#pragma unroll
            for (int g = 0; g < 4; ++g) {
                float m1 = scr[4 * g] + rb[4 * g], s1 = scr[4 * g]; int i1 = 0;
#pragma unroll
                for (int q = 1; q < 4; ++q) { const float sv = scr[4 * g + q] + rb[4 * g + q]; const bool ok = sv > m1; m1 = ok ? sv : m1; s1 = ok ? scr[4 * g + q] : s1; i1 = ok ? q : i1; }
                float m2 = -3.4e38f, s2 = 0.f; int i2 = 0;
#pragma unroll
                for (int q = 0; q < 4; ++q) { const float sv = scr[4 * g + q] + rb[4 * g + q]; const bool ok = (q != i1) && sv > m2; m2 = ok ? sv : m2; s2 = ok ? scr[4 * g + q] : s2; i2 = ok ? q : i2; }
                const float gs = m1 + m2; const bool better = gs > bestg;
                bestg = better ? gs : bestg; gb = better ? g : gb; bi1 = better ? i1 : bi1; bi2 = better ? i2 : bi2; bw1 = better ? s1 : bw1; bw2 = better ? s2 : bw2;
            }
            const float inv = 1.f / (bw1 + bw2);
            const int lo = bi1 < bi2 ? bi1 : bi2, hi2 = bi1 < bi2 ? bi2 : bi1;
            const float wlo = (bi1 < bi2 ? bw1 : bw2) * inv, whi = (bi1 < bi2 ? bw2 : bw1) * inv;
            const int pidx = lo == 0 ? hi2 - 1 : (lo == 1 ? hi2 + 1 : 5);
            const int slot = c.wave * 64 + nr + c.lane;
            rcls[slot] = gb * 6 + pidx; rw1[slot] = wlo; rw2[slot] = whi; rrow[slot] = base + c.lane;
        }
        nr += ROWS_PER_WAVE;
        LDS_WAIT();
    }
    LDS_WAIT();
    if (!publish) return;
    int rank = 0, cls = 0;
    if (c.lane < nr) { cls = rcls[c.wave * 64 + c.lane]; rank = atomicAdd(&lcnt[cls], 1); }
    __syncthreads();
    if (c.tid < NCLS) lbase[c.tid] = (int)__hip_atomic_fetch_add((unsigned*)(a.ws + WS_CTL) + CW_CNT + l * 32 + c.tid, (unsigned)lcnt[c.tid], RLX_AGENT);
    __syncthreads();
    if (c.lane < nr) {
        const int pos = lbase[cls] + rank;
        ((int*)(a.ws + WS_LIST))[(size_t)cls * LISTCAP + pos] = rrow[c.wave * 64 + c.lane];
        float* rw = (float*)(a.ws + WS_RW) + ((size_t)cls * LISTCAP + pos) * 2;
        rw[0] = rw1[c.wave * 64 + c.lane]; rw[1] = rw2[c.wave * 64 + c.lane];
    }
}

DEVFN void ph_rows_g(const Args& a, const Ctx& c, int l) {
    const float* mod = (const float*)(a.ws + WS_MOD) + (size_t)l * NB * NMOD;
    const bf16_t* X1B = (const bf16_t*)(a.ws + WS_X1B); const bf16_t* Y2 = (const bf16_t*)(a.ws + WS_AD);
    bf16_t* X2B = (bf16_t*)(a.ws + WS_X2B); bf16_t* HB = (bf16_t*)(a.ws + WS_HB);
    for (int base = c.gw * ROWS_PER_WAVE; base < NTOK; base += c.NGW * ROWS_PER_WAVE) {
        const float* mb = mod + (size_t)(base >> 11) * NMOD; const float* mb1 = mb + (size_t)NB * NMOD;
        f32x4 g2[4], lg[4], lb[4], sc[4], sh[4];
        vec_load(mb + 5 * DM, c.lane, g2); vec_load(a.in[I_LN2G] + l * DM, c.lane, lg); vec_load(a.in[I_LN2B] + l * DM, c.lane, lb);
        if (l == 0) { vec_load(mb1 + DM, c.lane, sc); vec_load(mb1, c.lane, sh); }
        u32x2 xc[4], xn[4], yc[4], yn[4];
        bfrow_load(X1B + (size_t)base * DM, c.lane, xc); bfrow_load(Y2 + (size_t)base * DM, c.lane, yc);
#pragma unroll 1
        for (int i = 0; i < ROWS_PER_WAVE; ++i) {
            const int m = base + i;
            if (i + 1 < ROWS_PER_WAVE) { bfrow_load(X1B + (size_t)(m + 1) * DM, c.lane, xn); bfrow_load(Y2 + (size_t)(m + 1) * DM, c.lane, yn); }
            f32x4 v[4];
#pragma unroll
            for (int j = 0; j < 4; ++j) v[j] = bf4(xc[j]) * ALPHA + g2[j] * bf4(yc[j]);
            ln_aff(v, lg, lb);
            if (l == 0) { bfrow_store(X2B + (size_t)m * DM, c.lane, v); ln_mod(v, sc, sh); bfrow_store(HB + (size_t)m * DM, c.lane, v); }
            else {
#pragma unroll
                for (int j = 0; j < 4; ++j) *(f32x4*)(a.out + (size_t)m * DM + 4 * c.lane + 256 * j) = v[j]; }
#pragma unroll
            for (int j = 0; j < 4; ++j) { xc[j] = xn[j]; yc[j] = yn[j]; }
        }
    }
}

constexpr int MOETAB_OFF = 131072 + 512;
DEVFN void ph_inproj_fast(const Args& a, const Ctx& c, int l, bool dummy_kbar) {
    pg8::DenseSched S; S.so.init(NTOK, DIN, c.G, c.bid); S.A = (const char*)(a.ws + WS_HB); S.Bt = (const char*)(a.ws + WS_WIN) + (size_t)l * DIN * DM * 2; S.lda = DM; S.ldb = DM;
    const pg8::EpiInproj E{(bf16_t*)(a.ws + WS_QKVP), (const float*)(a.ws + WS_ROPE), (dummy_kbar ? (float*)(a.ws + WS_RW) : (float*)(a.ws + WS_KBAR)) + (size_t)l * NB * NH * NBLK * HD};
    pg8::gemm_phase2<pg8::EpiInproj, pg8::DenseSched, true, false, false>(c.lds3, DM * 2, DM * 2, S, E, c.tid);
}
DEVFN void ph_wout_fast(const Args& a, const Ctx& c, int l) {
    pg8::DenseSched S; S.so.init(NTOK, DM, c.G, c.bid); S.A = (const char*)(a.ws + WS_AD); S.Bt = (const char*)(a.ws + WS_WOUT) + (size_t)l * DM * DM * 2; S.lda = DM; S.ldb = DM;
    const pg8::EpiBf16<0> E{(bf16_t*)(a.ws + WS_QKVP), DM, nullptr, 0, 0, 1.f};
    pg8::gemm_phase2<pg8::EpiBf16<0>, pg8::DenseSched, true, false, false>(c.lds3, DM * 2, DM * 2, S, E, c.tid);
}
DEVFN void moe_table_lds(const Args& a, const Ctx& c, int l) {
    int* cnt = (int*)(c.lds + MOETAB_OFF); int* tp = cnt + 32;
    if (c.tid < NCLS) cnt[c.tid] = (int)__hip_atomic_load((unsigned*)(a.ws + WS_CTL) + CW_CNT + l * 32 + c.tid, RLX_AGENT);
    __syncthreads();
    if (c.tid == 0) { int s = 0; for (int k = 0; k < NCLS; ++k) { tp[k] = s; s += (cnt[k] + 255) >> 8; } tp[NCLS] = s; }
    __syncthreads();
}
DEVFN void ph_gateup_fast(const Args& a, const Ctx& c, int l) {
    moe_table_lds(a, c, l);
    pg8::GateUpSched S; S.cnt = (const LAS int*)(c.lds3 + MOETAB_OFF); S.tp = S.cnt + 32; S.npn_shift = 3; S.nunits = S.tp[NCLS] * 8; S.G = c.G; S.c = c.bid;
    S.HB = (const char*)(a.ws + WS_HB); S.list = (const int*)(a.ws + WS_LIST); S.W = (const char*)(a.ws + WS_WGU) + (size_t)l * NE * DM * DM;
    const pg8::EpiGateUp E{(unsigned char*)(a.ws + WS_QKVP), (const float*)(a.ws + WS_RW)};
    pg8::gemm_phase2<pg8::EpiGateUp, pg8::GateUpSched, true, true, false, true, 127 - 5, 127>(c.lds3, DM, DM, S, E, c.tid);
}
DEVFN void ph_down_fast(const Args& a, const Ctx& c, int l) {
    moe_table_lds(a, c, l);
    pg8::DownSched S; S.cnt = (const LAS int*)(c.lds3 + MOETAB_OFF); S.tp = S.cnt + 32; S.npn_shift = 2; S.nunits = S.tp[NCLS] * 4; S.G = c.G; S.c = c.bid;
    S.ACT = (const char*)(a.ws + WS_QKVP); S.W = (const char*)(a.ws + WS_WD) + (size_t)l * NE * DM * DE;
    const pg8::EpiDown E{(bf16_t*)(a.ws + WS_AD), (const int*)(a.ws + WS_LIST)};
    pg8::gemm_phase2<pg8::EpiDown, pg8::DownSched, true, true, true, true, 127 - 5, 127 - 3>(c.lds3, DM, DE, S, E, c.tid);
}

#ifndef MK_N_LAUNCHES
#define MK_N_LAUNCHES 1
#endif
constexpr int RING_BYTES = 131072, LDSCTL_OFF = RING_BYTES, MISC_OFF = LDSCTL_OFF + 320, LDS_BYTES = 147456;
constexpr int PH_PER_LAYER = 7, NPHASE = 2 + 2 * PH_PER_LAYER;
constexpr int CW_BAR = 4096;
static_assert((CW_BAR + XCD_BAR_WORDS) * 4 <= (int)CTL_ZERO_BYTES, "CTL");

__global__ void __launch_bounds__(512, 2) fwd(Args a) {
    extern __shared__ __attribute__((aligned(16))) unsigned char lds[];
    const int wave_s = __builtin_amdgcn_readfirstlane(threadIdx.x >> 6);
#define MKTID() (wave_s * 64 + lane_id_volatile())
#define MKCTX() Args al = a; { size_t z_ = 0; asm volatile("" : "+s"(z_)); al.ws = a.ws + z_; } Ctx c; {     int t_ = MKTID(); asm volatile("" : "+v"(t_)); c.lds = lds; c.lds3 = (LAS unsigned char*)lds; c.tid = t_; c.lane = t_ & 63; c.wave = __builtin_amdgcn_readfirstlane(t_ >> 6); c.G = gridDim.x; c.bid = blockIdx.x; c.gw = c.bid * 8 + c.wave; c.NGW = c.G * 8; }
    const int lo = a.ph_lo, hi = a.ph_hi;
    const bool one = (hi - lo) > 1;
    for (int u = threadIdx.x; u < (LDS_BYTES - LDSCTL_OFF) / 4; u += 512) ((LAS unsigned*)((LAS unsigned char*)lds + LDSCTL_OFF))[u] = 0u;
    __syncthreads();
    XcdBarrier bar; bar.bar = (unsigned*)(a.ws + WS_CTL) + CW_BAR; bar.x = 0; bar.st = nullptr;
    if (one) bar = xcd_barrier_post((unsigned*)(a.ws + WS_CTL) + CW_BAR, (volatile LAS unsigned*)((LAS unsigned char*)lds + MISC_OFF) + 8);
#ifndef REP_PHASE
#define REP_PHASE -1
#endif
#define IN(k) (lo <= (k) && (k) < hi)
#define SEAM(k) do { if (IN(k) && IN((k) + 1)) { XcdBarrier bl_ = bar; { size_t z_ = 0; unsigned x_ = bar.x; asm volatile("" : "+s"(z_), "+s"(x_)); bl_.bar = bar.bar + z_; bl_.x = x_; } xcd_barrier(bl_, MKTID() == 0); } } while (0)
    if (IN(0)) { MKCTX(); ph_prologue(al, c); if (REP_PHASE == 0) { __syncthreads(); ph_prologue(al, c); } SEAM(0); }
    if (IN(1)) { MKCTX(); ph_h1_rows(al, c); if (REP_PHASE == 1) ph_h1_rows(al, c); SEAM(1); }
    {
        constexpr int l = 0; constexpr int p0 = 2 + l * PH_PER_LAYER;
        if (IN(p0 + 0)) { MKCTX(); ph_inproj_fast(al, c, l, false); if (REP_PHASE == 10) { __syncthreads(); ph_inproj_fast(al, c, l, true); } SEAM(p0 + 0); }
        if (IN(p0 + 1)) {
            { MKCTX(); ph_pool(al, c); }
            __syncthreads();
            const attn_body::AttnTensors AT{(const attn_body::bf16*)(a.ws + WS_QKVP), (const attn_body::bf16*)(a.ws + WS_QKVP) + 512, (const attn_body::bf16*)(a.ws + WS_QKVP) + 1024,
                                            (attn_body::bf16*)(a.ws + WS_AD), (const float*)(a.ws + WS_KBAR) + (size_t)l * NB * NH * NBLK * HD};
            const attn_body::StaticOrder S((int)gridDim.x, (int)blockIdx.x);
            attn_body::attn_phase<attn_body::StaticOrder>((char*)lds, AT, S, MKTID());
            if (REP_PHASE == 11) attn_body::attn_phase<attn_body::StaticOrder>((char*)lds, AT, S, MKTID());
            if (REP_PHASE == 17) { __syncthreads(); MKCTX(); ph_pool(al, c); }
            SEAM(p0 + 1);
        }
        if (IN(p0 + 2)) { MKCTX(); ph_wout_fast(al, c, l); if (REP_PHASE == 12) { __syncthreads(); ph_wout_fast(al, c, l); } SEAM(p0 + 2); }
        if (IN(p0 + 3)) { MKCTX(); if (REP_PHASE == 13) { ph_rows_c(al, c, l, false); __syncthreads(); } ph_rows_c(al, c, l, true); SEAM(p0 + 3); }
        if (IN(p0 + 4)) { MKCTX(); ph_gateup_fast(al, c, l); if (REP_PHASE == 14) { __syncthreads(); ph_gateup_fast(al, c, l); } SEAM(p0 + 4); }
        if (IN(p0 + 5)) { MKCTX(); ph_down_fast(al, c, l); if (REP_PHASE == 15) { __syncthreads(); ph_down_fast(al, c, l); } SEAM(p0 + 5); }
        if (IN(p0 + 6)) { MKCTX(); ph_rows_g(al, c, l); if (REP_PHASE == 16) ph_rows_g(al, c, l); SEAM(p0 + 6); }
    }
    {
        constexpr int l = 1; constexpr int p0 = 2 + l * PH_PER_LAYER;
        if (IN(p0 + 0)) { MKCTX(); ph_inproj_fast(al, c, l, false); if (REP_PHASE == 10) { __syncthreads(); ph_inproj_fast(al, c, l, true); } SEAM(p0 + 0); }
        if (IN(p0 + 1)) {
            { MKCTX(); ph_pool(al, c); }
            __syncthreads();
            const attn_body::AttnTensors AT{(const attn_body::bf16*)(a.ws + WS_QKVP), (const attn_body::bf16*)(a.ws + WS_QKVP) + 512, (const attn_body::bf16*)(a.ws + WS_QKVP) + 1024,
                                            (attn_body::bf16*)(a.ws + WS_AD), (const float*)(a.ws + WS_KBAR) + (size_t)l * NB * NH * NBLK * HD};
            const attn_body::StaticOrder S((int)gridDim.x, (int)blockIdx.x);
            attn_body::attn_phase<attn_body::StaticOrder>((char*)lds, AT, S, MKTID());
            if (REP_PHASE == 11) attn_body::attn_phase<attn_body::StaticOrder>((char*)lds, AT, S, MKTID());
            if (REP_PHASE == 17) { __syncthreads(); MKCTX(); ph_pool(al, c); }
            SEAM(p0 + 1);
        }
        if (IN(p0 + 2)) { MKCTX(); ph_wout_fast(al, c, l); if (REP_PHASE == 12) { __syncthreads(); ph_wout_fast(al, c, l); } SEAM(p0 + 2); }
        if (IN(p0 + 3)) { MKCTX(); if (REP_PHASE == 13) { ph_rows_c(al, c, l, false); __syncthreads(); } ph_rows_c(al, c, l, true); SEAM(p0 + 3); }
        if (IN(p0 + 4)) { MKCTX(); ph_gateup_fast(al, c, l); if (REP_PHASE == 14) { __syncthreads(); ph_gateup_fast(al, c, l); } SEAM(p0 + 4); }
        if (IN(p0 + 5)) { MKCTX(); ph_down_fast(al, c, l); if (REP_PHASE == 15) { __syncthreads(); ph_down_fast(al, c, l); } SEAM(p0 + 5); }
        if (IN(p0 + 6)) { MKCTX(); ph_rows_g(al, c, l); if (REP_PHASE == 16) ph_rows_g(al, c, l); SEAM(p0 + 6); }
    }
#undef IN
#undef SEAM
}

extern "C" void kernel_launch(void* const* d_in, const int* in_sizes, int n_in, void* d_out, int out_size, void* d_ws, size_t ws_size, hipStream_t stream) {
    static int grid = 0;
    if (grid == 0) {
        if (n_in != 17 || out_size != NTOK * DM || ws_size < WS_END) { fprintf(stderr, "kernel_launch: unexpected problem (n_in %d out %d ws %zu)\n", n_in, out_size, ws_size); grid = -1; return; }
        if (hipFuncSetAttribute((const void*)fwd, hipFuncAttributeMaxDynamicSharedMemorySize, LDS_BYTES) != hipSuccess) { fprintf(stderr, "kernel_launch: hipFuncSetAttribute failed\n"); grid = -1; return; }
        int dev = 0, cus = 0, per_cu = 0;
        (void)hipGetDevice(&dev); (void)hipDeviceGetAttribute(&cus, hipDeviceAttributeMultiprocessorCount, dev);
        if (hipOccupancyMaxActiveBlocksPerMultiprocessor(&per_cu, (const void*)fwd, 512, LDS_BYTES) != hipSuccess || per_cu < 1) fprintf(stderr, "kernel_launch: occupancy query reports %d workgroups per CU\n", per_cu);
        (void)hipGetLastError();
        grid = cus > 0 ? cus : 256;
    }
    if (grid < 0) return;
    (void)hipMemsetAsync((char*)d_ws + WS_CTL, 0, CTL_ZERO_BYTES, stream);
    Args a{};
    for (int i = 0; i < 17; ++i) a.in[i] = (const float*)d_in[i];
    a.out = (float*)d_out; a.ws = (unsigned char*)d_ws;
#if MK_N_LAUNCHES == 1
    a.ph_lo = 0; a.ph_hi = NPHASE; hipLaunchKernelGGL(fwd, dim3(grid), dim3(512), LDS_BYTES, stream, a);
#else
    for (int p = 0; p < NPHASE; ++p) { a.ph_lo = p; a.ph_hi = p + 1; hipLaunchKernelGGL(fwd, dim3(grid), dim3(512), LDS_BYTES, stream, a); }
#endif
}
```

```cpp
#include <hip/hip_runtime.h>
#include <cstdint>
#include <cstdio>

constexpr int NB = 16, SEQ = 2048, DM = 1024, NTOK = NB * SEQ, DIN = 2048, NH = 8, HD = 64, NBLK = 8, MBLK = 256;
constexpr int NE = 16, NCLS = 24, DE = 512, NMOD = 6 * DM;
constexpr float ALPHA = 1.41421356237309515f, LN_EPS = 1e-5f;
constexpr float QSCALE = 0.125f * 1.4426950408889634f;
constexpr int LISTCAP = NTOK;

constexpr size_t MiB = 1u << 20;
constexpr size_t WS_CTL = 0, CTL_ZERO_BYTES = 1 * MiB;
constexpr size_t WS_MOD = 1 * MiB;
constexpr size_t WS_ROPE = 2 * MiB;
constexpr size_t WS_KBAR = 2 * MiB + 256 * 1024;
constexpr size_t WS_LIST = 3 * MiB;
constexpr size_t WS_RW = 6 * MiB;
constexpr size_t WS_WIN = 12 * MiB;
constexpr size_t WS_WOUT = 20 * MiB;
constexpr size_t WS_WGU = 24 * MiB;
constexpr size_t WS_WD = 88 * MiB;
constexpr size_t WS_HB = 120 * MiB;
constexpr size_t WS_QKVP = 184 * MiB;
constexpr size_t WS_AD = 312 * MiB;
constexpr size_t WS_X1 = 376 * MiB;
constexpr size_t WS_END = 504 * MiB;
constexpr int CW_TMO = 0, CW_CNT = 64;

typedef unsigned short bf16_t;
typedef short bf16x8 __attribute__((ext_vector_type(8)));
typedef float f32x4 __attribute__((ext_vector_type(4)));
typedef float f32x16 __attribute__((ext_vector_type(16)));
typedef unsigned u32x4 __attribute__((ext_vector_type(4)));
typedef unsigned u32x2 __attribute__((ext_vector_type(2)));

#define DEVFN __device__ __forceinline__
#define LDS_WAIT() asm volatile("s_waitcnt lgkmcnt(0)" ::: "memory")
#define RLX_AGENT __ATOMIC_RELAXED, __HIP_MEMORY_SCOPE_AGENT

DEVFN float bf_lo(unsigned w) { return __uint_as_float(w << 16); }
DEVFN float bf_hi(unsigned w) { return __uint_as_float(w & 0xffff0000u); }
DEVFN float bf2f(bf16_t v) { return __uint_as_float((unsigned)v << 16); }
DEVFN unsigned f2bf(float f) { unsigned u = __float_as_uint(f); return (u + 0x7fffu + ((u >> 16) & 1u)) >> 16; }
DEVFN unsigned pk2(float lo, float hi) { return f2bf(lo) | (f2bf(hi) << 16); }
DEVFN unsigned pk4_fp8(float a, float b, float c, float d) {
    a = __builtin_amdgcn_fmed3f(a, -448.f, 448.f); b = __builtin_amdgcn_fmed3f(b, -448.f, 448.f); c = __builtin_amdgcn_fmed3f(c, -448.f, 448.f); d = __builtin_amdgcn_fmed3f(d, -448.f, 448.f);
    unsigned w = 0u; w = __builtin_amdgcn_cvt_pk_fp8_f32(a, b, w, false); w = __builtin_amdgcn_cvt_pk_fp8_f32(c, d, w, true); return w; }
DEVFN int crow(int r, int hi) { return (r & 3) + 8 * (r >> 2) + 4 * hi; }
#define SWZ_XOR(m) (0x1f | ((m) << 10))
DEVFN float swz_xor_add(float v, const int m) {
    switch (m) {
        case 1: return v + __int_as_float(__builtin_amdgcn_ds_swizzle(__float_as_int(v), SWZ_XOR(1)));
        case 2: return v + __int_as_float(__builtin_amdgcn_ds_swizzle(__float_as_int(v), SWZ_XOR(2)));
        case 4: return v + __int_as_float(__builtin_amdgcn_ds_swizzle(__float_as_int(v), SWZ_XOR(4)));
        case 8: return v + __int_as_float(__builtin_amdgcn_ds_swizzle(__float_as_int(v), SWZ_XOR(8)));
        default: return v + __int_as_float(__builtin_amdgcn_ds_swizzle(__float_as_int(v), SWZ_XOR(16)));
    }
}
DEVFN float half_swap_add(float v) { auto rr = __builtin_amdgcn_permlane32_swap(__float_as_uint(v), __float_as_uint(v), false, false); return __uint_as_float(rr[0]) + __uint_as_float(rr[1]); }
DEVFN float wave_sum(float v) {
    v = swz_xor_add(v, 1); v = swz_xor_add(v, 2); v = swz_xor_add(v, 4); v = swz_xor_add(v, 8); v = swz_xor_add(v, 16);
    return half_swap_add(v);
}
__host__ __device__ __forceinline__ int inproj_lgroup(int P) { return P < 16 ? (P >> 2) * 8 + (P & 3) * 2 : ((P - 16) >> 2) * 8 + ((P - 16) & 3) * 2 + 1; }
__host__ __device__ __forceinline__ int inproj_nlog(int n) { return (n & ~255) + inproj_lgroup((n & 255) >> 3) * 8 + (n & 7); }

#define GAS __attribute__((address_space(1)))
#define LAS __attribute__((address_space(3)))
typedef GAS unsigned gu32;
namespace pg8 {
#define PG8_LAS __attribute__((address_space(3)))
typedef unsigned short bf16_t;
typedef short bf16x8 __attribute__((ext_vector_type(8)));
typedef float f32x4 __attribute__((ext_vector_type(4)));
typedef unsigned u32x4 __attribute__((ext_vector_type(4)));
constexpr int BM = 256, BK = 64, HALF = 128, HTB = HALF * BK * 2  , STAGE_BYTES = 8 * HTB, NXCD = 8, WGM = 8;

__host__ __device__ __forceinline__ int lds_byte(int r, int c) { const int st = (r >> 4) * 2 + (c >> 5), rr = r & 15, cc = c & 31, ob = rr * 64 + cc * 2; return st * 1024 + (ob ^ (((ob >> 9) & 1) << 5)); }
__host__ __device__ __forceinline__ void stage_rc(int b, int& R, int& C) { const int st = b / 1024, sb = b % 1024, swz = sb ^ (((sb >> 9) & 1) << 5); R = (st >> 1) * 16 + swz / 64; C = (st & 1) * 32 + (swz % 64) / 2; }
__host__ __device__ __forceinline__ int perm32(int rho) { const int n = rho >> 4, i = rho & 15; return 8 * (i >> 2) + 4 * n + (i & 3); }

struct Unit { int pm, pn; };
struct Gemm { const bf16_t* A; const bf16_t* Bt; int M, N, K; };

struct StaticOrder {
    int nM, nN, nwg, G, c;
    __host__ __device__ void init(int M, int N, int G_, int c_) { nM = M / BM; nN = N / BM; nwg = nM * nN; G = G_; c = c_; }
    __host__ __device__ bool next(int i, Unit& u) const {
        const long L = (long)i * G + c; if (L >= nwg) return false;
        int wgid = (int)L; { const int q = nwg / NXCD, r = nwg % NXCD, xcd = wgid % NXCD, off = wgid / NXCD; wgid = (xcd < r ? xcd * (q + 1) : r * (q + 1) + (xcd - r) * q) + off; }
        const int nig = WGM * nN, gid = wgid / nig, fm = gid * WGM, gsz = (nM - fm) < WGM ? (nM - fm) : WGM;
        u.pm = fm + ((wgid % nig) % gsz); u.pn = (wgid % nig) / gsz; return true;
    }
    __device__ __forceinline__ void a_ready(const Unit&) const {}
    __device__ __forceinline__ void done(const Unit&) const {}
};

__device__ __forceinline__ unsigned cvt_pk_bf16(float lo, float hi) { unsigned r; asm volatile("v_cvt_pk_bf16_f32 %0, %1, %2" : "=v"(r) : "v"(lo), "v"(hi)); return r; }
typedef float f32x2 __attribute__((ext_vector_type(2)));
__device__ __forceinline__ f32x2 gelu_pk(f32x2 v) {
    const f32x2 av = __builtin_elementwise_abs(v), d = av * 0.2316418882f + 1.0f;
    f32x2 t; t.x = __builtin_amdgcn_rcpf(d.x); t.y = __builtin_amdgcn_rcpf(d.y);
    f32x2 q = t * 0.5307027145f + (-0.7265760135f); q = q * t + 0.7107068705f; q = q * t + (-0.142248368f); q = q * t + 0.127414796f; q = q * t;
    const f32x2 s = (v * v) * (-0.72134752044f);
    f32x2 e; e.x = __builtin_amdgcn_exp2f(s.x); e.y = __builtin_amdgcn_exp2f(s.y);
    const f32x2 m = v * (q * e), r = v - m;
    f32x2 o; o.x = v.x < 0.f ? m.x : r.x; o.y = v.y < 0.f ? m.y : r.y; return o;
}

template <int ACT  > struct EpiBf16 {
    static constexpr bool PERM = true, AFTER_DRAIN = false; static_assert(ACT == 0 || ACT == 1, "EpiBf16: ACT is 0 (none) or 1 (gelu_pk)");
    bf16_t* O; int ldc; const float* bias; int split_cols; size_t split_stride; float scale0;
    __device__ __forceinline__ void operator()(const f32x4 (&acc)[2][2][4][2], const Unit& u, int wr, int wc, int fr, int fq) const {
        const int row0 = u.pm * BM + wr * 64 + fr; int colt = u.pn * BM; bf16_t* base = O;
        float sc = 1.f; if (split_cols) { const int t = colt / split_cols; base += (size_t)t * split_stride; colt -= t * split_cols; if (t == 0) sc = scale0; }
        const int col0 = colt + wc * 32 + 8 * fq, bcol0 = u.pn * BM + wc * 32 + 8 * fq;
        f32x4 bv[2][2];
#pragma unroll
        for (int bj = 0; bj < 2; ++bj)
#pragma unroll
            for (int n = 0; n < 2; ++n) bv[bj][n] = bias ? *(const f32x4*)(bias + bcol0 + bj * HALF + 4 * n) : (f32x4){0.f, 0.f, 0.f, 0.f};
#pragma unroll
        for (int ai = 0; ai < 2; ++ai)
#pragma unroll
            for (int m = 0; m < 4; ++m) { bf16_t* rowp = base + (size_t)(row0 + ai * HALF + m * 16) * ldc + col0;
#pragma unroll
                for (int bj = 0; bj < 2; ++bj) { f32x4 v0 = acc[ai][bj][m][0] + bv[bj][0], v1 = acc[ai][bj][m][1] + bv[bj][1];
                    if (ACT == 1) { f32x2 a = gelu_pk((f32x2){v0[0], v0[1]}), b = gelu_pk((f32x2){v0[2], v0[3]}), c = gelu_pk((f32x2){v1[0], v1[1]}), d = gelu_pk((f32x2){v1[2], v1[3]});
                        v0 = (f32x4){a.x, a.y, b.x, b.y}; v1 = (f32x4){c.x, c.y, d.x, d.y}; }
                    v0 = v0 * sc; v1 = v1 * sc; u32x4 w; w.x = cvt_pk_bf16(v0[0], v0[1]); w.y = cvt_pk_bf16(v0[2], v0[3]); w.z = cvt_pk_bf16(v1[0], v1[1]); w.w = cvt_pk_bf16(v1[2], v1[3]);
                    *(u32x4*)(rowp + bj * HALF) = w; } }
    }
};

struct PanelStats {
    unsigned* xbuf;
    unsigned* cnt;
    unsigned* tmo;
    int ntn; float eps;
    unsigned code;
    __device__ __forceinline__ bool run(const f32x4 (&v)[2][2][4][2], const Unit& u, int wr, int wc, int fr, int fq, PG8_LAS unsigned char* lds, int wid, int lane) const {
        typedef float f32x2v __attribute__((ext_vector_type(2)));
        PG8_LAS f32x2v* P = (PG8_LAS f32x2v*)lds;
        PG8_LAS f32x2v* S = (PG8_LAS f32x2v*)(lds + 8192);
        PG8_LAS unsigned* flag = (PG8_LAS unsigned*)(lds + 8192 + 2048);
#pragma unroll
        for (int ai = 0; ai < 2; ++ai)
#pragma unroll
            for (int m = 0; m < 4; ++m) {
                float s = 0.f;
#pragma unroll
                for (int bj = 0; bj < 2; ++bj)
#pragma unroll
                    for (int n = 0; n < 2; ++n) { const f32x4 x = v[ai][bj][m][n]; s += (x[0] + x[1]) + (x[2] + x[3]); }
                s += __shfl_xor(s, 16); s += __shfl_xor(s, 32);
                const float mw = s * (1.0f / 64.0f); float q = 0.f;
#pragma unroll
                for (int bj = 0; bj < 2; ++bj)
#pragma unroll
                    for (int n = 0; n < 2; ++n) { const f32x4 d = v[ai][bj][m][n] - mw; q += (d[0] * d[0] + d[1] * d[1]) + (d[2] * d[2] + d[3] * d[3]); }
                q += __shfl_xor(q, 16); q += __shfl_xor(q, 32);
                if (fq == 0) P[(ai * HALF + wr * 64 + m * 16 + fr) * 4 + wc] = (f32x2v){mw, q};
            }
        asm volatile("s_waitcnt lgkmcnt(0)" ::: "memory"); __builtin_amdgcn_s_barrier(); asm volatile("" ::: "memory");
#if defined(BROKEN_EXCHANGE_NO_WAIT)
#warning BROKEN CONTROL BUILD: the row-statistics exchange does not wait; results are wrong by design
        if (blockIdx.x >= 64) { const long long t0_ = clock64(); while (clock64() - t0_ < 60000) __builtin_amdgcn_s_sleep(8); }
#endif
        const int row = wid * 32 + (lane & 31);
        if (lane < 32) {
            const f32x2v a = P[row * 4 + 0], b = P[row * 4 + 1], c = P[row * 4 + 2], d = P[row * 4 + 3];
            const float mt = (a.x + b.x + c.x + d.x) * 0.25f;
            const float da = a.x - mt, db = b.x - mt, dc = c.x - mt, dd = d.x - mt;
            const float m2 = (a.y + b.y) + (c.y + d.y) + 64.0f * ((da * da + db * db) + (dc * dc + dd * dd));
            unsigned long long* slot = (unsigned long long*)xbuf + ((size_t)(u.pm * BM + row) * 4 + u.pn);
            __hip_atomic_store(slot, ((unsigned long long)__float_as_uint(m2) << 32) | __float_as_uint(mt), __ATOMIC_RELAXED, __HIP_MEMORY_SCOPE_AGENT);
        }
        asm volatile("s_waitcnt vmcnt(0)" ::: "memory");
        if (lane == 0) __hip_atomic_fetch_add(cnt + 64 * u.pm, 1u, __ATOMIC_RELAXED, __HIP_MEMORY_SCOPE_AGENT);
        if (wid == 0) {
            bool dead = false; const unsigned long long t0 = __builtin_amdgcn_s_memrealtime(); const unsigned want = 8u * (unsigned)ntn;
            for (;;) {
#if defined(BROKEN_EXCHANGE_NO_WAIT)
                break;
#endif
                if ((unsigned)__builtin_amdgcn_readfirstlane(__hip_atomic_load(cnt + 64 * u.pm, __ATOMIC_RELAXED, __HIP_MEMORY_SCOPE_AGENT)) >= want) break;
                if (__builtin_amdgcn_s_memrealtime() - t0 > 2000000ull) {
                    if (lane == 0) { unsigned expect = 0u; __hip_atomic_compare_exchange_strong(tmo + 1, &expect, code | (unsigned)(u.pm & 0xff), __ATOMIC_RELAXED, __ATOMIC_RELAXED, __HIP_MEMORY_SCOPE_AGENT);
                                     __hip_atomic_store(tmo, 1u, __ATOMIC_RELAXED, __HIP_MEMORY_SCOPE_AGENT); }
                    dead = true; break; }
                __builtin_amdgcn_s_sleep(2);
            }
            __builtin_amdgcn_fence(__ATOMIC_ACQUIRE, "agent");
            if (lane == 0) flag[0] = dead ? 1u : 0u;
        }
        asm volatile("s_waitcnt vmcnt(0) lgkmcnt(0)" ::: "memory"); __builtin_amdgcn_s_barrier(); asm volatile("" ::: "memory");
        const bool bad = flag[0] != 0u;
        if (lane < 32) {
            const unsigned long long* slot = (const unsigned long long*)xbuf + (size_t)(u.pm * BM + row) * 4; float mt[4], m2[4]; float ms = 0.f;
#pragma unroll
            for (int t = 0; t < 4; ++t) { if (t < ntn) { const unsigned long long w = __hip_atomic_load(slot + t, __ATOMIC_RELAXED, __HIP_MEMORY_SCOPE_AGENT); mt[t] = __uint_as_float((unsigned)w); m2[t] = __uint_as_float((unsigned)(w >> 32)); } else { mt[t] = 0.f; m2[t] = 0.f; } ms += mt[t]; }
            const float mean = ms / (float)ntn; float q = 0.f;
#pragma unroll
            for (int t = 0; t < 4; ++t) if (t < ntn) { const float dm = mt[t] - mean; q += m2[t] + 256.0f * dm * dm; }
            S[row] = (f32x2v){mean, 1.0f / sqrtf(q / (256.0f * (float)ntn) + eps)};
        }
        asm volatile("s_waitcnt lgkmcnt(0)" ::: "memory"); __builtin_amdgcn_s_barrier(); asm volatile("" ::: "memory");
        return bad;
    }
};
struct EpiLnRes {
    static constexpr bool PERM = false, AFTER_DRAIN = true;
    const float* base; float* out; int ldc; const float* bias; PanelStats st; unsigned poison;
    __device__ __forceinline__ void fused(f32x4 (&acc)[2][2][4][2], const Unit& u, int wr, int wc, int fr, int fq, PG8_LAS unsigned char* lds, int wid, int lane) const {
        typedef float f32x2v __attribute__((ext_vector_type(2)));
        const PG8_LAS f32x2v* S = (const PG8_LAS f32x2v*)(lds + 8192);
        const int col0 = u.pn * BM + wc * 32 + 4 * fq;
#pragma unroll
        for (int bj = 0; bj < 2; ++bj)
#pragma unroll
            for (int n = 0; n < 2; ++n) { const f32x4 bv = bias ? *(const f32x4*)(bias + col0 + bj * HALF + n * 16) : (f32x4){0.f, 0.f, 0.f, 0.f};
#pragma unroll
                for (int ai = 0; ai < 2; ++ai)
#pragma unroll
                    for (int m = 0; m < 4; ++m) acc[ai][bj][m][n] += bv; }
        f32x4 pre[4][2][2];
#pragma unroll
        for (int m = 0; m < 4; ++m) { const size_t off = (size_t)(u.pm * BM + wr * 64 + m * 16 + fr) * ldc + col0;
#pragma unroll
            for (int bj = 0; bj < 2; ++bj)
#pragma unroll
                for (int n = 0; n < 2; ++n) pre[m][bj][n] = *(const f32x4*)(base + off + bj * HALF + n * 16); }
        const bool bad = st.run(acc, u, wr, wc, fr, fq, lds, wid, lane) || poison != 0u;
        const float qnan = __builtin_nanf("");
#pragma unroll
        for (int ai = 0; ai < 2; ++ai)
#pragma unroll
            for (int m = 0; m < 4; ++m) { const int r = ai * HALF + wr * 64 + m * 16 + fr; const f32x2v sr = S[r]; const size_t off = (size_t)(u.pm * BM + r) * ldc + col0;
#pragma unroll
                for (int bj = 0; bj < 2; ++bj)
#pragma unroll
                    for (int n = 0; n < 2; ++n) { const f32x4 bs = ai == 0 ? pre[m][bj][n] : *(const f32x4*)(base + off + bj * HALF + n * 16); f32x4 o = bs + (acc[ai][bj][m][n] - sr.x) * sr.y;
                        if (bad) o = (f32x4){qnan, qnan, qnan, qnan}; *(f32x4*)(out + off + bj * HALF + n * 16) = o; }
                if (m & 1) asm volatile("" ::: "memory"); }
    }
};
struct EpiLnResLn {
    static constexpr bool PERM = false, AFTER_DRAIN = true;
    const float* base; float* out; bf16_t* xn; int ldc; const float* bias; PanelStats st1, st2; unsigned poison;
    __device__ __forceinline__ void fused(f32x4 (&acc)[2][2][4][2], const Unit& u, int wr, int wc, int fr, int fq, PG8_LAS unsigned char* lds, int wid, int lane) const {
        typedef float f32x2v __attribute__((ext_vector_type(2))); typedef unsigned u32x2v __attribute__((ext_vector_type(2)));
        const PG8_LAS f32x2v* S = (const PG8_LAS f32x2v*)(lds + 8192);
        const int col0 = u.pn * BM + wc * 32 + 4 * fq;
#pragma unroll
        for (int bj = 0; bj < 2; ++bj)
#pragma unroll
            for (int n = 0; n < 2; ++n) { const f32x4 bv = bias ? *(const f32x4*)(bias + col0 + bj * HALF + n * 16) : (f32x4){0.f, 0.f, 0.f, 0.f};
#pragma unroll
                for (int ai = 0; ai < 2; ++ai)
#pragma unroll
                    for (int m = 0; m < 4; ++m) acc[ai][bj][m][n] += bv; }
        bool bad = st1.run(acc, u, wr, wc, fr, fq, lds, wid, lane) || poison != 0u;
        const float qnan = __builtin_nanf("");
#pragma unroll
        for (int ai = 0; ai < 2; ++ai)
#pragma unroll
            for (int m = 0; m < 4; ++m) { const int r = ai * HALF + wr * 64 + m * 16 + fr; const f32x2v sr = S[r]; const size_t off = (size_t)(u.pm * BM + r) * ldc + col0;
#pragma unroll
                for (int bj = 0; bj < 2; ++bj)
#pragma unroll
                    for (int n = 0; n < 2; ++n) { const f32x4 bs = *(const f32x4*)(base + off + bj * HALF + n * 16); acc[ai][bj][m][n] = bs + (acc[ai][bj][m][n] - sr.x) * sr.y; }
                asm volatile("" : "+v"(acc[ai][0][m][0]), "+v"(acc[ai][0][m][1]), "+v"(acc[ai][1][m][0]), "+v"(acc[ai][1][m][1]));
                if (m & 1) asm volatile("" ::: "memory"); }
        const bool bad1 = bad;
        bad = st2.run(acc, u, wr, wc, fr, fq, lds, wid, lane) || bad;
#pragma unroll
        for (int ai = 0; ai < 2; ++ai)
#pragma unroll
            for (int m = 0; m < 4; ++m) { const int r = ai * HALF + wr * 64 + m * 16 + fr; const f32x2v sr = S[r]; const size_t off = (size_t)(u.pm * BM + r) * ldc + col0;
#pragma unroll
                for (int bj = 0; bj < 2; ++bj)
#pragma unroll
                    for (int n = 0; n < 2; ++n) { const f32x4 x1 = acc[ai][bj][m][n]; *(f32x4*)(out + off + bj * HALF + n * 16) = bad1 ? (f32x4){qnan, qnan, qnan, qnan} : x1;
                        const f32x4 o = (x1 - sr.x) * sr.y; u32x2v w; w.x = cvt_pk_bf16(o[0], o[1]); w.y = cvt_pk_bf16(o[2], o[3]);
                        if (bad) { w.x = 0x7fc07fc0u; w.y = 0x7fc07fc0u; } *(u32x2v*)(xn + off + bj * HALF + n * 16) = w; }
                asm volatile("" ::: "memory"); }
    }
};

}
namespace pg8 {
typedef int v8i_t __attribute__((ext_vector_type(8))); typedef int v4i_t __attribute__((ext_vector_type(4)));
template <class Epi, class Sched, bool ALIGN_EPI, bool GATHER, bool KSPLIT, bool FP8 = false, int SCW = 127, int SCA = 127>
__device__ __forceinline__ void gemm_phase2(PG8_LAS unsigned char* lds, const int Kbytes, const int ldb_bytes, const Sched& S, const Epi& E, const int tid) {
    typedef typename Sched::UnitT UnitT;
    const int wid = __builtin_amdgcn_readfirstlane(tid >> 6), lane = tid & 63, wr = wid >> 2, wc = wid & 3, fr = lane & 15, fq = lane >> 4;
    int nt = Kbytes / (BK * 2); asm volatile("" : "+s"(nt));
    const int nth = nt / 2;
    unsigned voffB[2];
#pragma unroll
    for (int i = 0; i < 2; ++i) { int R[2], C[2]; stage_rc(tid * 16 + i * 8192, R[i], C[i]); const int Rb = Epi::PERM ? ((R[i] & ~31) + perm32(R[i] & 31)) : R[i]; voffB[i] = (unsigned)(Rb * ldb_bytes + C[i] * 2); }
    const size_t kstep = (size_t)(BK * 2);
    const size_t hstepB = (size_t)HALF * ldb_bytes;
    const unsigned ldsw = (unsigned)wid * 1024u;
    const int aoff = lds_byte(wr * 64 + fr, fq * 8), boff = lds_byte(wc * 32 + fr, fq * 8);
#define PG8_SA(b, h) (((b) * 2 + (h)) * HTB)
#define PG8_SB(b, h) ((4 + (b) * 2 + (h)) * HTB)
#define PG8_STAGE(bufoff, gbase, voff) do { _Pragma("unroll") for (int _i = 0; _i < 2; ++_i) \
        __builtin_amdgcn_global_load_lds((const unsigned*)((const char*)(gbase) + (voff)[_i]), (PG8_LAS unsigned*)(lds + (bufoff) + ldsw + _i * 8192), 16, 0, 0); } while (0)
#define PG8_LDA(dst, b, h) do { _Pragma("unroll") for (int m = 0; m < 4; ++m) _Pragma("unroll") for (int k = 0; k < 2; ++k) dst[m][k] = *(const PG8_LAS bf16x8*)(lds + PG8_SA(b, h) + aoff + m * 2048 + k * 1024); } while (0)
#define PG8_LDB(dst, b, h) do { _Pragma("unroll") for (int n = 0; n < 2; ++n) _Pragma("unroll") for (int k = 0; k < 2; ++k) dst[n][k] = *(const PG8_LAS bf16x8*)(lds + PG8_SB(b, h) + boff + n * 2048 + k * 1024); } while (0)
#define PG8_CAT8(x) __builtin_shufflevector(__builtin_bit_cast(v4i_t, (x)[0]), __builtin_bit_cast(v4i_t, (x)[1]), 0, 1, 2, 3, 4, 5, 6, 7)
#define PG8_MMA(ai, bj, At, Bt) do { __builtin_amdgcn_s_setprio(1); \
        if constexpr (FP8) { _Pragma("unroll") for (int m = 0; m < 4; ++m) _Pragma("unroll") for (int n = 0; n < 2; ++n) \
            acc[ai][bj][m][n] = __builtin_amdgcn_mfma_scale_f32_16x16x128_f8f6f4(PG8_CAT8(Bt[n]), PG8_CAT8(At[m]), acc[ai][bj][m][n], 0, 0, 0, SCW * 0x01010101, 0, SCA * 0x01010101); } \
        else { _Pragma("unroll") for (int m = 0; m < 4; ++m) _Pragma("unroll") for (int n = 0; n < 2; ++n) _Pragma("unroll") for (int k = 0; k < 2; ++k) \
            acc[ai][bj][m][n] = __builtin_amdgcn_mfma_f32_16x16x32_bf16(Bt[n][k], At[m][k], acc[ai][bj][m][n], 0, 0, 0); } \
        __builtin_amdgcn_s_setprio(0); } while (0)
#define PG8_WAIT_V(n) asm volatile("s_waitcnt vmcnt(" #n ")" ::: "memory")
#define PG8_WAIT_L(n) asm volatile("s_waitcnt lgkmcnt(" #n ")" ::: "memory")
#define PG8_BAR __builtin_amdgcn_s_barrier()
#define PG8_SCHED __builtin_amdgcn_sched_barrier(0)
#define PG8_BK(cb, cb2, kt) ((KSPLIT && (kt) >= nth) ? (cb2) + (size_t)((kt) - nth) * kstep : (cb) + (size_t)(kt) * kstep)
    UnitT cur, nxt; int ui = 0;
    if (!S.next(0, cur)) return;
    f32x4 acc[2][2][4][2];
#pragma unroll
    for (int a = 0; a < 2; ++a)
#pragma unroll
        for (int b = 0; b < 2; ++b)
#pragma unroll
            for (int m = 0; m < 4; ++m)
#pragma unroll
                for (int n = 0; n < 2; ++n) acc[a][b][m][n] = (f32x4){0.f, 0.f, 0.f, 0.f};
    bf16x8 At[4][2], B0[2][2], B1[2][2];
    unsigned vA[2][2], vAn[2][2];
    S.arows(cur, tid, vA);
#pragma unroll
    for (int h = 0; h < 2; ++h)
#pragma unroll
        for (int i = 0; i < 2; ++i) vAn[h][i] = vA[h][i];
    const char* cA = S.aptr(cur); const char* cB = S.bptr(cur); const char* cB2 = KSPLIT ? S.bptr2(cur) : cB;
    PG8_STAGE(PG8_SB(0, 0), cB, voffB); PG8_STAGE(PG8_SB(0, 1), cB + hstepB, voffB); PG8_STAGE(PG8_SA(0, 0), cA, vA[0]); PG8_STAGE(PG8_SA(0, 1), cA, vA[1]);
    if (wr == 1) PG8_BAR;
    PG8_WAIT_V(2); PG8_BAR;
    PG8_STAGE(PG8_SB(1, 0), PG8_BK(cB, cB2, 1), voffB); PG8_STAGE(PG8_SA(1, 0), cA + kstep, vA[0]); PG8_STAGE(PG8_SB(1, 1), PG8_BK(cB, cB2, 1) + hstepB, voffB);
    PG8_WAIT_V(6); PG8_BAR;
    for (;;) {
        const bool has_next = S.next(ui + 1, nxt);
        const char* nA = has_next ? S.aptr(nxt) : cA; const char* nB = has_next ? S.bptr(nxt) : cB; const char* nB2 = (KSPLIT && has_next) ? S.bptr2(nxt) : cB2;
        if (GATHER && has_next) S.arows(nxt, tid, vAn);
        for (int t = 0; t < nt; t += 2) {
            const bool last = (t == nt - 2);
            const char* a1 = cA + (size_t)(t + 1) * kstep;
            const char* a2 = last ? nA : cA + (size_t)(t + 2) * kstep;
            const char* b2 = last ? nB : PG8_BK(cB, cB2, t + 2);
            const char* b3 = last ? (KSPLIT ? PG8_BK(nB, nB2, 1) : nB + kstep) : PG8_BK(cB, cB2, t + 3);
            const char* a3 = a2 + kstep;
            PG8_LDB(B0, 0, 0); PG8_LDB(B1, 0, 1); PG8_SCHED; PG8_LDA(At, 0, 0); PG8_STAGE(PG8_SA(1, 1), a1, vA[1]);
            PG8_WAIT_V(8); PG8_WAIT_L(0); PG8_BAR; PG8_MMA(0, 0, At, B0); PG8_MMA(0, 1, At, B1); PG8_BAR; PG8_SCHED;
            if (GATHER && last) {
#pragma unroll
                for (int h = 0; h < 2; ++h)
#pragma unroll
                    for (int i = 0; i < 2; ++i) vA[h][i] = vAn[h][i]; }
            PG8_LDA(At, 0, 1); PG8_STAGE(PG8_SB(0, 0), b2, voffB); PG8_STAGE(PG8_SB(0, 1), b2 + hstepB, voffB); PG8_STAGE(PG8_SA(0, 0), a2, vA[0]);
            PG8_WAIT_V(8); PG8_WAIT_L(0); PG8_BAR; PG8_MMA(1, 0, At, B0); PG8_MMA(1, 1, At, B1); PG8_BAR; PG8_SCHED;
            PG8_LDB(B0, 1, 0); PG8_LDB(B1, 1, 1); PG8_SCHED; PG8_LDA(At, 1, 0); PG8_STAGE(PG8_SA(0, 1), a2, vA[1]);
            PG8_WAIT_V(8); PG8_WAIT_L(0); PG8_BAR; PG8_MMA(0, 0, At, B0); PG8_MMA(0, 1, At, B1); PG8_BAR; PG8_SCHED;
            PG8_LDA(At, 1, 1); PG8_STAGE(PG8_SB(1, 0), b3, voffB); PG8_STAGE(PG8_SB(1, 1), b3 + hstepB, voffB); PG8_STAGE(PG8_SA(1, 0), a3, vA[0]);
            PG8_WAIT_V(8); PG8_WAIT_L(0); PG8_BAR; PG8_MMA(1, 0, At, B0); PG8_MMA(1, 1, At, B1); PG8_BAR; PG8_SCHED;
        }
        if constexpr (ALIGN_EPI) { if (wr == 0) PG8_BAR; }
        if constexpr (!Epi::AFTER_DRAIN) { E(acc, cur, wr, wc, fr, fq); }
        if (!has_next) break;
#pragma unroll
        for (int a = 0; a < 2; ++a)
#pragma unroll
            for (int b = 0; b < 2; ++b)
#pragma unroll
                for (int m = 0; m < 4; ++m)
#pragma unroll
                    for (int n = 0; n < 2; ++n) acc[a][b][m][n] = (f32x4){0.f, 0.f, 0.f, 0.f};
        cur = nxt; cA = nA; cB = nB; cB2 = nB2; ++ui;
        if constexpr (ALIGN_EPI) { if (wr == 1) PG8_BAR; }
    }
    PG8_WAIT_V(0);
    if constexpr (!ALIGN_EPI) { if (wr == 0) PG8_BAR; }
    PG8_BAR;
    if constexpr (Epi::AFTER_DRAIN) { E.fused(acc, cur, wr, wc, fr, fq, lds, wid, lane); }
#undef PG8_SA
#undef PG8_SB
#undef PG8_STAGE
#undef PG8_LDA
#undef PG8_LDB
#undef PG8_MMA
#undef PG8_WAIT_V
#undef PG8_WAIT_L
#undef PG8_BAR
#undef PG8_SCHED
#undef PG8_BK
#undef PG8_CAT8
}
}
namespace pg8 {
DEVFN unsigned pkbf(float lo, float hi) { return cvt_pk_bf16(lo, hi); }
struct DenseSched {
    typedef Unit UnitT;
    StaticOrder so; const char* A; const char* Bt; int lda, ldb;
    DEVFN bool next(int i, Unit& u) const { return so.next(i, u); }
    DEVFN const char* aptr(const Unit&) const { return A; }
    DEVFN void arows(const Unit& u, const int tid_, unsigned (&v)[2][2]) const {
        int R[2], C[2]; { int t_ = tid_; asm volatile("" : "+v"(t_)); stage_rc(t_ * 16, R[0], C[0]); stage_rc(t_ * 16 + 8192, R[1], C[1]); }
#pragma unroll
        for (int h = 0; h < 2; ++h)
#pragma unroll
            for (int i = 0; i < 2; ++i) v[h][i] = (unsigned)((u.pm * BM + h * HALF + R[i]) * lda + C[i] * 2); }
    DEVFN const char* bptr(const Unit& u) const { return Bt + (size_t)u.pn * BM * ldb; }
    DEVFN const char* bptr2(const Unit& u) const { return bptr(u); }
};
struct EpiInproj {
    static constexpr bool PERM = true, AFTER_DRAIN = false;
    bf16_t* O; const float* rope; float* kbar;
    DEVFN void operator()(f32x4 (&acc)[2][2][4][2], const Unit& u, int wr, int wc, int fr, int fq) const {
        const int pn = u.pn, row0 = u.pm * BM + wr * 64 + fr;
        if (pn < 4 && fq == 0) {
#pragma unroll
            for (int ai = 0; ai < 2; ++ai)
#pragma unroll
                for (int m = 0; m < 4; ++m) { const int t = (row0 + ai * HALF + m * 16) & (SEQ - 1); const f32x4* rp = (const f32x4*)(rope + t * 16);
#pragma unroll
                    for (int q = 0; q < 4; ++q) { const f32x4 cs = rp[q];
                        { const int d = 2 * q, n = d >> 2, e = d & 3; const float x1 = acc[ai][0][m][n][e], x2 = acc[ai][1][m][n][e]; acc[ai][0][m][n][e] = x1 * cs[0] - x2 * cs[1]; acc[ai][1][m][n][e] = x2 * cs[0] + x1 * cs[1]; }
                        { const int d = 2 * q + 1, n = d >> 2, e = d & 3; const float x1 = acc[ai][0][m][n][e], x2 = acc[ai][1][m][n][e]; acc[ai][0][m][n][e] = x1 * cs[2] - x2 * cs[3]; acc[ai][1][m][n][e] = x2 * cs[2] + x1 * cs[3]; } } }
        }
        if (pn == 2 || pn == 3) {
            float* kb = kbar + (size_t)((((u.pm >> 3) * NH + (pn - 2) * 4 + wc) * NBLK + (u.pm & 7)) * HD);
#pragma unroll
            for (int bj = 0; bj < 2; ++bj)
#pragma unroll
                for (int n = 0; n < 2; ++n)
#pragma unroll
                    for (int e = 0; e < 4; ++e) { float s = 0.f;
#pragma unroll
                        for (int ai = 0; ai < 2; ++ai)
#pragma unroll
                            for (int m = 0; m < 4; ++m) s += acc[ai][bj][m][n][e];
                        s = swz_xor_add(s, 1); s = swz_xor_add(s, 2); s = swz_xor_add(s, 4); s = swz_xor_add(s, 8);
                        if (fr == 0) atomicAdd(kb + (2 * fq + bj) * 8 + 4 * n + e, s * (1.f / MBLK)); }
        }
        const float sc = pn < 2 ? QSCALE : 1.f;
#pragma unroll
        for (int ai = 0; ai < 2; ++ai)
#pragma unroll
            for (int m = 0; m < 4; ++m) { bf16_t* rowp = O + (size_t)(row0 + ai * HALF + m * 16) * DIN + pn * BM + wc * 64;
#pragma unroll
                for (int bj = 0; bj < 2; ++bj) { const f32x4 v0 = acc[ai][bj][m][0] * sc, v1 = acc[ai][bj][m][1] * sc;
                    u32x4 w; w.x = pkbf(v0[0], v0[1]); w.y = pkbf(v0[2], v0[3]); w.z = pkbf(v1[0], v1[1]); w.w = pkbf(v1[2], v1[3]);
                    *(u32x4*)(rowp + (2 * fq + bj) * 8) = w; } }
    }
};
struct MoeUnit { int pm, pn, cls, j, cnt; };
struct MoeBase {
    const PG8_LAS int* tp; const PG8_LAS int* cnt; int nunits, G, c, npn_shift;
    DEVFN bool next_(int i, MoeUnit& u) const {
        const int L = i * G + c; if (L >= nunits) return false;
        u.pm = L >> npn_shift; u.pn = L & ((1 << npn_shift) - 1);
        int cls = 0; while (u.pm >= tp[cls + 1]) ++cls;
        u.cls = cls; u.j = u.pm - tp[cls]; u.cnt = cnt[cls]; return true; }
};
DEVFN void moe_experts(int cls, int& e1, int& e2) { const int g = cls / 6, p = cls % 6; const int lo = p < 3 ? 0 : (p < 5 ? 1 : 2), hi = p < 3 ? p + 1 : (p < 5 ? p - 1 : 3); e1 = g * 4 + lo; e2 = g * 4 + hi; }
struct GateUpSched : MoeBase {
    typedef MoeUnit UnitT;
    const char* HB; const int* list; const char* W;
    DEVFN bool next(int i, MoeUnit& u) const { return next_(i, u); }
    DEVFN const char* aptr(const MoeUnit&) const { return HB; }
    DEVFN void arows(const MoeUnit& u, const int tid_, unsigned (&v)[2][2]) const {
        int R[2], C[2]; { int t_ = tid_; asm volatile("" : "+v"(t_)); stage_rc(t_ * 16, R[0], C[0]); stage_rc(t_ * 16 + 8192, R[1], C[1]); }
#pragma unroll
        for (int h = 0; h < 2; ++h)
#pragma unroll
            for (int i = 0; i < 2; ++i) { const int li = 256 * u.j + h * HALF + R[i]; const int tok = list[(size_t)u.cls * LISTCAP + (li < u.cnt ? li : 256 * u.j)]; v[h][i] = (unsigned)(tok * DM + C[i] * 2); } }
    DEVFN const char* bptr(const MoeUnit& u) const { int e1, e2; moe_experts(u.cls, e1, e2); return W + (size_t)(u.pn < 4 ? e1 : e2) * DM * DM + (size_t)(u.pn & 3) * BM * DM; }
    DEVFN const char* bptr2(const MoeUnit& u) const { return bptr(u); }
};
struct DownSched : MoeBase {
    typedef MoeUnit UnitT;
    const char* ACT; const char* W;
    DEVFN bool next(int i, MoeUnit& u) const { return next_(i, u); }
    DEVFN const char* aptr(const MoeUnit&) const { return ACT; }
    DEVFN void arows(const MoeUnit& u, const int tid_, unsigned (&v)[2][2]) const {
        int R[2], C[2]; { int t_ = tid_; asm volatile("" : "+v"(t_)); stage_rc(t_ * 16, R[0], C[0]); stage_rc(t_ * 16 + 8192, R[1], C[1]); }
#pragma unroll
        for (int h = 0; h < 2; ++h)
#pragma unroll
            for (int i = 0; i < 2; ++i) v[h][i] = (unsigned)((u.pm * BM + h * HALF + R[i]) * DM + C[i] * 2); }
    DEVFN const char* bptr(const MoeUnit& u) const { int e1, e2; moe_experts(u.cls, e1, e2); return W + (size_t)e1 * DM * DE + (size_t)u.pn * BM * DE; }
    DEVFN const char* bptr2(const MoeUnit& u) const { int e1, e2; moe_experts(u.cls, e1, e2); return W + (size_t)e2 * DM * DE + (size_t)u.pn * BM * DE; }
};
struct EpiGateUp {
    static constexpr bool PERM = true, AFTER_DRAIN = false;
    unsigned char* ACT; const float* rw;
    DEVFN void operator()(f32x4 (&acc)[2][2][4][2], const MoeUnit& u, int wr, int wc, int fr, int fq) const {
        const int half = u.pn >> 2, jt = u.pn & 3;
#pragma unroll
        for (int ai = 0; ai < 2; ++ai)
#pragma unroll
            for (int m = 0; m < 4; ++m) { const int lr = ai * HALF + wr * 64 + m * 16 + fr, li = 256 * u.j + lr;
                const float wgt = li < u.cnt ? 8.f * rw[((size_t)u.cls * LISTCAP + li) * 2 + half] : 0.f;
                f32x4 o[2];
#pragma unroll
                for (int n = 0; n < 2; ++n)
#pragma unroll
                    for (int e = 0; e < 4; ++e) { const float g = acc[ai][0][m][n][e]; o[n][e] = g * __builtin_amdgcn_rcpf(1.f + __expf(-g)) * acc[ai][1][m][n][e] * wgt; }
                u32x2 w; w.x = pk4_fp8(o[0][0], o[0][1], o[0][2], o[0][3]); w.y = pk4_fp8(o[1][0], o[1][1], o[1][2], o[1][3]);
                *(u32x2*)(ACT + (size_t)(u.pm * BM + lr) * DM + half * 512 + jt * 128 + wc * 32 + fq * 8) = w; }
    }
};
struct EpiDown {
    static constexpr bool PERM = true, AFTER_DRAIN = false;
    bf16_t* Y2; const int* list;
    DEVFN void operator()(f32x4 (&acc)[2][2][4][2], const MoeUnit& u, int wr, int wc, int fr, int fq) const {
#pragma unroll
        for (int ai = 0; ai < 2; ++ai)
#pragma unroll
            for (int m = 0; m < 4; ++m) { const int li = 256 * u.j + ai * HALF + wr * 64 + m * 16 + fr;
                if (li < u.cnt) { const int tok = list[(size_t)u.cls * LISTCAP + li]; bf16_t* rowp = Y2 + (size_t)tok * DM + u.pn * BM + wc * 32 + fq * 8;
#pragma unroll
                    for (int bj = 0; bj < 2; ++bj) { const f32x4 v0 = acc[ai][bj][m][0], v1 = acc[ai][bj][m][1];
                        u32x4 w; w.x = pkbf(v0[0], v0[1]); w.y = pkbf(v0[2], v0[3]); w.z = pkbf(v1[0], v1[1]); w.w = pkbf(v1[2], v1[3]);
                        *(u32x4*)(rowp + bj * HALF) = w; } } }
    }
};
}

#include <hip/hip_bf16.h>
#include <cmath>
namespace attn_body {
using bf16=__hip_bfloat16;
using bf16x8=__attribute__((ext_vector_type(8)))short;
using s16x4=__attribute__((ext_vector_type(4)))short;
using f32x16=__attribute__((ext_vector_type(16)))float;
using u32x4=__attribute__((ext_vector_type(4)))unsigned;
constexpr int BATCH=16,NHEAD=8,SEQ=2048,D=64,QP=2048,OP=1024;
constexpr int NW=8,QBLK=32,QB=QBLK*NW,KVBLK=64,NQB=SEQ/QB;
constexpr int ATTN_PITCH=QP, ATTN_UNIT_ROWS=QB;
__device__ __forceinline__ int crow(int r,int hi){return (r&3)+8*(r>>2)+4*hi;}
#define SBAR() __builtin_amdgcn_sched_barrier(0)
__device__ __forceinline__ void cmask(f32x16&p0,f32x16&p1,int jb,int qrel,int hi){
  const float NEG=-INFINITY; int kb=64*jb+4*hi;
  #pragma unroll
  for(int r=0;r<16;++r){int kv=kb+(r&3)+8*(r>>2); if(kv>qrel)p0[r]=NEG; if(kv+32>qrel)p1[r]=NEG;}
}

constexpr int NSLOT=3, SLOTB=8192;
constexpr int LDS_K=0, LDS_V=NSLOT*SLOTB, LDS_WS=2*NSLOT*SLOTB, LDS_OST=LDS_WS+NW*64*4, LDS_KBAR=LDS_OST+NW*4096, LDS_BYTES=LDS_KBAR+2048;
constexpr float NEGBIG=-1.0e30f; typedef float f32x4_t __attribute__((ext_vector_type(4)));
__device__ __forceinline__ float bfs(short v){return __uint_as_float(((unsigned)(unsigned short)v)<<16);}
constexpr float C2=0.125f*1.4426950408889634f;
__device__ __forceinline__ void glds16(const void*gsrc,unsigned lds_dst){unsigned keep;
  asm volatile("s_mov_b32 %0, m0\n\ts_mov_b32 m0, %2\n\ts_nop 0\n\tglobal_load_lds_dwordx4 %1, off\n\ts_mov_b32 m0, %0":"=&s"(keep):"v"(gsrc),"s"(lds_dst):"memory");}
__device__ __forceinline__ float max3f(float a,float b,float c){float r;asm("v_max3_f32 %0, %1, %2, %3":"=v"(r):"v"(a),"v"(b),"v"(c));return r;}
__device__ __forceinline__ float max2f(float a,float b){float r;asm("v_max_f32_e32 %0, %1, %2":"=v"(r):"v"(a),"v"(b));return r;}
__device__ __forceinline__ float fadd_s(float a,float b){float r;asm("v_add_f32_e32 %0, %1, %2":"=v"(r):"v"(a),"v"(b));return r;}
__device__ __forceinline__ float fsub_s(float a,float b){float r;asm("v_sub_f32_e32 %0, %1, %2":"=v"(r):"v"(a),"v"(b));return r;}
typedef float f32x2_t __attribute__((ext_vector_type(2))); typedef __bf16 bf16x2_t __attribute__((ext_vector_type(2)));
__device__ __forceinline__ unsigned cvtpk_s(float lo,float hi){f32x2_t v={lo,hi};bf16x2_t b=__builtin_convertvector(v,bf16x2_t);return __builtin_bit_cast(unsigned,b);}
#define WAIT_BAR(N) asm volatile("s_waitcnt vmcnt(" #N ") lgkmcnt(0)\n\ts_barrier":::"memory")

__device__ __forceinline__ void qkt(f32x16&p0,f32x16&p1,const char*Kslot,const bf16x8*qr,const f32x16&negm,int r32,int hi){
  const char*kb=Kslot+hi*1024+r32*16;
  #pragma unroll
  for(int d0=0;d0<4;++d0){
    const bf16x8 b0=*reinterpret_cast<const bf16x8*>(kb+d0*2048);
    const bf16x8 b1=*reinterpret_cast<const bf16x8*>(kb+d0*2048+512);
    if(d0==0){p0=__builtin_amdgcn_mfma_f32_32x32x16_bf16(b0,qr[0],negm,0,0,0);p1=__builtin_amdgcn_mfma_f32_32x32x16_bf16(b1,qr[0],negm,0,0,0);}
    else{p0=__builtin_amdgcn_mfma_f32_32x32x16_bf16(b0,qr[d0],p0,0,0,0);p1=__builtin_amdgcn_mfma_f32_32x32x16_bf16(b1,qr[d0],p1,0,0,0);}}
}
typedef __attribute__((address_space(3))) const char* lds_cptr;
typedef short v4i16_t __attribute__((ext_vector_type(4)));
__device__ __forceinline__ void kload8(bf16x8*kf,lds_cptr kp){
  kf[0]=*(const __attribute__((address_space(3))) bf16x8*)(kp);      kf[1]=*(const __attribute__((address_space(3))) bf16x8*)(kp+512);
  kf[2]=*(const __attribute__((address_space(3))) bf16x8*)(kp+2048); kf[3]=*(const __attribute__((address_space(3))) bf16x8*)(kp+2560);
  kf[4]=*(const __attribute__((address_space(3))) bf16x8*)(kp+4096); kf[5]=*(const __attribute__((address_space(3))) bf16x8*)(kp+4608);
  kf[6]=*(const __attribute__((address_space(3))) bf16x8*)(kp+6144); kf[7]=*(const __attribute__((address_space(3))) bf16x8*)(kp+6656);
}
__device__ __forceinline__ void kload2(bf16x8*kf,lds_cptr kp,int j){ kf[2*j]=*(const __attribute__((address_space(3))) bf16x8*)(kp+j*2048); kf[2*j+1]=*(const __attribute__((address_space(3))) bf16x8*)(kp+j*2048+512); }
__device__ __forceinline__ s16x4 vtr(lds_cptr p){ return __builtin_bit_cast(s16x4,__builtin_amdgcn_ds_read_tr16_b64_v4i16((__attribute__((address_space(3))) v4i16_t*)p)); }
__device__ __forceinline__ float rowmax(const f32x16&p0,const f32x16&p1){
  float a=max3f(p0[0],p0[1],p1[0]),b=max3f(p0[2],p0[3],p1[1]);a=max3f(a,p1[2],p1[3]);
  #pragma unroll
  for(int r=4;r<16;r+=4){a=max3f(a,p0[r],p0[r+1]);b=max3f(b,p0[r+2],p0[r+3]);a=max3f(a,p1[r],p1[r+1]);b=max3f(b,p1[r+2],p1[r+3]);}
  const float m=max2f(a,b);
  auto rr=__builtin_amdgcn_permlane32_swap(__float_as_uint(m),__float_as_uint(m),false,false);
  return max2f(__uint_as_float(rr[0]),__uint_as_float(rr[1]));
}
__device__ __forceinline__ void pv(f32x16*o,int vb,bf16x8 pa0,bf16x8 pa1,bf16x8 pa2,bf16x8 pa3){
  #pragma unroll
  for(int d0=0;d0<2;++d0){s16x4 lo[4],hi[4];
    #pragma unroll
    for(int ks=0;ks<4;++ks){
      asm volatile("ds_read_b64_tr_b16 %0,%1 offset:%c2":"=&v"(lo[ks]):"v"(vb),"i"(d0*4096+ks*1024):"memory");
      asm volatile("ds_read_b64_tr_b16 %0,%1 offset:%c2":"=&v"(hi[ks]):"v"(vb),"i"(d0*4096+ks*1024+512):"memory");}
    asm volatile("s_waitcnt lgkmcnt(0)":::"memory");SBAR();
    #define PK(k) (bf16x8){lo[k][0],lo[k][1],lo[k][2],lo[k][3],hi[k][0],hi[k][1],hi[k][2],hi[k][3]}
    o[d0]=__builtin_amdgcn_mfma_f32_32x32x16_bf16(pa0,PK(0),o[d0],0,0,0);
    o[d0]=__builtin_amdgcn_mfma_f32_32x32x16_bf16(pa1,PK(1),o[d0],0,0,0);
    o[d0]=__builtin_amdgcn_mfma_f32_32x32x16_bf16(pa2,PK(2),o[d0],0,0,0);
    o[d0]=__builtin_amdgcn_mfma_f32_32x32x16_bf16(pa3,PK(3),o[d0],0,0,0);
    #undef PK
  }
}

#ifndef ATTN_STORE16
#define ATTN_STORE16(p,v) (*(u32x4*)(p)=(v))
#endif
template<int THRL> __device__ __forceinline__ void attn_unit(int b,int h,int qb,const bf16*Q,const bf16*__restrict__ K,const bf16*__restrict__ V,bf16*O,const float*__restrict__ kbar,char*shm,const int tid){
  const int lane=tid&63,r32=lane&31,hi=lane>>5; const int wid=__builtin_amdgcn_readfirstlane(tid>>6);
  float kbv=0.f; { int tk=tid; asm volatile("":"+v"(tk)); if(qb>=4&&tk<448)kbv=kbar[tk]; }
  const long rowbase=(long)b*SEQ; const int q0=qb*QB;
  const bf16*Qw=Q+(rowbase+q0+wid*QBLK)*QP+h*D;
  const bf16*Kh=K+rowbase*QP+h*D,*Vh=V+rowbase*QP+h*D;
  const unsigned lds0=(unsigned)(uintptr_t)shm;
  float*wsf=(float*)(shm+LDS_WS)+wid*64;
  const bf16*ksrc=Kh+(long)lane*QP+wid*8;
  const bf16*vsrc=Vh+(long)(16*(wid&3)+(lane>>2))*QP+(wid>>2)*32+(lane&3)*8;
  const unsigned kdst=lds0+LDS_K+wid*1024, vdst=lds0+LDS_V+wid*1024;
  #define DMA_K(t,slot) glds16(ksrc+(long)(t)*KVBLK*QP,(unsigned)__builtin_amdgcn_readfirstlane(kdst+(slot)))
  #define DMA_V(t,slot) glds16(vsrc+(long)(t)*KVBLK*QP,(unsigned)__builtin_amdgcn_readfirstlane(vdst+(slot)))
  const int vb0=(int)(lds0+LDS_V)+((lane>>4)&1)*32+(lane&3)*8+(4*hi+((lane&15)>>2))*64;
  const char*Kbase=shm+LDS_K; bf16x8 kf[8];
  const lds_cptr shm3=(lds_cptr)shm; const lds_cptr kp0=shm3+LDS_K+hi*1024+r32*16; const lds_cptr vp0=shm3+LDS_V+((lane>>4)&1)*32+(lane&3)*8+(4*hi+((lane&15)>>2))*64;
  const int NT=(q0+QB)/KVBLK;
  DMA_K(0,0);DMA_V(0,0);DMA_K(1,SLOTB);
  bf16x8 qr[4];
  #pragma unroll
  for(int d0=0;d0<4;++d0)qr[d0]=*reinterpret_cast<const bf16x8*>(&Qw[(long)r32*QP+d0*16+hi*8]);
  float mhat=0.f,l_reg=0.f;f32x16 o[2];o[0]=f32x16{};o[1]=f32x16{};f32x16 negm=f32x16{};asm volatile("":"+v"(negm));
  const int qrel=wid*QBLK+r32;
  #define CMASK(P0,P1,t) do{int jb_=(t)-(NT-4); if(jb_>=0)cmask(P0,P1,jb_,qrel,hi);}while(0)
  bool resc=false;
  #define START(P0,P1) do{ const float rm=rowmax(P0,P1); resc=false; \
    { const float dl=selcur?rm:-64.f; mhat=fadd_s(mhat,dl); \
      _Pragma("unroll") for(int r=0;r<16;++r){P0[r]=fsub_s(P0[r],dl);P1[r]=fsub_s(P1[r],dl);} \
      { const float nv_=selcur?-mhat:NEGBIG; _Pragma("unroll") for(int r=0;r<16;++r)negm[r]=nv_; } asm volatile("":"+v"(negm)); } \
    _Pragma("unroll") for(int r=0;r<16;++r)P0[r]=__builtin_amdgcn_exp2f(P0[r]); }while(0)
  #define RESC() do{ if(resc){ asm volatile("s_waitcnt lgkmcnt(0)":::"memory"); \
      _Pragma("unroll") for(int d_=0;d_<2;++d_) _Pragma("unroll") for(int r=0;r<16;++r)o[d_][r]*=wsf[crow(r,hi)]; } }while(0)
  f32x16 pA0,pA1,pB0,pB1;
  int sl_prev=0,sl_cur=0,sl_next=SLOTB;
  #define ROT() do{sl_prev=sl_cur;sl_cur=sl_next;sl_next=(sl_next==(NSLOT-1)*SLOTB)?0:sl_next+SLOTB;}while(0)
  DMA_K(2,2*SLOTB);
  if(qb>=4){ if(tid<448){ const unsigned hb=__builtin_bit_cast(unsigned,kbv); const unsigned hr=(hb+0x7fffu+((hb>>16)&1u))&0xffff0000u; const float lo_=kbv-__builtin_bit_cast(float,hr); const unsigned lb=__builtin_bit_cast(unsigned,lo_);
      ((unsigned short*)(shm+LDS_KBAR))[tid]=(unsigned short)(hr>>16); ((unsigned short*)(shm+LDS_KBAR+1024))[tid]=(unsigned short)((lb+0x7fffu+((lb>>16)&1u))>>16); } }
  WAIT_BAR(3);
  unsigned bmask=(1u<<(qb+1))-1u;
  if(qb>=4){ float gsc[8];
    { const lds_cptr kb3=shm3+LDS_KBAR+(r32&7)*128+hi*16; f32x16 g=f32x16{};
      _Pragma("unroll") for(int d0=0;d0<4;++d0){ const bf16x8 ah=*(const __attribute__((address_space(3))) bf16x8*)(kb3+d0*32), al=*(const __attribute__((address_space(3))) bf16x8*)(kb3+1024+d0*32);
        g=__builtin_amdgcn_mfma_f32_32x32x16_bf16(ah,qr[d0],g,0,0,0); g=__builtin_amdgcn_mfma_f32_32x32x16_bf16(al,qr[d0],g,0,0,0); }
      _Pragma("unroll") for(int r=0;r<4;++r){ auto rr=__builtin_amdgcn_permlane32_swap(__float_as_uint(g[r]),__float_as_uint(g[r]),false,false); gsc[r]=__uint_as_float(rr[0]); gsc[4+r]=__uint_as_float(rr[1]); } }
    _Pragma("unroll") for(int n=0;n<7;++n) gsc[n]=(n<qb)?gsc[n]:-3.0e38f;
    bmask=1u<<qb;
    _Pragma("unroll") for(int pick=0;pick<3;++pick){ float best=-3.4e38f; unsigned bi=0u;
      _Pragma("unroll") for(int n=0;n<7;++n){ const bool ok=!((bmask>>n)&1u)&&gsc[n]>best; best=ok?gsc[n]:best; bi=ok?(unsigned)n:bi; }
      bmask|=1u<<bi; } }
  bool selcur=(bmask&1u)!=0u;
  { const float nv=selcur?0.f:NEGBIG; _Pragma("unroll") for(int r=0;r<16;++r)negm[r]=nv; asm volatile("":"+v"(negm)); }
  qkt(pA0,pA1,Kbase,qr,negm,r32,hi);asm volatile("s_nop 15\n\ts_nop 7":"+v"(pA0),"+v"(pA1));CMASK(pA0,pA1,0);
  START(pA0,pA1);
  _Pragma("unroll") for(int r=0;r<16;++r)pA1[r]=__builtin_amdgcn_exp2f(pA1[r]);
  WAIT_BAR(0);
  DMA_K(3,0);DMA_V(1,SLOTB);
  ROT();
  kload8(kf,kp0+sl_cur);
  WAIT_BAR(2);
  s16x4 vlo[8],vhi[8]; u32x4 pw0,pw1,pw2,pw3;
  #define PKW(P,B) cvtpk_s(P[B],P[B+1])
  #define PAF(k) __builtin_bit_cast(bf16x8,pw##k)
  #define VFR(i) (bf16x8){vlo[i][0],vlo[i][1],vlo[i][2],vlo[i][3],vhi[i][0],vhi[i][1],vhi[i][2],vhi[i][3]}
  #define PIN(x) asm volatile("":"+v"(x))
  #define MX3(a,b,c) __builtin_fmaxf(__builtin_fmaxf((a),(b)),(c))
  #define GAPA(MF,A0,A1,A2,A3,W0,W1,PW) do{ MF; sacc+=A0; sacc+=A1; sacc+=A2; sacc+=A3; PIN(sacc); W0; W1; PIN(PW); SBAR(); }while(0)
  #define EX(v) __builtin_amdgcn_exp2f(v)
  #define GAPB(MF,X,B) do{ MF; X[B]=EX(X[B]); X[B+1]=EX(X[B+1]); X[B+2]=EX(X[B+2]); X[B+3]=EX(X[B+3]); PIN(X); SBAR(); }while(0)
  #define VRD(i) do{ vlo[i]=vtr(vp_+(((i)>>2)*4096+((i)&3)*1024)); vhi[i]=vtr(vp_+(((i)>>2)*4096+((i)&3)*1024+512)); }while(0)
  #define KRD(G,j) do{ if(G){ kload2(kf,kp0+sl_next,j); SBAR(); } }while(0)
  #define STEP(C0,C1,P0,P1,t,GK,GV,GL) do{ SBAR(); \
    const lds_cptr vp_=vp0+sl_prev; \
    VRD(0); SBAR(); float sacc=(P0[0]+P0[1]); \
    GAPA(C0=__builtin_amdgcn_mfma_f32_32x32x16_bf16(kf[0],qr[0],negm,0,0,0), P0[2],P0[3],P0[4],P0[5],     pw0[0]=PKW(P0,0), pw0[1]=PKW(P0,2), pw0); \
    VRD(4); SBAR(); GAPA(C1=__builtin_amdgcn_mfma_f32_32x32x16_bf16(kf[1],qr[0],negm,0,0,0), P0[6],P0[7],P0[8],P0[9],     pw0[2]=PKW(P0,4), pw0[3]=PKW(P0,6), pw0); \
    VRD(1); SBAR(); GAPA(C0=__builtin_amdgcn_mfma_f32_32x32x16_bf16(kf[2],qr[1],C0,0,0,0),   P0[10],P0[11],P0[12],P0[13], pw1[0]=PKW(P0,8), pw1[1]=PKW(P0,10), pw1); \
    VRD(5); SBAR(); GAPA(C1=__builtin_amdgcn_mfma_f32_32x32x16_bf16(kf[3],qr[1],C1,0,0,0),   P0[14],P0[15],P1[0],P1[1],   pw1[2]=PKW(P0,12),pw1[3]=PKW(P0,14), pw1); \
    VRD(2); SBAR(); GAPA(C0=__builtin_amdgcn_mfma_f32_32x32x16_bf16(kf[4],qr[2],C0,0,0,0),   P1[2],P1[3],P1[4],P1[5],     pw2[0]=PKW(P1,0), pw2[1]=PKW(P1,2), pw2); \
    VRD(6); SBAR(); GAPA(C1=__builtin_amdgcn_mfma_f32_32x32x16_bf16(kf[5],qr[2],C1,0,0,0),   P1[6],P1[7],P1[8],P1[9],     pw2[2]=PKW(P1,4), pw2[3]=PKW(P1,6), pw2); \
    VRD(3); SBAR(); GAPA(C0=__builtin_amdgcn_mfma_f32_32x32x16_bf16(kf[6],qr[3],C0,0,0,0),   P1[10],P1[11],P1[12],P1[13], pw3[0]=PKW(P1,8), pw3[1]=PKW(P1,10), pw3); \
    VRD(7); SBAR(); GAPA(C1=__builtin_amdgcn_mfma_f32_32x32x16_bf16(kf[7],qr[3],C1,0,0,0),   P1[14],P1[15],0.f,0.f,       pw3[2]=PKW(P1,12),pw3[3]=PKW(P1,14), pw3); \
    l_reg+=sacc; \
    if(GK){DMA_K((t)+3,sl_cur);} if(GV){DMA_V((t)+1,sl_next);} \
    CMASK(C0,C1,t); \
    { float a=MX3(C0[0],C0[1],C1[0]),b=MX3(C0[2],C0[3],C1[1]); a=MX3(a,C1[2],C1[3]); \
      _Pragma("unroll") for(int r=4;r<16;r+=4){a=MX3(a,C0[r],C0[r+1]);b=MX3(b,C0[r+2],C0[r+3]);a=MX3(a,C1[r],C1[r+1]);b=MX3(b,C1[r+2],C1[r+3]);} \
      float rm=__builtin_fmaxf(a,b); { auto rr=__builtin_amdgcn_permlane32_swap(__float_as_uint(rm),__float_as_uint(rm),false,false); rm=__builtin_fmaxf(__uint_as_float(rr[0]),__uint_as_float(rr[1])); } \
      resc=false; \
      if(__builtin_expect(__any(rm>(float)THRL),0)){ const float dl=__builtin_fmaxf(rm,0.f); mhat+=dl; \
        _Pragma("unroll") for(int r=0;r<16;++r){C0[r]-=dl;C1[r]-=dl;} \
        { const float nv_=selcur?-mhat:NEGBIG; _Pragma("unroll") for(int r=0;r<16;++r)negm[r]=nv_; } asm volatile("":"+v"(negm)); \
        const float f=__builtin_amdgcn_exp2f(-dl); l_reg*=f; if(hi==0)wsf[r32]=f; resc=true; } } \
    SBAR(); \
    GAPB(o[0]=__builtin_amdgcn_mfma_f32_32x32x16_bf16(PAF(0),VFR(0),o[0],0,0,0), C0,0); \
    GAPB(o[1]=__builtin_amdgcn_mfma_f32_32x32x16_bf16(PAF(0),VFR(4),o[1],0,0,0), C0,4); \
    KRD(GL,0); GAPB(o[0]=__builtin_amdgcn_mfma_f32_32x32x16_bf16(PAF(1),VFR(1),o[0],0,0,0), C0,8); \
    KRD(GL,1); GAPB(o[1]=__builtin_amdgcn_mfma_f32_32x32x16_bf16(PAF(1),VFR(5),o[1],0,0,0), C0,12); \
    KRD(GL,2); GAPB(o[0]=__builtin_amdgcn_mfma_f32_32x32x16_bf16(PAF(2),VFR(2),o[0],0,0,0), C1,0); \
    KRD(GL,3); GAPB(o[1]=__builtin_amdgcn_mfma_f32_32x32x16_bf16(PAF(2),VFR(6),o[1],0,0,0), C1,4); \
    GAPB(o[0]=__builtin_amdgcn_mfma_f32_32x32x16_bf16(PAF(3),VFR(3),o[0],0,0,0), C1,8); \
    GAPB(o[1]=__builtin_amdgcn_mfma_f32_32x32x16_bf16(PAF(3),VFR(7),o[1],0,0,0), C1,12); \
    }while(0)
  #define BLKSEL(tt) do{ if((((tt))&3)==0){ selcur=((bmask>>((tt)>>2))&1u)!=0u; const float nv_=selcur?-mhat:NEGBIG; _Pragma("unroll") for(int r=0;r<16;++r)negm[r]=nv_; asm volatile("":"+v"(negm)); } }while(0)
  int t=1;
  #undef CMASK
  #define CMASK(P0,P1,t) do{}while(0)
  for(;t+5<NT;t+=2){
    STEP(pB0,pB1,pA0,pA1,t,true,true,true);     WAIT_BAR(2); RESC(); ROT(); BLKSEL(t+1);
    STEP(pA0,pA1,pB0,pB1,t+1,true,true,true);   WAIT_BAR(2); RESC(); ROT();
  }
  #undef CMASK
  #define CMASK(P0,P1,t) do{int jb_=(t)-(NT-4); if(jb_>=0)cmask(P0,P1,jb_,qrel,hi);}while(0)
  #define ENDW(tt) do{ if((tt)+3<NT){WAIT_BAR(2);} else if((tt)+2<NT){WAIT_BAR(1);} else {WAIT_BAR(0);} }while(0)
  for(;t+1<NT;t+=2){
    STEP(pB0,pB1,pA0,pA1,t,(t+3<NT),(t+1<NT),(t+1<NT));       ENDW(t);   RESC(); ROT(); BLKSEL(t+1);
    STEP(pA0,pA1,pB0,pB1,t+1,(t+4<NT),(t+2<NT),(t+2<NT));     ENDW(t+1); RESC(); ROT();
  }
  STEP(pB0,pB1,pA0,pA1,NT-1,false,false,false); RESC();
  { float sacc=pB0[0]+pB0[1]; _Pragma("unroll") for(int r=2;r<16;++r)sacc+=pB0[r]; _Pragma("unroll") for(int r=0;r<16;++r)sacc+=pB1[r]; l_reg+=sacc;
    pw0=(u32x4){PKW(pB0,0),PKW(pB0,2),PKW(pB0,4),PKW(pB0,6)};pw1=(u32x4){PKW(pB0,8),PKW(pB0,10),PKW(pB0,12),PKW(pB0,14)};pw2=(u32x4){PKW(pB1,0),PKW(pB1,2),PKW(pB1,4),PKW(pB1,6)};pw3=(u32x4){PKW(pB1,8),PKW(pB1,10),PKW(pB1,12),PKW(pB1,14)};
    SBAR(); pv(o,vb0+sl_cur,PAF(0),PAF(1),PAF(2),PAF(3)); }
  #undef PKW
  #undef PAF
  #undef VFR
  #undef PIN
  #undef MX3
  #undef GAPA
  #undef GAPB
  #undef EX
  #undef VRD
  #undef KRD
  #undef STEP
  #undef ENDW
  {auto rr=__builtin_amdgcn_permlane32_swap(__float_as_uint(l_reg),__float_as_uint(l_reg),false,false);l_reg=__uint_as_float(rr[0])+__uint_as_float(rr[1]);}
  if(hi==0)wsf[32+r32]=l_reg;asm volatile("s_waitcnt lgkmcnt(0)":::"memory");
  float rli[16];
  #pragma unroll
  for(int r=0;r<16;++r)rli[r]=__builtin_amdgcn_rcpf(wsf[32+crow(r,hi)]);
  bf16*Ow=O+(rowbase+q0+wid*QBLK)*OP+h*D;
  { bf16*stg=(bf16*)(shm+LDS_OST)+wid*2048;
    #pragma unroll
    for(int r=0;r<16;++r){const int orow=crow(r,hi);
      #pragma unroll
      for(int d0=0;d0<2;++d0)stg[orow*64+d0*32+r32]=__float2bfloat16(o[d0][r]*rli[r]);}
    asm volatile("s_waitcnt lgkmcnt(0)":::"memory");
    #pragma unroll
    for(int i=0;i<4;++i){const int row=i*8+(lane>>3),ch=lane&7; const u32x4 v=*(const u32x4*)(stg+row*64+ch*8); ATTN_STORE16(Ow+(long)row*OP+ch*8,v);} }
  asm volatile("s_waitcnt lgkmcnt(0)\n\ts_barrier":::"memory");
  #undef BLKSEL
  #undef DMA_K
  #undef DMA_V
  #undef CMASK
  #undef START
  #undef RESC
  #undef ROT
}
constexpr int ATTN_LDS_BYTES=LDS_BYTES;
struct AttnTensors { const bf16* Q; const bf16* K; const bf16* V; bf16* O; const float* kbar; };
struct AttnUnit { int bh; int qb; };
struct StaticOrder {
  int vcu, G;
  __device__ __forceinline__ explicit StaticOrder(int grid,int block):vcu((grid%8==0)?(block%8)*(grid/8)+block/8:block),G(grid){}
  __device__ __forceinline__ bool next(int i,AttnUnit&u)const{ const int pr=(vcu+(i>>2)*G)*2+((i>>1)&1); if(pr>=BATCH*NHEAD*4)return false;
    const int s=pr&3; u.bh=pr>>2; u.qb=(i&1)?7-s:s; return true; }
  __device__ __forceinline__ void a_ready(const AttnUnit&)const{}
  __device__ __forceinline__ void done(const AttnUnit&)const{}
};
template<class Sched,int THRL=8> __device__ __forceinline__ void attn_phase(char*lds,const AttnTensors&T,const Sched&S,const int tid_in){
  AttnUnit u; int tid_=tid_in; asm volatile("":"+v"(tid_));
  for(int i=0;S.next(i,u);++i){ S.a_ready(u); attn_unit<THRL>(u.bh/NHEAD,u.bh%NHEAD,u.qb,T.Q,T.K,T.V,T.O,T.kbar+(long)u.bh*512,lds,tid_); S.done(u); }
}
#undef SBAR
#undef WAIT_BAR
}

#define XB_TMO      128
#define XB_XCNT(j)  (256  + 64 * (j))
#define XB_XSUB(j)  (1280 + 64 * (j))
#define XB_XGEN(j)  (2304 + 64 * (j))
#define XB_TOP      3328
#define XB_TOPGEN   3392
#define XCD_BAR_WORDS 3456
#define XB_SPIN_CAP (1u << 18)

__device__ __forceinline__ unsigned xb_ld(unsigned* p)              { return __hip_atomic_load(p, __ATOMIC_RELAXED, __HIP_MEMORY_SCOPE_AGENT); }
__device__ __forceinline__ unsigned xb_add(unsigned* p, unsigned v) { return __hip_atomic_fetch_add(p, v, __ATOMIC_RELAXED, __HIP_MEMORY_SCOPE_AGENT); }
__device__ __forceinline__ unsigned xb_xcc_id() { return (unsigned)__builtin_amdgcn_s_getreg((3 << 11) | 20) & 0xFu; }
#define XB_SPIN(cond, bar) do { unsigned _sp = 0; while (cond) { __builtin_amdgcn_s_sleep(1); \
    if ((++_sp & 255u) == 0u) { if (xb_ld(&(bar)[XB_TMO])) break; if (_sp > XB_SPIN_CAP) { atomicAdd(&(bar)[XB_TMO], 1u); break; } } } } while (0)

struct XcdBarrier {
    unsigned* bar; unsigned x;
    volatile LAS unsigned* st;
};

__device__ __forceinline__ XcdBarrier xcd_barrier_post(unsigned* bar, volatile LAS unsigned* st) {
    XcdBarrier b; b.bar = bar; b.x = xb_xcc_id(); b.st = st;
    if (threadIdx.x == 0) (void)xb_add(&bar[XB_XCNT(b.x)], 1u);
    return b;
}
__device__ __forceinline__ void xcd_barrier_complete(unsigned* bar, unsigned x, unsigned& nloc, unsigned& nx) {
    const unsigned G = gridDim.x * gridDim.y * gridDim.z;
    unsigned sum, cnt, mine, sp = 0u;
    for (;;) {
        sum = 0u; cnt = 0u; mine = 0u;
#pragma unroll
        for (unsigned j = 0; j < 16; ++j) { const unsigned c = xb_ld(&bar[XB_XCNT(j)]); sum += c; cnt += (c > 0u) ? 1u : 0u; mine = (j == x) ? c : mine; }
        if (sum == G) break;
        __builtin_amdgcn_s_sleep(1);
        if ((++sp & 255u) == 0u) { if (xb_ld(&bar[XB_TMO])) break; if (sp > XB_SPIN_CAP) { atomicAdd(&bar[XB_TMO], 1u); break; } }
    }
    nloc = mine > 0u ? mine : 1u; nx = cnt > 0u ? cnt : 1u;
}

__device__ __forceinline__ void xcd_barrier(const XcdBarrier& b, const bool is_t0) {
    asm volatile("s_waitcnt vmcnt(0)" ::: "memory");
    __syncthreads();
    if (is_t0) {
        unsigned* bar = b.bar;
        __builtin_amdgcn_s_waitcnt(0);
        unsigned nloc = b.st[0], nx = b.st[1];
        if (nloc == 0u) { xcd_barrier_complete(bar, b.x, nloc, nx); b.st[0] = nloc; b.st[1] = nx; }
        const unsigned old = xb_add(&bar[XB_XSUB(b.x)], 1u);
        const unsigned gen = old / nloc;
        if (old + 1u == (gen + 1u) * nloc) {
            __builtin_amdgcn_fence(__ATOMIC_RELEASE, "agent");
            asm volatile("s_waitcnt vmcnt(0)" ::: "memory");
            const unsigned og = xb_add(&bar[XB_TOP], 1u);
            const unsigned tg = og / nx;
            if (og + 1u == (tg + 1u) * nx) xb_add(&bar[XB_TOPGEN], 1u);
            else XB_SPIN(xb_ld(&bar[XB_TOPGEN]) == tg, bar);
            __builtin_amdgcn_fence(__ATOMIC_ACQUIRE, "agent");
            xb_add(&bar[XB_XGEN(b.x)], 1u);
            asm volatile("s_waitcnt vmcnt(0)" ::: "memory");
        } else {
            XB_SPIN(xb_ld(&bar[XB_XGEN(b.x)]) == gen, bar);
            __builtin_amdgcn_fence(__ATOMIC_ACQUIRE, "agent");
            asm volatile("s_waitcnt vmcnt(0)" ::: "memory");
        }
    }
    __syncthreads();
}

struct Args { const float* in[17]; float* out; unsigned char* ws; int ph_lo, ph_hi; };
enum { I_X = 0, I_C, I_WMOD, I_BMOD, I_WIN, I_WPOOL, I_PSCALE, I_WOUT, I_LN1G, I_LN1B, I_WR, I_RB, I_WG, I_WU, I_WDN, I_LN2G, I_LN2B };

DEVFN int lane_id_volatile() { int l; asm volatile("v_mbcnt_lo_u32_b32 %0, -1, 0\n\tv_mbcnt_hi_u32_b32 %0, -1, %0" : "=v"(l)); return l; }
struct Ctx { unsigned char* lds; __attribute__((address_space(3))) unsigned char* lds3; int tid, lane, wave, G, bid, gw, NGW; };

DEVFN void transpose_item(const float* src, int ldn, int k0, int col, bf16_t* dst, int ldk, int dst_row0, int dst_k0, float* scr, int lane) {
#pragma unroll 8
    for (int i = 0; i < 32; ++i) { const int kk = 2 * i + (lane >> 5); scr[kk * 33 + (lane & 31)] = src[(size_t)(k0 + kk) * ldn + col]; }
    LDS_WAIT();
    const int c = lane & 7;
#pragma unroll
    for (int j = 0; j < 4; ++j) { const int n = (lane >> 3) + 8 * j; const float* s = scr + (8 * c) * 33 + n;
        u32x4 o; o.x = pk2(s[0 * 33], s[1 * 33]); o.y = pk2(s[2 * 33], s[3 * 33]); o.z = pk2(s[4 * 33], s[5 * 33]); o.w = pk2(s[6 * 33], s[7 * 33]);
        *(u32x4*)(dst + (size_t)(dst_row0 + n) * ldk + dst_k0 + 8 * c) = o; }
    LDS_WAIT();
}

DEVFN void transpose_item_f8(const float* src, int ldn, int k0, int col, unsigned char* dst, int ldk, int dst_row0, int dst_k0, float* scr, int lane) {
#pragma unroll 8
    for (int i = 0; i < 32; ++i) { const int kk = 2 * i + (lane >> 5); scr[kk * 33 + (lane & 31)] = src[(size_t)(k0 + kk) * ldn + col]; }
    LDS_WAIT();
    const int c = lane & 7;
#pragma unroll
    for (int j = 0; j < 4; ++j) { const int n = (lane >> 3) + 8 * j; const float* s = scr + (8 * c) * 33 + n;
        u32x2 o; o.x = pk4_fp8(32.f * s[0 * 33], 32.f * s[1 * 33], 32.f * s[2 * 33], 32.f * s[3 * 33]); o.y = pk4_fp8(32.f * s[4 * 33], 32.f * s[5 * 33], 32.f * s[6 * 33], 32.f * s[7 * 33]);
        *(u32x2*)(dst + (size_t)(dst_row0 + n) * ldk + dst_k0 + 8 * c) = o; }
    LDS_WAIT();
}

DEVFN void ph_prologue(const Args& a, const Ctx& c) {
    unsigned char* ws = a.ws;
    float* scr = (float*)(c.lds + c.wave * 16384);
    const int lane = c.lane;
    constexpr int N1 = 2 * 16 * 64, N2 = 2 * 8 * 32, N3 = 32 * 16 * 32, N4 = 32 * 8 * 32, N5 = 2 * 64 * 16, N6 = 256;
    for (int it = c.gw; it < N1 + N2 + N3 + N4 + N5 + N6; it += c.NGW) {
        int r = it;
        if (r < N1) {
            const int l = r / 1024, kb = (r % 1024) / 64, nb = r % 64;
            const int nphys = 32 * nb + (lane & 31);
            transpose_item_f8(a.in[I_WIN] + (size_t)l * DM * DIN, DIN, 64 * kb, inproj_nlog(nphys), (unsigned char*)(ws + WS_WIN) + (size_t)l * DIN * DM, DM, 32 * nb, 64 * kb, scr, lane);
            continue; }
        r -= N1;
        if (r < N2) {
            const int l = r / 256, kb = (r % 256) / 32, nb = r % 32;
            transpose_item(a.in[I_WOUT] + (size_t)l * DM * DM, DM, 64 * kb, 32 * nb + (lane & 31), (bf16_t*)(ws + WS_WOUT) + (size_t)l * DM * DM, DM, 32 * nb, 64 * kb, scr, lane);
            continue; }
        r -= N2;
        if (r < N3) {
            const int le = r / 512, kb = (r % 512) / 32, nb = r % 32;
            const int n = 32 * nb + (lane & 31), jt = n >> 8, bj = (n >> 7) & 1, i = n & 127;
            const float* src = (bj ? a.in[I_WU] : a.in[I_WG]) + (size_t)le * DM * DE;
            transpose_item_f8(src, DE, 64 * kb, jt * 128 + i, (unsigned char*)(ws + WS_WGU) + (size_t)le * DM * DM, DM, 32 * nb, 64 * kb, scr, lane);
            continue; }
        r -= N3;
        if (r < N4) {
            const int le = r / 256, kb = (r % 256) / 32, nb = r % 32;
            transpose_item_f8(a.in[I_WDN] + (size_t)le * DE * DM, DM, 64 * kb, 32 * nb + (lane & 31), (unsigned char*)(ws + WS_WD) + (size_t)le * DM * DE, DE, 32 * nb, 64 * kb, scr, lane);
            continue; }
        r -= N4;
        if (r < N5) {
            const int l = r / 1024, kdg = (r % 1024) / 16, nb = r % 16;
            const int n = nb * 64 + lane, kd0 = kdg * 8, g = kd0 >> 7, c0 = kd0 & 127;
            const float* wo = a.in[I_WOUT] + (size_t)l * DM * DM + (size_t)(512 + g * 128) * DM + n;
            const float* ps = a.in[I_PSCALE] + l * 512 + g * 128;
            const float* wp = a.in[I_WPOOL] + ((size_t)(l * 4 + g) * 128 + c0) * 128;
            float acc[8];
#pragma unroll
            for (int j = 0; j < 8; ++j) acc[j] = 0.f;
            for (int e = 0; e < 128; ++e) { const float w = wo[(size_t)e * DM] * ps[e];
#pragma unroll
                for (int j = 0; j < 8; ++j) acc[j] += wp[j * 128 + e] * w; }
            u32x4 o; o.x = pk2(acc[0], acc[1]); o.y = pk2(acc[2], acc[3]); o.z = pk2(acc[4], acc[5]); o.w = pk2(acc[6], acc[7]);
            *(u32x4*)((bf16_t*)(ws + WS_WOUT) + (size_t)l * DM * DM + (size_t)n * DM + 512 + kd0) = o;
            continue; }
        r -= N5;
        {
            const int ent = r * 64 + lane, pos = ent >> 3, i = ent & 7;
            const float inv = (float)exp2(-(double)i / 8.0 * 18.931568569324174);
            const float ang = (float)pos * inv;
            float* t = (float*)(ws + WS_ROPE) + ent * 2;
            t[0] = (float)cos((double)ang); t[1] = (float)sin((double)ang);
        }
    }
    for (int i = c.bid * 512 + c.tid; i < 2 * NB * NH * NBLK * HD; i += c.G * 512) ((float*)(ws + WS_KBAR))[i] = 0.f;
    __syncthreads();
    if (c.bid < 192) {
        float* condT = (float*)c.lds;
        float* red = (float*)(c.lds + 65536);
        for (int idx = c.tid; idx < NB * DM; idx += 512) { const int b = idx >> 10, k = idx & 1023; const float v = a.in[I_C][idx]; condT[k * 16 + b] = v / (1.f + __expf(-v)); }
        __syncthreads();
        for (int u = c.bid; u < 192; u += c.G) {
            const int l = u / 96, n0 = (u % 96) * 64;
            const float* W = a.in[I_WMOD] + (size_t)l * DM * NMOD + n0 + lane;
            float acc[16];
#pragma unroll
            for (int b = 0; b < 16; ++b) acc[b] = 0.f;
            for (int k = 128 * c.wave; k < 128 * c.wave + 128; k += 8) {
                float wv[8];
#pragma unroll
                for (int j = 0; j < 8; ++j) wv[j] = W[(size_t)(k + j) * NMOD];
#pragma unroll
                for (int j = 0; j < 8; ++j) {
                    const f32x4* cp = (const f32x4*)(condT + (k + j) * 16);
#pragma unroll
                    for (int q = 0; q < 4; ++q) { const f32x4 cv = cp[q]; acc[4 * q + 0] += cv.x * wv[j]; acc[4 * q + 1] += cv.y * wv[j]; acc[4 * q + 2] += cv.z * wv[j]; acc[4 * q + 3] += cv.w * wv[j]; }
                }
            }
#pragma unroll
            for (int b = 0; b < 16; ++b) red[(c.wave * 16 + b) * 64 + lane] = acc[b];
            __syncthreads();
            for (int o = c.tid; o < 1024; o += 512) { const int b = o >> 6, cc = o & 63; float s = a.in[I_BMOD][l * NMOD + n0 + cc];
#pragma unroll
                for (int w = 0; w < 8; ++w) s += red[(w * 16 + b) * 64 + cc];
                ((float*)(ws + WS_MOD))[(size_t)(l * NB + b) * NMOD + n0 + cc] = s; }
            __syncthreads();
        }
    }
}

DEVFN void row_stats(const f32x4 (&v)[4], float& mean, float& rstd) {
    float s = 0.f;
#pragma unroll
    for (int j = 0; j < 4; ++j) s += (v[j].x + v[j].y) + (v[j].z + v[j].w);
    mean = wave_sum(s) * (1.f / DM);
    float q = 0.f;
#pragma unroll
    for (int j = 0; j < 4; ++j) { const f32x4 d = v[j] - mean; q += (d.x * d.x + d.y * d.y) + (d.z * d.z + d.w * d.w); }
    rstd = 1.f / sqrtf(wave_sum(q) * (1.f / DM) + LN_EPS);
}
DEVFN void row_load(const float* p, int lane, f32x4 (&v)[4]) {
#pragma unroll
    for (int j = 0; j < 4; ++j) v[j] = *(const f32x4*)(p + 4 * lane + 256 * j);
}
DEVFN void row_mod_store(f32x4 (&v)[4], const float* sc, const float* sh, bf16_t* out, int lane) {
    float mean, rstd; row_stats(v, mean, rstd);
#pragma unroll
    for (int j = 0; j < 4; ++j) {
        const f32x4 s = *(const f32x4*)(sc + 4 * lane + 256 * j), h = *(const f32x4*)(sh + 4 * lane + 256 * j);
        v[j] = (v[j] - mean) * rstd * (s + 1.f) + h;
        u32x2 o; o.x = pk2(v[j].x, v[j].y); o.y = pk2(v[j].z, v[j].w);
        *(u32x2*)(out + 4 * lane + 256 * j) = o;
    }
}

DEVFN void wave_gemm32(f32x16& acc, const bf16_t* ap, const bf16_t* bp, int K) {
#pragma unroll 4
    for (int k = 0; k < K; k += 16) {
        const bf16x8 av = *(const bf16x8*)(ap + k), bv = *(const bf16x8*)(bp + k);
        acc = __builtin_amdgcn_mfma_f32_32x32x16_bf16(av, bv, acc, 0, 0, 0);
    }
}

DEVFN void ph_inproj_naive(const Args& a, const Ctx& c, int l) {
    const bf16_t* A = (const bf16_t*)(a.ws + WS_HB); const bf16_t* Bt = (const bf16_t*)(a.ws + WS_WIN) + (size_t)l * DIN * DM;
    bf16_t* O = (bf16_t*)(a.ws + WS_QKVP);
    const int r32 = c.lane & 31, hi = c.lane >> 5, wy = c.wave >> 2, wx = c.wave & 3;
    for (int u = c.bid; u < 512 * 16; u += c.G) {
        const int mt = u >> 4, nt = u & 15;
        f32x16 acc = {};
        wave_gemm32(acc, A + (size_t)(mt * 64 + wy * 32 + r32) * DM + hi * 8, Bt + (size_t)(nt * 128 + wx * 32 + r32) * DM + hi * 8, DM);
        const int nl = inproj_nlog(nt * 128 + wx * 32 + r32);
#pragma unroll
        for (int r = 0; r < 16; ++r) O[(size_t)(mt * 64 + wy * 32 + crow(r, hi)) * DIN + nl] = (bf16_t)f2bf(acc[r]);
    }
}

DEVFN void ph_rope_naive(const Args& a, const Ctx& c) {
    bf16_t* O = (bf16_t*)(a.ws + WS_QKVP); const float* rope = (const float*)(a.ws + WS_ROPE);
    for (int idx = c.bid * 512 + c.tid; idx < NTOK * 16; idx += c.G * 512) {
        const int which = idx & 1, hh = (idx >> 1) & 7, m = idx >> 4, t = m & (SEQ - 1);
        bf16_t* p = O + (size_t)m * DIN + which * 512 + hh * 64;
        float v[64];
#pragma unroll
        for (int q = 0; q < 8; ++q) { const u32x4 w = *(const u32x4*)(p + 8 * q);
            v[8 * q + 0] = bf_lo(w.x); v[8 * q + 1] = bf_hi(w.x); v[8 * q + 2] = bf_lo(w.y); v[8 * q + 3] = bf_hi(w.y);
            v[8 * q + 4] = bf_lo(w.z); v[8 * q + 5] = bf_hi(w.z); v[8 * q + 6] = bf_lo(w.w); v[8 * q + 7] = bf_hi(w.w); }
#pragma unroll
        for (int i = 0; i < 8; ++i) { const float cs = rope[(t * 8 + i) * 2], sn = rope[(t * 8 + i) * 2 + 1]; const float x1 = v[i], x2 = v[8 + i];
            v[i] = x1 * cs - x2 * sn; v[8 + i] = x2 * cs + x1 * sn; }
        const float sc = which == 0 ? QSCALE : 1.f;
#pragma unroll
        for (int q = 0; q < 8; ++q) { u32x4 w; w.x = pk2(v[8 * q] * sc, v[8 * q + 1] * sc); w.y = pk2(v[8 * q + 2] * sc, v[8 * q + 3] * sc); w.z = pk2(v[8 * q + 4] * sc, v[8 * q + 5] * sc); w.w = pk2(v[8 * q + 6] * sc, v[8 * q + 7] * sc);
            *(u32x4*)(p + 8 * q) = w; }
    }
}

DEVFN void ph_kbar(const Args& a, const Ctx& c, int l) {
    const bf16_t* O = (const bf16_t*)(a.ws + WS_QKVP); float* kbar = (float*)(a.ws + WS_KBAR) + (size_t)l * NB * NH * NBLK * HD;
    for (int it = c.gw; it < NB * NH * NBLK; it += c.NGW) {
        const int n = it & 7, hh = (it >> 3) & 7, b = it >> 6;
        const bf16_t* p = O + (size_t)(b * SEQ + n * MBLK) * DIN + 512 + hh * 64 + c.lane;
        float s = 0.f;
#pragma unroll 8
        for (int j = 0; j < MBLK; ++j) s += bf2f(p[(size_t)j * DIN]);
        kbar[(size_t)it * 64 + c.lane] = s * (1.f / MBLK);
    }
}

DEVFN void ph_pool(const Args& a, const Ctx& c) {
    const bf16_t* P = (const bf16_t*)(a.ws + WS_QKVP) + 1536; bf16_t* AD = (bf16_t*)(a.ws + WS_AD) + 512;
    for (int it = c.bid * 512 + c.tid; it < (NTOK / 16) * 64; it += c.G * 512) {
        const int cg = it & 63, m0 = (it >> 6) * 16, t0 = m0 & (SEQ - 1), g = cg >> 4, w = 2 << g;
        const bf16_t* pc = P + cg * 8;
        float s[8];
#pragma unroll
        for (int j = 0; j < 8; ++j) s[j] = 0.f;
        for (int i = 1; i < w; ++i) if (t0 - i >= 0) { const u32x4 v = *(const u32x4*)(pc + (size_t)(m0 - i) * DIN);
            s[0] += bf_lo(v.x); s[1] += bf_hi(v.x); s[2] += bf_lo(v.y); s[3] += bf_hi(v.y); s[4] += bf_lo(v.z); s[5] += bf_hi(v.z); s[6] += bf_lo(v.w); s[7] += bf_hi(v.w); }
#pragma unroll 4
        for (int r = 0; r < 16; ++r) {
            const int t = t0 + r; const u32x4 v = *(const u32x4*)(pc + (size_t)(m0 + r) * DIN);
            const float f[8] = {bf_lo(v.x), bf_hi(v.x), bf_lo(v.y), bf_hi(v.y), bf_lo(v.z), bf_hi(v.z), bf_lo(v.w), bf_hi(v.w)};
#pragma unroll
            for (int j = 0; j < 8; ++j) s[j] += f[j];
            const int cnt = (t + 1 < w) ? t + 1 : w; const float ic = 1.f / (float)cnt;
            u32x4 o; o.x = pk2(s[0] * ic - f[0], s[1] * ic - f[1]); o.y = pk2(s[2] * ic - f[2], s[3] * ic - f[3]); o.z = pk2(s[4] * ic - f[4], s[5] * ic - f[5]); o.w = pk2(s[6] * ic - f[6], s[7] * ic - f[7]);
            *(u32x4*)(AD + (size_t)(m0 + r) * DM + cg * 8) = o;
            if (t - w + 1 >= 0) { const u32x4 q = *(const u32x4*)(pc + (size_t)(m0 + r - w + 1) * DIN);
                s[0] -= bf_lo(q.x); s[1] -= bf_hi(q.x); s[2] -= bf_lo(q.y); s[3] -= bf_hi(q.y); s[4] -= bf_lo(q.z); s[5] -= bf_hi(q.z); s[6] -= bf_lo(q.w); s[7] -= bf_hi(q.w); }
        }
    }
}

DEVFN void ph_wout_naive(const Args& a, const Ctx& c, int l) {
    const bf16_t* A = (const bf16_t*)(a.ws + WS_AD); const bf16_t* Bt = (const bf16_t*)(a.ws + WS_WOUT) + (size_t)l * DM * DM;
    float* Y = (float*)(a.ws + WS_QKVP);
    const int r32 = c.lane & 31, hi = c.lane >> 5, wy = c.wave >> 2, wx = c.wave & 3;
    for (int u = c.bid; u < 512 * 8; u += c.G) {
        const int mt = u >> 3, nt = u & 7;
        f32x16 acc = {};
        wave_gemm32(acc, A + (size_t)(mt * 64 + wy * 32 + r32) * DM + hi * 8, Bt + (size_t)(nt * 128 + wx * 32 + r32) * DM + hi * 8, DM);
#pragma unroll
        for (int r = 0; r < 16; ++r) Y[(size_t)(mt * 64 + wy * 32 + crow(r, hi)) * DM + nt * 128 + wx * 32 + r32] = acc[r];
    }
}

struct MoeTab { int* cnt; int* tp; };
DEVFN MoeTab moe_table(const Args& a, const Ctx& c, int l, unsigned char* lds_at) {
    MoeTab t; t.cnt = (int*)lds_at; t.tp = t.cnt + 32;
    if (c.tid < NCLS) t.cnt[c.tid] = (int)__hip_atomic_load((unsigned*)(a.ws + WS_CTL) + CW_CNT + l * 32 + c.tid, RLX_AGENT);
    __syncthreads();
    if (c.tid == 0) { int s = 0; for (int k = 0; k < NCLS; ++k) { t.tp[k] = s; s += (t.cnt[k] + 255) >> 8; } t.tp[NCLS] = s; }
    __syncthreads();
    return t;
}
DEVFN void cls_experts(int cls, int& e1, int& e2) { const int g = cls / 6, p = cls % 6; const int lo = p < 3 ? 0 : (p < 5 ? 1 : 2), hi = p < 3 ? p + 1 : (p < 5 ? p - 1 : 3); e1 = g * 4 + lo; e2 = g * 4 + hi; }

DEVFN void ph_gateup_naive(const Args& a, const Ctx& c, int l) {
    const MoeTab T = moe_table(a, c, l, c.lds);
    const int ntiles = T.tp[NCLS];
    const bf16_t* HB = (const bf16_t*)(a.ws + WS_HB); const bf16_t* WGU = (const bf16_t*)(a.ws + WS_WGU) + (size_t)l * NE * DM * DM;
    const int* list = (const int*)(a.ws + WS_LIST); const float* rw = (const float*)(a.ws + WS_RW);
    bf16_t* ACT = (bf16_t*)(a.ws + WS_QKVP);
    const int r32 = c.lane & 31, hi = c.lane >> 5, wy = c.wave >> 2, wx = c.wave & 3;
    for (int u = c.bid; u < ntiles * 32; u += c.G) {
        const int Tt = u >> 5, sub = (u >> 3) & 3, half = (u >> 2) & 1, jt = u & 3;
        int cls = 0; while (Tt >= T.tp[cls + 1]) ++cls;
        const int j = Tt - T.tp[cls], cnt = T.cnt[cls];
        int e1, e2; cls_experts(cls, e1, e2); const int e = half ? e2 : e1;
        const int lr = sub * 64 + wy * 32 + r32, li = 256 * j + lr;
        const int tok = list[(size_t)cls * LISTCAP + (li < cnt ? li : 256 * j)];
        const bf16_t* ap = HB + (size_t)tok * DM + hi * 8;
        const bf16_t* bg = WGU + (size_t)e * DM * DM + (size_t)(jt * 256 + wx * 32 + r32) * DM + hi * 8;
        f32x16 ag = {}, au = {};
        wave_gemm32(ag, ap, bg, DM); wave_gemm32(au, ap, bg + (size_t)128 * DM, DM);
#pragma unroll
        for (int r = 0; r < 16; ++r) {
            const int lro = sub * 64 + wy * 32 + crow(r, hi), lio = 256 * j + lro;
            const float wgt = lio < cnt ? rw[((size_t)cls * LISTCAP + lio) * 2 + half] : 0.f;
            const float g = ag[r], act = g / (1.f + __expf(-g)) * au[r] * wgt;
            ACT[(size_t)(256 * Tt + lro) * DM + half * 512 + jt * 128 + wx * 32 + r32] = (bf16_t)f2bf(act);
        }
    }
}

DEVFN void ph_down_naive(const Args& a, const Ctx& c, int l) {
    const MoeTab T = moe_table(a, c, l, c.lds);
    const int ntiles = T.tp[NCLS];
    const bf16_t* ACT = (const bf16_t*)(a.ws + WS_QKVP); const bf16_t* WD = (const bf16_t*)(a.ws + WS_WD) + (size_t)l * NE * DM * DE;
    const int* list = (const int*)(a.ws + WS_LIST);
    bf16_t* Y2 = (bf16_t*)(a.ws + WS_AD);
    const int r32 = c.lane & 31, hi = c.lane >> 5, wy = c.wave >> 2, wx = c.wave & 3;
    for (int u = c.bid; u < ntiles * 32; u += c.G) {
        const int Tt = u >> 5, sub = (u >> 3) & 3, nt = u & 7;
        int cls = 0; while (Tt >= T.tp[cls + 1]) ++cls;
        const int j = Tt - T.tp[cls], cnt = T.cnt[cls];
        int e1, e2; cls_experts(cls, e1, e2);
        const bf16_t* ap = ACT + (size_t)(256 * Tt + sub * 64 + wy * 32 + r32) * DM + hi * 8;
        const int n = nt * 128 + wx * 32 + r32;
        f32x16 acc = {};
        wave_gemm32(acc, ap, WD + (size_t)e1 * DM * DE + (size_t)n * DE + hi * 8, DE);
        wave_gemm32(acc, ap + DE, WD + (size_t)e2 * DM * DE + (size_t)n * DE + hi * 8, DE);
#pragma unroll
        for (int r = 0; r < 16; ++r) {
            const int lio = 256 * j + sub * 64 + wy * 32 + crow(r, hi);
            if (lio < cnt) { const int tok = list[(size_t)cls * LISTCAP + lio]; Y2[(size_t)tok * DM + n] = (bf16_t)f2bf(acc[r]); }
        }
    }
}

constexpr size_t WS_X1B = WS_X1, WS_X2B = WS_X1 + 64 * MiB;
constexpr int ROWS_PER_WAVE = 16;
DEVFN void vec_load(const float* p, int lane, f32x4 (&v)[4]) {
#pragma unroll
    for (int j = 0; j < 4; ++j) v[j] = *(const f32x4*)(p + 4 * lane + 256 * j);
}
DEVFN void bfrow_load(const bf16_t* p, int lane, u32x2 (&w)[4]) {
#pragma unroll
    for (int j = 0; j < 4; ++j) w[j] = *(const u32x2*)(p + 4 * lane + 256 * j);
}
DEVFN f32x4 bf4(u32x2 w) { return (f32x4){bf_lo(w.x), bf_hi(w.x), bf_lo(w.y), bf_hi(w.y)}; }
DEVFN void bfrow_store(bf16_t* p, int lane, const f32x4 (&v)[4]) {
#pragma unroll
    for (int j = 0; j < 4; ++j) { u32x2 o; o.x = pk2(v[j].x, v[j].y); o.y = pk2(v[j].z, v[j].w); *(u32x2*)(p + 4 * lane + 256 * j) = o; }
}
DEVFN void f8row_store(unsigned char* p, int lane, const f32x4 (&v)[4]) {
#pragma unroll
    for (int j = 0; j < 4; ++j) *(unsigned*)(p + 4 * lane + 256 * j) = pk4_fp8(v[j].x, v[j].y, v[j].z, v[j].w);
}
DEVFN void ln_mod(f32x4 (&v)[4], const f32x4 (&sc)[4], const f32x4 (&sh)[4]) {
    float mean, rstd; row_stats(v, mean, rstd);
#pragma unroll
    for (int j = 0; j < 4; ++j) v[j] = (v[j] - mean) * rstd * (sc[j] + 1.f) + sh[j];
}
DEVFN void ln_aff(f32x4 (&v)[4], const f32x4 (&g)[4], const f32x4 (&b)[4]) {
    float mean, rstd; row_stats(v, mean, rstd);
#pragma unroll
    for (int j = 0; j < 4; ++j) v[j] = (v[j] - mean) * rstd * g[j] + b[j];
}

DEVFN void ph_h1_rows(const Args& a, const Ctx& c) {
    const float* mod = (const float*)(a.ws + WS_MOD); bf16_t* HB = (bf16_t*)(a.ws + WS_HB);
    for (int base = c.gw * ROWS_PER_WAVE; base < NTOK; base += c.NGW * ROWS_PER_WAVE) {
        const float* mb = mod + (size_t)(base >> 11) * NMOD;
        f32x4 sc[4], sh[4]; vec_load(mb + DM, c.lane, sc); vec_load(mb, c.lane, sh);
        f32x4 cur[4], nxt[4]; vec_load(a.in[I_X] + (size_t)base * DM, c.lane, cur);
#pragma unroll 1
        for (int i = 0; i < ROWS_PER_WAVE; ++i) {
            const int m = base + i;
            if (i + 1 < ROWS_PER_WAVE) vec_load(a.in[I_X] + (size_t)(m + 1) * DM, c.lane, nxt);
            ln_mod(cur, sc, sh); f8row_store((unsigned char*)HB + (size_t)m * DM, c.lane, cur);
#pragma unroll
            for (int j = 0; j < 4; ++j) cur[j] = nxt[j];
        }
    }
}

DEVFN f32x4 reduce16(const float (&lg)[16]) {
    float t[8], u[4];
#pragma unroll
    for (int e = 0; e < 8; ++e) { auto rr = __builtin_amdgcn_permlane32_swap(__float_as_uint(lg[e]), __float_as_uint(lg[e + 8]), false, false); t[e] = __uint_as_float(rr[0]) + __uint_as_float(rr[1]); }
#pragma unroll
    for (int k = 0; k < 4; ++k) { auto rr = __builtin_amdgcn_permlane16_swap(__float_as_uint(t[k]), __float_as_uint(t[k + 4]), false, false); u[k] = __uint_as_float(rr[0]) + __uint_as_float(rr[1]); }
#pragma unroll
    for (int k = 0; k < 4; ++k) { u[k] = swz_xor_add(u[k], 1); u[k] = swz_xor_add(u[k], 2); u[k] = swz_xor_add(u[k], 4); u[k] = swz_xor_add(u[k], 8); }
    return (f32x4){u[0], u[1], u[2], u[3]};
}

DEVFN void ph_rows_c(const Args& a, const Ctx& c, int l, bool publish) {
    const float* mod = (const float*)(a.ws + WS_MOD) + (size_t)l * NB * NMOD;
    const bf16_t* Y = (const bf16_t*)(a.ws + WS_QKVP); const bf16_t* X2B = (const bf16_t*)(a.ws + WS_X2B);
    bf16_t* X1B = (bf16_t*)(a.ws + WS_X1B); bf16_t* HB = (bf16_t*)(a.ws + WS_HB);
    float* wr = (float*)c.lds;
    int* lcnt = (int*)(c.lds + 65536); int* lbase = lcnt + 32;
    int* rcls = lbase + 32; float* rw1 = (float*)(rcls + 8 * 64); float* rw2 = rw1 + 8 * 64; int* rrow = (int*)(rw2 + 8 * 64); float* lgs = (float*)(rrow + 8 * 64);
    for (int i = c.tid; i < DM * NE; i += 512) wr[(i & 15) * DM + (i >> 4)] = a.in[I_WR][i];
    if (c.tid < 32) lcnt[c.tid] = 0;
    __syncthreads();
    int nr = 0;
    for (int base = c.gw * ROWS_PER_WAVE; base < NTOK; base += c.NGW * ROWS_PER_WAVE) {
        const float* mb = mod + (size_t)(base >> 11) * NMOD;
        f32x4 g1[4], sc[4], sh[4];
        vec_load(mb + 2 * DM, c.lane, g1); vec_load(mb + 4 * DM, c.lane, sc); vec_load(mb + 3 * DM, c.lane, sh);
        f32x4 xc[4], xn[4]; u32x2 yc[4], yn[4];
        if (l == 0) vec_load(a.in[I_X] + (size_t)base * DM, c.lane, xc);
        else { u32x2 w[4]; bfrow_load(X2B + (size_t)base * DM, c.lane, w);
#pragma unroll
            for (int j = 0; j < 4; ++j) { xc[j].x = __uint_as_float(w[j].x); xc[j].y = __uint_as_float(w[j].y); } }
        bfrow_load(Y + (size_t)base * DM, c.lane, yc);
#pragma unroll 1
        for (int i = 0; i < ROWS_PER_WAVE; ++i) {
            const int m = base + i;
            if (i + 1 < ROWS_PER_WAVE) {
                if (l == 0) vec_load(a.in[I_X] + (size_t)(m + 1) * DM, c.lane, xn);
                else { u32x2 w[4]; bfrow_load(X2B + (size_t)(m + 1) * DM, c.lane, w);
#pragma unroll
                    for (int j = 0; j < 4; ++j) { xn[j].x = __uint_as_float(w[j].x); xn[j].y = __uint_as_float(w[j].y); } }
                bfrow_load(Y + (size_t)(m + 1) * DM, c.lane, yn);
            }
            f32x4 v[4];
#pragma unroll
            for (int j = 0; j < 4; ++j) { const f32x4 xv = (l == 0) ? xc[j] : bf4((u32x2){__float_as_uint(xc[j].x), __float_as_uint(xc[j].y)}); v[j] = xv * ALPHA + g1[j] * bf4(yc[j]); }
            { f32x4 lg[4], lb[4]; vec_load(a.in[I_LN1G] + l * DM, c.lane, lg); vec_load(a.in[I_LN1B] + l * DM, c.lane, lb); ln_aff(v, lg, lb); } bfrow_store(X1B + (size_t)m * DM, c.lane, v);
            ln_mod(v, sc, sh);
#pragma unroll
            for (int j = 0; j < 4; ++j) *(unsigned*)((unsigned char*)HB + (size_t)m * DM + 4 * c.lane + 256 * j) = pk4_fp8(v[j].x, v[j].y, v[j].z, v[j].w);
            float lg16[16];
#pragma unroll
            for (int e = 0; e < 16; ++e) lg16[e] = 0.f;
#pragma unroll
            for (int j = 0; j < 4; ++j)
#pragma unroll
                for (int e = 0; e < 16; ++e) { const f32x4 w = *(const f32x4*)(wr + e * DM + 4 * c.lane + 256 * j); lg16[e] += (v[j].x * w.x + v[j].y * w.y) + (v[j].z * w.z + v[j].w * w.w); }
            { const f32x4 uu = reduce16(lg16); if ((c.lane & 15) == 0) *(f32x4*)(lgs + (c.wave * 16 + i) * 16 + (c.lane >> 4) * 4) = uu; }
#pragma unroll
            for (int j = 0; j < 4; ++j) { xc[j] = xn[j]; yc[j] = yn[j]; }
        }
        LDS_WAIT();
        if (c.lane < ROWS_PER_WAVE) {
            float lg16[16], rb[16];
#pragma unroll
            for (int e = 0; e < 16; ++e) rb[e] = a.in[I_RB][e];
#pragma unroll
            for (int q = 0; q < 4; ++q) { const f32x4 t = *(const f32x4*)(lgs + (c.wave * 16 + c.lane) * 16 + 4 * q); lg16[4 * q] = t.x; lg16[4 * q + 1] = t.y; lg16[4 * q + 2] = t.z; lg16[4 * q + 3] = t.w; }
            float mx = lg16[0];
#pragma unroll
            for (int e = 1; e < 16; ++e) mx = fmaxf(mx, lg16[e]);
            float sum = 0.f, scr[16];
#pragma unroll
            for (int e = 0; e < 16; ++e) { scr[e] = __expf(lg16[e] - mx); sum += scr[e]; }
            const float isum = 1.f / sum;
#pragma unroll
            for (int e = 0; e < 16; ++e) scr[e] *= isum;
            float bestg = -3.4e38f; int gb = 0, bi1 = 0, bi2 = 1; float bw1 = 0.f, bw2 = 0.f;
#pragma unroll
            for (int g = 0; g < 4; ++g) {
                float m1 = scr[4 * g] + rb[4 * g], s1 = scr[4 * g]; int i1 = 0;
#pragma unroll
                for (int q = 1; q < 4; ++q) { const float sv = scr[4 * g + q] + rb[4 * g + q]; const bool ok = sv > m1; m1 = ok ? sv : m1; s1 = ok ? scr[4 * g + q] : s1; i1 = ok ? q : i1; }
                float m2 = -3.4e38f, s2 = 0.f; int i2 = 0;
#pragma unroll
                for (int q = 0; q < 4; ++q) { const float sv = scr[4 * g + q] + rb[4 * g + q]; const bool ok = (q != i1) && sv > m2; m2 = ok ? sv : m2; s2 = ok ? scr[4 * g + q] : s2; i2 = ok ? q : i2; }
                const float gs = m1 + m2; const bool better = gs > bestg;
                bestg = better ? gs : bestg; gb = better ? g : gb; bi1 = better ? i1 : bi1; bi2 = better ? i2 : bi2; bw1 = better ? s1 : bw1; bw2 = better ? s2 : bw2;
            }
            const float inv = 1.f / (bw1 + bw2);
            const int lo = bi1 < bi2 ? bi1 : bi2, hi2 = bi1 < bi2 ? bi2 : bi1;
            const float wlo = (bi1 < bi2 ? bw1 : bw2) * inv, whi = (bi1 < bi2 ? bw2 : bw1) * inv;
            const int pidx = lo == 0 ? hi2 - 1 : (lo == 1 ? hi2 + 1 : 5);
            const int slot = c.wave * 64 + nr + c.lane;
            rcls[slot] = gb * 6 + pidx; rw1[slot] = wlo; rw2[slot] = whi; rrow[slot] = base + c.lane;
        }
        nr += ROWS_PER_WAVE;
        LDS_WAIT();
    }
    LDS_WAIT();
    if (!publish) return;
    int rank = 0, cls = 0;
    if (c.lane < nr) { cls = rcls[c.wave * 64 + c.lane]; rank = atomicAdd(&lcnt[cls], 1); }
    __syncthreads();
    if (c.tid < NCLS) lbase[c.tid] = (int)__hip_atomic_fetch_add((unsigned*)(a.ws + WS_CTL) + CW_CNT + l * 32 + c.tid, (unsigned)lcnt[c.tid], RLX_AGENT);
    __syncthreads();
    if (c.lane < nr) {
        const int pos = lbase[cls] + rank;
        ((int*)(a.ws + WS_LIST))[(size_t)cls * LISTCAP + pos] = rrow[c.wave * 64 + c.lane];
        float* rw = (float*)(a.ws + WS_RW) + ((size_t)cls * LISTCAP + pos) * 2;
        rw[0] = rw1[c.wave * 64 + c.lane]; rw[1] = rw2[c.wave * 64 + c.lane];
    }
}

DEVFN void ph_rows_g(const Args& a, const Ctx& c, int l) {
    const float* mod = (const float*)(a.ws + WS_MOD) + (size_t)l * NB * NMOD;
    const bf16_t* X1B = (const bf16_t*)(a.ws + WS_X1B); const bf16_t* Y2 = (const bf16_t*)(a.ws + WS_AD);
    bf16_t* X2B = (bf16_t*)(a.ws + WS_X2B); bf16_t* HB = (bf16_t*)(a.ws + WS_HB);
    for (int base = c.gw * ROWS_PER_WAVE; base < NTOK; base += c.NGW * ROWS_PER_WAVE) {
        const float* mb = mod + (size_t)(base >> 11) * NMOD; const float* mb1 = mb + (size_t)NB * NMOD;
        f32x4 g2[4], lg[4], lb[4], sc[4], sh[4];
        vec_load(mb + 5 * DM, c.lane, g2); vec_load(a.in[I_LN2G] + l * DM, c.lane, lg); vec_load(a.in[I_LN2B] + l * DM, c.lane, lb);
        if (l == 0) { vec_load(mb1 + DM, c.lane, sc); vec_load(mb1, c.lane, sh); }
        u32x2 xc[4], xn[4], yc[4], yn[4];
        bfrow_load(X1B + (size_t)base * DM, c.lane, xc); bfrow_load(Y2 + (size_t)base * DM, c.lane, yc);
#pragma unroll 1
        for (int i = 0; i < ROWS_PER_WAVE; ++i) {
            const int m = base + i;
            if (i + 1 < ROWS_PER_WAVE) { bfrow_load(X1B + (size_t)(m + 1) * DM, c.lane, xn); bfrow_load(Y2 + (size_t)(m + 1) * DM, c.lane, yn); }
            f32x4 v[4];
#pragma unroll
            for (int j = 0; j < 4; ++j) v[j] = bf4(xc[j]) * ALPHA + g2[j] * bf4(yc[j]);
            ln_aff(v, lg, lb);
            if (l == 0) { bfrow_store(X2B + (size_t)m * DM, c.lane, v); ln_mod(v, sc, sh); f8row_store((unsigned char*)HB + (size_t)m * DM, c.lane, v); }
            else {
#pragma unroll
                for (int j = 0; j < 4; ++j) *(f32x4*)(a.out + (size_t)m * DM + 4 * c.lane + 256 * j) = v[j]; }
#pragma unroll
            for (int j = 0; j < 4; ++j) { xc[j] = xn[j]; yc[j] = yn[j]; }
        }
    }
}

constexpr int MOETAB_OFF = 131072 + 512;
DEVFN void ph_inproj_fast(const Args& a, const Ctx& c, int l, bool dummy_kbar) {
    pg8::DenseSched S; S.so.init(NTOK, DIN, c.G, c.bid); S.A = (const char*)(a.ws + WS_HB); S.Bt = (const char*)(a.ws + WS_WIN) + (size_t)l * DIN * DM; S.lda = DM; S.ldb = DM;
    const pg8::EpiInproj E{(bf16_t*)(a.ws + WS_QKVP), (const float*)(a.ws + WS_ROPE), (dummy_kbar ? (float*)(a.ws + WS_RW) : (float*)(a.ws + WS_KBAR)) + (size_t)l * NB * NH * NBLK * HD};
    pg8::gemm_phase2<pg8::EpiInproj, pg8::DenseSched, true, true, false, true, 127 - 5, 127>(c.lds3, DM, DM, S, E, c.tid);
}
DEVFN void ph_wout_fast(const Args& a, const Ctx& c, int l) {
    pg8::DenseSched S; S.so.init(NTOK, DM, c.G, c.bid); S.A = (const char*)(a.ws + WS_AD); S.Bt = (const char*)(a.ws + WS_WOUT) + (size_t)l * DM * DM * 2; S.lda = DM * 2; S.ldb = DM * 2;
    const pg8::EpiBf16<0> E{(bf16_t*)(a.ws + WS_QKVP), DM, nullptr, 0, 0, 1.f};
    pg8::gemm_phase2<pg8::EpiBf16<0>, pg8::DenseSched, true, true, false>(c.lds3, DM * 2, DM * 2, S, E, c.tid);
}
DEVFN void moe_table_lds(const Args& a, const Ctx& c, int l) {
    int* cnt = (int*)(c.lds + MOETAB_OFF); int* tp = cnt + 32;
    if (c.tid < NCLS) cnt[c.tid] = (int)__hip_atomic_load((unsigned*)(a.ws + WS_CTL) + CW_CNT + l * 32 + c.tid, RLX_AGENT);
    __syncthreads();
    if (c.tid == 0) { int s = 0; for (int k = 0; k < NCLS; ++k) { tp[k] = s; s += (cnt[k] + 255) >> 8; } tp[NCLS] = s; }
    __syncthreads();
}
DEVFN void ph_gateup_fast(const Args& a, const Ctx& c, int l) {
    moe_table_lds(a, c, l);
    pg8::GateUpSched S; S.cnt = (const LAS int*)(c.lds3 + MOETAB_OFF); S.tp = S.cnt + 32; S.npn_shift = 3; S.nunits = S.tp[NCLS] * 8; S.G = c.G; S.c = c.bid;
    S.HB = (const char*)(a.ws + WS_HB); S.list = (const int*)(a.ws + WS_LIST); S.W = (const char*)(a.ws + WS_WGU) + (size_t)l * NE * DM * DM;
    const pg8::EpiGateUp E{(unsigned char*)(a.ws + WS_QKVP), (const float*)(a.ws + WS_RW)};
    pg8::gemm_phase2<pg8::EpiGateUp, pg8::GateUpSched, true, true, false, true, 127 - 5, 127>(c.lds3, DM, DM, S, E, c.tid);
}
DEVFN void ph_down_fast(const Args& a, const Ctx& c, int l) {
    moe_table_lds(a, c, l);
    pg8::DownSched S; S.cnt = (const LAS int*)(c.lds3 + MOETAB_OFF); S.tp = S.cnt + 32; S.npn_shift = 2; S.nunits = S.tp[NCLS] * 4; S.G = c.G; S.c = c.bid;
    S.ACT = (const char*)(a.ws + WS_QKVP); S.W = (const char*)(a.ws + WS_WD) + (size_t)l * NE * DM * DE;
    const pg8::EpiDown E{(bf16_t*)(a.ws + WS_AD), (const int*)(a.ws + WS_LIST)};
    pg8::gemm_phase2<pg8::EpiDown, pg8::DownSched, true, true, true, true, 127 - 5, 127 - 3>(c.lds3, DM, DE, S, E, c.tid);
}

#ifndef MK_N_LAUNCHES
#define MK_N_LAUNCHES 1
#endif
constexpr int RING_BYTES = 131072, LDSCTL_OFF = RING_BYTES, MISC_OFF = LDSCTL_OFF + 320, LDS_BYTES = 147456;
constexpr int PH_PER_LAYER = 7, NPHASE = 2 + 2 * PH_PER_LAYER;
constexpr int CW_BAR = 4096;
static_assert((CW_BAR + XCD_BAR_WORDS) * 4 <= (int)CTL_ZERO_BYTES, "CTL");

__global__ void __launch_bounds__(512, 2) fwd(Args a) {
    extern __shared__ __attribute__((aligned(16))) unsigned char lds[];
    const int wave_s = __builtin_amdgcn_readfirstlane(threadIdx.x >> 6);
#define MKTID() (wave_s * 64 + lane_id_volatile())
#define MKCTX() Args al = a; { size_t z_ = 0; asm volatile("" : "+s"(z_)); al.ws = a.ws + z_; } Ctx c; {     int t_ = MKTID(); asm volatile("" : "+v"(t_)); c.lds = lds; c.lds3 = (LAS unsigned char*)lds; c.tid = t_; c.lane = t_ & 63; c.wave = __builtin_amdgcn_readfirstlane(t_ >> 6); c.G = gridDim.x; c.bid = blockIdx.x; c.gw = c.bid * 8 + c.wave; c.NGW = c.G * 8; }
    const int lo = a.ph_lo, hi = a.ph_hi;
    const bool one = (hi - lo) > 1;
    for (int u = threadIdx.x; u < (LDS_BYTES - LDSCTL_OFF) / 4; u += 512) ((LAS unsigned*)((LAS unsigned char*)lds + LDSCTL_OFF))[u] = 0u;
    __syncthreads();
    XcdBarrier bar; bar.bar = (unsigned*)(a.ws + WS_CTL) + CW_BAR; bar.x = 0; bar.st = nullptr;
    if (one) bar = xcd_barrier_post((unsigned*)(a.ws + WS_CTL) + CW_BAR, (volatile LAS unsigned*)((LAS unsigned char*)lds + MISC_OFF) + 8);
#ifndef REP_PHASE
#define REP_PHASE -1
#endif
#define IN(k) (lo <= (k) && (k) < hi)
#define SEAM(k) do { if (IN(k) && IN((k) + 1)) { XcdBarrier bl_ = bar; { size_t z_ = 0; unsigned x_ = bar.x; asm volatile("" : "+s"(z_), "+s"(x_)); bl_.bar = bar.bar + z_; bl_.x = x_; } xcd_barrier(bl_, MKTID() == 0); } } while (0)
    if (IN(0)) { MKCTX(); ph_prologue(al, c); if (REP_PHASE == 0) { __syncthreads(); ph_prologue(al, c); } SEAM(0); }
    if (IN(1)) { MKCTX(); ph_h1_rows(al, c); if (REP_PHASE == 1) ph_h1_rows(al, c); SEAM(1); }
    {
        constexpr int l = 0; constexpr int p0 = 2 + l * PH_PER_LAYER;
        if (IN(p0 + 0)) { MKCTX(); ph_inproj_fast(al, c, l, false); if (REP_PHASE == 10) { __syncthreads(); ph_inproj_fast(al, c, l, true); } SEAM(p0 + 0); }
        if (IN(p0 + 1)) {
            { MKCTX(); ph_pool(al, c); }
            __syncthreads();
            const attn_body::AttnTensors AT{(const attn_body::bf16*)(a.ws + WS_QKVP), (const attn_body::bf16*)(a.ws + WS_QKVP) + 512, (const attn_body::bf16*)(a.ws + WS_QKVP) + 1024,
                                            (attn_body::bf16*)(a.ws + WS_AD), (const float*)(a.ws + WS_KBAR) + (size_t)l * NB * NH * NBLK * HD};
            const attn_body::StaticOrder S((int)gridDim.x, (int)blockIdx.x);
            attn_body::attn_phase<attn_body::StaticOrder>((char*)lds, AT, S, MKTID());
            if (REP_PHASE == 11) attn_body::attn_phase<attn_body::StaticOrder>((char*)lds, AT, S, MKTID());
            if (REP_PHASE == 17) { __syncthreads(); MKCTX(); ph_pool(al, c); }
            SEAM(p0 + 1);
        }
        if (IN(p0 + 2)) { MKCTX(); ph_wout_fast(al, c, l); if (REP_PHASE == 12) { __syncthreads(); ph_wout_fast(al, c, l); } SEAM(p0 + 2); }
        if (IN(p0 + 3)) { MKCTX(); if (REP_PHASE == 13) { ph_rows_c(al, c, l, false); __syncthreads(); } ph_rows_c(al, c, l, true); SEAM(p0 + 3); }
        if (IN(p0 + 4)) { MKCTX(); ph_gateup_fast(al, c, l); if (REP_PHASE == 14) { __syncthreads(); ph_gateup_fast(al, c, l); } SEAM(p0 + 4); }
        if (IN(p0 + 5)) { MKCTX(); ph_down_fast(al, c, l); if (REP_PHASE == 15) { __syncthreads(); ph_down_fast(al, c, l); } SEAM(p0 + 5); }
        if (IN(p0 + 6)) { MKCTX(); ph_rows_g(al, c, l); if (REP_PHASE == 16) ph_rows_g(al, c, l); SEAM(p0 + 6); }
    }
    {
        constexpr int l = 1; constexpr int p0 = 2 + l * PH_PER_LAYER;
        if (IN(p0 + 0)) { MKCTX(); ph_inproj_fast(al, c, l, false); if (REP_PHASE == 10) { __syncthreads(); ph_inproj_fast(al, c, l, true); } SEAM(p0 + 0); }
        if (IN(p0 + 1)) {
            { MKCTX(); ph_pool(al, c); }
            __syncthreads();
            const attn_body::AttnTensors AT{(const attn_body::bf16*)(a.ws + WS_QKVP), (const attn_body::bf16*)(a.ws + WS_QKVP) + 512, (const attn_body::bf16*)(a.ws + WS_QKVP) + 1024,
                                            (attn_body::bf16*)(a.ws + WS_AD), (const float*)(a.ws + WS_KBAR) + (size_t)l * NB * NH * NBLK * HD};
            const attn_body::StaticOrder S((int)gridDim.x, (int)blockIdx.x);
            attn_body::attn_phase<attn_body::StaticOrder>((char*)lds, AT, S, MKTID());
            if (REP_PHASE == 11) attn_body::attn_phase<attn_body::StaticOrder>((char*)lds, AT, S, MKTID());
            if (REP_PHASE == 17) { __syncthreads(); MKCTX(); ph_pool(al, c); }
            SEAM(p0 + 1);
        }
        if (IN(p0 + 2)) { MKCTX(); ph_wout_fast(al, c, l); if (REP_PHASE == 12) { __syncthreads(); ph_wout_fast(al, c, l); } SEAM(p0 + 2); }
        if (IN(p0 + 3)) { MKCTX(); if (REP_PHASE == 13) { ph_rows_c(al, c, l, false); __syncthreads(); } ph_rows_c(al, c, l, true); SEAM(p0 + 3); }
        if (IN(p0 + 4)) { MKCTX(); ph_gateup_fast(al, c, l); if (REP_PHASE == 14) { __syncthreads(); ph_gateup_fast(al, c, l); } SEAM(p0 + 4); }
        if (IN(p0 + 5)) { MKCTX(); ph_down_fast(al, c, l); if (REP_PHASE == 15) { __syncthreads(); ph_down_fast(al, c, l); } SEAM(p0 + 5); }
        if (IN(p0 + 6)) { MKCTX(); ph_rows_g(al, c, l); if (REP_PHASE == 16) ph_rows_g(al, c, l); SEAM(p0 + 6); }
    }
#undef IN
#undef SEAM
}

extern "C" void kernel_launch(void* const* d_in, const int* in_sizes, int n_in, void* d_out, int out_size, void* d_ws, size_t ws_size, hipStream_t stream) {
    static int grid = 0;
    if (grid == 0) {
        if (n_in != 17 || out_size != NTOK * DM || ws_size < WS_END) { fprintf(stderr, "kernel_launch: unexpected problem (n_in %d out %d ws %zu)\n", n_in, out_size, ws_size); grid = -1; return; }
        if (hipFuncSetAttribute((const void*)fwd, hipFuncAttributeMaxDynamicSharedMemorySize, LDS_BYTES) != hipSuccess) { fprintf(stderr, "kernel_launch: hipFuncSetAttribute failed\n"); grid = -1; return; }
        int dev = 0, cus = 0, per_cu = 0;
        (void)hipGetDevice(&dev); (void)hipDeviceGetAttribute(&cus, hipDeviceAttributeMultiprocessorCount, dev);
        if (hipOccupancyMaxActiveBlocksPerMultiprocessor(&per_cu, (const void*)fwd, 512, LDS_BYTES) != hipSuccess || per_cu < 1) fprintf(stderr, "kernel_launch: occupancy query reports %d workgroups per CU\n", per_cu);
        (void)hipGetLastError();
        grid = cus > 0 ? cus : 256;
    }
    if (grid < 0) return;
    (void)hipMemsetAsync((char*)d_ws + WS_CTL, 0, CTL_ZERO_BYTES, stream);
    Args a{};
    for (int i = 0; i < 17; ++i) a.in[i] = (const float*)d_in[i];
    a.out = (float*)d_out; a.ws = (unsigned char*)d_ws;
#if MK_N_LAUNCHES == 1
    a.ph_lo = 0; a.ph_hi = NPHASE; hipLaunchKernelGGL(fwd, dim3(grid), dim3(512), LDS_BYTES, stream, a);
#else
    for (int p = 0; p < NPHASE; ++p) { a.ph_lo = p; a.ph_hi = p + 1; hipLaunchKernelGGL(fwd, dim3(grid), dim3(512), LDS_BYTES, stream, a); }
#endif
}
```

```cpp
#include <hip/hip_runtime.h>
#include <cstdint>
#include <cstdio>

constexpr int NB = 16, SEQ = 2048, DM = 1024, NTOK = NB * SEQ, DIN = 2048, NH = 8, HD = 64, NBLK = 8, MBLK = 256;
constexpr int NE = 16, NCLS = 24, DE = 512, NMOD = 6 * DM;
constexpr float ALPHA = 1.41421356237309515f, LN_EPS = 1e-5f;
constexpr float QSCALE = 0.125f * 1.4426950408889634f;
constexpr int LISTCAP = NTOK;

constexpr size_t MiB = 1u << 20;
constexpr size_t WS_CTL = 0, CTL_ZERO_BYTES = 1 * MiB;
constexpr size_t WS_MOD = 1 * MiB;
constexpr size_t WS_ROPE = 2 * MiB;
constexpr size_t WS_KBAR = 2 * MiB + 256 * 1024;
constexpr size_t WS_LIST = 3 * MiB;
constexpr size_t WS_RW = 6 * MiB;
constexpr size_t WS_WIN = 12 * MiB;
constexpr size_t WS_WOUT = 20 * MiB;
constexpr size_t WS_WGU = 24 * MiB;
constexpr size_t WS_WD = 88 * MiB;
constexpr size_t WS_HB = 120 * MiB;
constexpr size_t WS_QKVP = 184 * MiB;
constexpr size_t WS_AD = 312 * MiB;
constexpr size_t WS_X1 = 376 * MiB;
constexpr size_t WS_END = 504 * MiB;
constexpr int CW_TMO = 0, CW_CNT = 64;

typedef unsigned short bf16_t;
typedef short bf16x8 __attribute__((ext_vector_type(8)));
typedef float f32x4 __attribute__((ext_vector_type(4)));
typedef float f32x16 __attribute__((ext_vector_type(16)));
typedef unsigned u32x4 __attribute__((ext_vector_type(4)));
typedef unsigned u32x2 __attribute__((ext_vector_type(2)));

#define DEVFN __device__ __forceinline__
#define LDS_WAIT() asm volatile("s_waitcnt lgkmcnt(0)" ::: "memory")
#define RLX_AGENT __ATOMIC_RELAXED, __HIP_MEMORY_SCOPE_AGENT

DEVFN float bf_lo(unsigned w) { return __uint_as_float(w << 16); }
DEVFN float bf_hi(unsigned w) { return __uint_as_float(w & 0xffff0000u); }
DEVFN float bf2f(bf16_t v) { return __uint_as_float((unsigned)v << 16); }
DEVFN unsigned f2bf(float f) { unsigned u = __float_as_uint(f); return (u + 0x7fffu + ((u >> 16) & 1u)) >> 16; }
DEVFN unsigned pk2(float lo, float hi) { return f2bf(lo) | (f2bf(hi) << 16); }
DEVFN unsigned pk4_fp8(float a, float b, float c, float d) {
    a = __builtin_amdgcn_fmed3f(a, -448.f, 448.f); b = __builtin_amdgcn_fmed3f(b, -448.f, 448.f); c = __builtin_amdgcn_fmed3f(c, -448.f, 448.f); d = __builtin_amdgcn_fmed3f(d, -448.f, 448.f);
    unsigned w = 0u; w = __builtin_amdgcn_cvt_pk_fp8_f32(a, b, w, false); w = __builtin_amdgcn_cvt_pk_fp8_f32(c, d, w, true); return w; }
DEVFN int crow(int r, int hi) { return (r & 3) + 8 * (r >> 2) + 4 * hi; }
#define SWZ_XOR(m) (0x1f | ((m) << 10))
DEVFN float swz_xor_add(float v, const int m) {
    switch (m) {
        case 1: return v + __int_as_float(__builtin_amdgcn_ds_swizzle(__float_as_int(v), SWZ_XOR(1)));
        case 2: return v + __int_as_float(__builtin_amdgcn_ds_swizzle(__float_as_int(v), SWZ_XOR(2)));
        case 4: return v + __int_as_float(__builtin_amdgcn_ds_swizzle(__float_as_int(v), SWZ_XOR(4)));
        case 8: return v + __int_as_float(__builtin_amdgcn_ds_swizzle(__float_as_int(v), SWZ_XOR(8)));
        default: return v + __int_as_float(__builtin_amdgcn_ds_swizzle(__float_as_int(v), SWZ_XOR(16)));
    }
}
DEVFN float half_swap_add(float v) { auto rr = __builtin_amdgcn_permlane32_swap(__float_as_uint(v), __float_as_uint(v), false, false); return __uint_as_float(rr[0]) + __uint_as_float(rr[1]); }
DEVFN float wave_sum(float v) {
    v = swz_xor_add(v, 1); v = swz_xor_add(v, 2); v = swz_xor_add(v, 4); v = swz_xor_add(v, 8); v = swz_xor_add(v, 16);
    return half_swap_add(v);
}
__host__ __device__ __forceinline__ int inproj_lgroup(int P) { return P < 16 ? (P >> 2) * 8 + (P & 3) * 2 : ((P - 16) >> 2) * 8 + ((P - 16) & 3) * 2 + 1; }
__host__ __device__ __forceinline__ int inproj_nlog(int n) { return (n & ~255) + inproj_lgroup((n & 255) >> 3) * 8 + (n & 7); }

#define GAS __attribute__((address_space(1)))
#define LAS __attribute__((address_space(3)))
typedef GAS unsigned gu32;
namespace pg8 {
#define PG8_LAS __attribute__((address_space(3)))
typedef unsigned short bf16_t;
typedef short bf16x8 __attribute__((ext_vector_type(8)));
typedef float f32x4 __attribute__((ext_vector_type(4)));
typedef unsigned u32x4 __attribute__((ext_vector_type(4)));
constexpr int BM = 256, BK = 64, HALF = 128, HTB = HALF * BK * 2  , STAGE_BYTES = 8 * HTB, NXCD = 8, WGM = 8;

__host__ __device__ __forceinline__ int lds_byte(int r, int c) { const int st = (r >> 4) * 2 + (c >> 5), rr = r & 15, cc = c & 31, ob = rr * 64 + cc * 2; return st * 1024 + (ob ^ (((ob >> 9) & 1) << 5)); }
__host__ __device__ __forceinline__ void stage_rc(int b, int& R, int& C) { const int st = b / 1024, sb = b % 1024, swz = sb ^ (((sb >> 9) & 1) << 5); R = (st >> 1) * 16 + swz / 64; C = (st & 1) * 32 + (swz % 64) / 2; }
__host__ __device__ __forceinline__ int perm32(int rho) { const int n = rho >> 4, i = rho & 15; return 8 * (i >> 2) + 4 * n + (i & 3); }

struct Unit { int pm, pn; };
struct Gemm { const bf16_t* A; const bf16_t* Bt; int M, N, K; };

struct StaticOrder {
    int nM, nN, nwg, G, c;
    __host__ __device__ void init(int M, int N, int G_, int c_) { nM = M / BM; nN = N / BM; nwg = nM * nN; G = G_; c = c_; }
    __host__ __device__ bool next(int i, Unit& u) const {
        const long L = (long)i * G + c; if (L >= nwg) return false;
        int wgid = (int)L; { const int q = nwg / NXCD, r = nwg % NXCD, xcd = wgid % NXCD, off = wgid / NXCD; wgid = (xcd < r ? xcd * (q + 1) : r * (q + 1) + (xcd - r) * q) + off; }
        const int nig = WGM * nN, gid = wgid / nig, fm = gid * WGM, gsz = (nM - fm) < WGM ? (nM - fm) : WGM;
        u.pm = fm + ((wgid % nig) % gsz); u.pn = (wgid % nig) / gsz; return true;
    }
    __device__ __forceinline__ void a_ready(const Unit&) const {}
    __device__ __forceinline__ void done(const Unit&) const {}
};

__device__ __forceinline__ unsigned cvt_pk_bf16(float lo, float hi) { unsigned r; asm volatile("v_cvt_pk_bf16_f32 %0, %1, %2" : "=v"(r) : "v"(lo), "v"(hi)); return r; }
typedef float f32x2 __attribute__((ext_vector_type(2)));
__device__ __forceinline__ f32x2 gelu_pk(f32x2 v) {
    const f32x2 av = __builtin_elementwise_abs(v), d = av * 0.2316418882f + 1.0f;
    f32x2 t; t.x = __builtin_amdgcn_rcpf(d.x); t.y = __builtin_amdgcn_rcpf(d.y);
    f32x2 q = t * 0.5307027145f + (-0.7265760135f); q = q * t + 0.7107068705f; q = q * t + (-0.142248368f); q = q * t + 0.127414796f; q = q * t;
    const f32x2 s = (v * v) * (-0.72134752044f);
    f32x2 e; e.x = __builtin_amdgcn_exp2f(s.x); e.y = __builtin_amdgcn_exp2f(s.y);
    const f32x2 m = v * (q * e), r = v - m;
    f32x2 o; o.x = v.x < 0.f ? m.x : r.x; o.y = v.y < 0.f ? m.y : r.y; return o;
}

template <int ACT  > struct EpiBf16 {
    static constexpr bool PERM = true, AFTER_DRAIN = false; static_assert(ACT == 0 || ACT == 1, "EpiBf16: ACT is 0 (none) or 1 (gelu_pk)");
    bf16_t* O; int ldc; const float* bias; int split_cols; size_t split_stride; float scale0;
    __device__ __forceinline__ void operator()(const f32x4 (&acc)[2][2][4][2], const Unit& u, int wr, int wc, int fr, int fq) const {
        const int row0 = u.pm * BM + wr * 64 + fr; int colt = u.pn * BM; bf16_t* base = O;
        float sc = 1.f; if (split_cols) { const int t = colt / split_cols; base += (size_t)t * split_stride; colt -= t * split_cols; if (t == 0) sc = scale0; }
        const int col0 = colt + wc * 32 + 8 * fq, bcol0 = u.pn * BM + wc * 32 + 8 * fq;
        f32x4 bv[2][2];
#pragma unroll
        for (int bj = 0; bj < 2; ++bj)
#pragma unroll
            for (int n = 0; n < 2; ++n) bv[bj][n] = bias ? *(const f32x4*)(bias + bcol0 + bj * HALF + 4 * n) : (f32x4){0.f, 0.f, 0.f, 0.f};
#pragma unroll
        for (int ai = 0; ai < 2; ++ai)
#pragma unroll
            for (int m = 0; m < 4; ++m) { bf16_t* rowp = base + (size_t)(row0 + ai * HALF + m * 16) * ldc + col0;
#pragma unroll
                for (int bj = 0; bj < 2; ++bj) { f32x4 v0 = acc[ai][bj][m][0] + bv[bj][0], v1 = acc[ai][bj][m][1] + bv[bj][1];
                    if (ACT == 1) { f32x2 a = gelu_pk((f32x2){v0[0], v0[1]}), b = gelu_pk((f32x2){v0[2], v0[3]}), c = gelu_pk((f32x2){v1[0], v1[1]}), d = gelu_pk((f32x2){v1[2], v1[3]});
                        v0 = (f32x4){a.x, a.y, b.x, b.y}; v1 = (f32x4){c.x, c.y, d.x, d.y}; }
                    v0 = v0 * sc; v1 = v1 * sc; u32x4 w; w.x = cvt_pk_bf16(v0[0], v0[1]); w.y = cvt_pk_bf16(v0[2], v0[3]); w.z = cvt_pk_bf16(v1[0], v1[1]); w.w = cvt_pk_bf16(v1[2], v1[3]);
                    *(u32x4*)(rowp + bj * HALF) = w; } }
    }
};

struct PanelStats {
    unsigned* xbuf;
    unsigned* cnt;
    unsigned* tmo;
    int ntn; float eps;
    unsigned code;
    __device__ __forceinline__ bool run(const f32x4 (&v)[2][2][4][2], const Unit& u, int wr, int wc, int fr, int fq, PG8_LAS unsigned char* lds, int wid, int lane) const {
        typedef float f32x2v __attribute__((ext_vector_type(2)));
        PG8_LAS f32x2v* P = (PG8_LAS f32x2v*)lds;
        PG8_LAS f32x2v* S = (PG8_LAS f32x2v*)(lds + 8192);
        PG8_LAS unsigned* flag = (PG8_LAS unsigned*)(lds + 8192 + 2048);
#pragma unroll
        for (int ai = 0; ai < 2; ++ai)
#pragma unroll
            for (int m = 0; m < 4; ++m) {
                float s = 0.f;
#pragma unroll
                for (int bj = 0; bj < 2; ++bj)
#pragma unroll
                    for (int n = 0; n < 2; ++n) { const f32x4 x = v[ai][bj][m][n]; s += (x[0] + x[1]) + (x[2] + x[3]); }
                s += __shfl_xor(s, 16); s += __shfl_xor(s, 32);
                const float mw = s * (1.0f / 64.0f); float q = 0.f;
#pragma unroll
                for (int bj = 0; bj < 2; ++bj)
#pragma unroll
                    for (int n = 0; n < 2; ++n) { const f32x4 d = v[ai][bj][m][n] - mw; q += (d[0] * d[0] + d[1] * d[1]) + (d[2] * d[2] + d[3] * d[3]); }
                q += __shfl_xor(q, 16); q += __shfl_xor(q, 32);
                if (fq == 0) P[(ai * HALF + wr * 64 + m * 16 + fr) * 4 + wc] = (f32x2v){mw, q};
            }
        asm volatile("s_waitcnt lgkmcnt(0)" ::: "memory"); __builtin_amdgcn_s_barrier(); asm volatile("" ::: "memory");
#if defined(BROKEN_EXCHANGE_NO_WAIT)
#warning BROKEN CONTROL BUILD: the row-statistics exchange does not wait; results are wrong by design
        if (blockIdx.x >= 64) { const long long t0_ = clock64(); while (clock64() - t0_ < 60000) __builtin_amdgcn_s_sleep(8); }
#endif
        const int row = wid * 32 + (lane & 31);
        if (lane < 32) {
            const f32x2v a = P[row * 4 + 0], b = P[row * 4 + 1], c = P[row * 4 + 2], d = P[row * 4 + 3];
            const float mt = (a.x + b.x + c.x + d.x) * 0.25f;
            const float da = a.x - mt, db = b.x - mt, dc = c.x - mt, dd = d.x - mt;
            const float m2 = (a.y + b.y) + (c.y + d.y) + 64.0f * ((da * da + db * db) + (dc * dc + dd * dd));
            unsigned long long* slot = (unsigned long long*)xbuf + ((size_t)(u.pm * BM + row) * 4 + u.pn);
            __hip_atomic_store(slot, ((unsigned long long)__float_as_uint(m2) << 32) | __float_as_uint(mt), __ATOMIC_RELAXED, __HIP_MEMORY_SCOPE_AGENT);
        }
        asm volatile("s_waitcnt vmcnt(0)" ::: "memory");
        if (lane == 0) __hip_atomic_fetch_add(cnt + 64 * u.pm, 1u, __ATOMIC_RELAXED, __HIP_MEMORY_SCOPE_AGENT);
        if (wid == 0) {
            bool dead = false; const unsigned long long t0 = __builtin_amdgcn_s_memrealtime(); const unsigned want = 8u * (unsigned)ntn;
            for (;;) {
#if defined(BROKEN_EXCHANGE_NO_WAIT)
                break;
#endif
                if ((unsigned)__builtin_amdgcn_readfirstlane(__hip_atomic_load(cnt + 64 * u.pm, __ATOMIC_RELAXED, __HIP_MEMORY_SCOPE_AGENT)) >= want) break;
                if (__builtin_amdgcn_s_memrealtime() - t0 > 2000000ull) {
                    if (lane == 0) { unsigned expect = 0u; __hip_atomic_compare_exchange_strong(tmo + 1, &expect, code | (unsigned)(u.pm & 0xff), __ATOMIC_RELAXED, __ATOMIC_RELAXED, __HIP_MEMORY_SCOPE_AGENT);
                                     __hip_atomic_store(tmo, 1u, __ATOMIC_RELAXED, __HIP_MEMORY_SCOPE_AGENT); }
                    dead = true; break; }
                __builtin_amdgcn_s_sleep(2);
            }
            __builtin_amdgcn_fence(__ATOMIC_ACQUIRE, "agent");
            if (lane == 0) flag[0] = dead ? 1u : 0u;
        }
        asm volatile("s_waitcnt vmcnt(0) lgkmcnt(0)" ::: "memory"); __builtin_amdgcn_s_barrier(); asm volatile("" ::: "memory");
        const bool bad = flag[0] != 0u;
        if (lane < 32) {
            const unsigned long long* slot = (const unsigned long long*)xbuf + (size_t)(u.pm * BM + row) * 4; float mt[4], m2[4]; float ms = 0.f;
#pragma unroll
            for (int t = 0; t < 4; ++t) { if (t < ntn) { const unsigned long long w = __hip_atomic_load(slot + t, __ATOMIC_RELAXED, __HIP_MEMORY_SCOPE_AGENT); mt[t] = __uint_as_float((unsigned)w); m2[t] = __uint_as_float((unsigned)(w >> 32)); } else { mt[t] = 0.f; m2[t] = 0.f; } ms += mt[t]; }
            const float mean = ms / (float)ntn; float q = 0.f;
#pragma unroll
            for (int t = 0; t < 4; ++t) if (t < ntn) { const float dm = mt[t] - mean; q += m2[t] + 256.0f * dm * dm; }
            S[row] = (f32x2v){mean, 1.0f / sqrtf(q / (256.0f * (float)ntn) + eps)};
        }
        asm volatile("s_waitcnt lgkmcnt(0)" ::: "memory"); __builtin_amdgcn_s_barrier(); asm volatile("" ::: "memory");
        return bad;
    }
};
struct EpiLnRes {
    static constexpr bool PERM = false, AFTER_DRAIN = true;
    const float* base; float* out; int ldc; const float* bias; PanelStats st; unsigned poison;
    __device__ __forceinline__ void fused(f32x4 (&acc)[2][2][4][2], const Unit& u, int wr, int wc, int fr, int fq, PG8_LAS unsigned char* lds, int wid, int lane) const {
        typedef float f32x2v __attribute__((ext_vector_type(2)));
        const PG8_LAS f32x2v* S = (const PG8_LAS f32x2v*)(lds + 8192);
        const int col0 = u.pn * BM + wc * 32 + 4 * fq;
#pragma unroll
        for (int bj = 0; bj < 2; ++bj)
#pragma unroll
            for (int n = 0; n < 2; ++n) { const f32x4 bv = bias ? *(const f32x4*)(bias + col0 + bj * HALF + n * 16) : (f32x4){0.f, 0.f, 0.f, 0.f};
#pragma unroll
                for (int ai = 0; ai < 2; ++ai)
#pragma unroll
                    for (int m = 0; m < 4; ++m) acc[ai][bj][m][n] += bv; }
        f32x4 pre[4][2][2];
#pragma unroll
        for (int m = 0; m < 4; ++m) { const size_t off = (size_t)(u.pm * BM + wr * 64 + m * 16 + fr) * ldc + col0;
#pragma unroll
            for (int bj = 0; bj < 2; ++bj)
#pragma unroll
                for (int n = 0; n < 2; ++n) pre[m][bj][n] = *(const f32x4*)(base + off + bj * HALF + n * 16); }
        const bool bad = st.run(acc, u, wr, wc, fr, fq, lds, wid, lane) || poison != 0u;
        const float qnan = __builtin_nanf("");
#pragma unroll
        for (int ai = 0; ai < 2; ++ai)
#pragma unroll
            for (int m = 0; m < 4; ++m) { const int r = ai * HALF + wr * 64 + m * 16 + fr; const f32x2v sr = S[r]; const size_t off = (size_t)(u.pm * BM + r) * ldc + col0;
#pragma unroll
                for (int bj = 0; bj < 2; ++bj)
#pragma unroll
                    for (int n = 0; n < 2; ++n) { const f32x4 bs = ai == 0 ? pre[m][bj][n] : *(const f32x4*)(base + off + bj * HALF + n * 16); f32x4 o = bs + (acc[ai][bj][m][n] - sr.x) * sr.y;
                        if (bad) o = (f32x4){qnan, qnan, qnan, qnan}; *(f32x4*)(out + off + bj * HALF + n * 16) = o; }
                if (m & 1) asm volatile("" ::: "memory"); }
    }
};
struct EpiLnResLn {
    static constexpr bool PERM = false, AFTER_DRAIN = true;
    const float* base; float* out; bf16_t* xn; int ldc; const float* bias; PanelStats st1, st2; unsigned poison;
    __device__ __forceinline__ void fused(f32x4 (&acc)[2][2][4][2], const Unit& u, int wr, int wc, int fr, int fq, PG8_LAS unsigned char* lds, int wid, int lane) const {
        typedef float f32x2v __attribute__((ext_vector_type(2))); typedef unsigned u32x2v __attribute__((ext_vector_type(2)));
        const PG8_LAS f32x2v* S = (const PG8_LAS f32x2v*)(lds + 8192);
        const int col0 = u.pn * BM + wc * 32 + 4 * fq;
#pragma unroll
        for (int bj = 0; bj < 2; ++bj)
#pragma unroll
            for (int n = 0; n < 2; ++n) { const f32x4 bv = bias ? *(const f32x4*)(bias + col0 + bj * HALF + n * 16) : (f32x4){0.f, 0.f, 0.f, 0.f};
#pragma unroll
                for (int ai = 0; ai < 2; ++ai)
#pragma unroll
                    for (int m = 0; m < 4; ++m) acc[ai][bj][m][n] += bv; }
        bool bad = st1.run(acc, u, wr, wc, fr, fq, lds, wid, lane) || poison != 0u;
        const float qnan = __builtin_nanf("");
#pragma unroll
        for (int ai = 0; ai < 2; ++ai)
#pragma unroll
            for (int m = 0; m < 4; ++m) { const int r = ai * HALF + wr * 64 + m * 16 + fr; const f32x2v sr = S[r]; const size_t off = (size_t)(u.pm * BM + r) * ldc + col0;
#pragma unroll
                for (int bj = 0; bj < 2; ++bj)
#pragma unroll
                    for (int n = 0; n < 2; ++n) { const f32x4 bs = *(const f32x4*)(base + off + bj * HALF + n * 16); acc[ai][bj][m][n] = bs + (acc[ai][bj][m][n] - sr.x) * sr.y; }
                asm volatile("" : "+v"(acc[ai][0][m][0]), "+v"(acc[ai][0][m][1]), "+v"(acc[ai][1][m][0]), "+v"(acc[ai][1][m][1]));
                if (m & 1) asm volatile("" ::: "memory"); }
        const bool bad1 = bad;
        bad = st2.run(acc, u, wr, wc, fr, fq, lds, wid, lane) || bad;
#pragma unroll
        for (int ai = 0; ai < 2; ++ai)
#pragma unroll
            for (int m = 0; m < 4; ++m) { const int r = ai * HALF + wr * 64 + m * 16 + fr; const f32x2v sr = S[r]; const size_t off = (size_t)(u.pm * BM + r) * ldc + col0;
#pragma unroll
                for (int bj = 0; bj < 2; ++bj)
#pragma unroll
                    for (int n = 0; n < 2; ++n) { const f32x4 x1 = acc[ai][bj][m][n]; *(f32x4*)(out + off + bj * HALF + n * 16) = bad1 ? (f32x4){qnan, qnan, qnan, qnan} : x1;
                        const f32x4 o = (x1 - sr.x) * sr.y; u32x2v w; w.x = cvt_pk_bf16(o[0], o[1]); w.y = cvt_pk_bf16(o[2], o[3]);
                        if (bad) { w.x = 0x7fc07fc0u; w.y = 0x7fc07fc0u; } *(u32x2v*)(xn + off + bj * HALF + n * 16) = w; }
                asm volatile("" ::: "memory"); }
    }
};

}
namespace pg8 {
typedef int v8i_t __attribute__((ext_vector_type(8))); typedef int v4i_t __attribute__((ext_vector_type(4)));
template <class Epi, class Sched, bool ALIGN_EPI, bool GATHER, bool KSPLIT, bool FP8 = false, int SCW = 127, int SCA = 127, bool SC2 = false, int SCW2 = 127, int SCA2 = 127>
__device__ __forceinline__ void gemm_phase2(PG8_LAS unsigned char* lds, const int Kbytes, const int ldb_bytes, const Sched& S, const Epi& E, const int tid) {
    typedef typename Sched::UnitT UnitT;
    const int wid = __builtin_amdgcn_readfirstlane(tid >> 6), lane = tid & 63, wr = wid >> 2, wc = wid & 3, fr = lane & 15, fq = lane >> 4;
    int nt = Kbytes / (BK * 2); asm volatile("" : "+s"(nt));
    const int nth = nt / 2;
    unsigned voffB[2];
#pragma unroll
    for (int i = 0; i < 2; ++i) { int R[2], C[2]; stage_rc(tid * 16 + i * 8192, R[i], C[i]); const int Rb = Epi::PERM ? ((R[i] & ~31) + perm32(R[i] & 31)) : R[i]; voffB[i] = (unsigned)(Rb * ldb_bytes + C[i] * 2); }
    const size_t kstep = (size_t)(BK * 2);
    const size_t hstepB = (size_t)HALF * ldb_bytes;
    const unsigned ldsw = (unsigned)wid * 1024u;
    const int aoff = lds_byte(wr * 64 + fr, fq * 8), boff = lds_byte(wc * 32 + fr, fq * 8);
#define PG8_SA(b, h) (((b) * 2 + (h)) * HTB)
#define PG8_SB(b, h) ((4 + (b) * 2 + (h)) * HTB)
#define PG8_STAGE(bufoff, gbase, voff) do { _Pragma("unroll") for (int _i = 0; _i < 2; ++_i) \
        __builtin_amdgcn_global_load_lds((const unsigned*)((const char*)(gbase) + (voff)[_i]), (PG8_LAS unsigned*)(lds + (bufoff) + ldsw + _i * 8192), 16, 0, 0); } while (0)
#define PG8_LDA(dst, b, h) do { _Pragma("unroll") for (int m = 0; m < 4; ++m) _Pragma("unroll") for (int k = 0; k < 2; ++k) dst[m][k] = *(const PG8_LAS bf16x8*)(lds + PG8_SA(b, h) + aoff + m * 2048 + k * 1024); } while (0)
#define PG8_LDB(dst, b, h) do { _Pragma("unroll") for (int n = 0; n < 2; ++n) _Pragma("unroll") for (int k = 0; k < 2; ++k) dst[n][k] = *(const PG8_LAS bf16x8*)(lds + PG8_SB(b, h) + boff + n * 2048 + k * 1024); } while (0)
#define PG8_CAT8(x) __builtin_shufflevector(__builtin_bit_cast(v4i_t, (x)[0]), __builtin_bit_cast(v4i_t, (x)[1]), 0, 1, 2, 3, 4, 5, 6, 7)
#define PG8_MMA(ai, bj, At, Bt) do { __builtin_amdgcn_s_setprio(1); \
        if constexpr (FP8) { _Pragma("unroll") for (int m = 0; m < 4; ++m) _Pragma("unroll") for (int n = 0; n < 2; ++n) \
            acc[ai][bj][m][n] = __builtin_amdgcn_mfma_scale_f32_16x16x128_f8f6f4(PG8_CAT8(Bt[n]), PG8_CAT8(At[m]), acc[ai][bj][m][n], 0, 0, 0, scw_, 0, sca_); } \
        else { _Pragma("unroll") for (int m = 0; m < 4; ++m) _Pragma("unroll") for (int n = 0; n < 2; ++n) _Pragma("unroll") for (int k = 0; k < 2; ++k) \
            acc[ai][bj][m][n] = __builtin_amdgcn_mfma_f32_16x16x32_bf16(Bt[n][k], At[m][k], acc[ai][bj][m][n], 0, 0, 0); } \
        __builtin_amdgcn_s_setprio(0); } while (0)
#define PG8_WAIT_V(n) asm volatile("s_waitcnt vmcnt(" #n ")" ::: "memory")
#define PG8_WAIT_L(n) asm volatile("s_waitcnt lgkmcnt(" #n ")" ::: "memory")
#define PG8_BAR __builtin_amdgcn_s_barrier()
#define PG8_SCHED __builtin_amdgcn_sched_barrier(0)
#define PG8_BK(cb, cb2, kt) ((KSPLIT && (kt) >= nth) ? (cb2) + (size_t)((kt) - nth) * kstep : (cb) + (size_t)(kt) * kstep)
    UnitT cur, nxt; int ui = 0;
    if (!S.next(0, cur)) return;
    f32x4 acc[2][2][4][2];
#pragma unroll
    for (int a = 0; a < 2; ++a)
#pragma unroll
        for (int b = 0; b < 2; ++b)
#pragma unroll
            for (int m = 0; m < 4; ++m)
#pragma unroll
                for (int n = 0; n < 2; ++n) acc[a][b][m][n] = (f32x4){0.f, 0.f, 0.f, 0.f};
    bf16x8 At[4][2], B0[2][2], B1[2][2];
    unsigned vA[2][2], vAn[2][2];
    S.arows(cur, tid, vA);
#pragma unroll
    for (int h = 0; h < 2; ++h)
#pragma unroll
        for (int i = 0; i < 2; ++i) vAn[h][i] = vA[h][i];
    const char* cA = S.aptr(cur); const char* cB = S.bptr(cur); const char* cB2 = KSPLIT ? S.bptr2(cur) : cB;
    PG8_STAGE(PG8_SB(0, 0), cB, voffB); PG8_STAGE(PG8_SB(0, 1), cB + hstepB, voffB); PG8_STAGE(PG8_SA(0, 0), cA, vA[0]); PG8_STAGE(PG8_SA(0, 1), cA, vA[1]);
    if (wr == 1) PG8_BAR;
    PG8_WAIT_V(2); PG8_BAR;
    PG8_STAGE(PG8_SB(1, 0), PG8_BK(cB, cB2, 1), voffB); PG8_STAGE(PG8_SA(1, 0), cA + kstep, vA[0]); PG8_STAGE(PG8_SB(1, 1), PG8_BK(cB, cB2, 1) + hstepB, voffB);
    PG8_WAIT_V(6); PG8_BAR;
    for (;;) {
        const bool has_next = S.next(ui + 1, nxt);
        const char* nA = has_next ? S.aptr(nxt) : cA; const char* nB = has_next ? S.bptr(nxt) : cB; const char* nB2 = (KSPLIT && has_next) ? S.bptr2(nxt) : cB2;
        if (GATHER && has_next) S.arows(nxt, tid, vAn);
        for (int t = 0; t < nt; t += 2) {
            const bool last = (t == nt - 2);
            const int scw_ = ((SC2 && t >= nth) ? SCW2 : SCW) * 0x01010101, sca_ = ((SC2 && t >= nth) ? SCA2 : SCA) * 0x01010101; (void)scw_; (void)sca_;
            const char* a1 = cA + (size_t)(t + 1) * kstep;
            const char* a2 = last ? nA : cA + (size_t)(t + 2) * kstep;
            const char* b2 = last ? nB : PG8_BK(cB, cB2, t + 2);
            const char* b3 = last ? (KSPLIT ? PG8_BK(nB, nB2, 1) : nB + kstep) : PG8_BK(cB, cB2, t + 3);
            const char* a3 = a2 + kstep;
            PG8_LDB(B0, 0, 0); PG8_LDB(B1, 0, 1); PG8_SCHED; PG8_LDA(At, 0, 0); PG8_STAGE(PG8_SA(1, 1), a1, vA[1]);
            PG8_WAIT_V(8); PG8_WAIT_L(0); PG8_BAR; PG8_MMA(0, 0, At, B0); PG8_MMA(0, 1, At, B1); PG8_BAR; PG8_SCHED;
            if (GATHER && last) {
#pragma unroll
                for (int h = 0; h < 2; ++h)
#pragma unroll
                    for (int i = 0; i < 2; ++i) vA[h][i] = vAn[h][i]; }
            PG8_LDA(At, 0, 1); PG8_STAGE(PG8_SB(0, 0), b2, voffB); PG8_STAGE(PG8_SB(0, 1), b2 + hstepB, voffB); PG8_STAGE(PG8_SA(0, 0), a2, vA[0]);
            PG8_WAIT_V(8); PG8_WAIT_L(0); PG8_BAR; PG8_MMA(1, 0, At, B0); PG8_MMA(1, 1, At, B1); PG8_BAR; PG8_SCHED;
            PG8_LDB(B0, 1, 0); PG8_LDB(B1, 1, 1); PG8_SCHED; PG8_LDA(At, 1, 0); PG8_STAGE(PG8_SA(0, 1), a2, vA[1]);
            PG8_WAIT_V(8); PG8_WAIT_L(0); PG8_BAR; PG8_MMA(0, 0, At, B0); PG8_MMA(0, 1, At, B1); PG8_BAR; PG8_SCHED;
            PG8_LDA(At, 1, 1); PG8_STAGE(PG8_SB(1, 0), b3, voffB); PG8_STAGE(PG8_SB(1, 1), b3 + hstepB, voffB); PG8_STAGE(PG8_SA(1, 0), a3, vA[0]);
            PG8_WAIT_V(8); PG8_WAIT_L(0); PG8_BAR; PG8_MMA(1, 0, At, B0); PG8_MMA(1, 1, At, B1); PG8_BAR; PG8_SCHED;
        }
        if constexpr (ALIGN_EPI) { if (wr == 0) PG8_BAR; }
        if constexpr (!Epi::AFTER_DRAIN) { E(acc, cur, wr, wc, fr, fq); }
        if (!has_next) break;
#pragma unroll
        for (int a = 0; a < 2; ++a)
#pragma unroll
            for (int b = 0; b < 2; ++b)
#pragma unroll
                for (int m = 0; m < 4; ++m)
#pragma unroll
                    for (int n = 0; n < 2; ++n) acc[a][b][m][n] = (f32x4){0.f, 0.f, 0.f, 0.f};
        cur = nxt; cA = nA; cB = nB; cB2 = nB2; ++ui;
        if constexpr (ALIGN_EPI) { if (wr == 1) PG8_BAR; }
    }
    PG8_WAIT_V(0);
    if constexpr (!ALIGN_EPI) { if (wr == 0) PG8_BAR; }
    PG8_BAR;
    if constexpr (Epi::AFTER_DRAIN) { E.fused(acc, cur, wr, wc, fr, fq, lds, wid, lane); }
#undef PG8_SA
#undef PG8_SB
#undef PG8_STAGE
#undef PG8_LDA
#undef PG8_LDB
#undef PG8_MMA
#undef PG8_WAIT_V
#undef PG8_WAIT_L
#undef PG8_BAR
#undef PG8_SCHED
#undef PG8_BK
#undef PG8_CAT8
}
}
namespace pg8 {
DEVFN unsigned pkbf(float lo, float hi) { return cvt_pk_bf16(lo, hi); }
struct DenseSched {
    typedef Unit UnitT;
    StaticOrder so; const char* A; const char* Bt; int lda, ldb;
    DEVFN bool next(int i, Unit& u) const { return so.next(i, u); }
    DEVFN const char* aptr(const Unit&) const { return A; }
    DEVFN void arows(const Unit& u, const int tid_, unsigned (&v)[2][2]) const {
        int R[2], C[2]; { int t_ = tid_; asm volatile("" : "+v"(t_)); stage_rc(t_ * 16, R[0], C[0]); stage_rc(t_ * 16 + 8192, R[1], C[1]); }
#pragma unroll
        for (int h = 0; h < 2; ++h)
#pragma unroll
            for (int i = 0; i < 2; ++i) v[h][i] = (unsigned)((u.pm * BM + h * HALF + R[i]) * lda + C[i] * 2); }
    DEVFN const char* bptr(const Unit& u) const { return Bt + (size_t)u.pn * BM * ldb; }
    DEVFN const char* bptr2(const Unit& u) const { return bptr(u); }
};
struct EpiInproj {
    static constexpr bool PERM = true, AFTER_DRAIN = false;
    bf16_t* O; const float* rope; float* kbar;
    DEVFN void operator()(f32x4 (&acc)[2][2][4][2], const Unit& u, int wr, int wc, int fr, int fq) const {
        const int pn = u.pn, row0 = u.pm * BM + wr * 64 + fr;
        if (pn < 4 && fq == 0) {
#pragma unroll
            for (int ai = 0; ai < 2; ++ai)
#pragma unroll
                for (int m = 0; m < 4; ++m) { const int t = (row0 + ai * HALF + m * 16) & (SEQ - 1); const f32x4* rp = (const f32x4*)(rope + t * 16);
#pragma unroll
                    for (int q = 0; q < 4; ++q) { const f32x4 cs = rp[q];
                        { const int d = 2 * q, n = d >> 2, e = d & 3; const float x1 = acc[ai][0][m][n][e], x2 = acc[ai][1][m][n][e]; acc[ai][0][m][n][e] = x1 * cs[0] - x2 * cs[1]; acc[ai][1][m][n][e] = x2 * cs[0] + x1 * cs[1]; }
                        { const int d = 2 * q + 1, n = d >> 2, e = d & 3; const float x1 = acc[ai][0][m][n][e], x2 = acc[ai][1][m][n][e]; acc[ai][0][m][n][e] = x1 * cs[2] - x2 * cs[3]; acc[ai][1][m][n][e] = x2 * cs[2] + x1 * cs[3]; } } }
        }
        if (pn == 2 || pn == 3) {
            float* kb = kbar + (size_t)((((u.pm >> 3) * NH + (pn - 2) * 4 + wc) * NBLK + (u.pm & 7)) * HD);
#pragma unroll
            for (int bj = 0; bj < 2; ++bj)
#pragma unroll
                for (int n = 0; n < 2; ++n)
#pragma unroll
                    for (int e = 0; e < 4; ++e) { float s = 0.f;
#pragma unroll
                        for (int ai = 0; ai < 2; ++ai)
#pragma unroll
                            for (int m = 0; m < 4; ++m) s += acc[ai][bj][m][n][e];
                        s = swz_xor_add(s, 1); s = swz_xor_add(s, 2); s = swz_xor_add(s, 4); s = swz_xor_add(s, 8);
                        if (fr == 0) atomicAdd(kb + (2 * fq + bj) * 8 + 4 * n + e, s * (1.f / MBLK)); }
        }
        const float sc = pn < 2 ? QSCALE : 1.f;
#pragma unroll
        for (int ai = 0; ai < 2; ++ai)
#pragma unroll
            for (int m = 0; m < 4; ++m) { bf16_t* rowp = O + (size_t)(row0 + ai * HALF + m * 16) * DIN + pn * BM + wc * 64;
#pragma unroll
                for (int bj = 0; bj < 2; ++bj) { const f32x4 v0 = acc[ai][bj][m][0] * sc, v1 = acc[ai][bj][m][1] * sc;
                    u32x4 w; w.x = pkbf(v0[0], v0[1]); w.y = pkbf(v0[2], v0[3]); w.z = pkbf(v1[0], v1[1]); w.w = pkbf(v1[2], v1[3]);
                    *(u32x4*)(rowp + (2 * fq + bj) * 8) = w; } }
    }
};
struct MoeUnit { int pm, pn, cls, j, cnt; };
struct MoeBase {
    const PG8_LAS int* tp; const PG8_LAS int* cnt; int nunits, G, c, npn_shift;
    DEVFN bool next_(int i, MoeUnit& u) const {
        const int L = i * G + c; if (L >= nunits) return false;
        u.pm = L >> npn_shift; u.pn = L & ((1 << npn_shift) - 1);
        int cls = 0; while (u.pm >= tp[cls + 1]) ++cls;
        u.cls = cls; u.j = u.pm - tp[cls]; u.cnt = cnt[cls]; return true; }
};
DEVFN void moe_experts(int cls, int& e1, int& e2) { const int g = cls / 6, p = cls % 6; const int lo = p < 3 ? 0 : (p < 5 ? 1 : 2), hi = p < 3 ? p + 1 : (p < 5 ? p - 1 : 3); e1 = g * 4 + lo; e2 = g * 4 + hi; }
struct GateUpSched : MoeBase {
    typedef MoeUnit UnitT;
    const char* HB; const int* list; const char* W;
    DEVFN bool next(int i, MoeUnit& u) const { return next_(i, u); }
    DEVFN const char* aptr(const MoeUnit&) const { return HB; }
    DEVFN void arows(const MoeUnit& u, const int tid_, unsigned (&v)[2][2]) const {
        int R[2], C[2]; { int t_ = tid_; asm volatile("" : "+v"(t_)); stage_rc(t_ * 16, R[0], C[0]); stage_rc(t_ * 16 + 8192, R[1], C[1]); }
#pragma unroll
        for (int h = 0; h < 2; ++h)
#pragma unroll
            for (int i = 0; i < 2; ++i) { const int li = 256 * u.j + h * HALF + R[i]; const int tok = list[(size_t)u.cls * LISTCAP + (li < u.cnt ? li : 256 * u.j)]; v[h][i] = (unsigned)(tok * DM + C[i] * 2); } }
    DEVFN const char* bptr(const MoeUnit& u) const { int e1, e2; moe_experts(u.cls, e1, e2); return W + (size_t)(u.pn < 4 ? e1 : e2) * DM * DM + (size_t)(u.pn & 3) * BM * DM; }
    DEVFN const char* bptr2(const MoeUnit& u) const { return bptr(u); }
};
struct DownSched : MoeBase {
    typedef MoeUnit UnitT;
    const char* ACT; const char* W;
    DEVFN bool next(int i, MoeUnit& u) const { return next_(i, u); }
    DEVFN const char* aptr(const MoeUnit&) const { return ACT; }
    DEVFN void arows(const MoeUnit& u, const int tid_, unsigned (&v)[2][2]) const {
        int R[2], C[2]; { int t_ = tid_; asm volatile("" : "+v"(t_)); stage_rc(t_ * 16, R[0], C[0]); stage_rc(t_ * 16 + 8192, R[1], C[1]); }
#pragma unroll
        for (int h = 0; h < 2; ++h)
#pragma unroll
            for (int i = 0; i < 2; ++i) v[h][i] = (unsigned)((u.pm * BM + h * HALF + R[i]) * DM + C[i] * 2); }
    DEVFN const char* bptr(const MoeUnit& u) const { int e1, e2; moe_experts(u.cls, e1, e2); return W + (size_t)e1 * DM * DE + (size_t)u.pn * BM * DE; }
    DEVFN const char* bptr2(const MoeUnit& u) const { int e1, e2; moe_experts(u.cls, e1, e2); return W + (size_t)e2 * DM * DE + (size_t)u.pn * BM * DE; }
};
struct EpiGateUp {
    static constexpr bool PERM = true, AFTER_DRAIN = false;
    unsigned char* ACT; const float* rw;
    DEVFN void operator()(f32x4 (&acc)[2][2][4][2], const MoeUnit& u, int wr, int wc, int fr, int fq) const {
        const int half = u.pn >> 2, jt = u.pn & 3;
#pragma unroll
        for (int ai = 0; ai < 2; ++ai)
#pragma unroll
            for (int m = 0; m < 4; ++m) { const int lr = ai * HALF + wr * 64 + m * 16 + fr, li = 256 * u.j + lr;
                const float wgt = li < u.cnt ? 8.f * rw[((size_t)u.cls * LISTCAP + li) * 2 + half] : 0.f;
                f32x4 o[2];
#pragma unroll
                for (int n = 0; n < 2; ++n)
#pragma unroll
                    for (int e = 0; e < 4; ++e) { const float g = acc[ai][0][m][n][e]; o[n][e] = g * __builtin_amdgcn_rcpf(1.f + __expf(-g)) * acc[ai][1][m][n][e] * wgt; }
                u32x2 w; w.x = pk4_fp8(o[0][0], o[0][1], o[0][2], o[0][3]); w.y = pk4_fp8(o[1][0], o[1][1], o[1][2], o[1][3]);
                *(u32x2*)(ACT + (size_t)(u.pm * BM + lr) * DM + half * 512 + jt * 128 + wc * 32 + fq * 8) = w; }
    }
};
struct EpiDown {
    static constexpr bool PERM = true, AFTER_DRAIN = false;
    bf16_t* Y2; const int* list;
    DEVFN void operator()(f32x4 (&acc)[2][2][4][2], const MoeUnit& u, int wr, int wc, int fr, int fq) const {
#pragma unroll
        for (int ai = 0; ai < 2; ++ai)
#pragma unroll
            for (int m = 0; m < 4; ++m) { const int li = 256 * u.j + ai * HALF + wr * 64 + m * 16 + fr;
                if (li < u.cnt) { const int tok = list[(size_t)u.cls * LISTCAP + li]; bf16_t* rowp = Y2 + (size_t)tok * DM + u.pn * BM + wc * 32 + fq * 8;
#pragma unroll
                    for (int bj = 0; bj < 2; ++bj) { const f32x4 v0 = acc[ai][bj][m][0], v1 = acc[ai][bj][m][1];
                        u32x4 w; w.x = pkbf(v0[0], v0[1]); w.y = pkbf(v0[2], v0[3]); w.z = pkbf(v1[0], v1[1]); w.w = pkbf(v1[2], v1[3]);
                        *(u32x4*)(rowp + bj * HALF) = w; } } }
    }
};
}

#include <hip/hip_bf16.h>
#include <cmath>
namespace attn_body {
using bf16=__hip_bfloat16;
using bf16x8=__attribute__((ext_vector_type(8)))short;
using s16x4=__attribute__((ext_vector_type(4)))short;
using f32x16=__attribute__((ext_vector_type(16)))float;
using u32x4=__attribute__((ext_vector_type(4)))unsigned;
constexpr int BATCH=16,NHEAD=8,SEQ=2048,D=64,QP=2048,OP=1024;
constexpr int NW=8,QBLK=32,QB=QBLK*NW,KVBLK=64,NQB=SEQ/QB;
constexpr int ATTN_PITCH=QP, ATTN_UNIT_ROWS=QB;
__device__ __forceinline__ int crow(int r,int hi){return (r&3)+8*(r>>2)+4*hi;}
#define SBAR() __builtin_amdgcn_sched_barrier(0)
__device__ __forceinline__ void cmask(f32x16&p0,f32x16&p1,int jb,int qrel,int hi){
  const float NEG=-INFINITY; int kb=64*jb+4*hi;
  #pragma unroll
  for(int r=0;r<16;++r){int kv=kb+(r&3)+8*(r>>2); if(kv>qrel)p0[r]=NEG; if(kv+32>qrel)p1[r]=NEG;}
}

constexpr int NSLOT=3, SLOTB=8192;
constexpr int LDS_K=0, LDS_V=NSLOT*SLOTB, LDS_WS=2*NSLOT*SLOTB, LDS_OST=LDS_WS+NW*64*4, LDS_KBAR=LDS_OST+NW*4096, LDS_BYTES=LDS_KBAR+2048;
constexpr float NEGBIG=-1.0e30f; typedef float f32x4_t __attribute__((ext_vector_type(4)));
__device__ __forceinline__ float bfs(short v){return __uint_as_float(((unsigned)(unsigned short)v)<<16);}
constexpr float C2=0.125f*1.4426950408889634f;
__device__ __forceinline__ void glds16(const void*gsrc,unsigned lds_dst){unsigned keep;
  asm volatile("s_mov_b32 %0, m0\n\ts_mov_b32 m0, %2\n\ts_nop 0\n\tglobal_load_lds_dwordx4 %1, off\n\ts_mov_b32 m0, %0":"=&s"(keep):"v"(gsrc),"s"(lds_dst):"memory");}
__device__ __forceinline__ float max3f(float a,float b,float c){float r;asm("v_max3_f32 %0, %1, %2, %3":"=v"(r):"v"(a),"v"(b),"v"(c));return r;}
__device__ __forceinline__ float max2f(float a,float b){float r;asm("v_max_f32_e32 %0, %1, %2":"=v"(r):"v"(a),"v"(b));return r;}
__device__ __forceinline__ float fadd_s(float a,float b){float r;asm("v_add_f32_e32 %0, %1, %2":"=v"(r):"v"(a),"v"(b));return r;}
__device__ __forceinline__ float fsub_s(float a,float b){float r;asm("v_sub_f32_e32 %0, %1, %2":"=v"(r):"v"(a),"v"(b));return r;}
typedef float f32x2_t __attribute__((ext_vector_type(2))); typedef __bf16 bf16x2_t __attribute__((ext_vector_type(2)));
__device__ __forceinline__ unsigned cvtpk_s(float lo,float hi){f32x2_t v={lo,hi};bf16x2_t b=__builtin_convertvector(v,bf16x2_t);return __builtin_bit_cast(unsigned,b);}
#define WAIT_BAR(N) asm volatile("s_waitcnt vmcnt(" #N ") lgkmcnt(0)\n\ts_barrier":::"memory")

__device__ __forceinline__ void qkt(f32x16&p0,f32x16&p1,const char*Kslot,const bf16x8*qr,const f32x16&negm,int r32,int hi){
  const char*kb=Kslot+hi*1024+r32*16;
  #pragma unroll
  for(int d0=0;d0<4;++d0){
    const bf16x8 b0=*reinterpret_cast<const bf16x8*>(kb+d0*2048);
    const bf16x8 b1=*reinterpret_cast<const bf16x8*>(kb+d0*2048+512);
    if(d0==0){p0=__builtin_amdgcn_mfma_f32_32x32x16_bf16(b0,qr[0],negm,0,0,0);p1=__builtin_amdgcn_mfma_f32_32x32x16_bf16(b1,qr[0],negm,0,0,0);}
    else{p0=__builtin_amdgcn_mfma_f32_32x32x16_bf16(b0,qr[d0],p0,0,0,0);p1=__builtin_amdgcn_mfma_f32_32x32x16_bf16(b1,qr[d0],p1,0,0,0);}}
}
typedef __attribute__((address_space(3))) const char* lds_cptr;
typedef short v4i16_t __attribute__((ext_vector_type(4)));
__device__ __forceinline__ void kload8(bf16x8*kf,lds_cptr kp){
  kf[0]=*(const __attribute__((address_space(3))) bf16x8*)(kp);      kf[1]=*(const __attribute__((address_space(3))) bf16x8*)(kp+512);
  kf[2]=*(const __attribute__((address_space(3))) bf16x8*)(kp+2048); kf[3]=*(const __attribute__((address_space(3))) bf16x8*)(kp+2560);
  kf[4]=*(const __attribute__((address_space(3))) bf16x8*)(kp+4096); kf[5]=*(const __attribute__((address_space(3))) bf16x8*)(kp+4608);
  kf[6]=*(const __attribute__((address_space(3))) bf16x8*)(kp+6144); kf[7]=*(const __attribute__((address_space(3))) bf16x8*)(kp+6656);
}
__device__ __forceinline__ void kload2(bf16x8*kf,lds_cptr kp,int j){ kf[2*j]=*(const __attribute__((address_space(3))) bf16x8*)(kp+j*2048); kf[2*j+1]=*(const __attribute__((address_space(3))) bf16x8*)(kp+j*2048+512); }
__device__ __forceinline__ s16x4 vtr(lds_cptr p){ return __builtin_bit_cast(s16x4,__builtin_amdgcn_ds_read_tr16_b64_v4i16((__attribute__((address_space(3))) v4i16_t*)p)); }
__device__ __forceinline__ float rowmax(const f32x16&p0,const f32x16&p1){
  float a=max3f(p0[0],p0[1],p1[0]),b=max3f(p0[2],p0[3],p1[1]);a=max3f(a,p1[2],p1[3]);
  #pragma unroll
  for(int r=4;r<16;r+=4){a=max3f(a,p0[r],p0[r+1]);b=max3f(b,p0[r+2],p0[r+3]);a=max3f(a,p1[r],p1[r+1]);b=max3f(b,p1[r+2],p1[r+3]);}
  const float m=max2f(a,b);
  auto rr=__builtin_amdgcn_permlane32_swap(__float_as_uint(m),__float_as_uint(m),false,false);
  return max2f(__uint_as_float(rr[0]),__uint_as_float(rr[1]));
}
__device__ __forceinline__ void pv(f32x16*o,int vb,bf16x8 pa0,bf16x8 pa1,bf16x8 pa2,bf16x8 pa3){
  #pragma unroll
  for(int d0=0;d0<2;++d0){s16x4 lo[4],hi[4];
    #pragma unroll
    for(int ks=0;ks<4;++ks){
      asm volatile("ds_read_b64_tr_b16 %0,%1 offset:%c2":"=&v"(lo[ks]):"v"(vb),"i"(d0*4096+ks*1024):"memory");
      asm volatile("ds_read_b64_tr_b16 %0,%1 offset:%c2":"=&v"(hi[ks]):"v"(vb),"i"(d0*4096+ks*1024+512):"memory");}
    asm volatile("s_waitcnt lgkmcnt(0)":::"memory");SBAR();
    #define PK(k) (bf16x8){lo[k][0],lo[k][1],lo[k][2],lo[k][3],hi[k][0],hi[k][1],hi[k][2],hi[k][3]}
    o[d0]=__builtin_amdgcn_mfma_f32_32x32x16_bf16(pa0,PK(0),o[d0],0,0,0);
    o[d0]=__builtin_amdgcn_mfma_f32_32x32x16_bf16(pa1,PK(1),o[d0],0,0,0);
    o[d0]=__builtin_amdgcn_mfma_f32_32x32x16_bf16(pa2,PK(2),o[d0],0,0,0);
    o[d0]=__builtin_amdgcn_mfma_f32_32x32x16_bf16(pa3,PK(3),o[d0],0,0,0);
    #undef PK
  }
}

#ifndef ATTN_STORE16
#define ATTN_STORE16(p,v) (*(u32x4*)(p)=(v))
#endif
template<int THRL> __device__ __forceinline__ void attn_unit(int b,int h,int qb,const bf16*Q,const bf16*__restrict__ K,const bf16*__restrict__ V,bf16*O,const float*__restrict__ kbar,char*shm,const int tid){
  const int lane=tid&63,r32=lane&31,hi=lane>>5; const int wid=__builtin_amdgcn_readfirstlane(tid>>6);
  float kbv=0.f; { int tk=tid; asm volatile("":"+v"(tk)); if(qb>=4&&tk<448)kbv=kbar[tk]; }
  const long rowbase=(long)b*SEQ; const int q0=qb*QB;
  const bf16*Qw=Q+(rowbase+q0+wid*QBLK)*QP+h*D;
  const bf16*Kh=K+rowbase*QP+h*D,*Vh=V+rowbase*QP+h*D;
  const unsigned lds0=(unsigned)(uintptr_t)shm;
  float*wsf=(float*)(shm+LDS_WS)+wid*64;
  const bf16*ksrc=Kh+(long)lane*QP+wid*8;
  const bf16*vsrc=Vh+(long)(16*(wid&3)+(lane>>2))*QP+(wid>>2)*32+(lane&3)*8;
  const unsigned kdst=lds0+LDS_K+wid*1024, vdst=lds0+LDS_V+wid*1024;
  #define DMA_K(t,slot) glds16(ksrc+(long)(t)*KVBLK*QP,(unsigned)__builtin_amdgcn_readfirstlane(kdst+(slot)))
  #define DMA_V(t,slot) glds16(vsrc+(long)(t)*KVBLK*QP,(unsigned)__builtin_amdgcn_readfirstlane(vdst+(slot)))
  const int vb0=(int)(lds0+LDS_V)+((lane>>4)&1)*32+(lane&3)*8+(4*hi+((lane&15)>>2))*64;
  const char*Kbase=shm+LDS_K; bf16x8 kf[8];
  const lds_cptr shm3=(lds_cptr)shm; const lds_cptr kp0=shm3+LDS_K+hi*1024+r32*16; const lds_cptr vp0=shm3+LDS_V+((lane>>4)&1)*32+(lane&3)*8+(4*hi+((lane&15)>>2))*64;
  const int NT=(q0+QB)/KVBLK;
  DMA_K(0,0);DMA_V(0,0);DMA_K(1,SLOTB);
  bf16x8 qr[4];
  #pragma unroll
  for(int d0=0;d0<4;++d0)qr[d0]=*reinterpret_cast<const bf16x8*>(&Qw[(long)r32*QP+d0*16+hi*8]);
  float mhat=0.f,l_reg=0.f;f32x16 o[2];o[0]=f32x16{};o[1]=f32x16{};f32x16 negm=f32x16{};asm volatile("":"+v"(negm));
  const int qrel=wid*QBLK+r32;
  #define CMASK(P0,P1,t) do{int jb_=(t)-(NT-4); if(jb_>=0)cmask(P0,P1,jb_,qrel,hi);}while(0)
  bool resc=false;
  #define START(P0,P1) do{ const float rm=rowmax(P0,P1); resc=false; \
    { const float dl=selcur?rm:-64.f; mhat=fadd_s(mhat,dl); \
      _Pragma("unroll") for(int r=0;r<16;++r){P0[r]=fsub_s(P0[r],dl);P1[r]=fsub_s(P1[r],dl);} \
      { const float nv_=selcur?-mhat:NEGBIG; _Pragma("unroll") for(int r=0;r<16;++r)negm[r]=nv_; } asm volatile("":"+v"(negm)); } \
    _Pragma("unroll") for(int r=0;r<16;++r)P0[r]=__builtin_amdgcn_exp2f(P0[r]); }while(0)
  #define RESC() do{ if(resc){ asm volatile("s_waitcnt lgkmcnt(0)":::"memory"); \
      _Pragma("unroll") for(int d_=0;d_<2;++d_) _Pragma("unroll") for(int r=0;r<16;++r)o[d_][r]*=wsf[crow(r,hi)]; } }while(0)
  f32x16 pA0,pA1,pB0,pB1;
  int sl_prev=0,sl_cur=0,sl_next=SLOTB;
  #define ROT() do{sl_prev=sl_cur;sl_cur=sl_next;sl_next=(sl_next==(NSLOT-1)*SLOTB)?0:sl_next+SLOTB;}while(0)
  DMA_K(2,2*SLOTB);
  if(qb>=4){ if(tid<448){ const unsigned hb=__builtin_bit_cast(unsigned,kbv); const unsigned hr=(hb+0x7fffu+((hb>>16)&1u))&0xffff0000u; const float lo_=kbv-__builtin_bit_cast(float,hr); const unsigned lb=__builtin_bit_cast(unsigned,lo_);
      ((unsigned short*)(shm+LDS_KBAR))[tid]=(unsigned short)(hr>>16); ((unsigned short*)(shm+LDS_KBAR+1024))[tid]=(unsigned short)((lb+0x7fffu+((lb>>16)&1u))>>16); } }
  WAIT_BAR(3);
  unsigned bmask=(1u<<(qb+1))-1u;
  if(qb>=4){ float gsc[8];
    { const lds_cptr kb3=shm3+LDS_KBAR+(r32&7)*128+hi*16; f32x16 g=f32x16{};
      _Pragma("unroll") for(int d0=0;d0<4;++d0){ const bf16x8 ah=*(const __attribute__((address_space(3))) bf16x8*)(kb3+d0*32), al=*(const __attribute__((address_space(3))) bf16x8*)(kb3+1024+d0*32);
        g=__builtin_amdgcn_mfma_f32_32x32x16_bf16(ah,qr[d0],g,0,0,0); g=__builtin_amdgcn_mfma_f32_32x32x16_bf16(al,qr[d0],g,0,0,0); }
      _Pragma("unroll") for(int r=0;r<4;++r){ auto rr=__builtin_amdgcn_permlane32_swap(__float_as_uint(g[r]),__float_as_uint(g[r]),false,false); gsc[r]=__uint_as_float(rr[0]); gsc[4+r]=__uint_as_float(rr[1]); } }
    _Pragma("unroll") for(int n=0;n<7;++n) gsc[n]=(n<qb)?gsc[n]:-3.0e38f;
    bmask=1u<<qb;
    _Pragma("unroll") for(int pick=0;pick<3;++pick){ float best=-3.4e38f; unsigned bi=0u;
      _Pragma("unroll") for(int n=0;n<7;++n){ const bool ok=!((bmask>>n)&1u)&&gsc[n]>best; best=ok?gsc[n]:best; bi=ok?(unsigned)n:bi; }
      bmask|=1u<<bi; } }
  bool selcur=(bmask&1u)!=0u;
  { const float nv=selcur?0.f:NEGBIG; _Pragma("unroll") for(int r=0;r<16;++r)negm[r]=nv; asm volatile("":"+v"(negm)); }
  qkt(pA0,pA1,Kbase,qr,negm,r32,hi);asm volatile("s_nop 15\n\ts_nop 7":"+v"(pA0),"+v"(pA1));CMASK(pA0,pA1,0);
  START(pA0,pA1);
  _Pragma("unroll") for(int r=0;r<16;++r)pA1[r]=__builtin_amdgcn_exp2f(pA1[r]);
  WAIT_BAR(0);
  DMA_K(3,0);DMA_V(1,SLOTB);
  ROT();
  kload8(kf,kp0+sl_cur);
  WAIT_BAR(2);
  s16x4 vlo[8],vhi[8]; u32x4 pw0,pw1,pw2,pw3;
  #define PKW(P,B) cvtpk_s(P[B],P[B+1])
  #define PAF(k) __builtin_bit_cast(bf16x8,pw##k)
  #define VFR(i) (bf16x8){vlo[i][0],vlo[i][1],vlo[i][2],vlo[i][3],vhi[i][0],vhi[i][1],vhi[i][2],vhi[i][3]}
  #define PIN(x) asm volatile("":"+v"(x))
  #define MX3(a,b,c) __builtin_fmaxf(__builtin_fmaxf((a),(b)),(c))
  #define GAPA(MF,A0,A1,A2,A3,W0,W1,PW) do{ MF; sacc+=A0; sacc+=A1; sacc+=A2; sacc+=A3; PIN(sacc); W0; W1; PIN(PW); SBAR(); }while(0)
  #define EX(v) __builtin_amdgcn_exp2f(v)
  #define GAPB(MF,X,B) do{ MF; X[B]=EX(X[B]); X[B+1]=EX(X[B+1]); X[B+2]=EX(X[B+2]); X[B+3]=EX(X[B+3]); PIN(X); SBAR(); }while(0)
  #define VRD(i) do{ vlo[i]=vtr(vp_+(((i)>>2)*4096+((i)&3)*1024)); vhi[i]=vtr(vp_+(((i)>>2)*4096+((i)&3)*1024+512)); }while(0)
  #define KRD(G,j) do{ if(G){ kload2(kf,kp0+sl_next,j); SBAR(); } }while(0)
  #define STEP(C0,C1,P0,P1,t,GK,GV,GL) do{ SBAR(); \
    const lds_cptr vp_=vp0+sl_prev; \
    VRD(0); SBAR(); float sacc=(P0[0]+P0[1]); \
    GAPA(C0=__builtin_amdgcn_mfma_f32_32x32x16_bf16(kf[0],qr[0],negm,0,0,0), P0[2],P0[3],P0[4],P0[5],     pw0[0]=PKW(P0,0), pw0[1]=PKW(P0,2), pw0); \
    VRD(4); SBAR(); GAPA(C1=__builtin_amdgcn_mfma_f32_32x32x16_bf16(kf[1],qr[0],negm,0,0,0), P0[6],P0[7],P0[8],P0[9],     pw0[2]=PKW(P0,4), pw0[3]=PKW(P0,6), pw0); \
    VRD(1); SBAR(); GAPA(C0=__builtin_amdgcn_mfma_f32_32x32x16_bf16(kf[2],qr[1],C0,0,0,0),   P0[10],P0[11],P0[12],P0[13], pw1[0]=PKW(P0,8), pw1[1]=PKW(P0,10), pw1); \
    VRD(5); SBAR(); GAPA(C1=__builtin_amdgcn_mfma_f32_32x32x16_bf16(kf[3],qr[1],C1,0,0,0),   P0[14],P0[15],P1[0],P1[1],   pw1[2]=PKW(P0,12),pw1[3]=PKW(P0,14), pw1); \
    VRD(2); SBAR(); GAPA(C0=__builtin_amdgcn_mfma_f32_32x32x16_bf16(kf[4],qr[2],C0,0,0,0),   P1[2],P1[3],P1[4],P1[5],     pw2[0]=PKW(P1,0), pw2[1]=PKW(P1,2), pw2); \
    VRD(6); SBAR(); GAPA(C1=__builtin_amdgcn_mfma_f32_32x32x16_bf16(kf[5],qr[2],C1,0,0,0),   P1[6],P1[7],P1[8],P1[9],     pw2[2]=PKW(P1,4), pw2[3]=PKW(P1,6), pw2); \
    VRD(3); SBAR(); GAPA(C0=__builtin_amdgcn_mfma_f32_32x32x16_bf16(kf[6],qr[3],C0,0,0,0),   P1[10],P1[11],P1[12],P1[13], pw3[0]=PKW(P1,8), pw3[1]=PKW(P1,10), pw3); \
    VRD(7); SBAR(); GAPA(C1=__builtin_amdgcn_mfma_f32_32x32x16_bf16(kf[7],qr[3],C1,0,0,0),   P1[14],P1[15],0.f,0.f,       pw3[2]=PKW(P1,12),pw3[3]=PKW(P1,14), pw3); \
    l_reg+=sacc; \
    if(GK){DMA_K((t)+3,sl_cur);} if(GV){DMA_V((t)+1,sl_next);} \
    CMASK(C0,C1,t); \
    { float a=MX3(C0[0],C0[1],C1[0]),b=MX3(C0[2],C0[3],C1[1]); a=MX3(a,C1[2],C1[3]); \
      _Pragma("unroll") for(int r=4;r<16;r+=4){a=MX3(a,C0[r],C0[r+1]);b=MX3(b,C0[r+2],C0[r+3]);a=MX3(a,C1[r],C1[r+1]);b=MX3(b,C1[r+2],C1[r+3]);} \
      float rm=__builtin_fmaxf(a,b); { auto rr=__builtin_amdgcn_permlane32_swap(__float_as_uint(rm),__float_as_uint(rm),false,false); rm=__builtin_fmaxf(__uint_as_float(rr[0]),__uint_as_float(rr[1])); } \
      resc=false; \
      if(__builtin_expect(__any(rm>(float)THRL),0)){ const float dl=__builtin_fmaxf(rm,0.f); mhat+=dl; \
        _Pragma("unroll") for(int r=0;r<16;++r){C0[r]-=dl;C1[r]-=dl;} \
        { const float nv_=selcur?-mhat:NEGBIG; _Pragma("unroll") for(int r=0;r<16;++r)negm[r]=nv_; } asm volatile("":"+v"(negm)); \
        const float f=__builtin_amdgcn_exp2f(-dl); l_reg*=f; if(hi==0)wsf[r32]=f; resc=true; } } \
    SBAR(); \
    GAPB(o[0]=__builtin_amdgcn_mfma_f32_32x32x16_bf16(PAF(0),VFR(0),o[0],0,0,0), C0,0); \
    GAPB(o[1]=__builtin_amdgcn_mfma_f32_32x32x16_bf16(PAF(0),VFR(4),o[1],0,0,0), C0,4); \
    KRD(GL,0); GAPB(o[0]=__builtin_amdgcn_mfma_f32_32x32x16_bf16(PAF(1),VFR(1),o[0],0,0,0), C0,8); \
    KRD(GL,1); GAPB(o[1]=__builtin_amdgcn_mfma_f32_32x32x16_bf16(PAF(1),VFR(5),o[1],0,0,0), C0,12); \
    KRD(GL,2); GAPB(o[0]=__builtin_amdgcn_mfma_f32_32x32x16_bf16(PAF(2),VFR(2),o[0],0,0,0), C1,0); \
    KRD(GL,3); GAPB(o[1]=__builtin_amdgcn_mfma_f32_32x32x16_bf16(PAF(2),VFR(6),o[1],0,0,0), C1,4); \
    GAPB(o[0]=__builtin_amdgcn_mfma_f32_32x32x16_bf16(PAF(3),VFR(3),o[0],0,0,0), C1,8); \
    GAPB(o[1]=__builtin_amdgcn_mfma_f32_32x32x16_bf16(PAF(3),VFR(7),o[1],0,0,0), C1,12); \
    }while(0)
  #define BLKSEL(tt) do{ if((((tt))&3)==0){ selcur=((bmask>>((tt)>>2))&1u)!=0u; const float nv_=selcur?-mhat:NEGBIG; _Pragma("unroll") for(int r=0;r<16;++r)negm[r]=nv_; asm volatile("":"+v"(negm)); } }while(0)
  int t=1;
  #undef CMASK
  #define CMASK(P0,P1,t) do{}while(0)
  for(;t+5<NT;t+=2){
    STEP(pB0,pB1,pA0,pA1,t,true,true,true);     WAIT_BAR(2); RESC(); ROT(); BLKSEL(t+1);
    STEP(pA0,pA1,pB0,pB1,t+1,true,true,true);   WAIT_BAR(2); RESC(); ROT();
  }
  #undef CMASK
  #define CMASK(P0,P1,t) do{int jb_=(t)-(NT-4); if(jb_>=0)cmask(P0,P1,jb_,qrel,hi);}while(0)
  #define ENDW(tt) do{ if((tt)+3<NT){WAIT_BAR(2);} else if((tt)+2<NT){WAIT_BAR(1);} else {WAIT_BAR(0);} }while(0)
  for(;t+1<NT;t+=2){
    STEP(pB0,pB1,pA0,pA1,t,(t+3<NT),(t+1<NT),(t+1<NT));       ENDW(t);   RESC(); ROT(); BLKSEL(t+1);
    STEP(pA0,pA1,pB0,pB1,t+1,(t+4<NT),(t+2<NT),(t+2<NT));     ENDW(t+1); RESC(); ROT();
  }
  STEP(pB0,pB1,pA0,pA1,NT-1,false,false,false); RESC();
  { float sacc=pB0[0]+pB0[1]; _Pragma("unroll") for(int r=2;r<16;++r)sacc+=pB0[r]; _Pragma("unroll") for(int r=0;r<16;++r)sacc+=pB1[r]; l_reg+=sacc;
    pw0=(u32x4){PKW(pB0,0),PKW(pB0,2),PKW(pB0,4),PKW(pB0,6)};pw1=(u32x4){PKW(pB0,8),PKW(pB0,10),PKW(pB0,12),PKW(pB0,14)};pw2=(u32x4){PKW(pB1,0),PKW(pB1,2),PKW(pB1,4),PKW(pB1,6)};pw3=(u32x4){PKW(pB1,8),PKW(pB1,10),PKW(pB1,12),PKW(pB1,14)};
    SBAR(); pv(o,vb0+sl_cur,PAF(0),PAF(1),PAF(2),PAF(3)); }
  #undef PKW
  #undef PAF
  #undef VFR
  #undef PIN
  #undef MX3
  #undef GAPA
  #undef GAPB
  #undef EX
  #undef VRD
  #undef KRD
  #undef STEP
  #undef ENDW
  {auto rr=__builtin_amdgcn_permlane32_swap(__float_as_uint(l_reg),__float_as_uint(l_reg),false,false);l_reg=__uint_as_float(rr[0])+__uint_as_float(rr[1]);}
  if(hi==0)wsf[32+r32]=l_reg;asm volatile("s_waitcnt lgkmcnt(0)":::"memory");
  float rli[16];
  #pragma unroll
  for(int r=0;r<16;++r)rli[r]=__builtin_amdgcn_rcpf(wsf[32+crow(r,hi)]);
  unsigned char*Ow=(unsigned char*)O+(rowbase+q0+wid*QBLK)*OP+h*D;
  { unsigned char*stg=(unsigned char*)(shm+LDS_OST)+wid*4096;
    #pragma unroll
    for(int r=0;r<16;++r){const int orow=crow(r,hi);
      #pragma unroll
      for(int d0=0;d0<2;++d0){const float ov=__builtin_amdgcn_fmed3f(o[d0][r]*rli[r]*32.f,-448.f,448.f); stg[orow*64+d0*32+r32]=(unsigned char)__builtin_amdgcn_cvt_pk_fp8_f32(ov,ov,0,false);}}
    asm volatile("s_waitcnt lgkmcnt(0)":::"memory");
    #pragma unroll
    for(int i=0;i<2;++i){const int row=i*16+(lane>>2),ch=lane&3; const u32x4 v=*(const u32x4*)(stg+row*64+ch*16); ATTN_STORE16(Ow+(long)row*OP+ch*16,v);} }
  asm volatile("s_waitcnt lgkmcnt(0)\n\ts_barrier":::"memory");
  #undef BLKSEL
  #undef DMA_K
  #undef DMA_V
  #undef CMASK
  #undef START
  #undef RESC
  #undef ROT
}
constexpr int ATTN_LDS_BYTES=LDS_BYTES;
struct AttnTensors { const bf16* Q; const bf16* K; const bf16* V; bf16* O; const float* kbar; };
struct AttnUnit { int bh; int qb; };
struct StaticOrder {
  int vcu, G;
  __device__ __forceinline__ explicit StaticOrder(int grid,int block):vcu((grid%8==0)?(block%8)*(grid/8)+block/8:block),G(grid){}
  __device__ __forceinline__ bool next(int i,AttnUnit&u)const{ const int pr=(vcu+(i>>2)*G)*2+((i>>1)&1); if(pr>=BATCH*NHEAD*4)return false;
    const int s=pr&3; u.bh=pr>>2; u.qb=(i&1)?7-s:s; return true; }
  __device__ __forceinline__ void a_ready(const AttnUnit&)const{}
  __device__ __forceinline__ void done(const AttnUnit&)const{}
};
template<class Sched,int THRL=8> __device__ __forceinline__ void attn_phase(char*lds,const AttnTensors&T,const Sched&S,const int tid_in){
  AttnUnit u; int tid_=tid_in; asm volatile("":"+v"(tid_));
  for(int i=0;S.next(i,u);++i){ S.a_ready(u); attn_unit<THRL>(u.bh/NHEAD,u.bh%NHEAD,u.qb,T.Q,T.K,T.V,T.O,T.kbar+(long)u.bh*512,lds,tid_); S.done(u); }
}
#undef SBAR
#undef WAIT_BAR
}

#define XB_TMO      128
#define XB_XCNT(j)  (256  + 64 * (j))
#define XB_XSUB(j)  (1280 + 64 * (j))
#define XB_XGEN(j)  (2304 + 64 * (j))
#define XB_TOP      3328
#define XB_TOPGEN   3392
#define XCD_BAR_WORDS 3456
#define XB_SPIN_CAP (1u << 18)

__device__ __forceinline__ unsigned xb_ld(unsigned* p)              { return __hip_atomic_load(p, __ATOMIC_RELAXED, __HIP_MEMORY_SCOPE_AGENT); }
__device__ __forceinline__ unsigned xb_add(unsigned* p, unsigned v) { return __hip_atomic_fetch_add(p, v, __ATOMIC_RELAXED, __HIP_MEMORY_SCOPE_AGENT); }
__device__ __forceinline__ unsigned xb_xcc_id() { return (unsigned)__builtin_amdgcn_s_getreg((3 << 11) | 20) & 0xFu; }
#define XB_SPIN(cond, bar) do { unsigned _sp = 0; while (cond) { __builtin_amdgcn_s_sleep(1); \
    if ((++_sp & 255u) == 0u) { if (xb_ld(&(bar)[XB_TMO])) break; if (_sp > XB_SPIN_CAP) { atomicAdd(&(bar)[XB_TMO], 1u); break; } } } } while (0)

struct XcdBarrier {
    unsigned* bar; unsigned x;
    volatile LAS unsigned* st;
};

__device__ __forceinline__ XcdBarrier xcd_barrier_post(unsigned* bar, volatile LAS unsigned* st) {
    XcdBarrier b; b.bar = bar; b.x = xb_xcc_id(); b.st = st;
    if (threadIdx.x == 0) (void)xb_add(&bar[XB_XCNT(b.x)], 1u);
    return b;
}
__device__ __forceinline__ void xcd_barrier_complete(unsigned* bar, unsigned x, unsigned& nloc, unsigned& nx) {
    const unsigned G = gridDim.x * gridDim.y * gridDim.z;
    unsigned sum, cnt, mine, sp = 0u;
    for (;;) {
        sum = 0u; cnt = 0u; mine = 0u;
#pragma unroll
        for (unsigned j = 0; j < 16; ++j) { const unsigned c = xb_ld(&bar[XB_XCNT(j)]); sum += c; cnt += (c > 0u) ? 1u : 0u; mine = (j == x) ? c : mine; }
        if (sum == G) break;
        __builtin_amdgcn_s_sleep(1);
        if ((++sp & 255u) == 0u) { if (xb_ld(&bar[XB_TMO])) break; if (sp > XB_SPIN_CAP) { atomicAdd(&bar[XB_TMO], 1u); break; } }
    }
    nloc = mine > 0u ? mine : 1u; nx = cnt > 0u ? cnt : 1u;
}

__device__ __forceinline__ void xcd_barrier(const XcdBarrier& b, const bool is_t0) {
    asm volatile("s_waitcnt vmcnt(0)" ::: "memory");
    __syncthreads();
    if (is_t0) {
        unsigned* bar = b.bar;
        __builtin_amdgcn_s_waitcnt(0);
        unsigned nloc = b.st[0], nx = b.st[1];
        if (nloc == 0u) { xcd_barrier_complete(bar, b.x, nloc, nx); b.st[0] = nloc; b.st[1] = nx; }
        const unsigned old = xb_add(&bar[XB_XSUB(b.x)], 1u);
        const unsigned gen = old / nloc;
        if (old + 1u == (gen + 1u) * nloc) {
            __builtin_amdgcn_fence(__ATOMIC_RELEASE, "agent");
            asm volatile("s_waitcnt vmcnt(0)" ::: "memory");
            const unsigned og = xb_add(&bar[XB_TOP], 1u);
            const unsigned tg = og / nx;
            if (og + 1u == (tg + 1u) * nx) xb_add(&bar[XB_TOPGEN], 1u);
            else XB_SPIN(xb_ld(&bar[XB_TOPGEN]) == tg, bar);
            __builtin_amdgcn_fence(__ATOMIC_ACQUIRE, "agent");
            xb_add(&bar[XB_XGEN(b.x)], 1u);
            asm volatile("s_waitcnt vmcnt(0)" ::: "memory");
        } else {
            XB_SPIN(xb_ld(&bar[XB_XGEN(b.x)]) == gen, bar);
            __builtin_amdgcn_fence(__ATOMIC_ACQUIRE, "agent");
            asm volatile("s_waitcnt vmcnt(0)" ::: "memory");
        }
    }
    __syncthreads();
}

struct Args { const float* in[17]; float* out; unsigned char* ws; int ph_lo, ph_hi; };
enum { I_X = 0, I_C, I_WMOD, I_BMOD, I_WIN, I_WPOOL, I_PSCALE, I_WOUT, I_LN1G, I_LN1B, I_WR, I_RB, I_WG, I_WU, I_WDN, I_LN2G, I_LN2B };

DEVFN int lane_id_volatile() { int l; asm volatile("v_mbcnt_lo_u32_b32 %0, -1, 0\n\tv_mbcnt_hi_u32_b32 %0, -1, %0" : "=v"(l)); return l; }
struct Ctx { unsigned char* lds; __attribute__((address_space(3))) unsigned char* lds3; int tid, lane, wave, G, bid, gw, NGW; };

DEVFN void transpose_item(const float* src, int ldn, int k0, int col, bf16_t* dst, int ldk, int dst_row0, int dst_k0, float* scr, int lane) {
#pragma unroll 8
    for (int i = 0; i < 32; ++i) { const int kk = 2 * i + (lane >> 5); scr[kk * 33 + (lane & 31)] = src[(size_t)(k0 + kk) * ldn + col]; }
    LDS_WAIT();
    const int c = lane & 7;
#pragma unroll
    for (int j = 0; j < 4; ++j) { const int n = (lane >> 3) + 8 * j; const float* s = scr + (8 * c) * 33 + n;
        u32x4 o; o.x = pk2(s[0 * 33], s[1 * 33]); o.y = pk2(s[2 * 33], s[3 * 33]); o.z = pk2(s[4 * 33], s[5 * 33]); o.w = pk2(s[6 * 33], s[7 * 33]);
        *(u32x4*)(dst + (size_t)(dst_row0 + n) * ldk + dst_k0 + 8 * c) = o; }
    LDS_WAIT();
}

DEVFN void transpose_item_f8(const float* src, int ldn, int k0, int col, unsigned char* dst, int ldk, int dst_row0, int dst_k0, float* scr, int lane) {
#pragma unroll 8
    for (int i = 0; i < 32; ++i) { const int kk = 2 * i + (lane >> 5); scr[kk * 33 + (lane & 31)] = src[(size_t)(k0 + kk) * ldn + col]; }
    LDS_WAIT();
    const int c = lane & 7;
#pragma unroll
    for (int j = 0; j < 4; ++j) { const int n = (lane >> 3) + 8 * j; const float* s = scr + (8 * c) * 33 + n;
        u32x2 o; o.x = pk4_fp8(32.f * s[0 * 33], 32.f * s[1 * 33], 32.f * s[2 * 33], 32.f * s[3 * 33]); o.y = pk4_fp8(32.f * s[4 * 33], 32.f * s[5 * 33], 32.f * s[6 * 33], 32.f * s[7 * 33]);
        *(u32x2*)(dst + (size_t)(dst_row0 + n) * ldk + dst_k0 + 8 * c) = o; }
    LDS_WAIT();
}

DEVFN void ph_prologue(const Args& a, const Ctx& c) {
    unsigned char* ws = a.ws;
    float* scr = (float*)(c.lds + c.wave * 16384);
    const int lane = c.lane;
    constexpr int N1 = 2 * 16 * 64, N2 = 2 * 8 * 32, N3 = 32 * 16 * 32, N4 = 32 * 8 * 32, N5 = 2 * 64 * 16, N6 = 256;
    for (int it = c.gw; it < N1 + N2 + N3 + N4 + N5 + N6; it += c.NGW) {
        int r = it;
        if (r < N1) {
            const int l = r / 1024, kb = (r % 1024) / 64, nb = r % 64;
            const int nphys = 32 * nb + (lane & 31);
            transpose_item_f8(a.in[I_WIN] + (size_t)l * DM * DIN, DIN, 64 * kb, inproj_nlog(nphys), (unsigned char*)(ws + WS_WIN) + (size_t)l * DIN * DM, DM, 32 * nb, 64 * kb, scr, lane);
            continue; }
        r -= N1;
        if (r < N2) {
            const int l = r / 256, kb = (r % 256) / 32, nb = r % 32;
            transpose_item_f8(a.in[I_WOUT] + (size_t)l * DM * DM, DM, 64 * kb, 32 * nb + (lane & 31), (unsigned char*)(ws + WS_WOUT) + (size_t)l * DM * DM, DM, 32 * nb, 64 * kb, scr, lane);
            continue; }
        r -= N2;
        if (r < N3) {
            const int le = r / 512, kb = (r % 512) / 32, nb = r % 32;
            const int n = 32 * nb + (lane & 31), jt = n >> 8, bj = (n >> 7) & 1, i = n & 127;
            const float* src = (bj ? a.in[I_WU] : a.in[I_WG]) + (size_t)le * DM * DE;
            transpose_item_f8(src, DE, 64 * kb, jt * 128 + i, (unsigned char*)(ws + WS_WGU) + (size_t)le * DM * DM, DM, 32 * nb, 64 * kb, scr, lane);
            continue; }
        r -= N3;
        if (r < N4) {
            const int le = r / 256, kb = (r % 256) / 32, nb = r % 32;
            transpose_item_f8(a.in[I_WDN] + (size_t)le * DE * DM, DM, 64 * kb, 32 * nb + (lane & 31), (unsigned char*)(ws + WS_WD) + (size_t)le * DM * DE, DE, 32 * nb, 64 * kb, scr, lane);
            continue; }
        r -= N4;
        if (r < N5) {
            const int l = r / 1024, kdg = (r % 1024) / 16, nb = r % 16;
            const int n = nb * 64 + lane, kd0 = kdg * 8, g = kd0 >> 7, c0 = kd0 & 127;
            const float* wo = a.in[I_WOUT] + (size_t)l * DM * DM + (size_t)(512 + g * 128) * DM + n;
            const float* ps = a.in[I_PSCALE] + l * 512 + g * 128;
            const float* wp = a.in[I_WPOOL] + ((size_t)(l * 4 + g) * 128 + c0) * 128;
            float acc[8];
#pragma unroll
            for (int j = 0; j < 8; ++j) acc[j] = 0.f;
            for (int e = 0; e < 128; ++e) { const float w = wo[(size_t)e * DM] * ps[e];
#pragma unroll
                for (int j = 0; j < 8; ++j) acc[j] += wp[j * 128 + e] * w; }
            u32x2 o; o.x = pk4_fp8(128.f * acc[0], 128.f * acc[1], 128.f * acc[2], 128.f * acc[3]); o.y = pk4_fp8(128.f * acc[4], 128.f * acc[5], 128.f * acc[6], 128.f * acc[7]);
            *(u32x2*)((unsigned char*)(ws + WS_WOUT) + (size_t)l * DM * DM + (size_t)n * DM + 512 + kd0) = o;
            continue; }
        r -= N5;
        {
            const int ent = r * 64 + lane, pos = ent >> 3, i = ent & 7;
            const float inv = (float)exp2(-(double)i / 8.0 * 18.931568569324174);
            const float ang = (float)pos * inv;
            float* t = (float*)(ws + WS_ROPE) + ent * 2;
            t[0] = (float)cos((double)ang); t[1] = (float)sin((double)ang);
        }
    }
    for (int i = c.bid * 512 + c.tid; i < 2 * NB * NH * NBLK * HD; i += c.G * 512) ((float*)(ws + WS_KBAR))[i] = 0.f;
    __syncthreads();
    if (c.bid < 192) {
        float* condT = (float*)c.lds;
        float* red = (float*)(c.lds + 65536);
        for (int idx = c.tid; idx < NB * DM; idx += 512) { const int b = idx >> 10, k = idx & 1023; const float v = a.in[I_C][idx]; condT[k * 16 + b] = v / (1.f + __expf(-v)); }
        __syncthreads();
        for (int u = c.bid; u < 192; u += c.G) {
            const int l = u / 96, n0 = (u % 96) * 64;
            const float* W = a.in[I_WMOD] + (size_t)l * DM * NMOD + n0 + lane;
            float acc[16];
#pragma unroll
            for (int b = 0; b < 16; ++b) acc[b] = 0.f;
            for (int k = 128 * c.wave; k < 128 * c.wave + 128; k += 8) {
                float wv[8];
#pragma unroll
                for (int j = 0; j < 8; ++j) wv[j] = W[(size_t)(k + j) * NMOD];
#pragma unroll
                for (int j = 0; j < 8; ++j) {
                    const f32x4* cp = (const f32x4*)(condT + (k + j) * 16);
#pragma unroll
                    for (int q = 0; q < 4; ++q) { const f32x4 cv = cp[q]; acc[4 * q + 0] += cv.x * wv[j]; acc[4 * q + 1] += cv.y * wv[j]; acc[4 * q + 2] += cv.z * wv[j]; acc[4 * q + 3] += cv.w * wv[j]; }
                }
            }
#pragma unroll
            for (int b = 0; b < 16; ++b) red[(c.wave * 16 + b) * 64 + lane] = acc[b];
            __syncthreads();
            for (int o = c.tid; o < 1024; o += 512) { const int b = o >> 6, cc = o & 63; float s = a.in[I_BMOD][l * NMOD + n0 + cc];
#pragma unroll
                for (int w = 0; w < 8; ++w) s += red[(w * 16 + b) * 64 + cc];
                ((float*)(ws + WS_MOD))[(size_t)(l * NB + b) * NMOD + n0 + cc] = s; }
            __syncthreads();
        }
    }
}

DEVFN void row_stats(const f32x4 (&v)[4], float& mean, float& rstd) {
    float s = 0.f;
#pragma unroll
    for (int j = 0; j < 4; ++j) s += (v[j].x + v[j].y) + (v[j].z + v[j].w);
    mean = wave_sum(s) * (1.f / DM);
    float q = 0.f;
#pragma unroll
    for (int j = 0; j < 4; ++j) { const f32x4 d = v[j] - mean; q += (d.x * d.x + d.y * d.y) + (d.z * d.z + d.w * d.w); }
    rstd = 1.f / sqrtf(wave_sum(q) * (1.f / DM) + LN_EPS);
}
DEVFN void row_load(const float* p, int lane, f32x4 (&v)[4]) {
#pragma unroll
    for (int j = 0; j < 4; ++j) v[j] = *(const f32x4*)(p + 4 * lane + 256 * j);
}
DEVFN void row_mod_store(f32x4 (&v)[4], const float* sc, const float* sh, bf16_t* out, int lane) {
    float mean, rstd; row_stats(v, mean, rstd);
#pragma unroll
    for (int j = 0; j < 4; ++j) {
        const f32x4 s = *(const f32x4*)(sc + 4 * lane + 256 * j), h = *(const f32x4*)(sh + 4 * lane + 256 * j);
        v[j] = (v[j] - mean) * rstd * (s + 1.f) + h;
        u32x2 o; o.x = pk2(v[j].x, v[j].y); o.y = pk2(v[j].z, v[j].w);
        *(u32x2*)(out + 4 * lane + 256 * j) = o;
    }
}

DEVFN void wave_gemm32(f32x16& acc, const bf16_t* ap, const bf16_t* bp, int K) {
#pragma unroll 4
    for (int k = 0; k < K; k += 16) {
        const bf16x8 av = *(const bf16x8*)(ap + k), bv = *(const bf16x8*)(bp + k);
        acc = __builtin_amdgcn_mfma_f32_32x32x16_bf16(av, bv, acc, 0, 0, 0);
    }
}

DEVFN void ph_inproj_naive(const Args& a, const Ctx& c, int l) {
    const bf16_t* A = (const bf16_t*)(a.ws + WS_HB); const bf16_t* Bt = (const bf16_t*)(a.ws + WS_WIN) + (size_t)l * DIN * DM;
    bf16_t* O = (bf16_t*)(a.ws + WS_QKVP);
    const int r32 = c.lane & 31, hi = c.lane >> 5, wy = c.wave >> 2, wx = c.wave & 3;
    for (int u = c.bid; u < 512 * 16; u += c.G) {
        const int mt = u >> 4, nt = u & 15;
        f32x16 acc = {};
        wave_gemm32(acc, A + (size_t)(mt * 64 + wy * 32 + r32) * DM + hi * 8, Bt + (size_t)(nt * 128 + wx * 32 + r32) * DM + hi * 8, DM);
        const int nl = inproj_nlog(nt * 128 + wx * 32 + r32);
#pragma unroll
        for (int r = 0; r < 16; ++r) O[(size_t)(mt * 64 + wy * 32 + crow(r, hi)) * DIN + nl] = (bf16_t)f2bf(acc[r]);
    }
}

DEVFN void ph_rope_naive(const Args& a, const Ctx& c) {
    bf16_t* O = (bf16_t*)(a.ws + WS_QKVP); const float* rope = (const float*)(a.ws + WS_ROPE);
    for (int idx = c.bid * 512 + c.tid; idx < NTOK * 16; idx += c.G * 512) {
        const int which = idx & 1, hh = (idx >> 1) & 7, m = idx >> 4, t = m & (SEQ - 1);
        bf16_t* p = O + (size_t)m * DIN + which * 512 + hh * 64;
        float v[64];
#pragma unroll
        for (int q = 0; q < 8; ++q) { const u32x4 w = *(const u32x4*)(p + 8 * q);
            v[8 * q + 0] = bf_lo(w.x); v[8 * q + 1] = bf_hi(w.x); v[8 * q + 2] = bf_lo(w.y); v[8 * q + 3] = bf_hi(w.y);
            v[8 * q + 4] = bf_lo(w.z); v[8 * q + 5] = bf_hi(w.z); v[8 * q + 6] = bf_lo(w.w); v[8 * q + 7] = bf_hi(w.w); }
#pragma unroll
        for (int i = 0; i < 8; ++i) { const float cs = rope[(t * 8 + i) * 2], sn = rope[(t * 8 + i) * 2 + 1]; const float x1 = v[i], x2 = v[8 + i];
            v[i] = x1 * cs - x2 * sn; v[8 + i] = x2 * cs + x1 * sn; }
        const float sc = which == 0 ? QSCALE : 1.f;
#pragma unroll
        for (int q = 0; q < 8; ++q) { u32x4 w; w.x = pk2(v[8 * q] * sc, v[8 * q + 1] * sc); w.y = pk2(v[8 * q + 2] * sc, v[8 * q + 3] * sc); w.z = pk2(v[8 * q + 4] * sc, v[8 * q + 5] * sc); w.w = pk2(v[8 * q + 6] * sc, v[8 * q + 7] * sc);
            *(u32x4*)(p + 8 * q) = w; }
    }
}

DEVFN void ph_kbar(const Args& a, const Ctx& c, int l) {
    const bf16_t* O = (const bf16_t*)(a.ws + WS_QKVP); float* kbar = (float*)(a.ws + WS_KBAR) + (size_t)l * NB * NH * NBLK * HD;
    for (int it = c.gw; it < NB * NH * NBLK; it += c.NGW) {
        const int n = it & 7, hh = (it >> 3) & 7, b = it >> 6;
        const bf16_t* p = O + (size_t)(b * SEQ + n * MBLK) * DIN + 512 + hh * 64 + c.lane;
        float s = 0.f;
#pragma unroll 8
        for (int j = 0; j < MBLK; ++j) s += bf2f(p[(size_t)j * DIN]);
        kbar[(size_t)it * 64 + c.lane] = s * (1.f / MBLK);
    }
}

DEVFN void ph_pool(const Args& a, const Ctx& c) {
    const bf16_t* P = (const bf16_t*)(a.ws + WS_QKVP) + 1536; unsigned char* AD = (unsigned char*)(a.ws + WS_AD) + 512;
    for (int it = c.bid * 512 + c.tid; it < (NTOK / 16) * 64; it += c.G * 512) {
        const int cg = it & 63, m0 = (it >> 6) * 16, t0 = m0 & (SEQ - 1), g = cg >> 4, w = 2 << g;
        const bf16_t* pc = P + cg * 8;
        float s[8];
#pragma unroll
        for (int j = 0; j < 8; ++j) s[j] = 0.f;
        for (int i = 1; i < w; ++i) if (t0 - i >= 0) { const u32x4 v = *(const u32x4*)(pc + (size_t)(m0 - i) * DIN);
            s[0] += bf_lo(v.x); s[1] += bf_hi(v.x); s[2] += bf_lo(v.y); s[3] += bf_hi(v.y); s[4] += bf_lo(v.z); s[5] += bf_hi(v.z); s[6] += bf_lo(v.w); s[7] += bf_hi(v.w); }
#pragma unroll 4
        for (int r = 0; r < 16; ++r) {
            const int t = t0 + r; const u32x4 v = *(const u32x4*)(pc + (size_t)(m0 + r) * DIN);
            const float f[8] = {bf_lo(v.x), bf_hi(v.x), bf_lo(v.y), bf_hi(v.y), bf_lo(v.z), bf_hi(v.z), bf_lo(v.w), bf_hi(v.w)};
#pragma unroll
            for (int j = 0; j < 8; ++j) s[j] += f[j];
            const int cnt = (t + 1 < w) ? t + 1 : w; const float ic = 1.f / (float)cnt;
            u32x2 o; o.x = pk4_fp8(s[0] * ic - f[0], s[1] * ic - f[1], s[2] * ic - f[2], s[3] * ic - f[3]); o.y = pk4_fp8(s[4] * ic - f[4], s[5] * ic - f[5], s[6] * ic - f[6], s[7] * ic - f[7]);
            *(u32x2*)(AD + (size_t)(m0 + r) * DM + cg * 8) = o;
            if (t - w + 1 >= 0) { const u32x4 q = *(const u32x4*)(pc + (size_t)(m0 + r - w + 1) * DIN);
                s[0] -= bf_lo(q.x); s[1] -= bf_hi(q.x); s[2] -= bf_lo(q.y); s[3] -= bf_hi(q.y); s[4] -= bf_lo(q.z); s[5] -= bf_hi(q.z); s[6] -= bf_lo(q.w); s[7] -= bf_hi(q.w); }
        }
    }
}

DEVFN void ph_wout_naive(const Args& a, const Ctx& c, int l) {
    const bf16_t* A = (const bf16_t*)(a.ws + WS_AD); const bf16_t* Bt = (const bf16_t*)(a.ws + WS_WOUT) + (size_t)l * DM * DM;
    float* Y = (float*)(a.ws + WS_QKVP);
    const int r32 = c.lane & 31, hi = c.lane >> 5, wy = c.wave >> 2, wx = c.wave & 3;
    for (int u = c.bid; u < 512 * 8; u += c.G) {
        const int mt = u >> 3, nt = u & 7;
        f32x16 acc = {};
        wave_gemm32(acc, A + (size_t)(mt * 64 + wy * 32 + r32) * DM + hi * 8, Bt + (size_t)(nt * 128 + wx * 32 + r32) * DM + hi * 8, DM);
#pragma unroll
        for (int r = 0; r < 16; ++r) Y[(size_t)(mt * 64 + wy * 32 + crow(r, hi)) * DM + nt * 128 + wx * 32 + r32] = acc[r];
    }
}

struct MoeTab { int* cnt; int* tp; };
DEVFN MoeTab moe_table(const Args& a, const Ctx& c, int l, unsigned char* lds_at) {
    MoeTab t; t.cnt = (int*)lds_at; t.tp = t.cnt + 32;
    if (c.tid < NCLS) t.cnt[c.tid] = (int)__hip_atomic_load((unsigned*)(a.ws + WS_CTL) + CW_CNT + l * 32 + c.tid, RLX_AGENT);
    __syncthreads();
    if (c.tid == 0) { int s = 0; for (int k = 0; k < NCLS; ++k) { t.tp[k] = s; s += (t.cnt[k] + 255) >> 8; } t.tp[NCLS] = s; }
    __syncthreads();
    return t;
}
DEVFN void cls_experts(int cls, int& e1, int& e2) { const int g = cls / 6, p = cls % 6; const int lo = p < 3 ? 0 : (p < 5 ? 1 : 2), hi = p < 3 ? p + 1 : (p < 5 ? p - 1 : 3); e1 = g * 4 + lo; e2 = g * 4 + hi; }

DEVFN void ph_gateup_naive(const Args& a, const Ctx& c, int l) {
    const MoeTab T = moe_table(a, c, l, c.lds);
    const int ntiles = T.tp[NCLS];
    const bf16_t* HB = (const bf16_t*)(a.ws + WS_HB); const bf16_t* WGU = (const bf16_t*)(a.ws + WS_WGU) + (size_t)l * NE * DM * DM;
    const int* list = (const int*)(a.ws + WS_LIST); const float* rw = (const float*)(a.ws + WS_RW);
    bf16_t* ACT = (bf16_t*)(a.ws + WS_QKVP);
    const int r32 = c.lane & 31, hi = c.lane >> 5, wy = c.wave >> 2, wx = c.wave & 3;
    for (int u = c.bid; u < ntiles * 32; u += c.G) {
        const int Tt = u >> 5, sub = (u >> 3) & 3, half = (u >> 2) & 1, jt = u & 3;
        int cls = 0; while (Tt >= T.tp[cls + 1]) ++cls;
        const int j = Tt - T.tp[cls], cnt = T.cnt[cls];
        int e1, e2; cls_experts(cls, e1, e2); const int e = half ? e2 : e1;
        const int lr = sub * 64 + wy * 32 + r32, li = 256 * j + lr;
        const int tok = list[(size_t)cls * LISTCAP + (li < cnt ? li : 256 * j)];
        const bf16_t* ap = HB + (size_t)tok * DM + hi * 8;
        const bf16_t* bg = WGU + (size_t)e * DM * DM + (size_t)(jt * 256 + wx * 32 + r32) * DM + hi * 8;
        f32x16 ag = {}, au = {};
        wave_gemm32(ag, ap, bg, DM); wave_gemm32(au, ap, bg + (size_t)128 * DM, DM);
#pragma unroll
        for (int r = 0; r < 16; ++r) {
            const int lro = sub * 64 + wy * 32 + crow(r, hi), lio = 256 * j + lro;
            const float wgt = lio < cnt ? rw[((size_t)cls * LISTCAP + lio) * 2 + half] : 0.f;
            const float g = ag[r], act = g / (1.f + __expf(-g)) * au[r] * wgt;
            ACT[(size_t)(256 * Tt + lro) * DM + half * 512 + jt * 128 + wx * 32 + r32] = (bf16_t)f2bf(act);
        }
    }
}

DEVFN void ph_down_naive(const Args& a, const Ctx& c, int l) {
    const MoeTab T = moe_table(a, c, l, c.lds);
    const int ntiles = T.tp[NCLS];
    const bf16_t* ACT = (const bf16_t*)(a.ws + WS_QKVP); const bf16_t* WD = (const bf16_t*)(a.ws + WS_WD) + (size_t)l * NE * DM * DE;
    const int* list = (const int*)(a.ws + WS_LIST);
    bf16_t* Y2 = (bf16_t*)(a.ws + WS_AD);
    const int r32 = c.lane & 31, hi = c.lane >> 5, wy = c.wave >> 2, wx = c.wave & 3;
    for (int u = c.bid; u < ntiles * 32; u += c.G) {
        const int Tt = u >> 5, sub = (u >> 3) & 3, nt = u & 7;
        int cls = 0; while (Tt >= T.tp[cls + 1]) ++cls;
        const int j = Tt - T.tp[cls], cnt = T.cnt[cls];
        int e1, e2; cls_experts(cls, e1, e2);
        const bf16_t* ap = ACT + (size_t)(256 * Tt + sub * 64 + wy * 32 + r32) * DM + hi * 8;
        const int n = nt * 128 + wx * 32 + r32;
        f32x16 acc = {};
        wave_gemm32(acc, ap, WD + (size_t)e1 * DM * DE + (size_t)n * DE + hi * 8, DE);
        wave_gemm32(acc, ap + DE, WD + (size_t)e2 * DM * DE + (size_t)n * DE + hi * 8, DE);
#pragma unroll
        for (int r = 0; r < 16; ++r) {
            const int lio = 256 * j + sub * 64 + wy * 32 + crow(r, hi);
            if (lio < cnt) { const int tok = list[(size_t)cls * LISTCAP + lio]; Y2[(size_t)tok * DM + n] = (bf16_t)f2bf(acc[r]); }
        }
    }
}

constexpr size_t WS_X1B = WS_X1, WS_X2B = WS_X1 + 64 * MiB;
constexpr int ROWS_PER_WAVE = 16;
DEVFN void vec_load(const float* p, int lane, f32x4 (&v)[4]) {
#pragma unroll
    for (int j = 0; j < 4; ++j) v[j] = *(const f32x4*)(p + 4 * lane + 256 * j);
}
DEVFN void bfrow_load(const bf16_t* p, int lane, u32x2 (&w)[4]) {
#pragma unroll
    for (int j = 0; j < 4; ++j) w[j] = *(const u32x2*)(p + 4 * lane + 256 * j);
}
DEVFN f32x4 bf4(u32x2 w) { return (f32x4){bf_lo(w.x), bf_hi(w.x), bf_lo(w.y), bf_hi(w.y)}; }
DEVFN void bfrow_store(bf16_t* p, int lane, const f32x4 (&v)[4]) {
#pragma unroll
    for (int j = 0; j < 4; ++j) { u32x2 o; o.x = pk2(v[j].x, v[j].y); o.y = pk2(v[j].z, v[j].w); *(u32x2*)(p + 4 * lane + 256 * j) = o; }
}
DEVFN void f8row_store(unsigned char* p, int lane, const f32x4 (&v)[4]) {
#pragma unroll
    for (int j = 0; j < 4; ++j) *(unsigned*)(p + 4 * lane + 256 * j) = pk4_fp8(v[j].x, v[j].y, v[j].z, v[j].w);
}
DEVFN void ln_mod(f32x4 (&v)[4], const f32x4 (&sc)[4], const f32x4 (&sh)[4]) {
    float mean, rstd; row_stats(v, mean, rstd);
#pragma unroll
    for (int j = 0; j < 4; ++j) v[j] = (v[j] - mean) * rstd * (sc[j] + 1.f) + sh[j];
}
DEVFN void ln_aff(f32x4 (&v)[4], const f32x4 (&g)[4], const f32x4 (&b)[4]) {
    float mean, rstd; row_stats(v, mean, rstd);
#pragma unroll
    for (int j = 0; j < 4; ++j) v[j] = (v[j] - mean) * rstd * g[j] + b[j];
}

DEVFN void ph_h1_rows(const Args& a, const Ctx& c) {
    const float* mod = (const float*)(a.ws + WS_MOD); bf16_t* HB = (bf16_t*)(a.ws + WS_HB);
    for (int base = c.gw * ROWS_PER_WAVE; base < NTOK; base += c.NGW * ROWS_PER_WAVE) {
        const float* mb = mod + (size_t)(base >> 11) * NMOD;
        f32x4 sc[4], sh[4]; vec_load(mb + DM, c.lane, sc); vec_load(mb, c.lane, sh);
        f32x4 cur[4], nxt[4]; vec_load(a.in[I_X] + (size_t)base * DM, c.lane, cur);
#pragma unroll 1
        for (int i = 0; i < ROWS_PER_WAVE; ++i) {
            const int m = base + i;
            if (i + 1 < ROWS_PER_WAVE) vec_load(a.in[I_X] + (size_t)(m + 1) * DM, c.lane, nxt);
            ln_mod(cur, sc, sh); f8row_store((unsigned char*)HB + (size_t)m * DM, c.lane, cur);
#pragma unroll
            for (int j = 0; j < 4; ++j) cur[j] = nxt[j];
        }
    }
}

DEVFN f32x4 reduce16(const float (&lg)[16]) {
    float t[8], u[4];
#pragma unroll
    for (int e = 0; e < 8; ++e) { auto rr = __builtin_amdgcn_permlane32_swap(__float_as_uint(lg[e]), __float_as_uint(lg[e + 8]), false, false); t[e] = __uint_as_float(rr[0]) + __uint_as_float(rr[1]); }
#pragma unroll
    for (int k = 0; k < 4; ++k) { auto rr = __builtin_amdgcn_permlane16_swap(__float_as_uint(t[k]), __float_as_uint(t[k + 4]), false, false); u[k] = __uint_as_float(rr[0]) + __uint_as_float(rr[1]); }
#pragma unroll
    for (int k = 0; k < 4; ++k) { u[k] = swz_xor_add(u[k], 1); u[k] = swz_xor_add(u[k], 2); u[k] = swz_xor_add(u[k], 4); u[k] = swz_xor_add(u[k], 8); }
    return (f32x4){u[0], u[1], u[2], u[3]};
}

DEVFN void ph_rows_c(const Args& a, const Ctx& c, int l, bool publish) {
    const float* mod = (const float*)(a.ws + WS_MOD) + (size_t)l * NB * NMOD;
    const bf16_t* Y = (const bf16_t*)(a.ws + WS_QKVP); const bf16_t* X2B = (const bf16_t*)(a.ws + WS_X2B);
    bf16_t* X1B = (bf16_t*)(a.ws + WS_X1B); bf16_t* HB = (bf16_t*)(a.ws + WS_HB);
    float* wr = (float*)c.lds;
    int* lcnt = (int*)(c.lds + 65536); int* lbase = lcnt + 32;
    int* rcls = lbase + 32; float* rw1 = (float*)(rcls + 8 * 64); float* rw2 = rw1 + 8 * 64; int* rrow = (int*)(rw2 + 8 * 64); float* lgs = (float*)(rrow + 8 * 64);
    for (int i = c.tid; i < DM * NE; i += 512) wr[(i & 15) * DM + (i >> 4)] = a.in[I_WR][i];
    if (c.tid < 32) lcnt[c.tid] = 0;
    __syncthreads();
    int nr = 0;
    for (int base = c.gw * ROWS_PER_WAVE; base < NTOK; base += c.NGW * ROWS_PER_WAVE) {
        const float* mb = mod + (size_t)(base >> 11) * NMOD;
        f32x4 g1[4], sc[4], sh[4];
        vec_load(mb + 2 * DM, c.lane, g1); vec_load(mb + 4 * DM, c.lane, sc); vec_load(mb + 3 * DM, c.lane, sh);
        f32x4 xc[4], xn[4]; u32x2 yc[4], yn[4];
        if (l == 0) vec_load(a.in[I_X] + (size_t)base * DM, c.lane, xc);
        else { u32x2 w[4]; bfrow_load(X2B + (size_t)base * DM, c.lane, w);
#pragma unroll
            for (int j = 0; j < 4; ++j) { xc[j].x = __uint_as_float(w[j].x); xc[j].y = __uint_as_float(w[j].y); } }
        bfrow_load(Y + (size_t)base * DM, c.lane, yc);
#pragma unroll 1
        for (int i = 0; i < ROWS_PER_WAVE; ++i) {
            const int m = base + i;
            if (i + 1 < ROWS_PER_WAVE) {
                if (l == 0) vec_load(a.in[I_X] + (size_t)(m + 1) * DM, c.lane, xn);
                else { u32x2 w[4]; bfrow_load(X2B + (size_t)(m + 1) * DM, c.lane, w);
#pragma unroll
                    for (int j = 0; j < 4; ++j) { xn[j].x = __uint_as_float(w[j].x); xn[j].y = __uint_as_float(w[j].y); } }
                bfrow_load(Y + (size_t)(m + 1) * DM, c.lane, yn);
            }
            f32x4 v[4];
#pragma unroll
            for (int j = 0; j < 4; ++j) { const f32x4 xv = (l == 0) ? xc[j] : bf4((u32x2){__float_as_uint(xc[j].x), __float_as_uint(xc[j].y)}); v[j] = xv * ALPHA + g1[j] * bf4(yc[j]); }
            { f32x4 lg[4], lb[4]; vec_load(a.in[I_LN1G] + l * DM, c.lane, lg); vec_load(a.in[I_LN1B] + l * DM, c.lane, lb); ln_aff(v, lg, lb); } bfrow_store(X1B + (size_t)m * DM, c.lane, v);
            ln_mod(v, sc, sh);
#pragma unroll
            for (int j = 0; j < 4; ++j) *(unsigned*)((unsigned char*)HB + (size_t)m * DM + 4 * c.lane + 256 * j) = pk4_fp8(v[j].x, v[j].y, v[j].z, v[j].w);
            float lg16[16];
#pragma unroll
            for (int e = 0; e < 16; ++e) lg16[e] = 0.f;
#pragma unroll
            for (int j = 0; j < 4; ++j)
#pragma unroll
                for (int e = 0; e < 16; ++e) { const f32x4 w = *(const f32x4*)(wr + e * DM + 4 * c.lane + 256 * j); lg16[e] += (v[j].x * w.x + v[j].y * w.y) + (v[j].z * w.z + v[j].w * w.w); }
            { const f32x4 uu = reduce16(lg16); if ((c.lane & 15) == 0) *(f32x4*)(lgs + (c.wave * 16 + i) * 16 + (c.lane >> 4) * 4) = uu; }
#pragma unroll
            for (int j = 0; j < 4; ++j) { xc[j] = xn[j]; yc[j] = yn[j]; }
        }
        LDS_WAIT();
        if (c.lane < ROWS_PER_WAVE) {
            float lg16[16], rb[16];
#pragma unroll
            for (int e = 0; e < 16; ++e) rb[e] = a.in[I_RB][e];
#pragma unroll
            for (int q = 0; q < 4; ++q) { const f32x4 t = *(const f32x4*)(lgs + (c.wave * 16 + c.lane) * 16 + 4 * q); lg16[4 * q] = t.x; lg16[4 * q + 1] = t.y; lg16[4 * q + 2] = t.z; lg16[4 * q + 3] = t.w; }
            float mx = lg16[0];
#pragma unroll
            for (int e = 1; e < 16; ++e) mx = fmaxf(mx, lg16[e]);
            float sum = 0.f, scr[16];
#pragma unroll
            for (int e = 0; e < 16; ++e) { scr[e] = __expf(lg16[e] - mx); sum += scr[e]; }
            const float isum = 1.f / sum;
#pragma unroll
            for (int e = 0; e < 16; ++e) scr[e] *= isum;
            float bestg = -3.4e38f; int gb = 0, bi1 = 0, bi2 = 1; float bw1 = 0.f, bw2 = 0.f;
#pragma unroll
            for (int g = 0; g < 4; ++g) {
                float m1 = scr[4 * g] + rb[4 * g], s1 = scr[4 * g]; int i1 = 0;
#pragma unroll
                for (int q = 1; q < 4; ++q) { const float sv = scr[4 * g + q] + rb[4 * g + q]; const bool ok = sv > m1; m1 = ok ? sv : m1; s1 = ok ? scr[4 * g + q] : s1; i1 = ok ? q : i1; }
                float m2 = -3.4e38f, s2 = 0.f; int i2 = 0;
#pragma unroll
                for (int q = 0; q < 4; ++q) { const float sv = scr[4 * g + q] + rb[4 * g + q]; const bool ok = (q != i1) && sv > m2; m2 = ok ? sv : m2; s2 = ok ? scr[4 * g + q] : s2; i2 = ok ? q : i2; }
                const float gs = m1 + m2; const bool better = gs > bestg;
                bestg = better ? gs : bestg; gb = better ? g : gb; bi1 = better ? i1 : bi1; bi2 = better ? i2 : bi2; bw1 = better ? s1 : bw1; bw2 = better ? s2 : bw2;
            }
            const float inv = 1.f / (bw1 + bw2);
            const int lo = bi1 < bi2 ? bi1 : bi2, hi2 = bi1 < bi2 ? bi2 : bi1;
            const float wlo = (bi1 < bi2 ? bw1 : bw2) * inv, whi = (bi1 < bi2 ? bw2 : bw1) * inv;
            const int pidx = lo == 0 ? hi2 - 1 : (lo == 1 ? hi2 + 1 : 5);
            const int slot = c.wave * 64 + nr + c.lane;
            rcls[slot] = gb * 6 + pidx; rw1[slot] = wlo; rw2[slot] = whi; rrow[slot] = base + c.lane;
        }
        nr += ROWS_PER_WAVE;
        LDS_WAIT();
    }
    LDS_WAIT();
    if (!publish) return;
    int rank = 0, cls = 0;
    if (c.lane < nr) { cls = rcls[c.wave * 64 + c.lane]; rank = atomicAdd(&lcnt[cls], 1); }
    __syncthreads();
    if (c.tid < NCLS) lbase[c.tid] = (int)__hip_atomic_fetch_add((unsigned*)(a.ws + WS_CTL) + CW_CNT + l * 32 + c.tid, (unsigned)lcnt[c.tid], RLX_AGENT);
    __syncthreads();
    if (c.lane < nr) {
        const int pos = lbase[cls] + rank;
        ((int*)(a.ws + WS_LIST))[(size_t)cls * LISTCAP + pos] = rrow[c.wave * 64 + c.lane];
        float* rw = (float*)(a.ws + WS_RW) + ((size_t)cls * LISTCAP + pos) * 2;
        rw[0] = rw1[c.wave * 64 + c.lane]; rw[1] = rw2[c.wave * 64 + c.lane];
    }
}

DEVFN void ph_rows_g(const Args& a, const Ctx& c, int l) {
    const float* mod = (const float*)(a.ws + WS_MOD) + (size_t)l * NB * NMOD;
    const bf16_t* X1B = (const bf16_t*)(a.ws + WS_X1B); const bf16_t* Y2 = (const bf16_t*)(a.ws + WS_AD);
    bf16_t* X2B = (bf16_t*)(a.ws + WS_X2B); bf16_t* HB = (bf16_t*)(a.ws + WS_HB);
    for (int base = c.gw * ROWS_PER_WAVE; base < NTOK; base += c.NGW * ROWS_PER_WAVE) {
        const float* mb = mod + (size_t)(base >> 11) * NMOD; const float* mb1 = mb + (size_t)NB * NMOD;
        f32x4 g2[4], lg[4], lb[4], sc[4], sh[4];
        vec_load(mb + 5 * DM, c.lane, g2); vec_load(a.in[I_LN2G] + l * DM, c.lane, lg); vec_load(a.in[I_LN2B] + l * DM, c.lane, lb);
        if (l == 0) { vec_load(mb1 + DM, c.lane, sc); vec_load(mb1, c.lane, sh); }
        u32x2 xc[4], xn[4], yc[4], yn[4];
        bfrow_load(X1B + (size_t)base * DM, c.lane, xc); bfrow_load(Y2 + (size_t)base * DM, c.lane, yc);
#pragma unroll 1
        for (int i = 0; i < ROWS_PER_WAVE; ++i) {
            const int m = base + i;
            if (i + 1 < ROWS_PER_WAVE) { bfrow_load(X1B + (size_t)(m + 1) * DM, c.lane, xn); bfrow_load(Y2 + (size_t)(m + 1) * DM, c.lane, yn); }
            f32x4 v[4];
#pragma unroll
            for (int j = 0; j < 4; ++j) v[j] = bf4(xc[j]) * ALPHA + g2[j] * bf4(yc[j]);
            ln_aff(v, lg, lb);
            if (l == 0) { bfrow_store(X2B + (size_t)m * DM, c.lane, v); ln_mod(v, sc, sh); f8row_store((unsigned char*)HB + (size_t)m * DM, c.lane, v); }
            else {
#pragma unroll
                for (int j = 0; j < 4; ++j) *(f32x4*)(a.out + (size_t)m * DM + 4 * c.lane + 256 * j) = v[j]; }
#pragma unroll
            for (int j = 0; j < 4; ++j) { xc[j] = xn[j]; yc[j] = yn[j]; }
        }
    }
}

constexpr int MOETAB_OFF = 131072 + 512;
DEVFN void ph_inproj_fast(const Args& a, const Ctx& c, int l, bool dummy_kbar) {
    pg8::DenseSched S; S.so.init(NTOK, DIN, c.G, c.bid); S.A = (const char*)(a.ws + WS_HB); S.Bt = (const char*)(a.ws + WS_WIN) + (size_t)l * DIN * DM; S.lda = DM; S.ldb = DM;
    const pg8::EpiInproj E{(bf16_t*)(a.ws + WS_QKVP), (const float*)(a.ws + WS_ROPE), (dummy_kbar ? (float*)(a.ws + WS_RW) : (float*)(a.ws + WS_KBAR)) + (size_t)l * NB * NH * NBLK * HD};
    pg8::gemm_phase2<pg8::EpiInproj, pg8::DenseSched, true, true, false, true, 127 - 5, 127>(c.lds3, DM, DM, S, E, c.tid);
}
DEVFN void ph_wout_fast(const Args& a, const Ctx& c, int l) {
    pg8::DenseSched S; S.so.init(NTOK, DM, c.G, c.bid); S.A = (const char*)(a.ws + WS_AD); S.Bt = (const char*)(a.ws + WS_WOUT) + (size_t)l * DM * DM; S.lda = DM; S.ldb = DM;
    const pg8::EpiBf16<0> E{(bf16_t*)(a.ws + WS_QKVP), DM, nullptr, 0, 0, 1.f};
    pg8::gemm_phase2<pg8::EpiBf16<0>, pg8::DenseSched, true, true, false, true, 127 - 5, 127 - 5, true, 127 - 7, 127>(c.lds3, DM, DM, S, E, c.tid);
}
DEVFN void moe_table_lds(const Args& a, const Ctx& c, int l) {
    int* cnt = (int*)(c.lds + MOETAB_OFF); int* tp = cnt + 32;
    if (c.tid < NCLS) cnt[c.tid] = (int)__hip_atomic_load((unsigned*)(a.ws + WS_CTL) + CW_CNT + l * 32 + c.tid, RLX_AGENT);
    __syncthreads();
    if (c.tid == 0) { int s = 0; for (int k = 0; k < NCLS; ++k) { tp[k] = s; s += (cnt[k] + 255) >> 8; } tp[NCLS] = s; }
    __syncthreads();
}
DEVFN void ph_gateup_fast(const Args& a, const Ctx& c, int l) {
    moe_table_lds(a, c, l);
    pg8::GateUpSched S; S.cnt = (const LAS int*)(c.lds3 + MOETAB_OFF); S.tp = S.cnt + 32; S.npn_shift = 3; S.nunits = S.tp[NCLS] * 8; S.G = c.G; S.c = c.bid;
    S.HB = (const char*)(a.ws + WS_HB); S.list = (const int*)(a.ws + WS_LIST); S.W = (const char*)(a.ws + WS_WGU) + (size_t)l * NE * DM * DM;
    const pg8::EpiGateUp E{(unsigned char*)(a.ws + WS_QKVP), (const float*)(a.ws + WS_RW)};
    pg8::gemm_phase2<pg8::EpiGateUp, pg8::GateUpSched, true, true, false, true, 127 - 5, 127>(c.lds3, DM, DM, S, E, c.tid);
}
DEVFN void ph_down_fast(const Args& a, const Ctx& c, int l) {
    moe_table_lds(a, c, l);
    pg8::DownSched S; S.cnt = (const LAS int*)(c.lds3 + MOETAB_OFF); S.tp = S.cnt + 32; S.npn_shift = 2; S.nunits = S.tp[NCLS] * 4; S.G = c.G; S.c = c.bid;
    S.ACT = (const char*)(a.ws + WS_QKVP); S.W = (const char*)(a.ws + WS_WD) + (size_t)l * NE * DM * DE;
    const pg8::EpiDown E{(bf16_t*)(a.ws + WS_AD), (const int*)(a.ws + WS_LIST)};
    pg8::gemm_phase2<pg8::EpiDown, pg8::DownSched, true, true, true, true, 127 - 5, 127 - 3>(c.lds3, DM, DE, S, E, c.tid);
}

#ifndef MK_N_LAUNCHES
#define MK_N_LAUNCHES 1
#endif
constexpr int RING_BYTES = 131072, LDSCTL_OFF = RING_BYTES, MISC_OFF = LDSCTL_OFF + 320, LDS_BYTES = 147456;
constexpr int PH_PER_LAYER = 7, NPHASE = 2 + 2 * PH_PER_LAYER;
constexpr int CW_BAR = 4096;
static_assert((CW_BAR + XCD_BAR_WORDS) * 4 <= (int)CTL_ZERO_BYTES, "CTL");

__global__ void __launch_bounds__(512, 2) fwd(Args a) {
    extern __shared__ __attribute__((aligned(16))) unsigned char lds[];
    const int wave_s = __builtin_amdgcn_readfirstlane(threadIdx.x >> 6);
#define MKTID() (wave_s * 64 + lane_id_volatile())
#define MKCTX() Args al = a; { size_t z_ = 0; asm volatile("" : "+s"(z_)); al.ws = a.ws + z_; } Ctx c; {     int t_ = MKTID(); asm volatile("" : "+v"(t_)); c.lds = lds; c.lds3 = (LAS unsigned char*)lds; c.tid = t_; c.lane = t_ & 63; c.wave = __builtin_amdgcn_readfirstlane(t_ >> 6); c.G = gridDim.x; c.bid = blockIdx.x; c.gw = c.bid * 8 + c.wave; c.NGW = c.G * 8; }
    const int lo = a.ph_lo, hi = a.ph_hi;
    const bool one = (hi - lo) > 1;
    for (int u = threadIdx.x; u < (LDS_BYTES - LDSCTL_OFF) / 4; u += 512) ((LAS unsigned*)((LAS unsigned char*)lds + LDSCTL_OFF))[u] = 0u;
    __syncthreads();
    XcdBarrier bar; bar.bar = (unsigned*)(a.ws + WS_CTL) + CW_BAR; bar.x = 0; bar.st = nullptr;
    if (one) bar = xcd_barrier_post((unsigned*)(a.ws + WS_CTL) + CW_BAR, (volatile LAS unsigned*)((LAS unsigned char*)lds + MISC_OFF) + 8);
#ifndef REP_PHASE
#define REP_PHASE -1
#endif
#define IN(k) (lo <= (k) && (k) < hi)
#define SEAM(k) do { if (IN(k) && IN((k) + 1)) { XcdBarrier bl_ = bar; { size_t z_ = 0; unsigned x_ = bar.x; asm volatile("" : "+s"(z_), "+s"(x_)); bl_.bar = bar.bar + z_; bl_.x = x_; } xcd_barrier(bl_, MKTID() == 0); } } while (0)
    if (IN(0)) { MKCTX(); ph_prologue(al, c); if (REP_PHASE == 0) { __syncthreads(); ph_prologue(al, c); } SEAM(0); }
    if (IN(1)) { MKCTX(); ph_h1_rows(al, c); if (REP_PHASE == 1) ph_h1_rows(al, c); SEAM(1); }
    {
        constexpr int l = 0; constexpr int p0 = 2 + l * PH_PER_LAYER;
        if (IN(p0 + 0)) { MKCTX(); ph_inproj_fast(al, c, l, false); if (REP_PHASE == 10) { __syncthreads(); ph_inproj_fast(al, c, l, true); } SEAM(p0 + 0); }
        if (IN(p0 + 1)) {
            { MKCTX(); ph_pool(al, c); }
            __syncthreads();
            const attn_body::AttnTensors AT{(const attn_body::bf16*)(a.ws + WS_QKVP), (const attn_body::bf16*)(a.ws + WS_QKVP) + 512, (const attn_body::bf16*)(a.ws + WS_QKVP) + 1024,
                                            (attn_body::bf16*)(a.ws + WS_AD), (const float*)(a.ws + WS_KBAR) + (size_t)l * NB * NH * NBLK * HD};
            const attn_body::StaticOrder S((int)gridDim.x, (int)blockIdx.x);
            attn_body::attn_phase<attn_body::StaticOrder>((char*)lds, AT, S, MKTID());
            if (REP_PHASE == 11) attn_body::attn_phase<attn_body::StaticOrder>((char*)lds, AT, S, MKTID());
            if (REP_PHASE == 17) { __syncthreads(); MKCTX(); ph_pool(al, c); }
            SEAM(p0 + 1);
        }
        if (IN(p0 + 2)) { MKCTX(); ph_wout_fast(al, c, l); if (REP_PHASE == 12) { __syncthreads(); ph_wout_fast(al, c, l); } SEAM(p0 + 2); }
        if (IN(p0 + 3)) { MKCTX(); if (REP_PHASE == 13) { ph_rows_c(al, c, l, false); __syncthreads(); } ph_rows_c(al, c, l, true); SEAM(p0 + 3); }
        if (IN(p0 + 4)) { MKCTX(); ph_gateup_fast(al, c, l); if (REP_PHASE == 14) { __syncthreads(); ph_gateup_fast(al, c, l); } SEAM(p0 + 4); }
        if (IN(p0 + 5)) { MKCTX(); ph_down_fast(al, c, l); if (REP_PHASE == 15) { __syncthreads(); ph_down_fast(al, c, l); } SEAM(p0 + 5); }
        if (IN(p0 + 6)) { MKCTX(); ph_rows_g(al, c, l); if (REP_PHASE == 16) ph_rows_g(al, c, l); SEAM(p0 + 6); }
    }
    {
        constexpr int l = 1; constexpr int p0 = 2 + l * PH_PER_LAYER;
        if (IN(p0 + 0)) { MKCTX(); ph_inproj_fast(al, c, l, false); if (REP_PHASE == 10) { __syncthreads(); ph_inproj_fast(al, c, l, true); } SEAM(p0 + 0); }
        if (IN(p0 + 1)) {
            { MKCTX(); ph_pool(al, c); }
            __syncthreads();
            const attn_body::AttnTensors AT{(const attn_body::bf16*)(a.ws + WS_QKVP), (const attn_body::bf16*)(a.ws + WS_QKVP) + 512, (const attn_body::bf16*)(a.ws + WS_QKVP) + 1024,
                                            (attn_body::bf16*)(a.ws + WS_AD), (const float*)(a.ws + WS_KBAR) + (size_t)l * NB * NH * NBLK * HD};
            const attn_body::StaticOrder S((int)gridDim.x, (int)blockIdx.x);
            attn_body::attn_phase<attn_body::StaticOrder>((char*)lds, AT, S, MKTID());
            if (REP_PHASE == 11) attn_body::attn_phase<attn_body::StaticOrder>((char*)lds, AT, S, MKTID());
            if (REP_PHASE == 17) { __syncthreads(); MKCTX(); ph_pool(al, c); }
            SEAM(p0 + 1);
        }
        if (IN(p0 + 2)) { MKCTX(); ph_wout_fast(al, c, l); if (REP_PHASE == 12) { __syncthreads(); ph_wout_fast(al, c, l); } SEAM(p0 + 2); }
        if (IN(p0 + 3)) { MKCTX(); if (REP_PHASE == 13) { ph_rows_c(al, c, l, false); __syncthreads(); } ph_rows_c(al, c, l, true); SEAM(p0 + 3); }
        if (IN(p0 + 4)) { MKCTX(); ph_gateup_fast(al, c, l); if (REP_PHASE == 14) { __syncthreads(); ph_gateup_fast(al, c, l); } SEAM(p0 + 4); }
        if (IN(p0 + 5)) { MKCTX(); ph_down_fast(al, c, l); if (REP_PHASE == 15) { __syncthreads(); ph_down_fast(al, c, l); } SEAM(p0 + 5); }
        if (IN(p0 + 6)) { MKCTX(); ph_rows_g(al, c, l); if (REP_PHASE == 16) ph_rows_g(al, c, l); SEAM(p0 + 6); }
    }
#undef IN
#undef SEAM
}

extern "C" void kernel_launch(void* const* d_in, const int* in_sizes, int n_in, void* d_out, int out_size, void* d_ws, size_t ws_size, hipStream_t stream) {
    static int grid = 0;
    if (grid == 0) {
        if (n_in != 17 || out_size != NTOK * DM || ws_size < WS_END) { fprintf(stderr, "kernel_launch: unexpected problem (n_in %d out %d ws %zu)\n", n_in, out_size, ws_size); grid = -1; return; }
        if (hipFuncSetAttribute((const void*)fwd, hipFuncAttributeMaxDynamicSharedMemorySize, LDS_BYTES) != hipSuccess) { fprintf(stderr, "kernel_launch: hipFuncSetAttribute failed\n"); grid = -1; return; }
        int dev = 0, cus = 0, per_cu = 0;
        (void)hipGetDevice(&dev); (void)hipDeviceGetAttribute(&cus, hipDeviceAttributeMultiprocessorCount, dev);
        if (hipOccupancyMaxActiveBlocksPerMultiprocessor(&per_cu, (const void*)fwd, 512, LDS_BYTES) != hipSuccess || per_cu < 1) fprintf(stderr, "kernel_launch: occupancy query reports %d workgroups per CU\n", per_cu);
        (void)hipGetLastError();
        grid = cus > 0 ? cus : 256;
    }
    if (grid < 0) return;
    (void)hipMemsetAsync((char*)d_ws + WS_CTL, 0, CTL_ZERO_BYTES, stream);
    Args a{};
    for (int i = 0; i < 17; ++i) a.in[i] = (const float*)d_in[i];
    a.out = (float*)d_out; a.ws = (unsigned char*)d_ws;
#if MK_N_LAUNCHES == 1
    a.ph_lo = 0; a.ph_hi = NPHASE; hipLaunchKernelGGL(fwd, dim3(grid), dim3(512), LDS_BYTES, stream, a);
#else
    for (int p = 0; p < NPHASE; ++p) { a.ph_lo = p; a.ph_hi = p + 1; hipLaunchKernelGGL(fwd, dim3(grid), dim3(512), LDS_BYTES, stream, a); }
#endif
}
```

```cpp
#include <hip/hip_runtime.h>
#include <cstdint>
#include <cstdio>

constexpr int NB = 16, SEQ = 2048, DM = 1024, NTOK = NB * SEQ, DIN = 2048, NH = 8, HD = 64, NBLK = 8, MBLK = 256;
constexpr int NE = 16, NCLS = 24, DE = 512, NMOD = 6 * DM;
constexpr float ALPHA = 1.41421356237309515f, LN_EPS = 1e-5f;
constexpr float QSCALE = 0.125f * 1.4426950408889634f;
constexpr int LISTCAP = NTOK;

constexpr size_t MiB = 1u << 20;
constexpr size_t WS_CTL = 0, CTL_ZERO_BYTES = 1 * MiB;
constexpr size_t WS_MOD = 1 * MiB;
constexpr size_t WS_ROPE = 2 * MiB;
constexpr size_t WS_KBAR = 2 * MiB + 256 * 1024;
constexpr size_t WS_LIST = 3 * MiB;
constexpr size_t WS_RW = 6 * MiB;
constexpr size_t WS_WIN = 12 * MiB;
constexpr size_t WS_WOUT = 20 * MiB;
constexpr size_t WS_WGU = 24 * MiB;
constexpr size_t WS_WD = 88 * MiB;
constexpr size_t WS_HB = 120 * MiB;
constexpr size_t WS_QKVP = 184 * MiB;
constexpr size_t WS_AD = 312 * MiB;
constexpr size_t WS_X1 = 376 * MiB;
constexpr size_t WS_END = 504 * MiB;
constexpr int CW_TMO = 0, CW_CNT = 64;

typedef unsigned short bf16_t;
typedef short bf16x8 __attribute__((ext_vector_type(8)));
typedef float f32x4 __attribute__((ext_vector_type(4)));
typedef float f32x16 __attribute__((ext_vector_type(16)));
typedef unsigned u32x4 __attribute__((ext_vector_type(4)));
typedef unsigned u32x2 __attribute__((ext_vector_type(2)));

#define DEVFN __device__ __forceinline__
#define LDS_WAIT() asm volatile("s_waitcnt lgkmcnt(0)" ::: "memory")
#define RLX_AGENT __ATOMIC_RELAXED, __HIP_MEMORY_SCOPE_AGENT

DEVFN float bf_lo(unsigned w) { return __uint_as_float(w << 16); }
DEVFN float bf_hi(unsigned w) { return __uint_as_float(w & 0xffff0000u); }
DEVFN float bf2f(bf16_t v) { return __uint_as_float((unsigned)v << 16); }
DEVFN unsigned f2bf(float f) { unsigned u = __float_as_uint(f); return (u + 0x7fffu + ((u >> 16) & 1u)) >> 16; }
DEVFN unsigned pk2(float lo, float hi) { return f2bf(lo) | (f2bf(hi) << 16); }
DEVFN unsigned pk4_fp8(float a, float b, float c, float d) {
    a = __builtin_amdgcn_fmed3f(a, -448.f, 448.f); b = __builtin_amdgcn_fmed3f(b, -448.f, 448.f); c = __builtin_amdgcn_fmed3f(c, -448.f, 448.f); d = __builtin_amdgcn_fmed3f(d, -448.f, 448.f);
    unsigned w = 0u; w = __builtin_amdgcn_cvt_pk_fp8_f32(a, b, w, false); w = __builtin_amdgcn_cvt_pk_fp8_f32(c, d, w, true); return w; }
DEVFN int crow(int r, int hi) { return (r & 3) + 8 * (r >> 2) + 4 * hi; }
#define SWZ_XOR(m) (0x1f | ((m) << 10))
DEVFN float swz_xor_add(float v, const int m) {
    switch (m) {
        case 1: return v + __int_as_float(__builtin_amdgcn_ds_swizzle(__float_as_int(v), SWZ_XOR(1)));
        case 2: return v + __int_as_float(__builtin_amdgcn_ds_swizzle(__float_as_int(v), SWZ_XOR(2)));
        case 4: return v + __int_as_float(__builtin_amdgcn_ds_swizzle(__float_as_int(v), SWZ_XOR(4)));
        case 8: return v + __int_as_float(__builtin_amdgcn_ds_swizzle(__float_as_int(v), SWZ_XOR(8)));
        default: return v + __int_as_float(__builtin_amdgcn_ds_swizzle(__float_as_int(v), SWZ_XOR(16)));
    }
}
DEVFN float half_swap_add(float v) { auto rr = __builtin_amdgcn_permlane32_swap(__float_as_uint(v), __float_as_uint(v), false, false); return __uint_as_float(rr[0]) + __uint_as_float(rr[1]); }
DEVFN float wave_sum(float v) {
    v = swz_xor_add(v, 1); v = swz_xor_add(v, 2); v = swz_xor_add(v, 4); v = swz_xor_add(v, 8); v = swz_xor_add(v, 16);
    return half_swap_add(v);
}
__host__ __device__ __forceinline__ int inproj_lgroup(int P) { return P < 16 ? (P >> 2) * 8 + (P & 3) * 2 : ((P - 16) >> 2) * 8 + ((P - 16) & 3) * 2 + 1; }
__host__ __device__ __forceinline__ int inproj_nlog(int n) { return (n & ~255) + inproj_lgroup((n & 255) >> 3) * 8 + (n & 7); }

#define GAS __attribute__((address_space(1)))
#define LAS __attribute__((address_space(3)))
typedef GAS unsigned gu32;
namespace pg8 {
#define PG8_LAS __attribute__((address_space(3)))
typedef unsigned short bf16_t;
typedef short bf16x8 __attribute__((ext_vector_type(8)));
typedef float f32x4 __attribute__((ext_vector_type(4)));
typedef unsigned u32x4 __attribute__((ext_vector_type(4)));
constexpr int BM = 256, BK = 64, HALF = 128, HTB = HALF * BK * 2  , STAGE_BYTES = 8 * HTB, NXCD = 8, WGM = 8;

__host__ __device__ __forceinline__ int lds_byte(int r, int c) { const int st = (r >> 4) * 2 + (c >> 5), rr = r & 15, cc = c & 31, ob = rr * 64 + cc * 2; return st * 1024 + (ob ^ (((ob >> 9) & 1) << 5)); }
__host__ __device__ __forceinline__ void stage_rc(int b, int& R, int& C) { const int st = b / 1024, sb = b % 1024, swz = sb ^ (((sb >> 9) & 1) << 5); R = (st >> 1) * 16 + swz / 64; C = (st & 1) * 32 + (swz % 64) / 2; }
__host__ __device__ __forceinline__ int perm32(int rho) { const int n = rho >> 4, i = rho & 15; return 8 * (i >> 2) + 4 * n + (i & 3); }

struct Unit { int pm, pn; };
struct Gemm { const bf16_t* A; const bf16_t* Bt; int M, N, K; };

struct StaticOrder {
    int nM, nN, nwg, G, c;
    __host__ __device__ void init(int M, int N, int G_, int c_) { nM = M / BM; nN = N / BM; nwg = nM * nN; G = G_; c = c_; }
    __host__ __device__ bool next(int i, Unit& u) const {
        const long L = (long)i * G + c; if (L >= nwg) return false;
        int wgid = (int)L; { const int q = nwg / NXCD, r = nwg % NXCD, xcd = wgid % NXCD, off = wgid / NXCD; wgid = (xcd < r ? xcd * (q + 1) : r * (q + 1) + (xcd - r) * q) + off; }
        const int nig = WGM * nN, gid = wgid / nig, fm = gid * WGM, gsz = (nM - fm) < WGM ? (nM - fm) : WGM;
        u.pm = fm + ((wgid % nig) % gsz); u.pn = (wgid % nig) / gsz; return true;
    }
    __device__ __forceinline__ void a_ready(const Unit&) const {}
    __device__ __forceinline__ void done(const Unit&) const {}
};

__device__ __forceinline__ unsigned cvt_pk_bf16(float lo, float hi) { unsigned r; asm volatile("v_cvt_pk_bf16_f32 %0, %1, %2" : "=v"(r) : "v"(lo), "v"(hi)); return r; }
typedef float f32x2 __attribute__((ext_vector_type(2)));
__device__ __forceinline__ f32x2 gelu_pk(f32x2 v) {
    const f32x2 av = __builtin_elementwise_abs(v), d = av * 0.2316418882f + 1.0f;
    f32x2 t; t.x = __builtin_amdgcn_rcpf(d.x); t.y = __builtin_amdgcn_rcpf(d.y);
    f32x2 q = t * 0.5307027145f + (-0.7265760135f); q = q * t + 0.7107068705f; q = q * t + (-0.142248368f); q = q * t + 0.127414796f; q = q * t;
    const f32x2 s = (v * v) * (-0.72134752044f);
    f32x2 e; e.x = __builtin_amdgcn_exp2f(s.x); e.y = __builtin_amdgcn_exp2f(s.y);
    const f32x2 m = v * (q * e), r = v - m;
    f32x2 o; o.x = v.x < 0.f ? m.x : r.x; o.y = v.y < 0.f ? m.y : r.y; return o;
}

template <int ACT  > struct EpiBf16 {
    static constexpr bool PERM = true, AFTER_DRAIN = false; static_assert(ACT == 0 || ACT == 1, "EpiBf16: ACT is 0 (none) or 1 (gelu_pk)");
    bf16_t* O; int ldc; const float* bias; int split_cols; size_t split_stride; float scale0;
    __device__ __forceinline__ void operator()(const f32x4 (&acc)[2][2][4][2], const Unit& u, int wr, int wc, int fr, int fq) const {
        const int row0 = u.pm * BM + wr * 64 + fr; int colt = u.pn * BM; bf16_t* base = O;
        float sc = 1.f; if (split_cols) { const int t = colt / split_cols; base += (size_t)t * split_stride; colt -= t * split_cols; if (t == 0) sc = scale0; }
        const int col0 = colt + wc * 32 + 8 * fq, bcol0 = u.pn * BM + wc * 32 + 8 * fq;
        f32x4 bv[2][2];
#pragma unroll
        for (int bj = 0; bj < 2; ++bj)
#pragma unroll
            for (int n = 0; n < 2; ++n) bv[bj][n] = bias ? *(const f32x4*)(bias + bcol0 + bj * HALF + 4 * n) : (f32x4){0.f, 0.f, 0.f, 0.f};
#pragma unroll
        for (int ai = 0; ai < 2; ++ai)
#pragma unroll
            for (int m = 0; m < 4; ++m) { bf16_t* rowp = base + (size_t)(row0 + ai * HALF + m * 16) * ldc + col0;
#pragma unroll
                for (int bj = 0; bj < 2; ++bj) { f32x4 v0 = acc[ai][bj][m][0] + bv[bj][0], v1 = acc[ai][bj][m][1] + bv[bj][1];
                    if (ACT == 1) { f32x2 a = gelu_pk((f32x2){v0[0], v0[1]}), b = gelu_pk((f32x2){v0[2], v0[3]}), c = gelu_pk((f32x2){v1[0], v1[1]}), d = gelu_pk((f32x2){v1[2], v1[3]});
                        v0 = (f32x4){a.x, a.y, b.x, b.y}; v1 = (f32x4){c.x, c.y, d.x, d.y}; }
                    v0 = v0 * sc; v1 = v1 * sc; u32x4 w; w.x = cvt_pk_bf16(v0[0], v0[1]); w.y = cvt_pk_bf16(v0[2], v0[3]); w.z = cvt_pk_bf16(v1[0], v1[1]); w.w = cvt_pk_bf16(v1[2], v1[3]);
                    *(u32x4*)(rowp + bj * HALF) = w; } }
    }
};

struct PanelStats {
    unsigned* xbuf;
    unsigned* cnt;
    unsigned* tmo;
    int ntn; float eps;
    unsigned code;
    __device__ __forceinline__ bool run(const f32x4 (&v)[2][2][4][2], const Unit& u, int wr, int wc, int fr, int fq, PG8_LAS unsigned char* lds, int wid, int lane) const {
        typedef float f32x2v __attribute__((ext_vector_type(2)));
        PG8_LAS f32x2v* P = (PG8_LAS f32x2v*)lds;
        PG8_LAS f32x2v* S = (PG8_LAS f32x2v*)(lds + 8192);
        PG8_LAS unsigned* flag = (PG8_LAS unsigned*)(lds + 8192 + 2048);
#pragma unroll
        for (int ai = 0; ai < 2; ++ai)
#pragma unroll
            for (int m = 0; m < 4; ++m) {
                float s = 0.f;
#pragma unroll
                for (int bj = 0; bj < 2; ++bj)
#pragma unroll
                    for (int n = 0; n < 2; ++n) { const f32x4 x = v[ai][bj][m][n]; s += (x[0] + x[1]) + (x[2] + x[3]); }
                s += __shfl_xor(s, 16); s += __shfl_xor(s, 32);
                const float mw = s * (1.0f / 64.0f); float q = 0.f;
#pragma unroll
                for (int bj = 0; bj < 2; ++bj)
#pragma unroll
                    for (int n = 0; n < 2; ++n) { const f32x4 d = v[ai][bj][m][n] - mw; q += (d[0] * d[0] + d[1] * d[1]) + (d[2] * d[2] + d[3] * d[3]); }
                q += __shfl_xor(q, 16); q += __shfl_xor(q, 32);
                if (fq == 0) P[(ai * HALF + wr * 64 + m * 16 + fr) * 4 + wc] = (f32x2v){mw, q};
            }
        asm volatile("s_waitcnt lgkmcnt(0)" ::: "memory"); __builtin_amdgcn_s_barrier(); asm volatile("" ::: "memory");
#if defined(BROKEN_EXCHANGE_NO_WAIT)
#warning BROKEN CONTROL BUILD: the row-statistics exchange does not wait; results are wrong by design
        if (blockIdx.x >= 64) { const long long t0_ = clock64(); while (clock64() - t0_ < 60000) __builtin_amdgcn_s_sleep(8); }
#endif
        const int row = wid * 32 + (lane & 31);
        if (lane < 32) {
            const f32x2v a = P[row * 4 + 0], b = P[row * 4 + 1], c = P[row * 4 + 2], d = P[row * 4 + 3];
            const float mt = (a.x + b.x + c.x + d.x) * 0.25f;
            const float da = a.x - mt, db = b.x - mt, dc = c.x - mt, dd = d.x - mt;
            const float m2 = (a.y + b.y) + (c.y + d.y) + 64.0f * ((da * da + db * db) + (dc * dc + dd * dd));
            unsigned long long* slot = (unsigned long long*)xbuf + ((size_t)(u.pm * BM + row) * 4 + u.pn);
            __hip_atomic_store(slot, ((unsigned long long)__float_as_uint(m2) << 32) | __float_as_uint(mt), __ATOMIC_RELAXED, __HIP_MEMORY_SCOPE_AGENT);
        }
        asm volatile("s_waitcnt vmcnt(0)" ::: "memory");
        if (lane == 0) __hip_atomic_fetch_add(cnt + 64 * u.pm, 1u, __ATOMIC_RELAXED, __HIP_MEMORY_SCOPE_AGENT);
        if (wid == 0) {
            bool dead = false; const unsigned long long t0 = __builtin_amdgcn_s_memrealtime(); const unsigned want = 8u * (unsigned)ntn;
            for (;;) {
#if defined(BROKEN_EXCHANGE_NO_WAIT)
                break;
#endif
                if ((unsigned)__builtin_amdgcn_readfirstlane(__hip_atomic_load(cnt + 64 * u.pm, __ATOMIC_RELAXED, __HIP_MEMORY_SCOPE_AGENT)) >= want) break;
                if (__builtin_amdgcn_s_memrealtime() - t0 > 2000000ull) {
                    if (lane == 0) { unsigned expect = 0u; __hip_atomic_compare_exchange_strong(tmo + 1, &expect, code | (unsigned)(u.pm & 0xff), __ATOMIC_RELAXED, __ATOMIC_RELAXED, __HIP_MEMORY_SCOPE_AGENT);
                                     __hip_atomic_store(tmo, 1u, __ATOMIC_RELAXED, __HIP_MEMORY_SCOPE_AGENT); }
                    dead = true; break; }
                __builtin_amdgcn_s_sleep(2);
            }
            __builtin_amdgcn_fence(__ATOMIC_ACQUIRE, "agent");
            if (lane == 0) flag[0] = dead ? 1u : 0u;
        }
        asm volatile("s_waitcnt vmcnt(0) lgkmcnt(0)" ::: "memory"); __builtin_amdgcn_s_barrier(); asm volatile("" ::: "memory");
        const bool bad = flag[0] != 0u;
        if (lane < 32) {
            const unsigned long long* slot = (const unsigned long long*)xbuf + (size_t)(u.pm * BM + row) * 4; float mt[4], m2[4]; float ms = 0.f;
#pragma unroll
            for (int t = 0; t < 4; ++t) { if (t < ntn) { const unsigned long long w = __hip_atomic_load(slot + t, __ATOMIC_RELAXED, __HIP_MEMORY_SCOPE_AGENT); mt[t] = __uint_as_float((unsigned)w); m2[t] = __uint_as_float((unsigned)(w >> 32)); } else { mt[t] = 0.f; m2[t] = 0.f; } ms += mt[t]; }
            const float mean = ms / (float)ntn; float q = 0.f;
#pragma unroll
            for (int t = 0; t < 4; ++t) if (t < ntn) { const float dm = mt[t] - mean; q += m2[t] + 256.0f * dm * dm; }
            S[row] = (f32x2v){mean, 1.0f / sqrtf(q / (256.0f * (float)ntn) + eps)};
        }
        asm volatile("s_waitcnt lgkmcnt(0)" ::: "memory"); __builtin_amdgcn_s_barrier(); asm volatile("" ::: "memory");
        return bad;
    }
};
struct EpiLnRes {
    static constexpr bool PERM = false, AFTER_DRAIN = true;
    const float* base; float* out; int ldc; const float* bias; PanelStats st; unsigned poison;
    __device__ __forceinline__ void fused(f32x4 (&acc)[2][2][4][2], const Unit& u, int wr, int wc, int fr, int fq, PG8_LAS unsigned char* lds, int wid, int lane) const {
        typedef float f32x2v __attribute__((ext_vector_type(2)));
        const PG8_LAS f32x2v* S = (const PG8_LAS f32x2v*)(lds + 8192);
        const int col0 = u.pn * BM + wc * 32 + 4 * fq;
#pragma unroll
        for (int bj = 0; bj < 2; ++bj)
#pragma unroll
            for (int n = 0; n < 2; ++n) { const f32x4 bv = bias ? *(const f32x4*)(bias + col0 + bj * HALF + n * 16) : (f32x4){0.f, 0.f, 0.f, 0.f};
#pragma unroll
                for (int ai = 0; ai < 2; ++ai)
#pragma unroll
                    for (int m = 0; m < 4; ++m) acc[ai][bj][m][n] += bv; }
        f32x4 pre[4][2][2];
#pragma unroll
        for (int m = 0; m < 4; ++m) { const size_t off = (size_t)(u.pm * BM + wr * 64 + m * 16 + fr) * ldc + col0;
#pragma unroll
            for (int bj = 0; bj < 2; ++bj)
#pragma unroll
                for (int n = 0; n < 2; ++n) pre[m][bj][n] = *(const f32x4*)(base + off + bj * HALF + n * 16); }
        const bool bad = st.run(acc, u, wr, wc, fr, fq, lds, wid, lane) || poison != 0u;
        const float qnan = __builtin_nanf("");
#pragma unroll
        for (int ai = 0; ai < 2; ++ai)
#pragma unroll
            for (int m = 0; m < 4; ++m) { const int r = ai * HALF + wr * 64 + m * 16 + fr; const f32x2v sr = S[r]; const size_t off = (size_t)(u.pm * BM + r) * ldc + col0;
#pragma unroll
                for (int bj = 0; bj < 2; ++bj)
#pragma unroll
                    for (int n = 0; n < 2; ++n) { const f32x4 bs = ai == 0 ? pre[m][bj][n] : *(const f32x4*)(base + off + bj * HALF + n * 16); f32x4 o = bs + (acc[ai][bj][m][n] - sr.x) * sr.y;
                        if (bad) o = (f32x4){qnan, qnan, qnan, qnan}; *(f32x4*)(out + off + bj * HALF + n * 16) = o; }
                if (m & 1) asm volatile("" ::: "memory"); }
    }
};
struct EpiLnResLn {
    static constexpr bool PERM = false, AFTER_DRAIN = true;
    const float* base; float* out; bf16_t* xn; int ldc; const float* bias; PanelStats st1, st2; unsigned poison;
    __device__ __forceinline__ void fused(f32x4 (&acc)[2][2][4][2], const Unit& u, int wr, int wc, int fr, int fq, PG8_LAS unsigned char* lds, int wid, int lane) const {
        typedef float f32x2v __attribute__((ext_vector_type(2))); typedef unsigned u32x2v __attribute__((ext_vector_type(2)));
        const PG8_LAS f32x2v* S = (const PG8_LAS f32x2v*)(lds + 8192);
        const int col0 = u.pn * BM + wc * 32 + 4 * fq;
#pragma unroll
        for (int bj = 0; bj < 2; ++bj)
#pragma unroll
            for (int n = 0; n < 2; ++n) { const f32x4 bv = bias ? *(const f32x4*)(bias + col0 + bj * HALF + n * 16) : (f32x4){0.f, 0.f, 0.f, 0.f};
#pragma unroll
                for (int ai = 0; ai < 2; ++ai)
#pragma unroll
                    for (int m = 0; m < 4; ++m) acc[ai][bj][m][n] += bv; }
        bool bad = st1.run(acc, u, wr, wc, fr, fq, lds, wid, lane) || poison != 0u;
        const float qnan = __builtin_nanf("");
#pragma unroll
        for (int ai = 0; ai < 2; ++ai)
#pragma unroll
            for (int m = 0; m < 4; ++m) { const int r = ai * HALF + wr * 64 + m * 16 + fr; const f32x2v sr = S[r]; const size_t off = (size_t)(u.pm * BM + r) * ldc + col0;
#pragma unroll
                for (int bj = 0; bj < 2; ++bj)
#pragma unroll
                    for (int n = 0; n < 2; ++n) { const f32x4 bs = *(const f32x4*)(base + off + bj * HALF + n * 16); acc[ai][bj][m][n] = bs + (acc[ai][bj][m][n] - sr.x) * sr.y; }
                asm volatile("" : "+v"(acc[ai][0][m][0]), "+v"(acc[ai][0][m][1]), "+v"(acc[ai][1][m][0]), "+v"(acc[ai][1][m][1]));
                if (m & 1) asm volatile("" ::: "memory"); }
        const bool bad1 = bad;
        bad = st2.run(acc, u, wr, wc, fr, fq, lds, wid, lane) || bad;
#pragma unroll
        for (int ai = 0; ai < 2; ++ai)
#pragma unroll
            for (int m = 0; m < 4; ++m) { const int r = ai * HALF + wr * 64 + m * 16 + fr; const f32x2v sr = S[r]; const size_t off = (size_t)(u.pm * BM + r) * ldc + col0;
#pragma unroll
                for (int bj = 0; bj < 2; ++bj)
#pragma unroll
                    for (int n = 0; n < 2; ++n) { const f32x4 x1 = acc[ai][bj][m][n]; *(f32x4*)(out + off + bj * HALF + n * 16) = bad1 ? (f32x4){qnan, qnan, qnan, qnan} : x1;
                        const f32x4 o = (x1 - sr.x) * sr.y; u32x2v w; w.x = cvt_pk_bf16(o[0], o[1]); w.y = cvt_pk_bf16(o[2], o[3]);
                        if (bad) { w.x = 0x7fc07fc0u; w.y = 0x7fc07fc0u; } *(u32x2v*)(xn + off + bj * HALF + n * 16) = w; }
                asm volatile("" ::: "memory"); }
    }
};

}
namespace pg8 {
typedef int v8i_t __attribute__((ext_vector_type(8))); typedef int v4i_t __attribute__((ext_vector_type(4)));
template <class Epi, class Sched, bool ALIGN_EPI, bool GATHER, bool KSPLIT, bool FP8 = false, int SCW = 127, int SCA = 127, bool SC2 = false, int SCW2 = 127, int SCA2 = 127>
__device__ __forceinline__ void gemm_phase2(PG8_LAS unsigned char* lds, const int Kbytes, const int ldb_bytes, const Sched& S, const Epi& E, const int tid) {
    typedef typename Sched::UnitT UnitT;
    const int wid = __builtin_amdgcn_readfirstlane(tid >> 6), lane = tid & 63, wr = wid >> 2, wc = wid & 3, fr = lane & 15, fq = lane >> 4;
    int nt = Kbytes / (BK * 2); asm volatile("" : "+s"(nt));
    const int nth = nt / 2;
    unsigned voffB[2];
#pragma unroll
    for (int i = 0; i < 2; ++i) { int R[2], C[2]; stage_rc(tid * 16 + i * 8192, R[i], C[i]); const int Rb = Epi::PERM ? ((R[i] & ~31) + perm32(R[i] & 31)) : R[i]; voffB[i] = (unsigned)(Rb * ldb_bytes + C[i] * 2); }
    const size_t kstep = (size_t)(BK * 2);
    const size_t hstepB = (size_t)HALF * ldb_bytes;
    const unsigned ldsw = (unsigned)wid * 1024u;
    const int aoff = lds_byte(wr * 64 + fr, fq * 8), boff = lds_byte(wc * 32 + fr, fq * 8);
#define PG8_SA(b, h) (((b) * 2 + (h)) * HTB)
#define PG8_SB(b, h) ((4 + (b) * 2 + (h)) * HTB)
#define PG8_STAGE(bufoff, gbase, voff) do { _Pragma("unroll") for (int _i = 0; _i < 2; ++_i) \
        __builtin_amdgcn_global_load_lds((const unsigned*)((const char*)(gbase) + (voff)[_i]), (PG8_LAS unsigned*)(lds + (bufoff) + ldsw + _i * 8192), 16, 0, 0); } while (0)
#define PG8_LDA(dst, b, h) do { _Pragma("unroll") for (int m = 0; m < 4; ++m) _Pragma("unroll") for (int k = 0; k < 2; ++k) dst[m][k] = *(const PG8_LAS bf16x8*)(lds + PG8_SA(b, h) + aoff + m * 2048 + k * 1024); } while (0)
#define PG8_LDB(dst, b, h) do { _Pragma("unroll") for (int n = 0; n < 2; ++n) _Pragma("unroll") for (int k = 0; k < 2; ++k) dst[n][k] = *(const PG8_LAS bf16x8*)(lds + PG8_SB(b, h) + boff + n * 2048 + k * 1024); } while (0)
#define PG8_CAT8(x) __builtin_shufflevector(__builtin_bit_cast(v4i_t, (x)[0]), __builtin_bit_cast(v4i_t, (x)[1]), 0, 1, 2, 3, 4, 5, 6, 7)
#define PG8_MMA(ai, bj, At, Bt) do { __builtin_amdgcn_s_setprio(1); \
        if constexpr (FP8) { _Pragma("unroll") for (int m = 0; m < 4; ++m) _Pragma("unroll") for (int n = 0; n < 2; ++n) \
            acc[ai][bj][m][n] = __builtin_amdgcn_mfma_scale_f32_16x16x128_f8f6f4(PG8_CAT8(Bt[n]), PG8_CAT8(At[m]), acc[ai][bj][m][n], 0, 0, 0, scw_, 0, sca_); } \
        else { _Pragma("unroll") for (int m = 0; m < 4; ++m) _Pragma("unroll") for (int n = 0; n < 2; ++n) _Pragma("unroll") for (int k = 0; k < 2; ++k) \
            acc[ai][bj][m][n] = __builtin_amdgcn_mfma_f32_16x16x32_bf16(Bt[n][k], At[m][k], acc[ai][bj][m][n], 0, 0, 0); } \
        __builtin_amdgcn_s_setprio(0); } while (0)
#define PG8_WAIT_V(n) asm volatile("s_waitcnt vmcnt(" #n ")" ::: "memory")
#define PG8_WAIT_L(n) asm volatile("s_waitcnt lgkmcnt(" #n ")" ::: "memory")
#define PG8_BAR __builtin_amdgcn_s_barrier()
#define PG8_SCHED __builtin_amdgcn_sched_barrier(0)
#define PG8_BK(cb, cb2, kt) ((KSPLIT && (kt) >= nth) ? (cb2) + (size_t)((kt) - nth) * kstep : (cb) + (size_t)(kt) * kstep)
    UnitT cur, nxt; int ui = 0;
    if (!S.next(0, cur)) return;
    f32x4 acc[2][2][4][2];
#pragma unroll
    for (int a = 0; a < 2; ++a)
#pragma unroll
        for (int b = 0; b < 2; ++b)
#pragma unroll
            for (int m = 0; m < 4; ++m)
#pragma unroll
                for (int n = 0; n < 2; ++n) acc[a][b][m][n] = (f32x4){0.f, 0.f, 0.f, 0.f};
    bf16x8 At[4][2], B0[2][2], B1[2][2];
    unsigned vA[2][2], vAn[2][2];
    S.arows(cur, tid, vA);
#pragma unroll
    for (int h = 0; h < 2; ++h)
#pragma unroll
        for (int i = 0; i < 2; ++i) vAn[h][i] = vA[h][i];
    const char* cA = S.aptr(cur); const char* cB = S.bptr(cur); const char* cB2 = KSPLIT ? S.bptr2(cur) : cB;
    PG8_STAGE(PG8_SB(0, 0), cB, voffB); PG8_STAGE(PG8_SB(0, 1), cB + hstepB, voffB); PG8_STAGE(PG8_SA(0, 0), cA, vA[0]); PG8_STAGE(PG8_SA(0, 1), cA, vA[1]);
    if (wr == 1) PG8_BAR;
    PG8_WAIT_V(2); PG8_BAR;
    PG8_STAGE(PG8_SB(1, 0), PG8_BK(cB, cB2, 1), voffB); PG8_STAGE(PG8_SA(1, 0), cA + kstep, vA[0]); PG8_STAGE(PG8_SB(1, 1), PG8_BK(cB, cB2, 1) + hstepB, voffB);
    PG8_WAIT_V(6); PG8_BAR;
    for (;;) {
        const bool has_next = S.next(ui + 1, nxt);
        const char* nA = has_next ? S.aptr(nxt) : cA; const char* nB = has_next ? S.bptr(nxt) : cB; const char* nB2 = (KSPLIT && has_next) ? S.bptr2(nxt) : cB2;
        if (GATHER && has_next) S.arows(nxt, tid, vAn);
        for (int t = 0; t < nt; t += 2) {
            const bool last = (t == nt - 2);
            const int scw_ = ((SC2 && t >= nth) ? SCW2 : SCW) * 0x01010101, sca_ = ((SC2 && t >= nth) ? SCA2 : SCA) * 0x01010101; (void)scw_; (void)sca_;
            const char* a1 = cA + (size_t)(t + 1) * kstep;
            const char* a2 = last ? nA : cA + (size_t)(t + 2) * kstep;
            const char* b2 = last ? nB : PG8_BK(cB, cB2, t + 2);
            const char* b3 = last ? (KSPLIT ? PG8_BK(nB, nB2, 1) : nB + kstep) : PG8_BK(cB, cB2, t + 3);
            const char* a3 = a2 + kstep;
            PG8_LDB(B0, 0, 0); PG8_LDB(B1, 0, 1); PG8_SCHED; PG8_LDA(At, 0, 0); PG8_STAGE(PG8_SA(1, 1), a1, vA[1]);
            PG8_WAIT_V(8); PG8_WAIT_L(0); PG8_BAR; PG8_MMA(0, 0, At, B0); PG8_MMA(0, 1, At, B1); PG8_BAR; PG8_SCHED;
            if (GATHER && last) {
#pragma unroll
                for (int h = 0; h < 2; ++h)
#pragma unroll
                    for (int i = 0; i < 2; ++i) vA[h][i] = vAn[h][i]; }
            PG8_LDA(At, 0, 1); PG8_STAGE(PG8_SB(0, 0), b2, voffB); PG8_STAGE(PG8_SB(0, 1), b2 + hstepB, voffB); PG8_STAGE(PG8_SA(0, 0), a2, vA[0]);
            PG8_WAIT_V(8); PG8_WAIT_L(0); PG8_BAR; PG8_MMA(1, 0, At, B0); PG8_MMA(1, 1, At, B1); PG8_BAR; PG8_SCHED;
            PG8_LDB(B0, 1, 0); PG8_LDB(B1, 1, 1); PG8_SCHED; PG8_LDA(At, 1, 0); PG8_STAGE(PG8_SA(0, 1), a2, vA[1]);
            PG8_WAIT_V(8); PG8_WAIT_L(0); PG8_BAR; PG8_MMA(0, 0, At, B0); PG8_MMA(0, 1, At, B1); PG8_BAR; PG8_SCHED;
            PG8_LDA(At, 1, 1); PG8_STAGE(PG8_SB(1, 0), b3, voffB); PG8_STAGE(PG8_SB(1, 1), b3 + hstepB, voffB); PG8_STAGE(PG8_SA(1, 0), a3, vA[0]);
            PG8_WAIT_V(8); PG8_WAIT_L(0); PG8_BAR; PG8_MMA(1, 0, At, B0); PG8_MMA(1, 1, At, B1); PG8_BAR; PG8_SCHED;
        }
        if constexpr (ALIGN_EPI) { if (wr == 0) PG8_BAR; }
        if constexpr (!Epi::AFTER_DRAIN) { E(acc, cur, wr, wc, fr, fq); }
        if (!has_next) break;
#pragma unroll
        for (int a = 0; a < 2; ++a)
#pragma unroll
            for (int b = 0; b < 2; ++b)
#pragma unroll
                for (int m = 0; m < 4; ++m)
#pragma unroll
                    for (int n = 0; n < 2; ++n) acc[a][b][m][n] = (f32x4){0.f, 0.f, 0.f, 0.f};
        cur = nxt; cA = nA; cB = nB; cB2 = nB2; ++ui;
        if constexpr (ALIGN_EPI) { if (wr == 1) PG8_BAR; }
    }
    PG8_WAIT_V(0);
    if constexpr (!ALIGN_EPI) { if (wr == 0) PG8_BAR; }
    PG8_BAR;
    if constexpr (Epi::AFTER_DRAIN) { E.fused(acc, cur, wr, wc, fr, fq, lds, wid, lane); }
#undef PG8_SA
#undef PG8_SB
#undef PG8_STAGE
#undef PG8_LDA
#undef PG8_LDB
#undef PG8_MMA
#undef PG8_WAIT_V
#undef PG8_WAIT_L
#undef PG8_BAR
#undef PG8_SCHED
#undef PG8_BK
#undef PG8_CAT8
}
}
namespace pg8 {
DEVFN unsigned pkbf(float lo, float hi) { return cvt_pk_bf16(lo, hi); }
struct DenseSched {
    typedef Unit UnitT;
    StaticOrder so; const char* A; const char* Bt; int lda, ldb;
    DEVFN bool next(int i, Unit& u) const { return so.next(i, u); }
    DEVFN const char* aptr(const Unit&) const { return A; }
    DEVFN void arows(const Unit& u, const int tid_, unsigned (&v)[2][2]) const {
        int R[2], C[2]; { int t_ = tid_; asm volatile("" : "+v"(t_)); stage_rc(t_ * 16, R[0], C[0]); stage_rc(t_ * 16 + 8192, R[1], C[1]); }
#pragma unroll
        for (int h = 0; h < 2; ++h)
#pragma unroll
            for (int i = 0; i < 2; ++i) v[h][i] = (unsigned)((u.pm * BM + h * HALF + R[i]) * lda + C[i] * 2); }
    DEVFN const char* bptr(const Unit& u) const { return Bt + (size_t)u.pn * BM * ldb; }
    DEVFN const char* bptr2(const Unit& u) const { return bptr(u); }
};
struct EpiInproj {
    static constexpr bool PERM = true, AFTER_DRAIN = false;
    bf16_t* O; const float* rope; float* kbar;
    DEVFN void operator()(f32x4 (&acc)[2][2][4][2], const Unit& u, int wr, int wc, int fr, int fq) const {
        const int pn = u.pn, row0 = u.pm * BM + wr * 64 + fr;
        if (pn < 4 && fq == 0) {
#pragma unroll
            for (int ai = 0; ai < 2; ++ai)
#pragma unroll
                for (int m = 0; m < 4; ++m) { const int t = (row0 + ai * HALF + m * 16) & (SEQ - 1); const f32x4* rp = (const f32x4*)(rope + t * 16);
#pragma unroll
                    for (int q = 0; q < 4; ++q) { const f32x4 cs = rp[q];
                        { const int d = 2 * q, n = d >> 2, e = d & 3; const float x1 = acc[ai][0][m][n][e], x2 = acc[ai][1][m][n][e]; acc[ai][0][m][n][e] = x1 * cs[0] - x2 * cs[1]; acc[ai][1][m][n][e] = x2 * cs[0] + x1 * cs[1]; }
                        { const int d = 2 * q + 1, n = d >> 2, e = d & 3; const float x1 = acc[ai][0][m][n][e], x2 = acc[ai][1][m][n][e]; acc[ai][0][m][n][e] = x1 * cs[2] - x2 * cs[3]; acc[ai][1][m][n][e] = x2 * cs[2] + x1 * cs[3]; } } }
        }
        if (pn == 2 || pn == 3) {
            float* kb = kbar + (size_t)((((u.pm >> 3) * NH + (pn - 2) * 4 + wc) * NBLK + (u.pm & 7)) * HD);
#pragma unroll
            for (int bj = 0; bj < 2; ++bj)
#pragma unroll
                for (int n = 0; n < 2; ++n)
#pragma unroll
                    for (int e = 0; e < 4; ++e) { float s = 0.f;
#pragma unroll
                        for (int ai = 0; ai < 2; ++ai)
#pragma unroll
                            for (int m = 0; m < 4; ++m) s += acc[ai][bj][m][n][e];
                        s = swz_xor_add(s, 1); s = swz_xor_add(s, 2); s = swz_xor_add(s, 4); s = swz_xor_add(s, 8);
                        if (fr == 0) atomicAdd(kb + (2 * fq + bj) * 8 + 4 * n + e, s * (1.f / MBLK)); }
        }
        const float sc = pn < 2 ? QSCALE : 1.f;
#pragma unroll
        for (int ai = 0; ai < 2; ++ai)
#pragma unroll
            for (int m = 0; m < 4; ++m) { bf16_t* rowp = O + (size_t)(row0 + ai * HALF + m * 16) * DIN + pn * BM + wc * 64;
#pragma unroll
                for (int bj = 0; bj < 2; ++bj) { const f32x4 v0 = acc[ai][bj][m][0] * sc, v1 = acc[ai][bj][m][1] * sc;
                    u32x4 w; w.x = pkbf(v0[0], v0[1]); w.y = pkbf(v0[2], v0[3]); w.z = pkbf(v1[0], v1[1]); w.w = pkbf(v1[2], v1[3]);
                    *(u32x4*)(rowp + (2 * fq + bj) * 8) = w; } }
    }
};
struct MoeUnit { int pm, pn, cls, j, cnt; };
struct MoeBase {
    const PG8_LAS int* tp; const PG8_LAS int* cnt; int nunits, G, c, npn_shift;
    DEVFN bool next_(int i, MoeUnit& u) const {
        const int L = i * G + c; if (L >= nunits) return false;
        u.pm = L >> npn_shift; u.pn = L & ((1 << npn_shift) - 1);
        int cls = 0; while (u.pm >= tp[cls + 1]) ++cls;
        u.cls = cls; u.j = u.pm - tp[cls]; u.cnt = cnt[cls]; return true; }
};
DEVFN void moe_experts(int cls, int& e1, int& e2) { const int g = cls / 6, p = cls % 6; const int lo = p < 3 ? 0 : (p < 5 ? 1 : 2), hi = p < 3 ? p + 1 : (p < 5 ? p - 1 : 3); e1 = g * 4 + lo; e2 = g * 4 + hi; }
struct GateUpSched : MoeBase {
    typedef MoeUnit UnitT;
    const char* HB; const int* list; const char* W;
    DEVFN bool next(int i, MoeUnit& u) const { return next_(i, u); }
    DEVFN const char* aptr(const MoeUnit&) const { return HB; }
    DEVFN void arows(const MoeUnit& u, const int tid_, unsigned (&v)[2][2]) const {
        int R[2], C[2]; { int t_ = tid_; asm volatile("" : "+v"(t_)); stage_rc(t_ * 16, R[0], C[0]); stage_rc(t_ * 16 + 8192, R[1], C[1]); }
#pragma unroll
        for (int h = 0; h < 2; ++h)
#pragma unroll
            for (int i = 0; i < 2; ++i) { const int li = 256 * u.j + h * HALF + R[i]; const int tok = list[(size_t)u.cls * LISTCAP + (li < u.cnt ? li : 256 * u.j)]; v[h][i] = (unsigned)(tok * DM + C[i] * 2); } }
    DEVFN const char* bptr(const MoeUnit& u) const { int e1, e2; moe_experts(u.cls, e1, e2); return W + (size_t)(u.pn < 4 ? e1 : e2) * DM * DM + (size_t)(u.pn & 3) * BM * DM; }
    DEVFN const char* bptr2(const MoeUnit& u) const { return bptr(u); }
};
struct DownSched : MoeBase {
    typedef MoeUnit UnitT;
    const char* ACT; const char* W;
    DEVFN bool next(int i, MoeUnit& u) const { return next_(i, u); }
    DEVFN const char* aptr(const MoeUnit&) const { return ACT; }
    DEVFN void arows(const MoeUnit& u, const int tid_, unsigned (&v)[2][2]) const {
        int R[2], C[2]; { int t_ = tid_; asm volatile("" : "+v"(t_)); stage_rc(t_ * 16, R[0], C[0]); stage_rc(t_ * 16 + 8192, R[1], C[1]); }
#pragma unroll
        for (int h = 0; h < 2; ++h)
#pragma unroll
            for (int i = 0; i < 2; ++i) v[h][i] = (unsigned)((u.pm * BM + h * HALF + R[i]) * DM + C[i] * 2); }
    DEVFN const char* bptr(const MoeUnit& u) const { int e1, e2; moe_experts(u.cls, e1, e2); return W + (size_t)e1 * DM * DE + (size_t)u.pn * BM * DE; }
    DEVFN const char* bptr2(const MoeUnit& u) const { int e1, e2; moe_experts(u.cls, e1, e2); return W + (size_t)e2 * DM * DE + (size_t)u.pn * BM * DE; }
};
struct EpiGateUp {
    static constexpr bool PERM = true, AFTER_DRAIN = false;
    unsigned char* ACT; const float* rw;
    DEVFN void operator()(f32x4 (&acc)[2][2][4][2], const MoeUnit& u, int wr, int wc, int fr, int fq) const {
        const int half = u.pn >> 2, jt = u.pn & 3;
#pragma unroll
        for (int ai = 0; ai < 2; ++ai)
#pragma unroll
            for (int m = 0; m < 4; ++m) { const int lr = ai * HALF + wr * 64 + m * 16 + fr, li = 256 * u.j + lr;
                const float wgt = li < u.cnt ? 8.f * rw[((size_t)u.cls * LISTCAP + li) * 2 + half] : 0.f;
                f32x4 o[2];
#pragma unroll
                for (int n = 0; n < 2; ++n)
#pragma unroll
                    for (int e = 0; e < 4; ++e) { const float g = acc[ai][0][m][n][e]; o[n][e] = g * __builtin_amdgcn_rcpf(1.f + __expf(-g)) * acc[ai][1][m][n][e] * wgt; }
                u32x2 w; w.x = pk4_fp8(o[0][0], o[0][1], o[0][2], o[0][3]); w.y = pk4_fp8(o[1][0], o[1][1], o[1][2], o[1][3]);
                *(u32x2*)(ACT + (size_t)(u.pm * BM + lr) * DM + half * 512 + jt * 128 + wc * 32 + fq * 8) = w; }
    }
};
struct EpiDown {
    static constexpr bool PERM = true, AFTER_DRAIN = false;
    bf16_t* Y2; const int* list;
    DEVFN void operator()(f32x4 (&acc)[2][2][4][2], const MoeUnit& u, int wr, int wc, int fr, int fq) const {
#pragma unroll
        for (int ai = 0; ai < 2; ++ai)
#pragma unroll
            for (int m = 0; m < 4; ++m) { const int li = 256 * u.j + ai * HALF + wr * 64 + m * 16 + fr;
                if (li < u.cnt) { const int tok = list[(size_t)u.cls * LISTCAP + li]; bf16_t* rowp = Y2 + (size_t)tok * DM + u.pn * BM + wc * 32 + fq * 8;
#pragma unroll
                    for (int bj = 0; bj < 2; ++bj) { const f32x4 v0 = acc[ai][bj][m][0], v1 = acc[ai][bj][m][1];
                        u32x4 w; w.x = pkbf(v0[0], v0[1]); w.y = pkbf(v0[2], v0[3]); w.z = pkbf(v1[0], v1[1]); w.w = pkbf(v1[2], v1[3]);
                        *(u32x4*)(rowp + bj * HALF) = w; } } }
    }
};
}

#include <hip/hip_bf16.h>
#include <cmath>
namespace attn_body {
using bf16=__hip_bfloat16;
using bf16x8=__attribute__((ext_vector_type(8)))short;
using s16x4=__attribute__((ext_vector_type(4)))short;
using f32x16=__attribute__((ext_vector_type(16)))float;
using u32x4=__attribute__((ext_vector_type(4)))unsigned;
constexpr int BATCH=16,NHEAD=8,SEQ=2048,D=64,QP=2048,OP=1024;
constexpr int NW=8,QBLK=32,QB=QBLK*NW,KVBLK=64,NQB=SEQ/QB;
constexpr int ATTN_PITCH=QP, ATTN_UNIT_ROWS=QB;
__device__ __forceinline__ int crow(int r,int hi){return (r&3)+8*(r>>2)+4*hi;}
#define SBAR() __builtin_amdgcn_sched_barrier(0)
__device__ __forceinline__ void cmask(f32x16&p0,f32x16&p1,int jb,int qrel,int hi){
  const float NEG=-INFINITY; int kb=64*jb+4*hi;
  #pragma unroll
  for(int r=0;r<16;++r){int kv=kb+(r&3)+8*(r>>2); if(kv>qrel)p0[r]=NEG; if(kv+32>qrel)p1[r]=NEG;}
}

constexpr int NSLOT=3, SLOTB=8192;
constexpr int LDS_K=0, LDS_V=NSLOT*SLOTB, LDS_WS=2*NSLOT*SLOTB, LDS_OST=LDS_WS+NW*64*4, LDS_KBAR=LDS_OST+NW*4096, LDS_BYTES=LDS_KBAR+2048;
constexpr float NEGBIG=-1.0e30f; typedef float f32x4_t __attribute__((ext_vector_type(4)));
__device__ __forceinline__ float bfs(short v){return __uint_as_float(((unsigned)(unsigned short)v)<<16);}
constexpr float C2=0.125f*1.4426950408889634f;
__device__ __forceinline__ void glds16(const void*gsrc,unsigned lds_dst){unsigned keep;
  asm volatile("s_mov_b32 %0, m0\n\ts_mov_b32 m0, %2\n\ts_nop 0\n\tglobal_load_lds_dwordx4 %1, off\n\ts_mov_b32 m0, %0":"=&s"(keep):"v"(gsrc),"s"(lds_dst):"memory");}
__device__ __forceinline__ float max3f(float a,float b,float c){float r;asm("v_max3_f32 %0, %1, %2, %3":"=v"(r):"v"(a),"v"(b),"v"(c));return r;}
__device__ __forceinline__ float max2f(float a,float b){float r;asm("v_max_f32_e32 %0, %1, %2":"=v"(r):"v"(a),"v"(b));return r;}
__device__ __forceinline__ float fadd_s(float a,float b){float r;asm("v_add_f32_e32 %0, %1, %2":"=v"(r):"v"(a),"v"(b));return r;}
__device__ __forceinline__ float fsub_s(float a,float b){float r;asm("v_sub_f32_e32 %0, %1, %2":"=v"(r):"v"(a),"v"(b));return r;}
typedef float f32x2_t __attribute__((ext_vector_type(2))); typedef __bf16 bf16x2_t __attribute__((ext_vector_type(2)));
__device__ __forceinline__ unsigned cvtpk_s(float lo,float hi){f32x2_t v={lo,hi};bf16x2_t b=__builtin_convertvector(v,bf16x2_t);return __builtin_bit_cast(unsigned,b);}
#define WAIT_BAR(N) asm volatile("s_waitcnt vmcnt(" #N ") lgkmcnt(0)\n\ts_barrier":::"memory")

__device__ __forceinline__ void qkt(f32x16&p0,f32x16&p1,const char*Kslot,const bf16x8*qr,const f32x16&negm,int r32,int hi){
  const char*kb=Kslot+hi*1024+r32*16;
  #pragma unroll
  for(int d0=0;d0<4;++d0){
    const bf16x8 b0=*reinterpret_cast<const bf16x8*>(kb+d0*2048);
    const bf16x8 b1=*reinterpret_cast<const bf16x8*>(kb+d0*2048+512);
    if(d0==0){p0=__builtin_amdgcn_mfma_f32_32x32x16_bf16(b0,qr[0],negm,0,0,0);p1=__builtin_amdgcn_mfma_f32_32x32x16_bf16(b1,qr[0],negm,0,0,0);}
    else{p0=__builtin_amdgcn_mfma_f32_32x32x16_bf16(b0,qr[d0],p0,0,0,0);p1=__builtin_amdgcn_mfma_f32_32x32x16_bf16(b1,qr[d0],p1,0,0,0);}}
}
typedef __attribute__((address_space(3))) const char* lds_cptr;
typedef short v4i16_t __attribute__((ext_vector_type(4)));
__device__ __forceinline__ void kload8(bf16x8*kf,lds_cptr kp){
  kf[0]=*(const __attribute__((address_space(3))) bf16x8*)(kp);      kf[1]=*(const __attribute__((address_space(3))) bf16x8*)(kp+512);
  kf[2]=*(const __attribute__((address_space(3))) bf16x8*)(kp+2048); kf[3]=*(const __attribute__((address_space(3))) bf16x8*)(kp+2560);
  kf[4]=*(const __attribute__((address_space(3))) bf16x8*)(kp+4096); kf[5]=*(const __attribute__((address_space(3))) bf16x8*)(kp+4608);
  kf[6]=*(const __attribute__((address_space(3))) bf16x8*)(kp+6144); kf[7]=*(const __attribute__((address_space(3))) bf16x8*)(kp+6656);
}
__device__ __forceinline__ void kload2(bf16x8*kf,lds_cptr kp,int j){ kf[2*j]=*(const __attribute__((address_space(3))) bf16x8*)(kp+j*2048); kf[2*j+1]=*(const __attribute__((address_space(3))) bf16x8*)(kp+j*2048+512); }
__device__ __forceinline__ s16x4 vtr(lds_cptr p){ return __builtin_bit_cast(s16x4,__builtin_amdgcn_ds_read_tr16_b64_v4i16((__attribute__((address_space(3))) v4i16_t*)p)); }
__device__ __forceinline__ float rowmax(const f32x16&p0,const f32x16&p1){
  float a=max3f(p0[0],p0[1],p1[0]),b=max3f(p0[2],p0[3],p1[1]);a=max3f(a,p1[2],p1[3]);
  #pragma unroll
  for(int r=4;r<16;r+=4){a=max3f(a,p0[r],p0[r+1]);b=max3f(b,p0[r+2],p0[r+3]);a=max3f(a,p1[r],p1[r+1]);b=max3f(b,p1[r+2],p1[r+3]);}
  const float m=max2f(a,b);
  auto rr=__builtin_amdgcn_permlane32_swap(__float_as_uint(m),__float_as_uint(m),false,false);
  return max2f(__uint_as_float(rr[0]),__uint_as_float(rr[1]));
}
__device__ __forceinline__ void pv(f32x16*o,int vb,bf16x8 pa0,bf16x8 pa1,bf16x8 pa2,bf16x8 pa3){
  #pragma unroll
  for(int d0=0;d0<2;++d0){s16x4 lo[4],hi[4];
    #pragma unroll
    for(int ks=0;ks<4;++ks){
      asm volatile("ds_read_b64_tr_b16 %0,%1 offset:%c2":"=&v"(lo[ks]):"v"(vb),"i"(d0*4096+ks*1024):"memory");
      asm volatile("ds_read_b64_tr_b16 %0,%1 offset:%c2":"=&v"(hi[ks]):"v"(vb),"i"(d0*4096+ks*1024+512):"memory");}
    asm volatile("s_waitcnt lgkmcnt(0)":::"memory");SBAR();
    #define PK(k) (bf16x8){lo[k][0],lo[k][1],lo[k][2],lo[k][3],hi[k][0],hi[k][1],hi[k][2],hi[k][3]}
    o[d0]=__builtin_amdgcn_mfma_f32_32x32x16_bf16(pa0,PK(0),o[d0],0,0,0);
    o[d0]=__builtin_amdgcn_mfma_f32_32x32x16_bf16(pa1,PK(1),o[d0],0,0,0);
    o[d0]=__builtin_amdgcn_mfma_f32_32x32x16_bf16(pa2,PK(2),o[d0],0,0,0);
    o[d0]=__builtin_amdgcn_mfma_f32_32x32x16_bf16(pa3,PK(3),o[d0],0,0,0);
    #undef PK
  }
}

#ifndef ATTN_STORE16
#define ATTN_STORE16(p,v) (*(u32x4*)(p)=(v))
#endif
template<int THRL> __device__ __forceinline__ void attn_unit(int b,int h,int qb,const bf16*Q,const bf16*__restrict__ K,const bf16*__restrict__ V,bf16*O,const float*__restrict__ kbar,char*shm,const int tid){
  const int lane=tid&63,r32=lane&31,hi=lane>>5; const int wid=__builtin_amdgcn_readfirstlane(tid>>6);
  float kbv=0.f; { int tk=tid; asm volatile("":"+v"(tk)); if(qb>=4&&tk<448)kbv=kbar[tk]; }
  const long rowbase=(long)b*SEQ; const int q0=qb*QB;
  const bf16*Qw=Q+(rowbase+q0+wid*QBLK)*QP+h*D;
  const bf16*Kh=K+rowbase*QP+h*D,*Vh=V+rowbase*QP+h*D;
  const unsigned lds0=(unsigned)(uintptr_t)shm;
  float*wsf=(float*)(shm+LDS_WS)+wid*64;
  const bf16*ksrc=Kh+(long)lane*QP+wid*8;
  const bf16*vsrc=Vh+(long)(16*(wid&3)+(lane>>2))*QP+(wid>>2)*32+(lane&3)*8;
  const unsigned kdst=lds0+LDS_K+wid*1024, vdst=lds0+LDS_V+wid*1024;
  #define DMA_K(t,slot) glds16(ksrc+(long)(t)*KVBLK*QP,(unsigned)__builtin_amdgcn_readfirstlane(kdst+(slot)))
  #define DMA_V(t,slot) glds16(vsrc+(long)(t)*KVBLK*QP,(unsigned)__builtin_amdgcn_readfirstlane(vdst+(slot)))
  const int vb0=(int)(lds0+LDS_V)+((lane>>4)&1)*32+(lane&3)*8+(4*hi+((lane&15)>>2))*64;
  const char*Kbase=shm+LDS_K; bf16x8 kf[8];
  const lds_cptr shm3=(lds_cptr)shm; const lds_cptr kp0=shm3+LDS_K+hi*1024+r32*16; const lds_cptr vp0=shm3+LDS_V+((lane>>4)&1)*32+(lane&3)*8+(4*hi+((lane&15)>>2))*64;
  const int NT=(q0+QB)/KVBLK;
  DMA_K(0,0);DMA_V(0,0);DMA_K(1,SLOTB);
  bf16x8 qr[4];
  #pragma unroll
  for(int d0=0;d0<4;++d0)qr[d0]=*reinterpret_cast<const bf16x8*>(&Qw[(long)r32*QP+d0*16+hi*8]);
  float mhat=0.f,l_reg=0.f;f32x16 o[2];o[0]=f32x16{};o[1]=f32x16{};f32x16 negm=f32x16{};asm volatile("":"+v"(negm));
  const int qrel=wid*QBLK+r32;
  #define CMASK(P0,P1,t) do{int jb_=(t)-(NT-4); if(jb_>=0)cmask(P0,P1,jb_,qrel,hi);}while(0)
  bool resc=false;
  #define START(P0,P1) do{ const float rm=rowmax(P0,P1); resc=false; \
    { const float dl=selcur?rm:-64.f; mhat=fadd_s(mhat,dl); \
      _Pragma("unroll") for(int r=0;r<16;++r){P0[r]=fsub_s(P0[r],dl);P1[r]=fsub_s(P1[r],dl);} \
      { const float nv_=selcur?-mhat:NEGBIG; _Pragma("unroll") for(int r=0;r<16;++r)negm[r]=nv_; } asm volatile("":"+v"(negm)); } \
    _Pragma("unroll") for(int r=0;r<16;++r)P0[r]=__builtin_amdgcn_exp2f(P0[r]); }while(0)
  #define RESC() do{ if(resc){ asm volatile("s_waitcnt lgkmcnt(0)":::"memory"); \
      _Pragma("unroll") for(int d_=0;d_<2;++d_) _Pragma("unroll") for(int r=0;r<16;++r)o[d_][r]*=wsf[crow(r,hi)]; } }while(0)
  f32x16 pA0,pA1,pB0,pB1;
  int sl_prev=0,sl_cur=0,sl_next=SLOTB;
  #define ROT() do{sl_prev=sl_cur;sl_cur=sl_next;sl_next=(sl_next==(NSLOT-1)*SLOTB)?0:sl_next+SLOTB;}while(0)
  DMA_K(2,2*SLOTB);
  if(qb>=4){ if(tid<448){ const unsigned hb=__builtin_bit_cast(unsigned,kbv); const unsigned hr=(hb+0x7fffu+((hb>>16)&1u))&0xffff0000u; const float lo_=kbv-__builtin_bit_cast(float,hr); const unsigned lb=__builtin_bit_cast(unsigned,lo_);
      ((unsigned short*)(shm+LDS_KBAR))[tid]=(unsigned short)(hr>>16); ((unsigned short*)(shm+LDS_KBAR+1024))[tid]=(unsigned short)((lb+0x7fffu+((lb>>16)&1u))>>16); } }
  WAIT_BAR(3);
  unsigned bmask=(1u<<(qb+1))-1u;
  if(qb>=4){ float gsc[8];
    { const lds_cptr kb3=shm3+LDS_KBAR+(r32&7)*128+hi*16; f32x16 g=f32x16{};
      _Pragma("unroll") for(int d0=0;d0<4;++d0){ const bf16x8 ah=*(const __attribute__((address_space(3))) bf16x8*)(kb3+d0*32), al=*(const __attribute__((address_space(3))) bf16x8*)(kb3+1024+d0*32);
        g=__builtin_amdgcn_mfma_f32_32x32x16_bf16(ah,qr[d0],g,0,0,0); g=__builtin_amdgcn_mfma_f32_32x32x16_bf16(al,qr[d0],g,0,0,0); }
      _Pragma("unroll") for(int r=0;r<4;++r){ auto rr=__builtin_amdgcn_permlane32_swap(__float_as_uint(g[r]),__float_as_uint(g[r]),false,false); gsc[r]=__uint_as_float(rr[0]); gsc[4+r]=__uint_as_float(rr[1]); } }
    _Pragma("unroll") for(int n=0;n<7;++n) gsc[n]=(n<qb)?gsc[n]:-3.0e38f;
    bmask=1u<<qb;
    _Pragma("unroll") for(int pick=0;pick<3;++pick){ float best=-3.4e38f; unsigned bi=0u;
      _Pragma("unroll") for(int n=0;n<7;++n){ const bool ok=!((bmask>>n)&1u)&&gsc[n]>best; best=ok?gsc[n]:best; bi=ok?(unsigned)n:bi; }
      bmask|=1u<<bi; } }
  bool selcur=(bmask&1u)!=0u;
  { const float nv=selcur?0.f:NEGBIG; _Pragma("unroll") for(int r=0;r<16;++r)negm[r]=nv; asm volatile("":"+v"(negm)); }
  qkt(pA0,pA1,Kbase,qr,negm,r32,hi);asm volatile("s_nop 15\n\ts_nop 7":"+v"(pA0),"+v"(pA1));CMASK(pA0,pA1,0);
  START(pA0,pA1);
  _Pragma("unroll") for(int r=0;r<16;++r)pA1[r]=__builtin_amdgcn_exp2f(pA1[r]);
  WAIT_BAR(0);
  DMA_K(3,0);DMA_V(1,SLOTB);
  ROT();
  kload8(kf,kp0+sl_cur);
  WAIT_BAR(2);
  s16x4 vlo[8],vhi[8]; u32x4 pw0,pw1,pw2,pw3;
  #define PKW(P,B) cvtpk_s(P[B],P[B+1])
  #define PAF(k) __builtin_bit_cast(bf16x8,pw##k)
  #define VFR(i) (bf16x8){vlo[i][0],vlo[i][1],vlo[i][2],vlo[i][3],vhi[i][0],vhi[i][1],vhi[i][2],vhi[i][3]}
  #define PIN(x) asm volatile("":"+v"(x))
  #define MX3(a,b,c) __builtin_fmaxf(__builtin_fmaxf((a),(b)),(c))
  #define GAPA(MF,A0,A1,A2,A3,W0,W1,PW) do{ MF; sacc+=A0; sacc+=A1; sacc+=A2; sacc+=A3; PIN(sacc); W0; W1; PIN(PW); SBAR(); }while(0)
  #define EX(v) __builtin_amdgcn_exp2f(v)
  #define GAPB(MF,X,B) do{ MF; X[B]=EX(X[B]); X[B+1]=EX(X[B+1]); X[B+2]=EX(X[B+2]); X[B+3]=EX(X[B+3]); PIN(X); SBAR(); }while(0)
  #define VRD(i) do{ vlo[i]=vtr(vp_+(((i)>>2)*4096+((i)&3)*1024)); vhi[i]=vtr(vp_+(((i)>>2)*4096+((i)&3)*1024+512)); }while(0)
  #define KRD(G,j) do{ if(G){ kload2(kf,kp0+sl_next,j); SBAR(); } }while(0)
  #define STEP(C0,C1,P0,P1,t,GK,GV,GL) do{ SBAR(); \
    const lds_cptr vp_=vp0+sl_prev; \
    VRD(0); SBAR(); float sacc=(P0[0]+P0[1]); \
    GAPA(C0=__builtin_amdgcn_mfma_f32_32x32x16_bf16(kf[0],qr[0],negm,0,0,0), P0[2],P0[3],P0[4],P0[5],     pw0[0]=PKW(P0,0), pw0[1]=PKW(P0,2), pw0); \
    VRD(4); SBAR(); GAPA(C1=__builtin_amdgcn_mfma_f32_32x32x16_bf16(kf[1],qr[0],negm,0,0,0), P0[6],P0[7],P0[8],P0[9],     pw0[2]=PKW(P0,4), pw0[3]=PKW(P0,6), pw0); \
    VRD(1); SBAR(); GAPA(C0=__builtin_amdgcn_mfma_f32_32x32x16_bf16(kf[2],qr[1],C0,0,0,0),   P0[10],P0[11],P0[12],P0[13], pw1[0]=PKW(P0,8), pw1[1]=PKW(P0,10), pw1); \
    VRD(5); SBAR(); GAPA(C1=__builtin_amdgcn_mfma_f32_32x32x16_bf16(kf[3],qr[1],C1,0,0,0),   P0[14],P0[15],P1[0],P1[1],   pw1[2]=PKW(P0,12),pw1[3]=PKW(P0,14), pw1); \
    VRD(2); SBAR(); GAPA(C0=__builtin_amdgcn_mfma_f32_32x32x16_bf16(kf[4],qr[2],C0,0,0,0),   P1[2],P1[3],P1[4],P1[5],     pw2[0]=PKW(P1,0), pw2[1]=PKW(P1,2), pw2); \
    VRD(6); SBAR(); GAPA(C1=__builtin_amdgcn_mfma_f32_32x32x16_bf16(kf[5],qr[2],C1,0,0,0),   P1[6],P1[7],P1[8],P1[9],     pw2[2]=PKW(P1,4), pw2[3]=PKW(P1,6), pw2); \
    VRD(3); SBAR(); GAPA(C0=__builtin_amdgcn_mfma_f32_32x32x16_bf16(kf[6],qr[3],C0,0,0,0),   P1[10],P1[11],P1[12],P1[13], pw3[0]=PKW(P1,8), pw3[1]=PKW(P1,10), pw3); \
    VRD(7); SBAR(); GAPA(C1=__builtin_amdgcn_mfma_f32_32x32x16_bf16(kf[7],qr[3],C1,0,0,0),   P1[14],P1[15],0.f,0.f,       pw3[2]=PKW(P1,12),pw3[3]=PKW(P1,14), pw3); \
    l_reg+=sacc; \
    if(GK){DMA_K((t)+3,sl_cur);} if(GV){DMA_V((t)+1,sl_next);} \
    CMASK(C0,C1,t); \
    { float a=MX3(C0[0],C0[1],C1[0]),b=MX3(C0[2],C0[3],C1[1]); a=MX3(a,C1[2],C1[3]); \
      _Pragma("unroll") for(int r=4;r<16;r+=4){a=MX3(a,C0[r],C0[r+1]);b=MX3(b,C0[r+2],C0[r+3]);a=MX3(a,C1[r],C1[r+1]);b=MX3(b,C1[r+2],C1[r+3]);} \
      float rm=__builtin_fmaxf(a,b); { auto rr=__builtin_amdgcn_permlane32_swap(__float_as_uint(rm),__float_as_uint(rm),false,false); rm=__builtin_fmaxf(__uint_as_float(rr[0]),__uint_as_float(rr[1])); } \
      resc=false; \
      if(__builtin_expect(__any(rm>(float)THRL),0)){ const float dl=__builtin_fmaxf(rm,0.f); mhat+=dl; \
        _Pragma("unroll") for(int r=0;r<16;++r){C0[r]-=dl;C1[r]-=dl;} \
        { const float nv_=selcur?-mhat:NEGBIG; _Pragma("unroll") for(int r=0;r<16;++r)negm[r]=nv_; } asm volatile("":"+v"(negm)); \
        const float f=__builtin_amdgcn_exp2f(-dl); l_reg*=f; if(hi==0)wsf[r32]=f; resc=true; } } \
    SBAR(); \
    GAPB(o[0]=__builtin_amdgcn_mfma_f32_32x32x16_bf16(PAF(0),VFR(0),o[0],0,0,0), C0,0); \
    GAPB(o[1]=__builtin_amdgcn_mfma_f32_32x32x16_bf16(PAF(0),VFR(4),o[1],0,0,0), C0,4); \
    KRD(GL,0); GAPB(o[0]=__builtin_amdgcn_mfma_f32_32x32x16_bf16(PAF(1),VFR(1),o[0],0,0,0), C0,8); \
    KRD(GL,1); GAPB(o[1]=__builtin_amdgcn_mfma_f32_32x32x16_bf16(PAF(1),VFR(5),o[1],0,0,0), C0,12); \
    KRD(GL,2); GAPB(o[0]=__builtin_amdgcn_mfma_f32_32x32x16_bf16(PAF(2),VFR(2),o[0],0,0,0), C1,0); \
    KRD(GL,3); GAPB(o[1]=__builtin_amdgcn_mfma_f32_32x32x16_bf16(PAF(2),VFR(6),o[1],0,0,0), C1,4); \
    GAPB(o[0]=__builtin_amdgcn_mfma_f32_32x32x16_bf16(PAF(3),VFR(3),o[0],0,0,0), C1,8); \
    GAPB(o[1]=__builtin_amdgcn_mfma_f32_32x32x16_bf16(PAF(3),VFR(7),o[1],0,0,0), C1,12); \
    }while(0)
  #define BLKSEL(tt) do{ if((((tt))&3)==0){ selcur=((bmask>>((tt)>>2))&1u)!=0u; const float nv_=selcur?-mhat:NEGBIG; _Pragma("unroll") for(int r=0;r<16;++r)negm[r]=nv_; asm volatile("":"+v"(negm)); } }while(0)
  int t=1;
  #undef CMASK
  #define CMASK(P0,P1,t) do{}while(0)
  for(;t+5<NT;t+=2){
    STEP(pB0,pB1,pA0,pA1,t,true,true,true);     WAIT_BAR(2); RESC(); ROT(); BLKSEL(t+1);
    STEP(pA0,pA1,pB0,pB1,t+1,true,true,true);   WAIT_BAR(2); RESC(); ROT();
  }
  #undef CMASK
  #define CMASK(P0,P1,t) do{int jb_=(t)-(NT-4); if(jb_>=0)cmask(P0,P1,jb_,qrel,hi);}while(0)
  #define ENDW(tt) do{ if((tt)+3<NT){WAIT_BAR(2);} else if((tt)+2<NT){WAIT_BAR(1);} else {WAIT_BAR(0);} }while(0)
  for(;t+1<NT;t+=2){
    STEP(pB0,pB1,pA0,pA1,t,(t+3<NT),(t+1<NT),(t+1<NT));       ENDW(t);   RESC(); ROT(); BLKSEL(t+1);
    STEP(pA0,pA1,pB0,pB1,t+1,(t+4<NT),(t+2<NT),(t+2<NT));     ENDW(t+1); RESC(); ROT();
  }
  STEP(pB0,pB1,pA0,pA1,NT-1,false,false,false); RESC();
  { float sacc=pB0[0]+pB0[1]; _Pragma("unroll") for(int r=2;r<16;++r)sacc+=pB0[r]; _Pragma("unroll") for(int r=0;r<16;++r)sacc+=pB1[r]; l_reg+=sacc;
    pw0=(u32x4){PKW(pB0,0),PKW(pB0,2),PKW(pB0,4),PKW(pB0,6)};pw1=(u32x4){PKW(pB0,8),PKW(pB0,10),PKW(pB0,12),PKW(pB0,14)};pw2=(u32x4){PKW(pB1,0),PKW(pB1,2),PKW(pB1,4),PKW(pB1,6)};pw3=(u32x4){PKW(pB1,8),PKW(pB1,10),PKW(pB1,12),PKW(pB1,14)};
    SBAR(); pv(o,vb0+sl_cur,PAF(0),PAF(1),PAF(2),PAF(3)); }
  #undef PKW
  #undef PAF
  #undef VFR
  #undef PIN
  #undef MX3
  #undef GAPA
  #undef GAPB
  #undef EX
  #undef VRD
  #undef KRD
  #undef STEP
  #undef ENDW
  {auto rr=__builtin_amdgcn_permlane32_swap(__float_as_uint(l_reg),__float_as_uint(l_reg),false,false);l_reg=__uint_as_float(rr[0])+__uint_as_float(rr[1]);}
  if(hi==0)wsf[32+r32]=l_reg;asm volatile("s_waitcnt lgkmcnt(0)":::"memory");
  float rli[16];
  #pragma unroll
  for(int r=0;r<16;++r)rli[r]=__builtin_amdgcn_rcpf(wsf[32+crow(r,hi)]);
  unsigned char*Ow=(unsigned char*)O+(rowbase+q0+wid*QBLK)*OP+h*D;
  { unsigned char*stg=(unsigned char*)(shm+LDS_OST)+wid*4096;
    #pragma unroll
    for(int r=0;r<16;++r){const int orow=crow(r,hi);
      #pragma unroll
      for(int d0=0;d0<2;++d0){const float ov=__builtin_amdgcn_fmed3f(o[d0][r]*rli[r]*32.f,-448.f,448.f); stg[orow*64+d0*32+r32]=(unsigned char)__builtin_amdgcn_cvt_pk_fp8_f32(ov,ov,0,false);}}
    asm volatile("s_waitcnt lgkmcnt(0)":::"memory");
    #pragma unroll
    for(int i=0;i<2;++i){const int row=i*16+(lane>>2),ch=lane&3; const u32x4 v=*(const u32x4*)(stg+row*64+ch*16); ATTN_STORE16(Ow+(long)row*OP+ch*16,v);} }
  asm volatile("s_waitcnt lgkmcnt(0)\n\ts_barrier":::"memory");
  #undef BLKSEL
  #undef DMA_K
  #undef DMA_V
  #undef CMASK
  #undef START
  #undef RESC
  #undef ROT
}
constexpr int ATTN_LDS_BYTES=LDS_BYTES;
struct AttnTensors { const bf16* Q; const bf16* K; const bf16* V; bf16* O; const float* kbar; };
struct AttnUnit { int bh; int qb; };
struct StaticOrder {
  int vcu, G;
  __device__ __forceinline__ explicit StaticOrder(int grid,int block):vcu((grid%8==0)?(block%8)*(grid/8)+block/8:block),G(grid){}
  __device__ __forceinline__ bool next(int i,AttnUnit&u)const{ const int pr=(vcu+(i>>2)*G)*2+((i>>1)&1); if(pr>=BATCH*NHEAD*4)return false;
    const int s=pr&3; u.bh=pr>>2; u.qb=(i&1)?7-s:s; return true; }
  __device__ __forceinline__ void a_ready(const AttnUnit&)const{}
  __device__ __forceinline__ void done(const AttnUnit&)const{}
};
template<class Sched,int THRL=8> __device__ __forceinline__ void attn_phase(char*lds,const AttnTensors&T,const Sched&S,const int tid_in){
  AttnUnit u; int tid_=tid_in; asm volatile("":"+v"(tid_));
  for(int i=0;S.next(i,u);++i){ S.a_ready(u); attn_unit<THRL>(u.bh/NHEAD,u.bh%NHEAD,u.qb,T.Q,T.K,T.V,T.O,T.kbar+(long)u.bh*512,lds,tid_); S.done(u); }
}
#undef SBAR
#undef WAIT_BAR
}

#define XB_TMO      128
#define XB_XCNT(j)  (256  + 64 * (j))
#define XB_XSUB(j)  (1280 + 64 * (j))
#define XB_XGEN(j)  (2304 + 64 * (j))
#define XB_TOP      3328
#define XB_TOPGEN   3392
#define XCD_BAR_WORDS 3456
#define XB_SPIN_CAP (1u << 18)

__device__ __forceinline__ unsigned xb_ld(unsigned* p)              { return __hip_atomic_load(p, __ATOMIC_RELAXED, __HIP_MEMORY_SCOPE_AGENT); }
__device__ __forceinline__ unsigned xb_add(unsigned* p, unsigned v) { return __hip_atomic_fetch_add(p, v, __ATOMIC_RELAXED, __HIP_MEMORY_SCOPE_AGENT); }
__device__ __forceinline__ unsigned xb_xcc_id() { return (unsigned)__builtin_amdgcn_s_getreg((3 << 11) | 20) & 0xFu; }
#define XB_SPIN(cond, bar) do { unsigned _sp = 0; while (cond) { __builtin_amdgcn_s_sleep(1); \
    if ((++_sp & 255u) == 0u) { if (xb_ld(&(bar)[XB_TMO])) break; if (_sp > XB_SPIN_CAP) { atomicAdd(&(bar)[XB_TMO], 1u); break; } } } } while (0)

struct XcdBarrier {
    unsigned* bar; unsigned x;
    volatile LAS unsigned* st;
};

__device__ __forceinline__ XcdBarrier xcd_barrier_post(unsigned* bar, volatile LAS unsigned* st) {
    XcdBarrier b; b.bar = bar; b.x = xb_xcc_id(); b.st = st;
    if (threadIdx.x == 0) (void)xb_add(&bar[XB_XCNT(b.x)], 1u);
    return b;
}
__device__ __forceinline__ void xcd_barrier_complete(unsigned* bar, unsigned x, unsigned& nloc, unsigned& nx) {
    const unsigned G = gridDim.x * gridDim.y * gridDim.z;
    unsigned sum, cnt, mine, sp = 0u;
    for (;;) {
        sum = 0u; cnt = 0u; mine = 0u;
#pragma unroll
        for (unsigned j = 0; j < 16; ++j) { const unsigned c = xb_ld(&bar[XB_XCNT(j)]); sum += c; cnt += (c > 0u) ? 1u : 0u; mine = (j == x) ? c : mine; }
        if (sum == G) break;
        __builtin_amdgcn_s_sleep(1);
        if ((++sp & 255u) == 0u) { if (xb_ld(&bar[XB_TMO])) break; if (sp > XB_SPIN_CAP) { atomicAdd(&bar[XB_TMO], 1u); break; } }
    }
    nloc = mine > 0u ? mine : 1u; nx = cnt > 0u ? cnt : 1u;
}

__device__ __forceinline__ void xcd_barrier(const XcdBarrier& b, const bool is_t0) {
    asm volatile("s_waitcnt vmcnt(0)" ::: "memory");
    __syncthreads();
    if (is_t0) {
        unsigned* bar = b.bar;
        __builtin_amdgcn_s_waitcnt(0);
        unsigned nloc = b.st[0], nx = b.st[1];
        if (nloc == 0u) { xcd_barrier_complete(bar, b.x, nloc, nx); b.st[0] = nloc; b.st[1] = nx; }
        const unsigned old = xb_add(&bar[XB_XSUB(b.x)], 1u);
        const unsigned gen = old / nloc;
        if (old + 1u == (gen + 1u) * nloc) {
            __builtin_amdgcn_fence(__ATOMIC_RELEASE, "agent");
            asm volatile("s_waitcnt vmcnt(0)" ::: "memory");
            const unsigned og = xb_add(&bar[XB_TOP], 1u);
            const unsigned tg = og / nx;
            if (og + 1u == (tg + 1u) * nx) xb_add(&bar[XB_TOPGEN], 1u);
            else XB_SPIN(xb_ld(&bar[XB_TOPGEN]) == tg, bar);
            __builtin_amdgcn_fence(__ATOMIC_ACQUIRE, "agent");
            xb_add(&bar[XB_XGEN(b.x)], 1u);
            asm volatile("s_waitcnt vmcnt(0)" ::: "memory");
        } else {
            XB_SPIN(xb_ld(&bar[XB_XGEN(b.x)]) == gen, bar);
            __builtin_amdgcn_fence(__ATOMIC_ACQUIRE, "agent");
            asm volatile("s_waitcnt vmcnt(0)" ::: "memory");
        }
    }
    __syncthreads();
}

struct Args { const float* in[17]; float* out; unsigned char* ws; int ph_lo, ph_hi; };
enum { I_X = 0, I_C, I_WMOD, I_BMOD, I_WIN, I_WPOOL, I_PSCALE, I_WOUT, I_LN1G, I_LN1B, I_WR, I_RB, I_WG, I_WU, I_WDN, I_LN2G, I_LN2B };

DEVFN int lane_id_volatile() { int l; asm volatile("v_mbcnt_lo_u32_b32 %0, -1, 0\n\tv_mbcnt_hi_u32_b32 %0, -1, %0" : "=v"(l)); return l; }
struct Ctx { unsigned char* lds; __attribute__((address_space(3))) unsigned char* lds3; int tid, lane, wave, G, bid, gw, NGW; };

DEVFN void transpose_item(const float* src, int ldn, int k0, int col, bf16_t* dst, int ldk, int dst_row0, int dst_k0, float* scr, int lane) {
#pragma unroll 8
    for (int i = 0; i < 32; ++i) { const int kk = 2 * i + (lane >> 5); scr[kk * 33 + (lane & 31)] = src[(size_t)(k0 + kk) * ldn + col]; }
    LDS_WAIT();
    const int c = lane & 7;
#pragma unroll
    for (int j = 0; j < 4; ++j) { const int n = (lane >> 3) + 8 * j; const float* s = scr + (8 * c) * 33 + n;
        u32x4 o; o.x = pk2(s[0 * 33], s[1 * 33]); o.y = pk2(s[2 * 33], s[3 * 33]); o.z = pk2(s[4 * 33], s[5 * 33]); o.w = pk2(s[6 * 33], s[7 * 33]);
        *(u32x4*)(dst + (size_t)(dst_row0 + n) * ldk + dst_k0 + 8 * c) = o; }
    LDS_WAIT();
}

DEVFN void transpose_item_f8(const float* src, int ldn, int k0, int col, unsigned char* dst, int ldk, int dst_row0, int dst_k0, float* scr, int lane) {
#pragma unroll 8
    for (int i = 0; i < 32; ++i) { const int kk = 2 * i + (lane >> 5); scr[kk * 33 + (lane & 31)] = src[(size_t)(k0 + kk) * ldn + col]; }
    LDS_WAIT();
    const int c = lane & 7;
#pragma unroll
    for (int j = 0; j < 4; ++j) { const int n = (lane >> 3) + 8 * j; const float* s = scr + (8 * c) * 33 + n;
        u32x2 o; o.x = pk4_fp8(32.f * s[0 * 33], 32.f * s[1 * 33], 32.f * s[2 * 33], 32.f * s[3 * 33]); o.y = pk4_fp8(32.f * s[4 * 33], 32.f * s[5 * 33], 32.f * s[6 * 33], 32.f * s[7 * 33]);
        *(u32x2*)(dst + (size_t)(dst_row0 + n) * ldk + dst_k0 + 8 * c) = o; }
    LDS_WAIT();
}

DEVFN void ph_prologue(const Args& a, const Ctx& c) {
    unsigned char* ws = a.ws;
    float* scr = (float*)(c.lds + c.wave * 16384);
    const int lane = c.lane;
    constexpr int N1 = 2 * 16 * 64, N2 = 2 * 8 * 32, N3 = 32 * 16 * 32, N4 = 32 * 8 * 32, N5 = 2 * 64 * 16, N6 = 256;
    for (int it = c.gw; it < N1 + N2 + N3 + N4 + N5 + N6; it += c.NGW) {
        int r = it;
        if (r < N1) {
            const int l = r / 1024, kb = (r % 1024) / 64, nb = r % 64;
            const int nphys = 32 * nb + (lane & 31);
            transpose_item_f8(a.in[I_WIN] + (size_t)l * DM * DIN, DIN, 64 * kb, inproj_nlog(nphys), (unsigned char*)(ws + WS_WIN) + (size_t)l * DIN * DM, DM, 32 * nb, 64 * kb, scr, lane);
            continue; }
        r -= N1;
        if (r < N2) {
            const int l = r / 256, kb = (r % 256) / 32, nb = r % 32;
            transpose_item_f8(a.in[I_WOUT] + (size_t)l * DM * DM, DM, 64 * kb, 32 * nb + (lane & 31), (unsigned char*)(ws + WS_WOUT) + (size_t)l * DM * DM, DM, 32 * nb, 64 * kb, scr, lane);
            continue; }
        r -= N2;
        if (r < N3) {
            const int le = r / 512, kb = (r % 512) / 32, nb = r % 32;
            const int n = 32 * nb + (lane & 31), jt = n >> 8, bj = (n >> 7) & 1, i = n & 127;
            const float* src = (bj ? a.in[I_WU] : a.in[I_WG]) + (size_t)le * DM * DE;
            transpose_item_f8(src, DE, 64 * kb, jt * 128 + i, (unsigned char*)(ws + WS_WGU) + (size_t)le * DM * DM, DM, 32 * nb, 64 * kb, scr, lane);
            continue; }
        r -= N3;
        if (r < N4) {
            const int le = r / 256, kb = (r % 256) / 32, nb = r % 32;
            transpose_item_f8(a.in[I_WDN] + (size_t)le * DE * DM, DM, 64 * kb, 32 * nb + (lane & 31), (unsigned char*)(ws + WS_WD) + (size_t)le * DM * DE, DE, 32 * nb, 64 * kb, scr, lane);
            continue; }
        r -= N4;
        if (r < N5) {
            const int l = r / 1024, kdg = (r % 1024) / 16, nb = r % 16;
            const int n = nb * 64 + lane, kd0 = kdg * 8, g = kd0 >> 7, c0 = kd0 & 127;
            const float* wo = a.in[I_WOUT] + (size_t)l * DM * DM + (size_t)(512 + g * 128) * DM + n;
            const float* ps = a.in[I_PSCALE] + l * 512 + g * 128;
            const float* wp = a.in[I_WPOOL] + ((size_t)(l * 4 + g) * 128 + c0) * 128;
            float acc[8];
#pragma unroll
            for (int j = 0; j < 8; ++j) acc[j] = 0.f;
            for (int e = 0; e < 128; ++e) { const float w = wo[(size_t)e * DM] * ps[e];
#pragma unroll
                for (int j = 0; j < 8; ++j) acc[j] += wp[j * 128 + e] * w; }
            u32x2 o; o.x = pk4_fp8(128.f * acc[0], 128.f * acc[1], 128.f * acc[2], 128.f * acc[3]); o.y = pk4_fp8(128.f * acc[4], 128.f * acc[5], 128.f * acc[6], 128.f * acc[7]);
            *(u32x2*)((unsigned char*)(ws + WS_WOUT) + (size_t)l * DM * DM + (size_t)n * DM + 512 + kd0) = o;
            continue; }
        r -= N5;
        {
            const int ent = r * 64 + lane, pos = ent >> 3, i = ent & 7;
            const float inv = (float)exp2(-(double)i / 8.0 * 18.931568569324174);
            const float ang = (float)pos * inv;
            float* t = (float*)(ws + WS_ROPE) + ent * 2;
            t[0] = (float)cos((double)ang); t[1] = (float)sin((double)ang);
        }
    }
    for (int i = c.bid * 512 + c.tid; i < 2 * NB * NH * NBLK * HD; i += c.G * 512) ((float*)(ws + WS_KBAR))[i] = 0.f;
    __syncthreads();
    if (c.bid < 192) {
        float* condT = (float*)c.lds;
        float* red = (float*)(c.lds + 65536);
        for (int idx = c.tid; idx < NB * DM; idx += 512) { const int b = idx >> 10, k = idx & 1023; const float v = a.in[I_C][idx]; condT[k * 16 + b] = v / (1.f + __expf(-v)); }
        __syncthreads();
        for (int u = c.bid; u < 192; u += c.G) {
            const int l = u / 96, n0 = (u % 96) * 64;
            const float* W = a.in[I_WMOD] + (size_t)l * DM * NMOD + n0 + lane;
            float acc[16];
#pragma unroll
            for (int b = 0; b < 16; ++b) acc[b] = 0.f;
            for (int k = 128 * c.wave; k < 128 * c.wave + 128; k += 8) {
                float wv[8];
#pragma unroll
                for (int j = 0; j < 8; ++j) wv[j] = W[(size_t)(k + j) * NMOD];
#pragma unroll
                for (int j = 0; j < 8; ++j) {
                    const f32x4* cp = (const f32x4*)(condT + (k + j) * 16);
#pragma unroll
                    for (int q = 0; q < 4; ++q) { const f32x4 cv = cp[q]; acc[4 * q + 0] += cv.x * wv[j]; acc[4 * q + 1] += cv.y * wv[j]; acc[4 * q + 2] += cv.z * wv[j]; acc[4 * q + 3] += cv.w * wv[j]; }
                }
            }
#pragma unroll
            for (int b = 0; b < 16; ++b) red[(c.wave * 16 + b) * 64 + lane] = acc[b];
            __syncthreads();
            for (int o = c.tid; o < 1024; o += 512) { const int b = o >> 6, cc = o & 63; float s = a.in[I_BMOD][l * NMOD + n0 + cc];
#pragma unroll
                for (int w = 0; w < 8; ++w) s += red[(w * 16 + b) * 64 + cc];
                ((float*)(ws + WS_MOD))[(size_t)(l * NB + b) * NMOD + n0 + cc] = s; }
            __syncthreads();
        }
    }
}

DEVFN void row_stats(const f32x4 (&v)[4], float& mean, float& rstd) {
    float s = 0.f;
#pragma unroll
    for (int j = 0; j < 4; ++j) s += (v[j].x + v[j].y) + (v[j].z + v[j].w);
    mean = wave_sum(s) * (1.f / DM);
    float q = 0.f;
#pragma unroll
    for (int j = 0; j < 4; ++j) { const f32x4 d = v[j] - mean; q += (d.x * d.x + d.y * d.y) + (d.z * d.z + d.w * d.w); }
    rstd = 1.f / sqrtf(wave_sum(q) * (1.f / DM) + LN_EPS);
}
DEVFN void row_load(const float* p, int lane, f32x4 (&v)[4]) {
#pragma unroll
    for (int j = 0; j < 4; ++j) v[j] = *(const f32x4*)(p + 4 * lane + 256 * j);
}
DEVFN void row_mod_store(f32x4 (&v)[4], const float* sc, const float* sh, bf16_t* out, int lane) {
    float mean, rstd; row_stats(v, mean, rstd);
#pragma unroll
    for (int j = 0; j < 4; ++j) {
        const f32x4 s = *(const f32x4*)(sc + 4 * lane + 256 * j), h = *(const f32x4*)(sh + 4 * lane + 256 * j);
        v[j] = (v[j] - mean) * rstd * (s + 1.f) + h;
        u32x2 o; o.x = pk2(v[j].x, v[j].y); o.y = pk2(v[j].z, v[j].w);
        *(u32x2*)(out + 4 * lane + 256 * j) = o;
    }
}

DEVFN void wave_gemm32(f32x16& acc, const bf16_t* ap, const bf16_t* bp, int K) {
#pragma unroll 4
    for (int k = 0; k < K; k += 16) {
        const bf16x8 av = *(const bf16x8*)(ap + k), bv = *(const bf16x8*)(bp + k);
        acc = __builtin_amdgcn_mfma_f32_32x32x16_bf16(av, bv, acc, 0, 0, 0);
    }
}

DEVFN void ph_inproj_naive(const Args& a, const Ctx& c, int l) {
    const bf16_t* A = (const bf16_t*)(a.ws + WS_HB); const bf16_t* Bt = (const bf16_t*)(a.ws + WS_WIN) + (size_t)l * DIN * DM;
    bf16_t* O = (bf16_t*)(a.ws + WS_QKVP);
    const int r32 = c.lane & 31, hi = c.lane >> 5, wy = c.wave >> 2, wx = c.wave & 3;
    for (int u = c.bid; u < 512 * 16; u += c.G) {
        const int mt = u >> 4, nt = u & 15;
        f32x16 acc = {};
        wave_gemm32(acc, A + (size_t)(mt * 64 + wy * 32 + r32) * DM + hi * 8, Bt + (size_t)(nt * 128 + wx * 32 + r32) * DM + hi * 8, DM);
        const int nl = inproj_nlog(nt * 128 + wx * 32 + r32);
#pragma unroll
        for (int r = 0; r < 16; ++r) O[(size_t)(mt * 64 + wy * 32 + crow(r, hi)) * DIN + nl] = (bf16_t)f2bf(acc[r]);
    }
}

DEVFN void ph_rope_naive(const Args& a, const Ctx& c) {
    bf16_t* O = (bf16_t*)(a.ws + WS_QKVP); const float* rope = (const float*)(a.ws + WS_ROPE);
    for (int idx = c.bid * 512 + c.tid; idx < NTOK * 16; idx += c.G * 512) {
        const int which = idx & 1, hh = (idx >> 1) & 7, m = idx >> 4, t = m & (SEQ - 1);
        bf16_t* p = O + (size_t)m * DIN + which * 512 + hh * 64;
        float v[64];
#pragma unroll
        for (int q = 0; q < 8; ++q) { const u32x4 w = *(const u32x4*)(p + 8 * q);
            v[8 * q + 0] = bf_lo(w.x); v[8 * q + 1] = bf_hi(w.x); v[8 * q + 2] = bf_lo(w.y); v[8 * q + 3] = bf_hi(w.y);
            v[8 * q + 4] = bf_lo(w.z); v[8 * q + 5] = bf_hi(w.z); v[8 * q + 6] = bf_lo(w.w); v[8 * q + 7] = bf_hi(w.w); }
#pragma unroll
        for (int i = 0; i < 8; ++i) { const float cs = rope[(t * 8 + i) * 2], sn = rope[(t * 8 + i) * 2 + 1]; const float x1 = v[i], x2 = v[8 + i];
            v[i] = x1 * cs - x2 * sn; v[8 + i] = x2 * cs + x1 * sn; }
        const float sc = which == 0 ? QSCALE : 1.f;
#pragma unroll
        for (int q = 0; q < 8; ++q) { u32x4 w; w.x = pk2(v[8 * q] * sc, v[8 * q + 1] * sc); w.y = pk2(v[8 * q + 2] * sc, v[8 * q + 3] * sc); w.z = pk2(v[8 * q + 4] * sc, v[8 * q + 5] * sc); w.w = pk2(v[8 * q + 6] * sc, v[8 * q + 7] * sc);
            *(u32x4*)(p + 8 * q) = w; }
    }
}

DEVFN void ph_kbar(const Args& a, const Ctx& c, int l) {
    const bf16_t* O = (const bf16_t*)(a.ws + WS_QKVP); float* kbar = (float*)(a.ws + WS_KBAR) + (size_t)l * NB * NH * NBLK * HD;
    for (int it = c.gw; it < NB * NH * NBLK; it += c.NGW) {
        const int n = it & 7, hh = (it >> 3) & 7, b = it >> 6;
        const bf16_t* p = O + (size_t)(b * SEQ + n * MBLK) * DIN + 512 + hh * 64 + c.lane;
        float s = 0.f;
#pragma unroll 8
        for (int j = 0; j < MBLK; ++j) s += bf2f(p[(size_t)j * DIN]);
        kbar[(size_t)it * 64 + c.lane] = s * (1.f / MBLK);
    }
}

DEVFN void ph_pool(const Args& a, const Ctx& c) {
    const bf16_t* P = (const bf16_t*)(a.ws + WS_QKVP) + 1536; unsigned char* AD = (unsigned char*)(a.ws + WS_AD) + 512;
    for (int it = c.bid * 512 + c.tid; it < (NTOK / 16) * 64; it += c.G * 512) {
        const int cg = it & 63, m0 = (it >> 6) * 16, t0 = m0 & (SEQ - 1), g = cg >> 4, w = 2 << g;
        const bf16_t* pc = P + cg * 8;
        float s[8];
#pragma unroll
        for (int j = 0; j < 8; ++j) s[j] = 0.f;
        for (int i = 1; i < w; ++i) if (t0 - i >= 0) { const u32x4 v = *(const u32x4*)(pc + (size_t)(m0 - i) * DIN);
            s[0] += bf_lo(v.x); s[1] += bf_hi(v.x); s[2] += bf_lo(v.y); s[3] += bf_hi(v.y); s[4] += bf_lo(v.z); s[5] += bf_hi(v.z); s[6] += bf_lo(v.w); s[7] += bf_hi(v.w); }
#pragma unroll 4
        for (int r = 0; r < 16; ++r) {
            const int t = t0 + r; const u32x4 v = *(const u32x4*)(pc + (size_t)(m0 + r) * DIN);
            const float f[8] = {bf_lo(v.x), bf_hi(v.x), bf_lo(v.y), bf_hi(v.y), bf_lo(v.z), bf_hi(v.z), bf_lo(v.w), bf_hi(v.w)};
#pragma unroll
            for (int j = 0; j < 8; ++j) s[j] += f[j];
            const int cnt = (t + 1 < w) ? t + 1 : w; const float ic = 1.f / (float)cnt;
            u32x2 o; o.x = pk4_fp8(s[0] * ic - f[0], s[1] * ic - f[1], s[2] * ic - f[2], s[3] * ic - f[3]); o.y = pk4_fp8(s[4] * ic - f[4], s[5] * ic - f[5], s[6] * ic - f[6], s[7] * ic - f[7]);
            *(u32x2*)(AD + (size_t)(m0 + r) * DM + cg * 8) = o;
            if (t - w + 1 >= 0) { const u32x4 q = *(const u32x4*)(pc + (size_t)(m0 + r - w + 1) * DIN);
                s[0] -= bf_lo(q.x); s[1] -= bf_hi(q.x); s[2] -= bf_lo(q.y); s[3] -= bf_hi(q.y); s[4] -= bf_lo(q.z); s[5] -= bf_hi(q.z); s[6] -= bf_lo(q.w); s[7] -= bf_hi(q.w); }
        }
    }
}

DEVFN void ph_wout_naive(const Args& a, const Ctx& c, int l) {
    const bf16_t* A = (const bf16_t*)(a.ws + WS_AD); const bf16_t* Bt = (const bf16_t*)(a.ws + WS_WOUT) + (size_t)l * DM * DM;
    float* Y = (float*)(a.ws + WS_QKVP);
    const int r32 = c.lane & 31, hi = c.lane >> 5, wy = c.wave >> 2, wx = c.wave & 3;
    for (int u = c.bid; u < 512 * 8; u += c.G) {
        const int mt = u >> 3, nt = u & 7;
        f32x16 acc = {};
        wave_gemm32(acc, A + (size_t)(mt * 64 + wy * 32 + r32) * DM + hi * 8, Bt + (size_t)(nt * 128 + wx * 32 + r32) * DM + hi * 8, DM);
#pragma unroll
        for (int r = 0; r < 16; ++r) Y[(size_t)(mt * 64 + wy * 32 + crow(r, hi)) * DM + nt * 128 + wx * 32 + r32] = acc[r];
    }
}

struct MoeTab { int* cnt; int* tp; };
DEVFN MoeTab moe_table(const Args& a, const Ctx& c, int l, unsigned char* lds_at) {
    MoeTab t; t.cnt = (int*)lds_at; t.tp = t.cnt + 32;
    if (c.tid < NCLS) t.cnt[c.tid] = (int)__hip_atomic_load((unsigned*)(a.ws + WS_CTL) + CW_CNT + l * 32 + c.tid, RLX_AGENT);
    __syncthreads();
    if (c.tid == 0) { int s = 0; for (int k = 0; k < NCLS; ++k) { t.tp[k] = s; s += (t.cnt[k] + 255) >> 8; } t.tp[NCLS] = s; }
    __syncthreads();
    return t;
}
DEVFN void cls_experts(int cls, int& e1, int& e2) { const int g = cls / 6, p = cls % 6; const int lo = p < 3 ? 0 : (p < 5 ? 1 : 2), hi = p < 3 ? p + 1 : (p < 5 ? p - 1 : 3); e1 = g * 4 + lo; e2 = g * 4 + hi; }

DEVFN void ph_gateup_naive(const Args& a, const Ctx& c, int l) {
    const MoeTab T = moe_table(a, c, l, c.lds);
    const int ntiles = T.tp[NCLS];
    const bf16_t* HB = (const bf16_t*)(a.ws + WS_HB); const bf16_t* WGU = (const bf16_t*)(a.ws + WS_WGU) + (size_t)l * NE * DM * DM;
    const int* list = (const int*)(a.ws + WS_LIST); const float* rw = (const float*)(a.ws + WS_RW);
    bf16_t* ACT = (bf16_t*)(a.ws + WS_QKVP);
    const int r32 = c.lane & 31, hi = c.lane >> 5, wy = c.wave >> 2, wx = c.wave & 3;
    for (int u = c.bid; u < ntiles * 32; u += c.G) {
        const int Tt = u >> 5, sub = (u >> 3) & 3, half = (u >> 2) & 1, jt = u & 3;
        int cls = 0; while (Tt >= T.tp[cls + 1]) ++cls;
        const int j = Tt - T.tp[cls], cnt = T.cnt[cls];
        int e1, e2; cls_experts(cls, e1, e2); const int e = half ? e2 : e1;
        const int lr = sub * 64 + wy * 32 + r32, li = 256 * j + lr;
        const int tok = list[(size_t)cls * LISTCAP + (li < cnt ? li : 256 * j)];
        const bf16_t* ap = HB + (size_t)tok * DM + hi * 8;
        const bf16_t* bg = WGU + (size_t)e * DM * DM + (size_t)(jt * 256 + wx * 32 + r32) * DM + hi * 8;
        f32x16 ag = {}, au = {};
        wave_gemm32(ag, ap, bg, DM); wave_gemm32(au, ap, bg + (size_t)128 * DM, DM);
#pragma unroll
        for (int r = 0; r < 16; ++r) {
            const int lro = sub * 64 + wy * 32 + crow(r, hi), lio = 256 * j + lro;
            const float wgt = lio < cnt ? rw[((size_t)cls * LISTCAP + lio) * 2 + half] : 0.f;
            const float g = ag[r], act = g / (1.f + __expf(-g)) * au[r] * wgt;
            ACT[(size_t)(256 * Tt + lro) * DM + half * 512 + jt * 128 + wx * 32 + r32] = (bf16_t)f2bf(act);
        }
    }
}

DEVFN void ph_down_naive(const Args& a, const Ctx& c, int l) {
    const MoeTab T = moe_table(a, c, l, c.lds);
    const int ntiles = T.tp[NCLS];
    const bf16_t* ACT = (const bf16_t*)(a.ws + WS_QKVP); const bf16_t* WD = (const bf16_t*)(a.ws + WS_WD) + (size_t)l * NE * DM * DE;
    const int* list = (const int*)(a.ws + WS_LIST);
    bf16_t* Y2 = (bf16_t*)(a.ws + WS_AD);
    const int r32 = c.lane & 31, hi = c.lane >> 5, wy = c.wave >> 2, wx = c.wave & 3;
    for (int u = c.bid; u < ntiles * 32; u += c.G) {
        const int Tt = u >> 5, sub = (u >> 3) & 3, nt = u & 7;
        int cls = 0; while (Tt >= T.tp[cls + 1]) ++cls;
        const int j = Tt - T.tp[cls], cnt = T.cnt[cls];
        int e1, e2; cls_experts(cls, e1, e2);
        const bf16_t* ap = ACT + (size_t)(256 * Tt + sub * 64 + wy * 32 + r32) * DM + hi * 8;
        const int n = nt * 128 + wx * 32 + r32;
        f32x16 acc = {};
        wave_gemm32(acc, ap, WD + (size_t)e1 * DM * DE + (size_t)n * DE + hi * 8, DE);
        wave_gemm32(acc, ap + DE, WD + (size_t)e2 * DM * DE + (size_t)n * DE + hi * 8, DE);
#pragma unroll
        for (int r = 0; r < 16; ++r) {
            const int lio = 256 * j + sub * 64 + wy * 32 + crow(r, hi);
            if (lio < cnt) { const int tok = list[(size_t)cls * LISTCAP + lio]; Y2[(size_t)tok * DM + n] = (bf16_t)f2bf(acc[r]); }
        }
    }
}

constexpr size_t WS_X1B = WS_X1, WS_X2B = WS_X1 + 64 * MiB;
constexpr int ROWS_PER_WAVE = 16;
DEVFN void vec_load(const float* p, int lane, f32x4 (&v)[4]) {
#pragma unroll
    for (int j = 0; j < 4; ++j) v[j] = *(const f32x4*)(p + 4 * lane + 256 * j);
}
DEVFN void bfrow_load(const bf16_t* p, int lane, u32x2 (&w)[4]) {
#pragma unroll
    for (int j = 0; j < 4; ++j) w[j] = *(const u32x2*)(p + 4 * lane + 256 * j);
}
DEVFN f32x4 bf4(u32x2 w) { return (f32x4){bf_lo(w.x), bf_hi(w.x), bf_lo(w.y), bf_hi(w.y)}; }
DEVFN void bfrow_store(bf16_t* p, int lane, const f32x4 (&v)[4]) {
#pragma unroll
    for (int j = 0; j < 4; ++j) { u32x2 o; o.x = pk2(v[j].x, v[j].y); o.y = pk2(v[j].z, v[j].w); *(u32x2*)(p + 4 * lane + 256 * j) = o; }
}
DEVFN void f8row_store(unsigned char* p, int lane, const f32x4 (&v)[4]) {
#pragma unroll
    for (int j = 0; j < 4; ++j) *(unsigned*)(p + 4 * lane + 256 * j) = pk4_fp8(v[j].x, v[j].y, v[j].z, v[j].w);
}
DEVFN void ln_mod(f32x4 (&v)[4], const f32x4 (&sc)[4], const f32x4 (&sh)[4]) {
    float mean, rstd; row_stats(v, mean, rstd);
#pragma unroll
    for (int j = 0; j < 4; ++j) v[j] = (v[j] - mean) * rstd * (sc[j] + 1.f) + sh[j];
}
DEVFN void ln_aff(f32x4 (&v)[4], const f32x4 (&g)[4], const f32x4 (&b)[4]) {
    float mean, rstd; row_stats(v, mean, rstd);
#pragma unroll
    for (int j = 0; j < 4; ++j) v[j] = (v[j] - mean) * rstd * g[j] + b[j];
}

DEVFN void ph_h1_rows(const Args& a, const Ctx& c) {
    const float* mod = (const float*)(a.ws + WS_MOD); bf16_t* HB = (bf16_t*)(a.ws + WS_HB);
    for (int base = c.gw * ROWS_PER_WAVE; base < NTOK; base += c.NGW * ROWS_PER_WAVE) {
        const float* mb = mod + (size_t)(base >> 11) * NMOD;
        f32x4 sc[4], sh[4]; vec_load(mb + DM, c.lane, sc); vec_load(mb, c.lane, sh);
        f32x4 cur[4], nxt[4]; vec_load(a.in[I_X] + (size_t)base * DM, c.lane, cur);
#pragma unroll 1
        for (int i = 0; i < ROWS_PER_WAVE; ++i) {
            const int m = base + i;
            if (i + 1 < ROWS_PER_WAVE) vec_load(a.in[I_X] + (size_t)(m + 1) * DM, c.lane, nxt);
            ln_mod(cur, sc, sh); f8row_store((unsigned char*)HB + (size_t)m * DM, c.lane, cur);
#pragma unroll
            for (int j = 0; j < 4; ++j) cur[j] = nxt[j];
        }
    }
}

DEVFN f32x4 reduce16(const float (&lg)[16]) {
    float t[8], u[4];
#pragma unroll
    for (int e = 0; e < 8; ++e) { auto rr = __builtin_amdgcn_permlane32_swap(__float_as_uint(lg[e]), __float_as_uint(lg[e + 8]), false, false); t[e] = __uint_as_float(rr[0]) + __uint_as_float(rr[1]); }
#pragma unroll
    for (int k = 0; k < 4; ++k) { auto rr = __builtin_amdgcn_permlane16_swap(__float_as_uint(t[k]), __float_as_uint(t[k + 4]), false, false); u[k] = __uint_as_float(rr[0]) + __uint_as_float(rr[1]); }
#pragma unroll
    for (int k = 0; k < 4; ++k) { u[k] = swz_xor_add(u[k], 1); u[k] = swz_xor_add(u[k], 2); u[k] = swz_xor_add(u[k], 4); u[k] = swz_xor_add(u[k], 8); }
    return (f32x4){u[0], u[1], u[2], u[3]};
}

DEVFN void rowc_load(const Args& a, int l, int m, int lane, f32x4 (&x)[4], u32x2 (&y)[4]) {
    if (l == 0) vec_load(a.in[I_X] + (size_t)m * DM, lane, x);
    else { u32x2 w[4]; bfrow_load((const bf16_t*)(a.ws + WS_X2B) + (size_t)m * DM, lane, w);
#pragma unroll
        for (int j = 0; j < 4; ++j) { x[j].x = __uint_as_float(w[j].x); x[j].y = __uint_as_float(w[j].y); } }
    bfrow_load((const bf16_t*)(a.ws + WS_QKVP) + (size_t)m * DM, lane, y);
}
DEVFN void rowc_step(const Args& a, int l, int m, int lane, const f32x4 (&x)[4], const u32x2 (&y)[4], const float* vg1, const float* vsc, const float* vsh, f32x4 (&v)[4]) {
    int z_ = 0; asm volatile("" : "+v"(z_));
    f32x4 g1[4]; vec_load(vg1 + z_, lane, g1);
#pragma unroll
    for (int j = 0; j < 4; ++j) { const f32x4 xv = (l == 0) ? x[j] : bf4((u32x2){__float_as_uint(x[j].x), __float_as_uint(x[j].y)}); v[j] = xv * ALPHA + g1[j] * bf4(y[j]); }
    { f32x4 lg[4], lb[4]; vec_load(a.in[I_LN1G] + l * DM + z_, lane, lg); vec_load(a.in[I_LN1B] + l * DM + z_, lane, lb); ln_aff(v, lg, lb); }
    bfrow_store((bf16_t*)(a.ws + WS_X1B) + (size_t)m * DM, lane, v);
    { f32x4 sc[4], sh[4]; vec_load(vsc + z_, lane, sc); vec_load(vsh + z_, lane, sh); ln_mod(v, sc, sh); }
    f8row_store((unsigned char*)(a.ws + WS_HB) + (size_t)m * DM, lane, v);
}

DEVFN void ph_rows_c(const Args& a, const Ctx& c, int l, bool publish) {
    const float* mod = (const float*)(a.ws + WS_MOD) + (size_t)l * NB * NMOD;
    const bf16_t* Y = (const bf16_t*)(a.ws + WS_QKVP); const bf16_t* X2B = (const bf16_t*)(a.ws + WS_X2B);
    bf16_t* X1B = (bf16_t*)(a.ws + WS_X1B); bf16_t* HB = (bf16_t*)(a.ws + WS_HB);
    float* wr = (float*)c.lds;
    float* vsc = (float*)(c.lds + 65536); float* vsh = vsc + DM; float* vg1 = vsh + DM;
    int* lcnt = (int*)(c.lds + 65536 + 12288); int* lbase = lcnt + 32;
    int* rcls = lbase + 32; float* rw1 = (float*)(rcls + 8 * 64); float* rw2 = rw1 + 8 * 64; int* rrow = (int*)(rw2 + 8 * 64); float* lgs = (float*)(rrow + 8 * 64);
    for (int i = c.tid; i < DM * NE; i += 512) wr[(i & 15) * DM + (i >> 4)] = a.in[I_WR][i];
    if (c.tid < 32) lcnt[c.tid] = 0;
    __syncthreads();
    int nr = 0;
    for (int base = c.gw * ROWS_PER_WAVE; base < NTOK; base += c.NGW * ROWS_PER_WAVE) {
        const float* mb = mod + (size_t)(base >> 11) * NMOD;
        __syncthreads();
        for (int i = c.tid; i < 3 * DM; i += 512) vsc[i] = (i < DM) ? mb[4 * DM + i] : (i < 2 * DM ? mb[3 * DM + (i - DM)] : mb[2 * DM + (i - 2 * DM)]);
        __syncthreads();
#pragma unroll 1
        for (int i = 0; i < ROWS_PER_WAVE; i += 2) {
            const int m = __builtin_amdgcn_readfirstlane(base + i);
            f32x4 va[4], vb[4];
            { f32x4 xa[4], xb[4]; u32x2 ya[4], yb[4];
              rowc_load(a, l, m, c.lane, xa, ya); rowc_load(a, l, m + 1, c.lane, xb, yb);
              rowc_step(a, l, m, c.lane, xa, ya, vg1, vsc, vsh, va);
              rowc_step(a, l, m + 1, c.lane, xb, yb, vg1, vsc, vsh, vb); }
            float la[16], lb2[16];
#pragma unroll
            for (int e = 0; e < 16; ++e) { la[e] = 0.f; lb2[e] = 0.f; }
#pragma unroll
            for (int j = 0; j < 4; ++j)
#pragma unroll
                for (int e = 0; e < 16; ++e) { const f32x4 w = *(const f32x4*)(wr + e * DM + 4 * c.lane + 256 * j);
                    la[e] += (va[j].x * w.x + va[j].y * w.y) + (va[j].z * w.z + va[j].w * w.w); lb2[e] += (vb[j].x * w.x + vb[j].y * w.y) + (vb[j].z * w.z + vb[j].w * w.w);
                    if ((e & 7) == 7) __builtin_amdgcn_sched_barrier(0); }
            { const f32x4 ua = reduce16(la), ub = reduce16(lb2);
              if ((c.lane & 15) == 0) { *(f32x4*)(lgs + (c.wave * 16 + i) * 16 + (c.lane >> 4) * 4) = ua; *(f32x4*)(lgs + (c.wave * 16 + i + 1) * 16 + (c.lane >> 4) * 4) = ub; } }
        }
        LDS_WAIT();
        if (c.lane < ROWS_PER_WAVE) {
            float lg16[16], rb[16];
#pragma unroll
            for (int e = 0; e < 16; ++e) rb[e] = a.in[I_RB][e];
#pragma unroll
            for (int q = 0; q < 4; ++q) { const f32x4 t = *(const f32x4*)(lgs + (c.wave * 16 + c.lane) * 16 + 4 * q); lg16[4 * q] = t.x; lg16[4 * q + 1] = t.y; lg16[4 * q + 2] = t.z; lg16[4 * q + 3] = t.w; }
            float mx = lg16[0];
#pragma unroll
            for (int e = 1; e < 16; ++e) mx = fmaxf(mx, lg16[e]);
            float sum = 0.f, scr[16];
#pragma unroll
            for (int e = 0; e < 16; ++e) { scr[e] = __expf(lg16[e] - mx); sum += scr[e]; }
            const float isum = 1.f / sum;
#pragma unroll
            for (int e = 0; e < 16; ++e) scr[e] *= isum;
            float bestg = -3.4e38f; int gb = 0, bi1 = 0, bi2 = 1; float bw1 = 0.f, bw2 = 0.f;
#pragma unroll
            for (int g = 0; g < 4; ++g) {
                float m1 = scr[4 * g] + rb[4 * g], s1 = scr[4 * g]; int i1 = 0;
#pragma unroll
                for (int q = 1; q < 4; ++q) { const float sv = scr[4 * g + q] + rb[4 * g + q]; const bool ok = sv > m1; m1 = ok ? sv : m1; s1 = ok ? scr[4 * g + q] : s1; i1 = ok ? q : i1; }
                float m2 = -3.4e38f, s2 = 0.f; int i2 = 0;
#pragma unroll
                for (int q = 0; q < 4; ++q) { const float sv = scr[4 * g + q] + rb[4 * g + q]; const bool ok = (q != i1) && sv > m2; m2 = ok ? sv : m2; s2 = ok ? scr[4 * g + q] : s2; i2 = ok ? q : i2; }
                const float gs = m1 + m2; const bool better = gs > bestg;
                bestg = better ? gs : bestg; gb = better ? g : gb; bi1 = better ? i1 : bi1; bi2 = better ? i2 : bi2; bw1 = better ? s1 : bw1; bw2 = better ? s2 : bw2;
            }
            const float inv = 1.f / (bw1 + bw2);
            const int lo = bi1 < bi2 ? bi1 : bi2, hi2 = bi1 < bi2 ? bi2 : bi1;
            const float wlo = (bi1 < bi2 ? bw1 : bw2) * inv, whi = (bi1 < bi2 ? bw2 : bw1) * inv;
            const int pidx = lo == 0 ? hi2 - 1 : (lo == 1 ? hi2 + 1 : 5);
            const int slot = c.wave * 64 + nr + c.lane;
            rcls[slot] = gb * 6 + pidx; rw1[slot] = wlo; rw2[slot] = whi; rrow[slot] = base + c.lane;
        }
        nr += ROWS_PER_WAVE;
        LDS_WAIT();
    }
    LDS_WAIT();
    if (!publish) return;
    int rank = 0, cls = 0;
    if (c.lane < nr) { cls = rcls[c.wave * 64 + c.lane]; rank = atomicAdd(&lcnt[cls], 1); }
    __syncthreads();
    if (c.tid < NCLS) lbase[c.tid] = (int)__hip_atomic_fetch_add((unsigned*)(a.ws + WS_CTL) + CW_CNT + l * 32 + c.tid, (unsigned)lcnt[c.tid], RLX_AGENT);
    __syncthreads();
    if (c.lane < nr) {
        const int pos = lbase[cls] + rank;
        ((int*)(a.ws + WS_LIST))[(size_t)cls * LISTCAP + pos] = rrow[c.wave * 64 + c.lane];
        float* rw = (float*)(a.ws + WS_RW) + ((size_t)cls * LISTCAP + pos) * 2;
        rw[0] = rw1[c.wave * 64 + c.lane]; rw[1] = rw2[c.wave * 64 + c.lane];
    }
}

DEVFN void ph_rows_g(const Args& a, const Ctx& c, int l) {
    const float* mod = (const float*)(a.ws + WS_MOD) + (size_t)l * NB * NMOD;
    const bf16_t* X1B = (const bf16_t*)(a.ws + WS_X1B); const bf16_t* Y2 = (const bf16_t*)(a.ws + WS_AD);
    bf16_t* X2B = (bf16_t*)(a.ws + WS_X2B); bf16_t* HB = (bf16_t*)(a.ws + WS_HB);
    for (int base = c.gw * ROWS_PER_WAVE; base < NTOK; base += c.NGW * ROWS_PER_WAVE) {
        const float* mb = mod + (size_t)(base >> 11) * NMOD; const float* mb1 = mb + (size_t)NB * NMOD;
        f32x4 g2[4], lg[4], lb[4], sc[4], sh[4];
        vec_load(mb + 5 * DM, c.lane, g2); vec_load(a.in[I_LN2G] + l * DM, c.lane, lg); vec_load(a.in[I_LN2B] + l * DM, c.lane, lb);
        if (l == 0) { vec_load(mb1 + DM, c.lane, sc); vec_load(mb1, c.lane, sh); }
        u32x2 xc[4], xn[4], yc[4], yn[4];
        bfrow_load(X1B + (size_t)base * DM, c.lane, xc); bfrow_load(Y2 + (size_t)base * DM, c.lane, yc);
#pragma unroll 1
        for (int i = 0; i < ROWS_PER_WAVE; ++i) {
            const int m = base + i;
            if (i + 1 < ROWS_PER_WAVE) { bfrow_load(X1B + (size_t)(m + 1) * DM, c.lane, xn); bfrow_load(Y2 + (size_t)(m + 1) * DM, c.lane, yn); }
            f32x4 v[4];
#pragma unroll
            for (int j = 0; j < 4; ++j) v[j] = bf4(xc[j]) * ALPHA + g2[j] * bf4(yc[j]);
            ln_aff(v, lg, lb);
            if (l == 0) { bfrow_store(X2B + (size_t)m * DM, c.lane, v); ln_mod(v, sc, sh); f8row_store((unsigned char*)HB + (size_t)m * DM, c.lane, v); }
            else {
#pragma unroll
                for (int j = 0; j < 4; ++j) *(f32x4*)(a.out + (size_t)m * DM + 4 * c.lane + 256 * j) = v[j]; }
#pragma unroll
            for (int j = 0; j < 4; ++j) { xc[j] = xn[j]; yc[j] = yn[j]; }
        }
    }
}

constexpr int MOETAB_OFF = 131072 + 512;
DEVFN void ph_inproj_fast(const Args& a, const Ctx& c, int l, bool dummy_kbar) {
    pg8::DenseSched S; S.so.init(NTOK, DIN, c.G, c.bid); S.A = (const char*)(a.ws + WS_HB); S.Bt = (const char*)(a.ws + WS_WIN) + (size_t)l * DIN * DM; S.lda = DM; S.ldb = DM;
    const pg8::EpiInproj E{(bf16_t*)(a.ws + WS_QKVP), (const float*)(a.ws + WS_ROPE), (dummy_kbar ? (float*)(a.ws + WS_RW) : (float*)(a.ws + WS_KBAR)) + (size_t)l * NB * NH * NBLK * HD};
    pg8::gemm_phase2<pg8::EpiInproj, pg8::DenseSched, true, true, false, true, 127 - 5, 127>(c.lds3, DM, DM, S, E, c.tid);
}
DEVFN void ph_wout_fast(const Args& a, const Ctx& c, int l) {
    pg8::DenseSched S; S.so.init(NTOK, DM, c.G, c.bid); S.A = (const char*)(a.ws + WS_AD); S.Bt = (const char*)(a.ws + WS_WOUT) + (size_t)l * DM * DM; S.lda = DM; S.ldb = DM;
    const pg8::EpiBf16<0> E{(bf16_t*)(a.ws + WS_QKVP), DM, nullptr, 0, 0, 1.f};
    pg8::gemm_phase2<pg8::EpiBf16<0>, pg8::DenseSched, true, true, false, true, 127 - 5, 127 - 5, true, 127 - 7, 127>(c.lds3, DM, DM, S, E, c.tid);
}
DEVFN void moe_table_lds(const Args& a, const Ctx& c, int l) {
    int* cnt = (int*)(c.lds + MOETAB_OFF); int* tp = cnt + 32;
    if (c.tid < NCLS) cnt[c.tid] = (int)__hip_atomic_load((unsigned*)(a.ws + WS_CTL) + CW_CNT + l * 32 + c.tid, RLX_AGENT);
    __syncthreads();
    if (c.tid == 0) { int s = 0; for (int k = 0; k < NCLS; ++k) { tp[k] = s; s += (cnt[k] + 255) >> 8; } tp[NCLS] = s; }
    __syncthreads();
}
DEVFN void ph_gateup_fast(const Args& a, const Ctx& c, int l) {
    moe_table_lds(a, c, l);
    pg8::GateUpSched S; S.cnt = (const LAS int*)(c.lds3 + MOETAB_OFF); S.tp = S.cnt + 32; S.npn_shift = 3; S.nunits = S.tp[NCLS] * 8; S.G = c.G; S.c = c.bid;
    S.HB = (const char*)(a.ws + WS_HB); S.list = (const int*)(a.ws + WS_LIST); S.W = (const char*)(a.ws + WS_WGU) + (size_t)l * NE * DM * DM;
    const pg8::EpiGateUp E{(unsigned char*)(a.ws + WS_QKVP), (const float*)(a.ws + WS_RW)};
    pg8::gemm_phase2<pg8::EpiGateUp, pg8::GateUpSched, true, true, false, true, 127 - 5, 127>(c.lds3, DM, DM, S, E, c.tid);
}
DEVFN void ph_down_fast(const Args& a, const Ctx& c, int l) {
    moe_table_lds(a, c, l);
    pg8::DownSched S; S.cnt = (const LAS int*)(c.lds3 + MOETAB_OFF); S.tp = S.cnt + 32; S.npn_shift = 2; S.nunits = S.tp[NCLS] * 4; S.G = c.G; S.c = c.bid;
    S.ACT = (const char*)(a.ws + WS_QKVP); S.W = (const char*)(a.ws + WS_WD) + (size_t)l * NE * DM * DE;
    const pg8::EpiDown E{(bf16_t*)(a.ws + WS_AD), (const int*)(a.ws + WS_LIST)};
    pg8::gemm_phase2<pg8::EpiDown, pg8::DownSched, true, true, true, true, 127 - 5, 127 - 3>(c.lds3, DM, DE, S, E, c.tid);
}

#ifndef MK_N_LAUNCHES
#define MK_N_LAUNCHES 1
#endif
constexpr int RING_BYTES = 131072, LDSCTL_OFF = RING_BYTES, MISC_OFF = LDSCTL_OFF + 320, LDS_BYTES = 147456;
constexpr int PH_PER_LAYER = 7, NPHASE = 2 + 2 * PH_PER_LAYER;
constexpr int CW_BAR = 4096;
static_assert((CW_BAR + XCD_BAR_WORDS) * 4 <= (int)CTL_ZERO_BYTES, "CTL");

__global__ void __launch_bounds__(512, 2) fwd(Args a) {
    extern __shared__ __attribute__((aligned(16))) unsigned char lds[];
    const int wave_s = __builtin_amdgcn_readfirstlane(threadIdx.x >> 6);
#define MKTID() (wave_s * 64 + lane_id_volatile())
#define MKCTX() Args al = a; { size_t z_ = 0; asm volatile("" : "+s"(z_)); al.ws = a.ws + z_; } Ctx c; {     int t_ = MKTID(); asm volatile("" : "+v"(t_)); c.lds = lds; c.lds3 = (LAS unsigned char*)lds; c.tid = t_; c.lane = t_ & 63; c.wave = __builtin_amdgcn_readfirstlane(t_ >> 6); c.G = gridDim.x; c.bid = blockIdx.x; c.gw = c.bid * 8 + c.wave; c.NGW = c.G * 8; }
    const int lo = a.ph_lo, hi = a.ph_hi;
    const bool one = (hi - lo) > 1;
    for (int u = threadIdx.x; u < (LDS_BYTES - LDSCTL_OFF) / 4; u += 512) ((LAS unsigned*)((LAS unsigned char*)lds + LDSCTL_OFF))[u] = 0u;
    __syncthreads();
    XcdBarrier bar; bar.bar = (unsigned*)(a.ws + WS_CTL) + CW_BAR; bar.x = 0; bar.st = nullptr;
    if (one) bar = xcd_barrier_post((unsigned*)(a.ws + WS_CTL) + CW_BAR, (volatile LAS unsigned*)((LAS unsigned char*)lds + MISC_OFF) + 8);
#ifndef REP_PHASE
#define REP_PHASE -1
#endif
#define IN(k) (lo <= (k) && (k) < hi)
#define SEAM(k) do { if (IN(k) && IN((k) + 1)) { XcdBarrier bl_ = bar; { size_t z_ = 0; unsigned x_ = bar.x; asm volatile("" : "+s"(z_), "+s"(x_)); bl_.bar = bar.bar + z_; bl_.x = x_; } xcd_barrier(bl_, MKTID() == 0); } } while (0)
    if (IN(0)) { MKCTX(); ph_prologue(al, c); if (REP_PHASE == 0) { __syncthreads(); ph_prologue(al, c); } SEAM(0); }
    if (IN(1)) { MKCTX(); ph_h1_rows(al, c); if (REP_PHASE == 1) ph_h1_rows(al, c); SEAM(1); }
    {
        constexpr int l = 0; constexpr int p0 = 2 + l * PH_PER_LAYER;
        if (IN(p0 + 0)) { MKCTX(); ph_inproj_fast(al, c, l, false); if (REP_PHASE == 10) { __syncthreads(); ph_inproj_fast(al, c, l, true); } SEAM(p0 + 0); }
        if (IN(p0 + 1)) {
            { MKCTX(); ph_pool(al, c); }
            __syncthreads();
            const attn_body::AttnTensors AT{(const attn_body::bf16*)(a.ws + WS_QKVP), (const attn_body::bf16*)(a.ws + WS_QKVP) + 512, (const attn_body::bf16*)(a.ws + WS_QKVP) + 1024,
                                            (attn_body::bf16*)(a.ws + WS_AD), (const float*)(a.ws + WS_KBAR) + (size_t)l * NB * NH * NBLK * HD};
            const attn_body::StaticOrder S((int)gridDim.x, (int)blockIdx.x);
            attn_body::attn_phase<attn_body::StaticOrder>((char*)lds, AT, S, MKTID());
            if (REP_PHASE == 11) attn_body::attn_phase<attn_body::StaticOrder>((char*)lds, AT, S, MKTID());
            if (REP_PHASE == 17) { __syncthreads(); MKCTX(); ph_pool(al, c); }
            SEAM(p0 + 1);
        }
        if (IN(p0 + 2)) { MKCTX(); ph_wout_fast(al, c, l); if (REP_PHASE == 12) { __syncthreads(); ph_wout_fast(al, c, l); } SEAM(p0 + 2); }
        if (IN(p0 + 3)) { MKCTX(); if (REP_PHASE == 13) { ph_rows_c(al, c, l, false); __syncthreads(); } ph_rows_c(al, c, l, true); SEAM(p0 + 3); }
        if (IN(p0 + 4)) { MKCTX(); ph_gateup_fast(al, c, l); if (REP_PHASE == 14) { __syncthreads(); ph_gateup_fast(al, c, l); } SEAM(p0 + 4); }
        if (IN(p0 + 5)) { MKCTX(); ph_down_fast(al, c, l); if (REP_PHASE == 15) { __syncthreads(); ph_down_fast(al, c, l); } SEAM(p0 + 5); }
        if (IN(p0 + 6)) { MKCTX(); ph_rows_g(al, c, l); if (REP_PHASE == 16) ph_rows_g(al, c, l); SEAM(p0 + 6); }
    }
    {
        constexpr int l = 1; constexpr int p0 = 2 + l * PH_PER_LAYER;
        if (IN(p0 + 0)) { MKCTX(); ph_inproj_fast(al, c, l, false); if (REP_PHASE == 10) { __syncthreads(); ph_inproj_fast(al, c, l, true); } SEAM(p0 + 0); }
        if (IN(p0 + 1)) {
            { MKCTX(); ph_pool(al, c); }
            __syncthreads();
            const attn_body::AttnTensors AT{(const attn_body::bf16*)(a.ws + WS_QKVP), (const attn_body::bf16*)(a.ws + WS_QKVP) + 512, (const attn_body::bf16*)(a.ws + WS_QKVP) + 1024,
                                            (attn_body::bf16*)(a.ws + WS_AD), (const float*)(a.ws + WS_KBAR) + (size_t)l * NB * NH * NBLK * HD};
            const attn_body::StaticOrder S((int)gridDim.x, (int)blockIdx.x);
            attn_body::attn_phase<attn_body::StaticOrder>((char*)lds, AT, S, MKTID());
            if (REP_PHASE == 11) attn_body::attn_phase<attn_body::StaticOrder>((char*)lds, AT, S, MKTID());
            if (REP_PHASE == 17) { __syncthreads(); MKCTX(); ph_pool(al, c); }
            SEAM(p0 + 1);
        }
        if (IN(p0 + 2)) { MKCTX(); ph_wout_fast(al, c, l); if (REP_PHASE == 12) { __syncthreads(); ph_wout_fast(al, c, l); } SEAM(p0 + 2); }
        if (IN(p0 + 3)) { MKCTX(); if (REP_PHASE == 13) { ph_rows_c(al, c, l, false); __syncthreads(); } ph_rows_c(al, c, l, true); SEAM(p0 + 3); }
        if (IN(p0 + 4)) { MKCTX(); ph_gateup_fast(al, c, l); if (REP_PHASE == 14) { __syncthreads(); ph_gateup_fast(al, c, l); } SEAM(p0 + 4); }
        if (IN(p0 + 5)) { MKCTX(); ph_down_fast(al, c, l); if (REP_PHASE == 15) { __syncthreads(); ph_down_fast(al, c, l); } SEAM(p0 + 5); }
        if (IN(p0 + 6)) { MKCTX(); ph_rows_g(al, c, l); if (REP_PHASE == 16) ph_rows_g(al, c, l); SEAM(p0 + 6); }
    }
#undef IN
#undef SEAM
}

extern "C" void kernel_launch(void* const* d_in, const int* in_sizes, int n_in, void* d_out, int out_size, void* d_ws, size_t ws_size, hipStream_t stream) {
    static int grid = 0;
    if (grid == 0) {
        if (n_in != 17 || out_size != NTOK * DM || ws_size < WS_END) { fprintf(stderr, "kernel_launch: unexpected problem (n_in %d out %d ws %zu)\n", n_in, out_size, ws_size); grid = -1; return; }
        if (hipFuncSetAttribute((const void*)fwd, hipFuncAttributeMaxDynamicSharedMemorySize, LDS_BYTES) != hipSuccess) { fprintf(stderr, "kernel_launch: hipFuncSetAttribute failed\n"); grid = -1; return; }
        int dev = 0, cus = 0, per_cu = 0;
        (void)hipGetDevice(&dev); (void)hipDeviceGetAttribute(&cus, hipDeviceAttributeMultiprocessorCount, dev);
        if (hipOccupancyMaxActiveBlocksPerMultiprocessor(&per_cu, (const void*)fwd, 512, LDS_BYTES) != hipSuccess || per_cu < 1) fprintf(stderr, "kernel_launch: occupancy query reports %d workgroups per CU\n", per_cu);
        (void)hipGetLastError();
        grid = cus > 0 ? cus : 256;
    }
    if (grid < 0) return;
    (void)hipMemsetAsync((char*)d_ws + WS_CTL, 0, CTL_ZERO_BYTES, stream);
    Args a{};
    for (int i = 0; i < 17; ++i) a.in[i] = (const float*)d_in[i];
    a.out = (float*)d_out; a.ws = (unsigned char*)d_ws;
#if MK_N_LAUNCHES == 1
    a.ph_lo = 0; a.ph_hi = NPHASE; hipLaunchKernelGGL(fwd, dim3(grid), dim3(512), LDS_BYTES, stream, a);
#else
    for (int p = 0; p < NPHASE; ++p) { a.ph_lo = p; a.ph_hi = p + 1; hipLaunchKernelGGL(fwd, dim3(grid), dim3(512), LDS_BYTES, stream, a); }
#endif
}
```

```cpp
#include <hip/hip_runtime.h>
#include <cstdint>
#include <cstdio>

constexpr int NB = 16, SEQ = 2048, DM = 1024, NTOK = NB * SEQ, DIN = 2048, NH = 8, HD = 64, NBLK = 8, MBLK = 256;
constexpr int NE = 16, NCLS = 24, DE = 512, NMOD = 6 * DM;
constexpr float ALPHA = 1.41421356237309515f, LN_EPS = 1e-5f;
constexpr float QSCALE = 0.125f * 1.4426950408889634f;
constexpr int LISTCAP = NTOK;

constexpr size_t MiB = 1u << 20;
constexpr size_t WS_CTL = 0, CTL_ZERO_BYTES = 1 * MiB;
constexpr size_t WS_MOD = 1 * MiB;
constexpr size_t WS_ROPE = 2 * MiB;
constexpr size_t WS_KBAR = 2 * MiB + 256 * 1024;
constexpr size_t WS_LIST = 3 * MiB;
constexpr size_t WS_RW = 6 * MiB;
constexpr size_t WS_WIN = 12 * MiB;
constexpr size_t WS_WOUT = 20 * MiB;
constexpr size_t WS_WGU = 24 * MiB;
constexpr size_t WS_WD = 88 * MiB;
constexpr size_t WS_HB = 120 * MiB;
constexpr size_t WS_QKVP = 184 * MiB;
constexpr size_t WS_AD = 312 * MiB;
constexpr size_t WS_X1 = 376 * MiB;
constexpr size_t WS_END = 504 * MiB;
constexpr int CW_TMO = 0, CW_CNT = 64;

typedef unsigned short bf16_t;
typedef short bf16x8 __attribute__((ext_vector_type(8)));
typedef float f32x4 __attribute__((ext_vector_type(4)));
typedef float f32x16 __attribute__((ext_vector_type(16)));
typedef unsigned u32x4 __attribute__((ext_vector_type(4)));
typedef unsigned u32x2 __attribute__((ext_vector_type(2)));

#define DEVFN __device__ __forceinline__
#define LDS_WAIT() asm volatile("s_waitcnt lgkmcnt(0)" ::: "memory")
#define RLX_AGENT __ATOMIC_RELAXED, __HIP_MEMORY_SCOPE_AGENT

DEVFN float bf_lo(unsigned w) { return __uint_as_float(w << 16); }
DEVFN float bf_hi(unsigned w) { return __uint_as_float(w & 0xffff0000u); }
DEVFN float bf2f(bf16_t v) { return __uint_as_float((unsigned)v << 16); }
DEVFN unsigned f2bf(float f) { unsigned u = __float_as_uint(f); return (u + 0x7fffu + ((u >> 16) & 1u)) >> 16; }
DEVFN unsigned pk2(float lo, float hi) { return f2bf(lo) | (f2bf(hi) << 16); }
DEVFN unsigned pk4_fp8(float a, float b, float c, float d) {
    a = __builtin_amdgcn_fmed3f(a, -448.f, 448.f); b = __builtin_amdgcn_fmed3f(b, -448.f, 448.f); c = __builtin_amdgcn_fmed3f(c, -448.f, 448.f); d = __builtin_amdgcn_fmed3f(d, -448.f, 448.f);
    unsigned w = 0u; w = __builtin_amdgcn_cvt_pk_fp8_f32(a, b, w, false); w = __builtin_amdgcn_cvt_pk_fp8_f32(c, d, w, true); return w; }
DEVFN f32x4 f8x4_to_f32(unsigned w, float sc) { const auto lo = __builtin_amdgcn_cvt_pk_f32_fp8(w, false), hi = __builtin_amdgcn_cvt_pk_f32_fp8(w, true); return (f32x4){lo[0] * sc, lo[1] * sc, hi[0] * sc, hi[1] * sc}; }
constexpr float YSCALE = 16.f;
DEVFN int crow(int r, int hi) { return (r & 3) + 8 * (r >> 2) + 4 * hi; }
#define SWZ_XOR(m) (0x1f | ((m) << 10))
DEVFN float swz_xor_add(float v, const int m) {
    switch (m) {
        case 1: return v + __int_as_float(__builtin_amdgcn_ds_swizzle(__float_as_int(v), SWZ_XOR(1)));
        case 2: return v + __int_as_float(__builtin_amdgcn_ds_swizzle(__float_as_int(v), SWZ_XOR(2)));
        case 4: return v + __int_as_float(__builtin_amdgcn_ds_swizzle(__float_as_int(v), SWZ_XOR(4)));
        case 8: return v + __int_as_float(__builtin_amdgcn_ds_swizzle(__float_as_int(v), SWZ_XOR(8)));
        default: return v + __int_as_float(__builtin_amdgcn_ds_swizzle(__float_as_int(v), SWZ_XOR(16)));
    }
}
DEVFN float half_swap_add(float v) { auto rr = __builtin_amdgcn_permlane32_swap(__float_as_uint(v), __float_as_uint(v), false, false); return __uint_as_float(rr[0]) + __uint_as_float(rr[1]); }
DEVFN float wave_sum(float v) {
    v = swz_xor_add(v, 1); v = swz_xor_add(v, 2); v = swz_xor_add(v, 4); v = swz_xor_add(v, 8); v = swz_xor_add(v, 16);
    return half_swap_add(v);
}
__host__ __device__ __forceinline__ int inproj_lgroup(int P) { return P < 16 ? (P >> 2) * 8 + (P & 3) * 2 : ((P - 16) >> 2) * 8 + ((P - 16) & 3) * 2 + 1; }
__host__ __device__ __forceinline__ int inproj_nlog(int n) { return (n & ~255) + inproj_lgroup((n & 255) >> 3) * 8 + (n & 7); }

#define GAS __attribute__((address_space(1)))
#define LAS __attribute__((address_space(3)))
typedef GAS unsigned gu32;
namespace pg8 {
#define PG8_LAS __attribute__((address_space(3)))
typedef unsigned short bf16_t;
typedef short bf16x8 __attribute__((ext_vector_type(8)));
typedef float f32x4 __attribute__((ext_vector_type(4)));
typedef unsigned u32x4 __attribute__((ext_vector_type(4)));
constexpr int BM = 256, BK = 64, HALF = 128, HTB = HALF * BK * 2  , STAGE_BYTES = 8 * HTB, NXCD = 8, WGM = 8;

__host__ __device__ __forceinline__ int lds_byte(int r, int c) { const int st = (r >> 4) * 2 + (c >> 5), rr = r & 15, cc = c & 31, ob = rr * 64 + cc * 2; return st * 1024 + (ob ^ (((ob >> 9) & 1) << 5)); }
__host__ __device__ __forceinline__ void stage_rc(int b, int& R, int& C) { const int st = b / 1024, sb = b % 1024, swz = sb ^ (((sb >> 9) & 1) << 5); R = (st >> 1) * 16 + swz / 64; C = (st & 1) * 32 + (swz % 64) / 2; }
__host__ __device__ __forceinline__ int perm32(int rho) { const int n = rho >> 4, i = rho & 15; return 8 * (i >> 2) + 4 * n + (i & 3); }

struct Unit { int pm, pn; };
struct Gemm { const bf16_t* A; const bf16_t* Bt; int M, N, K; };

struct StaticOrder {
    int nM, nN, nwg, G, c;
    __host__ __device__ void init(int M, int N, int G_, int c_) { nM = M / BM; nN = N / BM; nwg = nM * nN; G = G_; c = c_; }
    __host__ __device__ bool next(int i, Unit& u) const {
        const long L = (long)i * G + c; if (L >= nwg) return false;
        int wgid = (int)L; { const int q = nwg / NXCD, r = nwg % NXCD, xcd = wgid % NXCD, off = wgid / NXCD; wgid = (xcd < r ? xcd * (q + 1) : r * (q + 1) + (xcd - r) * q) + off; }
        const int nig = WGM * nN, gid = wgid / nig, fm = gid * WGM, gsz = (nM - fm) < WGM ? (nM - fm) : WGM;
        u.pm = fm + ((wgid % nig) % gsz); u.pn = (wgid % nig) / gsz; return true;
    }
    __device__ __forceinline__ void a_ready(const Unit&) const {}
    __device__ __forceinline__ void done(const Unit&) const {}
};

__device__ __forceinline__ unsigned cvt_pk_bf16(float lo, float hi) { unsigned r; asm volatile("v_cvt_pk_bf16_f32 %0, %1, %2" : "=v"(r) : "v"(lo), "v"(hi)); return r; }
typedef float f32x2 __attribute__((ext_vector_type(2)));
__device__ __forceinline__ f32x2 gelu_pk(f32x2 v) {
    const f32x2 av = __builtin_elementwise_abs(v), d = av * 0.2316418882f + 1.0f;
    f32x2 t; t.x = __builtin_amdgcn_rcpf(d.x); t.y = __builtin_amdgcn_rcpf(d.y);
    f32x2 q = t * 0.5307027145f + (-0.7265760135f); q = q * t + 0.7107068705f; q = q * t + (-0.142248368f); q = q * t + 0.127414796f; q = q * t;
    const f32x2 s = (v * v) * (-0.72134752044f);
    f32x2 e; e.x = __builtin_amdgcn_exp2f(s.x); e.y = __builtin_amdgcn_exp2f(s.y);
    const f32x2 m = v * (q * e), r = v - m;
    f32x2 o; o.x = v.x < 0.f ? m.x : r.x; o.y = v.y < 0.f ? m.y : r.y; return o;
}

template <int ACT  > struct EpiBf16 {
    static constexpr bool PERM = true, AFTER_DRAIN = false; static_assert(ACT == 0 || ACT == 1, "EpiBf16: ACT is 0 (none) or 1 (gelu_pk)");
    bf16_t* O; int ldc; const float* bias; int split_cols; size_t split_stride; float scale0;
    __device__ __forceinline__ void operator()(const f32x4 (&acc)[2][2][4][2], const Unit& u, int wr, int wc, int fr, int fq) const {
        const int row0 = u.pm * BM + wr * 64 + fr; int colt = u.pn * BM; bf16_t* base = O;
        float sc = 1.f; if (split_cols) { const int t = colt / split_cols; base += (size_t)t * split_stride; colt -= t * split_cols; if (t == 0) sc = scale0; }
        const int col0 = colt + wc * 32 + 8 * fq, bcol0 = u.pn * BM + wc * 32 + 8 * fq;
        f32x4 bv[2][2];
#pragma unroll
        for (int bj = 0; bj < 2; ++bj)
#pragma unroll
            for (int n = 0; n < 2; ++n) bv[bj][n] = bias ? *(const f32x4*)(bias + bcol0 + bj * HALF + 4 * n) : (f32x4){0.f, 0.f, 0.f, 0.f};
#pragma unroll
        for (int ai = 0; ai < 2; ++ai)
#pragma unroll
            for (int m = 0; m < 4; ++m) { bf16_t* rowp = base + (size_t)(row0 + ai * HALF + m * 16) * ldc + col0;
#pragma unroll
                for (int bj = 0; bj < 2; ++bj) { f32x4 v0 = acc[ai][bj][m][0] + bv[bj][0], v1 = acc[ai][bj][m][1] + bv[bj][1];
                    if (ACT == 1) { f32x2 a = gelu_pk((f32x2){v0[0], v0[1]}), b = gelu_pk((f32x2){v0[2], v0[3]}), c = gelu_pk((f32x2){v1[0], v1[1]}), d = gelu_pk((f32x2){v1[2], v1[3]});
                        v0 = (f32x4){a.x, a.y, b.x, b.y}; v1 = (f32x4){c.x, c.y, d.x, d.y}; }
                    v0 = v0 * sc; v1 = v1 * sc; u32x4 w; w.x = cvt_pk_bf16(v0[0], v0[1]); w.y = cvt_pk_bf16(v0[2], v0[3]); w.z = cvt_pk_bf16(v1[0], v1[1]); w.w = cvt_pk_bf16(v1[2], v1[3]);
                    *(u32x4*)(rowp + bj * HALF) = w; } }
    }
};

struct PanelStats {
    unsigned* xbuf;
    unsigned* cnt;
    unsigned* tmo;
    int ntn; float eps;
    unsigned code;
    __device__ __forceinline__ bool run(const f32x4 (&v)[2][2][4][2], const Unit& u, int wr, int wc, int fr, int fq, PG8_LAS unsigned char* lds, int wid, int lane) const {
        typedef float f32x2v __attribute__((ext_vector_type(2)));
        PG8_LAS f32x2v* P = (PG8_LAS f32x2v*)lds;
        PG8_LAS f32x2v* S = (PG8_LAS f32x2v*)(lds + 8192);
        PG8_LAS unsigned* flag = (PG8_LAS unsigned*)(lds + 8192 + 2048);
#pragma unroll
        for (int ai = 0; ai < 2; ++ai)
#pragma unroll
            for (int m = 0; m < 4; ++m) {
                float s = 0.f;
#pragma unroll
                for (int bj = 0; bj < 2; ++bj)
#pragma unroll
                    for (int n = 0; n < 2; ++n) { const f32x4 x = v[ai][bj][m][n]; s += (x[0] + x[1]) + (x[2] + x[3]); }
                s += __shfl_xor(s, 16); s += __shfl_xor(s, 32);
                const float mw = s * (1.0f / 64.0f); float q = 0.f;
#pragma unroll
                for (int bj = 0; bj < 2; ++bj)
#pragma unroll
                    for (int n = 0; n < 2; ++n) { const f32x4 d = v[ai][bj][m][n] - mw; q += (d[0] * d[0] + d[1] * d[1]) + (d[2] * d[2] + d[3] * d[3]); }
                q += __shfl_xor(q, 16); q += __shfl_xor(q, 32);
                if (fq == 0) P[(ai * HALF + wr * 64 + m * 16 + fr) * 4 + wc] = (f32x2v){mw, q};
            }
        asm volatile("s_waitcnt lgkmcnt(0)" ::: "memory"); __builtin_amdgcn_s_barrier(); asm volatile("" ::: "memory");
#if defined(BROKEN_EXCHANGE_NO_WAIT)
#warning BROKEN CONTROL BUILD: the row-statistics exchange does not wait; results are wrong by design
        if (blockIdx.x >= 64) { const long long t0_ = clock64(); while (clock64() - t0_ < 60000) __builtin_amdgcn_s_sleep(8); }
#endif
        const int row = wid * 32 + (lane & 31);
        if (lane < 32) {
            const f32x2v a = P[row * 4 + 0], b = P[row * 4 + 1], c = P[row * 4 + 2], d = P[row * 4 + 3];
            const float mt = (a.x + b.x + c.x + d.x) * 0.25f;
            const float da = a.x - mt, db = b.x - mt, dc = c.x - mt, dd = d.x - mt;
            const float m2 = (a.y + b.y) + (c.y + d.y) + 64.0f * ((da * da + db * db) + (dc * dc + dd * dd));
            unsigned long long* slot = (unsigned long long*)xbuf + ((size_t)(u.pm * BM + row) * 4 + u.pn);
            __hip_atomic_store(slot, ((unsigned long long)__float_as_uint(m2) << 32) | __float_as_uint(mt), __ATOMIC_RELAXED, __HIP_MEMORY_SCOPE_AGENT);
        }
        asm volatile("s_waitcnt vmcnt(0)" ::: "memory");
        if (lane == 0) __hip_atomic_fetch_add(cnt + 64 * u.pm, 1u, __ATOMIC_RELAXED, __HIP_MEMORY_SCOPE_AGENT);
        if (wid == 0) {
            bool dead = false; const unsigned long long t0 = __builtin_amdgcn_s_memrealtime(); const unsigned want = 8u * (unsigned)ntn;
            for (;;) {
#if defined(BROKEN_EXCHANGE_NO_WAIT)
                break;
#endif
                if ((unsigned)__builtin_amdgcn_readfirstlane(__hip_atomic_load(cnt + 64 * u.pm, __ATOMIC_RELAXED, __HIP_MEMORY_SCOPE_AGENT)) >= want) break;
                if (__builtin_amdgcn_s_memrealtime() - t0 > 2000000ull) {
                    if (lane == 0) { unsigned expect = 0u; __hip_atomic_compare_exchange_strong(tmo + 1, &expect, code | (unsigned)(u.pm & 0xff), __ATOMIC_RELAXED, __ATOMIC_RELAXED, __HIP_MEMORY_SCOPE_AGENT);
                                     __hip_atomic_store(tmo, 1u, __ATOMIC_RELAXED, __HIP_MEMORY_SCOPE_AGENT); }
                    dead = true; break; }
                __builtin_amdgcn_s_sleep(2);
            }
            __builtin_amdgcn_fence(__ATOMIC_ACQUIRE, "agent");
            if (lane == 0) flag[0] = dead ? 1u : 0u;
        }
        asm volatile("s_waitcnt vmcnt(0) lgkmcnt(0)" ::: "memory"); __builtin_amdgcn_s_barrier(); asm volatile("" ::: "memory");
        const bool bad = flag[0] != 0u;
        if (lane < 32) {
            const unsigned long long* slot = (const unsigned long long*)xbuf + (size_t)(u.pm * BM + row) * 4; float mt[4], m2[4]; float ms = 0.f;
#pragma unroll
            for (int t = 0; t < 4; ++t) { if (t < ntn) { const unsigned long long w = __hip_atomic_load(slot + t, __ATOMIC_RELAXED, __HIP_MEMORY_SCOPE_AGENT); mt[t] = __uint_as_float((unsigned)w); m2[t] = __uint_as_float((unsigned)(w >> 32)); } else { mt[t] = 0.f; m2[t] = 0.f; } ms += mt[t]; }
            const float mean = ms / (float)ntn; float q = 0.f;
#pragma unroll
            for (int t = 0; t < 4; ++t) if (t < ntn) { const float dm = mt[t] - mean; q += m2[t] + 256.0f * dm * dm; }
            S[row] = (f32x2v){mean, 1.0f / sqrtf(q / (256.0f * (float)ntn) + eps)};
        }
        asm volatile("s_waitcnt lgkmcnt(0)" ::: "memory"); __builtin_amdgcn_s_barrier(); asm volatile("" ::: "memory");
        return bad;
    }
};
struct EpiLnRes {
    static constexpr bool PERM = false, AFTER_DRAIN = true;
    const float* base; float* out; int ldc; const float* bias; PanelStats st; unsigned poison;
    __device__ __forceinline__ void fused(f32x4 (&acc)[2][2][4][2], const Unit& u, int wr, int wc, int fr, int fq, PG8_LAS unsigned char* lds, int wid, int lane) const {
        typedef float f32x2v __attribute__((ext_vector_type(2)));
        const PG8_LAS f32x2v* S = (const PG8_LAS f32x2v*)(lds + 8192);
        const int col0 = u.pn * BM + wc * 32 + 4 * fq;
#pragma unroll
        for (int bj = 0; bj < 2; ++bj)
#pragma unroll
            for (int n = 0; n < 2; ++n) { const f32x4 bv = bias ? *(const f32x4*)(bias + col0 + bj * HALF + n * 16) : (f32x4){0.f, 0.f, 0.f, 0.f};
#pragma unroll
                for (int ai = 0; ai < 2; ++ai)
#pragma unroll
                    for (int m = 0; m < 4; ++m) acc[ai][bj][m][n] += bv; }
        f32x4 pre[4][2][2];
#pragma unroll
        for (int m = 0; m < 4; ++m) { const size_t off = (size_t)(u.pm * BM + wr * 64 + m * 16 + fr) * ldc + col0;
#pragma unroll
            for (int bj = 0; bj < 2; ++bj)
#pragma unroll
                for (int n = 0; n < 2; ++n) pre[m][bj][n] = *(const f32x4*)(base + off + bj * HALF + n * 16); }
        const bool bad = st.run(acc, u, wr, wc, fr, fq, lds, wid, lane) || poison != 0u;
        const float qnan = __builtin_nanf("");
#pragma unroll
        for (int ai = 0; ai < 2; ++ai)
#pragma unroll
            for (int m = 0; m < 4; ++m) { const int r = ai * HALF + wr * 64 + m * 16 + fr; const f32x2v sr = S[r]; const size_t off = (size_t)(u.pm * BM + r) * ldc + col0;
#pragma unroll
                for (int bj = 0; bj < 2; ++bj)
#pragma unroll
                    for (int n = 0; n < 2; ++n) { const f32x4 bs = ai == 0 ? pre[m][bj][n] : *(const f32x4*)(base + off + bj * HALF + n * 16); f32x4 o = bs + (acc[ai][bj][m][n] - sr.x) * sr.y;
                        if (bad) o = (f32x4){qnan, qnan, qnan, qnan}; *(f32x4*)(out + off + bj * HALF + n * 16) = o; }
                if (m & 1) asm volatile("" ::: "memory"); }
    }
};
struct EpiLnResLn {
    static constexpr bool PERM = false, AFTER_DRAIN = true;
    const float* base; float* out; bf16_t* xn; int ldc; const float* bias; PanelStats st1, st2; unsigned poison;
    __device__ __forceinline__ void fused(f32x4 (&acc)[2][2][4][2], const Unit& u, int wr, int wc, int fr, int fq, PG8_LAS unsigned char* lds, int wid, int lane) const {
        typedef float f32x2v __attribute__((ext_vector_type(2))); typedef unsigned u32x2v __attribute__((ext_vector_type(2)));
        const PG8_LAS f32x2v* S = (const PG8_LAS f32x2v*)(lds + 8192);
        const int col0 = u.pn * BM + wc * 32 + 4 * fq;
#pragma unroll
        for (int bj = 0; bj < 2; ++bj)
#pragma unroll
            for (int n = 0; n < 2; ++n) { const f32x4 bv = bias ? *(const f32x4*)(bias + col0 + bj * HALF + n * 16) : (f32x4){0.f, 0.f, 0.f, 0.f};
#pragma unroll
                for (int ai = 0; ai < 2; ++ai)
#pragma unroll
                    for (int m = 0; m < 4; ++m) acc[ai][bj][m][n] += bv; }
        bool bad = st1.run(acc, u, wr, wc, fr, fq, lds, wid, lane) || poison != 0u;
        const float qnan = __builtin_nanf("");
#pragma unroll
        for (int ai = 0; ai < 2; ++ai)
#pragma unroll
            for (int m = 0; m < 4; ++m) { const int r = ai * HALF + wr * 64 + m * 16 + fr; const f32x2v sr = S[r]; const size_t off = (size_t)(u.pm * BM + r) * ldc + col0;
#pragma unroll
                for (int bj = 0; bj < 2; ++bj)
#pragma unroll
                    for (int n = 0; n < 2; ++n) { const f32x4 bs = *(const f32x4*)(base + off + bj * HALF + n * 16); acc[ai][bj][m][n] = bs + (acc[ai][bj][m][n] - sr.x) * sr.y; }
                asm volatile("" : "+v"(acc[ai][0][m][0]), "+v"(acc[ai][0][m][1]), "+v"(acc[ai][1][m][0]), "+v"(acc[ai][1][m][1]));
                if (m & 1) asm volatile("" ::: "memory"); }
        const bool bad1 = bad;
        bad = st2.run(acc, u, wr, wc, fr, fq, lds, wid, lane) || bad;
#pragma unroll
        for (int ai = 0; ai < 2; ++ai)
#pragma unroll
            for (int m = 0; m < 4; ++m) { const int r = ai * HALF + wr * 64 + m * 16 + fr; const f32x2v sr = S[r]; const size_t off = (size_t)(u.pm * BM + r) * ldc + col0;
#pragma unroll
                for (int bj = 0; bj < 2; ++bj)
#pragma unroll
                    for (int n = 0; n < 2; ++n) { const f32x4 x1 = acc[ai][bj][m][n]; *(f32x4*)(out + off + bj * HALF + n * 16) = bad1 ? (f32x4){qnan, qnan, qnan, qnan} : x1;
                        const f32x4 o = (x1 - sr.x) * sr.y; u32x2v w; w.x = cvt_pk_bf16(o[0], o[1]); w.y = cvt_pk_bf16(o[2], o[3]);
                        if (bad) { w.x = 0x7fc07fc0u; w.y = 0x7fc07fc0u; } *(u32x2v*)(xn + off + bj * HALF + n * 16) = w; }
                asm volatile("" ::: "memory"); }
    }
};

}
namespace pg8 {
typedef int v8i_t __attribute__((ext_vector_type(8))); typedef int v4i_t __attribute__((ext_vector_type(4)));
template <class Epi, class Sched, bool ALIGN_EPI, bool GATHER, bool KSPLIT, bool FP8 = false, int SCW = 127, int SCA = 127, bool SC2 = false, int SCW2 = 127, int SCA2 = 127>
__device__ __forceinline__ void gemm_phase2(PG8_LAS unsigned char* lds, const int Kbytes, const int ldb_bytes, const Sched& S, const Epi& E, const int tid) {
    typedef typename Sched::UnitT UnitT;
    const int wid = __builtin_amdgcn_readfirstlane(tid >> 6), lane = tid & 63, wr = wid >> 2, wc = wid & 3, fr = lane & 15, fq = lane >> 4;
    int nt = Kbytes / (BK * 2); asm volatile("" : "+s"(nt));
    const int nth = nt / 2;
    unsigned voffB[2];
#pragma unroll
    for (int i = 0; i < 2; ++i) { int R[2], C[2]; stage_rc(tid * 16 + i * 8192, R[i], C[i]); const int Rb = Epi::PERM ? ((R[i] & ~31) + perm32(R[i] & 31)) : R[i]; voffB[i] = (unsigned)(Rb * ldb_bytes + C[i] * 2); }
    const size_t kstep = (size_t)(BK * 2);
    const size_t hstepB = (size_t)HALF * ldb_bytes;
    const unsigned ldsw = (unsigned)wid * 1024u;
    const int aoff = lds_byte(wr * 64 + fr, fq * 8), boff = lds_byte(wc * 32 + fr, fq * 8);
#define PG8_SA(b, h) (((b) * 2 + (h)) * HTB)
#define PG8_SB(b, h) ((4 + (b) * 2 + (h)) * HTB)
#define PG8_STAGE(bufoff, gbase, voff) do { _Pragma("unroll") for (int _i = 0; _i < 2; ++_i) \
        __builtin_amdgcn_global_load_lds((const unsigned*)((const char*)(gbase) + (voff)[_i]), (PG8_LAS unsigned*)(lds + (bufoff) + ldsw + _i * 8192), 16, 0, 0); } while (0)
#define PG8_LDA(dst, b, h) do { _Pragma("unroll") for (int m = 0; m < 4; ++m) _Pragma("unroll") for (int k = 0; k < 2; ++k) dst[m][k] = *(const PG8_LAS bf16x8*)(lds + PG8_SA(b, h) + aoff + m * 2048 + k * 1024); } while (0)
#define PG8_LDB(dst, b, h) do { _Pragma("unroll") for (int n = 0; n < 2; ++n) _Pragma("unroll") for (int k = 0; k < 2; ++k) dst[n][k] = *(const PG8_LAS bf16x8*)(lds + PG8_SB(b, h) + boff + n * 2048 + k * 1024); } while (0)
#define PG8_CAT8(x) __builtin_shufflevector(__builtin_bit_cast(v4i_t, (x)[0]), __builtin_bit_cast(v4i_t, (x)[1]), 0, 1, 2, 3, 4, 5, 6, 7)
#define PG8_MMA(ai, bj, At, Bt) do { __builtin_amdgcn_s_setprio(1); \
        if constexpr (FP8) { _Pragma("unroll") for (int m = 0; m < 4; ++m) _Pragma("unroll") for (int n = 0; n < 2; ++n) \
            acc[ai][bj][m][n] = __builtin_amdgcn_mfma_scale_f32_16x16x128_f8f6f4(PG8_CAT8(Bt[n]), PG8_CAT8(At[m]), acc[ai][bj][m][n], 0, 0, 0, scw_, 0, sca_); } \
        else { _Pragma("unroll") for (int m = 0; m < 4; ++m) _Pragma("unroll") for (int n = 0; n < 2; ++n) _Pragma("unroll") for (int k = 0; k < 2; ++k) \
            acc[ai][bj][m][n] = __builtin_amdgcn_mfma_f32_16x16x32_bf16(Bt[n][k], At[m][k], acc[ai][bj][m][n], 0, 0, 0); } \
        __builtin_amdgcn_s_setprio(0); } while (0)
#define PG8_WAIT_V(n) asm volatile("s_waitcnt vmcnt(" #n ")" ::: "memory")
#define PG8_WAIT_L(n) asm volatile("s_waitcnt lgkmcnt(" #n ")" ::: "memory")
#define PG8_BAR __builtin_amdgcn_s_barrier()
#define PG8_SCHED __builtin_amdgcn_sched_barrier(0)
#define PG8_BK(cb, cb2, kt) ((KSPLIT && (kt) >= nth) ? (cb2) + (size_t)((kt) - nth) * kstep : (cb) + (size_t)(kt) * kstep)
    UnitT cur, nxt; int ui = 0;
    if (!S.next(0, cur)) return;
    f32x4 acc[2][2][4][2];
#pragma unroll
    for (int a = 0; a < 2; ++a)
#pragma unroll
        for (int b = 0; b < 2; ++b)
#pragma unroll
            for (int m = 0; m < 4; ++m)
#pragma unroll
                for (int n = 0; n < 2; ++n) acc[a][b][m][n] = (f32x4){0.f, 0.f, 0.f, 0.f};
    bf16x8 At[4][2], B0[2][2], B1[2][2];
    unsigned vA[2][2], vAn[2][2];
    S.arows(cur, tid, vA);
#pragma unroll
    for (int h = 0; h < 2; ++h)
#pragma unroll
        for (int i = 0; i < 2; ++i) vAn[h][i] = vA[h][i];
    const char* cA = S.aptr(cur); const char* cB = S.bptr(cur); const char* cB2 = KSPLIT ? S.bptr2(cur) : cB;
    PG8_STAGE(PG8_SB(0, 0), cB, voffB); PG8_STAGE(PG8_SB(0, 1), cB + hstepB, voffB); PG8_STAGE(PG8_SA(0, 0), cA, vA[0]); PG8_STAGE(PG8_SA(0, 1), cA, vA[1]);
    if (wr == 1) PG8_BAR;
    PG8_WAIT_V(2); PG8_BAR;
    PG8_STAGE(PG8_SB(1, 0), PG8_BK(cB, cB2, 1), voffB); PG8_STAGE(PG8_SA(1, 0), cA + kstep, vA[0]); PG8_STAGE(PG8_SB(1, 1), PG8_BK(cB, cB2, 1) + hstepB, voffB);
    PG8_WAIT_V(6); PG8_BAR;
    for (;;) {
        const bool has_next = S.next(ui + 1, nxt);
        const char* nA = has_next ? S.aptr(nxt) : cA; const char* nB = has_next ? S.bptr(nxt) : cB; const char* nB2 = (KSPLIT && has_next) ? S.bptr2(nxt) : cB2;
        if (GATHER && has_next) S.arows(nxt, tid, vAn);
        for (int t = 0; t < nt; t += 2) {
            const bool last = (t == nt - 2);
            const int scw_ = ((SC2 && t >= nth) ? SCW2 : SCW) * 0x01010101, sca_ = ((SC2 && t >= nth) ? SCA2 : SCA) * 0x01010101; (void)scw_; (void)sca_;
            const char* a1 = cA + (size_t)(t + 1) * kstep;
            const char* a2 = last ? nA : cA + (size_t)(t + 2) * kstep;
            const char* b2 = last ? nB : PG8_BK(cB, cB2, t + 2);
            const char* b3 = last ? (KSPLIT ? PG8_BK(nB, nB2, 1) : nB + kstep) : PG8_BK(cB, cB2, t + 3);
            const char* a3 = a2 + kstep;
            PG8_LDB(B0, 0, 0); PG8_LDB(B1, 0, 1); PG8_SCHED; PG8_LDA(At, 0, 0); PG8_STAGE(PG8_SA(1, 1), a1, vA[1]);
            PG8_WAIT_V(8); PG8_WAIT_L(0); PG8_BAR; PG8_MMA(0, 0, At, B0); PG8_MMA(0, 1, At, B1); PG8_BAR; PG8_SCHED;
            if (GATHER && last) {
#pragma unroll
                for (int h = 0; h < 2; ++h)
#pragma unroll
                    for (int i = 0; i < 2; ++i) vA[h][i] = vAn[h][i]; }
            PG8_LDA(At, 0, 1); PG8_STAGE(PG8_SB(0, 0), b2, voffB); PG8_STAGE(PG8_SB(0, 1), b2 + hstepB, voffB); PG8_STAGE(PG8_SA(0, 0), a2, vA[0]);
            PG8_WAIT_V(8); PG8_WAIT_L(0); PG8_BAR; PG8_MMA(1, 0, At, B0); PG8_MMA(1, 1, At, B1); PG8_BAR; PG8_SCHED;
            PG8_LDB(B0, 1, 0); PG8_LDB(B1, 1, 1); PG8_SCHED; PG8_LDA(At, 1, 0); PG8_STAGE(PG8_SA(0, 1), a2, vA[1]);
            PG8_WAIT_V(8); PG8_WAIT_L(0); PG8_BAR; PG8_MMA(0, 0, At, B0); PG8_MMA(0, 1, At, B1); PG8_BAR; PG8_SCHED;
            PG8_LDA(At, 1, 1); PG8_STAGE(PG8_SB(1, 0), b3, voffB); PG8_STAGE(PG8_SB(1, 1), b3 + hstepB, voffB); PG8_STAGE(PG8_SA(1, 0), a3, vA[0]);
            PG8_WAIT_V(8); PG8_WAIT_L(0); PG8_BAR; PG8_MMA(1, 0, At, B0); PG8_MMA(1, 1, At, B1); PG8_BAR; PG8_SCHED;
        }
        if constexpr (ALIGN_EPI) { if (wr == 0) PG8_BAR; }
        if constexpr (!Epi::AFTER_DRAIN) { E(acc, cur, wr, wc, fr, fq); }
        if (!has_next) break;
#pragma unroll
        for (int a = 0; a < 2; ++a)
#pragma unroll
            for (int b = 0; b < 2; ++b)
#pragma unroll
                for (int m = 0; m < 4; ++m)
#pragma unroll
                    for (int n = 0; n < 2; ++n) acc[a][b][m][n] = (f32x4){0.f, 0.f, 0.f, 0.f};
        cur = nxt; cA = nA; cB = nB; cB2 = nB2; ++ui;
        if constexpr (ALIGN_EPI) { if (wr == 1) PG8_BAR; }
    }
    PG8_WAIT_V(0);
    if constexpr (!ALIGN_EPI) { if (wr == 0) PG8_BAR; }
    PG8_BAR;
    if constexpr (Epi::AFTER_DRAIN) { E.fused(acc, cur, wr, wc, fr, fq, lds, wid, lane); }
#undef PG8_SA
#undef PG8_SB
#undef PG8_STAGE
#undef PG8_LDA
#undef PG8_LDB
#undef PG8_MMA
#undef PG8_WAIT_V
#undef PG8_WAIT_L
#undef PG8_BAR
#undef PG8_SCHED
#undef PG8_BK
#undef PG8_CAT8
}
}
namespace pg8 {
DEVFN unsigned pkbf(float lo, float hi) { return cvt_pk_bf16(lo, hi); }
struct DenseSched {
    typedef Unit UnitT;
    StaticOrder so; const char* A; const char* Bt; int lda, ldb;
    DEVFN bool next(int i, Unit& u) const { return so.next(i, u); }
    DEVFN const char* aptr(const Unit&) const { return A; }
    DEVFN void arows(const Unit& u, const int tid_, unsigned (&v)[2][2]) const {
        int R[2], C[2]; { int t_ = tid_; asm volatile("" : "+v"(t_)); stage_rc(t_ * 16, R[0], C[0]); stage_rc(t_ * 16 + 8192, R[1], C[1]); }
#pragma unroll
        for (int h = 0; h < 2; ++h)
#pragma unroll
            for (int i = 0; i < 2; ++i) v[h][i] = (unsigned)((u.pm * BM + h * HALF + R[i]) * lda + C[i] * 2); }
    DEVFN const char* bptr(const Unit& u) const { return Bt + (size_t)u.pn * BM * ldb; }
    DEVFN const char* bptr2(const Unit& u) const { return bptr(u); }
};
struct EpiInproj {
    static constexpr bool PERM = true, AFTER_DRAIN = false;
    bf16_t* O; const float* rope; float* kbar;
    DEVFN void operator()(f32x4 (&acc)[2][2][4][2], const Unit& u, int wr, int wc, int fr, int fq) const {
        const int pn = u.pn, row0 = u.pm * BM + wr * 64 + fr;
        if (pn < 4 && fq == 0) {
#pragma unroll
            for (int ai = 0; ai < 2; ++ai)
#pragma unroll
                for (int m = 0; m < 4; ++m) { const int t = (row0 + ai * HALF + m * 16) & (SEQ - 1); const f32x4* rp = (const f32x4*)(rope + t * 16);
#pragma unroll
                    for (int q = 0; q < 4; ++q) { const f32x4 cs = rp[q];
                        { const int d = 2 * q, n = d >> 2, e = d & 3; const float x1 = acc[ai][0][m][n][e], x2 = acc[ai][1][m][n][e]; acc[ai][0][m][n][e] = x1 * cs[0] - x2 * cs[1]; acc[ai][1][m][n][e] = x2 * cs[0] + x1 * cs[1]; }
                        { const int d = 2 * q + 1, n = d >> 2, e = d & 3; const float x1 = acc[ai][0][m][n][e], x2 = acc[ai][1][m][n][e]; acc[ai][0][m][n][e] = x1 * cs[2] - x2 * cs[3]; acc[ai][1][m][n][e] = x2 * cs[2] + x1 * cs[3]; } } }
        }
        if (pn == 2 || pn == 3) {
            float* kb = kbar + (size_t)((((u.pm >> 3) * NH + (pn - 2) * 4 + wc) * NBLK + (u.pm & 7)) * HD);
#pragma unroll
            for (int bj = 0; bj < 2; ++bj)
#pragma unroll
                for (int n = 0; n < 2; ++n)
#pragma unroll
                    for (int e = 0; e < 4; ++e) { float s = 0.f;
#pragma unroll
                        for (int ai = 0; ai < 2; ++ai)
#pragma unroll
                            for (int m = 0; m < 4; ++m) s += acc[ai][bj][m][n][e];
                        s = swz_xor_add(s, 1); s = swz_xor_add(s, 2); s = swz_xor_add(s, 4); s = swz_xor_add(s, 8);
                        if (fr == 0) atomicAdd(kb + (2 * fq + bj) * 8 + 4 * n + e, s * (1.f / MBLK)); }
        }
        const float sc = pn < 2 ? QSCALE : 1.f;
#pragma unroll
        for (int ai = 0; ai < 2; ++ai)
#pragma unroll
            for (int m = 0; m < 4; ++m) { bf16_t* rowp = O + (size_t)(row0 + ai * HALF + m * 16) * DIN + pn * BM + wc * 64;
#pragma unroll
                for (int bj = 0; bj < 2; ++bj) { const f32x4 v0 = acc[ai][bj][m][0] * sc, v1 = acc[ai][bj][m][1] * sc;
                    u32x4 w; w.x = pkbf(v0[0], v0[1]); w.y = pkbf(v0[2], v0[3]); w.z = pkbf(v1[0], v1[1]); w.w = pkbf(v1[2], v1[3]);
                    *(u32x4*)(rowp + (2 * fq + bj) * 8) = w; } }
    }
};
struct EpiF8 {
    static constexpr bool PERM = true, AFTER_DRAIN = false;
    unsigned char* O; int ldc;
    DEVFN void operator()(f32x4 (&acc)[2][2][4][2], const Unit& u, int wr, int wc, int fr, int fq) const {
#pragma unroll
        for (int ai = 0; ai < 2; ++ai)
#pragma unroll
            for (int m = 0; m < 4; ++m) { unsigned char* rowp = O + (size_t)(u.pm * BM + ai * HALF + wr * 64 + m * 16 + fr) * ldc + u.pn * BM + wc * 32 + fq * 8;
#pragma unroll
                for (int bj = 0; bj < 2; ++bj) { const f32x4 v0 = acc[ai][bj][m][0] * YSCALE, v1 = acc[ai][bj][m][1] * YSCALE;
                    u32x2 w; w.x = pk4_fp8(v0[0], v0[1], v0[2], v0[3]); w.y = pk4_fp8(v1[0], v1[1], v1[2], v1[3]);
                    *(u32x2*)(rowp + bj * HALF) = w; } }
    }
};
struct MoeUnit { int pm, pn, cls, j, cnt; };
struct MoeBase {
    const PG8_LAS int* tp; const PG8_LAS int* cnt; int nunits, G, c, npn_shift;
    DEVFN bool next_(int i, MoeUnit& u) const {
        const int L = i * G + c; if (L >= nunits) return false;
        u.pm = L >> npn_shift; u.pn = L & ((1 << npn_shift) - 1);
        int cls = 0; while (u.pm >= tp[cls + 1]) ++cls;
        u.cls = cls; u.j = u.pm - tp[cls]; u.cnt = cnt[cls]; return true; }
};
DEVFN void moe_experts(int cls, int& e1, int& e2) { const int g = cls / 6, p = cls % 6; const int lo = p < 3 ? 0 : (p < 5 ? 1 : 2), hi = p < 3 ? p + 1 : (p < 5 ? p - 1 : 3); e1 = g * 4 + lo; e2 = g * 4 + hi; }
struct GateUpSched : MoeBase {
    typedef MoeUnit UnitT;
    const char* HB; const int* list; const char* W;
    DEVFN bool next(int i, MoeUnit& u) const { return next_(i, u); }
    DEVFN const char* aptr(const MoeUnit&) const { return HB; }
    DEVFN void arows(const MoeUnit& u, const int tid_, unsigned (&v)[2][2]) const {
        int R[2], C[2]; { int t_ = tid_; asm volatile("" : "+v"(t_)); stage_rc(t_ * 16, R[0], C[0]); stage_rc(t_ * 16 + 8192, R[1], C[1]); }
#pragma unroll
        for (int h = 0; h < 2; ++h)
#pragma unroll
            for (int i = 0; i < 2; ++i) { const int li = 256 * u.j + h * HALF + R[i]; const int tok = list[(size_t)u.cls * LISTCAP + (li < u.cnt ? li : 256 * u.j)]; v[h][i] = (unsigned)(tok * DM + C[i] * 2); } }
    DEVFN const char* bptr(const MoeUnit& u) const { int e1, e2; moe_experts(u.cls, e1, e2); return W + (size_t)(u.pn < 4 ? e1 : e2) * DM * DM + (size_t)(u.pn & 3) * BM * DM; }
    DEVFN const char* bptr2(const MoeUnit& u) const { return bptr(u); }
};
struct DownSched : MoeBase {
    typedef MoeUnit UnitT;
    const char* ACT; const char* W;
    DEVFN bool next(int i, MoeUnit& u) const { return next_(i, u); }
    DEVFN const char* aptr(const MoeUnit&) const { return ACT; }
    DEVFN void arows(const MoeUnit& u, const int tid_, unsigned (&v)[2][2]) const {
        int R[2], C[2]; { int t_ = tid_; asm volatile("" : "+v"(t_)); stage_rc(t_ * 16, R[0], C[0]); stage_rc(t_ * 16 + 8192, R[1], C[1]); }
#pragma unroll
        for (int h = 0; h < 2; ++h)
#pragma unroll
            for (int i = 0; i < 2; ++i) v[h][i] = (unsigned)((u.pm * BM + h * HALF + R[i]) * DM + C[i] * 2); }
    DEVFN const char* bptr(const MoeUnit& u) const { int e1, e2; moe_experts(u.cls, e1, e2); return W + (size_t)e1 * DM * DE + (size_t)u.pn * BM * DE; }
    DEVFN const char* bptr2(const MoeUnit& u) const { int e1, e2; moe_experts(u.cls, e1, e2); return W + (size_t)e2 * DM * DE + (size_t)u.pn * BM * DE; }
};
struct EpiGateUp {
    static constexpr bool PERM = true, AFTER_DRAIN = false;
    unsigned char* ACT; const float* rw;
    DEVFN void operator()(f32x4 (&acc)[2][2][4][2], const MoeUnit& u, int wr, int wc, int fr, int fq) const {
        const int half = u.pn >> 2, jt = u.pn & 3;
#pragma unroll
        for (int ai = 0; ai < 2; ++ai)
#pragma unroll
            for (int m = 0; m < 4; ++m) { const int lr = ai * HALF + wr * 64 + m * 16 + fr, li = 256 * u.j + lr;
                const float wgt = li < u.cnt ? 8.f * rw[((size_t)u.cls * LISTCAP + li) * 2 + half] : 0.f;
                f32x4 o[2];
#pragma unroll
                for (int n = 0; n < 2; ++n)
#pragma unroll
                    for (int e = 0; e < 4; ++e) { const float g = acc[ai][0][m][n][e]; o[n][e] = g * __builtin_amdgcn_rcpf(1.f + __expf(-g)) * acc[ai][1][m][n][e] * wgt; }
                u32x2 w; w.x = pk4_fp8(o[0][0], o[0][1], o[0][2], o[0][3]); w.y = pk4_fp8(o[1][0], o[1][1], o[1][2], o[1][3]);
                *(u32x2*)(ACT + (size_t)(u.pm * BM + lr) * DM + half * 512 + jt * 128 + wc * 32 + fq * 8) = w; }
    }
};
struct EpiDown {
    static constexpr bool PERM = true, AFTER_DRAIN = false;
    unsigned char* Y2; const int* list;
    DEVFN void operator()(f32x4 (&acc)[2][2][4][2], const MoeUnit& u, int wr, int wc, int fr, int fq_) const {
        int fq = fq_; asm volatile("" : "+v"(fq));
#pragma unroll
        for (int ai = 0; ai < 2; ++ai)
#pragma unroll
            for (int m = 0; m < 4; ++m) { const int li = 256 * u.j + ai * HALF + wr * 64 + m * 16 + fr;
                if (li < u.cnt) { const int tok = list[(size_t)u.cls * LISTCAP + li]; unsigned char* rowp = Y2 + (size_t)tok * DM + u.pn * BM + wc * 32 + fq * 8;
#pragma unroll
                    for (int bj = 0; bj < 2; ++bj) { const f32x4 v0 = acc[ai][bj][m][0] * YSCALE, v1 = acc[ai][bj][m][1] * YSCALE;
                        u32x2 w; w.x = pk4_fp8(v0[0], v0[1], v0[2], v0[3]); w.y = pk4_fp8(v1[0], v1[1], v1[2], v1[3]);
                        *(u32x2*)(rowp + bj * HALF) = w; } } }
    }
};
}

#include <hip/hip_bf16.h>
#include <cmath>
namespace attn_body {
using bf16=__hip_bfloat16;
using bf16x8=__attribute__((ext_vector_type(8)))short;
using s16x4=__attribute__((ext_vector_type(4)))short;
using f32x16=__attribute__((ext_vector_type(16)))float;
using u32x4=__attribute__((ext_vector_type(4)))unsigned;
constexpr int BATCH=16,NHEAD=8,SEQ=2048,D=64,QP=2048,OP=1024;
constexpr int NW=8,QBLK=32,QB=QBLK*NW,KVBLK=64,NQB=SEQ/QB;
constexpr int ATTN_PITCH=QP, ATTN_UNIT_ROWS=QB;
__device__ __forceinline__ int crow(int r,int hi){return (r&3)+8*(r>>2)+4*hi;}
#define SBAR() __builtin_amdgcn_sched_barrier(0)
__device__ __forceinline__ void cmask(f32x16&p0,f32x16&p1,int jb,int qrel,int hi){
  const float NEG=-INFINITY; int kb=64*jb+4*hi;
  #pragma unroll
  for(int r=0;r<16;++r){int kv=kb+(r&3)+8*(r>>2); if(kv>qrel)p0[r]=NEG; if(kv+32>qrel)p1[r]=NEG;}
}

constexpr int NSLOT=3, SLOTB=8192;
constexpr int LDS_K=0, LDS_V=NSLOT*SLOTB, LDS_WS=2*NSLOT*SLOTB, LDS_OST=LDS_WS+NW*64*4, LDS_KBAR=LDS_OST+NW*4096, LDS_BYTES=LDS_KBAR+2048;
constexpr float NEGBIG=-1.0e30f; typedef float f32x4_t __attribute__((ext_vector_type(4)));
__device__ __forceinline__ float bfs(short v){return __uint_as_float(((unsigned)(unsigned short)v)<<16);}
constexpr float C2=0.125f*1.4426950408889634f;
__device__ __forceinline__ void glds16(const void*gsrc,unsigned lds_dst){unsigned keep;
  asm volatile("s_mov_b32 %0, m0\n\ts_mov_b32 m0, %2\n\ts_nop 0\n\tglobal_load_lds_dwordx4 %1, off\n\ts_mov_b32 m0, %0":"=&s"(keep):"v"(gsrc),"s"(lds_dst):"memory");}
__device__ __forceinline__ float max3f(float a,float b,float c){float r;asm("v_max3_f32 %0, %1, %2, %3":"=v"(r):"v"(a),"v"(b),"v"(c));return r;}
__device__ __forceinline__ float max2f(float a,float b){float r;asm("v_max_f32_e32 %0, %1, %2":"=v"(r):"v"(a),"v"(b));return r;}
__device__ __forceinline__ float fadd_s(float a,float b){float r;asm("v_add_f32_e32 %0, %1, %2":"=v"(r):"v"(a),"v"(b));return r;}
__device__ __forceinline__ float fsub_s(float a,float b){float r;asm("v_sub_f32_e32 %0, %1, %2":"=v"(r):"v"(a),"v"(b));return r;}
typedef float f32x2_t __attribute__((ext_vector_type(2))); typedef __bf16 bf16x2_t __attribute__((ext_vector_type(2)));
__device__ __forceinline__ unsigned cvtpk_s(float lo,float hi){f32x2_t v={lo,hi};bf16x2_t b=__builtin_convertvector(v,bf16x2_t);return __builtin_bit_cast(unsigned,b);}
#define WAIT_BAR(N) asm volatile("s_waitcnt vmcnt(" #N ") lgkmcnt(0)\n\ts_barrier":::"memory")

__device__ __forceinline__ void qkt(f32x16&p0,f32x16&p1,const char*Kslot,const bf16x8*qr,const f32x16&negm,int r32,int hi){
  const char*kb=Kslot+hi*1024+r32*16;
  #pragma unroll
  for(int d0=0;d0<4;++d0){
    const bf16x8 b0=*reinterpret_cast<const bf16x8*>(kb+d0*2048);
    const bf16x8 b1=*reinterpret_cast<const bf16x8*>(kb+d0*2048+512);
    if(d0==0){p0=__builtin_amdgcn_mfma_f32_32x32x16_bf16(b0,qr[0],negm,0,0,0);p1=__builtin_amdgcn_mfma_f32_32x32x16_bf16(b1,qr[0],negm,0,0,0);}
    else{p0=__builtin_amdgcn_mfma_f32_32x32x16_bf16(b0,qr[d0],p0,0,0,0);p1=__builtin_amdgcn_mfma_f32_32x32x16_bf16(b1,qr[d0],p1,0,0,0);}}
}
typedef __attribute__((address_space(3))) const char* lds_cptr;
typedef short v4i16_t __attribute__((ext_vector_type(4)));
__device__ __forceinline__ void kload8(bf16x8*kf,lds_cptr kp){
  kf[0]=*(const __attribute__((address_space(3))) bf16x8*)(kp);      kf[1]=*(const __attribute__((address_space(3))) bf16x8*)(kp+512);
  kf[2]=*(const __attribute__((address_space(3))) bf16x8*)(kp+2048); kf[3]=*(const __attribute__((address_space(3))) bf16x8*)(kp+2560);
  kf[4]=*(const __attribute__((address_space(3))) bf16x8*)(kp+4096); kf[5]=*(const __attribute__((address_space(3))) bf16x8*)(kp+4608);
  kf[6]=*(const __attribute__((address_space(3))) bf16x8*)(kp+6144); kf[7]=*(const __attribute__((address_space(3))) bf16x8*)(kp+6656);
}
__device__ __forceinline__ void kload2(bf16x8*kf,lds_cptr kp,int j){ kf[2*j]=*(const __attribute__((address_space(3))) bf16x8*)(kp+j*2048); kf[2*j+1]=*(const __attribute__((address_space(3))) bf16x8*)(kp+j*2048+512); }
__device__ __forceinline__ s16x4 vtr(lds_cptr p){ return __builtin_bit_cast(s16x4,__builtin_amdgcn_ds_read_tr16_b64_v4i16((__attribute__((address_space(3))) v4i16_t*)p)); }
__device__ __forceinline__ float rowmax(const f32x16&p0,const f32x16&p1){
  float a=max3f(p0[0],p0[1],p1[0]),b=max3f(p0[2],p0[3],p1[1]);a=max3f(a,p1[2],p1[3]);
  #pragma unroll
  for(int r=4;r<16;r+=4){a=max3f(a,p0[r],p0[r+1]);b=max3f(b,p0[r+2],p0[r+3]);a=max3f(a,p1[r],p1[r+1]);b=max3f(b,p1[r+2],p1[r+3]);}
  const float m=max2f(a,b);
  auto rr=__builtin_amdgcn_permlane32_swap(__float_as_uint(m),__float_as_uint(m),false,false);
  return max2f(__uint_as_float(rr[0]),__uint_as_float(rr[1]));
}
__device__ __forceinline__ void pv(f32x16*o,int vb,bf16x8 pa0,bf16x8 pa1,bf16x8 pa2,bf16x8 pa3){
  #pragma unroll
  for(int d0=0;d0<2;++d0){s16x4 lo[4],hi[4];
    #pragma unroll
    for(int ks=0;ks<4;++ks){
      asm volatile("ds_read_b64_tr_b16 %0,%1 offset:%c2":"=&v"(lo[ks]):"v"(vb),"i"(d0*4096+ks*1024):"memory");
      asm volatile("ds_read_b64_tr_b16 %0,%1 offset:%c2":"=&v"(hi[ks]):"v"(vb),"i"(d0*4096+ks*1024+512):"memory");}
    asm volatile("s_waitcnt lgkmcnt(0)":::"memory");SBAR();
    #define PK(k) (bf16x8){lo[k][0],lo[k][1],lo[k][2],lo[k][3],hi[k][0],hi[k][1],hi[k][2],hi[k][3]}
    o[d0]=__builtin_amdgcn_mfma_f32_32x32x16_bf16(pa0,PK(0),o[d0],0,0,0);
    o[d0]=__builtin_amdgcn_mfma_f32_32x32x16_bf16(pa1,PK(1),o[d0],0,0,0);
    o[d0]=__builtin_amdgcn_mfma_f32_32x32x16_bf16(pa2,PK(2),o[d0],0,0,0);
    o[d0]=__builtin_amdgcn_mfma_f32_32x32x16_bf16(pa3,PK(3),o[d0],0,0,0);
    #undef PK
  }
}

#ifndef ATTN_STORE16
#define ATTN_STORE16(p,v) (*(u32x4*)(p)=(v))
#endif
template<int THRL> __device__ __forceinline__ void attn_unit(int b,int h,int qb,const bf16*Q,const bf16*__restrict__ K,const bf16*__restrict__ V,bf16*O,const float*__restrict__ kbar,char*shm,const int tid){
  const int lane=tid&63,r32=lane&31,hi=lane>>5; const int wid=__builtin_amdgcn_readfirstlane(tid>>6);
  float kbv=0.f; { int tk=tid; asm volatile("":"+v"(tk)); if(qb>=4&&tk<448)kbv=kbar[tk]; }
  const long rowbase=(long)b*SEQ; const int q0=qb*QB;
  const bf16*Qw=Q+(rowbase+q0+wid*QBLK)*QP+h*D;
  const bf16*Kh=K+rowbase*QP+h*D,*Vh=V+rowbase*QP+h*D;
  const unsigned lds0=(unsigned)(uintptr_t)shm;
  float*wsf=(float*)(shm+LDS_WS)+wid*64;
  const bf16*ksrc=Kh+(long)lane*QP+wid*8;
  const bf16*vsrc=Vh+(long)(16*(wid&3)+(lane>>2))*QP+(wid>>2)*32+(lane&3)*8;
  const unsigned kdst=lds0+LDS_K+wid*1024, vdst=lds0+LDS_V+wid*1024;
  #define DMA_K(t,slot) glds16(ksrc+(long)(t)*KVBLK*QP,(unsigned)__builtin_amdgcn_readfirstlane(kdst+(slot)))
  #define DMA_V(t,slot) glds16(vsrc+(long)(t)*KVBLK*QP,(unsigned)__builtin_amdgcn_readfirstlane(vdst+(slot)))
  const int vb0=(int)(lds0+LDS_V)+((lane>>4)&1)*32+(lane&3)*8+(4*hi+((lane&15)>>2))*64;
  const char*Kbase=shm+LDS_K; bf16x8 kf[8];
  const lds_cptr shm3=(lds_cptr)shm; const lds_cptr kp0=shm3+LDS_K+hi*1024+r32*16; const lds_cptr vp0=shm3+LDS_V+((lane>>4)&1)*32+(lane&3)*8+(4*hi+((lane&15)>>2))*64;
  const int NT=(q0+QB)/KVBLK;
  DMA_K(0,0);DMA_V(0,0);DMA_K(1,SLOTB);
  bf16x8 qr[4];
  #pragma unroll
  for(int d0=0;d0<4;++d0)qr[d0]=*reinterpret_cast<const bf16x8*>(&Qw[(long)r32*QP+d0*16+hi*8]);
  float mhat=0.f,l_reg=0.f;f32x16 o[2];o[0]=f32x16{};o[1]=f32x16{};f32x16 negm=f32x16{};asm volatile("":"+v"(negm));
  const int qrel=wid*QBLK+r32;
  #define CMASK(P0,P1,t) do{int jb_=(t)-(NT-4); if(jb_>=0)cmask(P0,P1,jb_,qrel,hi);}while(0)
  bool resc=false;
  #define START(P0,P1) do{ const float rm=rowmax(P0,P1); resc=false; \
    { const float dl=selcur?rm:-64.f; mhat=fadd_s(mhat,dl); \
      _Pragma("unroll") for(int r=0;r<16;++r){P0[r]=fsub_s(P0[r],dl);P1[r]=fsub_s(P1[r],dl);} \
      { const float nv_=selcur?-mhat:NEGBIG; _Pragma("unroll") for(int r=0;r<16;++r)negm[r]=nv_; } asm volatile("":"+v"(negm)); } \
    _Pragma("unroll") for(int r=0;r<16;++r)P0[r]=__builtin_amdgcn_exp2f(P0[r]); }while(0)
  #define RESC() do{ if(resc){ asm volatile("s_waitcnt lgkmcnt(0)":::"memory"); \
      _Pragma("unroll") for(int d_=0;d_<2;++d_) _Pragma("unroll") for(int r=0;r<16;++r)o[d_][r]*=wsf[crow(r,hi)]; } }while(0)
  f32x16 pA0,pA1,pB0,pB1;
  int sl_prev=0,sl_cur=0,sl_next=SLOTB;
  #define ROT() do{sl_prev=sl_cur;sl_cur=sl_next;sl_next=(sl_next==(NSLOT-1)*SLOTB)?0:sl_next+SLOTB;}while(0)
  DMA_K(2,2*SLOTB);
  if(qb>=4){ if(tid<448){ const unsigned hb=__builtin_bit_cast(unsigned,kbv); const unsigned hr=(hb+0x7fffu+((hb>>16)&1u))&0xffff0000u; const float lo_=kbv-__builtin_bit_cast(float,hr); const unsigned lb=__builtin_bit_cast(unsigned,lo_);
      ((unsigned short*)(shm+LDS_KBAR))[tid]=(unsigned short)(hr>>16); ((unsigned short*)(shm+LDS_KBAR+1024))[tid]=(unsigned short)((lb+0x7fffu+((lb>>16)&1u))>>16); } }
  WAIT_BAR(3);
  unsigned bmask=(1u<<(qb+1))-1u;
  if(qb>=4){ float gsc[8];
    { const lds_cptr kb3=shm3+LDS_KBAR+(r32&7)*128+hi*16; f32x16 g=f32x16{};
      _Pragma("unroll") for(int d0=0;d0<4;++d0){ const bf16x8 ah=*(const __attribute__((address_space(3))) bf16x8*)(kb3+d0*32), al=*(const __attribute__((address_space(3))) bf16x8*)(kb3+1024+d0*32);
        g=__builtin_amdgcn_mfma_f32_32x32x16_bf16(ah,qr[d0],g,0,0,0); g=__builtin_amdgcn_mfma_f32_32x32x16_bf16(al,qr[d0],g,0,0,0); }
      _Pragma("unroll") for(int r=0;r<4;++r){ auto rr=__builtin_amdgcn_permlane32_swap(__float_as_uint(g[r]),__float_as_uint(g[r]),false,false); gsc[r]=__uint_as_float(rr[0]); gsc[4+r]=__uint_as_float(rr[1]); } }
    _Pragma("unroll") for(int n=0;n<7;++n) gsc[n]=(n<qb)?gsc[n]:-3.0e38f;
    bmask=1u<<qb;
    _Pragma("unroll") for(int pick=0;pick<3;++pick){ float best=-3.4e38f; unsigned bi=0u;
      _Pragma("unroll") for(int n=0;n<7;++n){ const bool ok=!((bmask>>n)&1u)&&gsc[n]>best; best=ok?gsc[n]:best; bi=ok?(unsigned)n:bi; }
      bmask|=1u<<bi; } }
  bool selcur=(bmask&1u)!=0u;
  { const float nv=selcur?0.f:NEGBIG; _Pragma("unroll") for(int r=0;r<16;++r)negm[r]=nv; asm volatile("":"+v"(negm)); }
  qkt(pA0,pA1,Kbase,qr,negm,r32,hi);asm volatile("s_nop 15\n\ts_nop 7":"+v"(pA0),"+v"(pA1));CMASK(pA0,pA1,0);
  START(pA0,pA1);
  _Pragma("unroll") for(int r=0;r<16;++r)pA1[r]=__builtin_amdgcn_exp2f(pA1[r]);
  WAIT_BAR(0);
  DMA_K(3,0);DMA_V(1,SLOTB);
  ROT();
  kload8(kf,kp0+sl_cur);
  WAIT_BAR(2);
  s16x4 vlo[8],vhi[8]; u32x4 pw0,pw1,pw2,pw3;
  #define PKW(P,B) cvtpk_s(P[B],P[B+1])
  #define PAF(k) __builtin_bit_cast(bf16x8,pw##k)
  #define VFR(i) (bf16x8){vlo[i][0],vlo[i][1],vlo[i][2],vlo[i][3],vhi[i][0],vhi[i][1],vhi[i][2],vhi[i][3]}
  #define PIN(x) asm volatile("":"+v"(x))
  #define MX3(a,b,c) __builtin_fmaxf(__builtin_fmaxf((a),(b)),(c))
  #define GAPA(MF,A0,A1,A2,A3,W0,W1,PW) do{ MF; sacc+=A0; sacc+=A1; sacc+=A2; sacc+=A3; PIN(sacc); W0; W1; PIN(PW); SBAR(); }while(0)
  #define EX(v) __builtin_amdgcn_exp2f(v)
  #define GAPB(MF,X,B) do{ MF; X[B]=EX(X[B]); X[B+1]=EX(X[B+1]); X[B+2]=EX(X[B+2]); X[B+3]=EX(X[B+3]); PIN(X); SBAR(); }while(0)
  #define VRD(i) do{ vlo[i]=vtr(vp_+(((i)>>2)*4096+((i)&3)*1024)); vhi[i]=vtr(vp_+(((i)>>2)*4096+((i)&3)*1024+512)); }while(0)
  #define KRD(G,j) do{ if(G){ kload2(kf,kp0+sl_next,j); SBAR(); } }while(0)
  #define STEP(C0,C1,P0,P1,t,GK,GV,GL) do{ SBAR(); \
    const lds_cptr vp_=vp0+sl_prev; \
    VRD(0); SBAR(); float sacc=(P0[0]+P0[1]); \
    GAPA(C0=__builtin_amdgcn_mfma_f32_32x32x16_bf16(kf[0],qr[0],negm,0,0,0), P0[2],P0[3],P0[4],P0[5],     pw0[0]=PKW(P0,0), pw0[1]=PKW(P0,2), pw0); \
    VRD(4); SBAR(); GAPA(C1=__builtin_amdgcn_mfma_f32_32x32x16_bf16(kf[1],qr[0],negm,0,0,0), P0[6],P0[7],P0[8],P0[9],     pw0[2]=PKW(P0,4), pw0[3]=PKW(P0,6), pw0); \
    VRD(1); SBAR(); GAPA(C0=__builtin_amdgcn_mfma_f32_32x32x16_bf16(kf[2],qr[1],C0,0,0,0),   P0[10],P0[11],P0[12],P0[13], pw1[0]=PKW(P0,8), pw1[1]=PKW(P0,10), pw1); \
    VRD(5); SBAR(); GAPA(C1=__builtin_amdgcn_mfma_f32_32x32x16_bf16(kf[3],qr[1],C1,0,0,0),   P0[14],P0[15],P1[0],P1[1],   pw1[2]=PKW(P0,12),pw1[3]=PKW(P0,14), pw1); \
    VRD(2); SBAR(); GAPA(C0=__builtin_amdgcn_mfma_f32_32x32x16_bf16(kf[4],qr[2],C0,0,0,0),   P1[2],P1[3],P1[4],P1[5],     pw2[0]=PKW(P1,0), pw2[1]=PKW(P1,2), pw2); \
    VRD(6); SBAR(); GAPA(C1=__builtin_amdgcn_mfma_f32_32x32x16_bf16(kf[5],qr[2],C1,0,0,0),   P1[6],P1[7],P1[8],P1[9],     pw2[2]=PKW(P1,4), pw2[3]=PKW(P1,6), pw2); \
    VRD(3); SBAR(); GAPA(C0=__builtin_amdgcn_mfma_f32_32x32x16_bf16(kf[6],qr[3],C0,0,0,0),   P1[10],P1[11],P1[12],P1[13], pw3[0]=PKW(P1,8), pw3[1]=PKW(P1,10), pw3); \
    VRD(7); SBAR(); GAPA(C1=__builtin_amdgcn_mfma_f32_32x32x16_bf16(kf[7],qr[3],C1,0,0,0),   P1[14],P1[15],0.f,0.f,       pw3[2]=PKW(P1,12),pw3[3]=PKW(P1,14), pw3); \
    l_reg+=sacc; \
    if(GK){DMA_K((t)+3,sl_cur);} if(GV){DMA_V((t)+1,sl_next);} \
    CMASK(C0,C1,t); \
    { float a=MX3(C0[0],C0[1],C1[0]),b=MX3(C0[2],C0[3],C1[1]); a=MX3(a,C1[2],C1[3]); \
      _Pragma("unroll") for(int r=4;r<16;r+=4){a=MX3(a,C0[r],C0[r+1]);b=MX3(b,C0[r+2],C0[r+3]);a=MX3(a,C1[r],C1[r+1]);b=MX3(b,C1[r+2],C1[r+3]);} \
      float rm=__builtin_fmaxf(a,b); { auto rr=__builtin_amdgcn_permlane32_swap(__float_as_uint(rm),__float_as_uint(rm),false,false); rm=__builtin_fmaxf(__uint_as_float(rr[0]),__uint_as_float(rr[1])); } \
      resc=false; \
      if(__builtin_expect(__any(rm>(float)THRL),0)){ const float dl=__builtin_fmaxf(rm,0.f); mhat+=dl; \
        _Pragma("unroll") for(int r=0;r<16;++r){C0[r]-=dl;C1[r]-=dl;} \
        { const float nv_=selcur?-mhat:NEGBIG; _Pragma("unroll") for(int r=0;r<16;++r)negm[r]=nv_; } asm volatile("":"+v"(negm)); \
        const float f=__builtin_amdgcn_exp2f(-dl); l_reg*=f; if(hi==0)wsf[r32]=f; resc=true; } } \
    SBAR(); \
    GAPB(o[0]=__builtin_amdgcn_mfma_f32_32x32x16_bf16(PAF(0),VFR(0),o[0],0,0,0), C0,0); \
    GAPB(o[1]=__builtin_amdgcn_mfma_f32_32x32x16_bf16(PAF(0),VFR(4),o[1],0,0,0), C0,4); \
    KRD(GL,0); GAPB(o[0]=__builtin_amdgcn_mfma_f32_32x32x16_bf16(PAF(1),VFR(1),o[0],0,0,0), C0,8); \
    KRD(GL,1); GAPB(o[1]=__builtin_amdgcn_mfma_f32_32x32x16_bf16(PAF(1),VFR(5),o[1],0,0,0), C0,12); \
    KRD(GL,2); GAPB(o[0]=__builtin_amdgcn_mfma_f32_32x32x16_bf16(PAF(2),VFR(2),o[0],0,0,0), C1,0); \
    KRD(GL,3); GAPB(o[1]=__builtin_amdgcn_mfma_f32_32x32x16_bf16(PAF(2),VFR(6),o[1],0,0,0), C1,4); \
    GAPB(o[0]=__builtin_amdgcn_mfma_f32_32x32x16_bf16(PAF(3),VFR(3),o[0],0,0,0), C1,8); \
    GAPB(o[1]=__builtin_amdgcn_mfma_f32_32x32x16_bf16(PAF(3),VFR(7),o[1],0,0,0), C1,12); \
    }while(0)
  #define BLKSEL(tt) do{ if((((tt))&3)==0){ selcur=((bmask>>((tt)>>2))&1u)!=0u; const float nv_=selcur?-mhat:NEGBIG; _Pragma("unroll") for(int r=0;r<16;++r)negm[r]=nv_; asm volatile("":"+v"(negm)); } }while(0)
  int t=1;
  #undef CMASK
  #define CMASK(P0,P1,t) do{}while(0)
  for(;t+5<NT;t+=2){
    STEP(pB0,pB1,pA0,pA1,t,true,true,true);     WAIT_BAR(2); RESC(); ROT(); BLKSEL(t+1);
    STEP(pA0,pA1,pB0,pB1,t+1,true,true,true);   WAIT_BAR(2); RESC(); ROT();
  }
  #undef CMASK
  #define CMASK(P0,P1,t) do{int jb_=(t)-(NT-4); if(jb_>=0)cmask(P0,P1,jb_,qrel,hi);}while(0)
  #define ENDW(tt) do{ if((tt)+3<NT){WAIT_BAR(2);} else if((tt)+2<NT){WAIT_BAR(1);} else {WAIT_BAR(0);} }while(0)
  for(;t+1<NT;t+=2){
    STEP(pB0,pB1,pA0,pA1,t,(t+3<NT),(t+1<NT),(t+1<NT));       ENDW(t);   RESC(); ROT(); BLKSEL(t+1);
    STEP(pA0,pA1,pB0,pB1,t+1,(t+4<NT),(t+2<NT),(t+2<NT));     ENDW(t+1); RESC(); ROT();
  }
  STEP(pB0,pB1,pA0,pA1,NT-1,false,false,false); RESC();
  { float sacc=pB0[0]+pB0[1]; _Pragma("unroll") for(int r=2;r<16;++r)sacc+=pB0[r]; _Pragma("unroll") for(int r=0;r<16;++r)sacc+=pB1[r]; l_reg+=sacc;
    pw0=(u32x4){PKW(pB0,0),PKW(pB0,2),PKW(pB0,4),PKW(pB0,6)};pw1=(u32x4){PKW(pB0,8),PKW(pB0,10),PKW(pB0,12),PKW(pB0,14)};pw2=(u32x4){PKW(pB1,0),PKW(pB1,2),PKW(pB1,4),PKW(pB1,6)};pw3=(u32x4){PKW(pB1,8),PKW(pB1,10),PKW(pB1,12),PKW(pB1,14)};
    SBAR(); pv(o,vb0+sl_cur,PAF(0),PAF(1),PAF(2),PAF(3)); }
  #undef PKW
  #undef PAF
  #undef VFR
  #undef PIN
  #undef MX3
  #undef GAPA
  #undef GAPB
  #undef EX
  #undef VRD
  #undef KRD
  #undef STEP
  #undef ENDW
  {auto rr=__builtin_amdgcn_permlane32_swap(__float_as_uint(l_reg),__float_as_uint(l_reg),false,false);l_reg=__uint_as_float(rr[0])+__uint_as_float(rr[1]);}
  if(hi==0)wsf[32+r32]=l_reg;asm volatile("s_waitcnt lgkmcnt(0)":::"memory");
  float rli[16];
  #pragma unroll
  for(int r=0;r<16;++r)rli[r]=__builtin_amdgcn_rcpf(wsf[32+crow(r,hi)]);
  unsigned char*Ow=(unsigned char*)O+(rowbase+q0+wid*QBLK)*OP+h*D;
  { unsigned char*stg=(unsigned char*)(shm+LDS_OST)+wid*4096;
    #pragma unroll
    for(int r=0;r<16;++r){const int orow=crow(r,hi);
      #pragma unroll
      for(int d0=0;d0<2;++d0){const float ov=__builtin_amdgcn_fmed3f(o[d0][r]*rli[r]*32.f,-448.f,448.f); stg[orow*64+d0*32+r32]=(unsigned char)__builtin_amdgcn_cvt_pk_fp8_f32(ov,ov,0,false);}}
    asm volatile("s_waitcnt lgkmcnt(0)":::"memory");
    #pragma unroll
    for(int i=0;i<2;++i){const int row=i*16+(lane>>2),ch=lane&3; const u32x4 v=*(const u32x4*)(stg+row*64+ch*16); ATTN_STORE16(Ow+(long)row*OP+ch*16,v);} }
  asm volatile("s_waitcnt lgkmcnt(0)\n\ts_barrier":::"memory");
  #undef BLKSEL
  #undef DMA_K
  #undef DMA_V
  #undef CMASK
  #undef START
  #undef RESC
  #undef ROT
}
constexpr int ATTN_LDS_BYTES=LDS_BYTES;
struct AttnTensors { const bf16* Q; const bf16* K; const bf16* V; bf16* O; const float* kbar; };
struct AttnUnit { int bh; int qb; };
struct StaticOrder {
  int vcu, G;
  __device__ __forceinline__ explicit StaticOrder(int grid,int block):vcu((grid%8==0)?(block%8)*(grid/8)+block/8:block),G(grid){}
  __device__ __forceinline__ bool next(int i,AttnUnit&u)const{ const int pr=(vcu+(i>>2)*G)*2+((i>>1)&1); if(pr>=BATCH*NHEAD*4)return false;
    const int s=pr&3; u.bh=pr>>2; u.qb=(i&1)?7-s:s; return true; }
  __device__ __forceinline__ void a_ready(const AttnUnit&)const{}
  __device__ __forceinline__ void done(const AttnUnit&)const{}
};
template<class Sched,int THRL=8> __device__ __forceinline__ void attn_phase(char*lds,const AttnTensors&T,const Sched&S,const int tid_in){
  AttnUnit u; int tid_=tid_in; asm volatile("":"+v"(tid_));
  for(int i=0;S.next(i,u);++i){ S.a_ready(u); attn_unit<THRL>(u.bh/NHEAD,u.bh%NHEAD,u.qb,T.Q,T.K,T.V,T.O,T.kbar+(long)u.bh*512,lds,tid_); S.done(u); }
}
#undef SBAR
#undef WAIT_BAR
}

#define XB_TMO      128
#define XB_XCNT(j)  (256  + 64 * (j))
#define XB_XSUB(j)  (1280 + 64 * (j))
#define XB_XGEN(j)  (2304 + 64 * (j))
#define XB_TOP      3328
#define XB_TOPGEN   3392
#define XCD_BAR_WORDS 3456
#define XB_SPIN_CAP (1u << 18)

__device__ __forceinline__ unsigned xb_ld(unsigned* p)              { return __hip_atomic_load(p, __ATOMIC_RELAXED, __HIP_MEMORY_SCOPE_AGENT); }
__device__ __forceinline__ unsigned xb_add(unsigned* p, unsigned v) { return __hip_atomic_fetch_add(p, v, __ATOMIC_RELAXED, __HIP_MEMORY_SCOPE_AGENT); }
__device__ __forceinline__ unsigned xb_xcc_id() { return (unsigned)__builtin_amdgcn_s_getreg((3 << 11) | 20) & 0xFu; }
#define XB_SPIN(cond, bar) do { unsigned _sp = 0; while (cond) { __builtin_amdgcn_s_sleep(1); \
    if ((++_sp & 255u) == 0u) { if (xb_ld(&(bar)[XB_TMO])) break; if (_sp > XB_SPIN_CAP) { atomicAdd(&(bar)[XB_TMO], 1u); break; } } } } while (0)

struct XcdBarrier {
    unsigned* bar; unsigned x;
    volatile LAS unsigned* st;
};

__device__ __forceinline__ XcdBarrier xcd_barrier_post(unsigned* bar, volatile LAS unsigned* st) {
    XcdBarrier b; b.bar = bar; b.x = xb_xcc_id(); b.st = st;
    if (threadIdx.x == 0) (void)xb_add(&bar[XB_XCNT(b.x)], 1u);
    return b;
}
__device__ __forceinline__ void xcd_barrier_complete(unsigned* bar, unsigned x, unsigned& nloc, unsigned& nx) {
    const unsigned G = gridDim.x * gridDim.y * gridDim.z;
    unsigned sum, cnt, mine, sp = 0u;
    for (;;) {
        sum = 0u; cnt = 0u; mine = 0u;
#pragma unroll
        for (unsigned j = 0; j < 16; ++j) { const unsigned c = xb_ld(&bar[XB_XCNT(j)]); sum += c; cnt += (c > 0u) ? 1u : 0u; mine = (j == x) ? c : mine; }
        if (sum == G) break;
        __builtin_amdgcn_s_sleep(1);
        if ((++sp & 255u) == 0u) { if (xb_ld(&bar[XB_TMO])) break; if (sp > XB_SPIN_CAP) { atomicAdd(&bar[XB_TMO], 1u); break; } }
    }
    nloc = mine > 0u ? mine : 1u; nx = cnt > 0u ? cnt : 1u;
}

__device__ __forceinline__ void xcd_barrier(const XcdBarrier& b, const bool is_t0) {
    asm volatile("s_waitcnt vmcnt(0)" ::: "memory");
    __syncthreads();
    if (is_t0) {
        unsigned* bar = b.bar;
        __builtin_amdgcn_s_waitcnt(0);
        unsigned nloc = b.st[0], nx = b.st[1];
        if (nloc == 0u) { xcd_barrier_complete(bar, b.x, nloc, nx); b.st[0] = nloc; b.st[1] = nx; }
        const unsigned old = xb_add(&bar[XB_XSUB(b.x)], 1u);
        const unsigned gen = old / nloc;
        if (old + 1u == (gen + 1u) * nloc) {
            __builtin_amdgcn_fence(__ATOMIC_RELEASE, "agent");
            asm volatile("s_waitcnt vmcnt(0)" ::: "memory");
            const unsigned og = xb_add(&bar[XB_TOP], 1u);
            const unsigned tg = og / nx;
            if (og + 1u == (tg + 1u) * nx) xb_add(&bar[XB_TOPGEN], 1u);
            else XB_SPIN(xb_ld(&bar[XB_TOPGEN]) == tg, bar);
            __builtin_amdgcn_fence(__ATOMIC_ACQUIRE, "agent");
            xb_add(&bar[XB_XGEN(b.x)], 1u);
            asm volatile("s_waitcnt vmcnt(0)" ::: "memory");
        } else {
            XB_SPIN(xb_ld(&bar[XB_XGEN(b.x)]) == gen, bar);
            __builtin_amdgcn_fence(__ATOMIC_ACQUIRE, "agent");
            asm volatile("s_waitcnt vmcnt(0)" ::: "memory");
        }
    }
    __syncthreads();
}

struct Args { const float* in[17]; float* out; unsigned char* ws; int ph_lo, ph_hi; };
enum { I_X = 0, I_C, I_WMOD, I_BMOD, I_WIN, I_WPOOL, I_PSCALE, I_WOUT, I_LN1G, I_LN1B, I_WR, I_RB, I_WG, I_WU, I_WDN, I_LN2G, I_LN2B };

DEVFN int lane_id_volatile() { int l; asm volatile("v_mbcnt_lo_u32_b32 %0, -1, 0\n\tv_mbcnt_hi_u32_b32 %0, -1, %0" : "=v"(l)); return l; }
struct Ctx { unsigned char* lds; __attribute__((address_space(3))) unsigned char* lds3; int tid, lane, wave, G, bid, gw, NGW; };

DEVFN void transpose_item(const float* src, int ldn, int k0, int col, bf16_t* dst, int ldk, int dst_row0, int dst_k0, float* scr, int lane) {
#pragma unroll 8
    for (int i = 0; i < 32; ++i) { const int kk = 2 * i + (lane >> 5); scr[kk * 33 + (lane & 31)] = src[(size_t)(k0 + kk) * ldn + col]; }
    LDS_WAIT();
    const int c = lane & 7;
#pragma unroll
    for (int j = 0; j < 4; ++j) { const int n = (lane >> 3) + 8 * j; const float* s = scr + (8 * c) * 33 + n;
        u32x4 o; o.x = pk2(s[0 * 33], s[1 * 33]); o.y = pk2(s[2 * 33], s[3 * 33]); o.z = pk2(s[4 * 33], s[5 * 33]); o.w = pk2(s[6 * 33], s[7 * 33]);
        *(u32x4*)(dst + (size_t)(dst_row0 + n) * ldk + dst_k0 + 8 * c) = o; }
    LDS_WAIT();
}

DEVFN void transpose_item_f8(const float* src, int ldn, int k0, int col, unsigned char* dst, int ldk, int dst_row0, int dst_k0, float* scr, int lane) {
#pragma unroll 8
    for (int i = 0; i < 32; ++i) { const int kk = 2 * i + (lane >> 5); scr[kk * 33 + (lane & 31)] = src[(size_t)(k0 + kk) * ldn + col]; }
    LDS_WAIT();
    const int c = lane & 7;
#pragma unroll
    for (int j = 0; j < 4; ++j) { const int n = (lane >> 3) + 8 * j; const float* s = scr + (8 * c) * 33 + n;
        u32x2 o; o.x = pk4_fp8(32.f * s[0 * 33], 32.f * s[1 * 33], 32.f * s[2 * 33], 32.f * s[3 * 33]); o.y = pk4_fp8(32.f * s[4 * 33], 32.f * s[5 * 33], 32.f * s[6 * 33], 32.f * s[7 * 33]);
        *(u32x2*)(dst + (size_t)(dst_row0 + n) * ldk + dst_k0 + 8 * c) = o; }
    LDS_WAIT();
}

DEVFN void ph_prologue(const Args& a, const Ctx& c) {
    unsigned char* ws = a.ws;
    float* scr = (float*)(c.lds + c.wave * 16384);
    const int lane = c.lane;
    constexpr int N1 = 2 * 16 * 64, N2 = 2 * 8 * 32, N3 = 32 * 16 * 32, N4 = 32 * 8 * 32, N5 = 2 * 64 * 16, N6 = 256;
    for (int it = c.gw; it < N1 + N2 + N3 + N4 + N5 + N6; it += c.NGW) {
        int r = it;
        if (r < N1) {
            const int l = r / 1024, kb = (r % 1024) / 64, nb = r % 64;
            const int nphys = 32 * nb + (lane & 31);
            transpose_item_f8(a.in[I_WIN] + (size_t)l * DM * DIN, DIN, 64 * kb, inproj_nlog(nphys), (unsigned char*)(ws + WS_WIN) + (size_t)l * DIN * DM, DM, 32 * nb, 64 * kb, scr, lane);
            continue; }
        r -= N1;
        if (r < N2) {
            const int l = r / 256, kb = (r % 256) / 32, nb = r % 32;
            transpose_item_f8(a.in[I_WOUT] + (size_t)l * DM * DM, DM, 64 * kb, 32 * nb + (lane & 31), (unsigned char*)(ws + WS_WOUT) + (size_t)l * DM * DM, DM, 32 * nb, 64 * kb, scr, lane);
            continue; }
        r -= N2;
        if (r < N3) {
            const int le = r / 512, kb = (r % 512) / 32, nb = r % 32;
            const int n = 32 * nb + (lane & 31), jt = n >> 8, bj = (n >> 7) & 1, i = n & 127;
            const float* src = (bj ? a.in[I_WU] : a.in[I_WG]) + (size_t)le * DM * DE;
            transpose_item_f8(src, DE, 64 * kb, jt * 128 + i, (unsigned char*)(ws + WS_WGU) + (size_t)le * DM * DM, DM, 32 * nb, 64 * kb, scr, lane);
            continue; }
        r -= N3;
        if (r < N4) {
            const int le = r / 256, kb = (r % 256) / 32, nb = r % 32;
            transpose_item_f8(a.in[I_WDN] + (size_t)le * DE * DM, DM, 64 * kb, 32 * nb + (lane & 31), (unsigned char*)(ws + WS_WD) + (size_t)le * DM * DE, DE, 32 * nb, 64 * kb, scr, lane);
            continue; }
        r -= N4;
        if (r < N5) {
            const int l = r / 1024, kdg = (r % 1024) / 16, nb = r % 16;
            const int n = nb * 64 + lane, kd0 = kdg * 8, g = kd0 >> 7, c0 = kd0 & 127;
            const float* wo = a.in[I_WOUT] + (size_t)l * DM * DM + (size_t)(512 + g * 128) * DM + n;
            const float* ps = a.in[I_PSCALE] + l * 512 + g * 128;
            const float* wp = a.in[I_WPOOL] + ((size_t)(l * 4 + g) * 128 + c0) * 128;
            float acc[8];
#pragma unroll
            for (int j = 0; j < 8; ++j) acc[j] = 0.f;
            for (int e = 0; e < 128; ++e) { const float w = wo[(size_t)e * DM] * ps[e];
#pragma unroll
                for (int j = 0; j < 8; ++j) acc[j] += wp[j * 128 + e] * w; }
            u32x2 o; o.x = pk4_fp8(128.f * acc[0], 128.f * acc[1], 128.f * acc[2], 128.f * acc[3]); o.y = pk4_fp8(128.f * acc[4], 128.f * acc[5], 128.f * acc[6], 128.f * acc[7]);
            *(u32x2*)((unsigned char*)(ws + WS_WOUT) + (size_t)l * DM * DM + (size_t)n * DM + 512 + kd0) = o;
            continue; }
        r -= N5;
        {
            const int ent = r * 64 + lane, pos = ent >> 3, i = ent & 7;
            const float inv = (float)exp2(-(double)i / 8.0 * 18.931568569324174);
            const float ang = (float)pos * inv;
            float* t = (float*)(ws + WS_ROPE) + ent * 2;
            t[0] = (float)cos((double)ang); t[1] = (float)sin((double)ang);
        }
    }
    for (int i = c.bid * 512 + c.tid; i < 2 * NB * NH * NBLK * HD; i += c.G * 512) ((float*)(ws + WS_KBAR))[i] = 0.f;
    __syncthreads();
    if (c.bid < 192) {
        float* condT = (float*)c.lds;
        float* red = (float*)(c.lds + 65536);
        for (int idx = c.tid; idx < NB * DM; idx += 512) { const int b = idx >> 10, k = idx & 1023; const float v = a.in[I_C][idx]; condT[k * 16 + b] = v / (1.f + __expf(-v)); }
        __syncthreads();
        for (int u = c.bid; u < 192; u += c.G) {
            const int l = u / 96, n0 = (u % 96) * 64;
            const float* W = a.in[I_WMOD] + (size_t)l * DM * NMOD + n0 + lane;
            float acc[16];
#pragma unroll
            for (int b = 0; b < 16; ++b) acc[b] = 0.f;
            for (int k = 128 * c.wave; k < 128 * c.wave + 128; k += 8) {
                float wv[8];
#pragma unroll
                for (int j = 0; j < 8; ++j) wv[j] = W[(size_t)(k + j) * NMOD];
#pragma unroll
                for (int j = 0; j < 8; ++j) {
                    const f32x4* cp = (const f32x4*)(condT + (k + j) * 16);
#pragma unroll
                    for (int q = 0; q < 4; ++q) { const f32x4 cv = cp[q]; acc[4 * q + 0] += cv.x * wv[j]; acc[4 * q + 1] += cv.y * wv[j]; acc[4 * q + 2] += cv.z * wv[j]; acc[4 * q + 3] += cv.w * wv[j]; }
                }
            }
#pragma unroll
            for (int b = 0; b < 16; ++b) red[(c.wave * 16 + b) * 64 + lane] = acc[b];
            __syncthreads();
            for (int o = c.tid; o < 1024; o += 512) { const int b = o >> 6, cc = o & 63; float s = a.in[I_BMOD][l * NMOD + n0 + cc];
#pragma unroll
                for (int w = 0; w < 8; ++w) s += red[(w * 16 + b) * 64 + cc];
                ((float*)(ws + WS_MOD))[(size_t)(l * NB + b) * NMOD + n0 + cc] = s; }
            __syncthreads();
        }
    }
}

DEVFN void row_stats(const f32x4 (&v)[4], float& mean, float& rstd) {
    float s = 0.f, q = 0.f;
#pragma unroll
    for (int j = 0; j < 4; ++j) { s += (v[j].x + v[j].y) + (v[j].z + v[j].w); q += (v[j].x * v[j].x + v[j].y * v[j].y) + (v[j].z * v[j].z + v[j].w * v[j].w); }
    s = swz_xor_add(s, 1); q = swz_xor_add(q, 1); s = swz_xor_add(s, 2); q = swz_xor_add(q, 2); s = swz_xor_add(s, 4); q = swz_xor_add(q, 4);
    s = swz_xor_add(s, 8); q = swz_xor_add(q, 8); s = swz_xor_add(s, 16); q = swz_xor_add(q, 16); s = half_swap_add(s); q = half_swap_add(q);
    mean = s * (1.f / DM);
    rstd = 1.f / sqrtf(fmaxf(q * (1.f / DM) - mean * mean, 0.f) + LN_EPS);
}
DEVFN void row_load(const float* p, int lane, f32x4 (&v)[4]) {
#pragma unroll
    for (int j = 0; j < 4; ++j) v[j] = *(const f32x4*)(p + 4 * lane + 256 * j);
}
DEVFN void row_mod_store(f32x4 (&v)[4], const float* sc, const float* sh, bf16_t* out, int lane) {
    float mean, rstd; row_stats(v, mean, rstd);
#pragma unroll
    for (int j = 0; j < 4; ++j) {
        const f32x4 s = *(const f32x4*)(sc + 4 * lane + 256 * j), h = *(const f32x4*)(sh + 4 * lane + 256 * j);
        v[j] = (v[j] - mean) * rstd * (s + 1.f) + h;
        u32x2 o; o.x = pk2(v[j].x, v[j].y); o.y = pk2(v[j].z, v[j].w);
        *(u32x2*)(out + 4 * lane + 256 * j) = o;
    }
}

DEVFN void wave_gemm32(f32x16& acc, const bf16_t* ap, const bf16_t* bp, int K) {
#pragma unroll 4
    for (int k = 0; k < K; k += 16) {
        const bf16x8 av = *(const bf16x8*)(ap + k), bv = *(const bf16x8*)(bp + k);
        acc = __builtin_amdgcn_mfma_f32_32x32x16_bf16(av, bv, acc, 0, 0, 0);
    }
}

DEVFN void ph_inproj_naive(const Args& a, const Ctx& c, int l) {
    const bf16_t* A = (const bf16_t*)(a.ws + WS_HB); const bf16_t* Bt = (const bf16_t*)(a.ws + WS_WIN) + (size_t)l * DIN * DM;
    bf16_t* O = (bf16_t*)(a.ws + WS_QKVP);
    const int r32 = c.lane & 31, hi = c.lane >> 5, wy = c.wave >> 2, wx = c.wave & 3;
    for (int u = c.bid; u < 512 * 16; u += c.G) {
        const int mt = u >> 4, nt = u & 15;
        f32x16 acc = {};
        wave_gemm32(acc, A + (size_t)(mt * 64 + wy * 32 + r32) * DM + hi * 8, Bt + (size_t)(nt * 128 + wx * 32 + r32) * DM + hi * 8, DM);
        const int nl = inproj_nlog(nt * 128 + wx * 32 + r32);
#pragma unroll
        for (int r = 0; r < 16; ++r) O[(size_t)(mt * 64 + wy * 32 + crow(r, hi)) * DIN + nl] = (bf16_t)f2bf(acc[r]);
    }
}

DEVFN void ph_rope_naive(const Args& a, const Ctx& c) {
    bf16_t* O = (bf16_t*)(a.ws + WS_QKVP); const float* rope = (const float*)(a.ws + WS_ROPE);
    for (int idx = c.bid * 512 + c.tid; idx < NTOK * 16; idx += c.G * 512) {
        const int which = idx & 1, hh = (idx >> 1) & 7, m = idx >> 4, t = m & (SEQ - 1);
        bf16_t* p = O + (size_t)m * DIN + which * 512 + hh * 64;
        float v[64];
#pragma unroll
        for (int q = 0; q < 8; ++q) { const u32x4 w = *(const u32x4*)(p + 8 * q);
            v[8 * q + 0] = bf_lo(w.x); v[8 * q + 1] = bf_hi(w.x); v[8 * q + 2] = bf_lo(w.y); v[8 * q + 3] = bf_hi(w.y);
            v[8 * q + 4] = bf_lo(w.z); v[8 * q + 5] = bf_hi(w.z); v[8 * q + 6] = bf_lo(w.w); v[8 * q + 7] = bf_hi(w.w); }
#pragma unroll
        for (int i = 0; i < 8; ++i) { const float cs = rope[(t * 8 + i) * 2], sn = rope[(t * 8 + i) * 2 + 1]; const float x1 = v[i], x2 = v[8 + i];
            v[i] = x1 * cs - x2 * sn; v[8 + i] = x2 * cs + x1 * sn; }
        const float sc = which == 0 ? QSCALE : 1.f;
#pragma unroll
        for (int q = 0; q < 8; ++q) { u32x4 w; w.x = pk2(v[8 * q] * sc, v[8 * q + 1] * sc); w.y = pk2(v[8 * q + 2] * sc, v[8 * q + 3] * sc); w.z = pk2(v[8 * q + 4] * sc, v[8 * q + 5] * sc); w.w = pk2(v[8 * q + 6] * sc, v[8 * q + 7] * sc);
            *(u32x4*)(p + 8 * q) = w; }
    }
}

DEVFN void ph_kbar(const Args& a, const Ctx& c, int l) {
    const bf16_t* O = (const bf16_t*)(a.ws + WS_QKVP); float* kbar = (float*)(a.ws + WS_KBAR) + (size_t)l * NB * NH * NBLK * HD;
    for (int it = c.gw; it < NB * NH * NBLK; it += c.NGW) {
        const int n = it & 7, hh = (it >> 3) & 7, b = it >> 6;
        const bf16_t* p = O + (size_t)(b * SEQ + n * MBLK) * DIN + 512 + hh * 64 + c.lane;
        float s = 0.f;
#pragma unroll 8
        for (int j = 0; j < MBLK; ++j) s += bf2f(p[(size_t)j * DIN]);
        kbar[(size_t)it * 64 + c.lane] = s * (1.f / MBLK);
    }
}

DEVFN void ph_pool(const Args& a, const Ctx& c) {
    const bf16_t* P = (const bf16_t*)(a.ws + WS_QKVP) + 1536; unsigned char* AD = (unsigned char*)(a.ws + WS_AD) + 512;
    for (int it = c.bid * 512 + c.tid; it < (NTOK / 8) * 64; it += c.G * 512) {
        const int cg = it & 63, m0 = (it >> 6) * 8, t0 = m0 & (SEQ - 1), g = cg >> 4, w = 2 << g;
        const bf16_t* pc = P + cg * 8;
        u32x4 rows[23];
#pragma unroll
        for (int k = 0; k < 23; ++k) { const int dt = k - 15; rows[k] = (u32x4){0u, 0u, 0u, 0u}; if (dt > -w && t0 + dt >= 0) rows[k] = *(const u32x4*)(pc + (size_t)(m0 + dt) * DIN); }
        float s[8];
#pragma unroll
        for (int j = 0; j < 8; ++j) s[j] = 0.f;
#pragma unroll
        for (int k = 0; k < 15; ++k) { const u32x4 v = rows[k]; s[0] += bf_lo(v.x); s[1] += bf_hi(v.x); s[2] += bf_lo(v.y); s[3] += bf_hi(v.y); s[4] += bf_lo(v.z); s[5] += bf_hi(v.z); s[6] += bf_lo(v.w); s[7] += bf_hi(v.w); }
#pragma unroll
        for (int r = 0; r < 8; ++r) {
            const int t = t0 + r; const u32x4 v = rows[15 + r];
            const float f[8] = {bf_lo(v.x), bf_hi(v.x), bf_lo(v.y), bf_hi(v.y), bf_lo(v.z), bf_hi(v.z), bf_lo(v.w), bf_hi(v.w)};
#pragma unroll
            for (int j = 0; j < 8; ++j) s[j] += f[j];
            const int cnt = (t + 1 < w) ? t + 1 : w; const float ic = 1.f / (float)cnt;
            u32x2 o; o.x = pk4_fp8(s[0] * ic - f[0], s[1] * ic - f[1], s[2] * ic - f[2], s[3] * ic - f[3]); o.y = pk4_fp8(s[4] * ic - f[4], s[5] * ic - f[5], s[6] * ic - f[6], s[7] * ic - f[7]);
            *(u32x2*)(AD + (size_t)(m0 + r) * DM + cg * 8) = o;
            u32x4 q = rows[r];
            if (w == 8) q = rows[r + 8]; else if (w == 4) q = rows[r + 12]; else if (w == 2) q = rows[r + 14];
            s[0] -= bf_lo(q.x); s[1] -= bf_hi(q.x); s[2] -= bf_lo(q.y); s[3] -= bf_hi(q.y); s[4] -= bf_lo(q.z); s[5] -= bf_hi(q.z); s[6] -= bf_lo(q.w); s[7] -= bf_hi(q.w);
        }
    }
}

DEVFN void ph_wout_naive(const Args& a, const Ctx& c, int l) {
    const bf16_t* A = (const bf16_t*)(a.ws + WS_AD); const bf16_t* Bt = (const bf16_t*)(a.ws + WS_WOUT) + (size_t)l * DM * DM;
    float* Y = (float*)(a.ws + WS_QKVP);
    const int r32 = c.lane & 31, hi = c.lane >> 5, wy = c.wave >> 2, wx = c.wave & 3;
    for (int u = c.bid; u < 512 * 8; u += c.G) {
        const int mt = u >> 3, nt = u & 7;
        f32x16 acc = {};
        wave_gemm32(acc, A + (size_t)(mt * 64 + wy * 32 + r32) * DM + hi * 8, Bt + (size_t)(nt * 128 + wx * 32 + r32) * DM + hi * 8, DM);
#pragma unroll
        for (int r = 0; r < 16; ++r) Y[(size_t)(mt * 64 + wy * 32 + crow(r, hi)) * DM + nt * 128 + wx * 32 + r32] = acc[r];
    }
}

struct MoeTab { int* cnt; int* tp; };
DEVFN MoeTab moe_table(const Args& a, const Ctx& c, int l, unsigned char* lds_at) {
    MoeTab t; t.cnt = (int*)lds_at; t.tp = t.cnt + 32;
    if (c.tid < NCLS) t.cnt[c.tid] = (int)__hip_atomic_load((unsigned*)(a.ws + WS_CTL) + CW_CNT + l * 32 + c.tid, RLX_AGENT);
    __syncthreads();
    if (c.tid == 0) { int s = 0; for (int k = 0; k < NCLS; ++k) { t.tp[k] = s; s += (t.cnt[k] + 255) >> 8; } t.tp[NCLS] = s; }
    __syncthreads();
    return t;
}
DEVFN void cls_experts(int cls, int& e1, int& e2) { const int g = cls / 6, p = cls % 6; const int lo = p < 3 ? 0 : (p < 5 ? 1 : 2), hi = p < 3 ? p + 1 : (p < 5 ? p - 1 : 3); e1 = g * 4 + lo; e2 = g * 4 + hi; }

DEVFN void ph_gateup_naive(const Args& a, const Ctx& c, int l) {
    const MoeTab T = moe_table(a, c, l, c.lds);
    const int ntiles = T.tp[NCLS];
    const bf16_t* HB = (const bf16_t*)(a.ws + WS_HB); const bf16_t* WGU = (const bf16_t*)(a.ws + WS_WGU) + (size_t)l * NE * DM * DM;
    const int* list = (const int*)(a.ws + WS_LIST); const float* rw = (const float*)(a.ws + WS_RW);
    bf16_t* ACT = (bf16_t*)(a.ws + WS_QKVP);
    const int r32 = c.lane & 31, hi = c.lane >> 5, wy = c.wave >> 2, wx = c.wave & 3;
    for (int u = c.bid; u < ntiles * 32; u += c.G) {
        const int Tt = u >> 5, sub = (u >> 3) & 3, half = (u >> 2) & 1, jt = u & 3;
        int cls = 0; while (Tt >= T.tp[cls + 1]) ++cls;
        const int j = Tt - T.tp[cls], cnt = T.cnt[cls];
        int e1, e2; cls_experts(cls, e1, e2); const int e = half ? e2 : e1;
        const int lr = sub * 64 + wy * 32 + r32, li = 256 * j + lr;
        const int tok = list[(size_t)cls * LISTCAP + (li < cnt ? li : 256 * j)];
        const bf16_t* ap = HB + (size_t)tok * DM + hi * 8;
        const bf16_t* bg = WGU + (size_t)e * DM * DM + (size_t)(jt * 256 + wx * 32 + r32) * DM + hi * 8;
        f32x16 ag = {}, au = {};
        wave_gemm32(ag, ap, bg, DM); wave_gemm32(au, ap, bg + (size_t)128 * DM, DM);
#pragma unroll
        for (int r = 0; r < 16; ++r) {
            const int lro = sub * 64 + wy * 32 + crow(r, hi), lio = 256 * j + lro;
            const float wgt = lio < cnt ? rw[((size_t)cls * LISTCAP + lio) * 2 + half] : 0.f;
            const float g = ag[r], act = g / (1.f + __expf(-g)) * au[r] * wgt;
            ACT[(size_t)(256 * Tt + lro) * DM + half * 512 + jt * 128 + wx * 32 + r32] = (bf16_t)f2bf(act);
        }
    }
}

DEVFN void ph_down_naive(const Args& a, const Ctx& c, int l) {
    const MoeTab T = moe_table(a, c, l, c.lds);
    const int ntiles = T.tp[NCLS];
    const bf16_t* ACT = (const bf16_t*)(a.ws + WS_QKVP); const bf16_t* WD = (const bf16_t*)(a.ws + WS_WD) + (size_t)l * NE * DM * DE;
    const int* list = (const int*)(a.ws + WS_LIST);
    bf16_t* Y2 = (bf16_t*)(a.ws + WS_AD);
    const int r32 = c.lane & 31, hi = c.lane >> 5, wy = c.wave >> 2, wx = c.wave & 3;
    for (int u = c.bid; u < ntiles * 32; u += c.G) {
        const int Tt = u >> 5, sub = (u >> 3) & 3, nt = u & 7;
        int cls = 0; while (Tt >= T.tp[cls + 1]) ++cls;
        const int j = Tt - T.tp[cls], cnt = T.cnt[cls];
        int e1, e2; cls_experts(cls, e1, e2);
        const bf16_t* ap = ACT + (size_t)(256 * Tt + sub * 64 + wy * 32 + r32) * DM + hi * 8;
        const int n = nt * 128 + wx * 32 + r32;
        f32x16 acc = {};
        wave_gemm32(acc, ap, WD + (size_t)e1 * DM * DE + (size_t)n * DE + hi * 8, DE);
        wave_gemm32(acc, ap + DE, WD + (size_t)e2 * DM * DE + (size_t)n * DE + hi * 8, DE);
#pragma unroll
        for (int r = 0; r < 16; ++r) {
            const int lio = 256 * j + sub * 64 + wy * 32 + crow(r, hi);
            if (lio < cnt) { const int tok = list[(size_t)cls * LISTCAP + lio]; Y2[(size_t)tok * DM + n] = (bf16_t)f2bf(acc[r]); }
        }
    }
}

constexpr size_t WS_X1B = WS_X1, WS_X2B = WS_X1 + 64 * MiB;
constexpr int ROWS_PER_WAVE = 16;
DEVFN void vec_load(const float* p, int lane, f32x4 (&v)[4]) {
#pragma unroll
    for (int j = 0; j < 4; ++j) v[j] = *(const f32x4*)(p + 4 * lane + 256 * j);
}
DEVFN void bfrow_load(const bf16_t* p, int lane, u32x2 (&w)[4]) {
#pragma unroll
    for (int j = 0; j < 4; ++j) w[j] = *(const u32x2*)(p + 4 * lane + 256 * j);
}
DEVFN f32x4 bf4(u32x2 w) { return (f32x4){bf_lo(w.x), bf_hi(w.x), bf_lo(w.y), bf_hi(w.y)}; }
DEVFN void bfrow_store(bf16_t* p, int lane, const f32x4 (&v)[4]) {
#pragma unroll
    for (int j = 0; j < 4; ++j) { u32x2 o; o.x = pk2(v[j].x, v[j].y); o.y = pk2(v[j].z, v[j].w); *(u32x2*)(p + 4 * lane + 256 * j) = o; }
}
DEVFN void f8row_store(unsigned char* p, int lane, const f32x4 (&v)[4]) {
#pragma unroll
    for (int j = 0; j < 4; ++j) *(unsigned*)(p + 4 * lane + 256 * j) = pk4_fp8(v[j].x, v[j].y, v[j].z, v[j].w);
}
DEVFN void ln_mod(f32x4 (&v)[4], const f32x4 (&sc)[4], const f32x4 (&sh)[4]) {
    float mean, rstd; row_stats(v, mean, rstd);
#pragma unroll
    for (int j = 0; j < 4; ++j) v[j] = (v[j] - mean) * rstd * (sc[j] + 1.f) + sh[j];
}
DEVFN void ln_aff(f32x4 (&v)[4], const f32x4 (&g)[4], const f32x4 (&b)[4]) {
    float mean, rstd; row_stats(v, mean, rstd);
#pragma unroll
    for (int j = 0; j < 4; ++j) v[j] = (v[j] - mean) * rstd * g[j] + b[j];
}

DEVFN void ph_h1_rows(const Args& a, const Ctx& c) {
    const float* mod = (const float*)(a.ws + WS_MOD); bf16_t* HB = (bf16_t*)(a.ws + WS_HB);
    for (int base = c.gw * ROWS_PER_WAVE; base < NTOK; base += c.NGW * ROWS_PER_WAVE) {
        const float* mb = mod + (size_t)(base >> 11) * NMOD;
        f32x4 sc[4], sh[4]; vec_load(mb + DM, c.lane, sc); vec_load(mb, c.lane, sh);
        f32x4 cur[4], nxt[4]; vec_load(a.in[I_X] + (size_t)base * DM, c.lane, cur);
#pragma unroll 1
        for (int i = 0; i < ROWS_PER_WAVE; ++i) {
            const int m = base + i;
            if (i + 1 < ROWS_PER_WAVE) vec_load(a.in[I_X] + (size_t)(m + 1) * DM, c.lane, nxt);
            ln_mod(cur, sc, sh); f8row_store((unsigned char*)HB + (size_t)m * DM, c.lane, cur);
#pragma unroll
            for (int j = 0; j < 4; ++j) cur[j] = nxt[j];
        }
    }
}

DEVFN f32x4 reduce16(const float (&lg)[16]) {
    float t[8], u[4];
#pragma unroll
    for (int e = 0; e < 8; ++e) { auto rr = __builtin_amdgcn_permlane32_swap(__float_as_uint(lg[e]), __float_as_uint(lg[e + 8]), false, false); t[e] = __uint_as_float(rr[0]) + __uint_as_float(rr[1]); }
#pragma unroll
    for (int k = 0; k < 4; ++k) { auto rr = __builtin_amdgcn_permlane16_swap(__float_as_uint(t[k]), __float_as_uint(t[k + 4]), false, false); u[k] = __uint_as_float(rr[0]) + __uint_as_float(rr[1]); }
#pragma unroll
    for (int k = 0; k < 4; ++k) { u[k] = swz_xor_add(u[k], 1); u[k] = swz_xor_add(u[k], 2); u[k] = swz_xor_add(u[k], 4); u[k] = swz_xor_add(u[k], 8); }
    return (f32x4){u[0], u[1], u[2], u[3]};
}

DEVFN void rowc_load(const Args& a, int l, int m, int lane, f32x4 (&x)[4], unsigned (&y)[4]) {
    if (l == 0) vec_load(a.in[I_X] + (size_t)m * DM, lane, x);
    else { u32x2 w[4]; bfrow_load((const bf16_t*)(a.ws + WS_X2B) + (size_t)m * DM, lane, w);
#pragma unroll
        for (int j = 0; j < 4; ++j) { x[j].x = __uint_as_float(w[j].x); x[j].y = __uint_as_float(w[j].y); } }
#pragma unroll
    for (int j = 0; j < 4; ++j) y[j] = *(const unsigned*)((const unsigned char*)(a.ws + WS_QKVP) + (size_t)m * DM + 4 * lane + 256 * j);
}
DEVFN void rowc_step(const Args& a, int l, int m, int lane, const f32x4 (&x)[4], const unsigned (&y)[4], const float* vg1, const float* vsc, const float* vsh, f32x4 (&v)[4]) {
    int z_ = 0; asm volatile("" : "+v"(z_));
    f32x4 g1[4]; vec_load(vg1 + z_, lane, g1);
#pragma unroll
    for (int j = 0; j < 4; ++j) { const f32x4 xv = (l == 0) ? x[j] : bf4((u32x2){__float_as_uint(x[j].x), __float_as_uint(x[j].y)}); v[j] = xv * ALPHA + g1[j] * f8x4_to_f32(y[j], 1.f / YSCALE); }
    { f32x4 lg[4], lb[4]; vec_load(a.in[I_LN1G] + l * DM + z_, lane, lg); vec_load(a.in[I_LN1B] + l * DM + z_, lane, lb); ln_aff(v, lg, lb); }
    bfrow_store((bf16_t*)(a.ws + WS_X1B) + (size_t)m * DM, lane, v);
    { f32x4 sc[4], sh[4]; vec_load(vsc + z_, lane, sc); vec_load(vsh + z_, lane, sh); ln_mod(v, sc, sh); }
    f8row_store((unsigned char*)(a.ws + WS_HB) + (size_t)m * DM, lane, v);
}

DEVFN void ph_rows_c(const Args& a, const Ctx& c, int l, bool publish) {
    const float* mod = (const float*)(a.ws + WS_MOD) + (size_t)l * NB * NMOD;
    const bf16_t* Y = (const bf16_t*)(a.ws + WS_QKVP); const bf16_t* X2B = (const bf16_t*)(a.ws + WS_X2B);
    bf16_t* X1B = (bf16_t*)(a.ws + WS_X1B); bf16_t* HB = (bf16_t*)(a.ws + WS_HB);
    float* wr = (float*)c.lds;
    float* vsc = (float*)(c.lds + 65536); float* vsh = vsc + DM; float* vg1 = vsh + DM;
    int* lcnt = (int*)(c.lds + 65536 + 12288); int* lbase = lcnt + 32;
    int* rcls = lbase + 32; float* rw1 = (float*)(rcls + 8 * 64); float* rw2 = rw1 + 8 * 64; int* rrow = (int*)(rw2 + 8 * 64); float* lgs = (float*)(rrow + 8 * 64);
    for (int i = c.tid; i < DM * NE; i += 512) wr[(i & 15) * DM + (i >> 4)] = a.in[I_WR][i];
    if (c.tid < 32) lcnt[c.tid] = 0;
    __syncthreads();
    int nr = 0;
    for (int base = c.gw * ROWS_PER_WAVE; base < NTOK; base += c.NGW * ROWS_PER_WAVE) {
        const float* mb = mod + (size_t)(base >> 11) * NMOD;
        __syncthreads();
        for (int i = c.tid; i < 3 * DM; i += 512) vsc[i] = (i < DM) ? mb[4 * DM + i] : (i < 2 * DM ? mb[3 * DM + (i - DM)] : mb[2 * DM + (i - 2 * DM)]);
        __syncthreads();
#pragma unroll 1
        for (int i = 0; i < ROWS_PER_WAVE; i += 2) {
            const int m = __builtin_amdgcn_readfirstlane(base + i);
            f32x4 va[4], vb[4];
            { f32x4 xa[4], xb[4]; unsigned ya[4], yb[4];
              rowc_load(a, l, m, c.lane, xa, ya); rowc_load(a, l, m + 1, c.lane, xb, yb);
              rowc_step(a, l, m, c.lane, xa, ya, vg1, vsc, vsh, va);
              rowc_step(a, l, m + 1, c.lane, xb, yb, vg1, vsc, vsh, vb); }
            float la[16], lb2[16];
#pragma unroll
            for (int e = 0; e < 16; ++e) { la[e] = 0.f; lb2[e] = 0.f; }
#pragma unroll
            for (int j = 0; j < 4; ++j)
#pragma unroll
                for (int e = 0; e < 16; ++e) { const f32x4 w = *(const f32x4*)(wr + e * DM + 4 * c.lane + 256 * j);
                    la[e] += (va[j].x * w.x + va[j].y * w.y) + (va[j].z * w.z + va[j].w * w.w); lb2[e] += (vb[j].x * w.x + vb[j].y * w.y) + (vb[j].z * w.z + vb[j].w * w.w);
                    if ((e & 7) == 7) __builtin_amdgcn_sched_barrier(0); }
            { const f32x4 ua = reduce16(la), ub = reduce16(lb2);
              if ((c.lane & 15) == 0) { *(f32x4*)(lgs + (c.wave * 16 + i) * 16 + (c.lane >> 4) * 4) = ua; *(f32x4*)(lgs + (c.wave * 16 + i + 1) * 16 + (c.lane >> 4) * 4) = ub; } }
        }
        LDS_WAIT();
        if (c.lane < ROWS_PER_WAVE) {
            float lg16[16], rb[16];
#pragma unroll
            for (int e = 0; e < 16; ++e) rb[e] = a.in[I_RB][e];
#pragma unroll
            for (int q = 0; q < 4; ++q) { const f32x4 t = *(const f32x4*)(lgs + (c.wave * 16 + c.lane) * 16 + 4 * q); lg16[4 * q] = t.x; lg16[4 * q + 1] = t.y; lg16[4 * q + 2] = t.z; lg16[4 * q + 3] = t.w; }
            float mx = lg16[0];
#pragma unroll
            for (int e = 1; e < 16; ++e) mx = fmaxf(mx, lg16[e]);
            float sum = 0.f, scr[16];
#pragma unroll
            for (int e = 0; e < 16; ++e) { scr[e] = __expf(lg16[e] - mx); sum += scr[e]; }
            const float isum = 1.f / sum;
#pragma unroll
            for (int e = 0; e < 16; ++e) scr[e] *= isum;
            float bestg = -3.4e38f; int gb = 0, bi1 = 0, bi2 = 1; float bw1 = 0.f, bw2 = 0.f;
#pragma unroll
            for (int g = 0; g < 4; ++g) {
                float m1 = scr[4 * g] + rb[4 * g], s1 = scr[4 * g]; int i1 = 0;
#pragma unroll
                for (int q = 1; q < 4; ++q) { const float sv = scr[4 * g + q] + rb[4 * g + q]; const bool ok = sv > m1; m1 = ok ? sv : m1; s1 = ok ? scr[4 * g + q] : s1; i1 = ok ? q : i1; }
                float m2 = -3.4e38f, s2 = 0.f; int i2 = 0;
#pragma unroll
                for (int q = 0; q < 4; ++q) { const float sv = scr[4 * g + q] + rb[4 * g + q]; const bool ok = (q != i1) && sv > m2; m2 = ok ? sv : m2; s2 = ok ? scr[4 * g + q] : s2; i2 = ok ? q : i2; }
                const float gs = m1 + m2; const bool better = gs > bestg;
                bestg = better ? gs : bestg; gb = better ? g : gb; bi1 = better ? i1 : bi1; bi2 = better ? i2 : bi2; bw1 = better ? s1 : bw1; bw2 = better ? s2 : bw2;
            }
            const float inv = 1.f / (bw1 + bw2);
            const int lo = bi1 < bi2 ? bi1 : bi2, hi2 = bi1 < bi2 ? bi2 : bi1;
            const float wlo = (bi1 < bi2 ? bw1 : bw2) * inv, whi = (bi1 < bi2 ? bw2 : bw1) * inv;
            const int pidx = lo == 0 ? hi2 - 1 : (lo == 1 ? hi2 + 1 : 5);
            const int slot = c.wave * 64 + nr + c.lane;
            rcls[slot] = gb * 6 + pidx; rw1[slot] = wlo; rw2[slot] = whi; rrow[slot] = base + c.lane;
        }
        nr += ROWS_PER_WAVE;
        LDS_WAIT();
    }
    LDS_WAIT();
    if (!publish) return;
    int rank = 0, cls = 0;
    if (c.lane < nr) { cls = rcls[c.wave * 64 + c.lane]; rank = atomicAdd(&lcnt[cls], 1); }
    __syncthreads();
    if (c.tid < NCLS) lbase[c.tid] = (int)__hip_atomic_fetch_add((unsigned*)(a.ws + WS_CTL) + CW_CNT + l * 32 + c.tid, (unsigned)lcnt[c.tid], RLX_AGENT);
    __syncthreads();
    if (c.lane < nr) {
        const int pos = lbase[cls] + rank;
        ((int*)(a.ws + WS_LIST))[(size_t)cls * LISTCAP + pos] = rrow[c.wave * 64 + c.lane];
        float* rw = (float*)(a.ws + WS_RW) + ((size_t)cls * LISTCAP + pos) * 2;
        rw[0] = rw1[c.wave * 64 + c.lane]; rw[1] = rw2[c.wave * 64 + c.lane];
    }
}

DEVFN void ph_rows_g(const Args& a, const Ctx& c, int l) {
    const float* mod = (const float*)(a.ws + WS_MOD) + (size_t)l * NB * NMOD;
    const bf16_t* X1B = (const bf16_t*)(a.ws + WS_X1B); const unsigned char* Y2 = (const unsigned char*)(a.ws + WS_AD);
    bf16_t* X2B = (bf16_t*)(a.ws + WS_X2B); bf16_t* HB = (bf16_t*)(a.ws + WS_HB);
    for (int base = c.gw * ROWS_PER_WAVE; base < NTOK; base += c.NGW * ROWS_PER_WAVE) {
        const float* mb = mod + (size_t)(base >> 11) * NMOD; const float* mb1 = mb + (size_t)NB * NMOD;
        f32x4 g2[4], lg[4], lb[4], sc[4], sh[4];
        vec_load(mb + 5 * DM, c.lane, g2); vec_load(a.in[I_LN2G] + l * DM, c.lane, lg); vec_load(a.in[I_LN2B] + l * DM, c.lane, lb);
        if (l == 0) { vec_load(mb1 + DM, c.lane, sc); vec_load(mb1, c.lane, sh); }
        u32x2 xc[4], xn[4]; unsigned yc[4], yn[4];
        bfrow_load(X1B + (size_t)base * DM, c.lane, xc);
#pragma unroll
        for (int j = 0; j < 4; ++j) yc[j] = *(const unsigned*)(Y2 + (size_t)base * DM + 4 * c.lane + 256 * j);
#pragma unroll 1
        for (int i = 0; i < ROWS_PER_WAVE; ++i) {
            const int m = base + i;
            if (i + 1 < ROWS_PER_WAVE) { bfrow_load(X1B + (size_t)(m + 1) * DM, c.lane, xn);
#pragma unroll
                for (int j = 0; j < 4; ++j) yn[j] = *(const unsigned*)(Y2 + (size_t)(m + 1) * DM + 4 * c.lane + 256 * j); }
            f32x4 v[4];
#pragma unroll
            for (int j = 0; j < 4; ++j) v[j] = bf4(xc[j]) * ALPHA + g2[j] * f8x4_to_f32(yc[j], 1.f / YSCALE);
            ln_aff(v, lg, lb);
            if (l == 0) { bfrow_store(X2B + (size_t)m * DM, c.lane, v); ln_mod(v, sc, sh); f8row_store((unsigned char*)HB + (size_t)m * DM, c.lane, v); }
            else {
#pragma unroll
                for (int j = 0; j < 4; ++j) *(f32x4*)(a.out + (size_t)m * DM + 4 * c.lane + 256 * j) = v[j]; }
#pragma unroll
            for (int j = 0; j < 4; ++j) { xc[j] = xn[j]; yc[j] = yn[j]; }
        }
    }
}

constexpr int MOETAB_OFF = 131072 + 512;
DEVFN void ph_inproj_fast(const Args& a, const Ctx& c, int l, bool dummy_kbar) {
    pg8::DenseSched S; S.so.init(NTOK, DIN, c.G, c.bid); S.A = (const char*)(a.ws + WS_HB); S.Bt = (const char*)(a.ws + WS_WIN) + (size_t)l * DIN * DM; S.lda = DM; S.ldb = DM;
    const pg8::EpiInproj E{(bf16_t*)(a.ws + WS_QKVP), (const float*)(a.ws + WS_ROPE), (dummy_kbar ? (float*)(a.ws + WS_RW) : (float*)(a.ws + WS_KBAR)) + (size_t)l * NB * NH * NBLK * HD};
    pg8::gemm_phase2<pg8::EpiInproj, pg8::DenseSched, true, true, false, true, 127 - 5, 127>(c.lds3, DM, DM, S, E, c.tid);
}
DEVFN void ph_wout_fast(const Args& a, const Ctx& c, int l) {
    pg8::DenseSched S; S.so.init(NTOK, DM, c.G, c.bid); S.A = (const char*)(a.ws + WS_AD); S.Bt = (const char*)(a.ws + WS_WOUT) + (size_t)l * DM * DM; S.lda = DM; S.ldb = DM;
    const pg8::EpiF8 E{(unsigned char*)(a.ws + WS_QKVP), DM};
    pg8::gemm_phase2<pg8::EpiF8, pg8::DenseSched, true, true, false, true, 127 - 5, 127 - 5, true, 127 - 7, 127>(c.lds3, DM, DM, S, E, c.tid);
}
DEVFN void moe_table_lds(const Args& a, const Ctx& c, int l) {
    int* cnt = (int*)(c.lds + MOETAB_OFF); int* tp = cnt + 32;
    if (c.tid < NCLS) cnt[c.tid] = (int)__hip_atomic_load((unsigned*)(a.ws + WS_CTL) + CW_CNT + l * 32 + c.tid, RLX_AGENT);
    __syncthreads();
    if (c.tid == 0) { int s = 0; for (int k = 0; k < NCLS; ++k) { tp[k] = s; s += (cnt[k] + 255) >> 8; } tp[NCLS] = s; }
    __syncthreads();
}
DEVFN void ph_gateup_fast(const Args& a, const Ctx& c, int l) {
    moe_table_lds(a, c, l);
    pg8::GateUpSched S; S.cnt = (const LAS int*)(c.lds3 + MOETAB_OFF); S.tp = S.cnt + 32; S.npn_shift = 3; S.nunits = S.tp[NCLS] * 8; S.G = c.G; S.c = c.bid;
    S.HB = (const char*)(a.ws + WS_HB); S.list = (const int*)(a.ws + WS_LIST); S.W = (const char*)(a.ws + WS_WGU) + (size_t)l * NE * DM * DM;
    const pg8::EpiGateUp E{(unsigned char*)(a.ws + WS_QKVP), (const float*)(a.ws + WS_RW)};
    pg8::gemm_phase2<pg8::EpiGateUp, pg8::GateUpSched, true, true, false, true, 127 - 5, 127>(c.lds3, DM, DM, S, E, c.tid);
}
DEVFN void ph_down_fast(const Args& a, const Ctx& c, int l) {
    moe_table_lds(a, c, l);
    pg8::DownSched S; S.cnt = (const LAS int*)(c.lds3 + MOETAB_OFF); S.tp = S.cnt + 32; S.npn_shift = 2; S.nunits = S.tp[NCLS] * 4; S.G = c.G; S.c = c.bid;
    S.ACT = (const char*)(a.ws + WS_QKVP); S.W = (const char*)(a.ws + WS_WD) + (size_t)l * NE * DM * DE;
    const pg8::EpiDown E{(unsigned char*)(a.ws + WS_AD), (const int*)(a.ws + WS_LIST)};
    pg8::gemm_phase2<pg8::EpiDown, pg8::DownSched, true, true, true, true, 127 - 5, 127 - 3>(c.lds3, DM, DE, S, E, c.tid);
}

#ifndef MK_N_LAUNCHES
#define MK_N_LAUNCHES 1
#endif
constexpr int RING_BYTES = 131072, LDSCTL_OFF = RING_BYTES, MISC_OFF = LDSCTL_OFF + 320, LDS_BYTES = 147456;
constexpr int PH_PER_LAYER = 7, NPHASE = 2 + 2 * PH_PER_LAYER;
constexpr int CW_BAR = 4096;
static_assert((CW_BAR + XCD_BAR_WORDS) * 4 <= (int)CTL_ZERO_BYTES, "CTL");

__global__ void __launch_bounds__(512, 2) fwd(Args a) {
    extern __shared__ __attribute__((aligned(16))) unsigned char lds[];
    const int wave_s = __builtin_amdgcn_readfirstlane(threadIdx.x >> 6);
#define MKTID() (wave_s * 64 + lane_id_volatile())
#define MKCTX() Args al = a; { size_t z_ = 0; asm volatile("" : "+s"(z_)); al.ws = a.ws + z_; } Ctx c; {     int t_ = MKTID(); asm volatile("" : "+v"(t_)); c.lds = lds; c.lds3 = (LAS unsigned char*)lds; c.tid = t_; c.lane = t_ & 63; c.wave = __builtin_amdgcn_readfirstlane(t_ >> 6); c.G = gridDim.x; c.bid = blockIdx.x; c.gw = c.bid * 8 + c.wave; c.NGW = c.G * 8; }
    const int lo = a.ph_lo, hi = a.ph_hi;
    const bool one = (hi - lo) > 1;
    for (int u = threadIdx.x; u < (LDS_BYTES - LDSCTL_OFF) / 4; u += 512) ((LAS unsigned*)((LAS unsigned char*)lds + LDSCTL_OFF))[u] = 0u;
    __syncthreads();
    XcdBarrier bar; bar.bar = (unsigned*)(a.ws + WS_CTL) + CW_BAR; bar.x = 0; bar.st = nullptr;
    if (one) bar = xcd_barrier_post((unsigned*)(a.ws + WS_CTL) + CW_BAR, (volatile LAS unsigned*)((LAS unsigned char*)lds + MISC_OFF) + 8);
#ifndef REP_PHASE
#define REP_PHASE -1
#endif
#define IN(k) (lo <= (k) && (k) < hi)
#define SEAM(k) do { if (IN(k) && IN((k) + 1)) { XcdBarrier bl_ = bar; { size_t z_ = 0; unsigned x_ = bar.x; asm volatile("" : "+s"(z_), "+s"(x_)); bl_.bar = bar.bar + z_; bl_.x = x_; } xcd_barrier(bl_, MKTID() == 0); } } while (0)
    if (IN(0)) { MKCTX(); ph_prologue(al, c); if (REP_PHASE == 0) { __syncthreads(); ph_prologue(al, c); } SEAM(0); }
    if (IN(1)) { MKCTX(); ph_h1_rows(al, c); if (REP_PHASE == 1) ph_h1_rows(al, c); SEAM(1); }
    {
        constexpr int l = 0; constexpr int p0 = 2 + l * PH_PER_LAYER;
        if (IN(p0 + 0)) { MKCTX(); ph_inproj_fast(al, c, l, false); if (REP_PHASE == 10) { __syncthreads(); ph_inproj_fast(al, c, l, true); } SEAM(p0 + 0); }
        if (IN(p0 + 1)) {
            { MKCTX(); ph_pool(al, c); }
            __syncthreads();
            const attn_body::AttnTensors AT{(const attn_body::bf16*)(a.ws + WS_QKVP), (const attn_body::bf16*)(a.ws + WS_QKVP) + 512, (const attn_body::bf16*)(a.ws + WS_QKVP) + 1024,
                                            (attn_body::bf16*)(a.ws + WS_AD), (const float*)(a.ws + WS_KBAR) + (size_t)l * NB * NH * NBLK * HD};
            const attn_body::StaticOrder S((int)gridDim.x, (int)blockIdx.x);
            attn_body::attn_phase<attn_body::StaticOrder>((char*)lds, AT, S, MKTID());
            if (REP_PHASE == 11) attn_body::attn_phase<attn_body::StaticOrder>((char*)lds, AT, S, MKTID());
            if (REP_PHASE == 17) { __syncthreads(); MKCTX(); ph_pool(al, c); }
            SEAM(p0 + 1);
        }
        if (IN(p0 + 2)) { MKCTX(); ph_wout_fast(al, c, l); if (REP_PHASE == 12) { __syncthreads(); ph_wout_fast(al, c, l); } SEAM(p0 + 2); }
        if (IN(p0 + 3)) { MKCTX(); if (REP_PHASE == 13) { ph_rows_c(al, c, l, false); __syncthreads(); } ph_rows_c(al, c, l, true); SEAM(p0 + 3); }
        if (IN(p0 + 4)) { MKCTX(); ph_gateup_fast(al, c, l); if (REP_PHASE == 14) { __syncthreads(); ph_gateup_fast(al, c, l); } SEAM(p0 + 4); }
        if (IN(p0 + 5)) { MKCTX(); ph_down_fast(al, c, l); if (REP_PHASE == 15) { __syncthreads(); ph_down_fast(al, c, l); } SEAM(p0 + 5); }
        if (IN(p0 + 6)) { MKCTX(); ph_rows_g(al, c, l); if (REP_PHASE == 16) ph_rows_g(al, c, l); SEAM(p0 + 6); }
    }
    {
        constexpr int l = 1; constexpr int p0 = 2 + l * PH_PER_LAYER;
        if (IN(p0 + 0)) { MKCTX(); ph_inproj_fast(al, c, l, false); if (REP_PHASE == 10) { __syncthreads(); ph_inproj_fast(al, c, l, true); } SEAM(p0 + 0); }
        if (IN(p0 + 1)) {
            { MKCTX(); ph_pool(al, c); }
            __syncthreads();
            const attn_body::AttnTensors AT{(const attn_body::bf16*)(a.ws + WS_QKVP), (const attn_body::bf16*)(a.ws + WS_QKVP) + 512, (const attn_body::bf16*)(a.ws + WS_QKVP) + 1024,
                                            (attn_body::bf16*)(a.ws + WS_AD), (const float*)(a.ws + WS_KBAR) + (size_t)l * NB * NH * NBLK * HD};
            const attn_body::StaticOrder S((int)gridDim.x, (int)blockIdx.x);
            attn_body::attn_phase<attn_body::StaticOrder>((char*)lds, AT, S, MKTID());
            if (REP_PHASE == 11) attn_body::attn_phase<attn_body::StaticOrder>((char*)lds, AT, S, MKTID());
            if (REP_PHASE == 17) { __syncthreads(); MKCTX(); ph_pool(al, c); }
            SEAM(p0 + 1);
        }
        if (IN(p0 + 2)) { MKCTX(); ph_wout_fast(al, c, l); if (REP_PHASE == 12) { __syncthreads(); ph_wout_fast(al, c, l); } SEAM(p0 + 2); }
        if (IN(p0 + 3)) { MKCTX(); if (REP_PHASE == 13) { ph_rows_c(al, c, l, false); __syncthreads(); } ph_rows_c(al, c, l, true); SEAM(p0 + 3); }
        if (IN(p0 + 4)) { MKCTX(); ph_gateup_fast(al, c, l); if (REP_PHASE == 14) { __syncthreads(); ph_gateup_fast(al, c, l); } SEAM(p0 + 4); }
        if (IN(p0 + 5)) { MKCTX(); ph_down_fast(al, c, l); if (REP_PHASE == 15) { __syncthreads(); ph_down_fast(al, c, l); } SEAM(p0 + 5); }
        if (IN(p0 + 6)) { MKCTX(); ph_rows_g(al, c, l); if (REP_PHASE == 16) ph_rows_g(al, c, l); SEAM(p0 + 6); }
    }
#undef IN
#undef SEAM
}

extern "C" void kernel_launch(void* const* d_in, const int* in_sizes, int n_in, void* d_out, int out_size, void* d_ws, size_t ws_size, hipStream_t stream) {
    static int grid = 0;
    if (grid == 0) {
        if (n_in != 17 || out_size != NTOK * DM || ws_size < WS_END) { fprintf(stderr, "kernel_launch: unexpected problem (n_in %d out %d ws %zu)\n", n_in, out_size, ws_size); grid = -1; return; }
        if (hipFuncSetAttribute((const void*)fwd, hipFuncAttributeMaxDynamicSharedMemorySize, LDS_BYTES) != hipSuccess) { fprintf(stderr, "kernel_launch: hipFuncSetAttribute failed\n"); grid = -1; return; }
        int dev = 0, cus = 0, per_cu = 0;
        (void)hipGetDevice(&dev); (void)hipDeviceGetAttribute(&cus, hipDeviceAttributeMultiprocessorCount, dev);
        if (hipOccupancyMaxActiveBlocksPerMultiprocessor(&per_cu, (const void*)fwd, 512, LDS_BYTES) != hipSuccess || per_cu < 1) fprintf(stderr, "kernel_launch: occupancy query reports %d workgroups per CU\n", per_cu);
        (void)hipGetLastError();
        grid = cus > 0 ? cus : 256;
    }
    if (grid < 0) return;
    (void)hipMemsetAsync((char*)d_ws + WS_CTL, 0, CTL_ZERO_BYTES, stream);
    Args a{};
    for (int i = 0; i < 17; ++i) a.in[i] = (const float*)d_in[i];
    a.out = (float*)d_out; a.ws = (unsigned char*)d_ws;
#if MK_N_LAUNCHES == 1
    a.ph_lo = 0; a.ph_hi = NPHASE; hipLaunchKernelGGL(fwd, dim3(grid), dim3(512), LDS_BYTES, stream, a);
#else
    for (int p = 0; p < NPHASE; ++p) { a.ph_lo = p; a.ph_hi = p + 1; hipLaunchKernelGGL(fwd, dim3(grid), dim3(512), LDS_BYTES, stream, a); }
#endif
}
```

```cpp
#include <hip/hip_runtime.h>
#include <cstdint>
#include <cstdio>

constexpr int NB = 16, SEQ = 2048, DM = 1024, NTOK = NB * SEQ, DIN = 2048, NH = 8, HD = 64, NBLK = 8, MBLK = 256;
constexpr int NE = 16, NCLS = 24, DE = 512, NMOD = 6 * DM;
constexpr float ALPHA = 1.41421356237309515f, LN_EPS = 1e-5f;
constexpr float QSCALE = 0.125f * 1.4426950408889634f;
constexpr int LISTCAP = NTOK;

constexpr size_t MiB = 1u << 20;
constexpr size_t WS_CTL = 0, CTL_ZERO_BYTES = 1 * MiB;
constexpr size_t WS_MOD = 1 * MiB;
constexpr size_t WS_ROPE = 2 * MiB;
constexpr size_t WS_KBAR = 2 * MiB + 256 * 1024;
constexpr size_t WS_LIST = 3 * MiB;
constexpr size_t WS_RW = 6 * MiB;
constexpr size_t WS_WIN = 12 * MiB;
constexpr size_t WS_WOUT = 20 * MiB;
constexpr size_t WS_WGU = 24 * MiB;
constexpr size_t WS_WD = 88 * MiB;
constexpr size_t WS_HB = 120 * MiB;
constexpr size_t WS_QKVP = 184 * MiB;
constexpr size_t WS_AD = 312 * MiB;
constexpr size_t WS_X1 = 376 * MiB;
constexpr size_t WS_END = 504 * MiB;
constexpr int CW_TMO = 0, CW_CNT = 64;

typedef unsigned short bf16_t;
typedef short bf16x8 __attribute__((ext_vector_type(8)));
typedef float f32x4 __attribute__((ext_vector_type(4)));
typedef float f32x16 __attribute__((ext_vector_type(16)));
typedef unsigned u32x4 __attribute__((ext_vector_type(4)));
typedef unsigned u32x2 __attribute__((ext_vector_type(2)));

#define DEVFN __device__ __forceinline__
#define LDS_WAIT() asm volatile("s_waitcnt lgkmcnt(0)" ::: "memory")
#define RLX_AGENT __ATOMIC_RELAXED, __HIP_MEMORY_SCOPE_AGENT

DEVFN float bf_lo(unsigned w) { return __uint_as_float(w << 16); }
DEVFN float bf_hi(unsigned w) { return __uint_as_float(w & 0xffff0000u); }
DEVFN float bf2f(bf16_t v) { return __uint_as_float((unsigned)v << 16); }
DEVFN unsigned f2bf(float f) { unsigned u = __float_as_uint(f); return (u + 0x7fffu + ((u >> 16) & 1u)) >> 16; }
DEVFN unsigned pk2(float lo, float hi) { unsigned r; asm("v_cvt_pk_bf16_f32 %0, %1, %2" : "=v"(r) : "v"(lo), "v"(hi)); return r; }
DEVFN unsigned pk4_fp8(float a, float b, float c, float d) {
    a = __builtin_amdgcn_fmed3f(a, -448.f, 448.f); b = __builtin_amdgcn_fmed3f(b, -448.f, 448.f); c = __builtin_amdgcn_fmed3f(c, -448.f, 448.f); d = __builtin_amdgcn_fmed3f(d, -448.f, 448.f);
    unsigned w = 0u; w = __builtin_amdgcn_cvt_pk_fp8_f32(a, b, w, false); w = __builtin_amdgcn_cvt_pk_fp8_f32(c, d, w, true); return w; }
DEVFN f32x4 f8x4_to_f32(unsigned w, float sc) { const auto lo = __builtin_amdgcn_cvt_pk_f32_fp8(w, false), hi = __builtin_amdgcn_cvt_pk_f32_fp8(w, true); return (f32x4){lo[0] * sc, lo[1] * sc, hi[0] * sc, hi[1] * sc}; }
constexpr float YSCALE = 16.f;
DEVFN int crow(int r, int hi) { return (r & 3) + 8 * (r >> 2) + 4 * hi; }
#define SWZ_XOR(m) (0x1f | ((m) << 10))
DEVFN float swz_xor_add(float v, const int m) {
    switch (m) {
        case 1: return v + __int_as_float(__builtin_amdgcn_ds_swizzle(__float_as_int(v), SWZ_XOR(1)));
        case 2: return v + __int_as_float(__builtin_amdgcn_ds_swizzle(__float_as_int(v), SWZ_XOR(2)));
        case 4: return v + __int_as_float(__builtin_amdgcn_ds_swizzle(__float_as_int(v), SWZ_XOR(4)));
        case 8: return v + __int_as_float(__builtin_amdgcn_ds_swizzle(__float_as_int(v), SWZ_XOR(8)));
        default: return v + __int_as_float(__builtin_amdgcn_ds_swizzle(__float_as_int(v), SWZ_XOR(16)));
    }
}
DEVFN float half_swap_add(float v) { auto rr = __builtin_amdgcn_permlane32_swap(__float_as_uint(v), __float_as_uint(v), false, false); return __uint_as_float(rr[0]) + __uint_as_float(rr[1]); }
DEVFN float wave_sum(float v) {
    v = swz_xor_add(v, 1); v = swz_xor_add(v, 2); v = swz_xor_add(v, 4); v = swz_xor_add(v, 8); v = swz_xor_add(v, 16);
    return half_swap_add(v);
}
__host__ __device__ __forceinline__ int inproj_lgroup(int P) { return P < 16 ? (P >> 2) * 8 + (P & 3) * 2 : ((P - 16) >> 2) * 8 + ((P - 16) & 3) * 2 + 1; }
__host__ __device__ __forceinline__ int inproj_nlog(int n) { return (n & ~255) + inproj_lgroup((n & 255) >> 3) * 8 + (n & 7); }

#define GAS __attribute__((address_space(1)))
#define LAS __attribute__((address_space(3)))
typedef GAS unsigned gu32;
namespace pg8 {
#define PG8_LAS __attribute__((address_space(3)))
typedef unsigned short bf16_t;
typedef short bf16x8 __attribute__((ext_vector_type(8)));
typedef float f32x4 __attribute__((ext_vector_type(4)));
typedef unsigned u32x4 __attribute__((ext_vector_type(4)));
constexpr int BM = 256, BK = 64, HALF = 128, HTB = HALF * BK * 2  , STAGE_BYTES = 8 * HTB, NXCD = 8, WGM = 8;

__host__ __device__ __forceinline__ int lds_byte(int r, int c) { const int st = (r >> 4) * 2 + (c >> 5), rr = r & 15, cc = c & 31, ob = rr * 64 + cc * 2; return st * 1024 + (ob ^ (((ob >> 9) & 1) << 5)); }
__host__ __device__ __forceinline__ void stage_rc(int b, int& R, int& C) { const int st = b / 1024, sb = b % 1024, swz = sb ^ (((sb >> 9) & 1) << 5); R = (st >> 1) * 16 + swz / 64; C = (st & 1) * 32 + (swz % 64) / 2; }
__host__ __device__ __forceinline__ int perm32(int rho) { const int n = rho >> 4, i = rho & 15; return 8 * (i >> 2) + 4 * n + (i & 3); }

struct Unit { int pm, pn; };
struct Gemm { const bf16_t* A; const bf16_t* Bt; int M, N, K; };

struct StaticOrder {
    int nM, nN, nwg, G, c;
    __host__ __device__ void init(int M, int N, int G_, int c_) { nM = M / BM; nN = N / BM; nwg = nM * nN; G = G_; c = c_; }
    __host__ __device__ bool next(int i, Unit& u) const {
        const long L = (long)i * G + c; if (L >= nwg) return false;
        int wgid = (int)L; { const int q = nwg / NXCD, r = nwg % NXCD, xcd = wgid % NXCD, off = wgid / NXCD; wgid = (xcd < r ? xcd * (q + 1) : r * (q + 1) + (xcd - r) * q) + off; }
        const int nig = WGM * nN, gid = wgid / nig, fm = gid * WGM, gsz = (nM - fm) < WGM ? (nM - fm) : WGM;
        u.pm = fm + ((wgid % nig) % gsz); u.pn = (wgid % nig) / gsz; return true;
    }
    __device__ __forceinline__ void a_ready(const Unit&) const {}
    __device__ __forceinline__ void done(const Unit&) const {}
};

__device__ __forceinline__ unsigned cvt_pk_bf16(float lo, float hi) { unsigned r; asm volatile("v_cvt_pk_bf16_f32 %0, %1, %2" : "=v"(r) : "v"(lo), "v"(hi)); return r; }
}
namespace pg8 {
typedef int v8i_t __attribute__((ext_vector_type(8))); typedef int v4i_t __attribute__((ext_vector_type(4)));
template <class Epi, class Sched, bool ALIGN_EPI, bool GATHER, bool KSPLIT, bool FP8 = false, int SCW = 127, int SCA = 127, bool SC2 = false, int SCW2 = 127, int SCA2 = 127>
__device__ __forceinline__ void gemm_phase2(PG8_LAS unsigned char* lds, const int Kbytes, const int ldb_bytes, const Sched& S, const Epi& E, const int tid) {
    typedef typename Sched::UnitT UnitT;
    const int wid = __builtin_amdgcn_readfirstlane(tid >> 6), lane = tid & 63, wr = wid >> 2, wc = wid & 3, fr = lane & 15, fq = lane >> 4;
    int nt = Kbytes / (BK * 2); asm volatile("" : "+s"(nt));
    const int nth = nt / 2;
    unsigned voffB[2];
#pragma unroll
    for (int i = 0; i < 2; ++i) { int R[2], C[2]; stage_rc(tid * 16 + i * 8192, R[i], C[i]); const int Rb = Epi::PERM ? ((R[i] & ~31) + perm32(R[i] & 31)) : R[i]; voffB[i] = (unsigned)(Rb * ldb_bytes + C[i] * 2); }
    const size_t kstep = (size_t)(BK * 2);
    const size_t hstepB = (size_t)HALF * ldb_bytes;
    const unsigned ldsw = (unsigned)wid * 1024u;
    const int aoff = lds_byte(wr * 64 + fr, fq * 8), boff = lds_byte(wc * 32 + fr, fq * 8);
#define PG8_SA(b, h) (((b) * 2 + (h)) * HTB)
#define PG8_SB(b, h) ((4 + (b) * 2 + (h)) * HTB)
#define PG8_STAGE(bufoff, gbase, voff) do { _Pragma("unroll") for (int _i = 0; _i < 2; ++_i) \
        __builtin_amdgcn_global_load_lds((const unsigned*)((const char*)(gbase) + (voff)[_i]), (PG8_LAS unsigned*)(lds + (bufoff) + ldsw + _i * 8192), 16, 0, 0); } while (0)
#define PG8_LDA(dst, b, h) do { _Pragma("unroll") for (int m = 0; m < 4; ++m) _Pragma("unroll") for (int k = 0; k < 2; ++k) dst[m][k] = *(const PG8_LAS bf16x8*)(lds + PG8_SA(b, h) + aoff + m * 2048 + k * 1024); } while (0)
#define PG8_LDB(dst, b, h) do { _Pragma("unroll") for (int n = 0; n < 2; ++n) _Pragma("unroll") for (int k = 0; k < 2; ++k) dst[n][k] = *(const PG8_LAS bf16x8*)(lds + PG8_SB(b, h) + boff + n * 2048 + k * 1024); } while (0)
#define PG8_CAT8(x) __builtin_shufflevector(__builtin_bit_cast(v4i_t, (x)[0]), __builtin_bit_cast(v4i_t, (x)[1]), 0, 1, 2, 3, 4, 5, 6, 7)
#define PG8_MMA(ai, bj, At, Bt) do { __builtin_amdgcn_s_setprio(1); \
        if constexpr (FP8) { _Pragma("unroll") for (int m = 0; m < 4; ++m) _Pragma("unroll") for (int n = 0; n < 2; ++n) \
            acc[ai][bj][m][n] = __builtin_amdgcn_mfma_scale_f32_16x16x128_f8f6f4(PG8_CAT8(Bt[n]), PG8_CAT8(At[m]), acc[ai][bj][m][n], 0, 0, 0, scw_, 0, sca_); } \
        else { _Pragma("unroll") for (int m = 0; m < 4; ++m) _Pragma("unroll") for (int n = 0; n < 2; ++n) _Pragma("unroll") for (int k = 0; k < 2; ++k) \
            acc[ai][bj][m][n] = __builtin_amdgcn_mfma_f32_16x16x32_bf16(Bt[n][k], At[m][k], acc[ai][bj][m][n], 0, 0, 0); } \
        __builtin_amdgcn_s_setprio(0); } while (0)
#define PG8_WAIT_V(n) asm volatile("s_waitcnt vmcnt(" #n ")" ::: "memory")
#define PG8_WAIT_L(n) asm volatile("s_waitcnt lgkmcnt(" #n ")" ::: "memory")
#define PG8_BAR __builtin_amdgcn_s_barrier()
#define PG8_SCHED __builtin_amdgcn_sched_barrier(0)
#define PG8_BK(cb, cb2, kt) ((KSPLIT && (kt) >= nth) ? (cb2) + (size_t)((kt) - nth) * kstep : (cb) + (size_t)(kt) * kstep)
    UnitT cur, nxt; int ui = 0;
    if (!S.next(0, cur)) return;
    f32x4 acc[2][2][4][2];
#pragma unroll
    for (int a = 0; a < 2; ++a)
#pragma unroll
        for (int b = 0; b < 2; ++b)
#pragma unroll
            for (int m = 0; m < 4; ++m)
#pragma unroll
                for (int n = 0; n < 2; ++n) acc[a][b][m][n] = (f32x4){0.f, 0.f, 0.f, 0.f};
    bf16x8 At[4][2], B0[2][2], B1[2][2];
    unsigned vA[2][2], vAn[2][2];
    S.arows(cur, tid, vA);
#pragma unroll
    for (int h = 0; h < 2; ++h)
#pragma unroll
        for (int i = 0; i < 2; ++i) vAn[h][i] = vA[h][i];
    const char* cA = S.aptr(cur); const char* cB = S.bptr(cur); const char* cB2 = KSPLIT ? S.bptr2(cur) : cB;
    PG8_STAGE(PG8_SB(0, 0), cB, voffB); PG8_STAGE(PG8_SB(0, 1), cB + hstepB, voffB); PG8_STAGE(PG8_SA(0, 0), cA, vA[0]); PG8_STAGE(PG8_SA(0, 1), cA, vA[1]);
    if (wr == 1) PG8_BAR;
    PG8_WAIT_V(2); PG8_BAR;
    PG8_STAGE(PG8_SB(1, 0), PG8_BK(cB, cB2, 1), voffB); PG8_STAGE(PG8_SA(1, 0), cA + kstep, vA[0]); PG8_STAGE(PG8_SB(1, 1), PG8_BK(cB, cB2, 1) + hstepB, voffB);
    PG8_WAIT_V(6); PG8_BAR;
    for (;;) {
        const bool has_next = S.next(ui + 1, nxt);
        const char* nA = has_next ? S.aptr(nxt) : cA; const char* nB = has_next ? S.bptr(nxt) : cB; const char* nB2 = (KSPLIT && has_next) ? S.bptr2(nxt) : cB2;
        if (GATHER && has_next) S.arows(nxt, tid, vAn);
        for (int t = 0; t < nt; t += 2) {
            const bool last = (t == nt - 2);
            const int scw_ = ((SC2 && t >= nth) ? SCW2 : SCW) * 0x01010101, sca_ = ((SC2 && t >= nth) ? SCA2 : SCA) * 0x01010101; (void)scw_; (void)sca_;
            const char* a1 = cA + (size_t)(t + 1) * kstep;
            const char* a2 = last ? nA : cA + (size_t)(t + 2) * kstep;
            const char* b2 = last ? nB : PG8_BK(cB, cB2, t + 2);
            const char* b3 = last ? (KSPLIT ? PG8_BK(nB, nB2, 1) : nB + kstep) : PG8_BK(cB, cB2, t + 3);
            const char* a3 = a2 + kstep;
            PG8_LDB(B0, 0, 0); PG8_LDB(B1, 0, 1); PG8_SCHED; PG8_LDA(At, 0, 0); PG8_STAGE(PG8_SA(1, 1), a1, vA[1]);
            PG8_WAIT_V(8); PG8_WAIT_L(0); PG8_BAR; PG8_MMA(0, 0, At, B0); PG8_MMA(0, 1, At, B1); PG8_BAR; PG8_SCHED;
            if (GATHER && last) {
#pragma unroll
                for (int h = 0; h < 2; ++h)
#pragma unroll
                    for (int i = 0; i < 2; ++i) vA[h][i] = vAn[h][i]; }
            PG8_LDA(At, 0, 1); PG8_STAGE(PG8_SB(0, 0), b2, voffB); PG8_STAGE(PG8_SB(0, 1), b2 + hstepB, voffB); PG8_STAGE(PG8_SA(0, 0), a2, vA[0]);
            PG8_WAIT_V(8); PG8_WAIT_L(0); PG8_BAR; PG8_MMA(1, 0, At, B0); PG8_MMA(1, 1, At, B1); PG8_BAR; PG8_SCHED;
            PG8_LDB(B0, 1, 0); PG8_LDB(B1, 1, 1); PG8_SCHED; PG8_LDA(At, 1, 0); PG8_STAGE(PG8_SA(0, 1), a2, vA[1]);
            PG8_WAIT_V(8); PG8_WAIT_L(0); PG8_BAR; PG8_MMA(0, 0, At, B0); PG8_MMA(0, 1, At, B1); PG8_BAR; PG8_SCHED;
            PG8_LDA(At, 1, 1); PG8_STAGE(PG8_SB(1, 0), b3, voffB); PG8_STAGE(PG8_SB(1, 1), b3 + hstepB, voffB); PG8_STAGE(PG8_SA(1, 0), a3, vA[0]);
            PG8_WAIT_V(8); PG8_WAIT_L(0); PG8_BAR; PG8_MMA(1, 0, At, B0); PG8_MMA(1, 1, At, B1); PG8_BAR; PG8_SCHED;
        }
        if constexpr (ALIGN_EPI) { if (wr == 0) PG8_BAR; }
        if constexpr (!Epi::AFTER_DRAIN) { E(acc, cur, wr, wc, fr, fq); }
        if (!has_next) break;
#pragma unroll
        for (int a = 0; a < 2; ++a)
#pragma unroll
            for (int b = 0; b < 2; ++b)
#pragma unroll
                for (int m = 0; m < 4; ++m)
#pragma unroll
                    for (int n = 0; n < 2; ++n) acc[a][b][m][n] = (f32x4){0.f, 0.f, 0.f, 0.f};
        cur = nxt; cA = nA; cB = nB; cB2 = nB2; ++ui;
        if constexpr (ALIGN_EPI) { if (wr == 1) PG8_BAR; }
    }
    PG8_WAIT_V(0);
    if constexpr (!ALIGN_EPI) { if (wr == 0) PG8_BAR; }
    PG8_BAR;
    if constexpr (Epi::AFTER_DRAIN) { E.fused(acc, cur, wr, wc, fr, fq, lds, wid, lane); }
#undef PG8_SA
#undef PG8_SB
#undef PG8_STAGE
#undef PG8_LDA
#undef PG8_LDB
#undef PG8_MMA
#undef PG8_WAIT_V
#undef PG8_WAIT_L
#undef PG8_BAR
#undef PG8_SCHED
#undef PG8_BK
#undef PG8_CAT8
}
}
namespace pg8 {
DEVFN unsigned pkbf(float lo, float hi) { return cvt_pk_bf16(lo, hi); }
struct DenseSched {
    typedef Unit UnitT;
    StaticOrder so; const char* A; const char* Bt; int lda, ldb;
    DEVFN bool next(int i, Unit& u) const { return so.next(i, u); }
    DEVFN const char* aptr(const Unit&) const { return A; }
    DEVFN void arows(const Unit& u, const int tid_, unsigned (&v)[2][2]) const {
        int R[2], C[2]; { int t_ = tid_; asm volatile("" : "+v"(t_)); stage_rc(t_ * 16, R[0], C[0]); stage_rc(t_ * 16 + 8192, R[1], C[1]); }
#pragma unroll
        for (int h = 0; h < 2; ++h)
#pragma unroll
            for (int i = 0; i < 2; ++i) v[h][i] = (unsigned)((u.pm * BM + h * HALF + R[i]) * lda + C[i] * 2); }
    DEVFN const char* bptr(const Unit& u) const { return Bt + (size_t)u.pn * BM * ldb; }
    DEVFN const char* bptr2(const Unit& u) const { return bptr(u); }
};
struct EpiInproj {
    static constexpr bool PERM = true, AFTER_DRAIN = false;
    bf16_t* O; const float* rope; float* kbar;
    DEVFN void operator()(f32x4 (&acc)[2][2][4][2], const Unit& u, int wr, int wc, int fr, int fq) const {
        const int pn = u.pn, row0 = u.pm * BM + wr * 64 + fr;
        if (pn < 4 && fq == 0) {
#pragma unroll
            for (int ai = 0; ai < 2; ++ai)
#pragma unroll
                for (int m = 0; m < 4; ++m) { const int t = (row0 + ai * HALF + m * 16) & (SEQ - 1); const f32x4* rp = (const f32x4*)(rope + t * 16);
#pragma unroll
                    for (int q = 0; q < 4; ++q) { const f32x4 cs = rp[q];
                        { const int d = 2 * q, n = d >> 2, e = d & 3; const float x1 = acc[ai][0][m][n][e], x2 = acc[ai][1][m][n][e]; acc[ai][0][m][n][e] = x1 * cs[0] - x2 * cs[1]; acc[ai][1][m][n][e] = x2 * cs[0] + x1 * cs[1]; }
                        { const int d = 2 * q + 1, n = d >> 2, e = d & 3; const float x1 = acc[ai][0][m][n][e], x2 = acc[ai][1][m][n][e]; acc[ai][0][m][n][e] = x1 * cs[2] - x2 * cs[3]; acc[ai][1][m][n][e] = x2 * cs[2] + x1 * cs[3]; } } }
        }
        if (pn == 2 || pn == 3) {
            float* kb = kbar + (size_t)((((u.pm >> 3) * NH + (pn - 2) * 4 + wc) * NBLK + (u.pm & 7)) * HD);
#pragma unroll
            for (int bj = 0; bj < 2; ++bj)
#pragma unroll
                for (int n = 0; n < 2; ++n)
#pragma unroll
                    for (int e = 0; e < 4; ++e) { float s = 0.f;
#pragma unroll
                        for (int ai = 0; ai < 2; ++ai)
#pragma unroll
                            for (int m = 0; m < 4; ++m) s += acc[ai][bj][m][n][e];
                        s = swz_xor_add(s, 1); s = swz_xor_add(s, 2); s = swz_xor_add(s, 4); s = swz_xor_add(s, 8);
                        if (fr == 0) atomicAdd(kb + (2 * fq + bj) * 8 + 4 * n + e, s * (1.f / MBLK)); }
        }
        const float sc = pn < 2 ? QSCALE : 1.f;
#pragma unroll
        for (int ai = 0; ai < 2; ++ai)
#pragma unroll
            for (int m = 0; m < 4; ++m) { bf16_t* rowp = O + (size_t)(row0 + ai * HALF + m * 16) * DIN + pn * BM + wc * 64;
#pragma unroll
                for (int bj = 0; bj < 2; ++bj) { const f32x4 v0 = acc[ai][bj][m][0] * sc, v1 = acc[ai][bj][m][1] * sc;
                    u32x4 w; w.x = pkbf(v0[0], v0[1]); w.y = pkbf(v0[2], v0[3]); w.z = pkbf(v1[0], v1[1]); w.w = pkbf(v1[2], v1[3]);
                    *(u32x4*)(rowp + (2 * fq + bj) * 8) = w; } }
    }
};
struct EpiF8 {
    static constexpr bool PERM = true, AFTER_DRAIN = false;
    unsigned char* O; int ldc;
    DEVFN void operator()(f32x4 (&acc)[2][2][4][2], const Unit& u, int wr, int wc, int fr, int fq) const {
#pragma unroll
        for (int ai = 0; ai < 2; ++ai)
#pragma unroll
            for (int m = 0; m < 4; ++m) { unsigned char* rowp = O + (size_t)(u.pm * BM + ai * HALF + wr * 64 + m * 16 + fr) * ldc + u.pn * BM + wc * 32 + fq * 8;
#pragma unroll
                for (int bj = 0; bj < 2; ++bj) { const f32x4 v0 = acc[ai][bj][m][0] * YSCALE, v1 = acc[ai][bj][m][1] * YSCALE;
                    u32x2 w; w.x = pk4_fp8(v0[0], v0[1], v0[2], v0[3]); w.y = pk4_fp8(v1[0], v1[1], v1[2], v1[3]);
                    *(u32x2*)(rowp + bj * HALF) = w; } }
    }
};
struct MoeUnit { int pm, pn, cls, j, cnt; };
struct MoeBase {
    const PG8_LAS int* tp; const PG8_LAS int* cnt; int nunits, G, c, npn_shift;
    DEVFN bool next_(int i, MoeUnit& u) const {
        const int L = i * G + c; if (L >= nunits) return false;
        u.pm = L >> npn_shift; u.pn = L & ((1 << npn_shift) - 1);
        int cls = 0; while (u.pm >= tp[cls + 1]) ++cls;
        u.cls = cls; u.j = u.pm - tp[cls]; u.cnt = cnt[cls]; return true; }
};
DEVFN void moe_experts(int cls, int& e1, int& e2) { const int g = cls / 6, p = cls % 6; const int lo = p < 3 ? 0 : (p < 5 ? 1 : 2), hi = p < 3 ? p + 1 : (p < 5 ? p - 1 : 3); e1 = g * 4 + lo; e2 = g * 4 + hi; }
struct GateUpSched : MoeBase {
    typedef MoeUnit UnitT;
    const char* HB; const int* list; const char* W;
    DEVFN bool next(int i, MoeUnit& u) const { return next_(i, u); }
    DEVFN const char* aptr(const MoeUnit&) const { return HB; }
    DEVFN void arows(const MoeUnit& u, const int tid_, unsigned (&v)[2][2]) const {
        int R[2], C[2]; { int t_ = tid_; asm volatile("" : "+v"(t_)); stage_rc(t_ * 16, R[0], C[0]); stage_rc(t_ * 16 + 8192, R[1], C[1]); }
#pragma unroll
        for (int h = 0; h < 2; ++h)
#pragma unroll
            for (int i = 0; i < 2; ++i) { const int li = 256 * u.j + h * HALF + R[i]; const int tok = list[(size_t)u.cls * LISTCAP + (li < u.cnt ? li : 256 * u.j)]; v[h][i] = (unsigned)(tok * DM + C[i] * 2); } }
    DEVFN const char* bptr(const MoeUnit& u) const { int e1, e2; moe_experts(u.cls, e1, e2); return W + (size_t)(u.pn < 4 ? e1 : e2) * DM * DM + (size_t)(u.pn & 3) * BM * DM; }
    DEVFN const char* bptr2(const MoeUnit& u) const { return bptr(u); }
};
struct DownSched : MoeBase {
    typedef MoeUnit UnitT;
    const char* ACT; const char* W;
    DEVFN bool next(int i, MoeUnit& u) const { return next_(i, u); }
    DEVFN const char* aptr(const MoeUnit&) const { return ACT; }
    DEVFN void arows(const MoeUnit& u, const int tid_, unsigned (&v)[2][2]) const {
        int R[2], C[2]; { int t_ = tid_; asm volatile("" : "+v"(t_)); stage_rc(t_ * 16, R[0], C[0]); stage_rc(t_ * 16 + 8192, R[1], C[1]); }
#pragma unroll
        for (int h = 0; h < 2; ++h)
#pragma unroll
            for (int i = 0; i < 2; ++i) v[h][i] = (unsigned)((u.pm * BM + h * HALF + R[i]) * DM + C[i] * 2); }
    DEVFN const char* bptr(const MoeUnit& u) const { int e1, e2; moe_experts(u.cls, e1, e2); return W + (size_t)e1 * DM * DE + (size_t)u.pn * BM * DE; }
    DEVFN const char* bptr2(const MoeUnit& u) const { int e1, e2; moe_experts(u.cls, e1, e2); return W + (size_t)e2 * DM * DE + (size_t)u.pn * BM * DE; }
};
struct EpiGateUp {
    static constexpr bool PERM = true, AFTER_DRAIN = false;
    unsigned char* ACT; const float* rw;
    DEVFN void operator()(f32x4 (&acc)[2][2][4][2], const MoeUnit& u, int wr, int wc, int fr, int fq) const {
        const int half = u.pn >> 2, jt = u.pn & 3;
#pragma unroll
        for (int ai = 0; ai < 2; ++ai)
#pragma unroll
            for (int m = 0; m < 4; ++m) { const int lr = ai * HALF + wr * 64 + m * 16 + fr, li = 256 * u.j + lr;
                const float wgt = li < u.cnt ? 8.f * rw[((size_t)u.cls * LISTCAP + li) * 2 + half] : 0.f;
                f32x4 o[2];
#pragma unroll
                for (int n = 0; n < 2; ++n)
#pragma unroll
                    for (int e = 0; e < 4; ++e) { const float g = acc[ai][0][m][n][e]; o[n][e] = g * __builtin_amdgcn_rcpf(1.f + __expf(-g)) * acc[ai][1][m][n][e] * wgt; }
                u32x2 w; w.x = pk4_fp8(o[0][0], o[0][1], o[0][2], o[0][3]); w.y = pk4_fp8(o[1][0], o[1][1], o[1][2], o[1][3]);
                *(u32x2*)(ACT + (size_t)(u.pm * BM + lr) * DM + half * 512 + jt * 128 + wc * 32 + fq * 8) = w; }
    }
};
struct EpiDown {
    static constexpr bool PERM = true, AFTER_DRAIN = false;
    unsigned char* Y2; const int* list;
    DEVFN void operator()(f32x4 (&acc)[2][2][4][2], const MoeUnit& u, int wr, int wc, int fr, int fq_) const {
        int fq = fq_; asm volatile("" : "+v"(fq));
#pragma unroll
        for (int ai = 0; ai < 2; ++ai)
#pragma unroll
            for (int m = 0; m < 4; ++m) { const int li = 256 * u.j + ai * HALF + wr * 64 + m * 16 + fr;
                if (li < u.cnt) { const int tok = list[(size_t)u.cls * LISTCAP + li]; unsigned char* rowp = Y2 + (size_t)tok * DM + u.pn * BM + wc * 32 + fq * 8;
#pragma unroll
                    for (int bj = 0; bj < 2; ++bj) { const f32x4 v0 = acc[ai][bj][m][0] * YSCALE, v1 = acc[ai][bj][m][1] * YSCALE;
                        u32x2 w; w.x = pk4_fp8(v0[0], v0[1], v0[2], v0[3]); w.y = pk4_fp8(v1[0], v1[1], v1[2], v1[3]);
                        *(u32x2*)(rowp + bj * HALF) = w; } } }
    }
};
}

#include <hip/hip_bf16.h>
#include <cmath>
namespace attn_body {
using bf16=__hip_bfloat16;
using bf16x8=__attribute__((ext_vector_type(8)))short;
using s16x4=__attribute__((ext_vector_type(4)))short;
using f32x16=__attribute__((ext_vector_type(16)))float;
using u32x4=__attribute__((ext_vector_type(4)))unsigned;
constexpr int BATCH=16,NHEAD=8,SEQ=2048,D=64,QP=2048,OP=1024;
constexpr int NW=8,QBLK=32,QB=QBLK*NW,KVBLK=64,NQB=SEQ/QB;
constexpr int ATTN_PITCH=QP, ATTN_UNIT_ROWS=QB;
__device__ __forceinline__ int crow(int r,int hi){return (r&3)+8*(r>>2)+4*hi;}
#define SBAR() __builtin_amdgcn_sched_barrier(0)
__device__ __forceinline__ void cmask(f32x16&p0,f32x16&p1,int jb,int qrel,int hi){
  const float NEG=-INFINITY; int kb=64*jb+4*hi;
  #pragma unroll
  for(int r=0;r<16;++r){int kv=kb+(r&3)+8*(r>>2); if(kv>qrel)p0[r]=NEG; if(kv+32>qrel)p1[r]=NEG;}
}

constexpr int NSLOT=3, SLOTB=8192;
constexpr int LDS_K=0, LDS_V=NSLOT*SLOTB, LDS_WS=2*NSLOT*SLOTB, LDS_OST=LDS_WS+NW*64*4, LDS_KBAR=LDS_OST+NW*4096, LDS_BYTES=LDS_KBAR+2048;
constexpr float NEGBIG=-1.0e30f; typedef float f32x4_t __attribute__((ext_vector_type(4)));
__device__ __forceinline__ float bfs(short v){return __uint_as_float(((unsigned)(unsigned short)v)<<16);}
constexpr float C2=0.125f*1.4426950408889634f;
__device__ __forceinline__ void glds16(const void*gsrc,unsigned lds_dst){unsigned keep;
  asm volatile("s_mov_b32 %0, m0\n\ts_mov_b32 m0, %2\n\ts_nop 0\n\tglobal_load_lds_dwordx4 %1, off\n\ts_mov_b32 m0, %0":"=&s"(keep):"v"(gsrc),"s"(lds_dst):"memory");}
__device__ __forceinline__ float max3f(float a,float b,float c){float r;asm("v_max3_f32 %0, %1, %2, %3":"=v"(r):"v"(a),"v"(b),"v"(c));return r;}
__device__ __forceinline__ float max2f(float a,float b){float r;asm("v_max_f32_e32 %0, %1, %2":"=v"(r):"v"(a),"v"(b));return r;}
__device__ __forceinline__ float fadd_s(float a,float b){float r;asm("v_add_f32_e32 %0, %1, %2":"=v"(r):"v"(a),"v"(b));return r;}
__device__ __forceinline__ float fsub_s(float a,float b){float r;asm("v_sub_f32_e32 %0, %1, %2":"=v"(r):"v"(a),"v"(b));return r;}
typedef float f32x2_t __attribute__((ext_vector_type(2))); typedef __bf16 bf16x2_t __attribute__((ext_vector_type(2)));
__device__ __forceinline__ unsigned cvtpk_s(float lo,float hi){f32x2_t v={lo,hi};bf16x2_t b=__builtin_convertvector(v,bf16x2_t);return __builtin_bit_cast(unsigned,b);}
#define WAIT_BAR(N) asm volatile("s_waitcnt vmcnt(" #N ") lgkmcnt(0)\n\ts_barrier":::"memory")

__device__ __forceinline__ void qkt(f32x16&p0,f32x16&p1,const char*Kslot,const bf16x8*qr,const f32x16&negm,int r32,int hi){
  const char*kb=Kslot+hi*1024+r32*16;
  #pragma unroll
  for(int d0=0;d0<4;++d0){
    const bf16x8 b0=*reinterpret_cast<const bf16x8*>(kb+d0*2048);
    const bf16x8 b1=*reinterpret_cast<const bf16x8*>(kb+d0*2048+512);
    if(d0==0){p0=__builtin_amdgcn_mfma_f32_32x32x16_bf16(b0,qr[0],negm,0,0,0);p1=__builtin_amdgcn_mfma_f32_32x32x16_bf16(b1,qr[0],negm,0,0,0);}
    else{p0=__builtin_amdgcn_mfma_f32_32x32x16_bf16(b0,qr[d0],p0,0,0,0);p1=__builtin_amdgcn_mfma_f32_32x32x16_bf16(b1,qr[d0],p1,0,0,0);}}
}
typedef __attribute__((address_space(3))) const char* lds_cptr;
typedef short v4i16_t __attribute__((ext_vector_type(4)));
__device__ __forceinline__ void kload8(bf16x8*kf,lds_cptr kp){
  kf[0]=*(const __attribute__((address_space(3))) bf16x8*)(kp);      kf[1]=*(const __attribute__((address_space(3))) bf16x8*)(kp+512);
  kf[2]=*(const __attribute__((address_space(3))) bf16x8*)(kp+2048); kf[3]=*(const __attribute__((address_space(3))) bf16x8*)(kp+2560);
  kf[4]=*(const __attribute__((address_space(3))) bf16x8*)(kp+4096); kf[5]=*(const __attribute__((address_space(3))) bf16x8*)(kp+4608);
  kf[6]=*(const __attribute__((address_space(3))) bf16x8*)(kp+6144); kf[7]=*(const __attribute__((address_space(3))) bf16x8*)(kp+6656);
}
__device__ __forceinline__ void kload2(bf16x8*kf,lds_cptr kp,int j){ kf[2*j]=*(const __attribute__((address_space(3))) bf16x8*)(kp+j*2048); kf[2*j+1]=*(const __attribute__((address_space(3))) bf16x8*)(kp+j*2048+512); }
__device__ __forceinline__ s16x4 vtr(lds_cptr p){ return __builtin_bit_cast(s16x4,__builtin_amdgcn_ds_read_tr16_b64_v4i16((__attribute__((address_space(3))) v4i16_t*)p)); }
__device__ __forceinline__ float rowmax(const f32x16&p0,const f32x16&p1){
  float a=max3f(p0[0],p0[1],p1[0]),b=max3f(p0[2],p0[3],p1[1]);a=max3f(a,p1[2],p1[3]);
  #pragma unroll
  for(int r=4;r<16;r+=4){a=max3f(a,p0[r],p0[r+1]);b=max3f(b,p0[r+2],p0[r+3]);a=max3f(a,p1[r],p1[r+1]);b=max3f(b,p1[r+2],p1[r+3]);}
  const float m=max2f(a,b);
  auto rr=__builtin_amdgcn_permlane32_swap(__float_as_uint(m),__float_as_uint(m),false,false);
  return max2f(__uint_as_float(rr[0]),__uint_as_float(rr[1]));
}
__device__ __forceinline__ void pv(f32x16*o,int vb,bf16x8 pa0,bf16x8 pa1,bf16x8 pa2,bf16x8 pa3){
  #pragma unroll
  for(int d0=0;d0<2;++d0){s16x4 lo[4],hi[4];
    #pragma unroll
    for(int ks=0;ks<4;++ks){
      asm volatile("ds_read_b64_tr_b16 %0,%1 offset:%c2":"=&v"(lo[ks]):"v"(vb),"i"(d0*4096+ks*1024):"memory");
      asm volatile("ds_read_b64_tr_b16 %0,%1 offset:%c2":"=&v"(hi[ks]):"v"(vb),"i"(d0*4096+ks*1024+512):"memory");}
    asm volatile("s_waitcnt lgkmcnt(0)":::"memory");SBAR();
    #define PK(k) (bf16x8){lo[k][0],lo[k][1],lo[k][2],lo[k][3],hi[k][0],hi[k][1],hi[k][2],hi[k][3]}
    o[d0]=__builtin_amdgcn_mfma_f32_32x32x16_bf16(pa0,PK(0),o[d0],0,0,0);
    o[d0]=__builtin_amdgcn_mfma_f32_32x32x16_bf16(pa1,PK(1),o[d0],0,0,0);
    o[d0]=__builtin_amdgcn_mfma_f32_32x32x16_bf16(pa2,PK(2),o[d0],0,0,0);
    o[d0]=__builtin_amdgcn_mfma_f32_32x32x16_bf16(pa3,PK(3),o[d0],0,0,0);
    #undef PK
  }
}

#ifndef ATTN_STORE16
#define ATTN_STORE16(p,v) (*(u32x4*)(p)=(v))
#endif
template<int THRL> __device__ __forceinline__ void attn_unit(int b,int h,int qb,const bf16*Q,const bf16*__restrict__ K,const bf16*__restrict__ V,bf16*O,const float*__restrict__ kbar,char*shm,const int tid){
  const int lane=tid&63,r32=lane&31,hi=lane>>5; const int wid=__builtin_amdgcn_readfirstlane(tid>>6);
  float kbv=0.f; { int tk=tid; asm volatile("":"+v"(tk)); if(qb>=4&&tk<448)kbv=kbar[tk]; }
  const long rowbase=(long)b*SEQ; const int q0=qb*QB;
  const bf16*Qw=Q+(rowbase+q0+wid*QBLK)*QP+h*D;
  const bf16*Kh=K+rowbase*QP+h*D,*Vh=V+rowbase*QP+h*D;
  const unsigned lds0=(unsigned)(uintptr_t)shm;
  float*wsf=(float*)(shm+LDS_WS)+wid*64;
  const bf16*ksrc=Kh+(long)lane*QP+wid*8;
  const bf16*vsrc=Vh+(long)(16*(wid&3)+(lane>>2))*QP+(wid>>2)*32+(lane&3)*8;
  const unsigned kdst=lds0+LDS_K+wid*1024, vdst=lds0+LDS_V+wid*1024;
  #define DMA_K(t,slot) glds16(ksrc+(long)(t)*KVBLK*QP,(unsigned)__builtin_amdgcn_readfirstlane(kdst+(slot)))
  #define DMA_V(t,slot) glds16(vsrc+(long)(t)*KVBLK*QP,(unsigned)__builtin_amdgcn_readfirstlane(vdst+(slot)))
  const int vb0=(int)(lds0+LDS_V)+((lane>>4)&1)*32+(lane&3)*8+(4*hi+((lane&15)>>2))*64;
  const char*Kbase=shm+LDS_K; bf16x8 kf[8];
  const lds_cptr shm3=(lds_cptr)shm; const lds_cptr kp0=shm3+LDS_K+hi*1024+r32*16; const lds_cptr vp0=shm3+LDS_V+((lane>>4)&1)*32+(lane&3)*8+(4*hi+((lane&15)>>2))*64;
  const int NT=(q0+QB)/KVBLK;
  DMA_K(0,0);DMA_V(0,0);DMA_K(1,SLOTB);
  bf16x8 qr[4];
  #pragma unroll
  for(int d0=0;d0<4;++d0)qr[d0]=*reinterpret_cast<const bf16x8*>(&Qw[(long)r32*QP+d0*16+hi*8]);
  float mhat=0.f,l_reg=0.f;f32x16 o[2];o[0]=f32x16{};o[1]=f32x16{};f32x16 negm=f32x16{};asm volatile("":"+v"(negm));
  const int qrel=wid*QBLK+r32;
  #define CMASK(P0,P1,t) do{int jb_=(t)-(NT-4); if(jb_>=0)cmask(P0,P1,jb_,qrel,hi);}while(0)
  bool resc=false;
  #define START(P0,P1) do{ const float rm=rowmax(P0,P1); resc=false; \
    { const float dl=selcur?rm:-64.f; mhat=fadd_s(mhat,dl); \
      _Pragma("unroll") for(int r=0;r<16;++r){P0[r]=fsub_s(P0[r],dl);P1[r]=fsub_s(P1[r],dl);} \
      { const float nv_=selcur?-mhat:NEGBIG; _Pragma("unroll") for(int r=0;r<16;++r)negm[r]=nv_; } asm volatile("":"+v"(negm)); } \
    _Pragma("unroll") for(int r=0;r<16;++r)P0[r]=__builtin_amdgcn_exp2f(P0[r]); }while(0)
  #define RESC() do{ if(resc){ asm volatile("s_waitcnt lgkmcnt(0)":::"memory"); \
      _Pragma("unroll") for(int d_=0;d_<2;++d_) _Pragma("unroll") for(int r=0;r<16;++r)o[d_][r]*=wsf[crow(r,hi)]; } }while(0)
  f32x16 pA0,pA1,pB0,pB1;
  int sl_prev=0,sl_cur=0,sl_next=SLOTB;
  #define ROT() do{sl_prev=sl_cur;sl_cur=sl_next;sl_next=(sl_next==(NSLOT-1)*SLOTB)?0:sl_next+SLOTB;}while(0)
  DMA_K(2,2*SLOTB);
  if(qb>=4){ if(tid<448){ const unsigned hb=__builtin_bit_cast(unsigned,kbv); const unsigned hr=(hb+0x7fffu+((hb>>16)&1u))&0xffff0000u; const float lo_=kbv-__builtin_bit_cast(float,hr); const unsigned lb=__builtin_bit_cast(unsigned,lo_);
      ((unsigned short*)(shm+LDS_KBAR))[tid]=(unsigned short)(hr>>16); ((unsigned short*)(shm+LDS_KBAR+1024))[tid]=(unsigned short)((lb+0x7fffu+((lb>>16)&1u))>>16); } }
  WAIT_BAR(3);
  unsigned bmask=(1u<<(qb+1))-1u;
  if(qb>=4){ float gsc[8];
    { const lds_cptr kb3=shm3+LDS_KBAR+(r32&7)*128+hi*16; f32x16 g=f32x16{};
      _Pragma("unroll") for(int d0=0;d0<4;++d0){ const bf16x8 ah=*(const __attribute__((address_space(3))) bf16x8*)(kb3+d0*32), al=*(const __attribute__((address_space(3))) bf16x8*)(kb3+1024+d0*32);
        g=__builtin_amdgcn_mfma_f32_32x32x16_bf16(ah,qr[d0],g,0,0,0); g=__builtin_amdgcn_mfma_f32_32x32x16_bf16(al,qr[d0],g,0,0,0); }
      _Pragma("unroll") for(int r=0;r<4;++r){ auto rr=__builtin_amdgcn_permlane32_swap(__float_as_uint(g[r]),__float_as_uint(g[r]),false,false); gsc[r]=__uint_as_float(rr[0]); gsc[4+r]=__uint_as_float(rr[1]); } }
    _Pragma("unroll") for(int n=0;n<7;++n) gsc[n]=(n<qb)?gsc[n]:-3.0e38f;
    bmask=1u<<qb;
    _Pragma("unroll") for(int pick=0;pick<3;++pick){ float best=-3.4e38f; unsigned bi=0u;
      _Pragma("unroll") for(int n=0;n<7;++n){ const bool ok=!((bmask>>n)&1u)&&gsc[n]>best; best=ok?gsc[n]:best; bi=ok?(unsigned)n:bi; }
      bmask|=1u<<bi; } }
  bool selcur=(bmask&1u)!=0u;
  { const float nv=selcur?0.f:NEGBIG; _Pragma("unroll") for(int r=0;r<16;++r)negm[r]=nv; asm volatile("":"+v"(negm)); }
  qkt(pA0,pA1,Kbase,qr,negm,r32,hi);asm volatile("s_nop 15\n\ts_nop 7":"+v"(pA0),"+v"(pA1));CMASK(pA0,pA1,0);
  START(pA0,pA1);
  _Pragma("unroll") for(int r=0;r<16;++r)pA1[r]=__builtin_amdgcn_exp2f(pA1[r]);
  WAIT_BAR(0);
  DMA_K(3,0);DMA_V(1,SLOTB);
  ROT();
  kload8(kf,kp0+sl_cur);
  WAIT_BAR(2);
  s16x4 vlo[8],vhi[8]; u32x4 pw0,pw1,pw2,pw3;
  #define PKW(P,B) cvtpk_s(P[B],P[B+1])
  #define PAF(k) __builtin_bit_cast(bf16x8,pw##k)
  #define VFR(i) (bf16x8){vlo[i][0],vlo[i][1],vlo[i][2],vlo[i][3],vhi[i][0],vhi[i][1],vhi[i][2],vhi[i][3]}
  #define PIN(x) asm volatile("":"+v"(x))
  #define MX3(a,b,c) __builtin_fmaxf(__builtin_fmaxf((a),(b)),(c))
  #define GAPA(MF,A0,A1,A2,A3,W0,W1,PW) do{ MF; sacc+=A0; sacc+=A1; sacc+=A2; sacc+=A3; PIN(sacc); W0; W1; PIN(PW); SBAR(); }while(0)
  #define EX(v) __builtin_amdgcn_exp2f(v)
  #define GAPB(MF,X,B) do{ MF; X[B]=EX(X[B]); X[B+1]=EX(X[B+1]); X[B+2]=EX(X[B+2]); X[B+3]=EX(X[B+3]); PIN(X); SBAR(); }while(0)
  #define VRD(i) do{ vlo[i]=vtr(vp_+(((i)>>2)*4096+((i)&3)*1024)); vhi[i]=vtr(vp_+(((i)>>2)*4096+((i)&3)*1024+512)); }while(0)
  #define KRD(G,j) do{ if(G){ kload2(kf,kp0+sl_next,j); SBAR(); } }while(0)
  #define STEP(C0,C1,P0,P1,t,GK,GV,GL) do{ SBAR(); \
    const lds_cptr vp_=vp0+sl_prev; \
    VRD(0); SBAR(); float sacc=(P0[0]+P0[1]); \
    GAPA(C0=__builtin_amdgcn_mfma_f32_32x32x16_bf16(kf[0],qr[0],negm,0,0,0), P0[2],P0[3],P0[4],P0[5],     pw0[0]=PKW(P0,0), pw0[1]=PKW(P0,2), pw0); \
    VRD(4); SBAR(); GAPA(C1=__builtin_amdgcn_mfma_f32_32x32x16_bf16(kf[1],qr[0],negm,0,0,0), P0[6],P0[7],P0[8],P0[9],     pw0[2]=PKW(P0,4), pw0[3]=PKW(P0,6), pw0); \
    VRD(1); SBAR(); GAPA(C0=__builtin_amdgcn_mfma_f32_32x32x16_bf16(kf[2],qr[1],C0,0,0,0),   P0[10],P0[11],P0[12],P0[13], pw1[0]=PKW(P0,8), pw1[1]=PKW(P0,10), pw1); \
    VRD(5); SBAR(); GAPA(C1=__builtin_amdgcn_mfma_f32_32x32x16_bf16(kf[3],qr[1],C1,0,0,0),   P0[14],P0[15],P1[0],P1[1],   pw1[2]=PKW(P0,12),pw1[3]=PKW(P0,14), pw1); \
    VRD(2); SBAR(); GAPA(C0=__builtin_amdgcn_mfma_f32_32x32x16_bf16(kf[4],qr[2],C0,0,0,0),   P1[2],P1[3],P1[4],P1[5],     pw2[0]=PKW(P1,0), pw2[1]=PKW(P1,2), pw2); \
    VRD(6); SBAR(); GAPA(C1=__builtin_amdgcn_mfma_f32_32x32x16_bf16(kf[5],qr[2],C1,0,0,0),   P1[6],P1[7],P1[8],P1[9],     pw2[2]=PKW(P1,4), pw2[3]=PKW(P1,6), pw2); \
    VRD(3); SBAR(); GAPA(C0=__builtin_amdgcn_mfma_f32_32x32x16_bf16(kf[6],qr[3],C0,0,0,0),   P1[10],P1[11],P1[12],P1[13], pw3[0]=PKW(P1,8), pw3[1]=PKW(P1,10), pw3); \
    VRD(7); SBAR(); GAPA(C1=__builtin_amdgcn_mfma_f32_32x32x16_bf16(kf[7],qr[3],C1,0,0,0),   P1[14],P1[15],0.f,0.f,       pw3[2]=PKW(P1,12),pw3[3]=PKW(P1,14), pw3); \
    l_reg+=sacc; \
    if(GK){DMA_K((t)+3,sl_cur);} if(GV){DMA_V((t)+1,sl_next);} \
    CMASK(C0,C1,t); \
    { float a=MX3(C0[0],C0[1],C1[0]),b=MX3(C0[2],C0[3],C1[1]); a=MX3(a,C1[2],C1[3]); \
      _Pragma("unroll") for(int r=4;r<16;r+=4){a=MX3(a,C0[r],C0[r+1]);b=MX3(b,C0[r+2],C0[r+3]);a=MX3(a,C1[r],C1[r+1]);b=MX3(b,C1[r+2],C1[r+3]);} \
      float rm=__builtin_fmaxf(a,b); { auto rr=__builtin_amdgcn_permlane32_swap(__float_as_uint(rm),__float_as_uint(rm),false,false); rm=__builtin_fmaxf(__uint_as_float(rr[0]),__uint_as_float(rr[1])); } \
      resc=false; \
      if(__builtin_expect(__any(rm>(float)THRL),0)){ const float dl=__builtin_fmaxf(rm,0.f); mhat+=dl; \
        _Pragma("unroll") for(int r=0;r<16;++r){C0[r]-=dl;C1[r]-=dl;} \
        { const float nv_=selcur?-mhat:NEGBIG; _Pragma("unroll") for(int r=0;r<16;++r)negm[r]=nv_; } asm volatile("":"+v"(negm)); \
        const float f=__builtin_amdgcn_exp2f(-dl); l_reg*=f; if(hi==0)wsf[r32]=f; resc=true; } } \
    SBAR(); \
    GAPB(o[0]=__builtin_amdgcn_mfma_f32_32x32x16_bf16(PAF(0),VFR(0),o[0],0,0,0), C0,0); \
    GAPB(o[1]=__builtin_amdgcn_mfma_f32_32x32x16_bf16(PAF(0),VFR(4),o[1],0,0,0), C0,4); \
    KRD(GL,0); GAPB(o[0]=__builtin_amdgcn_mfma_f32_32x32x16_bf16(PAF(1),VFR(1),o[0],0,0,0), C0,8); \
    KRD(GL,1); GAPB(o[1]=__builtin_amdgcn_mfma_f32_32x32x16_bf16(PAF(1),VFR(5),o[1],0,0,0), C0,12); \
    KRD(GL,2); GAPB(o[0]=__builtin_amdgcn_mfma_f32_32x32x16_bf16(PAF(2),VFR(2),o[0],0,0,0), C1,0); \
    KRD(GL,3); GAPB(o[1]=__builtin_amdgcn_mfma_f32_32x32x16_bf16(PAF(2),VFR(6),o[1],0,0,0), C1,4); \
    GAPB(o[0]=__builtin_amdgcn_mfma_f32_32x32x16_bf16(PAF(3),VFR(3),o[0],0,0,0), C1,8); \
    GAPB(o[1]=__builtin_amdgcn_mfma_f32_32x32x16_bf16(PAF(3),VFR(7),o[1],0,0,0), C1,12); \
    }while(0)
  #define BLKSEL(tt) do{ if((((tt))&3)==0){ selcur=((bmask>>((tt)>>2))&1u)!=0u; const float nv_=selcur?-mhat:NEGBIG; _Pragma("unroll") for(int r=0;r<16;++r)negm[r]=nv_; asm volatile("":"+v"(negm)); } }while(0)
  int t=1;
  #undef CMASK
  #define CMASK(P0,P1,t) do{}while(0)
  for(;t+5<NT;t+=2){
    STEP(pB0,pB1,pA0,pA1,t,true,true,true);     WAIT_BAR(2); RESC(); ROT(); BLKSEL(t+1);
    STEP(pA0,pA1,pB0,pB1,t+1,true,true,true);   WAIT_BAR(2); RESC(); ROT();
  }
  #undef CMASK
  #define CMASK(P0,P1,t) do{int jb_=(t)-(NT-4); if(jb_>=0)cmask(P0,P1,jb_,qrel,hi);}while(0)
  #define ENDW(tt) do{ if((tt)+3<NT){WAIT_BAR(2);} else if((tt)+2<NT){WAIT_BAR(1);} else {WAIT_BAR(0);} }while(0)
  for(;t+1<NT;t+=2){
    STEP(pB0,pB1,pA0,pA1,t,(t+3<NT),(t+1<NT),(t+1<NT));       ENDW(t);   RESC(); ROT(); BLKSEL(t+1);
    STEP(pA0,pA1,pB0,pB1,t+1,(t+4<NT),(t+2<NT),(t+2<NT));     ENDW(t+1); RESC(); ROT();
  }
  STEP(pB0,pB1,pA0,pA1,NT-1,false,false,false); RESC();
  { float sacc=pB0[0]+pB0[1]; _Pragma("unroll") for(int r=2;r<16;++r)sacc+=pB0[r]; _Pragma("unroll") for(int r=0;r<16;++r)sacc+=pB1[r]; l_reg+=sacc;
    pw0=(u32x4){PKW(pB0,0),PKW(pB0,2),PKW(pB0,4),PKW(pB0,6)};pw1=(u32x4){PKW(pB0,8),PKW(pB0,10),PKW(pB0,12),PKW(pB0,14)};pw2=(u32x4){PKW(pB1,0),PKW(pB1,2),PKW(pB1,4),PKW(pB1,6)};pw3=(u32x4){PKW(pB1,8),PKW(pB1,10),PKW(pB1,12),PKW(pB1,14)};
    SBAR(); pv(o,vb0+sl_cur,PAF(0),PAF(1),PAF(2),PAF(3)); }
  #undef PKW
  #undef PAF
  #undef VFR
  #undef PIN
  #undef MX3
  #undef GAPA
  #undef GAPB
  #undef EX
  #undef VRD
  #undef KRD
  #undef STEP
  #undef ENDW
  {auto rr=__builtin_amdgcn_permlane32_swap(__float_as_uint(l_reg),__float_as_uint(l_reg),false,false);l_reg=__uint_as_float(rr[0])+__uint_as_float(rr[1]);}
  if(hi==0)wsf[32+r32]=l_reg;asm volatile("s_waitcnt lgkmcnt(0)":::"memory");
  float rli[16];
  #pragma unroll
  for(int r=0;r<16;++r)rli[r]=__builtin_amdgcn_rcpf(wsf[32+crow(r,hi)]);
  unsigned char*Ow=(unsigned char*)O+(rowbase+q0+wid*QBLK)*OP+h*D;
  { unsigned char*stg=(unsigned char*)(shm+LDS_OST)+wid*4096;
    #pragma unroll
    for(int r=0;r<16;++r){const int orow=crow(r,hi);
      #pragma unroll
      for(int d0=0;d0<2;++d0){const float ov=__builtin_amdgcn_fmed3f(o[d0][r]*rli[r]*32.f,-448.f,448.f); stg[orow*64+d0*32+r32]=(unsigned char)__builtin_amdgcn_cvt_pk_fp8_f32(ov,ov,0,false);}}
    asm volatile("s_waitcnt lgkmcnt(0)":::"memory");
    #pragma unroll
    for(int i=0;i<2;++i){const int row=i*16+(lane>>2),ch=lane&3; const u32x4 v=*(const u32x4*)(stg+row*64+ch*16); ATTN_STORE16(Ow+(long)row*OP+ch*16,v);} }
  asm volatile("s_waitcnt lgkmcnt(0)\n\ts_barrier":::"memory");
  #undef BLKSEL
  #undef DMA_K
  #undef DMA_V
  #undef CMASK
  #undef START
  #undef RESC
  #undef ROT
}
constexpr int ATTN_LDS_BYTES=LDS_BYTES;
struct AttnTensors { const bf16* Q; const bf16* K; const bf16* V; bf16* O; const float* kbar; };
struct AttnUnit { int bh; int qb; };
struct StaticOrder {
  int vcu, G;
  __device__ __forceinline__ explicit StaticOrder(int grid,int block):vcu((grid%8==0)?(block%8)*(grid/8)+block/8:block),G(grid){}
  __device__ __forceinline__ bool next(int i,AttnUnit&u)const{ const int pr=(vcu+(i>>2)*G)*2+((i>>1)&1); if(pr>=BATCH*NHEAD*4)return false;
    const int s=pr&3; u.bh=pr>>2; u.qb=(i&1)?7-s:s; return true; }
  __device__ __forceinline__ void a_ready(const AttnUnit&)const{}
  __device__ __forceinline__ void done(const AttnUnit&)const{}
};
template<class Sched,int THRL=8> __device__ __forceinline__ void attn_phase(char*lds,const AttnTensors&T,const Sched&S,const int tid_in){
  AttnUnit u; int tid_=tid_in; asm volatile("":"+v"(tid_));
  for(int i=0;S.next(i,u);++i){ S.a_ready(u); attn_unit<THRL>(u.bh/NHEAD,u.bh%NHEAD,u.qb,T.Q,T.K,T.V,T.O,T.kbar+(long)u.bh*512,lds,tid_); S.done(u); }
}
#undef SBAR
#undef WAIT_BAR
}

#define XB_TMO      128
#define XB_XCNT(j)  (256  + 64 * (j))
#define XB_XSUB(j)  (1280 + 64 * (j))
#define XB_XGEN(j)  (2304 + 64 * (j))
#define XB_TOP      3328
#define XB_TOPGEN   3392
#define XCD_BAR_WORDS 3456
#define XB_SPIN_CAP (1u << 18)

__device__ __forceinline__ unsigned xb_ld(unsigned* p)              { return __hip_atomic_load(p, __ATOMIC_RELAXED, __HIP_MEMORY_SCOPE_AGENT); }
__device__ __forceinline__ unsigned xb_add(unsigned* p, unsigned v) { return __hip_atomic_fetch_add(p, v, __ATOMIC_RELAXED, __HIP_MEMORY_SCOPE_AGENT); }
__device__ __forceinline__ unsigned xb_xcc_id() { return (unsigned)__builtin_amdgcn_s_getreg((3 << 11) | 20) & 0xFu; }
#define XB_SPIN(cond, bar) do { unsigned _sp = 0; while (cond) { __builtin_amdgcn_s_sleep(1); \
    if ((++_sp & 255u) == 0u) { if (xb_ld(&(bar)[XB_TMO])) break; if (_sp > XB_SPIN_CAP) { atomicAdd(&(bar)[XB_TMO], 1u); break; } } } } while (0)

struct XcdBarrier {
    unsigned* bar; unsigned x;
    volatile LAS unsigned* st;
};

__device__ __forceinline__ XcdBarrier xcd_barrier_post(unsigned* bar, volatile LAS unsigned* st) {
    XcdBarrier b; b.bar = bar; b.x = xb_xcc_id(); b.st = st;
    if (threadIdx.x == 0) (void)xb_add(&bar[XB_XCNT(b.x)], 1u);
    return b;
}
__device__ __forceinline__ void xcd_barrier_complete(unsigned* bar, unsigned x, unsigned& nloc, unsigned& nx) {
    const unsigned G = gridDim.x * gridDim.y * gridDim.z;
    unsigned sum, cnt, mine, sp = 0u;
    for (;;) {
        sum = 0u; cnt = 0u; mine = 0u;
#pragma unroll
        for (unsigned j = 0; j < 16; ++j) { const unsigned c = xb_ld(&bar[XB_XCNT(j)]); sum += c; cnt += (c > 0u) ? 1u : 0u; mine = (j == x) ? c : mine; }
        if (sum == G) break;
        __builtin_amdgcn_s_sleep(1);
        if ((++sp & 255u) == 0u) { if (xb_ld(&bar[XB_TMO])) break; if (sp > XB_SPIN_CAP) { atomicAdd(&bar[XB_TMO], 1u); break; } }
    }
    nloc = mine > 0u ? mine : 1u; nx = cnt > 0u ? cnt : 1u;
}

__device__ __forceinline__ void xcd_barrier(const XcdBarrier& b, const bool is_t0) {
    asm volatile("s_waitcnt vmcnt(0)" ::: "memory");
    __syncthreads();
    if (is_t0) {
        unsigned* bar = b.bar;
        __builtin_amdgcn_s_waitcnt(0);
        unsigned nloc = b.st[0], nx = b.st[1];
        if (nloc == 0u) { xcd_barrier_complete(bar, b.x, nloc, nx); b.st[0] = nloc; b.st[1] = nx; }
        const unsigned old = xb_add(&bar[XB_XSUB(b.x)], 1u);
        const unsigned gen = old / nloc;
        if (old + 1u == (gen + 1u) * nloc) {
            __builtin_amdgcn_fence(__ATOMIC_RELEASE, "agent");
            asm volatile("s_waitcnt vmcnt(0)" ::: "memory");
            const unsigned og = xb_add(&bar[XB_TOP], 1u);
            const unsigned tg = og / nx;
            if (og + 1u == (tg + 1u) * nx) xb_add(&bar[XB_TOPGEN], 1u);
            else XB_SPIN(xb_ld(&bar[XB_TOPGEN]) == tg, bar);
            __builtin_amdgcn_fence(__ATOMIC_ACQUIRE, "agent");
            xb_add(&bar[XB_XGEN(b.x)], 1u);
            asm volatile("s_waitcnt vmcnt(0)" ::: "memory");
        } else {
            XB_SPIN(xb_ld(&bar[XB_XGEN(b.x)]) == gen, bar);
            __builtin_amdgcn_fence(__ATOMIC_ACQUIRE, "agent");
            asm volatile("s_waitcnt vmcnt(0)" ::: "memory");
        }
    }
    __syncthreads();
}

struct Args { const float* in[17]; float* out; unsigned char* ws; int ph_lo, ph_hi; };
enum { I_X = 0, I_C, I_WMOD, I_BMOD, I_WIN, I_WPOOL, I_PSCALE, I_WOUT, I_LN1G, I_LN1B, I_WR, I_RB, I_WG, I_WU, I_WDN, I_LN2G, I_LN2B };

DEVFN int lane_id_volatile() { int l; asm volatile("v_mbcnt_lo_u32_b32 %0, -1, 0\n\tv_mbcnt_hi_u32_b32 %0, -1, %0" : "=v"(l)); return l; }
struct Ctx { unsigned char* lds; __attribute__((address_space(3))) unsigned char* lds3; int tid, lane, wave, G, bid, gw, NGW; };

DEVFN void transpose_item_f8(const float* src, int ldn, int k0, int col, unsigned char* dst, int ldk, int dst_row0, int dst_k0, float* scr, int lane) {
#pragma unroll 8
    for (int i = 0; i < 32; ++i) { const int kk = 2 * i + (lane >> 5); scr[kk * 33 + (lane & 31)] = src[(size_t)(k0 + kk) * ldn + col]; }
    LDS_WAIT();
    const int c = lane & 7;
#pragma unroll
    for (int j = 0; j < 4; ++j) { const int n = (lane >> 3) + 8 * j; const float* s = scr + (8 * c) * 33 + n;
        u32x2 o; o.x = pk4_fp8(32.f * s[0 * 33], 32.f * s[1 * 33], 32.f * s[2 * 33], 32.f * s[3 * 33]); o.y = pk4_fp8(32.f * s[4 * 33], 32.f * s[5 * 33], 32.f * s[6 * 33], 32.f * s[7 * 33]);
        *(u32x2*)(dst + (size_t)(dst_row0 + n) * ldk + dst_k0 + 8 * c) = o; }
    LDS_WAIT();
}

DEVFN void ph_prologue(const Args& a, const Ctx& c) {
    unsigned char* ws = a.ws;
    float* scr = (float*)(c.lds + c.wave * 16384);
    const int lane = c.lane;
    constexpr int N1 = 2 * 16 * 64, N2 = 2 * 8 * 32, N3 = 32 * 16 * 32, N4 = 32 * 8 * 32, N5 = 2 * 64 * 16, N6 = 256;
    for (int it = c.gw; it < N1 + N2 + N3 + N4 + N5 + N6; it += c.NGW) {
        int r = it;
        if (r < N1) {
            const int l = r / 1024, kb = (r % 1024) / 64, nb = r % 64;
            const int nphys = 32 * nb + (lane & 31);
            transpose_item_f8(a.in[I_WIN] + (size_t)l * DM * DIN, DIN, 64 * kb, inproj_nlog(nphys), (unsigned char*)(ws + WS_WIN) + (size_t)l * DIN * DM, DM, 32 * nb, 64 * kb, scr, lane);
            continue; }
        r -= N1;
        if (r < N2) {
            const int l = r / 256, kb = (r % 256) / 32, nb = r % 32;
            transpose_item_f8(a.in[I_WOUT] + (size_t)l * DM * DM, DM, 64 * kb, 32 * nb + (lane & 31), (unsigned char*)(ws + WS_WOUT) + (size_t)l * DM * DM, DM, 32 * nb, 64 * kb, scr, lane);
            continue; }
        r -= N2;
        if (r < N3) {
            const int le = r / 512, kb = (r % 512) / 32, nb = r % 32;
            const int n = 32 * nb + (lane & 31), jt = n >> 8, bj = (n >> 7) & 1, i = n & 127;
            const float* src = (bj ? a.in[I_WU] : a.in[I_WG]) + (size_t)le * DM * DE;
            transpose_item_f8(src, DE, 64 * kb, jt * 128 + i, (unsigned char*)(ws + WS_WGU) + (size_t)le * DM * DM, DM, 32 * nb, 64 * kb, scr, lane);
            continue; }
        r -= N3;
        if (r < N4) {
            const int le = r / 256, kb = (r % 256) / 32, nb = r % 32;
            transpose_item_f8(a.in[I_WDN] + (size_t)le * DE * DM, DM, 64 * kb, 32 * nb + (lane & 31), (unsigned char*)(ws + WS_WD) + (size_t)le * DM * DE, DE, 32 * nb, 64 * kb, scr, lane);
            continue; }
        r -= N4;
        if (r < N5) {
            const int l = r / 1024, kdg = (r % 1024) / 16, nb = r % 16;
            const int n = nb * 64 + lane, kd0 = kdg * 8, g = kd0 >> 7, c0 = kd0 & 127;
            const float* wo = a.in[I_WOUT] + (size_t)l * DM * DM + (size_t)(512 + g * 128) * DM + n;
            const float* ps = a.in[I_PSCALE] + l * 512 + g * 128;
            const float* wp = a.in[I_WPOOL] + ((size_t)(l * 4 + g) * 128 + c0) * 128;
            float acc[8];
#pragma unroll
            for (int j = 0; j < 8; ++j) acc[j] = 0.f;
            for (int e = 0; e < 128; ++e) { const float w = wo[(size_t)e * DM] * ps[e];
#pragma unroll
                for (int j = 0; j < 8; ++j) acc[j] += wp[j * 128 + e] * w; }
            u32x2 o; o.x = pk4_fp8(128.f * acc[0], 128.f * acc[1], 128.f * acc[2], 128.f * acc[3]); o.y = pk4_fp8(128.f * acc[4], 128.f * acc[5], 128.f * acc[6], 128.f * acc[7]);
            *(u32x2*)((unsigned char*)(ws + WS_WOUT) + (size_t)l * DM * DM + (size_t)n * DM + 512 + kd0) = o;
            continue; }
        r -= N5;
        {
            const int ent = r * 64 + lane, pos = ent >> 3, i = ent & 7;
            const float inv = (float)exp2(-(double)i / 8.0 * 18.931568569324174);
            const float ang = (float)pos * inv;
            float* t = (float*)(ws + WS_ROPE) + ent * 2;
            t[0] = (float)cos((double)ang); t[1] = (float)sin((double)ang);
        }
    }
    for (int i = c.bid * 512 + c.tid; i < 2 * NB * NH * NBLK * HD; i += c.G * 512) ((float*)(ws + WS_KBAR))[i] = 0.f;
    __syncthreads();
    if (c.bid < 192) {
        float* condT = (float*)c.lds;
        float* red = (float*)(c.lds + 65536);
        for (int idx = c.tid; idx < NB * DM; idx += 512) { const int b = idx >> 10, k = idx & 1023; const float v = a.in[I_C][idx]; condT[k * 16 + b] = v / (1.f + __expf(-v)); }
        __syncthreads();
        for (int u = c.bid; u < 192; u += c.G) {
            const int l = u / 96, n0 = (u % 96) * 64;
            const float* W = a.in[I_WMOD] + (size_t)l * DM * NMOD + n0 + lane;
            float acc[16];
#pragma unroll
            for (int b = 0; b < 16; ++b) acc[b] = 0.f;
            for (int k = 128 * c.wave; k < 128 * c.wave + 128; k += 8) {
                float wv[8];
#pragma unroll
                for (int j = 0; j < 8; ++j) wv[j] = W[(size_t)(k + j) * NMOD];
#pragma unroll
                for (int j = 0; j < 8; ++j) {
                    const f32x4* cp = (const f32x4*)(condT + (k + j) * 16);
#pragma unroll
                    for (int q = 0; q < 4; ++q) { const f32x4 cv = cp[q]; acc[4 * q + 0] += cv.x * wv[j]; acc[4 * q + 1] += cv.y * wv[j]; acc[4 * q + 2] += cv.z * wv[j]; acc[4 * q + 3] += cv.w * wv[j]; }
                }
            }
#pragma unroll
            for (int b = 0; b < 16; ++b) red[(c.wave * 16 + b) * 64 + lane] = acc[b];
            __syncthreads();
            for (int o = c.tid; o < 1024; o += 512) { const int b = o >> 6, cc = o & 63; float s = a.in[I_BMOD][l * NMOD + n0 + cc];
#pragma unroll
                for (int w = 0; w < 8; ++w) s += red[(w * 16 + b) * 64 + cc];
                ((float*)(ws + WS_MOD))[(size_t)(l * NB + b) * NMOD + n0 + cc] = s; }
            __syncthreads();
        }
    }
}

DEVFN void row_stats(const f32x4 (&v)[4], float& mean, float& rstd) {
    float s = 0.f, q = 0.f;
#pragma unroll
    for (int j = 0; j < 4; ++j) { s += (v[j].x + v[j].y) + (v[j].z + v[j].w); q += (v[j].x * v[j].x + v[j].y * v[j].y) + (v[j].z * v[j].z + v[j].w * v[j].w); }
    s = swz_xor_add(s, 1); q = swz_xor_add(q, 1); s = swz_xor_add(s, 2); q = swz_xor_add(q, 2); s = swz_xor_add(s, 4); q = swz_xor_add(q, 4);
    s = swz_xor_add(s, 8); q = swz_xor_add(q, 8); s = swz_xor_add(s, 16); q = swz_xor_add(q, 16); s = half_swap_add(s); q = half_swap_add(q);
    mean = s * (1.f / DM);
    rstd = 1.f / sqrtf(fmaxf(q * (1.f / DM) - mean * mean, 0.f) + LN_EPS);
}
DEVFN void row_load(const float* p, int lane, f32x4 (&v)[4]) {
#pragma unroll
    for (int j = 0; j < 4; ++j) v[j] = *(const f32x4*)(p + 4 * lane + 256 * j);
}
DEVFN void row_mod_store(f32x4 (&v)[4], const float* sc, const float* sh, bf16_t* out, int lane) {
    float mean, rstd; row_stats(v, mean, rstd);
#pragma unroll
    for (int j = 0; j < 4; ++j) {
        const f32x4 s = *(const f32x4*)(sc + 4 * lane + 256 * j), h = *(const f32x4*)(sh + 4 * lane + 256 * j);
        v[j] = (v[j] - mean) * rstd * (s + 1.f) + h;
        u32x2 o; o.x = pk2(v[j].x, v[j].y); o.y = pk2(v[j].z, v[j].w);
        *(u32x2*)(out + 4 * lane + 256 * j) = o;
    }
}

DEVFN void ph_pool(const Args& a, const Ctx& c) {
    const bf16_t* P = (const bf16_t*)(a.ws + WS_QKVP) + 1536; unsigned char* AD = (unsigned char*)(a.ws + WS_AD) + 512;
    for (int it = c.bid * 512 + c.tid; it < (NTOK / 8) * 64; it += c.G * 512) {
        const int cg = it & 63, m0 = (it >> 6) * 8, t0 = m0 & (SEQ - 1), g = cg >> 4, w = 2 << g;
        const bf16_t* pc = P + cg * 8;
        u32x4 rows[23];
#pragma unroll
        for (int k = 0; k < 23; ++k) { const int dt = k - 15; rows[k] = (u32x4){0u, 0u, 0u, 0u}; if (dt > -w && t0 + dt >= 0) rows[k] = *(const u32x4*)(pc + (size_t)(m0 + dt) * DIN); }
        float s[8];
#pragma unroll
        for (int j = 0; j < 8; ++j) s[j] = 0.f;
#pragma unroll
        for (int k = 0; k < 15; ++k) { const u32x4 v = rows[k]; s[0] += bf_lo(v.x); s[1] += bf_hi(v.x); s[2] += bf_lo(v.y); s[3] += bf_hi(v.y); s[4] += bf_lo(v.z); s[5] += bf_hi(v.z); s[6] += bf_lo(v.w); s[7] += bf_hi(v.w); }
#pragma unroll
        for (int r = 0; r < 8; ++r) {
            const int t = t0 + r; const u32x4 v = rows[15 + r];
            const float f[8] = {bf_lo(v.x), bf_hi(v.x), bf_lo(v.y), bf_hi(v.y), bf_lo(v.z), bf_hi(v.z), bf_lo(v.w), bf_hi(v.w)};
#pragma unroll
            for (int j = 0; j < 8; ++j) s[j] += f[j];
            const int cnt = (t + 1 < w) ? t + 1 : w; const float ic = 1.f / (float)cnt;
            u32x2 o; o.x = pk4_fp8(s[0] * ic - f[0], s[1] * ic - f[1], s[2] * ic - f[2], s[3] * ic - f[3]); o.y = pk4_fp8(s[4] * ic - f[4], s[5] * ic - f[5], s[6] * ic - f[6], s[7] * ic - f[7]);
            *(u32x2*)(AD + (size_t)(m0 + r) * DM + cg * 8) = o;
            u32x4 q = rows[r];
            if (w == 8) q = rows[r + 8]; else if (w == 4) q = rows[r + 12]; else if (w == 2) q = rows[r + 14];
            s[0] -= bf_lo(q.x); s[1] -= bf_hi(q.x); s[2] -= bf_lo(q.y); s[3] -= bf_hi(q.y); s[4] -= bf_lo(q.z); s[5] -= bf_hi(q.z); s[6] -= bf_lo(q.w); s[7] -= bf_hi(q.w);
        }
    }
}

constexpr size_t WS_X1B = WS_X1, WS_X2B = WS_X1 + 64 * MiB;
constexpr int ROWS_PER_WAVE = 16;
DEVFN void vec_load(const float* p, int lane, f32x4 (&v)[4]) {
#pragma unroll
    for (int j = 0; j < 4; ++j) v[j] = *(const f32x4*)(p + 4 * lane + 256 * j);
}
DEVFN void bfrow_load(const bf16_t* p, int lane, u32x2 (&w)[4]) {
#pragma unroll
    for (int j = 0; j < 4; ++j) w[j] = *(const u32x2*)(p + 4 * lane + 256 * j);
}
DEVFN f32x4 bf4(u32x2 w) { return (f32x4){bf_lo(w.x), bf_hi(w.x), bf_lo(w.y), bf_hi(w.y)}; }
DEVFN void bfrow_store(bf16_t* p, int lane, const f32x4 (&v)[4]) {
#pragma unroll
    for (int j = 0; j < 4; ++j) { u32x2 o; o.x = pk2(v[j].x, v[j].y); o.y = pk2(v[j].z, v[j].w); *(u32x2*)(p + 4 * lane + 256 * j) = o; }
}
DEVFN void f8row_store(unsigned char* p, int lane, const f32x4 (&v)[4]) {
#pragma unroll
    for (int j = 0; j < 4; ++j) *(unsigned*)(p + 4 * lane + 256 * j) = pk4_fp8(v[j].x, v[j].y, v[j].z, v[j].w);
}
DEVFN void ln_mod(f32x4 (&v)[4], const f32x4 (&sc)[4], const f32x4 (&sh)[4]) {
    float mean, rstd; row_stats(v, mean, rstd);
#pragma unroll
    for (int j = 0; j < 4; ++j) v[j] = (v[j] - mean) * rstd * (sc[j] + 1.f) + sh[j];
}
DEVFN void ln_aff(f32x4 (&v)[4], const f32x4 (&g)[4], const f32x4 (&b)[4]) {
    float mean, rstd; row_stats(v, mean, rstd);
#pragma unroll
    for (int j = 0; j < 4; ++j) v[j] = (v[j] - mean) * rstd * g[j] + b[j];
}

DEVFN void ph_h1_rows(const Args& a, const Ctx& c) {
    const float* mod = (const float*)(a.ws + WS_MOD); bf16_t* HB = (bf16_t*)(a.ws + WS_HB);
    for (int base = c.gw * ROWS_PER_WAVE; base < NTOK; base += c.NGW * ROWS_PER_WAVE) {
        const float* mb = mod + (size_t)(base >> 11) * NMOD;
        f32x4 sc[4], sh[4]; vec_load(mb + DM, c.lane, sc); vec_load(mb, c.lane, sh);
        f32x4 cur[4], nxt[4]; vec_load(a.in[I_X] + (size_t)base * DM, c.lane, cur);
#pragma unroll 1
        for (int i = 0; i < ROWS_PER_WAVE; ++i) {
            const int m = base + i;
            if (i + 1 < ROWS_PER_WAVE) vec_load(a.in[I_X] + (size_t)(m + 1) * DM, c.lane, nxt);
            ln_mod(cur, sc, sh); f8row_store((unsigned char*)HB + (size_t)m * DM, c.lane, cur);
#pragma unroll
            for (int j = 0; j < 4; ++j) cur[j] = nxt[j];
        }
    }
}

DEVFN f32x4 reduce16(const float (&lg)[16]) {
    float t[8], u[4];
#pragma unroll
    for (int e = 0; e < 8; ++e) { auto rr = __builtin_amdgcn_permlane32_swap(__float_as_uint(lg[e]), __float_as_uint(lg[e + 8]), false, false); t[e] = __uint_as_float(rr[0]) + __uint_as_float(rr[1]); }
#pragma unroll
    for (int k = 0; k < 4; ++k) { auto rr = __builtin_amdgcn_permlane16_swap(__float_as_uint(t[k]), __float_as_uint(t[k + 4]), false, false); u[k] = __uint_as_float(rr[0]) + __uint_as_float(rr[1]); }
#pragma unroll
    for (int k = 0; k < 4; ++k) { u[k] = swz_xor_add(u[k], 1); u[k] = swz_xor_add(u[k], 2); u[k] = swz_xor_add(u[k], 4); u[k] = swz_xor_add(u[k], 8); }
    return (f32x4){u[0], u[1], u[2], u[3]};
}

DEVFN void rowc_load(const Args& a, int l, int m, int lane, f32x4 (&x)[4], unsigned (&y)[4]) {
    if (l == 0) vec_load(a.in[I_X] + (size_t)m * DM, lane, x);
    else { u32x2 w[4]; bfrow_load((const bf16_t*)(a.ws + WS_X2B) + (size_t)m * DM, lane, w);
#pragma unroll
        for (int j = 0; j < 4; ++j) { x[j].x = __uint_as_float(w[j].x); x[j].y = __uint_as_float(w[j].y); } }
#pragma unroll
    for (int j = 0; j < 4; ++j) y[j] = *(const unsigned*)((const unsigned char*)(a.ws + WS_QKVP) + (size_t)m * DM + 4 * lane + 256 * j);
}
DEVFN void rowc_step(const Args& a, int l, int m, int lane, const f32x4 (&x)[4], const unsigned (&y)[4], const float* vg1, const float* vsc, const float* vsh, f32x4 (&v)[4]) {
    int z_ = 0; asm volatile("" : "+v"(z_));
    f32x4 g1[4]; vec_load(vg1 + z_, lane, g1);
#pragma unroll
    for (int j = 0; j < 4; ++j) { const f32x4 xv = (l == 0) ? x[j] : bf4((u32x2){__float_as_uint(x[j].x), __float_as_uint(x[j].y)}); v[j] = xv * ALPHA + g1[j] * f8x4_to_f32(y[j], 1.f / YSCALE); }
    { f32x4 lg[4], lb[4]; vec_load(a.in[I_LN1G] + l * DM + z_, lane, lg); vec_load(a.in[I_LN1B] + l * DM + z_, lane, lb); ln_aff(v, lg, lb); }
    bfrow_store((bf16_t*)(a.ws + WS_X1B) + (size_t)m * DM, lane, v);
    { f32x4 sc[4], sh[4]; vec_load(vsc + z_, lane, sc); vec_load(vsh + z_, lane, sh); ln_mod(v, sc, sh); }
    f8row_store((unsigned char*)(a.ws + WS_HB) + (size_t)m * DM, lane, v);
}

DEVFN void ph_rows_c(const Args& a, const Ctx& c, int l, bool publish) {
    const float* mod = (const float*)(a.ws + WS_MOD) + (size_t)l * NB * NMOD;
    const bf16_t* Y = (const bf16_t*)(a.ws + WS_QKVP); const bf16_t* X2B = (const bf16_t*)(a.ws + WS_X2B);
    bf16_t* X1B = (bf16_t*)(a.ws + WS_X1B); bf16_t* HB = (bf16_t*)(a.ws + WS_HB);
    float* wr = (float*)c.lds;
    float* vsc = (float*)(c.lds + 65536); float* vsh = vsc + DM; float* vg1 = vsh + DM;
    int* lcnt = (int*)(c.lds + 65536 + 12288); int* lbase = lcnt + 32;
    int* rcls = lbase + 32; float* rw1 = (float*)(rcls + 8 * 64); float* rw2 = rw1 + 8 * 64; int* rrow = (int*)(rw2 + 8 * 64); float* lgs = (float*)(rrow + 8 * 64);
    for (int i = c.tid; i < DM * NE; i += 512) wr[(i & 15) * DM + (i >> 4)] = a.in[I_WR][i];
    if (c.tid < 32) lcnt[c.tid] = 0;
    __syncthreads();
    int nr = 0;
    for (int base = c.gw * ROWS_PER_WAVE; base < NTOK; base += c.NGW * ROWS_PER_WAVE) {
        const float* mb = mod + (size_t)(base >> 11) * NMOD;
        __syncthreads();
        for (int i = c.tid; i < 3 * DM; i += 512) vsc[i] = (i < DM) ? mb[4 * DM + i] : (i < 2 * DM ? mb[3 * DM + (i - DM)] : mb[2 * DM + (i - 2 * DM)]);
        __syncthreads();
#pragma unroll 1
        for (int i = 0; i < ROWS_PER_WAVE; i += 2) {
            const int m = __builtin_amdgcn_readfirstlane(base + i);
            f32x4 va[4], vb[4];
            { f32x4 xa[4], xb[4]; unsigned ya[4], yb[4];
              rowc_load(a, l, m, c.lane, xa, ya); rowc_load(a, l, m + 1, c.lane, xb, yb);
              rowc_step(a, l, m, c.lane, xa, ya, vg1, vsc, vsh, va);
              rowc_step(a, l, m + 1, c.lane, xb, yb, vg1, vsc, vsh, vb); }
            typedef float f32x2_t __attribute__((ext_vector_type(2)));
            f32x2_t acc2[16];
#pragma unroll
            for (int e = 0; e < 16; ++e) acc2[e] = (f32x2_t){0.f, 0.f};
#pragma unroll
            for (int j = 0; j < 4; ++j) {
                const f32x2_t p0 = {va[j].x, vb[j].x}, p1 = {va[j].y, vb[j].y}, p2 = {va[j].z, vb[j].z}, p3 = {va[j].w, vb[j].w};
#pragma unroll
                for (int e = 0; e < 16; ++e) { const f32x4 w = *(const f32x4*)(wr + e * DM + 4 * c.lane + 256 * j);
                    acc2[e] = __builtin_elementwise_fma(p0, (f32x2_t){w.x, w.x}, acc2[e]); acc2[e] = __builtin_elementwise_fma(p1, (f32x2_t){w.y, w.y}, acc2[e]);
                    acc2[e] = __builtin_elementwise_fma(p2, (f32x2_t){w.z, w.z}, acc2[e]); acc2[e] = __builtin_elementwise_fma(p3, (f32x2_t){w.w, w.w}, acc2[e]);
                    if ((e & 7) == 7) __builtin_amdgcn_sched_barrier(0); } }
            float la[16], lb2[16];
#pragma unroll
            for (int e = 0; e < 16; ++e) { la[e] = acc2[e].x; lb2[e] = acc2[e].y; }
            { const f32x4 ua = reduce16(la), ub = reduce16(lb2);
              if ((c.lane & 15) == 0) { *(f32x4*)(lgs + (c.wave * 16 + i) * 16 + (c.lane >> 4) * 4) = ua; *(f32x4*)(lgs + (c.wave * 16 + i + 1) * 16 + (c.lane >> 4) * 4) = ub; } }
        }
        LDS_WAIT();
        if (c.lane < ROWS_PER_WAVE) {
            float lg16[16], rb[16];
#pragma unroll
            for (int e = 0; e < 16; ++e) rb[e] = a.in[I_RB][e];
#pragma unroll
            for (int q = 0; q < 4; ++q) { const f32x4 t = *(const f32x4*)(lgs + (c.wave * 16 + c.lane) * 16 + 4 * q); lg16[4 * q] = t.x; lg16[4 * q + 1] = t.y; lg16[4 * q + 2] = t.z; lg16[4 * q + 3] = t.w; }
            float mx = lg16[0];
#pragma unroll
            for (int e = 1; e < 16; ++e) mx = fmaxf(mx, lg16[e]);
            float sum = 0.f, scr[16];
#pragma unroll
            for (int e = 0; e < 16; ++e) { scr[e] = __expf(lg16[e] - mx); sum += scr[e]; }
            const float isum = 1.f / sum;
#pragma unroll
            for (int e = 0; e < 16; ++e) scr[e] *= isum;
            float bestg = -3.4e38f; int gb = 0, bi1 = 0, bi2 = 1; float bw1 = 0.f, bw2 = 0.f;
#pragma unroll
            for (int g = 0; g < 4; ++g) {
                float m1 = scr[4 * g] + rb[4 * g], s1 = scr[4 * g]; int i1 = 0;
#pragma unroll
                for (int q = 1; q < 4; ++q) { const float sv = scr[4 * g + q] + rb[4 * g + q]; const bool ok = sv > m1; m1 = ok ? sv : m1; s1 = ok ? scr[4 * g + q] : s1; i1 = ok ? q : i1; }
                float m2 = -3.4e38f, s2 = 0.f; int i2 = 0;
#pragma unroll
                for (int q = 0; q < 4; ++q) { const float sv = scr[4 * g + q] + rb[4 * g + q]; const bool ok = (q != i1) && sv > m2; m2 = ok ? sv : m2; s2 = ok ? scr[4 * g + q] : s2; i2 = ok ? q : i2; }
                const float gs = m1 + m2; const bool better = gs > bestg;
                bestg = better ? gs : bestg; gb = better ? g : gb; bi1 = better ? i1 : bi1; bi2 = better ? i2 : bi2; bw1 = better ? s1 : bw1; bw2 = better ? s2 : bw2;
            }
            const float inv = 1.f / (bw1 + bw2);
            const int lo = bi1 < bi2 ? bi1 : bi2, hi2 = bi1 < bi2 ? bi2 : bi1;
            const float wlo = (bi1 < bi2 ? bw1 : bw2) * inv, whi = (bi1 < bi2 ? bw2 : bw1) * inv;
            const int pidx = lo == 0 ? hi2 - 1 : (lo == 1 ? hi2 + 1 : 5);
            const int slot = c.wave * 64 + nr + c.lane;
            rcls[slot] = gb * 6 + pidx; rw1[slot] = wlo; rw2[slot] = whi; rrow[slot] = base + c.lane;
        }
        nr += ROWS_PER_WAVE;
        LDS_WAIT();
    }
    LDS_WAIT();
    if (!publish) return;
    int rank = 0, cls = 0;
    if (c.lane < nr) { cls = rcls[c.wave * 64 + c.lane]; rank = atomicAdd(&lcnt[cls], 1); }
    __syncthreads();
    if (c.tid < NCLS) lbase[c.tid] = (int)__hip_atomic_fetch_add((unsigned*)(a.ws + WS_CTL) + CW_CNT + l * 32 + c.tid, (unsigned)lcnt[c.tid], RLX_AGENT);
    __syncthreads();
    if (c.lane < nr) {
        const int pos = lbase[cls] + rank;
        ((int*)(a.ws + WS_LIST))[(size_t)cls * LISTCAP + pos] = rrow[c.wave * 64 + c.lane];
        float* rw = (float*)(a.ws + WS_RW) + ((size_t)cls * LISTCAP + pos) * 2;
        rw[0] = rw1[c.wave * 64 + c.lane]; rw[1] = rw2[c.wave * 64 + c.lane];
    }
}

DEVFN void ph_rows_g(const Args& a, const Ctx& c, int l) {
    const float* mod = (const float*)(a.ws + WS_MOD) + (size_t)l * NB * NMOD;
    const bf16_t* X1B = (const bf16_t*)(a.ws + WS_X1B); const unsigned char* Y2 = (const unsigned char*)(a.ws + WS_AD);
    bf16_t* X2B = (bf16_t*)(a.ws + WS_X2B); bf16_t* HB = (bf16_t*)(a.ws + WS_HB);
    for (int base = c.gw * ROWS_PER_WAVE; base < NTOK; base += c.NGW * ROWS_PER_WAVE) {
        const float* mb = mod + (size_t)(base >> 11) * NMOD; const float* mb1 = mb + (size_t)NB * NMOD;
        f32x4 g2[4], lg[4], lb[4], sc[4], sh[4];
        vec_load(mb + 5 * DM, c.lane, g2); vec_load(a.in[I_LN2G] + l * DM, c.lane, lg); vec_load(a.in[I_LN2B] + l * DM, c.lane, lb);
        if (l == 0) { vec_load(mb1 + DM, c.lane, sc); vec_load(mb1, c.lane, sh); }
        u32x2 xc[4], xn[4]; unsigned yc[4], yn[4];
        bfrow_load(X1B + (size_t)base * DM, c.lane, xc);
#pragma unroll
        for (int j = 0; j < 4; ++j) yc[j] = *(const unsigned*)(Y2 + (size_t)base * DM + 4 * c.lane + 256 * j);
#pragma unroll 1
        for (int i = 0; i < ROWS_PER_WAVE; ++i) {
            const int m = base + i;
            if (i + 1 < ROWS_PER_WAVE) { bfrow_load(X1B + (size_t)(m + 1) * DM, c.lane, xn);
#pragma unroll
                for (int j = 0; j < 4; ++j) yn[j] = *(const unsigned*)(Y2 + (size_t)(m + 1) * DM + 4 * c.lane + 256 * j); }
            f32x4 v[4];
#pragma unroll
            for (int j = 0; j < 4; ++j) v[j] = bf4(xc[j]) * ALPHA + g2[j] * f8x4_to_f32(yc[j], 1.f / YSCALE);
            ln_aff(v, lg, lb);
            if (l == 0) { bfrow_store(X2B + (size_t)m * DM, c.lane, v); ln_mod(v, sc, sh); f8row_store((unsigned char*)HB + (size_t)m * DM, c.lane, v); }
            else {
#pragma unroll
                for (int j = 0; j < 4; ++j) *(f32x4*)(a.out + (size_t)m * DM + 4 * c.lane + 256 * j) = v[j]; }
#pragma unroll
            for (int j = 0; j < 4; ++j) { xc[j] = xn[j]; yc[j] = yn[j]; }
        }
    }
}

constexpr int MOETAB_OFF = 131072 + 512;
DEVFN void ph_inproj_fast(const Args& a, const Ctx& c, int l, bool dummy_kbar) {
    pg8::DenseSched S; S.so.init(NTOK, DIN, c.G, c.bid); S.A = (const char*)(a.ws + WS_HB); S.Bt = (const char*)(a.ws + WS_WIN) + (size_t)l * DIN * DM; S.lda = DM; S.ldb = DM;
    const pg8::EpiInproj E{(bf16_t*)(a.ws + WS_QKVP), (const float*)(a.ws + WS_ROPE), (dummy_kbar ? (float*)(a.ws + WS_RW) : (float*)(a.ws + WS_KBAR)) + (size_t)l * NB * NH * NBLK * HD};
    pg8::gemm_phase2<pg8::EpiInproj, pg8::DenseSched, true, true, false, true, 127 - 5, 127>(c.lds3, DM, DM, S, E, c.tid);
}
DEVFN void ph_wout_fast(const Args& a, const Ctx& c, int l) {
    pg8::DenseSched S; S.so.init(NTOK, DM, c.G, c.bid); S.A = (const char*)(a.ws + WS_AD); S.Bt = (const char*)(a.ws + WS_WOUT) + (size_t)l * DM * DM; S.lda = DM; S.ldb = DM;
    const pg8::EpiF8 E{(unsigned char*)(a.ws + WS_QKVP), DM};
    pg8::gemm_phase2<pg8::EpiF8, pg8::DenseSched, true, true, false, true, 127 - 5, 127 - 5, true, 127 - 7, 127>(c.lds3, DM, DM, S, E, c.tid);
}
DEVFN void moe_table_lds(const Args& a, const Ctx& c, int l) {
    int* cnt = (int*)(c.lds + MOETAB_OFF); int* tp = cnt + 32;
    if (c.tid < NCLS) cnt[c.tid] = (int)__hip_atomic_load((unsigned*)(a.ws + WS_CTL) + CW_CNT + l * 32 + c.tid, RLX_AGENT);
    __syncthreads();
    if (c.tid == 0) { int s = 0; for (int k = 0; k < NCLS; ++k) { tp[k] = s; s += (cnt[k] + 255) >> 8; } tp[NCLS] = s; }
    __syncthreads();
}
DEVFN void ph_gateup_fast(const Args& a, const Ctx& c, int l) {
    moe_table_lds(a, c, l);
    pg8::GateUpSched S; S.cnt = (const LAS int*)(c.lds3 + MOETAB_OFF); S.tp = S.cnt + 32; S.npn_shift = 3; S.nunits = S.tp[NCLS] * 8; S.G = c.G; S.c = c.bid;
    S.HB = (const char*)(a.ws + WS_HB); S.list = (const int*)(a.ws + WS_LIST); S.W = (const char*)(a.ws + WS_WGU) + (size_t)l * NE * DM * DM;
    const pg8::EpiGateUp E{(unsigned char*)(a.ws + WS_QKVP), (const float*)(a.ws + WS_RW)};
    pg8::gemm_phase2<pg8::EpiGateUp, pg8::GateUpSched, true, true, false, true, 127 - 5, 127>(c.lds3, DM, DM, S, E, c.tid);
}
DEVFN void ph_down_fast(const Args& a, const Ctx& c, int l) {
    moe_table_lds(a, c, l);
    pg8::DownSched S; S.cnt = (const LAS int*)(c.lds3 + MOETAB_OFF); S.tp = S.cnt + 32; S.npn_shift = 2; S.nunits = S.tp[NCLS] * 4; S.G = c.G; S.c = c.bid;
    S.ACT = (const char*)(a.ws + WS_QKVP); S.W = (const char*)(a.ws + WS_WD) + (size_t)l * NE * DM * DE;
    const pg8::EpiDown E{(unsigned char*)(a.ws + WS_AD), (const int*)(a.ws + WS_LIST)};
    pg8::gemm_phase2<pg8::EpiDown, pg8::DownSched, true, true, true, true, 127 - 5, 127 - 3>(c.lds3, DM, DE, S, E, c.tid);
}

#ifndef MK_N_LAUNCHES
#define MK_N_LAUNCHES 1
#endif
constexpr int RING_BYTES = 131072, LDSCTL_OFF = RING_BYTES, MISC_OFF = LDSCTL_OFF + 320, LDS_BYTES = 147456;
constexpr int PH_PER_LAYER = 7, NPHASE = 2 + 2 * PH_PER_LAYER;
constexpr int CW_BAR = 4096;
static_assert((CW_BAR + XCD_BAR_WORDS) * 4 <= (int)CTL_ZERO_BYTES, "CTL");

__global__ void __launch_bounds__(512, 2) fwd(Args a) {
    extern __shared__ __attribute__((aligned(16))) unsigned char lds[];
    const int wave_s = __builtin_amdgcn_readfirstlane(threadIdx.x >> 6);
#define MKTID() (wave_s * 64 + lane_id_volatile())
#define MKCTX() Args al = a; { size_t z_ = 0; asm volatile("" : "+s"(z_)); al.ws = a.ws + z_; } Ctx c; {     int t_ = MKTID(); asm volatile("" : "+v"(t_)); c.lds = lds; c.lds3 = (LAS unsigned char*)lds; c.tid = t_; c.lane = t_ & 63; c.wave = __builtin_amdgcn_readfirstlane(t_ >> 6); c.G = gridDim.x; c.bid = blockIdx.x; c.gw = c.bid * 8 + c.wave; c.NGW = c.G * 8; }
    const int lo = a.ph_lo, hi = a.ph_hi;
    const bool one = (hi - lo) > 1;
    for (int u = threadIdx.x; u < (LDS_BYTES - LDSCTL_OFF) / 4; u += 512) ((LAS unsigned*)((LAS unsigned char*)lds + LDSCTL_OFF))[u] = 0u;
    __syncthreads();
    XcdBarrier bar; bar.bar = (unsigned*)(a.ws + WS_CTL) + CW_BAR; bar.x = 0; bar.st = nullptr;
    if (one) bar = xcd_barrier_post((unsigned*)(a.ws + WS_CTL) + CW_BAR, (volatile LAS unsigned*)((LAS unsigned char*)lds + MISC_OFF) + 8);
#ifndef REP_PHASE
#define REP_PHASE -1
#endif
#define IN(k) (lo <= (k) && (k) < hi)
#define SEAM(k) do { if (IN(k) && IN((k) + 1)) { XcdBarrier bl_ = bar; { size_t z_ = 0; unsigned x_ = bar.x; asm volatile("" : "+s"(z_), "+s"(x_)); bl_.bar = bar.bar + z_; bl_.x = x_; } xcd_barrier(bl_, MKTID() == 0); } } while (0)
    if (IN(0)) { MKCTX(); ph_prologue(al, c); if (REP_PHASE == 0) { __syncthreads(); ph_prologue(al, c); } SEAM(0); }
    if (IN(1)) { MKCTX(); ph_h1_rows(al, c); if (REP_PHASE == 1) ph_h1_rows(al, c); SEAM(1); }
    {
        constexpr int l = 0; constexpr int p0 = 2 + l * PH_PER_LAYER;
        if (IN(p0 + 0)) { MKCTX(); ph_inproj_fast(al, c, l, false); if (REP_PHASE == 10) { __syncthreads(); ph_inproj_fast(al, c, l, true); } SEAM(p0 + 0); }
        if (IN(p0 + 1)) {
            { MKCTX(); ph_pool(al, c); }
            __syncthreads();
            const attn_body::AttnTensors AT{(const attn_body::bf16*)(a.ws + WS_QKVP), (const attn_body::bf16*)(a.ws + WS_QKVP) + 512, (const attn_body::bf16*)(a.ws + WS_QKVP) + 1024,
                                            (attn_body::bf16*)(a.ws + WS_AD), (const float*)(a.ws + WS_KBAR) + (size_t)l * NB * NH * NBLK * HD};
            const attn_body::StaticOrder S((int)gridDim.x, (int)blockIdx.x);
            attn_body::attn_phase<attn_body::StaticOrder>((char*)lds, AT, S, MKTID());
            if (REP_PHASE == 11) attn_body::attn_phase<attn_body::StaticOrder>((char*)lds, AT, S, MKTID());
            if (REP_PHASE == 17) { __syncthreads(); MKCTX(); ph_pool(al, c); }
            SEAM(p0 + 1);
        }
        if (IN(p0 + 2)) { MKCTX(); ph_wout_fast(al, c, l); if (REP_PHASE == 12) { __syncthreads(); ph_wout_fast(al, c, l); } SEAM(p0 + 2); }
        if (IN(p0 + 3)) { MKCTX(); if (REP_PHASE == 13) { ph_rows_c(al, c, l, false); __syncthreads(); } ph_rows_c(al, c, l, true); SEAM(p0 + 3); }
        if (IN(p0 + 4)) { MKCTX(); ph_gateup_fast(al, c, l); if (REP_PHASE == 14) { __syncthreads(); ph_gateup_fast(al, c, l); } SEAM(p0 + 4); }
        if (IN(p0 + 5)) { MKCTX(); ph_down_fast(al, c, l); if (REP_PHASE == 15) { __syncthreads(); ph_down_fast(al, c, l); } SEAM(p0 + 5); }
        if (IN(p0 + 6)) { MKCTX(); ph_rows_g(al, c, l); if (REP_PHASE == 16) ph_rows_g(al, c, l); SEAM(p0 + 6); }
    }
    {
        constexpr int l = 1; constexpr int p0 = 2 + l * PH_PER_LAYER;
        if (IN(p0 + 0)) { MKCTX(); ph_inproj_fast(al, c, l, false); if (REP_PHASE == 10) { __syncthreads(); ph_inproj_fast(al, c, l, true); } SEAM(p0 + 0); }
        if (IN(p0 + 1)) {
            { MKCTX(); ph_pool(al, c); }
            __syncthreads();
            const attn_body::AttnTensors AT{(const attn_body::bf16*)(a.ws + WS_QKVP), (const attn_body::bf16*)(a.ws + WS_QKVP) + 512, (const attn_body::bf16*)(a.ws + WS_QKVP) + 1024,
                                            (attn_body::bf16*)(a.ws + WS_AD), (const float*)(a.ws + WS_KBAR) + (size_t)l * NB * NH * NBLK * HD};
            const attn_body::StaticOrder S((int)gridDim.x, (int)blockIdx.x);
            attn_body::attn_phase<attn_body::StaticOrder>((char*)lds, AT, S, MKTID());
            if (REP_PHASE == 11) attn_body::attn_phase<attn_body::StaticOrder>((char*)lds, AT, S, MKTID());
            if (REP_PHASE == 17) { __syncthreads(); MKCTX(); ph_pool(al, c); }
            SEAM(p0 + 1);
        }
        if (IN(p0 + 2)) { MKCTX(); ph_wout_fast(al, c, l); if (REP_PHASE == 12) { __syncthreads(); ph_wout_fast(al, c, l); } SEAM(p0 + 2); }
        if (IN(p0 + 3)) { MKCTX(); if (REP_PHASE == 13) { ph_rows_c(al, c, l, false); __syncthreads(); } ph_rows_c(al, c, l, true); SEAM(p0 + 3); }
        if (IN(p0 + 4)) { MKCTX(); ph_gateup_fast(al, c, l); if (REP_PHASE == 14) { __syncthreads(); ph_gateup_fast(al, c, l); } SEAM(p0 + 4); }
        if (IN(p0 + 5)) { MKCTX(); ph_down_fast(al, c, l); if (REP_PHASE == 15) { __syncthreads(); ph_down_fast(al, c, l); } SEAM(p0 + 5); }
        if (IN(p0 + 6)) { MKCTX(); ph_rows_g(al, c, l); if (REP_PHASE == 16) ph_rows_g(al, c, l); SEAM(p0 + 6); }
    }
#undef IN
#undef SEAM
}

extern "C" void kernel_launch(void* const* d_in, const int* in_sizes, int n_in, void* d_out, int out_size, void* d_ws, size_t ws_size, hipStream_t stream) {
    static int grid = 0;
    if (grid == 0) {
        if (n_in != 17 || out_size != NTOK * DM || ws_size < WS_END) { fprintf(stderr, "kernel_launch: unexpected problem (n_in %d out %d ws %zu)\n", n_in, out_size, ws_size); grid = -1; return; }
        if (hipFuncSetAttribute((const void*)fwd, hipFuncAttributeMaxDynamicSharedMemorySize, LDS_BYTES) != hipSuccess) { fprintf(stderr, "kernel_launch: hipFuncSetAttribute failed\n"); grid = -1; return; }
        int dev = 0, cus = 0, per_cu = 0;
        (void)hipGetDevice(&dev); (void)hipDeviceGetAttribute(&cus, hipDeviceAttributeMultiprocessorCount, dev);
        if (hipOccupancyMaxActiveBlocksPerMultiprocessor(&per_cu, (const void*)fwd, 512, LDS_BYTES) != hipSuccess || per_cu < 1) fprintf(stderr, "kernel_launch: occupancy query reports %d workgroups per CU\n", per_cu);
        (void)hipGetLastError();
        grid = cus > 0 ? cus : 256;
    }
    if (grid < 0) return;
    (void)hipMemsetAsync((char*)d_ws + WS_CTL, 0, CTL_ZERO_BYTES, stream);
    Args a{};
    for (int i = 0; i < 17; ++i) a.in[i] = (const float*)d_in[i];
    a.out = (float*)d_out; a.ws = (unsigned char*)d_ws;
#if MK_N_LAUNCHES == 1
    a.ph_lo = 0; a.ph_hi = NPHASE; hipLaunchKernelGGL(fwd, dim3(grid), dim3(512), LDS_BYTES, stream, a);
#else
    for (int p = 0; p < NPHASE; ++p) { a.ph_lo = p; a.ph_hi = p + 1; hipLaunchKernelGGL(fwd, dim3(grid), dim3(512), LDS_BYTES, stream, a); }
#endif
}
```

```cpp
#include <hip/hip_runtime.h>
#include <cstdint>
#include <cstdio>

constexpr int NB = 16, SEQ = 2048, DM = 1024, NTOK = NB * SEQ, DIN = 2048, NH = 8, HD = 64, NBLK = 8, MBLK = 256;
constexpr int NE = 16, NCLS = 24, DE = 512, NMOD = 6 * DM;
constexpr float ALPHA = 1.41421356237309515f, LN_EPS = 1e-5f;
constexpr float QSCALE = 0.125f * 1.4426950408889634f;
constexpr int LISTCAP = NTOK;

constexpr size_t MiB = 1u << 20;
constexpr size_t WS_CTL = 0, CTL_ZERO_BYTES = 1 * MiB;
constexpr size_t WS_MOD = 1 * MiB;
constexpr size_t WS_ROPE = 2 * MiB;
constexpr size_t WS_KBAR = 2 * MiB + 256 * 1024;
constexpr size_t WS_LIST = 3 * MiB;
constexpr size_t WS_RW = 6 * MiB;
constexpr size_t WS_WIN = 12 * MiB;
constexpr size_t WS_WOUT = 20 * MiB;
constexpr size_t WS_WGU = 24 * MiB;
constexpr size_t WS_WD = 88 * MiB;
constexpr size_t WS_HB = 120 * MiB;
constexpr size_t WS_QKVP = 184 * MiB;
constexpr size_t WS_AD = 312 * MiB;
constexpr size_t WS_X1 = 376 * MiB;
constexpr size_t WS_END = 504 * MiB;
constexpr int CW_TMO = 0, CW_CNT = 64;

typedef unsigned short bf16_t;
typedef short bf16x8 __attribute__((ext_vector_type(8)));
typedef float f32x4 __attribute__((ext_vector_type(4)));
typedef float f32x16 __attribute__((ext_vector_type(16)));
typedef unsigned u32x4 __attribute__((ext_vector_type(4)));
typedef unsigned u32x2 __attribute__((ext_vector_type(2)));

#define DEVFN __device__ __forceinline__
#define LDS_WAIT() asm volatile("s_waitcnt lgkmcnt(0)" ::: "memory")
#define RLX_AGENT __ATOMIC_RELAXED, __HIP_MEMORY_SCOPE_AGENT

DEVFN float bf_lo(unsigned w) { return __uint_as_float(w << 16); }
DEVFN float bf_hi(unsigned w) { return __uint_as_float(w & 0xffff0000u); }
DEVFN float bf2f(bf16_t v) { return __uint_as_float((unsigned)v << 16); }
DEVFN unsigned f2bf(float f) { unsigned u = __float_as_uint(f); return (u + 0x7fffu + ((u >> 16) & 1u)) >> 16; }
DEVFN unsigned pk2(float lo, float hi) { unsigned r; asm("v_cvt_pk_bf16_f32 %0, %1, %2" : "=v"(r) : "v"(lo), "v"(hi)); return r; }
DEVFN unsigned pk4_fp8(float a, float b, float c, float d) {
    a = __builtin_amdgcn_fmed3f(a, -448.f, 448.f); b = __builtin_amdgcn_fmed3f(b, -448.f, 448.f); c = __builtin_amdgcn_fmed3f(c, -448.f, 448.f); d = __builtin_amdgcn_fmed3f(d, -448.f, 448.f);
    unsigned w = 0u; w = __builtin_amdgcn_cvt_pk_fp8_f32(a, b, w, false); w = __builtin_amdgcn_cvt_pk_fp8_f32(c, d, w, true); return w; }
DEVFN f32x4 f8x4_to_f32(unsigned w, float sc) { const auto lo = __builtin_amdgcn_cvt_pk_f32_fp8(w, false), hi = __builtin_amdgcn_cvt_pk_f32_fp8(w, true); return (f32x4){lo[0] * sc, lo[1] * sc, hi[0] * sc, hi[1] * sc}; }
constexpr float YSCALE = 16.f;
DEVFN int crow(int r, int hi) { return (r & 3) + 8 * (r >> 2) + 4 * hi; }
#define SWZ_XOR(m) (0x1f | ((m) << 10))
DEVFN float swz_xor_add(float v, const int m) {
    switch (m) {
        case 1: return v + __int_as_float(__builtin_amdgcn_ds_swizzle(__float_as_int(v), SWZ_XOR(1)));
        case 2: return v + __int_as_float(__builtin_amdgcn_ds_swizzle(__float_as_int(v), SWZ_XOR(2)));
        case 4: return v + __int_as_float(__builtin_amdgcn_ds_swizzle(__float_as_int(v), SWZ_XOR(4)));
        case 8: return v + __int_as_float(__builtin_amdgcn_ds_swizzle(__float_as_int(v), SWZ_XOR(8)));
        default: return v + __int_as_float(__builtin_amdgcn_ds_swizzle(__float_as_int(v), SWZ_XOR(16)));
    }
}
DEVFN float half_swap_add(float v) { auto rr = __builtin_amdgcn_permlane32_swap(__float_as_uint(v), __float_as_uint(v), false, false); return __uint_as_float(rr[0]) + __uint_as_float(rr[1]); }
DEVFN float wave_sum(float v) {
    v = swz_xor_add(v, 1); v = swz_xor_add(v, 2); v = swz_xor_add(v, 4); v = swz_xor_add(v, 8); v = swz_xor_add(v, 16);
    return half_swap_add(v);
}
__host__ __device__ __forceinline__ int inproj_lgroup(int P) { return P < 16 ? (P >> 2) * 8 + (P & 3) * 2 : ((P - 16) >> 2) * 8 + ((P - 16) & 3) * 2 + 1; }
__host__ __device__ __forceinline__ int inproj_nlog(int n) { return (n & ~255) + inproj_lgroup((n & 255) >> 3) * 8 + (n & 7); }

#define GAS __attribute__((address_space(1)))
#define LAS __attribute__((address_space(3)))
typedef GAS unsigned gu32;
namespace pg8 {
#define PG8_LAS __attribute__((address_space(3)))
typedef unsigned short bf16_t;
typedef short bf16x8 __attribute__((ext_vector_type(8)));
typedef float f32x4 __attribute__((ext_vector_type(4)));
typedef unsigned u32x4 __attribute__((ext_vector_type(4)));
constexpr int BM = 256, BK = 64, HALF = 128, HTB = HALF * BK * 2  , STAGE_BYTES = 8 * HTB, NXCD = 8, WGM = 8;

__host__ __device__ __forceinline__ int lds_byte(int r, int c) { const int st = (r >> 4) * 2 + (c >> 5), rr = r & 15, cc = c & 31, ob = rr * 64 + cc * 2; return st * 1024 + (ob ^ (((ob >> 9) & 1) << 5)); }
__host__ __device__ __forceinline__ void stage_rc(int b, int& R, int& C) { const int st = b / 1024, sb = b % 1024, swz = sb ^ (((sb >> 9) & 1) << 5); R = (st >> 1) * 16 + swz / 64; C = (st & 1) * 32 + (swz % 64) / 2; }
__host__ __device__ __forceinline__ int perm32(int rho) { const int n = rho >> 4, i = rho & 15; return 8 * (i >> 2) + 4 * n + (i & 3); }

struct Unit { int pm, pn; };
struct Gemm { const bf16_t* A; const bf16_t* Bt; int M, N, K; };

struct StaticOrder {
    int nM, nN, nwg, G, c;
    __host__ __device__ void init(int M, int N, int G_, int c_) { nM = M / BM; nN = N / BM; nwg = nM * nN; G = G_; c = c_; }
    __host__ __device__ bool next(int i, Unit& u) const {
        const long L = (long)i * G + c; if (L >= nwg) return false;
        int wgid = (int)L; { const int q = nwg / NXCD, r = nwg % NXCD, xcd = wgid % NXCD, off = wgid / NXCD; wgid = (xcd < r ? xcd * (q + 1) : r * (q + 1) + (xcd - r) * q) + off; }
        const int nig = WGM * nN, gid = wgid / nig, fm = gid * WGM, gsz = (nM - fm) < WGM ? (nM - fm) : WGM;
        u.pm = fm + ((wgid % nig) % gsz); u.pn = (wgid % nig) / gsz; return true;
    }
    __device__ __forceinline__ void a_ready(const Unit&) const {}
    __device__ __forceinline__ void done(const Unit&) const {}
};

__device__ __forceinline__ unsigned cvt_pk_bf16(float lo, float hi) { unsigned r; asm volatile("v_cvt_pk_bf16_f32 %0, %1, %2" : "=v"(r) : "v"(lo), "v"(hi)); return r; }
}
namespace pg8 {
typedef int v8i_t __attribute__((ext_vector_type(8))); typedef int v4i_t __attribute__((ext_vector_type(4)));
template <class Epi, class Sched, bool ALIGN_EPI, bool GATHER, bool KSPLIT, bool FP8 = false, int SCW = 127, int SCA = 127, bool SC2 = false, int SCW2 = 127, int SCA2 = 127>
__device__ __forceinline__ void gemm_phase2(PG8_LAS unsigned char* lds, const int Kbytes, const int ldb_bytes, const Sched& S, const Epi& E, const int tid) {
    typedef typename Sched::UnitT UnitT;
    const int wid = __builtin_amdgcn_readfirstlane(tid >> 6), lane = tid & 63, wr = wid >> 2, wc = wid & 3, fr = lane & 15, fq = lane >> 4;
    int nt = Kbytes / (BK * 2); asm volatile("" : "+s"(nt));
    const int nth = nt / 2;
    unsigned voffB[2];
#pragma unroll
    for (int i = 0; i < 2; ++i) { int R[2], C[2]; stage_rc(tid * 16 + i * 8192, R[i], C[i]); const int Rb = Epi::PERM ? ((R[i] & ~31) + perm32(R[i] & 31)) : R[i]; voffB[i] = (unsigned)(Rb * ldb_bytes + C[i] * 2); }
    const size_t kstep = (size_t)(BK * 2);
    const size_t hstepB = (size_t)HALF * ldb_bytes;
    const unsigned ldsw = (unsigned)wid * 1024u;
    const int aoff = lds_byte(wr * 64 + fr, fq * 8), boff = lds_byte(wc * 32 + fr, fq * 8);
#define PG8_SA(b, h) (((b) * 2 + (h)) * HTB)
#define PG8_SB(b, h) ((4 + (b) * 2 + (h)) * HTB)
#define PG8_STAGE(bufoff, gbase, voff) do { _Pragma("unroll") for (int _i = 0; _i < 2; ++_i) \
        __builtin_amdgcn_global_load_lds((const unsigned*)((const char*)(gbase) + (voff)[_i]), (PG8_LAS unsigned*)(lds + (bufoff) + ldsw + _i * 8192), 16, 0, 0); } while (0)
#define PG8_LDA(dst, b, h) do { _Pragma("unroll") for (int m = 0; m < 4; ++m) _Pragma("unroll") for (int k = 0; k < 2; ++k) dst[m][k] = *(const PG8_LAS bf16x8*)(lds + PG8_SA(b, h) + aoff + m * 2048 + k * 1024); } while (0)
#define PG8_LDB(dst, b, h) do { _Pragma("unroll") for (int n = 0; n < 2; ++n) _Pragma("unroll") for (int k = 0; k < 2; ++k) dst[n][k] = *(const PG8_LAS bf16x8*)(lds + PG8_SB(b, h) + boff + n * 2048 + k * 1024); } while (0)
#define PG8_CAT8(x) __builtin_shufflevector(__builtin_bit_cast(v4i_t, (x)[0]), __builtin_bit_cast(v4i_t, (x)[1]), 0, 1, 2, 3, 4, 5, 6, 7)
#define PG8_MMA(ai, bj, At, Bt) do { __builtin_amdgcn_s_setprio(1); \
        if constexpr (FP8) { _Pragma("unroll") for (int m = 0; m < 4; ++m) _Pragma("unroll") for (int n = 0; n < 2; ++n) \
            acc[ai][bj][m][n] = __builtin_amdgcn_mfma_scale_f32_16x16x128_f8f6f4(PG8_CAT8(Bt[n]), PG8_CAT8(At[m]), acc[ai][bj][m][n], 0, 0, 0, scw_, 0, sca_); } \
        else { _Pragma("unroll") for (int m = 0; m < 4; ++m) _Pragma("unroll") for (int n = 0; n < 2; ++n) _Pragma("unroll") for (int k = 0; k < 2; ++k) \
            acc[ai][bj][m][n] = __builtin_amdgcn_mfma_f32_16x16x32_bf16(Bt[n][k], At[m][k], acc[ai][bj][m][n], 0, 0, 0); } \
        __builtin_amdgcn_s_setprio(0); } while (0)
#define PG8_WAIT_V(n) asm volatile("s_waitcnt vmcnt(" #n ")" ::: "memory")
#define PG8_WAIT_L(n) asm volatile("s_waitcnt lgkmcnt(" #n ")" ::: "memory")
#define PG8_BAR __builtin_amdgcn_s_barrier()
#define PG8_SCHED __builtin_amdgcn_sched_barrier(0)
#define PG8_BK(cb, cb2, kt) ((KSPLIT && (kt) >= nth) ? (cb2) + (size_t)((kt) - nth) * kstep : (cb) + (size_t)(kt) * kstep)
    UnitT cur, nxt; int ui = 0;
    if (!S.next(0, cur)) return;
    f32x4 acc[2][2][4][2];
#pragma unroll
    for (int a = 0; a < 2; ++a)
#pragma unroll
        for (int b = 0; b < 2; ++b)
#pragma unroll
            for (int m = 0; m < 4; ++m)
#pragma unroll
                for (int n = 0; n < 2; ++n) acc[a][b][m][n] = (f32x4){0.f, 0.f, 0.f, 0.f};
    bf16x8 At[4][2], B0[2][2], B1[2][2];
    unsigned vA[2][2], vAn[2][2];
    S.arows(cur, tid, vA);
#pragma unroll
    for (int h = 0; h < 2; ++h)
#pragma unroll
        for (int i = 0; i < 2; ++i) vAn[h][i] = vA[h][i];
    const char* cA = S.aptr(cur); const char* cB = S.bptr(cur); const char* cB2 = KSPLIT ? S.bptr2(cur) : cB;
    PG8_STAGE(PG8_SB(0, 0), cB, voffB); PG8_STAGE(PG8_SB(0, 1), cB + hstepB, voffB); PG8_STAGE(PG8_SA(0, 0), cA, vA[0]); PG8_STAGE(PG8_SA(0, 1), cA, vA[1]);
    if (wr == 1) PG8_BAR;
    PG8_WAIT_V(2); PG8_BAR;
    PG8_STAGE(PG8_SB(1, 0), PG8_BK(cB, cB2, 1), voffB); PG8_STAGE(PG8_SA(1, 0), cA + kstep, vA[0]); PG8_STAGE(PG8_SB(1, 1), PG8_BK(cB, cB2, 1) + hstepB, voffB);
    PG8_WAIT_V(6); PG8_BAR;
    for (;;) {
        const bool has_next = S.next(ui + 1, nxt);
        const char* nA = has_next ? S.aptr(nxt) : cA; const char* nB = has_next ? S.bptr(nxt) : cB; const char* nB2 = (KSPLIT && has_next) ? S.bptr2(nxt) : cB2;
        if (GATHER && has_next) S.arows(nxt, tid, vAn);
        for (int t = 0; t < nt; t += 2) {
            const bool last = (t == nt - 2);
            const int scw_ = ((SC2 && t >= nth) ? SCW2 : SCW) * 0x01010101, sca_ = ((SC2 && t >= nth) ? SCA2 : SCA) * 0x01010101; (void)scw_; (void)sca_;
            const char* a1 = cA + (size_t)(t + 1) * kstep;
            const char* a2 = last ? nA : cA + (size_t)(t + 2) * kstep;
            const char* b2 = last ? nB : PG8_BK(cB, cB2, t + 2);
            const char* b3 = last ? (KSPLIT ? PG8_BK(nB, nB2, 1) : nB + kstep) : PG8_BK(cB, cB2, t + 3);
            const char* a3 = a2 + kstep;
            PG8_LDB(B0, 0, 0); PG8_LDB(B1, 0, 1); PG8_SCHED; PG8_LDA(At, 0, 0); PG8_STAGE(PG8_SA(1, 1), a1, vA[1]);
            PG8_WAIT_V(8); PG8_WAIT_L(0); PG8_BAR; PG8_MMA(0, 0, At, B0); PG8_MMA(0, 1, At, B1); PG8_BAR; PG8_SCHED;
            if (GATHER && last) {
#pragma unroll
                for (int h = 0; h < 2; ++h)
#pragma unroll
                    for (int i = 0; i < 2; ++i) vA[h][i] = vAn[h][i]; }
            PG8_LDA(At, 0, 1); PG8_STAGE(PG8_SB(0, 0), b2, voffB); PG8_STAGE(PG8_SB(0, 1), b2 + hstepB, voffB); PG8_STAGE(PG8_SA(0, 0), a2, vA[0]);
            PG8_WAIT_V(8); PG8_WAIT_L(0); PG8_BAR; PG8_MMA(1, 0, At, B0); PG8_MMA(1, 1, At, B1); PG8_BAR; PG8_SCHED;
            PG8_LDB(B0, 1, 0); PG8_LDB(B1, 1, 1); PG8_SCHED; PG8_LDA(At, 1, 0); PG8_STAGE(PG8_SA(0, 1), a2, vA[1]);
            PG8_WAIT_V(8); PG8_WAIT_L(0); PG8_BAR; PG8_MMA(0, 0, At, B0); PG8_MMA(0, 1, At, B1); PG8_BAR; PG8_SCHED;
            PG8_LDA(At, 1, 1); PG8_STAGE(PG8_SB(1, 0), b3, voffB); PG8_STAGE(PG8_SB(1, 1), b3 + hstepB, voffB); PG8_STAGE(PG8_SA(1, 0), a3, vA[0]);
            PG8_WAIT_V(8); PG8_WAIT_L(0); PG8_BAR; PG8_MMA(1, 0, At, B0); PG8_MMA(1, 1, At, B1); PG8_BAR; PG8_SCHED;
        }
        if constexpr (ALIGN_EPI) { if (wr == 0) PG8_BAR; }
        if constexpr (!Epi::AFTER_DRAIN) { E(acc, cur, wr, wc, fr, fq); }
        if (!has_next) break;
#pragma unroll
        for (int a = 0; a < 2; ++a)
#pragma unroll
            for (int b = 0; b < 2; ++b)
#pragma unroll
                for (int m = 0; m < 4; ++m)
#pragma unroll
                    for (int n = 0; n < 2; ++n) acc[a][b][m][n] = (f32x4){0.f, 0.f, 0.f, 0.f};
        cur = nxt; cA = nA; cB = nB; cB2 = nB2; ++ui;
        if constexpr (ALIGN_EPI) { if (wr == 1) PG8_BAR; }
    }
    PG8_WAIT_V(0);
    if constexpr (!ALIGN_EPI) { if (wr == 0) PG8_BAR; }
    PG8_BAR;
    if constexpr (Epi::AFTER_DRAIN) { E.fused(acc, cur, wr, wc, fr, fq, lds, wid, lane); }
#undef PG8_SA
#undef PG8_SB
#undef PG8_STAGE
#undef PG8_LDA
#undef PG8_LDB
#undef PG8_MMA
#undef PG8_WAIT_V
#undef PG8_WAIT_L
#undef PG8_BAR
#undef PG8_SCHED
#undef PG8_BK
#undef PG8_CAT8
}
}
namespace pg8 {
DEVFN unsigned pkbf(float lo, float hi) { return cvt_pk_bf16(lo, hi); }
struct DenseSched {
    typedef Unit UnitT;
    StaticOrder so; const char* A; const char* Bt; int lda, ldb;
    DEVFN bool next(int i, Unit& u) const { return so.next(i, u); }
    DEVFN const char* aptr(const Unit&) const { return A; }
    DEVFN void arows(const Unit& u, const int tid_, unsigned (&v)[2][2]) const {
        int R[2], C[2]; { int t_ = tid_; asm volatile("" : "+v"(t_)); stage_rc(t_ * 16, R[0], C[0]); stage_rc(t_ * 16 + 8192, R[1], C[1]); }
#pragma unroll
        for (int h = 0; h < 2; ++h)
#pragma unroll
            for (int i = 0; i < 2; ++i) v[h][i] = (unsigned)((u.pm * BM + h * HALF + R[i]) * lda + C[i] * 2); }
    DEVFN const char* bptr(const Unit& u) const { return Bt + (size_t)u.pn * BM * ldb; }
    DEVFN const char* bptr2(const Unit& u) const { return bptr(u); }
};
struct EpiInproj {
    static constexpr bool PERM = true, AFTER_DRAIN = false;
    bf16_t* O; const float* rope; float* kbar;
    DEVFN void operator()(f32x4 (&acc)[2][2][4][2], const Unit& u, int wr, int wc, int fr, int fq) const {
        const int pn = u.pn, row0 = u.pm * BM + wr * 64 + fr;
        if (pn < 4 && fq == 0) {
#pragma unroll
            for (int ai = 0; ai < 2; ++ai)
#pragma unroll
                for (int m = 0; m < 4; ++m) { const int t = (row0 + ai * HALF + m * 16) & (SEQ - 1); const f32x4* rp = (const f32x4*)(rope + t * 16);
#pragma unroll
                    for (int q = 0; q < 4; ++q) { const f32x4 cs = rp[q];
                        { const int d = 2 * q, n = d >> 2, e = d & 3; const float x1 = acc[ai][0][m][n][e], x2 = acc[ai][1][m][n][e]; acc[ai][0][m][n][e] = x1 * cs[0] - x2 * cs[1]; acc[ai][1][m][n][e] = x2 * cs[0] + x1 * cs[1]; }
                        { const int d = 2 * q + 1, n = d >> 2, e = d & 3; const float x1 = acc[ai][0][m][n][e], x2 = acc[ai][1][m][n][e]; acc[ai][0][m][n][e] = x1 * cs[2] - x2 * cs[3]; acc[ai][1][m][n][e] = x2 * cs[2] + x1 * cs[3]; } } }
        }
        if (pn == 2 || pn == 3) {
            float* kb = kbar + (size_t)((((u.pm >> 3) * NH + (pn - 2) * 4 + wc) * NBLK + (u.pm & 7)) * HD);
#pragma unroll
            for (int bj = 0; bj < 2; ++bj)
#pragma unroll
                for (int n = 0; n < 2; ++n)
#pragma unroll
                    for (int e = 0; e < 4; ++e) { float s = 0.f;
#pragma unroll
                        for (int ai = 0; ai < 2; ++ai)
#pragma unroll
                            for (int m = 0; m < 4; ++m) s += acc[ai][bj][m][n][e];
                        s = swz_xor_add(s, 1); s = swz_xor_add(s, 2); s = swz_xor_add(s, 4); s = swz_xor_add(s, 8);
                        if (fr == 0) atomicAdd(kb + (2 * fq + bj) * 8 + 4 * n + e, s * (1.f / MBLK)); }
        }
        const float sc = pn < 2 ? QSCALE : 1.f;
#pragma unroll
        for (int ai = 0; ai < 2; ++ai)
#pragma unroll
            for (int m = 0; m < 4; ++m) { bf16_t* rowp = O + (size_t)(row0 + ai * HALF + m * 16) * DIN + pn * BM + wc * 64;
#pragma unroll
                for (int bj = 0; bj < 2; ++bj) { const f32x4 v0 = acc[ai][bj][m][0] * sc, v1 = acc[ai][bj][m][1] * sc;
                    u32x4 w; w.x = pkbf(v0[0], v0[1]); w.y = pkbf(v0[2], v0[3]); w.z = pkbf(v1[0], v1[1]); w.w = pkbf(v1[2], v1[3]);
                    *(u32x4*)(rowp + (2 * fq + bj) * 8) = w; } }
    }
};
struct EpiF8 {
    static constexpr bool PERM = true, AFTER_DRAIN = false;
    unsigned char* O; int ldc;
    DEVFN void operator()(f32x4 (&acc)[2][2][4][2], const Unit& u, int wr, int wc, int fr, int fq) const {
#pragma unroll
        for (int ai = 0; ai < 2; ++ai)
#pragma unroll
            for (int m = 0; m < 4; ++m) { unsigned char* rowp = O + (size_t)(u.pm * BM + ai * HALF + wr * 64 + m * 16 + fr) * ldc + u.pn * BM + wc * 32 + fq * 8;
#pragma unroll
                for (int bj = 0; bj < 2; ++bj) { const f32x4 v0 = acc[ai][bj][m][0] * YSCALE, v1 = acc[ai][bj][m][1] * YSCALE;
                    u32x2 w; w.x = pk4_fp8(v0[0], v0[1], v0[2], v0[3]); w.y = pk4_fp8(v1[0], v1[1], v1[2], v1[3]);
                    *(u32x2*)(rowp + bj * HALF) = w; } }
    }
};
struct MoeUnit { int pm, pn, cls, j, cnt; };
struct MoeBase {
    const PG8_LAS int* tp; const PG8_LAS int* cnt; int nunits, G, c, npn_shift;
    DEVFN bool next_(int i, MoeUnit& u) const {
        const int L = i * G + c; if (L >= nunits) return false;
        u.pm = L >> npn_shift; u.pn = L & ((1 << npn_shift) - 1);
        int cls = 0; while (u.pm >= tp[cls + 1]) ++cls;
        u.cls = cls; u.j = u.pm - tp[cls]; u.cnt = cnt[cls]; return true; }
};
DEVFN void moe_experts(int cls, int& e1, int& e2) { const int g = cls / 6, p = cls % 6; const int lo = p < 3 ? 0 : (p < 5 ? 1 : 2), hi = p < 3 ? p + 1 : (p < 5 ? p - 1 : 3); e1 = g * 4 + lo; e2 = g * 4 + hi; }
struct GateUpSched : MoeBase {
    typedef MoeUnit UnitT;
    const char* HB; const int* list; const char* W;
    DEVFN bool next(int i, MoeUnit& u) const { return next_(i, u); }
    DEVFN const char* aptr(const MoeUnit&) const { return HB; }
    DEVFN void arows(const MoeUnit& u, const int tid_, unsigned (&v)[2][2]) const {
        int R[2], C[2]; { int t_ = tid_; asm volatile("" : "+v"(t_)); stage_rc(t_ * 16, R[0], C[0]); stage_rc(t_ * 16 + 8192, R[1], C[1]); }
#pragma unroll
        for (int h = 0; h < 2; ++h)
#pragma unroll
            for (int i = 0; i < 2; ++i) { const int li = 256 * u.j + h * HALF + R[i]; const int tok = list[(size_t)u.cls * LISTCAP + (li < u.cnt ? li : 256 * u.j)]; v[h][i] = (unsigned)(tok * DM + C[i] * 2); } }
    DEVFN const char* bptr(const MoeUnit& u) const { int e1, e2; moe_experts(u.cls, e1, e2); return W + (size_t)(u.pn < 4 ? e1 : e2) * DM * DM + (size_t)(u.pn & 3) * BM * DM; }
    DEVFN const char* bptr2(const MoeUnit& u) const { return bptr(u); }
};
struct DownSched : MoeBase {
    typedef MoeUnit UnitT;
    const char* ACT; const char* W;
    DEVFN bool next(int i, MoeUnit& u) const { return next_(i, u); }
    DEVFN const char* aptr(const MoeUnit&) const { return ACT; }
    DEVFN void arows(const MoeUnit& u, const int tid_, unsigned (&v)[2][2]) const {
        int R[2], C[2]; { int t_ = tid_; asm volatile("" : "+v"(t_)); stage_rc(t_ * 16, R[0], C[0]); stage_rc(t_ * 16 + 8192, R[1], C[1]); }
#pragma unroll
        for (int h = 0; h < 2; ++h)
#pragma unroll
            for (int i = 0; i < 2; ++i) v[h][i] = (unsigned)((u.pm * BM + h * HALF + R[i]) * DM + C[i] * 2); }
    DEVFN const char* bptr(const MoeUnit& u) const { int e1, e2; moe_experts(u.cls, e1, e2); return W + (size_t)e1 * DM * DE + (size_t)u.pn * BM * DE; }
    DEVFN const char* bptr2(const MoeUnit& u) const { int e1, e2; moe_experts(u.cls, e1, e2); return W + (size_t)e2 * DM * DE + (size_t)u.pn * BM * DE; }
};
struct EpiGateUp {
    static constexpr bool PERM = true, AFTER_DRAIN = false;
    unsigned char* ACT; const float* rw;
    DEVFN void operator()(f32x4 (&acc)[2][2][4][2], const MoeUnit& u, int wr, int wc, int fr, int fq) const {
        const int half = u.pn >> 2, jt = u.pn & 3;
#pragma unroll
        for (int ai = 0; ai < 2; ++ai)
#pragma unroll
            for (int m = 0; m < 4; ++m) { const int lr = ai * HALF + wr * 64 + m * 16 + fr, li = 256 * u.j + lr;
                const float wgt = li < u.cnt ? 8.f * rw[((size_t)u.cls * LISTCAP + li) * 2 + half] : 0.f;
                f32x4 o[2];
#pragma unroll
                for (int n = 0; n < 2; ++n)
#pragma unroll
                    for (int e = 0; e < 4; ++e) { const float g = acc[ai][0][m][n][e]; o[n][e] = g * __builtin_amdgcn_rcpf(1.f + __expf(-g)) * acc[ai][1][m][n][e] * wgt; }
                u32x2 w; w.x = pk4_fp8(o[0][0], o[0][1], o[0][2], o[0][3]); w.y = pk4_fp8(o[1][0], o[1][1], o[1][2], o[1][3]);
                *(u32x2*)(ACT + (size_t)(u.pm * BM + lr) * DM + half * 512 + jt * 128 + wc * 32 + fq * 8) = w; }
    }
};
struct EpiDown {
    static constexpr bool PERM = true, AFTER_DRAIN = false;
    unsigned char* Y2; const int* list;
    DEVFN void operator()(f32x4 (&acc)[2][2][4][2], const MoeUnit& u, int wr, int wc, int fr, int fq_) const {
        int fq = fq_; asm volatile("" : "+v"(fq));
#pragma unroll
        for (int ai = 0; ai < 2; ++ai)
#pragma unroll
            for (int m = 0; m < 4; ++m) { const int li = 256 * u.j + ai * HALF + wr * 64 + m * 16 + fr;
                if (li < u.cnt) { const int tok = list[(size_t)u.cls * LISTCAP + li]; unsigned char* rowp = Y2 + (size_t)tok * DM + u.pn * BM + wc * 32 + fq * 8;
#pragma unroll
                    for (int bj = 0; bj < 2; ++bj) { const f32x4 v0 = acc[ai][bj][m][0] * YSCALE, v1 = acc[ai][bj][m][1] * YSCALE;
                        u32x2 w; w.x = pk4_fp8(v0[0], v0[1], v0[2], v0[3]); w.y = pk4_fp8(v1[0], v1[1], v1[2], v1[3]);
                        *(u32x2*)(rowp + bj * HALF) = w; } } }
    }
};
}

#include <hip/hip_bf16.h>
#include <cmath>
namespace attn_body {
using bf16=__hip_bfloat16;
using bf16x8=__attribute__((ext_vector_type(8)))short;
using s16x4=__attribute__((ext_vector_type(4)))short;
using f32x16=__attribute__((ext_vector_type(16)))float;
using u32x4=__attribute__((ext_vector_type(4)))unsigned;
constexpr int BATCH=16,NHEAD=8,SEQ=2048,D=64,QP=2048,OP=1024;
constexpr int NW=8,QBLK=32,QB=QBLK*NW,KVBLK=64,NQB=SEQ/QB;
constexpr int ATTN_PITCH=QP, ATTN_UNIT_ROWS=QB;
__device__ __forceinline__ int crow(int r,int hi){return (r&3)+8*(r>>2)+4*hi;}
#define SBAR() __builtin_amdgcn_sched_barrier(0)
__device__ __forceinline__ void cmask(f32x16&p0,f32x16&p1,int jb,int qrel,int hi){
  const float NEG=-INFINITY; int kb=64*jb+4*hi;
  #pragma unroll
  for(int r=0;r<16;++r){int kv=kb+(r&3)+8*(r>>2); if(kv>qrel)p0[r]=NEG; if(kv+32>qrel)p1[r]=NEG;}
}

constexpr int NSLOT=3, SLOTB=8192;
constexpr int LDS_K=0, LDS_V=NSLOT*SLOTB, LDS_WS=2*NSLOT*SLOTB, LDS_OST=LDS_WS+NW*64*4, LDS_KBAR=LDS_OST+NW*4096, LDS_BYTES=LDS_KBAR+2048;
constexpr float NEGBIG=-1.0e30f; typedef float f32x4_t __attribute__((ext_vector_type(4)));
__device__ __forceinline__ float bfs(short v){return __uint_as_float(((unsigned)(unsigned short)v)<<16);}
constexpr float C2=0.125f*1.4426950408889634f;
__device__ __forceinline__ void glds16(const void*gsrc,unsigned lds_dst){unsigned keep;
  asm volatile("s_mov_b32 %0, m0\n\ts_mov_b32 m0, %2\n\ts_nop 0\n\tglobal_load_lds_dwordx4 %1, off\n\ts_mov_b32 m0, %0":"=&s"(keep):"v"(gsrc),"s"(lds_dst):"memory");}
__device__ __forceinline__ float max3f(float a,float b,float c){float r;asm("v_max3_f32 %0, %1, %2, %3":"=v"(r):"v"(a),"v"(b),"v"(c));return r;}
__device__ __forceinline__ float max2f(float a,float b){float r;asm("v_max_f32_e32 %0, %1, %2":"=v"(r):"v"(a),"v"(b));return r;}
__device__ __forceinline__ float fadd_s(float a,float b){float r;asm("v_add_f32_e32 %0, %1, %2":"=v"(r):"v"(a),"v"(b));return r;}
__device__ __forceinline__ float fsub_s(float a,float b){float r;asm("v_sub_f32_e32 %0, %1, %2":"=v"(r):"v"(a),"v"(b));return r;}
typedef float f32x2_t __attribute__((ext_vector_type(2))); typedef __bf16 bf16x2_t __attribute__((ext_vector_type(2)));
__device__ __forceinline__ unsigned cvtpk_s(float lo,float hi){f32x2_t v={lo,hi};bf16x2_t b=__builtin_convertvector(v,bf16x2_t);return __builtin_bit_cast(unsigned,b);}
#define WAIT_BAR(N) asm volatile("s_waitcnt vmcnt(" #N ") lgkmcnt(0)\n\ts_barrier":::"memory")

__device__ __forceinline__ void qkt(f32x16&p0,f32x16&p1,const char*Kslot,const bf16x8*qr,const f32x16&negm,int r32,int hi){
  const char*kb=Kslot+hi*1024+r32*16;
  #pragma unroll
  for(int d0=0;d0<4;++d0){
    const bf16x8 b0=*reinterpret_cast<const bf16x8*>(kb+d0*2048);
    const bf16x8 b1=*reinterpret_cast<const bf16x8*>(kb+d0*2048+512);
    if(d0==0){p0=__builtin_amdgcn_mfma_f32_32x32x16_bf16(b0,qr[0],negm,0,0,0);p1=__builtin_amdgcn_mfma_f32_32x32x16_bf16(b1,qr[0],negm,0,0,0);}
    else{p0=__builtin_amdgcn_mfma_f32_32x32x16_bf16(b0,qr[d0],p0,0,0,0);p1=__builtin_amdgcn_mfma_f32_32x32x16_bf16(b1,qr[d0],p1,0,0,0);}}
}
typedef __attribute__((address_space(3))) const char* lds_cptr;
typedef short v4i16_t __attribute__((ext_vector_type(4)));
__device__ __forceinline__ void kload8(bf16x8*kf,lds_cptr kp){
  kf[0]=*(const __attribute__((address_space(3))) bf16x8*)(kp);      kf[1]=*(const __attribute__((address_space(3))) bf16x8*)(kp+512);
  kf[2]=*(const __attribute__((address_space(3))) bf16x8*)(kp+2048); kf[3]=*(const __attribute__((address_space(3))) bf16x8*)(kp+2560);
  kf[4]=*(const __attribute__((address_space(3))) bf16x8*)(kp+4096); kf[5]=*(const __attribute__((address_space(3))) bf16x8*)(kp+4608);
  kf[6]=*(const __attribute__((address_space(3))) bf16x8*)(kp+6144); kf[7]=*(const __attribute__((address_space(3))) bf16x8*)(kp+6656);
}
__device__ __forceinline__ void kload2(bf16x8*kf,lds_cptr kp,int j){ kf[2*j]=*(const __attribute__((address_space(3))) bf16x8*)(kp+j*2048); kf[2*j+1]=*(const __attribute__((address_space(3))) bf16x8*)(kp+j*2048+512); }
__device__ __forceinline__ s16x4 vtr(lds_cptr p){ return __builtin_bit_cast(s16x4,__builtin_amdgcn_ds_read_tr16_b64_v4i16((__attribute__((address_space(3))) v4i16_t*)p)); }
__device__ __forceinline__ float rowmax(const f32x16&p0,const f32x16&p1){
  float a=max3f(p0[0],p0[1],p1[0]),b=max3f(p0[2],p0[3],p1[1]);a=max3f(a,p1[2],p1[3]);
  #pragma unroll
  for(int r=4;r<16;r+=4){a=max3f(a,p0[r],p0[r+1]);b=max3f(b,p0[r+2],p0[r+3]);a=max3f(a,p1[r],p1[r+1]);b=max3f(b,p1[r+2],p1[r+3]);}
  const float m=max2f(a,b);
  auto rr=__builtin_amdgcn_permlane32_swap(__float_as_uint(m),__float_as_uint(m),false,false);
  return max2f(__uint_as_float(rr[0]),__uint_as_float(rr[1]));
}
__device__ __forceinline__ void pv(f32x16*o,int vb,bf16x8 pa0,bf16x8 pa1,bf16x8 pa2,bf16x8 pa3){
  #pragma unroll
  for(int d0=0;d0<2;++d0){s16x4 lo[4],hi[4];
    #pragma unroll
    for(int ks=0;ks<4;++ks){
      asm volatile("ds_read_b64_tr_b16 %0,%1 offset:%c2":"=&v"(lo[ks]):"v"(vb),"i"(d0*4096+ks*1024):"memory");
      asm volatile("ds_read_b64_tr_b16 %0,%1 offset:%c2":"=&v"(hi[ks]):"v"(vb),"i"(d0*4096+ks*1024+512):"memory");}
    asm volatile("s_waitcnt lgkmcnt(0)":::"memory");SBAR();
    #define PK(k) (bf16x8){lo[k][0],lo[k][1],lo[k][2],lo[k][3],hi[k][0],hi[k][1],hi[k][2],hi[k][3]}
    o[d0]=__builtin_amdgcn_mfma_f32_32x32x16_bf16(pa0,PK(0),o[d0],0,0,0);
    o[d0]=__builtin_amdgcn_mfma_f32_32x32x16_bf16(pa1,PK(1),o[d0],0,0,0);
    o[d0]=__builtin_amdgcn_mfma_f32_32x32x16_bf16(pa2,PK(2),o[d0],0,0,0);
    o[d0]=__builtin_amdgcn_mfma_f32_32x32x16_bf16(pa3,PK(3),o[d0],0,0,0);
    #undef PK
  }
}

#ifndef ATTN_STORE16
#define ATTN_STORE16(p,v) (*(u32x4*)(p)=(v))
#endif
template<int THRL> __device__ __forceinline__ void attn_unit(int b,int h,int qb,const bf16*Q,const bf16*__restrict__ K,const bf16*__restrict__ V,bf16*O,const float*__restrict__ kbar,char*shm,const int tid){
  const int lane=tid&63,r32=lane&31,hi=lane>>5; const int wid=__builtin_amdgcn_readfirstlane(tid>>6);
  float kbv=0.f; { int tk=tid; asm volatile("":"+v"(tk)); if(qb>=4&&tk<448)kbv=kbar[tk]; }
  const long rowbase=(long)b*SEQ; const int q0=qb*QB;
  const bf16*Qw=Q+(rowbase+q0+wid*QBLK)*QP+h*D;
  const bf16*Kh=K+rowbase*QP+h*D,*Vh=V+rowbase*QP+h*D;
  const unsigned lds0=(unsigned)(uintptr_t)shm;
  float*wsf=(float*)(shm+LDS_WS)+wid*64;
  const bf16*ksrc=Kh+(long)lane*QP+wid*8;
  const bf16*vsrc=Vh+(long)(16*(wid&3)+(lane>>2))*QP+(wid>>2)*32+(lane&3)*8;
  const unsigned kdst=lds0+LDS_K+wid*1024, vdst=lds0+LDS_V+wid*1024;
  #define DMA_K(t,slot) glds16(ksrc+(long)(t)*KVBLK*QP,(unsigned)__builtin_amdgcn_readfirstlane(kdst+(slot)))
  #define DMA_V(t,slot) glds16(vsrc+(long)(t)*KVBLK*QP,(unsigned)__builtin_amdgcn_readfirstlane(vdst+(slot)))
  const int vb0=(int)(lds0+LDS_V)+((lane>>4)&1)*32+(lane&3)*8+(4*hi+((lane&15)>>2))*64;
  const char*Kbase=shm+LDS_K; bf16x8 kf[8];
  const lds_cptr shm3=(lds_cptr)shm; const lds_cptr kp0=shm3+LDS_K+hi*1024+r32*16; const lds_cptr vp0=shm3+LDS_V+((lane>>4)&1)*32+(lane&3)*8+(4*hi+((lane&15)>>2))*64;
  const int NT=(q0+QB)/KVBLK;
  DMA_K(0,0);DMA_V(0,0);DMA_K(1,SLOTB);
  bf16x8 qr[4];
  #pragma unroll
  for(int d0=0;d0<4;++d0)qr[d0]=*reinterpret_cast<const bf16x8*>(&Qw[(long)r32*QP+d0*16+hi*8]);
  float mhat=0.f,l_reg=0.f;f32x16 o[2];o[0]=f32x16{};o[1]=f32x16{};f32x16 negm=f32x16{};asm volatile("":"+v"(negm));
  const int qrel=wid*QBLK+r32;
  #define CMASK(P0,P1,t) do{int jb_=(t)-(NT-4); if(jb_>=0)cmask(P0,P1,jb_,qrel,hi);}while(0)
  bool resc=false;
  #define START(P0,P1) do{ const float rm=rowmax(P0,P1); resc=false; \
    { const float dl=selcur?rm:-64.f; mhat=fadd_s(mhat,dl); \
      _Pragma("unroll") for(int r=0;r<16;++r){P0[r]=fsub_s(P0[r],dl);P1[r]=fsub_s(P1[r],dl);} \
      { const float nv_=selcur?-mhat:NEGBIG; _Pragma("unroll") for(int r=0;r<16;++r)negm[r]=nv_; } asm volatile("":"+v"(negm)); } \
    _Pragma("unroll") for(int r=0;r<16;++r)P0[r]=__builtin_amdgcn_exp2f(P0[r]); }while(0)
  #define RESC() do{ if(resc){ asm volatile("s_waitcnt lgkmcnt(0)":::"memory"); \
      _Pragma("unroll") for(int d_=0;d_<2;++d_) _Pragma("unroll") for(int r=0;r<16;++r)o[d_][r]*=wsf[crow(r,hi)]; } }while(0)
  f32x16 pA0,pA1,pB0,pB1;
  int sl_prev=0,sl_cur=0,sl_next=SLOTB;
  #define ROT() do{sl_prev=sl_cur;sl_cur=sl_next;sl_next=(sl_next==(NSLOT-1)*SLOTB)?0:sl_next+SLOTB;}while(0)
  DMA_K(2,2*SLOTB);
  if(qb>=4){ if(tid<448){ const unsigned hb=__builtin_bit_cast(unsigned,kbv); const unsigned hr=(hb+0x7fffu+((hb>>16)&1u))&0xffff0000u; const float lo_=kbv-__builtin_bit_cast(float,hr); const unsigned lb=__builtin_bit_cast(unsigned,lo_);
      ((unsigned short*)(shm+LDS_KBAR))[tid]=(unsigned short)(hr>>16); ((unsigned short*)(shm+LDS_KBAR+1024))[tid]=(unsigned short)((lb+0x7fffu+((lb>>16)&1u))>>16); } }
  WAIT_BAR(3);
  unsigned bmask=(1u<<(qb+1))-1u;
  if(qb>=4){ float gsc[8];
    { const lds_cptr kb3=shm3+LDS_KBAR+(r32&7)*128+hi*16; f32x16 g=f32x16{};
      _Pragma("unroll") for(int d0=0;d0<4;++d0){ const bf16x8 ah=*(const __attribute__((address_space(3))) bf16x8*)(kb3+d0*32), al=*(const __attribute__((address_space(3))) bf16x8*)(kb3+1024+d0*32);
        g=__builtin_amdgcn_mfma_f32_32x32x16_bf16(ah,qr[d0],g,0,0,0); g=__builtin_amdgcn_mfma_f32_32x32x16_bf16(al,qr[d0],g,0,0,0); }
      _Pragma("unroll") for(int r=0;r<4;++r){ auto rr=__builtin_amdgcn_permlane32_swap(__float_as_uint(g[r]),__float_as_uint(g[r]),false,false); gsc[r]=__uint_as_float(rr[0]); gsc[4+r]=__uint_as_float(rr[1]); } }
    _Pragma("unroll") for(int n=0;n<7;++n) gsc[n]=(n<qb)?gsc[n]:-3.0e38f;
    bmask=1u<<qb;
    _Pragma("unroll") for(int pick=0;pick<3;++pick){ float best=-3.4e38f; unsigned bi=0u;
      _Pragma("unroll") for(int n=0;n<7;++n){ const bool ok=!((bmask>>n)&1u)&&gsc[n]>best; best=ok?gsc[n]:best; bi=ok?(unsigned)n:bi; }
      bmask|=1u<<bi; } }
  bool selcur=(bmask&1u)!=0u;
  { const float nv=selcur?0.f:NEGBIG; _Pragma("unroll") for(int r=0;r<16;++r)negm[r]=nv; asm volatile("":"+v"(negm)); }
  qkt(pA0,pA1,Kbase,qr,negm,r32,hi);asm volatile("s_nop 15\n\ts_nop 7":"+v"(pA0),"+v"(pA1));CMASK(pA0,pA1,0);
  START(pA0,pA1);
  _Pragma("unroll") for(int r=0;r<16;++r)pA1[r]=__builtin_amdgcn_exp2f(pA1[r]);
  WAIT_BAR(0);
  DMA_K(3,0);DMA_V(1,SLOTB);
  ROT();
  kload8(kf,kp0+sl_cur);
  WAIT_BAR(2);
  s16x4 vlo[8],vhi[8]; u32x4 pw0,pw1,pw2,pw3;
  #define PKW(P,B) cvtpk_s(P[B],P[B+1])
  #define PAF(k) __builtin_bit_cast(bf16x8,pw##k)
  #define VFR(i) (bf16x8){vlo[i][0],vlo[i][1],vlo[i][2],vlo[i][3],vhi[i][0],vhi[i][1],vhi[i][2],vhi[i][3]}
  #define PIN(x) asm volatile("":"+v"(x))
  #define MX3(a,b,c) __builtin_fmaxf(__builtin_fmaxf((a),(b)),(c))
  #define GAPA(MF,A0,A1,A2,A3,W0,W1,PW) do{ MF; sacc+=A0; sacc+=A1; sacc+=A2; sacc+=A3; PIN(sacc); W0; W1; PIN(PW); SBAR(); }while(0)
  #define EX(v) __builtin_amdgcn_exp2f(v)
  #define GAPB(MF,X,B) do{ MF; X[B]=EX(X[B]); X[B+1]=EX(X[B+1]); X[B+2]=EX(X[B+2]); X[B+3]=EX(X[B+3]); PIN(X); SBAR(); }while(0)
  #define VRD(i) do{ vlo[i]=vtr(vp_+(((i)>>2)*4096+((i)&3)*1024)); vhi[i]=vtr(vp_+(((i)>>2)*4096+((i)&3)*1024+512)); }while(0)
  #define KRD(G,j) do{ if(G){ kload2(kf,kp0+sl_next,j); SBAR(); } }while(0)
  #define STEP(C0,C1,P0,P1,t,GK,GV,GL) do{ SBAR(); \
    const lds_cptr vp_=vp0+sl_prev; \
    VRD(0); SBAR(); float sacc=(P0[0]+P0[1]); \
    GAPA(C0=__builtin_amdgcn_mfma_f32_32x32x16_bf16(kf[0],qr[0],negm,0,0,0), P0[2],P0[3],P0[4],P0[5],     pw0[0]=PKW(P0,0), pw0[1]=PKW(P0,2), pw0); \
    VRD(4); SBAR(); GAPA(C1=__builtin_amdgcn_mfma_f32_32x32x16_bf16(kf[1],qr[0],negm,0,0,0), P0[6],P0[7],P0[8],P0[9],     pw0[2]=PKW(P0,4), pw0[3]=PKW(P0,6), pw0); \
    VRD(1); SBAR(); GAPA(C0=__builtin_amdgcn_mfma_f32_32x32x16_bf16(kf[2],qr[1],C0,0,0,0),   P0[10],P0[11],P0[12],P0[13], pw1[0]=PKW(P0,8), pw1[1]=PKW(P0,10), pw1); \
    VRD(5); SBAR(); GAPA(C1=__builtin_amdgcn_mfma_f32_32x32x16_bf16(kf[3],qr[1],C1,0,0,0),   P0[14],P0[15],P1[0],P1[1],   pw1[2]=PKW(P0,12),pw1[3]=PKW(P0,14), pw1); \
    VRD(2); SBAR(); GAPA(C0=__builtin_amdgcn_mfma_f32_32x32x16_bf16(kf[4],qr[2],C0,0,0,0),   P1[2],P1[3],P1[4],P1[5],     pw2[0]=PKW(P1,0), pw2[1]=PKW(P1,2), pw2); \
    VRD(6); SBAR(); GAPA(C1=__builtin_amdgcn_mfma_f32_32x32x16_bf16(kf[5],qr[2],C1,0,0,0),   P1[6],P1[7],P1[8],P1[9],     pw2[2]=PKW(P1,4), pw2[3]=PKW(P1,6), pw2); \
    VRD(3); SBAR(); GAPA(C0=__builtin_amdgcn_mfma_f32_32x32x16_bf16(kf[6],qr[3],C0,0,0,0),   P1[10],P1[11],P1[12],P1[13], pw3[0]=PKW(P1,8), pw3[1]=PKW(P1,10), pw3); \
    VRD(7); SBAR(); GAPA(C1=__builtin_amdgcn_mfma_f32_32x32x16_bf16(kf[7],qr[3],C1,0,0,0),   P1[14],P1[15],0.f,0.f,       pw3[2]=PKW(P1,12),pw3[3]=PKW(P1,14), pw3); \
    l_reg+=sacc; \
    if(GK){DMA_K((t)+3,sl_cur);} if(GV){DMA_V((t)+1,sl_next);} \
    CMASK(C0,C1,t); \
    { float a=MX3(C0[0],C0[1],C1[0]),b=MX3(C0[2],C0[3],C1[1]); a=MX3(a,C1[2],C1[3]); \
      _Pragma("unroll") for(int r=4;r<16;r+=4){a=MX3(a,C0[r],C0[r+1]);b=MX3(b,C0[r+2],C0[r+3]);a=MX3(a,C1[r],C1[r+1]);b=MX3(b,C1[r+2],C1[r+3]);} \
      float rm=__builtin_fmaxf(a,b); { auto rr=__builtin_amdgcn_permlane32_swap(__float_as_uint(rm),__float_as_uint(rm),false,false); rm=__builtin_fmaxf(__uint_as_float(rr[0]),__uint_as_float(rr[1])); } \
      resc=false; \
      if(__builtin_expect(__any(rm>(float)THRL),0)){ const float dl=__builtin_fmaxf(rm,0.f); mhat+=dl; \
        _Pragma("unroll") for(int r=0;r<16;++r){C0[r]-=dl;C1[r]-=dl;} \
        { const float nv_=selcur?-mhat:NEGBIG; _Pragma("unroll") for(int r=0;r<16;++r)negm[r]=nv_; } asm volatile("":"+v"(negm)); \
        const float f=__builtin_amdgcn_exp2f(-dl); l_reg*=f; if(hi==0)wsf[r32]=f; resc=true; } } \
    SBAR(); \
    GAPB(o[0]=__builtin_amdgcn_mfma_f32_32x32x16_bf16(PAF(0),VFR(0),o[0],0,0,0), C0,0); \
    GAPB(o[1]=__builtin_amdgcn_mfma_f32_32x32x16_bf16(PAF(0),VFR(4),o[1],0,0,0), C0,4); \
    KRD(GL,0); GAPB(o[0]=__builtin_amdgcn_mfma_f32_32x32x16_bf16(PAF(1),VFR(1),o[0],0,0,0), C0,8); \
    KRD(GL,1); GAPB(o[1]=__builtin_amdgcn_mfma_f32_32x32x16_bf16(PAF(1),VFR(5),o[1],0,0,0), C0,12); \
    KRD(GL,2); GAPB(o[0]=__builtin_amdgcn_mfma_f32_32x32x16_bf16(PAF(2),VFR(2),o[0],0,0,0), C1,0); \
    KRD(GL,3); GAPB(o[1]=__builtin_amdgcn_mfma_f32_32x32x16_bf16(PAF(2),VFR(6),o[1],0,0,0), C1,4); \
    GAPB(o[0]=__builtin_amdgcn_mfma_f32_32x32x16_bf16(PAF(3),VFR(3),o[0],0,0,0), C1,8); \
    GAPB(o[1]=__builtin_amdgcn_mfma_f32_32x32x16_bf16(PAF(3),VFR(7),o[1],0,0,0), C1,12); \
    }while(0)
  #define BLKSEL(tt) do{ if((((tt))&3)==0){ selcur=((bmask>>((tt)>>2))&1u)!=0u; const float nv_=selcur?-mhat:NEGBIG; _Pragma("unroll") for(int r=0;r<16;++r)negm[r]=nv_; asm volatile("":"+v"(negm)); } }while(0)
  int t=1;
  #undef CMASK
  #define CMASK(P0,P1,t) do{}while(0)
  for(;t+5<NT;t+=2){
    STEP(pB0,pB1,pA0,pA1,t,true,true,true);     WAIT_BAR(2); RESC(); ROT(); BLKSEL(t+1);
    STEP(pA0,pA1,pB0,pB1,t+1,true,true,true);   WAIT_BAR(2); RESC(); ROT();
  }
  #undef CMASK
  #define CMASK(P0,P1,t) do{int jb_=(t)-(NT-4); if(jb_>=0)cmask(P0,P1,jb_,qrel,hi);}while(0)
  #define ENDW(tt) do{ if((tt)+3<NT){WAIT_BAR(2);} else if((tt)+2<NT){WAIT_BAR(1);} else {WAIT_BAR(0);} }while(0)
  for(;t+1<NT;t+=2){
    STEP(pB0,pB1,pA0,pA1,t,(t+3<NT),(t+1<NT),(t+1<NT));       ENDW(t);   RESC(); ROT(); BLKSEL(t+1);
    STEP(pA0,pA1,pB0,pB1,t+1,(t+4<NT),(t+2<NT),(t+2<NT));     ENDW(t+1); RESC(); ROT();
  }
  STEP(pB0,pB1,pA0,pA1,NT-1,false,false,false); RESC();
  { float sacc=pB0[0]+pB0[1]; _Pragma("unroll") for(int r=2;r<16;++r)sacc+=pB0[r]; _Pragma("unroll") for(int r=0;r<16;++r)sacc+=pB1[r]; l_reg+=sacc;
    pw0=(u32x4){PKW(pB0,0),PKW(pB0,2),PKW(pB0,4),PKW(pB0,6)};pw1=(u32x4){PKW(pB0,8),PKW(pB0,10),PKW(pB0,12),PKW(pB0,14)};pw2=(u32x4){PKW(pB1,0),PKW(pB1,2),PKW(pB1,4),PKW(pB1,6)};pw3=(u32x4){PKW(pB1,8),PKW(pB1,10),PKW(pB1,12),PKW(pB1,14)};
    SBAR(); pv(o,vb0+sl_cur,PAF(0),PAF(1),PAF(2),PAF(3)); }
  #undef PKW
  #undef PAF
  #undef VFR
  #undef PIN
  #undef MX3
  #undef GAPA
  #undef GAPB
  #undef EX
  #undef VRD
  #undef KRD
  #undef STEP
  #undef ENDW
  {auto rr=__builtin_amdgcn_permlane32_swap(__float_as_uint(l_reg),__float_as_uint(l_reg),false,false);l_reg=__uint_as_float(rr[0])+__uint_as_float(rr[1]);}
  if(hi==0)wsf[32+r32]=l_reg;asm volatile("s_waitcnt lgkmcnt(0)":::"memory");
  float rli[16];
  #pragma unroll
  for(int r=0;r<16;++r)rli[r]=__builtin_amdgcn_rcpf(wsf[32+crow(r,hi)]);
  unsigned char*Ow=(unsigned char*)O+(rowbase+q0+wid*QBLK)*OP+h*D;
  { unsigned char*stg=(unsigned char*)(shm+LDS_OST)+wid*4096;
    #pragma unroll
    for(int r=0;r<16;++r){const int orow=crow(r,hi);
      #pragma unroll
      for(int d0=0;d0<2;++d0){const float ov=__builtin_amdgcn_fmed3f(o[d0][r]*rli[r]*32.f,-448.f,448.f); stg[orow*64+d0*32+r32]=(unsigned char)__builtin_amdgcn_cvt_pk_fp8_f32(ov,ov,0,false);}}
    asm volatile("s_waitcnt lgkmcnt(0)":::"memory");
    #pragma unroll
    for(int i=0;i<2;++i){const int row=i*16+(lane>>2),ch=lane&3; const u32x4 v=*(const u32x4*)(stg+row*64+ch*16); ATTN_STORE16(Ow+(long)row*OP+ch*16,v);} }
  asm volatile("s_waitcnt lgkmcnt(0)\n\ts_barrier":::"memory");
  #undef BLKSEL
  #undef DMA_K
  #undef DMA_V
  #undef CMASK
  #undef START
  #undef RESC
  #undef ROT
}
constexpr int ATTN_LDS_BYTES=LDS_BYTES;
struct AttnTensors { const bf16* Q; const bf16* K; const bf16* V; bf16* O; const float* kbar; };
struct AttnUnit { int bh; int qb; };
struct StaticOrder {
  int vcu, G;
  __device__ __forceinline__ explicit StaticOrder(int grid,int block):vcu((grid%8==0)?(block%8)*(grid/8)+block/8:block),G(grid){}
  __device__ __forceinline__ bool next(int i,AttnUnit&u)const{ const int pr=(vcu+(i>>2)*G)*2+((i>>1)&1); if(pr>=BATCH*NHEAD*4)return false;
    const int s=pr&3; u.bh=pr>>2; u.qb=(i&1)?7-s:s; return true; }
  __device__ __forceinline__ void a_ready(const AttnUnit&)const{}
  __device__ __forceinline__ void done(const AttnUnit&)const{}
};
template<class Sched,int THRL=8> __device__ __forceinline__ void attn_phase(char*lds,const AttnTensors&T,const Sched&S,const int tid_in){
  AttnUnit u; int tid_=tid_in; asm volatile("":"+v"(tid_));
  for(int i=0;S.next(i,u);++i){ S.a_ready(u); attn_unit<THRL>(u.bh/NHEAD,u.bh%NHEAD,u.qb,T.Q,T.K,T.V,T.O,T.kbar+(long)u.bh*512,lds,tid_); S.done(u); }
}
#undef SBAR
#undef WAIT_BAR
}

#define XB_TMO      128
#define XB_XCNT(j)  (256  + 64 * (j))
#define XB_XSUB(j)  (1280 + 64 * (j))
#define XB_XGEN(j)  (2304 + 64 * (j))
#define XB_TOP      3328
#define XB_TOPGEN   3392
#define XCD_BAR_WORDS 3456
#define XB_SPIN_CAP (1u << 18)

__device__ __forceinline__ unsigned xb_ld(unsigned* p)              { return __hip_atomic_load(p, __ATOMIC_RELAXED, __HIP_MEMORY_SCOPE_AGENT); }
__device__ __forceinline__ unsigned xb_add(unsigned* p, unsigned v) { return __hip_atomic_fetch_add(p, v, __ATOMIC_RELAXED, __HIP_MEMORY_SCOPE_AGENT); }
__device__ __forceinline__ unsigned xb_xcc_id() { return (unsigned)__builtin_amdgcn_s_getreg((3 << 11) | 20) & 0xFu; }
#define XB_SPIN(cond, bar) do { unsigned _sp = 0; while (cond) { __builtin_amdgcn_s_sleep(1); \
    if ((++_sp & 255u) == 0u) { if (xb_ld(&(bar)[XB_TMO])) break; if (_sp > XB_SPIN_CAP) { atomicAdd(&(bar)[XB_TMO], 1u); break; } } } } while (0)

struct XcdBarrier {
    unsigned* bar; unsigned x;
    volatile LAS unsigned* st;
};

__device__ __forceinline__ XcdBarrier xcd_barrier_post(unsigned* bar, volatile LAS unsigned* st) {
    XcdBarrier b; b.bar = bar; b.x = xb_xcc_id(); b.st = st;
    if (threadIdx.x == 0) (void)xb_add(&bar[XB_XCNT(b.x)], 1u);
    return b;
}
__device__ __forceinline__ void xcd_barrier_complete(unsigned* bar, unsigned x, unsigned& nloc, unsigned& nx) {
    const unsigned G = gridDim.x * gridDim.y * gridDim.z;
    unsigned sum, cnt, mine, sp = 0u;
    for (;;) {
        sum = 0u; cnt = 0u; mine = 0u;
#pragma unroll
        for (unsigned j = 0; j < 16; ++j) { const unsigned c = xb_ld(&bar[XB_XCNT(j)]); sum += c; cnt += (c > 0u) ? 1u : 0u; mine = (j == x) ? c : mine; }
        if (sum == G) break;
        __builtin_amdgcn_s_sleep(1);
        if ((++sp & 255u) == 0u) { if (xb_ld(&bar[XB_TMO])) break; if (sp > XB_SPIN_CAP) { atomicAdd(&bar[XB_TMO], 1u); break; } }
    }
    nloc = mine > 0u ? mine : 1u; nx = cnt > 0u ? cnt : 1u;
}

__device__ __forceinline__ void xcd_barrier(const XcdBarrier& b, const bool is_t0) {
    asm volatile("s_waitcnt vmcnt(0)" ::: "memory");
    __syncthreads();
    if (is_t0) {
        unsigned* bar = b.bar;
        __builtin_amdgcn_s_waitcnt(0);
        unsigned nloc = b.st[0], nx = b.st[1];
        if (nloc == 0u) { xcd_barrier_complete(bar, b.x, nloc, nx); b.st[0] = nloc; b.st[1] = nx; }
        const unsigned old = xb_add(&bar[XB_XSUB(b.x)], 1u);
        const unsigned gen = old / nloc;
        if (old + 1u == (gen + 1u) * nloc) {
            __builtin_amdgcn_fence(__ATOMIC_RELEASE, "agent");
            asm volatile("s_waitcnt vmcnt(0)" ::: "memory");
            const unsigned og = xb_add(&bar[XB_TOP], 1u);
            const unsigned tg = og / nx;
            if (og + 1u == (tg + 1u) * nx) xb_add(&bar[XB_TOPGEN], 1u);
            else XB_SPIN(xb_ld(&bar[XB_TOPGEN]) == tg, bar);
            __builtin_amdgcn_fence(__ATOMIC_ACQUIRE, "agent");
            xb_add(&bar[XB_XGEN(b.x)], 1u);
            asm volatile("s_waitcnt vmcnt(0)" ::: "memory");
        } else {
            XB_SPIN(xb_ld(&bar[XB_XGEN(b.x)]) == gen, bar);
            __builtin_amdgcn_fence(__ATOMIC_ACQUIRE, "agent");
            asm volatile("s_waitcnt vmcnt(0)" ::: "memory");
        }
    }
    __syncthreads();
}

struct Args { const float* in[17]; float* out; unsigned char* ws; int ph_lo, ph_hi; };
enum { I_X = 0, I_C, I_WMOD, I_BMOD, I_WIN, I_WPOOL, I_PSCALE, I_WOUT, I_LN1G, I_LN1B, I_WR, I_RB, I_WG, I_WU, I_WDN, I_LN2G, I_LN2B };

DEVFN int lane_id_volatile() { int l; asm volatile("v_mbcnt_lo_u32_b32 %0, -1, 0\n\tv_mbcnt_hi_u32_b32 %0, -1, %0" : "=v"(l)); return l; }
struct Ctx { unsigned char* lds; __attribute__((address_space(3))) unsigned char* lds3; int tid, lane, wave, G, bid, gw, NGW; };

DEVFN void transpose_item_f8(const float* src, int ldn, int k0, int col, unsigned char* dst, int ldk, int dst_row0, int dst_k0, float* scr, int lane) {
#pragma unroll 8
    for (int i = 0; i < 32; ++i) { const int kk = 2 * i + (lane >> 5); scr[kk * 33 + (lane & 31)] = src[(size_t)(k0 + kk) * ldn + col]; }
    LDS_WAIT();
    const int c = lane & 7;
#pragma unroll
    for (int j = 0; j < 4; ++j) { const int n = (lane >> 3) + 8 * j; const float* s = scr + (8 * c) * 33 + n;
        u32x2 o; o.x = pk4_fp8(32.f * s[0 * 33], 32.f * s[1 * 33], 32.f * s[2 * 33], 32.f * s[3 * 33]); o.y = pk4_fp8(32.f * s[4 * 33], 32.f * s[5 * 33], 32.f * s[6 * 33], 32.f * s[7 * 33]);
        *(u32x2*)(dst + (size_t)(dst_row0 + n) * ldk + dst_k0 + 8 * c) = o; }
    LDS_WAIT();
}

DEVFN void ph_prologue(const Args& a, const Ctx& c) {
    unsigned char* ws = a.ws;
    float* scr = (float*)(c.lds + c.wave * 16384);
    const int lane = c.lane;
    constexpr int N1 = 2 * 16 * 64, N2 = 2 * 8 * 32, N3 = 32 * 16 * 32, N4 = 32 * 8 * 32, N5 = 2 * 64 * 16, N6 = 256;
    for (int it = c.gw; it < N1 + N2 + N3 + N4 + N5 + N6; it += c.NGW) {
        int r = it;
        if (r < N1) {
            const int l = r / 1024, kb = (r % 1024) / 64, nb = r % 64;
            const int nphys = 32 * nb + (lane & 31);
            transpose_item_f8(a.in[I_WIN] + (size_t)l * DM * DIN, DIN, 64 * kb, inproj_nlog(nphys), (unsigned char*)(ws + WS_WIN) + (size_t)l * DIN * DM, DM, 32 * nb, 64 * kb, scr, lane);
            continue; }
        r -= N1;
        if (r < N2) {
            const int l = r / 256, kb = (r % 256) / 32, nb = r % 32;
            transpose_item_f8(a.in[I_WOUT] + (size_t)l * DM * DM, DM, 64 * kb, 32 * nb + (lane & 31), (unsigned char*)(ws + WS_WOUT) + (size_t)l * DM * DM, DM, 32 * nb, 64 * kb, scr, lane);
            continue; }
        r -= N2;
        if (r < N3) {
            const int le = r / 512, kb = (r % 512) / 32, nb = r % 32;
            const int n = 32 * nb + (lane & 31), jt = n >> 8, bj = (n >> 7) & 1, i = n & 127;
            const float* src = (bj ? a.in[I_WU] : a.in[I_WG]) + (size_t)le * DM * DE;
            transpose_item_f8(src, DE, 64 * kb, jt * 128 + i, (unsigned char*)(ws + WS_WGU) + (size_t)le * DM * DM, DM, 32 * nb, 64 * kb, scr, lane);
            continue; }
        r -= N3;
        if (r < N4) {
            const int le = r / 256, kb = (r % 256) / 32, nb = r % 32;
            transpose_item_f8(a.in[I_WDN] + (size_t)le * DE * DM, DM, 64 * kb, 32 * nb + (lane & 31), (unsigned char*)(ws + WS_WD) + (size_t)le * DM * DE, DE, 32 * nb, 64 * kb, scr, lane);
            continue; }
        r -= N4;
        if (r < N5) {
            const int l = r / 1024, kdg = (r % 1024) / 16, nb = r % 16;
            const int n = nb * 64 + lane, kd0 = kdg * 8, g = kd0 >> 7, c0 = kd0 & 127;
            const float* wo = a.in[I_WOUT] + (size_t)l * DM * DM + (size_t)(512 + g * 128) * DM + n;
            const float* ps = a.in[I_PSCALE] + l * 512 + g * 128;
            const float* wp = a.in[I_WPOOL] + ((size_t)(l * 4 + g) * 128 + c0) * 128;
            float acc[8];
#pragma unroll
            for (int j = 0; j < 8; ++j) acc[j] = 0.f;
            for (int e = 0; e < 128; ++e) { const float w = wo[(size_t)e * DM] * ps[e];
#pragma unroll
                for (int j = 0; j < 8; ++j) acc[j] += wp[j * 128 + e] * w; }
            u32x2 o; o.x = pk4_fp8(128.f * acc[0], 128.f * acc[1], 128.f * acc[2], 128.f * acc[3]); o.y = pk4_fp8(128.f * acc[4], 128.f * acc[5], 128.f * acc[6], 128.f * acc[7]);
            *(u32x2*)((unsigned char*)(ws + WS_WOUT) + (size_t)l * DM * DM + (size_t)n * DM + 512 + kd0) = o;
            continue; }
        r -= N5;
        {
            const int ent = r * 64 + lane, pos = ent >> 3, i = ent & 7;
            const float inv = (float)exp2(-(double)i / 8.0 * 18.931568569324174);
            const float ang = (float)pos * inv;
            float* t = (float*)(ws + WS_ROPE) + ent * 2;
            t[0] = (float)cos((double)ang); t[1] = (float)sin((double)ang);
        }
    }
    for (int i = c.bid * 512 + c.tid; i < 2 * NB * NH * NBLK * HD; i += c.G * 512) ((float*)(ws + WS_KBAR))[i] = 0.f;
    __syncthreads();
    if (c.bid < 192) {
        float* condT = (float*)c.lds;
        float* red = (float*)(c.lds + 65536);
        for (int idx = c.tid; idx < NB * DM; idx += 512) { const int b = idx >> 10, k = idx & 1023; const float v = a.in[I_C][idx]; condT[k * 16 + b] = v / (1.f + __expf(-v)); }
        __syncthreads();
        for (int u = c.bid; u < 192; u += c.G) {
            const int l = u / 96, n0 = (u % 96) * 64;
            const float* W = a.in[I_WMOD] + (size_t)l * DM * NMOD + n0 + lane;
            float acc[16];
#pragma unroll
            for (int b = 0; b < 16; ++b) acc[b] = 0.f;
            for (int k = 128 * c.wave; k < 128 * c.wave + 128; k += 8) {
                float wv[8];
#pragma unroll
                for (int j = 0; j < 8; ++j) wv[j] = W[(size_t)(k + j) * NMOD];
#pragma unroll
                for (int j = 0; j < 8; ++j) {
                    const f32x4* cp = (const f32x4*)(condT + (k + j) * 16);
#pragma unroll
                    for (int q = 0; q < 4; ++q) { const f32x4 cv = cp[q]; acc[4 * q + 0] += cv.x * wv[j]; acc[4 * q + 1] += cv.y * wv[j]; acc[4 * q + 2] += cv.z * wv[j]; acc[4 * q + 3] += cv.w * wv[j]; }
                }
            }
#pragma unroll
            for (int b = 0; b < 16; ++b) red[(c.wave * 16 + b) * 64 + lane] = acc[b];
            __syncthreads();
            for (int o = c.tid; o < 1024; o += 512) { const int b = o >> 6, cc = o & 63; float s = a.in[I_BMOD][l * NMOD + n0 + cc];
#pragma unroll
                for (int w = 0; w < 8; ++w) s += red[(w * 16 + b) * 64 + cc];
                ((float*)(ws + WS_MOD))[(size_t)(l * NB + b) * NMOD + n0 + cc] = s; }
            __syncthreads();
        }
    }
}

DEVFN void row_stats(const f32x4 (&v)[4], float& mean, float& rstd) {
    float s = 0.f, q = 0.f;
#pragma unroll
    for (int j = 0; j < 4; ++j) { s += (v[j].x + v[j].y) + (v[j].z + v[j].w); q += (v[j].x * v[j].x + v[j].y * v[j].y) + (v[j].z * v[j].z + v[j].w * v[j].w); }
    s = swz_xor_add(s, 1); q = swz_xor_add(q, 1); s = swz_xor_add(s, 2); q = swz_xor_add(q, 2); s = swz_xor_add(s, 4); q = swz_xor_add(q, 4);
    s = swz_xor_add(s, 8); q = swz_xor_add(q, 8); s = swz_xor_add(s, 16); q = swz_xor_add(q, 16); s = half_swap_add(s); q = half_swap_add(q);
    mean = s * (1.f / DM);
    rstd = 1.f / sqrtf(fmaxf(q * (1.f / DM) - mean * mean, 0.f) + LN_EPS);
}
DEVFN void row_load(const float* p, int lane, f32x4 (&v)[4]) {
#pragma unroll
    for (int j = 0; j < 4; ++j) v[j] = *(const f32x4*)(p + 4 * lane + 256 * j);
}
DEVFN void row_mod_store(f32x4 (&v)[4], const float* sc, const float* sh, bf16_t* out, int lane) {
    float mean, rstd; row_stats(v, mean, rstd);
#pragma unroll
    for (int j = 0; j < 4; ++j) {
        const f32x4 s = *(const f32x4*)(sc + 4 * lane + 256 * j), h = *(const f32x4*)(sh + 4 * lane + 256 * j);
        v[j] = (v[j] - mean) * rstd * (s + 1.f) + h;
        u32x2 o; o.x = pk2(v[j].x, v[j].y); o.y = pk2(v[j].z, v[j].w);
        *(u32x2*)(out + 4 * lane + 256 * j) = o;
    }
}

DEVFN void ph_pool(const Args& a, const Ctx& c) {
    const bf16_t* P = (const bf16_t*)(a.ws + WS_QKVP) + 1536; unsigned char* AD = (unsigned char*)(a.ws + WS_AD) + 512;
    for (int it = c.bid * 512 + c.tid; it < (NTOK / 8) * 64; it += c.G * 512) {
        const int cg = it & 63, m0 = (it >> 6) * 8, t0 = m0 & (SEQ - 1), g = cg >> 4, w = 2 << g;
        const bf16_t* pc = P + cg * 8;
        u32x4 rows[23];
#pragma unroll
        for (int k = 0; k < 23; ++k) { const int dt = k - 15; rows[k] = (u32x4){0u, 0u, 0u, 0u}; if (dt > -w && t0 + dt >= 0) rows[k] = *(const u32x4*)(pc + (size_t)(m0 + dt) * DIN); }
        float s[8];
#pragma unroll
        for (int j = 0; j < 8; ++j) s[j] = 0.f;
#pragma unroll
        for (int k = 0; k < 15; ++k) { const u32x4 v = rows[k]; s[0] += bf_lo(v.x); s[1] += bf_hi(v.x); s[2] += bf_lo(v.y); s[3] += bf_hi(v.y); s[4] += bf_lo(v.z); s[5] += bf_hi(v.z); s[6] += bf_lo(v.w); s[7] += bf_hi(v.w); }
#pragma unroll
        for (int r = 0; r < 8; ++r) {
            const int t = t0 + r; const u32x4 v = rows[15 + r];
            const float f[8] = {bf_lo(v.x), bf_hi(v.x), bf_lo(v.y), bf_hi(v.y), bf_lo(v.z), bf_hi(v.z), bf_lo(v.w), bf_hi(v.w)};
#pragma unroll
            for (int j = 0; j < 8; ++j) s[j] += f[j];
            const int cnt = (t + 1 < w) ? t + 1 : w; const float ic = 1.f / (float)cnt;
            u32x2 o; o.x = pk4_fp8(s[0] * ic - f[0], s[1] * ic - f[1], s[2] * ic - f[2], s[3] * ic - f[3]); o.y = pk4_fp8(s[4] * ic - f[4], s[5] * ic - f[5], s[6] * ic - f[6], s[7] * ic - f[7]);
            *(u32x2*)(AD + (size_t)(m0 + r) * DM + cg * 8) = o;
            u32x4 q = rows[r];
            if (w == 8) q = rows[r + 8]; else if (w == 4) q = rows[r + 12]; else if (w == 2) q = rows[r + 14];
            s[0] -= bf_lo(q.x); s[1] -= bf_hi(q.x); s[2] -= bf_lo(q.y); s[3] -= bf_hi(q.y); s[4] -= bf_lo(q.z); s[5] -= bf_hi(q.z); s[6] -= bf_lo(q.w); s[7] -= bf_hi(q.w);
        }
    }
}

constexpr size_t WS_X1B = WS_X1, WS_X2B = WS_X1 + 64 * MiB;
constexpr int ROWS_PER_WAVE = 16;
DEVFN void vec_load(const float* p, int lane, f32x4 (&v)[4]) {
#pragma unroll
    for (int j = 0; j < 4; ++j) v[j] = *(const f32x4*)(p + 4 * lane + 256 * j);
}
DEVFN void bfrow_load(const bf16_t* p, int lane, u32x2 (&w)[4]) {
#pragma unroll
    for (int j = 0; j < 4; ++j) w[j] = *(const u32x2*)(p + 4 * lane + 256 * j);
}
DEVFN f32x4 bf4(u32x2 w) { return (f32x4){bf_lo(w.x), bf_hi(w.x), bf_lo(w.y), bf_hi(w.y)}; }
DEVFN void bfrow_store(bf16_t* p, int lane, const f32x4 (&v)[4]) {
#pragma unroll
    for (int j = 0; j < 4; ++j) { u32x2 o; o.x = pk2(v[j].x, v[j].y); o.y = pk2(v[j].z, v[j].w); *(u32x2*)(p + 4 * lane + 256 * j) = o; }
}
DEVFN void f8row_store(unsigned char* p, int lane, const f32x4 (&v)[4]) {
#pragma unroll
    for (int j = 0; j < 4; ++j) *(unsigned*)(p + 4 * lane + 256 * j) = pk4_fp8(v[j].x, v[j].y, v[j].z, v[j].w);
}
DEVFN void ln_mod(f32x4 (&v)[4], const f32x4 (&sc)[4], const f32x4 (&sh)[4]) {
    float mean, rstd; row_stats(v, mean, rstd);
#pragma unroll
    for (int j = 0; j < 4; ++j) v[j] = (v[j] - mean) * rstd * (sc[j] + 1.f) + sh[j];
}
DEVFN void ln_aff(f32x4 (&v)[4], const f32x4 (&g)[4], const f32x4 (&b)[4]) {
    float mean, rstd; row_stats(v, mean, rstd);
#pragma unroll
    for (int j = 0; j < 4; ++j) v[j] = (v[j] - mean) * rstd * g[j] + b[j];
}

DEVFN void ph_h1_rows(const Args& a, const Ctx& c) {
    const float* mod = (const float*)(a.ws + WS_MOD); bf16_t* HB = (bf16_t*)(a.ws + WS_HB);
    for (int base = c.gw * ROWS_PER_WAVE; base < NTOK; base += c.NGW * ROWS_PER_WAVE) {
        const float* mb = mod + (size_t)(base >> 11) * NMOD;
        f32x4 sc[4], sh[4]; vec_load(mb + DM, c.lane, sc); vec_load(mb, c.lane, sh);
        f32x4 cur[4], nxt[4]; vec_load(a.in[I_X] + (size_t)base * DM, c.lane, cur);
#pragma unroll 1
        for (int i = 0; i < ROWS_PER_WAVE; ++i) {
            const int m = base + i;
            if (i + 1 < ROWS_PER_WAVE) vec_load(a.in[I_X] + (size_t)(m + 1) * DM, c.lane, nxt);
            ln_mod(cur, sc, sh); f8row_store((unsigned char*)HB + (size_t)m * DM, c.lane, cur);
#pragma unroll
            for (int j = 0; j < 4; ++j) cur[j] = nxt[j];
        }
    }
}

DEVFN f32x4 reduce16(const float (&lg)[16]) {
    float t[8], u[4];
#pragma unroll
    for (int e = 0; e < 8; ++e) { auto rr = __builtin_amdgcn_permlane32_swap(__float_as_uint(lg[e]), __float_as_uint(lg[e + 8]), false, false); t[e] = __uint_as_float(rr[0]) + __uint_as_float(rr[1]); }
#pragma unroll
    for (int k = 0; k < 4; ++k) { auto rr = __builtin_amdgcn_permlane16_swap(__float_as_uint(t[k]), __float_as_uint(t[k + 4]), false, false); u[k] = __uint_as_float(rr[0]) + __uint_as_float(rr[1]); }
#pragma unroll
    for (int k = 0; k < 4; ++k) { u[k] = swz_xor_add(u[k], 1); u[k] = swz_xor_add(u[k], 2); u[k] = swz_xor_add(u[k], 4); u[k] = swz_xor_add(u[k], 8); }
    return (f32x4){u[0], u[1], u[2], u[3]};
}

DEVFN void rowc_load(const Args& a, int l, int m, int lane, f32x4 (&x)[4], unsigned (&y)[4]) {
    if (l == 0) vec_load(a.in[I_X] + (size_t)m * DM, lane, x);
    else { u32x2 w[4]; bfrow_load((const bf16_t*)(a.ws + WS_X2B) + (size_t)m * DM, lane, w);
#pragma unroll
        for (int j = 0; j < 4; ++j) { x[j].x = __uint_as_float(w[j].x); x[j].y = __uint_as_float(w[j].y); } }
#pragma unroll
    for (int j = 0; j < 4; ++j) y[j] = *(const unsigned*)((const unsigned char*)(a.ws + WS_QKVP) + (size_t)m * DM + 4 * lane + 256 * j);
}
DEVFN void rowc_step(const Args& a, int l, int m, int lane, const f32x4 (&x)[4], const unsigned (&y)[4], const float* vg1, const float* vsc, const float* vsh, f32x4 (&v)[4]) {
    int z_ = 0; asm volatile("" : "+v"(z_));
    f32x4 g1[4]; vec_load(vg1 + z_, lane, g1);
#pragma unroll
    for (int j = 0; j < 4; ++j) { const f32x4 xv = (l == 0) ? x[j] : bf4((u32x2){__float_as_uint(x[j].x), __float_as_uint(x[j].y)}); v[j] = xv * ALPHA + g1[j] * f8x4_to_f32(y[j], 1.f / YSCALE); }
    { f32x4 lg[4], lb[4]; vec_load(a.in[I_LN1G] + l * DM + z_, lane, lg); vec_load(a.in[I_LN1B] + l * DM + z_, lane, lb); ln_aff(v, lg, lb); }
    bfrow_store((bf16_t*)(a.ws + WS_X1B) + (size_t)m * DM, lane, v);
    { f32x4 sc[4], sh[4]; vec_load(vsc + z_, lane, sc); vec_load(vsh + z_, lane, sh); ln_mod(v, sc, sh); }
    f8row_store((unsigned char*)(a.ws + WS_HB) + (size_t)m * DM, lane, v);
}

DEVFN void ph_rows_c(const Args& a, const Ctx& c, int l, bool publish) {
    const float* mod = (const float*)(a.ws + WS_MOD) + (size_t)l * NB * NMOD;
    const bf16_t* Y = (const bf16_t*)(a.ws + WS_QKVP); const bf16_t* X2B = (const bf16_t*)(a.ws + WS_X2B);
    bf16_t* X1B = (bf16_t*)(a.ws + WS_X1B); bf16_t* HB = (bf16_t*)(a.ws + WS_HB);
    float* wr = (float*)c.lds;
    float* vsc = (float*)(c.lds + 65536); float* vsh = vsc + DM; float* vg1 = vsh + DM;
    int* lcnt = (int*)(c.lds + 65536 + 12288); int* lbase = lcnt + 32;
    int* rcls = lbase + 32; float* rw1 = (float*)(rcls + 8 * 64); float* rw2 = rw1 + 8 * 64; int* rrow = (int*)(rw2 + 8 * 64); float* lgs = (float*)(rrow + 8 * 64);
    for (int i = c.tid; i < DM * NE; i += 512) wr[(i & 15) * DM + (i >> 4)] = a.in[I_WR][i];
    if (c.tid < 32) lcnt[c.tid] = 0;
    __syncthreads();
    int nr = 0;
    for (int base = c.gw * ROWS_PER_WAVE; base < NTOK; base += c.NGW * ROWS_PER_WAVE) {
        const float* mb = mod + (size_t)(base >> 11) * NMOD;
        __syncthreads();
        for (int i = c.tid; i < 3 * DM; i += 512) vsc[i] = (i < DM) ? mb[4 * DM + i] : (i < 2 * DM ? mb[3 * DM + (i - DM)] : mb[2 * DM + (i - 2 * DM)]);
        __syncthreads();
#pragma unroll 1
        for (int i = 0; i < ROWS_PER_WAVE; i += 2) {
            const int m = __builtin_amdgcn_readfirstlane(base + i);
            f32x4 va[4], vb[4];
            { f32x4 xa[4], xb[4]; unsigned ya[4], yb[4];
              rowc_load(a, l, m, c.lane, xa, ya); rowc_load(a, l, m + 1, c.lane, xb, yb);
              rowc_step(a, l, m, c.lane, xa, ya, vg1, vsc, vsh, va);
              rowc_step(a, l, m + 1, c.lane, xb, yb, vg1, vsc, vsh, vb); }
            typedef float f32x2_t __attribute__((ext_vector_type(2)));
            f32x2_t acc2[16];
#pragma unroll
            for (int e = 0; e < 16; ++e) acc2[e] = (f32x2_t){0.f, 0.f};
#pragma unroll
            for (int j = 0; j < 4; ++j) {
                const f32x2_t p0 = {va[j].x, vb[j].x}, p1 = {va[j].y, vb[j].y}, p2 = {va[j].z, vb[j].z}, p3 = {va[j].w, vb[j].w};
#pragma unroll
                for (int e = 0; e < 16; ++e) { const f32x4 w = *(const f32x4*)(wr + e * DM + 4 * c.lane + 256 * j);
                    acc2[e] = __builtin_elementwise_fma(p0, (f32x2_t){w.x, w.x}, acc2[e]); acc2[e] = __builtin_elementwise_fma(p1, (f32x2_t){w.y, w.y}, acc2[e]);
                    acc2[e] = __builtin_elementwise_fma(p2, (f32x2_t){w.z, w.z}, acc2[e]); acc2[e] = __builtin_elementwise_fma(p3, (f32x2_t){w.w, w.w}, acc2[e]);
                    if ((e & 7) == 7) __builtin_amdgcn_sched_barrier(0); } }
            float la[16], lb2[16];
#pragma unroll
            for (int e = 0; e < 16; ++e) { la[e] = acc2[e].x; lb2[e] = acc2[e].y; }
            { const f32x4 ua = reduce16(la), ub = reduce16(lb2);
              if ((c.lane & 15) == 0) { *(f32x4*)(lgs + (c.wave * 16 + i) * 16 + (c.lane >> 4) * 4) = ua; *(f32x4*)(lgs + (c.wave * 16 + i + 1) * 16 + (c.lane >> 4) * 4) = ub; } }
        }
        LDS_WAIT();
        if (c.lane < ROWS_PER_WAVE) {
            float lg16[16], rb[16];
#pragma unroll
            for (int e = 0; e < 16; ++e) rb[e] = a.in[I_RB][e];
#pragma unroll
            for (int q = 0; q < 4; ++q) { const f32x4 t = *(const f32x4*)(lgs + (c.wave * 16 + c.lane) * 16 + 4 * q); lg16[4 * q] = t.x; lg16[4 * q + 1] = t.y; lg16[4 * q + 2] = t.z; lg16[4 * q + 3] = t.w; }
            float mx = lg16[0];
#pragma unroll
            for (int e = 1; e < 16; ++e) mx = fmaxf(mx, lg16[e]);
            float sum = 0.f, scr[16];
#pragma unroll
            for (int e = 0; e < 16; ++e) { scr[e] = __expf(lg16[e] - mx); sum += scr[e]; }
            const float isum = 1.f / sum;
#pragma unroll
            for (int e = 0; e < 16; ++e) scr[e] *= isum;
            float bestg = -3.4e38f; int gb = 0, bi1 = 0, bi2 = 1; float bw1 = 0.f, bw2 = 0.f;
#pragma unroll
            for (int g = 0; g < 4; ++g) {
                float m1 = scr[4 * g] + rb[4 * g], s1 = scr[4 * g]; int i1 = 0;
#pragma unroll
                for (int q = 1; q < 4; ++q) { const float sv = scr[4 * g + q] + rb[4 * g + q]; const bool ok = sv > m1; m1 = ok ? sv : m1; s1 = ok ? scr[4 * g + q] : s1; i1 = ok ? q : i1; }
                float m2 = -3.4e38f, s2 = 0.f; int i2 = 0;
#pragma unroll
                for (int q = 0; q < 4; ++q) { const float sv = scr[4 * g + q] + rb[4 * g + q]; const bool ok = (q != i1) && sv > m2; m2 = ok ? sv : m2; s2 = ok ? scr[4 * g + q] : s2; i2 = ok ? q : i2; }
                const float gs = m1 + m2; const bool better = gs > bestg;
                bestg = better ? gs : bestg; gb = better ? g : gb; bi1 = better ? i1 : bi1; bi2 = better ? i2 : bi2; bw1 = better ? s1 : bw1; bw2 = better ? s2 : bw2;
            }
            const float inv = 1.f / (bw1 + bw2);
            const int lo = bi1 < bi2 ? bi1 : bi2, hi2 = bi1 < bi2 ? bi2 : bi1;
            const float wlo = (bi1 < bi2 ? bw1 : bw2) * inv, whi = (bi1 < bi2 ? bw2 : bw1) * inv;
            const int pidx = lo == 0 ? hi2 - 1 : (lo == 1 ? hi2 + 1 : 5);
            const int slot = c.wave * 64 + nr + c.lane;
            rcls[slot] = gb * 6 + pidx; rw1[slot] = wlo; rw2[slot] = whi; rrow[slot] = base + c.lane;
        }
        nr += ROWS_PER_WAVE;
        LDS_WAIT();
    }
    LDS_WAIT();
    if (!publish) return;
    int rank = 0, cls = 0;
    if (c.lane < nr) { cls = rcls[c.wave * 64 + c.lane]; rank = atomicAdd(&lcnt[cls], 1); }
    __syncthreads();
    if (c.tid < NCLS) lbase[c.tid] = (int)__hip_atomic_fetch_add((unsigned*)(a.ws + WS_CTL) + CW_CNT + l * 32 + c.tid, (unsigned)lcnt[c.tid], RLX_AGENT);
    __syncthreads();
    if (c.lane < nr) {
        const int pos = lbase[cls] + rank;
        ((int*)(a.ws + WS_LIST))[(size_t)cls * LISTCAP + pos] = rrow[c.wave * 64 + c.lane];
        float* rw = (float*)(a.ws + WS_RW) + ((size_t)cls * LISTCAP + pos) * 2;
        rw[0] = rw1[c.wave * 64 + c.lane]; rw[1] = rw2[c.wave * 64 + c.lane];
    }
}

DEVFN void ph_rows_g(const Args& a, const Ctx& c, int l) {
    const float* mod = (const float*)(a.ws + WS_MOD) + (size_t)l * NB * NMOD;
    const bf16_t* X1B = (const bf16_t*)(a.ws + WS_X1B); const unsigned char* Y2 = (const unsigned char*)(a.ws + WS_AD);
    bf16_t* X2B = (bf16_t*)(a.ws + WS_X2B); bf16_t* HB = (bf16_t*)(a.ws + WS_HB);
    for (int base = c.gw * ROWS_PER_WAVE; base < NTOK; base += c.NGW * ROWS_PER_WAVE) {
        const float* mb = mod + (size_t)(base >> 11) * NMOD; const float* mb1 = mb + (size_t)NB * NMOD;
        f32x4 g2[4], lg[4], lb[4], sc[4], sh[4];
        vec_load(mb + 5 * DM, c.lane, g2); vec_load(a.in[I_LN2G] + l * DM, c.lane, lg); vec_load(a.in[I_LN2B] + l * DM, c.lane, lb);
        if (l == 0) { vec_load(mb1 + DM, c.lane, sc); vec_load(mb1, c.lane, sh); }
        u32x2 xc[4], xn[4]; unsigned yc[4], yn[4];
        bfrow_load(X1B + (size_t)base * DM, c.lane, xc);
#pragma unroll
        for (int j = 0; j < 4; ++j) yc[j] = *(const unsigned*)(Y2 + (size_t)base * DM + 4 * c.lane + 256 * j);
#pragma unroll 1
        for (int i = 0; i < ROWS_PER_WAVE; ++i) {
            const int m = base + i;
            if (i + 1 < ROWS_PER_WAVE) { bfrow_load(X1B + (size_t)(m + 1) * DM, c.lane, xn);
#pragma unroll
                for (int j = 0; j < 4; ++j) yn[j] = *(const unsigned*)(Y2 + (size_t)(m + 1) * DM + 4 * c.lane + 256 * j); }
            f32x4 v[4];
#pragma unroll
            for (int j = 0; j < 4; ++j) v[j] = bf4(xc[j]) * ALPHA + g2[j] * f8x4_to_f32(yc[j], 1.f / YSCALE);
            ln_aff(v, lg, lb);
            if (l == 0) { bfrow_store(X2B + (size_t)m * DM, c.lane, v); ln_mod(v, sc, sh); f8row_store((unsigned char*)HB + (size_t)m * DM, c.lane, v); }
            else {
#pragma unroll
                for (int j = 0; j < 4; ++j) *(f32x4*)(a.out + (size_t)m * DM + 4 * c.lane + 256 * j) = v[j]; }
#pragma unroll
            for (int j = 0; j < 4; ++j) { xc[j] = xn[j]; yc[j] = yn[j]; }
        }
    }
}

constexpr int MOETAB_OFF = 131072 + 512;
DEVFN void ph_inproj_fast(const Args& a, const Ctx& c, int l, bool dummy_kbar) {
    pg8::DenseSched S; S.so.init(NTOK, DIN, c.G, c.bid); S.A = (const char*)(a.ws + WS_HB); S.Bt = (const char*)(a.ws + WS_WIN) + (size_t)l * DIN * DM; S.lda = DM; S.ldb = DM;
    const pg8::EpiInproj E{(bf16_t*)(a.ws + WS_QKVP), (const float*)(a.ws + WS_ROPE), (dummy_kbar ? (float*)(a.ws + WS_RW) : (float*)(a.ws + WS_KBAR)) + (size_t)l * NB * NH * NBLK * HD};
    pg8::gemm_phase2<pg8::EpiInproj, pg8::DenseSched, true, true, false, true, 127 - 5, 127>(c.lds3, DM, DM, S, E, c.tid);
}
DEVFN void ph_wout_fast(const Args& a, const Ctx& c, int l) {
    pg8::DenseSched S; S.so.init(NTOK, DM, c.G, c.bid); S.A = (const char*)(a.ws + WS_AD); S.Bt = (const char*)(a.ws + WS_WOUT) + (size_t)l * DM * DM; S.lda = DM; S.ldb = DM;
    const pg8::EpiF8 E{(unsigned char*)(a.ws + WS_QKVP), DM};
    pg8::gemm_phase2<pg8::EpiF8, pg8::DenseSched, true, true, false, true, 127 - 5, 127 - 5, true, 127 - 7, 127>(c.lds3, DM, DM, S, E, c.tid);
}
DEVFN void moe_table_lds(const Args& a, const Ctx& c, int l) {
    int* cnt = (int*)(c.lds + MOETAB_OFF); int* tp = cnt + 32;
    if (c.tid < NCLS) cnt[c.tid] = (int)__hip_atomic_load((unsigned*)(a.ws + WS_CTL) + CW_CNT + l * 32 + c.tid, RLX_AGENT);
    __syncthreads();
    if (c.tid == 0) { int s = 0; for (int k = 0; k < NCLS; ++k) { tp[k] = s; s += (cnt[k] + 255) >> 8; } tp[NCLS] = s; }
    __syncthreads();
}
DEVFN void ph_gateup_fast(const Args& a, const Ctx& c, int l) {
    moe_table_lds(a, c, l);
    pg8::GateUpSched S; S.cnt = (const LAS int*)(c.lds3 + MOETAB_OFF); S.tp = S.cnt + 32; S.npn_shift = 3; S.nunits = S.tp[NCLS] * 8; S.G = c.G; S.c = (c.G % 8 == 0) ? (c.bid % 8) * (c.G / 8) + c.bid / 8 : c.bid;
    S.HB = (const char*)(a.ws + WS_HB); S.list = (const int*)(a.ws + WS_LIST); S.W = (const char*)(a.ws + WS_WGU) + (size_t)l * NE * DM * DM;
    const pg8::EpiGateUp E{(unsigned char*)(a.ws + WS_QKVP), (const float*)(a.ws + WS_RW)};
    pg8::gemm_phase2<pg8::EpiGateUp, pg8::GateUpSched, true, true, false, true, 127 - 5, 127>(c.lds3, DM, DM, S, E, c.tid);
}
DEVFN void ph_down_fast(const Args& a, const Ctx& c, int l) {
    moe_table_lds(a, c, l);
    pg8::DownSched S; S.cnt = (const LAS int*)(c.lds3 + MOETAB_OFF); S.tp = S.cnt + 32; S.npn_shift = 2; S.nunits = S.tp[NCLS] * 4; S.G = c.G; S.c = (c.G % 8 == 0) ? (c.bid % 8) * (c.G / 8) + c.bid / 8 : c.bid;
    S.ACT = (const char*)(a.ws + WS_QKVP); S.W = (const char*)(a.ws + WS_WD) + (size_t)l * NE * DM * DE;
    const pg8::EpiDown E{(unsigned char*)(a.ws + WS_AD), (const int*)(a.ws + WS_LIST)};
    pg8::gemm_phase2<pg8::EpiDown, pg8::DownSched, true, true, true, true, 127 - 5, 127 - 3>(c.lds3, DM, DE, S, E, c.tid);
}

#ifndef MK_N_LAUNCHES
#define MK_N_LAUNCHES 1
#endif
constexpr int RING_BYTES = 131072, LDSCTL_OFF = RING_BYTES, MISC_OFF = LDSCTL_OFF + 320, LDS_BYTES = 147456;
constexpr int PH_PER_LAYER = 7, NPHASE = 2 + 2 * PH_PER_LAYER;
constexpr int CW_BAR = 4096;
static_assert((CW_BAR + XCD_BAR_WORDS) * 4 <= (int)CTL_ZERO_BYTES, "CTL");

__global__ void __launch_bounds__(512, 2) fwd(Args a) {
    extern __shared__ __attribute__((aligned(16))) unsigned char lds[];
    const int wave_s = __builtin_amdgcn_readfirstlane(threadIdx.x >> 6);
#define MKTID() (wave_s * 64 + lane_id_volatile())
#define MKCTX() Args al = a; { size_t z_ = 0; asm volatile("" : "+s"(z_)); al.ws = a.ws + z_; } Ctx c; {     int t_ = MKTID(); asm volatile("" : "+v"(t_)); c.lds = lds; c.lds3 = (LAS unsigned char*)lds; c.tid = t_; c.lane = t_ & 63; c.wave = __builtin_amdgcn_readfirstlane(t_ >> 6); c.G = gridDim.x; c.bid = blockIdx.x; c.gw = c.bid * 8 + c.wave; c.NGW = c.G * 8; }
    const int lo = a.ph_lo, hi = a.ph_hi;
    const bool one = (hi - lo) > 1;
    for (int u = threadIdx.x; u < (LDS_BYTES - LDSCTL_OFF) / 4; u += 512) ((LAS unsigned*)((LAS unsigned char*)lds + LDSCTL_OFF))[u] = 0u;
    __syncthreads();
    XcdBarrier bar; bar.bar = (unsigned*)(a.ws + WS_CTL) + CW_BAR; bar.x = 0; bar.st = nullptr;
    if (one) bar = xcd_barrier_post((unsigned*)(a.ws + WS_CTL) + CW_BAR, (volatile LAS unsigned*)((LAS unsigned char*)lds + MISC_OFF) + 8);
#ifndef REP_PHASE
#define REP_PHASE -1
#endif
#define IN(k) (lo <= (k) && (k) < hi)
#define SEAM(k) do { if (IN(k) && IN((k) + 1)) { XcdBarrier bl_ = bar; { size_t z_ = 0; unsigned x_ = bar.x; asm volatile("" : "+s"(z_), "+s"(x_)); bl_.bar = bar.bar + z_; bl_.x = x_; } xcd_barrier(bl_, MKTID() == 0); } } while (0)
    if (IN(0)) { MKCTX(); ph_prologue(al, c); if (REP_PHASE == 0) { __syncthreads(); ph_prologue(al, c); } SEAM(0); }
    if (IN(1)) { MKCTX(); ph_h1_rows(al, c); if (REP_PHASE == 1) ph_h1_rows(al, c); SEAM(1); }
    {
        constexpr int l = 0; constexpr int p0 = 2 + l * PH_PER_LAYER;
        if (IN(p0 + 0)) { MKCTX(); ph_inproj_fast(al, c, l, false); if (REP_PHASE == 10) { __syncthreads(); ph_inproj_fast(al, c, l, true); } SEAM(p0 + 0); }
        if (IN(p0 + 1)) {
            { MKCTX(); ph_pool(al, c); }
            __syncthreads();
            const attn_body::AttnTensors AT{(const attn_body::bf16*)(a.ws + WS_QKVP), (const attn_body::bf16*)(a.ws + WS_QKVP) + 512, (const attn_body::bf16*)(a.ws + WS_QKVP) + 1024,
                                            (attn_body::bf16*)(a.ws + WS_AD), (const float*)(a.ws + WS_KBAR) + (size_t)l * NB * NH * NBLK * HD};
            const attn_body::StaticOrder S((int)gridDim.x, (int)blockIdx.x);
            attn_body::attn_phase<attn_body::StaticOrder>((char*)lds, AT, S, MKTID());
            if (REP_PHASE == 11) attn_body::attn_phase<attn_body::StaticOrder>((char*)lds, AT, S, MKTID());
            if (REP_PHASE == 17) { __syncthreads(); MKCTX(); ph_pool(al, c); }
            SEAM(p0 + 1);
        }
        if (IN(p0 + 2)) { MKCTX(); ph_wout_fast(al, c, l); if (REP_PHASE == 12) { __syncthreads(); ph_wout_fast(al, c, l); } SEAM(p0 + 2); }
        if (IN(p0 + 3)) { MKCTX(); if (REP_PHASE == 13) { ph_rows_c(al, c, l, false); __syncthreads(); } ph_rows_c(al, c, l, true); SEAM(p0 + 3); }
        if (IN(p0 + 4)) { MKCTX(); ph_gateup_fast(al, c, l); if (REP_PHASE == 14) { __syncthreads(); ph_gateup_fast(al, c, l); } SEAM(p0 + 4); }
        if (IN(p0 + 5)) { MKCTX(); ph_down_fast(al, c, l); if (REP_PHASE == 15) { __syncthreads(); ph_down_fast(al, c, l); } SEAM(p0 + 5); }
        if (IN(p0 + 6)) { MKCTX(); ph_rows_g(al, c, l); if (REP_PHASE == 16) ph_rows_g(al, c, l); SEAM(p0 + 6); }
    }
    {
        constexpr int l = 1; constexpr int p0 = 2 + l * PH_PER_LAYER;
        if (IN(p0 + 0)) { MKCTX(); ph_inproj_fast(al, c, l, false); if (REP_PHASE == 10) { __syncthreads(); ph_inproj_fast(al, c, l, true); } SEAM(p0 + 0); }
        if (IN(p0 + 1)) {
            { MKCTX(); ph_pool(al, c); }
            __syncthreads();
            const attn_body::AttnTensors AT{(const attn_body::bf16*)(a.ws + WS_QKVP), (const attn_body::bf16*)(a.ws + WS_QKVP) + 512, (const attn_body::bf16*)(a.ws + WS_QKVP) + 1024,
                                            (attn_body::bf16*)(a.ws + WS_AD), (const float*)(a.ws + WS_KBAR) + (size_t)l * NB * NH * NBLK * HD};
            const attn_body::StaticOrder S((int)gridDim.x, (int)blockIdx.x);
            attn_body::attn_phase<attn_body::StaticOrder>((char*)lds, AT, S, MKTID());
            if (REP_PHASE == 11) attn_body::attn_phase<attn_body::StaticOrder>((char*)lds, AT, S, MKTID());
            if (REP_PHASE == 17) { __syncthreads(); MKCTX(); ph_pool(al, c); }
            SEAM(p0 + 1);
        }
        if (IN(p0 + 2)) { MKCTX(); ph_wout_fast(al, c, l); if (REP_PHASE == 12) { __syncthreads(); ph_wout_fast(al, c, l); } SEAM(p0 + 2); }
        if (IN(p0 + 3)) { MKCTX(); if (REP_PHASE == 13) { ph_rows_c(al, c, l, false); __syncthreads(); } ph_rows_c(al, c, l, true); SEAM(p0 + 3); }
        if (IN(p0 + 4)) { MKCTX(); ph_gateup_fast(al, c, l); if (REP_PHASE == 14) { __syncthreads(); ph_gateup_fast(al, c, l); } SEAM(p0 + 4); }
        if (IN(p0 + 5)) { MKCTX(); ph_down_fast(al, c, l); if (REP_PHASE == 15) { __syncthreads(); ph_down_fast(al, c, l); } SEAM(p0 + 5); }
        if (IN(p0 + 6)) { MKCTX(); ph_rows_g(al, c, l); if (REP_PHASE == 16) ph_rows_g(al, c, l); SEAM(p0 + 6); }
    }
#undef IN
#undef SEAM
}

extern "C" void kernel_launch(void* const* d_in, const int* in_sizes, int n_in, void* d_out, int out_size, void* d_ws, size_t ws_size, hipStream_t stream) {
    static int grid = 0;
    if (grid == 0) {
        if (n_in != 17 || out_size != NTOK * DM || ws_size < WS_END) { fprintf(stderr, "kernel_launch: unexpected problem (n_in %d out %d ws %zu)\n", n_in, out_size, ws_size); grid = -1; return; }
        if (hipFuncSetAttribute((const void*)fwd, hipFuncAttributeMaxDynamicSharedMemorySize, LDS_BYTES) != hipSuccess) { fprintf(stderr, "kernel_launch: hipFuncSetAttribute failed\n"); grid = -1; return; }
        int dev = 0, cus = 0, per_cu = 0;
        (void)hipGetDevice(&dev); (void)hipDeviceGetAttribute(&cus, hipDeviceAttributeMultiprocessorCount, dev);
        if (hipOccupancyMaxActiveBlocksPerMultiprocessor(&per_cu, (const void*)fwd, 512, LDS_BYTES) != hipSuccess || per_cu < 1) fprintf(stderr, "kernel_launch: occupancy query reports %d workgroups per CU\n", per_cu);
        (void)hipGetLastError();
        grid = cus > 0 ? cus : 256;
    }
    if (grid < 0) return;
    (void)hipMemsetAsync((char*)d_ws + WS_CTL, 0, CTL_ZERO_BYTES, stream);
    Args a{};
    for (int i = 0; i < 17; ++i) a.in[i] = (const float*)d_in[i];
    a.out = (float*)d_out; a.ws = (unsigned char*)d_ws;
#if MK_N_LAUNCHES == 1
    a.ph_lo = 0; a.ph_hi = NPHASE; hipLaunchKernelGGL(fwd, dim3(grid), dim3(512), LDS_BYTES, stream, a);
#else
    for (int p = 0; p < NPHASE; ++p) { a.ph_lo = p; a.ph_hi = p + 1; hipLaunchKernelGGL(fwd, dim3(grid), dim3(512), LDS_BYTES, stream, a); }
#endif
}
```

```cpp
#include <hip/hip_runtime.h>
#include <cstdint>
#include <cstdio>

constexpr int NB = 16, SEQ = 2048, DM = 1024, NTOK = NB * SEQ, DIN = 2048, NH = 8, HD = 64, NBLK = 8, MBLK = 256;
constexpr int NE = 16, NCLS = 24, DE = 512, NMOD = 6 * DM;
constexpr float ALPHA = 1.41421356237309515f, LN_EPS = 1e-5f;
constexpr float QSCALE = 0.125f * 1.4426950408889634f;
constexpr int LISTCAP = NTOK;

constexpr size_t MiB = 1u << 20;
constexpr size_t WS_CTL = 0, CTL_ZERO_BYTES = 1 * MiB;
constexpr size_t WS_MOD = 1 * MiB;
constexpr size_t WS_ROPE = 2 * MiB;
constexpr size_t WS_KBAR = 2 * MiB + 256 * 1024;
constexpr size_t WS_LIST = 3 * MiB;
constexpr size_t WS_RW = 6 * MiB;
constexpr size_t WS_WIN = 12 * MiB;
constexpr size_t WS_WOUT = 20 * MiB;
constexpr size_t WS_WGU = 24 * MiB;
constexpr size_t WS_WD = 88 * MiB;
constexpr size_t WS_HB = 120 * MiB;
constexpr size_t WS_QKVP = 184 * MiB;
constexpr size_t WS_AD = 312 * MiB;
constexpr size_t WS_X1 = 376 * MiB;
constexpr size_t WS_END = 504 * MiB;
constexpr int CW_TMO = 0, CW_CNT = 64;

typedef unsigned short bf16_t;
typedef short bf16x8 __attribute__((ext_vector_type(8)));
typedef float f32x4 __attribute__((ext_vector_type(4)));
typedef float f32x16 __attribute__((ext_vector_type(16)));
typedef unsigned u32x4 __attribute__((ext_vector_type(4)));
typedef unsigned u32x2 __attribute__((ext_vector_type(2)));

#define DEVFN __device__ __forceinline__
#define LDS_WAIT() asm volatile("s_waitcnt lgkmcnt(0)" ::: "memory")
#define RLX_AGENT __ATOMIC_RELAXED, __HIP_MEMORY_SCOPE_AGENT

DEVFN float bf_lo(unsigned w) { return __uint_as_float(w << 16); }
DEVFN float bf_hi(unsigned w) { return __uint_as_float(w & 0xffff0000u); }
DEVFN float bf2f(bf16_t v) { return __uint_as_float((unsigned)v << 16); }
DEVFN unsigned f2bf(float f) { unsigned u = __float_as_uint(f); return (u + 0x7fffu + ((u >> 16) & 1u)) >> 16; }
DEVFN unsigned pk2(float lo, float hi) { unsigned r; asm("v_cvt_pk_bf16_f32 %0, %1, %2" : "=v"(r) : "v"(lo), "v"(hi)); return r; }
DEVFN unsigned pk4_fp8(float a, float b, float c, float d) {
    a = __builtin_amdgcn_fmed3f(a, -448.f, 448.f); b = __builtin_amdgcn_fmed3f(b, -448.f, 448.f); c = __builtin_amdgcn_fmed3f(c, -448.f, 448.f); d = __builtin_amdgcn_fmed3f(d, -448.f, 448.f);
    unsigned w = 0u; w = __builtin_amdgcn_cvt_pk_fp8_f32(a, b, w, false); w = __builtin_amdgcn_cvt_pk_fp8_f32(c, d, w, true); return w; }
DEVFN f32x4 f8x4_to_f32(unsigned w, float sc) { const auto lo = __builtin_amdgcn_cvt_pk_f32_fp8(w, false), hi = __builtin_amdgcn_cvt_pk_f32_fp8(w, true); return (f32x4){lo[0] * sc, lo[1] * sc, hi[0] * sc, hi[1] * sc}; }
constexpr float YSCALE = 16.f;
DEVFN int crow(int r, int hi) { return (r & 3) + 8 * (r >> 2) + 4 * hi; }
#define SWZ_XOR(m) (0x1f | ((m) << 10))
DEVFN float swz_xor_add(float v, const int m) {
    switch (m) {
        case 1: return v + __int_as_float(__builtin_amdgcn_ds_swizzle(__float_as_int(v), SWZ_XOR(1)));
        case 2: return v + __int_as_float(__builtin_amdgcn_ds_swizzle(__float_as_int(v), SWZ_XOR(2)));
        case 4: return v + __int_as_float(__builtin_amdgcn_ds_swizzle(__float_as_int(v), SWZ_XOR(4)));
        case 8: return v + __int_as_float(__builtin_amdgcn_ds_swizzle(__float_as_int(v), SWZ_XOR(8)));
        default: return v + __int_as_float(__builtin_amdgcn_ds_swizzle(__float_as_int(v), SWZ_XOR(16)));
    }
}
DEVFN float half_swap_add(float v) { auto rr = __builtin_amdgcn_permlane32_swap(__float_as_uint(v), __float_as_uint(v), false, false); return __uint_as_float(rr[0]) + __uint_as_float(rr[1]); }
DEVFN float wave_sum(float v) {
    v = swz_xor_add(v, 1); v = swz_xor_add(v, 2); v = swz_xor_add(v, 4); v = swz_xor_add(v, 8); v = swz_xor_add(v, 16);
    return half_swap_add(v);
}
__host__ __device__ __forceinline__ int inproj_lgroup(int P) { return P < 16 ? (P >> 2) * 8 + (P & 3) * 2 : ((P - 16) >> 2) * 8 + ((P - 16) & 3) * 2 + 1; }
__host__ __device__ __forceinline__ int inproj_nlog(int n) { return (n & ~255) + inproj_lgroup((n & 255) >> 3) * 8 + (n & 7); }

#define GAS __attribute__((address_space(1)))
#define LAS __attribute__((address_space(3)))
typedef GAS unsigned gu32;
namespace pg8 {
#define PG8_LAS __attribute__((address_space(3)))
typedef unsigned short bf16_t;
typedef short bf16x8 __attribute__((ext_vector_type(8)));
typedef float f32x4 __attribute__((ext_vector_type(4)));
typedef unsigned u32x4 __attribute__((ext_vector_type(4)));
constexpr int BM = 256, BK = 64, HALF = 128, HTB = HALF * BK * 2  , STAGE_BYTES = 8 * HTB, NXCD = 8, WGM = 8;

__host__ __device__ __forceinline__ int lds_byte(int r, int c) { const int st = (r >> 4) * 2 + (c >> 5), rr = r & 15, cc = c & 31, ob = rr * 64 + cc * 2; return st * 1024 + (ob ^ (((ob >> 9) & 1) << 5)); }
__host__ __device__ __forceinline__ void stage_rc(int b, int& R, int& C) { const int st = b / 1024, sb = b % 1024, swz = sb ^ (((sb >> 9) & 1) << 5); R = (st >> 1) * 16 + swz / 64; C = (st & 1) * 32 + (swz % 64) / 2; }
__host__ __device__ __forceinline__ int perm32(int rho) { const int n = rho >> 4, i = rho & 15; return 8 * (i >> 2) + 4 * n + (i & 3); }

struct Unit { int pm, pn; };
struct Gemm { const bf16_t* A; const bf16_t* Bt; int M, N, K; };

struct StaticOrder {
    int nM, nN, nwg, G, c;
    __host__ __device__ void init(int M, int N, int G_, int c_) { nM = M / BM; nN = N / BM; nwg = nM * nN; G = G_; c = c_; }
    __host__ __device__ bool next(int i, Unit& u) const {
        const long L = (long)i * G + c; if (L >= nwg) return false;
        int wgid = (int)L; { const int q = nwg / NXCD, r = nwg % NXCD, xcd = wgid % NXCD, off = wgid / NXCD; wgid = (xcd < r ? xcd * (q + 1) : r * (q + 1) + (xcd - r) * q) + off; }
        const int nig = WGM * nN, gid = wgid / nig, fm = gid * WGM, gsz = (nM - fm) < WGM ? (nM - fm) : WGM;
        u.pm = fm + ((wgid % nig) % gsz); u.pn = (wgid % nig) / gsz; return true;
    }
    __device__ __forceinline__ void a_ready(const Unit&) const {}
    __device__ __forceinline__ void done(const Unit&) const {}
};

__device__ __forceinline__ unsigned cvt_pk_bf16(float lo, float hi) { unsigned r; asm volatile("v_cvt_pk_bf16_f32 %0, %1, %2" : "=v"(r) : "v"(lo), "v"(hi)); return r; }
}
namespace pg8 {
typedef int v8i_t __attribute__((ext_vector_type(8))); typedef int v4i_t __attribute__((ext_vector_type(4)));
__device__ __forceinline__ int pg8_lane_volatile() { int l; asm volatile("v_mbcnt_lo_u32_b32 %0, -1, 0\n\tv_mbcnt_hi_u32_b32 %0, -1, %0" : "=v"(l)); return l; }
template <class Epi, class Sched, bool ALIGN_EPI, bool GATHER, bool KSPLIT, bool FP8 = false, int SCW = 127, int SCA = 127, bool SC2 = false, int SCW2 = 127, int SCA2 = 127>
__device__ __forceinline__ void gemm_phase2(PG8_LAS unsigned char* lds, const int Kbytes, const int ldb_bytes, const Sched& S, const Epi& E, const int tid) {
    typedef typename Sched::UnitT UnitT;
    const int wid = __builtin_amdgcn_readfirstlane(tid >> 6), lane = tid & 63, wr = wid >> 2, wc = wid & 3, fr = lane & 15, fq = lane >> 4;
    int nt = Kbytes / (BK * 2); asm volatile("" : "+s"(nt));
    const int nth = nt / 2;
    unsigned voffB[2];
#pragma unroll
    for (int i = 0; i < 2; ++i) { int R[2], C[2]; stage_rc(tid * 16 + i * 8192, R[i], C[i]); const int Rb = Epi::PERM ? ((R[i] & ~31) + perm32(R[i] & 31)) : R[i]; voffB[i] = (unsigned)(Rb * ldb_bytes + C[i] * 2); }
    const size_t kstep = (size_t)(BK * 2);
    const size_t hstepB = (size_t)HALF * ldb_bytes;
    const unsigned ldsw = (unsigned)wid * 1024u;
    const int aoff = lds_byte(wr * 64 + fr, fq * 8), boff = lds_byte(wc * 32 + fr, fq * 8);
#define PG8_SA(b, h) (((b) * 2 + (h)) * HTB)
#define PG8_SB(b, h) ((4 + (b) * 2 + (h)) * HTB)
#define PG8_STAGE(bufoff, gbase, voff) do { _Pragma("unroll") for (int _i = 0; _i < 2; ++_i) \
        __builtin_amdgcn_global_load_lds((const unsigned*)((const char*)(gbase) + (voff)[_i]), (PG8_LAS unsigned*)(lds + (bufoff) + ldsw + _i * 8192), 16, 0, 0); } while (0)
#define PG8_LDA(dst, b, h) do { _Pragma("unroll") for (int m = 0; m < 4; ++m) _Pragma("unroll") for (int k = 0; k < 2; ++k) dst[m][k] = *(const PG8_LAS bf16x8*)(lds + PG8_SA(b, h) + aoff + m * 2048 + k * 1024); } while (0)
#define PG8_LDB(dst, b, h) do { _Pragma("unroll") for (int n = 0; n < 2; ++n) _Pragma("unroll") for (int k = 0; k < 2; ++k) dst[n][k] = *(const PG8_LAS bf16x8*)(lds + PG8_SB(b, h) + boff + n * 2048 + k * 1024); } while (0)
#define PG8_CAT8(x) __builtin_shufflevector(__builtin_bit_cast(v4i_t, (x)[0]), __builtin_bit_cast(v4i_t, (x)[1]), 0, 1, 2, 3, 4, 5, 6, 7)
#define PG8_MMA(ai, bj, At, Bt) do { __builtin_amdgcn_s_setprio(1); \
        if constexpr (FP8) { _Pragma("unroll") for (int m = 0; m < 4; ++m) _Pragma("unroll") for (int n = 0; n < 2; ++n) \
            acc[ai][bj][m][n] = __builtin_amdgcn_mfma_scale_f32_16x16x128_f8f6f4(PG8_CAT8(Bt[n]), PG8_CAT8(At[m]), acc[ai][bj][m][n], 0, 0, 0, scw_, 0, sca_); } \
        else { _Pragma("unroll") for (int m = 0; m < 4; ++m) _Pragma("unroll") for (int n = 0; n < 2; ++n) _Pragma("unroll") for (int k = 0; k < 2; ++k) \
            acc[ai][bj][m][n] = __builtin_amdgcn_mfma_f32_16x16x32_bf16(Bt[n][k], At[m][k], acc[ai][bj][m][n], 0, 0, 0); } \
        __builtin_amdgcn_s_setprio(0); } while (0)
#define PG8_WAIT_V(n) asm volatile("s_waitcnt vmcnt(" #n ")" ::: "memory")
#define PG8_WAIT_L(n) asm volatile("s_waitcnt lgkmcnt(" #n ")" ::: "memory")
#define PG8_BAR __builtin_amdgcn_s_barrier()
#define PG8_SCHED __builtin_amdgcn_sched_barrier(0)
#define PG8_PIN(ai) asm volatile("" :: "v"(acc[ai][0][0][0]), "v"(acc[ai][0][0][1]), "v"(acc[ai][0][1][0]), "v"(acc[ai][0][1][1]), "v"(acc[ai][0][2][0]), "v"(acc[ai][0][2][1]), "v"(acc[ai][0][3][0]), "v"(acc[ai][0][3][1]), \
        "v"(acc[ai][1][0][0]), "v"(acc[ai][1][0][1]), "v"(acc[ai][1][1][0]), "v"(acc[ai][1][1][1]), "v"(acc[ai][1][2][0]), "v"(acc[ai][1][2][1]), "v"(acc[ai][1][3][0]), "v"(acc[ai][1][3][1]))
#define PG8_BK(cb, cb2, kt) ((KSPLIT && (kt) >= nth) ? (cb2) + (size_t)((kt) - nth) * kstep : (cb) + (size_t)(kt) * kstep)
    UnitT cur, nxt; int ui = 0;
    if (!S.next(0, cur)) return;
    f32x4 acc[2][2][4][2];
#pragma unroll
    for (int a = 0; a < 2; ++a)
#pragma unroll
        for (int b = 0; b < 2; ++b)
#pragma unroll
            for (int m = 0; m < 4; ++m)
#pragma unroll
                for (int n = 0; n < 2; ++n) acc[a][b][m][n] = (f32x4){0.f, 0.f, 0.f, 0.f};
    bf16x8 At[4][2], B0[2][2], B1[2][2];
    unsigned vA[2][2];
    S.arows(cur, tid, vA);
    PG8_LAS u32x4* const vslot = (PG8_LAS u32x4*)(lds + STAGE_BYTES + 1024) + tid;
    const char* cA = S.aptr(cur); const char* cB = S.bptr(cur); const char* cB2 = KSPLIT ? S.bptr2(cur) : cB;
    PG8_STAGE(PG8_SB(0, 0), cB, voffB); PG8_STAGE(PG8_SB(0, 1), cB + hstepB, voffB); PG8_STAGE(PG8_SA(0, 0), cA, vA[0]); PG8_STAGE(PG8_SA(0, 1), cA, vA[1]);
    if (wr == 1) PG8_BAR;
    PG8_WAIT_V(2); PG8_BAR;
    PG8_STAGE(PG8_SB(1, 0), PG8_BK(cB, cB2, 1), voffB); PG8_STAGE(PG8_SA(1, 0), cA + kstep, vA[0]); PG8_STAGE(PG8_SB(1, 1), PG8_BK(cB, cB2, 1) + hstepB, voffB);
    PG8_WAIT_V(6); PG8_BAR;
    for (;;) {
        const bool has_next = S.next(ui + 1, nxt);
        const char* nA = has_next ? S.aptr(nxt) : cA; const char* nB = has_next ? S.bptr(nxt) : cB; const char* nB2 = (KSPLIT && has_next) ? S.bptr2(nxt) : cB2;
        if (GATHER && has_next) { unsigned vn_[2][2]; S.arows(nxt, wid * 64 + pg8_lane_volatile(), vn_); *vslot = (u32x4){vn_[0][0], vn_[0][1], vn_[1][0], vn_[1][1]}; }
        for (int t = 0; t < nt; t += 2) {
            const bool last = (t == nt - 2);
            const int scw_ = ((SC2 && t >= nth) ? SCW2 : SCW) * 0x01010101, sca_ = ((SC2 && t >= nth) ? SCA2 : SCA) * 0x01010101; (void)scw_; (void)sca_;
            const char* a1 = cA + (size_t)(t + 1) * kstep;
            const char* a2 = last ? nA : cA + (size_t)(t + 2) * kstep;
            const char* b2 = last ? nB : PG8_BK(cB, cB2, t + 2);
            const char* b3 = last ? (KSPLIT ? PG8_BK(nB, nB2, 1) : nB + kstep) : PG8_BK(cB, cB2, t + 3);
            const char* a3 = a2 + kstep;
            PG8_LDB(B0, 0, 0); PG8_LDB(B1, 0, 1); PG8_SCHED; PG8_LDA(At, 0, 0); PG8_STAGE(PG8_SA(1, 1), a1, vA[1]);
            PG8_WAIT_V(8); PG8_WAIT_L(0); PG8_BAR; PG8_MMA(0, 0, At, B0); PG8_MMA(0, 1, At, B1); PG8_PIN(0); PG8_BAR; PG8_SCHED;
            if (GATHER && last && has_next) { const u32x4 vn_ = *vslot; vA[0][0] = vn_.x; vA[0][1] = vn_.y; vA[1][0] = vn_.z; vA[1][1] = vn_.w; }
            PG8_LDA(At, 0, 1); PG8_STAGE(PG8_SB(0, 0), b2, voffB); PG8_STAGE(PG8_SB(0, 1), b2 + hstepB, voffB); PG8_STAGE(PG8_SA(0, 0), a2, vA[0]);
            PG8_WAIT_V(8); PG8_WAIT_L(0); PG8_BAR; PG8_MMA(1, 0, At, B0); PG8_MMA(1, 1, At, B1); PG8_PIN(1); PG8_BAR; PG8_SCHED;
            PG8_LDB(B0, 1, 0); PG8_LDB(B1, 1, 1); PG8_SCHED; PG8_LDA(At, 1, 0); PG8_STAGE(PG8_SA(0, 1), a2, vA[1]);
            PG8_WAIT_V(8); PG8_WAIT_L(0); PG8_BAR; PG8_MMA(0, 0, At, B0); PG8_MMA(0, 1, At, B1); PG8_PIN(0); PG8_BAR; PG8_SCHED;
            PG8_LDA(At, 1, 1); PG8_STAGE(PG8_SB(1, 0), b3, voffB); PG8_STAGE(PG8_SB(1, 1), b3 + hstepB, voffB); PG8_STAGE(PG8_SA(1, 0), a3, vA[0]);
            PG8_WAIT_V(8); PG8_WAIT_L(0); PG8_BAR; PG8_MMA(1, 0, At, B0); PG8_MMA(1, 1, At, B1); PG8_PIN(1); PG8_BAR; PG8_SCHED;
        }
        if constexpr (ALIGN_EPI) { if (wr == 0) PG8_BAR; }
        if constexpr (!Epi::AFTER_DRAIN) { const int le_ = pg8_lane_volatile(); E(acc, cur, wr, wc, le_ & 15, le_ >> 4); }
        if (!has_next) break;
#pragma unroll
        for (int a = 0; a < 2; ++a)
#pragma unroll
            for (int b = 0; b < 2; ++b)
#pragma unroll
                for (int m = 0; m < 4; ++m)
#pragma unroll
                    for (int n = 0; n < 2; ++n) acc[a][b][m][n] = (f32x4){0.f, 0.f, 0.f, 0.f};
        cur = nxt; cA = nA; cB = nB; cB2 = nB2; ++ui;
        if constexpr (ALIGN_EPI) { if (wr == 1) PG8_BAR; }
    }
    PG8_WAIT_V(0);
    if constexpr (!ALIGN_EPI) { if (wr == 0) PG8_BAR; }
    PG8_BAR;
    if constexpr (Epi::AFTER_DRAIN) { E.fused(acc, cur, wr, wc, fr, fq, lds, wid, lane); }
#undef PG8_SA
#undef PG8_SB
#undef PG8_STAGE
#undef PG8_LDA
#undef PG8_LDB
#undef PG8_MMA
#undef PG8_WAIT_V
#undef PG8_WAIT_L
#undef PG8_BAR
#undef PG8_SCHED
#undef PG8_BK
#undef PG8_PIN
#undef PG8_CAT8
}
}
namespace pg8 {
DEVFN unsigned pkbf(float lo, float hi) { return cvt_pk_bf16(lo, hi); }
struct DenseSched {
    typedef Unit UnitT;
    StaticOrder so; const char* A; const char* Bt; int lda, ldb;
    DEVFN bool next(int i, Unit& u) const { return so.next(i, u); }
    DEVFN const char* aptr(const Unit&) const { return A; }
    DEVFN void arows(const Unit& u, const int tid_, unsigned (&v)[2][2]) const {
        int R[2], C[2]; { int t_ = tid_; asm volatile("" : "+v"(t_)); stage_rc(t_ * 16, R[0], C[0]); stage_rc(t_ * 16 + 8192, R[1], C[1]); }
#pragma unroll
        for (int h = 0; h < 2; ++h)
#pragma unroll
            for (int i = 0; i < 2; ++i) v[h][i] = (unsigned)((u.pm * BM + h * HALF + R[i]) * lda + C[i] * 2); }
    DEVFN const char* bptr(const Unit& u) const { return Bt + (size_t)u.pn * BM * ldb; }
    DEVFN const char* bptr2(const Unit& u) const { return bptr(u); }
};
struct EpiInproj {
    static constexpr bool PERM = true, AFTER_DRAIN = false;
    bf16_t* O; const float* rope; float* kbar;
    DEVFN void operator()(f32x4 (&acc)[2][2][4][2], const Unit& u, int wr, int wc, int fr, int fq) const {
        const int pn = u.pn, row0 = u.pm * BM + wr * 64 + fr;
        if (pn < 4 && fq == 0) {
#pragma unroll
            for (int ai = 0; ai < 2; ++ai)
#pragma unroll
                for (int m = 0; m < 4; ++m) { const int t = (row0 + ai * HALF + m * 16) & (SEQ - 1); const f32x4* rp = (const f32x4*)(rope + t * 16);
#pragma unroll
                    for (int q = 0; q < 4; ++q) { const f32x4 cs = rp[q];
                        { const int d = 2 * q, n = d >> 2, e = d & 3; const float x1 = acc[ai][0][m][n][e], x2 = acc[ai][1][m][n][e]; acc[ai][0][m][n][e] = x1 * cs[0] - x2 * cs[1]; acc[ai][1][m][n][e] = x2 * cs[0] + x1 * cs[1]; }
                        { const int d = 2 * q + 1, n = d >> 2, e = d & 3; const float x1 = acc[ai][0][m][n][e], x2 = acc[ai][1][m][n][e]; acc[ai][0][m][n][e] = x1 * cs[2] - x2 * cs[3]; acc[ai][1][m][n][e] = x2 * cs[2] + x1 * cs[3]; } } }
        }
        if (pn == 2 || pn == 3) {
            float* kb = kbar + (size_t)((((u.pm >> 3) * NH + (pn - 2) * 4 + wc) * NBLK + (u.pm & 7)) * HD);
#pragma unroll
            for (int bj = 0; bj < 2; ++bj)
#pragma unroll
                for (int n = 0; n < 2; ++n)
#pragma unroll
                    for (int e = 0; e < 4; ++e) { float s = 0.f;
#pragma unroll
                        for (int ai = 0; ai < 2; ++ai)
#pragma unroll
                            for (int m = 0; m < 4; ++m) s += acc[ai][bj][m][n][e];
                        s = swz_xor_add(s, 1); s = swz_xor_add(s, 2); s = swz_xor_add(s, 4); s = swz_xor_add(s, 8);
                        if (fr == 0) atomicAdd(kb + (2 * fq + bj) * 8 + 4 * n + e, s * (1.f / MBLK)); }
        }
        const float sc = pn < 2 ? QSCALE : 1.f;
#pragma unroll
        for (int ai = 0; ai < 2; ++ai)
#pragma unroll
            for (int m = 0; m < 4; ++m) { bf16_t* rowp = O + (size_t)(row0 + ai * HALF + m * 16) * DIN + pn * BM + wc * 64;
#pragma unroll
                for (int bj = 0; bj < 2; ++bj) { const f32x4 v0 = acc[ai][bj][m][0] * sc, v1 = acc[ai][bj][m][1] * sc;
                    u32x4 w; w.x = pkbf(v0[0], v0[1]); w.y = pkbf(v0[2], v0[3]); w.z = pkbf(v1[0], v1[1]); w.w = pkbf(v1[2], v1[3]);
                    *(u32x4*)(rowp + (2 * fq + bj) * 8) = w; } }
    }
};
struct EpiF8 {
    static constexpr bool PERM = true, AFTER_DRAIN = false;
    unsigned char* O; int ldc;
    DEVFN void operator()(f32x4 (&acc)[2][2][4][2], const Unit& u, int wr, int wc, int fr, int fq) const {
#pragma unroll
        for (int ai = 0; ai < 2; ++ai)
#pragma unroll
            for (int m = 0; m < 4; ++m) { unsigned char* rowp = O + (size_t)(u.pm * BM + ai * HALF + wr * 64 + m * 16 + fr) * ldc + u.pn * BM + wc * 32 + fq * 8;
#pragma unroll
                for (int bj = 0; bj < 2; ++bj) { const f32x4 v0 = acc[ai][bj][m][0] * YSCALE, v1 = acc[ai][bj][m][1] * YSCALE;
                    u32x2 w; w.x = pk4_fp8(v0[0], v0[1], v0[2], v0[3]); w.y = pk4_fp8(v1[0], v1[1], v1[2], v1[3]);
                    *(u32x2*)(rowp + bj * HALF) = w; } }
    }
};
struct MoeUnit { int pm, pn, cls, j, cnt; };
struct MoeBase {
    const PG8_LAS int* tp; const PG8_LAS int* cnt; int nunits, G, c, npn_shift;
    DEVFN bool next_(int i, MoeUnit& u) const {
        const int L = i * G + c; if (L >= nunits) return false;
        u.pm = L >> npn_shift; u.pn = L & ((1 << npn_shift) - 1);
        int cls = 0; while (u.pm >= __builtin_amdgcn_readfirstlane(tp[cls + 1])) ++cls;
        u.cls = cls; u.j = u.pm - __builtin_amdgcn_readfirstlane(tp[cls]); u.cnt = __builtin_amdgcn_readfirstlane(cnt[cls]); return true; }
};
DEVFN void moe_experts(int cls, int& e1, int& e2) { const int g = cls / 6, p = cls % 6; const int lo = p < 3 ? 0 : (p < 5 ? 1 : 2), hi = p < 3 ? p + 1 : (p < 5 ? p - 1 : 3); e1 = g * 4 + lo; e2 = g * 4 + hi; }
struct GateUpSched : MoeBase {
    typedef MoeUnit UnitT;
    const char* HB; const int* list; const char* W;
    DEVFN bool next(int i, MoeUnit& u) const { return next_(i, u); }
    DEVFN const char* aptr(const MoeUnit&) const { return HB; }
    DEVFN void arows(const MoeUnit& u, const int tid_, unsigned (&v)[2][2]) const {
        int R[2], C[2]; { int t_ = tid_; asm volatile("" : "+v"(t_)); stage_rc(t_ * 16, R[0], C[0]); stage_rc(t_ * 16 + 8192, R[1], C[1]); }
#pragma unroll
        for (int h = 0; h < 2; ++h)
#pragma unroll
            for (int i = 0; i < 2; ++i) { const int li = 256 * u.j + h * HALF + R[i]; const int tok = list[(size_t)u.cls * LISTCAP + (li < u.cnt ? li : 256 * u.j)]; v[h][i] = (unsigned)(tok * DM + C[i] * 2); } }
    DEVFN const char* bptr(const MoeUnit& u) const { int e1, e2; moe_experts(u.cls, e1, e2); return W + (size_t)(u.pn < 4 ? e1 : e2) * DM * DM + (size_t)(u.pn & 3) * BM * DM; }
    DEVFN const char* bptr2(const MoeUnit& u) const { return bptr(u); }
};
struct DownSched : MoeBase {
    typedef MoeUnit UnitT;
    const char* ACT; const char* W;
    DEVFN bool next(int i, MoeUnit& u) const { return next_(i, u); }
    DEVFN const char* aptr(const MoeUnit&) const { return ACT; }
    DEVFN void arows(const MoeUnit& u, const int tid_, unsigned (&v)[2][2]) const {
        int R[2], C[2]; { int t_ = tid_; asm volatile("" : "+v"(t_)); stage_rc(t_ * 16, R[0], C[0]); stage_rc(t_ * 16 + 8192, R[1], C[1]); }
#pragma unroll
        for (int h = 0; h < 2; ++h)
#pragma unroll
            for (int i = 0; i < 2; ++i) v[h][i] = (unsigned)((u.pm * BM + h * HALF + R[i]) * DM + C[i] * 2); }
    DEVFN const char* bptr(const MoeUnit& u) const { int e1, e2; moe_experts(u.cls, e1, e2); return W + (size_t)e1 * DM * DE + (size_t)u.pn * BM * DE; }
    DEVFN const char* bptr2(const MoeUnit& u) const { int e1, e2; moe_experts(u.cls, e1, e2); return W + (size_t)e2 * DM * DE + (size_t)u.pn * BM * DE; }
};
struct EpiGateUp {
    static constexpr bool PERM = true, AFTER_DRAIN = false;
    unsigned char* ACT; const float* rw;
    DEVFN void operator()(f32x4 (&acc)[2][2][4][2], const MoeUnit& u, int wr, int wc, int fr, int fq) const {
        const int half = u.pn >> 2, jt = u.pn & 3;
#pragma unroll
        for (int ai = 0; ai < 2; ++ai)
#pragma unroll
            for (int m = 0; m < 4; ++m) { const int lr = ai * HALF + wr * 64 + m * 16 + fr, li = 256 * u.j + lr;
                const float wgt = li < u.cnt ? 8.f * rw[((size_t)u.cls * LISTCAP + li) * 2 + half] : 0.f;
                f32x4 o[2];
#pragma unroll
                for (int n = 0; n < 2; ++n)
#pragma unroll
                    for (int e = 0; e < 4; ++e) { const float g = acc[ai][0][m][n][e]; o[n][e] = g * __builtin_amdgcn_rcpf(1.f + __expf(-g)) * acc[ai][1][m][n][e] * wgt; }
                u32x2 w; w.x = pk4_fp8(o[0][0], o[0][1], o[0][2], o[0][3]); w.y = pk4_fp8(o[1][0], o[1][1], o[1][2], o[1][3]);
                *(u32x2*)(ACT + (size_t)(u.pm * BM + lr) * DM + half * 512 + jt * 128 + wc * 32 + fq * 8) = w; }
    }
};
struct EpiDown {
    static constexpr bool PERM = true, AFTER_DRAIN = false;
    unsigned char* Y2; const int* list;
    DEVFN void operator()(f32x4 (&acc)[2][2][4][2], const MoeUnit& u, int wr, int wc, int fr, int fq_) const {
        int fq = fq_; asm volatile("" : "+v"(fq));
#pragma unroll
        for (int ai = 0; ai < 2; ++ai)
#pragma unroll
            for (int m = 0; m < 4; ++m) { const int li = 256 * u.j + ai * HALF + wr * 64 + m * 16 + fr;
                if (li < u.cnt) { const int tok = list[(size_t)u.cls * LISTCAP + li]; unsigned char* rowp = Y2 + (size_t)tok * DM + u.pn * BM + wc * 32 + fq * 8;
#pragma unroll
                    for (int bj = 0; bj < 2; ++bj) { const f32x4 v0 = acc[ai][bj][m][0] * YSCALE, v1 = acc[ai][bj][m][1] * YSCALE;
                        u32x2 w; w.x = pk4_fp8(v0[0], v0[1], v0[2], v0[3]); w.y = pk4_fp8(v1[0], v1[1], v1[2], v1[3]);
                        *(u32x2*)(rowp + bj * HALF) = w; } } }
    }
};
}

#include <hip/hip_bf16.h>
#include <cmath>
namespace attn_body {
using bf16=__hip_bfloat16;
using bf16x8=__attribute__((ext_vector_type(8)))short;
using s16x4=__attribute__((ext_vector_type(4)))short;
using f32x16=__attribute__((ext_vector_type(16)))float;
using u32x4=__attribute__((ext_vector_type(4)))unsigned;
constexpr int BATCH=16,NHEAD=8,SEQ=2048,D=64,QP=2048,OP=1024;
constexpr int NW=8,QBLK=32,QB=QBLK*NW,KVBLK=64,NQB=SEQ/QB;
constexpr int ATTN_PITCH=QP, ATTN_UNIT_ROWS=QB;
__device__ __forceinline__ int crow(int r,int hi){return (r&3)+8*(r>>2)+4*hi;}
#define SBAR() __builtin_amdgcn_sched_barrier(0)
__device__ __forceinline__ void cmask(f32x16&p0,f32x16&p1,int jb,int qrel,int hi){
  const float NEG=-INFINITY; int kb=64*jb+4*hi;
  #pragma unroll
  for(int r=0;r<16;++r){int kv=kb+(r&3)+8*(r>>2); if(kv>qrel)p0[r]=NEG; if(kv+32>qrel)p1[r]=NEG;}
}

constexpr int NSLOT=3, SLOTB=8192;
constexpr int LDS_K=0, LDS_V=NSLOT*SLOTB, LDS_WS=2*NSLOT*SLOTB, LDS_OST=LDS_WS+NW*64*4, LDS_KBAR=LDS_OST+NW*4096, LDS_BYTES=LDS_KBAR+2048;
constexpr float NEGBIG=-1.0e30f; typedef float f32x4_t __attribute__((ext_vector_type(4)));
__device__ __forceinline__ float bfs(short v){return __uint_as_float(((unsigned)(unsigned short)v)<<16);}
constexpr float C2=0.125f*1.4426950408889634f;
__device__ __forceinline__ void glds16(const void*gsrc,unsigned lds_dst){unsigned keep;
  asm volatile("s_mov_b32 %0, m0\n\ts_mov_b32 m0, %2\n\ts_nop 0\n\tglobal_load_lds_dwordx4 %1, off\n\ts_mov_b32 m0, %0":"=&s"(keep):"v"(gsrc),"s"(lds_dst):"memory");}
__device__ __forceinline__ float max3f(float a,float b,float c){float r;asm("v_max3_f32 %0, %1, %2, %3":"=v"(r):"v"(a),"v"(b),"v"(c));return r;}
__device__ __forceinline__ float max2f(float a,float b){float r;asm("v_max_f32_e32 %0, %1, %2":"=v"(r):"v"(a),"v"(b));return r;}
__device__ __forceinline__ float fadd_s(float a,float b){float r;asm("v_add_f32_e32 %0, %1, %2":"=v"(r):"v"(a),"v"(b));return r;}
__device__ __forceinline__ float fsub_s(float a,float b){float r;asm("v_sub_f32_e32 %0, %1, %2":"=v"(r):"v"(a),"v"(b));return r;}
typedef float f32x2_t __attribute__((ext_vector_type(2))); typedef __bf16 bf16x2_t __attribute__((ext_vector_type(2)));
__device__ __forceinline__ unsigned cvtpk_s(float lo,float hi){f32x2_t v={lo,hi};bf16x2_t b=__builtin_convertvector(v,bf16x2_t);return __builtin_bit_cast(unsigned,b);}
#define WAIT_BAR(N) asm volatile("s_waitcnt vmcnt(" #N ") lgkmcnt(0)\n\ts_barrier":::"memory")

__device__ __forceinline__ void qkt(f32x16&p0,f32x16&p1,const char*Kslot,const bf16x8*qr,const f32x16&negm,int r32,int hi){
  const char*kb=Kslot+hi*1024+r32*16;
  #pragma unroll
  for(int d0=0;d0<4;++d0){
    const bf16x8 b0=*reinterpret_cast<const bf16x8*>(kb+d0*2048);
    const bf16x8 b1=*reinterpret_cast<const bf16x8*>(kb+d0*2048+512);
    if(d0==0){p0=__builtin_amdgcn_mfma_f32_32x32x16_bf16(b0,qr[0],negm,0,0,0);p1=__builtin_amdgcn_mfma_f32_32x32x16_bf16(b1,qr[0],negm,0,0,0);}
    else{p0=__builtin_amdgcn_mfma_f32_32x32x16_bf16(b0,qr[d0],p0,0,0,0);p1=__builtin_amdgcn_mfma_f32_32x32x16_bf16(b1,qr[d0],p1,0,0,0);}}
}
typedef __attribute__((address_space(3))) const char* lds_cptr;
typedef short v4i16_t __attribute__((ext_vector_type(4)));
__device__ __forceinline__ void kload8(bf16x8*kf,lds_cptr kp){
  kf[0]=*(const __attribute__((address_space(3))) bf16x8*)(kp);      kf[1]=*(const __attribute__((address_space(3))) bf16x8*)(kp+512);
  kf[2]=*(const __attribute__((address_space(3))) bf16x8*)(kp+2048); kf[3]=*(const __attribute__((address_space(3))) bf16x8*)(kp+2560);
  kf[4]=*(const __attribute__((address_space(3))) bf16x8*)(kp+4096); kf[5]=*(const __attribute__((address_space(3))) bf16x8*)(kp+4608);
  kf[6]=*(const __attribute__((address_space(3))) bf16x8*)(kp+6144); kf[7]=*(const __attribute__((address_space(3))) bf16x8*)(kp+6656);
}
__device__ __forceinline__ void kload2(bf16x8*kf,lds_cptr kp,int j){ kf[2*j]=*(const __attribute__((address_space(3))) bf16x8*)(kp+j*2048); kf[2*j+1]=*(const __attribute__((address_space(3))) bf16x8*)(kp+j*2048+512); }
__device__ __forceinline__ s16x4 vtr(lds_cptr p){ return __builtin_bit_cast(s16x4,__builtin_amdgcn_ds_read_tr16_b64_v4i16((__attribute__((address_space(3))) v4i16_t*)p)); }
__device__ __forceinline__ float rowmax(const f32x16&p0,const f32x16&p1){
  float a=max3f(p0[0],p0[1],p1[0]),b=max3f(p0[2],p0[3],p1[1]);a=max3f(a,p1[2],p1[3]);
  #pragma unroll
  for(int r=4;r<16;r+=4){a=max3f(a,p0[r],p0[r+1]);b=max3f(b,p0[r+2],p0[r+3]);a=max3f(a,p1[r],p1[r+1]);b=max3f(b,p1[r+2],p1[r+3]);}
  const float m=max2f(a,b);
  auto rr=__builtin_amdgcn_permlane32_swap(__float_as_uint(m),__float_as_uint(m),false,false);
  return max2f(__uint_as_float(rr[0]),__uint_as_float(rr[1]));
}
__device__ __forceinline__ void pv(f32x16*o,int vb,bf16x8 pa0,bf16x8 pa1,bf16x8 pa2,bf16x8 pa3){
  #pragma unroll
  for(int d0=0;d0<2;++d0){s16x4 lo[4],hi[4];
    #pragma unroll
    for(int ks=0;ks<4;++ks){
      asm volatile("ds_read_b64_tr_b16 %0,%1 offset:%c2":"=&v"(lo[ks]):"v"(vb),"i"(d0*4096+ks*1024):"memory");
      asm volatile("ds_read_b64_tr_b16 %0,%1 offset:%c2":"=&v"(hi[ks]):"v"(vb),"i"(d0*4096+ks*1024+512):"memory");}
    asm volatile("s_waitcnt lgkmcnt(0)":::"memory");SBAR();
    #define PK(k) (bf16x8){lo[k][0],lo[k][1],lo[k][2],lo[k][3],hi[k][0],hi[k][1],hi[k][2],hi[k][3]}
    o[d0]=__builtin_amdgcn_mfma_f32_32x32x16_bf16(pa0,PK(0),o[d0],0,0,0);
    o[d0]=__builtin_amdgcn_mfma_f32_32x32x16_bf16(pa1,PK(1),o[d0],0,0,0);
    o[d0]=__builtin_amdgcn_mfma_f32_32x32x16_bf16(pa2,PK(2),o[d0],0,0,0);
    o[d0]=__builtin_amdgcn_mfma_f32_32x32x16_bf16(pa3,PK(3),o[d0],0,0,0);
    #undef PK
  }
}

#ifndef ATTN_STORE16
#define ATTN_STORE16(p,v) (*(u32x4*)(p)=(v))
#endif
template<int THRL> __device__ __forceinline__ void attn_unit(int b,int h,int qb,const bf16*Q,const bf16*__restrict__ K,const bf16*__restrict__ V,bf16*O,const float*__restrict__ kbar,char*shm,const int tid){
  const int lane=tid&63,r32=lane&31,hi=lane>>5; const int wid=__builtin_amdgcn_readfirstlane(tid>>6);
  float kbv=0.f; { int tk=tid; asm volatile("":"+v"(tk)); if(qb>=4&&tk<448)kbv=kbar[tk]; }
  const long rowbase=(long)b*SEQ; const int q0=qb*QB;
  const bf16*Qw=Q+(rowbase+q0+wid*QBLK)*QP+h*D;
  const bf16*Kh=K+rowbase*QP+h*D,*Vh=V+rowbase*QP+h*D;
  const unsigned lds0=(unsigned)(uintptr_t)shm;
  float*wsf=(float*)(shm+LDS_WS)+wid*64;
  const bf16*ksrc=Kh+(long)lane*QP+wid*8;
  const bf16*vsrc=Vh+(long)(16*(wid&3)+(lane>>2))*QP+(wid>>2)*32+(lane&3)*8;
  const unsigned kdst=lds0+LDS_K+wid*1024, vdst=lds0+LDS_V+wid*1024;
  #define DMA_K(t,slot) glds16(ksrc+(long)(t)*KVBLK*QP,(unsigned)__builtin_amdgcn_readfirstlane(kdst+(slot)))
  #define DMA_V(t,slot) glds16(vsrc+(long)(t)*KVBLK*QP,(unsigned)__builtin_amdgcn_readfirstlane(vdst+(slot)))
  const int vb0=(int)(lds0+LDS_V)+((lane>>4)&1)*32+(lane&3)*8+(4*hi+((lane&15)>>2))*64;
  const char*Kbase=shm+LDS_K; bf16x8 kf[8];
  const lds_cptr shm3=(lds_cptr)shm; const lds_cptr kp0=shm3+LDS_K+hi*1024+r32*16; const lds_cptr vp0=shm3+LDS_V+((lane>>4)&1)*32+(lane&3)*8+(4*hi+((lane&15)>>2))*64;
  const int NT=(q0+QB)/KVBLK;
  DMA_K(0,0);DMA_V(0,0);DMA_K(1,SLOTB);
  bf16x8 qr[4];
  #pragma unroll
  for(int d0=0;d0<4;++d0)qr[d0]=*reinterpret_cast<const bf16x8*>(&Qw[(long)r32*QP+d0*16+hi*8]);
  float mhat=0.f,l_reg=0.f;f32x16 o[2];o[0]=f32x16{};o[1]=f32x16{};f32x16 negm=f32x16{};asm volatile("":"+v"(negm));
  const int qrel=wid*QBLK+r32;
  #define CMASK(P0,P1,t) do{int jb_=(t)-(NT-4); if(jb_>=0)cmask(P0,P1,jb_,qrel,hi);}while(0)
  bool resc=false;
  #define START(P0,P1) do{ const float rm=rowmax(P0,P1); resc=false; \
    { const float dl=selcur?rm:-64.f; mhat=fadd_s(mhat,dl); \
      _Pragma("unroll") for(int r=0;r<16;++r){P0[r]=fsub_s(P0[r],dl);P1[r]=fsub_s(P1[r],dl);} \
      { const float nv_=selcur?-mhat:NEGBIG; _Pragma("unroll") for(int r=0;r<16;++r)negm[r]=nv_; } asm volatile("":"+v"(negm)); } \
    _Pragma("unroll") for(int r=0;r<16;++r)P0[r]=__builtin_amdgcn_exp2f(P0[r]); }while(0)
  #define RESC() do{ if(resc){ asm volatile("s_waitcnt lgkmcnt(0)":::"memory"); \
      _Pragma("unroll") for(int d_=0;d_<2;++d_) _Pragma("unroll") for(int r=0;r<16;++r)o[d_][r]*=wsf[crow(r,hi)]; } }while(0)
  f32x16 pA0,pA1,pB0,pB1;
  int sl_prev=0,sl_cur=0,sl_next=SLOTB;
  #define ROT() do{sl_prev=sl_cur;sl_cur=sl_next;sl_next=(sl_next==(NSLOT-1)*SLOTB)?0:sl_next+SLOTB;}while(0)
  DMA_K(2,2*SLOTB);
  if(qb>=4){ if(tid<448){ const unsigned hb=__builtin_bit_cast(unsigned,kbv); const unsigned hr=(hb+0x7fffu+((hb>>16)&1u))&0xffff0000u; const float lo_=kbv-__builtin_bit_cast(float,hr); const unsigned lb=__builtin_bit_cast(unsigned,lo_);
      ((unsigned short*)(shm+LDS_KBAR))[tid]=(unsigned short)(hr>>16); ((unsigned short*)(shm+LDS_KBAR+1024))[tid]=(unsigned short)((lb+0x7fffu+((lb>>16)&1u))>>16); } }
  WAIT_BAR(3);
  unsigned bmask=(1u<<(qb+1))-1u;
  if(qb>=4){ float gsc[8];
    { const lds_cptr kb3=shm3+LDS_KBAR+(r32&7)*128+hi*16; f32x16 g=f32x16{};
      _Pragma("unroll") for(int d0=0;d0<4;++d0){ const bf16x8 ah=*(const __attribute__((address_space(3))) bf16x8*)(kb3+d0*32), al=*(const __attribute__((address_space(3))) bf16x8*)(kb3+1024+d0*32);
        g=__builtin_amdgcn_mfma_f32_32x32x16_bf16(ah,qr[d0],g,0,0,0); g=__builtin_amdgcn_mfma_f32_32x32x16_bf16(al,qr[d0],g,0,0,0); }
      _Pragma("unroll") for(int r=0;r<4;++r){ auto rr=__builtin_amdgcn_permlane32_swap(__float_as_uint(g[r]),__float_as_uint(g[r]),false,false); gsc[r]=__uint_as_float(rr[0]); gsc[4+r]=__uint_as_float(rr[1]); } }
    _Pragma("unroll") for(int n=0;n<7;++n) gsc[n]=(n<qb)?gsc[n]:-3.0e38f;
    bmask=1u<<qb;
    _Pragma("unroll") for(int pick=0;pick<3;++pick){ float best=-3.4e38f; unsigned bi=0u;
      _Pragma("unroll") for(int n=0;n<7;++n){ const bool ok=!((bmask>>n)&1u)&&gsc[n]>best; best=ok?gsc[n]:best; bi=ok?(unsigned)n:bi; }
      bmask|=1u<<bi; } }
  bool selcur=(bmask&1u)!=0u;
  { const float nv=selcur?0.f:NEGBIG; _Pragma("unroll") for(int r=0;r<16;++r)negm[r]=nv; asm volatile("":"+v"(negm)); }
  qkt(pA0,pA1,Kbase,qr,negm,r32,hi);asm volatile("s_nop 15\n\ts_nop 7":"+v"(pA0),"+v"(pA1));CMASK(pA0,pA1,0);
  START(pA0,pA1);
  _Pragma("unroll") for(int r=0;r<16;++r)pA1[r]=__builtin_amdgcn_exp2f(pA1[r]);
  WAIT_BAR(0);
  DMA_K(3,0);DMA_V(1,SLOTB);
  ROT();
  kload8(kf,kp0+sl_cur);
  WAIT_BAR(2);
  s16x4 vlo[8],vhi[8]; u32x4 pw0,pw1,pw2,pw3;
  #define PKW(P,B) cvtpk_s(P[B],P[B+1])
  #define PAF(k) __builtin_bit_cast(bf16x8,pw##k)
  #define VFR(i) (bf16x8){vlo[i][0],vlo[i][1],vlo[i][2],vlo[i][3],vhi[i][0],vhi[i][1],vhi[i][2],vhi[i][3]}
  #define PIN(x) asm volatile("":"+v"(x))
  #define MX3(a,b,c) __builtin_fmaxf(__builtin_fmaxf((a),(b)),(c))
  #define GAPA(MF,A0,A1,A2,A3,W0,W1,PW) do{ MF; sacc+=A0; sacc+=A1; sacc+=A2; sacc+=A3; PIN(sacc); W0; W1; PIN(PW); SBAR(); }while(0)
  #define EX(v) __builtin_amdgcn_exp2f(v)
  #define GAPB(MF,X,B) do{ MF; X[B]=EX(X[B]); X[B+1]=EX(X[B+1]); X[B+2]=EX(X[B+2]); X[B+3]=EX(X[B+3]); PIN(X); SBAR(); }while(0)
  #define VRD(i) do{ vlo[i]=vtr(vp_+(((i)>>2)*4096+((i)&3)*1024)); vhi[i]=vtr(vp_+(((i)>>2)*4096+((i)&3)*1024+512)); }while(0)
  #define KRD(G,j) do{ if(G){ kload2(kf,kp0+sl_next,j); SBAR(); } }while(0)
  #define STEP(C0,C1,P0,P1,t,GK,GV,GL) do{ SBAR(); \
    const lds_cptr vp_=vp0+sl_prev; \
    VRD(0); SBAR(); float sacc=(P0[0]+P0[1]); \
    GAPA(C0=__builtin_amdgcn_mfma_f32_32x32x16_bf16(kf[0],qr[0],negm,0,0,0), P0[2],P0[3],P0[4],P0[5],     pw0[0]=PKW(P0,0), pw0[1]=PKW(P0,2), pw0); \
    VRD(4); SBAR(); GAPA(C1=__builtin_amdgcn_mfma_f32_32x32x16_bf16(kf[1],qr[0],negm,0,0,0), P0[6],P0[7],P0[8],P0[9],     pw0[2]=PKW(P0,4), pw0[3]=PKW(P0,6), pw0); \
    VRD(1); SBAR(); GAPA(C0=__builtin_amdgcn_mfma_f32_32x32x16_bf16(kf[2],qr[1],C0,0,0,0),   P0[10],P0[11],P0[12],P0[13], pw1[0]=PKW(P0,8), pw1[1]=PKW(P0,10), pw1); \
    VRD(5); SBAR(); GAPA(C1=__builtin_amdgcn_mfma_f32_32x32x16_bf16(kf[3],qr[1],C1,0,0,0),   P0[14],P0[15],P1[0],P1[1],   pw1[2]=PKW(P0,12),pw1[3]=PKW(P0,14), pw1); \
    VRD(2); SBAR(); GAPA(C0=__builtin_amdgcn_mfma_f32_32x32x16_bf16(kf[4],qr[2],C0,0,0,0),   P1[2],P1[3],P1[4],P1[5],     pw2[0]=PKW(P1,0), pw2[1]=PKW(P1,2), pw2); \
    VRD(6); SBAR(); GAPA(C1=__builtin_amdgcn_mfma_f32_32x32x16_bf16(kf[5],qr[2],C1,0,0,0),   P1[6],P1[7],P1[8],P1[9],     pw2[2]=PKW(P1,4), pw2[3]=PKW(P1,6), pw2); \
    VRD(3); SBAR(); GAPA(C0=__builtin_amdgcn_mfma_f32_32x32x16_bf16(kf[6],qr[3],C0,0,0,0),   P1[10],P1[11],P1[12],P1[13], pw3[0]=PKW(P1,8), pw3[1]=PKW(P1,10), pw3); \
    VRD(7); SBAR(); GAPA(C1=__builtin_amdgcn_mfma_f32_32x32x16_bf16(kf[7],qr[3],C1,0,0,0),   P1[14],P1[15],0.f,0.f,       pw3[2]=PKW(P1,12),pw3[3]=PKW(P1,14), pw3); \
    l_reg+=sacc; \
    if(GK){DMA_K((t)+3,sl_cur);} if(GV){DMA_V((t)+1,sl_next);} \
    CMASK(C0,C1,t); \
    { float a=MX3(C0[0],C0[1],C1[0]),b=MX3(C0[2],C0[3],C1[1]); a=MX3(a,C1[2],C1[3]); \
      _Pragma("unroll") for(int r=4;r<16;r+=4){a=MX3(a,C0[r],C0[r+1]);b=MX3(b,C0[r+2],C0[r+3]);a=MX3(a,C1[r],C1[r+1]);b=MX3(b,C1[r+2],C1[r+3]);} \
      float rm=__builtin_fmaxf(a,b); { auto rr=__builtin_amdgcn_permlane32_swap(__float_as_uint(rm),__float_as_uint(rm),false,false); rm=__builtin_fmaxf(__uint_as_float(rr[0]),__uint_as_float(rr[1])); } \
      resc=false; \
      if(__builtin_expect(__any(rm>(float)THRL),0)){ const float dl=__builtin_fmaxf(rm,0.f); mhat+=dl; \
        _Pragma("unroll") for(int r=0;r<16;++r){C0[r]-=dl;C1[r]-=dl;} \
        { const float nv_=selcur?-mhat:NEGBIG; _Pragma("unroll") for(int r=0;r<16;++r)negm[r]=nv_; } asm volatile("":"+v"(negm)); \
        const float f=__builtin_amdgcn_exp2f(-dl); l_reg*=f; if(hi==0)wsf[r32]=f; resc=true; } } \
    SBAR(); \
    GAPB(o[0]=__builtin_amdgcn_mfma_f32_32x32x16_bf16(PAF(0),VFR(0),o[0],0,0,0), C0,0); \
    GAPB(o[1]=__builtin_amdgcn_mfma_f32_32x32x16_bf16(PAF(0),VFR(4),o[1],0,0,0), C0,4); \
    KRD(GL,0); GAPB(o[0]=__builtin_amdgcn_mfma_f32_32x32x16_bf16(PAF(1),VFR(1),o[0],0,0,0), C0,8); \
    KRD(GL,1); GAPB(o[1]=__builtin_amdgcn_mfma_f32_32x32x16_bf16(PAF(1),VFR(5),o[1],0,0,0), C0,12); \
    KRD(GL,2); GAPB(o[0]=__builtin_amdgcn_mfma_f32_32x32x16_bf16(PAF(2),VFR(2),o[0],0,0,0), C1,0); \
    KRD(GL,3); GAPB(o[1]=__builtin_amdgcn_mfma_f32_32x32x16_bf16(PAF(2),VFR(6),o[1],0,0,0), C1,4); \
    GAPB(o[0]=__builtin_amdgcn_mfma_f32_32x32x16_bf16(PAF(3),VFR(3),o[0],0,0,0), C1,8); \
    GAPB(o[1]=__builtin_amdgcn_mfma_f32_32x32x16_bf16(PAF(3),VFR(7),o[1],0,0,0), C1,12); \
    }while(0)
  #define BLKSEL(tt) do{ if((((tt))&3)==0){ selcur=((bmask>>((tt)>>2))&1u)!=0u; const float nv_=selcur?-mhat:NEGBIG; _Pragma("unroll") for(int r=0;r<16;++r)negm[r]=nv_; asm volatile("":"+v"(negm)); } }while(0)
  int t=1;
  #undef CMASK
  #define CMASK(P0,P1,t) do{}while(0)
  for(;t+5<NT;t+=2){
    STEP(pB0,pB1,pA0,pA1,t,true,true,true);     WAIT_BAR(2); RESC(); ROT(); BLKSEL(t+1);
    STEP(pA0,pA1,pB0,pB1,t+1,true,true,true);   WAIT_BAR(2); RESC(); ROT();
  }
  #undef CMASK
  #define CMASK(P0,P1,t) do{int jb_=(t)-(NT-4); if(jb_>=0)cmask(P0,P1,jb_,qrel,hi);}while(0)
  #define ENDW(tt) do{ if((tt)+3<NT){WAIT_BAR(2);} else if((tt)+2<NT){WAIT_BAR(1);} else {WAIT_BAR(0);} }while(0)
  for(;t+1<NT;t+=2){
    STEP(pB0,pB1,pA0,pA1,t,(t+3<NT),(t+1<NT),(t+1<NT));       ENDW(t);   RESC(); ROT(); BLKSEL(t+1);
    STEP(pA0,pA1,pB0,pB1,t+1,(t+4<NT),(t+2<NT),(t+2<NT));     ENDW(t+1); RESC(); ROT();
  }
  STEP(pB0,pB1,pA0,pA1,NT-1,false,false,false); RESC();
  { float sacc=pB0[0]+pB0[1]; _Pragma("unroll") for(int r=2;r<16;++r)sacc+=pB0[r]; _Pragma("unroll") for(int r=0;r<16;++r)sacc+=pB1[r]; l_reg+=sacc;
    pw0=(u32x4){PKW(pB0,0),PKW(pB0,2),PKW(pB0,4),PKW(pB0,6)};pw1=(u32x4){PKW(pB0,8),PKW(pB0,10),PKW(pB0,12),PKW(pB0,14)};pw2=(u32x4){PKW(pB1,0),PKW(pB1,2),PKW(pB1,4),PKW(pB1,6)};pw3=(u32x4){PKW(pB1,8),PKW(pB1,10),PKW(pB1,12),PKW(pB1,14)};
    SBAR(); pv(o,vb0+sl_cur,PAF(0),PAF(1),PAF(2),PAF(3)); }
  #undef PKW
  #undef PAF
  #undef VFR
  #undef PIN
  #undef MX3
  #undef GAPA
  #undef GAPB
  #undef EX
  #undef VRD
  #undef KRD
  #undef STEP
  #undef ENDW
  {auto rr=__builtin_amdgcn_permlane32_swap(__float_as_uint(l_reg),__float_as_uint(l_reg),false,false);l_reg=__uint_as_float(rr[0])+__uint_as_float(rr[1]);}
  if(hi==0)wsf[32+r32]=l_reg;asm volatile("s_waitcnt lgkmcnt(0)":::"memory");
  float rli[16];
  #pragma unroll
  for(int r=0;r<16;++r)rli[r]=__builtin_amdgcn_rcpf(wsf[32+crow(r,hi)]);
  unsigned char*Ow=(unsigned char*)O+(rowbase+q0+wid*QBLK)*OP+h*D;
  { unsigned char*stg=(unsigned char*)(shm+LDS_OST)+wid*4096;
    #pragma unroll
    for(int r=0;r<16;++r){const int orow=crow(r,hi);
      #pragma unroll
      for(int d0=0;d0<2;++d0){const float ov=__builtin_amdgcn_fmed3f(o[d0][r]*rli[r]*32.f,-448.f,448.f); stg[orow*64+d0*32+r32]=(unsigned char)__builtin_amdgcn_cvt_pk_fp8_f32(ov,ov,0,false);}}
    asm volatile("s_waitcnt lgkmcnt(0)":::"memory");
    #pragma unroll
    for(int i=0;i<2;++i){const int row=i*16+(lane>>2),ch=lane&3; const u32x4 v=*(const u32x4*)(stg+row*64+ch*16); ATTN_STORE16(Ow+(long)row*OP+ch*16,v);} }
  asm volatile("s_waitcnt lgkmcnt(0)\n\ts_barrier":::"memory");
  #undef BLKSEL
  #undef DMA_K
  #undef DMA_V
  #undef CMASK
  #undef START
  #undef RESC
  #undef ROT
}
constexpr int ATTN_LDS_BYTES=LDS_BYTES;
struct AttnTensors { const bf16* Q; const bf16* K; const bf16* V; bf16* O; const float* kbar; };
struct AttnUnit { int bh; int qb; };
struct StaticOrder {
  int vcu, G;
  __device__ __forceinline__ explicit StaticOrder(int grid,int block):vcu((grid%8==0)?(block%8)*(grid/8)+block/8:block),G(grid){}
  __device__ __forceinline__ bool next(int i,AttnUnit&u)const{ const int pr=(vcu+(i>>2)*G)*2+((i>>1)&1); if(pr>=BATCH*NHEAD*4)return false;
    const int s=pr&3; u.bh=pr>>2; u.qb=(i&1)?7-s:s; return true; }
  __device__ __forceinline__ void a_ready(const AttnUnit&)const{}
  __device__ __forceinline__ void done(const AttnUnit&)const{}
};
template<class Sched,int THRL=8> __device__ __forceinline__ void attn_phase(char*lds,const AttnTensors&T,const Sched&S,const int tid_in){
  AttnUnit u; int tid_=tid_in; asm volatile("":"+v"(tid_));
  for(int i=0;S.next(i,u);++i){ S.a_ready(u); attn_unit<THRL>(u.bh/NHEAD,u.bh%NHEAD,u.qb,T.Q,T.K,T.V,T.O,T.kbar+(long)u.bh*512,lds,tid_); S.done(u); }
}
#undef SBAR
#undef WAIT_BAR
}

#define XB_TMO      128
#define XB_XCNT(j)  (256  + 64 * (j))
#define XB_XSUB(j)  (1280 + 64 * (j))
#define XB_XGEN(j)  (2304 + 64 * (j))
#define XB_TOP      3328
#define XB_TOPGEN   3392
#define XCD_BAR_WORDS 3456
#define XB_SPIN_CAP (1u << 18)

__device__ __forceinline__ unsigned xb_ld(unsigned* p)              { return __hip_atomic_load(p, __ATOMIC_RELAXED, __HIP_MEMORY_SCOPE_AGENT); }
__device__ __forceinline__ unsigned xb_add(unsigned* p, unsigned v) { return __hip_atomic_fetch_add(p, v, __ATOMIC_RELAXED, __HIP_MEMORY_SCOPE_AGENT); }
__device__ __forceinline__ unsigned xb_xcc_id() { return (unsigned)__builtin_amdgcn_s_getreg((3 << 11) | 20) & 0xFu; }
#define XB_SPIN(cond, bar) do { unsigned _sp = 0; while (cond) { __builtin_amdgcn_s_sleep(1); \
    if ((++_sp & 255u) == 0u) { if (xb_ld(&(bar)[XB_TMO])) break; if (_sp > XB_SPIN_CAP) { atomicAdd(&(bar)[XB_TMO], 1u); break; } } } } while (0)

struct XcdBarrier {
    unsigned* bar; unsigned x;
    volatile LAS unsigned* st;
};

__device__ __forceinline__ XcdBarrier xcd_barrier_post(unsigned* bar, volatile LAS unsigned* st) {
    XcdBarrier b; b.bar = bar; b.x = xb_xcc_id(); b.st = st;
    if (threadIdx.x == 0) (void)xb_add(&bar[XB_XCNT(b.x)], 1u);
    return b;
}
__device__ __forceinline__ void xcd_barrier_complete(unsigned* bar, unsigned x, unsigned& nloc, unsigned& nx) {
    const unsigned G = gridDim.x * gridDim.y * gridDim.z;
    unsigned sum, cnt, mine, sp = 0u;
    for (;;) {
        sum = 0u; cnt = 0u; mine = 0u;
#pragma unroll
        for (unsigned j = 0; j < 16; ++j) { const unsigned c = xb_ld(&bar[XB_XCNT(j)]); sum += c; cnt += (c > 0u) ? 1u : 0u; mine = (j == x) ? c : mine; }
        if (sum == G) break;
        __builtin_amdgcn_s_sleep(1);
        if ((++sp & 255u) == 0u) { if (xb_ld(&bar[XB_TMO])) break; if (sp > XB_SPIN_CAP) { atomicAdd(&bar[XB_TMO], 1u); break; } }
    }
    nloc = mine > 0u ? mine : 1u; nx = cnt > 0u ? cnt : 1u;
}

__device__ __forceinline__ void xcd_barrier(const XcdBarrier& b, const bool is_t0) {
    asm volatile("s_waitcnt vmcnt(0)" ::: "memory");
    __syncthreads();
    if (is_t0) {
        unsigned* bar = b.bar;
        __builtin_amdgcn_s_waitcnt(0);
        unsigned nloc = b.st[0], nx = b.st[1];
        if (nloc == 0u) { xcd_barrier_complete(bar, b.x, nloc, nx); b.st[0] = nloc; b.st[1] = nx; }
        const unsigned old = xb_add(&bar[XB_XSUB(b.x)], 1u);
        const unsigned gen = old / nloc;
        if (old + 1u == (gen + 1u) * nloc) {
            __builtin_amdgcn_fence(__ATOMIC_RELEASE, "agent");
            asm volatile("s_waitcnt vmcnt(0)" ::: "memory");
            const unsigned og = xb_add(&bar[XB_TOP], 1u);
            const unsigned tg = og / nx;
            if (og + 1u == (tg + 1u) * nx) xb_add(&bar[XB_TOPGEN], 1u);
            else XB_SPIN(xb_ld(&bar[XB_TOPGEN]) == tg, bar);
            __builtin_amdgcn_fence(__ATOMIC_ACQUIRE, "agent");
            xb_add(&bar[XB_XGEN(b.x)], 1u);
            asm volatile("s_waitcnt vmcnt(0)" ::: "memory");
        } else {
            XB_SPIN(xb_ld(&bar[XB_XGEN(b.x)]) == gen, bar);
            __builtin_amdgcn_fence(__ATOMIC_ACQUIRE, "agent");
            asm volatile("s_waitcnt vmcnt(0)" ::: "memory");
        }
    }
    __syncthreads();
}

struct Args { const float* in[17]; float* out; unsigned char* ws; int ph_lo, ph_hi; };
enum { I_X = 0, I_C, I_WMOD, I_BMOD, I_WIN, I_WPOOL, I_PSCALE, I_WOUT, I_LN1G, I_LN1B, I_WR, I_RB, I_WG, I_WU, I_WDN, I_LN2G, I_LN2B };

DEVFN int lane_id_volatile() { int l; asm volatile("v_mbcnt_lo_u32_b32 %0, -1, 0\n\tv_mbcnt_hi_u32_b32 %0, -1, %0" : "=v"(l)); return l; }
struct Ctx { unsigned char* lds; __attribute__((address_space(3))) unsigned char* lds3; int tid, lane, wave, G, bid, gw, NGW; };

DEVFN void transpose_item_f8(const float* src, int ldn, int k0, int col, unsigned char* dst, int ldk, int dst_row0, int dst_k0, float* scr, int lane) {
#pragma unroll 8
    for (int i = 0; i < 32; ++i) { const int kk = 2 * i + (lane >> 5); scr[kk * 33 + (lane & 31)] = src[(size_t)(k0 + kk) * ldn + col]; }
    LDS_WAIT();
    const int c = lane & 7;
#pragma unroll
    for (int j = 0; j < 4; ++j) { const int n = (lane >> 3) + 8 * j; const float* s = scr + (8 * c) * 33 + n;
        u32x2 o; o.x = pk4_fp8(32.f * s[0 * 33], 32.f * s[1 * 33], 32.f * s[2 * 33], 32.f * s[3 * 33]); o.y = pk4_fp8(32.f * s[4 * 33], 32.f * s[5 * 33], 32.f * s[6 * 33], 32.f * s[7 * 33]);
        *(u32x2*)(dst + (size_t)(dst_row0 + n) * ldk + dst_k0 + 8 * c) = o; }
    LDS_WAIT();
}

DEVFN void ph_prologue(const Args& a, const Ctx& c) {
    unsigned char* ws = a.ws;
    float* scr = (float*)(c.lds + c.wave * 16384);
    const int lane = c.lane;
    constexpr int N1 = 2 * 16 * 64, N2 = 2 * 8 * 32, N3 = 32 * 16 * 32, N4 = 32 * 8 * 32, N5 = 2 * 64 * 16, N6 = 256;
    for (int it = c.gw; it < N1 + N2 + N3 + N4 + N5 + N6; it += c.NGW) {
        int r = it;
        if (r < N1) {
            const int l = r / 1024, kb = (r % 1024) / 64, nb = r % 64;
            const int nphys = 32 * nb + (lane & 31);
            transpose_item_f8(a.in[I_WIN] + (size_t)l * DM * DIN, DIN, 64 * kb, inproj_nlog(nphys), (unsigned char*)(ws + WS_WIN) + (size_t)l * DIN * DM, DM, 32 * nb, 64 * kb, scr, lane);
            continue; }
        r -= N1;
        if (r < N2) {
            const int l = r / 256, kb = (r % 256) / 32, nb = r % 32;
            transpose_item_f8(a.in[I_WOUT] + (size_t)l * DM * DM, DM, 64 * kb, 32 * nb + (lane & 31), (unsigned char*)(ws + WS_WOUT) + (size_t)l * DM * DM, DM, 32 * nb, 64 * kb, scr, lane);
            continue; }
        r -= N2;
        if (r < N3) {
            const int le = r / 512, kb = (r % 512) / 32, nb = r % 32;
            const int n = 32 * nb + (lane & 31), jt = n >> 8, bj = (n >> 7) & 1, i = n & 127;
            const float* src = (bj ? a.in[I_WU] : a.in[I_WG]) + (size_t)le * DM * DE;
            transpose_item_f8(src, DE, 64 * kb, jt * 128 + i, (unsigned char*)(ws + WS_WGU) + (size_t)le * DM * DM, DM, 32 * nb, 64 * kb, scr, lane);
            continue; }
        r -= N3;
        if (r < N4) {
            const int le = r / 256, kb = (r % 256) / 32, nb = r % 32;
            transpose_item_f8(a.in[I_WDN] + (size_t)le * DE * DM, DM, 64 * kb, 32 * nb + (lane & 31), (unsigned char*)(ws + WS_WD) + (size_t)le * DM * DE, DE, 32 * nb, 64 * kb, scr, lane);
            continue; }
        r -= N4;
        if (r < N5) {
            const int l = r / 1024, kdg = (r % 1024) / 16, nb = r % 16;
            const int n = nb * 64 + lane, kd0 = kdg * 8, g = kd0 >> 7, c0 = kd0 & 127;
            const float* wo = a.in[I_WOUT] + (size_t)l * DM * DM + (size_t)(512 + g * 128) * DM + n;
            const float* ps = a.in[I_PSCALE] + l * 512 + g * 128;
            const float* wp = a.in[I_WPOOL] + ((size_t)(l * 4 + g) * 128 + c0) * 128;
            float acc[8];
#pragma unroll
            for (int j = 0; j < 8; ++j) acc[j] = 0.f;
            for (int e = 0; e < 128; ++e) { const float w = wo[(size_t)e * DM] * ps[e];
#pragma unroll
                for (int j = 0; j < 8; ++j) acc[j] += wp[j * 128 + e] * w; }
            u32x2 o; o.x = pk4_fp8(128.f * acc[0], 128.f * acc[1], 128.f * acc[2], 128.f * acc[3]); o.y = pk4_fp8(128.f * acc[4], 128.f * acc[5], 128.f * acc[6], 128.f * acc[7]);
            *(u32x2*)((unsigned char*)(ws + WS_WOUT) + (size_t)l * DM * DM + (size_t)n * DM + 512 + kd0) = o;
            continue; }
        r -= N5;
        {
            const int ent = r * 64 + lane, pos = ent >> 3, i = ent & 7;
            const float inv = (float)exp2(-(double)i / 8.0 * 18.931568569324174);
            const float ang = (float)pos * inv;
            float* t = (float*)(ws + WS_ROPE) + ent * 2;
            t[0] = (float)cos((double)ang); t[1] = (float)sin((double)ang);
        }
    }
    for (int i = c.bid * 512 + c.tid; i < 2 * NB * NH * NBLK * HD; i += c.G * 512) ((float*)(ws + WS_KBAR))[i] = 0.f;
    __syncthreads();
    if (c.bid < 192) {
        float* condT = (float*)c.lds;
        float* red = (float*)(c.lds + 65536);
        for (int idx = c.tid; idx < NB * DM; idx += 512) { const int b = idx >> 10, k = idx & 1023; const float v = a.in[I_C][idx]; condT[k * 16 + b] = v / (1.f + __expf(-v)); }
        __syncthreads();
        for (int u = c.bid; u < 192; u += c.G) {
            const int l = u / 96, n0 = (u % 96) * 64;
            const float* W = a.in[I_WMOD] + (size_t)l * DM * NMOD + n0 + lane;
            float acc[16];
#pragma unroll
            for (int b = 0; b < 16; ++b) acc[b] = 0.f;
            for (int k = 128 * c.wave; k < 128 * c.wave + 128; k += 8) {
                float wv[8];
#pragma unroll
                for (int j = 0; j < 8; ++j) wv[j] = W[(size_t)(k + j) * NMOD];
#pragma unroll
                for (int j = 0; j < 8; ++j) {
                    const f32x4* cp = (const f32x4*)(condT + (k + j) * 16);
#pragma unroll
                    for (int q = 0; q < 4; ++q) { const f32x4 cv = cp[q]; acc[4 * q + 0] += cv.x * wv[j]; acc[4 * q + 1] += cv.y * wv[j]; acc[4 * q + 2] += cv.z * wv[j]; acc[4 * q + 3] += cv.w * wv[j]; }
                }
            }
#pragma unroll
            for (int b = 0; b < 16; ++b) red[(c.wave * 16 + b) * 64 + lane] = acc[b];
            __syncthreads();
            for (int o = c.tid; o < 1024; o += 512) { const int b = o >> 6, cc = o & 63; float s = a.in[I_BMOD][l * NMOD + n0 + cc];
#pragma unroll
                for (int w = 0; w < 8; ++w) s += red[(w * 16 + b) * 64 + cc];
                ((float*)(ws + WS_MOD))[(size_t)(l * NB + b) * NMOD + n0 + cc] = s; }
            __syncthreads();
        }
    }
}

DEVFN void row_stats(const f32x4 (&v)[4], float& mean, float& rstd) {
    float s = 0.f, q = 0.f;
#pragma unroll
    for (int j = 0; j < 4; ++j) { s += (v[j].x + v[j].y) + (v[j].z + v[j].w); q += (v[j].x * v[j].x + v[j].y * v[j].y) + (v[j].z * v[j].z + v[j].w * v[j].w); }
    s = swz_xor_add(s, 1); q = swz_xor_add(q, 1); s = swz_xor_add(s, 2); q = swz_xor_add(q, 2); s = swz_xor_add(s, 4); q = swz_xor_add(q, 4);
    s = swz_xor_add(s, 8); q = swz_xor_add(q, 8); s = swz_xor_add(s, 16); q = swz_xor_add(q, 16); s = half_swap_add(s); q = half_swap_add(q);
    mean = s * (1.f / DM);
    rstd = 1.f / sqrtf(fmaxf(q * (1.f / DM) - mean * mean, 0.f) + LN_EPS);
}
DEVFN void row_load(const float* p, int lane, f32x4 (&v)[4]) {
#pragma unroll
    for (int j = 0; j < 4; ++j) v[j] = *(const f32x4*)(p + 4 * lane + 256 * j);
}
DEVFN void row_mod_store(f32x4 (&v)[4], const float* sc, const float* sh, bf16_t* out, int lane) {
    float mean, rstd; row_stats(v, mean, rstd);
#pragma unroll
    for (int j = 0; j < 4; ++j) {
        const f32x4 s = *(const f32x4*)(sc + 4 * lane + 256 * j), h = *(const f32x4*)(sh + 4 * lane + 256 * j);
        v[j] = (v[j] - mean) * rstd * (s + 1.f) + h;
        u32x2 o; o.x = pk2(v[j].x, v[j].y); o.y = pk2(v[j].z, v[j].w);
        *(u32x2*)(out + 4 * lane + 256 * j) = o;
    }
}

DEVFN void ph_pool(const Args& a, const Ctx& c) {
    const bf16_t* P = (const bf16_t*)(a.ws + WS_QKVP) + 1536; unsigned char* AD = (unsigned char*)(a.ws + WS_AD) + 512;
    for (int it = c.bid * 512 + c.tid; it < (NTOK / 8) * 64; it += c.G * 512) {
        const int cg = it & 63, m0 = (it >> 6) * 8, t0 = m0 & (SEQ - 1), g = cg >> 4, w = 2 << g;
        const bf16_t* pc = P + cg * 8;
        u32x4 rows[23];
#pragma unroll
        for (int k = 0; k < 23; ++k) { const int dt = k - 15; rows[k] = (u32x4){0u, 0u, 0u, 0u}; if (dt > -w && t0 + dt >= 0) rows[k] = *(const u32x4*)(pc + (size_t)(m0 + dt) * DIN); }
        float s[8];
#pragma unroll
        for (int j = 0; j < 8; ++j) s[j] = 0.f;
#pragma unroll
        for (int k = 0; k < 15; ++k) { const u32x4 v = rows[k]; s[0] += bf_lo(v.x); s[1] += bf_hi(v.x); s[2] += bf_lo(v.y); s[3] += bf_hi(v.y); s[4] += bf_lo(v.z); s[5] += bf_hi(v.z); s[6] += bf_lo(v.w); s[7] += bf_hi(v.w); }
#pragma unroll
        for (int r = 0; r < 8; ++r) {
            const int t = t0 + r; const u32x4 v = rows[15 + r];
            const float f[8] = {bf_lo(v.x), bf_hi(v.x), bf_lo(v.y), bf_hi(v.y), bf_lo(v.z), bf_hi(v.z), bf_lo(v.w), bf_hi(v.w)};
#pragma unroll
            for (int j = 0; j < 8; ++j) s[j] += f[j];
            const int cnt = (t + 1 < w) ? t + 1 : w; const float ic = 1.f / (float)cnt;
            u32x2 o; o.x = pk4_fp8(s[0] * ic - f[0], s[1] * ic - f[1], s[2] * ic - f[2], s[3] * ic - f[3]); o.y = pk4_fp8(s[4] * ic - f[4], s[5] * ic - f[5], s[6] * ic - f[6], s[7] * ic - f[7]);
            *(u32x2*)(AD + (size_t)(m0 + r) * DM + cg * 8) = o;
            u32x4 q = rows[r];
            if (w == 8) q = rows[r + 8]; else if (w == 4) q = rows[r + 12]; else if (w == 2) q = rows[r + 14];
            s[0] -= bf_lo(q.x); s[1] -= bf_hi(q.x); s[2] -= bf_lo(q.y); s[3] -= bf_hi(q.y); s[4] -= bf_lo(q.z); s[5] -= bf_hi(q.z); s[6] -= bf_lo(q.w); s[7] -= bf_hi(q.w);
        }
    }
}

constexpr size_t WS_X1B = WS_X1, WS_X2B = WS_X1 + 64 * MiB;
constexpr int ROWS_PER_WAVE = 16;
DEVFN void vec_load(const float* p, int lane, f32x4 (&v)[4]) {
#pragma unroll
    for (int j = 0; j < 4; ++j) v[j] = *(const f32x4*)(p + 4 * lane + 256 * j);
}
DEVFN void bfrow_load(const bf16_t* p, int lane, u32x2 (&w)[4]) {
#pragma unroll
    for (int j = 0; j < 4; ++j) w[j] = *(const u32x2*)(p + 4 * lane + 256 * j);
}
DEVFN f32x4 bf4(u32x2 w) { return (f32x4){bf_lo(w.x), bf_hi(w.x), bf_lo(w.y), bf_hi(w.y)}; }
DEVFN void bfrow_store(bf16_t* p, int lane, const f32x4 (&v)[4]) {
#pragma unroll
    for (int j = 0; j < 4; ++j) { u32x2 o; o.x = pk2(v[j].x, v[j].y); o.y = pk2(v[j].z, v[j].w); *(u32x2*)(p + 4 * lane + 256 * j) = o; }
}
DEVFN void f8row_store(unsigned char* p, int lane, const f32x4 (&v)[4]) {
#pragma unroll
    for (int j = 0; j < 4; ++j) *(unsigned*)(p + 4 * lane + 256 * j) = pk4_fp8(v[j].x, v[j].y, v[j].z, v[j].w);
}
DEVFN void ln_mod(f32x4 (&v)[4], const f32x4 (&sc)[4], const f32x4 (&sh)[4]) {
    float mean, rstd; row_stats(v, mean, rstd);
#pragma unroll
    for (int j = 0; j < 4; ++j) v[j] = (v[j] - mean) * rstd * (sc[j] + 1.f) + sh[j];
}
DEVFN void ln_aff(f32x4 (&v)[4], const f32x4 (&g)[4], const f32x4 (&b)[4]) {
    float mean, rstd; row_stats(v, mean, rstd);
#pragma unroll
    for (int j = 0; j < 4; ++j) v[j] = (v[j] - mean) * rstd * g[j] + b[j];
}

DEVFN void ph_h1_rows(const Args& a, const Ctx& c) {
    const float* mod = (const float*)(a.ws + WS_MOD); bf16_t* HB = (bf16_t*)(a.ws + WS_HB);
    for (int base = c.gw * ROWS_PER_WAVE; base < NTOK; base += c.NGW * ROWS_PER_WAVE) {
        const float* mb = mod + (size_t)(base >> 11) * NMOD;
        f32x4 sc[4], sh[4]; vec_load(mb + DM, c.lane, sc); vec_load(mb, c.lane, sh);
        f32x4 cur[4], nxt[4]; vec_load(a.in[I_X] + (size_t)base * DM, c.lane, cur);
#pragma unroll 1
        for (int i = 0; i < ROWS_PER_WAVE; ++i) {
            const int m = base + i;
            if (i + 1 < ROWS_PER_WAVE) vec_load(a.in[I_X] + (size_t)(m + 1) * DM, c.lane, nxt);
            ln_mod(cur, sc, sh); f8row_store((unsigned char*)HB + (size_t)m * DM, c.lane, cur);
#pragma unroll
            for (int j = 0; j < 4; ++j) cur[j] = nxt[j];
        }
    }
}

DEVFN f32x4 reduce16(const float (&lg)[16]) {
    float t[8], u[4];
#pragma unroll
    for (int e = 0; e < 8; ++e) { auto rr = __builtin_amdgcn_permlane32_swap(__float_as_uint(lg[e]), __float_as_uint(lg[e + 8]), false, false); t[e] = __uint_as_float(rr[0]) + __uint_as_float(rr[1]); }
#pragma unroll
    for (int k = 0; k < 4; ++k) { auto rr = __builtin_amdgcn_permlane16_swap(__float_as_uint(t[k]), __float_as_uint(t[k + 4]), false, false); u[k] = __uint_as_float(rr[0]) + __uint_as_float(rr[1]); }
#pragma unroll
    for (int k = 0; k < 4; ++k) { u[k] = swz_xor_add(u[k], 1); u[k] = swz_xor_add(u[k], 2); u[k] = swz_xor_add(u[k], 4); u[k] = swz_xor_add(u[k], 8); }
    return (f32x4){u[0], u[1], u[2], u[3]};
}

DEVFN void rowc_load(const Args& a, int l, int m, int lane, f32x4 (&x)[4], unsigned (&y)[4]) {
    if (l == 0) vec_load(a.in[I_X] + (size_t)m * DM, lane, x);
    else { u32x2 w[4]; bfrow_load((const bf16_t*)(a.ws + WS_X2B) + (size_t)m * DM, lane, w);
#pragma unroll
        for (int j = 0; j < 4; ++j) { x[j].x = __uint_as_float(w[j].x); x[j].y = __uint_as_float(w[j].y); } }
#pragma unroll
    for (int j = 0; j < 4; ++j) y[j] = *(const unsigned*)((const unsigned char*)(a.ws + WS_QKVP) + (size_t)m * DM + 4 * lane + 256 * j);
}
DEVFN void rowc_step(const Args& a, int l, int m, int lane, const f32x4 (&x)[4], const unsigned (&y)[4], const float* vg1, const float* vsc, const float* vsh, f32x4 (&v)[4]) {
    int z_ = 0; asm volatile("" : "+v"(z_));
    f32x4 g1[4]; vec_load(vg1 + z_, lane, g1);
#pragma unroll
    for (int j = 0; j < 4; ++j) { const f32x4 xv = (l == 0) ? x[j] : bf4((u32x2){__float_as_uint(x[j].x), __float_as_uint(x[j].y)}); v[j] = xv * ALPHA + g1[j] * f8x4_to_f32(y[j], 1.f / YSCALE); }
    { f32x4 lg[4], lb[4]; vec_load(a.in[I_LN1G] + l * DM + z_, lane, lg); vec_load(a.in[I_LN1B] + l * DM + z_, lane, lb); ln_aff(v, lg, lb); }
    bfrow_store((bf16_t*)(a.ws + WS_X1B) + (size_t)m * DM, lane, v);
    { f32x4 sc[4], sh[4]; vec_load(vsc + z_, lane, sc); vec_load(vsh + z_, lane, sh); ln_mod(v, sc, sh); }
    f8row_store((unsigned char*)(a.ws + WS_HB) + (size_t)m * DM, lane, v);
}

DEVFN void ph_rows_c(const Args& a, const Ctx& c, int l, bool publish) {
    const float* mod = (const float*)(a.ws + WS_MOD) + (size_t)l * NB * NMOD;
    const bf16_t* Y = (const bf16_t*)(a.ws + WS_QKVP); const bf16_t* X2B = (const bf16_t*)(a.ws + WS_X2B);
    bf16_t* X1B = (bf16_t*)(a.ws + WS_X1B); bf16_t* HB = (bf16_t*)(a.ws + WS_HB);
    float* wr = (float*)c.lds;
    float* vsc = (float*)(c.lds + 65536); float* vsh = vsc + DM; float* vg1 = vsh + DM;
    int* lcnt = (int*)(c.lds + 65536 + 12288); int* lbase = lcnt + 32;
    int* rcls = lbase + 32; float* rw1 = (float*)(rcls + 8 * 64); float* rw2 = rw1 + 8 * 64; int* rrow = (int*)(rw2 + 8 * 64); float* lgs = (float*)(rrow + 8 * 64);
    for (int i = c.tid; i < DM * NE; i += 512) wr[(i & 15) * DM + (i >> 4)] = a.in[I_WR][i];
    if (c.tid < 32) lcnt[c.tid] = 0;
    __syncthreads();
    int nr = 0;
    for (int base = c.gw * ROWS_PER_WAVE; base < NTOK; base += c.NGW * ROWS_PER_WAVE) {
        const float* mb = mod + (size_t)(base >> 11) * NMOD;
        __syncthreads();
        for (int i = c.tid; i < 3 * DM; i += 512) vsc[i] = (i < DM) ? mb[4 * DM + i] : (i < 2 * DM ? mb[3 * DM + (i - DM)] : mb[2 * DM + (i - 2 * DM)]);
        __syncthreads();
#pragma unroll 1
        for (int i = 0; i < ROWS_PER_WAVE; i += 2) {
            const int m = __builtin_amdgcn_readfirstlane(base + i);
            f32x4 va[4], vb[4];
            { f32x4 xa[4], xb[4]; unsigned ya[4], yb[4];
              rowc_load(a, l, m, c.lane, xa, ya); rowc_load(a, l, m + 1, c.lane, xb, yb);
              rowc_step(a, l, m, c.lane, xa, ya, vg1, vsc, vsh, va);
              rowc_step(a, l, m + 1, c.lane, xb, yb, vg1, vsc, vsh, vb); }
            typedef float f32x2_t __attribute__((ext_vector_type(2)));
            f32x2_t acc2[16];
#pragma unroll
            for (int e = 0; e < 16; ++e) acc2[e] = (f32x2_t){0.f, 0.f};
#pragma unroll
            for (int j = 0; j < 4; ++j) {
                const f32x2_t p0 = {va[j].x, vb[j].x}, p1 = {va[j].y, vb[j].y}, p2 = {va[j].z, vb[j].z}, p3 = {va[j].w, vb[j].w};
#pragma unroll
                for (int e = 0; e < 16; ++e) { const f32x4 w = *(const f32x4*)(wr + e * DM + 4 * c.lane + 256 * j);
                    acc2[e] = __builtin_elementwise_fma(p0, (f32x2_t){w.x, w.x}, acc2[e]); acc2[e] = __builtin_elementwise_fma(p1, (f32x2_t){w.y, w.y}, acc2[e]);
                    acc2[e] = __builtin_elementwise_fma(p2, (f32x2_t){w.z, w.z}, acc2[e]); acc2[e] = __builtin_elementwise_fma(p3, (f32x2_t){w.w, w.w}, acc2[e]);
                    if ((e & 7) == 7) __builtin_amdgcn_sched_barrier(0); } }
            float la[16], lb2[16];
#pragma unroll
            for (int e = 0; e < 16; ++e) { la[e] = acc2[e].x; lb2[e] = acc2[e].y; }
            { const f32x4 ua = reduce16(la), ub = reduce16(lb2);
              if ((c.lane & 15) == 0) { *(f32x4*)(lgs + (c.wave * 16 + i) * 16 + (c.lane >> 4) * 4) = ua; *(f32x4*)(lgs + (c.wave * 16 + i + 1) * 16 + (c.lane >> 4) * 4) = ub; } }
        }
        LDS_WAIT();
        if (c.lane < ROWS_PER_WAVE) {
            float lg16[16], rb[16];
#pragma unroll
            for (int e = 0; e < 16; ++e) rb[e] = a.in[I_RB][e];
#pragma unroll
            for (int q = 0; q < 4; ++q) { const f32x4 t = *(const f32x4*)(lgs + (c.wave * 16 + c.lane) * 16 + 4 * q); lg16[4 * q] = t.x; lg16[4 * q + 1] = t.y; lg16[4 * q + 2] = t.z; lg16[4 * q + 3] = t.w; }
            float mx = lg16[0];
#pragma unroll
            for (int e = 1; e < 16; ++e) mx = fmaxf(mx, lg16[e]);
            float sum = 0.f, scr[16];
#pragma unroll
            for (int e = 0; e < 16; ++e) { scr[e] = __expf(lg16[e] - mx); sum += scr[e]; }
            const float isum = 1.f / sum;
#pragma unroll
            for (int e = 0; e < 16; ++e) scr[e] *= isum;
            float bestg = -3.4e38f; int gb = 0, bi1 = 0, bi2 = 1; float bw1 = 0.f, bw2 = 0.f;
#pragma unroll
            for (int g = 0; g < 4; ++g) {
                float m1 = scr[4 * g] + rb[4 * g], s1 = scr[4 * g]; int i1 = 0;
#pragma unroll
                for (int q = 1; q < 4; ++q) { const float sv = scr[4 * g + q] + rb[4 * g + q]; const bool ok = sv > m1; m1 = ok ? sv : m1; s1 = ok ? scr[4 * g + q] : s1; i1 = ok ? q : i1; }
                float m2 = -3.4e38f, s2 = 0.f; int i2 = 0;
#pragma unroll
                for (int q = 0; q < 4; ++q) { const float sv = scr[4 * g + q] + rb[4 * g + q]; const bool ok = (q != i1) && sv > m2; m2 = ok ? sv : m2; s2 = ok ? scr[4 * g + q] : s2; i2 = ok ? q : i2; }
                const float gs = m1 + m2; const bool better = gs > bestg;
                bestg = better ? gs : bestg; gb = better ? g : gb; bi1 = better ? i1 : bi1; bi2 = better ? i2 : bi2; bw1 = better ? s1 : bw1; bw2 = better ? s2 : bw2;
            }
            const float inv = 1.f / (bw1 + bw2);
            const int lo = bi1 < bi2 ? bi1 : bi2, hi2 = bi1 < bi2 ? bi2 : bi1;
            const float wlo = (bi1 < bi2 ? bw1 : bw2) * inv, whi = (bi1 < bi2 ? bw2 : bw1) * inv;
            const int pidx = lo == 0 ? hi2 - 1 : (lo == 1 ? hi2 + 1 : 5);
            const int slot = c.wave * 64 + nr + c.lane;
            rcls[slot] = gb * 6 + pidx; rw1[slot] = wlo; rw2[slot] = whi; rrow[slot] = base + c.lane;
        }
        nr += ROWS_PER_WAVE;
        LDS_WAIT();
    }
    LDS_WAIT();
    if (!publish) return;
    int rank = 0, cls = 0;
    if (c.lane < nr) { cls = rcls[c.wave * 64 + c.lane]; rank = atomicAdd(&lcnt[cls], 1); }
    __syncthreads();
    if (c.tid < NCLS) lbase[c.tid] = (int)__hip_atomic_fetch_add((unsigned*)(a.ws + WS_CTL) + CW_CNT + l * 32 + c.tid, (unsigned)lcnt[c.tid], RLX_AGENT);
    __syncthreads();
    if (c.lane < nr) {
        const int pos = lbase[cls] + rank;
        ((int*)(a.ws + WS_LIST))[(size_t)cls * LISTCAP + pos] = rrow[c.wave * 64 + c.lane];
        float* rw = (float*)(a.ws + WS_RW) + ((size_t)cls * LISTCAP + pos) * 2;
        rw[0] = rw1[c.wave * 64 + c.lane]; rw[1] = rw2[c.wave * 64 + c.lane];
    }
}

DEVFN void ph_rows_g(const Args& a, const Ctx& c, int l) {
    const float* mod = (const float*)(a.ws + WS_MOD) + (size_t)l * NB * NMOD;
    const bf16_t* X1B = (const bf16_t*)(a.ws + WS_X1B); const unsigned char* Y2 = (const unsigned char*)(a.ws + WS_AD);
    bf16_t* X2B = (bf16_t*)(a.ws + WS_X2B); bf16_t* HB = (bf16_t*)(a.ws + WS_HB);
    for (int base = c.gw * ROWS_PER_WAVE; base < NTOK; base += c.NGW * ROWS_PER_WAVE) {
        const float* mb = mod + (size_t)(base >> 11) * NMOD; const float* mb1 = mb + (size_t)NB * NMOD;
        f32x4 g2[4], lg[4], lb[4], sc[4], sh[4];
        vec_load(mb + 5 * DM, c.lane, g2); vec_load(a.in[I_LN2G] + l * DM, c.lane, lg); vec_load(a.in[I_LN2B] + l * DM, c.lane, lb);
        if (l == 0) { vec_load(mb1 + DM, c.lane, sc); vec_load(mb1, c.lane, sh); }
        u32x2 xc[4], xn[4]; unsigned yc[4], yn[4];
        bfrow_load(X1B + (size_t)base * DM, c.lane, xc);
#pragma unroll
        for (int j = 0; j < 4; ++j) yc[j] = *(const unsigned*)(Y2 + (size_t)base * DM + 4 * c.lane + 256 * j);
#pragma unroll 1
        for (int i = 0; i < ROWS_PER_WAVE; ++i) {
            const int m = base + i;
            if (i + 1 < ROWS_PER_WAVE) { bfrow_load(X1B + (size_t)(m + 1) * DM, c.lane, xn);
#pragma unroll
                for (int j = 0; j < 4; ++j) yn[j] = *(const unsigned*)(Y2 + (size_t)(m + 1) * DM + 4 * c.lane + 256 * j); }
            f32x4 v[4];
#pragma unroll
            for (int j = 0; j < 4; ++j) v[j] = bf4(xc[j]) * ALPHA + g2[j] * f8x4_to_f32(yc[j], 1.f / YSCALE);
            ln_aff(v, lg, lb);
            if (l == 0) { bfrow_store(X2B + (size_t)m * DM, c.lane, v); ln_mod(v, sc, sh); f8row_store((unsigned char*)HB + (size_t)m * DM, c.lane, v); }
            else {
#pragma unroll
                for (int j = 0; j < 4; ++j) *(f32x4*)(a.out + (size_t)m * DM + 4 * c.lane + 256 * j) = v[j]; }
#pragma unroll
            for (int j = 0; j < 4; ++j) { xc[j] = xn[j]; yc[j] = yn[j]; }
        }
    }
}

constexpr int MOETAB_OFF = 131072 + 512;
DEVFN void ph_inproj_fast(const Args& a, const Ctx& c, int l, bool dummy_kbar) {
    pg8::DenseSched S; S.so.init(NTOK, DIN, c.G, c.bid); S.A = (const char*)(a.ws + WS_HB); S.Bt = (const char*)(a.ws + WS_WIN) + (size_t)l * DIN * DM; S.lda = DM; S.ldb = DM;
    const pg8::EpiInproj E{(bf16_t*)(a.ws + WS_QKVP), (const float*)(a.ws + WS_ROPE), (dummy_kbar ? (float*)(a.ws + WS_RW) : (float*)(a.ws + WS_KBAR)) + (size_t)l * NB * NH * NBLK * HD};
    pg8::gemm_phase2<pg8::EpiInproj, pg8::DenseSched, true, true, false, true, 127 - 5, 127>(c.lds3, DM, DM, S, E, c.tid);
}
DEVFN void ph_wout_fast(const Args& a, const Ctx& c, int l) {
    pg8::DenseSched S; S.so.init(NTOK, DM, c.G, c.bid); S.A = (const char*)(a.ws + WS_AD); S.Bt = (const char*)(a.ws + WS_WOUT) + (size_t)l * DM * DM; S.lda = DM; S.ldb = DM;
    const pg8::EpiF8 E{(unsigned char*)(a.ws + WS_QKVP), DM};
    pg8::gemm_phase2<pg8::EpiF8, pg8::DenseSched, true, true, false, true, 127 - 5, 127 - 5, true, 127 - 7, 127>(c.lds3, DM, DM, S, E, c.tid);
}
DEVFN void moe_table_lds(const Args& a, const Ctx& c, int l) {
    int* cnt = (int*)(c.lds + MOETAB_OFF); int* tp = cnt + 32;
    if (c.tid < NCLS) cnt[c.tid] = (int)__hip_atomic_load((unsigned*)(a.ws + WS_CTL) + CW_CNT + l * 32 + c.tid, RLX_AGENT);
    __syncthreads();
    if (c.tid == 0) { int s = 0; for (int k = 0; k < NCLS; ++k) { tp[k] = s; s += (cnt[k] + 255) >> 8; } tp[NCLS] = s; }
    __syncthreads();
}
DEVFN void ph_gateup_fast(const Args& a, const Ctx& c, int l) {
    moe_table_lds(a, c, l);
    pg8::GateUpSched S; S.cnt = (const LAS int*)(c.lds3 + MOETAB_OFF); S.tp = S.cnt + 32; S.npn_shift = 3; S.nunits = S.tp[NCLS] * 8; S.G = c.G; S.c = (c.G % 8 == 0) ? (c.bid % 8) * (c.G / 8) + c.bid / 8 : c.bid;
    S.HB = (const char*)(a.ws + WS_HB); S.list = (const int*)(a.ws + WS_LIST); S.W = (const char*)(a.ws + WS_WGU) + (size_t)l * NE * DM * DM;
    const pg8::EpiGateUp E{(unsigned char*)(a.ws + WS_QKVP), (const float*)(a.ws + WS_RW)};
    pg8::gemm_phase2<pg8::EpiGateUp, pg8::GateUpSched, true, true, false, true, 127 - 5, 127>(c.lds3, DM, DM, S, E, c.tid);
}
DEVFN void ph_down_fast(const Args& a, const Ctx& c, int l) {
    moe_table_lds(a, c, l);
    pg8::DownSched S; S.cnt = (const LAS int*)(c.lds3 + MOETAB_OFF); S.tp = S.cnt + 32; S.npn_shift = 2; S.nunits = S.tp[NCLS] * 4; S.G = c.G; S.c = (c.G % 8 == 0) ? (c.bid % 8) * (c.G / 8) + c.bid / 8 : c.bid;
    S.ACT = (const char*)(a.ws + WS_QKVP); S.W = (const char*)(a.ws + WS_WD) + (size_t)l * NE * DM * DE;
    const pg8::EpiDown E{(unsigned char*)(a.ws + WS_AD), (const int*)(a.ws + WS_LIST)};
    pg8::gemm_phase2<pg8::EpiDown, pg8::DownSched, true, true, true, true, 127 - 5, 127 - 3>(c.lds3, DM, DE, S, E, c.tid);
}

#ifndef MK_N_LAUNCHES
#define MK_N_LAUNCHES 1
#endif
constexpr int RING_BYTES = 131072, LDSCTL_OFF = RING_BYTES, MISC_OFF = LDSCTL_OFF + 320, LDS_BYTES = 147456;
constexpr int PH_PER_LAYER = 7, NPHASE = 2 + 2 * PH_PER_LAYER;
constexpr int CW_BAR = 4096;
static_assert((CW_BAR + XCD_BAR_WORDS) * 4 <= (int)CTL_ZERO_BYTES, "CTL");

__global__ void __launch_bounds__(512, 2) fwd(Args a) {
    extern __shared__ __attribute__((aligned(16))) unsigned char lds[];
    const int wave_s = __builtin_amdgcn_readfirstlane(threadIdx.x >> 6);
#define MKTID() (wave_s * 64 + lane_id_volatile())
#define MKCTX() Args al = a; { size_t z_ = 0; asm volatile("" : "+s"(z_)); al.ws = a.ws + z_; } Ctx c; {     int t_ = MKTID(); asm volatile("" : "+v"(t_)); c.lds = lds; c.lds3 = (LAS unsigned char*)lds; c.tid = t_; c.lane = t_ & 63; c.wave = __builtin_amdgcn_readfirstlane(t_ >> 6); c.G = gridDim.x; c.bid = blockIdx.x; c.gw = c.bid * 8 + c.wave; c.NGW = c.G * 8; }
    const int lo = a.ph_lo, hi = a.ph_hi;
    const bool one = (hi - lo) > 1;
    for (int u = threadIdx.x; u < (LDS_BYTES - LDSCTL_OFF) / 4; u += 512) ((LAS unsigned*)((LAS unsigned char*)lds + LDSCTL_OFF))[u] = 0u;
    __syncthreads();
    XcdBarrier bar; bar.bar = (unsigned*)(a.ws + WS_CTL) + CW_BAR; bar.x = 0; bar.st = nullptr;
    if (one) bar = xcd_barrier_post((unsigned*)(a.ws + WS_CTL) + CW_BAR, (volatile LAS unsigned*)((LAS unsigned char*)lds + MISC_OFF) + 8);
#ifndef REP_PHASE
#define REP_PHASE -1
#endif
#define IN(k) (lo <= (k) && (k) < hi)
#define SEAM(k) do { if (IN(k) && IN((k) + 1)) { XcdBarrier bl_ = bar; { size_t z_ = 0; unsigned x_ = bar.x; asm volatile("" : "+s"(z_), "+s"(x_)); bl_.bar = bar.bar + z_; bl_.x = x_; } xcd_barrier(bl_, MKTID() == 0); } } while (0)
    if (IN(0)) { MKCTX(); ph_prologue(al, c); if (REP_PHASE == 0) { __syncthreads(); ph_prologue(al, c); } SEAM(0); }
    if (IN(1)) { MKCTX(); ph_h1_rows(al, c); if (REP_PHASE == 1) ph_h1_rows(al, c); SEAM(1); }
    {
        constexpr int l = 0; constexpr int p0 = 2 + l * PH_PER_LAYER;
        if (IN(p0 + 0)) { MKCTX(); ph_inproj_fast(al, c, l, false); if (REP_PHASE == 10) { __syncthreads(); ph_inproj_fast(al, c, l, true); } SEAM(p0 + 0); }
        if (IN(p0 + 1)) {
            { MKCTX(); ph_pool(al, c); }
            __syncthreads();
            const attn_body::AttnTensors AT{(const attn_body::bf16*)(a.ws + WS_QKVP), (const attn_body::bf16*)(a.ws + WS_QKVP) + 512, (const attn_body::bf16*)(a.ws + WS_QKVP) + 1024,
                                            (attn_body::bf16*)(a.ws + WS_AD), (const float*)(a.ws + WS_KBAR) + (size_t)l * NB * NH * NBLK * HD};
            const attn_body::StaticOrder S((int)gridDim.x, (int)blockIdx.x);
            attn_body::attn_phase<attn_body::StaticOrder>((char*)lds, AT, S, MKTID());
            if (REP_PHASE == 11) attn_body::attn_phase<attn_body::StaticOrder>((char*)lds, AT, S, MKTID());
            if (REP_PHASE == 17) { __syncthreads(); MKCTX(); ph_pool(al, c); }
            SEAM(p0 + 1);
        }
        if (IN(p0 + 2)) { MKCTX(); ph_wout_fast(al, c, l); if (REP_PHASE == 12) { __syncthreads(); ph_wout_fast(al, c, l); } SEAM(p0 + 2); }
        if (IN(p0 + 3)) { MKCTX(); if (REP_PHASE == 13) { ph_rows_c(al, c, l, false); __syncthreads(); } ph_rows_c(al, c, l, true); SEAM(p0 + 3); }
        if (IN(p0 + 4)) { MKCTX(); ph_gateup_fast(al, c, l); if (REP_PHASE == 14) { __syncthreads(); ph_gateup_fast(al, c, l); } SEAM(p0 + 4); }
        if (IN(p0 + 5)) { MKCTX(); ph_down_fast(al, c, l); if (REP_PHASE == 15) { __syncthreads(); ph_down_fast(al, c, l); } SEAM(p0 + 5); }
        if (IN(p0 + 6)) { MKCTX(); ph_rows_g(al, c, l); if (REP_PHASE == 16) ph_rows_g(al, c, l); SEAM(p0 + 6); }
    }
    {
        constexpr int l = 1; constexpr int p0 = 2 + l * PH_PER_LAYER;
        if (IN(p0 + 0)) { MKCTX(); ph_inproj_fast(al, c, l, false); if (REP_PHASE == 10) { __syncthreads(); ph_inproj_fast(al, c, l, true); } SEAM(p0 + 0); }
        if (IN(p0 + 1)) {
            { MKCTX(); ph_pool(al, c); }
            __syncthreads();
            const attn_body::AttnTensors AT{(const attn_body::bf16*)(a.ws + WS_QKVP), (const attn_body::bf16*)(a.ws + WS_QKVP) + 512, (const attn_body::bf16*)(a.ws + WS_QKVP) + 1024,
                                            (attn_body::bf16*)(a.ws + WS_AD), (const float*)(a.ws + WS_KBAR) + (size_t)l * NB * NH * NBLK * HD};
            const attn_body::StaticOrder S((int)gridDim.x, (int)blockIdx.x);
            attn_body::attn_phase<attn_body::StaticOrder>((char*)lds, AT, S, MKTID());
            if (REP_PHASE == 11) attn_body::attn_phase<attn_body::StaticOrder>((char*)lds, AT, S, MKTID());
            if (REP_PHASE == 17) { __syncthreads(); MKCTX(); ph_pool(al, c); }
            SEAM(p0 + 1);
        }
        if (IN(p0 + 2)) { MKCTX(); ph_wout_fast(al, c, l); if (REP_PHASE == 12) { __syncthreads(); ph_wout_fast(al, c, l); } SEAM(p0 + 2); }
        if (IN(p0 + 3)) { MKCTX(); if (REP_PHASE == 13) { ph_rows_c(al, c, l, false); __syncthreads(); } ph_rows_c(al, c, l, true); SEAM(p0 + 3); }
        if (IN(p0 + 4)) { MKCTX(); ph_gateup_fast(al, c, l); if (REP_PHASE == 14) { __syncthreads(); ph_gateup_fast(al, c, l); } SEAM(p0 + 4); }
        if (IN(p0 + 5)) { MKCTX(); ph_down_fast(al, c, l); if (REP_PHASE == 15) { __syncthreads(); ph_down_fast(al, c, l); } SEAM(p0 + 5); }
        if (IN(p0 + 6)) { MKCTX(); ph_rows_g(al, c, l); if (REP_PHASE == 16) ph_rows_g(al, c, l); SEAM(p0 + 6); }
    }
#undef IN
#undef SEAM
}

extern "C" void kernel_launch(void* const* d_in, const int* in_sizes, int n_in, void* d_out, int out_size, void* d_ws, size_t ws_size, hipStream_t stream) {
    static int grid = 0;
    if (grid == 0) {
        if (n_in != 17 || out_size != NTOK * DM || ws_size < WS_END) { fprintf(stderr, "kernel_launch: unexpected problem (n_in %d out %d ws %zu)\n", n_in, out_size, ws_size); grid = -1; return; }
        if (hipFuncSetAttribute((const void*)fwd, hipFuncAttributeMaxDynamicSharedMemorySize, LDS_BYTES) != hipSuccess) { fprintf(stderr, "kernel_launch: hipFuncSetAttribute failed\n"); grid = -1; return; }
        int dev = 0, cus = 0, per_cu = 0;
        (void)hipGetDevice(&dev); (void)hipDeviceGetAttribute(&cus, hipDeviceAttributeMultiprocessorCount, dev);
        if (hipOccupancyMaxActiveBlocksPerMultiprocessor(&per_cu, (const void*)fwd, 512, LDS_BYTES) != hipSuccess || per_cu < 1) fprintf(stderr, "kernel_launch: occupancy query reports %d workgroups per CU\n", per_cu);
        (void)hipGetLastError();
        grid = cus > 0 ? cus : 256;
    }
    if (grid < 0) return;
    (void)hipMemsetAsync((char*)d_ws + WS_CTL, 0, CTL_ZERO_BYTES, stream);
    Args a{};
    for (int i = 0; i < 17; ++i) a.in[i] = (const float*)d_in[i];
    a.out = (float*)d_out; a.ws = (unsigned char*)d_ws;
#if MK_N_LAUNCHES == 1
    a.ph_lo = 0; a.ph_hi = NPHASE; hipLaunchKernelGGL(fwd, dim3(grid), dim3(512), LDS_BYTES, stream, a);
#else
    for (int p = 0; p < NPHASE; ++p) { a.ph_lo = p; a.ph_hi = p + 1; hipLaunchKernelGGL(fwd, dim3(grid), dim3(512), LDS_BYTES, stream, a); }
#endif
}
```

```cpp
#include <hip/hip_runtime.h>
#include <cstdint>
#include <cstdio>

constexpr int NB = 16, SEQ = 2048, DM = 1024, NTOK = NB * SEQ, DIN = 2048, NH = 8, HD = 64, NBLK = 8, MBLK = 256;
constexpr int NE = 16, NCLS = 24, DE = 512, NMOD = 6 * DM;
constexpr float ALPHA = 1.41421356237309515f, LN_EPS = 1e-5f;
constexpr float QSCALE = 0.125f * 1.4426950408889634f;
constexpr int LISTCAP = NTOK;

constexpr size_t MiB = 1u << 20;
constexpr size_t WS_CTL = 0, CTL_ZERO_BYTES = 1 * MiB;
constexpr size_t WS_MOD = 1 * MiB;
constexpr size_t WS_ROPE = 2 * MiB;
constexpr size_t WS_KBAR = 2 * MiB + 256 * 1024;
constexpr size_t WS_LIST = 3 * MiB;
constexpr size_t WS_RW = 6 * MiB;
constexpr size_t WS_WIN = 12 * MiB;
constexpr size_t WS_WOUT = 20 * MiB;
constexpr size_t WS_WGU = 24 * MiB;
constexpr size_t WS_WD = 88 * MiB;
constexpr size_t WS_HB = 120 * MiB;
constexpr size_t WS_QKVP = 184 * MiB;
constexpr size_t WS_AD = 312 * MiB;
constexpr size_t WS_X1 = 376 * MiB;
constexpr size_t WS_END = 504 * MiB;
constexpr int CW_TMO = 0, CW_CNT = 64;

typedef unsigned short bf16_t;
typedef short bf16x8 __attribute__((ext_vector_type(8)));
typedef float f32x4 __attribute__((ext_vector_type(4)));
typedef float f32x16 __attribute__((ext_vector_type(16)));
typedef unsigned u32x4 __attribute__((ext_vector_type(4)));
typedef unsigned u32x2 __attribute__((ext_vector_type(2)));

#define DEVFN __device__ __forceinline__
#define LDS_WAIT() asm volatile("s_waitcnt lgkmcnt(0)" ::: "memory")
#define RLX_AGENT __ATOMIC_RELAXED, __HIP_MEMORY_SCOPE_AGENT

DEVFN float bf_lo(unsigned w) { return __uint_as_float(w << 16); }
DEVFN float bf_hi(unsigned w) { return __uint_as_float(w & 0xffff0000u); }
DEVFN float bf2f(bf16_t v) { return __uint_as_float((unsigned)v << 16); }
DEVFN unsigned f2bf(float f) { unsigned u = __float_as_uint(f); return (u + 0x7fffu + ((u >> 16) & 1u)) >> 16; }
DEVFN unsigned pk2(float lo, float hi) { unsigned r; asm("v_cvt_pk_bf16_f32 %0, %1, %2" : "=v"(r) : "v"(lo), "v"(hi)); return r; }
DEVFN unsigned pk4_fp8(float a, float b, float c, float d) {
    a = __builtin_amdgcn_fmed3f(a, -448.f, 448.f); b = __builtin_amdgcn_fmed3f(b, -448.f, 448.f); c = __builtin_amdgcn_fmed3f(c, -448.f, 448.f); d = __builtin_amdgcn_fmed3f(d, -448.f, 448.f);
    unsigned w = 0u; w = __builtin_amdgcn_cvt_pk_fp8_f32(a, b, w, false); w = __builtin_amdgcn_cvt_pk_fp8_f32(c, d, w, true); return w; }
DEVFN f32x4 f8x4_to_f32(unsigned w, float sc) { const auto lo = __builtin_amdgcn_cvt_pk_f32_fp8(w, false), hi = __builtin_amdgcn_cvt_pk_f32_fp8(w, true); return (f32x4){lo[0] * sc, lo[1] * sc, hi[0] * sc, hi[1] * sc}; }
constexpr float YSCALE = 16.f;
DEVFN int crow(int r, int hi) { return (r & 3) + 8 * (r >> 2) + 4 * hi; }
#define SWZ_XOR(m) (0x1f | ((m) << 10))
DEVFN float swz_xor_add(float v, const int m) {
    switch (m) {
        case 1: return v + __int_as_float(__builtin_amdgcn_ds_swizzle(__float_as_int(v), SWZ_XOR(1)));
        case 2: return v + __int_as_float(__builtin_amdgcn_ds_swizzle(__float_as_int(v), SWZ_XOR(2)));
        case 4: return v + __int_as_float(__builtin_amdgcn_ds_swizzle(__float_as_int(v), SWZ_XOR(4)));
        case 8: return v + __int_as_float(__builtin_amdgcn_ds_swizzle(__float_as_int(v), SWZ_XOR(8)));
        default: return v + __int_as_float(__builtin_amdgcn_ds_swizzle(__float_as_int(v), SWZ_XOR(16)));
    }
}
DEVFN float half_swap_add(float v) { auto rr = __builtin_amdgcn_permlane32_swap(__float_as_uint(v), __float_as_uint(v), false, false); return __uint_as_float(rr[0]) + __uint_as_float(rr[1]); }
DEVFN float wave_sum(float v) {
    v = swz_xor_add(v, 1); v = swz_xor_add(v, 2); v = swz_xor_add(v, 4); v = swz_xor_add(v, 8); v = swz_xor_add(v, 16);
    return half_swap_add(v);
}
__host__ __device__ __forceinline__ int inproj_lgroup(int P) { return P < 16 ? (P >> 2) * 8 + (P & 3) * 2 : ((P - 16) >> 2) * 8 + ((P - 16) & 3) * 2 + 1; }
__host__ __device__ __forceinline__ int inproj_nlog(int n) { return (n & ~255) + inproj_lgroup((n & 255) >> 3) * 8 + (n & 7); }

#define GAS __attribute__((address_space(1)))
#define LAS __attribute__((address_space(3)))
typedef GAS unsigned gu32;
namespace pg8 {
#define PG8_LAS __attribute__((address_space(3)))
typedef unsigned short bf16_t;
typedef short bf16x8 __attribute__((ext_vector_type(8)));
typedef float f32x4 __attribute__((ext_vector_type(4)));
typedef unsigned u32x4 __attribute__((ext_vector_type(4)));
constexpr int BM = 256, BK = 64, HALF = 128, HTB = HALF * BK * 2  , STAGE_BYTES = 8 * HTB, NXCD = 8, WGM = 8;

__host__ __device__ __forceinline__ int lds_byte(int r, int c) { const int st = (r >> 4) * 2 + (c >> 5), rr = r & 15, cc = c & 31, ob = rr * 64 + cc * 2; return st * 1024 + (ob ^ (((ob >> 9) & 1) << 5)); }
__host__ __device__ __forceinline__ void stage_rc(int b, int& R, int& C) { const int st = b / 1024, sb = b % 1024, swz = sb ^ (((sb >> 9) & 1) << 5); R = (st >> 1) * 16 + swz / 64; C = (st & 1) * 32 + (swz % 64) / 2; }
__host__ __device__ __forceinline__ int perm32(int rho) { const int n = rho >> 4, i = rho & 15; return 8 * (i >> 2) + 4 * n + (i & 3); }

struct Unit { int pm, pn; };
struct Gemm { const bf16_t* A; const bf16_t* Bt; int M, N, K; };

struct StaticOrder {
    int nM, nN, nwg, G, c;
    __host__ __device__ void init(int M, int N, int G_, int c_) { nM = M / BM; nN = N / BM; nwg = nM * nN; G = G_; c = c_; }
    __host__ __device__ bool next(int i, Unit& u) const {
        const long L = (long)i * G + c; if (L >= nwg) return false;
        int wgid = (int)L; { const int q = nwg / NXCD, r = nwg % NXCD, xcd = wgid % NXCD, off = wgid / NXCD; wgid = (xcd < r ? xcd * (q + 1) : r * (q + 1) + (xcd - r) * q) + off; }
        const int nig = WGM * nN, gid = wgid / nig, fm = gid * WGM, gsz = (nM - fm) < WGM ? (nM - fm) : WGM;
        u.pm = fm + ((wgid % nig) % gsz); u.pn = (wgid % nig) / gsz; return true;
    }
    __device__ __forceinline__ void a_ready(const Unit&) const {}
    __device__ __forceinline__ void done(const Unit&) const {}
};

__device__ __forceinline__ unsigned cvt_pk_bf16(float lo, float hi) { unsigned r; asm volatile("v_cvt_pk_bf16_f32 %0, %1, %2" : "=v"(r) : "v"(lo), "v"(hi)); return r; }
}
namespace pg8 {
typedef int v8i_t __attribute__((ext_vector_type(8))); typedef int v4i_t __attribute__((ext_vector_type(4)));
__device__ __forceinline__ int pg8_lane_volatile() { int l; asm volatile("v_mbcnt_lo_u32_b32 %0, -1, 0\n\tv_mbcnt_hi_u32_b32 %0, -1, %0" : "=v"(l)); return l; }
template <class Epi, class Sched, bool ALIGN_EPI, bool GATHER, bool KSPLIT, bool FP8 = false, int SCW = 127, int SCA = 127, bool SC2 = false, int SCW2 = 127, int SCA2 = 127>
__device__ __forceinline__ void gemm_phase2(PG8_LAS unsigned char* lds, const int Kbytes, const int ldb_bytes, const Sched& S, const Epi& E, const int tid) {
    typedef typename Sched::UnitT UnitT;
    const int wid = __builtin_amdgcn_readfirstlane(tid >> 6), lane = tid & 63, wr = wid >> 2, wc = wid & 3, fr = lane & 15, fq = lane >> 4;
    int nt = Kbytes / (BK * 2); asm volatile("" : "+s"(nt));
    const int nth = nt / 2;
    unsigned voffB[2];
#pragma unroll
    for (int i = 0; i < 2; ++i) { int R[2], C[2]; stage_rc(tid * 16 + i * 8192, R[i], C[i]); const int Rb = Epi::PERM ? ((R[i] & ~31) + perm32(R[i] & 31)) : R[i]; voffB[i] = (unsigned)(Rb * ldb_bytes + C[i] * 2); }
    const size_t kstep = (size_t)(BK * 2);
    const size_t hstepB = (size_t)HALF * ldb_bytes;
    const unsigned ldsw = (unsigned)wid * 1024u;
    const int aoff = lds_byte(wr * 64 + fr, fq * 8), boff = lds_byte(wc * 32 + fr, fq * 8);
#define PG8_SA(b, h) (((b) * 2 + (h)) * HTB)
#define PG8_SB(b, h) ((4 + (b) * 2 + (h)) * HTB)
#define PG8_STAGE(bufoff, gbase, voff) do { _Pragma("unroll") for (int _i = 0; _i < 2; ++_i) \
        __builtin_amdgcn_global_load_lds((const unsigned*)((const char*)(gbase) + (voff)[_i]), (PG8_LAS unsigned*)(lds + (bufoff) + ldsw + _i * 8192), 16, 0, 0); } while (0)
#define PG8_LDA(dst, b, h) do { _Pragma("unroll") for (int m = 0; m < 4; ++m) _Pragma("unroll") for (int k = 0; k < 2; ++k) dst[m][k] = *(const PG8_LAS bf16x8*)(lds + PG8_SA(b, h) + aoff + m * 2048 + k * 1024); } while (0)
#define PG8_LDB(dst, b, h) do { _Pragma("unroll") for (int n = 0; n < 2; ++n) _Pragma("unroll") for (int k = 0; k < 2; ++k) dst[n][k] = *(const PG8_LAS bf16x8*)(lds + PG8_SB(b, h) + boff + n * 2048 + k * 1024); } while (0)
#define PG8_CAT8(x) __builtin_shufflevector(__builtin_bit_cast(v4i_t, (x)[0]), __builtin_bit_cast(v4i_t, (x)[1]), 0, 1, 2, 3, 4, 5, 6, 7)
#define PG8_MMA(ai, bj, At, Bt) do { __builtin_amdgcn_s_setprio(1); \
        if constexpr (FP8) { _Pragma("unroll") for (int m = 0; m < 4; ++m) _Pragma("unroll") for (int n = 0; n < 2; ++n) \
            acc[ai][bj][m][n] = __builtin_amdgcn_mfma_scale_f32_16x16x128_f8f6f4(PG8_CAT8(Bt[n]), PG8_CAT8(At[m]), acc[ai][bj][m][n], 0, 0, 0, scw_, 0, sca_); } \
        else { _Pragma("unroll") for (int m = 0; m < 4; ++m) _Pragma("unroll") for (int n = 0; n < 2; ++n) _Pragma("unroll") for (int k = 0; k < 2; ++k) \
            acc[ai][bj][m][n] = __builtin_amdgcn_mfma_f32_16x16x32_bf16(Bt[n][k], At[m][k], acc[ai][bj][m][n], 0, 0, 0); } \
        __builtin_amdgcn_s_setprio(0); } while (0)
#define PG8_STAGE1(bufoff, gbase, voff, _i) __builtin_amdgcn_global_load_lds((const unsigned*)((const char*)(gbase) + (voff)[_i]), (PG8_LAS unsigned*)(lds + (bufoff) + ldsw + (_i) * 8192), 16, 0, 0)
#define PG8_MF(ai, bj, m, n, At, Bt) do { if constexpr (FP8) acc[ai][bj][m][n] = __builtin_amdgcn_mfma_scale_f32_16x16x128_f8f6f4(PG8_CAT8(Bt[n]), PG8_CAT8(At[m]), acc[ai][bj][m][n], 0, 0, 0, scw_, 0, sca_); \
        else { acc[ai][bj][m][n] = __builtin_amdgcn_mfma_f32_16x16x32_bf16(Bt[n][0], At[m][0], acc[ai][bj][m][n], 0, 0, 0); acc[ai][bj][m][n] = __builtin_amdgcn_mfma_f32_16x16x32_bf16(Bt[n][1], At[m][1], acc[ai][bj][m][n], 0, 0, 0); } } while (0)
#define PG8_MF2(ai, bj, m, At, Bt) do { PG8_MF(ai, bj, m, 0, At, Bt); PG8_MF(ai, bj, m, 1, At, Bt); PG8_SCHED; } while (0)
#define PG8_CL1(ai, At, S0) do { __builtin_amdgcn_s_setprio(1); PG8_MF2(ai, 0, 0, At, B0); PG8_MF2(ai, 0, 1, At, B0); S0(0); PG8_SCHED; PG8_MF2(ai, 0, 2, At, B0); PG8_MF2(ai, 0, 3, At, B0); S0(1); PG8_SCHED; \
        PG8_MF2(ai, 1, 0, At, B1); PG8_MF2(ai, 1, 1, At, B1); PG8_MF2(ai, 1, 2, At, B1); PG8_MF2(ai, 1, 3, At, B1); __builtin_amdgcn_s_setprio(0); } while (0)
#define PG8_CL2(ai, At, S0, S1, S2) do { __builtin_amdgcn_s_setprio(1); PG8_MF2(ai, 0, 0, At, B0); S0(0); PG8_SCHED; PG8_MF2(ai, 0, 1, At, B0); S0(1); PG8_SCHED; PG8_MF2(ai, 0, 2, At, B0); S1(0); PG8_SCHED; PG8_MF2(ai, 0, 3, At, B0); S1(1); PG8_SCHED; \
        PG8_MF2(ai, 1, 0, At, B1); S2(0); PG8_SCHED; PG8_MF2(ai, 1, 1, At, B1); S2(1); PG8_SCHED; PG8_MF2(ai, 1, 2, At, B1); PG8_MF2(ai, 1, 3, At, B1); __builtin_amdgcn_s_setprio(0); } while (0)
#define PG8_WAIT_V(n) asm volatile("s_waitcnt vmcnt(" #n ")" ::: "memory")
#define PG8_WAIT_L(n) asm volatile("s_waitcnt lgkmcnt(" #n ")" ::: "memory")
#define PG8_BAR __builtin_amdgcn_s_barrier()
#define PG8_SCHED __builtin_amdgcn_sched_barrier(0)
#define PG8_PIN(ai) asm volatile("" :: "v"(acc[ai][0][0][0]), "v"(acc[ai][0][0][1]), "v"(acc[ai][0][1][0]), "v"(acc[ai][0][1][1]), "v"(acc[ai][0][2][0]), "v"(acc[ai][0][2][1]), "v"(acc[ai][0][3][0]), "v"(acc[ai][0][3][1]), \
        "v"(acc[ai][1][0][0]), "v"(acc[ai][1][0][1]), "v"(acc[ai][1][1][0]), "v"(acc[ai][1][1][1]), "v"(acc[ai][1][2][0]), "v"(acc[ai][1][2][1]), "v"(acc[ai][1][3][0]), "v"(acc[ai][1][3][1]))
#define PG8_BK(cb, cb2, kt) ((KSPLIT && (kt) >= nth) ? (cb2) + (size_t)((kt) - nth) * kstep : (cb) + (size_t)(kt) * kstep)
    UnitT cur, nxt; int ui = 0;
    if (!S.next(0, cur)) return;
    f32x4 acc[2][2][4][2];
#pragma unroll
    for (int a = 0; a < 2; ++a)
#pragma unroll
        for (int b = 0; b < 2; ++b)
#pragma unroll
            for (int m = 0; m < 4; ++m)
#pragma unroll
                for (int n = 0; n < 2; ++n) acc[a][b][m][n] = (f32x4){0.f, 0.f, 0.f, 0.f};
    bf16x8 At[4][2], B0[2][2], B1[2][2];
    unsigned vA[2][2];
    S.arows(cur, tid, vA);
    PG8_LAS u32x4* const vslot = (PG8_LAS u32x4*)(lds + STAGE_BYTES + 1024) + tid;
    const char* cA = S.aptr(cur); const char* cB = S.bptr(cur); const char* cB2 = KSPLIT ? S.bptr2(cur) : cB;
    PG8_STAGE(PG8_SB(0, 0), cB, voffB); PG8_STAGE(PG8_SB(0, 1), cB + hstepB, voffB); PG8_STAGE(PG8_SA(0, 0), cA, vA[0]); PG8_STAGE(PG8_SA(0, 1), cA, vA[1]);
    if (wr == 1) PG8_BAR;
    PG8_WAIT_V(2); PG8_BAR;
    PG8_STAGE(PG8_SB(1, 0), PG8_BK(cB, cB2, 1), voffB); PG8_STAGE(PG8_SA(1, 0), cA + kstep, vA[0]); PG8_STAGE(PG8_SB(1, 1), PG8_BK(cB, cB2, 1) + hstepB, voffB);
    PG8_WAIT_V(6); PG8_BAR;
    for (;;) {
        const bool has_next = S.next(ui + 1, nxt);
        const char* nA = has_next ? S.aptr(nxt) : cA; const char* nB = has_next ? S.bptr(nxt) : cB; const char* nB2 = (KSPLIT && has_next) ? S.bptr2(nxt) : cB2;
        if (GATHER && has_next) { unsigned vn_[2][2]; S.arows(nxt, wid * 64 + pg8_lane_volatile(), vn_); *vslot = (u32x4){vn_[0][0], vn_[0][1], vn_[1][0], vn_[1][1]}; }
        for (int t = 0; t < nt; t += 2) {
            const bool last = (t == nt - 2);
            const int scw_ = ((SC2 && t >= nth) ? SCW2 : SCW) * 0x01010101, sca_ = ((SC2 && t >= nth) ? SCA2 : SCA) * 0x01010101; (void)scw_; (void)sca_;
            const char* a1 = cA + (size_t)(t + 1) * kstep;
            const char* a2 = last ? nA : cA + (size_t)(t + 2) * kstep;
            const char* b2 = last ? nB : PG8_BK(cB, cB2, t + 2);
            const char* b3 = last ? (KSPLIT ? PG8_BK(nB, nB2, 1) : nB + kstep) : PG8_BK(cB, cB2, t + 3);
            const char* a3 = a2 + kstep;
#define ST_A11(i) PG8_STAGE1(PG8_SA(1, 1), a1, vA[1], i)
#define ST_B00(i) PG8_STAGE1(PG8_SB(0, 0), b2, voffB, i)
#define ST_B01(i) PG8_STAGE1(PG8_SB(0, 1), b2 + hstepB, voffB, i)
#define ST_A00(i) PG8_STAGE1(PG8_SA(0, 0), a2, vA[0], i)
#define ST_A01(i) PG8_STAGE1(PG8_SA(0, 1), a2, vA[1], i)
#define ST_B10(i) PG8_STAGE1(PG8_SB(1, 0), b3, voffB, i)
#define ST_B11(i) PG8_STAGE1(PG8_SB(1, 1), b3 + hstepB, voffB, i)
#define ST_A10(i) PG8_STAGE1(PG8_SA(1, 0), a3, vA[0], i)
            PG8_LDB(B0, 0, 0); PG8_LDB(B1, 0, 1); PG8_SCHED; PG8_LDA(At, 0, 0);
            PG8_WAIT_V(6); PG8_WAIT_L(0); PG8_BAR; PG8_CL1(0, At, ST_A11); PG8_PIN(0); PG8_BAR; PG8_SCHED;
            if (GATHER && last && has_next) { const u32x4 vn_ = *vslot; vA[0][0] = vn_.x; vA[0][1] = vn_.y; vA[1][0] = vn_.z; vA[1][1] = vn_.w; }
            PG8_LDA(At, 0, 1);
            PG8_WAIT_V(2); PG8_WAIT_L(0); PG8_BAR; PG8_CL2(1, At, ST_B00, ST_B01, ST_A00); PG8_PIN(1); PG8_BAR; PG8_SCHED;
            PG8_LDB(B0, 1, 0); PG8_LDB(B1, 1, 1); PG8_SCHED; PG8_LDA(At, 1, 0);
            PG8_WAIT_V(6); PG8_WAIT_L(0); PG8_BAR; PG8_CL1(0, At, ST_A01); PG8_PIN(0); PG8_BAR; PG8_SCHED;
            PG8_LDA(At, 1, 1);
            PG8_WAIT_V(2); PG8_WAIT_L(0); PG8_BAR; PG8_CL2(1, At, ST_B10, ST_B11, ST_A10); PG8_PIN(1); PG8_BAR; PG8_SCHED;
#undef ST_A11
#undef ST_B00
#undef ST_B01
#undef ST_A00
#undef ST_A01
#undef ST_B10
#undef ST_B11
#undef ST_A10
        }
        if constexpr (ALIGN_EPI) { if (wr == 0) PG8_BAR; }
        if constexpr (!Epi::AFTER_DRAIN) { const int le_ = pg8_lane_volatile(); E(acc, cur, wr, wc, le_ & 15, le_ >> 4); }
        if (!has_next) break;
#pragma unroll
        for (int a = 0; a < 2; ++a)
#pragma unroll
            for (int b = 0; b < 2; ++b)
#pragma unroll
                for (int m = 0; m < 4; ++m)
#pragma unroll
                    for (int n = 0; n < 2; ++n) acc[a][b][m][n] = (f32x4){0.f, 0.f, 0.f, 0.f};
        cur = nxt; cA = nA; cB = nB; cB2 = nB2; ++ui;
        if constexpr (ALIGN_EPI) { if (wr == 1) PG8_BAR; }
    }
    PG8_WAIT_V(0);
    if constexpr (!ALIGN_EPI) { if (wr == 0) PG8_BAR; }
    PG8_BAR;
    if constexpr (Epi::AFTER_DRAIN) { E.fused(acc, cur, wr, wc, fr, fq, lds, wid, lane); }
#undef PG8_SA
#undef PG8_SB
#undef PG8_STAGE
#undef PG8_LDA
#undef PG8_LDB
#undef PG8_MMA
#undef PG8_WAIT_V
#undef PG8_WAIT_L
#undef PG8_BAR
#undef PG8_SCHED
#undef PG8_BK
#undef PG8_PIN
#undef PG8_STAGE1
#undef PG8_MF
#undef PG8_MF2
#undef PG8_CL1
#undef PG8_CL2
#undef PG8_CAT8
}
}
namespace pg8 {
DEVFN unsigned pkbf(float lo, float hi) { return cvt_pk_bf16(lo, hi); }
struct DenseSched {
    typedef Unit UnitT;
    StaticOrder so; const char* A; const char* Bt; int lda, ldb;
    DEVFN bool next(int i, Unit& u) const { return so.next(i, u); }
    DEVFN const char* aptr(const Unit&) const { return A; }
    DEVFN void arows(const Unit& u, const int tid_, unsigned (&v)[2][2]) const {
        int R[2], C[2]; { int t_ = tid_; asm volatile("" : "+v"(t_)); stage_rc(t_ * 16, R[0], C[0]); stage_rc(t_ * 16 + 8192, R[1], C[1]); }
#pragma unroll
        for (int h = 0; h < 2; ++h)
#pragma unroll
            for (int i = 0; i < 2; ++i) v[h][i] = (unsigned)((u.pm * BM + h * HALF + R[i]) * lda + C[i] * 2); }
    DEVFN const char* bptr(const Unit& u) const { return Bt + (size_t)u.pn * BM * ldb; }
    DEVFN const char* bptr2(const Unit& u) const { return bptr(u); }
};
struct EpiInproj {
    static constexpr bool PERM = true, AFTER_DRAIN = false;
    bf16_t* O; const float* rope; float* kbar;
    DEVFN void operator()(f32x4 (&acc)[2][2][4][2], const Unit& u, int wr, int wc, int fr, int fq) const {
        const int pn = u.pn, row0 = u.pm * BM + wr * 64 + fr;
        if (pn < 4 && fq == 0) {
#pragma unroll
            for (int ai = 0; ai < 2; ++ai)
#pragma unroll
                for (int m = 0; m < 4; ++m) { const int t = (row0 + ai * HALF + m * 16) & (SEQ - 1); const f32x4* rp = (const f32x4*)(rope + t * 16);
#pragma unroll
                    for (int q = 0; q < 4; ++q) { const f32x4 cs = rp[q];
                        { const int d = 2 * q, n = d >> 2, e = d & 3; const float x1 = acc[ai][0][m][n][e], x2 = acc[ai][1][m][n][e]; acc[ai][0][m][n][e] = x1 * cs[0] - x2 * cs[1]; acc[ai][1][m][n][e] = x2 * cs[0] + x1 * cs[1]; }
                        { const int d = 2 * q + 1, n = d >> 2, e = d & 3; const float x1 = acc[ai][0][m][n][e], x2 = acc[ai][1][m][n][e]; acc[ai][0][m][n][e] = x1 * cs[2] - x2 * cs[3]; acc[ai][1][m][n][e] = x2 * cs[2] + x1 * cs[3]; } } }
        }
        if (pn == 2 || pn == 3) {
            float* kb = kbar + (size_t)((((u.pm >> 3) * NH + (pn - 2) * 4 + wc) * NBLK + (u.pm & 7)) * HD);
#pragma unroll
            for (int bj = 0; bj < 2; ++bj)
#pragma unroll
                for (int n = 0; n < 2; ++n)
#pragma unroll
                    for (int e = 0; e < 4; ++e) { float s = 0.f;
#pragma unroll
                        for (int ai = 0; ai < 2; ++ai)
#pragma unroll
                            for (int m = 0; m < 4; ++m) s += acc[ai][bj][m][n][e];
                        s = swz_xor_add(s, 1); s = swz_xor_add(s, 2); s = swz_xor_add(s, 4); s = swz_xor_add(s, 8);
                        if (fr == 0) atomicAdd(kb + (2 * fq + bj) * 8 + 4 * n + e, s * (1.f / MBLK)); }
        }
        const float sc = pn < 2 ? QSCALE : 1.f;
#pragma unroll
        for (int ai = 0; ai < 2; ++ai)
#pragma unroll
            for (int m = 0; m < 4; ++m) { bf16_t* rowp = O + (size_t)(row0 + ai * HALF + m * 16) * DIN + pn * BM + wc * 64;
#pragma unroll
                for (int bj = 0; bj < 2; ++bj) { const f32x4 v0 = acc[ai][bj][m][0] * sc, v1 = acc[ai][bj][m][1] * sc;
                    u32x4 w; w.x = pkbf(v0[0], v0[1]); w.y = pkbf(v0[2], v0[3]); w.z = pkbf(v1[0], v1[1]); w.w = pkbf(v1[2], v1[3]);
                    *(u32x4*)(rowp + (2 * fq + bj) * 8) = w; } }
    }
};
struct EpiF8 {
    static constexpr bool PERM = true, AFTER_DRAIN = false;
    unsigned char* O; int ldc;
    DEVFN void operator()(f32x4 (&acc)[2][2][4][2], const Unit& u, int wr, int wc, int fr, int fq) const {
#pragma unroll
        for (int ai = 0; ai < 2; ++ai)
#pragma unroll
            for (int m = 0; m < 4; ++m) { unsigned char* rowp = O + (size_t)(u.pm * BM + ai * HALF + wr * 64 + m * 16 + fr) * ldc + u.pn * BM + wc * 32 + fq * 8;
#pragma unroll
                for (int bj = 0; bj < 2; ++bj) { const f32x4 v0 = acc[ai][bj][m][0] * YSCALE, v1 = acc[ai][bj][m][1] * YSCALE;
                    u32x2 w; w.x = pk4_fp8(v0[0], v0[1], v0[2], v0[3]); w.y = pk4_fp8(v1[0], v1[1], v1[2], v1[3]);
                    *(u32x2*)(rowp + bj * HALF) = w; } }
    }
};
struct MoeUnit { int pm, pn, cls, j, cnt; };
struct MoeBase {
    const PG8_LAS int* tp; const PG8_LAS int* cnt; int nunits, G, c, npn_shift;
    DEVFN bool next_(int i, MoeUnit& u) const {
        const int L = i * G + c; if (L >= nunits) return false;
        u.pm = L >> npn_shift; u.pn = L & ((1 << npn_shift) - 1);
        int cls = 0; while (u.pm >= __builtin_amdgcn_readfirstlane(tp[cls + 1])) ++cls;
        u.cls = cls; u.j = u.pm - __builtin_amdgcn_readfirstlane(tp[cls]); u.cnt = __builtin_amdgcn_readfirstlane(cnt[cls]); return true; }
};
DEVFN void moe_experts(int cls, int& e1, int& e2) { const int g = cls / 6, p = cls % 6; const int lo = p < 3 ? 0 : (p < 5 ? 1 : 2), hi = p < 3 ? p + 1 : (p < 5 ? p - 1 : 3); e1 = g * 4 + lo; e2 = g * 4 + hi; }
struct GateUpSched : MoeBase {
    typedef MoeUnit UnitT;
    const char* HB; const int* list; const char* W;
    DEVFN bool next(int i, MoeUnit& u) const { return next_(i, u); }
    DEVFN const char* aptr(const MoeUnit&) const { return HB; }
    DEVFN void arows(const MoeUnit& u, const int tid_, unsigned (&v)[2][2]) const {
        int R[2], C[2]; { int t_ = tid_; asm volatile("" : "+v"(t_)); stage_rc(t_ * 16, R[0], C[0]); stage_rc(t_ * 16 + 8192, R[1], C[1]); }
#pragma unroll
        for (int h = 0; h < 2; ++h)
#pragma unroll
            for (int i = 0; i < 2; ++i) { const int li = 256 * u.j + h * HALF + R[i]; const int tok = list[(size_t)u.cls * LISTCAP + (li < u.cnt ? li : 256 * u.j)]; v[h][i] = (unsigned)(tok * DM + C[i] * 2); } }
    DEVFN const char* bptr(const MoeUnit& u) const { int e1, e2; moe_experts(u.cls, e1, e2); return W + (size_t)(u.pn < 4 ? e1 : e2) * DM * DM + (size_t)(u.pn & 3) * BM * DM; }
    DEVFN const char* bptr2(const MoeUnit& u) const { return bptr(u); }
};
struct DownSched : MoeBase {
    typedef MoeUnit UnitT;
    const char* ACT; const char* W;
    DEVFN bool next(int i, MoeUnit& u) const { return next_(i, u); }
    DEVFN const char* aptr(const MoeUnit&) const { return ACT; }
    DEVFN void arows(const MoeUnit& u, const int tid_, unsigned (&v)[2][2]) const {
        int R[2], C[2]; { int t_ = tid_; asm volatile("" : "+v"(t_)); stage_rc(t_ * 16, R[0], C[0]); stage_rc(t_ * 16 + 8192, R[1], C[1]); }
#pragma unroll
        for (int h = 0; h < 2; ++h)
#pragma unroll
            for (int i = 0; i < 2; ++i) v[h][i] = (unsigned)((u.pm * BM + h * HALF + R[i]) * DM + C[i] * 2); }
    DEVFN const char* bptr(const MoeUnit& u) const { int e1, e2; moe_experts(u.cls, e1, e2); return W + (size_t)e1 * DM * DE + (size_t)u.pn * BM * DE; }
    DEVFN const char* bptr2(const MoeUnit& u) const { int e1, e2; moe_experts(u.cls, e1, e2); return W + (size_t)e2 * DM * DE + (size_t)u.pn * BM * DE; }
};
struct EpiGateUp {
    static constexpr bool PERM = true, AFTER_DRAIN = false;
    unsigned char* ACT; const float* rw;
    DEVFN void operator()(f32x4 (&acc)[2][2][4][2], const MoeUnit& u, int wr, int wc, int fr, int fq) const {
        const int half = u.pn >> 2, jt = u.pn & 3;
#pragma unroll
        for (int ai = 0; ai < 2; ++ai)
#pragma unroll
            for (int m = 0; m < 4; ++m) { const int lr = ai * HALF + wr * 64 + m * 16 + fr, li = 256 * u.j + lr;
                const float wgt = li < u.cnt ? 8.f * rw[((size_t)u.cls * LISTCAP + li) * 2 + half] : 0.f;
                f32x4 o[2];
#pragma unroll
                for (int n = 0; n < 2; ++n)
#pragma unroll
                    for (int e = 0; e < 4; ++e) { const float g = acc[ai][0][m][n][e]; o[n][e] = g * __builtin_amdgcn_rcpf(1.f + __expf(-g)) * acc[ai][1][m][n][e] * wgt; }
                u32x2 w; w.x = pk4_fp8(o[0][0], o[0][1], o[0][2], o[0][3]); w.y = pk4_fp8(o[1][0], o[1][1], o[1][2], o[1][3]);
                *(u32x2*)(ACT + (size_t)(u.pm * BM + lr) * DM + half * 512 + jt * 128 + wc * 32 + fq * 8) = w; }
    }
};
struct EpiDown {
    static constexpr bool PERM = true, AFTER_DRAIN = false;
    unsigned char* Y2; const int* list;
    DEVFN void operator()(f32x4 (&acc)[2][2][4][2], const MoeUnit& u, int wr, int wc, int fr, int fq_) const {
        int fq = fq_; asm volatile("" : "+v"(fq));
#pragma unroll
        for (int ai = 0; ai < 2; ++ai)
#pragma unroll
            for (int m = 0; m < 4; ++m) { const int li = 256 * u.j + ai * HALF + wr * 64 + m * 16 + fr;
                if (li < u.cnt) { const int tok = list[(size_t)u.cls * LISTCAP + li]; unsigned char* rowp = Y2 + (size_t)tok * DM + u.pn * BM + wc * 32 + fq * 8;
#pragma unroll
                    for (int bj = 0; bj < 2; ++bj) { const f32x4 v0 = acc[ai][bj][m][0] * YSCALE, v1 = acc[ai][bj][m][1] * YSCALE;
                        u32x2 w; w.x = pk4_fp8(v0[0], v0[1], v0[2], v0[3]); w.y = pk4_fp8(v1[0], v1[1], v1[2], v1[3]);
                        *(u32x2*)(rowp + bj * HALF) = w; } } }
    }
};
}

#include <hip/hip_bf16.h>
#include <cmath>
namespace attn_body {
using bf16=__hip_bfloat16;
using bf16x8=__attribute__((ext_vector_type(8)))short;
using s16x4=__attribute__((ext_vector_type(4)))short;
using f32x16=__attribute__((ext_vector_type(16)))float;
using u32x4=__attribute__((ext_vector_type(4)))unsigned;
constexpr int BATCH=16,NHEAD=8,SEQ=2048,D=64,QP=2048,OP=1024;
constexpr int NW=8,QBLK=32,QB=QBLK*NW,KVBLK=64,NQB=SEQ/QB;
constexpr int ATTN_PITCH=QP, ATTN_UNIT_ROWS=QB;
__device__ __forceinline__ int crow(int r,int hi){return (r&3)+8*(r>>2)+4*hi;}
#define SBAR() __builtin_amdgcn_sched_barrier(0)
__device__ __forceinline__ void cmask(f32x16&p0,f32x16&p1,int jb,int qrel,int hi){
  const float NEG=-INFINITY; int kb=64*jb+4*hi;
  #pragma unroll
  for(int r=0;r<16;++r){int kv=kb+(r&3)+8*(r>>2); if(kv>qrel)p0[r]=NEG; if(kv+32>qrel)p1[r]=NEG;}
}

constexpr int NSLOT=3, SLOTB=8192;
constexpr int LDS_K=0, LDS_V=NSLOT*SLOTB, LDS_WS=2*NSLOT*SLOTB, LDS_OST=LDS_WS+NW*64*4, LDS_KBAR=LDS_OST+NW*4096, LDS_BYTES=LDS_KBAR+2048;
constexpr float NEGBIG=-1.0e30f; typedef float f32x4_t __attribute__((ext_vector_type(4)));
__device__ __forceinline__ float bfs(short v){return __uint_as_float(((unsigned)(unsigned short)v)<<16);}
constexpr float C2=0.125f*1.4426950408889634f;
__device__ __forceinline__ void glds16(const void*gsrc,unsigned lds_dst){unsigned keep;
  asm volatile("s_mov_b32 %0, m0\n\ts_mov_b32 m0, %2\n\ts_nop 0\n\tglobal_load_lds_dwordx4 %1, off\n\ts_mov_b32 m0, %0":"=&s"(keep):"v"(gsrc),"s"(lds_dst):"memory");}
__device__ __forceinline__ float max3f(float a,float b,float c){float r;asm("v_max3_f32 %0, %1, %2, %3":"=v"(r):"v"(a),"v"(b),"v"(c));return r;}
__device__ __forceinline__ float max2f(float a,float b){float r;asm("v_max_f32_e32 %0, %1, %2":"=v"(r):"v"(a),"v"(b));return r;}
__device__ __forceinline__ float fadd_s(float a,float b){float r;asm("v_add_f32_e32 %0, %1, %2":"=v"(r):"v"(a),"v"(b));return r;}
__device__ __forceinline__ float fsub_s(float a,float b){float r;asm("v_sub_f32_e32 %0, %1, %2":"=v"(r):"v"(a),"v"(b));return r;}
typedef float f32x2_t __attribute__((ext_vector_type(2))); typedef __bf16 bf16x2_t __attribute__((ext_vector_type(2)));
__device__ __forceinline__ unsigned cvtpk_s(float lo,float hi){f32x2_t v={lo,hi};bf16x2_t b=__builtin_convertvector(v,bf16x2_t);return __builtin_bit_cast(unsigned,b);}
#define WAIT_BAR(N) asm volatile("s_waitcnt vmcnt(" #N ") lgkmcnt(0)\n\ts_barrier":::"memory")

__device__ __forceinline__ void qkt(f32x16&p0,f32x16&p1,const char*Kslot,const bf16x8*qr,const f32x16&negm,int r32,int hi){
  const char*kb=Kslot+hi*1024+r32*16;
  #pragma unroll
  for(int d0=0;d0<4;++d0){
    const bf16x8 b0=*reinterpret_cast<const bf16x8*>(kb+d0*2048);
    const bf16x8 b1=*reinterpret_cast<const bf16x8*>(kb+d0*2048+512);
    if(d0==0){p0=__builtin_amdgcn_mfma_f32_32x32x16_bf16(b0,qr[0],negm,0,0,0);p1=__builtin_amdgcn_mfma_f32_32x32x16_bf16(b1,qr[0],negm,0,0,0);}
    else{p0=__builtin_amdgcn_mfma_f32_32x32x16_bf16(b0,qr[d0],p0,0,0,0);p1=__builtin_amdgcn_mfma_f32_32x32x16_bf16(b1,qr[d0],p1,0,0,0);}}
}
typedef __attribute__((address_space(3))) const char* lds_cptr;
typedef short v4i16_t __attribute__((ext_vector_type(4)));
__device__ __forceinline__ void kload8(bf16x8*kf,lds_cptr kp){
  kf[0]=*(const __attribute__((address_space(3))) bf16x8*)(kp);      kf[1]=*(const __attribute__((address_space(3))) bf16x8*)(kp+512);
  kf[2]=*(const __attribute__((address_space(3))) bf16x8*)(kp+2048); kf[3]=*(const __attribute__((address_space(3))) bf16x8*)(kp+2560);
  kf[4]=*(const __attribute__((address_space(3))) bf16x8*)(kp+4096); kf[5]=*(const __attribute__((address_space(3))) bf16x8*)(kp+4608);
  kf[6]=*(const __attribute__((address_space(3))) bf16x8*)(kp+6144); kf[7]=*(const __attribute__((address_space(3))) bf16x8*)(kp+6656);
}
__device__ __forceinline__ void kload2(bf16x8*kf,lds_cptr kp,int j){ kf[2*j]=*(const __attribute__((address_space(3))) bf16x8*)(kp+j*2048); kf[2*j+1]=*(const __attribute__((address_space(3))) bf16x8*)(kp+j*2048+512); }
__device__ __forceinline__ s16x4 vtr(lds_cptr p){ return __builtin_bit_cast(s16x4,__builtin_amdgcn_ds_read_tr16_b64_v4i16((__attribute__((address_space(3))) v4i16_t*)p)); }
__device__ __forceinline__ float rowmax(const f32x16&p0,const f32x16&p1){
  float a=max3f(p0[0],p0[1],p1[0]),b=max3f(p0[2],p0[3],p1[1]);a=max3f(a,p1[2],p1[3]);
  #pragma unroll
  for(int r=4;r<16;r+=4){a=max3f(a,p0[r],p0[r+1]);b=max3f(b,p0[r+2],p0[r+3]);a=max3f(a,p1[r],p1[r+1]);b=max3f(b,p1[r+2],p1[r+3]);}
  const float m=max2f(a,b);
  auto rr=__builtin_amdgcn_permlane32_swap(__float_as_uint(m),__float_as_uint(m),false,false);
  return max2f(__uint_as_float(rr[0]),__uint_as_float(rr[1]));
}
__device__ __forceinline__ void pv(f32x16*o,int vb,bf16x8 pa0,bf16x8 pa1,bf16x8 pa2,bf16x8 pa3){
  #pragma unroll
  for(int d0=0;d0<2;++d0){s16x4 lo[4],hi[4];
    #pragma unroll
    for(int ks=0;ks<4;++ks){
      asm volatile("ds_read_b64_tr_b16 %0,%1 offset:%c2":"=&v"(lo[ks]):"v"(vb),"i"(d0*4096+ks*1024):"memory");
      asm volatile("ds_read_b64_tr_b16 %0,%1 offset:%c2":"=&v"(hi[ks]):"v"(vb),"i"(d0*4096+ks*1024+512):"memory");}
    asm volatile("s_waitcnt lgkmcnt(0)":::"memory");SBAR();
    #define PK(k) (bf16x8){lo[k][0],lo[k][1],lo[k][2],lo[k][3],hi[k][0],hi[k][1],hi[k][2],hi[k][3]}
    o[d0]=__builtin_amdgcn_mfma_f32_32x32x16_bf16(pa0,PK(0),o[d0],0,0,0);
    o[d0]=__builtin_amdgcn_mfma_f32_32x32x16_bf16(pa1,PK(1),o[d0],0,0,0);
    o[d0]=__builtin_amdgcn_mfma_f32_32x32x16_bf16(pa2,PK(2),o[d0],0,0,0);
    o[d0]=__builtin_amdgcn_mfma_f32_32x32x16_bf16(pa3,PK(3),o[d0],0,0,0);
    #undef PK
  }
}

#ifndef ATTN_STORE16
#define ATTN_STORE16(p,v) (*(u32x4*)(p)=(v))
#endif
template<int THRL> __device__ __forceinline__ void attn_unit(int b,int h,int qb,const bf16*Q,const bf16*__restrict__ K,const bf16*__restrict__ V,bf16*O,const float*__restrict__ kbar,char*shm,const int tid){
  const int lane=tid&63,r32=lane&31,hi=lane>>5; const int wid=__builtin_amdgcn_readfirstlane(tid>>6);
  float kbv=0.f; { int tk=tid; asm volatile("":"+v"(tk)); if(qb>=4&&tk<448)kbv=kbar[tk]; }
  const long rowbase=(long)b*SEQ; const int q0=qb*QB;
  const bf16*Qw=Q+(rowbase+q0+wid*QBLK)*QP+h*D;
  const bf16*Kh=K+rowbase*QP+h*D,*Vh=V+rowbase*QP+h*D;
  const unsigned lds0=(unsigned)(uintptr_t)shm;
  float*wsf=(float*)(shm+LDS_WS)+wid*64;
  const bf16*ksrc=Kh+(long)lane*QP+wid*8;
  const bf16*vsrc=Vh+(long)(16*(wid&3)+(lane>>2))*QP+(wid>>2)*32+(lane&3)*8;
  const unsigned kdst=lds0+LDS_K+wid*1024, vdst=lds0+LDS_V+wid*1024;
  #define DMA_K(t,slot) glds16(ksrc+(long)(t)*KVBLK*QP,(unsigned)__builtin_amdgcn_readfirstlane(kdst+(slot)))
  #define DMA_V(t,slot) glds16(vsrc+(long)(t)*KVBLK*QP,(unsigned)__builtin_amdgcn_readfirstlane(vdst+(slot)))
  const int vb0=(int)(lds0+LDS_V)+((lane>>4)&1)*32+(lane&3)*8+(4*hi+((lane&15)>>2))*64;
  const char*Kbase=shm+LDS_K; bf16x8 kf[8];
  const lds_cptr shm3=(lds_cptr)shm; const lds_cptr kp0=shm3+LDS_K+hi*1024+r32*16; const lds_cptr vp0=shm3+LDS_V+((lane>>4)&1)*32+(lane&3)*8+(4*hi+((lane&15)>>2))*64;
  const int NT=(q0+QB)/KVBLK;
  DMA_K(0,0);DMA_V(0,0);DMA_K(1,SLOTB);
  bf16x8 qr[4];
  #pragma unroll
  for(int d0=0;d0<4;++d0)qr[d0]=*reinterpret_cast<const bf16x8*>(&Qw[(long)r32*QP+d0*16+hi*8]);
  float mhat=0.f,l_reg=0.f;f32x16 o[2];o[0]=f32x16{};o[1]=f32x16{};f32x16 negm=f32x16{};asm volatile("":"+v"(negm));
  const int qrel=wid*QBLK+r32;
  #define CMASK(P0,P1,t) do{int jb_=(t)-(NT-4); if(jb_>=0)cmask(P0,P1,jb_,qrel,hi);}while(0)
  bool resc=false;
  #define START(P0,P1) do{ const float rm=rowmax(P0,P1); resc=false; \
    { const float dl=selcur?rm:-64.f; mhat=fadd_s(mhat,dl); \
      _Pragma("unroll") for(int r=0;r<16;++r){P0[r]=fsub_s(P0[r],dl);P1[r]=fsub_s(P1[r],dl);} \
      { const float nv_=selcur?-mhat:NEGBIG; _Pragma("unroll") for(int r=0;r<16;++r)negm[r]=nv_; } asm volatile("":"+v"(negm)); } \
    _Pragma("unroll") for(int r=0;r<16;++r)P0[r]=__builtin_amdgcn_exp2f(P0[r]); }while(0)
  #define RESC() do{ if(resc){ asm volatile("s_waitcnt lgkmcnt(0)":::"memory"); \
      _Pragma("unroll") for(int d_=0;d_<2;++d_) _Pragma("unroll") for(int r=0;r<16;++r)o[d_][r]*=wsf[crow(r,hi)]; } }while(0)
  f32x16 pA0,pA1,pB0,pB1;
  int sl_prev=0,sl_cur=0,sl_next=SLOTB;
  #define ROT() do{sl_prev=sl_cur;sl_cur=sl_next;sl_next=(sl_next==(NSLOT-1)*SLOTB)?0:sl_next+SLOTB;}while(0)
  DMA_K(2,2*SLOTB);
  if(qb>=4){ if(tid<448){ const unsigned hb=__builtin_bit_cast(unsigned,kbv); const unsigned hr=(hb+0x7fffu+((hb>>16)&1u))&0xffff0000u; const float lo_=kbv-__builtin_bit_cast(float,hr); const unsigned lb=__builtin_bit_cast(unsigned,lo_);
      ((unsigned short*)(shm+LDS_KBAR))[tid]=(unsigned short)(hr>>16); ((unsigned short*)(shm+LDS_KBAR+1024))[tid]=(unsigned short)((lb+0x7fffu+((lb>>16)&1u))>>16); } }
  WAIT_BAR(3);
  unsigned bmask=(1u<<(qb+1))-1u;
  if(qb>=4){ float gsc[8];
    { const lds_cptr kb3=shm3+LDS_KBAR+(r32&7)*128+hi*16; f32x16 g=f32x16{};
      _Pragma("unroll") for(int d0=0;d0<4;++d0){ const bf16x8 ah=*(const __attribute__((address_space(3))) bf16x8*)(kb3+d0*32), al=*(const __attribute__((address_space(3))) bf16x8*)(kb3+1024+d0*32);
        g=__builtin_amdgcn_mfma_f32_32x32x16_bf16(ah,qr[d0],g,0,0,0); g=__builtin_amdgcn_mfma_f32_32x32x16_bf16(al,qr[d0],g,0,0,0); }
      _Pragma("unroll") for(int r=0;r<4;++r){ auto rr=__builtin_amdgcn_permlane32_swap(__float_as_uint(g[r]),__float_as_uint(g[r]),false,false); gsc[r]=__uint_as_float(rr[0]); gsc[4+r]=__uint_as_float(rr[1]); } }
    _Pragma("unroll") for(int n=0;n<7;++n) gsc[n]=(n<qb)?gsc[n]:-3.0e38f;
    bmask=1u<<qb;
    _Pragma("unroll") for(int pick=0;pick<3;++pick){ float best=-3.4e38f; unsigned bi=0u;
      _Pragma("unroll") for(int n=0;n<7;++n){ const bool ok=!((bmask>>n)&1u)&&gsc[n]>best; best=ok?gsc[n]:best; bi=ok?(unsigned)n:bi; }
      bmask|=1u<<bi; } }
  bool selcur=(bmask&1u)!=0u;
  { const float nv=selcur?0.f:NEGBIG; _Pragma("unroll") for(int r=0;r<16;++r)negm[r]=nv; asm volatile("":"+v"(negm)); }
  qkt(pA0,pA1,Kbase,qr,negm,r32,hi);asm volatile("s_nop 15\n\ts_nop 7":"+v"(pA0),"+v"(pA1));CMASK(pA0,pA1,0);
  START(pA0,pA1);
  _Pragma("unroll") for(int r=0;r<16;++r)pA1[r]=__builtin_amdgcn_exp2f(pA1[r]);
  WAIT_BAR(0);
  DMA_K(3,0);DMA_V(1,SLOTB);
  ROT();
  kload8(kf,kp0+sl_cur);
  WAIT_BAR(2);
  s16x4 vlo[8],vhi[8]; u32x4 pw0,pw1,pw2,pw3;
  #define PKW(P,B) cvtpk_s(P[B],P[B+1])
  #define PAF(k) __builtin_bit_cast(bf16x8,pw##k)
  #define VFR(i) (bf16x8){vlo[i][0],vlo[i][1],vlo[i][2],vlo[i][3],vhi[i][0],vhi[i][1],vhi[i][2],vhi[i][3]}
  #define PIN(x) asm volatile("":"+v"(x))
  #define MX3(a,b,c) __builtin_fmaxf(__builtin_fmaxf((a),(b)),(c))
  #define GAPA(MF,A0,A1,A2,A3,W0,W1,PW) do{ MF; sacc+=A0; sacc+=A1; sacc+=A2; sacc+=A3; PIN(sacc); W0; W1; PIN(PW); SBAR(); }while(0)
  #define EX(v) __builtin_amdgcn_exp2f(v)
  #define GAPB(MF,X,B) do{ MF; X[B]=EX(X[B]); X[B+1]=EX(X[B+1]); X[B+2]=EX(X[B+2]); X[B+3]=EX(X[B+3]); PIN(X); SBAR(); }while(0)
  #define VRD(i) do{ vlo[i]=vtr(vp_+(((i)>>2)*4096+((i)&3)*1024)); vhi[i]=vtr(vp_+(((i)>>2)*4096+((i)&3)*1024+512)); }while(0)
  #define KRD(G,j) do{ if(G){ kload2(kf,kp0+sl_next,j); SBAR(); } }while(0)
  #define STEP(C0,C1,P0,P1,t,GK,GV,GL) do{ SBAR(); \
    const lds_cptr vp_=vp0+sl_prev; \
    VRD(0); SBAR(); float sacc=(P0[0]+P0[1]); \
    GAPA(C0=__builtin_amdgcn_mfma_f32_32x32x16_bf16(kf[0],qr[0],negm,0,0,0), P0[2],P0[3],P0[4],P0[5],     pw0[0]=PKW(P0,0), pw0[1]=PKW(P0,2), pw0); \
    VRD(4); SBAR(); GAPA(C1=__builtin_amdgcn_mfma_f32_32x32x16_bf16(kf[1],qr[0],negm,0,0,0), P0[6],P0[7],P0[8],P0[9],     pw0[2]=PKW(P0,4), pw0[3]=PKW(P0,6), pw0); \
    VRD(1); SBAR(); GAPA(C0=__builtin_amdgcn_mfma_f32_32x32x16_bf16(kf[2],qr[1],C0,0,0,0),   P0[10],P0[11],P0[12],P0[13], pw1[0]=PKW(P0,8), pw1[1]=PKW(P0,10), pw1); \
    VRD(5); SBAR(); GAPA(C1=__builtin_amdgcn_mfma_f32_32x32x16_bf16(kf[3],qr[1],C1,0,0,0),   P0[14],P0[15],P1[0],P1[1],   pw1[2]=PKW(P0,12),pw1[3]=PKW(P0,14), pw1); \
    VRD(2); SBAR(); GAPA(C0=__builtin_amdgcn_mfma_f32_32x32x16_bf16(kf[4],qr[2],C0,0,0,0),   P1[2],P1[3],P1[4],P1[5],     pw2[0]=PKW(P1,0), pw2[1]=PKW(P1,2), pw2); \
    VRD(6); SBAR(); GAPA(C1=__builtin_amdgcn_mfma_f32_32x32x16_bf16(kf[5],qr[2],C1,0,0,0),   P1[6],P1[7],P1[8],P1[9],     pw2[2]=PKW(P1,4), pw2[3]=PKW(P1,6), pw2); \
    VRD(3); SBAR(); GAPA(C0=__builtin_amdgcn_mfma_f32_32x32x16_bf16(kf[6],qr[3],C0,0,0,0),   P1[10],P1[11],P1[12],P1[13], pw3[0]=PKW(P1,8), pw3[1]=PKW(P1,10), pw3); \
    VRD(7); SBAR(); GAPA(C1=__builtin_amdgcn_mfma_f32_32x32x16_bf16(kf[7],qr[3],C1,0,0,0),   P1[14],P1[15],0.f,0.f,       pw3[2]=PKW(P1,12),pw3[3]=PKW(P1,14), pw3); \
    l_reg+=sacc; \
    if(GK){DMA_K((t)+3,sl_cur);} if(GV){DMA_V((t)+1,sl_next);} \
    CMASK(C0,C1,t); \
    { float a=MX3(C0[0],C0[1],C1[0]),b=MX3(C0[2],C0[3],C1[1]); a=MX3(a,C1[2],C1[3]); \
      _Pragma("unroll") for(int r=4;r<16;r+=4){a=MX3(a,C0[r],C0[r+1]);b=MX3(b,C0[r+2],C0[r+3]);a=MX3(a,C1[r],C1[r+1]);b=MX3(b,C1[r+2],C1[r+3]);} \
      float rm=__builtin_fmaxf(a,b); { auto rr=__builtin_amdgcn_permlane32_swap(__float_as_uint(rm),__float_as_uint(rm),false,false); rm=__builtin_fmaxf(__uint_as_float(rr[0]),__uint_as_float(rr[1])); } \
      resc=false; \
      if(__builtin_expect(__any(rm>(float)THRL),0)){ const float dl=__builtin_fmaxf(rm,0.f); mhat+=dl; \
        _Pragma("unroll") for(int r=0;r<16;++r){C0[r]-=dl;C1[r]-=dl;} \
        { const float nv_=selcur?-mhat:NEGBIG; _Pragma("unroll") for(int r=0;r<16;++r)negm[r]=nv_; } asm volatile("":"+v"(negm)); \
        const float f=__builtin_amdgcn_exp2f(-dl); l_reg*=f; if(hi==0)wsf[r32]=f; resc=true; } } \
    SBAR(); \
    GAPB(o[0]=__builtin_amdgcn_mfma_f32_32x32x16_bf16(PAF(0),VFR(0),o[0],0,0,0), C0,0); \
    GAPB(o[1]=__builtin_amdgcn_mfma_f32_32x32x16_bf16(PAF(0),VFR(4),o[1],0,0,0), C0,4); \
    KRD(GL,0); GAPB(o[0]=__builtin_amdgcn_mfma_f32_32x32x16_bf16(PAF(1),VFR(1),o[0],0,0,0), C0,8); \
    KRD(GL,1); GAPB(o[1]=__builtin_amdgcn_mfma_f32_32x32x16_bf16(PAF(1),VFR(5),o[1],0,0,0), C0,12); \
    KRD(GL,2); GAPB(o[0]=__builtin_amdgcn_mfma_f32_32x32x16_bf16(PAF(2),VFR(2),o[0],0,0,0), C1,0); \
    KRD(GL,3); GAPB(o[1]=__builtin_amdgcn_mfma_f32_32x32x16_bf16(PAF(2),VFR(6),o[1],0,0,0), C1,4); \
    GAPB(o[0]=__builtin_amdgcn_mfma_f32_32x32x16_bf16(PAF(3),VFR(3),o[0],0,0,0), C1,8); \
    GAPB(o[1]=__builtin_amdgcn_mfma_f32_32x32x16_bf16(PAF(3),VFR(7),o[1],0,0,0), C1,12); \
    }while(0)
  #define BLKSEL(tt) do{ if((((tt))&3)==0){ selcur=((bmask>>((tt)>>2))&1u)!=0u; const float nv_=selcur?-mhat:NEGBIG; _Pragma("unroll") for(int r=0;r<16;++r)negm[r]=nv_; asm volatile("":"+v"(negm)); } }while(0)
  int t=1;
  #undef CMASK
  #define CMASK(P0,P1,t) do{}while(0)
  for(;t+5<NT;t+=2){
    STEP(pB0,pB1,pA0,pA1,t,true,true,true);     WAIT_BAR(2); RESC(); ROT(); BLKSEL(t+1);
    STEP(pA0,pA1,pB0,pB1,t+1,true,true,true);   WAIT_BAR(2); RESC(); ROT();
  }
  #undef CMASK
  #define CMASK(P0,P1,t) do{int jb_=(t)-(NT-4); if(jb_>=0)cmask(P0,P1,jb_,qrel,hi);}while(0)
  #define ENDW(tt) do{ if((tt)+3<NT){WAIT_BAR(2);} else if((tt)+2<NT){WAIT_BAR(1);} else {WAIT_BAR(0);} }while(0)
  for(;t+1<NT;t+=2){
    STEP(pB0,pB1,pA0,pA1,t,(t+3<NT),(t+1<NT),(t+1<NT));       ENDW(t);   RESC(); ROT(); BLKSEL(t+1);
    STEP(pA0,pA1,pB0,pB1,t+1,(t+4<NT),(t+2<NT),(t+2<NT));     ENDW(t+1); RESC(); ROT();
  }
  STEP(pB0,pB1,pA0,pA1,NT-1,false,false,false); RESC();
  { float sacc=pB0[0]+pB0[1]; _Pragma("unroll") for(int r=2;r<16;++r)sacc+=pB0[r]; _Pragma("unroll") for(int r=0;r<16;++r)sacc+=pB1[r]; l_reg+=sacc;
    pw0=(u32x4){PKW(pB0,0),PKW(pB0,2),PKW(pB0,4),PKW(pB0,6)};pw1=(u32x4){PKW(pB0,8),PKW(pB0,10),PKW(pB0,12),PKW(pB0,14)};pw2=(u32x4){PKW(pB1,0),PKW(pB1,2),PKW(pB1,4),PKW(pB1,6)};pw3=(u32x4){PKW(pB1,8),PKW(pB1,10),PKW(pB1,12),PKW(pB1,14)};
    SBAR(); pv(o,vb0+sl_cur,PAF(0),PAF(1),PAF(2),PAF(3)); }
  #undef PKW
  #undef PAF
  #undef VFR
  #undef PIN
  #undef MX3
  #undef GAPA
  #undef GAPB
  #undef EX
  #undef VRD
  #undef KRD
  #undef STEP
  #undef ENDW
  {auto rr=__builtin_amdgcn_permlane32_swap(__float_as_uint(l_reg),__float_as_uint(l_reg),false,false);l_reg=__uint_as_float(rr[0])+__uint_as_float(rr[1]);}
  if(hi==0)wsf[32+r32]=l_reg;asm volatile("s_waitcnt lgkmcnt(0)":::"memory");
  float rli[16];
  #pragma unroll
  for(int r=0;r<16;++r)rli[r]=__builtin_amdgcn_rcpf(wsf[32+crow(r,hi)]);
  unsigned char*Ow=(unsigned char*)O+(rowbase+q0+wid*QBLK)*OP+h*D;
  { unsigned char*stg=(unsigned char*)(shm+LDS_OST)+wid*4096;
    #pragma unroll
    for(int r=0;r<16;++r){const int orow=crow(r,hi);
      #pragma unroll
      for(int d0=0;d0<2;++d0){const float ov=__builtin_amdgcn_fmed3f(o[d0][r]*rli[r]*32.f,-448.f,448.f); stg[orow*64+d0*32+r32]=(unsigned char)__builtin_amdgcn_cvt_pk_fp8_f32(ov,ov,0,false);}}
    asm volatile("s_waitcnt lgkmcnt(0)":::"memory");
    #pragma unroll
    for(int i=0;i<2;++i){const int row=i*16+(lane>>2),ch=lane&3; const u32x4 v=*(const u32x4*)(stg+row*64+ch*16); ATTN_STORE16(Ow+(long)row*OP+ch*16,v);} }
  asm volatile("s_waitcnt lgkmcnt(0)\n\ts_barrier":::"memory");
  #undef BLKSEL
  #undef DMA_K
  #undef DMA_V
  #undef CMASK
  #undef START
  #undef RESC
  #undef ROT
}
constexpr int ATTN_LDS_BYTES=LDS_BYTES;
struct AttnTensors { const bf16* Q; const bf16* K; const bf16* V; bf16* O; const float* kbar; };
struct AttnUnit { int bh; int qb; };
struct StaticOrder {
  int vcu, G;
  __device__ __forceinline__ explicit StaticOrder(int grid,int block):vcu((grid%8==0)?(block%8)*(grid/8)+block/8:block),G(grid){}
  __device__ __forceinline__ bool next(int i,AttnUnit&u)const{ const int pr=(vcu+(i>>2)*G)*2+((i>>1)&1); if(pr>=BATCH*NHEAD*4)return false;
    const int s=pr&3; u.bh=pr>>2; u.qb=(i&1)?7-s:s; return true; }
  __device__ __forceinline__ void a_ready(const AttnUnit&)const{}
  __device__ __forceinline__ void done(const AttnUnit&)const{}
};
template<class Sched,int THRL=8> __device__ __forceinline__ void attn_phase(char*lds,const AttnTensors&T,const Sched&S,const int tid_in){
  AttnUnit u; int tid_=tid_in; asm volatile("":"+v"(tid_));
  for(int i=0;S.next(i,u);++i){ S.a_ready(u); attn_unit<THRL>(u.bh/NHEAD,u.bh%NHEAD,u.qb,T.Q,T.K,T.V,T.O,T.kbar+(long)u.bh*512,lds,tid_); S.done(u); }
}
#undef SBAR
#undef WAIT_BAR
}

#define XB_TMO      128
#define XB_XCNT(j)  (256  + 64 * (j))
#define XB_XSUB(j)  (1280 + 64 * (j))
#define XB_XGEN(j)  (2304 + 64 * (j))
#define XB_TOP      3328
#define XB_TOPGEN   3392
#define XCD_BAR_WORDS 3456
#define XB_SPIN_CAP (1u << 18)

__device__ __forceinline__ unsigned xb_ld(unsigned* p)              { return __hip_atomic_load(p, __ATOMIC_RELAXED, __HIP_MEMORY_SCOPE_AGENT); }
__device__ __forceinline__ unsigned xb_add(unsigned* p, unsigned v) { return __hip_atomic_fetch_add(p, v, __ATOMIC_RELAXED, __HIP_MEMORY_SCOPE_AGENT); }
__device__ __forceinline__ unsigned xb_xcc_id() { return (unsigned)__builtin_amdgcn_s_getreg((3 << 11) | 20) & 0xFu; }
#define XB_SPIN(cond, bar) do { unsigned _sp = 0; while (cond) { __builtin_amdgcn_s_sleep(1); \
    if ((++_sp & 255u) == 0u) { if (xb_ld(&(bar)[XB_TMO])) break; if (_sp > XB_SPIN_CAP) { atomicAdd(&(bar)[XB_TMO], 1u); break; } } } } while (0)

struct XcdBarrier {
    unsigned* bar; unsigned x;
    volatile LAS unsigned* st;
};

__device__ __forceinline__ XcdBarrier xcd_barrier_post(unsigned* bar, volatile LAS unsigned* st) {
    XcdBarrier b; b.bar = bar; b.x = xb_xcc_id(); b.st = st;
    if (threadIdx.x == 0) (void)xb_add(&bar[XB_XCNT(b.x)], 1u);
    return b;
}
__device__ __forceinline__ void xcd_barrier_complete(unsigned* bar, unsigned x, unsigned& nloc, unsigned& nx) {
    const unsigned G = gridDim.x * gridDim.y * gridDim.z;
    unsigned sum, cnt, mine, sp = 0u;
    for (;;) {
        sum = 0u; cnt = 0u; mine = 0u;
#pragma unroll
        for (unsigned j = 0; j < 16; ++j) { const unsigned c = xb_ld(&bar[XB_XCNT(j)]); sum += c; cnt += (c > 0u) ? 1u : 0u; mine = (j == x) ? c : mine; }
        if (sum == G) break;
        __builtin_amdgcn_s_sleep(1);
        if ((++sp & 255u) == 0u) { if (xb_ld(&bar[XB_TMO])) break; if (sp > XB_SPIN_CAP) { atomicAdd(&bar[XB_TMO], 1u); break; } }
    }
    nloc = mine > 0u ? mine : 1u; nx = cnt > 0u ? cnt : 1u;
}

__device__ __forceinline__ void xcd_barrier(const XcdBarrier& b, const bool is_t0) {
    asm volatile("s_waitcnt vmcnt(0)" ::: "memory");
    __syncthreads();
    if (is_t0) {
        unsigned* bar = b.bar;
        __builtin_amdgcn_s_waitcnt(0);
        unsigned nloc = b.st[0], nx = b.st[1];
        if (nloc == 0u) { xcd_barrier_complete(bar, b.x, nloc, nx); b.st[0] = nloc; b.st[1] = nx; }
        const unsigned old = xb_add(&bar[XB_XSUB(b.x)], 1u);
        const unsigned gen = old / nloc;
        if (old + 1u == (gen + 1u) * nloc) {
            __builtin_amdgcn_fence(__ATOMIC_RELEASE, "agent");
            asm volatile("s_waitcnt vmcnt(0)" ::: "memory");
            const unsigned og = xb_add(&bar[XB_TOP], 1u);
            const unsigned tg = og / nx;
            if (og + 1u == (tg + 1u) * nx) xb_add(&bar[XB_TOPGEN], 1u);
            else XB_SPIN(xb_ld(&bar[XB_TOPGEN]) == tg, bar);
            __builtin_amdgcn_fence(__ATOMIC_ACQUIRE, "agent");
            xb_add(&bar[XB_XGEN(b.x)], 1u);
            asm volatile("s_waitcnt vmcnt(0)" ::: "memory");
        } else {
            XB_SPIN(xb_ld(&bar[XB_XGEN(b.x)]) == gen, bar);
            __builtin_amdgcn_fence(__ATOMIC_ACQUIRE, "agent");
            asm volatile("s_waitcnt vmcnt(0)" ::: "memory");
        }
    }
    __syncthreads();
}

struct Args { const float* in[17]; float* out; unsigned char* ws; int ph_lo, ph_hi; };
enum { I_X = 0, I_C, I_WMOD, I_BMOD, I_WIN, I_WPOOL, I_PSCALE, I_WOUT, I_LN1G, I_LN1B, I_WR, I_RB, I_WG, I_WU, I_WDN, I_LN2G, I_LN2B };

DEVFN int lane_id_volatile() { int l; asm volatile("v_mbcnt_lo_u32_b32 %0, -1, 0\n\tv_mbcnt_hi_u32_b32 %0, -1, %0" : "=v"(l)); return l; }
struct Ctx { unsigned char* lds; __attribute__((address_space(3))) unsigned char* lds3; int tid, lane, wave, G, bid, gw, NGW; };

DEVFN void transpose_item_f8(const float* src, int ldn, int k0, int col, unsigned char* dst, int ldk, int dst_row0, int dst_k0, float* scr, int lane) {
#pragma unroll 8
    for (int i = 0; i < 32; ++i) { const int kk = 2 * i + (lane >> 5); scr[kk * 33 + (lane & 31)] = src[(size_t)(k0 + kk) * ldn + col]; }
    LDS_WAIT();
    const int c = lane & 7;
#pragma unroll
    for (int j = 0; j < 4; ++j) { const int n = (lane >> 3) + 8 * j; const float* s = scr + (8 * c) * 33 + n;
        u32x2 o; o.x = pk4_fp8(32.f * s[0 * 33], 32.f * s[1 * 33], 32.f * s[2 * 33], 32.f * s[3 * 33]); o.y = pk4_fp8(32.f * s[4 * 33], 32.f * s[5 * 33], 32.f * s[6 * 33], 32.f * s[7 * 33]);
        *(u32x2*)(dst + (size_t)(dst_row0 + n) * ldk + dst_k0 + 8 * c) = o; }
    LDS_WAIT();
}

DEVFN void ph_prologue(const Args& a, const Ctx& c) {
    unsigned char* ws = a.ws;
    float* scr = (float*)(c.lds + c.wave * 16384);
    const int lane = c.lane;
    constexpr int N1 = 2 * 16 * 64, N2 = 2 * 8 * 32, N3 = 32 * 16 * 32, N4 = 32 * 8 * 32, N5 = 2 * 64 * 16, N6 = 256;
    for (int it = c.gw; it < N1 + N2 + N3 + N4 + N5 + N6; it += c.NGW) {
        int r = it;
        if (r < N1) {
            const int l = r / 1024, kb = (r % 1024) / 64, nb = r % 64;
            const int nphys = 32 * nb + (lane & 31);
            transpose_item_f8(a.in[I_WIN] + (size_t)l * DM * DIN, DIN, 64 * kb, inproj_nlog(nphys), (unsigned char*)(ws + WS_WIN) + (size_t)l * DIN * DM, DM, 32 * nb, 64 * kb, scr, lane);
            continue; }
        r -= N1;
        if (r < N2) {
            const int l = r / 256, kb = (r % 256) / 32, nb = r % 32;
            transpose_item_f8(a.in[I_WOUT] + (size_t)l * DM * DM, DM, 64 * kb, 32 * nb + (lane & 31), (unsigned char*)(ws + WS_WOUT) + (size_t)l * DM * DM, DM, 32 * nb, 64 * kb, scr, lane);
            continue; }
        r -= N2;
        if (r < N3) {
            const int le = r / 512, kb = (r % 512) / 32, nb = r % 32;
            const int n = 32 * nb + (lane & 31), jt = n >> 8, bj = (n >> 7) & 1, i = n & 127;
            const float* src = (bj ? a.in[I_WU] : a.in[I_WG]) + (size_t)le * DM * DE;
            transpose_item_f8(src, DE, 64 * kb, jt * 128 + i, (unsigned char*)(ws + WS_WGU) + (size_t)le * DM * DM, DM, 32 * nb, 64 * kb, scr, lane);
            continue; }
        r -= N3;
        if (r < N4) {
            const int le = r / 256, kb = (r % 256) / 32, nb = r % 32;
            transpose_item_f8(a.in[I_WDN] + (size_t)le * DE * DM, DM, 64 * kb, 32 * nb + (lane & 31), (unsigned char*)(ws + WS_WD) + (size_t)le * DM * DE, DE, 32 * nb, 64 * kb, scr, lane);
            continue; }
        r -= N4;
        if (r < N5) {
            const int l = r / 1024, kdg = (r % 1024) / 16, nb = r % 16;
            const int n = nb * 64 + lane, kd0 = kdg * 8, g = kd0 >> 7, c0 = kd0 & 127;
            const float* wo = a.in[I_WOUT] + (size_t)l * DM * DM + (size_t)(512 + g * 128) * DM + n;
            const float* ps = a.in[I_PSCALE] + l * 512 + g * 128;
            const float* wp = a.in[I_WPOOL] + ((size_t)(l * 4 + g) * 128 + c0) * 128;
            float acc[8];
#pragma unroll
            for (int j = 0; j < 8; ++j) acc[j] = 0.f;
            for (int e = 0; e < 128; ++e) { const float w = wo[(size_t)e * DM] * ps[e];
#pragma unroll
                for (int j = 0; j < 8; ++j) acc[j] += wp[j * 128 + e] * w; }
            u32x2 o; o.x = pk4_fp8(128.f * acc[0], 128.f * acc[1], 128.f * acc[2], 128.f * acc[3]); o.y = pk4_fp8(128.f * acc[4], 128.f * acc[5], 128.f * acc[6], 128.f * acc[7]);
            *(u32x2*)((unsigned char*)(ws + WS_WOUT) + (size_t)l * DM * DM + (size_t)n * DM + 512 + kd0) = o;
            continue; }
        r -= N5;
        {
            const int ent = r * 64 + lane, pos = ent >> 3, i = ent & 7;
            const float inv = (float)exp2(-(double)i / 8.0 * 18.931568569324174);
            const float ang = (float)pos * inv;
            float* t = (float*)(ws + WS_ROPE) + ent * 2;
            t[0] = (float)cos((double)ang); t[1] = (float)sin((double)ang);
        }
    }
    for (int i = c.bid * 512 + c.tid; i < 2 * NB * NH * NBLK * HD; i += c.G * 512) ((float*)(ws + WS_KBAR))[i] = 0.f;
    __syncthreads();
    if (c.bid < 192) {
        float* condT = (float*)c.lds;
        float* red = (float*)(c.lds + 65536);
        for (int idx = c.tid; idx < NB * DM; idx += 512) { const int b = idx >> 10, k = idx & 1023; const float v = a.in[I_C][idx]; condT[k * 16 + b] = v / (1.f + __expf(-v)); }
        __syncthreads();
        for (int u = c.bid; u < 192; u += c.G) {
            const int l = u / 96, n0 = (u % 96) * 64;
            const float* W = a.in[I_WMOD] + (size_t)l * DM * NMOD + n0 + lane;
            float acc[16];
#pragma unroll
            for (int b = 0; b < 16; ++b) acc[b] = 0.f;
            for (int k = 128 * c.wave; k < 128 * c.wave + 128; k += 8) {
                float wv[8];
#pragma unroll
                for (int j = 0; j < 8; ++j) wv[j] = W[(size_t)(k + j) * NMOD];
#pragma unroll
                for (int j = 0; j < 8; ++j) {
                    const f32x4* cp = (const f32x4*)(condT + (k + j) * 16);
#pragma unroll
                    for (int q = 0; q < 4; ++q) { const f32x4 cv = cp[q]; acc[4 * q + 0] += cv.x * wv[j]; acc[4 * q + 1] += cv.y * wv[j]; acc[4 * q + 2] += cv.z * wv[j]; acc[4 * q + 3] += cv.w * wv[j]; }
                }
            }
#pragma unroll
            for (int b = 0; b < 16; ++b) red[(c.wave * 16 + b) * 64 + lane] = acc[b];
            __syncthreads();
            for (int o = c.tid; o < 1024; o += 512) { const int b = o >> 6, cc = o & 63; float s = a.in[I_BMOD][l * NMOD + n0 + cc];
#pragma unroll
                for (int w = 0; w < 8; ++w) s += red[(w * 16 + b) * 64 + cc];
                ((float*)(ws + WS_MOD))[(size_t)(l * NB + b) * NMOD + n0 + cc] = s; }
            __syncthreads();
        }
    }
}

DEVFN void row_stats(const f32x4 (&v)[4], float& mean, float& rstd) {
    float s = 0.f, q = 0.f;
#pragma unroll
    for (int j = 0; j < 4; ++j) { s += (v[j].x + v[j].y) + (v[j].z + v[j].w); q += (v[j].x * v[j].x + v[j].y * v[j].y) + (v[j].z * v[j].z + v[j].w * v[j].w); }
    s = swz_xor_add(s, 1); q = swz_xor_add(q, 1); s = swz_xor_add(s, 2); q = swz_xor_add(q, 2); s = swz_xor_add(s, 4); q = swz_xor_add(q, 4);
    s = swz_xor_add(s, 8); q = swz_xor_add(q, 8); s = swz_xor_add(s, 16); q = swz_xor_add(q, 16); s = half_swap_add(s); q = half_swap_add(q);
    mean = s * (1.f / DM);
    rstd = 1.f / sqrtf(fmaxf(q * (1.f / DM) - mean * mean, 0.f) + LN_EPS);
}
DEVFN void row_load(const float* p, int lane, f32x4 (&v)[4]) {
#pragma unroll
    for (int j = 0; j < 4; ++j) v[j] = *(const f32x4*)(p + 4 * lane + 256 * j);
}
DEVFN void row_mod_store(f32x4 (&v)[4], const float* sc, const float* sh, bf16_t* out, int lane) {
    float mean, rstd; row_stats(v, mean, rstd);
#pragma unroll
    for (int j = 0; j < 4; ++j) {
        const f32x4 s = *(const f32x4*)(sc + 4 * lane + 256 * j), h = *(const f32x4*)(sh + 4 * lane + 256 * j);
        v[j] = (v[j] - mean) * rstd * (s + 1.f) + h;
        u32x2 o; o.x = pk2(v[j].x, v[j].y); o.y = pk2(v[j].z, v[j].w);
        *(u32x2*)(out + 4 * lane + 256 * j) = o;
    }
}

DEVFN void ph_pool(const Args& a, const Ctx& c) {
    const bf16_t* P = (const bf16_t*)(a.ws + WS_QKVP) + 1536; unsigned char* AD = (unsigned char*)(a.ws + WS_AD) + 512;
    for (int it = c.bid * 512 + c.tid; it < (NTOK / 8) * 64; it += c.G * 512) {
        const int cg = it & 63, m0 = (it >> 6) * 8, t0 = m0 & (SEQ - 1), g = cg >> 4, w = 2 << g;
        const bf16_t* pc = P + cg * 8;
        u32x4 rows[23];
#pragma unroll
        for (int k = 0; k < 23; ++k) { const int dt = k - 15; rows[k] = (u32x4){0u, 0u, 0u, 0u}; if (dt > -w && t0 + dt >= 0) rows[k] = *(const u32x4*)(pc + (size_t)(m0 + dt) * DIN); }
        float s[8];
#pragma unroll
        for (int j = 0; j < 8; ++j) s[j] = 0.f;
#pragma unroll
        for (int k = 0; k < 15; ++k) { const u32x4 v = rows[k]; s[0] += bf_lo(v.x); s[1] += bf_hi(v.x); s[2] += bf_lo(v.y); s[3] += bf_hi(v.y); s[4] += bf_lo(v.z); s[5] += bf_hi(v.z); s[6] += bf_lo(v.w); s[7] += bf_hi(v.w); }
#pragma unroll
        for (int r = 0; r < 8; ++r) {
            const int t = t0 + r; const u32x4 v = rows[15 + r];
            const float f[8] = {bf_lo(v.x), bf_hi(v.x), bf_lo(v.y), bf_hi(v.y), bf_lo(v.z), bf_hi(v.z), bf_lo(v.w), bf_hi(v.w)};
#pragma unroll
            for (int j = 0; j < 8; ++j) s[j] += f[j];
            const int cnt = (t + 1 < w) ? t + 1 : w; const float ic = 1.f / (float)cnt;
            u32x2 o; o.x = pk4_fp8(s[0] * ic - f[0], s[1] * ic - f[1], s[2] * ic - f[2], s[3] * ic - f[3]); o.y = pk4_fp8(s[4] * ic - f[4], s[5] * ic - f[5], s[6] * ic - f[6], s[7] * ic - f[7]);
            *(u32x2*)(AD + (size_t)(m0 + r) * DM + cg * 8) = o;
            u32x4 q = rows[r];
            if (w == 8) q = rows[r + 8]; else if (w == 4) q = rows[r + 12]; else if (w == 2) q = rows[r + 14];
            s[0] -= bf_lo(q.x); s[1] -= bf_hi(q.x); s[2] -= bf_lo(q.y); s[3] -= bf_hi(q.y); s[4] -= bf_lo(q.z); s[5] -= bf_hi(q.z); s[6] -= bf_lo(q.w); s[7] -= bf_hi(q.w);
        }
    }
}

constexpr size_t WS_X1B = WS_X1, WS_X2B = WS_X1 + 64 * MiB;
constexpr int ROWS_PER_WAVE = 16;
DEVFN void vec_load(const float* p, int lane, f32x4 (&v)[4]) {
#pragma unroll
    for (int j = 0; j < 4; ++j) v[j] = *(const f32x4*)(p + 4 * lane + 256 * j);
}
DEVFN void bfrow_load(const bf16_t* p, int lane, u32x2 (&w)[4]) {
#pragma unroll
    for (int j = 0; j < 4; ++j) w[j] = *(const u32x2*)(p + 4 * lane + 256 * j);
}
DEVFN f32x4 bf4(u32x2 w) { return (f32x4){bf_lo(w.x), bf_hi(w.x), bf_lo(w.y), bf_hi(w.y)}; }
DEVFN void bfrow_store(bf16_t* p, int lane, const f32x4 (&v)[4]) {
#pragma unroll
    for (int j = 0; j < 4; ++j) { u32x2 o; o.x = pk2(v[j].x, v[j].y); o.y = pk2(v[j].z, v[j].w); *(u32x2*)(p + 4 * lane + 256 * j) = o; }
}
DEVFN void f8row_store(unsigned char* p, int lane, const f32x4 (&v)[4]) {
#pragma unroll
    for (int j = 0; j < 4; ++j) *(unsigned*)(p + 4 * lane + 256 * j) = pk4_fp8(v[j].x, v[j].y, v[j].z, v[j].w);
}
DEVFN void ln_mod(f32x4 (&v)[4], const f32x4 (&sc)[4], const f32x4 (&sh)[4]) {
    float mean, rstd; row_stats(v, mean, rstd);
#pragma unroll
    for (int j = 0; j < 4; ++j) v[j] = (v[j] - mean) * rstd * (sc[j] + 1.f) + sh[j];
}
DEVFN void ln_aff(f32x4 (&v)[4], const f32x4 (&g)[4], const f32x4 (&b)[4]) {
    float mean, rstd; row_stats(v, mean, rstd);
#pragma unroll
    for (int j = 0; j < 4; ++j) v[j] = (v[j] - mean) * rstd * g[j] + b[j];
}

DEVFN void ph_h1_rows(const Args& a, const Ctx& c) {
    const float* mod = (const float*)(a.ws + WS_MOD); bf16_t* HB = (bf16_t*)(a.ws + WS_HB);
    for (int base = c.gw * ROWS_PER_WAVE; base < NTOK; base += c.NGW * ROWS_PER_WAVE) {
        const float* mb = mod + (size_t)(base >> 11) * NMOD;
        f32x4 sc[4], sh[4]; vec_load(mb + DM, c.lane, sc); vec_load(mb, c.lane, sh);
        f32x4 cur[4], nxt[4]; vec_load(a.in[I_X] + (size_t)base * DM, c.lane, cur);
#pragma unroll 1
        for (int i = 0; i < ROWS_PER_WAVE; ++i) {
            const int m = base + i;
            if (i + 1 < ROWS_PER_WAVE) vec_load(a.in[I_X] + (size_t)(m + 1) * DM, c.lane, nxt);
            ln_mod(cur, sc, sh); f8row_store((unsigned char*)HB + (size_t)m * DM, c.lane, cur);
#pragma unroll
            for (int j = 0; j < 4; ++j) cur[j] = nxt[j];
        }
    }
}

DEVFN f32x4 reduce16(const float (&lg)[16]) {
    float t[8], u[4];
#pragma unroll
    for (int e = 0; e < 8; ++e) { auto rr = __builtin_amdgcn_permlane32_swap(__float_as_uint(lg[e]), __float_as_uint(lg[e + 8]), false, false); t[e] = __uint_as_float(rr[0]) + __uint_as_float(rr[1]); }
#pragma unroll
    for (int k = 0; k < 4; ++k) { auto rr = __builtin_amdgcn_permlane16_swap(__float_as_uint(t[k]), __float_as_uint(t[k + 4]), false, false); u[k] = __uint_as_float(rr[0]) + __uint_as_float(rr[1]); }
#pragma unroll
    for (int k = 0; k < 4; ++k) { u[k] = swz_xor_add(u[k], 1); u[k] = swz_xor_add(u[k], 2); u[k] = swz_xor_add(u[k], 4); u[k] = swz_xor_add(u[k], 8); }
    return (f32x4){u[0], u[1], u[2], u[3]};
}

DEVFN void rowc_load(const Args& a, int l, int m, int lane, f32x4 (&x)[4], unsigned (&y)[4]) {
    if (l == 0) vec_load(a.in[I_X] + (size_t)m * DM, lane, x);
    else { u32x2 w[4]; bfrow_load((const bf16_t*)(a.ws + WS_X2B) + (size_t)m * DM, lane, w);
#pragma unroll
        for (int j = 0; j < 4; ++j) { x[j].x = __uint_as_float(w[j].x); x[j].y = __uint_as_float(w[j].y); } }
#pragma unroll
    for (int j = 0; j < 4; ++j) y[j] = *(const unsigned*)((const unsigned char*)(a.ws + WS_QKVP) + (size_t)m * DM + 4 * lane + 256 * j);
}
DEVFN void rowc_step(const Args& a, int l, int m, int lane, const f32x4 (&x)[4], const unsigned (&y)[4], const float* vg1, const float* vsc, const float* vsh, f32x4 (&v)[4]) {
    int z_ = 0; asm volatile("" : "+v"(z_));
    f32x4 g1[4]; vec_load(vg1 + z_, lane, g1);
#pragma unroll
    for (int j = 0; j < 4; ++j) { const f32x4 xv = (l == 0) ? x[j] : bf4((u32x2){__float_as_uint(x[j].x), __float_as_uint(x[j].y)}); v[j] = xv * ALPHA + g1[j] * f8x4_to_f32(y[j], 1.f / YSCALE); }
    { f32x4 lg[4], lb[4]; vec_load(a.in[I_LN1G] + l * DM + z_, lane, lg); vec_load(a.in[I_LN1B] + l * DM + z_, lane, lb); ln_aff(v, lg, lb); }
    bfrow_store((bf16_t*)(a.ws + WS_X1B) + (size_t)m * DM, lane, v);
    { f32x4 sc[4], sh[4]; vec_load(vsc + z_, lane, sc); vec_load(vsh + z_, lane, sh); ln_mod(v, sc, sh); }
    f8row_store((unsigned char*)(a.ws + WS_HB) + (size_t)m * DM, lane, v);
}

DEVFN void ph_rows_c(const Args& a, const Ctx& c, int l, bool publish) {
    const float* mod = (const float*)(a.ws + WS_MOD) + (size_t)l * NB * NMOD;
    const bf16_t* Y = (const bf16_t*)(a.ws + WS_QKVP); const bf16_t* X2B = (const bf16_t*)(a.ws + WS_X2B);
    bf16_t* X1B = (bf16_t*)(a.ws + WS_X1B); bf16_t* HB = (bf16_t*)(a.ws + WS_HB);
    float* wr = (float*)c.lds;
    float* vsc = (float*)(c.lds + 65536); float* vsh = vsc + DM; float* vg1 = vsh + DM;
    int* lcnt = (int*)(c.lds + 65536 + 12288); int* lbase = lcnt + 32;
    int* rcls = lbase + 32; float* rw1 = (float*)(rcls + 8 * 64); float* rw2 = rw1 + 8 * 64; int* rrow = (int*)(rw2 + 8 * 64); float* lgs = (float*)(rrow + 8 * 64);
    for (int i = c.tid; i < DM * NE; i += 512) wr[(i & 15) * DM + (i >> 4)] = a.in[I_WR][i];
    if (c.tid < 32) lcnt[c.tid] = 0;
    __syncthreads();
    int nr = 0;
    for (int base = c.gw * ROWS_PER_WAVE; base < NTOK; base += c.NGW * ROWS_PER_WAVE) {
        const float* mb = mod + (size_t)(base >> 11) * NMOD;
        __syncthreads();
        for (int i = c.tid; i < 3 * DM; i += 512) vsc[i] = (i < DM) ? mb[4 * DM + i] : (i < 2 * DM ? mb[3 * DM + (i - DM)] : mb[2 * DM + (i - 2 * DM)]);
        __syncthreads();
#pragma unroll 1
        for (int i = 0; i < ROWS_PER_WAVE; i += 2) {
            const int m = __builtin_amdgcn_readfirstlane(base + i);
            f32x4 va[4], vb[4];
            { f32x4 xa[4], xb[4]; unsigned ya[4], yb[4];
              rowc_load(a, l, m, c.lane, xa, ya); rowc_load(a, l, m + 1, c.lane, xb, yb);
              rowc_step(a, l, m, c.lane, xa, ya, vg1, vsc, vsh, va);
              rowc_step(a, l, m + 1, c.lane, xb, yb, vg1, vsc, vsh, vb); }
            typedef float f32x2_t __attribute__((ext_vector_type(2)));
            f32x2_t acc2[16];
#pragma unroll
            for (int e = 0; e < 16; ++e) acc2[e] = (f32x2_t){0.f, 0.f};
#pragma unroll
            for (int j = 0; j < 4; ++j) {
                const f32x2_t p0 = {va[j].x, vb[j].x}, p1 = {va[j].y, vb[j].y}, p2 = {va[j].z, vb[j].z}, p3 = {va[j].w, vb[j].w};
#pragma unroll
                for (int e = 0; e < 16; ++e) { const f32x4 w = *(const f32x4*)(wr + e * DM + 4 * c.lane + 256 * j);
                    acc2[e] = __builtin_elementwise_fma(p0, (f32x2_t){w.x, w.x}, acc2[e]); acc2[e] = __builtin_elementwise_fma(p1, (f32x2_t){w.y, w.y}, acc2[e]);
                    acc2[e] = __builtin_elementwise_fma(p2, (f32x2_t){w.z, w.z}, acc2[e]); acc2[e] = __builtin_elementwise_fma(p3, (f32x2_t){w.w, w.w}, acc2[e]);
                    if ((e & 7) == 7) __builtin_amdgcn_sched_barrier(0); } }
            float la[16], lb2[16];
#pragma unroll
            for (int e = 0; e < 16; ++e) { la[e] = acc2[e].x; lb2[e] = acc2[e].y; }
            { const f32x4 ua = reduce16(la), ub = reduce16(lb2);
              if ((c.lane & 15) == 0) { *(f32x4*)(lgs + (c.wave * 16 + i) * 16 + (c.lane >> 4) * 4) = ua; *(f32x4*)(lgs + (c.wave * 16 + i + 1) * 16 + (c.lane >> 4) * 4) = ub; } }
        }
        LDS_WAIT();
        if (c.lane < ROWS_PER_WAVE) {
            float lg16[16], rb[16];
#pragma unroll
            for (int e = 0; e < 16; ++e) rb[e] = a.in[I_RB][e];
#pragma unroll
            for (int q = 0; q < 4; ++q) { const f32x4 t = *(const f32x4*)(lgs + (c.wave * 16 + c.lane) * 16 + 4 * q); lg16[4 * q] = t.x; lg16[4 * q + 1] = t.y; lg16[4 * q + 2] = t.z; lg16[4 * q + 3] = t.w; }
            float mx = lg16[0];
#pragma unroll
            for (int e = 1; e < 16; ++e) mx = fmaxf(mx, lg16[e]);
            float sum = 0.f, scr[16];
#pragma unroll
            for (int e = 0; e < 16; ++e) { scr[e] = __expf(lg16[e] - mx); sum += scr[e]; }
            const float isum = 1.f / sum;
#pragma unroll
            for (int e = 0; e < 16; ++e) scr[e] *= isum;
            float bestg = -3.4e38f; int gb = 0, bi1 = 0, bi2 = 1; float bw1 = 0.f, bw2 = 0.f;
#pragma unroll
            for (int g = 0; g < 4; ++g) {
                float m1 = scr[4 * g] + rb[4 * g], s1 = scr[4 * g]; int i1 = 0;
#pragma unroll
                for (int q = 1; q < 4; ++q) { const float sv = scr[4 * g + q] + rb[4 * g + q]; const bool ok = sv > m1; m1 = ok ? sv : m1; s1 = ok ? scr[4 * g + q] : s1; i1 = ok ? q : i1; }
                float m2 = -3.4e38f, s2 = 0.f; int i2 = 0;
#pragma unroll
                for (int q = 0; q < 4; ++q) { const float sv = scr[4 * g + q] + rb[4 * g + q]; const bool ok = (q != i1) && sv > m2; m2 = ok ? sv : m2; s2 = ok ? scr[4 * g + q] : s2; i2 = ok ? q : i2; }
                const float gs = m1 + m2; const bool better = gs > bestg;
                bestg = better ? gs : bestg; gb = better ? g : gb; bi1 = better ? i1 : bi1; bi2 = better ? i2 : bi2; bw1 = better ? s1 : bw1; bw2 = better ? s2 : bw2;
            }
            const float inv = 1.f / (bw1 + bw2);
            const int lo = bi1 < bi2 ? bi1 : bi2, hi2 = bi1 < bi2 ? bi2 : bi1;
            const float wlo = (bi1 < bi2 ? bw1 : bw2) * inv, whi = (bi1 < bi2 ? bw2 : bw1) * inv;
            const int pidx = lo == 0 ? hi2 - 1 : (lo == 1 ? hi2 + 1 : 5);
            const int slot = c.wave * 64 + nr + c.lane;
            rcls[slot] = gb * 6 + pidx; rw1[slot] = wlo; rw2[slot] = whi; rrow[slot] = base + c.lane;
        }
        nr += ROWS_PER_WAVE;
        LDS_WAIT();
    }
    LDS_WAIT();
    if (!publish) return;
    int rank = 0, cls = 0;
    if (c.lane < nr) { cls = rcls[c.wave * 64 + c.lane]; rank = atomicAdd(&lcnt[cls], 1); }
    __syncthreads();
    if (c.tid < NCLS) lbase[c.tid] = (int)__hip_atomic_fetch_add((unsigned*)(a.ws + WS_CTL) + CW_CNT + l * 32 + c.tid, (unsigned)lcnt[c.tid], RLX_AGENT);
    __syncthreads();
    if (c.lane < nr) {
        const int pos = lbase[cls] + rank;
        ((int*)(a.ws + WS_LIST))[(size_t)cls * LISTCAP + pos] = rrow[c.wave * 64 + c.lane];
        float* rw = (float*)(a.ws + WS_RW) + ((size_t)cls * LISTCAP + pos) * 2;
        rw[0] = rw1[c.wave * 64 + c.lane]; rw[1] = rw2[c.wave * 64 + c.lane];
    }
}

DEVFN void ph_rows_g(const Args& a, const Ctx& c, int l) {
    const float* mod = (const float*)(a.ws + WS_MOD) + (size_t)l * NB * NMOD;
    const bf16_t* X1B = (const bf16_t*)(a.ws + WS_X1B); const unsigned char* Y2 = (const unsigned char*)(a.ws + WS_AD);
    bf16_t* X2B = (bf16_t*)(a.ws + WS_X2B); bf16_t* HB = (bf16_t*)(a.ws + WS_HB);
    for (int base = c.gw * ROWS_PER_WAVE; base < NTOK; base += c.NGW * ROWS_PER_WAVE) {
        const float* mb = mod + (size_t)(base >> 11) * NMOD; const float* mb1 = mb + (size_t)NB * NMOD;
        f32x4 g2[4], lg[4], lb[4], sc[4], sh[4];
        vec_load(mb + 5 * DM, c.lane, g2); vec_load(a.in[I_LN2G] + l * DM, c.lane, lg); vec_load(a.in[I_LN2B] + l * DM, c.lane, lb);
        if (l == 0) { vec_load(mb1 + DM, c.lane, sc); vec_load(mb1, c.lane, sh); }
        u32x2 xc[4], xn[4]; unsigned yc[4], yn[4];
        bfrow_load(X1B + (size_t)base * DM, c.lane, xc);
#pragma unroll
        for (int j = 0; j < 4; ++j) yc[j] = *(const unsigned*)(Y2 + (size_t)base * DM + 4 * c.lane + 256 * j);
#pragma unroll 1
        for (int i = 0; i < ROWS_PER_WAVE; ++i) {
            const int m = base + i;
            if (i + 1 < ROWS_PER_WAVE) { bfrow_load(X1B + (size_t)(m + 1) * DM, c.lane, xn);
#pragma unroll
                for (int j = 0; j < 4; ++j) yn[j] = *(const unsigned*)(Y2 + (size_t)(m + 1) * DM + 4 * c.lane + 256 * j); }
            f32x4 v[4];
#pragma unroll
            for (int j = 0; j < 4; ++j) v[j] = bf4(xc[j]) * ALPHA + g2[j] * f8x4_to_f32(yc[j], 1.f / YSCALE);
            ln_aff(v, lg, lb);
            if (l == 0) { bfrow_store(X2B + (size_t)m * DM, c.lane, v); ln_mod(v, sc, sh); f8row_store((unsigned char*)HB + (size_t)m * DM, c.lane, v); }
            else {
#pragma unroll
                for (int j = 0; j < 4; ++j) *(f32x4*)(a.out + (size_t)m * DM + 4 * c.lane + 256 * j) = v[j]; }
#pragma unroll
            for (int j = 0; j < 4; ++j) { xc[j] = xn[j]; yc[j] = yn[j]; }
        }
    }
}

constexpr int MOETAB_OFF = 131072 + 512;
DEVFN void ph_inproj_fast(const Args& a, const Ctx& c, int l, bool dummy_kbar) {
    pg8::DenseSched S; S.so.init(NTOK, DIN, c.G, c.bid); S.A = (const char*)(a.ws + WS_HB); S.Bt = (const char*)(a.ws + WS_WIN) + (size_t)l * DIN * DM; S.lda = DM; S.ldb = DM;
    const pg8::EpiInproj E{(bf16_t*)(a.ws + WS_QKVP), (const float*)(a.ws + WS_ROPE), (dummy_kbar ? (float*)(a.ws + WS_RW) : (float*)(a.ws + WS_KBAR)) + (size_t)l * NB * NH * NBLK * HD};
    pg8::gemm_phase2<pg8::EpiInproj, pg8::DenseSched, true, true, false, true, 127 - 5, 127>(c.lds3, DM, DM, S, E, c.tid);
}
DEVFN void ph_wout_fast(const Args& a, const Ctx& c, int l) {
    pg8::DenseSched S; S.so.init(NTOK, DM, c.G, c.bid); S.A = (const char*)(a.ws + WS_AD); S.Bt = (const char*)(a.ws + WS_WOUT) + (size_t)l * DM * DM; S.lda = DM; S.ldb = DM;
    const pg8::EpiF8 E{(unsigned char*)(a.ws + WS_QKVP), DM};
    pg8::gemm_phase2<pg8::EpiF8, pg8::DenseSched, true, true, false, true, 127 - 5, 127 - 5, true, 127 - 7, 127>(c.lds3, DM, DM, S, E, c.tid);
}
DEVFN void moe_table_lds(const Args& a, const Ctx& c, int l) {
    int* cnt = (int*)(c.lds + MOETAB_OFF); int* tp = cnt + 32;
    if (c.tid < NCLS) cnt[c.tid] = (int)__hip_atomic_load((unsigned*)(a.ws + WS_CTL) + CW_CNT + l * 32 + c.tid, RLX_AGENT);
    __syncthreads();
    if (c.tid == 0) { int s = 0; for (int k = 0; k < NCLS; ++k) { tp[k] = s; s += (cnt[k] + 255) >> 8; } tp[NCLS] = s; }
    __syncthreads();
}
DEVFN void ph_gateup_fast(const Args& a, const Ctx& c, int l) {
    moe_table_lds(a, c, l);
    pg8::GateUpSched S; S.cnt = (const LAS int*)(c.lds3 + MOETAB_OFF); S.tp = S.cnt + 32; S.npn_shift = 3; S.nunits = S.tp[NCLS] * 8; S.G = c.G; S.c = (c.G % 8 == 0) ? (c.bid % 8) * (c.G / 8) + c.bid / 8 : c.bid;
    S.HB = (const char*)(a.ws + WS_HB); S.list = (const int*)(a.ws + WS_LIST); S.W = (const char*)(a.ws + WS_WGU) + (size_t)l * NE * DM * DM;
    const pg8::EpiGateUp E{(unsigned char*)(a.ws + WS_QKVP), (const float*)(a.ws + WS_RW)};
    pg8::gemm_phase2<pg8::EpiGateUp, pg8::GateUpSched, true, true, false, true, 127 - 5, 127>(c.lds3, DM, DM, S, E, c.tid);
}
DEVFN void ph_down_fast(const Args& a, const Ctx& c, int l) {
    moe_table_lds(a, c, l);
    pg8::DownSched S; S.cnt = (const LAS int*)(c.lds3 + MOETAB_OFF); S.tp = S.cnt + 32; S.npn_shift = 2; S.nunits = S.tp[NCLS] * 4; S.G = c.G; S.c = (c.G % 8 == 0) ? (c.bid % 8) * (c.G / 8) + c.bid / 8 : c.bid;
    S.ACT = (const char*)(a.ws + WS_QKVP); S.W = (const char*)(a.ws + WS_WD) + (size_t)l * NE * DM * DE;
    const pg8::EpiDown E{(unsigned char*)(a.ws + WS_AD), (const int*)(a.ws + WS_LIST)};
    pg8::gemm_phase2<pg8::EpiDown, pg8::DownSched, true, true, true, true, 127 - 5, 127 - 3>(c.lds3, DM, DE, S, E, c.tid);
}

#ifndef MK_N_LAUNCHES
#define MK_N_LAUNCHES 1
#endif
constexpr int RING_BYTES = 131072, LDSCTL_OFF = RING_BYTES, MISC_OFF = LDSCTL_OFF + 320, LDS_BYTES = 147456;
constexpr int PH_PER_LAYER = 7, NPHASE = 2 + 2 * PH_PER_LAYER;
constexpr int CW_BAR = 4096;
static_assert((CW_BAR + XCD_BAR_WORDS) * 4 <= (int)CTL_ZERO_BYTES, "CTL");

__global__ void __launch_bounds__(512, 2) fwd(Args a) {
    extern __shared__ __attribute__((aligned(16))) unsigned char lds[];
    const int wave_s = __builtin_amdgcn_readfirstlane(threadIdx.x >> 6);
#define MKTID() (wave_s * 64 + lane_id_volatile())
#define MKCTX() Args al = a; { size_t z_ = 0; asm volatile("" : "+s"(z_)); al.ws = a.ws + z_; } Ctx c; {     int t_ = MKTID(); asm volatile("" : "+v"(t_)); c.lds = lds; c.lds3 = (LAS unsigned char*)lds; c.tid = t_; c.lane = t_ & 63; c.wave = __builtin_amdgcn_readfirstlane(t_ >> 6); c.G = gridDim.x; c.bid = blockIdx.x; c.gw = c.bid * 8 + c.wave; c.NGW = c.G * 8; }
    const int lo = a.ph_lo, hi = a.ph_hi;
    const bool one = (hi - lo) > 1;
    for (int u = threadIdx.x; u < (LDS_BYTES - LDSCTL_OFF) / 4; u += 512) ((LAS unsigned*)((LAS unsigned char*)lds + LDSCTL_OFF))[u] = 0u;
    __syncthreads();
    XcdBarrier bar; bar.bar = (unsigned*)(a.ws + WS_CTL) + CW_BAR; bar.x = 0; bar.st = nullptr;
    if (one) bar = xcd_barrier_post((unsigned*)(a.ws + WS_CTL) + CW_BAR, (volatile LAS unsigned*)((LAS unsigned char*)lds + MISC_OFF) + 8);
#ifndef REP_PHASE
#define REP_PHASE -1
#endif
#define IN(k) (lo <= (k) && (k) < hi)
#define SEAM(k) do { if (IN(k) && IN((k) + 1)) { XcdBarrier bl_ = bar; { size_t z_ = 0; unsigned x_ = bar.x; asm volatile("" : "+s"(z_), "+s"(x_)); bl_.bar = bar.bar + z_; bl_.x = x_; } xcd_barrier(bl_, MKTID() == 0); } } while (0)
    if (IN(0)) { MKCTX(); ph_prologue(al, c); if (REP_PHASE == 0) { __syncthreads(); ph_prologue(al, c); } SEAM(0); }
    if (IN(1)) { MKCTX(); ph_h1_rows(al, c); if (REP_PHASE == 1) ph_h1_rows(al, c); SEAM(1); }
    {
        constexpr int l = 0; constexpr int p0 = 2 + l * PH_PER_LAYER;
        if (IN(p0 + 0)) { MKCTX(); ph_inproj_fast(al, c, l, false); if (REP_PHASE == 10) { __syncthreads(); ph_inproj_fast(al, c, l, true); } SEAM(p0 + 0); }
        if (IN(p0 + 1)) {
            { MKCTX(); ph_pool(al, c); }
            __syncthreads();
            const attn_body::AttnTensors AT{(const attn_body::bf16*)(a.ws + WS_QKVP), (const attn_body::bf16*)(a.ws + WS_QKVP) + 512, (const attn_body::bf16*)(a.ws + WS_QKVP) + 1024,
                                            (attn_body::bf16*)(a.ws + WS_AD), (const float*)(a.ws + WS_KBAR) + (size_t)l * NB * NH * NBLK * HD};
            const attn_body::StaticOrder S((int)gridDim.x, (int)blockIdx.x);
            attn_body::attn_phase<attn_body::StaticOrder>((char*)lds, AT, S, MKTID());
            if (REP_PHASE == 11) attn_body::attn_phase<attn_body::StaticOrder>((char*)lds, AT, S, MKTID());
            if (REP_PHASE == 17) { __syncthreads(); MKCTX(); ph_pool(al, c); }
            SEAM(p0 + 1);
        }
        if (IN(p0 + 2)) { MKCTX(); ph_wout_fast(al, c, l); if (REP_PHASE == 12) { __syncthreads(); ph_wout_fast(al, c, l); } SEAM(p0 + 2); }
        if (IN(p0 + 3)) { MKCTX(); if (REP_PHASE == 13) { ph_rows_c(al, c, l, false); __syncthreads(); } ph_rows_c(al, c, l, true); SEAM(p0 + 3); }
        if (IN(p0 + 4)) { MKCTX(); ph_gateup_fast(al, c, l); if (REP_PHASE == 14) { __syncthreads(); ph_gateup_fast(al, c, l); } SEAM(p0 + 4); }
        if (IN(p0 + 5)) { MKCTX(); ph_down_fast(al, c, l); if (REP_PHASE == 15) { __syncthreads(); ph_down_fast(al, c, l); } SEAM(p0 + 5); }
        if (IN(p0 + 6)) { MKCTX(); ph_rows_g(al, c, l); if (REP_PHASE == 16) ph_rows_g(al, c, l); SEAM(p0 + 6); }
    }
    {
        constexpr int l = 1; constexpr int p0 = 2 + l * PH_PER_LAYER;
        if (IN(p0 + 0)) { MKCTX(); ph_inproj_fast(al, c, l, false); if (REP_PHASE == 10) { __syncthreads(); ph_inproj_fast(al, c, l, true); } SEAM(p0 + 0); }
        if (IN(p0 + 1)) {
            { MKCTX(); ph_pool(al, c); }
            __syncthreads();
            const attn_body::AttnTensors AT{(const attn_body::bf16*)(a.ws + WS_QKVP), (const attn_body::bf16*)(a.ws + WS_QKVP) + 512, (const attn_body::bf16*)(a.ws + WS_QKVP) + 1024,
                                            (attn_body::bf16*)(a.ws + WS_AD), (const float*)(a.ws + WS_KBAR) + (size_t)l * NB * NH * NBLK * HD};
            const attn_body::StaticOrder S((int)gridDim.x, (int)blockIdx.x);
            attn_body::attn_phase<attn_body::StaticOrder>((char*)lds, AT, S, MKTID());
            if (REP_PHASE == 11) attn_body::attn_phase<attn_body::StaticOrder>((char*)lds, AT, S, MKTID());
            if (REP_PHASE == 17) { __syncthreads(); MKCTX(); ph_pool(al, c); }
            SEAM(p0 + 1);
        }
        if (IN(p0 + 2)) { MKCTX(); ph_wout_fast(al, c, l); if (REP_PHASE == 12) { __syncthreads(); ph_wout_fast(al, c, l); } SEAM(p0 + 2); }
        if (IN(p0 + 3)) { MKCTX(); if (REP_PHASE == 13) { ph_rows_c(al, c, l, false); __syncthreads(); } ph_rows_c(al, c, l, true); SEAM(p0 + 3); }
        if (IN(p0 + 4)) { MKCTX(); ph_gateup_fast(al, c, l); if (REP_PHASE == 14) { __syncthreads(); ph_gateup_fast(al, c, l); } SEAM(p0 + 4); }
        if (IN(p0 + 5)) { MKCTX(); ph_down_fast(al, c, l); if (REP_PHASE == 15) { __syncthreads(); ph_down_fast(al, c, l); } SEAM(p0 + 5); }
        if (IN(p0 + 6)) { MKCTX(); ph_rows_g(al, c, l); if (REP_PHASE == 16) ph_rows_g(al, c, l); SEAM(p0 + 6); }
    }
#undef IN
#undef SEAM
}

extern "C" void kernel_launch(void* const* d_in, const int* in_sizes, int n_in, void* d_out, int out_size, void* d_ws, size_t ws_size, hipStream_t stream) {
    static int grid = 0;
    if (grid == 0) {
        if (n_in != 17 || out_size != NTOK * DM || ws_size < WS_END) { fprintf(stderr, "kernel_launch: unexpected problem (n_in %d out %d ws %zu)\n", n_in, out_size, ws_size); grid = -1; return; }
        if (hipFuncSetAttribute((const void*)fwd, hipFuncAttributeMaxDynamicSharedMemorySize, LDS_BYTES) != hipSuccess) { fprintf(stderr, "kernel_launch: hipFuncSetAttribute failed\n"); grid = -1; return; }
        int dev = 0, cus = 0, per_cu = 0;
        (void)hipGetDevice(&dev); (void)hipDeviceGetAttribute(&cus, hipDeviceAttributeMultiprocessorCount, dev);
        if (hipOccupancyMaxActiveBlocksPerMultiprocessor(&per_cu, (const void*)fwd, 512, LDS_BYTES) != hipSuccess || per_cu < 1) fprintf(stderr, "kernel_launch: occupancy query reports %d workgroups per CU\n", per_cu);
        (void)hipGetLastError();
        grid = cus > 0 ? cus : 256;
    }
    if (grid < 0) return;
    (void)hipMemsetAsync((char*)d_ws + WS_CTL, 0, CTL_ZERO_BYTES, stream);
    Args a{};
    for (int i = 0; i < 17; ++i) a.in[i] = (const float*)d_in[i];
    a.out = (float*)d_out; a.ws = (unsigned char*)d_ws;
#if MK_N_LAUNCHES == 1
    a.ph_lo = 0; a.ph_hi = NPHASE; hipLaunchKernelGGL(fwd, dim3(grid), dim3(512), LDS_BYTES, stream, a);
#else
    for (int p = 0; p < NPHASE; ++p) { a.ph_lo = p; a.ph_hi = p + 1; hipLaunchKernelGGL(fwd, dim3(grid), dim3(512), LDS_BYTES, stream, a); }
#endif
}
```

```cpp
#include <hip/hip_runtime.h>
#include <cstdint>
#include <cstdio>

constexpr int NB = 16, SEQ = 2048, DM = 1024, NTOK = NB * SEQ, DIN = 2048, NH = 8, HD = 64, NBLK = 8, MBLK = 256;
constexpr int NE = 16, NCLS = 24, DE = 512, NMOD = 6 * DM;
constexpr float ALPHA = 1.41421356237309515f, LN_EPS = 1e-5f;
constexpr float QSCALE = 0.125f * 1.4426950408889634f;
constexpr int LISTCAP = NTOK;

constexpr size_t MiB = 1u << 20;
constexpr size_t WS_CTL = 0, CTL_ZERO_BYTES = 1 * MiB;
constexpr size_t WS_MOD = 1 * MiB;
constexpr size_t WS_ROPE = 2 * MiB;
constexpr size_t WS_KBAR = 2 * MiB + 256 * 1024;
constexpr size_t WS_LIST = 3 * MiB;
constexpr size_t WS_RW = 6 * MiB;
constexpr size_t WS_WIN = 12 * MiB;
constexpr size_t WS_WOUT = 20 * MiB;
constexpr size_t WS_WGU = 24 * MiB;
constexpr size_t WS_WD = 88 * MiB;
constexpr size_t WS_HB = 120 * MiB;
constexpr size_t WS_QKVP = 184 * MiB;
constexpr size_t WS_AD = 312 * MiB;
constexpr size_t WS_X1 = 376 * MiB;
constexpr size_t WS_END = 504 * MiB;
constexpr int CW_TMO = 0, CW_CNT = 64;

typedef unsigned short bf16_t;
typedef short bf16x8 __attribute__((ext_vector_type(8)));
typedef float f32x4 __attribute__((ext_vector_type(4)));
typedef float f32x16 __attribute__((ext_vector_type(16)));
typedef unsigned u32x4 __attribute__((ext_vector_type(4)));
typedef unsigned u32x2 __attribute__((ext_vector_type(2)));

#define DEVFN __device__ __forceinline__
#define LDS_WAIT() asm volatile("s_waitcnt lgkmcnt(0)" ::: "memory")
#define RLX_AGENT __ATOMIC_RELAXED, __HIP_MEMORY_SCOPE_AGENT

DEVFN float bf_lo(unsigned w) { return __uint_as_float(w << 16); }
DEVFN float bf_hi(unsigned w) { return __uint_as_float(w & 0xffff0000u); }
DEVFN float bf2f(bf16_t v) { return __uint_as_float((unsigned)v << 16); }
DEVFN unsigned f2bf(float f) { unsigned u = __float_as_uint(f); return (u + 0x7fffu + ((u >> 16) & 1u)) >> 16; }
DEVFN unsigned pk2(float lo, float hi) { unsigned r; asm("v_cvt_pk_bf16_f32 %0, %1, %2" : "=v"(r) : "v"(lo), "v"(hi)); return r; }
DEVFN unsigned pk4_fp8(float a, float b, float c, float d) {
    a = __builtin_amdgcn_fmed3f(a, -448.f, 448.f); b = __builtin_amdgcn_fmed3f(b, -448.f, 448.f); c = __builtin_amdgcn_fmed3f(c, -448.f, 448.f); d = __builtin_amdgcn_fmed3f(d, -448.f, 448.f);
    unsigned w = 0u; w = __builtin_amdgcn_cvt_pk_fp8_f32(a, b, w, false); w = __builtin_amdgcn_cvt_pk_fp8_f32(c, d, w, true); return w; }
DEVFN f32x4 f8x4_to_f32(unsigned w, float sc) { const auto lo = __builtin_amdgcn_cvt_pk_f32_fp8(w, false), hi = __builtin_amdgcn_cvt_pk_f32_fp8(w, true); return (f32x4){lo[0] * sc, lo[1] * sc, hi[0] * sc, hi[1] * sc}; }
constexpr float YSCALE = 16.f;
DEVFN int crow(int r, int hi) { return (r & 3) + 8 * (r >> 2) + 4 * hi; }
#define SWZ_XOR(m) (0x1f | ((m) << 10))
DEVFN float swz_xor_add(float v, const int m) {
    switch (m) {
        case 1: return v + __int_as_float(__builtin_amdgcn_ds_swizzle(__float_as_int(v), SWZ_XOR(1)));
        case 2: return v + __int_as_float(__builtin_amdgcn_ds_swizzle(__float_as_int(v), SWZ_XOR(2)));
        case 4: return v + __int_as_float(__builtin_amdgcn_ds_swizzle(__float_as_int(v), SWZ_XOR(4)));
        case 8: return v + __int_as_float(__builtin_amdgcn_ds_swizzle(__float_as_int(v), SWZ_XOR(8)));
        default: return v + __int_as_float(__builtin_amdgcn_ds_swizzle(__float_as_int(v), SWZ_XOR(16)));
    }
}
DEVFN float half_swap_add(float v) { auto rr = __builtin_amdgcn_permlane32_swap(__float_as_uint(v), __float_as_uint(v), false, false); return __uint_as_float(rr[0]) + __uint_as_float(rr[1]); }
DEVFN float wave_sum(float v) {
    v = swz_xor_add(v, 1); v = swz_xor_add(v, 2); v = swz_xor_add(v, 4); v = swz_xor_add(v, 8); v = swz_xor_add(v, 16);
    return half_swap_add(v);
}
__host__ __device__ __forceinline__ int inproj_lgroup(int P) { return P < 16 ? (P >> 2) * 8 + (P & 3) * 2 : ((P - 16) >> 2) * 8 + ((P - 16) & 3) * 2 + 1; }
__host__ __device__ __forceinline__ int inproj_nlog(int n) { return (n & ~255) + inproj_lgroup((n & 255) >> 3) * 8 + (n & 7); }

#define GAS __attribute__((address_space(1)))
#define LAS __attribute__((address_space(3)))
typedef GAS unsigned gu32;
namespace pg8 {
#define PG8_LAS __attribute__((address_space(3)))
typedef unsigned short bf16_t;
typedef short bf16x8 __attribute__((ext_vector_type(8)));
typedef float f32x4 __attribute__((ext_vector_type(4)));
typedef unsigned u32x4 __attribute__((ext_vector_type(4)));
constexpr int BM = 256, BK = 64, HALF = 128, HTB = HALF * BK * 2  , STAGE_BYTES = 8 * HTB, NXCD = 8, WGM = 8;

__host__ __device__ __forceinline__ int lds_byte(int r, int c) { const int st = (r >> 4) * 2 + (c >> 5), rr = r & 15, cc = c & 31, ob = rr * 64 + cc * 2; return st * 1024 + (ob ^ (((ob >> 9) & 1) << 5)); }
__host__ __device__ __forceinline__ void stage_rc(int b, int& R, int& C) { const int st = b / 1024, sb = b % 1024, swz = sb ^ (((sb >> 9) & 1) << 5); R = (st >> 1) * 16 + swz / 64; C = (st & 1) * 32 + (swz % 64) / 2; }
__host__ __device__ __forceinline__ int perm32(int rho) { const int n = rho >> 4, i = rho & 15; return 8 * (i >> 2) + 4 * n + (i & 3); }

struct Unit { int pm, pn; };
struct Gemm { const bf16_t* A; const bf16_t* Bt; int M, N, K; };

struct StaticOrder {
    int nM, nN, nwg, G, c;
    __host__ __device__ void init(int M, int N, int G_, int c_) { nM = M / BM; nN = N / BM; nwg = nM * nN; G = G_; c = c_; }
    __host__ __device__ bool next(int i, Unit& u) const {
        const long L = (long)i * G + c; if (L >= nwg) return false;
        int wgid = (int)L; { const int q = nwg / NXCD, r = nwg % NXCD, xcd = wgid % NXCD, off = wgid / NXCD; wgid = (xcd < r ? xcd * (q + 1) : r * (q + 1) + (xcd - r) * q) + off; }
        const int nig = WGM * nN, gid = wgid / nig, fm = gid * WGM, gsz = (nM - fm) < WGM ? (nM - fm) : WGM;
        u.pm = fm + ((wgid % nig) % gsz); u.pn = (wgid % nig) / gsz; return true;
    }
    __device__ __forceinline__ void a_ready(const Unit&) const {}
    __device__ __forceinline__ void done(const Unit&) const {}
};

__device__ __forceinline__ unsigned cvt_pk_bf16(float lo, float hi) { unsigned r; asm volatile("v_cvt_pk_bf16_f32 %0, %1, %2" : "=v"(r) : "v"(lo), "v"(hi)); return r; }
}
namespace pg8 {
typedef int v8i_t __attribute__((ext_vector_type(8))); typedef int v4i_t __attribute__((ext_vector_type(4)));
__device__ __forceinline__ int pg8_lane_volatile() { int l; asm volatile("v_mbcnt_lo_u32_b32 %0, -1, 0\n\tv_mbcnt_hi_u32_b32 %0, -1, %0" : "=v"(l)); return l; }
template <class Epi, class Sched, bool ALIGN_EPI, bool GATHER, bool KSPLIT, bool FP8 = false, int SCW = 127, int SCA = 127, bool SC2 = false, int SCW2 = 127, int SCA2 = 127>
__device__ __forceinline__ void gemm_phase2(PG8_LAS unsigned char* lds, const int Kbytes, const int ldb_bytes, const Sched& S, const Epi& E, const int tid) {
    typedef typename Sched::UnitT UnitT;
    const int wid = __builtin_amdgcn_readfirstlane(tid >> 6), lane = tid & 63, wr = wid >> 2, wc = wid & 3, fr = lane & 15, fq = lane >> 4;
    int nt = Kbytes / (BK * 2); asm volatile("" : "+s"(nt));
    const int nth = nt / 2;
    unsigned voffB[2];
#pragma unroll
    for (int i = 0; i < 2; ++i) { int R[2], C[2]; stage_rc(tid * 16 + i * 8192, R[i], C[i]); const int Rb = Epi::PERM ? ((R[i] & ~31) + perm32(R[i] & 31)) : R[i]; voffB[i] = (unsigned)(Rb * ldb_bytes + C[i] * 2); }
    const size_t kstep = (size_t)(BK * 2);
    const size_t hstepB = (size_t)HALF * ldb_bytes;
    const unsigned ldsw = (unsigned)wid * 1024u;
    const int aoff = lds_byte(wr * 64 + fr, fq * 8), boff = lds_byte(wc * 32 + fr, fq * 8);
#define PG8_SA(b, h) (((b) * 2 + (h)) * HTB)
#define PG8_SB(b, h) ((4 + (b) * 2 + (h)) * HTB)
#define PG8_STAGE(bufoff, gbase, voff) do { _Pragma("unroll") for (int _i = 0; _i < 2; ++_i) \
        __builtin_amdgcn_global_load_lds((const unsigned*)((const char*)(gbase) + (voff)[_i]), (PG8_LAS unsigned*)(lds + (bufoff) + ldsw + _i * 8192), 16, 0, 0); } while (0)
#define PG8_LDA(dst, b, h) do { _Pragma("unroll") for (int m = 0; m < 4; ++m) _Pragma("unroll") for (int k = 0; k < 2; ++k) dst[m][k] = *(const PG8_LAS bf16x8*)(lds + PG8_SA(b, h) + aoff + m * 2048 + k * 1024); } while (0)
#define PG8_LDB(dst, b, h) do { _Pragma("unroll") for (int n = 0; n < 2; ++n) _Pragma("unroll") for (int k = 0; k < 2; ++k) dst[n][k] = *(const PG8_LAS bf16x8*)(lds + PG8_SB(b, h) + boff + n * 2048 + k * 1024); } while (0)
#define PG8_CAT8(x) __builtin_shufflevector(__builtin_bit_cast(v4i_t, (x)[0]), __builtin_bit_cast(v4i_t, (x)[1]), 0, 1, 2, 3, 4, 5, 6, 7)
#define PG8_MMA(ai, bj, At, Bt) do { __builtin_amdgcn_s_setprio(1); \
        if constexpr (FP8) { _Pragma("unroll") for (int m = 0; m < 4; ++m) _Pragma("unroll") for (int n = 0; n < 2; ++n) \
            acc[ai][bj][m][n] = __builtin_amdgcn_mfma_scale_f32_16x16x128_f8f6f4(PG8_CAT8(Bt[n]), PG8_CAT8(At[m]), acc[ai][bj][m][n], 0, 0, 0, scw_, 0, sca_); } \
        else { _Pragma("unroll") for (int m = 0; m < 4; ++m) _Pragma("unroll") for (int n = 0; n < 2; ++n) _Pragma("unroll") for (int k = 0; k < 2; ++k) \
            acc[ai][bj][m][n] = __builtin_amdgcn_mfma_f32_16x16x32_bf16(Bt[n][k], At[m][k], acc[ai][bj][m][n], 0, 0, 0); } \
        __builtin_amdgcn_s_setprio(0); } while (0)
#define PG8_STAGE1(bufoff, gbase, voff, _i) __builtin_amdgcn_global_load_lds((const unsigned*)((const char*)(gbase) + (voff)[_i]), (PG8_LAS unsigned*)(lds + (bufoff) + ldsw + (_i) * 8192), 16, 0, 0)
#define PG8_MF(ai, bj, m, n, At, Bt) do { if constexpr (FP8) acc[ai][bj][m][n] = __builtin_amdgcn_mfma_scale_f32_16x16x128_f8f6f4(PG8_CAT8(Bt[n]), PG8_CAT8(At[m]), acc[ai][bj][m][n], 0, 0, 0, scw_, 0, sca_); \
        else { acc[ai][bj][m][n] = __builtin_amdgcn_mfma_f32_16x16x32_bf16(Bt[n][0], At[m][0], acc[ai][bj][m][n], 0, 0, 0); acc[ai][bj][m][n] = __builtin_amdgcn_mfma_f32_16x16x32_bf16(Bt[n][1], At[m][1], acc[ai][bj][m][n], 0, 0, 0); } } while (0)
#define PG8_MF2(ai, bj, m, At, Bt) do { PG8_MF(ai, bj, m, 0, At, Bt); PG8_MF(ai, bj, m, 1, At, Bt); PG8_SCHED; } while (0)
#define PG8_CL1(ai, At, S0) do { __builtin_amdgcn_s_setprio(1); PG8_MF2(ai, 0, 0, At, B0); PG8_MF2(ai, 0, 1, At, B0); S0(0); PG8_SCHED; PG8_MF2(ai, 0, 2, At, B0); PG8_MF2(ai, 0, 3, At, B0); S0(1); PG8_SCHED; \
        PG8_MF2(ai, 1, 0, At, B1); PG8_MF2(ai, 1, 1, At, B1); PG8_MF2(ai, 1, 2, At, B1); PG8_MF2(ai, 1, 3, At, B1); __builtin_amdgcn_s_setprio(0); } while (0)
#define PG8_CL2(ai, At, S0, S1, S2) do { __builtin_amdgcn_s_setprio(1); PG8_MF2(ai, 0, 0, At, B0); S0(0); PG8_SCHED; PG8_MF2(ai, 0, 1, At, B0); S0(1); PG8_SCHED; PG8_MF2(ai, 0, 2, At, B0); S1(0); PG8_SCHED; PG8_MF2(ai, 0, 3, At, B0); S1(1); PG8_SCHED; \
        PG8_MF2(ai, 1, 0, At, B1); S2(0); PG8_SCHED; PG8_MF2(ai, 1, 1, At, B1); S2(1); PG8_SCHED; PG8_MF2(ai, 1, 2, At, B1); PG8_MF2(ai, 1, 3, At, B1); __builtin_amdgcn_s_setprio(0); } while (0)
#define PG8_WAIT_V(n) asm volatile("s_waitcnt vmcnt(" #n ")" ::: "memory")
#define PG8_WAIT_L(n) asm volatile("s_waitcnt lgkmcnt(" #n ")" ::: "memory")
#define PG8_BAR __builtin_amdgcn_s_barrier()
#define PG8_SCHED __builtin_amdgcn_sched_barrier(0)
#define PG8_PIN(ai) asm volatile("" :: "v"(acc[ai][0][0][0]), "v"(acc[ai][0][0][1]), "v"(acc[ai][0][1][0]), "v"(acc[ai][0][1][1]), "v"(acc[ai][0][2][0]), "v"(acc[ai][0][2][1]), "v"(acc[ai][0][3][0]), "v"(acc[ai][0][3][1]), \
        "v"(acc[ai][1][0][0]), "v"(acc[ai][1][0][1]), "v"(acc[ai][1][1][0]), "v"(acc[ai][1][1][1]), "v"(acc[ai][1][2][0]), "v"(acc[ai][1][2][1]), "v"(acc[ai][1][3][0]), "v"(acc[ai][1][3][1]))
#define PG8_BK(cb, cb2, kt) ((KSPLIT && (kt) >= nth) ? (cb2) + (size_t)((kt) - nth) * kstep : (cb) + (size_t)(kt) * kstep)
    UnitT cur, nxt; int ui = 0;
    if (!S.next(0, cur)) return;
    f32x4 acc[2][2][4][2];
#pragma unroll
    for (int a = 0; a < 2; ++a)
#pragma unroll
        for (int b = 0; b < 2; ++b)
#pragma unroll
            for (int m = 0; m < 4; ++m)
#pragma unroll
                for (int n = 0; n < 2; ++n) acc[a][b][m][n] = (f32x4){0.f, 0.f, 0.f, 0.f};
    bf16x8 At[4][2], B0[2][2], B1[2][2];
    unsigned vA[2][2];
    S.arows(cur, tid, vA);
    PG8_LAS u32x4* const vslot = (PG8_LAS u32x4*)(lds + STAGE_BYTES + 2048) + tid;
    const char* cA = S.aptr(cur); const char* cB = S.bptr(cur); const char* cB2 = KSPLIT ? S.bptr2(cur) : cB;
    PG8_STAGE(PG8_SB(0, 0), cB, voffB); PG8_STAGE(PG8_SB(0, 1), cB + hstepB, voffB); PG8_STAGE(PG8_SA(0, 0), cA, vA[0]); PG8_STAGE(PG8_SA(0, 1), cA, vA[1]);
    if (wr == 1) PG8_BAR;
    PG8_WAIT_V(2); PG8_BAR;
    PG8_STAGE(PG8_SB(1, 0), PG8_BK(cB, cB2, 1), voffB); PG8_STAGE(PG8_SA(1, 0), cA + kstep, vA[0]); PG8_STAGE(PG8_SB(1, 1), PG8_BK(cB, cB2, 1) + hstepB, voffB);
    PG8_WAIT_V(6); PG8_BAR;
    for (;;) {
        const bool has_next = S.next(ui + 1, nxt);
        const char* nA = has_next ? S.aptr(nxt) : cA; const char* nB = has_next ? S.bptr(nxt) : cB; const char* nB2 = (KSPLIT && has_next) ? S.bptr2(nxt) : cB2;
        if (GATHER && has_next) { unsigned vn_[2][2]; S.arows(nxt, wid * 64 + pg8_lane_volatile(), vn_); *vslot = (u32x4){vn_[0][0], vn_[0][1], vn_[1][0], vn_[1][1]}; }
        for (int t = 0; t < nt; t += 2) {
            const bool last = (t == nt - 2);
            const int scw_ = ((SC2 && t >= nth) ? SCW2 : SCW) * 0x01010101, sca_ = ((SC2 && t >= nth) ? SCA2 : SCA) * 0x01010101; (void)scw_; (void)sca_;
            const char* a1 = cA + (size_t)(t + 1) * kstep;
            const char* a2 = last ? nA : cA + (size_t)(t + 2) * kstep;
            const char* b2 = last ? nB : PG8_BK(cB, cB2, t + 2);
            const char* b3 = last ? (KSPLIT ? PG8_BK(nB, nB2, 1) : nB + kstep) : PG8_BK(cB, cB2, t + 3);
            const char* a3 = a2 + kstep;
#define ST_A11(i) PG8_STAGE1(PG8_SA(1, 1), a1, vA[1], i)
#define ST_B00(i) PG8_STAGE1(PG8_SB(0, 0), b2, voffB, i)
#define ST_B01(i) PG8_STAGE1(PG8_SB(0, 1), b2 + hstepB, voffB, i)
#define ST_A00(i) PG8_STAGE1(PG8_SA(0, 0), a2, vA[0], i)
#define ST_A01(i) PG8_STAGE1(PG8_SA(0, 1), a2, vA[1], i)
#define ST_B10(i) PG8_STAGE1(PG8_SB(1, 0), b3, voffB, i)
#define ST_B11(i) PG8_STAGE1(PG8_SB(1, 1), b3 + hstepB, voffB, i)
#define ST_A10(i) PG8_STAGE1(PG8_SA(1, 0), a3, vA[0], i)
            PG8_LDB(B0, 0, 0); PG8_LDB(B1, 0, 1); PG8_SCHED; PG8_LDA(At, 0, 0);
            PG8_WAIT_V(6); PG8_WAIT_L(0); PG8_BAR; PG8_CL1(0, At, ST_A11); PG8_PIN(0); PG8_BAR; PG8_SCHED;
            if (GATHER && last && has_next) { const u32x4 vn_ = *vslot; vA[0][0] = vn_.x; vA[0][1] = vn_.y; vA[1][0] = vn_.z; vA[1][1] = vn_.w; }
            PG8_LDA(At, 0, 1);
            PG8_WAIT_V(2); PG8_WAIT_L(0); PG8_BAR; PG8_CL2(1, At, ST_B00, ST_B01, ST_A00); PG8_PIN(1); PG8_BAR; PG8_SCHED;
            PG8_LDB(B0, 1, 0); PG8_LDB(B1, 1, 1); PG8_SCHED; PG8_LDA(At, 1, 0);
            PG8_WAIT_V(6); PG8_WAIT_L(0); PG8_BAR; PG8_CL1(0, At, ST_A01); PG8_PIN(0); PG8_BAR; PG8_SCHED;
            PG8_LDA(At, 1, 1);
            PG8_WAIT_V(2); PG8_WAIT_L(0); PG8_BAR; PG8_CL2(1, At, ST_B10, ST_B11, ST_A10); PG8_PIN(1); PG8_BAR; PG8_SCHED;
#undef ST_A11
#undef ST_B00
#undef ST_B01
#undef ST_A00
#undef ST_A01
#undef ST_B10
#undef ST_B11
#undef ST_A10
        }
        if constexpr (ALIGN_EPI) { if (wr == 0) PG8_BAR; }
        if constexpr (!Epi::AFTER_DRAIN) { const int le_ = pg8_lane_volatile(); E(acc, cur, wr, wc, le_ & 15, le_ >> 4); }
        if (!has_next) break;
#pragma unroll
        for (int a = 0; a < 2; ++a)
#pragma unroll
            for (int b = 0; b < 2; ++b)
#pragma unroll
                for (int m = 0; m < 4; ++m)
#pragma unroll
                    for (int n = 0; n < 2; ++n) acc[a][b][m][n] = (f32x4){0.f, 0.f, 0.f, 0.f};
        cur = nxt; cA = nA; cB = nB; cB2 = nB2; ++ui;
        if constexpr (ALIGN_EPI) { if (wr == 1) PG8_BAR; }
    }
    PG8_WAIT_V(0);
    if constexpr (!ALIGN_EPI) { if (wr == 0) PG8_BAR; }
    PG8_BAR;
    if constexpr (Epi::AFTER_DRAIN) { E.fused(acc, cur, wr, wc, fr, fq, lds, wid, lane); }
#undef PG8_SA
#undef PG8_SB
#undef PG8_STAGE
#undef PG8_LDA
#undef PG8_LDB
#undef PG8_MMA
#undef PG8_WAIT_V
#undef PG8_WAIT_L
#undef PG8_BAR
#undef PG8_SCHED
#undef PG8_BK
#undef PG8_PIN
#undef PG8_STAGE1
#undef PG8_MF
#undef PG8_MF2
#undef PG8_CL1
#undef PG8_CL2
#undef PG8_CAT8
}
}
namespace pg8 {
DEVFN unsigned pkbf(float lo, float hi) { return cvt_pk_bf16(lo, hi); }
struct DenseSched {
    typedef Unit UnitT;
    StaticOrder so; const char* A; const char* Bt; int lda, ldb;
    DEVFN bool next(int i, Unit& u) const { return so.next(i, u); }
    DEVFN const char* aptr(const Unit&) const { return A; }
    DEVFN void arows(const Unit& u, const int tid_, unsigned (&v)[2][2]) const {
        int R[2], C[2]; { int t_ = tid_; asm volatile("" : "+v"(t_)); stage_rc(t_ * 16, R[0], C[0]); stage_rc(t_ * 16 + 8192, R[1], C[1]); }
#pragma unroll
        for (int h = 0; h < 2; ++h)
#pragma unroll
            for (int i = 0; i < 2; ++i) v[h][i] = (unsigned)((u.pm * BM + h * HALF + R[i]) * lda + C[i] * 2); }
    DEVFN const char* bptr(const Unit& u) const { return Bt + (size_t)u.pn * BM * ldb; }
    DEVFN const char* bptr2(const Unit& u) const { return bptr(u); }
};
struct EpiInproj {
    static constexpr bool PERM = true, AFTER_DRAIN = false;
    bf16_t* O; const float* rope; float* kbar;
    DEVFN void operator()(f32x4 (&acc)[2][2][4][2], const Unit& u, int wr, int wc, int fr, int fq) const {
        const int pn = u.pn, row0 = u.pm * BM + wr * 64 + fr;
        if (pn < 4 && fq == 0) {
#pragma unroll
            for (int ai = 0; ai < 2; ++ai)
#pragma unroll
                for (int m = 0; m < 4; ++m) { const int t = (row0 + ai * HALF + m * 16) & (SEQ - 1); const f32x4* rp = (const f32x4*)(rope + t * 16);
#pragma unroll
                    for (int q = 0; q < 4; ++q) { const f32x4 cs = rp[q];
                        { const int d = 2 * q, n = d >> 2, e = d & 3; const float x1 = acc[ai][0][m][n][e], x2 = acc[ai][1][m][n][e]; acc[ai][0][m][n][e] = x1 * cs[0] - x2 * cs[1]; acc[ai][1][m][n][e] = x2 * cs[0] + x1 * cs[1]; }
                        { const int d = 2 * q + 1, n = d >> 2, e = d & 3; const float x1 = acc[ai][0][m][n][e], x2 = acc[ai][1][m][n][e]; acc[ai][0][m][n][e] = x1 * cs[2] - x2 * cs[3]; acc[ai][1][m][n][e] = x2 * cs[2] + x1 * cs[3]; } } }
        }
        if (pn == 2 || pn == 3) {
            float* kb = kbar + (size_t)((((u.pm >> 3) * NH + (pn - 2) * 4 + wc) * NBLK + (u.pm & 7)) * HD);
#pragma unroll
            for (int bj = 0; bj < 2; ++bj)
#pragma unroll
                for (int n = 0; n < 2; ++n)
#pragma unroll
                    for (int e = 0; e < 4; ++e) { float s = 0.f;
#pragma unroll
                        for (int ai = 0; ai < 2; ++ai)
#pragma unroll
                            for (int m = 0; m < 4; ++m) s += acc[ai][bj][m][n][e];
                        s = swz_xor_add(s, 1); s = swz_xor_add(s, 2); s = swz_xor_add(s, 4); s = swz_xor_add(s, 8);
                        if (fr == 0) atomicAdd(kb + (2 * fq + bj) * 8 + 4 * n + e, s * (1.f / MBLK)); }
        }
        const float sc = pn < 2 ? QSCALE : 1.f;
#pragma unroll
        for (int ai = 0; ai < 2; ++ai)
#pragma unroll
            for (int m = 0; m < 4; ++m) { bf16_t* rowp = O + (size_t)(row0 + ai * HALF + m * 16) * DIN + pn * BM + wc * 64;
#pragma unroll
                for (int bj = 0; bj < 2; ++bj) { const f32x4 v0 = acc[ai][bj][m][0] * sc, v1 = acc[ai][bj][m][1] * sc;
                    u32x4 w; w.x = pkbf(v0[0], v0[1]); w.y = pkbf(v0[2], v0[3]); w.z = pkbf(v1[0], v1[1]); w.w = pkbf(v1[2], v1[3]);
                    *(u32x4*)(rowp + (2 * fq + bj) * 8) = w; } }
    }
};
struct EpiF8 {
    static constexpr bool PERM = true, AFTER_DRAIN = false;
    unsigned char* O; int ldc;
    DEVFN void operator()(f32x4 (&acc)[2][2][4][2], const Unit& u, int wr, int wc, int fr, int fq) const {
#pragma unroll
        for (int ai = 0; ai < 2; ++ai)
#pragma unroll
            for (int m = 0; m < 4; ++m) { unsigned char* rowp = O + (size_t)(u.pm * BM + ai * HALF + wr * 64 + m * 16 + fr) * ldc + u.pn * BM + wc * 32 + fq * 8;
#pragma unroll
                for (int bj = 0; bj < 2; ++bj) { const f32x4 v0 = acc[ai][bj][m][0] * YSCALE, v1 = acc[ai][bj][m][1] * YSCALE;
                    u32x2 w; w.x = pk4_fp8(v0[0], v0[1], v0[2], v0[3]); w.y = pk4_fp8(v1[0], v1[1], v1[2], v1[3]);
                    *(u32x2*)(rowp + bj * HALF) = w; } }
    }
};
struct MoeUnit { int pm, pn, cls, j, cnt; };
struct MoeBase {
    const PG8_LAS int* tp; const PG8_LAS int* cnt; const PG8_LAS int* tcls; int nunits, G, c, npn_shift;
    DEVFN bool next_(int i, MoeUnit& u) const {
        const int L = i * G + c; if (L >= nunits) return false;
        u.pm = L >> npn_shift; u.pn = L & ((1 << npn_shift) - 1);
        const int cls = __builtin_amdgcn_readfirstlane(tcls[u.pm]);
        u.cls = cls; u.j = u.pm - __builtin_amdgcn_readfirstlane(tp[cls]); u.cnt = __builtin_amdgcn_readfirstlane(cnt[cls]); return true; }
};
DEVFN void moe_experts(int cls, int& e1, int& e2) { const int g = cls / 6, p = cls % 6; const int lo = p < 3 ? 0 : (p < 5 ? 1 : 2), hi = p < 3 ? p + 1 : (p < 5 ? p - 1 : 3); e1 = g * 4 + lo; e2 = g * 4 + hi; }
struct GateUpSched : MoeBase {
    typedef MoeUnit UnitT;
    const char* HB; const int* list; const char* W;
    DEVFN bool next(int i, MoeUnit& u) const { return next_(i, u); }
    DEVFN const char* aptr(const MoeUnit&) const { return HB; }
    DEVFN void arows(const MoeUnit& u, const int tid_, unsigned (&v)[2][2]) const {
        int R[2], C[2]; { int t_ = tid_; asm volatile("" : "+v"(t_)); stage_rc(t_ * 16, R[0], C[0]); stage_rc(t_ * 16 + 8192, R[1], C[1]); }
#pragma unroll
        for (int h = 0; h < 2; ++h)
#pragma unroll
            for (int i = 0; i < 2; ++i) { const int li = 256 * u.j + h * HALF + R[i]; const int tok = list[(size_t)u.cls * LISTCAP + (li < u.cnt ? li : 256 * u.j)]; v[h][i] = (unsigned)(tok * DM + C[i] * 2); } }
    DEVFN const char* bptr(const MoeUnit& u) const { int e1, e2; moe_experts(u.cls, e1, e2); return W + (size_t)(u.pn < 4 ? e1 : e2) * DM * DM + (size_t)(u.pn & 3) * BM * DM; }
    DEVFN const char* bptr2(const MoeUnit& u) const { return bptr(u); }
};
struct DownSched : MoeBase {
    typedef MoeUnit UnitT;
    const char* ACT; const char* W;
    DEVFN bool next(int i, MoeUnit& u) const { return next_(i, u); }
    DEVFN const char* aptr(const MoeUnit&) const { return ACT; }
    DEVFN void arows(const MoeUnit& u, const int tid_, unsigned (&v)[2][2]) const {
        int R[2], C[2]; { int t_ = tid_; asm volatile("" : "+v"(t_)); stage_rc(t_ * 16, R[0], C[0]); stage_rc(t_ * 16 + 8192, R[1], C[1]); }
#pragma unroll
        for (int h = 0; h < 2; ++h)
#pragma unroll
            for (int i = 0; i < 2; ++i) v[h][i] = (unsigned)((u.pm * BM + h * HALF + R[i]) * DM + C[i] * 2); }
    DEVFN const char* bptr(const MoeUnit& u) const { int e1, e2; moe_experts(u.cls, e1, e2); return W + (size_t)e1 * DM * DE + (size_t)u.pn * BM * DE; }
    DEVFN const char* bptr2(const MoeUnit& u) const { int e1, e2; moe_experts(u.cls, e1, e2); return W + (size_t)e2 * DM * DE + (size_t)u.pn * BM * DE; }
};
struct EpiGateUp {
    static constexpr bool PERM = true, AFTER_DRAIN = false;
    unsigned char* ACT; const float* rw;
    DEVFN void operator()(f32x4 (&acc)[2][2][4][2], const MoeUnit& u, int wr, int wc, int fr, int fq) const {
        const int half = u.pn >> 2, jt = u.pn & 3;
#pragma unroll
        for (int ai = 0; ai < 2; ++ai)
#pragma unroll
            for (int m = 0; m < 4; ++m) { const int lr = ai * HALF + wr * 64 + m * 16 + fr, li = 256 * u.j + lr;
                const float wgt = li < u.cnt ? 8.f * rw[((size_t)u.cls * LISTCAP + li) * 2 + half] : 0.f;
                f32x4 o[2];
#pragma unroll
                for (int n = 0; n < 2; ++n)
#pragma unroll
                    for (int e = 0; e < 4; ++e) { const float g = acc[ai][0][m][n][e]; o[n][e] = g * __builtin_amdgcn_rcpf(1.f + __expf(-g)) * acc[ai][1][m][n][e] * wgt; }
                u32x2 w; w.x = pk4_fp8(o[0][0], o[0][1], o[0][2], o[0][3]); w.y = pk4_fp8(o[1][0], o[1][1], o[1][2], o[1][3]);
                *(u32x2*)(ACT + (size_t)(u.pm * BM + lr) * DM + half * 512 + jt * 128 + wc * 32 + fq * 8) = w; }
    }
};
struct EpiDown {
    static constexpr bool PERM = true, AFTER_DRAIN = false;
    unsigned char* Y2; const int* list;
    DEVFN void operator()(f32x4 (&acc)[2][2][4][2], const MoeUnit& u, int wr, int wc, int fr, int fq_) const {
        int fq = fq_; asm volatile("" : "+v"(fq));
#pragma unroll
        for (int ai = 0; ai < 2; ++ai)
#pragma unroll
            for (int m = 0; m < 4; ++m) { const int li = 256 * u.j + ai * HALF + wr * 64 + m * 16 + fr;
                if (li < u.cnt) { const int tok = list[(size_t)u.cls * LISTCAP + li]; unsigned char* rowp = Y2 + (size_t)tok * DM + u.pn * BM + wc * 32 + fq * 8;
#pragma unroll
                    for (int bj = 0; bj < 2; ++bj) { const f32x4 v0 = acc[ai][bj][m][0] * YSCALE, v1 = acc[ai][bj][m][1] * YSCALE;
                        u32x2 w; w.x = pk4_fp8(v0[0], v0[1], v0[2], v0[3]); w.y = pk4_fp8(v1[0], v1[1], v1[2], v1[3]);
                        *(u32x2*)(rowp + bj * HALF) = w; } } }
    }
};
}

#include <hip/hip_bf16.h>
#include <cmath>
namespace attn_body {
using bf16=__hip_bfloat16;
using bf16x8=__attribute__((ext_vector_type(8)))short;
using s16x4=__attribute__((ext_vector_type(4)))short;
using f32x16=__attribute__((ext_vector_type(16)))float;
using u32x4=__attribute__((ext_vector_type(4)))unsigned;
constexpr int BATCH=16,NHEAD=8,SEQ=2048,D=64,QP=2048,OP=1024;
constexpr int NW=8,QBLK=32,QB=QBLK*NW,KVBLK=64,NQB=SEQ/QB;
constexpr int ATTN_PITCH=QP, ATTN_UNIT_ROWS=QB;
__device__ __forceinline__ int crow(int r,int hi){return (r&3)+8*(r>>2)+4*hi;}
#define SBAR() __builtin_amdgcn_sched_barrier(0)
__device__ __forceinline__ void cmask(f32x16&p0,f32x16&p1,int jb,int qrel,int hi){
  const float NEG=-INFINITY; int kb=64*jb+4*hi;
  #pragma unroll
  for(int r=0;r<16;++r){int kv=kb+(r&3)+8*(r>>2); if(kv>qrel)p0[r]=NEG; if(kv+32>qrel)p1[r]=NEG;}
}

constexpr int NSLOT=3, SLOTB=8192;
constexpr int LDS_K=0, LDS_V=NSLOT*SLOTB, LDS_WS=2*NSLOT*SLOTB, LDS_OST=LDS_WS+NW*64*4, LDS_KBAR=LDS_OST+NW*4096, LDS_BYTES=LDS_KBAR+2048;
constexpr float NEGBIG=-1.0e30f; typedef float f32x4_t __attribute__((ext_vector_type(4)));
__device__ __forceinline__ float bfs(short v){return __uint_as_float(((unsigned)(unsigned short)v)<<16);}
constexpr float C2=0.125f*1.4426950408889634f;
__device__ __forceinline__ void glds16(const void*gsrc,unsigned lds_dst){unsigned keep;
  asm volatile("s_mov_b32 %0, m0\n\ts_mov_b32 m0, %2\n\ts_nop 0\n\tglobal_load_lds_dwordx4 %1, off\n\ts_mov_b32 m0, %0":"=&s"(keep):"v"(gsrc),"s"(lds_dst):"memory");}
__device__ __forceinline__ float max3f(float a,float b,float c){float r;asm("v_max3_f32 %0, %1, %2, %3":"=v"(r):"v"(a),"v"(b),"v"(c));return r;}
__device__ __forceinline__ float max2f(float a,float b){float r;asm("v_max_f32_e32 %0, %1, %2":"=v"(r):"v"(a),"v"(b));return r;}
__device__ __forceinline__ float fadd_s(float a,float b){float r;asm("v_add_f32_e32 %0, %1, %2":"=v"(r):"v"(a),"v"(b));return r;}
__device__ __forceinline__ float fsub_s(float a,float b){float r;asm("v_sub_f32_e32 %0, %1, %2":"=v"(r):"v"(a),"v"(b));return r;}
typedef float f32x2_t __attribute__((ext_vector_type(2))); typedef __bf16 bf16x2_t __attribute__((ext_vector_type(2)));
__device__ __forceinline__ unsigned cvtpk_s(float lo,float hi){f32x2_t v={lo,hi};bf16x2_t b=__builtin_convertvector(v,bf16x2_t);return __builtin_bit_cast(unsigned,b);}
#define WAIT_BAR(N) asm volatile("s_waitcnt vmcnt(" #N ") lgkmcnt(0)\n\ts_barrier":::"memory")

__device__ __forceinline__ void qkt(f32x16&p0,f32x16&p1,const char*Kslot,const bf16x8*qr,const f32x16&negm,int r32,int hi){
  const char*kb=Kslot+hi*1024+r32*16;
  #pragma unroll
  for(int d0=0;d0<4;++d0){
    const bf16x8 b0=*reinterpret_cast<const bf16x8*>(kb+d0*2048);
    const bf16x8 b1=*reinterpret_cast<const bf16x8*>(kb+d0*2048+512);
    if(d0==0){p0=__builtin_amdgcn_mfma_f32_32x32x16_bf16(b0,qr[0],negm,0,0,0);p1=__builtin_amdgcn_mfma_f32_32x32x16_bf16(b1,qr[0],negm,0,0,0);}
    else{p0=__builtin_amdgcn_mfma_f32_32x32x16_bf16(b0,qr[d0],p0,0,0,0);p1=__builtin_amdgcn_mfma_f32_32x32x16_bf16(b1,qr[d0],p1,0,0,0);}}
}
typedef __attribute__((address_space(3))) const char* lds_cptr;
typedef short v4i16_t __attribute__((ext_vector_type(4)));
__device__ __forceinline__ void kload8(bf16x8*kf,lds_cptr kp){
  kf[0]=*(const __attribute__((address_space(3))) bf16x8*)(kp);      kf[1]=*(const __attribute__((address_space(3))) bf16x8*)(kp+512);
  kf[2]=*(const __attribute__((address_space(3))) bf16x8*)(kp+2048); kf[3]=*(const __attribute__((address_space(3))) bf16x8*)(kp+2560);
  kf[4]=*(const __attribute__((address_space(3))) bf16x8*)(kp+4096); kf[5]=*(const __attribute__((address_space(3))) bf16x8*)(kp+4608);
  kf[6]=*(const __attribute__((address_space(3))) bf16x8*)(kp+6144); kf[7]=*(const __attribute__((address_space(3))) bf16x8*)(kp+6656);
}
__device__ __forceinline__ void kload2(bf16x8*kf,lds_cptr kp,int j){ kf[2*j]=*(const __attribute__((address_space(3))) bf16x8*)(kp+j*2048); kf[2*j+1]=*(const __attribute__((address_space(3))) bf16x8*)(kp+j*2048+512); }
__device__ __forceinline__ s16x4 vtr(lds_cptr p){ return __builtin_bit_cast(s16x4,__builtin_amdgcn_ds_read_tr16_b64_v4i16((__attribute__((address_space(3))) v4i16_t*)p)); }
__device__ __forceinline__ float rowmax(const f32x16&p0,const f32x16&p1){
  float a=max3f(p0[0],p0[1],p1[0]),b=max3f(p0[2],p0[3],p1[1]);a=max3f(a,p1[2],p1[3]);
  #pragma unroll
  for(int r=4;r<16;r+=4){a=max3f(a,p0[r],p0[r+1]);b=max3f(b,p0[r+2],p0[r+3]);a=max3f(a,p1[r],p1[r+1]);b=max3f(b,p1[r+2],p1[r+3]);}
  const float m=max2f(a,b);
  auto rr=__builtin_amdgcn_permlane32_swap(__float_as_uint(m),__float_as_uint(m),false,false);
  return max2f(__uint_as_float(rr[0]),__uint_as_float(rr[1]));
}
__device__ __forceinline__ void pv(f32x16*o,int vb,bf16x8 pa0,bf16x8 pa1,bf16x8 pa2,bf16x8 pa3){
  #pragma unroll
  for(int d0=0;d0<2;++d0){s16x4 lo[4],hi[4];
    #pragma unroll
    for(int ks=0;ks<4;++ks){
      asm volatile("ds_read_b64_tr_b16 %0,%1 offset:%c2":"=&v"(lo[ks]):"v"(vb),"i"(d0*4096+ks*1024):"memory");
      asm volatile("ds_read_b64_tr_b16 %0,%1 offset:%c2":"=&v"(hi[ks]):"v"(vb),"i"(d0*4096+ks*1024+512):"memory");}
    asm volatile("s_waitcnt lgkmcnt(0)":::"memory");SBAR();
    #define PK(k) (bf16x8){lo[k][0],lo[k][1],lo[k][2],lo[k][3],hi[k][0],hi[k][1],hi[k][2],hi[k][3]}
    o[d0]=__builtin_amdgcn_mfma_f32_32x32x16_bf16(pa0,PK(0),o[d0],0,0,0);
    o[d0]=__builtin_amdgcn_mfma_f32_32x32x16_bf16(pa1,PK(1),o[d0],0,0,0);
    o[d0]=__builtin_amdgcn_mfma_f32_32x32x16_bf16(pa2,PK(2),o[d0],0,0,0);
    o[d0]=__builtin_amdgcn_mfma_f32_32x32x16_bf16(pa3,PK(3),o[d0],0,0,0);
    #undef PK
  }
}

#ifndef ATTN_STORE16
#define ATTN_STORE16(p,v) (*(u32x4*)(p)=(v))
#endif
template<int THRL> __device__ __forceinline__ void attn_unit(int b,int h,int qb,const bf16*Q,const bf16*__restrict__ K,const bf16*__restrict__ V,bf16*O,const float*__restrict__ kbar,char*shm,const int tid){
  const int lane=tid&63,r32=lane&31,hi=lane>>5; const int wid=__builtin_amdgcn_readfirstlane(tid>>6);
  float kbv=0.f; { int tk=tid; asm volatile("":"+v"(tk)); if(qb>=4&&tk<448)kbv=kbar[tk]; }
  const long rowbase=(long)b*SEQ; const int q0=qb*QB;
  const bf16*Qw=Q+(rowbase+q0+wid*QBLK)*QP+h*D;
  const bf16*Kh=K+rowbase*QP+h*D,*Vh=V+rowbase*QP+h*D;
  const unsigned lds0=(unsigned)(uintptr_t)shm;
  float*wsf=(float*)(shm+LDS_WS)+wid*64;
  const bf16*ksrc=Kh+(long)lane*QP+wid*8;
  const bf16*vsrc=Vh+(long)(16*(wid&3)+(lane>>2))*QP+(wid>>2)*32+(lane&3)*8;
  const unsigned kdst=lds0+LDS_K+wid*1024, vdst=lds0+LDS_V+wid*1024;
  #define DMA_K(t,slot) glds16(ksrc+(long)(t)*KVBLK*QP,(unsigned)__builtin_amdgcn_readfirstlane(kdst+(slot)))
  #define DMA_V(t,slot) glds16(vsrc+(long)(t)*KVBLK*QP,(unsigned)__builtin_amdgcn_readfirstlane(vdst+(slot)))
  const int vb0=(int)(lds0+LDS_V)+((lane>>4)&1)*32+(lane&3)*8+(4*hi+((lane&15)>>2))*64;
  const char*Kbase=shm+LDS_K; bf16x8 kf[8];
  const lds_cptr shm3=(lds_cptr)shm; const lds_cptr kp0=shm3+LDS_K+hi*1024+r32*16; const lds_cptr vp0=shm3+LDS_V+((lane>>4)&1)*32+(lane&3)*8+(4*hi+((lane&15)>>2))*64;
  const int NT=(q0+QB)/KVBLK;
  DMA_K(0,0);DMA_V(0,0);DMA_K(1,SLOTB);
  bf16x8 qr[4];
  #pragma unroll
  for(int d0=0;d0<4;++d0)qr[d0]=*reinterpret_cast<const bf16x8*>(&Qw[(long)r32*QP+d0*16+hi*8]);
  float mhat=0.f,l_reg=0.f;f32x16 o[2];o[0]=f32x16{};o[1]=f32x16{};f32x16 negm=f32x16{};asm volatile("":"+v"(negm));
  const int qrel=wid*QBLK+r32;
  #define CMASK(P0,P1,t) do{int jb_=(t)-(NT-4); if(jb_>=0)cmask(P0,P1,jb_,qrel,hi);}while(0)
  bool resc=false;
  #define START(P0,P1) do{ const float rm=rowmax(P0,P1); resc=false; \
    { const float dl=selcur?rm:-64.f; mhat=fadd_s(mhat,dl); \
      _Pragma("unroll") for(int r=0;r<16;++r){P0[r]=fsub_s(P0[r],dl);P1[r]=fsub_s(P1[r],dl);} \
      { const float nv_=selcur?-mhat:NEGBIG; _Pragma("unroll") for(int r=0;r<16;++r)negm[r]=nv_; } asm volatile("":"+v"(negm)); } \
    _Pragma("unroll") for(int r=0;r<16;++r)P0[r]=__builtin_amdgcn_exp2f(P0[r]); }while(0)
  #define RESC() do{ if(resc){ asm volatile("s_waitcnt lgkmcnt(0)":::"memory"); \
      _Pragma("unroll") for(int d_=0;d_<2;++d_) _Pragma("unroll") for(int r=0;r<16;++r)o[d_][r]*=wsf[crow(r,hi)]; } }while(0)
  f32x16 pA0,pA1,pB0,pB1;
  int sl_prev=0,sl_cur=0,sl_next=SLOTB;
  #define ROT() do{sl_prev=sl_cur;sl_cur=sl_next;sl_next=(sl_next==(NSLOT-1)*SLOTB)?0:sl_next+SLOTB;}while(0)
  DMA_K(2,2*SLOTB);
  if(qb>=4){ if(tid<448){ const unsigned hb=__builtin_bit_cast(unsigned,kbv); const unsigned hr=(hb+0x7fffu+((hb>>16)&1u))&0xffff0000u; const float lo_=kbv-__builtin_bit_cast(float,hr); const unsigned lb=__builtin_bit_cast(unsigned,lo_);
      ((unsigned short*)(shm+LDS_KBAR))[tid]=(unsigned short)(hr>>16); ((unsigned short*)(shm+LDS_KBAR+1024))[tid]=(unsigned short)((lb+0x7fffu+((lb>>16)&1u))>>16); } }
  WAIT_BAR(3);
  unsigned bmask=(1u<<(qb+1))-1u;
  if(qb>=4){ float gsc[8];
    { const lds_cptr kb3=shm3+LDS_KBAR+(r32&7)*128+hi*16; f32x16 g=f32x16{};
      _Pragma("unroll") for(int d0=0;d0<4;++d0){ const bf16x8 ah=*(const __attribute__((address_space(3))) bf16x8*)(kb3+d0*32), al=*(const __attribute__((address_space(3))) bf16x8*)(kb3+1024+d0*32);
        g=__builtin_amdgcn_mfma_f32_32x32x16_bf16(ah,qr[d0],g,0,0,0); g=__builtin_amdgcn_mfma_f32_32x32x16_bf16(al,qr[d0],g,0,0,0); }
      _Pragma("unroll") for(int r=0;r<4;++r){ auto rr=__builtin_amdgcn_permlane32_swap(__float_as_uint(g[r]),__float_as_uint(g[r]),false,false); gsc[r]=__uint_as_float(rr[0]); gsc[4+r]=__uint_as_float(rr[1]); } }
    _Pragma("unroll") for(int n=0;n<7;++n) gsc[n]=(n<qb)?gsc[n]:-3.0e38f;
    bmask=1u<<qb;
    _Pragma("unroll") for(int pick=0;pick<3;++pick){ float best=-3.4e38f; unsigned bi=0u;
      _Pragma("unroll") for(int n=0;n<7;++n){ const bool ok=!((bmask>>n)&1u)&&gsc[n]>best; best=ok?gsc[n]:best; bi=ok?(unsigned)n:bi; }
      bmask|=1u<<bi; } }
  bool selcur=(bmask&1u)!=0u;
  { const float nv=selcur?0.f:NEGBIG; _Pragma("unroll") for(int r=0;r<16;++r)negm[r]=nv; asm volatile("":"+v"(negm)); }
  qkt(pA0,pA1,Kbase,qr,negm,r32,hi);asm volatile("s_nop 15\n\ts_nop 7":"+v"(pA0),"+v"(pA1));CMASK(pA0,pA1,0);
  START(pA0,pA1);
  _Pragma("unroll") for(int r=0;r<16;++r)pA1[r]=__builtin_amdgcn_exp2f(pA1[r]);
  WAIT_BAR(0);
  DMA_K(3,0);DMA_V(1,SLOTB);
  ROT();
  kload8(kf,kp0+sl_cur);
  WAIT_BAR(2);
  s16x4 vlo[8],vhi[8]; u32x4 pw0,pw1,pw2,pw3;
  #define PKW(P,B) cvtpk_s(P[B],P[B+1])
  #define PAF(k) __builtin_bit_cast(bf16x8,pw##k)
  #define VFR(i) (bf16x8){vlo[i][0],vlo[i][1],vlo[i][2],vlo[i][3],vhi[i][0],vhi[i][1],vhi[i][2],vhi[i][3]}
  #define PIN(x) asm volatile("":"+v"(x))
  #define MX3(a,b,c) __builtin_fmaxf(__builtin_fmaxf((a),(b)),(c))
  #define GAPA(MF,A0,A1,A2,A3,W0,W1,PW) do{ MF; sacc+=A0; sacc+=A1; sacc+=A2; sacc+=A3; PIN(sacc); W0; W1; PIN(PW); SBAR(); }while(0)
  #define EX(v) __builtin_amdgcn_exp2f(v)
  #define GAPB(MF,X,B) do{ MF; X[B]=EX(X[B]); X[B+1]=EX(X[B+1]); X[B+2]=EX(X[B+2]); X[B+3]=EX(X[B+3]); PIN(X); SBAR(); }while(0)
  #define VRD(i) do{ vlo[i]=vtr(vp_+(((i)>>2)*4096+((i)&3)*1024)); vhi[i]=vtr(vp_+(((i)>>2)*4096+((i)&3)*1024+512)); }while(0)
  #define KRD(G,j) do{ if(G){ kload2(kf,kp0+sl_next,j); SBAR(); } }while(0)
  #define STEP(C0,C1,P0,P1,t,GK,GV,GL) do{ SBAR(); \
    const lds_cptr vp_=vp0+sl_prev; \
    VRD(0); SBAR(); float sacc=(P0[0]+P0[1]); \
    GAPA(C0=__builtin_amdgcn_mfma_f32_32x32x16_bf16(kf[0],qr[0],negm,0,0,0), P0[2],P0[3],P0[4],P0[5],     pw0[0]=PKW(P0,0), pw0[1]=PKW(P0,2), pw0); \
    VRD(4); SBAR(); GAPA(C1=__builtin_amdgcn_mfma_f32_32x32x16_bf16(kf[1],qr[0],negm,0,0,0), P0[6],P0[7],P0[8],P0[9],     pw0[2]=PKW(P0,4), pw0[3]=PKW(P0,6), pw0); \
    VRD(1); SBAR(); GAPA(C0=__builtin_amdgcn_mfma_f32_32x32x16_bf16(kf[2],qr[1],C0,0,0,0),   P0[10],P0[11],P0[12],P0[13], pw1[0]=PKW(P0,8), pw1[1]=PKW(P0,10), pw1); \
    VRD(5); SBAR(); GAPA(C1=__builtin_amdgcn_mfma_f32_32x32x16_bf16(kf[3],qr[1],C1,0,0,0),   P0[14],P0[15],P1[0],P1[1],   pw1[2]=PKW(P0,12),pw1[3]=PKW(P0,14), pw1); \
    VRD(2); SBAR(); GAPA(C0=__builtin_amdgcn_mfma_f32_32x32x16_bf16(kf[4],qr[2],C0,0,0,0),   P1[2],P1[3],P1[4],P1[5],     pw2[0]=PKW(P1,0), pw2[1]=PKW(P1,2), pw2); \
    VRD(6); SBAR(); GAPA(C1=__builtin_amdgcn_mfma_f32_32x32x16_bf16(kf[5],qr[2],C1,0,0,0),   P1[6],P1[7],P1[8],P1[9],     pw2[2]=PKW(P1,4), pw2[3]=PKW(P1,6), pw2); \
    VRD(3); SBAR(); GAPA(C0=__builtin_amdgcn_mfma_f32_32x32x16_bf16(kf[6],qr[3],C0,0,0,0),   P1[10],P1[11],P1[12],P1[13], pw3[0]=PKW(P1,8), pw3[1]=PKW(P1,10), pw3); \
    VRD(7); SBAR(); GAPA(C1=__builtin_amdgcn_mfma_f32_32x32x16_bf16(kf[7],qr[3],C1,0,0,0),   P1[14],P1[15],0.f,0.f,       pw3[2]=PKW(P1,12),pw3[3]=PKW(P1,14), pw3); \
    l_reg+=sacc; \
    if(GK){DMA_K((t)+3,sl_cur);} if(GV){DMA_V((t)+1,sl_next);} \
    CMASK(C0,C1,t); \
    { float a=MX3(C0[0],C0[1],C1[0]),b=MX3(C0[2],C0[3],C1[1]); a=MX3(a,C1[2],C1[3]); \
      _Pragma("unroll") for(int r=4;r<16;r+=4){a=MX3(a,C0[r],C0[r+1]);b=MX3(b,C0[r+2],C0[r+3]);a=MX3(a,C1[r],C1[r+1]);b=MX3(b,C1[r+2],C1[r+3]);} \
      float rm=__builtin_fmaxf(a,b); { auto rr=__builtin_amdgcn_permlane32_swap(__float_as_uint(rm),__float_as_uint(rm),false,false); rm=__builtin_fmaxf(__uint_as_float(rr[0]),__uint_as_float(rr[1])); } \
      resc=false; \
      if(__builtin_expect(__any(rm>(float)THRL),0)){ const float dl=__builtin_fmaxf(rm,0.f); mhat+=dl; \
        _Pragma("unroll") for(int r=0;r<16;++r){C0[r]-=dl;C1[r]-=dl;} \
        { const float nv_=selcur?-mhat:NEGBIG; _Pragma("unroll") for(int r=0;r<16;++r)negm[r]=nv_; } asm volatile("":"+v"(negm)); \
        const float f=__builtin_amdgcn_exp2f(-dl); l_reg*=f; if(hi==0)wsf[r32]=f; resc=true; } } \
    SBAR(); \
    GAPB(o[0]=__builtin_amdgcn_mfma_f32_32x32x16_bf16(PAF(0),VFR(0),o[0],0,0,0), C0,0); \
    GAPB(o[1]=__builtin_amdgcn_mfma_f32_32x32x16_bf16(PAF(0),VFR(4),o[1],0,0,0), C0,4); \
    KRD(GL,0); GAPB(o[0]=__builtin_amdgcn_mfma_f32_32x32x16_bf16(PAF(1),VFR(1),o[0],0,0,0), C0,8); \
    KRD(GL,1); GAPB(o[1]=__builtin_amdgcn_mfma_f32_32x32x16_bf16(PAF(1),VFR(5),o[1],0,0,0), C0,12); \
    KRD(GL,2); GAPB(o[0]=__builtin_amdgcn_mfma_f32_32x32x16_bf16(PAF(2),VFR(2),o[0],0,0,0), C1,0); \
    KRD(GL,3); GAPB(o[1]=__builtin_amdgcn_mfma_f32_32x32x16_bf16(PAF(2),VFR(6),o[1],0,0,0), C1,4); \
    GAPB(o[0]=__builtin_amdgcn_mfma_f32_32x32x16_bf16(PAF(3),VFR(3),o[0],0,0,0), C1,8); \
    GAPB(o[1]=__builtin_amdgcn_mfma_f32_32x32x16_bf16(PAF(3),VFR(7),o[1],0,0,0), C1,12); \
    }while(0)
  #define BLKSEL(tt) do{ if((((tt))&3)==0){ selcur=((bmask>>((tt)>>2))&1u)!=0u; const float nv_=selcur?-mhat:NEGBIG; _Pragma("unroll") for(int r=0;r<16;++r)negm[r]=nv_; asm volatile("":"+v"(negm)); } }while(0)
  int t=1;
  #undef CMASK
  #define CMASK(P0,P1,t) do{}while(0)
  for(;t+5<NT;t+=2){
    STEP(pB0,pB1,pA0,pA1,t,true,true,true);     WAIT_BAR(2); RESC(); ROT(); BLKSEL(t+1);
    STEP(pA0,pA1,pB0,pB1,t+1,true,true,true);   WAIT_BAR(2); RESC(); ROT();
  }
  #undef CMASK
  #define CMASK(P0,P1,t) do{int jb_=(t)-(NT-4); if(jb_>=0)cmask(P0,P1,jb_,qrel,hi);}while(0)
  #define ENDW(tt) do{ if((tt)+3<NT){WAIT_BAR(2);} else if((tt)+2<NT){WAIT_BAR(1);} else {WAIT_BAR(0);} }while(0)
  for(;t+1<NT;t+=2){
    STEP(pB0,pB1,pA0,pA1,t,(t+3<NT),(t+1<NT),(t+1<NT));       ENDW(t);   RESC(); ROT(); BLKSEL(t+1);
    STEP(pA0,pA1,pB0,pB1,t+1,(t+4<NT),(t+2<NT),(t+2<NT));     ENDW(t+1); RESC(); ROT();
  }
  STEP(pB0,pB1,pA0,pA1,NT-1,false,false,false); RESC();
  { float sacc=pB0[0]+pB0[1]; _Pragma("unroll") for(int r=2;r<16;++r)sacc+=pB0[r]; _Pragma("unroll") for(int r=0;r<16;++r)sacc+=pB1[r]; l_reg+=sacc;
    pw0=(u32x4){PKW(pB0,0),PKW(pB0,2),PKW(pB0,4),PKW(pB0,6)};pw1=(u32x4){PKW(pB0,8),PKW(pB0,10),PKW(pB0,12),PKW(pB0,14)};pw2=(u32x4){PKW(pB1,0),PKW(pB1,2),PKW(pB1,4),PKW(pB1,6)};pw3=(u32x4){PKW(pB1,8),PKW(pB1,10),PKW(pB1,12),PKW(pB1,14)};
    SBAR(); pv(o,vb0+sl_cur,PAF(0),PAF(1),PAF(2),PAF(3)); }
  #undef PKW
  #undef PAF
  #undef VFR
  #undef PIN
  #undef MX3
  #undef GAPA
  #undef GAPB
  #undef EX
  #undef VRD
  #undef KRD
  #undef STEP
  #undef ENDW
  {auto rr=__builtin_amdgcn_permlane32_swap(__float_as_uint(l_reg),__float_as_uint(l_reg),false,false);l_reg=__uint_as_float(rr[0])+__uint_as_float(rr[1]);}
  if(hi==0)wsf[32+r32]=l_reg;asm volatile("s_waitcnt lgkmcnt(0)":::"memory");
  float rli[16];
  #pragma unroll
  for(int r=0;r<16;++r)rli[r]=__builtin_amdgcn_rcpf(wsf[32+crow(r,hi)]);
  unsigned char*Ow=(unsigned char*)O+(rowbase+q0+wid*QBLK)*OP+h*D;
  { unsigned char*stg=(unsigned char*)(shm+LDS_OST)+wid*4096;
    #pragma unroll
    for(int r=0;r<16;++r){const int orow=crow(r,hi);
      #pragma unroll
      for(int d0=0;d0<2;++d0){const float ov=__builtin_amdgcn_fmed3f(o[d0][r]*rli[r]*32.f,-448.f,448.f); stg[orow*64+d0*32+r32]=(unsigned char)__builtin_amdgcn_cvt_pk_fp8_f32(ov,ov,0,false);}}
    asm volatile("s_waitcnt lgkmcnt(0)":::"memory");
    #pragma unroll
    for(int i=0;i<2;++i){const int row=i*16+(lane>>2),ch=lane&3; const u32x4 v=*(const u32x4*)(stg+row*64+ch*16); ATTN_STORE16(Ow+(long)row*OP+ch*16,v);} }
  asm volatile("s_waitcnt lgkmcnt(0)\n\ts_barrier":::"memory");
  #undef BLKSEL
  #undef DMA_K
  #undef DMA_V
  #undef CMASK
  #undef START
  #undef RESC
  #undef ROT
}
constexpr int ATTN_LDS_BYTES=LDS_BYTES;
struct AttnTensors { const bf16* Q; const bf16* K; const bf16* V; bf16* O; const float* kbar; };
struct AttnUnit { int bh; int qb; };
struct StaticOrder {
  int vcu, G;
  __device__ __forceinline__ explicit StaticOrder(int grid,int block):vcu((grid%8==0)?(block%8)*(grid/8)+block/8:block),G(grid){}
  __device__ __forceinline__ bool next(int i,AttnUnit&u)const{ const int pr=(vcu+(i>>2)*G)*2+((i>>1)&1); if(pr>=BATCH*NHEAD*4)return false;
    const int s=pr&3; u.bh=pr>>2; u.qb=(i&1)?7-s:s; return true; }
  __device__ __forceinline__ void a_ready(const AttnUnit&)const{}
  __device__ __forceinline__ void done(const AttnUnit&)const{}
};
template<class Sched,int THRL=8> __device__ __forceinline__ void attn_phase(char*lds,const AttnTensors&T,const Sched&S,const int tid_in){
  AttnUnit u; int tid_=tid_in; asm volatile("":"+v"(tid_));
  for(int i=0;S.next(i,u);++i){ S.a_ready(u); attn_unit<THRL>(u.bh/NHEAD,u.bh%NHEAD,u.qb,T.Q,T.K,T.V,T.O,T.kbar+(long)u.bh*512,lds,tid_); S.done(u); }
}
#undef SBAR
#undef WAIT_BAR
}

#define XB_TMO      128
#define XB_XCNT(j)  (256  + 64 * (j))
#define XB_XSUB(j)  (1280 + 64 * (j))
#define XB_XGEN(j)  (2304 + 64 * (j))
#define XB_TOP      3328
#define XB_TOPGEN   3392
#define XCD_BAR_WORDS 3456
#define XB_SPIN_CAP (1u << 18)

__device__ __forceinline__ unsigned xb_ld(unsigned* p)              { return __hip_atomic_load(p, __ATOMIC_RELAXED, __HIP_MEMORY_SCOPE_AGENT); }
__device__ __forceinline__ unsigned xb_add(unsigned* p, unsigned v) { return __hip_atomic_fetch_add(p, v, __ATOMIC_RELAXED, __HIP_MEMORY_SCOPE_AGENT); }
__device__ __forceinline__ unsigned xb_xcc_id() { return (unsigned)__builtin_amdgcn_s_getreg((3 << 11) | 20) & 0xFu; }
#define XB_SPIN(cond, bar) do { unsigned _sp = 0; while (cond) { __builtin_amdgcn_s_sleep(1); \
    if ((++_sp & 255u) == 0u) { if (xb_ld(&(bar)[XB_TMO])) break; if (_sp > XB_SPIN_CAP) { atomicAdd(&(bar)[XB_TMO], 1u); break; } } } } while (0)

struct XcdBarrier {
    unsigned* bar; unsigned x;
    volatile LAS unsigned* st;
};

__device__ __forceinline__ XcdBarrier xcd_barrier_post(unsigned* bar, volatile LAS unsigned* st) {
    XcdBarrier b; b.bar = bar; b.x = xb_xcc_id(); b.st = st;
    if (threadIdx.x == 0) (void)xb_add(&bar[XB_XCNT(b.x)], 1u);
    return b;
}
__device__ __forceinline__ void xcd_barrier_complete(unsigned* bar, unsigned x, unsigned& nloc, unsigned& nx) {
    const unsigned G = gridDim.x * gridDim.y * gridDim.z;
    unsigned sum, cnt, mine, sp = 0u;
    for (;;) {
        sum = 0u; cnt = 0u; mine = 0u;
#pragma unroll
        for (unsigned j = 0; j < 16; ++j) { const unsigned c = xb_ld(&bar[XB_XCNT(j)]); sum += c; cnt += (c > 0u) ? 1u : 0u; mine = (j == x) ? c : mine; }
        if (sum == G) break;
        __builtin_amdgcn_s_sleep(1);
        if ((++sp & 255u) == 0u) { if (xb_ld(&bar[XB_TMO])) break; if (sp > XB_SPIN_CAP) { atomicAdd(&bar[XB_TMO], 1u); break; } }
    }
    nloc = mine > 0u ? mine : 1u; nx = cnt > 0u ? cnt : 1u;
}

__device__ __forceinline__ void xcd_barrier(const XcdBarrier& b, const bool is_t0) {
    asm volatile("s_waitcnt vmcnt(0)" ::: "memory");
    __syncthreads();
    if (is_t0) {
        unsigned* bar = b.bar;
        __builtin_amdgcn_s_waitcnt(0);
        unsigned nloc = b.st[0], nx = b.st[1];
        if (nloc == 0u) { xcd_barrier_complete(bar, b.x, nloc, nx); b.st[0] = nloc; b.st[1] = nx; }
        const unsigned old = xb_add(&bar[XB_XSUB(b.x)], 1u);
        const unsigned gen = old / nloc;
        if (old + 1u == (gen + 1u) * nloc) {
            __builtin_amdgcn_fence(__ATOMIC_RELEASE, "agent");
            asm volatile("s_waitcnt vmcnt(0)" ::: "memory");
            const unsigned og = xb_add(&bar[XB_TOP], 1u);
            const unsigned tg = og / nx;
            if (og + 1u == (tg + 1u) * nx) xb_add(&bar[XB_TOPGEN], 1u);
            else XB_SPIN(xb_ld(&bar[XB_TOPGEN]) == tg, bar);
            __builtin_amdgcn_fence(__ATOMIC_ACQUIRE, "agent");
            xb_add(&bar[XB_XGEN(b.x)], 1u);
            asm volatile("s_waitcnt vmcnt(0)" ::: "memory");
        } else {
            XB_SPIN(xb_ld(&bar[XB_XGEN(b.x)]) == gen, bar);
            __builtin_amdgcn_fence(__ATOMIC_ACQUIRE, "agent");
            asm volatile("s_waitcnt vmcnt(0)" ::: "memory");
        }
    }
    __syncthreads();
}

struct Args { const float* in[17]; float* out; unsigned char* ws; int ph_lo, ph_hi; };
enum { I_X = 0, I_C, I_WMOD, I_BMOD, I_WIN, I_WPOOL, I_PSCALE, I_WOUT, I_LN1G, I_LN1B, I_WR, I_RB, I_WG, I_WU, I_WDN, I_LN2G, I_LN2B };

DEVFN int lane_id_volatile() { int l; asm volatile("v_mbcnt_lo_u32_b32 %0, -1, 0\n\tv_mbcnt_hi_u32_b32 %0, -1, %0" : "=v"(l)); return l; }
struct Ctx { unsigned char* lds; __attribute__((address_space(3))) unsigned char* lds3; int tid, lane, wave, G, bid, gw, NGW; };

DEVFN void transpose_item_f8(const float* src, int ldn, int k0, int col, unsigned char* dst, int ldk, int dst_row0, int dst_k0, float* scr, int lane) {
#pragma unroll 8
    for (int i = 0; i < 32; ++i) { const int kk = 2 * i + (lane >> 5); scr[kk * 33 + (lane & 31)] = src[(size_t)(k0 + kk) * ldn + col]; }
    LDS_WAIT();
    const int c = lane & 7;
#pragma unroll
    for (int j = 0; j < 4; ++j) { const int n = (lane >> 3) + 8 * j; const float* s = scr + (8 * c) * 33 + n;
        u32x2 o; o.x = pk4_fp8(32.f * s[0 * 33], 32.f * s[1 * 33], 32.f * s[2 * 33], 32.f * s[3 * 33]); o.y = pk4_fp8(32.f * s[4 * 33], 32.f * s[5 * 33], 32.f * s[6 * 33], 32.f * s[7 * 33]);
        *(u32x2*)(dst + (size_t)(dst_row0 + n) * ldk + dst_k0 + 8 * c) = o; }
    LDS_WAIT();
}

DEVFN void ph_prologue(const Args& a, const Ctx& c) {
    unsigned char* ws = a.ws;
    float* scr = (float*)(c.lds + c.wave * 16384);
    const int lane = c.lane;
    constexpr int N1 = 2 * 16 * 64, N2 = 2 * 8 * 32, N3 = 32 * 16 * 32, N4 = 32 * 8 * 32, N5 = 2 * 64 * 16, N6 = 256;
    for (int it = c.gw; it < N1 + N2 + N3 + N4 + N5 + N6; it += c.NGW) {
        int r = it;
        if (r < N1) {
            const int l = r / 1024, kb = (r % 1024) / 64, nb = r % 64;
            const int nphys = 32 * nb + (lane & 31);
            transpose_item_f8(a.in[I_WIN] + (size_t)l * DM * DIN, DIN, 64 * kb, inproj_nlog(nphys), (unsigned char*)(ws + WS_WIN) + (size_t)l * DIN * DM, DM, 32 * nb, 64 * kb, scr, lane);
            continue; }
        r -= N1;
        if (r < N2) {
            const int l = r / 256, kb = (r % 256) / 32, nb = r % 32;
            transpose_item_f8(a.in[I_WOUT] + (size_t)l * DM * DM, DM, 64 * kb, 32 * nb + (lane & 31), (unsigned char*)(ws + WS_WOUT) + (size_t)l * DM * DM, DM, 32 * nb, 64 * kb, scr, lane);
            continue; }
        r -= N2;
        if (r < N3) {
            const int le = r / 512, kb = (r % 512) / 32, nb = r % 32;
            const int n = 32 * nb + (lane & 31), jt = n >> 8, bj = (n >> 7) & 1, i = n & 127;
            const float* src = (bj ? a.in[I_WU] : a.in[I_WG]) + (size_t)le * DM * DE;
            transpose_item_f8(src, DE, 64 * kb, jt * 128 + i, (unsigned char*)(ws + WS_WGU) + (size_t)le * DM * DM, DM, 32 * nb, 64 * kb, scr, lane);
            continue; }
        r -= N3;
        if (r < N4) {
            const int le = r / 256, kb = (r % 256) / 32, nb = r % 32;
            transpose_item_f8(a.in[I_WDN] + (size_t)le * DE * DM, DM, 64 * kb, 32 * nb + (lane & 31), (unsigned char*)(ws + WS_WD) + (size_t)le * DM * DE, DE, 32 * nb, 64 * kb, scr, lane);
            continue; }
        r -= N4;
        if (r < N5) {
            const int l = r / 1024, kdg = (r % 1024) / 16, nb = r % 16;
            const int n = nb * 64 + lane, kd0 = kdg * 8, g = kd0 >> 7, c0 = kd0 & 127;
            const float* wo = a.in[I_WOUT] + (size_t)l * DM * DM + (size_t)(512 + g * 128) * DM + n;
            const float* ps = a.in[I_PSCALE] + l * 512 + g * 128;
            const float* wp = a.in[I_WPOOL] + ((size_t)(l * 4 + g) * 128 + c0) * 128;
            float acc[8];
#pragma unroll
            for (int j = 0; j < 8; ++j) acc[j] = 0.f;
            for (int e = 0; e < 128; ++e) { const float w = wo[(size_t)e * DM] * ps[e];
#pragma unroll
                for (int j = 0; j < 8; ++j) acc[j] += wp[j * 128 + e] * w; }
            u32x2 o; o.x = pk4_fp8(128.f * acc[0], 128.f * acc[1], 128.f * acc[2], 128.f * acc[3]); o.y = pk4_fp8(128.f * acc[4], 128.f * acc[5], 128.f * acc[6], 128.f * acc[7]);
            *(u32x2*)((unsigned char*)(ws + WS_WOUT) + (size_t)l * DM * DM + (size_t)n * DM + 512 + kd0) = o;
            continue; }
        r -= N5;
        {
            const int ent = r * 64 + lane, pos = ent >> 3, i = ent & 7;
            const float inv = (float)exp2(-(double)i / 8.0 * 18.931568569324174);
            const float ang = (float)pos * inv;
            float* t = (float*)(ws + WS_ROPE) + ent * 2;
            t[0] = (float)cos((double)ang); t[1] = (float)sin((double)ang);
        }
    }
    for (int i = c.bid * 512 + c.tid; i < 2 * NB * NH * NBLK * HD; i += c.G * 512) ((float*)(ws + WS_KBAR))[i] = 0.f;
    __syncthreads();
    if (c.bid < 192) {
        float* condT = (float*)c.lds;
        float* red = (float*)(c.lds + 65536);
        for (int idx = c.tid; idx < NB * DM; idx += 512) { const int b = idx >> 10, k = idx & 1023; const float v = a.in[I_C][idx]; condT[k * 16 + b] = v / (1.f + __expf(-v)); }
        __syncthreads();
        for (int u = c.bid; u < 192; u += c.G) {
            const int l = u / 96, n0 = (u % 96) * 64;
            const float* W = a.in[I_WMOD] + (size_t)l * DM * NMOD + n0 + lane;
            float acc[16];
#pragma unroll
            for (int b = 0; b < 16; ++b) acc[b] = 0.f;
            for (int k = 128 * c.wave; k < 128 * c.wave + 128; k += 8) {
                float wv[8];
#pragma unroll
                for (int j = 0; j < 8; ++j) wv[j] = W[(size_t)(k + j) * NMOD];
#pragma unroll
                for (int j = 0; j < 8; ++j) {
                    const f32x4* cp = (const f32x4*)(condT + (k + j) * 16);
#pragma unroll
                    for (int q = 0; q < 4; ++q) { const f32x4 cv = cp[q]; acc[4 * q + 0] += cv.x * wv[j]; acc[4 * q + 1] += cv.y * wv[j]; acc[4 * q + 2] += cv.z * wv[j]; acc[4 * q + 3] += cv.w * wv[j]; }
                }
            }
#pragma unroll
            for (int b = 0; b < 16; ++b) red[(c.wave * 16 + b) * 64 + lane] = acc[b];
            __syncthreads();
            for (int o = c.tid; o < 1024; o += 512) { const int b = o >> 6, cc = o & 63; float s = a.in[I_BMOD][l * NMOD + n0 + cc];
#pragma unroll
                for (int w = 0; w < 8; ++w) s += red[(w * 16 + b) * 64 + cc];
                ((float*)(ws + WS_MOD))[(size_t)(l * NB + b) * NMOD + n0 + cc] = s; }
            __syncthreads();
        }
    }
}

DEVFN void row_stats(const f32x4 (&v)[4], float& mean, float& rstd) {
    float s = 0.f, q = 0.f;
#pragma unroll
    for (int j = 0; j < 4; ++j) { s += (v[j].x + v[j].y) + (v[j].z + v[j].w); q += (v[j].x * v[j].x + v[j].y * v[j].y) + (v[j].z * v[j].z + v[j].w * v[j].w); }
    s = swz_xor_add(s, 1); q = swz_xor_add(q, 1); s = swz_xor_add(s, 2); q = swz_xor_add(q, 2); s = swz_xor_add(s, 4); q = swz_xor_add(q, 4);
    s = swz_xor_add(s, 8); q = swz_xor_add(q, 8); s = swz_xor_add(s, 16); q = swz_xor_add(q, 16); s = half_swap_add(s); q = half_swap_add(q);
    mean = s * (1.f / DM);
    rstd = 1.f / sqrtf(fmaxf(q * (1.f / DM) - mean * mean, 0.f) + LN_EPS);
}
DEVFN void row_load(const float* p, int lane, f32x4 (&v)[4]) {
#pragma unroll
    for (int j = 0; j < 4; ++j) v[j] = *(const f32x4*)(p + 4 * lane + 256 * j);
}
DEVFN void row_mod_store(f32x4 (&v)[4], const float* sc, const float* sh, bf16_t* out, int lane) {
    float mean, rstd; row_stats(v, mean, rstd);
#pragma unroll
    for (int j = 0; j < 4; ++j) {
        const f32x4 s = *(const f32x4*)(sc + 4 * lane + 256 * j), h = *(const f32x4*)(sh + 4 * lane + 256 * j);
        v[j] = (v[j] - mean) * rstd * (s + 1.f) + h;
        u32x2 o; o.x = pk2(v[j].x, v[j].y); o.y = pk2(v[j].z, v[j].w);
        *(u32x2*)(out + 4 * lane + 256 * j) = o;
    }
}

DEVFN void ph_pool(const Args& a, const Ctx& c) {
    const bf16_t* P = (const bf16_t*)(a.ws + WS_QKVP) + 1536; unsigned char* AD = (unsigned char*)(a.ws + WS_AD) + 512;
    for (int it = c.bid * 512 + c.tid; it < (NTOK / 8) * 64; it += c.G * 512) {
        const int cg = it & 63, m0 = (it >> 6) * 8, t0 = m0 & (SEQ - 1), g = cg >> 4, w = 2 << g;
        const bf16_t* pc = P + cg * 8;
        u32x4 rows[23];
#pragma unroll
        for (int k = 0; k < 23; ++k) { const int dt = k - 15; rows[k] = (u32x4){0u, 0u, 0u, 0u}; if (dt > -w && t0 + dt >= 0) rows[k] = *(const u32x4*)(pc + (size_t)(m0 + dt) * DIN); }
        float s[8];
#pragma unroll
        for (int j = 0; j < 8; ++j) s[j] = 0.f;
#pragma unroll
        for (int k = 0; k < 15; ++k) { const u32x4 v = rows[k]; s[0] += bf_lo(v.x); s[1] += bf_hi(v.x); s[2] += bf_lo(v.y); s[3] += bf_hi(v.y); s[4] += bf_lo(v.z); s[5] += bf_hi(v.z); s[6] += bf_lo(v.w); s[7] += bf_hi(v.w); }
#pragma unroll
        for (int r = 0; r < 8; ++r) {
            const int t = t0 + r; const u32x4 v = rows[15 + r];
            const float f[8] = {bf_lo(v.x), bf_hi(v.x), bf_lo(v.y), bf_hi(v.y), bf_lo(v.z), bf_hi(v.z), bf_lo(v.w), bf_hi(v.w)};
#pragma unroll
            for (int j = 0; j < 8; ++j) s[j] += f[j];
            const int cnt = (t + 1 < w) ? t + 1 : w; const float ic = 1.f / (float)cnt;
            u32x2 o; o.x = pk4_fp8(s[0] * ic - f[0], s[1] * ic - f[1], s[2] * ic - f[2], s[3] * ic - f[3]); o.y = pk4_fp8(s[4] * ic - f[4], s[5] * ic - f[5], s[6] * ic - f[6], s[7] * ic - f[7]);
            *(u32x2*)(AD + (size_t)(m0 + r) * DM + cg * 8) = o;
            u32x4 q = rows[r];
            if (w == 8) q = rows[r + 8]; else if (w == 4) q = rows[r + 12]; else if (w == 2) q = rows[r + 14];
            s[0] -= bf_lo(q.x); s[1] -= bf_hi(q.x); s[2] -= bf_lo(q.y); s[3] -= bf_hi(q.y); s[4] -= bf_lo(q.z); s[5] -= bf_hi(q.z); s[6] -= bf_lo(q.w); s[7] -= bf_hi(q.w);
        }
    }
}

constexpr size_t WS_X1B = WS_X1, WS_X2B = WS_X1 + 64 * MiB;
constexpr int ROWS_PER_WAVE = 16;
DEVFN void vec_load(const float* p, int lane, f32x4 (&v)[4]) {
#pragma unroll
    for (int j = 0; j < 4; ++j) v[j] = *(const f32x4*)(p + 4 * lane + 256 * j);
}
DEVFN void bfrow_load(const bf16_t* p, int lane, u32x2 (&w)[4]) {
#pragma unroll
    for (int j = 0; j < 4; ++j) w[j] = *(const u32x2*)(p + 4 * lane + 256 * j);
}
DEVFN f32x4 bf4(u32x2 w) { return (f32x4){bf_lo(w.x), bf_hi(w.x), bf_lo(w.y), bf_hi(w.y)}; }
DEVFN void bfrow_store(bf16_t* p, int lane, const f32x4 (&v)[4]) {
#pragma unroll
    for (int j = 0; j < 4; ++j) { u32x2 o; o.x = pk2(v[j].x, v[j].y); o.y = pk2(v[j].z, v[j].w); *(u32x2*)(p + 4 * lane + 256 * j) = o; }
}
DEVFN void f8row_store(unsigned char* p, int lane, const f32x4 (&v)[4]) {
#pragma unroll
    for (int j = 0; j < 4; ++j) *(unsigned*)(p + 4 * lane + 256 * j) = pk4_fp8(v[j].x, v[j].y, v[j].z, v[j].w);
}
DEVFN void ln_mod(f32x4 (&v)[4], const f32x4 (&sc)[4], const f32x4 (&sh)[4]) {
    float mean, rstd; row_stats(v, mean, rstd);
#pragma unroll
    for (int j = 0; j < 4; ++j) v[j] = (v[j] - mean) * rstd * (sc[j] + 1.f) + sh[j];
}
DEVFN void ln_aff(f32x4 (&v)[4], const f32x4 (&g)[4], const f32x4 (&b)[4]) {
    float mean, rstd; row_stats(v, mean, rstd);
#pragma unroll
    for (int j = 0; j < 4; ++j) v[j] = (v[j] - mean) * rstd * g[j] + b[j];
}

DEVFN void ph_h1_rows(const Args& a, const Ctx& c) {
    const float* mod = (const float*)(a.ws + WS_MOD); bf16_t* HB = (bf16_t*)(a.ws + WS_HB);
    for (int base = c.gw * ROWS_PER_WAVE; base < NTOK; base += c.NGW * ROWS_PER_WAVE) {
        const float* mb = mod + (size_t)(base >> 11) * NMOD;
        f32x4 sc[4], sh[4]; vec_load(mb + DM, c.lane, sc); vec_load(mb, c.lane, sh);
        f32x4 cur[4], nxt[4]; vec_load(a.in[I_X] + (size_t)base * DM, c.lane, cur);
#pragma unroll 1
        for (int i = 0; i < ROWS_PER_WAVE; ++i) {
            const int m = base + i;
            if (i + 1 < ROWS_PER_WAVE) vec_load(a.in[I_X] + (size_t)(m + 1) * DM, c.lane, nxt);
            ln_mod(cur, sc, sh); f8row_store((unsigned char*)HB + (size_t)m * DM, c.lane, cur);
#pragma unroll
            for (int j = 0; j < 4; ++j) cur[j] = nxt[j];
        }
    }
}

DEVFN f32x4 reduce16(const float (&lg)[16]) {
    float t[8], u[4];
#pragma unroll
    for (int e = 0; e < 8; ++e) { auto rr = __builtin_amdgcn_permlane32_swap(__float_as_uint(lg[e]), __float_as_uint(lg[e + 8]), false, false); t[e] = __uint_as_float(rr[0]) + __uint_as_float(rr[1]); }
#pragma unroll
    for (int k = 0; k < 4; ++k) { auto rr = __builtin_amdgcn_permlane16_swap(__float_as_uint(t[k]), __float_as_uint(t[k + 4]), false, false); u[k] = __uint_as_float(rr[0]) + __uint_as_float(rr[1]); }
#pragma unroll
    for (int k = 0; k < 4; ++k) { u[k] = swz_xor_add(u[k], 1); u[k] = swz_xor_add(u[k], 2); u[k] = swz_xor_add(u[k], 4); u[k] = swz_xor_add(u[k], 8); }
    return (f32x4){u[0], u[1], u[2], u[3]};
}

DEVFN void rowc_load(const Args& a, int l, int m, int lane, f32x4 (&x)[4], unsigned (&y)[4]) {
    if (l == 0) vec_load(a.in[I_X] + (size_t)m * DM, lane, x);
    else { u32x2 w[4]; bfrow_load((const bf16_t*)(a.ws + WS_X2B) + (size_t)m * DM, lane, w);
#pragma unroll
        for (int j = 0; j < 4; ++j) { x[j].x = __uint_as_float(w[j].x); x[j].y = __uint_as_float(w[j].y); } }
#pragma unroll
    for (int j = 0; j < 4; ++j) y[j] = *(const unsigned*)((const unsigned char*)(a.ws + WS_QKVP) + (size_t)m * DM + 4 * lane + 256 * j);
}
DEVFN void rowc_step(const Args& a, int l, int m, int lane, const f32x4 (&x)[4], const unsigned (&y)[4], const float* vg1, const float* vsc, const float* vsh, f32x4 (&v)[4]) {
    int z_ = 0; asm volatile("" : "+v"(z_));
    f32x4 g1[4]; vec_load(vg1 + z_, lane, g1);
#pragma unroll
    for (int j = 0; j < 4; ++j) { const f32x4 xv = (l == 0) ? x[j] : bf4((u32x2){__float_as_uint(x[j].x), __float_as_uint(x[j].y)}); v[j] = xv * ALPHA + g1[j] * f8x4_to_f32(y[j], 1.f / YSCALE); }
    { f32x4 lg[4], lb[4]; vec_load(a.in[I_LN1G] + l * DM + z_, lane, lg); vec_load(a.in[I_LN1B] + l * DM + z_, lane, lb); ln_aff(v, lg, lb); }
    bfrow_store((bf16_t*)(a.ws + WS_X1B) + (size_t)m * DM, lane, v);
    { f32x4 sc[4], sh[4]; vec_load(vsc + z_, lane, sc); vec_load(vsh + z_, lane, sh); ln_mod(v, sc, sh); }
    f8row_store((unsigned char*)(a.ws + WS_HB) + (size_t)m * DM, lane, v);
}

DEVFN void ph_rows_c(const Args& a, const Ctx& c, int l, bool publish) {
    const float* mod = (const float*)(a.ws + WS_MOD) + (size_t)l * NB * NMOD;
    const bf16_t* Y = (const bf16_t*)(a.ws + WS_QKVP); const bf16_t* X2B = (const bf16_t*)(a.ws + WS_X2B);
    bf16_t* X1B = (bf16_t*)(a.ws + WS_X1B); bf16_t* HB = (bf16_t*)(a.ws + WS_HB);
    float* wr = (float*)c.lds;
    float* vsc = (float*)(c.lds + 65536); float* vsh = vsc + DM; float* vg1 = vsh + DM;
    int* lcnt = (int*)(c.lds + 65536 + 12288); int* lbase = lcnt + 32;
    int* rcls = lbase + 32; float* rw1 = (float*)(rcls + 8 * 64); float* rw2 = rw1 + 8 * 64; int* rrow = (int*)(rw2 + 8 * 64); float* lgs = (float*)(rrow + 8 * 64);
    for (int i = c.tid; i < DM * NE; i += 512) wr[(i & 15) * DM + (i >> 4)] = a.in[I_WR][i];
    if (c.tid < 32) lcnt[c.tid] = 0;
    __syncthreads();
    int nr = 0;
    for (int base = c.gw * ROWS_PER_WAVE; base < NTOK; base += c.NGW * ROWS_PER_WAVE) {
        const float* mb = mod + (size_t)(base >> 11) * NMOD;
        __syncthreads();
        for (int i = c.tid; i < 3 * DM; i += 512) vsc[i] = (i < DM) ? mb[4 * DM + i] : (i < 2 * DM ? mb[3 * DM + (i - DM)] : mb[2 * DM + (i - 2 * DM)]);
        __syncthreads();
#pragma unroll 1
        for (int i = 0; i < ROWS_PER_WAVE; i += 2) {
            const int m = __builtin_amdgcn_readfirstlane(base + i);
            f32x4 va[4], vb[4];
            { f32x4 xa[4], xb[4]; unsigned ya[4], yb[4];
              rowc_load(a, l, m, c.lane, xa, ya); rowc_load(a, l, m + 1, c.lane, xb, yb);
              rowc_step(a, l, m, c.lane, xa, ya, vg1, vsc, vsh, va);
              rowc_step(a, l, m + 1, c.lane, xb, yb, vg1, vsc, vsh, vb); }
            typedef float f32x2_t __attribute__((ext_vector_type(2)));
            f32x2_t acc2[16];
#pragma unroll
            for (int e = 0; e < 16; ++e) acc2[e] = (f32x2_t){0.f, 0.f};
#pragma unroll
            for (int j = 0; j < 4; ++j) {
                const f32x2_t p0 = {va[j].x, vb[j].x}, p1 = {va[j].y, vb[j].y}, p2 = {va[j].z, vb[j].z}, p3 = {va[j].w, vb[j].w};
#pragma unroll
                for (int e = 0; e < 16; ++e) { const f32x4 w = *(const f32x4*)(wr + e * DM + 4 * c.lane + 256 * j);
                    acc2[e] = __builtin_elementwise_fma(p0, (f32x2_t){w.x, w.x}, acc2[e]); acc2[e] = __builtin_elementwise_fma(p1, (f32x2_t){w.y, w.y}, acc2[e]);
                    acc2[e] = __builtin_elementwise_fma(p2, (f32x2_t){w.z, w.z}, acc2[e]); acc2[e] = __builtin_elementwise_fma(p3, (f32x2_t){w.w, w.w}, acc2[e]);
                    if ((e & 7) == 7) __builtin_amdgcn_sched_barrier(0); } }
            float la[16], lb2[16];
#pragma unroll
            for (int e = 0; e < 16; ++e) { la[e] = acc2[e].x; lb2[e] = acc2[e].y; }
            { const f32x4 ua = reduce16(la), ub = reduce16(lb2);
              if ((c.lane & 15) == 0) { *(f32x4*)(lgs + (c.wave * 16 + i) * 16 + (c.lane >> 4) * 4) = ua; *(f32x4*)(lgs + (c.wave * 16 + i + 1) * 16 + (c.lane >> 4) * 4) = ub; } }
        }
        LDS_WAIT();
        if (c.lane < ROWS_PER_WAVE) {
            float lg16[16], rb[16];
#pragma unroll
            for (int e = 0; e < 16; ++e) rb[e] = a.in[I_RB][e];
#pragma unroll
            for (int q = 0; q < 4; ++q) { const f32x4 t = *(const f32x4*)(lgs + (c.wave * 16 + c.lane) * 16 + 4 * q); lg16[4 * q] = t.x; lg16[4 * q + 1] = t.y; lg16[4 * q + 2] = t.z; lg16[4 * q + 3] = t.w; }
            float mx = lg16[0];
#pragma unroll
            for (int e = 1; e < 16; ++e) mx = fmaxf(mx, lg16[e]);
            float sum = 0.f, scr[16];
#pragma unroll
            for (int e = 0; e < 16; ++e) { scr[e] = __expf(lg16[e] - mx); sum += scr[e]; }
            const float isum = 1.f / sum;
#pragma unroll
            for (int e = 0; e < 16; ++e) scr[e] *= isum;
            float bestg = -3.4e38f; int gb = 0, bi1 = 0, bi2 = 1; float bw1 = 0.f, bw2 = 0.f;
#pragma unroll
            for (int g = 0; g < 4; ++g) {
                float m1 = scr[4 * g] + rb[4 * g], s1 = scr[4 * g]; int i1 = 0;
#pragma unroll
                for (int q = 1; q < 4; ++q) { const float sv = scr[4 * g + q] + rb[4 * g + q]; const bool ok = sv > m1; m1 = ok ? sv : m1; s1 = ok ? scr[4 * g + q] : s1; i1 = ok ? q : i1; }
                float m2 = -3.4e38f, s2 = 0.f; int i2 = 0;
#pragma unroll
                for (int q = 0; q < 4; ++q) { const float sv = scr[4 * g + q] + rb[4 * g + q]; const bool ok = (q != i1) && sv > m2; m2 = ok ? sv : m2; s2 = ok ? scr[4 * g + q] : s2; i2 = ok ? q : i2; }
                const float gs = m1 + m2; const bool better = gs > bestg;
                bestg = better ? gs : bestg; gb = better ? g : gb; bi1 = better ? i1 : bi1; bi2 = better ? i2 : bi2; bw1 = better ? s1 : bw1; bw2 = better ? s2 : bw2;
            }
            const float inv = 1.f / (bw1 + bw2);
            const int lo = bi1 < bi2 ? bi1 : bi2, hi2 = bi1 < bi2 ? bi2 : bi1;
            const float wlo = (bi1 < bi2 ? bw1 : bw2) * inv, whi = (bi1 < bi2 ? bw2 : bw1) * inv;
            const int pidx = lo == 0 ? hi2 - 1 : (lo == 1 ? hi2 + 1 : 5);
            const int slot = c.wave * 64 + nr + c.lane;
            rcls[slot] = gb * 6 + pidx; rw1[slot] = wlo; rw2[slot] = whi; rrow[slot] = base + c.lane;
        }
        nr += ROWS_PER_WAVE;
        LDS_WAIT();
    }
    LDS_WAIT();
    if (!publish) return;
    int rank = 0, cls = 0;
    if (c.lane < nr) { cls = rcls[c.wave * 64 + c.lane]; rank = atomicAdd(&lcnt[cls], 1); }
    __syncthreads();
    if (c.tid < NCLS) lbase[c.tid] = (int)__hip_atomic_fetch_add((unsigned*)(a.ws + WS_CTL) + CW_CNT + l * 32 + c.tid, (unsigned)lcnt[c.tid], RLX_AGENT);
    __syncthreads();
    if (c.lane < nr) {
        const int pos = lbase[cls] + rank;
        ((int*)(a.ws + WS_LIST))[(size_t)cls * LISTCAP + pos] = rrow[c.wave * 64 + c.lane];
        float* rw = (float*)(a.ws + WS_RW) + ((size_t)cls * LISTCAP + pos) * 2;
        rw[0] = rw1[c.wave * 64 + c.lane]; rw[1] = rw2[c.wave * 64 + c.lane];
    }
}

DEVFN void ph_rows_g(const Args& a, const Ctx& c, int l) {
    const float* mod = (const float*)(a.ws + WS_MOD) + (size_t)l * NB * NMOD;
    const bf16_t* X1B = (const bf16_t*)(a.ws + WS_X1B); const unsigned char* Y2 = (const unsigned char*)(a.ws + WS_AD);
    bf16_t* X2B = (bf16_t*)(a.ws + WS_X2B); bf16_t* HB = (bf16_t*)(a.ws + WS_HB);
    for (int base = c.gw * ROWS_PER_WAVE; base < NTOK; base += c.NGW * ROWS_PER_WAVE) {
        const float* mb = mod + (size_t)(base >> 11) * NMOD; const float* mb1 = mb + (size_t)NB * NMOD;
        f32x4 g2[4], lg[4], lb[4], sc[4], sh[4];
        vec_load(mb + 5 * DM, c.lane, g2); vec_load(a.in[I_LN2G] + l * DM, c.lane, lg); vec_load(a.in[I_LN2B] + l * DM, c.lane, lb);
        if (l == 0) { vec_load(mb1 + DM, c.lane, sc); vec_load(mb1, c.lane, sh); }
        u32x2 xc[4], xn[4]; unsigned yc[4], yn[4];
        bfrow_load(X1B + (size_t)base * DM, c.lane, xc);
#pragma unroll
        for (int j = 0; j < 4; ++j) yc[j] = *(const unsigned*)(Y2 + (size_t)base * DM + 4 * c.lane + 256 * j);
#pragma unroll 1
        for (int i = 0; i < ROWS_PER_WAVE; ++i) {
            const int m = base + i;
            if (i + 1 < ROWS_PER_WAVE) { bfrow_load(X1B + (size_t)(m + 1) * DM, c.lane, xn);
#pragma unroll
                for (int j = 0; j < 4; ++j) yn[j] = *(const unsigned*)(Y2 + (size_t)(m + 1) * DM + 4 * c.lane + 256 * j); }
            f32x4 v[4];
#pragma unroll
            for (int j = 0; j < 4; ++j) v[j] = bf4(xc[j]) * ALPHA + g2[j] * f8x4_to_f32(yc[j], 1.f / YSCALE);
            ln_aff(v, lg, lb);
            if (l == 0) { bfrow_store(X2B + (size_t)m * DM, c.lane, v); ln_mod(v, sc, sh); f8row_store((unsigned char*)HB + (size_t)m * DM, c.lane, v); }
            else {
#pragma unroll
                for (int j = 0; j < 4; ++j) *(f32x4*)(a.out + (size_t)m * DM + 4 * c.lane + 256 * j) = v[j]; }
#pragma unroll
            for (int j = 0; j < 4; ++j) { xc[j] = xn[j]; yc[j] = yn[j]; }
        }
    }
}

constexpr int MOETAB_OFF = 131072 + 512;
DEVFN void ph_inproj_fast(const Args& a, const Ctx& c, int l, bool dummy_kbar) {
    pg8::DenseSched S; S.so.init(NTOK, DIN, c.G, c.bid); S.A = (const char*)(a.ws + WS_HB); S.Bt = (const char*)(a.ws + WS_WIN) + (size_t)l * DIN * DM; S.lda = DM; S.ldb = DM;
    const pg8::EpiInproj E{(bf16_t*)(a.ws + WS_QKVP), (const float*)(a.ws + WS_ROPE), (dummy_kbar ? (float*)(a.ws + WS_RW) : (float*)(a.ws + WS_KBAR)) + (size_t)l * NB * NH * NBLK * HD};
    pg8::gemm_phase2<pg8::EpiInproj, pg8::DenseSched, true, true, false, true, 127 - 5, 127>(c.lds3, DM, DM, S, E, c.tid);
}
DEVFN void ph_wout_fast(const Args& a, const Ctx& c, int l) {
    pg8::DenseSched S; S.so.init(NTOK, DM, c.G, c.bid); S.A = (const char*)(a.ws + WS_AD); S.Bt = (const char*)(a.ws + WS_WOUT) + (size_t)l * DM * DM; S.lda = DM; S.ldb = DM;
    const pg8::EpiF8 E{(unsigned char*)(a.ws + WS_QKVP), DM};
    pg8::gemm_phase2<pg8::EpiF8, pg8::DenseSched, true, true, false, true, 127 - 5, 127 - 5, true, 127 - 7, 127>(c.lds3, DM, DM, S, E, c.tid);
}
DEVFN void moe_table_lds(const Args& a, const Ctx& c, int l) {
    int* cnt = (int*)(c.lds + MOETAB_OFF); int* tp = cnt + 32;
    if (c.tid < NCLS) cnt[c.tid] = (int)__hip_atomic_load((unsigned*)(a.ws + WS_CTL) + CW_CNT + l * 32 + c.tid, RLX_AGENT);
    __syncthreads();
    if (c.tid == 0) { int s = 0; for (int k = 0; k < NCLS; ++k) { tp[k] = s; s += (cnt[k] + 255) >> 8; } tp[NCLS] = s; }
    __syncthreads();
    int* tcls = tp + 32;
    for (int T = c.tid; T < tp[NCLS]; T += 512) { int k = 0; while (T >= tp[k + 1]) ++k; tcls[T] = k; }
    __syncthreads();
}
DEVFN void ph_gateup_fast(const Args& a, const Ctx& c, int l) {
    moe_table_lds(a, c, l);
    pg8::GateUpSched S; S.cnt = (const LAS int*)(c.lds3 + MOETAB_OFF); S.tp = S.cnt + 32; S.tcls = S.tp + 32; S.npn_shift = 3; S.nunits = S.tp[NCLS] * 8; S.G = c.G; S.c = (c.G % 8 == 0) ? (c.bid % 8) * (c.G / 8) + c.bid / 8 : c.bid;
    S.HB = (const char*)(a.ws + WS_HB); S.list = (const int*)(a.ws + WS_LIST); S.W = (const char*)(a.ws + WS_WGU) + (size_t)l * NE * DM * DM;
    const pg8::EpiGateUp E{(unsigned char*)(a.ws + WS_QKVP), (const float*)(a.ws + WS_RW)};
    pg8::gemm_phase2<pg8::EpiGateUp, pg8::GateUpSched, true, true, false, true, 127 - 5, 127>(c.lds3, DM, DM, S, E, c.tid);
}
DEVFN void ph_down_fast(const Args& a, const Ctx& c, int l) {
    moe_table_lds(a, c, l);
    pg8::DownSched S; S.cnt = (const LAS int*)(c.lds3 + MOETAB_OFF); S.tp = S.cnt + 32; S.tcls = S.tp + 32; S.npn_shift = 2; S.nunits = S.tp[NCLS] * 4; S.G = c.G; S.c = (c.G % 8 == 0) ? (c.bid % 8) * (c.G / 8) + c.bid / 8 : c.bid;
    S.ACT = (const char*)(a.ws + WS_QKVP); S.W = (const char*)(a.ws + WS_WD) + (size_t)l * NE * DM * DE;
    const pg8::EpiDown E{(unsigned char*)(a.ws + WS_AD), (const int*)(a.ws + WS_LIST)};
    pg8::gemm_phase2<pg8::EpiDown, pg8::DownSched, true, true, true, true, 127 - 5, 127 - 3>(c.lds3, DM, DE, S, E, c.tid);
}

#ifndef MK_N_LAUNCHES
#define MK_N_LAUNCHES 1
#endif
constexpr int RING_BYTES = 131072, LDSCTL_OFF = RING_BYTES, MISC_OFF = LDSCTL_OFF + 320, LDS_BYTES = 147456;
constexpr int PH_PER_LAYER = 7, NPHASE = 2 + 2 * PH_PER_LAYER;
constexpr int CW_BAR = 4096;
static_assert((CW_BAR + XCD_BAR_WORDS) * 4 <= (int)CTL_ZERO_BYTES, "CTL");

__global__ void __launch_bounds__(512, 2) fwd(Args a) {
    extern __shared__ __attribute__((aligned(16))) unsigned char lds[];
    const int wave_s = __builtin_amdgcn_readfirstlane(threadIdx.x >> 6);
#define MKTID() (wave_s * 64 + lane_id_volatile())
#define MKCTX() Args al = a; { size_t z_ = 0; asm volatile("" : "+s"(z_)); al.ws = a.ws + z_; } Ctx c; {     int t_ = MKTID(); asm volatile("" : "+v"(t_)); c.lds = lds; c.lds3 = (LAS unsigned char*)lds; c.tid = t_; c.lane = t_ & 63; c.wave = __builtin_amdgcn_readfirstlane(t_ >> 6); c.G = gridDim.x; c.bid = blockIdx.x; c.gw = c.bid * 8 + c.wave; c.NGW = c.G * 8; }
    const int lo = a.ph_lo, hi = a.ph_hi;
    const bool one = (hi - lo) > 1;
    for (int u = threadIdx.x; u < (LDS_BYTES - LDSCTL_OFF) / 4; u += 512) ((LAS unsigned*)((LAS unsigned char*)lds + LDSCTL_OFF))[u] = 0u;
    __syncthreads();
    XcdBarrier bar; bar.bar = (unsigned*)(a.ws + WS_CTL) + CW_BAR; bar.x = 0; bar.st = nullptr;
    if (one) bar = xcd_barrier_post((unsigned*)(a.ws + WS_CTL) + CW_BAR, (volatile LAS unsigned*)((LAS unsigned char*)lds + MISC_OFF) + 8);
#ifndef REP_PHASE
#define REP_PHASE -1
#endif
#define IN(k) (lo <= (k) && (k) < hi)
#define SEAM(k) do { if (IN(k) && IN((k) + 1)) { XcdBarrier bl_ = bar; { size_t z_ = 0; unsigned x_ = bar.x; asm volatile("" : "+s"(z_), "+s"(x_)); bl_.bar = bar.bar + z_; bl_.x = x_; } xcd_barrier(bl_, MKTID() == 0); } } while (0)
    if (IN(0)) { MKCTX(); ph_prologue(al, c); if (REP_PHASE == 0) { __syncthreads(); ph_prologue(al, c); } SEAM(0); }
    if (IN(1)) { MKCTX(); ph_h1_rows(al, c); if (REP_PHASE == 1) ph_h1_rows(al, c); SEAM(1); }
    {
        constexpr int l = 0; constexpr int p0 = 2 + l * PH_PER_LAYER;
        if (IN(p0 + 0)) { MKCTX(); ph_inproj_fast(al, c, l, false); if (REP_PHASE == 10) { __syncthreads(); ph_inproj_fast(al, c, l, true); } SEAM(p0 + 0); }
        if (IN(p0 + 1)) {
            { MKCTX(); ph_pool(al, c); }
            __syncthreads();
            const attn_body::AttnTensors AT{(const attn_body::bf16*)(a.ws + WS_QKVP), (const attn_body::bf16*)(a.ws + WS_QKVP) + 512, (const attn_body::bf16*)(a.ws + WS_QKVP) + 1024,
                                            (attn_body::bf16*)(a.ws + WS_AD), (const float*)(a.ws + WS_KBAR) + (size_t)l * NB * NH * NBLK * HD};
            const attn_body::StaticOrder S((int)gridDim.x, (int)blockIdx.x);
            attn_body::attn_phase<attn_body::StaticOrder>((char*)lds, AT, S, MKTID());
            if (REP_PHASE == 11) attn_body::attn_phase<attn_body::StaticOrder>((char*)lds, AT, S, MKTID());
            if (REP_PHASE == 17) { __syncthreads(); MKCTX(); ph_pool(al, c); }
            SEAM(p0 + 1);
        }
        if (IN(p0 + 2)) { MKCTX(); ph_wout_fast(al, c, l); if (REP_PHASE == 12) { __syncthreads(); ph_wout_fast(al, c, l); } SEAM(p0 + 2); }
        if (IN(p0 + 3)) { MKCTX(); if (REP_PHASE == 13) { ph_rows_c(al, c, l, false); __syncthreads(); } ph_rows_c(al, c, l, true); SEAM(p0 + 3); }
        if (IN(p0 + 4)) { MKCTX(); ph_gateup_fast(al, c, l); if (REP_PHASE == 14) { __syncthreads(); ph_gateup_fast(al, c, l); } SEAM(p0 + 4); }
        if (IN(p0 + 5)) { MKCTX(); ph_down_fast(al, c, l); if (REP_PHASE == 15) { __syncthreads(); ph_down_fast(al, c, l); } SEAM(p0 + 5); }
        if (IN(p0 + 6)) { MKCTX(); ph_rows_g(al, c, l); if (REP_PHASE == 16) ph_rows_g(al, c, l); SEAM(p0 + 6); }
    }
    {
        constexpr int l = 1; constexpr int p0 = 2 + l * PH_PER_LAYER;
        if (IN(p0 + 0)) { MKCTX(); ph_inproj_fast(al, c, l, false); if (REP_PHASE == 10) { __syncthreads(); ph_inproj_fast(al, c, l, true); } SEAM(p0 + 0); }
        if (IN(p0 + 1)) {
            { MKCTX(); ph_pool(al, c); }
            __syncthreads();
            const attn_body::AttnTensors AT{(const attn_body::bf16*)(a.ws + WS_QKVP), (const attn_body::bf16*)(a.ws + WS_QKVP) + 512, (const attn_body::bf16*)(a.ws + WS_QKVP) + 1024,
                                            (attn_body::bf16*)(a.ws + WS_AD), (const float*)(a.ws + WS_KBAR) + (size_t)l * NB * NH * NBLK * HD};
            const attn_body::StaticOrder S((int)gridDim.x, (int)blockIdx.x);
            attn_body::attn_phase<attn_body::StaticOrder>((char*)lds, AT, S, MKTID());
            if (REP_PHASE == 11) attn_body::attn_phase<attn_body::StaticOrder>((char*)lds, AT, S, MKTID());
            if (REP_PHASE == 17) { __syncthreads(); MKCTX(); ph_pool(al, c); }
            SEAM(p0 + 1);
        }
        if (IN(p0 + 2)) { MKCTX(); ph_wout_fast(al, c, l); if (REP_PHASE == 12) { __syncthreads(); ph_wout_fast(al, c, l); } SEAM(p0 + 2); }
        if (IN(p0 + 3)) { MKCTX(); if (REP_PHASE == 13) { ph_rows_c(al, c, l, false); __syncthreads(); } ph_rows_c(al, c, l, true); SEAM(p0 + 3); }
        if (IN(p0 + 4)) { MKCTX(); ph_gateup_fast(al, c, l); if (REP_PHASE == 14) { __syncthreads(); ph_gateup_fast(al, c, l); } SEAM(p0 + 4); }
        if (IN(p0 + 5)) { MKCTX(); ph_down_fast(al, c, l); if (REP_PHASE == 15) { __syncthreads(); ph_down_fast(al, c, l); } SEAM(p0 + 5); }
        if (IN(p0 + 6)) { MKCTX(); ph_rows_g(al, c, l); if (REP_PHASE == 16) ph_rows_g(al, c, l); SEAM(p0 + 6); }
    }
#undef IN
#undef SEAM
}

extern "C" void kernel_launch(void* const* d_in, const int* in_sizes, int n_in, void* d_out, int out_size, void* d_ws, size_t ws_size, hipStream_t stream) {
    static int grid = 0;
    if (grid == 0) {
        if (n_in != 17 || out_size != NTOK * DM || ws_size < WS_END) { fprintf(stderr, "kernel_launch: unexpected problem (n_in %d out %d ws %zu)\n", n_in, out_size, ws_size); grid = -1; return; }
        if (hipFuncSetAttribute((const void*)fwd, hipFuncAttributeMaxDynamicSharedMemorySize, LDS_BYTES) != hipSuccess) { fprintf(stderr, "kernel_launch: hipFuncSetAttribute failed\n"); grid = -1; return; }
        int dev = 0, cus = 0, per_cu = 0;
        (void)hipGetDevice(&dev); (void)hipDeviceGetAttribute(&cus, hipDeviceAttributeMultiprocessorCount, dev);
        if (hipOccupancyMaxActiveBlocksPerMultiprocessor(&per_cu, (const void*)fwd, 512, LDS_BYTES) != hipSuccess || per_cu < 1) fprintf(stderr, "kernel_launch: occupancy query reports %d workgroups per CU\n", per_cu);
        (void)hipGetLastError();
        grid = cus > 0 ? cus : 256;
    }
    if (grid < 0) return;
    (void)hipMemsetAsync((char*)d_ws + WS_CTL, 0, CTL_ZERO_BYTES, stream);
    Args a{};
    for (int i = 0; i < 17; ++i) a.in[i] = (const float*)d_in[i];
    a.out = (float*)d_out; a.ws = (unsigned char*)d_ws;
#if MK_N_LAUNCHES == 1
    a.ph_lo = 0; a.ph_hi = NPHASE; hipLaunchKernelGGL(fwd, dim3(grid), dim3(512), LDS_BYTES, stream, a);
#else
    for (int p = 0; p < NPHASE; ++p) { a.ph_lo = p; a.ph_hi = p + 1; hipLaunchKernelGGL(fwd, dim3(grid), dim3(512), LDS_BYTES, stream, a); }
#endif
}
```

```cpp
#include <hip/hip_runtime.h>
#include <cstdint>
#include <cstdio>

constexpr int NB = 16, SEQ = 2048, DM = 1024, NTOK = NB * SEQ, DIN = 2048, NH = 8, HD = 64, NBLK = 8, MBLK = 256;
constexpr int NE = 16, NCLS = 24, DE = 512, NMOD = 6 * DM;
constexpr float ALPHA = 1.41421356237309515f, LN_EPS = 1e-5f;
constexpr float QSCALE = 0.125f * 1.4426950408889634f;
constexpr int LISTCAP = NTOK;

constexpr size_t MiB = 1u << 20;
constexpr size_t WS_CTL = 0, CTL_ZERO_BYTES = 1 * MiB;
constexpr size_t WS_MOD = 1 * MiB;
constexpr size_t WS_ROPE = 2 * MiB;
constexpr size_t WS_KBAR = 2 * MiB + 256 * 1024;
constexpr size_t WS_LIST = 3 * MiB;
constexpr size_t WS_RW = 6 * MiB;
constexpr size_t WS_WIN = 12 * MiB;
constexpr size_t WS_WOUT = 20 * MiB;
constexpr size_t WS_WGU = 24 * MiB;
constexpr size_t WS_WD = 88 * MiB;
constexpr size_t WS_HB = 120 * MiB;
constexpr size_t WS_QKVP = 184 * MiB;
constexpr size_t WS_AD = 312 * MiB;
constexpr size_t WS_X1 = 376 * MiB;
constexpr size_t WS_END = 504 * MiB;
constexpr int CW_TMO = 0, CW_CNT = 64;

typedef unsigned short bf16_t;
typedef short bf16x8 __attribute__((ext_vector_type(8)));
typedef float f32x4 __attribute__((ext_vector_type(4)));
typedef float f32x16 __attribute__((ext_vector_type(16)));
typedef unsigned u32x4 __attribute__((ext_vector_type(4)));
typedef unsigned u32x2 __attribute__((ext_vector_type(2)));

#define DEVFN __device__ __forceinline__
#define LDS_WAIT() asm volatile("s_waitcnt lgkmcnt(0)" ::: "memory")
#define RLX_AGENT __ATOMIC_RELAXED, __HIP_MEMORY_SCOPE_AGENT

DEVFN float bf_lo(unsigned w) { return __uint_as_float(w << 16); }
DEVFN float bf_hi(unsigned w) { return __uint_as_float(w & 0xffff0000u); }
DEVFN float bf2f(bf16_t v) { return __uint_as_float((unsigned)v << 16); }
DEVFN unsigned f2bf(float f) { unsigned u = __float_as_uint(f); return (u + 0x7fffu + ((u >> 16) & 1u)) >> 16; }
DEVFN unsigned pk2(float lo, float hi) { unsigned r; asm("v_cvt_pk_bf16_f32 %0, %1, %2" : "=v"(r) : "v"(lo), "v"(hi)); return r; }
DEVFN unsigned pk4_fp8(float a, float b, float c, float d) {
    a = __builtin_amdgcn_fmed3f(a, -448.f, 448.f); b = __builtin_amdgcn_fmed3f(b, -448.f, 448.f); c = __builtin_amdgcn_fmed3f(c, -448.f, 448.f); d = __builtin_amdgcn_fmed3f(d, -448.f, 448.f);
    unsigned w = 0u; w = __builtin_amdgcn_cvt_pk_fp8_f32(a, b, w, false); w = __builtin_amdgcn_cvt_pk_fp8_f32(c, d, w, true); return w; }
DEVFN f32x4 f8x4_to_f32(unsigned w, float sc) { const auto lo = __builtin_amdgcn_cvt_pk_f32_fp8(w, false), hi = __builtin_amdgcn_cvt_pk_f32_fp8(w, true); return (f32x4){lo[0] * sc, lo[1] * sc, hi[0] * sc, hi[1] * sc}; }
constexpr float YSCALE = 16.f;
DEVFN int crow(int r, int hi) { return (r & 3) + 8 * (r >> 2) + 4 * hi; }
#define SWZ_XOR(m) (0x1f | ((m) << 10))
DEVFN float swz_xor_add(float v, const int m) {
    switch (m) {
        case 1: return v + __int_as_float(__builtin_amdgcn_ds_swizzle(__float_as_int(v), SWZ_XOR(1)));
        case 2: return v + __int_as_float(__builtin_amdgcn_ds_swizzle(__float_as_int(v), SWZ_XOR(2)));
        case 4: return v + __int_as_float(__builtin_amdgcn_ds_swizzle(__float_as_int(v), SWZ_XOR(4)));
        case 8: return v + __int_as_float(__builtin_amdgcn_ds_swizzle(__float_as_int(v), SWZ_XOR(8)));
        default: return v + __int_as_float(__builtin_amdgcn_ds_swizzle(__float_as_int(v), SWZ_XOR(16)));
    }
}
DEVFN float half_swap_add(float v) { auto rr = __builtin_amdgcn_permlane32_swap(__float_as_uint(v), __float_as_uint(v), false, false); return __uint_as_float(rr[0]) + __uint_as_float(rr[1]); }
DEVFN float wave_sum(float v) {
    v = swz_xor_add(v, 1); v = swz_xor_add(v, 2); v = swz_xor_add(v, 4); v = swz_xor_add(v, 8); v = swz_xor_add(v, 16);
    return half_swap_add(v);
}
__host__ __device__ __forceinline__ int inproj_lgroup(int P) { return P < 16 ? (P >> 2) * 8 + (P & 3) * 2 : ((P - 16) >> 2) * 8 + ((P - 16) & 3) * 2 + 1; }
__host__ __device__ __forceinline__ int inproj_nlog(int n) { return (n & ~255) + inproj_lgroup((n & 255) >> 3) * 8 + (n & 7); }

#define GAS __attribute__((address_space(1)))
#define LAS __attribute__((address_space(3)))
typedef GAS unsigned gu32;
namespace pg8 {
#define PG8_LAS __attribute__((address_space(3)))
typedef unsigned short bf16_t;
typedef short bf16x8 __attribute__((ext_vector_type(8)));
typedef float f32x4 __attribute__((ext_vector_type(4)));
typedef unsigned u32x4 __attribute__((ext_vector_type(4)));
constexpr int BM = 256, BK = 64, HALF = 128, HTB = HALF * BK * 2  , STAGE_BYTES = 8 * HTB, NXCD = 8, WGM = 8;

__host__ __device__ __forceinline__ int lds_byte(int r, int c) { const int st = (r >> 4) * 2 + (c >> 5), rr = r & 15, cc = c & 31, ob = rr * 64 + cc * 2; return st * 1024 + (ob ^ (((ob >> 9) & 1) << 5)); }
__host__ __device__ __forceinline__ void stage_rc(int b, int& R, int& C) { const int st = b / 1024, sb = b % 1024, swz = sb ^ (((sb >> 9) & 1) << 5); R = (st >> 1) * 16 + swz / 64; C = (st & 1) * 32 + (swz % 64) / 2; }
__host__ __device__ __forceinline__ int perm32(int rho) { const int n = rho >> 4, i = rho & 15; return 8 * (i >> 2) + 4 * n + (i & 3); }

struct Unit { int pm, pn; };
struct Gemm { const bf16_t* A; const bf16_t* Bt; int M, N, K; };

struct StaticOrder {
    int nM, nN, nwg, G, c;
    __host__ __device__ void init(int M, int N, int G_, int c_) { nM = M / BM; nN = N / BM; nwg = nM * nN; G = G_; c = c_; }
    __host__ __device__ bool next(int i, Unit& u) const {
        const long L = (long)i * G + c; if (L >= nwg) return false;
        int wgid = (int)L; { const int q = nwg / NXCD, r = nwg % NXCD, xcd = wgid % NXCD, off = wgid / NXCD; wgid = (xcd < r ? xcd * (q + 1) : r * (q + 1) + (xcd - r) * q) + off; }
        const int nig = WGM * nN, gid = wgid / nig, fm = gid * WGM, gsz = (nM - fm) < WGM ? (nM - fm) : WGM;
        u.pm = fm + ((wgid % nig) % gsz); u.pn = (wgid % nig) / gsz; return true;
    }
    __device__ __forceinline__ void a_ready(const Unit&) const {}
    __device__ __forceinline__ void done(const Unit&) const {}
};

__device__ __forceinline__ unsigned cvt_pk_bf16(float lo, float hi) { unsigned r; asm volatile("v_cvt_pk_bf16_f32 %0, %1, %2" : "=v"(r) : "v"(lo), "v"(hi)); return r; }
}
namespace pg8 {
typedef int v8i_t __attribute__((ext_vector_type(8))); typedef int v4i_t __attribute__((ext_vector_type(4)));
__device__ __forceinline__ int pg8_lane_volatile() { int l; asm volatile("v_mbcnt_lo_u32_b32 %0, -1, 0\n\tv_mbcnt_hi_u32_b32 %0, -1, %0" : "=v"(l)); return l; }
template <class Epi, class Sched, bool ALIGN_EPI, bool GATHER, bool KSPLIT, bool FP8 = false, int SCW = 127, int SCA = 127, bool SC2 = false, int SCW2 = 127, int SCA2 = 127>
__device__ __forceinline__ void gemm_phase2(PG8_LAS unsigned char* lds, const int Kbytes, const int ldb_bytes, const Sched& S, const Epi& E, const int tid) {
    typedef typename Sched::UnitT UnitT;
    const int wid = __builtin_amdgcn_readfirstlane(tid >> 6), lane = tid & 63, wr = wid >> 2, wc = wid & 3, fr = lane & 15, fq = lane >> 4;
    int nt = Kbytes / (BK * 2); asm volatile("" : "+s"(nt));
    const int nth = nt / 2;
    unsigned voffB[2];
#pragma unroll
    for (int i = 0; i < 2; ++i) { int R[2], C[2]; stage_rc(tid * 16 + i * 8192, R[i], C[i]); const int Rb = Epi::PERM ? ((R[i] & ~31) + perm32(R[i] & 31)) : R[i]; voffB[i] = (unsigned)(Rb * ldb_bytes + C[i] * 2); }
    const size_t kstep = (size_t)(BK * 2);
    const size_t hstepB = (size_t)HALF * ldb_bytes;
    const unsigned ldsw = (unsigned)wid * 1024u;
    const int aoff = lds_byte(wr * 64 + fr, fq * 8), boff = lds_byte(wc * 32 + fr, fq * 8);
#define PG8_SA(b, h) (((b) * 2 + (h)) * HTB)
#define PG8_SB(b, h) ((4 + (b) * 2 + (h)) * HTB)
#define PG8_STAGE(bufoff, gbase, voff) do { _Pragma("unroll") for (int _i = 0; _i < 2; ++_i) \
        __builtin_amdgcn_global_load_lds((const unsigned*)((const char*)(gbase) + (voff)[_i]), (PG8_LAS unsigned*)(lds + (bufoff) + ldsw + _i * 8192), 16, 0, 0); } while (0)
#define PG8_LDA(dst, b, h) do { _Pragma("unroll") for (int m = 0; m < 4; ++m) _Pragma("unroll") for (int k = 0; k < 2; ++k) dst[m][k] = *(const PG8_LAS bf16x8*)(lds + PG8_SA(b, h) + aoff + m * 2048 + k * 1024); } while (0)
#define PG8_LDB(dst, b, h) do { _Pragma("unroll") for (int n = 0; n < 2; ++n) _Pragma("unroll") for (int k = 0; k < 2; ++k) dst[n][k] = *(const PG8_LAS bf16x8*)(lds + PG8_SB(b, h) + boff + n * 2048 + k * 1024); } while (0)
#define PG8_CAT8(x) __builtin_shufflevector(__builtin_bit_cast(v4i_t, (x)[0]), __builtin_bit_cast(v4i_t, (x)[1]), 0, 1, 2, 3, 4, 5, 6, 7)
#define PG8_MMA(ai, bj, At, Bt) do { __builtin_amdgcn_s_setprio(1); \
        if constexpr (FP8) { _Pragma("unroll") for (int m = 0; m < 4; ++m) _Pragma("unroll") for (int n = 0; n < 2; ++n) \
            acc[ai][bj][m][n] = __builtin_amdgcn_mfma_scale_f32_16x16x128_f8f6f4(PG8_CAT8(Bt[n]), PG8_CAT8(At[m]), acc[ai][bj][m][n], 0, 0, 0, scw_, 0, sca_); } \
        else { _Pragma("unroll") for (int m = 0; m < 4; ++m) _Pragma("unroll") for (int n = 0; n < 2; ++n) _Pragma("unroll") for (int k = 0; k < 2; ++k) \
            acc[ai][bj][m][n] = __builtin_amdgcn_mfma_f32_16x16x32_bf16(Bt[n][k], At[m][k], acc[ai][bj][m][n], 0, 0, 0); } \
        __builtin_amdgcn_s_setprio(0); } while (0)
#define PG8_STAGE1(bufoff, gbase, voff, _i) __builtin_amdgcn_global_load_lds((const unsigned*)((const char*)(gbase) + (voff)[_i]), (PG8_LAS unsigned*)(lds + (bufoff) + ldsw + (_i) * 8192), 16, 0, 0)
#define PG8_MF(ai, bj, m, n, At, Bt) do { if constexpr (FP8) acc[ai][bj][m][n] = __builtin_amdgcn_mfma_scale_f32_16x16x128_f8f6f4(PG8_CAT8(Bt[n]), PG8_CAT8(At[m]), acc[ai][bj][m][n], 0, 0, 0, scw_, 0, sca_); \
        else { acc[ai][bj][m][n] = __builtin_amdgcn_mfma_f32_16x16x32_bf16(Bt[n][0], At[m][0], acc[ai][bj][m][n], 0, 0, 0); acc[ai][bj][m][n] = __builtin_amdgcn_mfma_f32_16x16x32_bf16(Bt[n][1], At[m][1], acc[ai][bj][m][n], 0, 0, 0); } } while (0)
#define PG8_MF2(ai, bj, m, At, Bt) do { PG8_MF(ai, bj, m, 0, At, Bt); PG8_MF(ai, bj, m, 1, At, Bt); PG8_SCHED; } while (0)
#define PG8_CL1(ai, At, S0) do { __builtin_amdgcn_s_setprio(1); PG8_MF2(ai, 0, 0, At, B0); PG8_MF2(ai, 0, 1, At, B0); S0(0); PG8_SCHED; PG8_MF2(ai, 0, 2, At, B0); PG8_MF2(ai, 0, 3, At, B0); S0(1); PG8_SCHED; \
        PG8_MF2(ai, 1, 0, At, B1); PG8_MF2(ai, 1, 1, At, B1); PG8_MF2(ai, 1, 2, At, B1); PG8_MF2(ai, 1, 3, At, B1); __builtin_amdgcn_s_setprio(0); } while (0)
#define PG8_CL2(ai, At, S0, S1, S2) do { __builtin_amdgcn_s_setprio(1); PG8_MF2(ai, 0, 0, At, B0); S0(0); PG8_SCHED; PG8_MF2(ai, 0, 1, At, B0); S0(1); PG8_SCHED; PG8_MF2(ai, 0, 2, At, B0); S1(0); PG8_SCHED; PG8_MF2(ai, 0, 3, At, B0); S1(1); PG8_SCHED; \
        PG8_MF2(ai, 1, 0, At, B1); S2(0); PG8_SCHED; PG8_MF2(ai, 1, 1, At, B1); S2(1); PG8_SCHED; PG8_MF2(ai, 1, 2, At, B1); PG8_MF2(ai, 1, 3, At, B1); __builtin_amdgcn_s_setprio(0); } while (0)
#define PG8_WAIT_V(n) asm volatile("s_waitcnt vmcnt(" #n ")" ::: "memory")
#define PG8_WAIT_L(n) asm volatile("s_waitcnt lgkmcnt(" #n ")" ::: "memory")
#define PG8_BAR __builtin_amdgcn_s_barrier()
#define PG8_SCHED __builtin_amdgcn_sched_barrier(0)
#define PG8_PIN(ai) asm volatile("" :: "v"(acc[ai][0][0][0]), "v"(acc[ai][0][0][1]), "v"(acc[ai][0][1][0]), "v"(acc[ai][0][1][1]), "v"(acc[ai][0][2][0]), "v"(acc[ai][0][2][1]), "v"(acc[ai][0][3][0]), "v"(acc[ai][0][3][1]), \
        "v"(acc[ai][1][0][0]), "v"(acc[ai][1][0][1]), "v"(acc[ai][1][1][0]), "v"(acc[ai][1][1][1]), "v"(acc[ai][1][2][0]), "v"(acc[ai][1][2][1]), "v"(acc[ai][1][3][0]), "v"(acc[ai][1][3][1]))
#define PG8_BK(cb, cb2, kt) ((KSPLIT && (kt) >= nth) ? (cb2) + (size_t)((kt) - nth) * kstep : (cb) + (size_t)(kt) * kstep)
    UnitT cur, nxt; int ui = 0;
    if (!S.next(0, cur)) return;
    f32x4 acc[2][2][4][2];
#pragma unroll
    for (int a = 0; a < 2; ++a)
#pragma unroll
        for (int b = 0; b < 2; ++b)
#pragma unroll
            for (int m = 0; m < 4; ++m)
#pragma unroll
                for (int n = 0; n < 2; ++n) acc[a][b][m][n] = (f32x4){0.f, 0.f, 0.f, 0.f};
    bf16x8 At[4][2], B0[2][2], B1[2][2];
    unsigned vA[2][2];
    S.arows(cur, tid, vA);
    PG8_LAS u32x4* const vslot = (PG8_LAS u32x4*)(lds + STAGE_BYTES + 2048) + tid;
    const char* cA = S.aptr(cur); const char* cB = S.bptr(cur); const char* cB2 = KSPLIT ? S.bptr2(cur) : cB;
    PG8_STAGE(PG8_SB(0, 0), cB, voffB); PG8_STAGE(PG8_SB(0, 1), cB + hstepB, voffB); PG8_STAGE(PG8_SA(0, 0), cA, vA[0]); PG8_STAGE(PG8_SA(0, 1), cA, vA[1]);
    if (wr == 1) PG8_BAR;
    PG8_WAIT_V(2); PG8_BAR;
    PG8_STAGE(PG8_SB(1, 0), PG8_BK(cB, cB2, 1), voffB); PG8_STAGE(PG8_SA(1, 0), cA + kstep, vA[0]); PG8_STAGE(PG8_SB(1, 1), PG8_BK(cB, cB2, 1) + hstepB, voffB);
    PG8_WAIT_V(6); PG8_BAR;
    for (;;) {
        const bool has_next = S.next(ui + 1, nxt);
        const char* nA = has_next ? S.aptr(nxt) : cA; const char* nB = has_next ? S.bptr(nxt) : cB; const char* nB2 = (KSPLIT && has_next) ? S.bptr2(nxt) : cB2;
        if (GATHER && has_next) { unsigned vn_[2][2]; S.arows(nxt, wid * 64 + pg8_lane_volatile(), vn_); *vslot = (u32x4){vn_[0][0], vn_[0][1], vn_[1][0], vn_[1][1]}; }
        for (int t = 0; t < nt; t += 2) {
            const bool last = (t == nt - 2);
            const int scw_ = ((SC2 && t >= nth) ? SCW2 : SCW) * 0x01010101, sca_ = ((SC2 && t >= nth) ? SCA2 : SCA) * 0x01010101; (void)scw_; (void)sca_;
            const char* a1 = cA + (size_t)(t + 1) * kstep;
            const char* a2 = last ? nA : cA + (size_t)(t + 2) * kstep;
            const char* b2 = last ? nB : PG8_BK(cB, cB2, t + 2);
            const char* b3 = last ? (KSPLIT ? PG8_BK(nB, nB2, 1) : nB + kstep) : PG8_BK(cB, cB2, t + 3);
            const char* a3 = a2 + kstep;
#define ST_A11(i) PG8_STAGE1(PG8_SA(1, 1), a1, vA[1], i)
#define ST_B00(i) PG8_STAGE1(PG8_SB(0, 0), b2, voffB, i)
#define ST_B01(i) PG8_STAGE1(PG8_SB(0, 1), b2 + hstepB, voffB, i)
#define ST_A00(i) PG8_STAGE1(PG8_SA(0, 0), a2, vA[0], i)
#define ST_A01(i) PG8_STAGE1(PG8_SA(0, 1), a2, vA[1], i)
#define ST_B10(i) PG8_STAGE1(PG8_SB(1, 0), b3, voffB, i)
#define ST_B11(i) PG8_STAGE1(PG8_SB(1, 1), b3 + hstepB, voffB, i)
#define ST_A10(i) PG8_STAGE1(PG8_SA(1, 0), a3, vA[0], i)
            PG8_LDB(B0, 0, 0); PG8_LDB(B1, 0, 1); PG8_SCHED; PG8_LDA(At, 0, 0);
            PG8_WAIT_V(6); PG8_WAIT_L(0); PG8_BAR; PG8_CL1(0, At, ST_A11); PG8_PIN(0); PG8_BAR; PG8_SCHED;
            if (GATHER && last && has_next) { const u32x4 vn_ = *vslot; vA[0][0] = vn_.x; vA[0][1] = vn_.y; vA[1][0] = vn_.z; vA[1][1] = vn_.w; }
            PG8_LDA(At, 0, 1);
            PG8_WAIT_V(2); PG8_WAIT_L(0); PG8_BAR; PG8_CL2(1, At, ST_B00, ST_B01, ST_A00); PG8_PIN(1); PG8_BAR; PG8_SCHED;
            PG8_LDB(B0, 1, 0); PG8_LDB(B1, 1, 1); PG8_SCHED; PG8_LDA(At, 1, 0);
            PG8_WAIT_V(6); PG8_WAIT_L(0); PG8_BAR; PG8_CL1(0, At, ST_A01); PG8_PIN(0); PG8_BAR; PG8_SCHED;
            PG8_LDA(At, 1, 1);
            PG8_WAIT_V(2); PG8_WAIT_L(0); PG8_BAR; PG8_CL2(1, At, ST_B10, ST_B11, ST_A10); PG8_PIN(1); PG8_BAR; PG8_SCHED;
#undef ST_A11
#undef ST_B00
#undef ST_B01
#undef ST_A00
#undef ST_A01
#undef ST_B10
#undef ST_B11
#undef ST_A10
        }
        if constexpr (ALIGN_EPI) { if (wr == 0) PG8_BAR; }
        if constexpr (!Epi::AFTER_DRAIN) { const int le_ = pg8_lane_volatile(); E(acc, cur, wr, wc, le_ & 15, le_ >> 4); }
        if (!has_next) break;
#pragma unroll
        for (int a = 0; a < 2; ++a)
#pragma unroll
            for (int b = 0; b < 2; ++b)
#pragma unroll
                for (int m = 0; m < 4; ++m)
#pragma unroll
                    for (int n = 0; n < 2; ++n) acc[a][b][m][n] = (f32x4){0.f, 0.f, 0.f, 0.f};
        cur = nxt; cA = nA; cB = nB; cB2 = nB2; ++ui;
        if constexpr (ALIGN_EPI) { if (wr == 1) PG8_BAR; }
    }
    PG8_WAIT_V(0);
    if constexpr (!ALIGN_EPI) { if (wr == 0) PG8_BAR; }
    PG8_BAR;
    if constexpr (Epi::AFTER_DRAIN) { E.fused(acc, cur, wr, wc, fr, fq, lds, wid, lane); }
#undef PG8_SA
#undef PG8_SB
#undef PG8_STAGE
#undef PG8_LDA
#undef PG8_LDB
#undef PG8_MMA
#undef PG8_WAIT_V
#undef PG8_WAIT_L
#undef PG8_BAR
#undef PG8_SCHED
#undef PG8_BK
#undef PG8_PIN
#undef PG8_STAGE1
#undef PG8_MF
#undef PG8_MF2
#undef PG8_CL1
#undef PG8_CL2
#undef PG8_CAT8
}
}
namespace pg8 {
DEVFN unsigned pkbf(float lo, float hi) { return cvt_pk_bf16(lo, hi); }
struct DenseSched {
    typedef Unit UnitT;
    StaticOrder so; const char* A; const char* Bt; int lda, ldb;
    DEVFN bool next(int i, Unit& u) const { return so.next(i, u); }
    DEVFN const char* aptr(const Unit&) const { return A; }
    DEVFN void arows(const Unit& u, const int tid_, unsigned (&v)[2][2]) const {
        int R[2], C[2]; { int t_ = tid_; asm volatile("" : "+v"(t_)); stage_rc(t_ * 16, R[0], C[0]); stage_rc(t_ * 16 + 8192, R[1], C[1]); }
#pragma unroll
        for (int h = 0; h < 2; ++h)
#pragma unroll
            for (int i = 0; i < 2; ++i) v[h][i] = (unsigned)((u.pm * BM + h * HALF + R[i]) * lda + C[i] * 2); }
    DEVFN const char* bptr(const Unit& u) const { return Bt + (size_t)u.pn * BM * ldb; }
    DEVFN const char* bptr2(const Unit& u) const { return bptr(u); }
};
struct EpiInproj {
    static constexpr bool PERM = true, AFTER_DRAIN = false;
    bf16_t* O; const float* rope; float* kbar;
    DEVFN void operator()(f32x4 (&acc)[2][2][4][2], const Unit& u, int wr, int wc, int fr, int fq) const {
        const int pn = u.pn, row0 = u.pm * BM + wr * 64 + fr;
        if (pn < 4 && fq == 0) {
#pragma unroll
            for (int ai = 0; ai < 2; ++ai)
#pragma unroll
                for (int m = 0; m < 4; ++m) { const int t = (row0 + ai * HALF + m * 16) & (SEQ - 1); const f32x4* rp = (const f32x4*)(rope + t * 16);
#pragma unroll
                    for (int q = 0; q < 4; ++q) { const f32x4 cs = rp[q];
                        { const int d = 2 * q, n = d >> 2, e = d & 3; const float x1 = acc[ai][0][m][n][e], x2 = acc[ai][1][m][n][e]; acc[ai][0][m][n][e] = x1 * cs[0] - x2 * cs[1]; acc[ai][1][m][n][e] = x2 * cs[0] + x1 * cs[1]; }
                        { const int d = 2 * q + 1, n = d >> 2, e = d & 3; const float x1 = acc[ai][0][m][n][e], x2 = acc[ai][1][m][n][e]; acc[ai][0][m][n][e] = x1 * cs[2] - x2 * cs[3]; acc[ai][1][m][n][e] = x2 * cs[2] + x1 * cs[3]; } } }
        }
        if (pn == 2 || pn == 3) {
            float* kb = kbar + (size_t)((((u.pm >> 3) * NH + (pn - 2) * 4 + wc) * NBLK + (u.pm & 7)) * HD);
#pragma unroll
            for (int bj = 0; bj < 2; ++bj)
#pragma unroll
                for (int n = 0; n < 2; ++n)
#pragma unroll
                    for (int e = 0; e < 4; ++e) { float s = 0.f;
#pragma unroll
                        for (int ai = 0; ai < 2; ++ai)
#pragma unroll
                            for (int m = 0; m < 4; ++m) s += acc[ai][bj][m][n][e];
                        s = swz_xor_add(s, 1); s = swz_xor_add(s, 2); s = swz_xor_add(s, 4); s = swz_xor_add(s, 8);
                        if (fr == 0) atomicAdd(kb + (2 * fq + bj) * 8 + 4 * n + e, s * (1.f / MBLK)); }
        }
        if (pn < 2) {
#pragma unroll
            for (int ai = 0; ai < 2; ++ai)
#pragma unroll
                for (int bj = 0; bj < 2; ++bj)
#pragma unroll
                    for (int m = 0; m < 4; ++m) { acc[ai][bj][m][0] = acc[ai][bj][m][0] * QSCALE; acc[ai][bj][m][1] = acc[ai][bj][m][1] * QSCALE; } }
#pragma unroll
        for (int ai = 0; ai < 2; ++ai)
#pragma unroll
            for (int m = 0; m < 4; ++m) { bf16_t* rowp = O + (size_t)(row0 + ai * HALF + m * 16) * DIN + pn * BM + wc * 64;
#pragma unroll
                for (int bj = 0; bj < 2; ++bj) { const f32x4 v0 = acc[ai][bj][m][0], v1 = acc[ai][bj][m][1];
                    u32x4 w; w.x = pkbf(v0[0], v0[1]); w.y = pkbf(v0[2], v0[3]); w.z = pkbf(v1[0], v1[1]); w.w = pkbf(v1[2], v1[3]);
                    *(u32x4*)(rowp + (2 * fq + bj) * 8) = w; } }
    }
};
struct EpiF8 {
    static constexpr bool PERM = true, AFTER_DRAIN = false;
    unsigned char* O; int ldc;
    DEVFN void operator()(f32x4 (&acc)[2][2][4][2], const Unit& u, int wr, int wc, int fr, int fq) const {
#pragma unroll
        for (int ai = 0; ai < 2; ++ai)
#pragma unroll
            for (int m = 0; m < 4; ++m) { unsigned char* rowp = O + (size_t)(u.pm * BM + ai * HALF + wr * 64 + m * 16 + fr) * ldc + u.pn * BM + wc * 32 + fq * 8;
#pragma unroll
                for (int bj = 0; bj < 2; ++bj) { const f32x4 v0 = acc[ai][bj][m][0], v1 = acc[ai][bj][m][1];
                    u32x2 w; w.x = pk4_fp8(v0[0], v0[1], v0[2], v0[3]); w.y = pk4_fp8(v1[0], v1[1], v1[2], v1[3]);
                    *(u32x2*)(rowp + bj * HALF) = w; } }
    }
};
struct MoeUnit { int pm, pn, cls, j, cnt; };
struct MoeBase {
    const PG8_LAS int* tp; const PG8_LAS int* cnt; const PG8_LAS int* tcls; int nunits, G, c, npn_shift;
    DEVFN bool next_(int i, MoeUnit& u) const {
        const int L = i * G + c; if (L >= nunits) return false;
        u.pm = L >> npn_shift; u.pn = L & ((1 << npn_shift) - 1);
        const int cls = __builtin_amdgcn_readfirstlane(tcls[u.pm]);
        u.cls = cls; u.j = u.pm - __builtin_amdgcn_readfirstlane(tp[cls]); u.cnt = __builtin_amdgcn_readfirstlane(cnt[cls]); return true; }
};
DEVFN void moe_experts(int cls, int& e1, int& e2) { const int g = cls / 6, p = cls % 6; const int lo = p < 3 ? 0 : (p < 5 ? 1 : 2), hi = p < 3 ? p + 1 : (p < 5 ? p - 1 : 3); e1 = g * 4 + lo; e2 = g * 4 + hi; }
struct GateUpSched : MoeBase {
    typedef MoeUnit UnitT;
    const char* HB; const int* list; const char* W;
    DEVFN bool next(int i, MoeUnit& u) const { return next_(i, u); }
    DEVFN const char* aptr(const MoeUnit&) const { return HB; }
    DEVFN void arows(const MoeUnit& u, const int tid_, unsigned (&v)[2][2]) const {
        int R[2], C[2]; { int t_ = tid_; asm volatile("" : "+v"(t_)); stage_rc(t_ * 16, R[0], C[0]); stage_rc(t_ * 16 + 8192, R[1], C[1]); }
#pragma unroll
        for (int h = 0; h < 2; ++h)
#pragma unroll
            for (int i = 0; i < 2; ++i) { const int li = 256 * u.j + h * HALF + R[i]; const int tok = list[(size_t)u.cls * LISTCAP + (li < u.cnt ? li : 256 * u.j)]; v[h][i] = (unsigned)(tok * DM + C[i] * 2); } }
    DEVFN const char* bptr(const MoeUnit& u) const { int e1, e2; moe_experts(u.cls, e1, e2); return W + (size_t)(u.pn < 4 ? e1 : e2) * DM * DM + (size_t)(u.pn & 3) * BM * DM; }
    DEVFN const char* bptr2(const MoeUnit& u) const { return bptr(u); }
};
struct DownSched : MoeBase {
    typedef MoeUnit UnitT;
    const char* ACT; const char* W;
    DEVFN bool next(int i, MoeUnit& u) const { return next_(i, u); }
    DEVFN const char* aptr(const MoeUnit&) const { return ACT; }
    DEVFN void arows(const MoeUnit& u, const int tid_, unsigned (&v)[2][2]) const {
        int R[2], C[2]; { int t_ = tid_; asm volatile("" : "+v"(t_)); stage_rc(t_ * 16, R[0], C[0]); stage_rc(t_ * 16 + 8192, R[1], C[1]); }
#pragma unroll
        for (int h = 0; h < 2; ++h)
#pragma unroll
            for (int i = 0; i < 2; ++i) v[h][i] = (unsigned)((u.pm * BM + h * HALF + R[i]) * DM + C[i] * 2); }
    DEVFN const char* bptr(const MoeUnit& u) const { int e1, e2; moe_experts(u.cls, e1, e2); return W + (size_t)e1 * DM * DE + (size_t)u.pn * BM * DE; }
    DEVFN const char* bptr2(const MoeUnit& u) const { int e1, e2; moe_experts(u.cls, e1, e2); return W + (size_t)e2 * DM * DE + (size_t)u.pn * BM * DE; }
};
struct EpiGateUp {
    static constexpr bool PERM = true, AFTER_DRAIN = false;
    unsigned char* ACT; const float* rw;
    DEVFN void operator()(f32x4 (&acc)[2][2][4][2], const MoeUnit& u, int wr, int wc, int fr, int fq) const {
        const int half = u.pn >> 2, jt = u.pn & 3;
        float wg8[2][4];
#pragma unroll
        for (int ai = 0; ai < 2; ++ai)
#pragma unroll
            for (int m = 0; m < 4; ++m) { const int li = 256 * u.j + ai * HALF + wr * 64 + m * 16 + fr; wg8[ai][m] = rw[((size_t)u.cls * LISTCAP + (li < u.cnt ? li : 256 * u.j)) * 2 + half]; }
#pragma unroll
        for (int ai = 0; ai < 2; ++ai)
#pragma unroll
            for (int m = 0; m < 4; ++m) { const int lr = ai * HALF + wr * 64 + m * 16 + fr, li = 256 * u.j + lr;
                const float wgt = li < u.cnt ? 8.f * wg8[ai][m] : 0.f;
                f32x4 o[2];
#pragma unroll
                for (int n = 0; n < 2; ++n) {
                    const f32x4 g = acc[ai][0][m][n], t = g * (-1.4426950408889634f);
                    f32x4 d; d.x = __builtin_amdgcn_exp2f(t.x); d.y = __builtin_amdgcn_exp2f(t.y); d.z = __builtin_amdgcn_exp2f(t.z); d.w = __builtin_amdgcn_exp2f(t.w);
                    d = d + 1.f;
                    f32x4 r; r.x = __builtin_amdgcn_rcpf(d.x); r.y = __builtin_amdgcn_rcpf(d.y); r.z = __builtin_amdgcn_rcpf(d.z); r.w = __builtin_amdgcn_rcpf(d.w);
                    o[n] = (g * r) * (acc[ai][1][m][n] * wgt); }
                u32x2 w; w.x = pk4_fp8(o[0][0], o[0][1], o[0][2], o[0][3]); w.y = pk4_fp8(o[1][0], o[1][1], o[1][2], o[1][3]);
                *(u32x2*)(ACT + (size_t)(u.pm * BM + lr) * DM + half * 512 + jt * 128 + wc * 32 + fq * 8) = w; }
    }
};
struct EpiDown {
    static constexpr bool PERM = true, AFTER_DRAIN = false;
    unsigned char* Y2; const int* list;
    DEVFN void operator()(f32x4 (&acc)[2][2][4][2], const MoeUnit& u, int wr, int wc, int fr, int fq_) const {
        int fq = fq_; asm volatile("" : "+v"(fq));
        int tk8[2][4];
#pragma unroll
        for (int ai = 0; ai < 2; ++ai)
#pragma unroll
            for (int m = 0; m < 4; ++m) { const int li = 256 * u.j + ai * HALF + wr * 64 + m * 16 + fr; tk8[ai][m] = list[(size_t)u.cls * LISTCAP + (li < u.cnt ? li : 256 * u.j)]; }
#pragma unroll
        for (int ai = 0; ai < 2; ++ai)
#pragma unroll
            for (int m = 0; m < 4; ++m) { const int li = 256 * u.j + ai * HALF + wr * 64 + m * 16 + fr;
                if (li < u.cnt) { const int tok = tk8[ai][m]; unsigned char* rowp = Y2 + (size_t)tok * DM + u.pn * BM + wc * 32 + fq * 8;
#pragma unroll
                    for (int bj = 0; bj < 2; ++bj) { const f32x4 v0 = acc[ai][bj][m][0], v1 = acc[ai][bj][m][1];
                        u32x2 w; w.x = pk4_fp8(v0[0], v0[1], v0[2], v0[3]); w.y = pk4_fp8(v1[0], v1[1], v1[2], v1[3]);
                        *(u32x2*)(rowp + bj * HALF) = w; } } }
    }
};
}

#include <hip/hip_bf16.h>
#include <cmath>
namespace attn_body {
using bf16=__hip_bfloat16;
using bf16x8=__attribute__((ext_vector_type(8)))short;
using s16x4=__attribute__((ext_vector_type(4)))short;
using f32x16=__attribute__((ext_vector_type(16)))float;
using u32x4=__attribute__((ext_vector_type(4)))unsigned;
constexpr int BATCH=16,NHEAD=8,SEQ=2048,D=64,QP=2048,OP=1024;
constexpr int NW=8,QBLK=32,QB=QBLK*NW,KVBLK=64,NQB=SEQ/QB;
constexpr int ATTN_PITCH=QP, ATTN_UNIT_ROWS=QB;
__device__ __forceinline__ int crow(int r,int hi){return (r&3)+8*(r>>2)+4*hi;}
#define SBAR() __builtin_amdgcn_sched_barrier(0)
__device__ __forceinline__ void cmask(f32x16&p0,f32x16&p1,int jb,int qrel,int hi){
  const float NEG=-INFINITY; int kb=64*jb+4*hi;
  #pragma unroll
  for(int r=0;r<16;++r){int kv=kb+(r&3)+8*(r>>2); if(kv>qrel)p0[r]=NEG; if(kv+32>qrel)p1[r]=NEG;}
}

constexpr int NSLOT=3, SLOTB=8192;
constexpr int LDS_K=0, LDS_V=NSLOT*SLOTB, LDS_WS=2*NSLOT*SLOTB, LDS_OST=LDS_WS+NW*64*4, LDS_KBAR=LDS_OST+NW*4096, LDS_BYTES=LDS_KBAR+2048;
constexpr float NEGBIG=-1.0e30f; typedef float f32x4_t __attribute__((ext_vector_type(4)));
__device__ __forceinline__ float bfs(short v){return __uint_as_float(((unsigned)(unsigned short)v)<<16);}
constexpr float C2=0.125f*1.4426950408889634f;
__device__ __forceinline__ void glds16(const void*gsrc,unsigned lds_dst){unsigned keep;
  asm volatile("s_mov_b32 %0, m0\n\ts_mov_b32 m0, %2\n\ts_nop 0\n\tglobal_load_lds_dwordx4 %1, off\n\ts_mov_b32 m0, %0":"=&s"(keep):"v"(gsrc),"s"(lds_dst):"memory");}
__device__ __forceinline__ float max3f(float a,float b,float c){float r;asm("v_max3_f32 %0, %1, %2, %3":"=v"(r):"v"(a),"v"(b),"v"(c));return r;}
__device__ __forceinline__ float max2f(float a,float b){float r;asm("v_max_f32_e32 %0, %1, %2":"=v"(r):"v"(a),"v"(b));return r;}
__device__ __forceinline__ float fadd_s(float a,float b){float r;asm("v_add_f32_e32 %0, %1, %2":"=v"(r):"v"(a),"v"(b));return r;}
__device__ __forceinline__ float fsub_s(float a,float b){float r;asm("v_sub_f32_e32 %0, %1, %2":"=v"(r):"v"(a),"v"(b));return r;}
typedef float f32x2_t __attribute__((ext_vector_type(2))); typedef __bf16 bf16x2_t __attribute__((ext_vector_type(2)));
__device__ __forceinline__ unsigned cvtpk_s(float lo,float hi){f32x2_t v={lo,hi};bf16x2_t b=__builtin_convertvector(v,bf16x2_t);return __builtin_bit_cast(unsigned,b);}
#define WAIT_BAR(N) asm volatile("s_waitcnt vmcnt(" #N ") lgkmcnt(0)\n\ts_barrier":::"memory")

__device__ __forceinline__ void qkt(f32x16&p0,f32x16&p1,const char*Kslot,const bf16x8*qr,const f32x16&negm,int r32,int hi){
  const char*kb=Kslot+hi*1024+r32*16;
  #pragma unroll
  for(int d0=0;d0<4;++d0){
    const bf16x8 b0=*reinterpret_cast<const bf16x8*>(kb+d0*2048);
    const bf16x8 b1=*reinterpret_cast<const bf16x8*>(kb+d0*2048+512);
    if(d0==0){p0=__builtin_amdgcn_mfma_f32_32x32x16_bf16(b0,qr[0],negm,0,0,0);p1=__builtin_amdgcn_mfma_f32_32x32x16_bf16(b1,qr[0],negm,0,0,0);}
    else{p0=__builtin_amdgcn_mfma_f32_32x32x16_bf16(b0,qr[d0],p0,0,0,0);p1=__builtin_amdgcn_mfma_f32_32x32x16_bf16(b1,qr[d0],p1,0,0,0);}}
}
typedef __attribute__((address_space(3))) const char* lds_cptr;
typedef short v4i16_t __attribute__((ext_vector_type(4)));
__device__ __forceinline__ void kload8(bf16x8*kf,lds_cptr kp){
  kf[0]=*(const __attribute__((address_space(3))) bf16x8*)(kp);      kf[1]=*(const __attribute__((address_space(3))) bf16x8*)(kp+512);
  kf[2]=*(const __attribute__((address_space(3))) bf16x8*)(kp+2048); kf[3]=*(const __attribute__((address_space(3))) bf16x8*)(kp+2560);
  kf[4]=*(const __attribute__((address_space(3))) bf16x8*)(kp+4096); kf[5]=*(const __attribute__((address_space(3))) bf16x8*)(kp+4608);
  kf[6]=*(const __attribute__((address_space(3))) bf16x8*)(kp+6144); kf[7]=*(const __attribute__((address_space(3))) bf16x8*)(kp+6656);
}
__device__ __forceinline__ void kload2(bf16x8*kf,lds_cptr kp,int j){ kf[2*j]=*(const __attribute__((address_space(3))) bf16x8*)(kp+j*2048); kf[2*j+1]=*(const __attribute__((address_space(3))) bf16x8*)(kp+j*2048+512); }
__device__ __forceinline__ s16x4 vtr(lds_cptr p){ return __builtin_bit_cast(s16x4,__builtin_amdgcn_ds_read_tr16_b64_v4i16((__attribute__((address_space(3))) v4i16_t*)p)); }
__device__ __forceinline__ float rowmax(const f32x16&p0,const f32x16&p1){
  float a=max3f(p0[0],p0[1],p1[0]),b=max3f(p0[2],p0[3],p1[1]);a=max3f(a,p1[2],p1[3]);
  #pragma unroll
  for(int r=4;r<16;r+=4){a=max3f(a,p0[r],p0[r+1]);b=max3f(b,p0[r+2],p0[r+3]);a=max3f(a,p1[r],p1[r+1]);b=max3f(b,p1[r+2],p1[r+3]);}
  const float m=max2f(a,b);
  auto rr=__builtin_amdgcn_permlane32_swap(__float_as_uint(m),__float_as_uint(m),false,false);
  return max2f(__uint_as_float(rr[0]),__uint_as_float(rr[1]));
}
__device__ __forceinline__ void pv(f32x16*o,int vb,bf16x8 pa0,bf16x8 pa1,bf16x8 pa2,bf16x8 pa3){
  #pragma unroll
  for(int d0=0;d0<2;++d0){s16x4 lo[4],hi[4];
    #pragma unroll
    for(int ks=0;ks<4;++ks){
      asm volatile("ds_read_b64_tr_b16 %0,%1 offset:%c2":"=&v"(lo[ks]):"v"(vb),"i"(d0*4096+ks*1024):"memory");
      asm volatile("ds_read_b64_tr_b16 %0,%1 offset:%c2":"=&v"(hi[ks]):"v"(vb),"i"(d0*4096+ks*1024+512):"memory");}
    asm volatile("s_waitcnt lgkmcnt(0)":::"memory");SBAR();
    #define PK(k) (bf16x8){lo[k][0],lo[k][1],lo[k][2],lo[k][3],hi[k][0],hi[k][1],hi[k][2],hi[k][3]}
    o[d0]=__builtin_amdgcn_mfma_f32_32x32x16_bf16(pa0,PK(0),o[d0],0,0,0);
    o[d0]=__builtin_amdgcn_mfma_f32_32x32x16_bf16(pa1,PK(1),o[d0],0,0,0);
    o[d0]=__builtin_amdgcn_mfma_f32_32x32x16_bf16(pa2,PK(2),o[d0],0,0,0);
    o[d0]=__builtin_amdgcn_mfma_f32_32x32x16_bf16(pa3,PK(3),o[d0],0,0,0);
    #undef PK
  }
}

#ifndef ATTN_STORE16
#define ATTN_STORE16(p,v) (*(u32x4*)(p)=(v))
#endif
template<int THRL> __device__ __forceinline__ void attn_unit(int b,int h,int qb,const bf16*Q,const bf16*__restrict__ K,const bf16*__restrict__ V,bf16*O,const float*__restrict__ kbar,char*shm,const int tid){
  const int lane=tid&63,r32=lane&31,hi=lane>>5; const int wid=__builtin_amdgcn_readfirstlane(tid>>6);
  float kbv=0.f; { int tk=tid; asm volatile("":"+v"(tk)); if(qb>=4&&tk<448)kbv=kbar[tk]; }
  const long rowbase=(long)b*SEQ; const int q0=qb*QB;
  const bf16*Qw=Q+(rowbase+q0+wid*QBLK)*QP+h*D;
  const bf16*Kh=K+rowbase*QP+h*D,*Vh=V+rowbase*QP+h*D;
  const unsigned lds0=(unsigned)(uintptr_t)shm;
  float*wsf=(float*)(shm+LDS_WS)+wid*64;
  const bf16*ksrc=Kh+(long)lane*QP+wid*8;
  const bf16*vsrc=Vh+(long)(16*(wid&3)+(lane>>2))*QP+(wid>>2)*32+(lane&3)*8;
  const unsigned kdst=lds0+LDS_K+wid*1024, vdst=lds0+LDS_V+wid*1024;
  #define DMA_K(t,slot) glds16(ksrc+(long)(t)*KVBLK*QP,(unsigned)__builtin_amdgcn_readfirstlane(kdst+(slot)))
  #define DMA_V(t,slot) glds16(vsrc+(long)(t)*KVBLK*QP,(unsigned)__builtin_amdgcn_readfirstlane(vdst+(slot)))
  const int vb0=(int)(lds0+LDS_V)+((lane>>4)&1)*32+(lane&3)*8+(4*hi+((lane&15)>>2))*64;
  const char*Kbase=shm+LDS_K; bf16x8 kf[8];
  const lds_cptr shm3=(lds_cptr)shm; const lds_cptr kp0=shm3+LDS_K+hi*1024+r32*16; const lds_cptr vp0=shm3+LDS_V+((lane>>4)&1)*32+(lane&3)*8+(4*hi+((lane&15)>>2))*64;
  const int NT=(q0+QB)/KVBLK;
  DMA_K(0,0);DMA_V(0,0);DMA_K(1,SLOTB);
  bf16x8 qr[4];
  #pragma unroll
  for(int d0=0;d0<4;++d0)qr[d0]=*reinterpret_cast<const bf16x8*>(&Qw[(long)r32*QP+d0*16+hi*8]);
  float mhat=0.f,l_reg=0.f;f32x16 o[2];o[0]=f32x16{};o[1]=f32x16{};f32x16 negm=f32x16{};asm volatile("":"+v"(negm));
  const int qrel=wid*QBLK+r32;
  #define CMASK(P0,P1,t) do{int jb_=(t)-(NT-4); if(jb_>=0)cmask(P0,P1,jb_,qrel,hi);}while(0)
  bool resc=false;
  #define START(P0,P1) do{ const float rm=rowmax(P0,P1); resc=false; \
    { const float dl=selcur?rm:-64.f; mhat=fadd_s(mhat,dl); \
      _Pragma("unroll") for(int r=0;r<16;++r){P0[r]=fsub_s(P0[r],dl);P1[r]=fsub_s(P1[r],dl);} \
      { const float nv_=selcur?-mhat:NEGBIG; _Pragma("unroll") for(int r=0;r<16;++r)negm[r]=nv_; } asm volatile("":"+v"(negm)); } \
    _Pragma("unroll") for(int r=0;r<16;++r)P0[r]=__builtin_amdgcn_exp2f(P0[r]); }while(0)
  #define RESC() do{ if(resc){ asm volatile("s_waitcnt lgkmcnt(0)":::"memory"); \
      _Pragma("unroll") for(int d_=0;d_<2;++d_) _Pragma("unroll") for(int r=0;r<16;++r)o[d_][r]*=wsf[crow(r,hi)]; } }while(0)
  f32x16 pA0,pA1,pB0,pB1;
  int sl_prev=0,sl_cur=0,sl_next=SLOTB;
  #define ROT() do{sl_prev=sl_cur;sl_cur=sl_next;sl_next=(sl_next==(NSLOT-1)*SLOTB)?0:sl_next+SLOTB;}while(0)
  DMA_K(2,2*SLOTB);
  if(qb>=4){ if(tid<448){ const unsigned hb=__builtin_bit_cast(unsigned,kbv); const unsigned hr=(hb+0x7fffu+((hb>>16)&1u))&0xffff0000u; const float lo_=kbv-__builtin_bit_cast(float,hr); const unsigned lb=__builtin_bit_cast(unsigned,lo_);
      ((unsigned short*)(shm+LDS_KBAR))[tid]=(unsigned short)(hr>>16); ((unsigned short*)(shm+LDS_KBAR+1024))[tid]=(unsigned short)((lb+0x7fffu+((lb>>16)&1u))>>16); } }
  WAIT_BAR(3);
  unsigned bmask=(1u<<(qb+1))-1u;
  if(qb>=4){ float gsc[8];
    { const lds_cptr kb3=shm3+LDS_KBAR+(r32&7)*128+hi*16; f32x16 g=f32x16{};
      _Pragma("unroll") for(int d0=0;d0<4;++d0){ const bf16x8 ah=*(const __attribute__((address_space(3))) bf16x8*)(kb3+d0*32), al=*(const __attribute__((address_space(3))) bf16x8*)(kb3+1024+d0*32);
        g=__builtin_amdgcn_mfma_f32_32x32x16_bf16(ah,qr[d0],g,0,0,0); g=__builtin_amdgcn_mfma_f32_32x32x16_bf16(al,qr[d0],g,0,0,0); }
      _Pragma("unroll") for(int r=0;r<4;++r){ auto rr=__builtin_amdgcn_permlane32_swap(__float_as_uint(g[r]),__float_as_uint(g[r]),false,false); gsc[r]=__uint_as_float(rr[0]); gsc[4+r]=__uint_as_float(rr[1]); } }
    _Pragma("unroll") for(int n=0;n<7;++n) gsc[n]=(n<qb)?gsc[n]:-3.0e38f;
    bmask=1u<<qb;
    _Pragma("unroll") for(int pick=0;pick<3;++pick){ float best=-3.4e38f; unsigned bi=0u;
      _Pragma("unroll") for(int n=0;n<7;++n){ const bool ok=!((bmask>>n)&1u)&&gsc[n]>best; best=ok?gsc[n]:best; bi=ok?(unsigned)n:bi; }
      bmask|=1u<<bi; } }
  bool selcur=(bmask&1u)!=0u;
  { const float nv=selcur?0.f:NEGBIG; _Pragma("unroll") for(int r=0;r<16;++r)negm[r]=nv; asm volatile("":"+v"(negm)); }
  qkt(pA0,pA1,Kbase,qr,negm,r32,hi);asm volatile("s_nop 15\n\ts_nop 7":"+v"(pA0),"+v"(pA1));CMASK(pA0,pA1,0);
  START(pA0,pA1);
  _Pragma("unroll") for(int r=0;r<16;++r)pA1[r]=__builtin_amdgcn_exp2f(pA1[r]);
  WAIT_BAR(0);
  DMA_K(3,0);DMA_V(1,SLOTB);
  ROT();
  kload8(kf,kp0+sl_cur);
  WAIT_BAR(2);
  s16x4 vlo[8],vhi[8]; u32x4 pw0,pw1,pw2,pw3;
  #define PKW(P,B) cvtpk_s(P[B],P[B+1])
  #define PAF(k) __builtin_bit_cast(bf16x8,pw##k)
  #define VFR(i) (bf16x8){vlo[i][0],vlo[i][1],vlo[i][2],vlo[i][3],vhi[i][0],vhi[i][1],vhi[i][2],vhi[i][3]}
  #define PIN(x) asm volatile("":"+v"(x))
  #define MX3(a,b,c) __builtin_fmaxf(__builtin_fmaxf((a),(b)),(c))
  #define GAPA(MF,A0,A1,A2,A3,W0,W1,PW) do{ MF; sacc+=A0; sacc+=A1; sacc+=A2; sacc+=A3; PIN(sacc); W0; W1; PIN(PW); SBAR(); }while(0)
  #define EX(v) __builtin_amdgcn_exp2f(v)
  #define GAPB(MF,X,B) do{ MF; X[B]=EX(X[B]); X[B+1]=EX(X[B+1]); X[B+2]=EX(X[B+2]); X[B+3]=EX(X[B+3]); PIN(X); SBAR(); }while(0)
  #define VRD(i) do{ vlo[i]=vtr(vp_+(((i)>>2)*4096+((i)&3)*1024)); vhi[i]=vtr(vp_+(((i)>>2)*4096+((i)&3)*1024+512)); }while(0)
  #define KRD(G,j) do{ if(G){ kload2(kf,kp0+sl_next,j); SBAR(); } }while(0)
  #define STEP(C0,C1,P0,P1,t,GK,GV,GL) do{ SBAR(); \
    const lds_cptr vp_=vp0+sl_prev; \
    VRD(0); SBAR(); float sacc=(P0[0]+P0[1]); \
    GAPA(C0=__builtin_amdgcn_mfma_f32_32x32x16_bf16(kf[0],qr[0],negm,0,0,0), P0[2],P0[3],P0[4],P0[5],     pw0[0]=PKW(P0,0), pw0[1]=PKW(P0,2), pw0); \
    VRD(4); SBAR(); GAPA(C1=__builtin_amdgcn_mfma_f32_32x32x16_bf16(kf[1],qr[0],negm,0,0,0), P0[6],P0[7],P0[8],P0[9],     pw0[2]=PKW(P0,4), pw0[3]=PKW(P0,6), pw0); \
    VRD(1); SBAR(); GAPA(C0=__builtin_amdgcn_mfma_f32_32x32x16_bf16(kf[2],qr[1],C0,0,0,0),   P0[10],P0[11],P0[12],P0[13], pw1[0]=PKW(P0,8), pw1[1]=PKW(P0,10), pw1); \
    VRD(5); SBAR(); GAPA(C1=__builtin_amdgcn_mfma_f32_32x32x16_bf16(kf[3],qr[1],C1,0,0,0),   P0[14],P0[15],P1[0],P1[1],   pw1[2]=PKW(P0,12),pw1[3]=PKW(P0,14), pw1); \
    VRD(2); SBAR(); GAPA(C0=__builtin_amdgcn_mfma_f32_32x32x16_bf16(kf[4],qr[2],C0,0,0,0),   P1[2],P1[3],P1[4],P1[5],     pw2[0]=PKW(P1,0), pw2[1]=PKW(P1,2), pw2); \
    VRD(6); SBAR(); GAPA(C1=__builtin_amdgcn_mfma_f32_32x32x16_bf16(kf[5],qr[2],C1,0,0,0),   P1[6],P1[7],P1[8],P1[9],     pw2[2]=PKW(P1,4), pw2[3]=PKW(P1,6), pw2); \
    VRD(3); SBAR(); GAPA(C0=__builtin_amdgcn_mfma_f32_32x32x16_bf16(kf[6],qr[3],C0,0,0,0),   P1[10],P1[11],P1[12],P1[13], pw3[0]=PKW(P1,8), pw3[1]=PKW(P1,10), pw3); \
    VRD(7); SBAR(); GAPA(C1=__builtin_amdgcn_mfma_f32_32x32x16_bf16(kf[7],qr[3],C1,0,0,0),   P1[14],P1[15],0.f,0.f,       pw3[2]=PKW(P1,12),pw3[3]=PKW(P1,14), pw3); \
    l_reg+=sacc; \
    if(GK){DMA_K((t)+3,sl_cur);} if(GV){DMA_V((t)+1,sl_next);} \
    CMASK(C0,C1,t); \
    { float a=MX3(C0[0],C0[1],C1[0]),b=MX3(C0[2],C0[3],C1[1]); a=MX3(a,C1[2],C1[3]); \
      _Pragma("unroll") for(int r=4;r<16;r+=4){a=MX3(a,C0[r],C0[r+1]);b=MX3(b,C0[r+2],C0[r+3]);a=MX3(a,C1[r],C1[r+1]);b=MX3(b,C1[r+2],C1[r+3]);} \
      float rm=__builtin_fmaxf(a,b); { auto rr=__builtin_amdgcn_permlane32_swap(__float_as_uint(rm),__float_as_uint(rm),false,false); rm=__builtin_fmaxf(__uint_as_float(rr[0]),__uint_as_float(rr[1])); } \
      resc=false; \
      if(__builtin_expect(__any(rm>(float)THRL),0)){ const float dl=__builtin_fmaxf(rm,0.f); mhat+=dl; \
        _Pragma("unroll") for(int r=0;r<16;++r){C0[r]-=dl;C1[r]-=dl;} \
        { const float nv_=selcur?-mhat:NEGBIG; _Pragma("unroll") for(int r=0;r<16;++r)negm[r]=nv_; } asm volatile("":"+v"(negm)); \
        const float f=__builtin_amdgcn_exp2f(-dl); l_reg*=f; if(hi==0)wsf[r32]=f; resc=true; } } \
    SBAR(); \
    GAPB(o[0]=__builtin_amdgcn_mfma_f32_32x32x16_bf16(PAF(0),VFR(0),o[0],0,0,0), C0,0); \
    GAPB(o[1]=__builtin_amdgcn_mfma_f32_32x32x16_bf16(PAF(0),VFR(4),o[1],0,0,0), C0,4); \
    KRD(GL,0); GAPB(o[0]=__builtin_amdgcn_mfma_f32_32x32x16_bf16(PAF(1),VFR(1),o[0],0,0,0), C0,8); \
    KRD(GL,1); GAPB(o[1]=__builtin_amdgcn_mfma_f32_32x32x16_bf16(PAF(1),VFR(5),o[1],0,0,0), C0,12); \
    KRD(GL,2); GAPB(o[0]=__builtin_amdgcn_mfma_f32_32x32x16_bf16(PAF(2),VFR(2),o[0],0,0,0), C1,0); \
    KRD(GL,3); GAPB(o[1]=__builtin_amdgcn_mfma_f32_32x32x16_bf16(PAF(2),VFR(6),o[1],0,0,0), C1,4); \
    GAPB(o[0]=__builtin_amdgcn_mfma_f32_32x32x16_bf16(PAF(3),VFR(3),o[0],0,0,0), C1,8); \
    GAPB(o[1]=__builtin_amdgcn_mfma_f32_32x32x16_bf16(PAF(3),VFR(7),o[1],0,0,0), C1,12); \
    }while(0)
  #define BLKSEL(tt) do{ if((((tt))&3)==0){ selcur=((bmask>>((tt)>>2))&1u)!=0u; const float nv_=selcur?-mhat:NEGBIG; _Pragma("unroll") for(int r=0;r<16;++r)negm[r]=nv_; asm volatile("":"+v"(negm)); } }while(0)
  int t=1;
  #undef CMASK
  #define CMASK(P0,P1,t) do{}while(0)
  for(;t+5<NT;t+=2){
    STEP(pB0,pB1,pA0,pA1,t,true,true,true);     WAIT_BAR(2); RESC(); ROT(); BLKSEL(t+1);
    STEP(pA0,pA1,pB0,pB1,t+1,true,true,true);   WAIT_BAR(2); RESC(); ROT();
  }
  #undef CMASK
  #define CMASK(P0,P1,t) do{int jb_=(t)-(NT-4); if(jb_>=0)cmask(P0,P1,jb_,qrel,hi);}while(0)
  #define ENDW(tt) do{ if((tt)+3<NT){WAIT_BAR(2);} else if((tt)+2<NT){WAIT_BAR(1);} else {WAIT_BAR(0);} }while(0)
  for(;t+1<NT;t+=2){
    STEP(pB0,pB1,pA0,pA1,t,(t+3<NT),(t+1<NT),(t+1<NT));       ENDW(t);   RESC(); ROT(); BLKSEL(t+1);
    STEP(pA0,pA1,pB0,pB1,t+1,(t+4<NT),(t+2<NT),(t+2<NT));     ENDW(t+1); RESC(); ROT();
  }
  STEP(pB0,pB1,pA0,pA1,NT-1,false,false,false); RESC();
  { float sacc=pB0[0]+pB0[1]; _Pragma("unroll") for(int r=2;r<16;++r)sacc+=pB0[r]; _Pragma("unroll") for(int r=0;r<16;++r)sacc+=pB1[r]; l_reg+=sacc;
    pw0=(u32x4){PKW(pB0,0),PKW(pB0,2),PKW(pB0,4),PKW(pB0,6)};pw1=(u32x4){PKW(pB0,8),PKW(pB0,10),PKW(pB0,12),PKW(pB0,14)};pw2=(u32x4){PKW(pB1,0),PKW(pB1,2),PKW(pB1,4),PKW(pB1,6)};pw3=(u32x4){PKW(pB1,8),PKW(pB1,10),PKW(pB1,12),PKW(pB1,14)};
    SBAR(); pv(o,vb0+sl_cur,PAF(0),PAF(1),PAF(2),PAF(3)); }
  #undef PKW
  #undef PAF
  #undef VFR
  #undef PIN
  #undef MX3
  #undef GAPA
  #undef GAPB
  #undef EX
  #undef VRD
  #undef KRD
  #undef STEP
  #undef ENDW
  {auto rr=__builtin_amdgcn_permlane32_swap(__float_as_uint(l_reg),__float_as_uint(l_reg),false,false);l_reg=__uint_as_float(rr[0])+__uint_as_float(rr[1]);}
  if(hi==0)wsf[32+r32]=l_reg;asm volatile("s_waitcnt lgkmcnt(0)":::"memory");
  float rli[16];
  #pragma unroll
  for(int r=0;r<16;++r)rli[r]=__builtin_amdgcn_rcpf(wsf[32+crow(r,hi)]);
  unsigned char*Ow=(unsigned char*)O+(rowbase+q0+wid*QBLK)*OP+h*D;
  { unsigned char*stg=(unsigned char*)(shm+LDS_OST)+wid*4096;
    #pragma unroll
    for(int r=0;r<16;++r){const int orow=crow(r,hi);
      #pragma unroll
      for(int d0=0;d0<2;++d0){const float ov=__builtin_amdgcn_fmed3f(o[d0][r]*rli[r]*32.f,-448.f,448.f); stg[orow*64+d0*32+r32]=(unsigned char)__builtin_amdgcn_cvt_pk_fp8_f32(ov,ov,0,false);}}
    asm volatile("s_waitcnt lgkmcnt(0)":::"memory");
    #pragma unroll
    for(int i=0;i<2;++i){const int row=i*16+(lane>>2),ch=lane&3; const u32x4 v=*(const u32x4*)(stg+row*64+ch*16); ATTN_STORE16(Ow+(long)row*OP+ch*16,v);} }
  asm volatile("s_waitcnt lgkmcnt(0)\n\ts_barrier":::"memory");
  #undef BLKSEL
  #undef DMA_K
  #undef DMA_V
  #undef CMASK
  #undef START
  #undef RESC
  #undef ROT
}
constexpr int ATTN_LDS_BYTES=LDS_BYTES;
struct AttnTensors { const bf16* Q; const bf16* K; const bf16* V; bf16* O; const float* kbar; };
struct AttnUnit { int bh; int qb; };
struct StaticOrder {
  int vcu, G;
  __device__ __forceinline__ explicit StaticOrder(int grid,int block):vcu((grid%8==0)?(block%8)*(grid/8)+block/8:block),G(grid){}
  __device__ __forceinline__ bool next(int i,AttnUnit&u)const{ const int pr=(vcu+(i>>2)*G)*2+((i>>1)&1); if(pr>=BATCH*NHEAD*4)return false;
    const int s=pr&3; u.bh=pr>>2; u.qb=(i&1)?7-s:s; return true; }
  __device__ __forceinline__ void a_ready(const AttnUnit&)const{}
  __device__ __forceinline__ void done(const AttnUnit&)const{}
};
template<class Sched,int THRL=8> __device__ __forceinline__ void attn_phase(char*lds,const AttnTensors&T,const Sched&S,const int tid_in){
  AttnUnit u; int tid_=tid_in; asm volatile("":"+v"(tid_));
  for(int i=0;S.next(i,u);++i){ S.a_ready(u); attn_unit<THRL>(u.bh/NHEAD,u.bh%NHEAD,u.qb,T.Q,T.K,T.V,T.O,T.kbar+(long)u.bh*512,lds,tid_); S.done(u); }
}
#undef SBAR
#undef WAIT_BAR
}

#define XB_TMO      128
#define XB_XCNT(j)  (256  + 64 * (j))
#define XB_XSUB(j)  (1280 + 64 * (j))
#define XB_XGEN(j)  (2304 + 64 * (j))
#define XB_TOP      3328
#define XB_TOPGEN   3392
#define XCD_BAR_WORDS 3456
#define XB_SPIN_CAP (1u << 18)

__device__ __forceinline__ unsigned xb_ld(unsigned* p)              { return __hip_atomic_load(p, __ATOMIC_RELAXED, __HIP_MEMORY_SCOPE_AGENT); }
__device__ __forceinline__ unsigned xb_add(unsigned* p, unsigned v) { return __hip_atomic_fetch_add(p, v, __ATOMIC_RELAXED, __HIP_MEMORY_SCOPE_AGENT); }
__device__ __forceinline__ unsigned xb_xcc_id() { return (unsigned)__builtin_amdgcn_s_getreg((3 << 11) | 20) & 0xFu; }
#define XB_SPIN(cond, bar) do { unsigned _sp = 0; while (cond) { __builtin_amdgcn_s_sleep(1); \
    if ((++_sp & 255u) == 0u) { if (xb_ld(&(bar)[XB_TMO])) break; if (_sp > XB_SPIN_CAP) { atomicAdd(&(bar)[XB_TMO], 1u); break; } } } } while (0)

struct XcdBarrier {
    unsigned* bar; unsigned x;
    volatile LAS unsigned* st;
};

__device__ __forceinline__ XcdBarrier xcd_barrier_post(unsigned* bar, volatile LAS unsigned* st) {
    XcdBarrier b; b.bar = bar; b.x = xb_xcc_id(); b.st = st;
    if (threadIdx.x == 0) (void)xb_add(&bar[XB_XCNT(b.x)], 1u);
    return b;
}
__device__ __forceinline__ void xcd_barrier_complete(unsigned* bar, unsigned x, unsigned& nloc, unsigned& nx) {
    const unsigned G = gridDim.x * gridDim.y * gridDim.z;
    unsigned sum, cnt, mine, sp = 0u;
    for (;;) {
        sum = 0u; cnt = 0u; mine = 0u;
#pragma unroll
        for (unsigned j = 0; j < 16; ++j) { const unsigned c = xb_ld(&bar[XB_XCNT(j)]); sum += c; cnt += (c > 0u) ? 1u : 0u; mine = (j == x) ? c : mine; }
        if (sum == G) break;
        __builtin_amdgcn_s_sleep(1);
        if ((++sp & 255u) == 0u) { if (xb_ld(&bar[XB_TMO])) break; if (sp > XB_SPIN_CAP) { atomicAdd(&bar[XB_TMO], 1u); break; } }
    }
    nloc = mine > 0u ? mine : 1u; nx = cnt > 0u ? cnt : 1u;
}

__device__ __forceinline__ void xcd_barrier(const XcdBarrier& b, const bool is_t0) {
    asm volatile("s_waitcnt vmcnt(0)" ::: "memory");
    __syncthreads();
    if (is_t0) {
        unsigned* bar = b.bar;
        __builtin_amdgcn_s_waitcnt(0);
        unsigned nloc = b.st[0], nx = b.st[1];
        if (nloc == 0u) { xcd_barrier_complete(bar, b.x, nloc, nx); b.st[0] = nloc; b.st[1] = nx; }
        const unsigned old = xb_add(&bar[XB_XSUB(b.x)], 1u);
        const unsigned gen = old / nloc;
        if (old + 1u == (gen + 1u) * nloc) {
            __builtin_amdgcn_fence(__ATOMIC_RELEASE, "agent");
            asm volatile("s_waitcnt vmcnt(0)" ::: "memory");
            const unsigned og = xb_add(&bar[XB_TOP], 1u);
            const unsigned tg = og / nx;
            if (og + 1u == (tg + 1u) * nx) xb_add(&bar[XB_TOPGEN], 1u);
            else XB_SPIN(xb_ld(&bar[XB_TOPGEN]) == tg, bar);
            __builtin_amdgcn_fence(__ATOMIC_ACQUIRE, "agent");
            xb_add(&bar[XB_XGEN(b.x)], 1u);
            asm volatile("s_waitcnt vmcnt(0)" ::: "memory");
        } else {
            XB_SPIN(xb_ld(&bar[XB_XGEN(b.x)]) == gen, bar);
            __builtin_amdgcn_fence(__ATOMIC_ACQUIRE, "agent");
            asm volatile("s_waitcnt vmcnt(0)" ::: "memory");
        }
    }
    __syncthreads();
}

struct Args { const float* in[17]; float* out; unsigned char* ws; int ph_lo, ph_hi; };
enum { I_X = 0, I_C, I_WMOD, I_BMOD, I_WIN, I_WPOOL, I_PSCALE, I_WOUT, I_LN1G, I_LN1B, I_WR, I_RB, I_WG, I_WU, I_WDN, I_LN2G, I_LN2B };

DEVFN int lane_id_volatile() { int l; asm volatile("v_mbcnt_lo_u32_b32 %0, -1, 0\n\tv_mbcnt_hi_u32_b32 %0, -1, %0" : "=v"(l)); return l; }
struct Ctx { unsigned char* lds; __attribute__((address_space(3))) unsigned char* lds3; int tid, lane, wave, G, bid, gw, NGW; };

DEVFN void transpose_item_f8(const float* src, int ldn, int k0, int col, unsigned char* dst, int ldk, int dst_row0, int dst_k0, float* scr, int lane) {
#pragma unroll 8
    for (int i = 0; i < 32; ++i) { const int kk = 2 * i + (lane >> 5); scr[kk * 33 + (lane & 31)] = src[(size_t)(k0 + kk) * ldn + col]; }
    LDS_WAIT();
    const int c = lane & 7;
#pragma unroll
    for (int j = 0; j < 4; ++j) { const int n = (lane >> 3) + 8 * j; const float* s = scr + (8 * c) * 33 + n;
        u32x2 o; o.x = pk4_fp8(32.f * s[0 * 33], 32.f * s[1 * 33], 32.f * s[2 * 33], 32.f * s[3 * 33]); o.y = pk4_fp8(32.f * s[4 * 33], 32.f * s[5 * 33], 32.f * s[6 * 33], 32.f * s[7 * 33]);
        *(u32x2*)(dst + (size_t)(dst_row0 + n) * ldk + dst_k0 + 8 * c) = o; }
    LDS_WAIT();
}

DEVFN void ph_prologue(const Args& a, const Ctx& c) {
    unsigned char* ws = a.ws;
    float* scr = (float*)(c.lds + c.wave * 16384);
    const int lane = c.lane;
    constexpr int N1 = 2 * 16 * 64, N2 = 2 * 8 * 32, N3 = 32 * 16 * 32, N4 = 32 * 8 * 32, N5 = 2 * 64 * 16, N6 = 256;
    for (int it = c.gw; it < N1 + N2 + N3 + N4 + N5 + N6; it += c.NGW) {
        int r = it;
        if (r < N1) {
            const int l = r / 1024, kb = (r % 1024) / 64, nb = r % 64;
            const int nphys = 32 * nb + (lane & 31);
            transpose_item_f8(a.in[I_WIN] + (size_t)l * DM * DIN, DIN, 64 * kb, inproj_nlog(nphys), (unsigned char*)(ws + WS_WIN) + (size_t)l * DIN * DM, DM, 32 * nb, 64 * kb, scr, lane);
            continue; }
        r -= N1;
        if (r < N2) {
            const int l = r / 256, kb = (r % 256) / 32, nb = r % 32;
            transpose_item_f8(a.in[I_WOUT] + (size_t)l * DM * DM, DM, 64 * kb, 32 * nb + (lane & 31), (unsigned char*)(ws + WS_WOUT) + (size_t)l * DM * DM, DM, 32 * nb, 64 * kb, scr, lane);
            continue; }
        r -= N2;
        if (r < N3) {
            const int le = r / 512, kb = (r % 512) / 32, nb = r % 32;
            const int n = 32 * nb + (lane & 31), jt = n >> 8, bj = (n >> 7) & 1, i = n & 127;
            const float* src = (bj ? a.in[I_WU] : a.in[I_WG]) + (size_t)le * DM * DE;
            transpose_item_f8(src, DE, 64 * kb, jt * 128 + i, (unsigned char*)(ws + WS_WGU) + (size_t)le * DM * DM, DM, 32 * nb, 64 * kb, scr, lane);
            continue; }
        r -= N3;
        if (r < N4) {
            const int le = r / 256, kb = (r % 256) / 32, nb = r % 32;
            transpose_item_f8(a.in[I_WDN] + (size_t)le * DE * DM, DM, 64 * kb, 32 * nb + (lane & 31), (unsigned char*)(ws + WS_WD) + (size_t)le * DM * DE, DE, 32 * nb, 64 * kb, scr, lane);
            continue; }
        r -= N4;
        if (r < N5) {
            const int l = r / 1024, kdg = (r % 1024) / 16, nb = r % 16;
            const int n = nb * 64 + lane, kd0 = kdg * 8, g = kd0 >> 7, c0 = kd0 & 127;
            const float* wo = a.in[I_WOUT] + (size_t)l * DM * DM + (size_t)(512 + g * 128) * DM + n;
            const float* ps = a.in[I_PSCALE] + l * 512 + g * 128;
            const float* wp = a.in[I_WPOOL] + ((size_t)(l * 4 + g) * 128 + c0) * 128;
            float acc[8];
#pragma unroll
            for (int j = 0; j < 8; ++j) acc[j] = 0.f;
            for (int e = 0; e < 128; ++e) { const float w = wo[(size_t)e * DM] * ps[e];
#pragma unroll
                for (int j = 0; j < 8; ++j) acc[j] += wp[j * 128 + e] * w; }
            u32x2 o; o.x = pk4_fp8(128.f * acc[0], 128.f * acc[1], 128.f * acc[2], 128.f * acc[3]); o.y = pk4_fp8(128.f * acc[4], 128.f * acc[5], 128.f * acc[6], 128.f * acc[7]);
            *(u32x2*)((unsigned char*)(ws + WS_WOUT) + (size_t)l * DM * DM + (size_t)n * DM + 512 + kd0) = o;
            continue; }
        r -= N5;
        {
            const int ent = r * 64 + lane, pos = ent >> 3, i = ent & 7;
            const float inv = (float)exp2(-(double)i / 8.0 * 18.931568569324174);
            const float ang = (float)pos * inv;
            float* t = (float*)(ws + WS_ROPE) + ent * 2;
            t[0] = (float)cos((double)ang); t[1] = (float)sin((double)ang);
        }
    }
    for (int i = c.bid * 512 + c.tid; i < 2 * NB * NH * NBLK * HD; i += c.G * 512) ((float*)(ws + WS_KBAR))[i] = 0.f;
    __syncthreads();
    if (c.bid < 192) {
        float* condT = (float*)c.lds;
        float* red = (float*)(c.lds + 65536);
        for (int idx = c.tid; idx < NB * DM; idx += 512) { const int b = idx >> 10, k = idx & 1023; const float v = a.in[I_C][idx]; condT[k * 16 + b] = v / (1.f + __expf(-v)); }
        __syncthreads();
        for (int u = c.bid; u < 192; u += c.G) {
            const int l = u / 96, n0 = (u % 96) * 64;
            const float* W = a.in[I_WMOD] + (size_t)l * DM * NMOD + n0 + lane;
            float acc[16];
#pragma unroll
            for (int b = 0; b < 16; ++b) acc[b] = 0.f;
            for (int k = 128 * c.wave; k < 128 * c.wave + 128; k += 8) {
                float wv[8];
#pragma unroll
                for (int j = 0; j < 8; ++j) wv[j] = W[(size_t)(k + j) * NMOD];
#pragma unroll
                for (int j = 0; j < 8; ++j) {
                    const f32x4* cp = (const f32x4*)(condT + (k + j) * 16);
#pragma unroll
                    for (int q = 0; q < 4; ++q) { const f32x4 cv = cp[q]; acc[4 * q + 0] += cv.x * wv[j]; acc[4 * q + 1] += cv.y * wv[j]; acc[4 * q + 2] += cv.z * wv[j]; acc[4 * q + 3] += cv.w * wv[j]; }
                }
            }
#pragma unroll
            for (int b = 0; b < 16; ++b) red[(c.wave * 16 + b) * 64 + lane] = acc[b];
            __syncthreads();
            for (int o = c.tid; o < 1024; o += 512) { const int b = o >> 6, cc = o & 63; float s = a.in[I_BMOD][l * NMOD + n0 + cc];
#pragma unroll
                for (int w = 0; w < 8; ++w) s += red[(w * 16 + b) * 64 + cc];
                ((float*)(ws + WS_MOD))[(size_t)(l * NB + b) * NMOD + n0 + cc] = s; }
            __syncthreads();
        }
    }
}

DEVFN void row_stats(const f32x4 (&v)[4], float& mean, float& rstd) {
    float s = 0.f, q = 0.f;
#pragma unroll
    for (int j = 0; j < 4; ++j) { s += (v[j].x + v[j].y) + (v[j].z + v[j].w); q += (v[j].x * v[j].x + v[j].y * v[j].y) + (v[j].z * v[j].z + v[j].w * v[j].w); }
    s = swz_xor_add(s, 1); q = swz_xor_add(q, 1); s = swz_xor_add(s, 2); q = swz_xor_add(q, 2); s = swz_xor_add(s, 4); q = swz_xor_add(q, 4);
    s = swz_xor_add(s, 8); q = swz_xor_add(q, 8); s = swz_xor_add(s, 16); q = swz_xor_add(q, 16); s = half_swap_add(s); q = half_swap_add(q);
    mean = s * (1.f / DM);
    rstd = 1.f / sqrtf(fmaxf(q * (1.f / DM) - mean * mean, 0.f) + LN_EPS);
}
DEVFN void row_load(const float* p, int lane, f32x4 (&v)[4]) {
#pragma unroll
    for (int j = 0; j < 4; ++j) v[j] = *(const f32x4*)(p + 4 * lane + 256 * j);
}
DEVFN void row_mod_store(f32x4 (&v)[4], const float* sc, const float* sh, bf16_t* out, int lane) {
    float mean, rstd; row_stats(v, mean, rstd);
#pragma unroll
    for (int j = 0; j < 4; ++j) {
        const f32x4 s = *(const f32x4*)(sc + 4 * lane + 256 * j), h = *(const f32x4*)(sh + 4 * lane + 256 * j);
        v[j] = (v[j] - mean) * rstd * (s + 1.f) + h;
        u32x2 o; o.x = pk2(v[j].x, v[j].y); o.y = pk2(v[j].z, v[j].w);
        *(u32x2*)(out + 4 * lane + 256 * j) = o;
    }
}

DEVFN void ph_pool(const Args& a, const Ctx& c) {
    const bf16_t* P = (const bf16_t*)(a.ws + WS_QKVP) + 1536; unsigned char* AD = (unsigned char*)(a.ws + WS_AD) + 512;
    for (int it = c.bid * 512 + c.tid; it < (NTOK / 8) * 64; it += c.G * 512) {
        const int cg = it & 63, m0 = (it >> 6) * 8, t0 = m0 & (SEQ - 1), g = cg >> 4, w = 2 << g;
        const bf16_t* pc = P + cg * 8;
        u32x4 rows[23];
#pragma unroll
        for (int k = 0; k < 23; ++k) { const int dt = k - 15; rows[k] = (u32x4){0u, 0u, 0u, 0u}; if (dt > -w && t0 + dt >= 0) rows[k] = *(const u32x4*)(pc + (size_t)(m0 + dt) * DIN); }
        float s[8];
#pragma unroll
        for (int j = 0; j < 8; ++j) s[j] = 0.f;
#pragma unroll
        for (int k = 0; k < 15; ++k) { const u32x4 v = rows[k]; s[0] += bf_lo(v.x); s[1] += bf_hi(v.x); s[2] += bf_lo(v.y); s[3] += bf_hi(v.y); s[4] += bf_lo(v.z); s[5] += bf_hi(v.z); s[6] += bf_lo(v.w); s[7] += bf_hi(v.w); }
#pragma unroll
        for (int r = 0; r < 8; ++r) {
            const int t = t0 + r; const u32x4 v = rows[15 + r];
            const float f[8] = {bf_lo(v.x), bf_hi(v.x), bf_lo(v.y), bf_hi(v.y), bf_lo(v.z), bf_hi(v.z), bf_lo(v.w), bf_hi(v.w)};
#pragma unroll
            for (int j = 0; j < 8; ++j) s[j] += f[j];
            const int cnt = (t + 1 < w) ? t + 1 : w; const float ic = 1.f / (float)cnt;
            u32x2 o; o.x = pk4_fp8(s[0] * ic - f[0], s[1] * ic - f[1], s[2] * ic - f[2], s[3] * ic - f[3]); o.y = pk4_fp8(s[4] * ic - f[4], s[5] * ic - f[5], s[6] * ic - f[6], s[7] * ic - f[7]);
            *(u32x2*)(AD + (size_t)(m0 + r) * DM + cg * 8) = o;
            u32x4 q = rows[r];
            if (w == 8) q = rows[r + 8]; else if (w == 4) q = rows[r + 12]; else if (w == 2) q = rows[r + 14];
            s[0] -= bf_lo(q.x); s[1] -= bf_hi(q.x); s[2] -= bf_lo(q.y); s[3] -= bf_hi(q.y); s[4] -= bf_lo(q.z); s[5] -= bf_hi(q.z); s[6] -= bf_lo(q.w); s[7] -= bf_hi(q.w);
        }
    }
}

constexpr size_t WS_X1B = WS_X1, WS_X2B = WS_X1 + 64 * MiB;
constexpr int ROWS_PER_WAVE = 16;
DEVFN void vec_load(const float* p, int lane, f32x4 (&v)[4]) {
#pragma unroll
    for (int j = 0; j < 4; ++j) v[j] = *(const f32x4*)(p + 4 * lane + 256 * j);
}
DEVFN void bfrow_load(const bf16_t* p, int lane, u32x2 (&w)[4]) {
#pragma unroll
    for (int j = 0; j < 4; ++j) w[j] = *(const u32x2*)(p + 4 * lane + 256 * j);
}
DEVFN f32x4 bf4(u32x2 w) { return (f32x4){bf_lo(w.x), bf_hi(w.x), bf_lo(w.y), bf_hi(w.y)}; }
DEVFN void bfrow_store(bf16_t* p, int lane, const f32x4 (&v)[4]) {
#pragma unroll
    for (int j = 0; j < 4; ++j) { u32x2 o; o.x = pk2(v[j].x, v[j].y); o.y = pk2(v[j].z, v[j].w); *(u32x2*)(p + 4 * lane + 256 * j) = o; }
}
DEVFN void f8row_store(unsigned char* p, int lane, const f32x4 (&v)[4]) {
#pragma unroll
    for (int j = 0; j < 4; ++j) *(unsigned*)(p + 4 * lane + 256 * j) = pk4_fp8(v[j].x, v[j].y, v[j].z, v[j].w);
}
DEVFN void ln_mod(f32x4 (&v)[4], const f32x4 (&sc)[4], const f32x4 (&sh)[4]) {
    float mean, rstd; row_stats(v, mean, rstd);
#pragma unroll
    for (int j = 0; j < 4; ++j) v[j] = (v[j] - mean) * rstd * (sc[j] + 1.f) + sh[j];
}
DEVFN void ln_aff(f32x4 (&v)[4], const f32x4 (&g)[4], const f32x4 (&b)[4]) {
    float mean, rstd; row_stats(v, mean, rstd);
#pragma unroll
    for (int j = 0; j < 4; ++j) v[j] = (v[j] - mean) * rstd * g[j] + b[j];
}

DEVFN void ph_h1_rows(const Args& a, const Ctx& c) {
    const float* mod = (const float*)(a.ws + WS_MOD); bf16_t* HB = (bf16_t*)(a.ws + WS_HB);
    for (int base = c.gw * ROWS_PER_WAVE; base < NTOK; base += c.NGW * ROWS_PER_WAVE) {
        const float* mb = mod + (size_t)(base >> 11) * NMOD;
        f32x4 sc[4], sh[4]; vec_load(mb + DM, c.lane, sc); vec_load(mb, c.lane, sh);
        f32x4 cur[4], nxt[4]; vec_load(a.in[I_X] + (size_t)base * DM, c.lane, cur);
#pragma unroll 1
        for (int i = 0; i < ROWS_PER_WAVE; ++i) {
            const int m = base + i;
            if (i + 1 < ROWS_PER_WAVE) vec_load(a.in[I_X] + (size_t)(m + 1) * DM, c.lane, nxt);
            ln_mod(cur, sc, sh); f8row_store((unsigned char*)HB + (size_t)m * DM, c.lane, cur);
#pragma unroll
            for (int j = 0; j < 4; ++j) cur[j] = nxt[j];
        }
    }
}

DEVFN f32x4 reduce16(const float (&lg)[16]) {
    float t[8], u[4];
#pragma unroll
    for (int e = 0; e < 8; ++e) { auto rr = __builtin_amdgcn_permlane32_swap(__float_as_uint(lg[e]), __float_as_uint(lg[e + 8]), false, false); t[e] = __uint_as_float(rr[0]) + __uint_as_float(rr[1]); }
#pragma unroll
    for (int k = 0; k < 4; ++k) { auto rr = __builtin_amdgcn_permlane16_swap(__float_as_uint(t[k]), __float_as_uint(t[k + 4]), false, false); u[k] = __uint_as_float(rr[0]) + __uint_as_float(rr[1]); }
#pragma unroll
    for (int k = 0; k < 4; ++k) { u[k] = swz_xor_add(u[k], 1); u[k] = swz_xor_add(u[k], 2); u[k] = swz_xor_add(u[k], 4); u[k] = swz_xor_add(u[k], 8); }
    return (f32x4){u[0], u[1], u[2], u[3]};
}

DEVFN void rowc_load(const Args& a, int l, int m, int lane, f32x4 (&x)[4], unsigned (&y)[4]) {
    if (l == 0) vec_load(a.in[I_X] + (size_t)m * DM, lane, x);
    else { u32x2 w[4]; bfrow_load((const bf16_t*)(a.ws + WS_X2B) + (size_t)m * DM, lane, w);
#pragma unroll
        for (int j = 0; j < 4; ++j) { x[j].x = __uint_as_float(w[j].x); x[j].y = __uint_as_float(w[j].y); } }
#pragma unroll
    for (int j = 0; j < 4; ++j) y[j] = *(const unsigned*)((const unsigned char*)(a.ws + WS_QKVP) + (size_t)m * DM + 4 * lane + 256 * j);
}
DEVFN void rowc_step(const Args& a, int l, int m, int lane, const f32x4 (&x)[4], const unsigned (&y)[4], const float* vg1, const float* vsc, const float* vsh, f32x4 (&v)[4]) {
    int z_ = 0; asm volatile("" : "+v"(z_));
    f32x4 g1[4]; vec_load(vg1 + z_, lane, g1);
#pragma unroll
    for (int j = 0; j < 4; ++j) { const f32x4 xv = (l == 0) ? x[j] : bf4((u32x2){__float_as_uint(x[j].x), __float_as_uint(x[j].y)}); v[j] = xv * ALPHA + g1[j] * f8x4_to_f32(y[j], 1.f / YSCALE); }
    { f32x4 lg[4], lb[4]; vec_load(a.in[I_LN1G] + l * DM + z_, lane, lg); vec_load(a.in[I_LN1B] + l * DM + z_, lane, lb); ln_aff(v, lg, lb); }
    bfrow_store((bf16_t*)(a.ws + WS_X1B) + (size_t)m * DM, lane, v);
    { f32x4 sc[4], sh[4]; vec_load(vsc + z_, lane, sc); vec_load(vsh + z_, lane, sh); ln_mod(v, sc, sh); }
    f8row_store((unsigned char*)(a.ws + WS_HB) + (size_t)m * DM, lane, v);
}

DEVFN void ph_rows_c(const Args& a, const Ctx& c, int l, bool publish) {
    const float* mod = (const float*)(a.ws + WS_MOD) + (size_t)l * NB * NMOD;
    const bf16_t* Y = (const bf16_t*)(a.ws + WS_QKVP); const bf16_t* X2B = (const bf16_t*)(a.ws + WS_X2B);
    bf16_t* X1B = (bf16_t*)(a.ws + WS_X1B); bf16_t* HB = (bf16_t*)(a.ws + WS_HB);
    float* wr = (float*)c.lds;
    float* vsc = (float*)(c.lds + 65536); float* vsh = vsc + DM; float* vg1 = vsh + DM;
    int* lcnt = (int*)(c.lds + 65536 + 12288); int* lbase = lcnt + 32;
    int* rcls = lbase + 32; float* rw1 = (float*)(rcls + 8 * 64); float* rw2 = rw1 + 8 * 64; int* rrow = (int*)(rw2 + 8 * 64); float* lgs = (float*)(rrow + 8 * 64);
#pragma unroll
    for (int it = 0; it < 8; ++it) { const int idx = it * 512 + c.tid, k = idx & 1023, q = idx >> 10;
        const f32x4 w = *(const f32x4*)(a.in[I_WR] + k * 16 + 4 * q);
        wr[(4 * q + 0) * DM + k] = w.x; wr[(4 * q + 1) * DM + k] = w.y; wr[(4 * q + 2) * DM + k] = w.z; wr[(4 * q + 3) * DM + k] = w.w; }
    if (c.tid < 32) lcnt[c.tid] = 0;
    __syncthreads();
    int nr = 0;
    for (int base = c.gw * ROWS_PER_WAVE; base < NTOK; base += c.NGW * ROWS_PER_WAVE) {
        const float* mb = mod + (size_t)(base >> 11) * NMOD;
        __syncthreads();
        for (int i = c.tid; i < 3 * DM; i += 512) vsc[i] = (i < DM) ? mb[4 * DM + i] : (i < 2 * DM ? mb[3 * DM + (i - DM)] : mb[2 * DM + (i - 2 * DM)]);
        __syncthreads();
#pragma unroll 1
        for (int i = 0; i < ROWS_PER_WAVE; i += 2) {
            const int m = __builtin_amdgcn_readfirstlane(base + i);
            f32x4 va[4], vb[4];
            { f32x4 xa[4], xb[4]; unsigned ya[4], yb[4];
              rowc_load(a, l, m, c.lane, xa, ya); rowc_load(a, l, m + 1, c.lane, xb, yb);
              rowc_step(a, l, m, c.lane, xa, ya, vg1, vsc, vsh, va);
              rowc_step(a, l, m + 1, c.lane, xb, yb, vg1, vsc, vsh, vb); }
            typedef float f32x2_t __attribute__((ext_vector_type(2)));
            f32x2_t acc2[16];
#pragma unroll
            for (int e = 0; e < 16; ++e) acc2[e] = (f32x2_t){0.f, 0.f};
#pragma unroll
            for (int j = 0; j < 4; ++j) {
                const f32x2_t p0 = {va[j].x, vb[j].x}, p1 = {va[j].y, vb[j].y}, p2 = {va[j].z, vb[j].z}, p3 = {va[j].w, vb[j].w};
#pragma unroll
                for (int e = 0; e < 16; ++e) { const f32x4 w = *(const f32x4*)(wr + e * DM + 4 * c.lane + 256 * j);
                    acc2[e] = __builtin_elementwise_fma(p0, (f32x2_t){w.x, w.x}, acc2[e]); acc2[e] = __builtin_elementwise_fma(p1, (f32x2_t){w.y, w.y}, acc2[e]);
                    acc2[e] = __builtin_elementwise_fma(p2, (f32x2_t){w.z, w.z}, acc2[e]); acc2[e] = __builtin_elementwise_fma(p3, (f32x2_t){w.w, w.w}, acc2[e]);
                    if ((e & 7) == 7) __builtin_amdgcn_sched_barrier(0); } }
            float la[16], lb2[16];
#pragma unroll
            for (int e = 0; e < 16; ++e) { la[e] = acc2[e].x; lb2[e] = acc2[e].y; }
            { const f32x4 ua = reduce16(la), ub = reduce16(lb2);
              if ((c.lane & 15) == 0) { *(f32x4*)(lgs + (c.wave * 16 + i) * 16 + (c.lane >> 4) * 4) = ua; *(f32x4*)(lgs + (c.wave * 16 + i + 1) * 16 + (c.lane >> 4) * 4) = ub; } }
        }
        LDS_WAIT();
        if (c.lane < ROWS_PER_WAVE) {
            float lg16[16], rb[16];
#pragma unroll
            for (int e = 0; e < 16; ++e) rb[e] = a.in[I_RB][e];
#pragma unroll
            for (int q = 0; q < 4; ++q) { const f32x4 t = *(const f32x4*)(lgs + (c.wave * 16 + c.lane) * 16 + 4 * q); lg16[4 * q] = t.x; lg16[4 * q + 1] = t.y; lg16[4 * q + 2] = t.z; lg16[4 * q + 3] = t.w; }
            float mx = lg16[0];
#pragma unroll
            for (int e = 1; e < 16; ++e) mx = fmaxf(mx, lg16[e]);
            float sum = 0.f, scr[16];
#pragma unroll
            for (int e = 0; e < 16; ++e) { scr[e] = __expf(lg16[e] - mx); sum += scr[e]; }
            const float isum = 1.f / sum;
#pragma unroll
            for (int e = 0; e < 16; ++e) scr[e] *= isum;
            float bestg = -3.4e38f; int gb = 0, bi1 = 0, bi2 = 1; float bw1 = 0.f, bw2 = 0.f;
#pragma unroll
            for (int g = 0; g < 4; ++g) {
                float m1 = scr[4 * g] + rb[4 * g], s1 = scr[4 * g]; int i1 = 0;
#pragma unroll
                for (int q = 1; q < 4; ++q) { const float sv = scr[4 * g + q] + rb[4 * g + q]; const bool ok = sv > m1; m1 = ok ? sv : m1; s1 = ok ? scr[4 * g + q] : s1; i1 = ok ? q : i1; }
                float m2 = -3.4e38f, s2 = 0.f; int i2 = 0;
#pragma unroll
                for (int q = 0; q < 4; ++q) { const float sv = scr[4 * g + q] + rb[4 * g + q]; const bool ok = (q != i1) && sv > m2; m2 = ok ? sv : m2; s2 = ok ? scr[4 * g + q] : s2; i2 = ok ? q : i2; }
                const float gs = m1 + m2; const bool better = gs > bestg;
                bestg = better ? gs : bestg; gb = better ? g : gb; bi1 = better ? i1 : bi1; bi2 = better ? i2 : bi2; bw1 = better ? s1 : bw1; bw2 = better ? s2 : bw2;
            }
            const float inv = 1.f / (bw1 + bw2);
            const int lo = bi1 < bi2 ? bi1 : bi2, hi2 = bi1 < bi2 ? bi2 : bi1;
            const float wlo = (bi1 < bi2 ? bw1 : bw2) * inv, whi = (bi1 < bi2 ? bw2 : bw1) * inv;
            const int pidx = lo == 0 ? hi2 - 1 : (lo == 1 ? hi2 + 1 : 5);
            const int slot = c.wave * 64 + nr + c.lane;
            rcls[slot] = gb * 6 + pidx; rw1[slot] = wlo; rw2[slot] = whi; rrow[slot] = base + c.lane;
        }
        nr += ROWS_PER_WAVE;
        LDS_WAIT();
    }
    LDS_WAIT();
    if (!publish) return;
    int rank = 0, cls = 0;
    if (c.lane < nr) { cls = rcls[c.wave * 64 + c.lane]; rank = atomicAdd(&lcnt[cls], 1); }
    __syncthreads();
    if (c.tid < NCLS) lbase[c.tid] = (int)__hip_atomic_fetch_add((unsigned*)(a.ws + WS_CTL) + CW_CNT + l * 32 + c.tid, (unsigned)lcnt[c.tid], RLX_AGENT);
    __syncthreads();
    if (c.lane < nr) {
        const int pos = lbase[cls] + rank;
        ((int*)(a.ws + WS_LIST))[(size_t)cls * LISTCAP + pos] = rrow[c.wave * 64 + c.lane];
        float* rw = (float*)(a.ws + WS_RW) + ((size_t)cls * LISTCAP + pos) * 2;
        rw[0] = rw1[c.wave * 64 + c.lane]; rw[1] = rw2[c.wave * 64 + c.lane];
    }
}

DEVFN void ph_rows_g(const Args& a, const Ctx& c, int l) {
    const float* mod = (const float*)(a.ws + WS_MOD) + (size_t)l * NB * NMOD;
    const bf16_t* X1B = (const bf16_t*)(a.ws + WS_X1B); const unsigned char* Y2 = (const unsigned char*)(a.ws + WS_AD);
    bf16_t* X2B = (bf16_t*)(a.ws + WS_X2B); bf16_t* HB = (bf16_t*)(a.ws + WS_HB);
    for (int base = c.gw * ROWS_PER_WAVE; base < NTOK; base += c.NGW * ROWS_PER_WAVE) {
        const float* mb = mod + (size_t)(base >> 11) * NMOD; const float* mb1 = mb + (size_t)NB * NMOD;
        f32x4 g2[4], lg[4], lb[4], sc[4], sh[4];
        vec_load(mb + 5 * DM, c.lane, g2); vec_load(a.in[I_LN2G] + l * DM, c.lane, lg); vec_load(a.in[I_LN2B] + l * DM, c.lane, lb);
        if (l == 0) { vec_load(mb1 + DM, c.lane, sc); vec_load(mb1, c.lane, sh); }
        u32x2 xc[4], xn[4]; unsigned yc[4], yn[4];
        bfrow_load(X1B + (size_t)base * DM, c.lane, xc);
#pragma unroll
        for (int j = 0; j < 4; ++j) yc[j] = *(const unsigned*)(Y2 + (size_t)base * DM + 4 * c.lane + 256 * j);
#pragma unroll 1
        for (int i = 0; i < ROWS_PER_WAVE; ++i) {
            const int m = base + i;
            if (i + 1 < ROWS_PER_WAVE) { bfrow_load(X1B + (size_t)(m + 1) * DM, c.lane, xn);
#pragma unroll
                for (int j = 0; j < 4; ++j) yn[j] = *(const unsigned*)(Y2 + (size_t)(m + 1) * DM + 4 * c.lane + 256 * j); }
            f32x4 v[4];
#pragma unroll
            for (int j = 0; j < 4; ++j) v[j] = bf4(xc[j]) * ALPHA + g2[j] * f8x4_to_f32(yc[j], 1.f / YSCALE);
            ln_aff(v, lg, lb);
            if (l == 0) { bfrow_store(X2B + (size_t)m * DM, c.lane, v); ln_mod(v, sc, sh); f8row_store((unsigned char*)HB + (size_t)m * DM, c.lane, v); }
            else {
#pragma unroll
                for (int j = 0; j < 4; ++j) *(f32x4*)(a.out + (size_t)m * DM + 4 * c.lane + 256 * j) = v[j]; }
#pragma unroll
            for (int j = 0; j < 4; ++j) { xc[j] = xn[j]; yc[j] = yn[j]; }
        }
    }
}

constexpr int MOETAB_OFF = 131072 + 512;
DEVFN void ph_inproj_fast(const Args& a, const Ctx& c, int l, bool dummy_kbar) {
    pg8::DenseSched S; S.so.init(NTOK, DIN, c.G, c.bid); S.A = (const char*)(a.ws + WS_HB); S.Bt = (const char*)(a.ws + WS_WIN) + (size_t)l * DIN * DM; S.lda = DM; S.ldb = DM;
    const pg8::EpiInproj E{(bf16_t*)(a.ws + WS_QKVP), (const float*)(a.ws + WS_ROPE), (dummy_kbar ? (float*)(a.ws + WS_RW) : (float*)(a.ws + WS_KBAR)) + (size_t)l * NB * NH * NBLK * HD};
    pg8::gemm_phase2<pg8::EpiInproj, pg8::DenseSched, true, true, false, true, 127 - 5, 127>(c.lds3, DM, DM, S, E, c.tid);
}
DEVFN void ph_wout_fast(const Args& a, const Ctx& c, int l) {
    pg8::DenseSched S; S.so.init(NTOK, DM, c.G, c.bid); S.A = (const char*)(a.ws + WS_AD); S.Bt = (const char*)(a.ws + WS_WOUT) + (size_t)l * DM * DM; S.lda = DM; S.ldb = DM;
    const pg8::EpiF8 E{(unsigned char*)(a.ws + WS_QKVP), DM};
    pg8::gemm_phase2<pg8::EpiF8, pg8::DenseSched, true, true, false, true, 127 - 5 + 4, 127 - 5, true, 127 - 7 + 4, 127>    (c.lds3, DM, DM, S, E, c.tid);
}
DEVFN void moe_table_lds(const Args& a, const Ctx& c, int l) {
    int* cnt = (int*)(c.lds + MOETAB_OFF); int* tp = cnt + 32;
    if (c.tid < NCLS) cnt[c.tid] = (int)__hip_atomic_load((unsigned*)(a.ws + WS_CTL) + CW_CNT + l * 32 + c.tid, RLX_AGENT);
    __syncthreads();
    if (c.tid <= NCLS) { int s = 0;
#pragma unroll
        for (int k = 0; k < NCLS; ++k) { const int nk = (cnt[k] + 255) >> 8; s += (k < c.tid) ? nk : 0; }
        tp[c.tid] = s; }
    __syncthreads();
    int* tcls = tp + 32;
    for (int T = c.tid; T < tp[NCLS]; T += 512) { int k = 0; while (T >= tp[k + 1]) ++k; tcls[T] = k; }
    __syncthreads();
}
DEVFN void ph_gateup_fast(const Args& a, const Ctx& c, int l) {
    moe_table_lds(a, c, l);
    pg8::GateUpSched S; S.cnt = (const LAS int*)(c.lds3 + MOETAB_OFF); S.tp = S.cnt + 32; S.tcls = S.tp + 32; S.npn_shift = 3; S.nunits = S.tp[NCLS] * 8; S.G = c.G; S.c = (c.G % 8 == 0) ? (c.bid % 8) * (c.G / 8) + c.bid / 8 : c.bid;
    S.HB = (const char*)(a.ws + WS_HB); S.list = (const int*)(a.ws + WS_LIST); S.W = (const char*)(a.ws + WS_WGU) + (size_t)l * NE * DM * DM;
    const pg8::EpiGateUp E{(unsigned char*)(a.ws + WS_QKVP), (const float*)(a.ws + WS_RW)};
    pg8::gemm_phase2<pg8::EpiGateUp, pg8::GateUpSched, true, true, false, true, 127 - 5, 127>(c.lds3, DM, DM, S, E, c.tid);
}
DEVFN void ph_down_fast(const Args& a, const Ctx& c, int l) {
    moe_table_lds(a, c, l);
    pg8::DownSched S; S.cnt = (const LAS int*)(c.lds3 + MOETAB_OFF); S.tp = S.cnt + 32; S.tcls = S.tp + 32; S.npn_shift = 2; S.nunits = S.tp[NCLS] * 4; S.G = c.G; S.c = (c.G % 8 == 0) ? (c.bid % 8) * (c.G / 8) + c.bid / 8 : c.bid;
    S.ACT = (const char*)(a.ws + WS_QKVP); S.W = (const char*)(a.ws + WS_WD) + (size_t)l * NE * DM * DE;
    const pg8::EpiDown E{(unsigned char*)(a.ws + WS_AD), (const int*)(a.ws + WS_LIST)};
    pg8::gemm_phase2<pg8::EpiDown, pg8::DownSched, true, true, true, true, 127 - 5 + 4, 127 - 3>    (c.lds3, DM, DE, S, E, c.tid);
}

#ifndef MK_N_LAUNCHES
#define MK_N_LAUNCHES 1
#endif
constexpr int RING_BYTES = 131072, LDSCTL_OFF = RING_BYTES, MISC_OFF = LDSCTL_OFF + 320, LDS_BYTES = 147456;
constexpr int PH_PER_LAYER = 7, NPHASE = 2 + 2 * PH_PER_LAYER;
constexpr int CW_BAR = 4096;
static_assert((CW_BAR + XCD_BAR_WORDS) * 4 <= (int)CTL_ZERO_BYTES, "CTL");

__global__ void __launch_bounds__(512, 2) fwd(Args a) {
    extern __shared__ __attribute__((aligned(16))) unsigned char lds[];
    const int wave_s = __builtin_amdgcn_readfirstlane(threadIdx.x >> 6);
#define MKTID() (wave_s * 64 + lane_id_volatile())
#define MKCTX() Args al = a; { size_t z_ = 0; asm volatile("" : "+s"(z_)); al.ws = a.ws + z_; } Ctx c; {     int t_ = MKTID(); asm volatile("" : "+v"(t_)); c.lds = lds; c.lds3 = (LAS unsigned char*)lds; c.tid = t_; c.lane = t_ & 63; c.wave = __builtin_amdgcn_readfirstlane(t_ >> 6); c.G = gridDim.x; c.bid = blockIdx.x; c.gw = c.bid * 8 + c.wave; c.NGW = c.G * 8; }
    const int lo = a.ph_lo, hi = a.ph_hi;
    const bool one = (hi - lo) > 1;
    for (int u = threadIdx.x; u < (LDS_BYTES - LDSCTL_OFF) / 4; u += 512) ((LAS unsigned*)((LAS unsigned char*)lds + LDSCTL_OFF))[u] = 0u;
    __syncthreads();
    XcdBarrier bar; bar.bar = (unsigned*)(a.ws + WS_CTL) + CW_BAR; bar.x = 0; bar.st = nullptr;
    if (one) bar = xcd_barrier_post((unsigned*)(a.ws + WS_CTL) + CW_BAR, (volatile LAS unsigned*)((LAS unsigned char*)lds + MISC_OFF) + 8);
#ifndef REP_PHASE
#define REP_PHASE -1
#endif
#define IN(k) (lo <= (k) && (k) < hi)
#define SEAM(k) do { if (IN(k) && IN((k) + 1)) { XcdBarrier bl_ = bar; { size_t z_ = 0; unsigned x_ = bar.x; asm volatile("" : "+s"(z_), "+s"(x_)); bl_.bar = bar.bar + z_; bl_.x = x_; } xcd_barrier(bl_, MKTID() == 0); } } while (0)
    if (IN(0)) { MKCTX(); ph_prologue(al, c); if (REP_PHASE == 0) { __syncthreads(); ph_prologue(al, c); } SEAM(0); }
    if (IN(1)) { MKCTX(); ph_h1_rows(al, c); if (REP_PHASE == 1) ph_h1_rows(al, c); SEAM(1); }
    {
        constexpr int l = 0; constexpr int p0 = 2 + l * PH_PER_LAYER;
        if (IN(p0 + 0)) { MKCTX(); ph_inproj_fast(al, c, l, false); if (REP_PHASE == 10) { __syncthreads(); ph_inproj_fast(al, c, l, true); } SEAM(p0 + 0); }
        if (IN(p0 + 1)) {
            { MKCTX(); ph_pool(al, c); }
            __syncthreads();
            const attn_body::AttnTensors AT{(const attn_body::bf16*)(a.ws + WS_QKVP), (const attn_body::bf16*)(a.ws + WS_QKVP) + 512, (const attn_body::bf16*)(a.ws + WS_QKVP) + 1024,
                                            (attn_body::bf16*)(a.ws + WS_AD), (const float*)(a.ws + WS_KBAR) + (size_t)l * NB * NH * NBLK * HD};
            const attn_body::StaticOrder S((int)gridDim.x, (int)blockIdx.x);
            attn_body::attn_phase<attn_body::StaticOrder>((char*)lds, AT, S, MKTID());
            if (REP_PHASE == 11) attn_body::attn_phase<attn_body::StaticOrder>((char*)lds, AT, S, MKTID());
            if (REP_PHASE == 17) { __syncthreads(); MKCTX(); ph_pool(al, c); }
            SEAM(p0 + 1);
        }
        if (IN(p0 + 2)) { MKCTX(); ph_wout_fast(al, c, l); if (REP_PHASE == 12) { __syncthreads(); ph_wout_fast(al, c, l); } SEAM(p0 + 2); }
        if (IN(p0 + 3)) { MKCTX(); if (REP_PHASE == 13) { ph_rows_c(al, c, l, false); __syncthreads(); } ph_rows_c(al, c, l, true); SEAM(p0 + 3); }
        if (IN(p0 + 4)) { MKCTX(); ph_gateup_fast(al, c, l); if (REP_PHASE == 14) { __syncthreads(); ph_gateup_fast(al, c, l); } SEAM(p0 + 4); }
        if (IN(p0 + 5)) { MKCTX(); ph_down_fast(al, c, l); if (REP_PHASE == 15) { __syncthreads(); ph_down_fast(al, c, l); } SEAM(p0 + 5); }
        if (IN(p0 + 6)) { MKCTX(); ph_rows_g(al, c, l); if (REP_PHASE == 16) ph_rows_g(al, c, l); SEAM(p0 + 6); }
    }
    {
        constexpr int l = 1; constexpr int p0 = 2 + l * PH_PER_LAYER;
        if (IN(p0 + 0)) { MKCTX(); ph_inproj_fast(al, c, l, false); if (REP_PHASE == 10) { __syncthreads(); ph_inproj_fast(al, c, l, true); } SEAM(p0 + 0); }
        if (IN(p0 + 1)) {
            { MKCTX(); ph_pool(al, c); }
            __syncthreads();
            const attn_body::AttnTensors AT{(const attn_body::bf16*)(a.ws + WS_QKVP), (const attn_body::bf16*)(a.ws + WS_QKVP) + 512, (const attn_body::bf16*)(a.ws + WS_QKVP) + 1024,
                                            (attn_body::bf16*)(a.ws + WS_AD), (const float*)(a.ws + WS_KBAR) + (size_t)l * NB * NH * NBLK * HD};
            const attn_body::StaticOrder S((int)gridDim.x, (int)blockIdx.x);
            attn_body::attn_phase<attn_body::StaticOrder>((char*)lds, AT, S, MKTID());
            if (REP_PHASE == 11) attn_body::attn_phase<attn_body::StaticOrder>((char*)lds, AT, S, MKTID());
            if (REP_PHASE == 17) { __syncthreads(); MKCTX(); ph_pool(al, c); }
            SEAM(p0 + 1);
        }
        if (IN(p0 + 2)) { MKCTX(); ph_wout_fast(al, c, l); if (REP_PHASE == 12) { __syncthreads(); ph_wout_fast(al, c, l); } SEAM(p0 + 2); }
        if (IN(p0 + 3)) { MKCTX(); if (REP_PHASE == 13) { ph_rows_c(al, c, l, false); __syncthreads(); } ph_rows_c(al, c, l, true); SEAM(p0 + 3); }
        if (IN(p0 + 4)) { MKCTX(); ph_gateup_fast(al, c, l); if (REP_PHASE == 14) { __syncthreads(); ph_gateup_fast(al, c, l); } SEAM(p0 + 4); }
        if (IN(p0 + 5)) { MKCTX(); ph_down_fast(al, c, l); if (REP_PHASE == 15) { __syncthreads(); ph_down_fast(al, c, l); } SEAM(p0 + 5); }
        if (IN(p0 + 6)) { MKCTX(); ph_rows_g(al, c, l); if (REP_PHASE == 16) ph_rows_g(al, c, l); SEAM(p0 + 6); }
    }
#undef IN
#undef SEAM
}

extern "C" void kernel_launch(void* const* d_in, const int* in_sizes, int n_in, void* d_out, int out_size, void* d_ws, size_t ws_size, hipStream_t stream) {
    static int grid = 0;
    if (grid == 0) {
        if (n_in != 17 || out_size != NTOK * DM || ws_size < WS_END) { fprintf(stderr, "kernel_launch: unexpected problem (n_in %d out %d ws %zu)\n", n_in, out_size, ws_size); grid = -1; return; }
        if (hipFuncSetAttribute((const void*)fwd, hipFuncAttributeMaxDynamicSharedMemorySize, LDS_BYTES) != hipSuccess) { fprintf(stderr, "kernel_launch: hipFuncSetAttribute failed\n"); grid = -1; return; }
        int dev = 0, cus = 0, per_cu = 0;
        (void)hipGetDevice(&dev); (void)hipDeviceGetAttribute(&cus, hipDeviceAttributeMultiprocessorCount, dev);
        if (hipOccupancyMaxActiveBlocksPerMultiprocessor(&per_cu, (const void*)fwd, 512, LDS_BYTES) != hipSuccess || per_cu < 1) fprintf(stderr, "kernel_launch: occupancy query reports %d workgroups per CU\n", per_cu);
        (void)hipGetLastError();
        grid = cus > 0 ? cus : 256;
    }
    if (grid < 0) return;
    (void)hipMemsetAsync((char*)d_ws + WS_CTL, 0, CTL_ZERO_BYTES, stream);
    Args a{};
    for (int i = 0; i < 17; ++i) a.in[i] = (const float*)d_in[i];
    a.out = (float*)d_out; a.ws = (unsigned char*)d_ws;
#if MK_N_LAUNCHES == 1
    a.ph_lo = 0; a.ph_hi = NPHASE; hipLaunchKernelGGL(fwd, dim3(grid), dim3(512), LDS_BYTES, stream, a);
#else
    for (int p = 0; p < NPHASE; ++p) { a.ph_lo = p; a.ph_hi = p + 1; hipLaunchKernelGGL(fwd, dim3(grid), dim3(512), LDS_BYTES, stream, a); }
#endif
}
```

```cpp
#include <hip/hip_runtime.h>
#include <cstdint>
#include <cstdio>

constexpr int NB = 16, SEQ = 2048, DM = 1024, NTOK = NB * SEQ, DIN = 2048, NH = 8, HD = 64, NBLK = 8, MBLK = 256;
constexpr int NE = 16, NCLS = 24, DE = 512, NMOD = 6 * DM;
constexpr float ALPHA = 1.41421356237309515f, LN_EPS = 1e-5f;
constexpr float QSCALE = 0.125f * 1.4426950408889634f;
constexpr int LISTCAP = NTOK;

constexpr size_t MiB = 1u << 20;
constexpr size_t WS_CTL = 0, CTL_ZERO_BYTES = 1 * MiB;
constexpr size_t WS_MOD = 1 * MiB;
constexpr size_t WS_ROPE = 2 * MiB;
constexpr size_t WS_KBAR = 2 * MiB + 256 * 1024;
constexpr size_t WS_LIST = 3 * MiB;
constexpr size_t WS_RW = 6 * MiB;
constexpr size_t WS_WIN = 12 * MiB;
constexpr size_t WS_WOUT = 20 * MiB;
constexpr size_t WS_WGU = 24 * MiB;
constexpr size_t WS_WD = 88 * MiB;
constexpr size_t WS_HB = 120 * MiB;
constexpr size_t WS_QKVP = 184 * MiB;
constexpr size_t WS_AD = 312 * MiB;
constexpr size_t WS_X1 = 376 * MiB;
constexpr size_t WS_END = 504 * MiB;
constexpr int CW_TMO = 0, CW_CNT = 64;

typedef unsigned short bf16_t;
typedef short bf16x8 __attribute__((ext_vector_type(8)));
typedef float f32x4 __attribute__((ext_vector_type(4)));
typedef float f32x16 __attribute__((ext_vector_type(16)));
typedef unsigned u32x4 __attribute__((ext_vector_type(4)));
typedef unsigned u32x2 __attribute__((ext_vector_type(2)));

#define DEVFN __device__ __forceinline__
#define LDS_WAIT() asm volatile("s_waitcnt lgkmcnt(0)" ::: "memory")
#define RLX_AGENT __ATOMIC_RELAXED, __HIP_MEMORY_SCOPE_AGENT

DEVFN float bf_lo(unsigned w) { return __uint_as_float(w << 16); }
DEVFN float bf_hi(unsigned w) { return __uint_as_float(w & 0xffff0000u); }
DEVFN float bf2f(bf16_t v) { return __uint_as_float((unsigned)v << 16); }
DEVFN unsigned f2bf(float f) { unsigned u = __float_as_uint(f); return (u + 0x7fffu + ((u >> 16) & 1u)) >> 16; }
DEVFN unsigned pk2(float lo, float hi) { unsigned r; asm("v_cvt_pk_bf16_f32 %0, %1, %2" : "=v"(r) : "v"(lo), "v"(hi)); return r; }
DEVFN unsigned pk4_fp8(float a, float b, float c, float d) {
    a = __builtin_amdgcn_fmed3f(a, -448.f, 448.f); b = __builtin_amdgcn_fmed3f(b, -448.f, 448.f); c = __builtin_amdgcn_fmed3f(c, -448.f, 448.f); d = __builtin_amdgcn_fmed3f(d, -448.f, 448.f);
    unsigned w = 0u; w = __builtin_amdgcn_cvt_pk_fp8_f32(a, b, w, false); w = __builtin_amdgcn_cvt_pk_fp8_f32(c, d, w, true); return w; }
DEVFN f32x4 f8x4_to_f32(unsigned w, float sc) { const auto lo = __builtin_amdgcn_cvt_pk_f32_fp8(w, false), hi = __builtin_amdgcn_cvt_pk_f32_fp8(w, true); return (f32x4){lo[0] * sc, lo[1] * sc, hi[0] * sc, hi[1] * sc}; }
constexpr float YSCALE = 16.f;
DEVFN int crow(int r, int hi) { return (r & 3) + 8 * (r >> 2) + 4 * hi; }
#define SWZ_XOR(m) (0x1f | ((m) << 10))
DEVFN float swz_xor_add(float v, const int m) {
    switch (m) {
        case 1: return v + __int_as_float(__builtin_amdgcn_ds_swizzle(__float_as_int(v), SWZ_XOR(1)));
        case 2: return v + __int_as_float(__builtin_amdgcn_ds_swizzle(__float_as_int(v), SWZ_XOR(2)));
        case 4: return v + __int_as_float(__builtin_amdgcn_ds_swizzle(__float_as_int(v), SWZ_XOR(4)));
        case 8: return v + __int_as_float(__builtin_amdgcn_ds_swizzle(__float_as_int(v), SWZ_XOR(8)));
        default: return v + __int_as_float(__builtin_amdgcn_ds_swizzle(__float_as_int(v), SWZ_XOR(16)));
    }
}
DEVFN float half_swap_add(float v) { auto rr = __builtin_amdgcn_permlane32_swap(__float_as_uint(v), __float_as_uint(v), false, false); return __uint_as_float(rr[0]) + __uint_as_float(rr[1]); }
DEVFN float wave_sum(float v) {
    v = swz_xor_add(v, 1); v = swz_xor_add(v, 2); v = swz_xor_add(v, 4); v = swz_xor_add(v, 8); v = swz_xor_add(v, 16);
    return half_swap_add(v);
}
__host__ __device__ __forceinline__ int inproj_lgroup(int P) { return P < 16 ? (P >> 2) * 8 + (P & 3) * 2 : ((P - 16) >> 2) * 8 + ((P - 16) & 3) * 2 + 1; }
__host__ __device__ __forceinline__ int inproj_nlog(int n) { return (n & ~255) + inproj_lgroup((n & 255) >> 3) * 8 + (n & 7); }

#define GAS __attribute__((address_space(1)))
#define LAS __attribute__((address_space(3)))
typedef GAS unsigned gu32;
namespace pg8 {
#define PG8_LAS __attribute__((address_space(3)))
typedef unsigned short bf16_t;
typedef short bf16x8 __attribute__((ext_vector_type(8)));
typedef float f32x4 __attribute__((ext_vector_type(4)));
typedef unsigned u32x4 __attribute__((ext_vector_type(4)));
constexpr int BM = 256, BK = 64, HALF = 128, HTB = HALF * BK * 2  , STAGE_BYTES = 8 * HTB, NXCD = 8, WGM = 8;

__host__ __device__ __forceinline__ int lds_byte(int r, int c) { const int st = (r >> 4) * 2 + (c >> 5), rr = r & 15, cc = c & 31, ob = rr * 64 + cc * 2; return st * 1024 + (ob ^ (((ob >> 9) & 1) << 5)); }
__host__ __device__ __forceinline__ void stage_rc(int b, int& R, int& C) { const int st = b / 1024, sb = b % 1024, swz = sb ^ (((sb >> 9) & 1) << 5); R = (st >> 1) * 16 + swz / 64; C = (st & 1) * 32 + (swz % 64) / 2; }
__host__ __device__ __forceinline__ int perm32(int rho) { const int n = rho >> 4, i = rho & 15; return 8 * (i >> 2) + 4 * n + (i & 3); }

struct Unit { int pm, pn; };
struct Gemm { const bf16_t* A; const bf16_t* Bt; int M, N, K; };

struct StaticOrder {
    int nM, nN, nwg, G, c;
    __host__ __device__ void init(int M, int N, int G_, int c_) { nM = M / BM; nN = N / BM; nwg = nM * nN; G = G_; c = c_; }
    __host__ __device__ bool next(int i, Unit& u) const {
        const long L = (long)i * G + c; if (L >= nwg) return false;
        int wgid = (int)L; { const int q = nwg / NXCD, r = nwg % NXCD, xcd = wgid % NXCD, off = wgid / NXCD; wgid = (xcd < r ? xcd * (q + 1) : r * (q + 1) + (xcd - r) * q) + off; }
        const int nig = WGM * nN, gid = wgid / nig, fm = gid * WGM, gsz = (nM - fm) < WGM ? (nM - fm) : WGM;
        u.pm = fm + ((wgid % nig) % gsz); u.pn = (wgid % nig) / gsz; return true;
    }
    __device__ __forceinline__ void a_ready(const Unit&) const {}
    __device__ __forceinline__ void done(const Unit&) const {}
};

__device__ __forceinline__ unsigned cvt_pk_bf16(float lo, float hi) { unsigned r; asm volatile("v_cvt_pk_bf16_f32 %0, %1, %2" : "=v"(r) : "v"(lo), "v"(hi)); return r; }
}
namespace pg8 {
typedef int v8i_t __attribute__((ext_vector_type(8))); typedef int v4i_t __attribute__((ext_vector_type(4)));
__device__ __forceinline__ int pg8_lane_volatile() { int l; asm volatile("v_mbcnt_lo_u32_b32 %0, -1, 0\n\tv_mbcnt_hi_u32_b32 %0, -1, %0" : "=v"(l)); return l; }
template <class Epi, class Sched, bool ALIGN_EPI, bool GATHER, bool KSPLIT, bool FP8 = false, int SCW = 127, int SCA = 127, bool SC2 = false, int SCW2 = 127, int SCA2 = 127>
__device__ __forceinline__ void gemm_phase2(PG8_LAS unsigned char* lds, const int Kbytes, const int ldb_bytes, const Sched& S, const Epi& E, const int tid) {
    typedef typename Sched::UnitT UnitT;
    const int wid = __builtin_amdgcn_readfirstlane(tid >> 6), lane = tid & 63, wr = wid >> 2, wc = wid & 3, fr = lane & 15, fq = lane >> 4;
    int nt = Kbytes / (BK * 2); asm volatile("" : "+s"(nt));
    const int nth = nt / 2;
    unsigned voffB[2];
#pragma unroll
    for (int i = 0; i < 2; ++i) { int R[2], C[2]; stage_rc(tid * 16 + i * 8192, R[i], C[i]); const int Rb = Epi::PERM ? ((R[i] & ~31) + perm32(R[i] & 31)) : R[i]; voffB[i] = (unsigned)(Rb * ldb_bytes + C[i] * 2); }
    const size_t kstep = (size_t)(BK * 2);
    const size_t hstepB = (size_t)HALF * ldb_bytes;
    const unsigned ldsw = (unsigned)wid * 1024u;
    const int aoff = lds_byte(wr * 64 + fr, fq * 8), boff = lds_byte(wc * 32 + fr, fq * 8);
#define PG8_SA(b, h) (((b) * 2 + (h)) * HTB)
#define PG8_SB(b, h) ((4 + (b) * 2 + (h)) * HTB)
#define PG8_STAGE(bufoff, gbase, voff) do { _Pragma("unroll") for (int _i = 0; _i < 2; ++_i) \
        __builtin_amdgcn_global_load_lds((const unsigned*)((const char*)(gbase) + (voff)[_i]), (PG8_LAS unsigned*)(lds + (bufoff) + ldsw + _i * 8192), 16, 0, 0); } while (0)
#define PG8_LDA(dst, b, h) do { _Pragma("unroll") for (int m = 0; m < 4; ++m) _Pragma("unroll") for (int k = 0; k < 2; ++k) dst[m][k] = *(const PG8_LAS bf16x8*)(lds + PG8_SA(b, h) + aoff + m * 2048 + k * 1024); } while (0)
#define PG8_LDB(dst, b, h) do { _Pragma("unroll") for (int n = 0; n < 2; ++n) _Pragma("unroll") for (int k = 0; k < 2; ++k) dst[n][k] = *(const PG8_LAS bf16x8*)(lds + PG8_SB(b, h) + boff + n * 2048 + k * 1024); } while (0)
#define PG8_CAT8(x) __builtin_shufflevector(__builtin_bit_cast(v4i_t, (x)[0]), __builtin_bit_cast(v4i_t, (x)[1]), 0, 1, 2, 3, 4, 5, 6, 7)
#define PG8_MMA(ai, bj, At, Bt) do { __builtin_amdgcn_s_setprio(1); \
        if constexpr (FP8) { _Pragma("unroll") for (int m = 0; m < 4; ++m) _Pragma("unroll") for (int n = 0; n < 2; ++n) \
            acc[ai][bj][m][n] = __builtin_amdgcn_mfma_scale_f32_16x16x128_f8f6f4(PG8_CAT8(Bt[n]), PG8_CAT8(At[m]), acc[ai][bj][m][n], 0, 0, 0, scw_, 0, sca_); } \
        else { _Pragma("unroll") for (int m = 0; m < 4; ++m) _Pragma("unroll") for (int n = 0; n < 2; ++n) _Pragma("unroll") for (int k = 0; k < 2; ++k) \
            acc[ai][bj][m][n] = __builtin_amdgcn_mfma_f32_16x16x32_bf16(Bt[n][k], At[m][k], acc[ai][bj][m][n], 0, 0, 0); } \
        __builtin_amdgcn_s_setprio(0); } while (0)
#define PG8_STAGE1(bufoff, gbase, voff, _i) __builtin_amdgcn_global_load_lds((const unsigned*)((const char*)(gbase) + (voff)[_i]), (PG8_LAS unsigned*)(lds + (bufoff) + ldsw + (_i) * 8192), 16, 0, 0)
#define PG8_MF(ai, bj, m, n, At, Bt) do { if constexpr (FP8) acc[ai][bj][m][n] = __builtin_amdgcn_mfma_scale_f32_16x16x128_f8f6f4(PG8_CAT8(Bt[n]), PG8_CAT8(At[m]), acc[ai][bj][m][n], 0, 0, 0, scw_, 0, sca_); \
        else { acc[ai][bj][m][n] = __builtin_amdgcn_mfma_f32_16x16x32_bf16(Bt[n][0], At[m][0], acc[ai][bj][m][n], 0, 0, 0); acc[ai][bj][m][n] = __builtin_amdgcn_mfma_f32_16x16x32_bf16(Bt[n][1], At[m][1], acc[ai][bj][m][n], 0, 0, 0); } } while (0)
#define PG8_MF2(ai, bj, m, At, Bt) do { PG8_MF(ai, bj, m, 0, At, Bt); PG8_MF(ai, bj, m, 1, At, Bt); PG8_SCHED; } while (0)
#define PG8_CL1(ai, At, S0) do { __builtin_amdgcn_s_setprio(1); PG8_MF2(ai, 0, 0, At, B0); PG8_MF2(ai, 0, 1, At, B0); S0(0); PG8_SCHED; PG8_MF2(ai, 0, 2, At, B0); PG8_MF2(ai, 0, 3, At, B0); S0(1); PG8_SCHED; \
        PG8_MF2(ai, 1, 0, At, B1); PG8_MF2(ai, 1, 1, At, B1); PG8_MF2(ai, 1, 2, At, B1); PG8_MF2(ai, 1, 3, At, B1); __builtin_amdgcn_s_setprio(0); } while (0)
#define PG8_CL2(ai, At, S0, S1, S2) do { __builtin_amdgcn_s_setprio(1); PG8_MF2(ai, 0, 0, At, B0); S0(0); PG8_SCHED; PG8_MF2(ai, 0, 1, At, B0); S0(1); PG8_SCHED; PG8_MF2(ai, 0, 2, At, B0); S1(0); PG8_SCHED; PG8_MF2(ai, 0, 3, At, B0); S1(1); PG8_SCHED; \
        PG8_MF2(ai, 1, 0, At, B1); S2(0); PG8_SCHED; PG8_MF2(ai, 1, 1, At, B1); S2(1); PG8_SCHED; PG8_MF2(ai, 1, 2, At, B1); PG8_MF2(ai, 1, 3, At, B1); __builtin_amdgcn_s_setprio(0); } while (0)
#define PG8_WAIT_V(n) asm volatile("s_waitcnt vmcnt(" #n ")" ::: "memory")
#define PG8_WAIT_L(n) asm volatile("s_waitcnt lgkmcnt(" #n ")" ::: "memory")
#define PG8_BAR __builtin_amdgcn_s_barrier()
#define PG8_SCHED __builtin_amdgcn_sched_barrier(0)
#define PG8_PIN(ai) asm volatile("" :: "v"(acc[ai][0][0][0]), "v"(acc[ai][0][0][1]), "v"(acc[ai][0][1][0]), "v"(acc[ai][0][1][1]), "v"(acc[ai][0][2][0]), "v"(acc[ai][0][2][1]), "v"(acc[ai][0][3][0]), "v"(acc[ai][0][3][1]), \
        "v"(acc[ai][1][0][0]), "v"(acc[ai][1][0][1]), "v"(acc[ai][1][1][0]), "v"(acc[ai][1][1][1]), "v"(acc[ai][1][2][0]), "v"(acc[ai][1][2][1]), "v"(acc[ai][1][3][0]), "v"(acc[ai][1][3][1]))
#define PG8_BK(cb, cb2, kt) ((KSPLIT && (kt) >= nth) ? (cb2) + (size_t)((kt) - nth) * kstep : (cb) + (size_t)(kt) * kstep)
    UnitT cur, nxt; int ui = 0;
    if (!S.next(0, cur)) return;
    f32x4 acc[2][2][4][2];
#pragma unroll
    for (int a = 0; a < 2; ++a)
#pragma unroll
        for (int b = 0; b < 2; ++b)
#pragma unroll
            for (int m = 0; m < 4; ++m)
#pragma unroll
                for (int n = 0; n < 2; ++n) acc[a][b][m][n] = (f32x4){0.f, 0.f, 0.f, 0.f};
    bf16x8 At[4][2], B0[2][2], B1[2][2];
    unsigned vA[2][2];
    S.arows(cur, tid, vA);
    PG8_LAS u32x4* const vslot = (PG8_LAS u32x4*)(lds + STAGE_BYTES + 2048) + tid;
    const char* cA = S.aptr(cur); const char* cB = S.bptr(cur); const char* cB2 = KSPLIT ? S.bptr2(cur) : cB;
    PG8_STAGE(PG8_SB(0, 0), cB, voffB); PG8_STAGE(PG8_SB(0, 1), cB + hstepB, voffB); PG8_STAGE(PG8_SA(0, 0), cA, vA[0]); PG8_STAGE(PG8_SA(0, 1), cA, vA[1]);
    if (wr == 1) PG8_BAR;
    PG8_WAIT_V(2); PG8_BAR;
    PG8_STAGE(PG8_SB(1, 0), PG8_BK(cB, cB2, 1), voffB); PG8_STAGE(PG8_SA(1, 0), cA + kstep, vA[0]); PG8_STAGE(PG8_SB(1, 1), PG8_BK(cB, cB2, 1) + hstepB, voffB);
    PG8_WAIT_V(6); PG8_BAR;
    for (;;) {
        const bool has_next = S.next(ui + 1, nxt);
        const char* nA = has_next ? S.aptr(nxt) : cA; const char* nB = has_next ? S.bptr(nxt) : cB; const char* nB2 = (KSPLIT && has_next) ? S.bptr2(nxt) : cB2;
        if (GATHER && has_next) { unsigned vn_[2][2]; S.arows(nxt, wid * 64 + pg8_lane_volatile(), vn_); *vslot = (u32x4){vn_[0][0], vn_[0][1], vn_[1][0], vn_[1][1]}; }
        for (int t = 0; t < nt; t += 2) {
            const bool last = (t == nt - 2);
            const int scw_ = ((SC2 && t >= nth) ? SCW2 : SCW) * 0x01010101, sca_ = ((SC2 && t >= nth) ? SCA2 : SCA) * 0x01010101; (void)scw_; (void)sca_;
            const char* a1 = cA + (size_t)(t + 1) * kstep;
            const char* a2 = last ? nA : cA + (size_t)(t + 2) * kstep;
            const char* b2 = last ? nB : PG8_BK(cB, cB2, t + 2);
            const char* b3 = last ? (KSPLIT ? PG8_BK(nB, nB2, 1) : nB + kstep) : PG8_BK(cB, cB2, t + 3);
            const char* a3 = a2 + kstep;
#define ST_A11(i) PG8_STAGE1(PG8_SA(1, 1), a1, vA[1], i)
#define ST_B00(i) PG8_STAGE1(PG8_SB(0, 0), b2, voffB, i)
#define ST_B01(i) PG8_STAGE1(PG8_SB(0, 1), b2 + hstepB, voffB, i)
#define ST_A00(i) PG8_STAGE1(PG8_SA(0, 0), a2, vA[0], i)
#define ST_A01(i) PG8_STAGE1(PG8_SA(0, 1), a2, vA[1], i)
#define ST_B10(i) PG8_STAGE1(PG8_SB(1, 0), b3, voffB, i)
#define ST_B11(i) PG8_STAGE1(PG8_SB(1, 1), b3 + hstepB, voffB, i)
#define ST_A10(i) PG8_STAGE1(PG8_SA(1, 0), a3, vA[0], i)
            PG8_LDB(B0, 0, 0); PG8_LDB(B1, 0, 1); PG8_SCHED; PG8_LDA(At, 0, 0);
            PG8_WAIT_V(6); PG8_WAIT_L(0); PG8_BAR; PG8_CL1(0, At, ST_A11); PG8_PIN(0); PG8_BAR; PG8_SCHED;
            if (GATHER && last && has_next) { const u32x4 vn_ = *vslot; vA[0][0] = vn_.x; vA[0][1] = vn_.y; vA[1][0] = vn_.z; vA[1][1] = vn_.w; }
            PG8_LDA(At, 0, 1);
            PG8_WAIT_V(2); PG8_WAIT_L(0); PG8_BAR; PG8_CL2(1, At, ST_B00, ST_B01, ST_A00); PG8_PIN(1); PG8_BAR; PG8_SCHED;
            PG8_LDB(B0, 1, 0); PG8_LDB(B1, 1, 1); PG8_SCHED; PG8_LDA(At, 1, 0);
            PG8_WAIT_V(6); PG8_WAIT_L(0); PG8_BAR; PG8_CL1(0, At, ST_A01); PG8_PIN(0); PG8_BAR; PG8_SCHED;
            PG8_LDA(At, 1, 1);
            PG8_WAIT_V(2); PG8_WAIT_L(0); PG8_BAR; PG8_CL2(1, At, ST_B10, ST_B11, ST_A10); PG8_PIN(1); PG8_BAR; PG8_SCHED;
#undef ST_A11
#undef ST_B00
#undef ST_B01
#undef ST_A00
#undef ST_A01
#undef ST_B10
#undef ST_B11
#undef ST_A10
        }
        if constexpr (ALIGN_EPI) { if (wr == 0) PG8_BAR; }
        if constexpr (!Epi::AFTER_DRAIN) { const int le_ = pg8_lane_volatile(); E(acc, cur, wr, wc, le_ & 15, le_ >> 4); }
        if (!has_next) break;
#pragma unroll
        for (int a = 0; a < 2; ++a)
#pragma unroll
            for (int b = 0; b < 2; ++b)
#pragma unroll
                for (int m = 0; m < 4; ++m)
#pragma unroll
                    for (int n = 0; n < 2; ++n) acc[a][b][m][n] = (f32x4){0.f, 0.f, 0.f, 0.f};
        cur = nxt; cA = nA; cB = nB; cB2 = nB2; ++ui;
        if constexpr (ALIGN_EPI) { if (wr == 1) PG8_BAR; }
    }
    PG8_WAIT_V(0);
    if constexpr (!ALIGN_EPI) { if (wr == 0) PG8_BAR; }
    PG8_BAR;
    if constexpr (Epi::AFTER_DRAIN) { E.fused(acc, cur, wr, wc, fr, fq, lds, wid, lane); }
#undef PG8_SA
#undef PG8_SB
#undef PG8_STAGE
#undef PG8_LDA
#undef PG8_LDB
#undef PG8_MMA
#undef PG8_WAIT_V
#undef PG8_WAIT_L
#undef PG8_BAR
#undef PG8_SCHED
#undef PG8_BK
#undef PG8_PIN
#undef PG8_STAGE1
#undef PG8_MF
#undef PG8_MF2
#undef PG8_CL1
#undef PG8_CL2
#undef PG8_CAT8
}
}
namespace pg8 {
DEVFN unsigned pkbf(float lo, float hi) { return cvt_pk_bf16(lo, hi); }
struct DenseSched {
    typedef Unit UnitT;
    StaticOrder so; const char* A; const char* Bt; int lda, ldb;
    DEVFN bool next(int i, Unit& u) const { return so.next(i, u); }
    DEVFN const char* aptr(const Unit&) const { return A; }
    DEVFN void arows(const Unit& u, const int tid_, unsigned (&v)[2][2]) const {
        int R[2], C[2]; { int t_ = tid_; asm volatile("" : "+v"(t_)); stage_rc(t_ * 16, R[0], C[0]); stage_rc(t_ * 16 + 8192, R[1], C[1]); }
#pragma unroll
        for (int h = 0; h < 2; ++h)
#pragma unroll
            for (int i = 0; i < 2; ++i) v[h][i] = (unsigned)((u.pm * BM + h * HALF + R[i]) * lda + C[i] * 2); }
    DEVFN const char* bptr(const Unit& u) const { return Bt + (size_t)u.pn * BM * ldb; }
    DEVFN const char* bptr2(const Unit& u) const { return bptr(u); }
};
struct EpiInproj {
    static constexpr bool PERM = true, AFTER_DRAIN = false;
    bf16_t* O; const float* rope; float* kbar;
    DEVFN void operator()(f32x4 (&acc)[2][2][4][2], const Unit& u, int wr, int wc, int fr, int fq) const {
        const int pn = u.pn, row0 = u.pm * BM + wr * 64 + fr;
        if (pn < 4 && fq == 0) {
#pragma unroll
            for (int ai = 0; ai < 2; ++ai)
#pragma unroll
                for (int m = 0; m < 4; ++m) { const int t = (row0 + ai * HALF + m * 16) & (SEQ - 1); const f32x4* rp = (const f32x4*)(rope + t * 16);
#pragma unroll
                    for (int q = 0; q < 4; ++q) { const f32x4 cs = rp[q];
                        { const int d = 2 * q, n = d >> 2, e = d & 3; const float x1 = acc[ai][0][m][n][e], x2 = acc[ai][1][m][n][e]; acc[ai][0][m][n][e] = x1 * cs[0] - x2 * cs[1]; acc[ai][1][m][n][e] = x2 * cs[0] + x1 * cs[1]; }
                        { const int d = 2 * q + 1, n = d >> 2, e = d & 3; const float x1 = acc[ai][0][m][n][e], x2 = acc[ai][1][m][n][e]; acc[ai][0][m][n][e] = x1 * cs[2] - x2 * cs[3]; acc[ai][1][m][n][e] = x2 * cs[2] + x1 * cs[3]; } } }
        }
        if (pn == 2 || pn == 3) {
            float* kb = kbar + (size_t)((((u.pm >> 3) * NH + (pn - 2) * 4 + wc) * NBLK + (u.pm & 7)) * HD);
#pragma unroll
            for (int bj = 0; bj < 2; ++bj)
#pragma unroll
                for (int n = 0; n < 2; ++n)
#pragma unroll
                    for (int e = 0; e < 4; ++e) { float s = 0.f;
#pragma unroll
                        for (int ai = 0; ai < 2; ++ai)
#pragma unroll
                            for (int m = 0; m < 4; ++m) s += acc[ai][bj][m][n][e];
                        s = swz_xor_add(s, 1); s = swz_xor_add(s, 2); s = swz_xor_add(s, 4); s = swz_xor_add(s, 8);
                        if (fr == 0) atomicAdd(kb + (2 * fq + bj) * 8 + 4 * n + e, s * (1.f / MBLK)); }
        }
        if (pn < 2) {
#pragma unroll
            for (int ai = 0; ai < 2; ++ai)
#pragma unroll
                for (int bj = 0; bj < 2; ++bj)
#pragma unroll
                    for (int m = 0; m < 4; ++m) { acc[ai][bj][m][0] = acc[ai][bj][m][0] * QSCALE; acc[ai][bj][m][1] = acc[ai][bj][m][1] * QSCALE; } }
#pragma unroll
        for (int ai = 0; ai < 2; ++ai)
#pragma unroll
            for (int m = 0; m < 4; ++m) { bf16_t* rowp = O + (size_t)(row0 + ai * HALF + m * 16) * DIN + pn * BM + wc * 64;
#pragma unroll
                for (int bj = 0; bj < 2; ++bj) { const f32x4 v0 = acc[ai][bj][m][0], v1 = acc[ai][bj][m][1];
                    u32x4 w; w.x = pkbf(v0[0], v0[1]); w.y = pkbf(v0[2], v0[3]); w.z = pkbf(v1[0], v1[1]); w.w = pkbf(v1[2], v1[3]);
                    *(u32x4*)(rowp + (2 * fq + bj) * 8) = w; } }
    }
};
struct EpiF8 {
    static constexpr bool PERM = true, AFTER_DRAIN = false;
    unsigned char* O; int ldc;
    DEVFN void operator()(f32x4 (&acc)[2][2][4][2], const Unit& u, int wr, int wc, int fr, int fq) const {
#pragma unroll
        for (int ai = 0; ai < 2; ++ai)
#pragma unroll
            for (int m = 0; m < 4; ++m) { unsigned char* rowp = O + (size_t)(u.pm * BM + ai * HALF + wr * 64 + m * 16 + fr) * ldc + u.pn * BM + wc * 64 + fq * 16;
                const f32x4 a0 = acc[ai][0][m][0], a1 = acc[ai][0][m][1], b0 = acc[ai][1][m][0], b1 = acc[ai][1][m][1];
                u32x4 w; w.x = pk4_fp8(a0[0], a0[1], a0[2], a0[3]); w.y = pk4_fp8(a1[0], a1[1], a1[2], a1[3]); w.z = pk4_fp8(b0[0], b0[1], b0[2], b0[3]); w.w = pk4_fp8(b1[0], b1[1], b1[2], b1[3]);
                *(u32x4*)rowp = w; }
    }
};
struct MoeUnit { int pm, pn, cls, j, cnt; };
struct MoeBase {
    const PG8_LAS int* tp; const PG8_LAS int* cnt; const PG8_LAS int* tcls; int nunits, G, c, npn_shift;
    DEVFN bool next_(int i, MoeUnit& u) const {
        const int L = i * G + c; if (L >= nunits) return false;
        u.pm = L >> npn_shift; u.pn = L & ((1 << npn_shift) - 1);
        const int cls = __builtin_amdgcn_readfirstlane(tcls[u.pm]);
        u.cls = cls; u.j = u.pm - __builtin_amdgcn_readfirstlane(tp[cls]); u.cnt = __builtin_amdgcn_readfirstlane(cnt[cls]); return true; }
};
DEVFN void moe_experts(int cls, int& e1, int& e2) { const int g = cls / 6, p = cls % 6; const int lo = p < 3 ? 0 : (p < 5 ? 1 : 2), hi = p < 3 ? p + 1 : (p < 5 ? p - 1 : 3); e1 = g * 4 + lo; e2 = g * 4 + hi; }
struct GateUpSched : MoeBase {
    typedef MoeUnit UnitT;
    const char* HB; const int* list; const char* W;
    DEVFN bool next(int i, MoeUnit& u) const { return next_(i, u); }
    DEVFN const char* aptr(const MoeUnit&) const { return HB; }
    DEVFN void arows(const MoeUnit& u, const int tid_, unsigned (&v)[2][2]) const {
        int R[2], C[2]; { int t_ = tid_; asm volatile("" : "+v"(t_)); stage_rc(t_ * 16, R[0], C[0]); stage_rc(t_ * 16 + 8192, R[1], C[1]); }
#pragma unroll
        for (int h = 0; h < 2; ++h)
#pragma unroll
            for (int i = 0; i < 2; ++i) { const int li = 256 * u.j + h * HALF + R[i]; const int tok = list[(size_t)u.cls * LISTCAP + (li < u.cnt ? li : 256 * u.j)]; v[h][i] = (unsigned)(tok * DM + C[i] * 2); } }
    DEVFN const char* bptr(const MoeUnit& u) const { int e1, e2; moe_experts(u.cls, e1, e2); return W + (size_t)(u.pn < 4 ? e1 : e2) * DM * DM + (size_t)(u.pn & 3) * BM * DM; }
    DEVFN const char* bptr2(const MoeUnit& u) const { return bptr(u); }
};
struct DownSched : MoeBase {
    typedef MoeUnit UnitT;
    const char* ACT; const char* W;
    DEVFN bool next(int i, MoeUnit& u) const { return next_(i, u); }
    DEVFN const char* aptr(const MoeUnit&) const { return ACT; }
    DEVFN void arows(const MoeUnit& u, const int tid_, unsigned (&v)[2][2]) const {
        int R[2], C[2]; { int t_ = tid_; asm volatile("" : "+v"(t_)); stage_rc(t_ * 16, R[0], C[0]); stage_rc(t_ * 16 + 8192, R[1], C[1]); }
#pragma unroll
        for (int h = 0; h < 2; ++h)
#pragma unroll
            for (int i = 0; i < 2; ++i) v[h][i] = (unsigned)((u.pm * BM + h * HALF + R[i]) * DM + C[i] * 2); }
    DEVFN const char* bptr(const MoeUnit& u) const { int e1, e2; moe_experts(u.cls, e1, e2); return W + (size_t)e1 * DM * DE + (size_t)u.pn * BM * DE; }
    DEVFN const char* bptr2(const MoeUnit& u) const { int e1, e2; moe_experts(u.cls, e1, e2); return W + (size_t)e2 * DM * DE + (size_t)u.pn * BM * DE; }
};
struct EpiGateUp {
    static constexpr bool PERM = true, AFTER_DRAIN = false;
    unsigned char* ACT; const float* rw;
    DEVFN void operator()(f32x4 (&acc)[2][2][4][2], const MoeUnit& u, int wr, int wc, int fr, int fq) const {
        const int half = u.pn >> 2, jt = u.pn & 3;
        float wg8[2][4];
#pragma unroll
        for (int ai = 0; ai < 2; ++ai)
#pragma unroll
            for (int m = 0; m < 4; ++m) { const int li = 256 * u.j + ai * HALF + wr * 64 + m * 16 + fr; wg8[ai][m] = rw[((size_t)u.cls * LISTCAP + (li < u.cnt ? li : 256 * u.j)) * 2 + half]; }
#pragma unroll
        for (int ai = 0; ai < 2; ++ai)
#pragma unroll
            for (int mp = 0; mp < 4; mp += 2) {
                u32x2 w2[2];
#pragma unroll
                for (int q = 0; q < 2; ++q) { const int m = mp + q; const int li = 256 * u.j + ai * HALF + wr * 64 + m * 16 + fr;
                    const float wgt = li < u.cnt ? 8.f * wg8[ai][m] : 0.f;
                    f32x4 o[2];
#pragma unroll
                    for (int n = 0; n < 2; ++n) {
                        const f32x4 g = acc[ai][0][m][n], t = g * (-1.4426950408889634f);
                        f32x4 d; d.x = __builtin_amdgcn_exp2f(t.x); d.y = __builtin_amdgcn_exp2f(t.y); d.z = __builtin_amdgcn_exp2f(t.z); d.w = __builtin_amdgcn_exp2f(t.w);
                        d = d + 1.f;
                        f32x4 r; r.x = __builtin_amdgcn_rcpf(d.x); r.y = __builtin_amdgcn_rcpf(d.y); r.z = __builtin_amdgcn_rcpf(d.z); r.w = __builtin_amdgcn_rcpf(d.w);
                        o[n] = (g * r) * (acc[ai][1][m][n] * wgt); }
                    w2[q].x = pk4_fp8(o[0][0], o[0][1], o[0][2], o[0][3]); w2[q].y = pk4_fp8(o[1][0], o[1][1], o[1][2], o[1][3]); }
                const auto s0 = __builtin_amdgcn_permlane16_swap(w2[0].x, w2[1].x, false, false), s1 = __builtin_amdgcn_permlane16_swap(w2[0].y, w2[1].y, false, false);
                const u32x4 w = {s0[0], s1[0], s0[1], s1[1]};
                const int lr = ai * HALF + wr * 64 + (mp + (fq & 1)) * 16 + fr;
                *(u32x4*)(ACT + (size_t)(u.pm * BM + lr) * DM + half * 512 + jt * 128 + wc * 32 + (fq & 2) * 8) = w; }
    }
};
struct EpiDown {
    static constexpr bool PERM = true, AFTER_DRAIN = false;
    unsigned char* Y2; const int* list;
    DEVFN void operator()(f32x4 (&acc)[2][2][4][2], const MoeUnit& u, int wr, int wc, int fr, int fq_) const {
        int fq = fq_; asm volatile("" : "+v"(fq));
        int tk8[2][4];
#pragma unroll
        for (int ai = 0; ai < 2; ++ai)
#pragma unroll
            for (int m = 0; m < 4; ++m) { const int li = 256 * u.j + ai * HALF + wr * 64 + m * 16 + fr; tk8[ai][m] = list[(size_t)u.cls * LISTCAP + (li < u.cnt ? li : 256 * u.j)]; }
#pragma unroll
        for (int ai = 0; ai < 2; ++ai)
#pragma unroll
            for (int m = 0; m < 4; ++m) { const int li = 256 * u.j + ai * HALF + wr * 64 + m * 16 + fr;
                if (li < u.cnt) { const int tok = tk8[ai][m]; unsigned char* rowp = Y2 + (size_t)tok * DM + u.pn * BM + wc * 64 + fq * 16;
                    const f32x4 a0 = acc[ai][0][m][0], a1 = acc[ai][0][m][1], b0 = acc[ai][1][m][0], b1 = acc[ai][1][m][1];
                    u32x4 w; w.x = pk4_fp8(a0[0], a0[1], a0[2], a0[3]); w.y = pk4_fp8(a1[0], a1[1], a1[2], a1[3]); w.z = pk4_fp8(b0[0], b0[1], b0[2], b0[3]); w.w = pk4_fp8(b1[0], b1[1], b1[2], b1[3]);
                    *(u32x4*)rowp = w; } }
    }
};
}

#include <hip/hip_bf16.h>
#include <cmath>
namespace attn_body {
using bf16=__hip_bfloat16;
using bf16x8=__attribute__((ext_vector_type(8)))short;
using s16x4=__attribute__((ext_vector_type(4)))short;
using f32x16=__attribute__((ext_vector_type(16)))float;
using u32x4=__attribute__((ext_vector_type(4)))unsigned;
constexpr int BATCH=16,NHEAD=8,SEQ=2048,D=64,QP=2048,OP=1024;
constexpr int NW=8,QBLK=32,QB=QBLK*NW,KVBLK=64,NQB=SEQ/QB;
constexpr int ATTN_PITCH=QP, ATTN_UNIT_ROWS=QB;
__device__ __forceinline__ int crow(int r,int hi){return (r&3)+8*(r>>2)+4*hi;}
#define SBAR() __builtin_amdgcn_sched_barrier(0)
__device__ __forceinline__ void cmask(f32x16&p0,f32x16&p1,int jb,int qrel,int hi){
  const float NEG=-INFINITY; int kb=64*jb+4*hi;
  #pragma unroll
  for(int r=0;r<16;++r){int kv=kb+(r&3)+8*(r>>2); if(kv>qrel)p0[r]=NEG; if(kv+32>qrel)p1[r]=NEG;}
}

constexpr int NSLOT=3, SLOTB=8192;
constexpr int LDS_K=0, LDS_V=NSLOT*SLOTB, LDS_WS=2*NSLOT*SLOTB, LDS_OST=LDS_WS+NW*64*4, LDS_KBAR=LDS_OST+NW*4096, LDS_BYTES=LDS_KBAR+2048;
constexpr float NEGBIG=-1.0e30f; typedef float f32x4_t __attribute__((ext_vector_type(4)));
__device__ __forceinline__ float bfs(short v){return __uint_as_float(((unsigned)(unsigned short)v)<<16);}
constexpr float C2=0.125f*1.4426950408889634f;
__device__ __forceinline__ void glds16(const void*gsrc,unsigned lds_dst){unsigned keep;
  asm volatile("s_mov_b32 %0, m0\n\ts_mov_b32 m0, %2\n\ts_nop 0\n\tglobal_load_lds_dwordx4 %1, off\n\ts_mov_b32 m0, %0":"=&s"(keep):"v"(gsrc),"s"(lds_dst):"memory");}
__device__ __forceinline__ float max3f(float a,float b,float c){float r;asm("v_max3_f32 %0, %1, %2, %3":"=v"(r):"v"(a),"v"(b),"v"(c));return r;}
__device__ __forceinline__ float max2f(float a,float b){float r;asm("v_max_f32_e32 %0, %1, %2":"=v"(r):"v"(a),"v"(b));return r;}
__device__ __forceinline__ float fadd_s(float a,float b){float r;asm("v_add_f32_e32 %0, %1, %2":"=v"(r):"v"(a),"v"(b));return r;}
__device__ __forceinline__ float fsub_s(float a,float b){float r;asm("v_sub_f32_e32 %0, %1, %2":"=v"(r):"v"(a),"v"(b));return r;}
typedef float f32x2_t __attribute__((ext_vector_type(2))); typedef __bf16 bf16x2_t __attribute__((ext_vector_type(2)));
__device__ __forceinline__ unsigned cvtpk_s(float lo,float hi){f32x2_t v={lo,hi};bf16x2_t b=__builtin_convertvector(v,bf16x2_t);return __builtin_bit_cast(unsigned,b);}
#define WAIT_BAR(N) asm volatile("s_waitcnt vmcnt(" #N ") lgkmcnt(0)\n\ts_barrier":::"memory")

__device__ __forceinline__ void qkt(f32x16&p0,f32x16&p1,const char*Kslot,const bf16x8*qr,const f32x16&negm,int r32,int hi){
  const char*kb=Kslot+hi*1024+r32*16;
  #pragma unroll
  for(int d0=0;d0<4;++d0){
    const bf16x8 b0=*reinterpret_cast<const bf16x8*>(kb+d0*2048);
    const bf16x8 b1=*reinterpret_cast<const bf16x8*>(kb+d0*2048+512);
    if(d0==0){p0=__builtin_amdgcn_mfma_f32_32x32x16_bf16(b0,qr[0],negm,0,0,0);p1=__builtin_amdgcn_mfma_f32_32x32x16_bf16(b1,qr[0],negm,0,0,0);}
    else{p0=__builtin_amdgcn_mfma_f32_32x32x16_bf16(b0,qr[d0],p0,0,0,0);p1=__builtin_amdgcn_mfma_f32_32x32x16_bf16(b1,qr[d0],p1,0,0,0);}}
}
typedef __attribute__((address_space(3))) const char* lds_cptr;
typedef short v4i16_t __attribute__((ext_vector_type(4)));
__device__ __forceinline__ void kload8(bf16x8*kf,lds_cptr kp){
  kf[0]=*(const __attribute__((address_space(3))) bf16x8*)(kp);      kf[1]=*(const __attribute__((address_space(3))) bf16x8*)(kp+512);
  kf[2]=*(const __attribute__((address_space(3))) bf16x8*)(kp+2048); kf[3]=*(const __attribute__((address_space(3))) bf16x8*)(kp+2560);
  kf[4]=*(const __attribute__((address_space(3))) bf16x8*)(kp+4096); kf[5]=*(const __attribute__((address_space(3))) bf16x8*)(kp+4608);
  kf[6]=*(const __attribute__((address_space(3))) bf16x8*)(kp+6144); kf[7]=*(const __attribute__((address_space(3))) bf16x8*)(kp+6656);
}
__device__ __forceinline__ void kload2(bf16x8*kf,lds_cptr kp,int j){ kf[2*j]=*(const __attribute__((address_space(3))) bf16x8*)(kp+j*2048); kf[2*j+1]=*(const __attribute__((address_space(3))) bf16x8*)(kp+j*2048+512); }
__device__ __forceinline__ s16x4 vtr(lds_cptr p){ return __builtin_bit_cast(s16x4,__builtin_amdgcn_ds_read_tr16_b64_v4i16((__attribute__((address_space(3))) v4i16_t*)p)); }
__device__ __forceinline__ float rowmax(const f32x16&p0,const f32x16&p1){
  float a=max3f(p0[0],p0[1],p1[0]),b=max3f(p0[2],p0[3],p1[1]);a=max3f(a,p1[2],p1[3]);
  #pragma unroll
  for(int r=4;r<16;r+=4){a=max3f(a,p0[r],p0[r+1]);b=max3f(b,p0[r+2],p0[r+3]);a=max3f(a,p1[r],p1[r+1]);b=max3f(b,p1[r+2],p1[r+3]);}
  const float m=max2f(a,b);
  auto rr=__builtin_amdgcn_permlane32_swap(__float_as_uint(m),__float_as_uint(m),false,false);
  return max2f(__uint_as_float(rr[0]),__uint_as_float(rr[1]));
}
__device__ __forceinline__ void pv(f32x16*o,int vb,bf16x8 pa0,bf16x8 pa1,bf16x8 pa2,bf16x8 pa3){
  #pragma unroll
  for(int d0=0;d0<2;++d0){s16x4 lo[4],hi[4];
    #pragma unroll
    for(int ks=0;ks<4;++ks){
      asm volatile("ds_read_b64_tr_b16 %0,%1 offset:%c2":"=&v"(lo[ks]):"v"(vb),"i"(d0*4096+ks*1024):"memory");
      asm volatile("ds_read_b64_tr_b16 %0,%1 offset:%c2":"=&v"(hi[ks]):"v"(vb),"i"(d0*4096+ks*1024+512):"memory");}
    asm volatile("s_waitcnt lgkmcnt(0)":::"memory");SBAR();
    #define PK(k) (bf16x8){lo[k][0],lo[k][1],lo[k][2],lo[k][3],hi[k][0],hi[k][1],hi[k][2],hi[k][3]}
    o[d0]=__builtin_amdgcn_mfma_f32_32x32x16_bf16(pa0,PK(0),o[d0],0,0,0);
    o[d0]=__builtin_amdgcn_mfma_f32_32x32x16_bf16(pa1,PK(1),o[d0],0,0,0);
    o[d0]=__builtin_amdgcn_mfma_f32_32x32x16_bf16(pa2,PK(2),o[d0],0,0,0);
    o[d0]=__builtin_amdgcn_mfma_f32_32x32x16_bf16(pa3,PK(3),o[d0],0,0,0);
    #undef PK
  }
}

#ifndef ATTN_STORE16
#define ATTN_STORE16(p,v) (*(u32x4*)(p)=(v))
#endif
template<int THRL> __device__ __forceinline__ void attn_unit(int b,int h,int qb,const bf16*Q,const bf16*__restrict__ K,const bf16*__restrict__ V,bf16*O,const float*__restrict__ kbar,char*shm,const int tid){
  const int lane=tid&63,r32=lane&31,hi=lane>>5; const int wid=__builtin_amdgcn_readfirstlane(tid>>6);
  float kbv=0.f; { int tk=tid; asm volatile("":"+v"(tk)); if(qb>=4&&tk<448)kbv=kbar[tk]; }
  const long rowbase=(long)b*SEQ; const int q0=qb*QB;
  const bf16*Qw=Q+(rowbase+q0+wid*QBLK)*QP+h*D;
  const bf16*Kh=K+rowbase*QP+h*D,*Vh=V+rowbase*QP+h*D;
  const unsigned lds0=(unsigned)(uintptr_t)shm;
  float*wsf=(float*)(shm+LDS_WS)+wid*64;
  const bf16*ksrc=Kh+(long)lane*QP+wid*8;
  const bf16*vsrc=Vh+(long)(16*(wid&3)+(lane>>2))*QP+(wid>>2)*32+(lane&3)*8;
  const unsigned kdst=lds0+LDS_K+wid*1024, vdst=lds0+LDS_V+wid*1024;
  #define DMA_K(t,slot) glds16(ksrc+(long)(t)*KVBLK*QP,(unsigned)__builtin_amdgcn_readfirstlane(kdst+(slot)))
  #define DMA_V(t,slot) glds16(vsrc+(long)(t)*KVBLK*QP,(unsigned)__builtin_amdgcn_readfirstlane(vdst+(slot)))
  const int vb0=(int)(lds0+LDS_V)+((lane>>4)&1)*32+(lane&3)*8+(4*hi+((lane&15)>>2))*64;
  const char*Kbase=shm+LDS_K; bf16x8 kf[8];
  const lds_cptr shm3=(lds_cptr)shm; const lds_cptr kp0=shm3+LDS_K+hi*1024+r32*16; const lds_cptr vp0=shm3+LDS_V+((lane>>4)&1)*32+(lane&3)*8+(4*hi+((lane&15)>>2))*64;
  const int NT=(q0+QB)/KVBLK;
  DMA_K(0,0);DMA_V(0,0);DMA_K(1,SLOTB);
  bf16x8 qr[4];
  #pragma unroll
  for(int d0=0;d0<4;++d0)qr[d0]=*reinterpret_cast<const bf16x8*>(&Qw[(long)r32*QP+d0*16+hi*8]);
  float mhat=0.f,l_reg=0.f;f32x16 o[2];o[0]=f32x16{};o[1]=f32x16{};f32x16 negm=f32x16{};asm volatile("":"+v"(negm));
  const int qrel=wid*QBLK+r32;
  #define CMASK(P0,P1,t) do{int jb_=(t)-(NT-4); if(jb_>=0)cmask(P0,P1,jb_,qrel,hi);}while(0)
  bool resc=false;
  #define START(P0,P1) do{ const float rm=rowmax(P0,P1); resc=false; \
    { const float dl=selcur?rm:-64.f; mhat=fadd_s(mhat,dl); \
      _Pragma("unroll") for(int r=0;r<16;++r){P0[r]=fsub_s(P0[r],dl);P1[r]=fsub_s(P1[r],dl);} \
      { const float nv_=selcur?-mhat:NEGBIG; _Pragma("unroll") for(int r=0;r<16;++r)negm[r]=nv_; } asm volatile("":"+v"(negm)); } \
    _Pragma("unroll") for(int r=0;r<16;++r)P0[r]=__builtin_amdgcn_exp2f(P0[r]); }while(0)
  #define RESC() do{ if(resc){ asm volatile("s_waitcnt lgkmcnt(0)":::"memory"); \
      _Pragma("unroll") for(int d_=0;d_<2;++d_) _Pragma("unroll") for(int r=0;r<16;++r)o[d_][r]*=wsf[crow(r,hi)]; } }while(0)
  f32x16 pA0,pA1,pB0,pB1;
  int sl_prev=0,sl_cur=0,sl_next=SLOTB;
  #define ROT() do{sl_prev=sl_cur;sl_cur=sl_next;sl_next=(sl_next==(NSLOT-1)*SLOTB)?0:sl_next+SLOTB;}while(0)
  DMA_K(2,2*SLOTB);
  if(qb>=4){ if(tid<448){ const unsigned hb=__builtin_bit_cast(unsigned,kbv); const unsigned hr=(hb+0x7fffu+((hb>>16)&1u))&0xffff0000u; const float lo_=kbv-__builtin_bit_cast(float,hr); const unsigned lb=__builtin_bit_cast(unsigned,lo_);
      ((unsigned short*)(shm+LDS_KBAR))[tid]=(unsigned short)(hr>>16); ((unsigned short*)(shm+LDS_KBAR+1024))[tid]=(unsigned short)((lb+0x7fffu+((lb>>16)&1u))>>16); } }
  WAIT_BAR(3);
  unsigned bmask=(1u<<(qb+1))-1u;
  if(qb>=4){ float gsc[8];
    { const lds_cptr kb3=shm3+LDS_KBAR+(r32&7)*128+hi*16; f32x16 g=f32x16{};
      _Pragma("unroll") for(int d0=0;d0<4;++d0){ const bf16x8 ah=*(const __attribute__((address_space(3))) bf16x8*)(kb3+d0*32), al=*(const __attribute__((address_space(3))) bf16x8*)(kb3+1024+d0*32);
        g=__builtin_amdgcn_mfma_f32_32x32x16_bf16(ah,qr[d0],g,0,0,0); g=__builtin_amdgcn_mfma_f32_32x32x16_bf16(al,qr[d0],g,0,0,0); }
      _Pragma("unroll") for(int r=0;r<4;++r){ auto rr=__builtin_amdgcn_permlane32_swap(__float_as_uint(g[r]),__float_as_uint(g[r]),false,false); gsc[r]=__uint_as_float(rr[0]); gsc[4+r]=__uint_as_float(rr[1]); } }
    _Pragma("unroll") for(int n=0;n<7;++n) gsc[n]=(n<qb)?gsc[n]:-3.0e38f;
    bmask=1u<<qb;
    _Pragma("unroll") for(int pick=0;pick<3;++pick){ float best=-3.4e38f; unsigned bi=0u;
      _Pragma("unroll") for(int n=0;n<7;++n){ const bool ok=!((bmask>>n)&1u)&&gsc[n]>best; best=ok?gsc[n]:best; bi=ok?(unsigned)n:bi; }
      bmask|=1u<<bi; } }
  bool selcur=(bmask&1u)!=0u;
  { const float nv=selcur?0.f:NEGBIG; _Pragma("unroll") for(int r=0;r<16;++r)negm[r]=nv; asm volatile("":"+v"(negm)); }
  qkt(pA0,pA1,Kbase,qr,negm,r32,hi);asm volatile("s_nop 15\n\ts_nop 7":"+v"(pA0),"+v"(pA1));CMASK(pA0,pA1,0);
  START(pA0,pA1);
  _Pragma("unroll") for(int r=0;r<16;++r)pA1[r]=__builtin_amdgcn_exp2f(pA1[r]);
  WAIT_BAR(0);
  DMA_K(3,0);DMA_V(1,SLOTB);
  ROT();
  kload8(kf,kp0+sl_cur);
  WAIT_BAR(2);
  s16x4 vlo[8],vhi[8]; u32x4 pw0,pw1,pw2,pw3;
  #define PKW(P,B) cvtpk_s(P[B],P[B+1])
  #define PAF(k) __builtin_bit_cast(bf16x8,pw##k)
  #define VFR(i) (bf16x8){vlo[i][0],vlo[i][1],vlo[i][2],vlo[i][3],vhi[i][0],vhi[i][1],vhi[i][2],vhi[i][3]}
  #define PIN(x) asm volatile("":"+v"(x))
  #define MX3(a,b,c) __builtin_fmaxf(__builtin_fmaxf((a),(b)),(c))
  #define GAPA(MF,A0,A1,A2,A3,W0,W1,PW) do{ MF; sacc+=A0; sacc+=A1; sacc+=A2; sacc+=A3; PIN(sacc); W0; W1; PIN(PW); SBAR(); }while(0)
  #define EX(v) __builtin_amdgcn_exp2f(v)
  #define GAPB(MF,X,B) do{ MF; X[B]=EX(X[B]); X[B+1]=EX(X[B+1]); X[B+2]=EX(X[B+2]); X[B+3]=EX(X[B+3]); PIN(X); SBAR(); }while(0)
  #define VRD(i) do{ vlo[i]=vtr(vp_+(((i)>>2)*4096+((i)&3)*1024)); vhi[i]=vtr(vp_+(((i)>>2)*4096+((i)&3)*1024+512)); }while(0)
  #define KRD(G,j) do{ if(G){ kload2(kf,kp0+sl_next,j); SBAR(); } }while(0)
  #define STEP(C0,C1,P0,P1,t,GK,GV,GL) do{ SBAR(); \
    const lds_cptr vp_=vp0+sl_prev; \
    VRD(0); SBAR(); float sacc=(P0[0]+P0[1]); \
    GAPA(C0=__builtin_amdgcn_mfma_f32_32x32x16_bf16(kf[0],qr[0],negm,0,0,0), P0[2],P0[3],P0[4],P0[5],     pw0[0]=PKW(P0,0), pw0[1]=PKW(P0,2), pw0); \
    VRD(4); SBAR(); GAPA(C1=__builtin_amdgcn_mfma_f32_32x32x16_bf16(kf[1],qr[0],negm,0,0,0), P0[6],P0[7],P0[8],P0[9],     pw0[2]=PKW(P0,4), pw0[3]=PKW(P0,6), pw0); \
    VRD(1); SBAR(); GAPA(C0=__builtin_amdgcn_mfma_f32_32x32x16_bf16(kf[2],qr[1],C0,0,0,0),   P0[10],P0[11],P0[12],P0[13], pw1[0]=PKW(P0,8), pw1[1]=PKW(P0,10), pw1); \
    VRD(5); SBAR(); GAPA(C1=__builtin_amdgcn_mfma_f32_32x32x16_bf16(kf[3],qr[1],C1,0,0,0),   P0[14],P0[15],P1[0],P1[1],   pw1[2]=PKW(P0,12),pw1[3]=PKW(P0,14), pw1); \
    VRD(2); SBAR(); GAPA(C0=__builtin_amdgcn_mfma_f32_32x32x16_bf16(kf[4],qr[2],C0,0,0,0),   P1[2],P1[3],P1[4],P1[5],     pw2[0]=PKW(P1,0), pw2[1]=PKW(P1,2), pw2); \
    VRD(6); SBAR(); GAPA(C1=__builtin_amdgcn_mfma_f32_32x32x16_bf16(kf[5],qr[2],C1,0,0,0),   P1[6],P1[7],P1[8],P1[9],     pw2[2]=PKW(P1,4), pw2[3]=PKW(P1,6), pw2); \
    VRD(3); SBAR(); GAPA(C0=__builtin_amdgcn_mfma_f32_32x32x16_bf16(kf[6],qr[3],C0,0,0,0),   P1[10],P1[11],P1[12],P1[13], pw3[0]=PKW(P1,8), pw3[1]=PKW(P1,10), pw3); \
    VRD(7); SBAR(); GAPA(C1=__builtin_amdgcn_mfma_f32_32x32x16_bf16(kf[7],qr[3],C1,0,0,0),   P1[14],P1[15],0.f,0.f,       pw3[2]=PKW(P1,12),pw3[3]=PKW(P1,14), pw3); \
    l_reg+=sacc; \
    if(GK){DMA_K((t)+3,sl_cur);} if(GV){DMA_V((t)+1,sl_next);} \
    CMASK(C0,C1,t); \
    { float a=MX3(C0[0],C0[1],C1[0]),b=MX3(C0[2],C0[3],C1[1]); a=MX3(a,C1[2],C1[3]); \
      _Pragma("unroll") for(int r=4;r<16;r+=4){a=MX3(a,C0[r],C0[r+1]);b=MX3(b,C0[r+2],C0[r+3]);a=MX3(a,C1[r],C1[r+1]);b=MX3(b,C1[r+2],C1[r+3]);} \
      float rm=__builtin_fmaxf(a,b); { auto rr=__builtin_amdgcn_permlane32_swap(__float_as_uint(rm),__float_as_uint(rm),false,false); rm=__builtin_fmaxf(__uint_as_float(rr[0]),__uint_as_float(rr[1])); } \
      resc=false; \
      if(__builtin_expect(__any(rm>(float)THRL),0)){ const float dl=__builtin_fmaxf(rm,0.f); mhat+=dl; \
        _Pragma("unroll") for(int r=0;r<16;++r){C0[r]-=dl;C1[r]-=dl;} \
        { const float nv_=selcur?-mhat:NEGBIG; _Pragma("unroll") for(int r=0;r<16;++r)negm[r]=nv_; } asm volatile("":"+v"(negm)); \
        const float f=__builtin_amdgcn_exp2f(-dl); l_reg*=f; if(hi==0)wsf[r32]=f; resc=true; } } \
    SBAR(); \
    GAPB(o[0]=__builtin_amdgcn_mfma_f32_32x32x16_bf16(PAF(0),VFR(0),o[0],0,0,0), C0,0); \
    GAPB(o[1]=__builtin_amdgcn_mfma_f32_32x32x16_bf16(PAF(0),VFR(4),o[1],0,0,0), C0,4); \
    KRD(GL,0); GAPB(o[0]=__builtin_amdgcn_mfma_f32_32x32x16_bf16(PAF(1),VFR(1),o[0],0,0,0), C0,8); \
    KRD(GL,1); GAPB(o[1]=__builtin_amdgcn_mfma_f32_32x32x16_bf16(PAF(1),VFR(5),o[1],0,0,0), C0,12); \
    KRD(GL,2); GAPB(o[0]=__builtin_amdgcn_mfma_f32_32x32x16_bf16(PAF(2),VFR(2),o[0],0,0,0), C1,0); \
    KRD(GL,3); GAPB(o[1]=__builtin_amdgcn_mfma_f32_32x32x16_bf16(PAF(2),VFR(6),o[1],0,0,0), C1,4); \
    GAPB(o[0]=__builtin_amdgcn_mfma_f32_32x32x16_bf16(PAF(3),VFR(3),o[0],0,0,0), C1,8); \
    GAPB(o[1]=__builtin_amdgcn_mfma_f32_32x32x16_bf16(PAF(3),VFR(7),o[1],0,0,0), C1,12); \
    }while(0)
  #define BLKSEL(tt) do{ if((((tt))&3)==0){ selcur=((bmask>>((tt)>>2))&1u)!=0u; const float nv_=selcur?-mhat:NEGBIG; _Pragma("unroll") for(int r=0;r<16;++r)negm[r]=nv_; asm volatile("":"+v"(negm)); } }while(0)
  int t=1;
  #undef CMASK
  #define CMASK(P0,P1,t) do{}while(0)
  for(;t+5<NT;t+=2){
    STEP(pB0,pB1,pA0,pA1,t,true,true,true);     WAIT_BAR(2); RESC(); ROT(); BLKSEL(t+1);
    STEP(pA0,pA1,pB0,pB1,t+1,true,true,true);   WAIT_BAR(2); RESC(); ROT();
  }
  #undef CMASK
  #define CMASK(P0,P1,t) do{int jb_=(t)-(NT-4); if(jb_>=0)cmask(P0,P1,jb_,qrel,hi);}while(0)
  #define ENDW(tt) do{ if((tt)+3<NT){WAIT_BAR(2);} else if((tt)+2<NT){WAIT_BAR(1);} else {WAIT_BAR(0);} }while(0)
  for(;t+1<NT;t+=2){
    STEP(pB0,pB1,pA0,pA1,t,(t+3<NT),(t+1<NT),(t+1<NT));       ENDW(t);   RESC(); ROT(); BLKSEL(t+1);
    STEP(pA0,pA1,pB0,pB1,t+1,(t+4<NT),(t+2<NT),(t+2<NT));     ENDW(t+1); RESC(); ROT();
  }
  STEP(pB0,pB1,pA0,pA1,NT-1,false,false,false); RESC();
  { float sacc=pB0[0]+pB0[1]; _Pragma("unroll") for(int r=2;r<16;++r)sacc+=pB0[r]; _Pragma("unroll") for(int r=0;r<16;++r)sacc+=pB1[r]; l_reg+=sacc;
    pw0=(u32x4){PKW(pB0,0),PKW(pB0,2),PKW(pB0,4),PKW(pB0,6)};pw1=(u32x4){PKW(pB0,8),PKW(pB0,10),PKW(pB0,12),PKW(pB0,14)};pw2=(u32x4){PKW(pB1,0),PKW(pB1,2),PKW(pB1,4),PKW(pB1,6)};pw3=(u32x4){PKW(pB1,8),PKW(pB1,10),PKW(pB1,12),PKW(pB1,14)};
    SBAR(); pv(o,vb0+sl_cur,PAF(0),PAF(1),PAF(2),PAF(3)); }
  #undef PKW
  #undef PAF
  #undef VFR
  #undef PIN
  #undef MX3
  #undef GAPA
  #undef GAPB
  #undef EX
  #undef VRD
  #undef KRD
  #undef STEP
  #undef ENDW
  {auto rr=__builtin_amdgcn_permlane32_swap(__float_as_uint(l_reg),__float_as_uint(l_reg),false,false);l_reg=__uint_as_float(rr[0])+__uint_as_float(rr[1]);}
  if(hi==0)wsf[32+r32]=l_reg;asm volatile("s_waitcnt lgkmcnt(0)":::"memory");
  float rli[16];
  #pragma unroll
  for(int r=0;r<16;++r)rli[r]=__builtin_amdgcn_rcpf(wsf[32+crow(r,hi)]);
  unsigned char*Ow=(unsigned char*)O+(rowbase+q0+wid*QBLK)*OP+h*D;
  { unsigned char*stg=(unsigned char*)(shm+LDS_OST)+wid*4096;
    #pragma unroll
    for(int r=0;r<16;++r){const int orow=crow(r,hi);
      #pragma unroll
      for(int d0=0;d0<2;++d0){const float ov=__builtin_amdgcn_fmed3f(o[d0][r]*rli[r]*32.f,-448.f,448.f); stg[orow*64+d0*32+r32]=(unsigned char)__builtin_amdgcn_cvt_pk_fp8_f32(ov,ov,0,false);}}
    asm volatile("s_waitcnt lgkmcnt(0)":::"memory");
    #pragma unroll
    for(int i=0;i<2;++i){const int row=i*16+(lane>>2),ch=lane&3; const u32x4 v=*(const u32x4*)(stg+row*64+ch*16); ATTN_STORE16(Ow+(long)row*OP+ch*16,v);} }
  asm volatile("s_waitcnt lgkmcnt(0)\n\ts_barrier":::"memory");
  #undef BLKSEL
  #undef DMA_K
  #undef DMA_V
  #undef CMASK
  #undef START
  #undef RESC
  #undef ROT
}
constexpr int ATTN_LDS_BYTES=LDS_BYTES;
struct AttnTensors { const bf16* Q; const bf16* K; const bf16* V; bf16* O; const float* kbar; };
struct AttnUnit { int bh; int qb; };
struct StaticOrder {
  int vcu, G;
  __device__ __forceinline__ explicit StaticOrder(int grid,int block):vcu((grid%8==0)?(block%8)*(grid/8)+block/8:block),G(grid){}
  __device__ __forceinline__ bool next(int i,AttnUnit&u)const{ const int pr=(vcu+(i>>2)*G)*2+((i>>1)&1); if(pr>=BATCH*NHEAD*4)return false;
    const int s=pr&3; u.bh=pr>>2; u.qb=(i&1)?7-s:s; return true; }
  __device__ __forceinline__ void a_ready(const AttnUnit&)const{}
  __device__ __forceinline__ void done(const AttnUnit&)const{}
};
template<class Sched,int THRL=8> __device__ __forceinline__ void attn_phase(char*lds,const AttnTensors&T,const Sched&S,const int tid_in){
  AttnUnit u; int tid_=tid_in; asm volatile("":"+v"(tid_));
  for(int i=0;S.next(i,u);++i){ S.a_ready(u); attn_unit<THRL>(u.bh/NHEAD,u.bh%NHEAD,u.qb,T.Q,T.K,T.V,T.O,T.kbar+(long)u.bh*512,lds,tid_); S.done(u); }
}
#undef SBAR
#undef WAIT_BAR
}

#define XB_TMO      128
#define XB_XCNT(j)  (256  + 64 * (j))
#define XB_XSUB(j)  (1280 + 64 * (j))
#define XB_XGEN(j)  (2304 + 64 * (j))
#define XB_TOP      3328
#define XB_TOPGEN   3392
#define XCD_BAR_WORDS 3456
#define XB_SPIN_CAP (1u << 18)

__device__ __forceinline__ unsigned xb_ld(unsigned* p)              { return __hip_atomic_load(p, __ATOMIC_RELAXED, __HIP_MEMORY_SCOPE_AGENT); }
__device__ __forceinline__ unsigned xb_add(unsigned* p, unsigned v) { return __hip_atomic_fetch_add(p, v, __ATOMIC_RELAXED, __HIP_MEMORY_SCOPE_AGENT); }
__device__ __forceinline__ unsigned xb_xcc_id() { return (unsigned)__builtin_amdgcn_s_getreg((3 << 11) | 20) & 0xFu; }
#define XB_SPIN(cond, bar) do { unsigned _sp = 0; while (cond) { __builtin_amdgcn_s_sleep(1); \
    if ((++_sp & 255u) == 0u) { if (xb_ld(&(bar)[XB_TMO])) break; if (_sp > XB_SPIN_CAP) { atomicAdd(&(bar)[XB_TMO], 1u); break; } } } } while (0)

struct XcdBarrier {
    unsigned* bar; unsigned x;
    volatile LAS unsigned* st;
};

__device__ __forceinline__ XcdBarrier xcd_barrier_post(unsigned* bar, volatile LAS unsigned* st) {
    XcdBarrier b; b.bar = bar; b.x = xb_xcc_id(); b.st = st;
    if (threadIdx.x == 0) (void)xb_add(&bar[XB_XCNT(b.x)], 1u);
    return b;
}
__device__ __forceinline__ void xcd_barrier_complete(unsigned* bar, unsigned x, unsigned& nloc, unsigned& nx) {
    const unsigned G = gridDim.x * gridDim.y * gridDim.z;
    unsigned sum, cnt, mine, sp = 0u;
    for (;;) {
        sum = 0u; cnt = 0u; mine = 0u;
#pragma unroll
        for (unsigned j = 0; j < 16; ++j) { const unsigned c = xb_ld(&bar[XB_XCNT(j)]); sum += c; cnt += (c > 0u) ? 1u : 0u; mine = (j == x) ? c : mine; }
        if (sum == G) break;
        __builtin_amdgcn_s_sleep(1);
        if ((++sp & 255u) == 0u) { if (xb_ld(&bar[XB_TMO])) break; if (sp > XB_SPIN_CAP) { atomicAdd(&bar[XB_TMO], 1u); break; } }
    }
    nloc = mine > 0u ? mine : 1u; nx = cnt > 0u ? cnt : 1u;
}

__device__ __forceinline__ void xcd_barrier(const XcdBarrier& b, const bool is_t0) {
    asm volatile("s_waitcnt vmcnt(0)" ::: "memory");
    __syncthreads();
    if (is_t0) {
        unsigned* bar = b.bar;
        __builtin_amdgcn_s_waitcnt(0);
        unsigned nloc = b.st[0], nx = b.st[1];
        if (nloc == 0u) { xcd_barrier_complete(bar, b.x, nloc, nx); b.st[0] = nloc; b.st[1] = nx; }
        const unsigned old = xb_add(&bar[XB_XSUB(b.x)], 1u);
        const unsigned gen = old / nloc;
        if (old + 1u == (gen + 1u) * nloc) {
            __builtin_amdgcn_fence(__ATOMIC_RELEASE, "agent");
            asm volatile("s_waitcnt vmcnt(0)" ::: "memory");
            const unsigned og = xb_add(&bar[XB_TOP], 1u);
            const unsigned tg = og / nx;
            if (og + 1u == (tg + 1u) * nx) xb_add(&bar[XB_TOPGEN], 1u);
            else XB_SPIN(xb_ld(&bar[XB_TOPGEN]) == tg, bar);
            __builtin_amdgcn_fence(__ATOMIC_ACQUIRE, "agent");
            xb_add(&bar[XB_XGEN(b.x)], 1u);
            asm volatile("s_waitcnt vmcnt(0)" ::: "memory");
        } else {
            XB_SPIN(xb_ld(&bar[XB_XGEN(b.x)]) == gen, bar);
            __builtin_amdgcn_fence(__ATOMIC_ACQUIRE, "agent");
            asm volatile("s_waitcnt vmcnt(0)" ::: "memory");
        }
    }
    __syncthreads();
}

struct Args { const float* in[17]; float* out; unsigned char* ws; int ph_lo, ph_hi; };
enum { I_X = 0, I_C, I_WMOD, I_BMOD, I_WIN, I_WPOOL, I_PSCALE, I_WOUT, I_LN1G, I_LN1B, I_WR, I_RB, I_WG, I_WU, I_WDN, I_LN2G, I_LN2B };

DEVFN int lane_id_volatile() { int l; asm volatile("v_mbcnt_lo_u32_b32 %0, -1, 0\n\tv_mbcnt_hi_u32_b32 %0, -1, %0" : "=v"(l)); return l; }
struct Ctx { unsigned char* lds; __attribute__((address_space(3))) unsigned char* lds3; int tid, lane, wave, G, bid, gw, NGW; };

DEVFN void transpose_item_f8(const float* src, int ldn, int k0, int col, unsigned char* dst, int ldk, int dst_row0, int dst_k0, float* scr, int lane) {
#pragma unroll 8
    for (int i = 0; i < 32; ++i) { const int kk = 2 * i + (lane >> 5); scr[kk * 33 + (lane & 31)] = src[(size_t)(k0 + kk) * ldn + col]; }
    LDS_WAIT();
    const int c = lane & 7;
#pragma unroll
    for (int j = 0; j < 4; ++j) { const int n = (lane >> 3) + 8 * j; const float* s = scr + (8 * c) * 33 + n;
        u32x2 o; o.x = pk4_fp8(32.f * s[0 * 33], 32.f * s[1 * 33], 32.f * s[2 * 33], 32.f * s[3 * 33]); o.y = pk4_fp8(32.f * s[4 * 33], 32.f * s[5 * 33], 32.f * s[6 * 33], 32.f * s[7 * 33]);
        *(u32x2*)(dst + (size_t)(dst_row0 + n) * ldk + dst_k0 + 8 * c) = o; }
    LDS_WAIT();
}

DEVFN void ph_prologue(const Args& a, const Ctx& c) {
    unsigned char* ws = a.ws;
    float* scr = (float*)(c.lds + c.wave * 16384);
    const int lane = c.lane;
    constexpr int N1 = 2 * 16 * 64, N2 = 2 * 8 * 32, N3 = 32 * 16 * 32, N4 = 32 * 8 * 32, N5 = 2 * 64 * 16, N6 = 256;
    for (int it = c.gw; it < N1 + N2 + N3 + N4 + N5 + N6; it += c.NGW) {
        int r = it;
        if (r < N1) {
            const int l = r / 1024, kb = (r % 1024) / 64, nb = r % 64;
            const int nphys = 32 * nb + (lane & 31);
            transpose_item_f8(a.in[I_WIN] + (size_t)l * DM * DIN, DIN, 64 * kb, inproj_nlog(nphys), (unsigned char*)(ws + WS_WIN) + (size_t)l * DIN * DM, DM, 32 * nb, 64 * kb, scr, lane);
            continue; }
        r -= N1;
        if (r < N2) {
            const int l = r / 256, kb = (r % 256) / 32, nb = r % 32;
            transpose_item_f8(a.in[I_WOUT] + (size_t)l * DM * DM, DM, 64 * kb, inproj_nlog(32 * nb + (lane & 31)), (unsigned char*)(ws + WS_WOUT) + (size_t)l * DM * DM, DM, 32 * nb, 64 * kb, scr, lane);
            continue; }
        r -= N2;
        if (r < N3) {
            const int le = r / 512, kb = (r % 512) / 32, nb = r % 32;
            const int n = 32 * nb + (lane & 31), jt = n >> 8, bj = (n >> 7) & 1, i = n & 127;
            const float* src = (bj ? a.in[I_WU] : a.in[I_WG]) + (size_t)le * DM * DE;
            transpose_item_f8(src, DE, 64 * kb, jt * 128 + i, (unsigned char*)(ws + WS_WGU) + (size_t)le * DM * DM, DM, 32 * nb, 64 * kb, scr, lane);
            continue; }
        r -= N3;
        if (r < N4) {
            const int le = r / 256, kb = (r % 256) / 32, nb = r % 32;
            transpose_item_f8(a.in[I_WDN] + (size_t)le * DE * DM, DM, 64 * kb, inproj_nlog(32 * nb + (lane & 31)), (unsigned char*)(ws + WS_WD) + (size_t)le * DM * DE, DE, 32 * nb, 64 * kb, scr, lane);
            continue; }
        r -= N4;
        if (r < N5) {
            const int l = r / 1024, kdg = (r % 1024) / 16, nb = r % 16;
            const int n = nb * 64 + lane, kd0 = kdg * 8, g = kd0 >> 7, c0 = kd0 & 127;
            const float* wo = a.in[I_WOUT] + (size_t)l * DM * DM + (size_t)(512 + g * 128) * DM + inproj_nlog(n);
            const float* ps = a.in[I_PSCALE] + l * 512 + g * 128;
            const float* wp = a.in[I_WPOOL] + ((size_t)(l * 4 + g) * 128 + c0) * 128;
            float acc[8];
#pragma unroll
            for (int j = 0; j < 8; ++j) acc[j] = 0.f;
            for (int e = 0; e < 128; ++e) { const float w = wo[(size_t)e * DM] * ps[e];
#pragma unroll
                for (int j = 0; j < 8; ++j) acc[j] += wp[j * 128 + e] * w; }
            u32x2 o; o.x = pk4_fp8(128.f * acc[0], 128.f * acc[1], 128.f * acc[2], 128.f * acc[3]); o.y = pk4_fp8(128.f * acc[4], 128.f * acc[5], 128.f * acc[6], 128.f * acc[7]);
            *(u32x2*)((unsigned char*)(ws + WS_WOUT) + (size_t)l * DM * DM + (size_t)n * DM + 512 + kd0) = o;
            continue; }
        r -= N5;
        {
            const int ent = r * 64 + lane, pos = ent >> 3, i = ent & 7;
            const float inv = (float)exp2(-(double)i / 8.0 * 18.931568569324174);
            const float ang = (float)pos * inv;
            float* t = (float*)(ws + WS_ROPE) + ent * 2;
            t[0] = (float)cos((double)ang); t[1] = (float)sin((double)ang);
        }
    }
    for (int i = c.bid * 512 + c.tid; i < 2 * NB * NH * NBLK * HD; i += c.G * 512) ((float*)(ws + WS_KBAR))[i] = 0.f;
    __syncthreads();
    if (c.bid < 192) {
        float* condT = (float*)c.lds;
        float* red = (float*)(c.lds + 65536);
        for (int idx = c.tid; idx < NB * DM; idx += 512) { const int b = idx >> 10, k = idx & 1023; const float v = a.in[I_C][idx]; condT[k * 16 + b] = v / (1.f + __expf(-v)); }
        __syncthreads();
        for (int u = c.bid; u < 192; u += c.G) {
            const int l = u / 96, n0 = (u % 96) * 64;
            const float* W = a.in[I_WMOD] + (size_t)l * DM * NMOD + n0 + lane;
            float acc[16];
#pragma unroll
            for (int b = 0; b < 16; ++b) acc[b] = 0.f;
            for (int k = 128 * c.wave; k < 128 * c.wave + 128; k += 8) {
                float wv[8];
#pragma unroll
                for (int j = 0; j < 8; ++j) wv[j] = W[(size_t)(k + j) * NMOD];
#pragma unroll
                for (int j = 0; j < 8; ++j) {
                    const f32x4* cp = (const f32x4*)(condT + (k + j) * 16);
#pragma unroll
                    for (int q = 0; q < 4; ++q) { const f32x4 cv = cp[q]; acc[4 * q + 0] += cv.x * wv[j]; acc[4 * q + 1] += cv.y * wv[j]; acc[4 * q + 2] += cv.z * wv[j]; acc[4 * q + 3] += cv.w * wv[j]; }
                }
            }
#pragma unroll
            for (int b = 0; b < 16; ++b) red[(c.wave * 16 + b) * 64 + lane] = acc[b];
            __syncthreads();
            for (int o = c.tid; o < 1024; o += 512) { const int b = o >> 6, cc = o & 63; float s = a.in[I_BMOD][l * NMOD + n0 + cc];
#pragma unroll
                for (int w = 0; w < 8; ++w) s += red[(w * 16 + b) * 64 + cc];
                ((float*)(ws + WS_MOD))[(size_t)(l * NB + b) * NMOD + n0 + cc] = s; }
            __syncthreads();
        }
    }
}

DEVFN void row_stats(const f32x4 (&v)[4], float& mean, float& rstd) {
    float s = 0.f, q = 0.f;
#pragma unroll
    for (int j = 0; j < 4; ++j) { s += (v[j].x + v[j].y) + (v[j].z + v[j].w); q += (v[j].x * v[j].x + v[j].y * v[j].y) + (v[j].z * v[j].z + v[j].w * v[j].w); }
    s = swz_xor_add(s, 1); q = swz_xor_add(q, 1); s = swz_xor_add(s, 2); q = swz_xor_add(q, 2); s = swz_xor_add(s, 4); q = swz_xor_add(q, 4);
    s = swz_xor_add(s, 8); q = swz_xor_add(q, 8); s = swz_xor_add(s, 16); q = swz_xor_add(q, 16); s = half_swap_add(s); q = half_swap_add(q);
    mean = s * (1.f / DM);
    rstd = 1.f / sqrtf(fmaxf(q * (1.f / DM) - mean * mean, 0.f) + LN_EPS);
}
DEVFN void row_load(const float* p, int lane, f32x4 (&v)[4]) {
#pragma unroll
    for (int j = 0; j < 4; ++j) v[j] = *(const f32x4*)(p + 4 * lane + 256 * j);
}
DEVFN void row_mod_store(f32x4 (&v)[4], const float* sc, const float* sh, bf16_t* out, int lane) {
    float mean, rstd; row_stats(v, mean, rstd);
#pragma unroll
    for (int j = 0; j < 4; ++j) {
        const f32x4 s = *(const f32x4*)(sc + 4 * lane + 256 * j), h = *(const f32x4*)(sh + 4 * lane + 256 * j);
        v[j] = (v[j] - mean) * rstd * (s + 1.f) + h;
        u32x2 o; o.x = pk2(v[j].x, v[j].y); o.y = pk2(v[j].z, v[j].w);
        *(u32x2*)(out + 4 * lane + 256 * j) = o;
    }
}

DEVFN void ph_pool(const Args& a, const Ctx& c) {
    const bf16_t* P = (const bf16_t*)(a.ws + WS_QKVP) + 1536; unsigned char* AD = (unsigned char*)(a.ws + WS_AD) + 512;
    for (int it = c.bid * 512 + c.tid; it < (NTOK / 8) * 64; it += c.G * 512) {
        const int cg = it & 63, m0 = (it >> 6) * 8, t0 = m0 & (SEQ - 1), g = cg >> 4, w = 2 << g;
        const bf16_t* pc = P + cg * 8;
        u32x4 rows[23];
#pragma unroll
        for (int k = 0; k < 23; ++k) { const int dt = k - 15; rows[k] = (u32x4){0u, 0u, 0u, 0u}; if (dt > -w && t0 + dt >= 0) rows[k] = *(const u32x4*)(pc + (size_t)(m0 + dt) * DIN); }
        float s[8];
#pragma unroll
        for (int j = 0; j < 8; ++j) s[j] = 0.f;
#pragma unroll
        for (int k = 0; k < 15; ++k) { const u32x4 v = rows[k]; s[0] += bf_lo(v.x); s[1] += bf_hi(v.x); s[2] += bf_lo(v.y); s[3] += bf_hi(v.y); s[4] += bf_lo(v.z); s[5] += bf_hi(v.z); s[6] += bf_lo(v.w); s[7] += bf_hi(v.w); }
#pragma unroll
        for (int r = 0; r < 8; ++r) {
            const int t = t0 + r; const u32x4 v = rows[15 + r];
            const float f[8] = {bf_lo(v.x), bf_hi(v.x), bf_lo(v.y), bf_hi(v.y), bf_lo(v.z), bf_hi(v.z), bf_lo(v.w), bf_hi(v.w)};
#pragma unroll
            for (int j = 0; j < 8; ++j) s[j] += f[j];
            const int cnt = (t + 1 < w) ? t + 1 : w; const float ic = 1.f / (float)cnt;
            u32x2 o; o.x = pk4_fp8(s[0] * ic - f[0], s[1] * ic - f[1], s[2] * ic - f[2], s[3] * ic - f[3]); o.y = pk4_fp8(s[4] * ic - f[4], s[5] * ic - f[5], s[6] * ic - f[6], s[7] * ic - f[7]);
            *(u32x2*)(AD + (size_t)(m0 + r) * DM + cg * 8) = o;
            u32x4 q = rows[r];
            if (w == 8) q = rows[r + 8]; else if (w == 4) q = rows[r + 12]; else if (w == 2) q = rows[r + 14];
            s[0] -= bf_lo(q.x); s[1] -= bf_hi(q.x); s[2] -= bf_lo(q.y); s[3] -= bf_hi(q.y); s[4] -= bf_lo(q.z); s[5] -= bf_hi(q.z); s[6] -= bf_lo(q.w); s[7] -= bf_hi(q.w);
        }
    }
}

constexpr size_t WS_X1B = WS_X1, WS_X2B = WS_X1 + 64 * MiB;
constexpr int ROWS_PER_WAVE = 16;
DEVFN void vec_load(const float* p, int lane, f32x4 (&v)[4]) {
#pragma unroll
    for (int j = 0; j < 4; ++j) v[j] = *(const f32x4*)(p + 4 * lane + 256 * j);
}
DEVFN void bfrow_load(const bf16_t* p, int lane, u32x2 (&w)[4]) {
#pragma unroll
    for (int j = 0; j < 4; ++j) w[j] = *(const u32x2*)(p + 4 * lane + 256 * j);
}
DEVFN f32x4 bf4(u32x2 w) { return (f32x4){bf_lo(w.x), bf_hi(w.x), bf_lo(w.y), bf_hi(w.y)}; }
DEVFN void bfrow_store(bf16_t* p, int lane, const f32x4 (&v)[4]) {
#pragma unroll
    for (int j = 0; j < 4; ++j) { u32x2 o; o.x = pk2(v[j].x, v[j].y); o.y = pk2(v[j].z, v[j].w); *(u32x2*)(p + 4 * lane + 256 * j) = o; }
}
DEVFN void f8row_store(unsigned char* p, int lane, const f32x4 (&v)[4]) {
#pragma unroll
    for (int j = 0; j < 4; ++j) *(unsigned*)(p + 4 * lane + 256 * j) = pk4_fp8(v[j].x, v[j].y, v[j].z, v[j].w);
}
DEVFN void ln_mod(f32x4 (&v)[4], const f32x4 (&sc)[4], const f32x4 (&sh)[4]) {
    float mean, rstd; row_stats(v, mean, rstd);
#pragma unroll
    for (int j = 0; j < 4; ++j) v[j] = (v[j] - mean) * rstd * (sc[j] + 1.f) + sh[j];
}
DEVFN void ln_aff(f32x4 (&v)[4], const f32x4 (&g)[4], const f32x4 (&b)[4]) {
    float mean, rstd; row_stats(v, mean, rstd);
#pragma unroll
    for (int j = 0; j < 4; ++j) v[j] = (v[j] - mean) * rstd * g[j] + b[j];
}

DEVFN void ph_h1_rows(const Args& a, const Ctx& c) {
    const float* mod = (const float*)(a.ws + WS_MOD); bf16_t* HB = (bf16_t*)(a.ws + WS_HB);
    for (int base = c.gw * ROWS_PER_WAVE; base < NTOK; base += c.NGW * ROWS_PER_WAVE) {
        const float* mb = mod + (size_t)(base >> 11) * NMOD;
        f32x4 sc[4], sh[4]; vec_load(mb + DM, c.lane, sc); vec_load(mb, c.lane, sh);
        f32x4 cur[4], nxt[4]; vec_load(a.in[I_X] + (size_t)base * DM, c.lane, cur);
#pragma unroll 1
        for (int i = 0; i < ROWS_PER_WAVE; ++i) {
            const int m = base + i;
            if (i + 1 < ROWS_PER_WAVE) vec_load(a.in[I_X] + (size_t)(m + 1) * DM, c.lane, nxt);
            ln_mod(cur, sc, sh); f8row_store((unsigned char*)HB + (size_t)m * DM, c.lane, cur);
#pragma unroll
            for (int j = 0; j < 4; ++j) cur[j] = nxt[j];
        }
    }
}

DEVFN f32x4 reduce16(const float (&lg)[16]) {
    float t[8], u[4];
#pragma unroll
    for (int e = 0; e < 8; ++e) { auto rr = __builtin_amdgcn_permlane32_swap(__float_as_uint(lg[e]), __float_as_uint(lg[e + 8]), false, false); t[e] = __uint_as_float(rr[0]) + __uint_as_float(rr[1]); }
#pragma unroll
    for (int k = 0; k < 4; ++k) { auto rr = __builtin_amdgcn_permlane16_swap(__float_as_uint(t[k]), __float_as_uint(t[k + 4]), false, false); u[k] = __uint_as_float(rr[0]) + __uint_as_float(rr[1]); }
#pragma unroll
    for (int k = 0; k < 4; ++k) { u[k] = swz_xor_add(u[k], 1); u[k] = swz_xor_add(u[k], 2); u[k] = swz_xor_add(u[k], 4); u[k] = swz_xor_add(u[k], 8); }
    return (f32x4){u[0], u[1], u[2], u[3]};
}

DEVFN void rowc_load(const Args& a, int l, int m, int lane, f32x4 (&x)[4], unsigned (&y)[4]) {
    if (l == 0) vec_load(a.in[I_X] + (size_t)m * DM, lane, x);
    else { u32x2 w[4]; bfrow_load((const bf16_t*)(a.ws + WS_X2B) + (size_t)m * DM, lane, w);
#pragma unroll
        for (int j = 0; j < 4; ++j) { x[j].x = __uint_as_float(w[j].x); x[j].y = __uint_as_float(w[j].y); } }
#pragma unroll
    for (int j = 0; j < 4; ++j) y[j] = *(const unsigned*)((const unsigned char*)(a.ws + WS_QKVP) + (size_t)m * DM + 4 * lane + 256 * j);
}
DEVFN void rowc_step(const Args& a, int l, int m, int lane, const f32x4 (&x)[4], const unsigned (&y)[4], const float* vg1, const float* vsc, const float* vsh, f32x4 (&v)[4]) {
    int z_ = 0; asm volatile("" : "+v"(z_));
    f32x4 g1[4]; vec_load(vg1 + z_, lane, g1);
#pragma unroll
    for (int j = 0; j < 4; ++j) { const f32x4 xv = (l == 0) ? x[j] : bf4((u32x2){__float_as_uint(x[j].x), __float_as_uint(x[j].y)}); v[j] = xv * ALPHA + g1[j] * f8x4_to_f32(y[j], 1.f / YSCALE); }
    { f32x4 lg[4], lb[4]; vec_load(a.in[I_LN1G] + l * DM + z_, lane, lg); vec_load(a.in[I_LN1B] + l * DM + z_, lane, lb); ln_aff(v, lg, lb); }
    bfrow_store((bf16_t*)(a.ws + WS_X1B) + (size_t)m * DM, lane, v);
    { f32x4 sc[4], sh[4]; vec_load(vsc + z_, lane, sc); vec_load(vsh + z_, lane, sh); ln_mod(v, sc, sh); }
    f8row_store((unsigned char*)(a.ws + WS_HB) + (size_t)m * DM, lane, v);
}

DEVFN void ph_rows_c(const Args& a, const Ctx& c, int l, bool publish) {
    const float* mod = (const float*)(a.ws + WS_MOD) + (size_t)l * NB * NMOD;
    const bf16_t* Y = (const bf16_t*)(a.ws + WS_QKVP); const bf16_t* X2B = (const bf16_t*)(a.ws + WS_X2B);
    bf16_t* X1B = (bf16_t*)(a.ws + WS_X1B); bf16_t* HB = (bf16_t*)(a.ws + WS_HB);
    float* wr = (float*)c.lds;
    float* vsc = (float*)(c.lds + 65536); float* vsh = vsc + DM; float* vg1 = vsh + DM;
    int* lcnt = (int*)(c.lds + 65536 + 12288); int* lbase = lcnt + 32;
    int* rcls = lbase + 32; float* rw1 = (float*)(rcls + 8 * 64); float* rw2 = rw1 + 8 * 64; int* rrow = (int*)(rw2 + 8 * 64); float* lgs = (float*)(rrow + 8 * 64);
#pragma unroll
    for (int it = 0; it < 8; ++it) { const int idx = it * 512 + c.tid, k = idx & 1023, q = idx >> 10;
        const f32x4 w = *(const f32x4*)(a.in[I_WR] + k * 16 + 4 * q);
        wr[(4 * q + 0) * DM + k] = w.x; wr[(4 * q + 1) * DM + k] = w.y; wr[(4 * q + 2) * DM + k] = w.z; wr[(4 * q + 3) * DM + k] = w.w; }
    if (c.tid < 32) lcnt[c.tid] = 0;
    __syncthreads();
    int nr = 0;
    for (int base = c.gw * ROWS_PER_WAVE; base < NTOK; base += c.NGW * ROWS_PER_WAVE) {
        const float* mb = mod + (size_t)(base >> 11) * NMOD;
        __syncthreads();
        for (int i = c.tid; i < 3 * DM; i += 512) vsc[i] = (i < DM) ? mb[4 * DM + i] : (i < 2 * DM ? mb[3 * DM + (i - DM)] : mb[2 * DM + (i - 2 * DM)]);
        __syncthreads();
#pragma unroll 1
        for (int i = 0; i < ROWS_PER_WAVE; i += 2) {
            const int m = __builtin_amdgcn_readfirstlane(base + i);
            f32x4 va[4], vb[4];
            { f32x4 xa[4], xb[4]; unsigned ya[4], yb[4];
              rowc_load(a, l, m, c.lane, xa, ya); rowc_load(a, l, m + 1, c.lane, xb, yb);
              rowc_step(a, l, m, c.lane, xa, ya, vg1, vsc, vsh, va);
              rowc_step(a, l, m + 1, c.lane, xb, yb, vg1, vsc, vsh, vb); }
            typedef float f32x2_t __attribute__((ext_vector_type(2)));
            f32x2_t acc2[16];
#pragma unroll
            for (int e = 0; e < 16; ++e) acc2[e] = (f32x2_t){0.f, 0.f};
#pragma unroll
            for (int j = 0; j < 4; ++j) {
                const f32x2_t p0 = {va[j].x, vb[j].x}, p1 = {va[j].y, vb[j].y}, p2 = {va[j].z, vb[j].z}, p3 = {va[j].w, vb[j].w};
#pragma unroll
                for (int e = 0; e < 16; ++e) { const f32x4 w = *(const f32x4*)(wr + e * DM + 4 * c.lane + 256 * j);
                    acc2[e] = __builtin_elementwise_fma(p0, (f32x2_t){w.x, w.x}, acc2[e]); acc2[e] = __builtin_elementwise_fma(p1, (f32x2_t){w.y, w.y}, acc2[e]);
                    acc2[e] = __builtin_elementwise_fma(p2, (f32x2_t){w.z, w.z}, acc2[e]); acc2[e] = __builtin_elementwise_fma(p3, (f32x2_t){w.w, w.w}, acc2[e]);
                    if ((e & 7) == 7) __builtin_amdgcn_sched_barrier(0); } }
            float la[16], lb2[16];
#pragma unroll
            for (int e = 0; e < 16; ++e) { la[e] = acc2[e].x; lb2[e] = acc2[e].y; }
            { const f32x4 ua = reduce16(la), ub = reduce16(lb2);
              if ((c.lane & 15) == 0) { *(f32x4*)(lgs + (c.wave * 16 + i) * 16 + (c.lane >> 4) * 4) = ua; *(f32x4*)(lgs + (c.wave * 16 + i + 1) * 16 + (c.lane >> 4) * 4) = ub; } }
        }
        LDS_WAIT();
        if (c.lane < ROWS_PER_WAVE) {
            float lg16[16], rb[16];
#pragma unroll
            for (int e = 0; e < 16; ++e) rb[e] = a.in[I_RB][e];
#pragma unroll
            for (int q = 0; q < 4; ++q) { const f32x4 t = *(const f32x4*)(lgs + (c.wave * 16 + c.lane) * 16 + 4 * q); lg16[4 * q] = t.x; lg16[4 * q + 1] = t.y; lg16[4 * q + 2] = t.z; lg16[4 * q + 3] = t.w; }
            float mx = lg16[0];
#pragma unroll
            for (int e = 1; e < 16; ++e) mx = fmaxf(mx, lg16[e]);
            float sum = 0.f, scr[16];
#pragma unroll
            for (int e = 0; e < 16; ++e) { scr[e] = __expf(lg16[e] - mx); sum += scr[e]; }
            const float isum = 1.f / sum;
#pragma unroll
            for (int e = 0; e < 16; ++e) scr[e] *= isum;
            float bestg = -3.4e38f; int gb = 0, bi1 = 0, bi2 = 1; float bw1 = 0.f, bw2 = 0.f;
#pragma unroll
            for (int g = 0; g < 4; ++g) {
                float m1 = scr[4 * g] + rb[4 * g], s1 = scr[4 * g]; int i1 = 0;
#pragma unroll
                for (int q = 1; q < 4; ++q) { const float sv = scr[4 * g + q] + rb[4 * g + q]; const bool ok = sv > m1; m1 = ok ? sv : m1; s1 = ok ? scr[4 * g + q] : s1; i1 = ok ? q : i1; }
                float m2 = -3.4e38f, s2 = 0.f; int i2 = 0;
#pragma unroll
                for (int q = 0; q < 4; ++q) { const float sv = scr[4 * g + q] + rb[4 * g + q]; const bool ok = (q != i1) && sv > m2; m2 = ok ? sv : m2; s2 = ok ? scr[4 * g + q] : s2; i2 = ok ? q : i2; }
                const float gs = m1 + m2; const bool better = gs > bestg;
                bestg = better ? gs : bestg; gb = better ? g : gb; bi1 = better ? i1 : bi1; bi2 = better ? i2 : bi2; bw1 = better ? s1 : bw1; bw2 = better ? s2 : bw2;
            }
            const float inv = 1.f / (bw1 + bw2);
            const int lo = bi1 < bi2 ? bi1 : bi2, hi2 = bi1 < bi2 ? bi2 : bi1;
            const float wlo = (bi1 < bi2 ? bw1 : bw2) * inv, whi = (bi1 < bi2 ? bw2 : bw1) * inv;
            const int pidx = lo == 0 ? hi2 - 1 : (lo == 1 ? hi2 + 1 : 5);
            const int slot = c.wave * 64 + nr + c.lane;
            rcls[slot] = gb * 6 + pidx; rw1[slot] = wlo; rw2[slot] = whi; rrow[slot] = base + c.lane;
        }
        nr += ROWS_PER_WAVE;
        LDS_WAIT();
    }
    LDS_WAIT();
    if (!publish) return;
    int rank = 0, cls = 0;
    if (c.lane < nr) { cls = rcls[c.wave * 64 + c.lane]; rank = atomicAdd(&lcnt[cls], 1); }
    __syncthreads();
    if (c.tid < NCLS) lbase[c.tid] = (int)__hip_atomic_fetch_add((unsigned*)(a.ws + WS_CTL) + CW_CNT + l * 32 + c.tid, (unsigned)lcnt[c.tid], RLX_AGENT);
    __syncthreads();
    if (c.lane < nr) {
        const int pos = lbase[cls] + rank;
        ((int*)(a.ws + WS_LIST))[(size_t)cls * LISTCAP + pos] = rrow[c.wave * 64 + c.lane];
        float* rw = (float*)(a.ws + WS_RW) + ((size_t)cls * LISTCAP + pos) * 2;
        rw[0] = rw1[c.wave * 64 + c.lane]; rw[1] = rw2[c.wave * 64 + c.lane];
    }
}

DEVFN void ph_rows_g(const Args& a, const Ctx& c, int l) {
    const float* mod = (const float*)(a.ws + WS_MOD) + (size_t)l * NB * NMOD;
    const bf16_t* X1B = (const bf16_t*)(a.ws + WS_X1B); const unsigned char* Y2 = (const unsigned char*)(a.ws + WS_AD);
    bf16_t* X2B = (bf16_t*)(a.ws + WS_X2B); bf16_t* HB = (bf16_t*)(a.ws + WS_HB);
    for (int base = c.gw * ROWS_PER_WAVE; base < NTOK; base += c.NGW * ROWS_PER_WAVE) {
        const float* mb = mod + (size_t)(base >> 11) * NMOD; const float* mb1 = mb + (size_t)NB * NMOD;
        f32x4 g2[4], lg[4], lb[4], sc[4], sh[4];
        vec_load(mb + 5 * DM, c.lane, g2); vec_load(a.in[I_LN2G] + l * DM, c.lane, lg); vec_load(a.in[I_LN2B] + l * DM, c.lane, lb);
        if (l == 0) { vec_load(mb1 + DM, c.lane, sc); vec_load(mb1, c.lane, sh); }
        u32x2 xc[4], xn[4]; unsigned yc[4], yn[4];
        bfrow_load(X1B + (size_t)base * DM, c.lane, xc);
#pragma unroll
        for (int j = 0; j < 4; ++j) yc[j] = *(const unsigned*)(Y2 + (size_t)base * DM + 4 * c.lane + 256 * j);
#pragma unroll 1
        for (int i = 0; i < ROWS_PER_WAVE; ++i) {
            const int m = base + i;
            if (i + 1 < ROWS_PER_WAVE) { bfrow_load(X1B + (size_t)(m + 1) * DM, c.lane, xn);
#pragma unroll
                for (int j = 0; j < 4; ++j) yn[j] = *(const unsigned*)(Y2 + (size_t)(m + 1) * DM + 4 * c.lane + 256 * j); }
            f32x4 v[4];
#pragma unroll
            for (int j = 0; j < 4; ++j) v[j] = bf4(xc[j]) * ALPHA + g2[j] * f8x4_to_f32(yc[j], 1.f / YSCALE);
            ln_aff(v, lg, lb);
            if (l == 0) { bfrow_store(X2B + (size_t)m * DM, c.lane, v); ln_mod(v, sc, sh); f8row_store((unsigned char*)HB + (size_t)m * DM, c.lane, v); }
            else {
#pragma unroll
                for (int j = 0; j < 4; ++j) *(f32x4*)(a.out + (size_t)m * DM + 4 * c.lane + 256 * j) = v[j]; }
#pragma unroll
            for (int j = 0; j < 4; ++j) { xc[j] = xn[j]; yc[j] = yn[j]; }
        }
    }
}

constexpr int MOETAB_OFF = 131072 + 512;
DEVFN void ph_inproj_fast(const Args& a, const Ctx& c, int l, bool dummy_kbar) {
    pg8::DenseSched S; S.so.init(NTOK, DIN, c.G, c.bid); S.A = (const char*)(a.ws + WS_HB); S.Bt = (const char*)(a.ws + WS_WIN) + (size_t)l * DIN * DM; S.lda = DM; S.ldb = DM;
    const pg8::EpiInproj E{(bf16_t*)(a.ws + WS_QKVP), (const float*)(a.ws + WS_ROPE), (dummy_kbar ? (float*)(a.ws + WS_RW) : (float*)(a.ws + WS_KBAR)) + (size_t)l * NB * NH * NBLK * HD};
    pg8::gemm_phase2<pg8::EpiInproj, pg8::DenseSched, true, true, false, true, 127 - 5, 127>(c.lds3, DM, DM, S, E, c.tid);
}
DEVFN void ph_wout_fast(const Args& a, const Ctx& c, int l) {
    pg8::DenseSched S; S.so.init(NTOK, DM, c.G, c.bid); S.A = (const char*)(a.ws + WS_AD); S.Bt = (const char*)(a.ws + WS_WOUT) + (size_t)l * DM * DM; S.lda = DM; S.ldb = DM;
    const pg8::EpiF8 E{(unsigned char*)(a.ws + WS_QKVP), DM};
    pg8::gemm_phase2<pg8::EpiF8, pg8::DenseSched, true, true, false, true, 127 - 5 + 4, 127 - 5, true, 127 - 7 + 4, 127>    (c.lds3, DM, DM, S, E, c.tid);
}
DEVFN void moe_table_lds(const Args& a, const Ctx& c, int l) {
    int* cnt = (int*)(c.lds + MOETAB_OFF); int* tp = cnt + 32;
    if (c.tid < NCLS) cnt[c.tid] = (int)__hip_atomic_load((unsigned*)(a.ws + WS_CTL) + CW_CNT + l * 32 + c.tid, RLX_AGENT);
    __syncthreads();
    if (c.tid <= NCLS) { int s = 0;
#pragma unroll
        for (int k = 0; k < NCLS; ++k) { const int nk = (cnt[k] + 255) >> 8; s += (k < c.tid) ? nk : 0; }
        tp[c.tid] = s; }
    __syncthreads();
    int* tcls = tp + 32;
    for (int T = c.tid; T < tp[NCLS]; T += 512) { int k = 0; while (T >= tp[k + 1]) ++k; tcls[T] = k; }
    __syncthreads();
}
DEVFN void ph_gateup_fast(const Args& a, const Ctx& c, int l) {
    moe_table_lds(a, c, l);
    pg8::GateUpSched S; S.cnt = (const LAS int*)(c.lds3 + MOETAB_OFF); S.tp = S.cnt + 32; S.tcls = S.tp + 32; S.npn_shift = 3; S.nunits = S.tp[NCLS] * 8; S.G = c.G; S.c = (c.G % 8 == 0) ? (c.bid % 8) * (c.G / 8) + c.bid / 8 : c.bid;
    S.HB = (const char*)(a.ws + WS_HB); S.list = (const int*)(a.ws + WS_LIST); S.W = (const char*)(a.ws + WS_WGU) + (size_t)l * NE * DM * DM;
    const pg8::EpiGateUp E{(unsigned char*)(a.ws + WS_QKVP), (const float*)(a.ws + WS_RW)};
    pg8::gemm_phase2<pg8::EpiGateUp, pg8::GateUpSched, true, true, false, true, 127 - 5, 127>(c.lds3, DM, DM, S, E, c.tid);
}
DEVFN void ph_down_fast(const Args& a, const Ctx& c, int l) {
    moe_table_lds(a, c, l);
    pg8::DownSched S; S.cnt = (const LAS int*)(c.lds3 + MOETAB_OFF); S.tp = S.cnt + 32; S.tcls = S.tp + 32; S.npn_shift = 2; S.nunits = S.tp[NCLS] * 4; S.G = c.G; S.c = (c.G % 8 == 0) ? (c.bid % 8) * (c.G / 8) + c.bid / 8 : c.bid;
    S.ACT = (const char*)(a.ws + WS_QKVP); S.W = (const char*)(a.ws + WS_WD) + (size_t)l * NE * DM * DE;
    const pg8::EpiDown E{(unsigned char*)(a.ws + WS_AD), (const int*)(a.ws + WS_LIST)};
    pg8::gemm_phase2<pg8::EpiDown, pg8::DownSched, true, true, true, true, 127 - 5 + 4, 127 - 3>    (c.lds3, DM, DE, S, E, c.tid);
}

#ifndef MK_N_LAUNCHES
#define MK_N_LAUNCHES 1
#endif
constexpr int RING_BYTES = 131072, LDSCTL_OFF = RING_BYTES, MISC_OFF = LDSCTL_OFF + 320, LDS_BYTES = 147456;
constexpr int PH_PER_LAYER = 7, NPHASE = 2 + 2 * PH_PER_LAYER;
constexpr int CW_BAR = 4096;
static_assert((CW_BAR + XCD_BAR_WORDS) * 4 <= (int)CTL_ZERO_BYTES, "CTL");

__global__ void __launch_bounds__(512, 2) fwd(Args a) {
    extern __shared__ __attribute__((aligned(16))) unsigned char lds[];
    const int wave_s = __builtin_amdgcn_readfirstlane(threadIdx.x >> 6);
#define MKTID() (wave_s * 64 + lane_id_volatile())
#define MKCTX() Args al = a; { size_t z_ = 0; asm volatile("" : "+s"(z_)); al.ws = a.ws + z_; } Ctx c; {     int t_ = MKTID(); asm volatile("" : "+v"(t_)); c.lds = lds; c.lds3 = (LAS unsigned char*)lds; c.tid = t_; c.lane = t_ & 63; c.wave = __builtin_amdgcn_readfirstlane(t_ >> 6); c.G = gridDim.x; c.bid = blockIdx.x; c.gw = c.bid * 8 + c.wave; c.NGW = c.G * 8; }
    const int lo = a.ph_lo, hi = a.ph_hi;
    const bool one = (hi - lo) > 1;
    for (int u = threadIdx.x; u < (LDS_BYTES - LDSCTL_OFF) / 4; u += 512) ((LAS unsigned*)((LAS unsigned char*)lds + LDSCTL_OFF))[u] = 0u;
    __syncthreads();
    XcdBarrier bar; bar.bar = (unsigned*)(a.ws + WS_CTL) + CW_BAR; bar.x = 0; bar.st = nullptr;
    if (one) bar = xcd_barrier_post((unsigned*)(a.ws + WS_CTL) + CW_BAR, (volatile LAS unsigned*)((LAS unsigned char*)lds + MISC_OFF) + 8);
#ifndef REP_PHASE
#define REP_PHASE -1
#endif
#define IN(k) (lo <= (k) && (k) < hi)
#define SEAM(k) do { if (IN(k) && IN((k) + 1)) { XcdBarrier bl_ = bar; { size_t z_ = 0; unsigned x_ = bar.x; asm volatile("" : "+s"(z_), "+s"(x_)); bl_.bar = bar.bar + z_; bl_.x = x_; } xcd_barrier(bl_, MKTID() == 0); } } while (0)
    if (IN(0)) { MKCTX(); ph_prologue(al, c); if (REP_PHASE == 0) { __syncthreads(); ph_prologue(al, c); } SEAM(0); }
    if (IN(1)) { MKCTX(); ph_h1_rows(al, c); if (REP_PHASE == 1) ph_h1_rows(al, c); SEAM(1); }
    {
        constexpr int l = 0; constexpr int p0 = 2 + l * PH_PER_LAYER;
        if (IN(p0 + 0)) { MKCTX(); ph_inproj_fast(al, c, l, false); if (REP_PHASE == 10) { __syncthreads(); ph_inproj_fast(al, c, l, true); } SEAM(p0 + 0); }
        if (IN(p0 + 1)) {
            { MKCTX(); ph_pool(al, c); }
            __syncthreads();
            const attn_body::AttnTensors AT{(const attn_body::bf16*)(a.ws + WS_QKVP), (const attn_body::bf16*)(a.ws + WS_QKVP) + 512, (const attn_body::bf16*)(a.ws + WS_QKVP) + 1024,
                                            (attn_body::bf16*)(a.ws + WS_AD), (const float*)(a.ws + WS_KBAR) + (size_t)l * NB * NH * NBLK * HD};
            const attn_body::StaticOrder S((int)gridDim.x, (int)blockIdx.x);
            attn_body::attn_phase<attn_body::StaticOrder>((char*)lds, AT, S, MKTID());
            if (REP_PHASE == 11) attn_body::attn_phase<attn_body::StaticOrder>((char*)lds, AT, S, MKTID());
            if (REP_PHASE == 17) { __syncthreads(); MKCTX(); ph_pool(al, c); }
            SEAM(p0 + 1);
        }
        if (IN(p0 + 2)) { MKCTX(); ph_wout_fast(al, c, l); if (REP_PHASE == 12) { __syncthreads(); ph_wout_fast(al, c, l); } SEAM(p0 + 2); }
        if (IN(p0 + 3)) { MKCTX(); if (REP_PHASE == 13) { ph_rows_c(al, c, l, false); __syncthreads(); } ph_rows_c(al, c, l, true); SEAM(p0 + 3); }
        if (IN(p0 + 4)) { MKCTX(); ph_gateup_fast(al, c, l); if (REP_PHASE == 14) { __syncthreads(); ph_gateup_fast(al, c, l); } SEAM(p0 + 4); }
        if (IN(p0 + 5)) { MKCTX(); ph_down_fast(al, c, l); if (REP_PHASE == 15) { __syncthreads(); ph_down_fast(al, c, l); } SEAM(p0 + 5); }
        if (IN(p0 + 6)) { MKCTX(); ph_rows_g(al, c, l); if (REP_PHASE == 16) ph_rows_g(al, c, l); SEAM(p0 + 6); }
    }
    {
        constexpr int l = 1; constexpr int p0 = 2 + l * PH_PER_LAYER;
        if (IN(p0 + 0)) { MKCTX(); ph_inproj_fast(al, c, l, false); if (REP_PHASE == 10) { __syncthreads(); ph_inproj_fast(al, c, l, true); } SEAM(p0 + 0); }
        if (IN(p0 + 1)) {
            { MKCTX(); ph_pool(al, c); }
            __syncthreads();
            const attn_body::AttnTensors AT{(const attn_body::bf16*)(a.ws + WS_QKVP), (const attn_body::bf16*)(a.ws + WS_QKVP) + 512, (const attn_body::bf16*)(a.ws + WS_QKVP) + 1024,
                                            (attn_body::bf16*)(a.ws + WS_AD), (const float*)(a.ws + WS_KBAR) + (size_t)l * NB * NH * NBLK * HD};
            const attn_body::StaticOrder S((int)gridDim.x, (int)blockIdx.x);
            attn_body::attn_phase<attn_body::StaticOrder>((char*)lds, AT, S, MKTID());
            if (REP_PHASE == 11) attn_body::attn_phase<attn_body::StaticOrder>((char*)lds, AT, S, MKTID());
            if (REP_PHASE == 17) { __syncthreads(); MKCTX(); ph_pool(al, c); }
            SEAM(p0 + 1);
        }
        if (IN(p0 + 2)) { MKCTX(); ph_wout_fast(al, c, l); if (REP_PHASE == 12) { __syncthreads(); ph_wout_fast(al, c, l); } SEAM(p0 + 2); }
        if (IN(p0 + 3)) { MKCTX(); if (REP_PHASE == 13) { ph_rows_c(al, c, l, false); __syncthreads(); } ph_rows_c(al, c, l, true); SEAM(p0 + 3); }
        if (IN(p0 + 4)) { MKCTX(); ph_gateup_fast(al, c, l); if (REP_PHASE == 14) { __syncthreads(); ph_gateup_fast(al, c, l); } SEAM(p0 + 4); }
        if (IN(p0 + 5)) { MKCTX(); ph_down_fast(al, c, l); if (REP_PHASE == 15) { __syncthreads(); ph_down_fast(al, c, l); } SEAM(p0 + 5); }
        if (IN(p0 + 6)) { MKCTX(); ph_rows_g(al, c, l); if (REP_PHASE == 16) ph_rows_g(al, c, l); SEAM(p0 + 6); }
    }
#undef IN
#undef SEAM
}

extern "C" void kernel_launch(void* const* d_in, const int* in_sizes, int n_in, void* d_out, int out_size, void* d_ws, size_t ws_size, hipStream_t stream) {
    static int grid = 0;
    if (grid == 0) {
        if (n_in != 17 || out_size != NTOK * DM || ws_size < WS_END) { fprintf(stderr, "kernel_launch: unexpected problem (n_in %d out %d ws %zu)\n", n_in, out_size, ws_size); grid = -1; return; }
        if (hipFuncSetAttribute((const void*)fwd, hipFuncAttributeMaxDynamicSharedMemorySize, LDS_BYTES) != hipSuccess) { fprintf(stderr, "kernel_launch: hipFuncSetAttribute failed\n"); grid = -1; return; }
        int dev = 0, cus = 0, per_cu = 0;
        (void)hipGetDevice(&dev); (void)hipDeviceGetAttribute(&cus, hipDeviceAttributeMultiprocessorCount, dev);
        if (hipOccupancyMaxActiveBlocksPerMultiprocessor(&per_cu, (const void*)fwd, 512, LDS_BYTES) != hipSuccess || per_cu < 1) fprintf(stderr, "kernel_launch: occupancy query reports %d workgroups per CU\n", per_cu);
        (void)hipGetLastError();
        grid = cus > 0 ? cus : 256;
    }
    if (grid < 0) return;
    (void)hipMemsetAsync((char*)d_ws + WS_CTL, 0, CTL_ZERO_BYTES, stream);
    Args a{};
    for (int i = 0; i < 17; ++i) a.in[i] = (const float*)d_in[i];
    a.out = (float*)d_out; a.ws = (unsigned char*)d_ws;
#if MK_N_LAUNCHES == 1
    a.ph_lo = 0; a.ph_hi = NPHASE; hipLaunchKernelGGL(fwd, dim3(grid), dim3(512), LDS_BYTES, stream, a);
#else
    for (int p = 0; p < NPHASE; ++p) { a.ph_lo = p; a.ph_hi = p + 1; hipLaunchKernelGGL(fwd, dim3(grid), dim3(512), LDS_BYTES, stream, a); }
#endif
}
```

```cpp
#include <hip/hip_runtime.h>
#include <cstdint>
#include <cstdio>

constexpr int NB = 16, SEQ = 2048, DM = 1024, NTOK = NB * SEQ, DIN = 2048, NH = 8, HD = 64, NBLK = 8, MBLK = 256;
constexpr int NE = 16, NCLS = 24, DE = 512, NMOD = 6 * DM;
constexpr float ALPHA = 1.41421356237309515f, LN_EPS = 1e-5f;
constexpr float QSCALE = 0.125f * 1.4426950408889634f;
constexpr int LISTCAP = NTOK;

constexpr size_t MiB = 1u << 20;
constexpr size_t WS_CTL = 0, CTL_ZERO_BYTES = 1 * MiB;
constexpr size_t WS_MOD = 1 * MiB;
constexpr size_t WS_ROPE = 2 * MiB;
constexpr size_t WS_KBAR = 2 * MiB + 256 * 1024;
constexpr size_t WS_LIST = 3 * MiB;
constexpr size_t WS_RW = 6 * MiB;
constexpr size_t WS_WIN = 12 * MiB;
constexpr size_t WS_WOUT = 20 * MiB;
constexpr size_t WS_WGU = 24 * MiB;
constexpr size_t WS_WD = 88 * MiB;
constexpr size_t WS_HB = 120 * MiB;
constexpr size_t WS_QKVP = 184 * MiB;
constexpr size_t WS_AD = 312 * MiB;
constexpr size_t WS_X1 = 376 * MiB;
constexpr size_t WS_END = 504 * MiB;
constexpr int CW_TMO = 0, CW_CNT = 64;

typedef unsigned short bf16_t;
typedef short bf16x8 __attribute__((ext_vector_type(8)));
typedef float f32x4 __attribute__((ext_vector_type(4)));
typedef float f32x16 __attribute__((ext_vector_type(16)));
typedef unsigned u32x4 __attribute__((ext_vector_type(4)));
typedef unsigned u32x2 __attribute__((ext_vector_type(2)));

#define DEVFN __device__ __forceinline__
#define LDS_WAIT() asm volatile("s_waitcnt lgkmcnt(0)" ::: "memory")
#define RLX_AGENT __ATOMIC_RELAXED, __HIP_MEMORY_SCOPE_AGENT

DEVFN float bf_lo(unsigned w) { return __uint_as_float(w << 16); }
DEVFN float bf_hi(unsigned w) { return __uint_as_float(w & 0xffff0000u); }
DEVFN float bf2f(bf16_t v) { return __uint_as_float((unsigned)v << 16); }
DEVFN unsigned f2bf(float f) { unsigned u = __float_as_uint(f); return (u + 0x7fffu + ((u >> 16) & 1u)) >> 16; }
DEVFN unsigned pk2(float lo, float hi) { unsigned r; asm("v_cvt_pk_bf16_f32 %0, %1, %2" : "=v"(r) : "v"(lo), "v"(hi)); return r; }
DEVFN unsigned pk4_fp8(float a, float b, float c, float d) {
    a = __builtin_amdgcn_fmed3f(a, -448.f, 448.f); b = __builtin_amdgcn_fmed3f(b, -448.f, 448.f); c = __builtin_amdgcn_fmed3f(c, -448.f, 448.f); d = __builtin_amdgcn_fmed3f(d, -448.f, 448.f);
    unsigned w = 0u; w = __builtin_amdgcn_cvt_pk_fp8_f32(a, b, w, false); w = __builtin_amdgcn_cvt_pk_fp8_f32(c, d, w, true); return w; }
DEVFN f32x4 f8x4_to_f32(unsigned w, float sc) { const auto lo = __builtin_amdgcn_cvt_pk_f32_fp8(w, false), hi = __builtin_amdgcn_cvt_pk_f32_fp8(w, true); return (f32x4){lo[0] * sc, lo[1] * sc, hi[0] * sc, hi[1] * sc}; }
constexpr float YSCALE = 16.f;
DEVFN int crow(int r, int hi) { return (r & 3) + 8 * (r >> 2) + 4 * hi; }
#define SWZ_XOR(m) (0x1f | ((m) << 10))
DEVFN float swz_xor_add(float v, const int m) {
    switch (m) {
        case 1: return v + __int_as_float(__builtin_amdgcn_ds_swizzle(__float_as_int(v), SWZ_XOR(1)));
        case 2: return v + __int_as_float(__builtin_amdgcn_ds_swizzle(__float_as_int(v), SWZ_XOR(2)));
        case 4: return v + __int_as_float(__builtin_amdgcn_ds_swizzle(__float_as_int(v), SWZ_XOR(4)));
        case 8: return v + __int_as_float(__builtin_amdgcn_ds_swizzle(__float_as_int(v), SWZ_XOR(8)));
        default: return v + __int_as_float(__builtin_amdgcn_ds_swizzle(__float_as_int(v), SWZ_XOR(16)));
    }
}
DEVFN float half_swap_add(float v) { auto rr = __builtin_amdgcn_permlane32_swap(__float_as_uint(v), __float_as_uint(v), false, false); return __uint_as_float(rr[0]) + __uint_as_float(rr[1]); }
DEVFN float wave_sum(float v) {
    v = swz_xor_add(v, 1); v = swz_xor_add(v, 2); v = swz_xor_add(v, 4); v = swz_xor_add(v, 8); v = swz_xor_add(v, 16);
    return half_swap_add(v);
}
__host__ __device__ __forceinline__ int inproj_lgroup(int P) { return P < 16 ? (P >> 2) * 8 + (P & 3) * 2 : ((P - 16) >> 2) * 8 + ((P - 16) & 3) * 2 + 1; }
__host__ __device__ __forceinline__ int inproj_nlog(int n) { return (n & ~255) + inproj_lgroup((n & 255) >> 3) * 8 + (n & 7); }

#define GAS __attribute__((address_space(1)))
#define LAS __attribute__((address_space(3)))
typedef GAS unsigned gu32;
namespace pg8 {
#define PG8_LAS __attribute__((address_space(3)))
typedef unsigned short bf16_t;
typedef short bf16x8 __attribute__((ext_vector_type(8)));
typedef float f32x4 __attribute__((ext_vector_type(4)));
typedef unsigned u32x4 __attribute__((ext_vector_type(4)));
constexpr int BM = 256, BK = 64, HALF = 128, HTB = HALF * BK * 2  , STAGE_BYTES = 8 * HTB, NXCD = 8, WGM = 8;

__host__ __device__ __forceinline__ int lds_byte(int r, int c) { const int st = (r >> 4) * 2 + (c >> 5), rr = r & 15, cc = c & 31, ob = rr * 64 + cc * 2; return st * 1024 + (ob ^ (((ob >> 9) & 1) << 5)); }
__host__ __device__ __forceinline__ void stage_rc(int b, int& R, int& C) { const int st = b / 1024, sb = b % 1024, swz = sb ^ (((sb >> 9) & 1) << 5); R = (st >> 1) * 16 + swz / 64; C = (st & 1) * 32 + (swz % 64) / 2; }
__host__ __device__ __forceinline__ int perm32(int rho) { const int n = rho >> 4, i = rho & 15; return 8 * (i >> 2) + 4 * n + (i & 3); }

struct Unit { int pm, pn; };
struct Gemm { const bf16_t* A; const bf16_t* Bt; int M, N, K; };

struct StaticOrder {
    int nM, nN, nwg, G, c;
    __host__ __device__ void init(int M, int N, int G_, int c_) { nM = M / BM; nN = N / BM; nwg = nM * nN; G = G_; c = c_; }
    __host__ __device__ bool next(int i, Unit& u) const {
        const long L = (long)i * G + c; if (L >= nwg) return false;
        int wgid = (int)L; { const int q = nwg / NXCD, r = nwg % NXCD, xcd = wgid % NXCD, off = wgid / NXCD; wgid = (xcd < r ? xcd * (q + 1) : r * (q + 1) + (xcd - r) * q) + off; }
        const int nig = WGM * nN, gid = wgid / nig, fm = gid * WGM, gsz = (nM - fm) < WGM ? (nM - fm) : WGM;
        u.pm = fm + ((wgid % nig) % gsz); u.pn = (wgid % nig) / gsz; return true;
    }
    __device__ __forceinline__ void a_ready(const Unit&) const {}
    __device__ __forceinline__ void done(const Unit&) const {}
};

__device__ __forceinline__ unsigned cvt_pk_bf16(float lo, float hi) { unsigned r; asm volatile("v_cvt_pk_bf16_f32 %0, %1, %2" : "=v"(r) : "v"(lo), "v"(hi)); return r; }
}
namespace pg8 {
typedef int v8i_t __attribute__((ext_vector_type(8))); typedef int v4i_t __attribute__((ext_vector_type(4)));
__device__ __forceinline__ int pg8_lane_volatile() { int l; asm volatile("v_mbcnt_lo_u32_b32 %0, -1, 0\n\tv_mbcnt_hi_u32_b32 %0, -1, %0" : "=v"(l)); return l; }
template <class Epi, class Sched, bool ALIGN_EPI, bool GATHER, bool KSPLIT, bool FP8 = false, int SCW = 127, int SCA = 127, bool SC2 = false, int SCW2 = 127, int SCA2 = 127>
__device__ __forceinline__ void gemm_phase2(PG8_LAS unsigned char* lds, const int Kbytes, const int ldb_bytes, const Sched& S, const Epi& E, const int tid) {
    typedef typename Sched::UnitT UnitT;
    const int wid = __builtin_amdgcn_readfirstlane(tid >> 6), lane = tid & 63, wr = wid >> 2, wc = wid & 3, fr = lane & 15, fq = lane >> 4;
    int nt = Kbytes / (BK * 2); asm volatile("" : "+s"(nt));
    const int nth = nt / 2;
    unsigned voffB[2];
#pragma unroll
    for (int i = 0; i < 2; ++i) { int R[2], C[2]; stage_rc(tid * 16 + i * 8192, R[i], C[i]); const int Rb = Epi::PERM ? ((R[i] & ~31) + perm32(R[i] & 31)) : R[i]; voffB[i] = (unsigned)(Rb * ldb_bytes + C[i] * 2); }
    const size_t kstep = (size_t)(BK * 2);
    const size_t hstepB = (size_t)HALF * ldb_bytes;
    const unsigned ldsw = (unsigned)wid * 1024u;
    const int aoff = lds_byte(wr * 64 + fr, fq * 8), boff = lds_byte(wc * 32 + fr, fq * 8);
#define PG8_SA(b, h) (((b) * 2 + (h)) * HTB)
#define PG8_SB(b, h) ((4 + (b) * 2 + (h)) * HTB)
#define PG8_STAGE(bufoff, gbase, voff) do { _Pragma("unroll") for (int _i = 0; _i < 2; ++_i) \
        __builtin_amdgcn_global_load_lds((const unsigned*)((const char*)(gbase) + (voff)[_i]), (PG8_LAS unsigned*)(lds + (bufoff) + ldsw + _i * 8192), 16, 0, 0); } while (0)
#define PG8_LDA(dst, b, h) do { _Pragma("unroll") for (int m = 0; m < 4; ++m) _Pragma("unroll") for (int k = 0; k < 2; ++k) dst[m][k] = *(const PG8_LAS bf16x8*)(lds + PG8_SA(b, h) + aoff + m * 2048 + k * 1024); } while (0)
#define PG8_LDB(dst, b, h) do { _Pragma("unroll") for (int n = 0; n < 2; ++n) _Pragma("unroll") for (int k = 0; k < 2; ++k) dst[n][k] = *(const PG8_LAS bf16x8*)(lds + PG8_SB(b, h) + boff + n * 2048 + k * 1024); } while (0)
#define PG8_CAT8(x) __builtin_shufflevector(__builtin_bit_cast(v4i_t, (x)[0]), __builtin_bit_cast(v4i_t, (x)[1]), 0, 1, 2, 3, 4, 5, 6, 7)
#define PG8_MMA(ai, bj, At, Bt) do { __builtin_amdgcn_s_setprio(1); \
        if constexpr (FP8) { _Pragma("unroll") for (int m = 0; m < 4; ++m) _Pragma("unroll") for (int n = 0; n < 2; ++n) \
            acc[ai][bj][m][n] = __builtin_amdgcn_mfma_scale_f32_16x16x128_f8f6f4(PG8_CAT8(Bt[n]), PG8_CAT8(At[m]), acc[ai][bj][m][n], 0, 0, 0, scw_, 0, sca_); } \
        else { _Pragma("unroll") for (int m = 0; m < 4; ++m) _Pragma("unroll") for (int n = 0; n < 2; ++n) _Pragma("unroll") for (int k = 0; k < 2; ++k) \
            acc[ai][bj][m][n] = __builtin_amdgcn_mfma_f32_16x16x32_bf16(Bt[n][k], At[m][k], acc[ai][bj][m][n], 0, 0, 0); } \
        __builtin_amdgcn_s_setprio(0); } while (0)
#define PG8_STAGE1(bufoff, gbase, voff, _i) __builtin_amdgcn_global_load_lds((const unsigned*)((const char*)(gbase) + (voff)[_i]), (PG8_LAS unsigned*)(lds + (bufoff) + ldsw + (_i) * 8192), 16, 0, 0)
#define PG8_MF(ai, bj, m, n, At, Bt) do { if constexpr (FP8) acc[ai][bj][m][n] = __builtin_amdgcn_mfma_scale_f32_16x16x128_f8f6f4(PG8_CAT8(Bt[n]), PG8_CAT8(At[m]), acc[ai][bj][m][n], 0, 0, 0, scw_, 0, sca_); \
        else { acc[ai][bj][m][n] = __builtin_amdgcn_mfma_f32_16x16x32_bf16(Bt[n][0], At[m][0], acc[ai][bj][m][n], 0, 0, 0); acc[ai][bj][m][n] = __builtin_amdgcn_mfma_f32_16x16x32_bf16(Bt[n][1], At[m][1], acc[ai][bj][m][n], 0, 0, 0); } } while (0)
#define PG8_MF2(ai, bj, m, At, Bt) do { PG8_MF(ai, bj, m, 0, At, Bt); PG8_MF(ai, bj, m, 1, At, Bt); PG8_SCHED; } while (0)
#define PG8_CL1(ai, At, S0) do { __builtin_amdgcn_s_setprio(1); PG8_MF2(ai, 0, 0, At, B0); PG8_MF2(ai, 0, 1, At, B0); S0(0); PG8_SCHED; PG8_MF2(ai, 0, 2, At, B0); PG8_MF2(ai, 0, 3, At, B0); S0(1); PG8_SCHED; \
        PG8_MF2(ai, 1, 0, At, B1); PG8_MF2(ai, 1, 1, At, B1); PG8_MF2(ai, 1, 2, At, B1); PG8_MF2(ai, 1, 3, At, B1); __builtin_amdgcn_s_setprio(0); } while (0)
#define PG8_CL2(ai, At, S0, S1, S2) do { __builtin_amdgcn_s_setprio(1); PG8_MF2(ai, 0, 0, At, B0); S0(0); PG8_SCHED; PG8_MF2(ai, 0, 1, At, B0); S0(1); PG8_SCHED; PG8_MF2(ai, 0, 2, At, B0); S1(0); PG8_SCHED; PG8_MF2(ai, 0, 3, At, B0); S1(1); PG8_SCHED; \
        PG8_MF2(ai, 1, 0, At, B1); S2(0); PG8_SCHED; PG8_MF2(ai, 1, 1, At, B1); S2(1); PG8_SCHED; PG8_MF2(ai, 1, 2, At, B1); PG8_MF2(ai, 1, 3, At, B1); __builtin_amdgcn_s_setprio(0); } while (0)
#define PG8_WAIT_V(n) asm volatile("s_waitcnt vmcnt(" #n ")" ::: "memory")
#define PG8_WAIT_L(n) asm volatile("s_waitcnt lgkmcnt(" #n ")" ::: "memory")
#define PG8_BAR __builtin_amdgcn_s_barrier()
#define PG8_SCHED __builtin_amdgcn_sched_barrier(0)
#define PG8_PIN(ai) asm volatile("" :: "v"(acc[ai][0][0][0]), "v"(acc[ai][0][0][1]), "v"(acc[ai][0][1][0]), "v"(acc[ai][0][1][1]), "v"(acc[ai][0][2][0]), "v"(acc[ai][0][2][1]), "v"(acc[ai][0][3][0]), "v"(acc[ai][0][3][1]), \
        "v"(acc[ai][1][0][0]), "v"(acc[ai][1][0][1]), "v"(acc[ai][1][1][0]), "v"(acc[ai][1][1][1]), "v"(acc[ai][1][2][0]), "v"(acc[ai][1][2][1]), "v"(acc[ai][1][3][0]), "v"(acc[ai][1][3][1]))
#define PG8_BK(cb, cb2, kt) ((KSPLIT && (kt) >= nth) ? (cb2) + (size_t)((kt) - nth) * kstep : (cb) + (size_t)(kt) * kstep)
    UnitT cur, nxt; int ui = 0;
    if (!S.next(0, cur)) return;
    f32x4 acc[2][2][4][2];
#pragma unroll
    for (int a = 0; a < 2; ++a)
#pragma unroll
        for (int b = 0; b < 2; ++b)
#pragma unroll
            for (int m = 0; m < 4; ++m)
#pragma unroll
                for (int n = 0; n < 2; ++n) acc[a][b][m][n] = (f32x4){0.f, 0.f, 0.f, 0.f};
    bf16x8 At[4][2], B0[2][2], B1[2][2];
    unsigned vA[2][2];
    S.arows(cur, tid, vA);
    PG8_LAS u32x4* const vslot = (PG8_LAS u32x4*)(lds + STAGE_BYTES + 2048) + tid;
    const char* cA = S.aptr(cur); const char* cB = S.bptr(cur); const char* cB2 = KSPLIT ? S.bptr2(cur) : cB;
    PG8_STAGE(PG8_SB(0, 0), cB, voffB); PG8_STAGE(PG8_SB(0, 1), cB + hstepB, voffB); PG8_STAGE(PG8_SA(0, 0), cA, vA[0]); PG8_STAGE(PG8_SA(0, 1), cA, vA[1]);
    if (wr == 1) PG8_BAR;
    PG8_WAIT_V(2); PG8_BAR;
    PG8_STAGE(PG8_SB(1, 0), PG8_BK(cB, cB2, 1), voffB); PG8_STAGE(PG8_SA(1, 0), cA + kstep, vA[0]); PG8_STAGE(PG8_SB(1, 1), PG8_BK(cB, cB2, 1) + hstepB, voffB);
    PG8_WAIT_V(6); PG8_BAR;
    for (;;) {
        const bool has_next = S.next(ui + 1, nxt);
        const char* nA = has_next ? S.aptr(nxt) : cA; const char* nB = has_next ? S.bptr(nxt) : cB; const char* nB2 = (KSPLIT && has_next) ? S.bptr2(nxt) : cB2;
        if (GATHER && has_next) { unsigned vn_[2][2]; S.arows(nxt, wid * 64 + pg8_lane_volatile(), vn_); *vslot = (u32x4){vn_[0][0], vn_[0][1], vn_[1][0], vn_[1][1]}; }
        for (int t = 0; t < nt; t += 2) {
            const bool last = (t == nt - 2);
            const int scw_ = ((SC2 && t >= nth) ? SCW2 : SCW) * 0x01010101, sca_ = ((SC2 && t >= nth) ? SCA2 : SCA) * 0x01010101; (void)scw_; (void)sca_;
            const char* a1 = cA + (size_t)(t + 1) * kstep;
            const char* a2 = last ? nA : cA + (size_t)(t + 2) * kstep;
            const char* b2 = last ? nB : PG8_BK(cB, cB2, t + 2);
            const char* b3 = last ? (KSPLIT ? PG8_BK(nB, nB2, 1) : nB + kstep) : PG8_BK(cB, cB2, t + 3);
            const char* a3 = a2 + kstep;
#define ST_A11(i) PG8_STAGE1(PG8_SA(1, 1), a1, vA[1], i)
#define ST_B00(i) PG8_STAGE1(PG8_SB(0, 0), b2, voffB, i)
#define ST_B01(i) PG8_STAGE1(PG8_SB(0, 1), b2 + hstepB, voffB, i)
#define ST_A00(i) PG8_STAGE1(PG8_SA(0, 0), a2, vA[0], i)
#define ST_A01(i) PG8_STAGE1(PG8_SA(0, 1), a2, vA[1], i)
#define ST_B10(i) PG8_STAGE1(PG8_SB(1, 0), b3, voffB, i)
#define ST_B11(i) PG8_STAGE1(PG8_SB(1, 1), b3 + hstepB, voffB, i)
#define ST_A10(i) PG8_STAGE1(PG8_SA(1, 0), a3, vA[0], i)
            PG8_LDB(B0, 0, 0); PG8_LDB(B1, 0, 1); PG8_SCHED; PG8_LDA(At, 0, 0);
            PG8_WAIT_V(6); PG8_WAIT_L(0); PG8_BAR; PG8_CL1(0, At, ST_A11); PG8_PIN(0); PG8_BAR; PG8_SCHED;
            if (GATHER && last && has_next) { const u32x4 vn_ = *vslot; vA[0][0] = vn_.x; vA[0][1] = vn_.y; vA[1][0] = vn_.z; vA[1][1] = vn_.w; }
            PG8_LDA(At, 0, 1);
            PG8_WAIT_V(2); PG8_WAIT_L(0); PG8_BAR; PG8_CL2(1, At, ST_B00, ST_B01, ST_A00); PG8_PIN(1); PG8_BAR; PG8_SCHED;
            PG8_LDB(B0, 1, 0); PG8_LDB(B1, 1, 1); PG8_SCHED; PG8_LDA(At, 1, 0);
            PG8_WAIT_V(6); PG8_WAIT_L(0); PG8_BAR; PG8_CL1(0, At, ST_A01); PG8_PIN(0); PG8_BAR; PG8_SCHED;
            PG8_LDA(At, 1, 1);
            PG8_WAIT_V(2); PG8_WAIT_L(0); PG8_BAR; PG8_CL2(1, At, ST_B10, ST_B11, ST_A10); PG8_PIN(1); PG8_BAR; PG8_SCHED;
#undef ST_A11
#undef ST_B00
#undef ST_B01
#undef ST_A00
#undef ST_A01
#undef ST_B10
#undef ST_B11
#undef ST_A10
        }
        if constexpr (ALIGN_EPI) { if (wr == 0) PG8_BAR; }
        if constexpr (!Epi::AFTER_DRAIN) { const int le_ = pg8_lane_volatile(); E(acc, cur, wr, wc, le_ & 15, le_ >> 4); }
        if (!has_next) break;
#pragma unroll
        for (int a = 0; a < 2; ++a)
#pragma unroll
            for (int b = 0; b < 2; ++b)
#pragma unroll
                for (int m = 0; m < 4; ++m)
#pragma unroll
                    for (int n = 0; n < 2; ++n) acc[a][b][m][n] = (f32x4){0.f, 0.f, 0.f, 0.f};
        cur = nxt; cA = nA; cB = nB; cB2 = nB2; ++ui;
        if constexpr (ALIGN_EPI) { if (wr == 1) PG8_BAR; }
    }
    PG8_WAIT_V(0);
    if constexpr (!ALIGN_EPI) { if (wr == 0) PG8_BAR; }
    PG8_BAR;
    if constexpr (Epi::AFTER_DRAIN) { E.fused(acc, cur, wr, wc, fr, fq, lds, wid, lane); }
#undef PG8_SA
#undef PG8_SB
#undef PG8_STAGE
#undef PG8_LDA
#undef PG8_LDB
#undef PG8_MMA
#undef PG8_WAIT_V
#undef PG8_WAIT_L
#undef PG8_BAR
#undef PG8_SCHED
#undef PG8_BK
#undef PG8_PIN
#undef PG8_STAGE1
#undef PG8_MF
#undef PG8_MF2
#undef PG8_CL1
#undef PG8_CL2
#undef PG8_CAT8
}
}
namespace pg8 {
DEVFN unsigned pkbf(float lo, float hi) { return cvt_pk_bf16(lo, hi); }
struct DenseSched {
    typedef Unit UnitT;
    StaticOrder so; const char* A; const char* Bt; int lda, ldb;
    DEVFN bool next(int i, Unit& u) const { return so.next(i, u); }
    DEVFN const char* aptr(const Unit&) const { return A; }
    DEVFN void arows(const Unit& u, const int tid_, unsigned (&v)[2][2]) const {
        int R[2], C[2]; { int t_ = tid_; asm volatile("" : "+v"(t_)); stage_rc(t_ * 16, R[0], C[0]); stage_rc(t_ * 16 + 8192, R[1], C[1]); }
#pragma unroll
        for (int h = 0; h < 2; ++h)
#pragma unroll
            for (int i = 0; i < 2; ++i) v[h][i] = (unsigned)((u.pm * BM + h * HALF + R[i]) * lda + C[i] * 2); }
    DEVFN const char* bptr(const Unit& u) const { return Bt + (size_t)u.pn * BM * ldb; }
    DEVFN const char* bptr2(const Unit& u) const { return bptr(u); }
};
struct EpiInproj {
    static constexpr bool PERM = true, AFTER_DRAIN = false;
    bf16_t* O; const float* rope; float* kbar;
    DEVFN void operator()(f32x4 (&acc)[2][2][4][2], const Unit& u, int wr, int wc, int fr, int fq) const {
        const int pn = u.pn, row0 = u.pm * BM + wr * 64 + fr;
        if (pn < 4 && fq == 0) {
#pragma unroll
            for (int ai = 0; ai < 2; ++ai)
#pragma unroll
                for (int m = 0; m < 4; ++m) { const int t = (row0 + ai * HALF + m * 16) & (SEQ - 1); const f32x4* rp = (const f32x4*)(rope + t * 16);
#pragma unroll
                    for (int q = 0; q < 4; ++q) { const f32x4 cs = rp[q];
                        { const int d = 2 * q, n = d >> 2, e = d & 3; const float x1 = acc[ai][0][m][n][e], x2 = acc[ai][1][m][n][e]; acc[ai][0][m][n][e] = x1 * cs[0] - x2 * cs[1]; acc[ai][1][m][n][e] = x2 * cs[0] + x1 * cs[1]; }
                        { const int d = 2 * q + 1, n = d >> 2, e = d & 3; const float x1 = acc[ai][0][m][n][e], x2 = acc[ai][1][m][n][e]; acc[ai][0][m][n][e] = x1 * cs[2] - x2 * cs[3]; acc[ai][1][m][n][e] = x2 * cs[2] + x1 * cs[3]; } } }
        }
        if (pn == 2 || pn == 3) {
            float* kb = kbar + (size_t)((((u.pm >> 3) * NH + (pn - 2) * 4 + wc) * NBLK + (u.pm & 7)) * HD);
#pragma unroll
            for (int bj = 0; bj < 2; ++bj)
#pragma unroll
                for (int n = 0; n < 2; ++n)
#pragma unroll
                    for (int e = 0; e < 4; ++e) { float s = 0.f;
#pragma unroll
                        for (int ai = 0; ai < 2; ++ai)
#pragma unroll
                            for (int m = 0; m < 4; ++m) s += acc[ai][bj][m][n][e];
                        s = swz_xor_add(s, 1); s = swz_xor_add(s, 2); s = swz_xor_add(s, 4); s = swz_xor_add(s, 8);
                        if (fr == 0) atomicAdd(kb + (2 * fq + bj) * 8 + 4 * n + e, s * (1.f / MBLK)); }
        }
        if (pn < 2) {
#pragma unroll
            for (int ai = 0; ai < 2; ++ai)
#pragma unroll
                for (int bj = 0; bj < 2; ++bj)
#pragma unroll
                    for (int m = 0; m < 4; ++m) { acc[ai][bj][m][0] = acc[ai][bj][m][0] * QSCALE; acc[ai][bj][m][1] = acc[ai][bj][m][1] * QSCALE; } }
#pragma unroll
        for (int ai = 0; ai < 2; ++ai)
#pragma unroll
            for (int m = 0; m < 4; ++m) { bf16_t* rowp = O + (size_t)(row0 + ai * HALF + m * 16) * DIN + pn * BM + wc * 64;
#pragma unroll
                for (int bj = 0; bj < 2; ++bj) { const f32x4 v0 = acc[ai][bj][m][0], v1 = acc[ai][bj][m][1];
                    u32x4 w; w.x = pkbf(v0[0], v0[1]); w.y = pkbf(v0[2], v0[3]); w.z = pkbf(v1[0], v1[1]); w.w = pkbf(v1[2], v1[3]);
                    *(u32x4*)(rowp + (2 * fq + bj) * 8) = w; } }
    }
};
struct EpiF8 {
    static constexpr bool PERM = true, AFTER_DRAIN = false;
    unsigned char* O; int ldc;
    DEVFN void operator()(f32x4 (&acc)[2][2][4][2], const Unit& u, int wr, int wc, int fr, int fq) const {
#pragma unroll
        for (int ai = 0; ai < 2; ++ai)
#pragma unroll
            for (int m = 0; m < 4; ++m) { unsigned char* rowp = O + (size_t)(u.pm * BM + ai * HALF + wr * 64 + m * 16 + fr) * ldc + u.pn * BM + wc * 64 + fq * 16;
                const f32x4 a0 = acc[ai][0][m][0], a1 = acc[ai][0][m][1], b0 = acc[ai][1][m][0], b1 = acc[ai][1][m][1];
                u32x4 w; w.x = pk4_fp8(a0[0], a0[1], a0[2], a0[3]); w.y = pk4_fp8(a1[0], a1[1], a1[2], a1[3]); w.z = pk4_fp8(b0[0], b0[1], b0[2], b0[3]); w.w = pk4_fp8(b1[0], b1[1], b1[2], b1[3]);
                *(u32x4*)rowp = w; }
    }
};
struct MoeUnit { int pm, pn, cls, j, cnt; };
struct MoeBase {
    const PG8_LAS int* tp; const PG8_LAS int* cnt; const PG8_LAS int* tcls; int nunits, G, c, npn_shift;
    DEVFN bool next_(int i, MoeUnit& u) const {
        const int L = i * G + c; if (L >= nunits) return false;
        u.pm = L >> npn_shift; u.pn = L & ((1 << npn_shift) - 1);
        const int cls = __builtin_amdgcn_readfirstlane(tcls[u.pm]);
        u.cls = cls; u.j = u.pm - __builtin_amdgcn_readfirstlane(tp[cls]); u.cnt = __builtin_amdgcn_readfirstlane(cnt[cls]); return true; }
};
DEVFN void moe_experts(int cls, int& e1, int& e2) { const int g = cls / 6, p = cls % 6; const int lo = p < 3 ? 0 : (p < 5 ? 1 : 2), hi = p < 3 ? p + 1 : (p < 5 ? p - 1 : 3); e1 = g * 4 + lo; e2 = g * 4 + hi; }
struct GateUpSched : MoeBase {
    typedef MoeUnit UnitT;
    const char* HB; const int* list; const char* W;
    DEVFN bool next(int i, MoeUnit& u) const { return next_(i, u); }
    DEVFN const char* aptr(const MoeUnit&) const { return HB; }
    DEVFN void arows(const MoeUnit& u, const int tid_, unsigned (&v)[2][2]) const {
        int R[2], C[2]; { int t_ = tid_; asm volatile("" : "+v"(t_)); stage_rc(t_ * 16, R[0], C[0]); stage_rc(t_ * 16 + 8192, R[1], C[1]); }
#pragma unroll
        for (int h = 0; h < 2; ++h)
#pragma unroll
            for (int i = 0; i < 2; ++i) { const int li = 256 * u.j + h * HALF + R[i]; const int tok = list[(size_t)u.cls * LISTCAP + (li < u.cnt ? li : 256 * u.j)]; v[h][i] = (unsigned)(tok * DM + C[i] * 2); } }
    DEVFN const char* bptr(const MoeUnit& u) const { int e1, e2; moe_experts(u.cls, e1, e2); return W + (size_t)(u.pn < 4 ? e1 : e2) * DM * DM + (size_t)(u.pn & 3) * BM * DM; }
    DEVFN const char* bptr2(const MoeUnit& u) const { return bptr(u); }
};
struct DownSched : MoeBase {
    typedef MoeUnit UnitT;
    const char* ACT; const char* W;
    DEVFN bool next(int i, MoeUnit& u) const { return next_(i, u); }
    DEVFN const char* aptr(const MoeUnit&) const { return ACT; }
    DEVFN void arows(const MoeUnit& u, const int tid_, unsigned (&v)[2][2]) const {
        int R[2], C[2]; { int t_ = tid_; asm volatile("" : "+v"(t_)); stage_rc(t_ * 16, R[0], C[0]); stage_rc(t_ * 16 + 8192, R[1], C[1]); }
#pragma unroll
        for (int h = 0; h < 2; ++h)
#pragma unroll
            for (int i = 0; i < 2; ++i) v[h][i] = (unsigned)((u.pm * BM + h * HALF + R[i]) * DM + C[i] * 2); }
    DEVFN const char* bptr(const MoeUnit& u) const { int e1, e2; moe_experts(u.cls, e1, e2); return W + (size_t)e1 * DM * DE + (size_t)u.pn * BM * DE; }
    DEVFN const char* bptr2(const MoeUnit& u) const { int e1, e2; moe_experts(u.cls, e1, e2); return W + (size_t)e2 * DM * DE + (size_t)u.pn * BM * DE; }
};
struct EpiGateUp {
    static constexpr bool PERM = true, AFTER_DRAIN = false;
    unsigned char* ACT; const float* rw;
    DEVFN void operator()(f32x4 (&acc)[2][2][4][2], const MoeUnit& u, int wr, int wc, int fr, int fq) const {
        const int half = u.pn >> 2, jt = u.pn & 3;
        float wg8[2][4];
#pragma unroll
        for (int ai = 0; ai < 2; ++ai)
#pragma unroll
            for (int m = 0; m < 4; ++m) { const int li = 256 * u.j + ai * HALF + wr * 64 + m * 16 + fr; wg8[ai][m] = rw[((size_t)u.cls * LISTCAP + (li < u.cnt ? li : 256 * u.j)) * 2 + half]; }
#pragma unroll
        for (int ai = 0; ai < 2; ++ai)
#pragma unroll
            for (int mp = 0; mp < 4; mp += 2) {
                u32x2 w2[2];
#pragma unroll
                for (int q = 0; q < 2; ++q) { const int m = mp + q; const int li = 256 * u.j + ai * HALF + wr * 64 + m * 16 + fr;
                    const float wgt = li < u.cnt ? 8.f * wg8[ai][m] : 0.f;
                    f32x4 o[2];
#pragma unroll
                    for (int n = 0; n < 2; ++n) {
                        const f32x4 g = acc[ai][0][m][n], t = g * (-1.4426950408889634f);
                        f32x4 d; d.x = __builtin_amdgcn_exp2f(t.x); d.y = __builtin_amdgcn_exp2f(t.y); d.z = __builtin_amdgcn_exp2f(t.z); d.w = __builtin_amdgcn_exp2f(t.w);
                        d = d + 1.f;
                        f32x4 r; r.x = __builtin_amdgcn_rcpf(d.x); r.y = __builtin_amdgcn_rcpf(d.y); r.z = __builtin_amdgcn_rcpf(d.z); r.w = __builtin_amdgcn_rcpf(d.w);
                        o[n] = (g * r) * (acc[ai][1][m][n] * wgt); }
                    w2[q].x = pk4_fp8(o[0][0], o[0][1], o[0][2], o[0][3]); w2[q].y = pk4_fp8(o[1][0], o[1][1], o[1][2], o[1][3]); }
                const auto s0 = __builtin_amdgcn_permlane16_swap(w2[0].x, w2[1].x, false, false), s1 = __builtin_amdgcn_permlane16_swap(w2[0].y, w2[1].y, false, false);
                const u32x4 w = {s0[0], s1[0], s0[1], s1[1]};
                const int lr = ai * HALF + wr * 64 + (mp + (fq & 1)) * 16 + fr;
                *(u32x4*)(ACT + (size_t)(u.pm * BM + lr) * DM + half * 512 + jt * 128 + wc * 32 + (fq & 2) * 8) = w; }
    }
};
struct EpiDown {
    static constexpr bool PERM = true, AFTER_DRAIN = false;
    unsigned char* Y2; const int* list;
    DEVFN void operator()(f32x4 (&acc)[2][2][4][2], const MoeUnit& u, int wr, int wc, int fr, int fq_) const {
        int fq = fq_; asm volatile("" : "+v"(fq));
        int tk8[2][4];
#pragma unroll
        for (int ai = 0; ai < 2; ++ai)
#pragma unroll
            for (int m = 0; m < 4; ++m) { const int li = 256 * u.j + ai * HALF + wr * 64 + m * 16 + fr; tk8[ai][m] = list[(size_t)u.cls * LISTCAP + (li < u.cnt ? li : 256 * u.j)]; }
#pragma unroll
        for (int ai = 0; ai < 2; ++ai)
#pragma unroll
            for (int m = 0; m < 4; ++m) { const int li = 256 * u.j + ai * HALF + wr * 64 + m * 16 + fr;
                if (li < u.cnt) { const int tok = tk8[ai][m]; unsigned char* rowp = Y2 + (size_t)tok * DM + u.pn * BM + wc * 64 + fq * 16;
                    const f32x4 a0 = acc[ai][0][m][0], a1 = acc[ai][0][m][1], b0 = acc[ai][1][m][0], b1 = acc[ai][1][m][1];
                    u32x4 w; w.x = pk4_fp8(a0[0], a0[1], a0[2], a0[3]); w.y = pk4_fp8(a1[0], a1[1], a1[2], a1[3]); w.z = pk4_fp8(b0[0], b0[1], b0[2], b0[3]); w.w = pk4_fp8(b1[0], b1[1], b1[2], b1[3]);
                    *(u32x4*)rowp = w; } }
    }
};
}

#include <hip/hip_bf16.h>
#include <cmath>
namespace attn_body {
using bf16=__hip_bfloat16;
using bf16x8=__attribute__((ext_vector_type(8)))short;
using s16x4=__attribute__((ext_vector_type(4)))short;
using f32x16=__attribute__((ext_vector_type(16)))float;
using u32x4=__attribute__((ext_vector_type(4)))unsigned;
constexpr int BATCH=16,NHEAD=8,SEQ=2048,D=64,QP=2048,OP=1024;
constexpr int NW=8,QBLK=32,QB=QBLK*NW,KVBLK=64,NQB=SEQ/QB;
constexpr int ATTN_PITCH=QP, ATTN_UNIT_ROWS=QB;
__device__ __forceinline__ int crow(int r,int hi){return (r&3)+8*(r>>2)+4*hi;}
#define SBAR() __builtin_amdgcn_sched_barrier(0)
__device__ __forceinline__ void cmask(f32x16&p0,f32x16&p1,int jb,int qrel,int hi){
  const float NEG=-INFINITY; int kb=64*jb+4*hi;
  #pragma unroll
  for(int r=0;r<16;++r){int kv=kb+(r&3)+8*(r>>2); if(kv>qrel)p0[r]=NEG; if(kv+32>qrel)p1[r]=NEG;}
}

constexpr int NSLOT=3, SLOTB=8192;
constexpr int LDS_K=0, LDS_V=NSLOT*SLOTB, LDS_WS=2*NSLOT*SLOTB, LDS_OST=LDS_WS+NW*64*4, LDS_KBAR=LDS_OST+NW*4096, LDS_BYTES=LDS_KBAR+2048;
constexpr float NEGBIG=-1.0e30f; typedef float f32x4_t __attribute__((ext_vector_type(4)));
__device__ __forceinline__ float bfs(short v){return __uint_as_float(((unsigned)(unsigned short)v)<<16);}
constexpr float C2=0.125f*1.4426950408889634f;
__device__ __forceinline__ void glds16(const void*gsrc,unsigned lds_dst){unsigned keep;
  asm volatile("s_mov_b32 %0, m0\n\ts_mov_b32 m0, %2\n\ts_nop 0\n\tglobal_load_lds_dwordx4 %1, off\n\ts_mov_b32 m0, %0":"=&s"(keep):"v"(gsrc),"s"(lds_dst):"memory");}
__device__ __forceinline__ float max3f(float a,float b,float c){float r;asm("v_max3_f32 %0, %1, %2, %3":"=v"(r):"v"(a),"v"(b),"v"(c));return r;}
__device__ __forceinline__ float max2f(float a,float b){float r;asm("v_max_f32_e32 %0, %1, %2":"=v"(r):"v"(a),"v"(b));return r;}
__device__ __forceinline__ float fadd_s(float a,float b){float r;asm("v_add_f32_e32 %0, %1, %2":"=v"(r):"v"(a),"v"(b));return r;}
__device__ __forceinline__ float fsub_s(float a,float b){float r;asm("v_sub_f32_e32 %0, %1, %2":"=v"(r):"v"(a),"v"(b));return r;}
typedef float f32x2_t __attribute__((ext_vector_type(2))); typedef __bf16 bf16x2_t __attribute__((ext_vector_type(2)));
__device__ __forceinline__ unsigned cvtpk_s(float lo,float hi){f32x2_t v={lo,hi};bf16x2_t b=__builtin_convertvector(v,bf16x2_t);return __builtin_bit_cast(unsigned,b);}
#define WAIT_BAR(N) asm volatile("s_waitcnt vmcnt(" #N ") lgkmcnt(0)\n\ts_barrier":::"memory")

__device__ __forceinline__ void qkt(f32x16&p0,f32x16&p1,const char*Kslot,const bf16x8*qr,const f32x16&negm,int r32,int hi){
  const char*kb=Kslot+hi*1024+r32*16;
  #pragma unroll
  for(int d0=0;d0<4;++d0){
    const bf16x8 b0=*reinterpret_cast<const bf16x8*>(kb+d0*2048);
    const bf16x8 b1=*reinterpret_cast<const bf16x8*>(kb+d0*2048+512);
    if(d0==0){p0=__builtin_amdgcn_mfma_f32_32x32x16_bf16(b0,qr[0],negm,0,0,0);p1=__builtin_amdgcn_mfma_f32_32x32x16_bf16(b1,qr[0],negm,0,0,0);}
    else{p0=__builtin_amdgcn_mfma_f32_32x32x16_bf16(b0,qr[d0],p0,0,0,0);p1=__builtin_amdgcn_mfma_f32_32x32x16_bf16(b1,qr[d0],p1,0,0,0);}}
}
typedef __attribute__((address_space(3))) const char* lds_cptr;
typedef short v4i16_t __attribute__((ext_vector_type(4)));
__device__ __forceinline__ void kload8(bf16x8*kf,lds_cptr kp){
  kf[0]=*(const __attribute__((address_space(3))) bf16x8*)(kp);      kf[1]=*(const __attribute__((address_space(3))) bf16x8*)(kp+512);
  kf[2]=*(const __attribute__((address_space(3))) bf16x8*)(kp+2048); kf[3]=*(const __attribute__((address_space(3))) bf16x8*)(kp+2560);
  kf[4]=*(const __attribute__((address_space(3))) bf16x8*)(kp+4096); kf[5]=*(const __attribute__((address_space(3))) bf16x8*)(kp+4608);
  kf[6]=*(const __attribute__((address_space(3))) bf16x8*)(kp+6144); kf[7]=*(const __attribute__((address_space(3))) bf16x8*)(kp+6656);
}
__device__ __forceinline__ void kload2(bf16x8*kf,lds_cptr kp,int j){ kf[2*j]=*(const __attribute__((address_space(3))) bf16x8*)(kp+j*2048); kf[2*j+1]=*(const __attribute__((address_space(3))) bf16x8*)(kp+j*2048+512); }
__device__ __forceinline__ s16x4 vtr(lds_cptr p){ return __builtin_bit_cast(s16x4,__builtin_amdgcn_ds_read_tr16_b64_v4i16((__attribute__((address_space(3))) v4i16_t*)p)); }
__device__ __forceinline__ float rowmax(const f32x16&p0,const f32x16&p1){
  float a=max3f(p0[0],p0[1],p1[0]),b=max3f(p0[2],p0[3],p1[1]);a=max3f(a,p1[2],p1[3]);
  #pragma unroll
  for(int r=4;r<16;r+=4){a=max3f(a,p0[r],p0[r+1]);b=max3f(b,p0[r+2],p0[r+3]);a=max3f(a,p1[r],p1[r+1]);b=max3f(b,p1[r+2],p1[r+3]);}
  const float m=max2f(a,b);
  auto rr=__builtin_amdgcn_permlane32_swap(__float_as_uint(m),__float_as_uint(m),false,false);
  return max2f(__uint_as_float(rr[0]),__uint_as_float(rr[1]));
}
__device__ __forceinline__ void pv(f32x16*o,int vb,bf16x8 pa0,bf16x8 pa1,bf16x8 pa2,bf16x8 pa3){
  #pragma unroll
  for(int d0=0;d0<2;++d0){s16x4 lo[4],hi[4];
    #pragma unroll
    for(int ks=0;ks<4;++ks){
      asm volatile("ds_read_b64_tr_b16 %0,%1 offset:%c2":"=&v"(lo[ks]):"v"(vb),"i"(d0*4096+ks*1024):"memory");
      asm volatile("ds_read_b64_tr_b16 %0,%1 offset:%c2":"=&v"(hi[ks]):"v"(vb),"i"(d0*4096+ks*1024+512):"memory");}
    asm volatile("s_waitcnt lgkmcnt(0)":::"memory");SBAR();
    #define PK(k) (bf16x8){lo[k][0],lo[k][1],lo[k][2],lo[k][3],hi[k][0],hi[k][1],hi[k][2],hi[k][3]}
    o[d0]=__builtin_amdgcn_mfma_f32_32x32x16_bf16(pa0,PK(0),o[d0],0,0,0);
    o[d0]=__builtin_amdgcn_mfma_f32_32x32x16_bf16(pa1,PK(1),o[d0],0,0,0);
    o[d0]=__builtin_amdgcn_mfma_f32_32x32x16_bf16(pa2,PK(2),o[d0],0,0,0);
    o[d0]=__builtin_amdgcn_mfma_f32_32x32x16_bf16(pa3,PK(3),o[d0],0,0,0);
    #undef PK
  }
}

#ifndef ATTN_STORE16
#define ATTN_STORE16(p,v) (*(u32x4*)(p)=(v))
#endif
template<int THRL> __device__ __forceinline__ void attn_unit(int b,int h,int qb,const bf16*Q,const bf16*__restrict__ K,const bf16*__restrict__ V,bf16*O,const float*__restrict__ kbar,char*shm,const int tid){
  const int lane=tid&63,r32=lane&31,hi=lane>>5; const int wid=__builtin_amdgcn_readfirstlane(tid>>6);
  float kbv=0.f; { int tk=tid; asm volatile("":"+v"(tk)); if(qb>=4&&tk<448)kbv=kbar[tk]; }
  const long rowbase=(long)b*SEQ; const int q0=qb*QB;
  const bf16*Qw=Q+(rowbase+q0+wid*QBLK)*QP+h*D;
  const bf16*Kh=K+rowbase*QP+h*D,*Vh=V+rowbase*QP+h*D;
  const unsigned lds0=(unsigned)(uintptr_t)shm;
  float*wsf=(float*)(shm+LDS_WS)+wid*64;
  const bf16*ksrc=Kh+(long)lane*QP+wid*8;
  const bf16*vsrc=Vh+(long)(16*(wid&3)+(lane>>2))*QP+(wid>>2)*32+(lane&3)*8;
  const unsigned kdst=lds0+LDS_K+wid*1024, vdst=lds0+LDS_V+wid*1024;
  #define DMA_K(t,slot) glds16(ksrc+(long)(t)*KVBLK*QP,(unsigned)__builtin_amdgcn_readfirstlane(kdst+(slot)))
  #define DMA_V(t,slot) glds16(vsrc+(long)(t)*KVBLK*QP,(unsigned)__builtin_amdgcn_readfirstlane(vdst+(slot)))
  const int vb0=(int)(lds0+LDS_V)+((lane>>4)&1)*32+(lane&3)*8+(4*hi+((lane&15)>>2))*64;
  const char*Kbase=shm+LDS_K; bf16x8 kf[8];
  const lds_cptr shm3=(lds_cptr)shm; const lds_cptr kp0=shm3+LDS_K+hi*1024+r32*16; const lds_cptr vp0=shm3+LDS_V+((lane>>4)&1)*32+(lane&3)*8+(4*hi+((lane&15)>>2))*64;
  const int NT=(q0+QB)/KVBLK;
  DMA_K(0,0);DMA_V(0,0);DMA_K(1,SLOTB);
  bf16x8 qr[4];
  #pragma unroll
  for(int d0=0;d0<4;++d0)qr[d0]=*reinterpret_cast<const bf16x8*>(&Qw[(long)r32*QP+d0*16+hi*8]);
  float mhat=0.f,l_reg=0.f;f32x16 o[2];o[0]=f32x16{};o[1]=f32x16{};f32x16 negm=f32x16{};asm volatile("":"+v"(negm));
  const int qrel=wid*QBLK+r32;
  #define CMASK(P0,P1,t) do{int jb_=(t)-(NT-4); if(jb_>=0)cmask(P0,P1,jb_,qrel,hi);}while(0)
  bool resc=false;
  #define START(P0,P1) do{ const float rm=rowmax(P0,P1); resc=false; \
    { const float dl=selcur?rm:-64.f; mhat=fadd_s(mhat,dl); \
      _Pragma("unroll") for(int r=0;r<16;++r){P0[r]=fsub_s(P0[r],dl);P1[r]=fsub_s(P1[r],dl);} \
      { const float nv_=selcur?-mhat:NEGBIG; _Pragma("unroll") for(int r=0;r<16;++r)negm[r]=nv_; } asm volatile("":"+v"(negm)); } \
    _Pragma("unroll") for(int r=0;r<16;++r)P0[r]=__builtin_amdgcn_exp2f(P0[r]); }while(0)
  #define RESC() do{ if(resc){ asm volatile("s_waitcnt lgkmcnt(0)":::"memory"); \
      _Pragma("unroll") for(int d_=0;d_<2;++d_) _Pragma("unroll") for(int r=0;r<16;++r)o[d_][r]*=wsf[crow(r,hi)]; } }while(0)
  f32x16 pA0,pA1,pB0,pB1;
  int sl_prev=0,sl_cur=0,sl_next=SLOTB;
  #define ROT() do{sl_prev=sl_cur;sl_cur=sl_next;sl_next=(sl_next==(NSLOT-1)*SLOTB)?0:sl_next+SLOTB;}while(0)
  DMA_K(2,2*SLOTB);
  if(qb>=4){ if(tid<448){ const unsigned hb=__builtin_bit_cast(unsigned,kbv); const unsigned hr=(hb+0x7fffu+((hb>>16)&1u))&0xffff0000u; const float lo_=kbv-__builtin_bit_cast(float,hr); const unsigned lb=__builtin_bit_cast(unsigned,lo_);
      ((unsigned short*)(shm+LDS_KBAR))[tid]=(unsigned short)(hr>>16); ((unsigned short*)(shm+LDS_KBAR+1024))[tid]=(unsigned short)((lb+0x7fffu+((lb>>16)&1u))>>16); } }
  WAIT_BAR(3);
  unsigned bmask=(1u<<(qb+1))-1u;
  if(qb>=4){ float gsc[8];
    { const lds_cptr kb3=shm3+LDS_KBAR+(r32&7)*128+hi*16; f32x16 g=f32x16{};
      _Pragma("unroll") for(int d0=0;d0<4;++d0){ const bf16x8 ah=*(const __attribute__((address_space(3))) bf16x8*)(kb3+d0*32), al=*(const __attribute__((address_space(3))) bf16x8*)(kb3+1024+d0*32);
        g=__builtin_amdgcn_mfma_f32_32x32x16_bf16(ah,qr[d0],g,0,0,0); g=__builtin_amdgcn_mfma_f32_32x32x16_bf16(al,qr[d0],g,0,0,0); }
      _Pragma("unroll") for(int r=0;r<4;++r){ auto rr=__builtin_amdgcn_permlane32_swap(__float_as_uint(g[r]),__float_as_uint(g[r]),false,false); gsc[r]=__uint_as_float(rr[0]); gsc[4+r]=__uint_as_float(rr[1]); } }
    _Pragma("unroll") for(int n=0;n<7;++n) gsc[n]=(n<qb)?gsc[n]:-3.0e38f;
    bmask=1u<<qb;
    _Pragma("unroll") for(int pick=0;pick<3;++pick){ float best=-3.4e38f; unsigned bi=0u;
      _Pragma("unroll") for(int n=0;n<7;++n){ const bool ok=!((bmask>>n)&1u)&&gsc[n]>best; best=ok?gsc[n]:best; bi=ok?(unsigned)n:bi; }
      bmask|=1u<<bi; } }
  bool selcur=(bmask&1u)!=0u;
  { const float nv=selcur?0.f:NEGBIG; _Pragma("unroll") for(int r=0;r<16;++r)negm[r]=nv; asm volatile("":"+v"(negm)); }
  qkt(pA0,pA1,Kbase,qr,negm,r32,hi);asm volatile("s_nop 15\n\ts_nop 7":"+v"(pA0),"+v"(pA1));CMASK(pA0,pA1,0);
  START(pA0,pA1);
  _Pragma("unroll") for(int r=0;r<16;++r)pA1[r]=__builtin_amdgcn_exp2f(pA1[r]);
  WAIT_BAR(0);
  DMA_K(3,0);DMA_V(1,SLOTB);
  ROT();
  kload8(kf,kp0+sl_cur);
  WAIT_BAR(2);
  s16x4 vlo[8],vhi[8]; u32x4 pw0,pw1,pw2,pw3;
  #define PKW(P,B) cvtpk_s(P[B],P[B+1])
  #define PAF(k) __builtin_bit_cast(bf16x8,pw##k)
  #define VFR(i) (bf16x8){vlo[i][0],vlo[i][1],vlo[i][2],vlo[i][3],vhi[i][0],vhi[i][1],vhi[i][2],vhi[i][3]}
  #define PIN(x) asm volatile("":"+v"(x))
  #define MX3(a,b,c) __builtin_fmaxf(__builtin_fmaxf((a),(b)),(c))
  #define GAPA(MF,A0,A1,A2,A3,W0,W1,PW) do{ MF; sacc+=A0; sacc+=A1; sacc+=A2; sacc+=A3; PIN(sacc); W0; W1; PIN(PW); SBAR(); }while(0)
  #define EX(v) __builtin_amdgcn_exp2f(v)
  #define GAPB(MF,X,B) do{ MF; X[B]=EX(X[B]); X[B+1]=EX(X[B+1]); X[B+2]=EX(X[B+2]); X[B+3]=EX(X[B+3]); PIN(X); SBAR(); }while(0)
  #define VRD(i) do{ vlo[i]=vtr(vp_+(((i)>>2)*4096+((i)&3)*1024)); vhi[i]=vtr(vp_+(((i)>>2)*4096+((i)&3)*1024+512)); }while(0)
  #define KRD(G,j) do{ if(G){ kload2(kf,kp0+sl_next,j); SBAR(); } }while(0)
  #define STEP(C0,C1,P0,P1,t,GK,GV,GL) do{ SBAR(); \
    const lds_cptr vp_=vp0+sl_prev; \
    VRD(0); SBAR(); float sacc=(P0[0]+P0[1]); \
    GAPA(C0=__builtin_amdgcn_mfma_f32_32x32x16_bf16(kf[0],qr[0],negm,0,0,0), P0[2],P0[3],P0[4],P0[5],     pw0[0]=PKW(P0,0), pw0[1]=PKW(P0,2), pw0); \
    VRD(4); SBAR(); GAPA(C1=__builtin_amdgcn_mfma_f32_32x32x16_bf16(kf[1],qr[0],negm,0,0,0), P0[6],P0[7],P0[8],P0[9],     pw0[2]=PKW(P0,4), pw0[3]=PKW(P0,6), pw0); \
    VRD(1); SBAR(); GAPA(C0=__builtin_amdgcn_mfma_f32_32x32x16_bf16(kf[2],qr[1],C0,0,0,0),   P0[10],P0[11],P0[12],P0[13], pw1[0]=PKW(P0,8), pw1[1]=PKW(P0,10), pw1); \
    VRD(5); SBAR(); GAPA(C1=__builtin_amdgcn_mfma_f32_32x32x16_bf16(kf[3],qr[1],C1,0,0,0),   P0[14],P0[15],P1[0],P1[1],   pw1[2]=PKW(P0,12),pw1[3]=PKW(P0,14), pw1); \
    VRD(2); SBAR(); GAPA(C0=__builtin_amdgcn_mfma_f32_32x32x16_bf16(kf[4],qr[2],C0,0,0,0),   P1[2],P1[3],P1[4],P1[5],     pw2[0]=PKW(P1,0), pw2[1]=PKW(P1,2), pw2); \
    VRD(6); SBAR(); GAPA(C1=__builtin_amdgcn_mfma_f32_32x32x16_bf16(kf[5],qr[2],C1,0,0,0),   P1[6],P1[7],P1[8],P1[9],     pw2[2]=PKW(P1,4), pw2[3]=PKW(P1,6), pw2); \
    VRD(3); SBAR(); GAPA(C0=__builtin_amdgcn_mfma_f32_32x32x16_bf16(kf[6],qr[3],C0,0,0,0),   P1[10],P1[11],P1[12],P1[13], pw3[0]=PKW(P1,8), pw3[1]=PKW(P1,10), pw3); \
    VRD(7); SBAR(); GAPA(C1=__builtin_amdgcn_mfma_f32_32x32x16_bf16(kf[7],qr[3],C1,0,0,0),   P1[14],P1[15],0.f,0.f,       pw3[2]=PKW(P1,12),pw3[3]=PKW(P1,14), pw3); \
    l_reg+=sacc; \
    if(GK){DMA_K((t)+3,sl_cur);} if(GV){DMA_V((t)+1,sl_next);} \
    CMASK(C0,C1,t); \
    { float a=MX3(C0[0],C0[1],C1[0]),b=MX3(C0[2],C0[3],C1[1]); a=MX3(a,C1[2],C1[3]); \
      _Pragma("unroll") for(int r=4;r<16;r+=4){a=MX3(a,C0[r],C0[r+1]);b=MX3(b,C0[r+2],C0[r+3]);a=MX3(a,C1[r],C1[r+1]);b=MX3(b,C1[r+2],C1[r+3]);} \
      float rm=__builtin_fmaxf(a,b); { auto rr=__builtin_amdgcn_permlane32_swap(__float_as_uint(rm),__float_as_uint(rm),false,false); rm=__builtin_fmaxf(__uint_as_float(rr[0]),__uint_as_float(rr[1])); } \
      resc=false; \
      if(__builtin_expect(__any(rm>(float)THRL),0)){ const float dl=__builtin_fmaxf(rm,0.f); mhat+=dl; \
        _Pragma("unroll") for(int r=0;r<16;++r){C0[r]-=dl;C1[r]-=dl;} \
        { const float nv_=selcur?-mhat:NEGBIG; _Pragma("unroll") for(int r=0;r<16;++r)negm[r]=nv_; } asm volatile("":"+v"(negm)); \
        const float f=__builtin_amdgcn_exp2f(-dl); l_reg*=f; if(hi==0)wsf[r32]=f; resc=true; } } \
    SBAR(); \
    GAPB(o[0]=__builtin_amdgcn_mfma_f32_32x32x16_bf16(PAF(0),VFR(0),o[0],0,0,0), C0,0); \
    GAPB(o[1]=__builtin_amdgcn_mfma_f32_32x32x16_bf16(PAF(0),VFR(4),o[1],0,0,0), C0,4); \
    KRD(GL,0); GAPB(o[0]=__builtin_amdgcn_mfma_f32_32x32x16_bf16(PAF(1),VFR(1),o[0],0,0,0), C0,8); \
    KRD(GL,1); GAPB(o[1]=__builtin_amdgcn_mfma_f32_32x32x16_bf16(PAF(1),VFR(5),o[1],0,0,0), C0,12); \
    KRD(GL,2); GAPB(o[0]=__builtin_amdgcn_mfma_f32_32x32x16_bf16(PAF(2),VFR(2),o[0],0,0,0), C1,0); \
    KRD(GL,3); GAPB(o[1]=__builtin_amdgcn_mfma_f32_32x32x16_bf16(PAF(2),VFR(6),o[1],0,0,0), C1,4); \
    GAPB(o[0]=__builtin_amdgcn_mfma_f32_32x32x16_bf16(PAF(3),VFR(3),o[0],0,0,0), C1,8); \
    GAPB(o[1]=__builtin_amdgcn_mfma_f32_32x32x16_bf16(PAF(3),VFR(7),o[1],0,0,0), C1,12); \
    }while(0)
  #define BLKSEL(tt) do{ if((((tt))&3)==0){ selcur=((bmask>>((tt)>>2))&1u)!=0u; const float nv_=selcur?-mhat:NEGBIG; _Pragma("unroll") for(int r=0;r<16;++r)negm[r]=nv_; asm volatile("":"+v"(negm)); } }while(0)
  int t=1;
  #undef CMASK
  #define CMASK(P0,P1,t) do{}while(0)
  for(;t+5<NT;t+=2){
    STEP(pB0,pB1,pA0,pA1,t,true,true,true);     WAIT_BAR(2); RESC(); ROT(); BLKSEL(t+1);
    STEP(pA0,pA1,pB0,pB1,t+1,true,true,true);   WAIT_BAR(2); RESC(); ROT();
  }
  #undef CMASK
  #define CMASK(P0,P1,t) do{int jb_=(t)-(NT-4); if(jb_>=0)cmask(P0,P1,jb_,qrel,hi);}while(0)
  #define ENDW(tt) do{ if((tt)+3<NT){WAIT_BAR(2);} else if((tt)+2<NT){WAIT_BAR(1);} else {WAIT_BAR(0);} }while(0)
  for(;t+1<NT;t+=2){
    STEP(pB0,pB1,pA0,pA1,t,(t+3<NT),(t+1<NT),(t+1<NT));       ENDW(t);   RESC(); ROT(); BLKSEL(t+1);
    STEP(pA0,pA1,pB0,pB1,t+1,(t+4<NT),(t+2<NT),(t+2<NT));     ENDW(t+1); RESC(); ROT();
  }
  STEP(pB0,pB1,pA0,pA1,NT-1,false,false,false); RESC();
  { float sacc=pB0[0]+pB0[1]; _Pragma("unroll") for(int r=2;r<16;++r)sacc+=pB0[r]; _Pragma("unroll") for(int r=0;r<16;++r)sacc+=pB1[r]; l_reg+=sacc;
    pw0=(u32x4){PKW(pB0,0),PKW(pB0,2),PKW(pB0,4),PKW(pB0,6)};pw1=(u32x4){PKW(pB0,8),PKW(pB0,10),PKW(pB0,12),PKW(pB0,14)};pw2=(u32x4){PKW(pB1,0),PKW(pB1,2),PKW(pB1,4),PKW(pB1,6)};pw3=(u32x4){PKW(pB1,8),PKW(pB1,10),PKW(pB1,12),PKW(pB1,14)};
    SBAR(); pv(o,vb0+sl_cur,PAF(0),PAF(1),PAF(2),PAF(3)); }
  #undef PKW
  #undef PAF
  #undef VFR
  #undef PIN
  #undef MX3
  #undef GAPA
  #undef GAPB
  #undef EX
  #undef VRD
  #undef KRD
  #undef STEP
  #undef ENDW
  {auto rr=__builtin_amdgcn_permlane32_swap(__float_as_uint(l_reg),__float_as_uint(l_reg),false,false);l_reg=__uint_as_float(rr[0])+__uint_as_float(rr[1]);}
  if(hi==0)wsf[32+r32]=l_reg;asm volatile("s_waitcnt lgkmcnt(0)":::"memory");
  float rli[16];
  #pragma unroll
  for(int r=0;r<16;++r)rli[r]=__builtin_amdgcn_rcpf(wsf[32+crow(r,hi)]);
  unsigned char*Ow=(unsigned char*)O+(rowbase+q0+wid*QBLK)*OP+h*D;
  { unsigned char*stg=(unsigned char*)(shm+LDS_OST)+wid*4096;
    #pragma unroll
    for(int r=0;r<16;++r){const int orow=crow(r,hi);
      #pragma unroll
      for(int d0=0;d0<2;++d0){const float ov=__builtin_amdgcn_fmed3f(o[d0][r]*rli[r]*32.f,-448.f,448.f); stg[orow*64+d0*32+r32]=(unsigned char)__builtin_amdgcn_cvt_pk_fp8_f32(ov,ov,0,false);}}
    asm volatile("s_waitcnt lgkmcnt(0)":::"memory");
    #pragma unroll
    for(int i=0;i<2;++i){const int row=i*16+(lane>>2),ch=lane&3; const u32x4 v=*(const u32x4*)(stg+row*64+ch*16); ATTN_STORE16(Ow+(long)row*OP+ch*16,v);} }
  asm volatile("s_waitcnt lgkmcnt(0)\n\ts_barrier":::"memory");
  #undef BLKSEL
  #undef DMA_K
  #undef DMA_V
  #undef CMASK
  #undef START
  #undef RESC
  #undef ROT
}
constexpr int ATTN_LDS_BYTES=LDS_BYTES;
struct AttnTensors { const bf16* Q; const bf16* K; const bf16* V; bf16* O; const float* kbar; };
struct AttnUnit { int bh; int qb; };
struct StaticOrder {
  int vcu, G;
  __device__ __forceinline__ explicit StaticOrder(int grid,int block):vcu((grid%8==0)?(block%8)*(grid/8)+block/8:block),G(grid){}
  __device__ __forceinline__ bool next(int i,AttnUnit&u)const{ const int pr=(vcu+(i>>2)*G)*2+((i>>1)&1); if(pr>=BATCH*NHEAD*4)return false;
    const int s=pr&3; u.bh=pr>>2; u.qb=(i&1)?7-s:s; return true; }
  __device__ __forceinline__ void a_ready(const AttnUnit&)const{}
  __device__ __forceinline__ void done(const AttnUnit&)const{}
};
template<class Sched,int THRL=8> __device__ __forceinline__ void attn_phase(char*lds,const AttnTensors&T,const Sched&S,const int tid_in){
  AttnUnit u; int tid_=tid_in; asm volatile("":"+v"(tid_));
  for(int i=0;S.next(i,u);++i){ S.a_ready(u); attn_unit<THRL>(u.bh/NHEAD,u.bh%NHEAD,u.qb,T.Q,T.K,T.V,T.O,T.kbar+(long)u.bh*512,lds,tid_); S.done(u); }
}
#undef SBAR
#undef WAIT_BAR
}

#define XB_TMO      128
#define XB_XCNT(j)  (256  + 64 * (j))
#define XB_XSUB(j)  (1280 + 64 * (j))
#define XB_XGEN(j)  (2304 + 64 * (j))
#define XB_TOP      3328
#define XB_TOPGEN   3392
#define XCD_BAR_WORDS 3456
#define XB_SPIN_CAP (1u << 18)

__device__ __forceinline__ unsigned xb_ld(unsigned* p)              { return __hip_atomic_load(p, __ATOMIC_RELAXED, __HIP_MEMORY_SCOPE_AGENT); }
__device__ __forceinline__ unsigned xb_add(unsigned* p, unsigned v) { return __hip_atomic_fetch_add(p, v, __ATOMIC_RELAXED, __HIP_MEMORY_SCOPE_AGENT); }
__device__ __forceinline__ unsigned xb_xcc_id() { return (unsigned)__builtin_amdgcn_s_getreg((3 << 11) | 20) & 0xFu; }
#define XB_SPIN(cond, bar) do { unsigned _sp = 0; while (cond) { __builtin_amdgcn_s_sleep(1); \
    if ((++_sp & 255u) == 0u) { if (xb_ld(&(bar)[XB_TMO])) break; if (_sp > XB_SPIN_CAP) { atomicAdd(&(bar)[XB_TMO], 1u); break; } } } } while (0)

struct XcdBarrier {
    unsigned* bar; unsigned x;
    volatile LAS unsigned* st;
};

__device__ __forceinline__ XcdBarrier xcd_barrier_post(unsigned* bar, volatile LAS unsigned* st) {
    XcdBarrier b; b.bar = bar; b.x = xb_xcc_id(); b.st = st;
    if (threadIdx.x == 0) (void)xb_add(&bar[XB_XCNT(b.x)], 1u);
    return b;
}
__device__ __forceinline__ void xcd_barrier_complete(unsigned* bar, unsigned x, unsigned& nloc, unsigned& nx) {
    const unsigned G = gridDim.x * gridDim.y * gridDim.z;
    unsigned sum, cnt, mine, sp = 0u;
    for (;;) {
        sum = 0u; cnt = 0u; mine = 0u;
#pragma unroll
        for (unsigned j = 0; j < 16; ++j) { const unsigned c = xb_ld(&bar[XB_XCNT(j)]); sum += c; cnt += (c > 0u) ? 1u : 0u; mine = (j == x) ? c : mine; }
        if (sum == G) break;
        __builtin_amdgcn_s_sleep(1);
        if ((++sp & 255u) == 0u) { if (xb_ld(&bar[XB_TMO])) break; if (sp > XB_SPIN_CAP) { atomicAdd(&bar[XB_TMO], 1u); break; } }
    }
    nloc = mine > 0u ? mine : 1u; nx = cnt > 0u ? cnt : 1u;
}

__device__ __forceinline__ void xcd_barrier(const XcdBarrier& b, const bool is_t0) {
    asm volatile("s_waitcnt vmcnt(0)" ::: "memory");
    __syncthreads();
    if (is_t0) {
        unsigned* bar = b.bar;
        __builtin_amdgcn_s_waitcnt(0);
        unsigned nloc = b.st[0], nx = b.st[1];
        if (nloc == 0u) { xcd_barrier_complete(bar, b.x, nloc, nx); b.st[0] = nloc; b.st[1] = nx; }
        const unsigned old = xb_add(&bar[XB_XSUB(b.x)], 1u);
        const unsigned gen = old / nloc;
        if (old + 1u == (gen + 1u) * nloc) {
            __builtin_amdgcn_fence(__ATOMIC_RELEASE, "agent");
            asm volatile("s_waitcnt vmcnt(0)" ::: "memory");
            const unsigned og = xb_add(&bar[XB_TOP], 1u);
            const unsigned tg = og / nx;
            if (og + 1u == (tg + 1u) * nx) xb_add(&bar[XB_TOPGEN], 1u);
            else XB_SPIN(xb_ld(&bar[XB_TOPGEN]) == tg, bar);
            __builtin_amdgcn_fence(__ATOMIC_ACQUIRE, "agent");
            xb_add(&bar[XB_XGEN(b.x)], 1u);
            asm volatile("s_waitcnt vmcnt(0)" ::: "memory");
        } else {
            XB_SPIN(xb_ld(&bar[XB_XGEN(b.x)]) == gen, bar);
            __builtin_amdgcn_fence(__ATOMIC_ACQUIRE, "agent");
            asm volatile("s_waitcnt vmcnt(0)" ::: "memory");
        }
    }
    __syncthreads();
}

struct Args { const float* in[17]; float* out; unsigned char* ws; int ph_lo, ph_hi; };
enum { I_X = 0, I_C, I_WMOD, I_BMOD, I_WIN, I_WPOOL, I_PSCALE, I_WOUT, I_LN1G, I_LN1B, I_WR, I_RB, I_WG, I_WU, I_WDN, I_LN2G, I_LN2B };

DEVFN int lane_id_volatile() { int l; asm volatile("v_mbcnt_lo_u32_b32 %0, -1, 0\n\tv_mbcnt_hi_u32_b32 %0, -1, %0" : "=v"(l)); return l; }
struct Ctx { unsigned char* lds; __attribute__((address_space(3))) unsigned char* lds3; int tid, lane, wave, G, bid, gw, NGW; };

DEVFN void transpose_item_f8(const float* src, int ldn, int k0, int col, unsigned char* dst, int ldk, int dst_row0, int dst_k0, float* scr, int lane) {
#pragma unroll 8
    for (int i = 0; i < 32; ++i) { const int kk = 2 * i + (lane >> 5); scr[kk * 33 + (lane & 31)] = src[(size_t)(k0 + kk) * ldn + col]; }
    LDS_WAIT();
    const int c = lane & 7;
#pragma unroll
    for (int j = 0; j < 4; ++j) { const int n = (lane >> 3) + 8 * j; const float* s = scr + (8 * c) * 33 + n;
        u32x2 o; o.x = pk4_fp8(32.f * s[0 * 33], 32.f * s[1 * 33], 32.f * s[2 * 33], 32.f * s[3 * 33]); o.y = pk4_fp8(32.f * s[4 * 33], 32.f * s[5 * 33], 32.f * s[6 * 33], 32.f * s[7 * 33]);
        *(u32x2*)(dst + (size_t)(dst_row0 + n) * ldk + dst_k0 + 8 * c) = o; }
    LDS_WAIT();
}

DEVFN void ph_prologue(const Args& a, const Ctx& c) {
    unsigned char* ws = a.ws;
    float* scr = (float*)(c.lds + c.wave * 16384);
    const int lane = c.lane;
    constexpr int N1 = 2 * 16 * 64, N2 = 2 * 8 * 32, N3 = 32 * 16 * 32, N4 = 32 * 8 * 32, N5 = 2 * 64 * 16, N6 = 256;
    for (int it = c.gw; it < N1 + N2 + N3 + N4 + N5 + N6; it += c.NGW) {
        int r = it;
        if (r < N1) {
            const int l = r / 1024, kb = (r % 1024) / 64, nb = r % 64;
            const int nphys = 32 * nb + (lane & 31);
            transpose_item_f8(a.in[I_WIN] + (size_t)l * DM * DIN, DIN, 64 * kb, inproj_nlog(nphys), (unsigned char*)(ws + WS_WIN) + (size_t)l * DIN * DM, DM, 32 * nb, 64 * kb, scr, lane);
            continue; }
        r -= N1;
        if (r < N2) {
            const int l = r / 256, kb = (r % 256) / 32, nb = r % 32;
            transpose_item_f8(a.in[I_WOUT] + (size_t)l * DM * DM, DM, 64 * kb, inproj_nlog(32 * nb + (lane & 31)), (unsigned char*)(ws + WS_WOUT) + (size_t)l * DM * DM, DM, 32 * nb, 64 * kb, scr, lane);
            continue; }
        r -= N2;
        if (r < N3) {
            const int le = r / 512, kb = (r % 512) / 32, nb = r % 32;
            const int n = 32 * nb + (lane & 31), jt = n >> 8, bj = (n >> 7) & 1, i = n & 127;
            const float* src = (bj ? a.in[I_WU] : a.in[I_WG]) + (size_t)le * DM * DE;
            transpose_item_f8(src, DE, 64 * kb, jt * 128 + i, (unsigned char*)(ws + WS_WGU) + (size_t)le * DM * DM, DM, 32 * nb, 64 * kb, scr, lane);
            continue; }
        r -= N3;
        if (r < N4) {
            const int le = r / 256, kb = (r % 256) / 32, nb = r % 32;
            transpose_item_f8(a.in[I_WDN] + (size_t)le * DE * DM, DM, 64 * kb, inproj_nlog(32 * nb + (lane & 31)), (unsigned char*)(ws + WS_WD) + (size_t)le * DM * DE, DE, 32 * nb, 64 * kb, scr, lane);
            continue; }
        r -= N4;
        if (r < N5) {
            const int l = r / 1024, kdg = (r % 1024) / 16, nb = r % 16;
            const int n = nb * 64 + lane, kd0 = kdg * 8, g = kd0 >> 7, c0 = kd0 & 127;
            const float* wo = a.in[I_WOUT] + (size_t)l * DM * DM + (size_t)(512 + g * 128) * DM + inproj_nlog(n);
            const float* ps = a.in[I_PSCALE] + l * 512 + g * 128;
            const float* wp = a.in[I_WPOOL] + ((size_t)(l * 4 + g) * 128 + c0) * 128;
            float acc[8];
#pragma unroll
            for (int j = 0; j < 8; ++j) acc[j] = 0.f;
            for (int e = 0; e < 128; ++e) { const float w = wo[(size_t)e * DM] * ps[e];
#pragma unroll
                for (int j = 0; j < 8; ++j) acc[j] += wp[j * 128 + e] * w; }
            u32x2 o; o.x = pk4_fp8(128.f * acc[0], 128.f * acc[1], 128.f * acc[2], 128.f * acc[3]); o.y = pk4_fp8(128.f * acc[4], 128.f * acc[5], 128.f * acc[6], 128.f * acc[7]);
            *(u32x2*)((unsigned char*)(ws + WS_WOUT) + (size_t)l * DM * DM + (size_t)n * DM + 512 + kd0) = o;
            continue; }
        r -= N5;
        {
            const int ent = r * 64 + lane, pos = ent >> 3, i = ent & 7;
            const float inv = (float)exp2(-(double)i / 8.0 * 18.931568569324174);
            const float ang = (float)pos * inv;
            float* t = (float*)(ws + WS_ROPE) + ent * 2;
            t[0] = (float)cos((double)ang); t[1] = (float)sin((double)ang);
        }
    }
    for (int i = c.bid * 512 + c.tid; i < 2 * NB * NH * NBLK * HD; i += c.G * 512) ((float*)(ws + WS_KBAR))[i] = 0.f;
    __syncthreads();
    if (c.bid < 192) {
        float* condT = (float*)c.lds;
        float* red = (float*)(c.lds + 65536);
        for (int idx = c.tid; idx < NB * DM; idx += 512) { const int b = idx >> 10, k = idx & 1023; const float v = a.in[I_C][idx]; condT[k * 16 + b] = v / (1.f + __expf(-v)); }
        __syncthreads();
        for (int u = c.bid; u < 192; u += c.G) {
            const int l = u / 96, n0 = (u % 96) * 64;
            const float* W = a.in[I_WMOD] + (size_t)l * DM * NMOD + n0 + lane;
            float acc[16];
#pragma unroll
            for (int b = 0; b < 16; ++b) acc[b] = 0.f;
            for (int k = 128 * c.wave; k < 128 * c.wave + 128; k += 8) {
                float wv[8];
#pragma unroll
                for (int j = 0; j < 8; ++j) wv[j] = W[(size_t)(k + j) * NMOD];
#pragma unroll
                for (int j = 0; j < 8; ++j) {
                    const f32x4* cp = (const f32x4*)(condT + (k + j) * 16);
#pragma unroll
                    for (int q = 0; q < 4; ++q) { const f32x4 cv = cp[q]; acc[4 * q + 0] += cv.x * wv[j]; acc[4 * q + 1] += cv.y * wv[j]; acc[4 * q + 2] += cv.z * wv[j]; acc[4 * q + 3] += cv.w * wv[j]; }
                }
            }
#pragma unroll
            for (int b = 0; b < 16; ++b) red[(c.wave * 16 + b) * 64 + lane] = acc[b];
            __syncthreads();
            for (int o = c.tid; o < 1024; o += 512) { const int b = o >> 6, cc = o & 63; float s = a.in[I_BMOD][l * NMOD + n0 + cc];
#pragma unroll
                for (int w = 0; w < 8; ++w) s += red[(w * 16 + b) * 64 + cc];
                ((float*)(ws + WS_MOD))[(size_t)(l * NB + b) * NMOD + n0 + cc] = s; }
            __syncthreads();
        }
    }
}

DEVFN void row_stats(const f32x4 (&v)[4], float& mean, float& rstd) {
    float s = 0.f, q = 0.f;
#pragma unroll
    for (int j = 0; j < 4; ++j) { s += (v[j].x + v[j].y) + (v[j].z + v[j].w); q += (v[j].x * v[j].x + v[j].y * v[j].y) + (v[j].z * v[j].z + v[j].w * v[j].w); }
    s = swz_xor_add(s, 1); q = swz_xor_add(q, 1); s = swz_xor_add(s, 2); q = swz_xor_add(q, 2); s = swz_xor_add(s, 4); q = swz_xor_add(q, 4);
    s = swz_xor_add(s, 8); q = swz_xor_add(q, 8); s = swz_xor_add(s, 16); q = swz_xor_add(q, 16); s = half_swap_add(s); q = half_swap_add(q);
    mean = s * (1.f / DM);
    rstd = 1.f / sqrtf(fmaxf(q * (1.f / DM) - mean * mean, 0.f) + LN_EPS);
}
DEVFN void row_load(const float* p, int lane, f32x4 (&v)[4]) {
#pragma unroll
    for (int j = 0; j < 4; ++j) v[j] = *(const f32x4*)(p + 4 * lane + 256 * j);
}
DEVFN void row_mod_store(f32x4 (&v)[4], const float* sc, const float* sh, bf16_t* out, int lane) {
    float mean, rstd; row_stats(v, mean, rstd);
#pragma unroll
    for (int j = 0; j < 4; ++j) {
        const f32x4 s = *(const f32x4*)(sc + 4 * lane + 256 * j), h = *(const f32x4*)(sh + 4 * lane + 256 * j);
        v[j] = (v[j] - mean) * rstd * (s + 1.f) + h;
        u32x2 o; o.x = pk2(v[j].x, v[j].y); o.y = pk2(v[j].z, v[j].w);
        *(u32x2*)(out + 4 * lane + 256 * j) = o;
    }
}

DEVFN void ph_pool(const Args& a, const Ctx& c) {
    const bf16_t* P = (const bf16_t*)(a.ws + WS_QKVP) + 1536; unsigned char* AD = (unsigned char*)(a.ws + WS_AD) + 512;
    for (int it = c.bid * 512 + c.tid; it < (NTOK / 8) * 64; it += c.G * 512) {
        const int cg = it & 63, m0 = (it >> 6) * 8, t0 = m0 & (SEQ - 1), g = cg >> 4, w = 2 << g;
        const bf16_t* pc = P + cg * 8;
        u32x4 rows[23];
#pragma unroll
        for (int k = 0; k < 23; ++k) { const int dt = k - 15; rows[k] = (u32x4){0u, 0u, 0u, 0u}; if (dt > -w && t0 + dt >= 0) rows[k] = *(const u32x4*)(pc + (size_t)(m0 + dt) * DIN); }
        float s[8];
#pragma unroll
        for (int j = 0; j < 8; ++j) s[j] = 0.f;
#pragma unroll
        for (int k = 0; k < 15; ++k) { const u32x4 v = rows[k]; s[0] += bf_lo(v.x); s[1] += bf_hi(v.x); s[2] += bf_lo(v.y); s[3] += bf_hi(v.y); s[4] += bf_lo(v.z); s[5] += bf_hi(v.z); s[6] += bf_lo(v.w); s[7] += bf_hi(v.w); }
#pragma unroll
        for (int r = 0; r < 8; ++r) {
            const int t = t0 + r; const u32x4 v = rows[15 + r];
            const float f[8] = {bf_lo(v.x), bf_hi(v.x), bf_lo(v.y), bf_hi(v.y), bf_lo(v.z), bf_hi(v.z), bf_lo(v.w), bf_hi(v.w)};
#pragma unroll
            for (int j = 0; j < 8; ++j) s[j] += f[j];
            const int cnt = (t + 1 < w) ? t + 1 : w; const float ic = 1.f / (float)cnt;
            u32x2 o; o.x = pk4_fp8(s[0] * ic - f[0], s[1] * ic - f[1], s[2] * ic - f[2], s[3] * ic - f[3]); o.y = pk4_fp8(s[4] * ic - f[4], s[5] * ic - f[5], s[6] * ic - f[6], s[7] * ic - f[7]);
            *(u32x2*)(AD + (size_t)(m0 + r) * DM + cg * 8) = o;
            u32x4 q = rows[r];
            if (w == 8) q = rows[r + 8]; else if (w == 4) q = rows[r + 12]; else if (w == 2) q = rows[r + 14];
            s[0] -= bf_lo(q.x); s[1] -= bf_hi(q.x); s[2] -= bf_lo(q.y); s[3] -= bf_hi(q.y); s[4] -= bf_lo(q.z); s[5] -= bf_hi(q.z); s[6] -= bf_lo(q.w); s[7] -= bf_hi(q.w);
        }
    }
}

constexpr size_t WS_X1B = WS_X1, WS_X2B = WS_X1 + 64 * MiB;
constexpr int ROWS_PER_WAVE = 16;
DEVFN void vec_load(const float* p, int lane, f32x4 (&v)[4]) {
#pragma unroll
    for (int j = 0; j < 4; ++j) v[j] = *(const f32x4*)(p + 4 * lane + 256 * j);
}
DEVFN void bfrow_load(const bf16_t* p, int lane, u32x2 (&w)[4]) {
#pragma unroll
    for (int j = 0; j < 4; ++j) w[j] = *(const u32x2*)(p + 4 * lane + 256 * j);
}
DEVFN f32x4 bf4(u32x2 w) { return (f32x4){bf_lo(w.x), bf_hi(w.x), bf_lo(w.y), bf_hi(w.y)}; }
DEVFN void bfrow_store(bf16_t* p, int lane, const f32x4 (&v)[4]) {
#pragma unroll
    for (int j = 0; j < 4; ++j) { u32x2 o; o.x = pk2(v[j].x, v[j].y); o.y = pk2(v[j].z, v[j].w); *(u32x2*)(p + 4 * lane + 256 * j) = o; }
}
DEVFN void f8row_store(unsigned char* p, int lane, const f32x4 (&v)[4]) {
#pragma unroll
    for (int j = 0; j < 4; ++j) *(unsigned*)(p + 4 * lane + 256 * j) = pk4_fp8(v[j].x, v[j].y, v[j].z, v[j].w);
}
DEVFN void ln_mod(f32x4 (&v)[4], const f32x4 (&sc)[4], const f32x4 (&sh)[4]) {
    float mean, rstd; row_stats(v, mean, rstd);
#pragma unroll
    for (int j = 0; j < 4; ++j) v[j] = (v[j] - mean) * rstd * (sc[j] + 1.f) + sh[j];
}
DEVFN void ln_aff(f32x4 (&v)[4], const f32x4 (&g)[4], const f32x4 (&b)[4]) {
    float mean, rstd; row_stats(v, mean, rstd);
#pragma unroll
    for (int j = 0; j < 4; ++j) v[j] = (v[j] - mean) * rstd * g[j] + b[j];
}

DEVFN void ph_h1_rows(const Args& a, const Ctx& c) {
    const float* mod = (const float*)(a.ws + WS_MOD); bf16_t* HB = (bf16_t*)(a.ws + WS_HB);
    for (int base = c.gw * ROWS_PER_WAVE; base < NTOK; base += c.NGW * ROWS_PER_WAVE) {
        const float* mb = mod + (size_t)(base >> 11) * NMOD;
        f32x4 sc[4], sh[4]; vec_load(mb + DM, c.lane, sc); vec_load(mb, c.lane, sh);
        f32x4 cur[4], nxt[4]; vec_load(a.in[I_X] + (size_t)base * DM, c.lane, cur);
#pragma unroll 1
        for (int i = 0; i < ROWS_PER_WAVE; ++i) {
            const int m = base + i;
            if (i + 1 < ROWS_PER_WAVE) vec_load(a.in[I_X] + (size_t)(m + 1) * DM, c.lane, nxt);
            ln_mod(cur, sc, sh); f8row_store((unsigned char*)HB + (size_t)m * DM, c.lane, cur);
#pragma unroll
            for (int j = 0; j < 4; ++j) cur[j] = nxt[j];
        }
    }
}

DEVFN f32x4 reduce16(const float (&lg)[16]) {
    float t[8], u[4];
#pragma unroll
    for (int e = 0; e < 8; ++e) { auto rr = __builtin_amdgcn_permlane32_swap(__float_as_uint(lg[e]), __float_as_uint(lg[e + 8]), false, false); t[e] = __uint_as_float(rr[0]) + __uint_as_float(rr[1]); }
#pragma unroll
    for (int k = 0; k < 4; ++k) { auto rr = __builtin_amdgcn_permlane16_swap(__float_as_uint(t[k]), __float_as_uint(t[k + 4]), false, false); u[k] = __uint_as_float(rr[0]) + __uint_as_float(rr[1]); }
#pragma unroll
    for (int k = 0; k < 4; ++k) { u[k] = swz_xor_add(u[k], 1); u[k] = swz_xor_add(u[k], 2); u[k] = swz_xor_add(u[k], 4); u[k] = swz_xor_add(u[k], 8); }
    return (f32x4){u[0], u[1], u[2], u[3]};
}

DEVFN void rowc_load(const Args& a, int l, int m, int lane, f32x4 (&x)[4], unsigned (&y)[4]) {
    if (l == 0) vec_load(a.in[I_X] + (size_t)m * DM, lane, x);
    else { u32x2 w[4]; bfrow_load((const bf16_t*)(a.ws + WS_X2B) + (size_t)m * DM, lane, w);
#pragma unroll
        for (int j = 0; j < 4; ++j) { x[j].x = __uint_as_float(w[j].x); x[j].y = __uint_as_float(w[j].y); } }
#pragma unroll
    for (int j = 0; j < 4; ++j) y[j] = *(const unsigned*)((const unsigned char*)(a.ws + WS_QKVP) + (size_t)m * DM + 4 * lane + 256 * j);
}
DEVFN void rowc_step(const Args& a, int l, int m, int lane, const f32x4 (&x)[4], const unsigned (&y)[4], const float* vg1, const float* vsc, const float* vsh, f32x4 (&v)[4]) {
    int z_ = 0; asm volatile("" : "+v"(z_));
    f32x4 g1[4]; vec_load(vg1 + z_, lane, g1);
#pragma unroll
    for (int j = 0; j < 4; ++j) { const f32x4 xv = (l == 0) ? x[j] : bf4((u32x2){__float_as_uint(x[j].x), __float_as_uint(x[j].y)}); v[j] = xv * ALPHA + g1[j] * f8x4_to_f32(y[j], 1.f / YSCALE); }
    { f32x4 lg[4], lb[4]; vec_load(a.in[I_LN1G] + l * DM + z_, lane, lg); vec_load(a.in[I_LN1B] + l * DM + z_, lane, lb); ln_aff(v, lg, lb); }
    bfrow_store((bf16_t*)(a.ws + WS_X1B) + (size_t)m * DM, lane, v);
    { f32x4 sc[4], sh[4]; vec_load(vsc + z_, lane, sc); vec_load(vsh + z_, lane, sh); ln_mod(v, sc, sh); }
    f8row_store((unsigned char*)(a.ws + WS_HB) + (size_t)m * DM, lane, v);
}

DEVFN void ph_rows_c(const Args& a, const Ctx& c, int l, bool publish) {
    const float* mod = (const float*)(a.ws + WS_MOD) + (size_t)l * NB * NMOD;
    const bf16_t* Y = (const bf16_t*)(a.ws + WS_QKVP); const bf16_t* X2B = (const bf16_t*)(a.ws + WS_X2B);
    bf16_t* X1B = (bf16_t*)(a.ws + WS_X1B); bf16_t* HB = (bf16_t*)(a.ws + WS_HB);
    float* wr = (float*)c.lds;
    float* vsc = (float*)(c.lds + 65536); float* vsh = vsc + DM; float* vg1 = vsh + DM;
    int* lcnt = (int*)(c.lds + 65536 + 12288); int* lbase = lcnt + 32;
    int* rcls = lbase + 32; float* rw1 = (float*)(rcls + 8 * 64); float* rw2 = rw1 + 8 * 64; int* rrow = (int*)(rw2 + 8 * 64); float* lgs = (float*)(rrow + 8 * 64);
#pragma unroll
    for (int it = 0; it < 8; ++it) { const int idx = it * 512 + c.tid, k = idx & 1023, q = idx >> 10;
        const f32x4 w = *(const f32x4*)(a.in[I_WR] + k * 16 + 4 * q);
        wr[(4 * q + 0) * DM + k] = w.x; wr[(4 * q + 1) * DM + k] = w.y; wr[(4 * q + 2) * DM + k] = w.z; wr[(4 * q + 3) * DM + k] = w.w; }
    if (c.tid < 32) lcnt[c.tid] = 0;
    __syncthreads();
    int nr = 0;
    for (int base = c.gw * ROWS_PER_WAVE; base < NTOK; base += c.NGW * ROWS_PER_WAVE) {
        const float* mb = mod + (size_t)(base >> 11) * NMOD;
        __syncthreads();
        for (int i = c.tid; i < 3 * DM; i += 512) vsc[i] = (i < DM) ? mb[4 * DM + i] : (i < 2 * DM ? mb[3 * DM + (i - DM)] : mb[2 * DM + (i - 2 * DM)]);
        __syncthreads();
#pragma unroll 1
        for (int i = 0; i < ROWS_PER_WAVE; i += 2) {
            const int m = __builtin_amdgcn_readfirstlane(base + i);
            f32x4 va[4], vb[4];
            { f32x4 xa[4], xb[4]; unsigned ya[4], yb[4];
              rowc_load(a, l, m, c.lane, xa, ya); rowc_load(a, l, m + 1, c.lane, xb, yb);
              rowc_step(a, l, m, c.lane, xa, ya, vg1, vsc, vsh, va);
              rowc_step(a, l, m + 1, c.lane, xb, yb, vg1, vsc, vsh, vb); }
            typedef float f32x2_t __attribute__((ext_vector_type(2)));
            f32x2_t acc2[16];
#pragma unroll
            for (int e = 0; e < 16; ++e) acc2[e] = (f32x2_t){0.f, 0.f};
#pragma unroll
            for (int j = 0; j < 4; ++j) {
                const f32x2_t p0 = {va[j].x, vb[j].x}, p1 = {va[j].y, vb[j].y}, p2 = {va[j].z, vb[j].z}, p3 = {va[j].w, vb[j].w};
#pragma unroll
                for (int e = 0; e < 16; ++e) { const f32x4 w = *(const f32x4*)(wr + e * DM + 4 * c.lane + 256 * j);
                    acc2[e] = __builtin_elementwise_fma(p0, (f32x2_t){w.x, w.x}, acc2[e]); acc2[e] = __builtin_elementwise_fma(p1, (f32x2_t){w.y, w.y}, acc2[e]);
                    acc2[e] = __builtin_elementwise_fma(p2, (f32x2_t){w.z, w.z}, acc2[e]); acc2[e] = __builtin_elementwise_fma(p3, (f32x2_t){w.w, w.w}, acc2[e]);
                    if ((e & 7) == 7) __builtin_amdgcn_sched_barrier(0); } }
            float la[16], lb2[16];
#pragma unroll
            for (int e = 0; e < 16; ++e) { la[e] = acc2[e].x; lb2[e] = acc2[e].y; }
            { const f32x4 ua = reduce16(la), ub = reduce16(lb2);
              if ((c.lane & 15) == 0) { *(f32x4*)(lgs + (c.wave * 16 + i) * 16 + (c.lane >> 4) * 4) = ua; *(f32x4*)(lgs + (c.wave * 16 + i + 1) * 16 + (c.lane >> 4) * 4) = ub; } }
        }
        LDS_WAIT();
        if (c.lane < ROWS_PER_WAVE) {
            float lg16[16], rb[16];
#pragma unroll
            for (int e = 0; e < 16; ++e) rb[e] = a.in[I_RB][e];
#pragma unroll
            for (int q = 0; q < 4; ++q) { const f32x4 t = *(const f32x4*)(lgs + (c.wave * 16 + c.lane) * 16 + 4 * q); lg16[4 * q] = t.x; lg16[4 * q + 1] = t.y; lg16[4 * q + 2] = t.z; lg16[4 * q + 3] = t.w; }
            float mx = lg16[0];
#pragma unroll
            for (int e = 1; e < 16; ++e) mx = fmaxf(mx, lg16[e]);
            float sum = 0.f, scr[16];
#pragma unroll
            for (int e = 0; e < 16; ++e) { scr[e] = __expf(lg16[e] - mx); sum += scr[e]; }
            const float isum = 1.f / sum;
#pragma unroll
            for (int e = 0; e < 16; ++e) scr[e] *= isum;
            float bestg = -3.4e38f; int gb = 0, bi1 = 0, bi2 = 1; float bw1 = 0.f, bw2 = 0.f;
#pragma unroll
            for (int g = 0; g < 4; ++g) {
                float m1 = scr[4 * g] + rb[4 * g], s1 = scr[4 * g]; int i1 = 0;
#pragma unroll
                for (int q = 1; q < 4; ++q) { const float sv = scr[4 * g + q] + rb[4 * g + q]; const bool ok = sv > m1; m1 = ok ? sv : m1; s1 = ok ? scr[4 * g + q] : s1; i1 = ok ? q : i1; }
                float m2 = -3.4e38f, s2 = 0.f; int i2 = 0;
#pragma unroll
                for (int q = 0; q < 4; ++q) { const float sv = scr[4 * g + q] + rb[4 * g + q]; const bool ok = (q != i1) && sv > m2; m2 = ok ? sv : m2; s2 = ok ? scr[4 * g + q] : s2; i2 = ok ? q : i2; }
                const float gs = m1 + m2; const bool better = gs > bestg;
                bestg = better ? gs : bestg; gb = better ? g : gb; bi1 = better ? i1 : bi1; bi2 = better ? i2 : bi2; bw1 = better ? s1 : bw1; bw2 = better ? s2 : bw2;
            }
            const float inv = 1.f / (bw1 + bw2);
            const int lo = bi1 < bi2 ? bi1 : bi2, hi2 = bi1 < bi2 ? bi2 : bi1;
            const float wlo = (bi1 < bi2 ? bw1 : bw2) * inv, whi = (bi1 < bi2 ? bw2 : bw1) * inv;
            const int pidx = lo == 0 ? hi2 - 1 : (lo == 1 ? hi2 + 1 : 5);
            const int slot = c.wave * 64 + nr + c.lane;
            rcls[slot] = gb * 6 + pidx; rw1[slot] = wlo; rw2[slot] = whi; rrow[slot] = base + c.lane;
        }
        nr += ROWS_PER_WAVE;
        LDS_WAIT();
    }
    LDS_WAIT();
    if (!publish) return;
    int rank = 0, cls = 0;
    if (c.lane < nr) { cls = rcls[c.wave * 64 + c.lane]; rank = atomicAdd(&lcnt[cls], 1); }
    __syncthreads();
    if (c.tid < NCLS) lbase[c.tid] = (int)__hip_atomic_fetch_add((unsigned*)(a.ws + WS_CTL) + CW_CNT + l * 32 + c.tid, (unsigned)lcnt[c.tid], RLX_AGENT);
    __syncthreads();
    if (c.lane < nr) {
        const int pos = lbase[cls] + rank;
        ((int*)(a.ws + WS_LIST))[(size_t)cls * LISTCAP + pos] = rrow[c.wave * 64 + c.lane];
        float* rw = (float*)(a.ws + WS_RW) + ((size_t)cls * LISTCAP + pos) * 2;
        rw[0] = rw1[c.wave * 64 + c.lane]; rw[1] = rw2[c.wave * 64 + c.lane];
    }
}

DEVFN void ph_rows_g(const Args& a, const Ctx& c, int l) {
    const float* mod = (const float*)(a.ws + WS_MOD) + (size_t)l * NB * NMOD;
    const bf16_t* X1B = (const bf16_t*)(a.ws + WS_X1B); const unsigned char* Y2 = (const unsigned char*)(a.ws + WS_AD);
    bf16_t* X2B = (bf16_t*)(a.ws + WS_X2B); bf16_t* HB = (bf16_t*)(a.ws + WS_HB);
    for (int base = c.gw * ROWS_PER_WAVE; base < NTOK; base += c.NGW * ROWS_PER_WAVE) {
        const float* mb = mod + (size_t)(base >> 11) * NMOD; const float* mb1 = mb + (size_t)NB * NMOD;
        f32x4 g2[4], lg[4], lb[4], sc[4], sh[4];
        vec_load(mb + 5 * DM, c.lane, g2); vec_load(a.in[I_LN2G] + l * DM, c.lane, lg); vec_load(a.in[I_LN2B] + l * DM, c.lane, lb);
        if (l == 0) { vec_load(mb1 + DM, c.lane, sc); vec_load(mb1, c.lane, sh); }
        u32x2 xc[4], xn[4]; unsigned yc[4], yn[4];
        bfrow_load(X1B + (size_t)base * DM, c.lane, xc);
#pragma unroll
        for (int j = 0; j < 4; ++j) yc[j] = *(const unsigned*)(Y2 + (size_t)base * DM + 4 * c.lane + 256 * j);
#pragma unroll 1
        for (int i = 0; i < ROWS_PER_WAVE; ++i) {
            const int m = base + i;
            if (i + 1 < ROWS_PER_WAVE) { bfrow_load(X1B + (size_t)(m + 1) * DM, c.lane, xn);
#pragma unroll
                for (int j = 0; j < 4; ++j) yn[j] = *(const unsigned*)(Y2 + (size_t)(m + 1) * DM + 4 * c.lane + 256 * j); }
            f32x4 v[4];
#pragma unroll
            for (int j = 0; j < 4; ++j) v[j] = bf4(xc[j]) * ALPHA + g2[j] * f8x4_to_f32(yc[j], 1.f / YSCALE);
            ln_aff(v, lg, lb);
            if (l == 0) { bfrow_store(X2B + (size_t)m * DM, c.lane, v); ln_mod(v, sc, sh); f8row_store((unsigned char*)HB + (size_t)m * DM, c.lane, v); }
            else {
#pragma unroll
                for (int j = 0; j < 4; ++j) *(f32x4*)(a.out + (size_t)m * DM + 4 * c.lane + 256 * j) = v[j]; }
#pragma unroll
            for (int j = 0; j < 4; ++j) { xc[j] = xn[j]; yc[j] = yn[j]; }
        }
    }
}

constexpr int MOETAB_OFF = 131072 + 512;
DEVFN void ph_inproj_fast(const Args& a, const Ctx& c, int l, bool dummy_kbar) {
    pg8::DenseSched S; S.so.init(NTOK, DIN, c.G, c.bid); S.A = (const char*)(a.ws + WS_HB); S.Bt = (const char*)(a.ws + WS_WIN) + (size_t)l * DIN * DM; S.lda = DM; S.ldb = DM;
    const pg8::EpiInproj E{(bf16_t*)(a.ws + WS_QKVP), (const float*)(a.ws + WS_ROPE), (dummy_kbar ? (float*)(a.ws + WS_RW) : (float*)(a.ws + WS_KBAR)) + (size_t)l * NB * NH * NBLK * HD};
    pg8::gemm_phase2<pg8::EpiInproj, pg8::DenseSched, true, true, false, true, 127 - 5, 127>(c.lds3, DM, DM, S, E, c.tid);
}
DEVFN void ph_wout_fast(const Args& a, const Ctx& c, int l) {
    pg8::DenseSched S; S.so.init(NTOK, DM, c.G, c.bid); S.A = (const char*)(a.ws + WS_AD); S.Bt = (const char*)(a.ws + WS_WOUT) + (size_t)l * DM * DM; S.lda = DM; S.ldb = DM;
    const pg8::EpiF8 E{(unsigned char*)(a.ws + WS_QKVP), DM};
    pg8::gemm_phase2<pg8::EpiF8, pg8::DenseSched, true, true, false, true, 127 - 5 + 4, 127 - 5, true, 127 - 7 + 4, 127>    (c.lds3, DM, DM, S, E, c.tid);
}
DEVFN void moe_table_lds(const Args& a, const Ctx& c, int l) {
    int* cnt = (int*)(c.lds + MOETAB_OFF); int* tp = cnt + 32;
    if (c.tid < NCLS) cnt[c.tid] = (int)__hip_atomic_load((unsigned*)(a.ws + WS_CTL) + CW_CNT + l * 32 + c.tid, RLX_AGENT);
    __syncthreads();
    if (c.tid <= NCLS) { int s = 0;
#pragma unroll
        for (int k = 0; k < NCLS; ++k) { const int nk = (cnt[k] + 255) >> 8; s += (k < c.tid) ? nk : 0; }
        tp[c.tid] = s; }
    __syncthreads();
    int* tcls = tp + 32;
    for (int T = c.tid; T < tp[NCLS]; T += 512) { int k = 0; while (T >= tp[k + 1]) ++k; tcls[T] = k; }
    __syncthreads();
}
DEVFN void ph_gateup_fast(const Args& a, const Ctx& c, int l) {
    moe_table_lds(a, c, l);
    pg8::GateUpSched S; S.cnt = (const LAS int*)(c.lds3 + MOETAB_OFF); S.tp = S.cnt + 32; S.tcls = S.tp + 32; S.npn_shift = 3; S.nunits = S.tp[NCLS] * 8; S.G = c.G; S.c = (c.G % 8 == 0) ? (c.bid % 8) * (c.G / 8) + c.bid / 8 : c.bid;
    S.HB = (const char*)(a.ws + WS_HB); S.list = (const int*)(a.ws + WS_LIST); S.W = (const char*)(a.ws + WS_WGU) + (size_t)l * NE * DM * DM;
    const pg8::EpiGateUp E{(unsigned char*)(a.ws + WS_QKVP), (const float*)(a.ws + WS_RW)};
    pg8::gemm_phase2<pg8::EpiGateUp, pg8::GateUpSched, true, true, false, true, 127 - 5, 127>(c.lds3, DM, DM, S, E, c.tid);
}
DEVFN void ph_down_fast(const Args& a, const Ctx& c, int l) {
    moe_table_lds(a, c, l);
    pg8::DownSched S; S.cnt = (const LAS int*)(c.lds3 + MOETAB_OFF); S.tp = S.cnt + 32; S.tcls = S.tp + 32; S.npn_shift = 2; S.nunits = S.tp[NCLS] * 4; S.G = c.G; S.c = (c.G % 8 == 0) ? (c.bid % 8) * (c.G / 8) + c.bid / 8 : c.bid;
    S.ACT = (const char*)(a.ws + WS_QKVP); S.W = (const char*)(a.ws + WS_WD) + (size_t)l * NE * DM * DE;
    const pg8::EpiDown E{(unsigned char*)(a.ws + WS_AD), (const int*)(a.ws + WS_LIST)};
    pg8::gemm_phase2<pg8::EpiDown, pg8::DownSched, true, true, true, true, 127 - 5 + 4, 127 - 3>    (c.lds3, DM, DE, S, E, c.tid);
}

#ifndef MK_N_LAUNCHES
#define MK_N_LAUNCHES 1
#endif
constexpr int RING_BYTES = 131072, LDSCTL_OFF = RING_BYTES, MISC_OFF = LDSCTL_OFF + 320, LDS_BYTES = 147456;
constexpr int PH_PER_LAYER = 7, NPHASE = 2 + 2 * PH_PER_LAYER;
constexpr int CW_BAR = 4096;
static_assert((CW_BAR + XCD_BAR_WORDS) * 4 <= (int)CTL_ZERO_BYTES, "CTL");

__global__ void __launch_bounds__(512, 2) fwd(Args a) {
    extern __shared__ __attribute__((aligned(16))) unsigned char lds[];
    const int wave_s = __builtin_amdgcn_readfirstlane(threadIdx.x >> 6);
#define MKTID() (wave_s * 64 + lane_id_volatile())
#define MKCTX() Args al = a; { size_t z_ = 0; asm volatile("" : "+s"(z_)); al.ws = a.ws + z_; } Ctx c; {     int t_ = MKTID(); asm volatile("" : "+v"(t_)); c.lds = lds; c.lds3 = (LAS unsigned char*)lds; c.tid = t_; c.lane = t_ & 63; c.wave = __builtin_amdgcn_readfirstlane(t_ >> 6); c.G = gridDim.x; c.bid = blockIdx.x; c.gw = ((c.G % 8 == 0) ? (c.bid % 8) * (c.G / 8) + c.bid / 8 : c.bid) * 8 + c.wave; c.NGW = c.G * 8; }
    const int lo = a.ph_lo, hi = a.ph_hi;
    const bool one = (hi - lo) > 1;
    for (int u = threadIdx.x; u < (LDS_BYTES - LDSCTL_OFF) / 4; u += 512) ((LAS unsigned*)((LAS unsigned char*)lds + LDSCTL_OFF))[u] = 0u;
    __syncthreads();
    XcdBarrier bar; bar.bar = (unsigned*)(a.ws + WS_CTL) + CW_BAR; bar.x = 0; bar.st = nullptr;
    if (one) bar = xcd_barrier_post((unsigned*)(a.ws + WS_CTL) + CW_BAR, (volatile LAS unsigned*)((LAS unsigned char*)lds + MISC_OFF) + 8);
#ifndef REP_PHASE
#define REP_PHASE -1
#endif
#define IN(k) (lo <= (k) && (k) < hi)
#define SEAM(k) do { if (IN(k) && IN((k) + 1)) { XcdBarrier bl_ = bar; { size_t z_ = 0; unsigned x_ = bar.x; asm volatile("" : "+s"(z_), "+s"(x_)); bl_.bar = bar.bar + z_; bl_.x = x_; } xcd_barrier(bl_, MKTID() == 0); } } while (0)
    if (IN(0)) { MKCTX(); ph_prologue(al, c); if (REP_PHASE == 0) { __syncthreads(); ph_prologue(al, c); } SEAM(0); }
    if (IN(1)) { MKCTX(); ph_h1_rows(al, c); if (REP_PHASE == 1) ph_h1_rows(al, c); SEAM(1); }
    {
        constexpr int l = 0; constexpr int p0 = 2 + l * PH_PER_LAYER;
        if (IN(p0 + 0)) { MKCTX(); ph_inproj_fast(al, c, l, false); if (REP_PHASE == 10) { __syncthreads(); ph_inproj_fast(al, c, l, true); } SEAM(p0 + 0); }
        if (IN(p0 + 1)) {
            { MKCTX(); ph_pool(al, c); }
            __syncthreads();
            const attn_body::AttnTensors AT{(const attn_body::bf16*)(a.ws + WS_QKVP), (const attn_body::bf16*)(a.ws + WS_QKVP) + 512, (const attn_body::bf16*)(a.ws + WS_QKVP) + 1024,
                                            (attn_body::bf16*)(a.ws + WS_AD), (const float*)(a.ws + WS_KBAR) + (size_t)l * NB * NH * NBLK * HD};
            const attn_body::StaticOrder S((int)gridDim.x, (int)blockIdx.x);
            attn_body::attn_phase<attn_body::StaticOrder>((char*)lds, AT, S, MKTID());
            if (REP_PHASE == 11) attn_body::attn_phase<attn_body::StaticOrder>((char*)lds, AT, S, MKTID());
            if (REP_PHASE == 17) { __syncthreads(); MKCTX(); ph_pool(al, c); }
            SEAM(p0 + 1);
        }
        if (IN(p0 + 2)) { MKCTX(); ph_wout_fast(al, c, l); if (REP_PHASE == 12) { __syncthreads(); ph_wout_fast(al, c, l); } SEAM(p0 + 2); }
        if (IN(p0 + 3)) { MKCTX(); if (REP_PHASE == 13) { ph_rows_c(al, c, l, false); __syncthreads(); } ph_rows_c(al, c, l, true); SEAM(p0 + 3); }
        if (IN(p0 + 4)) { MKCTX(); ph_gateup_fast(al, c, l); if (REP_PHASE == 14) { __syncthreads(); ph_gateup_fast(al, c, l); } SEAM(p0 + 4); }
        if (IN(p0 + 5)) { MKCTX(); ph_down_fast(al, c, l); if (REP_PHASE == 15) { __syncthreads(); ph_down_fast(al, c, l); } SEAM(p0 + 5); }
        if (IN(p0 + 6)) { MKCTX(); ph_rows_g(al, c, l); if (REP_PHASE == 16) ph_rows_g(al, c, l); SEAM(p0 + 6); }
    }
    {
        constexpr int l = 1; constexpr int p0 = 2 + l * PH_PER_LAYER;
        if (IN(p0 + 0)) { MKCTX(); ph_inproj_fast(al, c, l, false); if (REP_PHASE == 10) { __syncthreads(); ph_inproj_fast(al, c, l, true); } SEAM(p0 + 0); }
        if (IN(p0 + 1)) {
            { MKCTX(); ph_pool(al, c); }
            __syncthreads();
            const attn_body::AttnTensors AT{(const attn_body::bf16*)(a.ws + WS_QKVP), (const attn_body::bf16*)(a.ws + WS_QKVP) + 512, (const attn_body::bf16*)(a.ws + WS_QKVP) + 1024,
                                            (attn_body::bf16*)(a.ws + WS_AD), (const float*)(a.ws + WS_KBAR) + (size_t)l * NB * NH * NBLK * HD};
            const attn_body::StaticOrder S((int)gridDim.x, (int)blockIdx.x);
            attn_body::attn_phase<attn_body::StaticOrder>((char*)lds, AT, S, MKTID());
            if (REP_PHASE == 11) attn_body::attn_phase<attn_body::StaticOrder>((char*)lds, AT, S, MKTID());
            if (REP_PHASE == 17) { __syncthreads(); MKCTX(); ph_pool(al, c); }
            SEAM(p0 + 1);
        }
        if (IN(p0 + 2)) { MKCTX(); ph_wout_fast(al, c, l); if (REP_PHASE == 12) { __syncthreads(); ph_wout_fast(al, c, l); } SEAM(p0 + 2); }
        if (IN(p0 + 3)) { MKCTX(); if (REP_PHASE == 13) { ph_rows_c(al, c, l, false); __syncthreads(); } ph_rows_c(al, c, l, true); SEAM(p0 + 3); }
        if (IN(p0 + 4)) { MKCTX(); ph_gateup_fast(al, c, l); if (REP_PHASE == 14) { __syncthreads(); ph_gateup_fast(al, c, l); } SEAM(p0 + 4); }
        if (IN(p0 + 5)) { MKCTX(); ph_down_fast(al, c, l); if (REP_PHASE == 15) { __syncthreads(); ph_down_fast(al, c, l); } SEAM(p0 + 5); }
        if (IN(p0 + 6)) { MKCTX(); ph_rows_g(al, c, l); if (REP_PHASE == 16) ph_rows_g(al, c, l); SEAM(p0 + 6); }
    }
#undef IN
#undef SEAM
}

extern "C" void kernel_launch(void* const* d_in, const int* in_sizes, int n_in, void* d_out, int out_size, void* d_ws, size_t ws_size, hipStream_t stream) {
    static int grid = 0;
    if (grid == 0) {
        if (n_in != 17 || out_size != NTOK * DM || ws_size < WS_END) { fprintf(stderr, "kernel_launch: unexpected problem (n_in %d out %d ws %zu)\n", n_in, out_size, ws_size); grid = -1; return; }
        if (hipFuncSetAttribute((const void*)fwd, hipFuncAttributeMaxDynamicSharedMemorySize, LDS_BYTES) != hipSuccess) { fprintf(stderr, "kernel_launch: hipFuncSetAttribute failed\n"); grid = -1; return; }
        int dev = 0, cus = 0, per_cu = 0;
        (void)hipGetDevice(&dev); (void)hipDeviceGetAttribute(&cus, hipDeviceAttributeMultiprocessorCount, dev);
        if (hipOccupancyMaxActiveBlocksPerMultiprocessor(&per_cu, (const void*)fwd, 512, LDS_BYTES) != hipSuccess || per_cu < 1) fprintf(stderr, "kernel_launch: occupancy query reports %d workgroups per CU\n", per_cu);
        (void)hipGetLastError();
        grid = cus > 0 ? cus : 256;
    }
    if (grid < 0) return;
    (void)hipMemsetAsync((char*)d_ws + WS_CTL, 0, CTL_ZERO_BYTES, stream);
    Args a{};
    for (int i = 0; i < 17; ++i) a.in[i] = (const float*)d_in[i];
    a.out = (float*)d_out; a.ws = (unsigned char*)d_ws;
#if MK_N_LAUNCHES == 1
    a.ph_lo = 0; a.ph_hi = NPHASE; hipLaunchKernelGGL(fwd, dim3(grid), dim3(512), LDS_BYTES, stream, a);
#else
    for (int p = 0; p < NPHASE; ++p) { a.ph_lo = p; a.ph_hi = p + 1; hipLaunchKernelGGL(fwd, dim3(grid), dim3(512), LDS_BYTES, stream, a); }
#endif
}
```

```cpp
#include <hip/hip_runtime.h>
#include <cstdint>
#include <cstdio>

constexpr int NB = 16, SEQ = 2048, DM = 1024, NTOK = NB * SEQ, DIN = 2048, NH = 8, HD = 64, NBLK = 8, MBLK = 256;
constexpr int NE = 16, NCLS = 24, DE = 512, NMOD = 6 * DM;
constexpr float ALPHA = 1.41421356237309515f, LN_EPS = 1e-5f;
constexpr float QSCALE = 0.125f * 1.4426950408889634f;
constexpr int LISTCAP = NTOK;

constexpr size_t MiB = 1u << 20;
constexpr size_t WS_CTL = 0, CTL_ZERO_BYTES = 1 * MiB;
constexpr size_t WS_MOD = 1 * MiB;
constexpr size_t WS_ROPE = 2 * MiB;
constexpr size_t WS_KBAR = 2 * MiB + 256 * 1024;
constexpr size_t WS_LIST = 3 * MiB;
constexpr size_t WS_RW = 6 * MiB;
constexpr size_t WS_WIN = 12 * MiB;
constexpr size_t WS_WOUT = 20 * MiB;
constexpr size_t WS_WGU = 24 * MiB;
constexpr size_t WS_WD = 88 * MiB;
constexpr size_t WS_HB = 120 * MiB;
constexpr size_t WS_QKVP = 184 * MiB;
constexpr size_t WS_AD = 312 * MiB;
constexpr size_t WS_X1 = 376 * MiB;
constexpr size_t WS_END = 504 * MiB;
constexpr int CW_TMO = 0, CW_CNT = 64;

typedef unsigned short bf16_t;
typedef short bf16x8 __attribute__((ext_vector_type(8)));
typedef float f32x4 __attribute__((ext_vector_type(4)));
typedef float f32x16 __attribute__((ext_vector_type(16)));
typedef unsigned u32x4 __attribute__((ext_vector_type(4)));
typedef unsigned u32x2 __attribute__((ext_vector_type(2)));

#define DEVFN __device__ __forceinline__
#define LDS_WAIT() asm volatile("s_waitcnt lgkmcnt(0)" ::: "memory")
#define RLX_AGENT __ATOMIC_RELAXED, __HIP_MEMORY_SCOPE_AGENT

DEVFN float bf_lo(unsigned w) { return __uint_as_float(w << 16); }
DEVFN float bf_hi(unsigned w) { return __uint_as_float(w & 0xffff0000u); }
DEVFN float bf2f(bf16_t v) { return __uint_as_float((unsigned)v << 16); }
DEVFN unsigned f2bf(float f) { unsigned u = __float_as_uint(f); return (u + 0x7fffu + ((u >> 16) & 1u)) >> 16; }
DEVFN unsigned pk2(float lo, float hi) { unsigned r; asm("v_cvt_pk_bf16_f32 %0, %1, %2" : "=v"(r) : "v"(lo), "v"(hi)); return r; }
DEVFN unsigned pk4_fp8(float a, float b, float c, float d) {
    a = __builtin_amdgcn_fmed3f(a, -448.f, 448.f); b = __builtin_amdgcn_fmed3f(b, -448.f, 448.f); c = __builtin_amdgcn_fmed3f(c, -448.f, 448.f); d = __builtin_amdgcn_fmed3f(d, -448.f, 448.f);
    unsigned w = 0u; w = __builtin_amdgcn_cvt_pk_fp8_f32(a, b, w, false); w = __builtin_amdgcn_cvt_pk_fp8_f32(c, d, w, true); return w; }
DEVFN f32x4 f8x4_to_f32(unsigned w, float sc) { const auto lo = __builtin_amdgcn_cvt_pk_f32_fp8(w, false), hi = __builtin_amdgcn_cvt_pk_f32_fp8(w, true); return (f32x4){lo[0] * sc, lo[1] * sc, hi[0] * sc, hi[1] * sc}; }
constexpr float YSCALE = 16.f;
DEVFN int crow(int r, int hi) { return (r & 3) + 8 * (r >> 2) + 4 * hi; }
DEVFN float dpp_f(float v, const int ctrl) {
    switch (ctrl) {
        case 0xB1:  return __int_as_float(__builtin_amdgcn_update_dpp(0, __float_as_int(v), 0xB1, 0xF, 0xF, false));
        case 0x4E:  return __int_as_float(__builtin_amdgcn_update_dpp(0, __float_as_int(v), 0x4E, 0xF, 0xF, false));
        case 0x141: return __int_as_float(__builtin_amdgcn_update_dpp(0, __float_as_int(v), 0x141, 0xF, 0xF, false));
        default:    return __int_as_float(__builtin_amdgcn_update_dpp(0, __float_as_int(v), 0x140, 0xF, 0xF, false));
    }
}
DEVFN float swz_xor_add(float v, const int m) {
    switch (m) {
        case 1: return v + dpp_f(v, 0xB1);
        case 2: return v + dpp_f(v, 0x4E);
        case 4: return v + dpp_f(v, 0x141);
        case 8: return v + dpp_f(v, 0x140);
        default: { auto rr = __builtin_amdgcn_permlane16_swap(__float_as_uint(v), __float_as_uint(v), false, false); return __uint_as_float(rr[0]) + __uint_as_float(rr[1]); }
    }
}
DEVFN float half_swap_add(float v) { auto rr = __builtin_amdgcn_permlane32_swap(__float_as_uint(v), __float_as_uint(v), false, false); return __uint_as_float(rr[0]) + __uint_as_float(rr[1]); }
DEVFN float wave_sum(float v) {
    v = swz_xor_add(v, 1); v = swz_xor_add(v, 2); v = swz_xor_add(v, 4); v = swz_xor_add(v, 8); v = swz_xor_add(v, 16);
    return half_swap_add(v);
}
__host__ __device__ __forceinline__ int inproj_lgroup(int P) { return P < 16 ? (P >> 2) * 8 + (P & 3) * 2 : ((P - 16) >> 2) * 8 + ((P - 16) & 3) * 2 + 1; }
__host__ __device__ __forceinline__ int inproj_nlog(int n) { return (n & ~255) + inproj_lgroup((n & 255) >> 3) * 8 + (n & 7); }

#define GAS __attribute__((address_space(1)))
#define LAS __attribute__((address_space(3)))
typedef GAS unsigned gu32;
namespace pg8 {
#define PG8_LAS __attribute__((address_space(3)))
typedef unsigned short bf16_t;
typedef short bf16x8 __attribute__((ext_vector_type(8)));
typedef float f32x4 __attribute__((ext_vector_type(4)));
typedef unsigned u32x4 __attribute__((ext_vector_type(4)));
constexpr int BM = 256, BK = 64, HALF = 128, HTB = HALF * BK * 2  , STAGE_BYTES = 8 * HTB, NXCD = 8, WGM = 8;

__host__ __device__ __forceinline__ int lds_byte(int r, int c) { const int st = (r >> 4) * 2 + (c >> 5), rr = r & 15, cc = c & 31, ob = rr * 64 + cc * 2; return st * 1024 + (ob ^ (((ob >> 9) & 1) << 5)); }
__host__ __device__ __forceinline__ void stage_rc(int b, int& R, int& C) { const int st = b / 1024, sb = b % 1024, swz = sb ^ (((sb >> 9) & 1) << 5); R = (st >> 1) * 16 + swz / 64; C = (st & 1) * 32 + (swz % 64) / 2; }
__host__ __device__ __forceinline__ int perm32(int rho) { const int n = rho >> 4, i = rho & 15; return 8 * (i >> 2) + 4 * n + (i & 3); }

struct Unit { int pm, pn; };
struct Gemm { const bf16_t* A; const bf16_t* Bt; int M, N, K; };

struct StaticOrder {
    int nM, nN, nwg, G, c;
    __host__ __device__ void init(int M, int N, int G_, int c_) { nM = M / BM; nN = N / BM; nwg = nM * nN; G = G_; c = c_; }
    __host__ __device__ bool next(int i, Unit& u) const {
        const long L = (long)i * G + c; if (L >= nwg) return false;
        int wgid = (int)L; { const int q = nwg / NXCD, r = nwg % NXCD, xcd = wgid % NXCD, off = wgid / NXCD; wgid = (xcd < r ? xcd * (q + 1) : r * (q + 1) + (xcd - r) * q) + off; }
        const int nig = WGM * nN, gid = wgid / nig, fm = gid * WGM, gsz = (nM - fm) < WGM ? (nM - fm) : WGM;
        u.pm = fm + ((wgid % nig) % gsz); u.pn = (wgid % nig) / gsz; return true;
    }
    __device__ __forceinline__ void a_ready(const Unit&) const {}
    __device__ __forceinline__ void done(const Unit&) const {}
};

__device__ __forceinline__ unsigned cvt_pk_bf16(float lo, float hi) { unsigned r; asm volatile("v_cvt_pk_bf16_f32 %0, %1, %2" : "=v"(r) : "v"(lo), "v"(hi)); return r; }
}
namespace pg8 {
typedef int v8i_t __attribute__((ext_vector_type(8))); typedef int v4i_t __attribute__((ext_vector_type(4)));
__device__ __forceinline__ int pg8_lane_volatile() { int l; asm volatile("v_mbcnt_lo_u32_b32 %0, -1, 0\n\tv_mbcnt_hi_u32_b32 %0, -1, %0" : "=v"(l)); return l; }
template <class Epi, class Sched, bool ALIGN_EPI, bool GATHER, bool KSPLIT, bool FP8 = false, int SCW = 127, int SCA = 127, bool SC2 = false, int SCW2 = 127, int SCA2 = 127>
__device__ __forceinline__ void gemm_phase2(PG8_LAS unsigned char* lds, const int Kbytes, const int ldb_bytes, const Sched& S, const Epi& E, const int tid) {
    typedef typename Sched::UnitT UnitT;
    const int wid = __builtin_amdgcn_readfirstlane(tid >> 6), lane = tid & 63, wr = wid >> 2, wc = wid & 3, fr = lane & 15, fq = lane >> 4;
    int nt = Kbytes / (BK * 2); asm volatile("" : "+s"(nt));
    const int nth = nt / 2;
    unsigned voffB[2];
#pragma unroll
    for (int i = 0; i < 2; ++i) { int R[2], C[2]; stage_rc(tid * 16 + i * 8192, R[i], C[i]); const int Rb = Epi::PERM ? ((R[i] & ~31) + perm32(R[i] & 31)) : R[i]; voffB[i] = (unsigned)(Rb * ldb_bytes + C[i] * 2); }
    const size_t kstep = (size_t)(BK * 2);
    const size_t hstepB = (size_t)HALF * ldb_bytes;
    const unsigned ldsw = (unsigned)wid * 1024u;
    const int aoff = lds_byte(wr * 64 + fr, fq * 8), boff = lds_byte(wc * 32 + fr, fq * 8);
#define PG8_SA(b, h) (((b) * 2 + (h)) * HTB)
#define PG8_SB(b, h) ((4 + (b) * 2 + (h)) * HTB)
#define PG8_STAGE(bufoff, gbase, voff) do { _Pragma("unroll") for (int _i = 0; _i < 2; ++_i) \
        __builtin_amdgcn_global_load_lds((const unsigned*)((const char*)(gbase) + (voff)[_i]), (PG8_LAS unsigned*)(lds + (bufoff) + ldsw + _i * 8192), 16, 0, 0); } while (0)
#define PG8_LDA(dst, b, h) do { _Pragma("unroll") for (int m = 0; m < 4; ++m) _Pragma("unroll") for (int k = 0; k < 2; ++k) dst[m][k] = *(const PG8_LAS bf16x8*)(lds + PG8_SA(b, h) + aoff + m * 2048 + k * 1024); } while (0)
#define PG8_LDB(dst, b, h) do { _Pragma("unroll") for (int n = 0; n < 2; ++n) _Pragma("unroll") for (int k = 0; k < 2; ++k) dst[n][k] = *(const PG8_LAS bf16x8*)(lds + PG8_SB(b, h) + boff + n * 2048 + k * 1024); } while (0)
#define PG8_CAT8(x) __builtin_shufflevector(__builtin_bit_cast(v4i_t, (x)[0]), __builtin_bit_cast(v4i_t, (x)[1]), 0, 1, 2, 3, 4, 5, 6, 7)
#define PG8_MMA(ai, bj, At, Bt) do { __builtin_amdgcn_s_setprio(1); \
        if constexpr (FP8) { _Pragma("unroll") for (int m = 0; m < 4; ++m) _Pragma("unroll") for (int n = 0; n < 2; ++n) \
            acc[ai][bj][m][n] = __builtin_amdgcn_mfma_scale_f32_16x16x128_f8f6f4(PG8_CAT8(Bt[n]), PG8_CAT8(At[m]), acc[ai][bj][m][n], 0, 0, 0, scw_, 0, sca_); } \
        else { _Pragma("unroll") for (int m = 0; m < 4; ++m) _Pragma("unroll") for (int n = 0; n < 2; ++n) _Pragma("unroll") for (int k = 0; k < 2; ++k) \
            acc[ai][bj][m][n] = __builtin_amdgcn_mfma_f32_16x16x32_bf16(Bt[n][k], At[m][k], acc[ai][bj][m][n], 0, 0, 0); } \
        __builtin_amdgcn_s_setprio(0); } while (0)
#define PG8_STAGE1(bufoff, gbase, voff, _i) __builtin_amdgcn_global_load_lds((const unsigned*)((const char*)(gbase) + (voff)[_i]), (PG8_LAS unsigned*)(lds + (bufoff) + ldsw + (_i) * 8192), 16, 0, 0)
#define PG8_MF(ai, bj, m, n, At, Bt) do { if constexpr (FP8) acc[ai][bj][m][n] = __builtin_amdgcn_mfma_scale_f32_16x16x128_f8f6f4(PG8_CAT8(Bt[n]), PG8_CAT8(At[m]), acc[ai][bj][m][n], 0, 0, 0, scw_, 0, sca_); \
        else { acc[ai][bj][m][n] = __builtin_amdgcn_mfma_f32_16x16x32_bf16(Bt[n][0], At[m][0], acc[ai][bj][m][n], 0, 0, 0); acc[ai][bj][m][n] = __builtin_amdgcn_mfma_f32_16x16x32_bf16(Bt[n][1], At[m][1], acc[ai][bj][m][n], 0, 0, 0); } } while (0)
#define PG8_MF2(ai, bj, m, At, Bt) do { PG8_MF(ai, bj, m, 0, At, Bt); PG8_MF(ai, bj, m, 1, At, Bt); PG8_SCHED; } while (0)
#define PG8_CL1(ai, At, S0) do { __builtin_amdgcn_s_setprio(1); PG8_MF2(ai, 0, 0, At, B0); PG8_MF2(ai, 0, 1, At, B0); S0(0); PG8_SCHED; PG8_MF2(ai, 0, 2, At, B0); PG8_MF2(ai, 0, 3, At, B0); S0(1); PG8_SCHED; \
        PG8_MF2(ai, 1, 0, At, B1); PG8_MF2(ai, 1, 1, At, B1); PG8_MF2(ai, 1, 2, At, B1); PG8_MF2(ai, 1, 3, At, B1); __builtin_amdgcn_s_setprio(0); } while (0)
#define PG8_CL2(ai, At, S0, S1, S2) do { __builtin_amdgcn_s_setprio(1); PG8_MF2(ai, 0, 0, At, B0); S0(0); PG8_SCHED; PG8_MF2(ai, 0, 1, At, B0); S0(1); PG8_SCHED; PG8_MF2(ai, 0, 2, At, B0); S1(0); PG8_SCHED; PG8_MF2(ai, 0, 3, At, B0); S1(1); PG8_SCHED; \
        PG8_MF2(ai, 1, 0, At, B1); S2(0); PG8_SCHED; PG8_MF2(ai, 1, 1, At, B1); S2(1); PG8_SCHED; PG8_MF2(ai, 1, 2, At, B1); PG8_MF2(ai, 1, 3, At, B1); __builtin_amdgcn_s_setprio(0); } while (0)
#define PG8_WAIT_V(n) asm volatile("s_waitcnt vmcnt(" #n ")" ::: "memory")
#define PG8_WAIT_L(n) asm volatile("s_waitcnt lgkmcnt(" #n ")" ::: "memory")
#define PG8_BAR __builtin_amdgcn_s_barrier()
#define PG8_SCHED __builtin_amdgcn_sched_barrier(0)
#define PG8_PIN(ai) asm volatile("" :: "v"(acc[ai][0][0][0]), "v"(acc[ai][0][0][1]), "v"(acc[ai][0][1][0]), "v"(acc[ai][0][1][1]), "v"(acc[ai][0][2][0]), "v"(acc[ai][0][2][1]), "v"(acc[ai][0][3][0]), "v"(acc[ai][0][3][1]), \
        "v"(acc[ai][1][0][0]), "v"(acc[ai][1][0][1]), "v"(acc[ai][1][1][0]), "v"(acc[ai][1][1][1]), "v"(acc[ai][1][2][0]), "v"(acc[ai][1][2][1]), "v"(acc[ai][1][3][0]), "v"(acc[ai][1][3][1]))
#define PG8_BK(cb, cb2, kt) ((KSPLIT && (kt) >= nth) ? (cb2) + (size_t)((kt) - nth) * kstep : (cb) + (size_t)(kt) * kstep)
    UnitT cur, nxt; int ui = 0;
    if (!S.next(0, cur)) return;
    f32x4 acc[2][2][4][2];
#pragma unroll
    for (int a = 0; a < 2; ++a)
#pragma unroll
        for (int b = 0; b < 2; ++b)
#pragma unroll
            for (int m = 0; m < 4; ++m)
#pragma unroll
                for (int n = 0; n < 2; ++n) acc[a][b][m][n] = (f32x4){0.f, 0.f, 0.f, 0.f};
    bf16x8 At[4][2], B0[2][2], B1[2][2];
    unsigned vA[2][2];
    S.arows(cur, tid, vA);
    PG8_LAS u32x4* const vslot = (PG8_LAS u32x4*)(lds + STAGE_BYTES + 2048) + tid;
    const char* cA = S.aptr(cur); const char* cB = S.bptr(cur); const char* cB2 = KSPLIT ? S.bptr2(cur) : cB;
    PG8_STAGE(PG8_SB(0, 0), cB, voffB); PG8_STAGE(PG8_SB(0, 1), cB + hstepB, voffB); PG8_STAGE(PG8_SA(0, 0), cA, vA[0]); PG8_STAGE(PG8_SA(0, 1), cA, vA[1]);
    if (wr == 1) PG8_BAR;
    PG8_WAIT_V(2); PG8_BAR;
    PG8_STAGE(PG8_SB(1, 0), PG8_BK(cB, cB2, 1), voffB); PG8_STAGE(PG8_SA(1, 0), cA + kstep, vA[0]); PG8_STAGE(PG8_SB(1, 1), PG8_BK(cB, cB2, 1) + hstepB, voffB);
    PG8_WAIT_V(6); PG8_BAR;
    for (;;) {
        const bool has_next = S.next(ui + 1, nxt);
        const char* nA = has_next ? S.aptr(nxt) : cA; const char* nB = has_next ? S.bptr(nxt) : cB; const char* nB2 = (KSPLIT && has_next) ? S.bptr2(nxt) : cB2;
        if (GATHER && has_next) { unsigned vn_[2][2]; S.arows(nxt, wid * 64 + pg8_lane_volatile(), vn_); *vslot = (u32x4){vn_[0][0], vn_[0][1], vn_[1][0], vn_[1][1]}; }
        for (int t = 0; t < nt; t += 2) {
            const bool last = (t == nt - 2);
            const int scw_ = ((SC2 && t >= nth) ? SCW2 : SCW) * 0x01010101, sca_ = ((SC2 && t >= nth) ? SCA2 : SCA) * 0x01010101; (void)scw_; (void)sca_;
            const char* a1 = cA + (size_t)(t + 1) * kstep;
            const char* a2 = last ? nA : cA + (size_t)(t + 2) * kstep;
            const char* b2 = last ? nB : PG8_BK(cB, cB2, t + 2);
            const char* b3 = last ? (KSPLIT ? PG8_BK(nB, nB2, 1) : nB + kstep) : PG8_BK(cB, cB2, t + 3);
            const char* a3 = a2 + kstep;
#define ST_A11(i) PG8_STAGE1(PG8_SA(1, 1), a1, vA[1], i)
#define ST_B00(i) PG8_STAGE1(PG8_SB(0, 0), b2, voffB, i)
#define ST_B01(i) PG8_STAGE1(PG8_SB(0, 1), b2 + hstepB, voffB, i)
#define ST_A00(i) PG8_STAGE1(PG8_SA(0, 0), a2, vA[0], i)
#define ST_A01(i) PG8_STAGE1(PG8_SA(0, 1), a2, vA[1], i)
#define ST_B10(i) PG8_STAGE1(PG8_SB(1, 0), b3, voffB, i)
#define ST_B11(i) PG8_STAGE1(PG8_SB(1, 1), b3 + hstepB, voffB, i)
#define ST_A10(i) PG8_STAGE1(PG8_SA(1, 0), a3, vA[0], i)
            PG8_LDB(B0, 0, 0); PG8_LDB(B1, 0, 1); PG8_SCHED; PG8_LDA(At, 0, 0);
            PG8_WAIT_V(6); PG8_WAIT_L(0); PG8_BAR; PG8_CL1(0, At, ST_A11); PG8_PIN(0); PG8_BAR; PG8_SCHED;
            if (GATHER && last && has_next) { const u32x4 vn_ = *vslot; vA[0][0] = vn_.x; vA[0][1] = vn_.y; vA[1][0] = vn_.z; vA[1][1] = vn_.w; }
            PG8_LDA(At, 0, 1);
            PG8_WAIT_V(2); PG8_WAIT_L(0); PG8_BAR; PG8_CL2(1, At, ST_B00, ST_B01, ST_A00); PG8_PIN(1); PG8_BAR; PG8_SCHED;
            PG8_LDB(B0, 1, 0); PG8_LDB(B1, 1, 1); PG8_SCHED; PG8_LDA(At, 1, 0);
            PG8_WAIT_V(6); PG8_WAIT_L(0); PG8_BAR; PG8_CL1(0, At, ST_A01); PG8_PIN(0); PG8_BAR; PG8_SCHED;
            PG8_LDA(At, 1, 1);
            PG8_WAIT_V(2); PG8_WAIT_L(0); PG8_BAR; PG8_CL2(1, At, ST_B10, ST_B11, ST_A10); PG8_PIN(1); PG8_BAR; PG8_SCHED;
#undef ST_A11
#undef ST_B00
#undef ST_B01
#undef ST_A00
#undef ST_A01
#undef ST_B10
#undef ST_B11
#undef ST_A10
        }
        if constexpr (ALIGN_EPI) { if (wr == 0) PG8_BAR; }
        if constexpr (!Epi::AFTER_DRAIN) { const int le_ = pg8_lane_volatile(); E(acc, cur, wr, wc, le_ & 15, le_ >> 4); }
        if (!has_next) break;
#pragma unroll
        for (int a = 0; a < 2; ++a)
#pragma unroll
            for (int b = 0; b < 2; ++b)
#pragma unroll
                for (int m = 0; m < 4; ++m)
#pragma unroll
                    for (int n = 0; n < 2; ++n) acc[a][b][m][n] = (f32x4){0.f, 0.f, 0.f, 0.f};
        cur = nxt; cA = nA; cB = nB; cB2 = nB2; ++ui;
        if constexpr (ALIGN_EPI) { if (wr == 1) PG8_BAR; }
    }
    PG8_WAIT_V(0);
    if constexpr (!ALIGN_EPI) { if (wr == 0) PG8_BAR; }
    PG8_BAR;
    if constexpr (Epi::AFTER_DRAIN) { E.fused(acc, cur, wr, wc, fr, fq, lds, wid, lane); }
#undef PG8_SA
#undef PG8_SB
#undef PG8_STAGE
#undef PG8_LDA
#undef PG8_LDB
#undef PG8_MMA
#undef PG8_WAIT_V
#undef PG8_WAIT_L
#undef PG8_BAR
#undef PG8_SCHED
#undef PG8_BK
#undef PG8_PIN
#undef PG8_STAGE1
#undef PG8_MF
#undef PG8_MF2
#undef PG8_CL1
#undef PG8_CL2
#undef PG8_CAT8
}
}
namespace pg8 {
DEVFN unsigned pkbf(float lo, float hi) { return cvt_pk_bf16(lo, hi); }
struct DenseSched {
    typedef Unit UnitT;
    StaticOrder so; const char* A; const char* Bt; int lda, ldb;
    DEVFN bool next(int i, Unit& u) const { return so.next(i, u); }
    DEVFN const char* aptr(const Unit&) const { return A; }
    DEVFN void arows(const Unit& u, const int tid_, unsigned (&v)[2][2]) const {
        int R[2], C[2]; { int t_ = tid_; asm volatile("" : "+v"(t_)); stage_rc(t_ * 16, R[0], C[0]); stage_rc(t_ * 16 + 8192, R[1], C[1]); }
#pragma unroll
        for (int h = 0; h < 2; ++h)
#pragma unroll
            for (int i = 0; i < 2; ++i) v[h][i] = (unsigned)((u.pm * BM + h * HALF + R[i]) * lda + C[i] * 2); }
    DEVFN const char* bptr(const Unit& u) const { return Bt + (size_t)u.pn * BM * ldb; }
    DEVFN const char* bptr2(const Unit& u) const { return bptr(u); }
};
struct EpiInproj {
    static constexpr bool PERM = true, AFTER_DRAIN = false;
    bf16_t* O; const float* rope; float* kbar;
    DEVFN void operator()(f32x4 (&acc)[2][2][4][2], const Unit& u, int wr, int wc, int fr, int fq) const {
        const int pn = u.pn, row0 = u.pm * BM + wr * 64 + fr;
        if (pn < 4 && fq == 0) {
#pragma unroll
            for (int ai = 0; ai < 2; ++ai)
#pragma unroll
                for (int m = 0; m < 4; ++m) { const int t = (row0 + ai * HALF + m * 16) & (SEQ - 1); const f32x4* rp = (const f32x4*)(rope + t * 16);
#pragma unroll
                    for (int q = 0; q < 4; ++q) { const f32x4 cs = rp[q];
                        { const int d = 2 * q, n = d >> 2, e = d & 3; const float x1 = acc[ai][0][m][n][e], x2 = acc[ai][1][m][n][e]; acc[ai][0][m][n][e] = x1 * cs[0] - x2 * cs[1]; acc[ai][1][m][n][e] = x2 * cs[0] + x1 * cs[1]; }
                        { const int d = 2 * q + 1, n = d >> 2, e = d & 3; const float x1 = acc[ai][0][m][n][e], x2 = acc[ai][1][m][n][e]; acc[ai][0][m][n][e] = x1 * cs[2] - x2 * cs[3]; acc[ai][1][m][n][e] = x2 * cs[2] + x1 * cs[3]; } } }
        }
        if (pn == 2 || pn == 3) {
            float* kb = kbar + (size_t)((((u.pm >> 3) * NH + (pn - 2) * 4 + wc) * NBLK + (u.pm & 7)) * HD);
#pragma unroll
            for (int bj = 0; bj < 2; ++bj)
#pragma unroll
                for (int n = 0; n < 2; ++n)
#pragma unroll
                    for (int e = 0; e < 4; ++e) { float s = 0.f;
#pragma unroll
                        for (int ai = 0; ai < 2; ++ai)
#pragma unroll
                            for (int m = 0; m < 4; ++m) s += acc[ai][bj][m][n][e];
                        s = swz_xor_add(s, 1); s = swz_xor_add(s, 2); s = swz_xor_add(s, 4); s = swz_xor_add(s, 8);
                        if (fr == 0) atomicAdd(kb + (2 * fq + bj) * 8 + 4 * n + e, s * (1.f / MBLK)); }
        }
        if (pn < 2) {
#pragma unroll
            for (int ai = 0; ai < 2; ++ai)
#pragma unroll
                for (int bj = 0; bj < 2; ++bj)
#pragma unroll
                    for (int m = 0; m < 4; ++m) { acc[ai][bj][m][0] = acc[ai][bj][m][0] * QSCALE; acc[ai][bj][m][1] = acc[ai][bj][m][1] * QSCALE; } }
#pragma unroll
        for (int ai = 0; ai < 2; ++ai)
#pragma unroll
            for (int m = 0; m < 4; ++m) { bf16_t* rowp = O + (size_t)(row0 + ai * HALF + m * 16) * DIN + pn * BM + wc * 64;
#pragma unroll
                for (int bj = 0; bj < 2; ++bj) { const f32x4 v0 = acc[ai][bj][m][0], v1 = acc[ai][bj][m][1];
                    u32x4 w; w.x = pkbf(v0[0], v0[1]); w.y = pkbf(v0[2], v0[3]); w.z = pkbf(v1[0], v1[1]); w.w = pkbf(v1[2], v1[3]);
                    *(u32x4*)(rowp + (2 * fq + bj) * 8) = w; } }
    }
};
struct EpiF8 {
    static constexpr bool PERM = true, AFTER_DRAIN = false;
    unsigned char* O; int ldc;
    DEVFN void operator()(f32x4 (&acc)[2][2][4][2], const Unit& u, int wr, int wc, int fr, int fq) const {
#pragma unroll
        for (int ai = 0; ai < 2; ++ai)
#pragma unroll
            for (int m = 0; m < 4; ++m) { unsigned char* rowp = O + (size_t)(u.pm * BM + ai * HALF + wr * 64 + m * 16 + fr) * ldc + u.pn * BM + wc * 64 + fq * 16;
                const f32x4 a0 = acc[ai][0][m][0], a1 = acc[ai][0][m][1], b0 = acc[ai][1][m][0], b1 = acc[ai][1][m][1];
                u32x4 w; w.x = pk4_fp8(a0[0], a0[1], a0[2], a0[3]); w.y = pk4_fp8(a1[0], a1[1], a1[2], a1[3]); w.z = pk4_fp8(b0[0], b0[1], b0[2], b0[3]); w.w = pk4_fp8(b1[0], b1[1], b1[2], b1[3]);
                *(u32x4*)rowp = w; }
    }
};
struct MoeUnit { int pm, pn, cls, j, cnt; };
struct MoeBase {
    const PG8_LAS int* tp; const PG8_LAS int* cnt; const PG8_LAS int* tcls; int nunits, G, c, npn_shift;
    DEVFN bool next_(int i, MoeUnit& u) const {
        const int L = i * G + c; if (L >= nunits) return false;
        u.pm = L >> npn_shift; u.pn = L & ((1 << npn_shift) - 1);
        const int cls = __builtin_amdgcn_readfirstlane(tcls[u.pm]);
        u.cls = cls; u.j = u.pm - __builtin_amdgcn_readfirstlane(tp[cls]); u.cnt = __builtin_amdgcn_readfirstlane(cnt[cls]); return true; }
};
DEVFN void moe_experts(int cls, int& e1, int& e2) { const int g = cls / 6, p = cls % 6; const int lo = p < 3 ? 0 : (p < 5 ? 1 : 2), hi = p < 3 ? p + 1 : (p < 5 ? p - 1 : 3); e1 = g * 4 + lo; e2 = g * 4 + hi; }
struct GateUpSched : MoeBase {
    typedef MoeUnit UnitT;
    const char* HB; const int* list; const char* W;
    DEVFN bool next(int i, MoeUnit& u) const { return next_(i, u); }
    DEVFN const char* aptr(const MoeUnit&) const { return HB; }
    DEVFN void arows(const MoeUnit& u, const int tid_, unsigned (&v)[2][2]) const {
        int R[2], C[2]; { int t_ = tid_; asm volatile("" : "+v"(t_)); stage_rc(t_ * 16, R[0], C[0]); stage_rc(t_ * 16 + 8192, R[1], C[1]); }
#pragma unroll
        for (int h = 0; h < 2; ++h)
#pragma unroll
            for (int i = 0; i < 2; ++i) { const int li = 256 * u.j + h * HALF + R[i]; const int tok = list[(size_t)u.cls * LISTCAP + (li < u.cnt ? li : 256 * u.j)]; v[h][i] = (unsigned)(tok * DM + C[i] * 2); } }
    DEVFN const char* bptr(const MoeUnit& u) const { int e1, e2; moe_experts(u.cls, e1, e2); return W + (size_t)(u.pn < 4 ? e1 : e2) * DM * DM + (size_t)(u.pn & 3) * BM * DM; }
    DEVFN const char* bptr2(const MoeUnit& u) const { return bptr(u); }
};
struct DownSched : MoeBase {
    typedef MoeUnit UnitT;
    const char* ACT; const char* W;
    DEVFN bool next(int i, MoeUnit& u) const { return next_(i, u); }
    DEVFN const char* aptr(const MoeUnit&) const { return ACT; }
    DEVFN void arows(const MoeUnit& u, const int tid_, unsigned (&v)[2][2]) const {
        int R[2], C[2]; { int t_ = tid_; asm volatile("" : "+v"(t_)); stage_rc(t_ * 16, R[0], C[0]); stage_rc(t_ * 16 + 8192, R[1], C[1]); }
#pragma unroll
        for (int h = 0; h < 2; ++h)
#pragma unroll
            for (int i = 0; i < 2; ++i) v[h][i] = (unsigned)((u.pm * BM + h * HALF + R[i]) * DM + C[i] * 2); }
    DEVFN const char* bptr(const MoeUnit& u) const { int e1, e2; moe_experts(u.cls, e1, e2); return W + (size_t)e1 * DM * DE + (size_t)u.pn * BM * DE; }
    DEVFN const char* bptr2(const MoeUnit& u) const { int e1, e2; moe_experts(u.cls, e1, e2); return W + (size_t)e2 * DM * DE + (size_t)u.pn * BM * DE; }
};
struct EpiGateUp {
    static constexpr bool PERM = true, AFTER_DRAIN = false;
    unsigned char* ACT; const float* rw;
    DEVFN void operator()(f32x4 (&acc)[2][2][4][2], const MoeUnit& u, int wr, int wc, int fr, int fq) const {
        const int half = u.pn >> 2, jt = u.pn & 3;
        float wg8[2][4];
#pragma unroll
        for (int ai = 0; ai < 2; ++ai)
#pragma unroll
            for (int m = 0; m < 4; ++m) { const int li = 256 * u.j + ai * HALF + wr * 64 + m * 16 + fr; wg8[ai][m] = rw[((size_t)u.cls * LISTCAP + (li < u.cnt ? li : 256 * u.j)) * 2 + half]; }
#pragma unroll
        for (int ai = 0; ai < 2; ++ai)
#pragma unroll
            for (int mp = 0; mp < 4; mp += 2) {
                u32x2 w2[2];
#pragma unroll
                for (int q = 0; q < 2; ++q) { const int m = mp + q; const int li = 256 * u.j + ai * HALF + wr * 64 + m * 16 + fr;
                    const float wgt = li < u.cnt ? 8.f * wg8[ai][m] : 0.f;
                    f32x4 o[2];
#pragma unroll
                    for (int n = 0; n < 2; ++n) {
                        const f32x4 g = acc[ai][0][m][n], t = g * (-1.4426950408889634f);
                        f32x4 d; d.x = __builtin_amdgcn_exp2f(t.x); d.y = __builtin_amdgcn_exp2f(t.y); d.z = __builtin_amdgcn_exp2f(t.z); d.w = __builtin_amdgcn_exp2f(t.w);
                        d = d + 1.f;
                        f32x4 r; r.x = __builtin_amdgcn_rcpf(d.x); r.y = __builtin_amdgcn_rcpf(d.y); r.z = __builtin_amdgcn_rcpf(d.z); r.w = __builtin_amdgcn_rcpf(d.w);
                        o[n] = (g * r) * (acc[ai][1][m][n] * wgt); }
                    w2[q].x = pk4_fp8(o[0][0], o[0][1], o[0][2], o[0][3]); w2[q].y = pk4_fp8(o[1][0], o[1][1], o[1][2], o[1][3]); }
                const auto s0 = __builtin_amdgcn_permlane16_swap(w2[0].x, w2[1].x, false, false), s1 = __builtin_amdgcn_permlane16_swap(w2[0].y, w2[1].y, false, false);
                const u32x4 w = {s0[0], s1[0], s0[1], s1[1]};
                const int lr = ai * HALF + wr * 64 + (mp + (fq & 1)) * 16 + fr;
                *(u32x4*)(ACT + (size_t)(u.pm * BM + lr) * DM + half * 512 + jt * 128 + wc * 32 + (fq & 2) * 8) = w; }
    }
};
struct EpiDown {
    static constexpr bool PERM = true, AFTER_DRAIN = false;
    unsigned char* Y2; const int* list;
    DEVFN void operator()(f32x4 (&acc)[2][2][4][2], const MoeUnit& u, int wr, int wc, int fr, int fq_) const {
        int fq = fq_; asm volatile("" : "+v"(fq));
        int tk8[2][4];
#pragma unroll
        for (int ai = 0; ai < 2; ++ai)
#pragma unroll
            for (int m = 0; m < 4; ++m) { const int li = 256 * u.j + ai * HALF + wr * 64 + m * 16 + fr; tk8[ai][m] = list[(size_t)u.cls * LISTCAP + (li < u.cnt ? li : 256 * u.j)]; }
#pragma unroll
        for (int ai = 0; ai < 2; ++ai)
#pragma unroll
            for (int m = 0; m < 4; ++m) { const int li = 256 * u.j + ai * HALF + wr * 64 + m * 16 + fr;
                if (li < u.cnt) { const int tok = tk8[ai][m]; unsigned char* rowp = Y2 + (size_t)tok * DM + u.pn * BM + wc * 64 + fq * 16;
                    const f32x4 a0 = acc[ai][0][m][0], a1 = acc[ai][0][m][1], b0 = acc[ai][1][m][0], b1 = acc[ai][1][m][1];
                    u32x4 w; w.x = pk4_fp8(a0[0], a0[1], a0[2], a0[3]); w.y = pk4_fp8(a1[0], a1[1], a1[2], a1[3]); w.z = pk4_fp8(b0[0], b0[1], b0[2], b0[3]); w.w = pk4_fp8(b1[0], b1[1], b1[2], b1[3]);
                    *(u32x4*)rowp = w; } }
    }
};
}

#include <hip/hip_bf16.h>
#include <cmath>
namespace attn_body {
using bf16=__hip_bfloat16;
using bf16x8=__attribute__((ext_vector_type(8)))short;
using s16x4=__attribute__((ext_vector_type(4)))short;
using f32x16=__attribute__((ext_vector_type(16)))float;
using u32x4=__attribute__((ext_vector_type(4)))unsigned;
constexpr int BATCH=16,NHEAD=8,SEQ=2048,D=64,QP=2048,OP=1024;
constexpr int NW=8,QBLK=32,QB=QBLK*NW,KVBLK=64,NQB=SEQ/QB;
constexpr int ATTN_PITCH=QP, ATTN_UNIT_ROWS=QB;
__device__ __forceinline__ int crow(int r,int hi){return (r&3)+8*(r>>2)+4*hi;}
#define SBAR() __builtin_amdgcn_sched_barrier(0)
__device__ __forceinline__ void cmask(f32x16&p0,f32x16&p1,int jb,int qrel,int hi){
  const float NEG=-INFINITY; int kb=64*jb+4*hi;
  #pragma unroll
  for(int r=0;r<16;++r){int kv=kb+(r&3)+8*(r>>2); if(kv>qrel)p0[r]=NEG; if(kv+32>qrel)p1[r]=NEG;}
}

constexpr int NSLOT=3, SLOTB=8192;
constexpr int LDS_K=0, LDS_V=NSLOT*SLOTB, LDS_WS=2*NSLOT*SLOTB, LDS_OST=LDS_WS+NW*64*4, LDS_KBAR=LDS_OST+NW*4096, LDS_BYTES=LDS_KBAR+2048;
constexpr float NEGBIG=-1.0e30f; typedef float f32x4_t __attribute__((ext_vector_type(4)));
__device__ __forceinline__ float bfs(short v){return __uint_as_float(((unsigned)(unsigned short)v)<<16);}
constexpr float C2=0.125f*1.4426950408889634f;
__device__ __forceinline__ void glds16(const void*gsrc,unsigned lds_dst){unsigned keep;
  asm volatile("s_mov_b32 %0, m0\n\ts_mov_b32 m0, %2\n\ts_nop 0\n\tglobal_load_lds_dwordx4 %1, off\n\ts_mov_b32 m0, %0":"=&s"(keep):"v"(gsrc),"s"(lds_dst):"memory");}
__device__ __forceinline__ float max3f(float a,float b,float c){float r;asm("v_max3_f32 %0, %1, %2, %3":"=v"(r):"v"(a),"v"(b),"v"(c));return r;}
__device__ __forceinline__ float max2f(float a,float b){float r;asm("v_max_f32_e32 %0, %1, %2":"=v"(r):"v"(a),"v"(b));return r;}
__device__ __forceinline__ float fadd_s(float a,float b){float r;asm("v_add_f32_e32 %0, %1, %2":"=v"(r):"v"(a),"v"(b));return r;}
__device__ __forceinline__ float fsub_s(float a,float b){float r;asm("v_sub_f32_e32 %0, %1, %2":"=v"(r):"v"(a),"v"(b));return r;}
typedef float f32x2_t __attribute__((ext_vector_type(2))); typedef __bf16 bf16x2_t __attribute__((ext_vector_type(2)));
__device__ __forceinline__ unsigned cvtpk_s(float lo,float hi){f32x2_t v={lo,hi};bf16x2_t b=__builtin_convertvector(v,bf16x2_t);return __builtin_bit_cast(unsigned,b);}
#define WAIT_BAR(N) asm volatile("s_waitcnt vmcnt(" #N ") lgkmcnt(0)\n\ts_barrier":::"memory")

__device__ __forceinline__ void qkt(f32x16&p0,f32x16&p1,const char*Kslot,const bf16x8*qr,const f32x16&negm,int r32,int hi){
  const char*kb=Kslot+hi*1024+r32*16;
  #pragma unroll
  for(int d0=0;d0<4;++d0){
    const bf16x8 b0=*reinterpret_cast<const bf16x8*>(kb+d0*2048);
    const bf16x8 b1=*reinterpret_cast<const bf16x8*>(kb+d0*2048+512);
    if(d0==0){p0=__builtin_amdgcn_mfma_f32_32x32x16_bf16(b0,qr[0],negm,0,0,0);p1=__builtin_amdgcn_mfma_f32_32x32x16_bf16(b1,qr[0],negm,0,0,0);}
    else{p0=__builtin_amdgcn_mfma_f32_32x32x16_bf16(b0,qr[d0],p0,0,0,0);p1=__builtin_amdgcn_mfma_f32_32x32x16_bf16(b1,qr[d0],p1,0,0,0);}}
}
typedef __attribute__((address_space(3))) const char* lds_cptr;
typedef short v4i16_t __attribute__((ext_vector_type(4)));
__device__ __forceinline__ void kload8(bf16x8*kf,lds_cptr kp){
  kf[0]=*(const __attribute__((address_space(3))) bf16x8*)(kp);      kf[1]=*(const __attribute__((address_space(3))) bf16x8*)(kp+512);
  kf[2]=*(const __attribute__((address_space(3))) bf16x8*)(kp+2048); kf[3]=*(const __attribute__((address_space(3))) bf16x8*)(kp+2560);
  kf[4]=*(const __attribute__((address_space(3))) bf16x8*)(kp+4096); kf[5]=*(const __attribute__((address_space(3))) bf16x8*)(kp+4608);
  kf[6]=*(const __attribute__((address_space(3))) bf16x8*)(kp+6144); kf[7]=*(const __attribute__((address_space(3))) bf16x8*)(kp+6656);
}
__device__ __forceinline__ void kload2(bf16x8*kf,lds_cptr kp,int j){ kf[2*j]=*(const __attribute__((address_space(3))) bf16x8*)(kp+j*2048); kf[2*j+1]=*(const __attribute__((address_space(3))) bf16x8*)(kp+j*2048+512); }
__device__ __forceinline__ s16x4 vtr(lds_cptr p){ return __builtin_bit_cast(s16x4,__builtin_amdgcn_ds_read_tr16_b64_v4i16((__attribute__((address_space(3))) v4i16_t*)p)); }
__device__ __forceinline__ float rowmax(const f32x16&p0,const f32x16&p1){
  float a=max3f(p0[0],p0[1],p1[0]),b=max3f(p0[2],p0[3],p1[1]);a=max3f(a,p1[2],p1[3]);
  #pragma unroll
  for(int r=4;r<16;r+=4){a=max3f(a,p0[r],p0[r+1]);b=max3f(b,p0[r+2],p0[r+3]);a=max3f(a,p1[r],p1[r+1]);b=max3f(b,p1[r+2],p1[r+3]);}
  const float m=max2f(a,b);
  auto rr=__builtin_amdgcn_permlane32_swap(__float_as_uint(m),__float_as_uint(m),false,false);
  return max2f(__uint_as_float(rr[0]),__uint_as_float(rr[1]));
}
__device__ __forceinline__ void pv(f32x16*o,int vb,bf16x8 pa0,bf16x8 pa1,bf16x8 pa2,bf16x8 pa3){
  #pragma unroll
  for(int d0=0;d0<2;++d0){s16x4 lo[4],hi[4];
    #pragma unroll
    for(int ks=0;ks<4;++ks){
      asm volatile("ds_read_b64_tr_b16 %0,%1 offset:%c2":"=&v"(lo[ks]):"v"(vb),"i"(d0*4096+ks*1024):"memory");
      asm volatile("ds_read_b64_tr_b16 %0,%1 offset:%c2":"=&v"(hi[ks]):"v"(vb),"i"(d0*4096+ks*1024+512):"memory");}
    asm volatile("s_waitcnt lgkmcnt(0)":::"memory");SBAR();
    #define PK(k) (bf16x8){lo[k][0],lo[k][1],lo[k][2],lo[k][3],hi[k][0],hi[k][1],hi[k][2],hi[k][3]}
    o[d0]=__builtin_amdgcn_mfma_f32_32x32x16_bf16(pa0,PK(0),o[d0],0,0,0);
    o[d0]=__builtin_amdgcn_mfma_f32_32x32x16_bf16(pa1,PK(1),o[d0],0,0,0);
    o[d0]=__builtin_amdgcn_mfma_f32_32x32x16_bf16(pa2,PK(2),o[d0],0,0,0);
    o[d0]=__builtin_amdgcn_mfma_f32_32x32x16_bf16(pa3,PK(3),o[d0],0,0,0);
    #undef PK
  }
}

#ifndef ATTN_STORE16
#define ATTN_STORE16(p,v) (*(u32x4*)(p)=(v))
#endif
template<int THRL> __device__ __forceinline__ void attn_unit(int b,int h,int qb,const bf16*Q,const bf16*__restrict__ K,const bf16*__restrict__ V,bf16*O,const float*__restrict__ kbar,char*shm,const int tid){
  const int lane=tid&63,r32=lane&31,hi=lane>>5; const int wid=__builtin_amdgcn_readfirstlane(tid>>6);
  float kbv=0.f; { int tk=tid; asm volatile("":"+v"(tk)); if(qb>=4&&tk<448)kbv=kbar[tk]; }
  const long rowbase=(long)b*SEQ; const int q0=qb*QB;
  const bf16*Qw=Q+(rowbase+q0+wid*QBLK)*QP+h*D;
  const bf16*Kh=K+rowbase*QP+h*D,*Vh=V+rowbase*QP+h*D;
  const unsigned lds0=(unsigned)(uintptr_t)shm;
  float*wsf=(float*)(shm+LDS_WS)+wid*64;
  const bf16*ksrc=Kh+(long)lane*QP+wid*8;
  const bf16*vsrc=Vh+(long)(16*(wid&3)+(lane>>2))*QP+(wid>>2)*32+(lane&3)*8;
  const unsigned kdst=lds0+LDS_K+wid*1024, vdst=lds0+LDS_V+wid*1024;
  #define DMA_K(t,slot) glds16(ksrc+(long)(t)*KVBLK*QP,(unsigned)__builtin_amdgcn_readfirstlane(kdst+(slot)))
  #define DMA_V(t,slot) glds16(vsrc+(long)(t)*KVBLK*QP,(unsigned)__builtin_amdgcn_readfirstlane(vdst+(slot)))
  const int vb0=(int)(lds0+LDS_V)+((lane>>4)&1)*32+(lane&3)*8+(4*hi+((lane&15)>>2))*64;
  const char*Kbase=shm+LDS_K; bf16x8 kf[8];
  const lds_cptr shm3=(lds_cptr)shm; const lds_cptr kp0=shm3+LDS_K+hi*1024+r32*16; const lds_cptr vp0=shm3+LDS_V+((lane>>4)&1)*32+(lane&3)*8+(4*hi+((lane&15)>>2))*64;
  const int NT=(q0+QB)/KVBLK;
  DMA_K(0,0);DMA_V(0,0);DMA_K(1,SLOTB);
  bf16x8 qr[4];
  #pragma unroll
  for(int d0=0;d0<4;++d0)qr[d0]=*reinterpret_cast<const bf16x8*>(&Qw[(long)r32*QP+d0*16+hi*8]);
  float mhat=0.f,l_reg=0.f;f32x16 o[2];o[0]=f32x16{};o[1]=f32x16{};f32x16 negm=f32x16{};asm volatile("":"+v"(negm));
  const int qrel=wid*QBLK+r32;
  #define CMASK(P0,P1,t) do{int jb_=(t)-(NT-4); if(jb_>=0)cmask(P0,P1,jb_,qrel,hi);}while(0)
  bool resc=false;
  #define START(P0,P1) do{ const float rm=rowmax(P0,P1); resc=false; \
    { const float dl=selcur?rm:-64.f; mhat=fadd_s(mhat,dl); \
      _Pragma("unroll") for(int r=0;r<16;++r){P0[r]=fsub_s(P0[r],dl);P1[r]=fsub_s(P1[r],dl);} \
      { const float nv_=selcur?-mhat:NEGBIG; _Pragma("unroll") for(int r=0;r<16;++r)negm[r]=nv_; } asm volatile("":"+v"(negm)); } \
    _Pragma("unroll") for(int r=0;r<16;++r)P0[r]=__builtin_amdgcn_exp2f(P0[r]); }while(0)
  #define RESC() do{ if(resc){ asm volatile("s_waitcnt lgkmcnt(0)":::"memory"); \
      _Pragma("unroll") for(int d_=0;d_<2;++d_) _Pragma("unroll") for(int r=0;r<16;++r)o[d_][r]*=wsf[crow(r,hi)]; } }while(0)
  f32x16 pA0,pA1,pB0,pB1;
  int sl_prev=0,sl_cur=0,sl_next=SLOTB;
  #define ROT() do{sl_prev=sl_cur;sl_cur=sl_next;sl_next=(sl_next==(NSLOT-1)*SLOTB)?0:sl_next+SLOTB;}while(0)
  DMA_K(2,2*SLOTB);
  if(qb>=4){ if(tid<448){ const unsigned hb=__builtin_bit_cast(unsigned,kbv); const unsigned hr=(hb+0x7fffu+((hb>>16)&1u))&0xffff0000u; const float lo_=kbv-__builtin_bit_cast(float,hr); const unsigned lb=__builtin_bit_cast(unsigned,lo_);
      ((unsigned short*)(shm+LDS_KBAR))[tid]=(unsigned short)(hr>>16); ((unsigned short*)(shm+LDS_KBAR+1024))[tid]=(unsigned short)((lb+0x7fffu+((lb>>16)&1u))>>16); } }
  WAIT_BAR(3);
  unsigned bmask=(1u<<(qb+1))-1u;
  if(qb>=4){ float gsc[8];
    { const lds_cptr kb3=shm3+LDS_KBAR+(r32&7)*128+hi*16; f32x16 g=f32x16{};
      _Pragma("unroll") for(int d0=0;d0<4;++d0){ const bf16x8 ah=*(const __attribute__((address_space(3))) bf16x8*)(kb3+d0*32), al=*(const __attribute__((address_space(3))) bf16x8*)(kb3+1024+d0*32);
        g=__builtin_amdgcn_mfma_f32_32x32x16_bf16(ah,qr[d0],g,0,0,0); g=__builtin_amdgcn_mfma_f32_32x32x16_bf16(al,qr[d0],g,0,0,0); }
      _Pragma("unroll") for(int r=0;r<4;++r){ auto rr=__builtin_amdgcn_permlane32_swap(__float_as_uint(g[r]),__float_as_uint(g[r]),false,false); gsc[r]=__uint_as_float(rr[0]); gsc[4+r]=__uint_as_float(rr[1]); } }
    _Pragma("unroll") for(int n=0;n<7;++n) gsc[n]=(n<qb)?gsc[n]:-3.0e38f;
    bmask=1u<<qb;
    _Pragma("unroll") for(int pick=0;pick<3;++pick){ float best=-3.4e38f; unsigned bi=0u;
      _Pragma("unroll") for(int n=0;n<7;++n){ const bool ok=!((bmask>>n)&1u)&&gsc[n]>best; best=ok?gsc[n]:best; bi=ok?(unsigned)n:bi; }
      bmask|=1u<<bi; } }
  bool selcur=(bmask&1u)!=0u;
  { const float nv=selcur?0.f:NEGBIG; _Pragma("unroll") for(int r=0;r<16;++r)negm[r]=nv; asm volatile("":"+v"(negm)); }
  qkt(pA0,pA1,Kbase,qr,negm,r32,hi);asm volatile("s_nop 15\n\ts_nop 7":"+v"(pA0),"+v"(pA1));CMASK(pA0,pA1,0);
  START(pA0,pA1);
  _Pragma("unroll") for(int r=0;r<16;++r)pA1[r]=__builtin_amdgcn_exp2f(pA1[r]);
  WAIT_BAR(0);
  DMA_K(3,0);DMA_V(1,SLOTB);
  ROT();
  kload8(kf,kp0+sl_cur);
  WAIT_BAR(2);
  s16x4 vlo[8],vhi[8]; u32x4 pw0,pw1,pw2,pw3;
  #define PKW(P,B) cvtpk_s(P[B],P[B+1])
  #define PAF(k) __builtin_bit_cast(bf16x8,pw##k)
  #define VFR(i) (bf16x8){vlo[i][0],vlo[i][1],vlo[i][2],vlo[i][3],vhi[i][0],vhi[i][1],vhi[i][2],vhi[i][3]}
  #define PIN(x) asm volatile("":"+v"(x))
  #define MX3(a,b,c) __builtin_fmaxf(__builtin_fmaxf((a),(b)),(c))
  #define GAPA(MF,A0,A1,A2,A3,W0,W1,PW) do{ MF; sacc+=A0; sacc+=A1; sacc+=A2; sacc+=A3; PIN(sacc); W0; W1; PIN(PW); SBAR(); }while(0)
  #define EX(v) __builtin_amdgcn_exp2f(v)
  #define GAPB(MF,X,B) do{ MF; X[B]=EX(X[B]); X[B+1]=EX(X[B+1]); X[B+2]=EX(X[B+2]); X[B+3]=EX(X[B+3]); PIN(X); SBAR(); }while(0)
  #define VRD(i) do{ vlo[i]=vtr(vp_+(((i)>>2)*4096+((i)&3)*1024)); vhi[i]=vtr(vp_+(((i)>>2)*4096+((i)&3)*1024+512)); }while(0)
  #define KRD(G,j) do{ if(G){ kload2(kf,kp0+sl_next,j); SBAR(); } }while(0)
  #define STEP(C0,C1,P0,P1,t,GK,GV,GL) do{ SBAR(); \
    const lds_cptr vp_=vp0+sl_prev; \
    VRD(0); SBAR(); float sacc=(P0[0]+P0[1]); \
    GAPA(C0=__builtin_amdgcn_mfma_f32_32x32x16_bf16(kf[0],qr[0],negm,0,0,0), P0[2],P0[3],P0[4],P0[5],     pw0[0]=PKW(P0,0), pw0[1]=PKW(P0,2), pw0); \
    VRD(4); SBAR(); GAPA(C1=__builtin_amdgcn_mfma_f32_32x32x16_bf16(kf[1],qr[0],negm,0,0,0), P0[6],P0[7],P0[8],P0[9],     pw0[2]=PKW(P0,4), pw0[3]=PKW(P0,6), pw0); \
    VRD(1); SBAR(); GAPA(C0=__builtin_amdgcn_mfma_f32_32x32x16_bf16(kf[2],qr[1],C0,0,0,0),   P0[10],P0[11],P0[12],P0[13], pw1[0]=PKW(P0,8), pw1[1]=PKW(P0,10), pw1); \
    VRD(5); SBAR(); GAPA(C1=__builtin_amdgcn_mfma_f32_32x32x16_bf16(kf[3],qr[1],C1,0,0,0),   P0[14],P0[15],P1[0],P1[1],   pw1[2]=PKW(P0,12),pw1[3]=PKW(P0,14), pw1); \
    VRD(2); SBAR(); GAPA(C0=__builtin_amdgcn_mfma_f32_32x32x16_bf16(kf[4],qr[2],C0,0,0,0),   P1[2],P1[3],P1[4],P1[5],     pw2[0]=PKW(P1,0), pw2[1]=PKW(P1,2), pw2); \
    VRD(6); SBAR(); GAPA(C1=__builtin_amdgcn_mfma_f32_32x32x16_bf16(kf[5],qr[2],C1,0,0,0),   P1[6],P1[7],P1[8],P1[9],     pw2[2]=PKW(P1,4), pw2[3]=PKW(P1,6), pw2); \
    VRD(3); SBAR(); GAPA(C0=__builtin_amdgcn_mfma_f32_32x32x16_bf16(kf[6],qr[3],C0,0,0,0),   P1[10],P1[11],P1[12],P1[13], pw3[0]=PKW(P1,8), pw3[1]=PKW(P1,10), pw3); \
    VRD(7); SBAR(); GAPA(C1=__builtin_amdgcn_mfma_f32_32x32x16_bf16(kf[7],qr[3],C1,0,0,0),   P1[14],P1[15],0.f,0.f,       pw3[2]=PKW(P1,12),pw3[3]=PKW(P1,14), pw3); \
    l_reg+=sacc; \
    if(GK){DMA_K((t)+3,sl_cur);} if(GV){DMA_V((t)+1,sl_next);} \
    CMASK(C0,C1,t); \
    { float a=MX3(C0[0],C0[1],C1[0]),b=MX3(C0[2],C0[3],C1[1]); a=MX3(a,C1[2],C1[3]); \
      _Pragma("unroll") for(int r=4;r<16;r+=4){a=MX3(a,C0[r],C0[r+1]);b=MX3(b,C0[r+2],C0[r+3]);a=MX3(a,C1[r],C1[r+1]);b=MX3(b,C1[r+2],C1[r+3]);} \
      float rm=__builtin_fmaxf(a,b); { auto rr=__builtin_amdgcn_permlane32_swap(__float_as_uint(rm),__float_as_uint(rm),false,false); rm=__builtin_fmaxf(__uint_as_float(rr[0]),__uint_as_float(rr[1])); } \
      resc=false; \
      if(__builtin_expect(__any(rm>(float)THRL),0)){ const float dl=__builtin_fmaxf(rm,0.f); mhat+=dl; \
        _Pragma("unroll") for(int r=0;r<16;++r){C0[r]-=dl;C1[r]-=dl;} \
        { const float nv_=selcur?-mhat:NEGBIG; _Pragma("unroll") for(int r=0;r<16;++r)negm[r]=nv_; } asm volatile("":"+v"(negm)); \
        const float f=__builtin_amdgcn_exp2f(-dl); l_reg*=f; if(hi==0)wsf[r32]=f; resc=true; } } \
    SBAR(); \
    GAPB(o[0]=__builtin_amdgcn_mfma_f32_32x32x16_bf16(PAF(0),VFR(0),o[0],0,0,0), C0,0); \
    GAPB(o[1]=__builtin_amdgcn_mfma_f32_32x32x16_bf16(PAF(0),VFR(4),o[1],0,0,0), C0,4); \
    KRD(GL,0); GAPB(o[0]=__builtin_amdgcn_mfma_f32_32x32x16_bf16(PAF(1),VFR(1),o[0],0,0,0), C0,8); \
    KRD(GL,1); GAPB(o[1]=__builtin_amdgcn_mfma_f32_32x32x16_bf16(PAF(1),VFR(5),o[1],0,0,0), C0,12); \
    KRD(GL,2); GAPB(o[0]=__builtin_amdgcn_mfma_f32_32x32x16_bf16(PAF(2),VFR(2),o[0],0,0,0), C1,0); \
    KRD(GL,3); GAPB(o[1]=__builtin_amdgcn_mfma_f32_32x32x16_bf16(PAF(2),VFR(6),o[1],0,0,0), C1,4); \
    GAPB(o[0]=__builtin_amdgcn_mfma_f32_32x32x16_bf16(PAF(3),VFR(3),o[0],0,0,0), C1,8); \
    GAPB(o[1]=__builtin_amdgcn_mfma_f32_32x32x16_bf16(PAF(3),VFR(7),o[1],0,0,0), C1,12); \
    }while(0)
  #define BLKSEL(tt) do{ if((((tt))&3)==0){ selcur=((bmask>>((tt)>>2))&1u)!=0u; const float nv_=selcur?-mhat:NEGBIG; _Pragma("unroll") for(int r=0;r<16;++r)negm[r]=nv_; asm volatile("":"+v"(negm)); } }while(0)
  int t=1;
  #undef CMASK
  #define CMASK(P0,P1,t) do{}while(0)
  for(;t+5<NT;t+=2){
    STEP(pB0,pB1,pA0,pA1,t,true,true,true);     WAIT_BAR(2); RESC(); ROT(); BLKSEL(t+1);
    STEP(pA0,pA1,pB0,pB1,t+1,true,true,true);   WAIT_BAR(2); RESC(); ROT();
  }
  #undef CMASK
  #define CMASK(P0,P1,t) do{int jb_=(t)-(NT-4); if(jb_>=0)cmask(P0,P1,jb_,qrel,hi);}while(0)
  #define ENDW(tt) do{ if((tt)+3<NT){WAIT_BAR(2);} else if((tt)+2<NT){WAIT_BAR(1);} else {WAIT_BAR(0);} }while(0)
  for(;t+1<NT;t+=2){
    STEP(pB0,pB1,pA0,pA1,t,(t+3<NT),(t+1<NT),(t+1<NT));       ENDW(t);   RESC(); ROT(); BLKSEL(t+1);
    STEP(pA0,pA1,pB0,pB1,t+1,(t+4<NT),(t+2<NT),(t+2<NT));     ENDW(t+1); RESC(); ROT();
  }
  STEP(pB0,pB1,pA0,pA1,NT-1,false,false,false); RESC();
  { float sacc=pB0[0]+pB0[1]; _Pragma("unroll") for(int r=2;r<16;++r)sacc+=pB0[r]; _Pragma("unroll") for(int r=0;r<16;++r)sacc+=pB1[r]; l_reg+=sacc;
    pw0=(u32x4){PKW(pB0,0),PKW(pB0,2),PKW(pB0,4),PKW(pB0,6)};pw1=(u32x4){PKW(pB0,8),PKW(pB0,10),PKW(pB0,12),PKW(pB0,14)};pw2=(u32x4){PKW(pB1,0),PKW(pB1,2),PKW(pB1,4),PKW(pB1,6)};pw3=(u32x4){PKW(pB1,8),PKW(pB1,10),PKW(pB1,12),PKW(pB1,14)};
    SBAR(); pv(o,vb0+sl_cur,PAF(0),PAF(1),PAF(2),PAF(3)); }
  #undef PKW
  #undef PAF
  #undef VFR
  #undef PIN
  #undef MX3
  #undef GAPA
  #undef GAPB
  #undef EX
  #undef VRD
  #undef KRD
  #undef STEP
  #undef ENDW
  {auto rr=__builtin_amdgcn_permlane32_swap(__float_as_uint(l_reg),__float_as_uint(l_reg),false,false);l_reg=__uint_as_float(rr[0])+__uint_as_float(rr[1]);}
  if(hi==0)wsf[32+r32]=l_reg;asm volatile("s_waitcnt lgkmcnt(0)":::"memory");
  float rli[16];
  #pragma unroll
  for(int r=0;r<16;++r)rli[r]=__builtin_amdgcn_rcpf(wsf[32+crow(r,hi)]);
  unsigned char*Ow=(unsigned char*)O+(rowbase+q0+wid*QBLK)*OP+h*D;
  { unsigned char*stg=(unsigned char*)(shm+LDS_OST)+wid*4096;
    #pragma unroll
    for(int r=0;r<16;++r){const int orow=crow(r,hi);
      #pragma unroll
      for(int d0=0;d0<2;++d0){const float ov=__builtin_amdgcn_fmed3f(o[d0][r]*rli[r]*32.f,-448.f,448.f); stg[orow*64+d0*32+r32]=(unsigned char)__builtin_amdgcn_cvt_pk_fp8_f32(ov,ov,0,false);}}
    asm volatile("s_waitcnt lgkmcnt(0)":::"memory");
    #pragma unroll
    for(int i=0;i<2;++i){const int row=i*16+(lane>>2),ch=lane&3; const u32x4 v=*(const u32x4*)(stg+row*64+ch*16); ATTN_STORE16(Ow+(long)row*OP+ch*16,v);} }
  asm volatile("s_waitcnt lgkmcnt(0)\n\ts_barrier":::"memory");
  #undef BLKSEL
  #undef DMA_K
  #undef DMA_V
  #undef CMASK
  #undef START
  #undef RESC
  #undef ROT
}
constexpr int ATTN_LDS_BYTES=LDS_BYTES;
struct AttnTensors { const bf16* Q; const bf16* K; const bf16* V; bf16* O; const float* kbar; };
struct AttnUnit { int bh; int qb; };
struct StaticOrder {
  int vcu, G;
  __device__ __forceinline__ explicit StaticOrder(int grid,int block):vcu((grid%8==0)?(block%8)*(grid/8)+block/8:block),G(grid){}
  __device__ __forceinline__ bool next(int i,AttnUnit&u)const{ const int pr=(vcu+(i>>2)*G)*2+((i>>1)&1); if(pr>=BATCH*NHEAD*4)return false;
    const int s=pr&3; u.bh=pr>>2; u.qb=(i&1)?7-s:s; return true; }
  __device__ __forceinline__ void a_ready(const AttnUnit&)const{}
  __device__ __forceinline__ void done(const AttnUnit&)const{}
};
template<class Sched,int THRL=8> __device__ __forceinline__ void attn_phase(char*lds,const AttnTensors&T,const Sched&S,const int tid_in){
  AttnUnit u; int tid_=tid_in; asm volatile("":"+v"(tid_));
  for(int i=0;S.next(i,u);++i){ S.a_ready(u); attn_unit<THRL>(u.bh/NHEAD,u.bh%NHEAD,u.qb,T.Q,T.K,T.V,T.O,T.kbar+(long)u.bh*512,lds,tid_); S.done(u); }
}
#undef SBAR
#undef WAIT_BAR
}

#define XB_TMO      128
#define XB_XCNT(j)  (256  + 64 * (j))
#define XB_XSUB(j)  (1280 + 64 * (j))
#define XB_XGEN(j)  (2304 + 64 * (j))
#define XB_TOP      3328
#define XB_TOPGEN   3392
#define XCD_BAR_WORDS 3456
#define XB_SPIN_CAP (1u << 18)

__device__ __forceinline__ unsigned xb_ld(unsigned* p)              { return __hip_atomic_load(p, __ATOMIC_RELAXED, __HIP_MEMORY_SCOPE_AGENT); }
__device__ __forceinline__ unsigned xb_add(unsigned* p, unsigned v) { return __hip_atomic_fetch_add(p, v, __ATOMIC_RELAXED, __HIP_MEMORY_SCOPE_AGENT); }
__device__ __forceinline__ unsigned xb_xcc_id() { return (unsigned)__builtin_amdgcn_s_getreg((3 << 11) | 20) & 0xFu; }
#define XB_SPIN(cond, bar) do { unsigned _sp = 0; while (cond) { __builtin_amdgcn_s_sleep(1); \
    if ((++_sp & 255u) == 0u) { if (xb_ld(&(bar)[XB_TMO])) break; if (_sp > XB_SPIN_CAP) { atomicAdd(&(bar)[XB_TMO], 1u); break; } } } } while (0)

struct XcdBarrier {
    unsigned* bar; unsigned x;
    volatile LAS unsigned* st;
};

__device__ __forceinline__ XcdBarrier xcd_barrier_post(unsigned* bar, volatile LAS unsigned* st) {
    XcdBarrier b; b.bar = bar; b.x = xb_xcc_id(); b.st = st;
    if (threadIdx.x == 0) (void)xb_add(&bar[XB_XCNT(b.x)], 1u);
    return b;
}
__device__ __forceinline__ void xcd_barrier_complete(unsigned* bar, unsigned x, unsigned& nloc, unsigned& nx) {
    const unsigned G = gridDim.x * gridDim.y * gridDim.z;
    unsigned sum, cnt, mine, sp = 0u;
    for (;;) {
        sum = 0u; cnt = 0u; mine = 0u;
#pragma unroll
        for (unsigned j = 0; j < 16; ++j) { const unsigned c = xb_ld(&bar[XB_XCNT(j)]); sum += c; cnt += (c > 0u) ? 1u : 0u; mine = (j == x) ? c : mine; }
        if (sum == G) break;
        __builtin_amdgcn_s_sleep(1);
        if ((++sp & 255u) == 0u) { if (xb_ld(&bar[XB_TMO])) break; if (sp > XB_SPIN_CAP) { atomicAdd(&bar[XB_TMO], 1u); break; } }
    }
    nloc = mine > 0u ? mine : 1u; nx = cnt > 0u ? cnt : 1u;
}

__device__ __forceinline__ void xcd_barrier(const XcdBarrier& b, const bool is_t0) {
    asm volatile("s_waitcnt vmcnt(0)" ::: "memory");
    __syncthreads();
    if (is_t0) {
        unsigned* bar = b.bar;
        __builtin_amdgcn_s_waitcnt(0);
        unsigned nloc = b.st[0], nx = b.st[1];
        if (nloc == 0u) { xcd_barrier_complete(bar, b.x, nloc, nx); b.st[0] = nloc; b.st[1] = nx; }
        const unsigned old = xb_add(&bar[XB_XSUB(b.x)], 1u);
        const unsigned gen = old / nloc;
        if (old + 1u == (gen + 1u) * nloc) {
            __builtin_amdgcn_fence(__ATOMIC_RELEASE, "agent");
            asm volatile("s_waitcnt vmcnt(0)" ::: "memory");
            const unsigned og = xb_add(&bar[XB_TOP], 1u);
            const unsigned tg = og / nx;
            if (og + 1u == (tg + 1u) * nx) xb_add(&bar[XB_TOPGEN], 1u);
            else XB_SPIN(xb_ld(&bar[XB_TOPGEN]) == tg, bar);
            __builtin_amdgcn_fence(__ATOMIC_ACQUIRE, "agent");
            xb_add(&bar[XB_XGEN(b.x)], 1u);
            asm volatile("s_waitcnt vmcnt(0)" ::: "memory");
        } else {
            XB_SPIN(xb_ld(&bar[XB_XGEN(b.x)]) == gen, bar);
            __builtin_amdgcn_fence(__ATOMIC_ACQUIRE, "agent");
            asm volatile("s_waitcnt vmcnt(0)" ::: "memory");
        }
    }
    __syncthreads();
}

struct Args { const float* in[17]; float* out; unsigned char* ws; int ph_lo, ph_hi; };
enum { I_X = 0, I_C, I_WMOD, I_BMOD, I_WIN, I_WPOOL, I_PSCALE, I_WOUT, I_LN1G, I_LN1B, I_WR, I_RB, I_WG, I_WU, I_WDN, I_LN2G, I_LN2B };

DEVFN int lane_id_volatile() { int l; asm volatile("v_mbcnt_lo_u32_b32 %0, -1, 0\n\tv_mbcnt_hi_u32_b32 %0, -1, %0" : "=v"(l)); return l; }
struct Ctx { unsigned char* lds; __attribute__((address_space(3))) unsigned char* lds3; int tid, lane, wave, G, bid, gw, NGW; };

DEVFN void transpose_item_f8(const float* src, int ldn, int k0, int col, unsigned char* dst, int ldk, int dst_row0, int dst_k0, float* scr, int lane) {
#pragma unroll 8
    for (int i = 0; i < 32; ++i) { const int kk = 2 * i + (lane >> 5); scr[kk * 33 + (lane & 31)] = src[(size_t)(k0 + kk) * ldn + col]; }
    LDS_WAIT();
    const int c = lane & 7;
#pragma unroll
    for (int j = 0; j < 4; ++j) { const int n = (lane >> 3) + 8 * j; const float* s = scr + (8 * c) * 33 + n;
        u32x2 o; o.x = pk4_fp8(32.f * s[0 * 33], 32.f * s[1 * 33], 32.f * s[2 * 33], 32.f * s[3 * 33]); o.y = pk4_fp8(32.f * s[4 * 33], 32.f * s[5 * 33], 32.f * s[6 * 33], 32.f * s[7 * 33]);
        *(u32x2*)(dst + (size_t)(dst_row0 + n) * ldk + dst_k0 + 8 * c) = o; }
    LDS_WAIT();
}

DEVFN void ph_prologue(const Args& a, const Ctx& c) {
    unsigned char* ws = a.ws;
    float* scr = (float*)(c.lds + c.wave * 16384);
    const int lane = c.lane;
    constexpr int N1 = 2 * 16 * 64, N2 = 2 * 8 * 32, N3 = 32 * 16 * 32, N4 = 32 * 8 * 32, N5 = 2 * 64 * 16, N6 = 256;
    for (int it = c.gw; it < N1 + N2 + N3 + N4 + N5 + N6; it += c.NGW) {
        int r = it;
        if (r < N1) {
            const int l = r / 1024, kb = (r % 1024) / 64, nb = r % 64;
            const int nphys = 32 * nb + (lane & 31);
            transpose_item_f8(a.in[I_WIN] + (size_t)l * DM * DIN, DIN, 64 * kb, inproj_nlog(nphys), (unsigned char*)(ws + WS_WIN) + (size_t)l * DIN * DM, DM, 32 * nb, 64 * kb, scr, lane);
            continue; }
        r -= N1;
        if (r < N2) {
            const int l = r / 256, kb = (r % 256) / 32, nb = r % 32;
            transpose_item_f8(a.in[I_WOUT] + (size_t)l * DM * DM, DM, 64 * kb, inproj_nlog(32 * nb + (lane & 31)), (unsigned char*)(ws + WS_WOUT) + (size_t)l * DM * DM, DM, 32 * nb, 64 * kb, scr, lane);
            continue; }
        r -= N2;
        if (r < N3) {
            const int le = r / 512, kb = (r % 512) / 32, nb = r % 32;
            const int n = 32 * nb + (lane & 31), jt = n >> 8, bj = (n >> 7) & 1, i = n & 127;
            const float* src = (bj ? a.in[I_WU] : a.in[I_WG]) + (size_t)le * DM * DE;
            transpose_item_f8(src, DE, 64 * kb, jt * 128 + i, (unsigned char*)(ws + WS_WGU) + (size_t)le * DM * DM, DM, 32 * nb, 64 * kb, scr, lane);
            continue; }
        r -= N3;
        if (r < N4) {
            const int le = r / 256, kb = (r % 256) / 32, nb = r % 32;
            transpose_item_f8(a.in[I_WDN] + (size_t)le * DE * DM, DM, 64 * kb, inproj_nlog(32 * nb + (lane & 31)), (unsigned char*)(ws + WS_WD) + (size_t)le * DM * DE, DE, 32 * nb, 64 * kb, scr, lane);
            continue; }
        r -= N4;
        if (r < N5) {
            const int l = r / 1024, kdg = (r % 1024) / 16, nb = r % 16;
            const int n = nb * 64 + lane, kd0 = kdg * 8, g = kd0 >> 7, c0 = kd0 & 127;
            const float* wo = a.in[I_WOUT] + (size_t)l * DM * DM + (size_t)(512 + g * 128) * DM + inproj_nlog(n);
            const float* ps = a.in[I_PSCALE] + l * 512 + g * 128;
            const float* wp = a.in[I_WPOOL] + ((size_t)(l * 4 + g) * 128 + c0) * 128;
            float acc[8];
#pragma unroll
            for (int j = 0; j < 8; ++j) acc[j] = 0.f;
            for (int e = 0; e < 128; ++e) { const float w = wo[(size_t)e * DM] * ps[e];
#pragma unroll
                for (int j = 0; j < 8; ++j) acc[j] += wp[j * 128 + e] * w; }
            u32x2 o; o.x = pk4_fp8(128.f * acc[0], 128.f * acc[1], 128.f * acc[2], 128.f * acc[3]); o.y = pk4_fp8(128.f * acc[4], 128.f * acc[5], 128.f * acc[6], 128.f * acc[7]);
            *(u32x2*)((unsigned char*)(ws + WS_WOUT) + (size_t)l * DM * DM + (size_t)n * DM + 512 + kd0) = o;
            continue; }
        r -= N5;
        {
            const int ent = r * 64 + lane, pos = ent >> 3, i = ent & 7;
            const float inv = (float)exp2(-(double)i / 8.0 * 18.931568569324174);
            const float ang = (float)pos * inv;
            float* t = (float*)(ws + WS_ROPE) + ent * 2;
            t[0] = (float)cos((double)ang); t[1] = (float)sin((double)ang);
        }
    }
    for (int i = c.bid * 512 + c.tid; i < 2 * NB * NH * NBLK * HD; i += c.G * 512) ((float*)(ws + WS_KBAR))[i] = 0.f;
    __syncthreads();
    if (c.bid < 192) {
        float* condT = (float*)c.lds;
        float* red = (float*)(c.lds + 65536);
        for (int idx = c.tid; idx < NB * DM; idx += 512) { const int b = idx >> 10, k = idx & 1023; const float v = a.in[I_C][idx]; condT[k * 16 + b] = v / (1.f + __expf(-v)); }
        __syncthreads();
        for (int u = c.bid; u < 192; u += c.G) {
            const int l = u / 96, n0 = (u % 96) * 64;
            const float* W = a.in[I_WMOD] + (size_t)l * DM * NMOD + n0 + lane;
            float acc[16];
#pragma unroll
            for (int b = 0; b < 16; ++b) acc[b] = 0.f;
            for (int k = 128 * c.wave; k < 128 * c.wave + 128; k += 8) {
                float wv[8];
#pragma unroll
                for (int j = 0; j < 8; ++j) wv[j] = W[(size_t)(k + j) * NMOD];
#pragma unroll
                for (int j = 0; j < 8; ++j) {
                    const f32x4* cp = (const f32x4*)(condT + (k + j) * 16);
#pragma unroll
                    for (int q = 0; q < 4; ++q) { const f32x4 cv = cp[q]; acc[4 * q + 0] += cv.x * wv[j]; acc[4 * q + 1] += cv.y * wv[j]; acc[4 * q + 2] += cv.z * wv[j]; acc[4 * q + 3] += cv.w * wv[j]; }
                }
            }
#pragma unroll
            for (int b = 0; b < 16; ++b) red[(c.wave * 16 + b) * 64 + lane] = acc[b];
            __syncthreads();
            for (int o = c.tid; o < 1024; o += 512) { const int b = o >> 6, cc = o & 63; float s = a.in[I_BMOD][l * NMOD + n0 + cc];
#pragma unroll
                for (int w = 0; w < 8; ++w) s += red[(w * 16 + b) * 64 + cc];
                ((float*)(ws + WS_MOD))[(size_t)(l * NB + b) * NMOD + n0 + cc] = s; }
            __syncthreads();
        }
    }
}

DEVFN void row_stats(const f32x4 (&v)[4], float& mean, float& rstd) {
    float s = 0.f, q = 0.f;
#pragma unroll
    for (int j = 0; j < 4; ++j) { s += (v[j].x + v[j].y) + (v[j].z + v[j].w); q += (v[j].x * v[j].x + v[j].y * v[j].y) + (v[j].z * v[j].z + v[j].w * v[j].w); }
    s = swz_xor_add(s, 1); q = swz_xor_add(q, 1); s = swz_xor_add(s, 2); q = swz_xor_add(q, 2); s = swz_xor_add(s, 4); q = swz_xor_add(q, 4);
    s = swz_xor_add(s, 8); q = swz_xor_add(q, 8); s = swz_xor_add(s, 16); q = swz_xor_add(q, 16); s = half_swap_add(s); q = half_swap_add(q);
    mean = s * (1.f / DM);
    rstd = 1.f / sqrtf(fmaxf(q * (1.f / DM) - mean * mean, 0.f) + LN_EPS);
}
DEVFN void row_load(const float* p, int lane, f32x4 (&v)[4]) {
#pragma unroll
    for (int j = 0; j < 4; ++j) v[j] = *(const f32x4*)(p + 4 * lane + 256 * j);
}
DEVFN void row_mod_store(f32x4 (&v)[4], const float* sc, const float* sh, bf16_t* out, int lane) {
    float mean, rstd; row_stats(v, mean, rstd);
#pragma unroll
    for (int j = 0; j < 4; ++j) {
        const f32x4 s = *(const f32x4*)(sc + 4 * lane + 256 * j), h = *(const f32x4*)(sh + 4 * lane + 256 * j);
        v[j] = (v[j] - mean) * rstd * (s + 1.f) + h;
        u32x2 o; o.x = pk2(v[j].x, v[j].y); o.y = pk2(v[j].z, v[j].w);
        *(u32x2*)(out + 4 * lane + 256 * j) = o;
    }
}

DEVFN void ph_pool(const Args& a, const Ctx& c) {
    const bf16_t* P = (const bf16_t*)(a.ws + WS_QKVP) + 1536; unsigned char* AD = (unsigned char*)(a.ws + WS_AD) + 512;
    for (int it = c.bid * 512 + c.tid; it < (NTOK / 8) * 64; it += c.G * 512) {
        const int cg = it & 63, m0 = (it >> 6) * 8, t0 = m0 & (SEQ - 1), g = cg >> 4, w = 2 << g;
        const bf16_t* pc = P + cg * 8;
        u32x4 rows[23];
#pragma unroll
        for (int k = 0; k < 23; ++k) { const int dt = k - 15; rows[k] = (u32x4){0u, 0u, 0u, 0u}; if (dt > -w && t0 + dt >= 0) rows[k] = *(const u32x4*)(pc + (size_t)(m0 + dt) * DIN); }
        float s[8];
#pragma unroll
        for (int j = 0; j < 8; ++j) s[j] = 0.f;
#pragma unroll
        for (int k = 0; k < 15; ++k) { const u32x4 v = rows[k]; s[0] += bf_lo(v.x); s[1] += bf_hi(v.x); s[2] += bf_lo(v.y); s[3] += bf_hi(v.y); s[4] += bf_lo(v.z); s[5] += bf_hi(v.z); s[6] += bf_lo(v.w); s[7] += bf_hi(v.w); }
#pragma unroll
        for (int r = 0; r < 8; ++r) {
            const int t = t0 + r; const u32x4 v = rows[15 + r];
            const float f[8] = {bf_lo(v.x), bf_hi(v.x), bf_lo(v.y), bf_hi(v.y), bf_lo(v.z), bf_hi(v.z), bf_lo(v.w), bf_hi(v.w)};
#pragma unroll
            for (int j = 0; j < 8; ++j) s[j] += f[j];
            const int cnt = (t + 1 < w) ? t + 1 : w; const float ic = 1.f / (float)cnt;
            u32x2 o; o.x = pk4_fp8(s[0] * ic - f[0], s[1] * ic - f[1], s[2] * ic - f[2], s[3] * ic - f[3]); o.y = pk4_fp8(s[4] * ic - f[4], s[5] * ic - f[5], s[6] * ic - f[6], s[7] * ic - f[7]);
            *(u32x2*)(AD + (size_t)(m0 + r) * DM + cg * 8) = o;
            u32x4 q = rows[r];
            if (w == 8) q = rows[r + 8]; else if (w == 4) q = rows[r + 12]; else if (w == 2) q = rows[r + 14];
            s[0] -= bf_lo(q.x); s[1] -= bf_hi(q.x); s[2] -= bf_lo(q.y); s[3] -= bf_hi(q.y); s[4] -= bf_lo(q.z); s[5] -= bf_hi(q.z); s[6] -= bf_lo(q.w); s[7] -= bf_hi(q.w);
        }
    }
}

constexpr size_t WS_X1B = WS_X1, WS_X2B = WS_X1 + 64 * MiB;
constexpr int ROWS_PER_WAVE = 16;
DEVFN void vec_load(const float* p, int lane, f32x4 (&v)[4]) {
#pragma unroll
    for (int j = 0; j < 4; ++j) v[j] = *(const f32x4*)(p + 4 * lane + 256 * j);
}
DEVFN void bfrow_load(const bf16_t* p, int lane, u32x2 (&w)[4]) {
#pragma unroll
    for (int j = 0; j < 4; ++j) w[j] = *(const u32x2*)(p + 4 * lane + 256 * j);
}
DEVFN f32x4 bf4(u32x2 w) { return (f32x4){bf_lo(w.x), bf_hi(w.x), bf_lo(w.y), bf_hi(w.y)}; }
DEVFN void bfrow_store(bf16_t* p, int lane, const f32x4 (&v)[4]) {
#pragma unroll
    for (int j = 0; j < 4; ++j) { u32x2 o; o.x = pk2(v[j].x, v[j].y); o.y = pk2(v[j].z, v[j].w); *(u32x2*)(p + 4 * lane + 256 * j) = o; }
}
DEVFN void f8row_store(unsigned char* p, int lane, const f32x4 (&v)[4]) {
#pragma unroll
    for (int j = 0; j < 4; ++j) *(unsigned*)(p + 4 * lane + 256 * j) = pk4_fp8(v[j].x, v[j].y, v[j].z, v[j].w);
}
DEVFN void ln_mod(f32x4 (&v)[4], const f32x4 (&sc)[4], const f32x4 (&sh)[4]) {
    float mean, rstd; row_stats(v, mean, rstd);
#pragma unroll
    for (int j = 0; j < 4; ++j) v[j] = (v[j] - mean) * rstd * (sc[j] + 1.f) + sh[j];
}
DEVFN void ln_aff(f32x4 (&v)[4], const f32x4 (&g)[4], const f32x4 (&b)[4]) {
    float mean, rstd; row_stats(v, mean, rstd);
#pragma unroll
    for (int j = 0; j < 4; ++j) v[j] = (v[j] - mean) * rstd * g[j] + b[j];
}

DEVFN void ph_h1_rows(const Args& a, const Ctx& c) {
    const float* mod = (const float*)(a.ws + WS_MOD); bf16_t* HB = (bf16_t*)(a.ws + WS_HB);
    for (int base = c.gw * ROWS_PER_WAVE; base < NTOK; base += c.NGW * ROWS_PER_WAVE) {
        const float* mb = mod + (size_t)(base >> 11) * NMOD;
        f32x4 sc[4], sh[4]; vec_load(mb + DM, c.lane, sc); vec_load(mb, c.lane, sh);
        f32x4 cur[4], nxt[4]; vec_load(a.in[I_X] + (size_t)base * DM, c.lane, cur);
#pragma unroll 1
        for (int i = 0; i < ROWS_PER_WAVE; ++i) {
            const int m = base + i;
            if (i + 1 < ROWS_PER_WAVE) vec_load(a.in[I_X] + (size_t)(m + 1) * DM, c.lane, nxt);
            ln_mod(cur, sc, sh); f8row_store((unsigned char*)HB + (size_t)m * DM, c.lane, cur);
#pragma unroll
            for (int j = 0; j < 4; ++j) cur[j] = nxt[j];
        }
    }
}

DEVFN f32x4 reduce16(const float (&lg)[16]) {
    float t[8], u[4];
#pragma unroll
    for (int e = 0; e < 8; ++e) { auto rr = __builtin_amdgcn_permlane32_swap(__float_as_uint(lg[e]), __float_as_uint(lg[e + 8]), false, false); t[e] = __uint_as_float(rr[0]) + __uint_as_float(rr[1]); }
#pragma unroll
    for (int k = 0; k < 4; ++k) { auto rr = __builtin_amdgcn_permlane16_swap(__float_as_uint(t[k]), __float_as_uint(t[k + 4]), false, false); u[k] = __uint_as_float(rr[0]) + __uint_as_float(rr[1]); }
#pragma unroll
    for (int k = 0; k < 4; ++k) { u[k] = swz_xor_add(u[k], 1); u[k] = swz_xor_add(u[k], 2); u[k] = swz_xor_add(u[k], 4); u[k] = swz_xor_add(u[k], 8); }
    return (f32x4){u[0], u[1], u[2], u[3]};
}

DEVFN void rowc_load(const Args& a, int l, int m, int lane, f32x4 (&x)[4], unsigned (&y)[4]) {
    if (l == 0) vec_load(a.in[I_X] + (size_t)m * DM, lane, x);
    else { u32x2 w[4]; bfrow_load((const bf16_t*)(a.ws + WS_X2B) + (size_t)m * DM, lane, w);
#pragma unroll
        for (int j = 0; j < 4; ++j) { x[j].x = __uint_as_float(w[j].x); x[j].y = __uint_as_float(w[j].y); } }
#pragma unroll
    for (int j = 0; j < 4; ++j) y[j] = *(const unsigned*)((const unsigned char*)(a.ws + WS_QKVP) + (size_t)m * DM + 4 * lane + 256 * j);
}
DEVFN void rowc_step(const Args& a, int l, int m, int lane, const f32x4 (&x)[4], const unsigned (&y)[4], const float* vg1, const float* vsc, const float* vsh, f32x4 (&v)[4]) {
    int z_ = 0; asm volatile("" : "+v"(z_));
    f32x4 g1[4]; vec_load(vg1 + z_, lane, g1);
#pragma unroll
    for (int j = 0; j < 4; ++j) { const f32x4 xv = (l == 0) ? x[j] : bf4((u32x2){__float_as_uint(x[j].x), __float_as_uint(x[j].y)}); v[j] = xv * ALPHA + g1[j] * f8x4_to_f32(y[j], 1.f / YSCALE); }
    { f32x4 lg[4], lb[4]; vec_load(a.in[I_LN1G] + l * DM + z_, lane, lg); vec_load(a.in[I_LN1B] + l * DM + z_, lane, lb); ln_aff(v, lg, lb); }
    bfrow_store((bf16_t*)(a.ws + WS_X1B) + (size_t)m * DM, lane, v);
    { f32x4 sc[4], sh[4]; vec_load(vsc + z_, lane, sc); vec_load(vsh + z_, lane, sh); ln_mod(v, sc, sh); }
    f8row_store((unsigned char*)(a.ws + WS_HB) + (size_t)m * DM, lane, v);
}

DEVFN void ph_rows_c(const Args& a, const Ctx& c, int l, bool publish) {
    const float* mod = (const float*)(a.ws + WS_MOD) + (size_t)l * NB * NMOD;
    const bf16_t* Y = (const bf16_t*)(a.ws + WS_QKVP); const bf16_t* X2B = (const bf16_t*)(a.ws + WS_X2B);
    bf16_t* X1B = (bf16_t*)(a.ws + WS_X1B); bf16_t* HB = (bf16_t*)(a.ws + WS_HB);
    float* wr = (float*)c.lds;
    float* vsc = (float*)(c.lds + 65536); float* vsh = vsc + DM; float* vg1 = vsh + DM;
    int* lcnt = (int*)(c.lds + 65536 + 12288); int* lbase = lcnt + 32;
    int* rcls = lbase + 32; float* rw1 = (float*)(rcls + 8 * 64); float* rw2 = rw1 + 8 * 64; int* rrow = (int*)(rw2 + 8 * 64); float* lgs = (float*)(rrow + 8 * 64);
#pragma unroll
    for (int it = 0; it < 8; ++it) { const int idx = it * 512 + c.tid, k = idx & 1023, q = idx >> 10;
        const f32x4 w = *(const f32x4*)(a.in[I_WR] + k * 16 + 4 * q);
        wr[(4 * q + 0) * DM + k] = w.x; wr[(4 * q + 1) * DM + k] = w.y; wr[(4 * q + 2) * DM + k] = w.z; wr[(4 * q + 3) * DM + k] = w.w; }
    if (c.tid < 32) lcnt[c.tid] = 0;
    __syncthreads();
    int nr = 0;
    for (int base = c.gw * ROWS_PER_WAVE; base < NTOK; base += c.NGW * ROWS_PER_WAVE) {
        const float* mb = mod + (size_t)(base >> 11) * NMOD;
        __syncthreads();
        for (int i = c.tid; i < 3 * DM; i += 512) vsc[i] = (i < DM) ? mb[4 * DM + i] : (i < 2 * DM ? mb[3 * DM + (i - DM)] : mb[2 * DM + (i - 2 * DM)]);
        __syncthreads();
#pragma unroll 1
        for (int i = 0; i < ROWS_PER_WAVE; i += 2) {
            const int m = __builtin_amdgcn_readfirstlane(base + i);
            f32x4 va[4], vb[4];
            { f32x4 xa[4], xb[4]; unsigned ya[4], yb[4];
              rowc_load(a, l, m, c.lane, xa, ya); rowc_load(a, l, m + 1, c.lane, xb, yb);
              rowc_step(a, l, m, c.lane, xa, ya, vg1, vsc, vsh, va);
              rowc_step(a, l, m + 1, c.lane, xb, yb, vg1, vsc, vsh, vb); }
            typedef float f32x2_t __attribute__((ext_vector_type(2)));
            f32x2_t acc2[16];
#pragma unroll
            for (int e = 0; e < 16; ++e) acc2[e] = (f32x2_t){0.f, 0.f};
#pragma unroll
            for (int j = 0; j < 4; ++j) {
                const f32x2_t p0 = {va[j].x, vb[j].x}, p1 = {va[j].y, vb[j].y}, p2 = {va[j].z, vb[j].z}, p3 = {va[j].w, vb[j].w};
#pragma unroll
                for (int e = 0; e < 16; ++e) { const f32x4 w = *(const f32x4*)(wr + e * DM + 4 * c.lane + 256 * j);
                    acc2[e] = __builtin_elementwise_fma(p0, (f32x2_t){w.x, w.x}, acc2[e]); acc2[e] = __builtin_elementwise_fma(p1, (f32x2_t){w.y, w.y}, acc2[e]);
                    acc2[e] = __builtin_elementwise_fma(p2, (f32x2_t){w.z, w.z}, acc2[e]); acc2[e] = __builtin_elementwise_fma(p3, (f32x2_t){w.w, w.w}, acc2[e]);
                    if ((e & 7) == 7) __builtin_amdgcn_sched_barrier(0); } }
            float la[16], lb2[16];
#pragma unroll
            for (int e = 0; e < 16; ++e) { la[e] = acc2[e].x; lb2[e] = acc2[e].y; }
            { const f32x4 ua = reduce16(la), ub = reduce16(lb2);
              if ((c.lane & 15) == 0) { *(f32x4*)(lgs + (c.wave * 16 + i) * 16 + (c.lane >> 4) * 4) = ua; *(f32x4*)(lgs + (c.wave * 16 + i + 1) * 16 + (c.lane >> 4) * 4) = ub; } }
        }
        LDS_WAIT();
        if (c.lane < ROWS_PER_WAVE) {
            float lg16[16], rb[16];
#pragma unroll
            for (int e = 0; e < 16; ++e) rb[e] = a.in[I_RB][e];
#pragma unroll
            for (int q = 0; q < 4; ++q) { const f32x4 t = *(const f32x4*)(lgs + (c.wave * 16 + c.lane) * 16 + 4 * q); lg16[4 * q] = t.x; lg16[4 * q + 1] = t.y; lg16[4 * q + 2] = t.z; lg16[4 * q + 3] = t.w; }
            float mx = lg16[0];
#pragma unroll
            for (int e = 1; e < 16; ++e) mx = fmaxf(mx, lg16[e]);
            float sum = 0.f, scr[16];
#pragma unroll
            for (int e = 0; e < 16; ++e) { scr[e] = __expf(lg16[e] - mx); sum += scr[e]; }
            const float isum = 1.f / sum;
#pragma unroll
            for (int e = 0; e < 16; ++e) scr[e] *= isum;
            float bestg = -3.4e38f; int gb = 0, bi1 = 0, bi2 = 1; float bw1 = 0.f, bw2 = 0.f;
#pragma unroll
            for (int g = 0; g < 4; ++g) {
                float m1 = scr[4 * g] + rb[4 * g], s1 = scr[4 * g]; int i1 = 0;
#pragma unroll
                for (int q = 1; q < 4; ++q) { const float sv = scr[4 * g + q] + rb[4 * g + q]; const bool ok = sv > m1; m1 = ok ? sv : m1; s1 = ok ? scr[4 * g + q] : s1; i1 = ok ? q : i1; }
                float m2 = -3.4e38f, s2 = 0.f; int i2 = 0;
#pragma unroll
                for (int q = 0; q < 4; ++q) { const float sv = scr[4 * g + q] + rb[4 * g + q]; const bool ok = (q != i1) && sv > m2; m2 = ok ? sv : m2; s2 = ok ? scr[4 * g + q] : s2; i2 = ok ? q : i2; }
                const float gs = m1 + m2; const bool better = gs > bestg;
                bestg = better ? gs : bestg; gb = better ? g : gb; bi1 = better ? i1 : bi1; bi2 = better ? i2 : bi2; bw1 = better ? s1 : bw1; bw2 = better ? s2 : bw2;
            }
            const float inv = 1.f / (bw1 + bw2);
            const int lo = bi1 < bi2 ? bi1 : bi2, hi2 = bi1 < bi2 ? bi2 : bi1;
            const float wlo = (bi1 < bi2 ? bw1 : bw2) * inv, whi = (bi1 < bi2 ? bw2 : bw1) * inv;
            const int pidx = lo == 0 ? hi2 - 1 : (lo == 1 ? hi2 + 1 : 5);
            const int slot = c.wave * 64 + nr + c.lane;
            rcls[slot] = gb * 6 + pidx; rw1[slot] = wlo; rw2[slot] = whi; rrow[slot] = base + c.lane;
        }
        nr += ROWS_PER_WAVE;
        LDS_WAIT();
    }
    LDS_WAIT();
    if (!publish) return;
    int rank = 0, cls = 0;
    if (c.lane < nr) { cls = rcls[c.wave * 64 + c.lane]; rank = atomicAdd(&lcnt[cls], 1); }
    __syncthreads();
    if (c.tid < NCLS) lbase[c.tid] = (int)__hip_atomic_fetch_add((unsigned*)(a.ws + WS_CTL) + CW_CNT + l * 32 + c.tid, (unsigned)lcnt[c.tid], RLX_AGENT);
    __syncthreads();
    if (c.lane < nr) {
        const int pos = lbase[cls] + rank;
        ((int*)(a.ws + WS_LIST))[(size_t)cls * LISTCAP + pos] = rrow[c.wave * 64 + c.lane];
        float* rw = (float*)(a.ws + WS_RW) + ((size_t)cls * LISTCAP + pos) * 2;
        rw[0] = rw1[c.wave * 64 + c.lane]; rw[1] = rw2[c.wave * 64 + c.lane];
    }
}

DEVFN void ph_rows_g(const Args& a, const Ctx& c, int l) {
    const float* mod = (const float*)(a.ws + WS_MOD) + (size_t)l * NB * NMOD;
    const bf16_t* X1B = (const bf16_t*)(a.ws + WS_X1B); const unsigned char* Y2 = (const unsigned char*)(a.ws + WS_AD);
    bf16_t* X2B = (bf16_t*)(a.ws + WS_X2B); bf16_t* HB = (bf16_t*)(a.ws + WS_HB);
    for (int base = c.gw * ROWS_PER_WAVE; base < NTOK; base += c.NGW * ROWS_PER_WAVE) {
        const float* mb = mod + (size_t)(base >> 11) * NMOD; const float* mb1 = mb + (size_t)NB * NMOD;
        f32x4 g2[4], lg[4], lb[4], sc[4], sh[4];
        vec_load(mb + 5 * DM, c.lane, g2); vec_load(a.in[I_LN2G] + l * DM, c.lane, lg); vec_load(a.in[I_LN2B] + l * DM, c.lane, lb);
        if (l == 0) { vec_load(mb1 + DM, c.lane, sc); vec_load(mb1, c.lane, sh); }
        u32x2 xc[4], xn[4]; unsigned yc[4], yn[4];
        bfrow_load(X1B + (size_t)base * DM, c.lane, xc);
#pragma unroll
        for (int j = 0; j < 4; ++j) yc[j] = *(const unsigned*)(Y2 + (size_t)base * DM + 4 * c.lane + 256 * j);
#pragma unroll 1
        for (int i = 0; i < ROWS_PER_WAVE; ++i) {
            const int m = base + i;
            if (i + 1 < ROWS_PER_WAVE) { bfrow_load(X1B + (size_t)(m + 1) * DM, c.lane, xn);
#pragma unroll
                for (int j = 0; j < 4; ++j) yn[j] = *(const unsigned*)(Y2 + (size_t)(m + 1) * DM + 4 * c.lane + 256 * j); }
            f32x4 v[4];
#pragma unroll
            for (int j = 0; j < 4; ++j) v[j] = bf4(xc[j]) * ALPHA + g2[j] * f8x4_to_f32(yc[j], 1.f / YSCALE);
            ln_aff(v, lg, lb);
            if (l == 0) { bfrow_store(X2B + (size_t)m * DM, c.lane, v); ln_mod(v, sc, sh); f8row_store((unsigned char*)HB + (size_t)m * DM, c.lane, v); }
            else {
#pragma unroll
                for (int j = 0; j < 4; ++j) *(f32x4*)(a.out + (size_t)m * DM + 4 * c.lane + 256 * j) = v[j]; }
#pragma unroll
            for (int j = 0; j < 4; ++j) { xc[j] = xn[j]; yc[j] = yn[j]; }
        }
    }
}

constexpr int MOETAB_OFF = 131072 + 512;
DEVFN void ph_inproj_fast(const Args& a, const Ctx& c, int l, bool dummy_kbar) {
    pg8::DenseSched S; S.so.init(NTOK, DIN, c.G, c.bid); S.A = (const char*)(a.ws + WS_HB); S.Bt = (const char*)(a.ws + WS_WIN) + (size_t)l * DIN * DM; S.lda = DM; S.ldb = DM;
    const pg8::EpiInproj E{(bf16_t*)(a.ws + WS_QKVP), (const float*)(a.ws + WS_ROPE), (dummy_kbar ? (float*)(a.ws + WS_RW) : (float*)(a.ws + WS_KBAR)) + (size_t)l * NB * NH * NBLK * HD};
    pg8::gemm_phase2<pg8::EpiInproj, pg8::DenseSched, true, true, false, true, 127 - 5, 127>(c.lds3, DM, DM, S, E, c.tid);
}
DEVFN void ph_wout_fast(const Args& a, const Ctx& c, int l) {
    pg8::DenseSched S; S.so.init(NTOK, DM, c.G, c.bid); S.A = (const char*)(a.ws + WS_AD); S.Bt = (const char*)(a.ws + WS_WOUT) + (size_t)l * DM * DM; S.lda = DM; S.ldb = DM;
    const pg8::EpiF8 E{(unsigned char*)(a.ws + WS_QKVP), DM};
    pg8::gemm_phase2<pg8::EpiF8, pg8::DenseSched, true, true, false, true, 127 - 5 + 4, 127 - 5, true, 127 - 7 + 4, 127>    (c.lds3, DM, DM, S, E, c.tid);
}
DEVFN void moe_table_lds(const Args& a, const Ctx& c, int l) {
    int* cnt = (int*)(c.lds + MOETAB_OFF); int* tp = cnt + 32;
    if (c.tid < NCLS) cnt[c.tid] = (int)__hip_atomic_load((unsigned*)(a.ws + WS_CTL) + CW_CNT + l * 32 + c.tid, RLX_AGENT);
    __syncthreads();
    if (c.tid <= NCLS) { int s = 0;
#pragma unroll
        for (int k = 0; k < NCLS; ++k) { const int nk = (cnt[k] + 255) >> 8; s += (k < c.tid) ? nk : 0; }
        tp[c.tid] = s; }
    __syncthreads();
    int* tcls = tp + 32;
    for (int T = c.tid; T < tp[NCLS]; T += 512) { int k = 0; while (T >= tp[k + 1]) ++k; tcls[T] = k; }
    __syncthreads();
}
DEVFN void ph_gateup_fast(const Args& a, const Ctx& c, int l) {
    moe_table_lds(a, c, l);
    pg8::GateUpSched S; S.cnt = (const LAS int*)(c.lds3 + MOETAB_OFF); S.tp = S.cnt + 32; S.tcls = S.tp + 32; S.npn_shift = 3; S.nunits = S.tp[NCLS] * 8; S.G = c.G; S.c = (c.G % 8 == 0) ? (c.bid % 8) * (c.G / 8) + c.bid / 8 : c.bid;
    S.HB = (const char*)(a.ws + WS_HB); S.list = (const int*)(a.ws + WS_LIST); S.W = (const char*)(a.ws + WS_WGU) + (size_t)l * NE * DM * DM;
    const pg8::EpiGateUp E{(unsigned char*)(a.ws + WS_QKVP), (const float*)(a.ws + WS_RW)};
    pg8::gemm_phase2<pg8::EpiGateUp, pg8::GateUpSched, true, true, false, true, 127 - 5, 127>(c.lds3, DM, DM, S, E, c.tid);
}
DEVFN void ph_down_fast(const Args& a, const Ctx& c, int l) {
    moe_table_lds(a, c, l);
    pg8::DownSched S; S.cnt = (const LAS int*)(c.lds3 + MOETAB_OFF); S.tp = S.cnt + 32; S.tcls = S.tp + 32; S.npn_shift = 2; S.nunits = S.tp[NCLS] * 4; S.G = c.G; S.c = (c.G % 8 == 0) ? (c.bid % 8) * (c.G / 8) + c.bid / 8 : c.bid;
    S.ACT = (const char*)(a.ws + WS_QKVP); S.W = (const char*)(a.ws + WS_WD) + (size_t)l * NE * DM * DE;
    const pg8::EpiDown E{(unsigned char*)(a.ws + WS_AD), (const int*)(a.ws + WS_LIST)};
    pg8::gemm_phase2<pg8::EpiDown, pg8::DownSched, true, true, true, true, 127 - 5 + 4, 127 - 3>    (c.lds3, DM, DE, S, E, c.tid);
}

#ifndef MK_N_LAUNCHES
#define MK_N_LAUNCHES 1
#endif
constexpr int RING_BYTES = 131072, LDSCTL_OFF = RING_BYTES, MISC_OFF = LDSCTL_OFF + 320, LDS_BYTES = 147456;
constexpr int PH_PER_LAYER = 7, NPHASE = 2 + 2 * PH_PER_LAYER;
constexpr int CW_BAR = 4096;
static_assert((CW_BAR + XCD_BAR_WORDS) * 4 <= (int)CTL_ZERO_BYTES, "CTL");

__global__ void __launch_bounds__(512, 2) fwd(Args a) {
    extern __shared__ __attribute__((aligned(16))) unsigned char lds[];
    const int wave_s = __builtin_amdgcn_readfirstlane(threadIdx.x >> 6);
#define MKTID() (wave_s * 64 + lane_id_volatile())
#define MKCTX() Args al = a; { size_t z_ = 0; asm volatile("" : "+s"(z_)); al.ws = a.ws + z_; } Ctx c; {     int t_ = MKTID(); asm volatile("" : "+v"(t_)); c.lds = lds; c.lds3 = (LAS unsigned char*)lds; c.tid = t_; c.lane = t_ & 63; c.wave = __builtin_amdgcn_readfirstlane(t_ >> 6); c.G = gridDim.x; c.bid = blockIdx.x; c.gw = ((c.G % 8 == 0) ? (c.bid % 8) * (c.G / 8) + c.bid / 8 : c.bid) * 8 + c.wave; c.NGW = c.G * 8; }
    const int lo = a.ph_lo, hi = a.ph_hi;
    const bool one = (hi - lo) > 1;
    for (int u = threadIdx.x; u < (LDS_BYTES - LDSCTL_OFF) / 4; u += 512) ((LAS unsigned*)((LAS unsigned char*)lds + LDSCTL_OFF))[u] = 0u;
    __syncthreads();
    XcdBarrier bar; bar.bar = (unsigned*)(a.ws + WS_CTL) + CW_BAR; bar.x = 0; bar.st = nullptr;
    if (one) bar = xcd_barrier_post((unsigned*)(a.ws + WS_CTL) + CW_BAR, (volatile LAS unsigned*)((LAS unsigned char*)lds + MISC_OFF) + 8);
#ifndef REP_PHASE
#define REP_PHASE -1
#endif
#define IN(k) (lo <= (k) && (k) < hi)
#define SEAM(k) do { if (IN(k) && IN((k) + 1)) { XcdBarrier bl_ = bar; { size_t z_ = 0; unsigned x_ = bar.x; asm volatile("" : "+s"(z_), "+s"(x_)); bl_.bar = bar.bar + z_; bl_.x = x_; } xcd_barrier(bl_, MKTID() == 0); } } while (0)
    if (IN(0)) { MKCTX(); ph_prologue(al, c); if (REP_PHASE == 0) { __syncthreads(); ph_prologue(al, c); } SEAM(0); }
    if (IN(1)) { MKCTX(); ph_h1_rows(al, c); if (REP_PHASE == 1) ph_h1_rows(al, c); SEAM(1); }
    {
        constexpr int l = 0; constexpr int p0 = 2 + l * PH_PER_LAYER;
        if (IN(p0 + 0)) { MKCTX(); ph_inproj_fast(al, c, l, false); if (REP_PHASE == 10) { __syncthreads(); ph_inproj_fast(al, c, l, true); } SEAM(p0 + 0); }
        if (IN(p0 + 1)) {
            { MKCTX(); ph_pool(al, c); }
            __syncthreads();
            const attn_body::AttnTensors AT{(const attn_body::bf16*)(a.ws + WS_QKVP), (const attn_body::bf16*)(a.ws + WS_QKVP) + 512, (const attn_body::bf16*)(a.ws + WS_QKVP) + 1024,
                                            (attn_body::bf16*)(a.ws + WS_AD), (const float*)(a.ws + WS_KBAR) + (size_t)l * NB * NH * NBLK * HD};
            const attn_body::StaticOrder S((int)gridDim.x, (int)blockIdx.x);
            attn_body::attn_phase<attn_body::StaticOrder>((char*)lds, AT, S, MKTID());
            if (REP_PHASE == 11) attn_body::attn_phase<attn_body::StaticOrder>((char*)lds, AT, S, MKTID());
            if (REP_PHASE == 17) { __syncthreads(); MKCTX(); ph_pool(al, c); }
            SEAM(p0 + 1);
        }
        if (IN(p0 + 2)) { MKCTX(); ph_wout_fast(al, c, l); if (REP_PHASE == 12) { __syncthreads(); ph_wout_fast(al, c, l); } SEAM(p0 + 2); }
        if (IN(p0 + 3)) { MKCTX(); if (REP_PHASE == 13) { ph_rows_c(al, c, l, false); __syncthreads(); } ph_rows_c(al, c, l, true); SEAM(p0 + 3); }
        if (IN(p0 + 4)) { MKCTX(); ph_gateup_fast(al, c, l); if (REP_PHASE == 14) { __syncthreads(); ph_gateup_fast(al, c, l); } SEAM(p0 + 4); }
        if (IN(p0 + 5)) { MKCTX(); ph_down_fast(al, c, l); if (REP_PHASE == 15) { __syncthreads(); ph_down_fast(al, c, l); } SEAM(p0 + 5); }
        if (IN(p0 + 6)) { MKCTX(); ph_rows_g(al, c, l); if (REP_PHASE == 16) ph_rows_g(al, c, l); SEAM(p0 + 6); }
    }
    {
        constexpr int l = 1; constexpr int p0 = 2 + l * PH_PER_LAYER;
        if (IN(p0 + 0)) { MKCTX(); ph_inproj_fast(al, c, l, false); if (REP_PHASE == 10) { __syncthreads(); ph_inproj_fast(al, c, l, true); } SEAM(p0 + 0); }
        if (IN(p0 + 1)) {
            { MKCTX(); ph_pool(al, c); }
            __syncthreads();
            const attn_body::AttnTensors AT{(const attn_body::bf16*)(a.ws + WS_QKVP), (const attn_body::bf16*)(a.ws + WS_QKVP) + 512, (const attn_body::bf16*)(a.ws + WS_QKVP) + 1024,
                                            (attn_body::bf16*)(a.ws + WS_AD), (const float*)(a.ws + WS_KBAR) + (size_t)l * NB * NH * NBLK * HD};
            const attn_body::StaticOrder S((int)gridDim.x, (int)blockIdx.x);
            attn_body::attn_phase<attn_body::StaticOrder>((char*)lds, AT, S, MKTID());
            if (REP_PHASE == 11) attn_body::attn_phase<attn_body::StaticOrder>((char*)lds, AT, S, MKTID());
            if (REP_PHASE == 17) { __syncthreads(); MKCTX(); ph_pool(al, c); }
            SEAM(p0 + 1);
        }
        if (IN(p0 + 2)) { MKCTX(); ph_wout_fast(al, c, l); if (REP_PHASE == 12) { __syncthreads(); ph_wout_fast(al, c, l); } SEAM(p0 + 2); }
        if (IN(p0 + 3)) { MKCTX(); if (REP_PHASE == 13) { ph_rows_c(al, c, l, false); __syncthreads(); } ph_rows_c(al, c, l, true); SEAM(p0 + 3); }
        if (IN(p0 + 4)) { MKCTX(); ph_gateup_fast(al, c, l); if (REP_PHASE == 14) { __syncthreads(); ph_gateup_fast(al, c, l); } SEAM(p0 + 4); }
        if (IN(p0 + 5)) { MKCTX(); ph_down_fast(al, c, l); if (REP_PHASE == 15) { __syncthreads(); ph_down_fast(al, c, l); } SEAM(p0 + 5); }
        if (IN(p0 + 6)) { MKCTX(); ph_rows_g(al, c, l); if (REP_PHASE == 16) ph_rows_g(al, c, l); SEAM(p0 + 6); }
    }
#undef IN
#undef SEAM
}

extern "C" void kernel_launch(void* const* d_in, const int* in_sizes, int n_in, void* d_out, int out_size, void* d_ws, size_t ws_size, hipStream_t stream) {
    static int grid = 0;
    if (grid == 0) {
        if (n_in != 17 || out_size != NTOK * DM || ws_size < WS_END) { fprintf(stderr, "kernel_launch: unexpected problem (n_in %d out %d ws %zu)\n", n_in, out_size, ws_size); grid = -1; return; }
        if (hipFuncSetAttribute((const void*)fwd, hipFuncAttributeMaxDynamicSharedMemorySize, LDS_BYTES) != hipSuccess) { fprintf(stderr, "kernel_launch: hipFuncSetAttribute failed\n"); grid = -1; return; }
        int dev = 0, cus = 0, per_cu = 0;
        (void)hipGetDevice(&dev); (void)hipDeviceGetAttribute(&cus, hipDeviceAttributeMultiprocessorCount, dev);
        if (hipOccupancyMaxActiveBlocksPerMultiprocessor(&per_cu, (const void*)fwd, 512, LDS_BYTES) != hipSuccess || per_cu < 1) fprintf(stderr, "kernel_launch: occupancy query reports %d workgroups per CU\n", per_cu);
        (void)hipGetLastError();
        grid = cus > 0 ? cus : 256;
    }
    if (grid < 0) return;
    (void)hipMemsetAsync((char*)d_ws + WS_CTL, 0, CTL_ZERO_BYTES, stream);
    Args a{};
    for (int i = 0; i < 17; ++i) a.in[i] = (const float*)d_in[i];
    a.out = (float*)d_out; a.ws = (unsigned char*)d_ws;
#if MK_N_LAUNCHES == 1
    a.ph_lo = 0; a.ph_hi = NPHASE; hipLaunchKernelGGL(fwd, dim3(grid), dim3(512), LDS_BYTES, stream, a);
#else
    for (int p = 0; p < NPHASE; ++p) { a.ph_lo = p; a.ph_hi = p + 1; hipLaunchKernelGGL(fwd, dim3(grid), dim3(512), LDS_BYTES, stream, a); }
#endif
}
```

```cpp
#include <hip/hip_runtime.h>
#include <cstdint>
#include <cstdio>

constexpr int NB = 16, SEQ = 2048, DM = 1024, NTOK = NB * SEQ, DIN = 2048, NH = 8, HD = 64, NBLK = 8, MBLK = 256;
constexpr int NE = 16, NCLS = 24, DE = 512, NMOD = 6 * DM;
constexpr float ALPHA = 1.41421356237309515f, LN_EPS = 1e-5f;
constexpr float QSCALE = 0.125f * 1.4426950408889634f;
constexpr int LISTCAP = NTOK;

constexpr size_t MiB = 1u << 20;
constexpr size_t WS_CTL = 0, CTL_ZERO_BYTES = 1 * MiB;
constexpr size_t WS_MOD = 1 * MiB;
constexpr size_t WS_ROPE = 2 * MiB;
constexpr size_t WS_KBAR = 2 * MiB + 256 * 1024;
constexpr size_t WS_LIST = 3 * MiB;
constexpr size_t WS_RW = 6 * MiB;
constexpr size_t WS_WIN = 12 * MiB;
constexpr size_t WS_WOUT = 20 * MiB;
constexpr size_t WS_WGU = 24 * MiB;
constexpr size_t WS_WD = 88 * MiB;
constexpr size_t WS_HB = 120 * MiB;
constexpr size_t WS_QKVP = 184 * MiB;
constexpr size_t WS_AD = 312 * MiB;
constexpr size_t WS_X1 = 376 * MiB;
constexpr size_t WS_END = 504 * MiB;
constexpr int CW_TMO = 0, CW_CNT = 64;

typedef unsigned short bf16_t;
typedef short bf16x8 __attribute__((ext_vector_type(8)));
typedef float f32x4 __attribute__((ext_vector_type(4)));
typedef float f32x16 __attribute__((ext_vector_type(16)));
typedef unsigned u32x4 __attribute__((ext_vector_type(4)));
typedef unsigned u32x2 __attribute__((ext_vector_type(2)));

#define DEVFN __device__ __forceinline__
#define LDS_WAIT() asm volatile("s_waitcnt lgkmcnt(0)" ::: "memory")
#define RLX_AGENT __ATOMIC_RELAXED, __HIP_MEMORY_SCOPE_AGENT

DEVFN float bf_lo(unsigned w) { return __uint_as_float(w << 16); }
DEVFN float bf_hi(unsigned w) { return __uint_as_float(w & 0xffff0000u); }
DEVFN float bf2f(bf16_t v) { return __uint_as_float((unsigned)v << 16); }
DEVFN unsigned f2bf(float f) { unsigned u = __float_as_uint(f); return (u + 0x7fffu + ((u >> 16) & 1u)) >> 16; }
DEVFN unsigned pk2(float lo, float hi) { unsigned r; asm("v_cvt_pk_bf16_f32 %0, %1, %2" : "=v"(r) : "v"(lo), "v"(hi)); return r; }
DEVFN unsigned pk4_fp8(float a, float b, float c, float d) {
    a = __builtin_amdgcn_fmed3f(a, -448.f, 448.f); b = __builtin_amdgcn_fmed3f(b, -448.f, 448.f); c = __builtin_amdgcn_fmed3f(c, -448.f, 448.f); d = __builtin_amdgcn_fmed3f(d, -448.f, 448.f);
    unsigned w = 0u; w = __builtin_amdgcn_cvt_pk_fp8_f32(a, b, w, false); w = __builtin_amdgcn_cvt_pk_fp8_f32(c, d, w, true); return w; }
DEVFN f32x4 f8x4_to_f32(unsigned w, float sc) { const auto lo = __builtin_amdgcn_cvt_pk_f32_fp8(w, false), hi = __builtin_amdgcn_cvt_pk_f32_fp8(w, true); return (f32x4){lo[0] * sc, lo[1] * sc, hi[0] * sc, hi[1] * sc}; }
constexpr float YSCALE = 16.f;
DEVFN int crow(int r, int hi) { return (r & 3) + 8 * (r >> 2) + 4 * hi; }
DEVFN float dpp_f(float v, const int ctrl) {
    switch (ctrl) {
        case 0xB1:  return __int_as_float(__builtin_amdgcn_update_dpp(0, __float_as_int(v), 0xB1, 0xF, 0xF, false));
        case 0x4E:  return __int_as_float(__builtin_amdgcn_update_dpp(0, __float_as_int(v), 0x4E, 0xF, 0xF, false));
        case 0x141: return __int_as_float(__builtin_amdgcn_update_dpp(0, __float_as_int(v), 0x141, 0xF, 0xF, false));
        default:    return __int_as_float(__builtin_amdgcn_update_dpp(0, __float_as_int(v), 0x140, 0xF, 0xF, false));
    }
}
DEVFN float swz_xor_add(float v, const int m) {
    switch (m) {
        case 1: return v + dpp_f(v, 0xB1);
        case 2: return v + dpp_f(v, 0x4E);
        case 4: return v + dpp_f(v, 0x141);
        case 8: return v + dpp_f(v, 0x140);
        default: { auto rr = __builtin_amdgcn_permlane16_swap(__float_as_uint(v), __float_as_uint(v), false, false); return __uint_as_float(rr[0]) + __uint_as_float(rr[1]); }
    }
}
DEVFN float half_swap_add(float v) { auto rr = __builtin_amdgcn_permlane32_swap(__float_as_uint(v), __float_as_uint(v), false, false); return __uint_as_float(rr[0]) + __uint_as_float(rr[1]); }
DEVFN float wave_sum(float v) {
    v = swz_xor_add(v, 1); v = swz_xor_add(v, 2); v = swz_xor_add(v, 4); v = swz_xor_add(v, 8); v = swz_xor_add(v, 16);
    return half_swap_add(v);
}
__host__ __device__ __forceinline__ int inproj_lgroup(int P) { return P < 16 ? (P >> 2) * 8 + (P & 3) * 2 : ((P - 16) >> 2) * 8 + ((P - 16) & 3) * 2 + 1; }
__host__ __device__ __forceinline__ int inproj_nlog(int n) { return (n & ~255) + inproj_lgroup((n & 255) >> 3) * 8 + (n & 7); }

#define GAS __attribute__((address_space(1)))
#define LAS __attribute__((address_space(3)))
typedef GAS unsigned gu32;
namespace pg8 {
#define PG8_LAS __attribute__((address_space(3)))
typedef unsigned short bf16_t;
typedef short bf16x8 __attribute__((ext_vector_type(8)));
typedef float f32x4 __attribute__((ext_vector_type(4)));
typedef unsigned u32x4 __attribute__((ext_vector_type(4)));
constexpr int BM = 256, BK = 64, HALF = 128, HTB = HALF * BK * 2  , STAGE_BYTES = 8 * HTB, NXCD = 8, WGM = 8;

__host__ __device__ __forceinline__ int lds_byte(int r, int c) { const int st = (r >> 4) * 2 + (c >> 5), rr = r & 15, cc = c & 31, ob = rr * 64 + cc * 2; return st * 1024 + (ob ^ (((ob >> 9) & 1) << 5)); }
__host__ __device__ __forceinline__ void stage_rc(int b, int& R, int& C) { const int st = b / 1024, sb = b % 1024, swz = sb ^ (((sb >> 9) & 1) << 5); R = (st >> 1) * 16 + swz / 64; C = (st & 1) * 32 + (swz % 64) / 2; }
__host__ __device__ __forceinline__ int perm32(int rho) { const int n = rho >> 4, i = rho & 15; return 8 * (i >> 2) + 4 * n + (i & 3); }

struct Unit { int pm, pn; };
struct Gemm { const bf16_t* A; const bf16_t* Bt; int M, N, K; };

struct StaticOrder {
    int nM, nN, nwg, G, c;
    __host__ __device__ void init(int M, int N, int G_, int c_) { nM = M / BM; nN = N / BM; nwg = nM * nN; G = G_; c = c_; }
    __host__ __device__ bool next(int i, Unit& u) const {
        const long L = (long)i * G + c; if (L >= nwg) return false;
        int wgid = (int)L; { const int q = nwg / NXCD, r = nwg % NXCD, xcd = wgid % NXCD, off = wgid / NXCD; wgid = (xcd < r ? xcd * (q + 1) : r * (q + 1) + (xcd - r) * q) + off; }
        const int nig = WGM * nN, gid = wgid / nig, fm = gid * WGM, gsz = (nM - fm) < WGM ? (nM - fm) : WGM;
        u.pm = fm + ((wgid % nig) % gsz); u.pn = (wgid % nig) / gsz; return true;
    }
    __device__ __forceinline__ void a_ready(const Unit&) const {}
    __device__ __forceinline__ void done(const Unit&) const {}
};

__device__ __forceinline__ unsigned cvt_pk_bf16(float lo, float hi) { unsigned r; asm volatile("v_cvt_pk_bf16_f32 %0, %1, %2" : "=v"(r) : "v"(lo), "v"(hi)); return r; }
}
namespace pg8 {
typedef int v8i_t __attribute__((ext_vector_type(8))); typedef int v4i_t __attribute__((ext_vector_type(4)));
__device__ __forceinline__ int pg8_lane_volatile() { int l; asm volatile("v_mbcnt_lo_u32_b32 %0, -1, 0\n\tv_mbcnt_hi_u32_b32 %0, -1, %0" : "=v"(l)); return l; }
template <class Epi, class Sched, bool ALIGN_EPI, bool GATHER, bool KSPLIT, bool FP8 = false, int SCW = 127, int SCA = 127, bool SC2 = false, int SCW2 = 127, int SCA2 = 127>
__device__ __forceinline__ void gemm_phase2(PG8_LAS unsigned char* lds, const int Kbytes, const int ldb_bytes, const Sched& S, const Epi& E, const int tid) {
    typedef typename Sched::UnitT UnitT;
    const int wid = __builtin_amdgcn_readfirstlane(tid >> 6), lane = tid & 63, wr = wid >> 2, wc = wid & 3, fr = lane & 15, fq = lane >> 4;
    int nt = Kbytes / (BK * 2); asm volatile("" : "+s"(nt));
    const int nth = nt / 2;
    unsigned voffB[2];
#pragma unroll
    for (int i = 0; i < 2; ++i) { int R[2], C[2]; stage_rc(tid * 16 + i * 8192, R[i], C[i]); const int Rb = Epi::PERM ? ((R[i] & ~31) + perm32(R[i] & 31)) : R[i]; voffB[i] = (unsigned)(Rb * ldb_bytes + C[i] * 2); }
    const size_t kstep = (size_t)(BK * 2);
    const size_t hstepB = (size_t)HALF * ldb_bytes;
    const unsigned ldsw = (unsigned)wid * 1024u;
    const int aoff = lds_byte(wr * 64 + fr, fq * 8), boff = lds_byte(wc * 32 + fr, fq * 8);
#define PG8_SA(b, h) (((b) * 2 + (h)) * HTB)
#define PG8_SB(b, h) ((4 + (b) * 2 + (h)) * HTB)
#define PG8_STAGE(bufoff, gbase, voff) do { _Pragma("unroll") for (int _i = 0; _i < 2; ++_i) \
        __builtin_amdgcn_global_load_lds((const unsigned*)((const char*)(gbase) + (voff)[_i]), (PG8_LAS unsigned*)(lds + (bufoff) + ldsw + _i * 8192), 16, 0, 0); } while (0)
#define PG8_LDA(dst, b, h) do { _Pragma("unroll") for (int m = 0; m < 4; ++m) _Pragma("unroll") for (int k = 0; k < 2; ++k) dst[m][k] = *(const PG8_LAS bf16x8*)(lds + PG8_SA(b, h) + aoff + m * 2048 + k * 1024); } while (0)
#define PG8_LDB(dst, b, h) do { _Pragma("unroll") for (int n = 0; n < 2; ++n) _Pragma("unroll") for (int k = 0; k < 2; ++k) dst[n][k] = *(const PG8_LAS bf16x8*)(lds + PG8_SB(b, h) + boff + n * 2048 + k * 1024); } while (0)
#define PG8_CAT8(x) __builtin_shufflevector(__builtin_bit_cast(v4i_t, (x)[0]), __builtin_bit_cast(v4i_t, (x)[1]), 0, 1, 2, 3, 4, 5, 6, 7)
#define PG8_MMA(ai, bj, At, Bt) do { __builtin_amdgcn_s_setprio(1); \
        if constexpr (FP8) { _Pragma("unroll") for (int m = 0; m < 4; ++m) _Pragma("unroll") for (int n = 0; n < 2; ++n) \
            acc[ai][bj][m][n] = __builtin_amdgcn_mfma_scale_f32_16x16x128_f8f6f4(PG8_CAT8(Bt[n]), PG8_CAT8(At[m]), acc[ai][bj][m][n], 0, 0, 0, scw_, 0, sca_); } \
        else { _Pragma("unroll") for (int m = 0; m < 4; ++m) _Pragma("unroll") for (int n = 0; n < 2; ++n) _Pragma("unroll") for (int k = 0; k < 2; ++k) \
            acc[ai][bj][m][n] = __builtin_amdgcn_mfma_f32_16x16x32_bf16(Bt[n][k], At[m][k], acc[ai][bj][m][n], 0, 0, 0); } \
        __builtin_amdgcn_s_setprio(0); } while (0)
#define PG8_STAGE1(bufoff, gbase, voff, _i) __builtin_amdgcn_global_load_lds((const unsigned*)((const char*)(gbase) + (voff)[_i]), (PG8_LAS unsigned*)(lds + (bufoff) + ldsw + (_i) * 8192), 16, 0, 0)
#define PG8_MF(ai, bj, m, n, At, Bt) do { if constexpr (FP8) acc[ai][bj][m][n] = __builtin_amdgcn_mfma_scale_f32_16x16x128_f8f6f4(PG8_CAT8(Bt[n]), PG8_CAT8(At[m]), acc[ai][bj][m][n], 0, 0, 0, scw_, 0, sca_); \
        else { acc[ai][bj][m][n] = __builtin_amdgcn_mfma_f32_16x16x32_bf16(Bt[n][0], At[m][0], acc[ai][bj][m][n], 0, 0, 0); acc[ai][bj][m][n] = __builtin_amdgcn_mfma_f32_16x16x32_bf16(Bt[n][1], At[m][1], acc[ai][bj][m][n], 0, 0, 0); } } while (0)
#define PG8_MF2(ai, bj, m, At, Bt) do { PG8_MF(ai, bj, m, 0, At, Bt); PG8_MF(ai, bj, m, 1, At, Bt); PG8_SCHED; } while (0)
#define PG8_CL1(ai, At, S0) do { __builtin_amdgcn_s_setprio(1); PG8_MF2(ai, 0, 0, At, B0); PG8_MF2(ai, 0, 1, At, B0); S0(0); PG8_SCHED; PG8_MF2(ai, 0, 2, At, B0); PG8_MF2(ai, 0, 3, At, B0); S0(1); PG8_SCHED; \
        PG8_MF2(ai, 1, 0, At, B1); PG8_MF2(ai, 1, 1, At, B1); PG8_MF2(ai, 1, 2, At, B1); PG8_MF2(ai, 1, 3, At, B1); __builtin_amdgcn_s_setprio(0); } while (0)
#define PG8_CL2(ai, At, S0, S1, S2) do { __builtin_amdgcn_s_setprio(1); PG8_MF2(ai, 0, 0, At, B0); S0(0); PG8_SCHED; PG8_MF2(ai, 0, 1, At, B0); S0(1); PG8_SCHED; PG8_MF2(ai, 0, 2, At, B0); S1(0); PG8_SCHED; PG8_MF2(ai, 0, 3, At, B0); S1(1); PG8_SCHED; \
        PG8_MF2(ai, 1, 0, At, B1); S2(0); PG8_SCHED; PG8_MF2(ai, 1, 1, At, B1); S2(1); PG8_SCHED; PG8_MF2(ai, 1, 2, At, B1); PG8_MF2(ai, 1, 3, At, B1); __builtin_amdgcn_s_setprio(0); } while (0)
#define PG8_WAIT_V(n) asm volatile("s_waitcnt vmcnt(" #n ")" ::: "memory")
#define PG8_WAIT_L(n) asm volatile("s_waitcnt lgkmcnt(" #n ")" ::: "memory")
#define PG8_BAR __builtin_amdgcn_s_barrier()
#define PG8_SCHED __builtin_amdgcn_sched_barrier(0)
#define PG8_PIN(ai) asm volatile("" :: "v"(acc[ai][0][0][0]), "v"(acc[ai][0][0][1]), "v"(acc[ai][0][1][0]), "v"(acc[ai][0][1][1]), "v"(acc[ai][0][2][0]), "v"(acc[ai][0][2][1]), "v"(acc[ai][0][3][0]), "v"(acc[ai][0][3][1]), \
        "v"(acc[ai][1][0][0]), "v"(acc[ai][1][0][1]), "v"(acc[ai][1][1][0]), "v"(acc[ai][1][1][1]), "v"(acc[ai][1][2][0]), "v"(acc[ai][1][2][1]), "v"(acc[ai][1][3][0]), "v"(acc[ai][1][3][1]))
#define PG8_BK(cb, cb2, kt) ((KSPLIT && (kt) >= nth) ? (cb2) + (size_t)((kt) - nth) * kstep : (cb) + (size_t)(kt) * kstep)
    UnitT cur, nxt; int ui = 0;
    if (!S.next(0, cur)) return;
    f32x4 acc[2][2][4][2];
#pragma unroll
    for (int a = 0; a < 2; ++a)
#pragma unroll
        for (int b = 0; b < 2; ++b)
#pragma unroll
            for (int m = 0; m < 4; ++m)
#pragma unroll
                for (int n = 0; n < 2; ++n) acc[a][b][m][n] = (f32x4){0.f, 0.f, 0.f, 0.f};
    bf16x8 At[4][2], B0[2][2], B1[2][2];
    unsigned vA[2][2];
    S.arows(cur, tid, vA);
    PG8_LAS u32x4* const vslot = (PG8_LAS u32x4*)(lds + STAGE_BYTES + 2048) + tid;
    const char* cA = S.aptr(cur); const char* cB = S.bptr(cur); const char* cB2 = KSPLIT ? S.bptr2(cur) : cB;
    PG8_STAGE(PG8_SB(0, 0), cB, voffB); PG8_STAGE(PG8_SB(0, 1), cB + hstepB, voffB); PG8_STAGE(PG8_SA(0, 0), cA, vA[0]); PG8_STAGE(PG8_SA(0, 1), cA, vA[1]);
    if (wr == 1) PG8_BAR;
    PG8_WAIT_V(2); PG8_BAR;
    PG8_STAGE(PG8_SB(1, 0), PG8_BK(cB, cB2, 1), voffB); PG8_STAGE(PG8_SA(1, 0), cA + kstep, vA[0]); PG8_STAGE(PG8_SB(1, 1), PG8_BK(cB, cB2, 1) + hstepB, voffB);
    PG8_WAIT_V(6); PG8_BAR;
    for (;;) {
        const bool has_next = S.next(ui + 1, nxt);
        const char* nA = has_next ? S.aptr(nxt) : cA; const char* nB = has_next ? S.bptr(nxt) : cB; const char* nB2 = (KSPLIT && has_next) ? S.bptr2(nxt) : cB2;
        if (GATHER && has_next) { unsigned vn_[2][2]; S.arows(nxt, wid * 64 + pg8_lane_volatile(), vn_); *vslot = (u32x4){vn_[0][0], vn_[0][1], vn_[1][0], vn_[1][1]}; }
        for (int t = 0; t < nt; t += 2) {
            const bool last = (t == nt - 2);
            const int scw_ = ((SC2 && t >= nth) ? SCW2 : SCW) * 0x01010101, sca_ = ((SC2 && t >= nth) ? SCA2 : SCA) * 0x01010101; (void)scw_; (void)sca_;
            const char* a1 = cA + (size_t)(t + 1) * kstep;
            const char* a2 = last ? nA : cA + (size_t)(t + 2) * kstep;
            const char* b2 = last ? nB : PG8_BK(cB, cB2, t + 2);
            const char* b3 = last ? (KSPLIT ? PG8_BK(nB, nB2, 1) : nB + kstep) : PG8_BK(cB, cB2, t + 3);
            const char* a3 = a2 + kstep;
#define ST_A11(i) PG8_STAGE1(PG8_SA(1, 1), a1, vA[1], i)
#define ST_B00(i) PG8_STAGE1(PG8_SB(0, 0), b2, voffB, i)
#define ST_B01(i) PG8_STAGE1(PG8_SB(0, 1), b2 + hstepB, voffB, i)
#define ST_A00(i) PG8_STAGE1(PG8_SA(0, 0), a2, vA[0], i)
#define ST_A01(i) PG8_STAGE1(PG8_SA(0, 1), a2, vA[1], i)
#define ST_B10(i) PG8_STAGE1(PG8_SB(1, 0), b3, voffB, i)
#define ST_B11(i) PG8_STAGE1(PG8_SB(1, 1), b3 + hstepB, voffB, i)
#define ST_A10(i) PG8_STAGE1(PG8_SA(1, 0), a3, vA[0], i)
            PG8_LDB(B0, 0, 0); PG8_LDB(B1, 0, 1); PG8_SCHED; PG8_LDA(At, 0, 0);
            PG8_WAIT_V(6); PG8_WAIT_L(0); PG8_BAR; PG8_CL1(0, At, ST_A11); PG8_PIN(0); PG8_BAR; PG8_SCHED;
            if (GATHER && last && has_next) { const u32x4 vn_ = *vslot; vA[0][0] = vn_.x; vA[0][1] = vn_.y; vA[1][0] = vn_.z; vA[1][1] = vn_.w; }
            PG8_LDA(At, 0, 1);
            PG8_WAIT_V(2); PG8_WAIT_L(0); PG8_BAR; PG8_CL2(1, At, ST_B00, ST_B01, ST_A00); PG8_PIN(1); PG8_BAR; PG8_SCHED;
            PG8_LDB(B0, 1, 0); PG8_LDB(B1, 1, 1); PG8_SCHED; PG8_LDA(At, 1, 0);
            PG8_WAIT_V(6); PG8_WAIT_L(0); PG8_BAR; PG8_CL1(0, At, ST_A01); PG8_PIN(0); PG8_BAR; PG8_SCHED;
            PG8_LDA(At, 1, 1);
            PG8_WAIT_V(2); PG8_WAIT_L(0); PG8_BAR; PG8_CL2(1, At, ST_B10, ST_B11, ST_A10); PG8_PIN(1); PG8_BAR; PG8_SCHED;
#undef ST_A11
#undef ST_B00
#undef ST_B01
#undef ST_A00
#undef ST_A01
#undef ST_B10
#undef ST_B11
#undef ST_A10
        }
        if constexpr (ALIGN_EPI) { if (wr == 0) PG8_BAR; }
        if constexpr (!Epi::AFTER_DRAIN) { const int le_ = pg8_lane_volatile(); E(acc, cur, wr, wc, le_ & 15, le_ >> 4); }
        if (!has_next) break;
#pragma unroll
        for (int a = 0; a < 2; ++a)
#pragma unroll
            for (int b = 0; b < 2; ++b)
#pragma unroll
                for (int m = 0; m < 4; ++m)
#pragma unroll
                    for (int n = 0; n < 2; ++n) acc[a][b][m][n] = (f32x4){0.f, 0.f, 0.f, 0.f};
        cur = nxt; cA = nA; cB = nB; cB2 = nB2; ++ui;
        if constexpr (ALIGN_EPI) { if (wr == 1) PG8_BAR; }
    }
    PG8_WAIT_V(0);
    if constexpr (!ALIGN_EPI) { if (wr == 0) PG8_BAR; }
    PG8_BAR;
    if constexpr (Epi::AFTER_DRAIN) { E.fused(acc, cur, wr, wc, fr, fq, lds, wid, lane); }
#undef PG8_SA
#undef PG8_SB
#undef PG8_STAGE
#undef PG8_LDA
#undef PG8_LDB
#undef PG8_MMA
#undef PG8_WAIT_V
#undef PG8_WAIT_L
#undef PG8_BAR
#undef PG8_SCHED
#undef PG8_BK
#undef PG8_PIN
#undef PG8_STAGE1
#undef PG8_MF
#undef PG8_MF2
#undef PG8_CL1
#undef PG8_CL2
#undef PG8_CAT8
}
}
namespace pg8 {
DEVFN unsigned pkbf(float lo, float hi) { return cvt_pk_bf16(lo, hi); }
struct DenseSched {
    typedef Unit UnitT;
    StaticOrder so; const char* A; const char* Bt; int lda, ldb;
    DEVFN bool next(int i, Unit& u) const { return so.next(i, u); }
    DEVFN const char* aptr(const Unit&) const { return A; }
    DEVFN void arows(const Unit& u, const int tid_, unsigned (&v)[2][2]) const {
        int R[2], C[2]; { int t_ = tid_; asm volatile("" : "+v"(t_)); stage_rc(t_ * 16, R[0], C[0]); stage_rc(t_ * 16 + 8192, R[1], C[1]); }
#pragma unroll
        for (int h = 0; h < 2; ++h)
#pragma unroll
            for (int i = 0; i < 2; ++i) v[h][i] = (unsigned)((u.pm * BM + h * HALF + R[i]) * lda + C[i] * 2); }
    DEVFN const char* bptr(const Unit& u) const { return Bt + (size_t)u.pn * BM * ldb; }
    DEVFN const char* bptr2(const Unit& u) const { return bptr(u); }
};
struct EpiInproj {
    static constexpr bool PERM = true, AFTER_DRAIN = false;
    bf16_t* O; const float* rope; float* kbar;
    DEVFN void operator()(f32x4 (&acc)[2][2][4][2], const Unit& u, int wr, int wc, int fr, int fq) const {
        const int pn = u.pn, row0 = u.pm * BM + wr * 64 + fr;
        if (pn < 4 && fq == 0) {
#pragma unroll
            for (int ai = 0; ai < 2; ++ai)
#pragma unroll
                for (int m = 0; m < 4; ++m) { const int t = (row0 + ai * HALF + m * 16) & (SEQ - 1); const f32x4* rp = (const f32x4*)(rope + t * 16);
#pragma unroll
                    for (int q = 0; q < 4; ++q) { const f32x4 cs = rp[q];
                        { const int d = 2 * q, n = d >> 2, e = d & 3; const float x1 = acc[ai][0][m][n][e], x2 = acc[ai][1][m][n][e]; acc[ai][0][m][n][e] = x1 * cs[0] - x2 * cs[1]; acc[ai][1][m][n][e] = x2 * cs[0] + x1 * cs[1]; }
                        { const int d = 2 * q + 1, n = d >> 2, e = d & 3; const float x1 = acc[ai][0][m][n][e], x2 = acc[ai][1][m][n][e]; acc[ai][0][m][n][e] = x1 * cs[2] - x2 * cs[3]; acc[ai][1][m][n][e] = x2 * cs[2] + x1 * cs[3]; } } }
        }
        if (pn == 2 || pn == 3) {
            float* kb = kbar + (size_t)((((u.pm >> 3) * NH + (pn - 2) * 4 + wc) * NBLK + (u.pm & 7)) * HD);
#pragma unroll
            for (int bj = 0; bj < 2; ++bj)
#pragma unroll
                for (int n = 0; n < 2; ++n)
#pragma unroll
                    for (int e = 0; e < 4; ++e) { float s = 0.f;
#pragma unroll
                        for (int ai = 0; ai < 2; ++ai)
#pragma unroll
                            for (int m = 0; m < 4; ++m) s += acc[ai][bj][m][n][e];
                        s = swz_xor_add(s, 1); s = swz_xor_add(s, 2); s = swz_xor_add(s, 4); s = swz_xor_add(s, 8);
                        if (fr == 0) atomicAdd(kb + (2 * fq + bj) * 8 + 4 * n + e, s * (1.f / MBLK)); }
        }
        if (pn < 2) {
#pragma unroll
            for (int ai = 0; ai < 2; ++ai)
#pragma unroll
                for (int bj = 0; bj < 2; ++bj)
#pragma unroll
                    for (int m = 0; m < 4; ++m) { acc[ai][bj][m][0] = acc[ai][bj][m][0] * QSCALE; acc[ai][bj][m][1] = acc[ai][bj][m][1] * QSCALE; } }
#pragma unroll
        for (int ai = 0; ai < 2; ++ai)
#pragma unroll
            for (int m = 0; m < 4; ++m) { bf16_t* rowp = O + (size_t)(row0 + ai * HALF + m * 16) * DIN + pn * BM + wc * 64;
#pragma unroll
                for (int bj = 0; bj < 2; ++bj) { const f32x4 v0 = acc[ai][bj][m][0], v1 = acc[ai][bj][m][1];
                    u32x4 w; w.x = pkbf(v0[0], v0[1]); w.y = pkbf(v0[2], v0[3]); w.z = pkbf(v1[0], v1[1]); w.w = pkbf(v1[2], v1[3]);
                    *(u32x4*)(rowp + (2 * fq + bj) * 8) = w; } }
    }
};
struct EpiF8 {
    static constexpr bool PERM = true, AFTER_DRAIN = false;
    unsigned char* O; int ldc;
    DEVFN void operator()(f32x4 (&acc)[2][2][4][2], const Unit& u, int wr, int wc, int fr, int fq) const {
#pragma unroll
        for (int ai = 0; ai < 2; ++ai)
#pragma unroll
            for (int m = 0; m < 4; ++m) { unsigned char* rowp = O + (size_t)(u.pm * BM + ai * HALF + wr * 64 + m * 16 + fr) * ldc + u.pn * BM + wc * 64 + fq * 16;
                const f32x4 a0 = acc[ai][0][m][0], a1 = acc[ai][0][m][1], b0 = acc[ai][1][m][0], b1 = acc[ai][1][m][1];
                u32x4 w; w.x = pk4_fp8(a0[0], a0[1], a0[2], a0[3]); w.y = pk4_fp8(a1[0], a1[1], a1[2], a1[3]); w.z = pk4_fp8(b0[0], b0[1], b0[2], b0[3]); w.w = pk4_fp8(b1[0], b1[1], b1[2], b1[3]);
                *(u32x4*)rowp = w; }
    }
};
struct MoeUnit { int pm, pn, cls, j, cnt; };
struct MoeBase {
    const PG8_LAS int* tp; const PG8_LAS int* cnt; const PG8_LAS int* tcls; int nunits, G, c, npn_shift;
    DEVFN bool next_(int i, MoeUnit& u) const {
        const int L = i * G + c; if (L >= nunits) return false;
        u.pm = L >> npn_shift; u.pn = L & ((1 << npn_shift) - 1);
        const int cls = __builtin_amdgcn_readfirstlane(tcls[u.pm]);
        u.cls = cls; u.j = u.pm - __builtin_amdgcn_readfirstlane(tp[cls]); u.cnt = __builtin_amdgcn_readfirstlane(cnt[cls]); return true; }
};
DEVFN void moe_experts(int cls, int& e1, int& e2) { const int g = cls / 6, p = cls % 6; const int lo = p < 3 ? 0 : (p < 5 ? 1 : 2), hi = p < 3 ? p + 1 : (p < 5 ? p - 1 : 3); e1 = g * 4 + lo; e2 = g * 4 + hi; }
struct GateUpSched : MoeBase {
    typedef MoeUnit UnitT;
    const char* HB; const int* list; const char* W;
    DEVFN bool next(int i, MoeUnit& u) const { return next_(i, u); }
    DEVFN const char* aptr(const MoeUnit&) const { return HB; }
    DEVFN void arows(const MoeUnit& u, const int tid_, unsigned (&v)[2][2]) const {
        int R[2], C[2]; { int t_ = tid_; asm volatile("" : "+v"(t_)); stage_rc(t_ * 16, R[0], C[0]); stage_rc(t_ * 16 + 8192, R[1], C[1]); }
#pragma unroll
        for (int h = 0; h < 2; ++h)
#pragma unroll
            for (int i = 0; i < 2; ++i) { const int li = 256 * u.j + h * HALF + R[i]; const int tok = list[(size_t)u.cls * LISTCAP + (li < u.cnt ? li : 256 * u.j)]; v[h][i] = (unsigned)(tok * DM + C[i] * 2); } }
    DEVFN const char* bptr(const MoeUnit& u) const { int e1, e2; moe_experts(u.cls, e1, e2); return W + (size_t)(u.pn < 4 ? e1 : e2) * DM * DM + (size_t)(u.pn & 3) * BM * DM; }
    DEVFN const char* bptr2(const MoeUnit& u) const { return bptr(u); }
};
struct DownSched : MoeBase {
    typedef MoeUnit UnitT;
    const char* ACT; const char* W;
    DEVFN bool next(int i, MoeUnit& u) const { return next_(i, u); }
    DEVFN const char* aptr(const MoeUnit&) const { return ACT; }
    DEVFN void arows(const MoeUnit& u, const int tid_, unsigned (&v)[2][2]) const {
        int R[2], C[2]; { int t_ = tid_; asm volatile("" : "+v"(t_)); stage_rc(t_ * 16, R[0], C[0]); stage_rc(t_ * 16 + 8192, R[1], C[1]); }
#pragma unroll
        for (int h = 0; h < 2; ++h)
#pragma unroll
            for (int i = 0; i < 2; ++i) v[h][i] = (unsigned)((u.pm * BM + h * HALF + R[i]) * DM + C[i] * 2); }
    DEVFN const char* bptr(const MoeUnit& u) const { int e1, e2; moe_experts(u.cls, e1, e2); return W + (size_t)e1 * DM * DE + (size_t)u.pn * BM * DE; }
    DEVFN const char* bptr2(const MoeUnit& u) const { int e1, e2; moe_experts(u.cls, e1, e2); return W + (size_t)e2 * DM * DE + (size_t)u.pn * BM * DE; }
};
struct EpiGateUp {
    static constexpr bool PERM = true, AFTER_DRAIN = false;
    unsigned char* ACT; const float* rw;
    DEVFN void operator()(f32x4 (&acc)[2][2][4][2], const MoeUnit& u, int wr, int wc, int fr, int fq) const {
        const int half = u.pn >> 2, jt = u.pn & 3;
        float wg8[2][4];
#pragma unroll
        for (int ai = 0; ai < 2; ++ai)
#pragma unroll
            for (int m = 0; m < 4; ++m) { const int li = 256 * u.j + ai * HALF + wr * 64 + m * 16 + fr; wg8[ai][m] = rw[((size_t)u.cls * LISTCAP + (li < u.cnt ? li : 256 * u.j)) * 2 + half]; }
#pragma unroll
        for (int ai = 0; ai < 2; ++ai)
#pragma unroll
            for (int mp = 0; mp < 4; mp += 2) {
                u32x2 w2[2];
#pragma unroll
                for (int q = 0; q < 2; ++q) { const int m = mp + q; const int li = 256 * u.j + ai * HALF + wr * 64 + m * 16 + fr;
                    const float wgt = li < u.cnt ? 8.f * wg8[ai][m] : 0.f;
                    f32x4 o[2];
#pragma unroll
                    for (int n = 0; n < 2; ++n) {
                        const f32x4 g = acc[ai][0][m][n], t = g * (-1.4426950408889634f);
                        f32x4 d; d.x = __builtin_amdgcn_exp2f(t.x); d.y = __builtin_amdgcn_exp2f(t.y); d.z = __builtin_amdgcn_exp2f(t.z); d.w = __builtin_amdgcn_exp2f(t.w);
                        d = d + 1.f;
                        f32x4 r; r.x = __builtin_amdgcn_rcpf(d.x); r.y = __builtin_amdgcn_rcpf(d.y); r.z = __builtin_amdgcn_rcpf(d.z); r.w = __builtin_amdgcn_rcpf(d.w);
                        o[n] = (g * r) * (acc[ai][1][m][n] * wgt); }
                    w2[q].x = pk4_fp8(o[0][0], o[0][1], o[0][2], o[0][3]); w2[q].y = pk4_fp8(o[1][0], o[1][1], o[1][2], o[1][3]); }
                const auto s0 = __builtin_amdgcn_permlane16_swap(w2[0].x, w2[1].x, false, false), s1 = __builtin_amdgcn_permlane16_swap(w2[0].y, w2[1].y, false, false);
                const u32x4 w = {s0[0], s1[0], s0[1], s1[1]};
                const int lr = ai * HALF + wr * 64 + (mp + (fq & 1)) * 16 + fr;
                *(u32x4*)(ACT + (size_t)(u.pm * BM + lr) * DM + half * 512 + jt * 128 + wc * 32 + (fq & 2) * 8) = w; }
    }
};
struct EpiDown {
    static constexpr bool PERM = true, AFTER_DRAIN = false;
    unsigned char* Y2; const int* list;
    DEVFN void operator()(f32x4 (&acc)[2][2][4][2], const MoeUnit& u, int wr, int wc, int fr, int fq_) const {
        int fq = fq_; asm volatile("" : "+v"(fq));
        int tk8[2][4];
#pragma unroll
        for (int ai = 0; ai < 2; ++ai)
#pragma unroll
            for (int m = 0; m < 4; ++m) { const int li = 256 * u.j + ai * HALF + wr * 64 + m * 16 + fr; tk8[ai][m] = list[(size_t)u.cls * LISTCAP + (li < u.cnt ? li : 256 * u.j)]; }
#pragma unroll
        for (int ai = 0; ai < 2; ++ai)
#pragma unroll
            for (int m = 0; m < 4; ++m) { const int li = 256 * u.j + ai * HALF + wr * 64 + m * 16 + fr;
                if (li < u.cnt) { const int tok = tk8[ai][m]; unsigned char* rowp = Y2 + (size_t)tok * DM + u.pn * BM + wc * 64 + fq * 16;
                    const f32x4 a0 = acc[ai][0][m][0], a1 = acc[ai][0][m][1], b0 = acc[ai][1][m][0], b1 = acc[ai][1][m][1];
                    u32x4 w; w.x = pk4_fp8(a0[0], a0[1], a0[2], a0[3]); w.y = pk4_fp8(a1[0], a1[1], a1[2], a1[3]); w.z = pk4_fp8(b0[0], b0[1], b0[2], b0[3]); w.w = pk4_fp8(b1[0], b1[1], b1[2], b1[3]);
                    *(u32x4*)rowp = w; } }
    }
};
}

#include <hip/hip_bf16.h>
#include <cmath>
namespace attn_body {
using bf16=__hip_bfloat16;
using bf16x8=__attribute__((ext_vector_type(8)))short;
using s16x4=__attribute__((ext_vector_type(4)))short;
using f32x16=__attribute__((ext_vector_type(16)))float;
using u32x4=__attribute__((ext_vector_type(4)))unsigned;
constexpr int BATCH=16,NHEAD=8,SEQ=2048,D=64,QP=2048,OP=1024;
constexpr int NW=8,QBLK=32,QB=QBLK*NW,KVBLK=64,NQB=SEQ/QB;
constexpr int ATTN_PITCH=QP, ATTN_UNIT_ROWS=QB;
__device__ __forceinline__ int crow(int r,int hi){return (r&3)+8*(r>>2)+4*hi;}
#define SBAR() __builtin_amdgcn_sched_barrier(0)
__device__ __forceinline__ void cmask(f32x16&p0,f32x16&p1,int jb,int qrel,int hi){
  const float NEG=-INFINITY; int kb=64*jb+4*hi;
  #pragma unroll
  for(int r=0;r<16;++r){int kv=kb+(r&3)+8*(r>>2); if(kv>qrel)p0[r]=NEG; if(kv+32>qrel)p1[r]=NEG;}
}

constexpr int NSLOT=3, SLOTB=8192;
constexpr int LDS_K=0, LDS_V=NSLOT*SLOTB, LDS_WS=2*NSLOT*SLOTB, LDS_OST=LDS_WS+NW*64*4, LDS_KBAR=LDS_OST+NW*4096, LDS_BYTES=LDS_KBAR+2048;
constexpr float NEGBIG=-1.0e30f; typedef float f32x4_t __attribute__((ext_vector_type(4)));
__device__ __forceinline__ float bfs(short v){return __uint_as_float(((unsigned)(unsigned short)v)<<16);}
constexpr float C2=0.125f*1.4426950408889634f;
__device__ __forceinline__ void glds16(const void*gsrc,unsigned lds_dst){unsigned keep;
  asm volatile("s_mov_b32 %0, m0\n\ts_mov_b32 m0, %2\n\ts_nop 0\n\tglobal_load_lds_dwordx4 %1, off\n\ts_mov_b32 m0, %0":"=&s"(keep):"v"(gsrc),"s"(lds_dst):"memory");}
__device__ __forceinline__ float max3f(float a,float b,float c){float r;asm("v_max3_f32 %0, %1, %2, %3":"=v"(r):"v"(a),"v"(b),"v"(c));return r;}
__device__ __forceinline__ float max2f(float a,float b){float r;asm("v_max_f32_e32 %0, %1, %2":"=v"(r):"v"(a),"v"(b));return r;}
__device__ __forceinline__ float fadd_s(float a,float b){float r;asm("v_add_f32_e32 %0, %1, %2":"=v"(r):"v"(a),"v"(b));return r;}
__device__ __forceinline__ float fsub_s(float a,float b){float r;asm("v_sub_f32_e32 %0, %1, %2":"=v"(r):"v"(a),"v"(b));return r;}
typedef float f32x2_t __attribute__((ext_vector_type(2))); typedef __bf16 bf16x2_t __attribute__((ext_vector_type(2)));
__device__ __forceinline__ unsigned cvtpk_s(float lo,float hi){f32x2_t v={lo,hi};bf16x2_t b=__builtin_convertvector(v,bf16x2_t);return __builtin_bit_cast(unsigned,b);}
#define WAIT_BAR(N) asm volatile("s_waitcnt vmcnt(" #N ") lgkmcnt(0)\n\ts_barrier":::"memory")

__device__ __forceinline__ void qkt(f32x16&p0,f32x16&p1,const char*Kslot,const bf16x8*qr,const f32x16&negm,int r32,int hi){
  const char*kb=Kslot+hi*1024+r32*16;
  #pragma unroll
  for(int d0=0;d0<4;++d0){
    const bf16x8 b0=*reinterpret_cast<const bf16x8*>(kb+d0*2048);
    const bf16x8 b1=*reinterpret_cast<const bf16x8*>(kb+d0*2048+512);
    if(d0==0){p0=__builtin_amdgcn_mfma_f32_32x32x16_bf16(b0,qr[0],negm,0,0,0);p1=__builtin_amdgcn_mfma_f32_32x32x16_bf16(b1,qr[0],negm,0,0,0);}
    else{p0=__builtin_amdgcn_mfma_f32_32x32x16_bf16(b0,qr[d0],p0,0,0,0);p1=__builtin_amdgcn_mfma_f32_32x32x16_bf16(b1,qr[d0],p1,0,0,0);}}
}
typedef __attribute__((address_space(3))) const char* lds_cptr;
typedef short v4i16_t __attribute__((ext_vector_type(4)));
__device__ __forceinline__ void kload8(bf16x8*kf,lds_cptr kp){
  kf[0]=*(const __attribute__((address_space(3))) bf16x8*)(kp);      kf[1]=*(const __attribute__((address_space(3))) bf16x8*)(kp+512);
  kf[2]=*(const __attribute__((address_space(3))) bf16x8*)(kp+2048); kf[3]=*(const __attribute__((address_space(3))) bf16x8*)(kp+2560);
  kf[4]=*(const __attribute__((address_space(3))) bf16x8*)(kp+4096); kf[5]=*(const __attribute__((address_space(3))) bf16x8*)(kp+4608);
  kf[6]=*(const __attribute__((address_space(3))) bf16x8*)(kp+6144); kf[7]=*(const __attribute__((address_space(3))) bf16x8*)(kp+6656);
}
__device__ __forceinline__ void kload2(bf16x8*kf,lds_cptr kp,int j){ kf[2*j]=*(const __attribute__((address_space(3))) bf16x8*)(kp+j*2048); kf[2*j+1]=*(const __attribute__((address_space(3))) bf16x8*)(kp+j*2048+512); }
__device__ __forceinline__ s16x4 vtr(lds_cptr p){ return __builtin_bit_cast(s16x4,__builtin_amdgcn_ds_read_tr16_b64_v4i16((__attribute__((address_space(3))) v4i16_t*)p)); }
__device__ __forceinline__ float rowmax(const f32x16&p0,const f32x16&p1){
  float a=max3f(p0[0],p0[1],p1[0]),b=max3f(p0[2],p0[3],p1[1]);a=max3f(a,p1[2],p1[3]);
  #pragma unroll
  for(int r=4;r<16;r+=4){a=max3f(a,p0[r],p0[r+1]);b=max3f(b,p0[r+2],p0[r+3]);a=max3f(a,p1[r],p1[r+1]);b=max3f(b,p1[r+2],p1[r+3]);}
  const float m=max2f(a,b);
  auto rr=__builtin_amdgcn_permlane32_swap(__float_as_uint(m),__float_as_uint(m),false,false);
  return max2f(__uint_as_float(rr[0]),__uint_as_float(rr[1]));
}
__device__ __forceinline__ void pv(f32x16*o,int vb,bf16x8 pa0,bf16x8 pa1,bf16x8 pa2,bf16x8 pa3){
  #pragma unroll
  for(int d0=0;d0<2;++d0){s16x4 lo[4],hi[4];
    #pragma unroll
    for(int ks=0;ks<4;++ks){
      asm volatile("ds_read_b64_tr_b16 %0,%1 offset:%c2":"=&v"(lo[ks]):"v"(vb),"i"(d0*4096+ks*1024):"memory");
      asm volatile("ds_read_b64_tr_b16 %0,%1 offset:%c2":"=&v"(hi[ks]):"v"(vb),"i"(d0*4096+ks*1024+512):"memory");}
    asm volatile("s_waitcnt lgkmcnt(0)":::"memory");SBAR();
    #define PK(k) (bf16x8){lo[k][0],lo[k][1],lo[k][2],lo[k][3],hi[k][0],hi[k][1],hi[k][2],hi[k][3]}
    o[d0]=__builtin_amdgcn_mfma_f32_32x32x16_bf16(pa0,PK(0),o[d0],0,0,0);
    o[d0]=__builtin_amdgcn_mfma_f32_32x32x16_bf16(pa1,PK(1),o[d0],0,0,0);
    o[d0]=__builtin_amdgcn_mfma_f32_32x32x16_bf16(pa2,PK(2),o[d0],0,0,0);
    o[d0]=__builtin_amdgcn_mfma_f32_32x32x16_bf16(pa3,PK(3),o[d0],0,0,0);
    #undef PK
  }
}

#ifndef ATTN_STORE16
#define ATTN_STORE16(p,v) (*(u32x4*)(p)=(v))
#endif
template<int THRL> __device__ __forceinline__ void attn_unit(int b,int h,int qb,const bf16*Q,const bf16*__restrict__ K,const bf16*__restrict__ V,bf16*O,const float*__restrict__ kbar,char*shm,const int tid){
  const int lane=tid&63,r32=lane&31,hi=lane>>5; const int wid=__builtin_amdgcn_readfirstlane(tid>>6);
  float kbv=0.f; { int tk=tid; asm volatile("":"+v"(tk)); if(qb>=4&&tk<448)kbv=kbar[tk]; }
  const long rowbase=(long)b*SEQ; const int q0=qb*QB;
  const bf16*Qw=Q+(rowbase+q0+wid*QBLK)*QP+h*D;
  const bf16*Kh=K+rowbase*QP+h*D,*Vh=V+rowbase*QP+h*D;
  const unsigned lds0=(unsigned)(uintptr_t)shm;
  float*wsf=(float*)(shm+LDS_WS)+wid*64;
  const bf16*ksrc=Kh+(long)lane*QP+wid*8;
  const bf16*vsrc=Vh+(long)(16*(wid&3)+(lane>>2))*QP+(wid>>2)*32+(lane&3)*8;
  const unsigned kdst=lds0+LDS_K+wid*1024, vdst=lds0+LDS_V+wid*1024;
  #define DMA_K(t,slot) glds16(ksrc+(long)(t)*KVBLK*QP,(unsigned)__builtin_amdgcn_readfirstlane(kdst+(slot)))
  #define DMA_V(t,slot) glds16(vsrc+(long)(t)*KVBLK*QP,(unsigned)__builtin_amdgcn_readfirstlane(vdst+(slot)))
  const int vb0=(int)(lds0+LDS_V)+((lane>>4)&1)*32+(lane&3)*8+(4*hi+((lane&15)>>2))*64;
  const char*Kbase=shm+LDS_K; bf16x8 kf[8];
  const lds_cptr shm3=(lds_cptr)shm; const lds_cptr kp0=shm3+LDS_K+hi*1024+r32*16; const lds_cptr vp0=shm3+LDS_V+((lane>>4)&1)*32+(lane&3)*8+(4*hi+((lane&15)>>2))*64;
  const int NT=(q0+QB)/KVBLK;
  DMA_K(0,0);DMA_V(0,0);DMA_K(1,SLOTB);
  bf16x8 qr[4];
  #pragma unroll
  for(int d0=0;d0<4;++d0)qr[d0]=*reinterpret_cast<const bf16x8*>(&Qw[(long)r32*QP+d0*16+hi*8]);
  float mhat=0.f,l_reg=0.f;f32x16 o[2];o[0]=f32x16{};o[1]=f32x16{};f32x16 negm=f32x16{};asm volatile("":"+v"(negm));
  const int qrel=wid*QBLK+r32;
  #define CMASK(P0,P1,t) do{int jb_=(t)-(NT-4); if(jb_>=0)cmask(P0,P1,jb_,qrel,hi);}while(0)
  bool resc=false;
  #define START(P0,P1) do{ const float rm=rowmax(P0,P1); resc=false; \
    { const float dl=selcur?rm:-64.f; mhat=fadd_s(mhat,dl); \
      _Pragma("unroll") for(int r=0;r<16;++r){P0[r]=fsub_s(P0[r],dl);P1[r]=fsub_s(P1[r],dl);} \
      { const float nv_=selcur?-mhat:NEGBIG; _Pragma("unroll") for(int r=0;r<16;++r)negm[r]=nv_; } asm volatile("":"+v"(negm)); } \
    _Pragma("unroll") for(int r=0;r<16;++r)P0[r]=__builtin_amdgcn_exp2f(P0[r]); }while(0)
  #define RESC() do{ if(resc){ asm volatile("s_waitcnt lgkmcnt(0)":::"memory"); \
      _Pragma("unroll") for(int d_=0;d_<2;++d_) _Pragma("unroll") for(int r=0;r<16;++r)o[d_][r]*=wsf[crow(r,hi)]; } }while(0)
  f32x16 pA0,pA1,pB0,pB1;
  int sl_prev=0,sl_cur=0,sl_next=SLOTB;
  #define ROT() do{sl_prev=sl_cur;sl_cur=sl_next;sl_next=(sl_next==(NSLOT-1)*SLOTB)?0:sl_next+SLOTB;}while(0)
  DMA_K(2,2*SLOTB);
  if(qb>=4){ if(tid<448){ const unsigned hb=__builtin_bit_cast(unsigned,kbv); const unsigned hr=(hb+0x7fffu+((hb>>16)&1u))&0xffff0000u; const float lo_=kbv-__builtin_bit_cast(float,hr); const unsigned lb=__builtin_bit_cast(unsigned,lo_);
      ((unsigned short*)(shm+LDS_KBAR))[tid]=(unsigned short)(hr>>16); ((unsigned short*)(shm+LDS_KBAR+1024))[tid]=(unsigned short)((lb+0x7fffu+((lb>>16)&1u))>>16); } }
  WAIT_BAR(3);
  unsigned bmask=(1u<<(qb+1))-1u;
  if(qb>=4){ float gsc[8];
    { const lds_cptr kb3=shm3+LDS_KBAR+(r32&7)*128+hi*16; f32x16 g=f32x16{};
      _Pragma("unroll") for(int d0=0;d0<4;++d0){ const bf16x8 ah=*(const __attribute__((address_space(3))) bf16x8*)(kb3+d0*32), al=*(const __attribute__((address_space(3))) bf16x8*)(kb3+1024+d0*32);
        g=__builtin_amdgcn_mfma_f32_32x32x16_bf16(ah,qr[d0],g,0,0,0); g=__builtin_amdgcn_mfma_f32_32x32x16_bf16(al,qr[d0],g,0,0,0); }
      _Pragma("unroll") for(int r=0;r<4;++r){ auto rr=__builtin_amdgcn_permlane32_swap(__float_as_uint(g[r]),__float_as_uint(g[r]),false,false); gsc[r]=__uint_as_float(rr[0]); gsc[4+r]=__uint_as_float(rr[1]); } }
    _Pragma("unroll") for(int n=0;n<7;++n) gsc[n]=(n<qb)?gsc[n]:-3.0e38f;
    bmask=1u<<qb;
    _Pragma("unroll") for(int pick=0;pick<3;++pick){ float best=-3.4e38f; unsigned bi=0u;
      _Pragma("unroll") for(int n=0;n<7;++n){ const bool ok=!((bmask>>n)&1u)&&gsc[n]>best; best=ok?gsc[n]:best; bi=ok?(unsigned)n:bi; }
      bmask|=1u<<bi; } }
  bool selcur=(bmask&1u)!=0u;
  { const float nv=selcur?0.f:NEGBIG; _Pragma("unroll") for(int r=0;r<16;++r)negm[r]=nv; asm volatile("":"+v"(negm)); }
  qkt(pA0,pA1,Kbase,qr,negm,r32,hi);asm volatile("s_nop 15\n\ts_nop 7":"+v"(pA0),"+v"(pA1));CMASK(pA0,pA1,0);
  START(pA0,pA1);
  _Pragma("unroll") for(int r=0;r<16;++r)pA1[r]=__builtin_amdgcn_exp2f(pA1[r]);
  WAIT_BAR(0);
  DMA_K(3,0);DMA_V(1,SLOTB);
  ROT();
  kload8(kf,kp0+sl_cur);
  WAIT_BAR(2);
  s16x4 vlo[8],vhi[8]; u32x4 pw0,pw1,pw2,pw3;
  #define PKW(P,B) cvtpk_s(P[B],P[B+1])
  #define PAF(k) __builtin_bit_cast(bf16x8,pw##k)
  #define VFR(i) (bf16x8){vlo[i][0],vlo[i][1],vlo[i][2],vlo[i][3],vhi[i][0],vhi[i][1],vhi[i][2],vhi[i][3]}
  #define PIN(x) asm volatile("":"+v"(x))
  #define MX3(a,b,c) __builtin_fmaxf(__builtin_fmaxf((a),(b)),(c))
  #define GAPA(MF,A0,A1,A2,A3,W0,W1,PW) do{ MF; sacc+=A0; sacc+=A1; sacc+=A2; sacc+=A3; PIN(sacc); W0; W1; PIN(PW); SBAR(); }while(0)
  #define EX(v) __builtin_amdgcn_exp2f(v)
  #define GAPB(MF,X,B) do{ MF; X[B]=EX(X[B]); X[B+1]=EX(X[B+1]); X[B+2]=EX(X[B+2]); X[B+3]=EX(X[B+3]); PIN(X); SBAR(); }while(0)
  #define VRD(i) do{ vlo[i]=vtr(vp_+(((i)>>2)*4096+((i)&3)*1024)); vhi[i]=vtr(vp_+(((i)>>2)*4096+((i)&3)*1024+512)); }while(0)
  #define KRD(G,j) do{ if(G){ kload2(kf,kp0+sl_next,j); SBAR(); } }while(0)
  #define STEP(C0,C1,P0,P1,t,GK,GV,GL) do{ SBAR(); \
    const lds_cptr vp_=vp0+sl_prev; \
    VRD(0); SBAR(); float sacc=(P0[0]+P0[1]); \
    GAPA(C0=__builtin_amdgcn_mfma_f32_32x32x16_bf16(kf[0],qr[0],negm,0,0,0), P0[2],P0[3],P0[4],P0[5],     pw0[0]=PKW(P0,0), pw0[1]=PKW(P0,2), pw0); \
    VRD(4); SBAR(); GAPA(C1=__builtin_amdgcn_mfma_f32_32x32x16_bf16(kf[1],qr[0],negm,0,0,0), P0[6],P0[7],P0[8],P0[9],     pw0[2]=PKW(P0,4), pw0[3]=PKW(P0,6), pw0); \
    VRD(1); SBAR(); GAPA(C0=__builtin_amdgcn_mfma_f32_32x32x16_bf16(kf[2],qr[1],C0,0,0,0),   P0[10],P0[11],P0[12],P0[13], pw1[0]=PKW(P0,8), pw1[1]=PKW(P0,10), pw1); \
    VRD(5); SBAR(); GAPA(C1=__builtin_amdgcn_mfma_f32_32x32x16_bf16(kf[3],qr[1],C1,0,0,0),   P0[14],P0[15],P1[0],P1[1],   pw1[2]=PKW(P0,12),pw1[3]=PKW(P0,14), pw1); \
    VRD(2); SBAR(); GAPA(C0=__builtin_amdgcn_mfma_f32_32x32x16_bf16(kf[4],qr[2],C0,0,0,0),   P1[2],P1[3],P1[4],P1[5],     pw2[0]=PKW(P1,0), pw2[1]=PKW(P1,2), pw2); \
    VRD(6); SBAR(); GAPA(C1=__builtin_amdgcn_mfma_f32_32x32x16_bf16(kf[5],qr[2],C1,0,0,0),   P1[6],P1[7],P1[8],P1[9],     pw2[2]=PKW(P1,4), pw2[3]=PKW(P1,6), pw2); \
    VRD(3); SBAR(); GAPA(C0=__builtin_amdgcn_mfma_f32_32x32x16_bf16(kf[6],qr[3],C0,0,0,0),   P1[10],P1[11],P1[12],P1[13], pw3[0]=PKW(P1,8), pw3[1]=PKW(P1,10), pw3); \
    VRD(7); SBAR(); GAPA(C1=__builtin_amdgcn_mfma_f32_32x32x16_bf16(kf[7],qr[3],C1,0,0,0),   P1[14],P1[15],0.f,0.f,       pw3[2]=PKW(P1,12),pw3[3]=PKW(P1,14), pw3); \
    l_reg+=sacc; \
    if(GK){DMA_K((t)+3,sl_cur);} if(GV){DMA_V((t)+1,sl_next);} \
    CMASK(C0,C1,t); \
    { float a=MX3(C0[0],C0[1],C1[0]),b=MX3(C0[2],C0[3],C1[1]); a=MX3(a,C1[2],C1[3]); \
      _Pragma("unroll") for(int r=4;r<16;r+=4){a=MX3(a,C0[r],C0[r+1]);b=MX3(b,C0[r+2],C0[r+3]);a=MX3(a,C1[r],C1[r+1]);b=MX3(b,C1[r+2],C1[r+3]);} \
      float rm=__builtin_fmaxf(a,b); { auto rr=__builtin_amdgcn_permlane32_swap(__float_as_uint(rm),__float_as_uint(rm),false,false); rm=__builtin_fmaxf(__uint_as_float(rr[0]),__uint_as_float(rr[1])); } \
      resc=false; \
      if(__builtin_expect(__any(rm>(float)THRL),0)){ const float dl=__builtin_fmaxf(rm,0.f); mhat+=dl; \
        _Pragma("unroll") for(int r=0;r<16;++r){C0[r]-=dl;C1[r]-=dl;} \
        { const float nv_=selcur?-mhat:NEGBIG; _Pragma("unroll") for(int r=0;r<16;++r)negm[r]=nv_; } asm volatile("":"+v"(negm)); \
        const float f=__builtin_amdgcn_exp2f(-dl); l_reg*=f; if(hi==0)wsf[r32]=f; resc=true; } } \
    SBAR(); \
    GAPB(o[0]=__builtin_amdgcn_mfma_f32_32x32x16_bf16(PAF(0),VFR(0),o[0],0,0,0), C0,0); \
    GAPB(o[1]=__builtin_amdgcn_mfma_f32_32x32x16_bf16(PAF(0),VFR(4),o[1],0,0,0), C0,4); \
    KRD(GL,0); GAPB(o[0]=__builtin_amdgcn_mfma_f32_32x32x16_bf16(PAF(1),VFR(1),o[0],0,0,0), C0,8); \
    KRD(GL,1); GAPB(o[1]=__builtin_amdgcn_mfma_f32_32x32x16_bf16(PAF(1),VFR(5),o[1],0,0,0), C0,12); \
    KRD(GL,2); GAPB(o[0]=__builtin_amdgcn_mfma_f32_32x32x16_bf16(PAF(2),VFR(2),o[0],0,0,0), C1,0); \
    KRD(GL,3); GAPB(o[1]=__builtin_amdgcn_mfma_f32_32x32x16_bf16(PAF(2),VFR(6),o[1],0,0,0), C1,4); \
    GAPB(o[0]=__builtin_amdgcn_mfma_f32_32x32x16_bf16(PAF(3),VFR(3),o[0],0,0,0), C1,8); \
    GAPB(o[1]=__builtin_amdgcn_mfma_f32_32x32x16_bf16(PAF(3),VFR(7),o[1],0,0,0), C1,12); \
    }while(0)
  #define BLKSEL(tt) do{ if((((tt))&3)==0){ selcur=((bmask>>((tt)>>2))&1u)!=0u; const float nv_=selcur?-mhat:NEGBIG; _Pragma("unroll") for(int r=0;r<16;++r)negm[r]=nv_; asm volatile("":"+v"(negm)); } }while(0)
  int t=1;
  #undef CMASK
  #define CMASK(P0,P1,t) do{}while(0)
  for(;t+5<NT;t+=2){
    STEP(pB0,pB1,pA0,pA1,t,true,true,true);     WAIT_BAR(2); RESC(); ROT(); BLKSEL(t+1);
    STEP(pA0,pA1,pB0,pB1,t+1,true,true,true);   WAIT_BAR(2); RESC(); ROT();
  }
  #undef CMASK
  #define CMASK(P0,P1,t) do{int jb_=(t)-(NT-4); if(jb_>=0)cmask(P0,P1,jb_,qrel,hi);}while(0)
  #define ENDW(tt) do{ if((tt)+3<NT){WAIT_BAR(2);} else if((tt)+2<NT){WAIT_BAR(1);} else {WAIT_BAR(0);} }while(0)
  for(;t+1<NT;t+=2){
    STEP(pB0,pB1,pA0,pA1,t,(t+3<NT),(t+1<NT),(t+1<NT));       ENDW(t);   RESC(); ROT(); BLKSEL(t+1);
    STEP(pA0,pA1,pB0,pB1,t+1,(t+4<NT),(t+2<NT),(t+2<NT));     ENDW(t+1); RESC(); ROT();
  }
  STEP(pB0,pB1,pA0,pA1,NT-1,false,false,false); RESC();
  { float sacc=pB0[0]+pB0[1]; _Pragma("unroll") for(int r=2;r<16;++r)sacc+=pB0[r]; _Pragma("unroll") for(int r=0;r<16;++r)sacc+=pB1[r]; l_reg+=sacc;
    pw0=(u32x4){PKW(pB0,0),PKW(pB0,2),PKW(pB0,4),PKW(pB0,6)};pw1=(u32x4){PKW(pB0,8),PKW(pB0,10),PKW(pB0,12),PKW(pB0,14)};pw2=(u32x4){PKW(pB1,0),PKW(pB1,2),PKW(pB1,4),PKW(pB1,6)};pw3=(u32x4){PKW(pB1,8),PKW(pB1,10),PKW(pB1,12),PKW(pB1,14)};
    SBAR(); pv(o,vb0+sl_cur,PAF(0),PAF(1),PAF(2),PAF(3)); }
  #undef PKW
  #undef PAF
  #undef VFR
  #undef PIN
  #undef MX3
  #undef GAPA
  #undef GAPB
  #undef EX
  #undef VRD
  #undef KRD
  #undef STEP
  #undef ENDW
  {auto rr=__builtin_amdgcn_permlane32_swap(__float_as_uint(l_reg),__float_as_uint(l_reg),false,false);l_reg=__uint_as_float(rr[0])+__uint_as_float(rr[1]);}
  if(hi==0)wsf[32+r32]=l_reg;asm volatile("s_waitcnt lgkmcnt(0)":::"memory");
  float rli[16];
  #pragma unroll
  for(int r=0;r<16;++r)rli[r]=__builtin_amdgcn_rcpf(wsf[32+crow(r,hi)]);
  unsigned char*Ow=(unsigned char*)O+(rowbase+q0+wid*QBLK)*OP+h*D;
  { unsigned char*stg=(unsigned char*)(shm+LDS_OST)+wid*4096;
    #pragma unroll
    for(int r=0;r<16;++r){const int orow=crow(r,hi);
      #pragma unroll
      for(int d0=0;d0<2;++d0){const float ov=__builtin_amdgcn_fmed3f(o[d0][r]*rli[r]*32.f,-448.f,448.f); stg[orow*64+d0*32+r32]=(unsigned char)__builtin_amdgcn_cvt_pk_fp8_f32(ov,ov,0,false);}}
    asm volatile("s_waitcnt lgkmcnt(0)":::"memory");
    #pragma unroll
    for(int i=0;i<2;++i){const int row=i*16+(lane>>2),ch=lane&3; const u32x4 v=*(const u32x4*)(stg+row*64+ch*16); ATTN_STORE16(Ow+(long)row*OP+ch*16,v);} }
  asm volatile("s_waitcnt lgkmcnt(0)\n\ts_barrier":::"memory");
  #undef BLKSEL
  #undef DMA_K
  #undef DMA_V
  #undef CMASK
  #undef START
  #undef RESC
  #undef ROT
}
constexpr int ATTN_LDS_BYTES=LDS_BYTES;
struct AttnTensors { const bf16* Q; const bf16* K; const bf16* V; bf16* O; const float* kbar; };
struct AttnUnit { int bh; int qb; };
struct StaticOrder {
  int vcu, G;
  __device__ __forceinline__ explicit StaticOrder(int grid,int block):vcu((grid%8==0)?(block%8)*(grid/8)+block/8:block),G(grid){}
  __device__ __forceinline__ bool next(int i,AttnUnit&u)const{ const int pr=(vcu+(i>>2)*G)*2+((i>>1)&1); if(pr>=BATCH*NHEAD*4)return false;
    const int s=pr&3; u.bh=pr>>2; u.qb=(i&1)?7-s:s; return true; }
  __device__ __forceinline__ void a_ready(const AttnUnit&)const{}
  __device__ __forceinline__ void done(const AttnUnit&)const{}
};
template<class Sched,int THRL=8> __device__ __forceinline__ void attn_phase(char*lds,const AttnTensors&T,const Sched&S,const int tid_in){
  AttnUnit u; int tid_=tid_in; asm volatile("":"+v"(tid_));
  for(int i=0;S.next(i,u);++i){ S.a_ready(u); attn_unit<THRL>(u.bh/NHEAD,u.bh%NHEAD,u.qb,T.Q,T.K,T.V,T.O,T.kbar+(long)u.bh*512,lds,tid_); S.done(u); }
}
#undef SBAR
#undef WAIT_BAR
}

#define XB_TMO      128
#define XB_XCNT(j)  (256  + 64 * (j))
#define XB_XSUB(j)  (1280 + 64 * (j))
#define XB_XGEN(j)  (2304 + 64 * (j))
#define XB_TOP      3328
#define XB_TOPGEN   3392
#define XCD_BAR_WORDS 3456
#define XB_SPIN_CAP (1u << 18)

__device__ __forceinline__ unsigned xb_ld(unsigned* p)              { return __hip_atomic_load(p, __ATOMIC_RELAXED, __HIP_MEMORY_SCOPE_AGENT); }
__device__ __forceinline__ unsigned xb_add(unsigned* p, unsigned v) { return __hip_atomic_fetch_add(p, v, __ATOMIC_RELAXED, __HIP_MEMORY_SCOPE_AGENT); }
__device__ __forceinline__ unsigned xb_xcc_id() { return (unsigned)__builtin_amdgcn_s_getreg((3 << 11) | 20) & 0xFu; }
#define XB_SPIN(cond, bar) do { unsigned _sp = 0; while (cond) { __builtin_amdgcn_s_sleep(1); \
    if ((++_sp & 255u) == 0u) { if (xb_ld(&(bar)[XB_TMO])) break; if (_sp > XB_SPIN_CAP) { atomicAdd(&(bar)[XB_TMO], 1u); break; } } } } while (0)

struct XcdBarrier {
    unsigned* bar; unsigned x;
    volatile LAS unsigned* st;
};

__device__ __forceinline__ XcdBarrier xcd_barrier_post(unsigned* bar, volatile LAS unsigned* st) {
    XcdBarrier b; b.bar = bar; b.x = xb_xcc_id(); b.st = st;
    if (threadIdx.x == 0) (void)xb_add(&bar[XB_XCNT(b.x)], 1u);
    return b;
}
__device__ __forceinline__ void xcd_barrier_complete(unsigned* bar, unsigned x, unsigned& nloc, unsigned& nx) {
    const unsigned G = gridDim.x * gridDim.y * gridDim.z;
    unsigned sum, cnt, mine, sp = 0u;
    for (;;) {
        sum = 0u; cnt = 0u; mine = 0u;
#pragma unroll
        for (unsigned j = 0; j < 16; ++j) { const unsigned c = xb_ld(&bar[XB_XCNT(j)]); sum += c; cnt += (c > 0u) ? 1u : 0u; mine = (j == x) ? c : mine; }
        if (sum == G) break;
        __builtin_amdgcn_s_sleep(1);
        if ((++sp & 255u) == 0u) { if (xb_ld(&bar[XB_TMO])) break; if (sp > XB_SPIN_CAP) { atomicAdd(&bar[XB_TMO], 1u); break; } }
    }
    nloc = mine > 0u ? mine : 1u; nx = cnt > 0u ? cnt : 1u;
}

__device__ __forceinline__ void xcd_barrier(const XcdBarrier& b, const bool is_t0) {
    asm volatile("s_waitcnt vmcnt(0)" ::: "memory");
    __syncthreads();
    if (is_t0) {
        unsigned* bar = b.bar;
        __builtin_amdgcn_s_waitcnt(0);
        unsigned nloc = b.st[0], nx = b.st[1];
        if (nloc == 0u) { xcd_barrier_complete(bar, b.x, nloc, nx); b.st[0] = nloc; b.st[1] = nx; }
        const unsigned old = xb_add(&bar[XB_XSUB(b.x)], 1u);
        const unsigned gen = old / nloc;
        if (old + 1u == (gen + 1u) * nloc) {
            __builtin_amdgcn_fence(__ATOMIC_RELEASE, "agent");
            asm volatile("s_waitcnt vmcnt(0)" ::: "memory");
            const unsigned og = xb_add(&bar[XB_TOP], 1u);
            const unsigned tg = og / nx;
            if (og + 1u == (tg + 1u) * nx) xb_add(&bar[XB_TOPGEN], 1u);
            else XB_SPIN(xb_ld(&bar[XB_TOPGEN]) == tg, bar);
            __builtin_amdgcn_fence(__ATOMIC_ACQUIRE, "agent");
            xb_add(&bar[XB_XGEN(b.x)], 1u);
            asm volatile("s_waitcnt vmcnt(0)" ::: "memory");
        } else {
            XB_SPIN(xb_ld(&bar[XB_XGEN(b.x)]) == gen, bar);
            __builtin_amdgcn_fence(__ATOMIC_ACQUIRE, "agent");
            asm volatile("s_waitcnt vmcnt(0)" ::: "memory");
        }
    }
    __syncthreads();
}

struct Args { const float* in[17]; float* out; unsigned char* ws; int ph_lo, ph_hi; };
enum { I_X = 0, I_C, I_WMOD, I_BMOD, I_WIN, I_WPOOL, I_PSCALE, I_WOUT, I_LN1G, I_LN1B, I_WR, I_RB, I_WG, I_WU, I_WDN, I_LN2G, I_LN2B };

DEVFN int lane_id_volatile() { int l; asm volatile("v_mbcnt_lo_u32_b32 %0, -1, 0\n\tv_mbcnt_hi_u32_b32 %0, -1, %0" : "=v"(l)); return l; }
struct Ctx { unsigned char* lds; __attribute__((address_space(3))) unsigned char* lds3; int tid, lane, wave, G, bid, gw, NGW; };

DEVFN void transpose_item_f8(const float* src, int ldn, int k0, int col, unsigned char* dst, int ldk, int dst_row0, int dst_k0, float* scr, int lane) {
#pragma unroll 8
    for (int i = 0; i < 32; ++i) { const int kk = 2 * i + (lane >> 5); scr[kk * 33 + (lane & 31)] = src[(size_t)(k0 + kk) * ldn + col]; }
    LDS_WAIT();
    const int c = lane & 7;
#pragma unroll
    for (int j = 0; j < 4; ++j) { const int n = (lane >> 3) + 8 * j; const float* s = scr + (8 * c) * 33 + n;
        u32x2 o; o.x = pk4_fp8(32.f * s[0 * 33], 32.f * s[1 * 33], 32.f * s[2 * 33], 32.f * s[3 * 33]); o.y = pk4_fp8(32.f * s[4 * 33], 32.f * s[5 * 33], 32.f * s[6 * 33], 32.f * s[7 * 33]);
        *(u32x2*)(dst + (size_t)(dst_row0 + n) * ldk + dst_k0 + 8 * c) = o; }
    LDS_WAIT();
}

DEVFN void ph_prologue(const Args& a, const Ctx& c) {
    unsigned char* ws = a.ws;
    float* scr = (float*)(c.lds + c.wave * 16384);
    const int lane = c.lane;
    constexpr int N1 = 2 * 16 * 64, N2 = 2 * 8 * 32, N3 = 32 * 16 * 32, N4 = 32 * 8 * 32, N5 = 2 * 64 * 16, N6 = 256;
    for (int it = c.gw; it < N1 + N2 + N3 + N4 + N5 + N6; it += c.NGW) {
        int r = it;
        if (r < N1) {
            const int l = r / 1024, kb = (r % 1024) / 64, nb = r % 64;
            const int nphys = 32 * nb + (lane & 31);
            transpose_item_f8(a.in[I_WIN] + (size_t)l * DM * DIN, DIN, 64 * kb, inproj_nlog(nphys), (unsigned char*)(ws + WS_WIN) + (size_t)l * DIN * DM, DM, 32 * nb, 64 * kb, scr, lane);
            continue; }
        r -= N1;
        if (r < N2) {
            const int l = r / 256, kb = (r % 256) / 32, nb = r % 32;
            transpose_item_f8(a.in[I_WOUT] + (size_t)l * DM * DM, DM, 64 * kb, inproj_nlog(32 * nb + (lane & 31)), (unsigned char*)(ws + WS_WOUT) + (size_t)l * DM * DM, DM, 32 * nb, 64 * kb, scr, lane);
            continue; }
        r -= N2;
        if (r < N3) {
            const int le = r / 512, kb = (r % 512) / 32, nb = r % 32;
            const int n = 32 * nb + (lane & 31), jt = n >> 8, bj = (n >> 7) & 1, i = n & 127;
            const float* src = (bj ? a.in[I_WU] : a.in[I_WG]) + (size_t)le * DM * DE;
            transpose_item_f8(src, DE, 64 * kb, jt * 128 + i, (unsigned char*)(ws + WS_WGU) + (size_t)le * DM * DM, DM, 32 * nb, 64 * kb, scr, lane);
            continue; }
        r -= N3;
        if (r < N4) {
            const int le = r / 256, kb = (r % 256) / 32, nb = r % 32;
            transpose_item_f8(a.in[I_WDN] + (size_t)le * DE * DM, DM, 64 * kb, inproj_nlog(32 * nb + (lane & 31)), (unsigned char*)(ws + WS_WD) + (size_t)le * DM * DE, DE, 32 * nb, 64 * kb, scr, lane);
            continue; }
        r -= N4;
        if (r < N5) {
            const int l = r / 1024, kdg = (r % 1024) / 16, nb = r % 16;
            const int n = nb * 64 + lane, kd0 = kdg * 8, g = kd0 >> 7, c0 = kd0 & 127;
            const float* wo = a.in[I_WOUT] + (size_t)l * DM * DM + (size_t)(512 + g * 128) * DM + inproj_nlog(n);
            const float* ps = a.in[I_PSCALE] + l * 512 + g * 128;
            const float* wp = a.in[I_WPOOL] + ((size_t)(l * 4 + g) * 128 + c0) * 128;
            float acc[8];
#pragma unroll
            for (int j = 0; j < 8; ++j) acc[j] = 0.f;
            for (int e = 0; e < 128; ++e) { const float w = wo[(size_t)e * DM] * ps[e];
#pragma unroll
                for (int j = 0; j < 8; ++j) acc[j] += wp[j * 128 + e] * w; }
            u32x2 o; o.x = pk4_fp8(128.f * acc[0], 128.f * acc[1], 128.f * acc[2], 128.f * acc[3]); o.y = pk4_fp8(128.f * acc[4], 128.f * acc[5], 128.f * acc[6], 128.f * acc[7]);
            *(u32x2*)((unsigned char*)(ws + WS_WOUT) + (size_t)l * DM * DM + (size_t)n * DM + 512 + kd0) = o;
            continue; }
        r -= N5;
        {
            const int ent = r * 64 + lane, pos = ent >> 3, i = ent & 7;
            const float inv = (float)exp2(-(double)i / 8.0 * 18.931568569324174);
            const float ang = (float)pos * inv;
            float* t = (float*)(ws + WS_ROPE) + ent * 2;
            t[0] = (float)cos((double)ang); t[1] = (float)sin((double)ang);
        }
    }
    for (int i = c.bid * 512 + c.tid; i < 2 * NB * NH * NBLK * HD; i += c.G * 512) ((float*)(ws + WS_KBAR))[i] = 0.f;
    __syncthreads();
    if (c.bid < 192) {
        float* condT = (float*)c.lds;
        float* red = (float*)(c.lds + 65536);
        for (int idx = c.tid; idx < NB * DM; idx += 512) { const int b = idx >> 10, k = idx & 1023; const float v = a.in[I_C][idx]; condT[k * 16 + b] = v / (1.f + __expf(-v)); }
        __syncthreads();
        for (int u = c.bid; u < 192; u += c.G) {
            const int l = u / 96, n0 = (u % 96) * 64;
            const float* W = a.in[I_WMOD] + (size_t)l * DM * NMOD + n0 + lane;
            float acc[16];
#pragma unroll
            for (int b = 0; b < 16; ++b) acc[b] = 0.f;
            for (int k = 128 * c.wave; k < 128 * c.wave + 128; k += 8) {
                float wv[8];
#pragma unroll
                for (int j = 0; j < 8; ++j) wv[j] = W[(size_t)(k + j) * NMOD];
#pragma unroll
                for (int j = 0; j < 8; ++j) {
                    const f32x4* cp = (const f32x4*)(condT + (k + j) * 16);
#pragma unroll
                    for (int q = 0; q < 4; ++q) { const f32x4 cv = cp[q]; acc[4 * q + 0] += cv.x * wv[j]; acc[4 * q + 1] += cv.y * wv[j]; acc[4 * q + 2] += cv.z * wv[j]; acc[4 * q + 3] += cv.w * wv[j]; }
                }
            }
#pragma unroll
            for (int b = 0; b < 16; ++b) red[(c.wave * 16 + b) * 64 + lane] = acc[b];
            __syncthreads();
            for (int o = c.tid; o < 1024; o += 512) { const int b = o >> 6, cc = o & 63; float s = a.in[I_BMOD][l * NMOD + n0 + cc];
#pragma unroll
                for (int w = 0; w < 8; ++w) s += red[(w * 16 + b) * 64 + cc];
                ((float*)(ws + WS_MOD))[(size_t)(l * NB + b) * NMOD + n0 + cc] = s; }
            __syncthreads();
        }
    }
}

DEVFN void row_stats(const f32x4 (&v)[4], float& mean, float& rstd) {
    float s = 0.f, q = 0.f;
#pragma unroll
    for (int j = 0; j < 4; ++j) { s += (v[j].x + v[j].y) + (v[j].z + v[j].w); q += (v[j].x * v[j].x + v[j].y * v[j].y) + (v[j].z * v[j].z + v[j].w * v[j].w); }
    s = swz_xor_add(s, 1); q = swz_xor_add(q, 1); s = swz_xor_add(s, 2); q = swz_xor_add(q, 2); s = swz_xor_add(s, 4); q = swz_xor_add(q, 4);
    s = swz_xor_add(s, 8); q = swz_xor_add(q, 8); s = swz_xor_add(s, 16); q = swz_xor_add(q, 16); s = half_swap_add(s); q = half_swap_add(q);
    mean = s * (1.f / DM);
    rstd = __builtin_amdgcn_rsqf(fmaxf(q * (1.f / DM) - mean * mean, 0.f) + LN_EPS);
}
DEVFN void row_load(const float* p, int lane, f32x4 (&v)[4]) {
#pragma unroll
    for (int j = 0; j < 4; ++j) v[j] = *(const f32x4*)(p + 4 * lane + 256 * j);
}
DEVFN void row_mod_store(f32x4 (&v)[4], const float* sc, const float* sh, bf16_t* out, int lane) {
    float mean, rstd; row_stats(v, mean, rstd);
#pragma unroll
    for (int j = 0; j < 4; ++j) {
        const f32x4 s = *(const f32x4*)(sc + 4 * lane + 256 * j), h = *(const f32x4*)(sh + 4 * lane + 256 * j);
        v[j] = (v[j] - mean) * rstd * (s + 1.f) + h;
        u32x2 o; o.x = pk2(v[j].x, v[j].y); o.y = pk2(v[j].z, v[j].w);
        *(u32x2*)(out + 4 * lane + 256 * j) = o;
    }
}

DEVFN void ph_pool(const Args& a, const Ctx& c) {
    const bf16_t* P = (const bf16_t*)(a.ws + WS_QKVP) + 1536; unsigned char* AD = (unsigned char*)(a.ws + WS_AD) + 512;
    for (int it = c.bid * 512 + c.tid; it < (NTOK / 8) * 64; it += c.G * 512) {
        const int cg = it & 63, m0 = (it >> 6) * 8, t0 = m0 & (SEQ - 1), g = cg >> 4, w = 2 << g;
        const bf16_t* pc = P + cg * 8;
        u32x4 rows[23];
#pragma unroll
        for (int k = 0; k < 23; ++k) { const int dt = k - 15; rows[k] = (u32x4){0u, 0u, 0u, 0u}; if (dt > -w && t0 + dt >= 0) rows[k] = *(const u32x4*)(pc + (size_t)(m0 + dt) * DIN); }
        float s[8];
#pragma unroll
        for (int j = 0; j < 8; ++j) s[j] = 0.f;
#pragma unroll
        for (int k = 0; k < 15; ++k) { const u32x4 v = rows[k]; s[0] += bf_lo(v.x); s[1] += bf_hi(v.x); s[2] += bf_lo(v.y); s[3] += bf_hi(v.y); s[4] += bf_lo(v.z); s[5] += bf_hi(v.z); s[6] += bf_lo(v.w); s[7] += bf_hi(v.w); }
#pragma unroll
        for (int r = 0; r < 8; ++r) {
            const int t = t0 + r; const u32x4 v = rows[15 + r];
            const float f[8] = {bf_lo(v.x), bf_hi(v.x), bf_lo(v.y), bf_hi(v.y), bf_lo(v.z), bf_hi(v.z), bf_lo(v.w), bf_hi(v.w)};
#pragma unroll
            for (int j = 0; j < 8; ++j) s[j] += f[j];
            const int cnt = (t + 1 < w) ? t + 1 : w; const float ic = 1.f / (float)cnt;
            u32x2 o; o.x = pk4_fp8(s[0] * ic - f[0], s[1] * ic - f[1], s[2] * ic - f[2], s[3] * ic - f[3]); o.y = pk4_fp8(s[4] * ic - f[4], s[5] * ic - f[5], s[6] * ic - f[6], s[7] * ic - f[7]);
            *(u32x2*)(AD + (size_t)(m0 + r) * DM + cg * 8) = o;
            u32x4 q = rows[r];
            if (w == 8) q = rows[r + 8]; else if (w == 4) q = rows[r + 12]; else if (w == 2) q = rows[r + 14];
            s[0] -= bf_lo(q.x); s[1] -= bf_hi(q.x); s[2] -= bf_lo(q.y); s[3] -= bf_hi(q.y); s[4] -= bf_lo(q.z); s[5] -= bf_hi(q.z); s[6] -= bf_lo(q.w); s[7] -= bf_hi(q.w);
        }
    }
}

constexpr size_t WS_X1B = WS_X1, WS_X2B = WS_X1 + 64 * MiB;
constexpr int ROWS_PER_WAVE = 16;
DEVFN void vec_load(const float* p, int lane, f32x4 (&v)[4]) {
#pragma unroll
    for (int j = 0; j < 4; ++j) v[j] = *(const f32x4*)(p + 4 * lane + 256 * j);
}
DEVFN void bfrow_load(const bf16_t* p, int lane, u32x2 (&w)[4]) {
#pragma unroll
    for (int j = 0; j < 4; ++j) w[j] = *(const u32x2*)(p + 4 * lane + 256 * j);
}
DEVFN f32x4 bf4(u32x2 w) { return (f32x4){bf_lo(w.x), bf_hi(w.x), bf_lo(w.y), bf_hi(w.y)}; }
DEVFN void bfrow_store(bf16_t* p, int lane, const f32x4 (&v)[4]) {
#pragma unroll
    for (int j = 0; j < 4; ++j) { u32x2 o; o.x = pk2(v[j].x, v[j].y); o.y = pk2(v[j].z, v[j].w); *(u32x2*)(p + 4 * lane + 256 * j) = o; }
}
DEVFN void f8row_store(unsigned char* p, int lane, const f32x4 (&v)[4]) {
#pragma unroll
    for (int j = 0; j < 4; ++j) *(unsigned*)(p + 4 * lane + 256 * j) = pk4_fp8(v[j].x, v[j].y, v[j].z, v[j].w);
}
DEVFN void ln_mod(f32x4 (&v)[4], const f32x4 (&sc)[4], const f32x4 (&sh)[4]) {
    float mean, rstd; row_stats(v, mean, rstd);
#pragma unroll
    for (int j = 0; j < 4; ++j) v[j] = (v[j] - mean) * rstd * (sc[j] + 1.f) + sh[j];
}
DEVFN void ln_aff(f32x4 (&v)[4], const f32x4 (&g)[4], const f32x4 (&b)[4]) {
    float mean, rstd; row_stats(v, mean, rstd);
#pragma unroll
    for (int j = 0; j < 4; ++j) v[j] = (v[j] - mean) * rstd * g[j] + b[j];
}

DEVFN void ph_h1_rows(const Args& a, const Ctx& c) {
    const float* mod = (const float*)(a.ws + WS_MOD); bf16_t* HB = (bf16_t*)(a.ws + WS_HB);
    for (int base = c.gw * ROWS_PER_WAVE; base < NTOK; base += c.NGW * ROWS_PER_WAVE) {
        const float* mb = mod + (size_t)(base >> 11) * NMOD;
        f32x4 sc[4], sh[4]; vec_load(mb + DM, c.lane, sc); vec_load(mb, c.lane, sh);
        f32x4 cur[4], nxt[4]; vec_load(a.in[I_X] + (size_t)base * DM, c.lane, cur);
#pragma unroll 1
        for (int i = 0; i < ROWS_PER_WAVE; ++i) {
            const int m = base + i;
            if (i + 1 < ROWS_PER_WAVE) vec_load(a.in[I_X] + (size_t)(m + 1) * DM, c.lane, nxt);
            ln_mod(cur, sc, sh); f8row_store((unsigned char*)HB + (size_t)m * DM, c.lane, cur);
#pragma unroll
            for (int j = 0; j < 4; ++j) cur[j] = nxt[j];
        }
    }
}

DEVFN f32x4 reduce16(const float (&lg)[16]) {
    float t[8], u[4];
#pragma unroll
    for (int e = 0; e < 8; ++e) { auto rr = __builtin_amdgcn_permlane32_swap(__float_as_uint(lg[e]), __float_as_uint(lg[e + 8]), false, false); t[e] = __uint_as_float(rr[0]) + __uint_as_float(rr[1]); }
#pragma unroll
    for (int k = 0; k < 4; ++k) { auto rr = __builtin_amdgcn_permlane16_swap(__float_as_uint(t[k]), __float_as_uint(t[k + 4]), false, false); u[k] = __uint_as_float(rr[0]) + __uint_as_float(rr[1]); }
#pragma unroll
    for (int k = 0; k < 4; ++k) { u[k] = swz_xor_add(u[k], 1); u[k] = swz_xor_add(u[k], 2); u[k] = swz_xor_add(u[k], 4); u[k] = swz_xor_add(u[k], 8); }
    return (f32x4){u[0], u[1], u[2], u[3]};
}

DEVFN void rowc_load(const Args& a, int l, int m, int lane, f32x4 (&x)[4], unsigned (&y)[4]) {
    if (l == 0) vec_load(a.in[I_X] + (size_t)m * DM, lane, x);
    else { u32x2 w[4]; bfrow_load((const bf16_t*)(a.ws + WS_X2B) + (size_t)m * DM, lane, w);
#pragma unroll
        for (int j = 0; j < 4; ++j) { x[j].x = __uint_as_float(w[j].x); x[j].y = __uint_as_float(w[j].y); } }
#pragma unroll
    for (int j = 0; j < 4; ++j) y[j] = *(const unsigned*)((const unsigned char*)(a.ws + WS_QKVP) + (size_t)m * DM + 4 * lane + 256 * j);
}
DEVFN void rowc_step(const Args& a, int l, int m, int lane, const f32x4 (&x)[4], const unsigned (&y)[4], const float* vg1, const float* vsc, const float* vsh, f32x4 (&v)[4]) {
    int z_ = 0; asm volatile("" : "+v"(z_));
    f32x4 g1[4]; vec_load(vg1 + z_, lane, g1);
#pragma unroll
    for (int j = 0; j < 4; ++j) { const f32x4 xv = (l == 0) ? x[j] : bf4((u32x2){__float_as_uint(x[j].x), __float_as_uint(x[j].y)}); v[j] = xv * ALPHA + g1[j] * f8x4_to_f32(y[j], 1.f / YSCALE); }
    { f32x4 lg[4], lb[4]; vec_load(a.in[I_LN1G] + l * DM + z_, lane, lg); vec_load(a.in[I_LN1B] + l * DM + z_, lane, lb); ln_aff(v, lg, lb); }
    bfrow_store((bf16_t*)(a.ws + WS_X1B) + (size_t)m * DM, lane, v);
    { f32x4 sc[4], sh[4]; vec_load(vsc + z_, lane, sc); vec_load(vsh + z_, lane, sh); ln_mod(v, sc, sh); }
    f8row_store((unsigned char*)(a.ws + WS_HB) + (size_t)m * DM, lane, v);
}

DEVFN void ph_rows_c(const Args& a, const Ctx& c, int l, bool publish) {
    const float* mod = (const float*)(a.ws + WS_MOD) + (size_t)l * NB * NMOD;
    const bf16_t* Y = (const bf16_t*)(a.ws + WS_QKVP); const bf16_t* X2B = (const bf16_t*)(a.ws + WS_X2B);
    bf16_t* X1B = (bf16_t*)(a.ws + WS_X1B); bf16_t* HB = (bf16_t*)(a.ws + WS_HB);
    float* wr = (float*)c.lds;
    float* vsc = (float*)(c.lds + 65536); float* vsh = vsc + DM; float* vg1 = vsh + DM;
    int* lcnt = (int*)(c.lds + 65536 + 12288); int* lbase = lcnt + 32;
    int* rcls = lbase + 32; float* rw1 = (float*)(rcls + 8 * 64); float* rw2 = rw1 + 8 * 64; int* rrow = (int*)(rw2 + 8 * 64); float* lgs = (float*)(rrow + 8 * 64);
#pragma unroll
    for (int it = 0; it < 8; ++it) { const int idx = it * 512 + c.tid, k = idx & 1023, q = idx >> 10;
        const f32x4 w = *(const f32x4*)(a.in[I_WR] + k * 16 + 4 * q);
        wr[(4 * q + 0) * DM + k] = w.x; wr[(4 * q + 1) * DM + k] = w.y; wr[(4 * q + 2) * DM + k] = w.z; wr[(4 * q + 3) * DM + k] = w.w; }
    if (c.tid < 32) lcnt[c.tid] = 0;
    __syncthreads();
    int nr = 0;
    for (int base = c.gw * ROWS_PER_WAVE; base < NTOK; base += c.NGW * ROWS_PER_WAVE) {
        const float* mb = mod + (size_t)(base >> 11) * NMOD;
        __syncthreads();
        for (int i = c.tid; i < 3 * DM; i += 512) vsc[i] = (i < DM) ? mb[4 * DM + i] : (i < 2 * DM ? mb[3 * DM + (i - DM)] : mb[2 * DM + (i - 2 * DM)]);
        __syncthreads();
#pragma unroll 1
        for (int i = 0; i < ROWS_PER_WAVE; i += 2) {
            const int m = __builtin_amdgcn_readfirstlane(base + i);
            f32x4 va[4], vb[4];
            { f32x4 xa[4], xb[4]; unsigned ya[4], yb[4];
              rowc_load(a, l, m, c.lane, xa, ya); rowc_load(a, l, m + 1, c.lane, xb, yb);
              rowc_step(a, l, m, c.lane, xa, ya, vg1, vsc, vsh, va);
              rowc_step(a, l, m + 1, c.lane, xb, yb, vg1, vsc, vsh, vb); }
            typedef float f32x2_t __attribute__((ext_vector_type(2)));
            f32x2_t acc2[16];
#pragma unroll
            for (int e = 0; e < 16; ++e) acc2[e] = (f32x2_t){0.f, 0.f};
#pragma unroll
            for (int j = 0; j < 4; ++j) {
                const f32x2_t p0 = {va[j].x, vb[j].x}, p1 = {va[j].y, vb[j].y}, p2 = {va[j].z, vb[j].z}, p3 = {va[j].w, vb[j].w};
#pragma unroll
                for (int e = 0; e < 16; ++e) { const f32x4 w = *(const f32x4*)(wr + e * DM + 4 * c.lane + 256 * j);
                    acc2[e] = __builtin_elementwise_fma(p0, (f32x2_t){w.x, w.x}, acc2[e]); acc2[e] = __builtin_elementwise_fma(p1, (f32x2_t){w.y, w.y}, acc2[e]);
                    acc2[e] = __builtin_elementwise_fma(p2, (f32x2_t){w.z, w.z}, acc2[e]); acc2[e] = __builtin_elementwise_fma(p3, (f32x2_t){w.w, w.w}, acc2[e]);
                    if ((e & 7) == 7) __builtin_amdgcn_sched_barrier(0); } }
            float la[16], lb2[16];
#pragma unroll
            for (int e = 0; e < 16; ++e) { la[e] = acc2[e].x; lb2[e] = acc2[e].y; }
            { const f32x4 ua = reduce16(la), ub = reduce16(lb2);
              if ((c.lane & 15) == 0) { *(f32x4*)(lgs + (c.wave * 16 + i) * 16 + (c.lane >> 4) * 4) = ua; *(f32x4*)(lgs + (c.wave * 16 + i + 1) * 16 + (c.lane >> 4) * 4) = ub; } }
        }
        LDS_WAIT();
        if (c.lane < ROWS_PER_WAVE) {
            float lg16[16], rb[16];
#pragma unroll
            for (int e = 0; e < 16; ++e) rb[e] = a.in[I_RB][e];
#pragma unroll
            for (int q = 0; q < 4; ++q) { const f32x4 t = *(const f32x4*)(lgs + (c.wave * 16 + c.lane) * 16 + 4 * q); lg16[4 * q] = t.x; lg16[4 * q + 1] = t.y; lg16[4 * q + 2] = t.z; lg16[4 * q + 3] = t.w; }
            float mx = lg16[0];
#pragma unroll
            for (int e = 1; e < 16; ++e) mx = fmaxf(mx, lg16[e]);
            float sum = 0.f, scr[16];
#pragma unroll
            for (int e = 0; e < 16; ++e) { scr[e] = __expf(lg16[e] - mx); sum += scr[e]; }
            const float isum = 1.f / sum;
#pragma unroll
            for (int e = 0; e < 16; ++e) scr[e] *= isum;
            float bestg = -3.4e38f; int gb = 0, bi1 = 0, bi2 = 1; float bw1 = 0.f, bw2 = 0.f;
#pragma unroll
            for (int g = 0; g < 4; ++g) {
                float m1 = scr[4 * g] + rb[4 * g], s1 = scr[4 * g]; int i1 = 0;
#pragma unroll
                for (int q = 1; q < 4; ++q) { const float sv = scr[4 * g + q] + rb[4 * g + q]; const bool ok = sv > m1; m1 = ok ? sv : m1; s1 = ok ? scr[4 * g + q] : s1; i1 = ok ? q : i1; }
                float m2 = -3.4e38f, s2 = 0.f; int i2 = 0;
#pragma unroll
                for (int q = 0; q < 4; ++q) { const float sv = scr[4 * g + q] + rb[4 * g + q]; const bool ok = (q != i1) && sv > m2; m2 = ok ? sv : m2; s2 = ok ? scr[4 * g + q] : s2; i2 = ok ? q : i2; }
                const float gs = m1 + m2; const bool better = gs > bestg;
                bestg = better ? gs : bestg; gb = better ? g : gb; bi1 = better ? i1 : bi1; bi2 = better ? i2 : bi2; bw1 = better ? s1 : bw1; bw2 = better ? s2 : bw2;
            }
            const float inv = 1.f / (bw1 + bw2);
            const int lo = bi1 < bi2 ? bi1 : bi2, hi2 = bi1 < bi2 ? bi2 : bi1;
            const float wlo = (bi1 < bi2 ? bw1 : bw2) * inv, whi = (bi1 < bi2 ? bw2 : bw1) * inv;
            const int pidx = lo == 0 ? hi2 - 1 : (lo == 1 ? hi2 + 1 : 5);
            const int slot = c.wave * 64 + nr + c.lane;
            rcls[slot] = gb * 6 + pidx; rw1[slot] = wlo; rw2[slot] = whi; rrow[slot] = base + c.lane;
        }
        nr += ROWS_PER_WAVE;
        LDS_WAIT();
    }
    LDS_WAIT();
    if (!publish) return;
    int rank = 0, cls = 0;
    if (c.lane < nr) { cls = rcls[c.wave * 64 + c.lane]; rank = atomicAdd(&lcnt[cls], 1); }
    __syncthreads();
    if (c.tid < NCLS) lbase[c.tid] = (int)__hip_atomic_fetch_add((unsigned*)(a.ws + WS_CTL) + CW_CNT + l * 32 + c.tid, (unsigned)lcnt[c.tid], RLX_AGENT);
    __syncthreads();
    if (c.lane < nr) {
        const int pos = lbase[cls] + rank;
        ((int*)(a.ws + WS_LIST))[(size_t)cls * LISTCAP + pos] = rrow[c.wave * 64 + c.lane];
        float* rw = (float*)(a.ws + WS_RW) + ((size_t)cls * LISTCAP + pos) * 2;
        rw[0] = rw1[c.wave * 64 + c.lane]; rw[1] = rw2[c.wave * 64 + c.lane];
    }
}

DEVFN void ph_rows_g(const Args& a, const Ctx& c, int l) {
    const float* mod = (const float*)(a.ws + WS_MOD) + (size_t)l * NB * NMOD;
    const bf16_t* X1B = (const bf16_t*)(a.ws + WS_X1B); const unsigned char* Y2 = (const unsigned char*)(a.ws + WS_AD);
    bf16_t* X2B = (bf16_t*)(a.ws + WS_X2B); bf16_t* HB = (bf16_t*)(a.ws + WS_HB);
    for (int base = c.gw * ROWS_PER_WAVE; base < NTOK; base += c.NGW * ROWS_PER_WAVE) {
        const float* mb = mod + (size_t)(base >> 11) * NMOD; const float* mb1 = mb + (size_t)NB * NMOD;
        f32x4 g2[4], lg[4], lb[4], sc[4], sh[4];
        vec_load(mb + 5 * DM, c.lane, g2); vec_load(a.in[I_LN2G] + l * DM, c.lane, lg); vec_load(a.in[I_LN2B] + l * DM, c.lane, lb);
        if (l == 0) { vec_load(mb1 + DM, c.lane, sc); vec_load(mb1, c.lane, sh); }
        u32x2 xa[4], xb[4], xna[4], xnb[4]; unsigned ya[4], yb[4], yna[4], ynb[4];
        bfrow_load(X1B + (size_t)base * DM, c.lane, xa); bfrow_load(X1B + (size_t)(base + 1) * DM, c.lane, xb);
#pragma unroll
        for (int j = 0; j < 4; ++j) { ya[j] = *(const unsigned*)(Y2 + (size_t)base * DM + 4 * c.lane + 256 * j); yb[j] = *(const unsigned*)(Y2 + (size_t)(base + 1) * DM + 4 * c.lane + 256 * j); }
#pragma unroll 1
        for (int i = 0; i < ROWS_PER_WAVE; i += 2) {
            const int m = base + i;
            if (i + 2 < ROWS_PER_WAVE) { bfrow_load(X1B + (size_t)(m + 2) * DM, c.lane, xna); bfrow_load(X1B + (size_t)(m + 3) * DM, c.lane, xnb);
#pragma unroll
                for (int j = 0; j < 4; ++j) { yna[j] = *(const unsigned*)(Y2 + (size_t)(m + 2) * DM + 4 * c.lane + 256 * j); ynb[j] = *(const unsigned*)(Y2 + (size_t)(m + 3) * DM + 4 * c.lane + 256 * j); } }
            f32x4 va[4], vb[4];
#pragma unroll
            for (int j = 0; j < 4; ++j) { va[j] = bf4(xa[j]) * ALPHA + g2[j] * f8x4_to_f32(ya[j], 1.f / YSCALE); vb[j] = bf4(xb[j]) * ALPHA + g2[j] * f8x4_to_f32(yb[j], 1.f / YSCALE); }
            ln_aff(va, lg, lb); ln_aff(vb, lg, lb);
            if (l == 0) { bfrow_store(X2B + (size_t)m * DM, c.lane, va); bfrow_store(X2B + (size_t)(m + 1) * DM, c.lane, vb); ln_mod(va, sc, sh); ln_mod(vb, sc, sh);
                f8row_store((unsigned char*)HB + (size_t)m * DM, c.lane, va); f8row_store((unsigned char*)HB + (size_t)(m + 1) * DM, c.lane, vb); }
            else {
#pragma unroll
                for (int j = 0; j < 4; ++j) { *(f32x4*)(a.out + (size_t)m * DM + 4 * c.lane + 256 * j) = va[j]; *(f32x4*)(a.out + (size_t)(m + 1) * DM + 4 * c.lane + 256 * j) = vb[j]; } }
#pragma unroll
            for (int j = 0; j < 4; ++j) { xa[j] = xna[j]; xb[j] = xnb[j]; ya[j] = yna[j]; yb[j] = ynb[j]; }
        }
    }
}

constexpr int MOETAB_OFF = 131072 + 512;
DEVFN void ph_inproj_fast(const Args& a, const Ctx& c, int l, bool dummy_kbar) {
    pg8::DenseSched S; S.so.init(NTOK, DIN, c.G, c.bid); S.A = (const char*)(a.ws + WS_HB); S.Bt = (const char*)(a.ws + WS_WIN) + (size_t)l * DIN * DM; S.lda = DM; S.ldb = DM;
    const pg8::EpiInproj E{(bf16_t*)(a.ws + WS_QKVP), (const float*)(a.ws + WS_ROPE), (dummy_kbar ? (float*)(a.ws + WS_RW) : (float*)(a.ws + WS_KBAR)) + (size_t)l * NB * NH * NBLK * HD};
    pg8::gemm_phase2<pg8::EpiInproj, pg8::DenseSched, true, true, false, true, 127 - 5, 127>(c.lds3, DM, DM, S, E, c.tid);
}
DEVFN void ph_wout_fast(const Args& a, const Ctx& c, int l) {
    pg8::DenseSched S; S.so.init(NTOK, DM, c.G, c.bid); S.A = (const char*)(a.ws + WS_AD); S.Bt = (const char*)(a.ws + WS_WOUT) + (size_t)l * DM * DM; S.lda = DM; S.ldb = DM;
    const pg8::EpiF8 E{(unsigned char*)(a.ws + WS_QKVP), DM};
    pg8::gemm_phase2<pg8::EpiF8, pg8::DenseSched, true, true, false, true, 127 - 5 + 4, 127 - 5, true, 127 - 7 + 4, 127>    (c.lds3, DM, DM, S, E, c.tid);
}
DEVFN void moe_table_lds(const Args& a, const Ctx& c, int l) {
    int* cnt = (int*)(c.lds + MOETAB_OFF); int* tp = cnt + 32;
    if (c.tid < NCLS) cnt[c.tid] = (int)__hip_atomic_load((unsigned*)(a.ws + WS_CTL) + CW_CNT + l * 32 + c.tid, RLX_AGENT);
    __syncthreads();
    if (c.tid <= NCLS) { int s = 0;
#pragma unroll
        for (int k = 0; k < NCLS; ++k) { const int nk = (cnt[k] + 255) >> 8; s += (k < c.tid) ? nk : 0; }
        tp[c.tid] = s; }
    __syncthreads();
    int* tcls = tp + 32;
    for (int T = c.tid; T < tp[NCLS]; T += 512) { int k = 0; while (T >= tp[k + 1]) ++k; tcls[T] = k; }
    __syncthreads();
}
DEVFN void ph_gateup_fast(const Args& a, const Ctx& c, int l) {
    moe_table_lds(a, c, l);
    pg8::GateUpSched S; S.cnt = (const LAS int*)(c.lds3 + MOETAB_OFF); S.tp = S.cnt + 32; S.tcls = S.tp + 32; S.npn_shift = 3; S.nunits = S.tp[NCLS] * 8; S.G = c.G; S.c = (c.G % 8 == 0) ? (c.bid % 8) * (c.G / 8) + c.bid / 8 : c.bid;
    S.HB = (const char*)(a.ws + WS_HB); S.list = (const int*)(a.ws + WS_LIST); S.W = (const char*)(a.ws + WS_WGU) + (size_t)l * NE * DM * DM;
    const pg8::EpiGateUp E{(unsigned char*)(a.ws + WS_QKVP), (const float*)(a.ws + WS_RW)};
    pg8::gemm_phase2<pg8::EpiGateUp, pg8::GateUpSched, true, true, false, true, 127 - 5, 127>(c.lds3, DM, DM, S, E, c.tid);
}
DEVFN void ph_down_fast(const Args& a, const Ctx& c, int l) {
    moe_table_lds(a, c, l);
    pg8::DownSched S; S.cnt = (const LAS int*)(c.lds3 + MOETAB_OFF); S.tp = S.cnt + 32; S.tcls = S.tp + 32; S.npn_shift = 2; S.nunits = S.tp[NCLS] * 4; S.G = c.G; S.c = (c.G % 8 == 0) ? (c.bid % 8) * (c.G / 8) + c.bid / 8 : c.bid;
    S.ACT = (const char*)(a.ws + WS_QKVP); S.W = (const char*)(a.ws + WS_WD) + (size_t)l * NE * DM * DE;
    const pg8::EpiDown E{(unsigned char*)(a.ws + WS_AD), (const int*)(a.ws + WS_LIST)};
    pg8::gemm_phase2<pg8::EpiDown, pg8::DownSched, true, true, true, true, 127 - 5 + 4, 127 - 3>    (c.lds3, DM, DE, S, E, c.tid);
}

#ifndef MK_N_LAUNCHES
#define MK_N_LAUNCHES 1
#endif
constexpr int RING_BYTES = 131072, LDSCTL_OFF = RING_BYTES, MISC_OFF = LDSCTL_OFF + 320, LDS_BYTES = 147456;
constexpr int PH_PER_LAYER = 7, NPHASE = 2 + 2 * PH_PER_LAYER;
constexpr int CW_BAR = 4096;
static_assert((CW_BAR + XCD_BAR_WORDS) * 4 <= (int)CTL_ZERO_BYTES, "CTL");

__global__ void __launch_bounds__(512, 2) fwd(Args a) {
    extern __shared__ __attribute__((aligned(16))) unsigned char lds[];
    const int wave_s = __builtin_amdgcn_readfirstlane(threadIdx.x >> 6);
#define MKTID() (wave_s * 64 + lane_id_volatile())
#define MKCTX() Args al = a; { size_t z_ = 0; asm volatile("" : "+s"(z_)); al.ws = a.ws + z_; } Ctx c; {     int t_ = MKTID(); asm volatile("" : "+v"(t_)); c.lds = lds; c.lds3 = (LAS unsigned char*)lds; c.tid = t_; c.lane = t_ & 63; c.wave = __builtin_amdgcn_readfirstlane(t_ >> 6); c.G = gridDim.x; c.bid = blockIdx.x; c.gw = ((c.G % 8 == 0) ? (c.bid % 8) * (c.G / 8) + c.bid / 8 : c.bid) * 8 + c.wave; c.NGW = c.G * 8; }
    const int lo = a.ph_lo, hi = a.ph_hi;
    const bool one = (hi - lo) > 1;
    for (int u = threadIdx.x; u < (LDS_BYTES - LDSCTL_OFF) / 4; u += 512) ((LAS unsigned*)((LAS unsigned char*)lds + LDSCTL_OFF))[u] = 0u;
    __syncthreads();
    XcdBarrier bar; bar.bar = (unsigned*)(a.ws + WS_CTL) + CW_BAR; bar.x = 0; bar.st = nullptr;
    if (one) bar = xcd_barrier_post((unsigned*)(a.ws + WS_CTL) + CW_BAR, (volatile LAS unsigned*)((LAS unsigned char*)lds + MISC_OFF) + 8);
#ifndef REP_PHASE
#define REP_PHASE -1
#endif
#define IN(k) (lo <= (k) && (k) < hi)
#define SEAM(k) do { if (IN(k) && IN((k) + 1)) { XcdBarrier bl_ = bar; { size_t z_ = 0; unsigned x_ = bar.x; asm volatile("" : "+s"(z_), "+s"(x_)); bl_.bar = bar.bar + z_; bl_.x = x_; } xcd_barrier(bl_, MKTID() == 0); } } while (0)
    if (IN(0)) { MKCTX(); ph_prologue(al, c); if (REP_PHASE == 0) { __syncthreads(); ph_prologue(al, c); } SEAM(0); }
    if (IN(1)) { MKCTX(); ph_h1_rows(al, c); if (REP_PHASE == 1) ph_h1_rows(al, c); SEAM(1); }
    {
        constexpr int l = 0; constexpr int p0 = 2 + l * PH_PER_LAYER;
        if (IN(p0 + 0)) { MKCTX(); ph_inproj_fast(al, c, l, false); if (REP_PHASE == 10) { __syncthreads(); ph_inproj_fast(al, c, l, true); } SEAM(p0 + 0); }
        if (IN(p0 + 1)) {
            { MKCTX(); ph_pool(al, c); }
            __syncthreads();
            const attn_body::AttnTensors AT{(const attn_body::bf16*)(a.ws + WS_QKVP), (const attn_body::bf16*)(a.ws + WS_QKVP) + 512, (const attn_body::bf16*)(a.ws + WS_QKVP) + 1024,
                                            (attn_body::bf16*)(a.ws + WS_AD), (const float*)(a.ws + WS_KBAR) + (size_t)l * NB * NH * NBLK * HD};
            const attn_body::StaticOrder S((int)gridDim.x, (int)blockIdx.x);
            attn_body::attn_phase<attn_body::StaticOrder>((char*)lds, AT, S, MKTID());
            if (REP_PHASE == 11) attn_body::attn_phase<attn_body::StaticOrder>((char*)lds, AT, S, MKTID());
            if (REP_PHASE == 17) { __syncthreads(); MKCTX(); ph_pool(al, c); }
            SEAM(p0 + 1);
        }
        if (IN(p0 + 2)) { MKCTX(); ph_wout_fast(al, c, l); if (REP_PHASE == 12) { __syncthreads(); ph_wout_fast(al, c, l); } SEAM(p0 + 2); }
        if (IN(p0 + 3)) { MKCTX(); if (REP_PHASE == 13) { ph_rows_c(al, c, l, false); __syncthreads(); } ph_rows_c(al, c, l, true); SEAM(p0 + 3); }
        if (IN(p0 + 4)) { MKCTX(); ph_gateup_fast(al, c, l); if (REP_PHASE == 14) { __syncthreads(); ph_gateup_fast(al, c, l); } SEAM(p0 + 4); }
        if (IN(p0 + 5)) { MKCTX(); ph_down_fast(al, c, l); if (REP_PHASE == 15) { __syncthreads(); ph_down_fast(al, c, l); } SEAM(p0 + 5); }
        if (IN(p0 + 6)) { MKCTX(); ph_rows_g(al, c, l); if (REP_PHASE == 16) ph_rows_g(al, c, l); SEAM(p0 + 6); }
    }
    {
        constexpr int l = 1; constexpr int p0 = 2 + l * PH_PER_LAYER;
        if (IN(p0 + 0)) { MKCTX(); ph_inproj_fast(al, c, l, false); if (REP_PHASE == 10) { __syncthreads(); ph_inproj_fast(al, c, l, true); } SEAM(p0 + 0); }
        if (IN(p0 + 1)) {
            { MKCTX(); ph_pool(al, c); }
            __syncthreads();
            const attn_body::AttnTensors AT{(const attn_body::bf16*)(a.ws + WS_QKVP), (const attn_body::bf16*)(a.ws + WS_QKVP) + 512, (const attn_body::bf16*)(a.ws + WS_QKVP) + 1024,
                                            (attn_body::bf16*)(a.ws + WS_AD), (const float*)(a.ws + WS_KBAR) + (size_t)l * NB * NH * NBLK * HD};
            const attn_body::StaticOrder S((int)gridDim.x, (int)blockIdx.x);
            attn_body::attn_phase<attn_body::StaticOrder>((char*)lds, AT, S, MKTID());
            if (REP_PHASE == 11) attn_body::attn_phase<attn_body::StaticOrder>((char*)lds, AT, S, MKTID());
            if (REP_PHASE == 17) { __syncthreads(); MKCTX(); ph_pool(al, c); }
            SEAM(p0 + 1);
        }
        if (IN(p0 + 2)) { MKCTX(); ph_wout_fast(al, c, l); if (REP_PHASE == 12) { __syncthreads(); ph_wout_fast(al, c, l); } SEAM(p0 + 2); }
        if (IN(p0 + 3)) { MKCTX(); if (REP_PHASE == 13) { ph_rows_c(al, c, l, false); __syncthreads(); } ph_rows_c(al, c, l, true); SEAM(p0 + 3); }
        if (IN(p0 + 4)) { MKCTX(); ph_gateup_fast(al, c, l); if (REP_PHASE == 14) { __syncthreads(); ph_gateup_fast(al, c, l); } SEAM(p0 + 4); }
        if (IN(p0 + 5)) { MKCTX(); ph_down_fast(al, c, l); if (REP_PHASE == 15) { __syncthreads(); ph_down_fast(al, c, l); } SEAM(p0 + 5); }
        if (IN(p0 + 6)) { MKCTX(); ph_rows_g(al, c, l); if (REP_PHASE == 16) ph_rows_g(al, c, l); SEAM(p0 + 6); }
    }
#undef IN
#undef SEAM
}

extern "C" void kernel_launch(void* const* d_in, const int* in_sizes, int n_in, void* d_out, int out_size, void* d_ws, size_t ws_size, hipStream_t stream) {
    static int grid = 0;
    if (grid == 0) {
        if (n_in != 17 || out_size != NTOK * DM || ws_size < WS_END) { fprintf(stderr, "kernel_launch: unexpected problem (n_in %d out %d ws %zu)\n", n_in, out_size, ws_size); grid = -1; return; }
        if (hipFuncSetAttribute((const void*)fwd, hipFuncAttributeMaxDynamicSharedMemorySize, LDS_BYTES) != hipSuccess) { fprintf(stderr, "kernel_launch: hipFuncSetAttribute failed\n"); grid = -1; return; }
        int dev = 0, cus = 0, per_cu = 0;
        (void)hipGetDevice(&dev); (void)hipDeviceGetAttribute(&cus, hipDeviceAttributeMultiprocessorCount, dev);
        if (hipOccupancyMaxActiveBlocksPerMultiprocessor(&per_cu, (const void*)fwd, 512, LDS_BYTES) != hipSuccess || per_cu < 1) fprintf(stderr, "kernel_launch: occupancy query reports %d workgroups per CU\n", per_cu);
        (void)hipGetLastError();
        grid = cus > 0 ? cus : 256;
    }
    if (grid < 0) return;
    (void)hipMemsetAsync((char*)d_ws + WS_CTL, 0, CTL_ZERO_BYTES, stream);
    Args a{};
    for (int i = 0; i < 17; ++i) a.in[i] = (const float*)d_in[i];
    a.out = (float*)d_out; a.ws = (unsigned char*)d_ws;
#if MK_N_LAUNCHES == 1
    a.ph_lo = 0; a.ph_hi = NPHASE; hipLaunchKernelGGL(fwd, dim3(grid), dim3(512), LDS_BYTES, stream, a);
#else
    for (int p = 0; p < NPHASE; ++p) { a.ph_lo = p; a.ph_hi = p + 1; hipLaunchKernelGGL(fwd, dim3(grid), dim3(512), LDS_BYTES, stream, a); }
#endif
}
```
